# Optimizing an MI355X kernel written in HIP

```python
import math
import jax
import jax.numpy as jnp
from jax import lax
import numpy as np

D_MODEL = 1024
BATCH = 2
SEQ = 8192
DEPTH = 2

CTX_LEN = 256
GRID_W = 64
EPS = 1e-6

N_HEADS = 8
HEAD_DIM = 64
V_DIM = 2 * HEAD_DIM
QK_WIDTH = N_HEADS * 2 * HEAD_DIM
V_WIDTH = N_HEADS * V_DIM
Q_BLOCK = 128
ATTN_SCALE = HEAD_DIM ** -0.5
ROPE_THETA = 10000.0
ROPE_FREQS = HEAD_DIM // 4

LRU_WIDTH = D_MODEL
LRU_BLOCKS = 16
LRU_BLOCK_DIM = LRU_WIDTH // LRU_BLOCKS
LRU_C = 8.0
CONV_W = 4
CONV_LEFT = CONV_W // 2

FOUR_GROUPS = 4
FOUR_WIDTH = D_MODEL
FOUR_GROUP_DIM = FOUR_WIDTH // FOUR_GROUPS

N_BRANCH = 3

COL_K = 0
COL_V = COL_K + QK_WIDTH
COL_LX = COL_V + V_WIDTH
COL_Q = COL_LX + LRU_WIDTH
COL_LG = COL_Q + QK_WIDTH
COL_F = COL_LG + LRU_WIDTH
COL_G = COL_F + FOUR_WIDTH
IN_WIDTH = COL_G + N_BRANCH * D_MODEL

N_EXPERTS = 256
TOP_K = 8
N_GROUPS = 8
TOPK_GROUPS = 4
EXPERT_FF = 256
SHARED_FF = 256
ROUTED_SCALE = 2.5
MOE_BLOCK = 128

kernel_name = 'hybrid_diffattn_rglru_fourier_moe_dit'


def rms_norm(x, g):
    xf = x.astype(jnp.float32)
    y = xf * lax.rsqrt(jnp.mean(xf * xf, axis=-1, keepdims=True) + EPS)
    return (y * g.astype(jnp.float32)).astype(x.dtype)


def modulate(h, shift, scale):
    return h * (1 + scale) + shift


def axial_rope_tables(n_tokens):
    rows = n_tokens // GRID_W
    row = jnp.repeat(jnp.arange(rows), GRID_W)
    col = jnp.tile(jnp.arange(GRID_W), rows)
    inv = ROPE_THETA ** (-jnp.arange(ROPE_FREQS, dtype=jnp.float32) / ROPE_FREQS)
    ang = jnp.stack([row[:, None] * inv, col[:, None] * inv], axis=1)
    return jnp.cos(ang), jnp.sin(ang)


def apply_axial_rope(x, cos, sin):
    sh = x.shape
    xr = x.reshape(sh[:-1] + (2, 2, ROPE_FREQS)).astype(jnp.float32)
    x1, x2 = xr[..., 0, :], xr[..., 1, :]
    c = cos[:, None, None]
    s = sin[:, None, None]
    out = jnp.stack([x1 * c - x2 * s, x1 * s + x2 * c], axis=-2)
    return out.reshape(sh).astype(x.dtype)


def qk_heads(u, col):
    return u[..., col:col + QK_WIDTH].reshape(u.shape[:2] + (N_HEADS, 2, HEAD_DIM))


def v_heads(u):
    return u[..., COL_V:COL_V + V_WIDTH].reshape(u.shape[:2] + (N_HEADS, V_DIM))


def diff_read(q, k, v, lam):
    s = jnp.einsum('bqhmd,bkhmd->bhmqk', q, k, preferred_element_type=jnp.float32) * ATTN_SCALE
    p = jax.nn.softmax(s, axis=-1)
    w = p[:, :, 0] - lam * p[:, :, 1]
    return jnp.einsum('bhqk,bkhe->bqhe', w.astype(v.dtype), v)


def centred_conv(x, w, b):
    t = x.shape[1]
    xp = jnp.pad(x, ((0, 0), (CONV_LEFT, CONV_W - 1 - CONV_LEFT), (0, 0)))
    y = xp[:, 0:t] * w[0]
    for j in range(1, CONV_W):
        y = y + xp[:, j:j + t] * w[j]
    return y + b


def block_diag(x, w, b):
    xs = x.reshape(x.shape[:-1] + (LRU_BLOCKS, LRU_BLOCK_DIM))
    return jnp.einsum('btnd,nde->btne', xs, w).reshape(x.shape) + b


def rglru_coeffs(xc, wa, ba, wi, bi, lam):
    r = jax.nn.sigmoid(block_diag(xc, wa, ba).astype(jnp.float32))
    i = jax.nn.sigmoid(block_diag(xc, wi, bi).astype(jnp.float32))
    log_a = -LRU_C * r * jax.nn.softplus(-lam.astype(jnp.float32))
    a = jnp.exp(log_a)
    mult = jnp.sqrt(-jnp.expm1(2.0 * log_a))
    return a, mult * i * xc.astype(jnp.float32)


def linear_scan(a, b, h0=None):
    def combine(left, right):
        return left[0] * right[0], right[0] * left[1] + right[1]
    a_cum, h = lax.associative_scan(combine, (a, b), axis=1)
    if h0 is not None:
        h = h + a_cum * h0[:, None, :]
    return h


def rglru_bidir(xl, xc, conv_w, conv_b, wa, ba, wi, bi, lam, ctx_out):
    ul = centred_conv(xl, conv_w, conv_b)
    uc = centred_conv(xc, conv_w, conv_b)
    outs_l, outs_c = [], []
    for d, rev in ((0, False), (1, True)):
        a_l, b_l = rglru_coeffs(ul, wa[d], ba[d], wi[d], bi[d], lam[d])
        a_c, b_c = rglru_coeffs(uc, wa[d], ba[d], wi[d], bi[d], lam[d])
        if rev:
            a_l, b_l, a_c, b_c = jnp.flip(a_l, 1), jnp.flip(b_l, 1), jnp.flip(a_c, 1), jnp.flip(b_c, 1)
        h_c = linear_scan(a_c, b_c)
        h_l = linear_scan(a_l, b_l, h_c[:, -1])
        if rev:
            h_l, h_c = jnp.flip(h_l, 1), jnp.flip(h_c, 1)
        outs_l.append(h_l)
        outs_c.append(h_c)
    rec_l = (outs_l[0] + outs_l[1]).astype(xl.dtype)
    if not ctx_out:
        return rec_l, None
    return rec_l, (outs_c[0] + outs_c[1]).astype(xc.dtype)


def fourier_mix(u):
    bsz, t = u.shape[:2]
    ug = u.reshape(bsz, t, FOUR_GROUPS, FOUR_GROUP_DIM).astype(jnp.float32)
    f = jnp.fft.fft2(ug, axes=(1, 3), norm='ortho')
    return jnp.real(f).reshape(bsz, t, FOUR_WIDTH).astype(u.dtype)


def token_mixer(hl, hc, w_in, q_norm_g, k_norm_g, lambda_qk, subln_g, w_attn_o,
                conv_w, conv_b, lru_wa, lru_ba, lru_wi, lru_bi, lru_lambda,
                w_lru_o, w_four_o, w_out, lam_init, cos, sin, ctx_out):
    bsz, n_lat, _ = hl.shape
    ul = hl @ w_in
    uc = hc @ (w_in if ctx_out else w_in[:, :COL_Q])

    lq = lambda_qk.astype(jnp.float32)
    lam = jnp.exp(jnp.sum(lq[0] * lq[1])) - jnp.exp(jnp.sum(lq[2] * lq[3])) + lam_init
    k_l = apply_axial_rope(rms_norm(qk_heads(ul, COL_K), k_norm_g), cos, sin)
    k_c = rms_norm(qk_heads(uc, COL_K), k_norm_g)
    v_c = v_heads(uc)
    k_all = jnp.concatenate([k_c, k_l], axis=1)
    v_all = jnp.concatenate([v_c, v_heads(ul)], axis=1)
    q_l = apply_axial_rope(rms_norm(qk_heads(ul, COL_Q), q_norm_g), cos, sin)
    n_blk = n_lat // Q_BLOCK
    q_blocks = q_l.reshape(bsz, n_blk, Q_BLOCK, N_HEADS, 2, HEAD_DIM).swapaxes(0, 1)
    o_l = lax.map(lambda qb: diff_read(qb, k_all, v_all, lam), q_blocks)
    o_l = o_l.swapaxes(0, 1).reshape(bsz, n_lat, N_HEADS, V_DIM)

    def attn_out(o):
        o = rms_norm(o, subln_g) * (1.0 - lam_init)
        return o.reshape(o.shape[:2] + (V_WIDTH,)) @ w_attn_o

    rec_l, rec_c = rglru_bidir(ul[..., COL_LX:COL_LX + LRU_WIDTH], uc[..., COL_LX:COL_LX + LRU_WIDTH],
                               conv_w, conv_b, lru_wa, lru_ba, lru_wi, lru_bi, lru_lambda, ctx_out)

    def merge(u, attn, rec):
        gates = jax.nn.sigmoid(u[..., COL_G:].reshape(u.shape[:2] + (N_BRANCH, D_MODEL)))
        rec_o = (rec * jax.nn.gelu(u[..., COL_LG:COL_LG + LRU_WIDTH])) @ w_lru_o
        four_o = fourier_mix(u[..., COL_F:COL_F + FOUR_WIDTH]) @ w_four_o
        mixed = gates[..., 0, :] * attn_out(attn) + gates[..., 1, :] * rec_o + gates[..., 2, :] * four_o
        return mixed @ w_out

    y_l = merge(ul, o_l, rec_l)
    if not ctx_out:
        return y_l, None
    q_c = rms_norm(qk_heads(uc, COL_Q), q_norm_g)
    o_c = diff_read(q_c, k_c, v_c, lam)
    return y_l, merge(uc, o_c, rec_c)


def moe_ffn(h, router_w, router_b, w_gate, w_up, w_down, ws_gate, ws_up, ws_down):
    n_tok, d = h.shape
    scores = jax.nn.sigmoid(jnp.dot(h, router_w, preferred_element_type=jnp.float32))
    biased = scores + router_b.astype(jnp.float32)
    grp_score = lax.top_k(biased.reshape(n_tok, N_GROUPS, N_EXPERTS // N_GROUPS), 2)[0].sum(-1)
    _, grp_idx = lax.top_k(grp_score, TOPK_GROUPS)
    grp_mask = jax.nn.one_hot(grp_idx, N_GROUPS, dtype=jnp.float32).sum(-2) > 0
    exp_mask = jnp.repeat(grp_mask, N_EXPERTS // N_GROUPS, axis=-1)
    _, top_idx = lax.top_k(jnp.where(exp_mask, biased, -jnp.inf), TOP_K)
    top_w = jnp.take_along_axis(scores, top_idx, axis=-1)
    top_w = top_w / jnp.sum(top_w, axis=-1, keepdims=True) * ROUTED_SCALE

    n_assign = n_tok * TOP_K
    e_flat = top_idx.reshape(-1)
    tok_flat = jnp.arange(n_assign, dtype=jnp.int32) // TOP_K
    order = jnp.argsort(e_flat)
    e_sorted = e_flat[order]
    counts = jnp.bincount(e_flat, length=N_EXPERTS)
    padded = (counts + MOE_BLOCK - 1) // MOE_BLOCK * MOE_BLOCK
    ends = jnp.cumsum(padded)
    dest = (ends - padded)[e_sorted] + jnp.arange(n_assign, dtype=jnp.int32) - (jnp.cumsum(counts) - counts)[e_sorted]
    n_blocks = -(-(n_assign + N_EXPERTS * (MOE_BLOCK - 1)) // MOE_BLOCK)
    buf_tok = jnp.full((n_blocks * MOE_BLOCK,), n_tok, jnp.int32).at[dest].set(tok_flat[order])
    buf_w = jnp.zeros((n_blocks * MOE_BLOCK,), jnp.float32).at[dest].set(top_w.reshape(-1)[order])
    block_e = jnp.minimum(jnp.searchsorted(ends, jnp.arange(n_blocks, dtype=jnp.int32) * MOE_BLOCK, side='right'),
                          N_EXPERTS - 1)
    h_pad = jnp.concatenate([h, jnp.zeros((1, d), h.dtype)], axis=0)

    def expert_block(acc, blk):
        tok, wt, e = blk
        xb = h_pad[tok]
        yb = (jax.nn.silu(xb @ w_gate[e]) * (xb @ w_up[e])) @ w_down[e]
        return acc.at[tok].add(yb.astype(jnp.float32) * wt[:, None]), None

    acc, _ = lax.scan(expert_block, jnp.zeros((n_tok + 1, d), jnp.float32),
                      (buf_tok.reshape(n_blocks, MOE_BLOCK), buf_w.reshape(n_blocks, MOE_BLOCK), block_e))
    shared = (jax.nn.silu(h @ ws_gate) * (h @ ws_up)) @ ws_down
    return (acc[:n_tok] + shared.astype(jnp.float32)).astype(h.dtype)


def setup_inputs(seed: int = 0) -> dict:
    key = jax.random.key(seed)
    ks = iter(jax.random.split(key, 48))
    L, D = DEPTH, D_MODEL

    def nrm(shape, scale):
        return jax.random.normal(next(ks), shape, jnp.float32) * scale

    u = jax.random.uniform(next(ks), (L, 2, LRU_WIDTH), jnp.float32, 0.9, 0.999)
    a0 = u ** (1.0 / LRU_C)
    lru_lambda = jnp.log(a0) - jnp.log1p(-a0)
    return {
        'x': nrm((BATCH, SEQ, D), 1.0),
        'c': nrm((BATCH, D), 1.0),
        'ctx': nrm((BATCH, CTX_LEN, D), 1.0),
        'c_ctx': nrm((D,), 1.0),
        'w_mod': nrm((L, D, 6 * D), 0.5 * D ** -0.5),
        'b_mod': nrm((L, 6 * D), 0.02),
        'norm1_g': 1.0 + nrm((L, D), 0.02),
        'w_in': nrm((L, D, IN_WIDTH), D ** -0.5),
        'q_norm_g': 1.0 + nrm((L, HEAD_DIM), 0.02),
        'k_norm_g': 1.0 + nrm((L, HEAD_DIM), 0.02),
        'lambda_qk': nrm((L, 4, HEAD_DIM), 0.1),
        'subln_g': 1.0 + nrm((L, V_DIM), 0.02),
        'w_attn_o': nrm((L, V_WIDTH, D), V_WIDTH ** -0.5),
        'conv_w': nrm((L, CONV_W, LRU_WIDTH), CONV_W ** -0.5),
        'conv_b': nrm((L, LRU_WIDTH), 0.02),
        'lru_wa': nrm((L, 2, LRU_BLOCKS, LRU_BLOCK_DIM, LRU_BLOCK_DIM), LRU_BLOCK_DIM ** -0.5),
        'lru_ba': nrm((L, 2, LRU_WIDTH), 0.02),
        'lru_wi': nrm((L, 2, LRU_BLOCKS, LRU_BLOCK_DIM, LRU_BLOCK_DIM), LRU_BLOCK_DIM ** -0.5),
        'lru_bi': nrm((L, 2, LRU_WIDTH), 0.02),
        'lru_lambda': lru_lambda,
        'w_lru_o': nrm((L, LRU_WIDTH, D), LRU_WIDTH ** -0.5),
        'w_four_o': nrm((L, FOUR_WIDTH, D), FOUR_WIDTH ** -0.5),
        'w_out': nrm((L, D, D), D ** -0.5),
        'norm2_g': 1.0 + nrm((L, D), 0.02),
        'router_w': nrm((L, D, N_EXPERTS), D ** -0.5),
        'router_b': nrm((L, N_EXPERTS), 0.01),
        'exp_w_gate': nrm((L, N_EXPERTS, D, EXPERT_FF), D ** -0.5),
        'exp_w_up': nrm((L, N_EXPERTS, D, EXPERT_FF), D ** -0.5),
        'exp_w_down': nrm((L, N_EXPERTS, EXPERT_FF, D), EXPERT_FF ** -0.5),
        'sh_w_gate': nrm((L, D, SHARED_FF), D ** -0.5),
        'sh_w_up': nrm((L, D, SHARED_FF), D ** -0.5),
        'sh_w_down': nrm((L, SHARED_FF, D), SHARED_FF ** -0.5),
    }


def reference(x, c, ctx, c_ctx, w_mod, b_mod, norm1_g, w_in, q_norm_g, k_norm_g, lambda_qk, subln_g,
              w_attn_o, conv_w, conv_b, lru_wa, lru_ba, lru_wi, lru_bi, lru_lambda, w_lru_o, w_four_o,
              w_out, norm2_g, router_w, router_b, exp_w_gate, exp_w_up, exp_w_down,
              sh_w_gate, sh_w_up, sh_w_down):
    bsz, n_lat, d = x.shape
    n_ctx = ctx.shape[1]
    cos, sin = axial_rope_tables(n_lat)
    xl, xc = x, ctx
    for l in range(DEPTH):
        last = l == DEPTH - 1
        lam_init = 0.8 - 0.6 * math.exp(-0.3 * l)
        mod_l = (jax.nn.silu(c) @ w_mod[l] + b_mod[l])[:, None, :]
        mod_c = (jax.nn.silu(c_ctx) @ w_mod[l] + b_mod[l])[None, None, :]
        sh1, sc1, g1, sh2, sc2, g2 = jnp.split(mod_l, 6, axis=-1)
        csh1, csc1, cg1, csh2, csc2, cg2 = jnp.split(mod_c, 6, axis=-1)

        hl = modulate(rms_norm(xl, norm1_g[l]), sh1, sc1)
        hc = modulate(rms_norm(xc, norm1_g[l]), csh1, csc1)
        y_l, y_c = token_mixer(hl, hc, w_in[l], q_norm_g[l], k_norm_g[l], lambda_qk[l], subln_g[l],
                               w_attn_o[l], conv_w[l], conv_b[l], lru_wa[l], lru_ba[l], lru_wi[l],
                               lru_bi[l], lru_lambda[l], w_lru_o[l], w_four_o[l], w_out[l],
                               lam_init, cos, sin, not last)
        xl = xl + g1 * y_l
        tokens = modulate(rms_norm(xl, norm2_g[l]), sh2, sc2).reshape(-1, d)
        if not last:
            xc = xc + cg1 * y_c
            tokens = jnp.concatenate(
                [tokens, modulate(rms_norm(xc, norm2_g[l]), csh2, csc2).reshape(-1, d)], axis=0)
        f = moe_ffn(tokens, router_w[l], router_b[l], exp_w_gate[l], exp_w_up[l], exp_w_down[l],
                    sh_w_gate[l], sh_w_up[l], sh_w_down[l])
        xl = xl + g2 * f[:bsz * n_lat].reshape(bsz, n_lat, d)
        if not last:
            xc = xc + cg2 * f[bsz * n_lat:].reshape(bsz, n_ctx, d)
    return xl
```

```cpp
#include <hip/hip_runtime.h>
#include <cstdio>
#include <cstdint>

#ifndef N_LAUNCH_MODE
#define N_LAUNCH_MODE 0
#endif

namespace pg8 {
#define PG8_LAS __attribute__((address_space(3)))
typedef unsigned short bf16_t;
typedef short bf16x8 __attribute__((ext_vector_type(8)));
typedef float f32x4 __attribute__((ext_vector_type(4)));
typedef unsigned u32x4 __attribute__((ext_vector_type(4)));
constexpr int BM = 256, BK = 64, HALF = 128, HTB = HALF * BK * 2, STAGE_BYTES = 8 * HTB, NXCD = 8, WGM = 8;
__host__ __device__ __forceinline__ int lds_byte(int r, int c) { const int st = (r >> 4) * 2 + (c >> 5), rr = r & 15, cc = c & 31, ob = rr * 64 + cc * 2; return st * 1024 + (ob ^ (((ob >> 9) & 1) << 5)); }
__host__ __device__ __forceinline__ void stage_rc(int b, int& R, int& C) { const int st = b / 1024, sb = b % 1024, swz = sb ^ (((sb >> 9) & 1) << 5); R = (st >> 1) * 16 + swz / 64; C = (st & 1) * 32 + (swz % 64) / 2; }
__host__ __device__ __forceinline__ int perm32(int rho) { const int n = rho >> 4, i = rho & 15; return 8 * (i >> 2) + 4 * n + (i & 3); }
struct Unit { int pm, pn; };
struct Gemm { const bf16_t* A; const bf16_t* Bt; int M, N, K, lda, ldb; };
struct StaticOrder {
    int nM, nN, nwg, G, c;
    __host__ __device__ void init(int M, int N, int G_, int c_) { nM = M / BM; nN = N / BM; nwg = nM * nN; G = G_; c = c_; }
    __host__ __device__ bool next(int i, Unit& u) const {
        const long L = (long)i * G + c; if (L >= nwg) return false;
        int wgid = (int)L; { const int q = nwg / NXCD, r = nwg % NXCD, xcd = wgid % NXCD, off = wgid / NXCD; wgid = (xcd < r ? xcd * (q + 1) : r * (q + 1) + (xcd - r) * q) + off; }
        const int nig = WGM * nN, gid = wgid / nig, fm = gid * WGM, gsz = (nM - fm) < WGM ? (nM - fm) : WGM;
        u.pm = fm + ((wgid % nig) % gsz); u.pn = (wgid % nig) / gsz; return true;
    }
};
__device__ __forceinline__ unsigned cvt_pk_bf16(float lo, float hi) { unsigned r; asm volatile("v_cvt_pk_bf16_f32 %0, %1, %2" : "=v"(r) : "v"(lo), "v"(hi)); return r; }

struct EpiF32 {
    static constexpr bool PERM = false;
    float* C; int ldc;
    __device__ __forceinline__ void operator()(const f32x4 (&acc)[2][2][4][2], const Unit& u, int wr, int wc, int fr, int fq) const {
        const int row0 = u.pm * BM + wr * 64 + fr, col0 = u.pn * BM + wc * 32 + 4 * fq;
#pragma unroll
        for (int ai = 0; ai < 2; ++ai)
#pragma unroll
            for (int m = 0; m < 4; ++m) { float* rowp = C + (size_t)(row0 + ai * HALF + m * 16) * ldc + col0;
#pragma unroll
                for (int bj = 0; bj < 2; ++bj)
#pragma unroll
                    for (int n = 0; n < 2; ++n) *(f32x4*)(rowp + bj * HALF + n * 16) = acc[ai][bj][m][n]; }
    }
};

template <class Epi>
__device__ __forceinline__ void gemm_phase(PG8_LAS unsigned char* lds, const Gemm g, const StaticOrder& S, const Epi& E) {
    const int tid = threadIdx.x, wid = __builtin_amdgcn_readfirstlane(tid >> 6), lane = tid & 63, wr = wid >> 2, wc = wid & 3, fr = lane & 15, fq = lane >> 4;
    const int K = g.K, nt = K / BK;
    unsigned voffA[2], voffB[2];
#pragma unroll
    for (int i = 0; i < 2; ++i) { int R, C; stage_rc(tid * 16 + i * 8192, R, C); const int Rb = Epi::PERM ? ((R & ~31) + perm32(R & 31)) : R;
        voffA[i] = (unsigned)(R * g.lda + C) * 2u; voffB[i] = (unsigned)(Rb * g.ldb + C) * 2u; }
    const size_t kstep = (size_t)(BK * 2);
    const size_t hA = (size_t)HALF * g.lda * 2, hB = (size_t)HALF * g.ldb * 2;
    const size_t tA = 2 * hA, tB = 2 * hB;
    const unsigned ldsw = (unsigned)wid * 1024u;
    const int aoff = lds_byte(wr * 64 + fr, fq * 8), boff = lds_byte(wc * 32 + fr, fq * 8);
#define PG8_SA(b, h) (((b) * 2 + (h)) * HTB)
#define PG8_SB(b, h) ((4 + (b) * 2 + (h)) * HTB)
#define PG8_STAGE(bufoff, gbase, voff) do { _Pragma("unroll") for (int _i = 0; _i < 2; ++_i) \
        __builtin_amdgcn_global_load_lds((const unsigned*)((const char*)(gbase) + (voff)[_i]), (PG8_LAS unsigned*)(lds + (bufoff) + ldsw + _i * 8192), 16, 0, 0); } while (0)
#define PG8_LDA(dst, b, h) do { _Pragma("unroll") for (int m = 0; m < 4; ++m) _Pragma("unroll") for (int k = 0; k < 2; ++k) dst[m][k] = *(const PG8_LAS bf16x8*)(lds + PG8_SA(b, h) + aoff + m * 2048 + k * 1024); } while (0)
#define PG8_LDB(dst, b, h) do { _Pragma("unroll") for (int n = 0; n < 2; ++n) _Pragma("unroll") for (int k = 0; k < 2; ++k) dst[n][k] = *(const PG8_LAS bf16x8*)(lds + PG8_SB(b, h) + boff + n * 2048 + k * 1024); } while (0)
#define PG8_MMA(ai, bj, At, Bt) do { __builtin_amdgcn_s_setprio(1); _Pragma("unroll") for (int m = 0; m < 4; ++m) _Pragma("unroll") for (int n = 0; n < 2; ++n) _Pragma("unroll") for (int k = 0; k < 2; ++k) \
        acc[ai][bj][m][n] = __builtin_amdgcn_mfma_f32_16x16x32_bf16(Bt[n][k], At[m][k], acc[ai][bj][m][n], 0, 0, 0); __builtin_amdgcn_s_setprio(0); } while (0)
#define PG8_WAIT_V(n) asm volatile("s_waitcnt vmcnt(" #n ")" ::: "memory")
#define PG8_WAIT_L(n) asm volatile("s_waitcnt lgkmcnt(" #n ")" ::: "memory")
#define PG8_BAR __builtin_amdgcn_s_barrier()
#define PG8_SCHED __builtin_amdgcn_sched_barrier(0)
    Unit cur, nxt; int ui = 0;
    if (!S.next(0, cur)) return;
    f32x4 acc[2][2][4][2];
#pragma unroll
    for (int a = 0; a < 2; ++a)
#pragma unroll
        for (int b = 0; b < 2; ++b)
#pragma unroll
            for (int m = 0; m < 4; ++m)
#pragma unroll
                for (int n = 0; n < 2; ++n) acc[a][b][m][n] = (f32x4){0.f, 0.f, 0.f, 0.f};
    bf16x8 At[4][2], B0[2][2], B1[2][2];
    const char* cA = (const char*)g.A + (size_t)cur.pm * tA; const char* cB = (const char*)g.Bt + (size_t)cur.pn * tB;
    PG8_STAGE(PG8_SB(0, 0), cB, voffB); PG8_STAGE(PG8_SB(0, 1), cB + hB, voffB); PG8_STAGE(PG8_SA(0, 0), cA, voffA); PG8_STAGE(PG8_SA(0, 1), cA + hA, voffA);
    if (wr == 1) PG8_BAR;
    PG8_WAIT_V(2); PG8_BAR;
    PG8_STAGE(PG8_SB(1, 0), cB + kstep, voffB); PG8_STAGE(PG8_SA(1, 0), cA + kstep, voffA); PG8_STAGE(PG8_SB(1, 1), cB + hB + kstep, voffB);
    PG8_WAIT_V(6); PG8_BAR;
    for (;;) {
        const bool has_next = S.next(ui + 1, nxt);
        const char* nA = has_next ? (const char*)g.A + (size_t)nxt.pm * tA : cA; const char* nB = has_next ? (const char*)g.Bt + (size_t)nxt.pn * tB : cB;
        for (int t = 0; t < nt; t += 2) {
            const bool last = (t == nt - 2);
            const char* a1 = cA + (size_t)(t + 1) * kstep;
            const char* a2 = last ? nA : cA + (size_t)(t + 2) * kstep; const char* b2 = last ? nB : cB + (size_t)(t + 2) * kstep;
            const char* a3 = a2 + kstep; const char* b3 = b2 + kstep;
            PG8_LDB(B0, 0, 0); PG8_LDB(B1, 0, 1); PG8_SCHED; PG8_LDA(At, 0, 0); PG8_STAGE(PG8_SA(1, 1), a1 + hA, voffA);
            PG8_WAIT_V(8); PG8_WAIT_L(0); PG8_BAR; PG8_MMA(0, 0, At, B0); PG8_MMA(0, 1, At, B1); PG8_BAR; PG8_SCHED;
            PG8_LDA(At, 0, 1); PG8_STAGE(PG8_SB(0, 0), b2, voffB); PG8_STAGE(PG8_SB(0, 1), b2 + hB, voffB); PG8_STAGE(PG8_SA(0, 0), a2, voffA);
            PG8_WAIT_V(8); PG8_WAIT_L(0); PG8_BAR; PG8_MMA(1, 0, At, B0); PG8_MMA(1, 1, At, B1); PG8_BAR; PG8_SCHED;
            PG8_LDB(B0, 1, 0); PG8_LDB(B1, 1, 1); PG8_SCHED; PG8_LDA(At, 1, 0); PG8_STAGE(PG8_SA(0, 1), a2 + hA, voffA);
            PG8_WAIT_V(8); PG8_WAIT_L(0); PG8_BAR; PG8_MMA(0, 0, At, B0); PG8_MMA(0, 1, At, B1); PG8_BAR; PG8_SCHED;
            PG8_LDA(At, 1, 1); PG8_STAGE(PG8_SB(1, 0), b3, voffB); PG8_STAGE(PG8_SB(1, 1), b3 + hB, voffB); PG8_STAGE(PG8_SA(1, 0), a3, voffA);
            PG8_WAIT_V(8); PG8_WAIT_L(0); PG8_BAR; PG8_MMA(1, 0, At, B0); PG8_MMA(1, 1, At, B1); PG8_BAR; PG8_SCHED;
        }
        if (wr == 0) PG8_BAR;
        E(acc, cur, wr, wc, fr, fq);
        if (!has_next) break;
#pragma unroll
        for (int a = 0; a < 2; ++a)
#pragma unroll
            for (int b = 0; b < 2; ++b)
#pragma unroll
                for (int m = 0; m < 4; ++m)
#pragma unroll
                    for (int n = 0; n < 2; ++n) acc[a][b][m][n] = (f32x4){0.f, 0.f, 0.f, 0.f};
        cur = nxt; cA = nA; cB = nB; ++ui;
        if (wr == 1) PG8_BAR;
    }
    PG8_WAIT_V(0);
    PG8_BAR;
#undef PG8_SA
#undef PG8_SB
#undef PG8_STAGE
#undef PG8_LDA
#undef PG8_LDB
#undef PG8_MMA
#undef PG8_WAIT_V
#undef PG8_WAIT_L
#undef PG8_BAR
#undef PG8_SCHED
}
}

constexpr int DM = 1024, NB = 2, SEQ = 8192, CTX = 256, TPB = SEQ + CTX, MROWS = NB * TPB, DEPTH = 2;
constexpr int INW = 9216, COL_K = 0, COL_V = 1024, COL_LX = 2048, COL_Q = 3072, COL_LG = 4096, COL_F = 5120, COL_G = 6144;
constexpr int NE = 256, TOPK = 8, EFF = 256, NPAIR = MROWS * TOPK, LCAP = MROWS;
constexpr float EPS = 1e-6f;
constexpr float QSCALE = 0.125f * 1.4426950408889634f;
constexpr int NCHUNK = TPB / 64;
static_assert(MROWS % 256 == 0, "rows");

constexpr size_t MiB = 1u << 20;
constexpr size_t WS_CTL = 0, CTL_ZERO_BYTES = 1 * MiB;
constexpr size_t WS_W = 1 * MiB, WL_STRIDE = 32 * MiB;
constexpr size_t WO_WIN = 0, WO_D1 = 18 * MiB, WO_OUT = 24 * MiB, WO_R = 26 * MiB, WO_SGU = 27 * MiB, WO_SD = 28 * MiB, WO_LRU = 29 * MiB;
constexpr size_t WS_XALL = 65 * MiB;
constexpr size_t WS_H = WS_XALL + 66 * MiB;
constexpr size_t WS_U = WS_H + 33 * MiB;
constexpr size_t WS_KB = WS_U + 594 * MiB, WS_VB = WS_KB + 33 * MiB, WS_QB = WS_VB + 33 * MiB, WS_LXB = WS_QB + 33 * MiB, WS_GLG = WS_LXB + 33 * MiB, WS_ZP = WS_GLG + 33 * MiB;
constexpr size_t WS_GATES = WS_ZP + 33 * MiB;
constexpr size_t WS_MIXIN = WS_GATES + 99 * MiB;
constexpr size_t WS_S = WS_MIXIN + 99 * MiB;
constexpr size_t WS_UC = WS_S, WS_AB = WS_UC + 33 * MiB, WS_SUMM = WS_AB + 132 * MiB, WS_CARRY = WS_SUMM + 5 * MiB, WS_XA = WS_CARRY + 3 * MiB, WS_XB = WS_XA + 32 * MiB, WS_GB = WS_XB + 32 * MiB, WS_GC = WS_GB + 32 * MiB;
constexpr size_t WS_PA = WS_S, WS_PR = WS_PA + 66 * MiB, WS_PF = WS_PR + 66 * MiB, WS_Y1 = WS_PF + 66 * MiB;
static_assert(WS_GC + 3 * MiB <= WS_S + 280 * MiB && WS_Y1 + 66 * MiB <= WS_S + 280 * MiB, "scratch S");
constexpr size_t WS_MIXED = WS_S + 280 * MiB, WS_TOK = WS_MIXED + 33 * MiB;
constexpr size_t WS_LOG = WS_TOK + 33 * MiB, WS_SGU = WS_LOG + 17 * MiB, WS_SH = WS_SGU + 33 * MiB, WS_LIST = WS_SH + 9 * MiB, WS_TOPW = WS_LIST + 17 * MiB, WS_SD = WS_TOPW + 1 * MiB;
constexpr size_t WS_YB = WS_U;
constexpr size_t WS_END = WS_SD + 66 * MiB;
static_assert(WS_END <= 2048 * MiB, "d_ws budget");
constexpr int CW_BAR = 4096;
constexpr int CW_CNT = 16384;
constexpr int CW_MOD = 65536;
static_assert((CW_MOD + 2 * 3 * 6144) * 4 <= (int)CTL_ZERO_BYTES, "ctl");

constexpr int LDS_BYTES = 147456, RING_BYTES = 131072, MISC_OFF = RING_BYTES + 320;
constexpr int NWAVES = 8;

#define GAS __attribute__((address_space(1)))
#define LAS __attribute__((address_space(3)))
typedef unsigned short bf16;
typedef unsigned v4u __attribute__((ext_vector_type(4)));
typedef float f32x4 __attribute__((ext_vector_type(4)));
typedef GAS unsigned gu32;
#define RLX_AGENT __ATOMIC_RELAXED, __HIP_MEMORY_SCOPE_AGENT
#define LDS_WAIT() asm volatile("s_waitcnt lgkmcnt(0)" ::: "memory")
__device__ __forceinline__ unsigned f2bf(float f) { unsigned u = __builtin_bit_cast(unsigned, f); return (u + 0x7fffu + ((u >> 16) & 1u)) >> 16; }
__device__ __forceinline__ unsigned pk2(float lo, float hi) { return f2bf(lo) | (f2bf(hi) << 16); }
__device__ __forceinline__ float bf2f(unsigned h) { return __uint_as_float(h << 16); }
__device__ __forceinline__ float sigmoidf_(float x) { return 1.f / (1.f + __expf(-x)); }
__device__ __forceinline__ float siluf_(float x) { return x / (1.f + __expf(-x)); }
__device__ __forceinline__ float gelu_tanh(float x) { const float u = 0.7978845608028654f * (x + 0.044715f * x * x * x); return 0.5f * x * (1.f + tanhf(u)); }

#define XB_TMO      128
#define XB_XCNT(j)  (256  + 64 * (j))
#define XB_XSUB(j)  (1280 + 64 * (j))
#define XB_XGEN(j)  (2304 + 64 * (j))
#define XB_TOP      3328
#define XB_TOPGEN   3392
#define XCD_BAR_WORDS 3456
#define XB_SPIN_CAP (1u << 18)
__device__ __forceinline__ unsigned xb_ld(unsigned* p)              { return __hip_atomic_load(p, __ATOMIC_RELAXED, __HIP_MEMORY_SCOPE_AGENT); }
__device__ __forceinline__ unsigned xb_add(unsigned* p, unsigned v) { return __hip_atomic_fetch_add(p, v, __ATOMIC_RELAXED, __HIP_MEMORY_SCOPE_AGENT); }
__device__ __forceinline__ unsigned xb_xcc_id() { return (unsigned)__builtin_amdgcn_s_getreg((3 << 11) | 20) & 0xFu; }
#define XB_SPIN(cond, bar) do { unsigned _sp = 0; while (cond) { __builtin_amdgcn_s_sleep(1); \
    if ((++_sp & 255u) == 0u) { if (xb_ld(&(bar)[XB_TMO])) break; if (_sp > XB_SPIN_CAP) { atomicAdd(&(bar)[XB_TMO], 1u); break; } } } } while (0)
struct XcdBarrier { unsigned* bar; unsigned x; volatile LAS unsigned* st; };
__device__ __forceinline__ XcdBarrier xcd_barrier_post(unsigned* bar, volatile LAS unsigned* st) {
    XcdBarrier b; b.bar = bar; b.x = xb_xcc_id(); b.st = st;
    if (threadIdx.x == 0) (void)xb_add(&bar[XB_XCNT(b.x)], 1u);
    return b;
}
__device__ __forceinline__ void xcd_barrier_complete(unsigned* bar, unsigned x, unsigned& nloc, unsigned& nx) {
    const unsigned G = gridDim.x * gridDim.y * gridDim.z;
    unsigned sum, cnt, mine, sp = 0u;
    for (;;) {
        sum = 0u; cnt = 0u; mine = 0u;
#pragma unroll
        for (unsigned j = 0; j < 16; ++j) { const unsigned c = xb_ld(&bar[XB_XCNT(j)]); sum += c; cnt += (c > 0u) ? 1u : 0u; mine = (j == x) ? c : mine; }
        if (sum == G) break;
        __builtin_amdgcn_s_sleep(1);
        if ((++sp & 255u) == 0u) { if (xb_ld(&bar[XB_TMO])) break; if (sp > XB_SPIN_CAP) { atomicAdd(&bar[XB_TMO], 1u); break; } }
    }
    nloc = mine > 0u ? mine : 1u; nx = cnt > 0u ? cnt : 1u;
}
__device__ __forceinline__ void xcd_barrier(const XcdBarrier& b) {
    asm volatile("s_waitcnt vmcnt(0)" ::: "memory");
    __syncthreads();
    if (threadIdx.x == 0) {
        unsigned* bar = b.bar;
        __builtin_amdgcn_s_waitcnt(0);
        unsigned nloc = b.st[0], nx = b.st[1];
        if (nloc == 0u) { xcd_barrier_complete(bar, b.x, nloc, nx); b.st[0] = nloc; b.st[1] = nx; }
        const unsigned old = xb_add(&bar[XB_XSUB(b.x)], 1u);
        const unsigned gen = old / nloc;
        if (old + 1u == (gen + 1u) * nloc) {
            __builtin_amdgcn_fence(__ATOMIC_RELEASE, "agent");
            asm volatile("s_waitcnt vmcnt(0)" ::: "memory");
            const unsigned og = xb_add(&bar[XB_TOP], 1u);
            const unsigned tg = og / nx;
            if (og + 1u == (tg + 1u) * nx) xb_add(&bar[XB_TOPGEN], 1u);
            else XB_SPIN(xb_ld(&bar[XB_TOPGEN]) == tg, bar);
            __builtin_amdgcn_fence(__ATOMIC_ACQUIRE, "agent");
            xb_add(&bar[XB_XGEN(b.x)], 1u);
            asm volatile("s_waitcnt vmcnt(0)" ::: "memory");
        } else {
            XB_SPIN(xb_ld(&bar[XB_XGEN(b.x)]) == gen, bar);
            __builtin_amdgcn_fence(__ATOMIC_ACQUIRE, "agent");
            asm volatile("s_waitcnt vmcnt(0)" ::: "memory");
        }
    }
    __syncthreads();
}

struct Args { const float* in[32]; float* out; unsigned char* ws; int ph_lo, ph_hi; };
struct Frame { LAS unsigned char* lds; int tid, lane, wave, G, gw, NGW; long gtid, NT; };
#define WSP(T, off) ((T*)(A.ws + (off)))
#define WLP(l, off) ((bf16*)(A.ws + WS_W + (size_t)(l) * WL_STRIDE + (off)))
#define MODP(l, s, j) ((const float*)(A.ws + WS_CTL) + CW_MOD + ((l) * 3 + (s)) * 6144 + (j) * 1024)

__device__ __forceinline__ float wave_sum(float v) {
#pragma unroll
    for (int o = 1; o < 64; o <<= 1) v += __shfl_xor(v, o);
    return v;
}
__device__ __forceinline__ void p0_transpose_item(const float* W, int K, int N, bf16* WT, int ldwt, int row_off, int col_off, LAS float* scr, int item, int lane) {
    const int nblk = N / 32, kb = item / nblk, nb = item % nblk, k0 = 64 * kb, n0 = 32 * nb;
#pragma unroll 8
    for (int i = 0; i < 32; ++i) { const int kk = 2 * i + (lane >> 5); scr[kk * 33 + (lane & 31)] = W[(size_t)(k0 + kk) * N + n0 + (lane & 31)]; }
    LDS_WAIT(); asm volatile("" ::: "memory");
    const int c = lane & 7;
#pragma unroll
    for (int j = 0; j < 4; ++j) { const int n = (lane >> 3) + 8 * j; const LAS float* s = scr + (8 * c) * 33 + n;
        v4u o; o.x = pk2(s[0 * 33], s[1 * 33]); o.y = pk2(s[2 * 33], s[3 * 33]); o.z = pk2(s[4 * 33], s[5 * 33]); o.w = pk2(s[6 * 33], s[7 * 33]);
        *(v4u*)(WT + (size_t)(row_off + n0 + n) * ldwt + col_off + k0 + 8 * c) = o; }
    LDS_WAIT(); asm volatile("" ::: "memory");
}

__device__ __forceinline__ void ph_prologue(const Frame& F, const Args& A) {
    LAS float* scr = (LAS float*)(F.lds + F.wave * 16384);
    constexpr int I_WIN = 16 * 288, I_SQ = 16 * 32, I_R = 16 * 8, I_SD = 4 * 32;
    constexpr int PER_L = I_WIN + 4 * I_SQ + 3 * I_R + I_SD;
    for (int it = F.gw; it < 2 * PER_L; it += F.NGW) {
        const int l = it / PER_L; int r = it % PER_L;
        if (r < I_WIN) { p0_transpose_item(A.in[7] + (size_t)l * 1024 * 9216, 1024, 9216, WLP(l, WO_WIN), 1024, 0, 0, scr, r, F.lane); continue; } r -= I_WIN;
        if (r < I_SQ) { p0_transpose_item(A.in[12] + (size_t)l * 1048576, 1024, 1024, WLP(l, WO_D1), 3072, 0, 0, scr, r, F.lane); continue; } r -= I_SQ;
        if (r < I_SQ) { p0_transpose_item(A.in[20] + (size_t)l * 1048576, 1024, 1024, WLP(l, WO_D1), 3072, 0, 1024, scr, r, F.lane); continue; } r -= I_SQ;
        if (r < I_SQ) { p0_transpose_item(A.in[21] + (size_t)l * 1048576, 1024, 1024, WLP(l, WO_D1), 3072, 0, 2048, scr, r, F.lane); continue; } r -= I_SQ;
        if (r < I_SQ) { p0_transpose_item(A.in[22] + (size_t)l * 1048576, 1024, 1024, WLP(l, WO_OUT), 1024, 0, 0, scr, r, F.lane); continue; } r -= I_SQ;
        if (r < I_R) { p0_transpose_item(A.in[24] + (size_t)l * 262144, 1024, 256, WLP(l, WO_R), 1024, 0, 0, scr, r, F.lane); continue; } r -= I_R;
        if (r < I_R) { p0_transpose_item(A.in[29] + (size_t)l * 262144, 1024, 256, WLP(l, WO_SGU), 1024, 0, 0, scr, r, F.lane); continue; } r -= I_R;
        if (r < I_R) { p0_transpose_item(A.in[30] + (size_t)l * 262144, 1024, 256, WLP(l, WO_SGU), 1024, 256, 0, scr, r, F.lane); continue; } r -= I_R;
        p0_transpose_item(A.in[31] + (size_t)l * 262144, 256, 1024, WLP(l, WO_SD), 256, 0, 0, scr, r, F.lane);
    }
    float* MOD = (float*)(A.ws + WS_CTL) + CW_MOD;
    LAS float* part = (LAS float*)(F.lds + 8 * 16384 - 8192);
    for (int it = blockIdx.x; it < 2 * 96; it += F.G) {
        const int l = it / 96, nb = it % 96, n = nb * 64 + F.lane;
        const float* wm = A.in[4] + (size_t)l * 1024 * 6144 + n;
        float a0 = 0.f, a1 = 0.f, a2 = 0.f;
#pragma unroll 8
        for (int k = F.wave * 128; k < F.wave * 128 + 128; ++k) {
            const float w = wm[(size_t)k * 6144];
            a0 += siluf_(A.in[1][k]) * w; a1 += siluf_(A.in[1][1024 + k]) * w; a2 += siluf_(A.in[3][k]) * w;
        }
        __syncthreads();
        part[(F.wave * 3 + 0) * 64 + F.lane] = a0; part[(F.wave * 3 + 1) * 64 + F.lane] = a1; part[(F.wave * 3 + 2) * 64 + F.lane] = a2;
        __syncthreads();
        if (F.wave < 3) { float s = A.in[5][l * 6144 + n];
#pragma unroll
            for (int w = 0; w < 8; ++w) s += part[(w * 3 + F.wave) * 64 + F.lane];
            MOD[(l * 3 + F.wave) * 6144 + n] = s; }
    }
    f32x4* XA = WSP(f32x4, WS_XALL);
    for (long i = F.gtid; i < (long)MROWS * 256; i += F.NT) {
        const int R = (int)(i >> 8), c4 = (int)(i & 255), b = R / TPB, p = R % TPB;
        const f32x4* src = (p < CTX) ? (const f32x4*)(A.in[2] + ((size_t)b * CTX + p) * 1024) : (const f32x4*)(A.in[0] + ((size_t)b * SEQ + (p - CTX)) * 1024);
        XA[i] = src[c4];
    }
}

__device__ __forceinline__ void norm_mod_row(const f32x4 (&v)[4], const float* g, const float* sc, const float* sh, bf16* orow, int lane) {
    float s = 0.f;
#pragma unroll
    for (int j = 0; j < 4; ++j) s += (v[j].x * v[j].x + v[j].y * v[j].y) + (v[j].z * v[j].z + v[j].w * v[j].w);
    const float rs = rsqrtf(wave_sum(s) * (1.f / 1024.f) + EPS);
#pragma unroll
    for (int j = 0; j < 4; ++j) { const int c = 4 * lane + 256 * j;
        const f32x4 gg = *(const f32x4*)(g + c), s1 = *(const f32x4*)(sc + c), s0 = *(const f32x4*)(sh + c);
        const float y0 = v[j].x * rs * gg.x * (1.f + s1.x) + s0.x, y1 = v[j].y * rs * gg.y * (1.f + s1.y) + s0.y, y2 = v[j].z * rs * gg.z * (1.f + s1.z) + s0.z, y3 = v[j].w * rs * gg.w * (1.f + s1.w) + s0.w;
        *(unsigned long long*)(orow + c) = (unsigned long long)pk2(y0, y1) | ((unsigned long long)pk2(y2, y3) << 32); }
}
__device__ __forceinline__ void ph_norm1(const Frame& F, const Args& A, int l) {
    const float* X = WSP(float, WS_XALL); bf16* H = WSP(bf16, WS_H);
    for (int R = F.gw; R < MROWS; R += F.NGW) {
        const int b = R / TPB, p = R % TPB, s = (p < CTX) ? 2 : b;
        f32x4 v[4];
#pragma unroll
        for (int j = 0; j < 4; ++j) v[j] = *(const f32x4*)(X + (size_t)R * 1024 + 4 * F.lane + 256 * j);
        norm_mod_row(v, A.in[6] + l * 1024, MODP(l, s, 1), MODP(l, s, 0), H + (size_t)R * 1024, F.lane);
    }
}

__device__ __forceinline__ void ph_uelem(const Frame& F, const Args& A, int l) {
    const float* U = WSP(float, WS_U);
    bf16 *Kb = WSP(bf16, WS_KB), *Vb = WSP(bf16, WS_VB), *Qb = WSP(bf16, WS_QB), *LXb = WSP(bf16, WS_LXB), *GLG = WSP(bf16, WS_GLG), *ZP = WSP(bf16, WS_ZP), *GT = WSP(bf16, WS_GATES);
    LAS float* sF = (LAS float*)F.lds; LAS float* sT = sF + 1024;
    if (F.tid < 256) sT[F.tid] = cospif((float)F.tid / 128.0f);
    __syncthreads();
    for (int R = blockIdx.x; R < MROWS; R += F.G) {
        const float* u = U + (size_t)R * INW; const int p = R % TPB; const bool lat = p >= CTX; const int t = p - CTX;
        for (int gi = F.wave; gi < 32; gi += 8) {
            const bool isq = gi >= 16; const int grp = gi & 15;
            const float v = u[(isq ? COL_Q : COL_K) + grp * 64 + F.lane];
            const float ss = wave_sum(v * v);
            float y = v * rsqrtf(ss * (1.f / 64.f) + EPS) * (isq ? A.in[8] : A.in[9])[l * 64 + F.lane];
            const float part = __shfl_xor(y, 16);
            if (lat) { const int axis = F.lane >> 5, hf = (F.lane >> 4) & 1, f = F.lane & 15;
                const float pos = (float)(axis ? (t & 63) : (t >> 6)); const float inv = exp2f(-(float)f * (13.287712379549449f / 16.f));
                float sn, cs; sincosf(pos * inv, &sn, &cs);
                y = hf ? (part * sn + y * cs) : (y * cs - part * sn); }
            if (isq) y *= QSCALE;
            (isq ? Qb : Kb)[(size_t)R * 1024 + grp * 64 + F.lane] = (bf16)f2bf(y);
        }
        for (int c = F.tid; c < 1024; c += 512) { const size_t o = (size_t)R * 1024 + c;
            Vb[o] = (bf16)f2bf(u[COL_V + c]); LXb[o] = (bf16)f2bf(u[COL_LX + c]); GLG[o] = (bf16)f2bf(gelu_tanh(u[COL_LG + c])); sF[c] = u[COL_F + c]; }
        for (int c = F.tid; c < 3072; c += 512) GT[(size_t)R * 3072 + c] = (bf16)f2bf(sigmoidf_(u[COL_G + c]));
        __syncthreads();
        for (int o = F.tid; o < 1024; o += 512) { const int g = o >> 8, oo = o & 255; int j = oo >> 1, odd = oo & 1; if (oo == 1) { j = 128; odd = 0; }
            const int m0 = odd ? 192 : 0; float acc = 0.f;
            for (int c = 0; c < 256; ++c) acc += sF[g * 256 + c] * sT[(j * c + m0) & 255];
            ZP[(size_t)R * 1024 + o] = (bf16)f2bf(acc); }
        __syncthreads();
    }
}

__device__ __forceinline__ void ph_conv(const Frame& F, const Args& A, int l) {
    const bf16* LXb = WSP(bf16, WS_LXB); bf16* UC = WSP(bf16, WS_UC);
    const float* cw = A.in[13] + l * 4096; const float* cb = A.in[14] + l * 1024;
    for (long i = F.gtid; i < (long)MROWS * 1024; i += F.NT) {
        const int R = (int)(i >> 10), ch = (int)(i & 1023), p = R % TPB; const int lo = p < CTX ? 0 : CTX, hi = p < CTX ? CTX : TPB;
        float acc = cb[ch];
#pragma unroll
        for (int j = 0; j < 4; ++j) { const int pp = p + j - 2; if (pp >= lo && pp < hi) acc += cw[j * 1024 + ch] * bf2f(LXb[(size_t)(R + j - 2) * 1024 + ch]); }
        UC[i] = (bf16)f2bf(acc);
    }
}
__device__ __forceinline__ void ph_lrucoef(const Frame& F, const Args& A, int l) {
    const bf16* UC = WSP(bf16, WS_UC); unsigned* AB = WSP(unsigned, WS_AB);
    for (long i = F.gtid; i < 2L * MROWS * 1024; i += F.NT) {
        const int d = (int)(i / ((long)MROWS * 1024)); const long rem = i % ((long)MROWS * 1024); const int R = (int)(rem >> 10), ch = (int)(rem & 1023), blk = ch >> 6, e = ch & 63;
        const float* wa = A.in[15] + ((size_t)(l * 2 + d) * 16 + blk) * 4096 + e; const float* wi = A.in[17] + ((size_t)(l * 2 + d) * 16 + blk) * 4096 + e;
        float r = A.in[16][(l * 2 + d) * 1024 + ch], ig = A.in[18][(l * 2 + d) * 1024 + ch];
        const bf16* ur = UC + (size_t)R * 1024 + blk * 64;
        for (int dd = 0; dd < 64; ++dd) { const float x = bf2f(ur[dd]); r += x * wa[dd * 64]; ig += x * wi[dd * 64]; }
        const float lam = A.in[19][(l * 2 + d) * 1024 + ch]; const float sp = log1pf(expf(-lam));
        const float la = -8.f * sigmoidf_(r) * sp; const float mult = sqrtf(-expm1f(2.f * la));
        const float bc = mult * sigmoidf_(ig) * bf2f(ur[e]);
        AB[i] = pk2(la, bc);
    }
}
__device__ __forceinline__ void ph_scan1(const Frame& F, const Args& A) {
    const unsigned* AB = WSP(unsigned, WS_AB); float2* SUMM = WSP(float2, WS_SUMM);
    for (int it = F.gw; it < NB * 2 * NCHUNK * 16; it += F.NGW) {
        const int cg = it & 15, ck = (it >> 4) % NCHUNK, bd = (it >> 4) / NCHUNK, b = bd >> 1, d = bd & 1, ch = cg * 64 + F.lane;
        const unsigned* ab = AB + ((size_t)d * MROWS + (size_t)b * TPB + ck * 64) * 1024 + ch;
        float ac = 1.f, h = 0.f;
#pragma unroll 8
        for (int i = 0; i < 64; ++i) { const int ii = d ? 63 - i : i; const unsigned w = ab[(size_t)ii * 1024]; const float a = __expf(bf2f(w & 0xffffu)); h = a * h + bf2f(w >> 16); ac *= a; }
        SUMM[((size_t)bd * NCHUNK + ck) * 1024 + ch] = make_float2(ac, h);
    }
}
__device__ __forceinline__ void ph_scan2(const Frame& F, const Args& A) {
    const float2* SUMM = WSP(float2, WS_SUMM); float* CARRY = WSP(float, WS_CARRY);
    if (F.gtid < 4096) {
        const int bd = (int)(F.gtid >> 10), ch = (int)(F.gtid & 1023), d = bd & 1; float h = 0.f;
        for (int s = 0; s < NCHUNK; ++s) { const int ck = d ? (s < 4 ? 3 - s : NCHUNK + 3 - s) : s;
            const size_t o = ((size_t)bd * NCHUNK + ck) * 1024 + ch; CARRY[o] = h; const float2 v = SUMM[o]; h = v.x * h + v.y; }
    }
}
__device__ __forceinline__ void ph_scan3(const Frame& F, const Args& A) {
    const unsigned* AB = WSP(unsigned, WS_AB); const float* CARRY = WSP(float, WS_CARRY); const bf16* GLG = WSP(bf16, WS_GLG); bf16* MX = WSP(bf16, WS_MIXIN);
    for (int it = F.gw; it < NB * NCHUNK * 16; it += F.NGW) {
        const int cg = it & 15, ck = (it >> 4) % NCHUNK, b = (it >> 4) / NCHUNK, ch = cg * 64 + F.lane; const size_t R0 = (size_t)b * TPB + ck * 64;
        const unsigned* ab0 = AB + R0 * 1024 + ch; const unsigned* ab1 = AB + ((size_t)MROWS + R0) * 1024 + ch;
        float hf[64]; float h = CARRY[((size_t)(b * 2 + 0) * NCHUNK + ck) * 1024 + ch];
#pragma unroll
        for (int i = 0; i < 64; ++i) { const unsigned w = ab0[(size_t)i * 1024]; h = __expf(bf2f(w & 0xffffu)) * h + bf2f(w >> 16); hf[i] = h; }
        h = CARRY[((size_t)(b * 2 + 1) * NCHUNK + ck) * 1024 + ch];
#pragma unroll
        for (int i = 63; i >= 0; --i) { const unsigned w = ab1[(size_t)i * 1024]; h = __expf(bf2f(w & 0xffffu)) * h + bf2f(w >> 16);
            MX[(R0 + i) * 3072 + 1024 + ch] = (bf16)f2bf((hf[i] + h) * bf2f(GLG[(R0 + i) * 1024 + ch])); }
    }
}

__device__ __forceinline__ void ph_fft_t1(const Frame& F, const Args& A) {
    const unsigned* ZP = WSP(unsigned, WS_ZP); unsigned* XA = WSP(unsigned, WS_XA);
    for (long i = F.gtid; i < (long)NB * 512 * 8192; i += F.NT) {
        const int t1 = (int)(i & 127), t2 = (int)((i >> 7) & 63), cc = (int)((i >> 13) & 511), b = (int)(i >> 22);
        XA[i] = ZP[((size_t)b * TPB + CTX + 64 * t1 + t2) * 512 + cc];
    }
}
__device__ __forceinline__ void ph_fft_a(const Frame& F, const Args& A) {
    const unsigned* XA = WSP(unsigned, WS_XA); unsigned* XB = WSP(unsigned, WS_XB);
    for (long i = F.gtid; i < (long)NB * 512 * 8192; i += F.NT) {
        const int k1 = (int)(i & 127); const long row = i >> 7; const int t2 = (int)(row & 63); const long bc = row >> 6;
        const unsigned* x = XA + row * 128; float yr = 0.f, yi = 0.f;
        for (int t1 = 0; t1 < 128; ++t1) { const unsigned w = x[t1]; const float wr = bf2f(w & 0xffffu), wi = bf2f(w >> 16);
            float sn, cs; sincospif((float)((k1 * t1) & 127) / 64.0f, &sn, &cs);
            yr += wr * cs + wi * sn; yi += wi * cs - wr * sn; }
        float sn, cs; sincospif((float)(k1 * t2) / 4096.0f, &sn, &cs);
        const float zr = yr * cs + yi * sn, zi = yi * cs - yr * sn;
        XB[(bc * 64 + (k1 >> 1)) * 128 + (k1 & 1) * 64 + t2] = pk2(zr, zi);
    }
}
__device__ __forceinline__ void ph_fft_b(const Frame& F, const Args& A) {
    const unsigned* XB = WSP(unsigned, WS_XB); unsigned* GB = WSP(unsigned, WS_GB);
    for (long i = F.gtid; i < (long)NB * 512 * 8192; i += F.NT) {
        const int k2 = (int)(i & 63); const long hrow = i >> 6;
        const unsigned* x = XB + hrow * 64; float yr = 0.f, yi = 0.f;
        for (int t2 = 0; t2 < 64; ++t2) { const unsigned w = x[t2]; const float wr = bf2f(w & 0xffffu), wi = bf2f(w >> 16);
            float sn, cs; sincospif((float)((k2 * t2) & 63) / 32.0f, &sn, &cs);
            yr += wr * cs + wi * sn; yi += wi * cs - wr * sn; }
        GB[hrow * 64 + k2] = pk2(yr, yi);
    }
}
__device__ __forceinline__ void ph_fft_c(const Frame& F, const Args& A) {
    const unsigned* ZP = WSP(unsigned, WS_ZP); float2* GC = WSP(float2, WS_GC);
    for (long i = F.gtid; i < (long)NB * 512 * 256; i += F.NT) {
        const int cc = (int)(i & 511), k = (int)((i >> 9) & 255), b = (int)(i >> 17);
        float yr = 0.f, yi = 0.f;
        for (int t = 0; t < 256; ++t) { const unsigned w = ZP[((size_t)b * TPB + t) * 512 + cc]; const float wr = bf2f(w & 0xffffu), wi = bf2f(w >> 16);
            float sn, cs; sincospif((float)((k * t) & 255) / 128.0f, &sn, &cs);
            yr += wr * cs + wi * sn; yi += wi * cs - wr * sn; }
        GC[((size_t)b * 512 + cc) * 256 + k] = make_float2(yr, yi);
    }
}
__device__ __forceinline__ void ph_fft_t2(const Frame& F, const Args& A) {
    const unsigned* GB = WSP(unsigned, WS_GB); const float2* GC = WSP(float2, WS_GC); bf16* MX = WSP(bf16, WS_MIXIN);
    for (long i = F.gtid; i < (long)MROWS * 1024; i += F.NT) {
        const int R = (int)(i >> 10), col = (int)(i & 1023), g = col >> 8, jc = col & 255, b = R / TPB, p = R % TPB;
        const bool lat = p >= CTX; const int T = lat ? SEQ : CTX, k = lat ? p - CTX : p, km = (T - k) & (T - 1);
        const int j = (jc == 0 || jc == 128) ? 0 : (jc < 128 ? jc : 256 - jc); const int cc = g * 128 + j;
        float vr, vi, mr, mi;
        if (lat) { const size_t base = ((size_t)b * 512 + cc) * 64;
            const unsigned w = GB[(base + ((k & 127) >> 1)) * 128 + (k & 1) * 64 + (k >> 7)], wm = GB[(base + ((km & 127) >> 1)) * 128 + (km & 1) * 64 + (km >> 7)];
            vr = bf2f(w & 0xffffu); vi = bf2f(w >> 16); mr = bf2f(wm & 0xffffu); mi = bf2f(wm >> 16); }
        else { const float2 w = GC[((size_t)b * 512 + cc) * 256 + k], wm = GC[((size_t)b * 512 + cc) * 256 + km]; vr = w.x; vi = w.y; mr = wm.x; mi = wm.y; }
        float o;
        if (jc == 0) o = 0.5f * (vr + mr); else if (jc == 128) o = 0.5f * (vi + mi); else if (jc < 128) o = mr; else o = vr;
        o *= lat ? 6.9053396600248786e-4f : 3.90625e-3f;
        MX[(size_t)R * 3072 + 2048 + col] = (bf16)f2bf(o);
    }
}

__device__ __forceinline__ void ph_attn_naive(const Frame& F, const Args& A, int l) {
    const bf16 *Kb = WSP(bf16, WS_KB), *Vb = WSP(bf16, WS_VB), *Qb = WSP(bf16, WS_QB); bf16* MX = WSP(bf16, WS_MIXIN);
    const float* lq = A.in[10] + l * 256; float d01 = 0.f, d23 = 0.f;
    for (int i = 0; i < 64; ++i) { d01 += lq[i] * lq[64 + i]; d23 += lq[128 + i] * lq[192 + i]; }
    const float lam_init = 0.8f - 0.6f * expf(-0.3f * (float)l), lam = expf(d01) - expf(d23) + lam_init;
    LAS float* Ks = (LAS float*)F.lds; LAS float* Vs = Ks + 64 * 132; LAS float* Qs = Vs + 64 * 132; LAS float* Ws = Qs + 16 * 128;
    const int r = F.tid >> 5, tl = F.tid & 31;
    for (int u = blockIdx.x; u < 16 * 528; u += F.G) {
        const int bh = u / 528, qb = u % 528, b = bh >> 3, h = bh & 7; const size_t R0 = (size_t)b * TPB + qb * 16; const int nkeys = qb < 16 ? CTX : TPB;
        __syncthreads();
        for (int e = F.tid; e < 2048; e += 512) Qs[e] = bf2f(Qb[(R0 + (e >> 7)) * 1024 + h * 128 + (e & 127)]);
        float m0 = -1e30f, l0 = 0.f, m1 = -1e30f, l1 = 0.f;
        for (int pass = 0; pass < 2; ++pass) {
            float inv0 = 0.f, inv1 = 0.f;
            if (pass == 1) {
#pragma unroll
                for (int o = 1; o < 32; o <<= 1) { float mo = __shfl_xor(m0, o), lo = __shfl_xor(l0, o), mn = fmaxf(m0, mo); l0 = l0 * exp2f(m0 - mn) + lo * exp2f(mo - mn); m0 = mn;
                    mo = __shfl_xor(m1, o); lo = __shfl_xor(l1, o); mn = fmaxf(m1, mo); l1 = l1 * exp2f(m1 - mn) + lo * exp2f(mo - mn); m1 = mn; }
                inv0 = 1.f / l0; inv1 = lam / l1;
            }
            float o4[4] = {0.f, 0.f, 0.f, 0.f};
            for (int kt = 0; kt < nkeys; kt += 64) {
                __syncthreads();
                for (int e = F.tid; e < 1024; e += 512) { const int kk = e >> 4, c8 = (e & 15) * 8; const size_t src = ((size_t)b * TPB + kt + kk) * 1024 + h * 128 + c8;
                    const v4u kv = *(const v4u*)(Kb + src);
                    Ks[kk * 132 + c8 + 0] = bf2f(kv.x & 0xffffu); Ks[kk * 132 + c8 + 1] = bf2f(kv.x >> 16); Ks[kk * 132 + c8 + 2] = bf2f(kv.y & 0xffffu); Ks[kk * 132 + c8 + 3] = bf2f(kv.y >> 16);
                    Ks[kk * 132 + c8 + 4] = bf2f(kv.z & 0xffffu); Ks[kk * 132 + c8 + 5] = bf2f(kv.z >> 16); Ks[kk * 132 + c8 + 6] = bf2f(kv.w & 0xffffu); Ks[kk * 132 + c8 + 7] = bf2f(kv.w >> 16);
                    if (pass == 1) { const v4u vv = *(const v4u*)(Vb + src);
                        Vs[kk * 132 + c8 + 0] = bf2f(vv.x & 0xffffu); Vs[kk * 132 + c8 + 1] = bf2f(vv.x >> 16); Vs[kk * 132 + c8 + 2] = bf2f(vv.y & 0xffffu); Vs[kk * 132 + c8 + 3] = bf2f(vv.y >> 16);
                        Vs[kk * 132 + c8 + 4] = bf2f(vv.z & 0xffffu); Vs[kk * 132 + c8 + 5] = bf2f(vv.z >> 16); Vs[kk * 132 + c8 + 6] = bf2f(vv.w & 0xffffu); Vs[kk * 132 + c8 + 7] = bf2f(vv.w >> 16); } }
                __syncthreads();
#pragma unroll
                for (int kq = 0; kq < 2; ++kq) { const int kk = tl + 32 * kq; float s0 = 0.f, s1 = 0.f;
                    for (int d = 0; d < 64; d += 4) { const f32x4 q0 = *(const LAS f32x4*)(Qs + r * 128 + d), q1 = *(const LAS f32x4*)(Qs + r * 128 + 64 + d), k0 = *(const LAS f32x4*)(Ks + kk * 132 + d), k1 = *(const LAS f32x4*)(Ks + kk * 132 + 64 + d);
                        s0 += q0.x * k0.x + q0.y * k0.y + q0.z * k0.z + q0.w * k0.w; s1 += q1.x * k1.x + q1.y * k1.y + q1.z * k1.z + q1.w * k1.w; }
                    if (pass == 0) { float mn = fmaxf(m0, s0); l0 = l0 * exp2f(m0 - mn) + exp2f(s0 - mn); m0 = mn; mn = fmaxf(m1, s1); l1 = l1 * exp2f(m1 - mn) + exp2f(s1 - mn); m1 = mn; }
                    else Ws[r * 64 + kk] = exp2f(s0 - m0) * inv0 - exp2f(s1 - m1) * inv1; }
                if (pass == 1) { __syncthreads();
                    for (int kk = 0; kk < 64; ++kk) { const float w = Ws[r * 64 + kk];
#pragma unroll
                        for (int i = 0; i < 4; ++i) o4[i] += w * Vs[kk * 132 + tl + 32 * i]; } }
            }
            if (pass == 1) { float ss = o4[0] * o4[0] + o4[1] * o4[1] + o4[2] * o4[2] + o4[3] * o4[3];
#pragma unroll
                for (int o = 1; o < 32; o <<= 1) ss += __shfl_xor(ss, o);
                const float sc = rsqrtf(ss * (1.f / 128.f) + EPS) * (1.f - lam_init);
#pragma unroll
                for (int i = 0; i < 4; ++i) MX[(R0 + r) * 3072 + h * 128 + tl + 32 * i] = (bf16)f2bf(o4[i] * sc * A.in[11][l * 128 + tl + 32 * i]); }
        }
    }
}

__device__ __forceinline__ void ph_mix(const Frame& F, const Args& A) {
    const float *PA = WSP(float, WS_PA), *PR = WSP(float, WS_PR), *PF = WSP(float, WS_PF); const bf16* GT = WSP(bf16, WS_GATES); bf16* MD = WSP(bf16, WS_MIXED);
    for (long i = F.gtid; i < (long)MROWS * 1024; i += F.NT) { const size_t R = (size_t)(i >> 10); const int c = (int)(i & 1023);
        MD[i] = (bf16)f2bf(bf2f(GT[R * 3072 + c]) * PA[i] + bf2f(GT[R * 3072 + 1024 + c]) * PR[i] + bf2f(GT[R * 3072 + 2048 + c]) * PF[i]); }
}
__device__ __forceinline__ void ph_resid_norm2(const Frame& F, const Args& A, int l) {
    float* X = WSP(float, WS_XALL); const float* Y1 = WSP(float, WS_Y1); bf16* TOK = WSP(bf16, WS_TOK);
    for (int R = F.gw; R < MROWS; R += F.NGW) {
        const int b = R / TPB, p = R % TPB, s = (p < CTX) ? 2 : b; const float* g1 = MODP(l, s, 2);
        f32x4 v[4];
#pragma unroll
        for (int j = 0; j < 4; ++j) { const int c = 4 * F.lane + 256 * j; const f32x4 x = *(const f32x4*)(X + (size_t)R * 1024 + c), y = *(const f32x4*)(Y1 + (size_t)R * 1024 + c), gg = *(const f32x4*)(g1 + c);
            v[j] = x + gg * y; *(f32x4*)(X + (size_t)R * 1024 + c) = v[j]; }
        norm_mod_row(v, A.in[23] + l * 1024, MODP(l, s, 4), MODP(l, s, 3), TOK + (size_t)R * 1024, F.lane);
    }
}
__device__ __forceinline__ void ph_topk(const Frame& F, const Args& A, int l) {
    const float* LG = WSP(float, WS_LOG); const float* SGU = WSP(float, WS_SGU); bf16* SH = WSP(bf16, WS_SH);
    int* LIST = WSP(int, WS_LIST); float* TOPW = WSP(float, WS_TOPW); int* CNT = (int*)(A.ws + WS_CTL) + CW_CNT + l * 256;
    const float NEG = -__builtin_inff();
    for (int R = F.gw; R < MROWS; R += F.NGW) {
        const f32x4 lg4 = *(const f32x4*)(LG + (size_t)R * 256 + 4 * F.lane); const f32x4 rb4 = *(const f32x4*)(A.in[25] + l * 256 + 4 * F.lane);
        float sc[4] = {sigmoidf_(lg4.x), sigmoidf_(lg4.y), sigmoidf_(lg4.z), sigmoidf_(lg4.w)};
        float bi[4] = {sc[0] + rb4.x, sc[1] + rb4.y, sc[2] + rb4.z, sc[3] + rb4.w};
        float t1 = NEG, t2 = NEG;
#pragma unroll
        for (int q = 0; q < 4; ++q) { const float v = bi[q]; if (v > t1) { t2 = t1; t1 = v; } else if (v > t2) t2 = v; }
#pragma unroll
        for (int o = 1; o < 8; o <<= 1) { const float o1 = __shfl_xor(t1, o), o2 = __shfl_xor(t2, o); const float n1 = fmaxf(t1, o1), n2 = fmaxf(fminf(t1, o1), fmaxf(t2, o2)); t1 = n1; t2 = n2; }
        const float gs = t1 + t2; const int mygrp = F.lane >> 3; int rank = 0;
#pragma unroll
        for (int j = 0; j < 8; ++j) { const float sj = __shfl(gs, j * 8); rank += (sj > gs || (sj == gs && j < mygrp)) ? 1 : 0; }
        const bool sel = rank < 4;
        float cand[4];
#pragma unroll
        for (int q = 0; q < 4; ++q) cand[q] = sel ? bi[q] : NEG;
        int my_e = 0; float my_s = 0.f, ssum = 0.f;
#pragma unroll
        for (int k = 0; k < 8; ++k) {
            float bv = cand[0]; int bq = 0;
#pragma unroll
            for (int q = 1; q < 4; ++q) if (cand[q] > bv) { bv = cand[q]; bq = q; }
            float v = bv; int e = 4 * F.lane + bq;
#pragma unroll
            for (int o = 1; o < 64; o <<= 1) { const float ov = __shfl_xor(v, o); const int oe = __shfl_xor(e, o); if (ov > v || (ov == v && oe < e)) { v = ov; e = oe; } }
            const int ol = e >> 2, oq = e & 3; float sv = 0.f;
#pragma unroll
            for (int q = 0; q < 4; ++q) if (oq == q) { sv = sc[q]; if (F.lane == ol) cand[q] = NEG; }
            sv = __shfl(sv, ol); ssum += sv;
            if (F.lane == k) { my_e = e; my_s = sv; }
        }
        if (F.lane < 8) { const int pos = atomicAdd(CNT + my_e, 1); LIST[(size_t)my_e * LCAP + pos] = R * 8 + F.lane; TOPW[(size_t)R * 8 + F.lane] = my_s / ssum * 2.5f; }
#pragma unroll
        for (int j = 0; j < 4; ++j) { const int f = F.lane + 64 * j; SH[(size_t)R * 256 + f] = (bf16)f2bf(siluf_(SGU[(size_t)R * 512 + f]) * SGU[(size_t)R * 512 + 256 + f]); }
    }
}
__device__ __forceinline__ void ph_experts_naive(const Frame& F, const Args& A, int l) {
    const bf16* TOK = WSP(bf16, WS_TOK); const int* LIST = WSP(int, WS_LIST); const float* TOPW = WSP(float, WS_TOPW); float* YB = WSP(float, WS_YB);
    const int* CNT = (const int*)(A.ws + WS_CTL) + CW_CNT + l * 256;
    LAS bf16* Xs = (LAS bf16*)F.lds;
    LAS float* Hs = (LAS float*)(F.lds + 65536);
    LAS int* pref = (LAS int*)(F.lds + 98304);
    LAS int* sPair = pref + 320; LAS float* sW = (LAS float*)(sPair + 32);
    __syncthreads();
    if (F.tid == 0) { int s = 0; for (int e = 0; e < 256; ++e) { pref[e] = s; s += (CNT[e] + 31) >> 5; } pref[256] = s; }
    __syncthreads();
    const int total = pref[256];
    for (int id = blockIdx.x; id < total; id += F.G) {
        int lo = 0, hi = 255; while (lo < hi) { const int mid = (lo + hi + 1) >> 1; if (pref[mid] <= id) lo = mid; else hi = mid - 1; }
        const int e = lo, c = id - pref[e], n = min(32, CNT[e] - c * 32);
        __syncthreads();
        if (F.tid < 32) { const int pr = F.tid < n ? LIST[(size_t)e * LCAP + c * 32 + F.tid] : -1; sPair[F.tid] = pr; sW[F.tid] = pr >= 0 ? TOPW[pr] : 0.f; }
        __syncthreads();
        for (int pc = F.tid; pc < 4096; pc += 512) { const int row = pc >> 7, c8 = (pc & 127) * 8, pr = sPair[row];
            v4u v = {0u, 0u, 0u, 0u}; if (pr >= 0) v = *(const v4u*)(TOK + (size_t)(pr >> 3) * 1024 + c8);
            *(LAS v4u*)(Xs + row * 1024 + c8) = v; }
        __syncthreads();
        { const int f = F.tid & 255, gu = F.tid >> 8; const float* W = (gu ? A.in[27] : A.in[26]) + ((size_t)(l * 256 + e) * 1024) * 256 + f;
          float acc[32];
#pragma unroll
          for (int r = 0; r < 32; ++r) acc[r] = 0.f;
          for (int k = 0; k < 1024; ++k) { const float w = W[(size_t)k * 256];
#pragma unroll
              for (int r = 0; r < 32; ++r) acc[r] += bf2f(Xs[r * 1024 + k]) * w; }
          if (gu == 0) {
#pragma unroll
              for (int r = 0; r < 32; ++r) Hs[r * 256 + f] = siluf_(acc[r]); }
          __syncthreads();
          if (gu == 1) {
#pragma unroll
              for (int r = 0; r < 32; ++r) Hs[r * 256 + f] *= acc[r]; }
          __syncthreads(); }
        { const float* Wd = A.in[28] + ((size_t)(l * 256 + e) * 256) * 1024 + F.tid;
          float a0[32], a1[32];
#pragma unroll
          for (int r = 0; r < 32; ++r) { a0[r] = 0.f; a1[r] = 0.f; }
          for (int k = 0; k < 256; ++k) { const float w0 = Wd[(size_t)k * 1024], w1 = Wd[(size_t)k * 1024 + 512];
#pragma unroll
              for (int r = 0; r < 32; ++r) { const float hv = Hs[r * 256 + k]; a0[r] += hv * w0; a1[r] += hv * w1; } }
#pragma unroll
          for (int r = 0; r < 32; ++r) { const int pr = sPair[r]; if (pr >= 0) { const float w = sW[r]; YB[(size_t)pr * 1024 + F.tid] = a0[r] * w; YB[(size_t)pr * 1024 + 512 + F.tid] = a1[r] * w; } } }
    }
}
__device__ __forceinline__ void ph_combine(const Frame& F, const Args& A, int l) {
    float* X = WSP(float, WS_XALL); const float* YB = WSP(float, WS_YB); const float* SD = WSP(float, WS_SD);
    for (int R = F.gw; R < MROWS; R += F.NGW) {
        const int b = R / TPB, p = R % TPB, s = (p < CTX) ? 2 : b; const float* g2 = MODP(l, s, 5);
#pragma unroll
        for (int j = 0; j < 4; ++j) { const int c = 4 * F.lane + 256 * j; f32x4 f = *(const f32x4*)(SD + (size_t)R * 1024 + c);
#pragma unroll
            for (int k = 0; k < 8; ++k) f += *(const f32x4*)(YB + ((size_t)R * 8 + k) * 1024 + c);
            const f32x4 x = *(const f32x4*)(X + (size_t)R * 1024 + c) + *(const f32x4*)(g2 + c) * f;
            *(f32x4*)(X + (size_t)R * 1024 + c) = x;
            if (l == DEPTH - 1 && p >= CTX) *(f32x4*)(A.out + ((size_t)b * SEQ + (p - CTX)) * 1024 + c) = x; }
    }
}

constexpr int PH_PER_L = 17, N_PHASES = 1 + DEPTH * PH_PER_L;
template <int P> __device__ __forceinline__ void run_phase(const Frame& F, const Args& A, int l) {
    if constexpr (P == -1) ph_prologue(F, A);
    if constexpr (P == 0) ph_norm1(F, A, l);
    if constexpr (P == 1) { pg8::Gemm g{WSP(bf16, WS_H), WLP(l, WO_WIN), MROWS, INW, 1024, 1024, 1024}; pg8::StaticOrder S; S.init(MROWS, INW, F.G, (int)blockIdx.x);
        pg8::EpiF32 E{WSP(float, WS_U), INW}; pg8::gemm_phase(F.lds, g, S, E); }
    if constexpr (P == 2) ph_uelem(F, A, l);
    if constexpr (P == 3) { ph_conv(F, A, l); ph_fft_t1(F, A); }
    if constexpr (P == 4) { ph_lrucoef(F, A, l); ph_fft_a(F, A); ph_fft_c(F, A); }
    if constexpr (P == 5) { ph_scan1(F, A); ph_fft_b(F, A); }
    if constexpr (P == 6) { ph_scan2(F, A); ph_fft_t2(F, A); }
    if constexpr (P == 7) ph_scan3(F, A);
    if constexpr (P == 8) { ph_attn_naive(F, A, l); __syncthreads(); }
    if constexpr (P == 9) {
        { pg8::Gemm g{WSP(bf16, WS_MIXIN), WLP(l, WO_D1), MROWS, 1024, 1024, 3072, 3072}; pg8::StaticOrder S; S.init(MROWS, 1024, F.G, (int)blockIdx.x); pg8::EpiF32 E{WSP(float, WS_PA), 1024}; pg8::gemm_phase(F.lds, g, S, E); }
        { pg8::Gemm g{WSP(bf16, WS_MIXIN) + 1024, WLP(l, WO_D1) + 1024, MROWS, 1024, 1024, 3072, 3072}; pg8::StaticOrder S; S.init(MROWS, 1024, F.G, (int)blockIdx.x); pg8::EpiF32 E{WSP(float, WS_PR), 1024}; pg8::gemm_phase(F.lds, g, S, E); }
        { pg8::Gemm g{WSP(bf16, WS_MIXIN) + 2048, WLP(l, WO_D1) + 2048, MROWS, 1024, 1024, 3072, 3072}; pg8::StaticOrder S; S.init(MROWS, 1024, F.G, (int)blockIdx.x); pg8::EpiF32 E{WSP(float, WS_PF), 1024}; pg8::gemm_phase(F.lds, g, S, E); } }
    if constexpr (P == 10) ph_mix(F, A);
    if constexpr (P == 11) { pg8::Gemm g{WSP(bf16, WS_MIXED), WLP(l, WO_OUT), MROWS, 1024, 1024, 1024, 1024}; pg8::StaticOrder S; S.init(MROWS, 1024, F.G, (int)blockIdx.x);
        pg8::EpiF32 E{WSP(float, WS_Y1), 1024}; pg8::gemm_phase(F.lds, g, S, E); }
    if constexpr (P == 12) ph_resid_norm2(F, A, l);
    if constexpr (P == 13) {
        { pg8::Gemm g{WSP(bf16, WS_TOK), WLP(l, WO_R), MROWS, 256, 1024, 1024, 1024}; pg8::StaticOrder S; S.init(MROWS, 256, F.G, (int)blockIdx.x); pg8::EpiF32 E{WSP(float, WS_LOG), 256}; pg8::gemm_phase(F.lds, g, S, E); }
        { pg8::Gemm g{WSP(bf16, WS_TOK), WLP(l, WO_SGU), MROWS, 512, 1024, 1024, 1024}; pg8::StaticOrder S; S.init(MROWS, 512, F.G, (int)blockIdx.x); pg8::EpiF32 E{WSP(float, WS_SGU), 512}; pg8::gemm_phase(F.lds, g, S, E); } }
    if constexpr (P == 14) ph_topk(F, A, l);
    if constexpr (P == 15) { ph_experts_naive(F, A, l); __syncthreads();
        { pg8::Gemm g{WSP(bf16, WS_SH), WLP(l, WO_SD), MROWS, 1024, 256, 256, 256}; pg8::StaticOrder S; S.init(MROWS, 1024, F.G, (int)blockIdx.x); pg8::EpiF32 E{WSP(float, WS_SD), 1024}; pg8::gemm_phase(F.lds, g, S, E); } }
    if constexpr (P == 16) ph_combine(F, A, l);
}
__device__ __forceinline__ Frame make_frame(unsigned char* lds) {
    Frame F; F.lds = (LAS unsigned char*)lds; F.tid = threadIdx.x; F.lane = F.tid & 63; F.wave = __builtin_amdgcn_readfirstlane(F.tid >> 6);
    F.G = gridDim.x; F.gw = blockIdx.x * NWAVES + F.wave; F.NGW = F.G * NWAVES; F.gtid = (long)blockIdx.x * 512 + F.tid; F.NT = (long)F.G * 512;
    return F;
}
template <int P> __global__ void __launch_bounds__(NWAVES * 64, 2) mk_phase(Args A) {
    extern __shared__ __attribute__((aligned(16))) unsigned char lds[];
    const Frame F = make_frame(lds);
    run_phase<P>(F, A, A.ph_lo);
}
#if N_LAUNCH_MODE == 1
__global__ void __launch_bounds__(NWAVES * 64, 2) mk_fwd(Args A) {
    extern __shared__ __attribute__((aligned(16))) unsigned char lds[];
    const Frame F = make_frame(lds);
    volatile LAS unsigned* MISC = (volatile LAS unsigned*)(F.lds + MISC_OFF);
    for (int u = F.tid; u < (LDS_BYTES - RING_BYTES) / 4; u += NWAVES * 64) ((LAS unsigned*)(F.lds + RING_BYTES))[u] = 0u;
    __syncthreads();
    XcdBarrier bar = xcd_barrier_post((unsigned*)(A.ws + WS_CTL) + CW_BAR, MISC + 8);
#define RUN(P) do { run_phase<P>(F, A, l); xcd_barrier(bar); } while (0)
    { const int l = 0; RUN(-1); }
    for (int l = 0; l < DEPTH; ++l) {
        RUN(0); RUN(1); RUN(2); RUN(3); RUN(4); RUN(5); RUN(6); RUN(7); RUN(8); RUN(9); RUN(10); RUN(11); RUN(12); RUN(13); RUN(14); RUN(15); RUN(16);
    }
#undef RUN
}
#endif

extern "C" void kernel_launch(void* const* d_in, const int* in_sizes, int n_in, void* d_out, int out_size, void* d_ws, size_t ws_size, hipStream_t stream) {
    static int grid = 0;
    if (grid == 0) {
        if (n_in != 32 || out_size != NB * SEQ * DM || ws_size < WS_END) { fprintf(stderr, "kernel_launch: unexpected shapes (n_in %d, out %d, ws %zu < %zu)\n", n_in, out_size, ws_size, (size_t)WS_END); grid = -1; return; }
        int dev = 0, cus = 0;
        if (hipGetDevice(&dev) != hipSuccess || hipDeviceGetAttribute(&cus, hipDeviceAttributeMultiprocessorCount, dev) != hipSuccess) { grid = -1; return; }
#define SETA(K) if (hipFuncSetAttribute((const void*)K, hipFuncAttributeMaxDynamicSharedMemorySize, LDS_BYTES) != hipSuccess) { fprintf(stderr, "kernel_launch: hipFuncSetAttribute failed\n"); grid = -1; return; }
#if N_LAUNCH_MODE == 1
        SETA(mk_fwd)
#else
        SETA(mk_phase<-1>) SETA(mk_phase<0>) SETA(mk_phase<1>) SETA(mk_phase<2>) SETA(mk_phase<3>) SETA(mk_phase<4>) SETA(mk_phase<5>) SETA(mk_phase<6>) SETA(mk_phase<7>) SETA(mk_phase<8>)
        SETA(mk_phase<9>) SETA(mk_phase<10>) SETA(mk_phase<11>) SETA(mk_phase<12>) SETA(mk_phase<13>) SETA(mk_phase<14>) SETA(mk_phase<15>) SETA(mk_phase<16>)
#endif
#undef SETA
        int per_cu = 0;
        (void)per_cu;
        grid = cus;
    }
    if (grid < 0) return;
    (void)hipMemsetAsync((char*)d_ws + WS_CTL, 0, CTL_ZERO_BYTES, stream);
    Args a{};
    for (int i = 0; i < 32; ++i) a.in[i] = (const float*)d_in[i];
    a.out = (float*)d_out; a.ws = (unsigned char*)d_ws;
#if N_LAUNCH_MODE == 1
    a.ph_lo = 0; a.ph_hi = N_PHASES;
    hipLaunchKernelGGL(mk_fwd, dim3(grid), dim3(NWAVES * 64), LDS_BYTES, stream, a);
#else
#define LAUNCH_P(P) hipLaunchKernelGGL(mk_phase<P>, dim3(grid), dim3(NWAVES * 64), LDS_BYTES, stream, a)
    a.ph_lo = 0; a.ph_hi = 0; LAUNCH_P(-1);
    for (int l = 0; l < DEPTH; ++l) { a.ph_lo = l;
        LAUNCH_P(0); LAUNCH_P(1); LAUNCH_P(2); LAUNCH_P(3); LAUNCH_P(4); LAUNCH_P(5); LAUNCH_P(6); LAUNCH_P(7); LAUNCH_P(8); LAUNCH_P(9); LAUNCH_P(10); LAUNCH_P(11); LAUNCH_P(12); LAUNCH_P(13); LAUNCH_P(14); LAUNCH_P(15); LAUNCH_P(16); }
#undef LAUNCH_P
#endif
    const hipError_t le = hipPeekAtLastError();
    if (le != hipSuccess) fprintf(stderr, "kernel_launch: launch failed: %s\n", hipGetErrorName(le));
}
```

```cpp
#include <hip/hip_runtime.h>
#include <cstdio>
#include <cstdint>

#ifndef FAST_LRU
#define FAST_LRU 1
#endif
#define FAST_FFT 0
#ifndef FAST_FFT_A
#define FAST_FFT_A 1
#endif
#ifndef FAST_FFT_B
#define FAST_FFT_B 1
#endif
#ifndef FAST_MOE
#define FAST_MOE 1
#endif
#ifndef FAST_ATTN
#define FAST_ATTN 1
#endif
#ifndef N_LAUNCH_MODE
#define N_LAUNCH_MODE 1
#endif

__device__ __forceinline__ int otid() { int t = threadIdx.x; asm volatile("" : "+v"(t)); return t; }
__device__ __forceinline__ int obid() { int b = blockIdx.x; asm volatile("" : "+s"(b)); return b; }
__device__ __forceinline__ int ogrid() { int g = gridDim.x; asm volatile("" : "+s"(g)); return g; }
template <int M> __device__ __forceinline__ float sx(float v) {
    static_assert(M == 1 || M == 2 || M == 4 || M == 8 || M == 16 || M == 32, "xor mask");
    if constexpr (M < 32) return __uint_as_float((unsigned)__builtin_amdgcn_ds_swizzle((int)__float_as_uint(v), (M << 10) | 0x1f));
    else { auto rr = __builtin_amdgcn_permlane32_swap(__float_as_uint(v), __float_as_uint(v), false, false); const unsigned a = rr[0], b = rr[1]; return __uint_as_float(a == __float_as_uint(v) ? b : a); }
}
template <int M> __device__ __forceinline__ int sxi(int v) { return (int)__float_as_uint(sx<M>(__uint_as_float((unsigned)v))); }
namespace pg8 {
#define PG8_LAS __attribute__((address_space(3)))
typedef unsigned short bf16_t;
typedef short bf16x8 __attribute__((ext_vector_type(8)));
typedef float f32x4 __attribute__((ext_vector_type(4)));
typedef unsigned u32x4 __attribute__((ext_vector_type(4)));
constexpr int BM = 256, BK = 64, HALF = 128, HTB = HALF * BK * 2, STAGE_BYTES = 8 * HTB, NXCD = 8, WGM = 8;
__host__ __device__ __forceinline__ int lds_byte(int r, int c) { const int st = (r >> 4) * 2 + (c >> 5), rr = r & 15, cc = c & 31, ob = rr * 64 + cc * 2; return st * 1024 + (ob ^ (((ob >> 9) & 1) << 5)); }
__host__ __device__ __forceinline__ void stage_rc(int b, int& R, int& C) { const int st = b / 1024, sb = b % 1024, swz = sb ^ (((sb >> 9) & 1) << 5); R = (st >> 1) * 16 + swz / 64; C = (st & 1) * 32 + (swz % 64) / 2; }
__host__ __device__ __forceinline__ int perm32(int rho) { const int n = rho >> 4, i = rho & 15; return 8 * (i >> 2) + 4 * n + (i & 3); }
struct Unit { int pm, pn; };
struct Gemm { const bf16_t* A; const bf16_t* Bt; int M, N, K, lda, ldb; };
struct StaticOrder {
    int nM, nN, nwg, G, c;
    __host__ __device__ void init(int M, int N, int G_, int c_) { nM = M / BM; nN = N / BM; nwg = nM * nN; G = G_; c = c_; }
    __host__ __device__ bool next(int i, Unit& u) const {
        const long L = (long)i * G + c; if (L >= nwg) return false;
        int wgid = (int)L; { const int q = nwg / NXCD, r = nwg % NXCD, xcd = wgid % NXCD, off = wgid / NXCD; wgid = (xcd < r ? xcd * (q + 1) : r * (q + 1) + (xcd - r) * q) + off; }
        const int nig = WGM * nN, gid = wgid / nig, fm = gid * WGM, gsz = (nM - fm) < WGM ? (nM - fm) : WGM;
        u.pm = fm + ((wgid % nig) % gsz); u.pn = (wgid % nig) / gsz; return true;
    }
};
__device__ __forceinline__ unsigned cvt_pk_bf16(float lo, float hi) { unsigned r; asm volatile("v_cvt_pk_bf16_f32 %0, %1, %2" : "=v"(r) : "v"(lo), "v"(hi)); return r; }

struct EpiF32 {
    static constexpr bool PERM = false;
    float* C; int ldc;
    __device__ __forceinline__ void operator()(const f32x4 (&acc)[2][2][4][2], const Unit& u, int wr, int wc, int fr, int fq) const {
        const int row0 = u.pm * BM + wr * 64 + fr, col0 = u.pn * BM + wc * 32 + 4 * fq;
#pragma unroll
        for (int ai = 0; ai < 2; ++ai)
#pragma unroll
            for (int m = 0; m < 4; ++m) { float* rowp = C + (size_t)(row0 + ai * HALF + m * 16) * ldc + col0;
#pragma unroll
                for (int bj = 0; bj < 2; ++bj)
#pragma unroll
                    for (int n = 0; n < 2; ++n) *(f32x4*)(rowp + bj * HALF + n * 16) = acc[ai][bj][m][n]; }
    }
};

template <class Epi>
__device__ __forceinline__ void gemm_phase(PG8_LAS unsigned char* lds, const Gemm g, const StaticOrder& S, const Epi& E) {
    const int tid = otid(), wid = __builtin_amdgcn_readfirstlane(tid >> 6), lane = tid & 63, wr = wid >> 2, wc = wid & 3, fr = lane & 15, fq = lane >> 4;
    const int K = g.K, nt = K / BK;
    unsigned voffA[2], voffB[2];
#pragma unroll
    for (int i = 0; i < 2; ++i) { int R, C; stage_rc(tid * 16 + i * 8192, R, C); const int Rb = Epi::PERM ? ((R & ~31) + perm32(R & 31)) : R;
        voffA[i] = (unsigned)(R * g.lda + C) * 2u; voffB[i] = (unsigned)(Rb * g.ldb + C) * 2u; }
    const size_t kstep = (size_t)(BK * 2);
    const size_t hA = (size_t)HALF * g.lda * 2, hB = (size_t)HALF * g.ldb * 2;
    const size_t tA = 2 * hA, tB = 2 * hB;
    const unsigned ldsw = (unsigned)wid * 1024u;
    const int aoff = lds_byte(wr * 64 + fr, fq * 8), boff = lds_byte(wc * 32 + fr, fq * 8);
#define PG8_SA(b, h) (((b) * 2 + (h)) * HTB)
#define PG8_SB(b, h) ((4 + (b) * 2 + (h)) * HTB)
#define PG8_STAGE(bufoff, gbase, voff) do { _Pragma("unroll") for (int _i = 0; _i < 2; ++_i) \
        __builtin_amdgcn_global_load_lds((const unsigned*)((const char*)(gbase) + (voff)[_i]), (PG8_LAS unsigned*)(lds + (bufoff) + ldsw + _i * 8192), 16, 0, 0); } while (0)
#define PG8_LDA(dst, b, h) do { _Pragma("unroll") for (int m = 0; m < 4; ++m) _Pragma("unroll") for (int k = 0; k < 2; ++k) dst[m][k] = *(const PG8_LAS bf16x8*)(lds + PG8_SA(b, h) + aoff + m * 2048 + k * 1024); } while (0)
#define PG8_LDB(dst, b, h) do { _Pragma("unroll") for (int n = 0; n < 2; ++n) _Pragma("unroll") for (int k = 0; k < 2; ++k) dst[n][k] = *(const PG8_LAS bf16x8*)(lds + PG8_SB(b, h) + boff + n * 2048 + k * 1024); } while (0)
#define PG8_MMA(ai, bj, At, Bt) do { __builtin_amdgcn_s_setprio(1); _Pragma("unroll") for (int m = 0; m < 4; ++m) _Pragma("unroll") for (int n = 0; n < 2; ++n) _Pragma("unroll") for (int k = 0; k < 2; ++k) \
        acc[ai][bj][m][n] = __builtin_amdgcn_mfma_f32_16x16x32_bf16(Bt[n][k], At[m][k], acc[ai][bj][m][n], 0, 0, 0); __builtin_amdgcn_s_setprio(0); } while (0)
#define PG8_WAIT_V(n) asm volatile("s_waitcnt vmcnt(" #n ")" ::: "memory")
#define PG8_WAIT_L(n) asm volatile("s_waitcnt lgkmcnt(" #n ")" ::: "memory")
#define PG8_BAR __builtin_amdgcn_s_barrier()
#define PG8_SCHED __builtin_amdgcn_sched_barrier(0)
    Unit cur, nxt; int ui = 0;
    if (!S.next(0, cur)) return;
    f32x4 acc[2][2][4][2];
#pragma unroll
    for (int a = 0; a < 2; ++a)
#pragma unroll
        for (int b = 0; b < 2; ++b)
#pragma unroll
            for (int m = 0; m < 4; ++m)
#pragma unroll
                for (int n = 0; n < 2; ++n) acc[a][b][m][n] = (f32x4){0.f, 0.f, 0.f, 0.f};
    bf16x8 At[4][2], B0[2][2], B1[2][2];
    const char* cA = (const char*)g.A + (size_t)cur.pm * tA; const char* cB = (const char*)g.Bt + (size_t)cur.pn * tB;
    PG8_STAGE(PG8_SB(0, 0), cB, voffB); PG8_STAGE(PG8_SB(0, 1), cB + hB, voffB); PG8_STAGE(PG8_SA(0, 0), cA, voffA); PG8_STAGE(PG8_SA(0, 1), cA + hA, voffA);
    if (wr == 1) PG8_BAR;
    PG8_WAIT_V(2); PG8_BAR;
    PG8_STAGE(PG8_SB(1, 0), cB + kstep, voffB); PG8_STAGE(PG8_SA(1, 0), cA + kstep, voffA); PG8_STAGE(PG8_SB(1, 1), cB + hB + kstep, voffB);
    PG8_WAIT_V(6); PG8_BAR;
    for (;;) {
        const bool has_next = S.next(ui + 1, nxt);
        const char* nA = has_next ? (const char*)g.A + (size_t)nxt.pm * tA : cA; const char* nB = has_next ? (const char*)g.Bt + (size_t)nxt.pn * tB : cB;
#pragma unroll 1
        for (int t = 0; t < nt; t += 2) {
            const bool last = (t == nt - 2);
            const char* a1 = cA + (size_t)(t + 1) * kstep;
            const char* a2 = last ? nA : cA + (size_t)(t + 2) * kstep; const char* b2 = last ? nB : cB + (size_t)(t + 2) * kstep;
            const char* a3 = a2 + kstep; const char* b3 = b2 + kstep;
            PG8_LDB(B0, 0, 0); PG8_LDB(B1, 0, 1); PG8_SCHED; PG8_LDA(At, 0, 0); PG8_STAGE(PG8_SA(1, 1), a1 + hA, voffA);
            PG8_WAIT_V(8); PG8_WAIT_L(0); PG8_BAR; PG8_MMA(0, 0, At, B0); PG8_MMA(0, 1, At, B1); PG8_BAR; PG8_SCHED;
            PG8_LDA(At, 0, 1); PG8_STAGE(PG8_SB(0, 0), b2, voffB); PG8_STAGE(PG8_SB(0, 1), b2 + hB, voffB); PG8_STAGE(PG8_SA(0, 0), a2, voffA);
            PG8_WAIT_V(8); PG8_WAIT_L(0); PG8_BAR; PG8_MMA(1, 0, At, B0); PG8_MMA(1, 1, At, B1); PG8_BAR; PG8_SCHED;
            PG8_LDB(B0, 1, 0); PG8_LDB(B1, 1, 1); PG8_SCHED; PG8_LDA(At, 1, 0); PG8_STAGE(PG8_SA(0, 1), a2 + hA, voffA);
            PG8_WAIT_V(8); PG8_WAIT_L(0); PG8_BAR; PG8_MMA(0, 0, At, B0); PG8_MMA(0, 1, At, B1); PG8_BAR; PG8_SCHED;
            PG8_LDA(At, 1, 1); PG8_STAGE(PG8_SB(1, 0), b3, voffB); PG8_STAGE(PG8_SB(1, 1), b3 + hB, voffB); PG8_STAGE(PG8_SA(1, 0), a3, voffA);
            PG8_WAIT_V(8); PG8_WAIT_L(0); PG8_BAR; PG8_MMA(1, 0, At, B0); PG8_MMA(1, 1, At, B1); PG8_BAR; PG8_SCHED;
        }
        if (wr == 0) PG8_BAR;
        E(acc, cur, wr, wc, fr, fq);
        if (!has_next) break;
#pragma unroll
        for (int a = 0; a < 2; ++a)
#pragma unroll
            for (int b = 0; b < 2; ++b)
#pragma unroll
                for (int m = 0; m < 4; ++m)
#pragma unroll
                    for (int n = 0; n < 2; ++n) acc[a][b][m][n] = (f32x4){0.f, 0.f, 0.f, 0.f};
        cur = nxt; cA = nA; cB = nB; ++ui;
        if (wr == 1) PG8_BAR;
    }
    PG8_WAIT_V(0);
    PG8_BAR;
#undef PG8_SA
#undef PG8_SB
#undef PG8_STAGE
#undef PG8_LDA
#undef PG8_LDB
#undef PG8_MMA
#undef PG8_WAIT_V
#undef PG8_WAIT_L
#undef PG8_BAR
#undef PG8_SCHED
}

struct UnitG { const char* a; const char* b; int row0, pn, e, valid; const int* rows; };
template <class Epi, class Sched, bool GATHER>
__device__ __forceinline__ void gemm_phase_g(PG8_LAS unsigned char* lds, const int K, const int lda, const int ldb, const Sched& S, const Epi& E) {
    const int tid = otid(), wid = __builtin_amdgcn_readfirstlane(tid >> 6), lane = tid & 63, wr = wid >> 2, wc = wid & 3, fr = lane & 15, fq = lane >> 4;
    const int nt = K / BK;
    int RA[2], CA[2]; unsigned voffB[2];
#pragma unroll
    for (int i = 0; i < 2; ++i) { int R, C; stage_rc(tid * 16 + i * 8192, R, C); const int Rb = Epi::PERM ? ((R & ~31) + perm32(R & 31)) : R;
        RA[i] = R; CA[i] = C; voffB[i] = (unsigned)(Rb * ldb + C) * 2u; }
    const size_t kstep = (size_t)(BK * 2);
    const size_t hB = (size_t)HALF * ldb * 2;
    const unsigned ldsw = (unsigned)wid * 1024u;
    const int aoff = lds_byte(wr * 64 + fr, fq * 8), boff = lds_byte(wc * 32 + fr, fq * 8);
#define PG8_SA(b, h) (((b) * 2 + (h)) * HTB)
#define PG8_SB(b, h) ((4 + (b) * 2 + (h)) * HTB)
#define PG8_STAGE(bufoff, gbase, voff) do { _Pragma("unroll") for (int _i = 0; _i < 2; ++_i) \
        __builtin_amdgcn_global_load_lds((const unsigned*)((const char*)(gbase) + (voff)[_i]), (PG8_LAS unsigned*)(lds + (bufoff) + ldsw + _i * 8192), 16, 0, 0); } while (0)
#define PG8_LDA(dst, b, h) do { _Pragma("unroll") for (int m = 0; m < 4; ++m) _Pragma("unroll") for (int k = 0; k < 2; ++k) dst[m][k] = *(const PG8_LAS bf16x8*)(lds + PG8_SA(b, h) + aoff + m * 2048 + k * 1024); } while (0)
#define PG8_LDB(dst, b, h) do { _Pragma("unroll") for (int n = 0; n < 2; ++n) _Pragma("unroll") for (int k = 0; k < 2; ++k) dst[n][k] = *(const PG8_LAS bf16x8*)(lds + PG8_SB(b, h) + boff + n * 2048 + k * 1024); } while (0)
#define PG8_MMA(ai, bj, At, Bt) do { __builtin_amdgcn_s_setprio(1); _Pragma("unroll") for (int m = 0; m < 4; ++m) _Pragma("unroll") for (int n = 0; n < 2; ++n) _Pragma("unroll") for (int k = 0; k < 2; ++k) \
        acc[ai][bj][m][n] = __builtin_amdgcn_mfma_f32_16x16x32_bf16(Bt[n][k], At[m][k], acc[ai][bj][m][n], 0, 0, 0); __builtin_amdgcn_s_setprio(0); } while (0)
#define PG8_WAIT_V(n) asm volatile("s_waitcnt vmcnt(" #n ")" ::: "memory")
#define PG8_WAIT_L(n) asm volatile("s_waitcnt lgkmcnt(" #n ")" ::: "memory")
#define PG8_BAR __builtin_amdgcn_s_barrier()
#define PG8_SCHED __builtin_amdgcn_sched_barrier(0)
#define PG8_MKOFF(u, v) do { _Pragma("unroll") for (int _h = 0; _h < 2; ++_h) _Pragma("unroll") for (int _i = 0; _i < 2; ++_i) { const int _row = _h * HALF + RA[_i]; \
        if (GATHER) { const int _pr = _row < (u).valid ? (u).rows[_row] : 0; v[_h][_i] = (unsigned)(_pr >> 3) * (unsigned)(lda * 2) + (unsigned)(CA[_i] * 2); } \
        else v[_h][_i] = (unsigned)(_row * lda + CA[_i]) * 2u; } } while (0)
    UnitG cur, nxt; int ui = 0;
    if (!S.next(0, cur)) return;
    f32x4 acc[2][2][4][2];
#pragma unroll
    for (int a = 0; a < 2; ++a)
#pragma unroll
        for (int b = 0; b < 2; ++b)
#pragma unroll
            for (int m = 0; m < 4; ++m)
#pragma unroll
                for (int n = 0; n < 2; ++n) acc[a][b][m][n] = (f32x4){0.f, 0.f, 0.f, 0.f};
    bf16x8 At[4][2], B0[2][2], B1[2][2];
    unsigned vA[2][2], vN[2][2];
    PG8_MKOFF(cur, vA);
    const char* cA = cur.a; const char* cB = cur.b;
    PG8_STAGE(PG8_SB(0, 0), cB, voffB); PG8_STAGE(PG8_SB(0, 1), cB + hB, voffB); PG8_STAGE(PG8_SA(0, 0), cA, vA[0]); PG8_STAGE(PG8_SA(0, 1), cA, vA[1]);
    if (wr == 1) PG8_BAR;
    PG8_WAIT_V(2); PG8_BAR;
    PG8_STAGE(PG8_SB(1, 0), cB + kstep, voffB); PG8_STAGE(PG8_SA(1, 0), cA + kstep, vA[0]); PG8_STAGE(PG8_SB(1, 1), cB + hB + kstep, voffB);
    PG8_WAIT_V(6); PG8_BAR;
    for (;;) {
        const bool has_next = S.next(ui + 1, nxt);
        if constexpr (GATHER) { if (has_next) { PG8_MKOFF(nxt, vN); } else { vN[0][0] = vA[0][0]; vN[0][1] = vA[0][1]; vN[1][0] = vA[1][0]; vN[1][1] = vA[1][1]; } }
        const char* nA = has_next ? nxt.a : cA; const char* nB = has_next ? nxt.b : cB;
#pragma unroll 1
        for (int t = 0; t < nt; t += 2) {
            const bool last = (t == nt - 2);
            const char* a1 = cA + (size_t)(t + 1) * kstep;
            const char* a2 = last ? nA : cA + (size_t)(t + 2) * kstep; const char* b2 = last ? nB : cB + (size_t)(t + 2) * kstep;
            const char* a3 = a2 + kstep; const char* b3 = b2 + kstep;
            unsigned s0[2], s1[2];
            if constexpr (GATHER) { s0[0] = last ? vN[0][0] : vA[0][0]; s0[1] = last ? vN[0][1] : vA[0][1]; s1[0] = last ? vN[1][0] : vA[1][0]; s1[1] = last ? vN[1][1] : vA[1][1]; }
            else { s0[0] = vA[0][0]; s0[1] = vA[0][1]; s1[0] = vA[1][0]; s1[1] = vA[1][1]; }
            PG8_LDB(B0, 0, 0); PG8_LDB(B1, 0, 1); PG8_SCHED; PG8_LDA(At, 0, 0); PG8_STAGE(PG8_SA(1, 1), a1, vA[1]);
            PG8_WAIT_V(8); PG8_WAIT_L(0); PG8_BAR; PG8_MMA(0, 0, At, B0); PG8_MMA(0, 1, At, B1); PG8_BAR; PG8_SCHED;
            PG8_LDA(At, 0, 1); PG8_STAGE(PG8_SB(0, 0), b2, voffB); PG8_STAGE(PG8_SB(0, 1), b2 + hB, voffB); PG8_STAGE(PG8_SA(0, 0), a2, s0);
            PG8_WAIT_V(8); PG8_WAIT_L(0); PG8_BAR; PG8_MMA(1, 0, At, B0); PG8_MMA(1, 1, At, B1); PG8_BAR; PG8_SCHED;
            PG8_LDB(B0, 1, 0); PG8_LDB(B1, 1, 1); PG8_SCHED; PG8_LDA(At, 1, 0); PG8_STAGE(PG8_SA(0, 1), a2, s1);
            PG8_WAIT_V(8); PG8_WAIT_L(0); PG8_BAR; PG8_MMA(0, 0, At, B0); PG8_MMA(0, 1, At, B1); PG8_BAR; PG8_SCHED;
            PG8_LDA(At, 1, 1); PG8_STAGE(PG8_SB(1, 0), b3, voffB); PG8_STAGE(PG8_SB(1, 1), b3 + hB, voffB); PG8_STAGE(PG8_SA(1, 0), a3, s0);
            PG8_WAIT_V(8); PG8_WAIT_L(0); PG8_BAR; PG8_MMA(1, 0, At, B0); PG8_MMA(1, 1, At, B1); PG8_BAR; PG8_SCHED;
        }
        if (wr == 0) PG8_BAR;
        E(acc, cur, wr, wc, fr, fq);
        if (!has_next) break;
#pragma unroll
        for (int a = 0; a < 2; ++a)
#pragma unroll
            for (int b = 0; b < 2; ++b)
#pragma unroll
                for (int m = 0; m < 4; ++m)
#pragma unroll
                    for (int n = 0; n < 2; ++n) acc[a][b][m][n] = (f32x4){0.f, 0.f, 0.f, 0.f};
        cur = nxt; cA = nA; cB = nB; ++ui;
        if constexpr (GATHER) { vA[0][0] = vN[0][0]; vA[0][1] = vN[0][1]; vA[1][0] = vN[1][0]; vA[1][1] = vN[1][1]; }
        if (wr == 1) PG8_BAR;
    }
    PG8_WAIT_V(0);
    PG8_BAR;
#undef PG8_SA
#undef PG8_SB
#undef PG8_STAGE
#undef PG8_LDA
#undef PG8_LDB
#undef PG8_MMA
#undef PG8_WAIT_V
#undef PG8_WAIT_L
#undef PG8_BAR
#undef PG8_SCHED
#undef PG8_MKOFF
}
}

constexpr int DM = 1024, NB = 2, SEQ = 8192, CTX = 256, TPB = SEQ + CTX, MROWS = NB * TPB, DEPTH = 2;
constexpr int INW = 9216, COL_K = 0, COL_V = 1024, COL_LX = 2048, COL_Q = 3072, COL_LG = 4096, COL_F = 5120, COL_G = 6144;
constexpr int NE = 256, TOPK = 8, EFF = 256, NPAIR = MROWS * TOPK, LCAP = MROWS;
constexpr float EPS = 1e-6f;
constexpr float QSCALE = 0.125f * 1.4426950408889634f;
constexpr int NCHUNK = TPB / 64;
static_assert(MROWS % 256 == 0, "rows");

constexpr size_t MiB = 1u << 20;
constexpr size_t WS_CTL = 0, CTL_ZERO_BYTES = 1 * MiB;
constexpr size_t WS_W = 1 * MiB, WL_STRIDE = 32 * MiB;
constexpr size_t WO_TAB = 31 * MiB;
constexpr size_t WO_WIN = 0, WO_D1 = 18 * MiB, WO_OUT = 24 * MiB, WO_R = 26 * MiB, WO_SGU = 27 * MiB, WO_SD = 28 * MiB, WO_LRU = 29 * MiB;
constexpr size_t WS_XALL = 65 * MiB;
constexpr size_t WS_H = WS_XALL + 66 * MiB;
constexpr size_t WS_U = WS_H + 33 * MiB;
constexpr size_t WS_KB = WS_U + 594 * MiB, WS_VB = WS_KB + 33 * MiB, WS_QB = WS_VB + 33 * MiB, WS_LXB = WS_QB + 33 * MiB, WS_GLG = WS_LXB + 33 * MiB, WS_ZP = WS_GLG + 33 * MiB;
constexpr size_t WS_GATES = WS_ZP + 33 * MiB;
constexpr size_t WS_MIXIN = WS_GATES + 99 * MiB;
constexpr size_t WS_S = WS_MIXIN + 99 * MiB;
constexpr size_t WS_UC = WS_S, WS_AB = WS_UC + 33 * MiB, WS_SUMM = WS_AB + 132 * MiB, WS_CARRY = WS_SUMM + 5 * MiB, WS_XA = WS_CARRY + 3 * MiB, WS_XB = WS_XA + 32 * MiB, WS_GB = WS_XB + 32 * MiB, WS_GC = WS_GB + 32 * MiB;
constexpr size_t WS_PA = WS_S, WS_PR = WS_PA + 66 * MiB, WS_PF = WS_PR + 66 * MiB, WS_Y1 = WS_PF + 66 * MiB;
static_assert(WS_GC + 3 * MiB <= WS_S + 280 * MiB && WS_Y1 + 66 * MiB <= WS_S + 280 * MiB, "scratch S");
constexpr size_t WS_MIXED = WS_S + 280 * MiB, WS_TOK = WS_MIXED + 33 * MiB;
constexpr size_t WS_LOG = WS_TOK + 33 * MiB, WS_SGU = WS_LOG + 17 * MiB, WS_SH = WS_SGU + 33 * MiB, WS_LIST = WS_SH + 9 * MiB, WS_TOPW = WS_LIST + 17 * MiB, WS_SD = WS_TOPW + 1 * MiB;
constexpr size_t WS_YB = WS_U;
constexpr size_t WS_Y16 = WS_U, WS_HB = WS_U + 264 * MiB;
constexpr size_t WS_EW = WS_SD + 66 * MiB, EW_STRIDE = 3 * MiB / 2;
constexpr size_t WS_END = WS_EW + 384 * MiB;
static_assert(WS_END <= 2048 * MiB, "d_ws budget");
constexpr int CW_BAR = 4096;
constexpr int CW_CNT = 16384;
constexpr int CW_MOD = 65536;
static_assert((CW_MOD + 2 * 3 * 6144) * 4 <= (int)CTL_ZERO_BYTES, "ctl");

constexpr int LDS_BYTES = 147456, RING_BYTES = 131072, MISC_OFF = RING_BYTES + 320;
constexpr int NWAVES = 8;

#define GAS __attribute__((address_space(1)))
#define LAS __attribute__((address_space(3)))
typedef unsigned short bf16;
typedef unsigned v4u __attribute__((ext_vector_type(4)));
typedef float f32x4 __attribute__((ext_vector_type(4)));
typedef GAS unsigned gu32;
#define RLX_AGENT __ATOMIC_RELAXED, __HIP_MEMORY_SCOPE_AGENT
#define LDS_WAIT() asm volatile("s_waitcnt lgkmcnt(0)" ::: "memory")
__device__ __forceinline__ unsigned f2bf(float f) { unsigned u = __builtin_bit_cast(unsigned, f); return (u + 0x7fffu + ((u >> 16) & 1u)) >> 16; }
__device__ __forceinline__ unsigned pk2(float lo, float hi) { return f2bf(lo) | (f2bf(hi) << 16); }
__device__ __forceinline__ float bf2f(unsigned h) { return __uint_as_float(h << 16); }
__device__ __forceinline__ float sigmoidf_(float x) { return 1.f / (1.f + __expf(-x)); }
__device__ __forceinline__ float siluf_(float x) { return x / (1.f + __expf(-x)); }
__device__ __forceinline__ float gelu_tanh(float x) { const float u = 0.7978845608028654f * (x + 0.044715f * x * x * x); return 0.5f * x * (1.f + tanhf(u)); }

#define XB_TMO      128
#define XB_XCNT(j)  (256  + 64 * (j))
#define XB_XSUB(j)  (1280 + 64 * (j))
#define XB_XGEN(j)  (2304 + 64 * (j))
#define XB_TOP      3328
#define XB_TOPGEN   3392
#define XCD_BAR_WORDS 3456
#define XB_SPIN_CAP (1u << 18)
__device__ __forceinline__ unsigned xb_ld(unsigned* p)              { return __hip_atomic_load(p, __ATOMIC_RELAXED, __HIP_MEMORY_SCOPE_AGENT); }
__device__ __forceinline__ unsigned xb_add(unsigned* p, unsigned v) { return __hip_atomic_fetch_add(p, v, __ATOMIC_RELAXED, __HIP_MEMORY_SCOPE_AGENT); }
__device__ __forceinline__ unsigned xb_xcc_id() { return (unsigned)__builtin_amdgcn_s_getreg((3 << 11) | 20) & 0xFu; }
#define XB_SPIN(cond, bar) do { unsigned _sp = 0; while (cond) { __builtin_amdgcn_s_sleep(1); \
    if ((++_sp & 255u) == 0u) { if (xb_ld(&(bar)[XB_TMO])) break; if (_sp > XB_SPIN_CAP) { atomicAdd(&(bar)[XB_TMO], 1u); break; } } } } while (0)
struct XcdBarrier { unsigned* bar; unsigned x; volatile LAS unsigned* st; };
__device__ __forceinline__ XcdBarrier xcd_barrier_post(unsigned* bar, volatile LAS unsigned* st) {
    XcdBarrier b; b.bar = bar; b.x = xb_xcc_id(); b.st = st;
    if (threadIdx.x == 0) (void)xb_add(&bar[XB_XCNT(b.x)], 1u);
    return b;
}
__device__ __forceinline__ void xcd_barrier_complete(unsigned* bar, unsigned x, unsigned& nloc, unsigned& nx) {
    const unsigned G = gridDim.x * gridDim.y * gridDim.z;
    unsigned sum, cnt, mine, sp = 0u;
    for (;;) {
        sum = 0u; cnt = 0u; mine = 0u;
#pragma unroll
        for (unsigned j = 0; j < 16; ++j) { const unsigned c = xb_ld(&bar[XB_XCNT(j)]); sum += c; cnt += (c > 0u) ? 1u : 0u; mine = (j == x) ? c : mine; }
        if (sum == G) break;
        __builtin_amdgcn_s_sleep(1);
        if ((++sp & 255u) == 0u) { if (xb_ld(&bar[XB_TMO])) break; if (sp > XB_SPIN_CAP) { atomicAdd(&bar[XB_TMO], 1u); break; } }
    }
    nloc = mine > 0u ? mine : 1u; nx = cnt > 0u ? cnt : 1u;
}
__device__ __forceinline__ void xcd_barrier(const XcdBarrier& b) {
    asm volatile("s_waitcnt vmcnt(0)" ::: "memory");
    __syncthreads();
    if (threadIdx.x == 0) {
        unsigned* bar = b.bar; asm volatile("" : "+s"(bar));
        __builtin_amdgcn_s_waitcnt(0);
        unsigned nloc = b.st[0], nx = b.st[1];
        unsigned bx = b.x; asm volatile("" : "+s"(bx));
        if (nloc == 0u) { xcd_barrier_complete(bar, bx, nloc, nx); b.st[0] = nloc; b.st[1] = nx; }
        const unsigned old = xb_add(&bar[XB_XSUB(bx)], 1u);
        const unsigned gen = old / nloc;
        if (old + 1u == (gen + 1u) * nloc) {
            __builtin_amdgcn_fence(__ATOMIC_RELEASE, "agent");
            asm volatile("s_waitcnt vmcnt(0)" ::: "memory");
            const unsigned og = xb_add(&bar[XB_TOP], 1u);
            const unsigned tg = og / nx;
            if (og + 1u == (tg + 1u) * nx) xb_add(&bar[XB_TOPGEN], 1u);
            else XB_SPIN(xb_ld(&bar[XB_TOPGEN]) == tg, bar);
            __builtin_amdgcn_fence(__ATOMIC_ACQUIRE, "agent");
            xb_add(&bar[XB_XGEN(bx)], 1u);
            asm volatile("s_waitcnt vmcnt(0)" ::: "memory");
        } else {
            XB_SPIN(xb_ld(&bar[XB_XGEN(bx)]) == gen, bar);
            __builtin_amdgcn_fence(__ATOMIC_ACQUIRE, "agent");
            asm volatile("s_waitcnt vmcnt(0)" ::: "memory");
        }
    }
    __syncthreads();
}

struct Args { const float* in[32]; float* out; unsigned char* ws; int ph_lo, ph_hi; };
struct Frame { LAS unsigned char* lds; int tid, lane, wave, bid, G, gw, NGW; long gtid, NT; };
#define WSP(T, off) ((T*)(A.ws + (off)))
#define WLP(l, off) ((bf16*)(A.ws + WS_W + (size_t)(l) * WL_STRIDE + (off)))
#define MODP(l, s, j) ((const float*)(A.ws + WS_CTL) + CW_MOD + ((l) * 3 + (s)) * 6144 + (j) * 1024)

__device__ __forceinline__ float wave_sum(float v) {
    v += sx<1>(v); v += sx<2>(v); v += sx<4>(v); v += sx<8>(v); v += sx<16>(v); v += sx<32>(v);
    return v;
}
__device__ __forceinline__ void p0_transpose_item(const float* W, int K, int N, bf16* WT, int ldwt, int row_off, int col_off, LAS float* scr, int item, int lane) {
    const int nblk = N / 32, kb = item / nblk, nb = item % nblk, k0 = 64 * kb, n0 = 32 * nb;
#pragma unroll 8
    for (int i = 0; i < 32; ++i) { const int kk = 2 * i + (lane >> 5); scr[kk * 33 + (lane & 31)] = W[(size_t)(k0 + kk) * N + n0 + (lane & 31)]; }
    LDS_WAIT(); asm volatile("" ::: "memory");
    const int c = lane & 7;
#pragma unroll
    for (int j = 0; j < 4; ++j) { const int n = (lane >> 3) + 8 * j; const LAS float* s = scr + (8 * c) * 33 + n;
        v4u o; o.x = pk2(s[0 * 33], s[1 * 33]); o.y = pk2(s[2 * 33], s[3 * 33]); o.z = pk2(s[4 * 33], s[5 * 33]); o.w = pk2(s[6 * 33], s[7 * 33]);
        *(v4u*)(WT + (size_t)(row_off + n0 + n) * ldwt + col_off + k0 + 8 * c) = o; }
    LDS_WAIT(); asm volatile("" ::: "memory");
}

__device__ __forceinline__ void ph_prologue(const Frame& F, const Args& A) {
    LAS float* scr = (LAS float*)(F.lds + F.wave * 16384);
    constexpr int I_WIN = 16 * 288, I_SQ = 16 * 32, I_R = 16 * 8, I_SD = 4 * 32;
    constexpr int PER_L = I_WIN + 4 * I_SQ + 3 * I_R + I_SD;
    for (int it = F.gw; it < 2 * PER_L; it += F.NGW) {
        const int l = it / PER_L; int r = it % PER_L;
        if (r < I_WIN) { p0_transpose_item(A.in[7] + (size_t)l * 1024 * 9216, 1024, 9216, WLP(l, WO_WIN), 1024, 0, 0, scr, r, F.lane); continue; } r -= I_WIN;
        if (r < I_SQ) { p0_transpose_item(A.in[12] + (size_t)l * 1048576, 1024, 1024, WLP(l, WO_D1), 3072, 0, 0, scr, r, F.lane); continue; } r -= I_SQ;
        if (r < I_SQ) { p0_transpose_item(A.in[20] + (size_t)l * 1048576, 1024, 1024, WLP(l, WO_D1), 3072, 0, 1024, scr, r, F.lane); continue; } r -= I_SQ;
        if (r < I_SQ) { p0_transpose_item(A.in[21] + (size_t)l * 1048576, 1024, 1024, WLP(l, WO_D1), 3072, 0, 2048, scr, r, F.lane); continue; } r -= I_SQ;
        if (r < I_SQ) { p0_transpose_item(A.in[22] + (size_t)l * 1048576, 1024, 1024, WLP(l, WO_OUT), 1024, 0, 0, scr, r, F.lane); continue; } r -= I_SQ;
        if (r < I_R) { p0_transpose_item(A.in[24] + (size_t)l * 262144, 1024, 256, WLP(l, WO_R), 1024, 0, 0, scr, r, F.lane); continue; } r -= I_R;
        if (r < I_R) { p0_transpose_item(A.in[29] + (size_t)l * 262144, 1024, 256, WLP(l, WO_SGU), 1024, 0, 0, scr, r, F.lane); continue; } r -= I_R;
        if (r < I_R) { p0_transpose_item(A.in[30] + (size_t)l * 262144, 1024, 256, WLP(l, WO_SGU), 1024, 256, 0, scr, r, F.lane); continue; } r -= I_R;
        p0_transpose_item(A.in[31] + (size_t)l * 262144, 256, 1024, WLP(l, WO_SD), 256, 0, 0, scr, r, F.lane);
    }
    float* MOD = (float*)(A.ws + WS_CTL) + CW_MOD;
    LAS float* part = (LAS float*)(F.lds + 8 * 16384 - 8192);
    for (int it = F.bid; it < 2 * 96; it += F.G) {
        const int l = it / 96, nb = it % 96, n = nb * 64 + F.lane;
        const float* wm = A.in[4] + (size_t)l * 1024 * 6144 + n;
        float a0 = 0.f, a1 = 0.f, a2 = 0.f;
#pragma unroll 8
        for (int k = F.wave * 128; k < F.wave * 128 + 128; ++k) {
            const float w = wm[(size_t)k * 6144];
            a0 += siluf_(A.in[1][k]) * w; a1 += siluf_(A.in[1][1024 + k]) * w; a2 += siluf_(A.in[3][k]) * w;
        }
        __syncthreads();
        part[(F.wave * 3 + 0) * 64 + F.lane] = a0; part[(F.wave * 3 + 1) * 64 + F.lane] = a1; part[(F.wave * 3 + 2) * 64 + F.lane] = a2;
        __syncthreads();
        if (F.wave < 3) { float s = A.in[5][l * 6144 + n];
#pragma unroll
            for (int w = 0; w < 8; ++w) s += part[(w * 3 + F.wave) * 64 + F.lane];
            MOD[(l * 3 + F.wave) * 6144 + n] = s; }
    }
    for (long i = F.gtid; i < 2L * 4096 * 256; i += F.NT) {
        const int l = (int)(i >> 20), n = (int)((i >> 8) & 4095), kk = (int)(i & 255), pn = n >> 8, rr = n & 255, gate = rr >> 7, rho = rr & 127, d = pn >> 3, cb = pn & 7;
        const int cho = 128 * cb + rho, blk = cho >> 6, e = cho & 63, chi = 256 * (cb >> 1) + kk; float v = 0.f;
        if ((chi >> 6) == blk) v = (gate ? A.in[17] : A.in[15])[((size_t)(l * 2 + d) * 16 + blk) * 4096 + (chi & 63) * 64 + e];
        WLP(l, WO_LRU)[i & 0xFFFFF] = (bf16)f2bf(v);
    }
    for (long i = F.gtid; i < 2L * 65536; i += F.NT) {
        const int which = (int)(i >> 16), n = (int)((i >> 8) & 255), k = (int)(i & 255); float v;
        if (which == 0) { const int k1 = n >> 1, cp = n & 1, t1 = k >> 1, c = k & 1; const float rev = (float)((k1 * t1) & 127) * (1.f / 128.f);
            const float cs = __builtin_amdgcn_cosf(rev), sn = __builtin_amdgcn_sinf(rev); v = cp == 0 ? (c == 0 ? cs : sn) : (c == 0 ? -sn : cs); }
        else { const int h = n >> 7, k2 = (n >> 1) & 63, cp = n & 1, hp = k >> 7, t2 = (k >> 1) & 63, c = k & 1; const float rev = (float)((k2 * t2) & 63) * (1.f / 64.f);
            const float cs = __builtin_amdgcn_cosf(rev), sn = __builtin_amdgcn_sinf(rev); v = (h != hp) ? 0.f : (cp == 0 ? (c == 0 ? cs : sn) : (c == 0 ? -sn : cs)); }
        WLP(0, WO_TAB)[i] = (bf16)f2bf(v);
    }
    for (long i = F.gtid; i < 4096; i += F.NT) ((float*)(A.ws + WS_W + WO_TAB + 262144))[i] = log1pf(expf(-A.in[19][i]));
    f32x4* XA = WSP(f32x4, WS_XALL);
    for (long i = F.gtid; i < (long)MROWS * 256; i += F.NT) {
        const int R = (int)(i >> 8), c4 = (int)(i & 255), b = R / TPB, p = R % TPB;
        const f32x4* src = (p < CTX) ? (const f32x4*)(A.in[2] + ((size_t)b * CTX + p) * 1024) : (const f32x4*)(A.in[0] + ((size_t)b * SEQ + (p - CTX)) * 1024);
        XA[i] = src[c4];
    }
}

__device__ __forceinline__ void norm_mod_row(const f32x4 (&v)[4], const float* g, const float* sc, const float* sh, bf16* orow, int lane) {
    float s = 0.f;
#pragma unroll
    for (int j = 0; j < 4; ++j) s += (v[j].x * v[j].x + v[j].y * v[j].y) + (v[j].z * v[j].z + v[j].w * v[j].w);
    const float rs = rsqrtf(wave_sum(s) * (1.f / 1024.f) + EPS);
#pragma unroll
    for (int j = 0; j < 4; ++j) { const int c = 4 * lane + 256 * j;
        const f32x4 gg = *(const f32x4*)(g + c), s1 = *(const f32x4*)(sc + c), s0 = *(const f32x4*)(sh + c);
        const float y0 = v[j].x * rs * gg.x * (1.f + s1.x) + s0.x, y1 = v[j].y * rs * gg.y * (1.f + s1.y) + s0.y, y2 = v[j].z * rs * gg.z * (1.f + s1.z) + s0.z, y3 = v[j].w * rs * gg.w * (1.f + s1.w) + s0.w;
        *(unsigned long long*)(orow + c) = (unsigned long long)pk2(y0, y1) | ((unsigned long long)pk2(y2, y3) << 32); }
}
__device__ __forceinline__ void ph_norm1(const Frame& F, const Args& A, int l) {
    const float* X = WSP(float, WS_XALL); bf16* H = WSP(bf16, WS_H);
    for (int R = F.gw; R < MROWS; R += F.NGW) {
        const int b = R / TPB, p = R % TPB, s = (p < CTX) ? 2 : b;
        f32x4 v[4];
#pragma unroll
        for (int j = 0; j < 4; ++j) v[j] = *(const f32x4*)(X + (size_t)R * 1024 + 4 * F.lane + 256 * j);
        norm_mod_row(v, A.in[6] + l * 1024, MODP(l, s, 1), MODP(l, s, 0), H + (size_t)R * 1024, F.lane);
    }
}

__device__ __forceinline__ void ph_uelem(const Frame& F, const Args& A, int l) {
    const float* U = WSP(float, WS_U);
    bf16 *Kb = WSP(bf16, WS_KB), *Vb = WSP(bf16, WS_VB), *Qb = WSP(bf16, WS_QB), *LXb = WSP(bf16, WS_LXB), *GLG = WSP(bf16, WS_GLG), *ZP = WSP(bf16, WS_ZP), *GT = WSP(bf16, WS_GATES);
    LAS float* sF = (LAS float*)F.lds; LAS float* sT = sF + 1024;
    if (F.tid < 256) sT[F.tid] = cospif((float)F.tid / 128.0f);
    __syncthreads();
    for (int R = F.bid; R < MROWS; R += F.G) {
        const float* u = U + (size_t)R * INW; const int p = R % TPB; const bool lat = p >= CTX; const int t = p - CTX;
        for (int gi = F.wave; gi < 32; gi += 8) {
            const bool isq = gi >= 16; const int grp = gi & 15;
            const float v = u[(isq ? COL_Q : COL_K) + grp * 64 + F.lane];
            const float ss = wave_sum(v * v);
            float y = v * rsqrtf(ss * (1.f / 64.f) + EPS) * (isq ? A.in[8] : A.in[9])[l * 64 + F.lane];
            const float part = sx<16>(y);
            if (lat) { const int axis = F.lane >> 5, hf = (F.lane >> 4) & 1, f = F.lane & 15;
                const float pos = (float)(axis ? (t & 63) : (t >> 6)); const float inv = exp2f(-(float)f * (13.287712379549449f / 16.f));
                float sn, cs; sincosf(pos * inv, &sn, &cs);
                y = hf ? (part * sn + y * cs) : (y * cs - part * sn); }
            if (isq) y *= QSCALE;
            (isq ? Qb : Kb)[(size_t)R * 1024 + grp * 64 + F.lane] = (bf16)f2bf(y);
        }
        for (int c = F.tid; c < 1024; c += 512) { const size_t o = (size_t)R * 1024 + c;
            Vb[o] = (bf16)f2bf(u[COL_V + c]); LXb[o] = (bf16)f2bf(u[COL_LX + c]); GLG[o] = (bf16)f2bf(gelu_tanh(u[COL_LG + c])); sF[c] = u[COL_F + c]; }
        for (int c = F.tid; c < 3072; c += 512) GT[(size_t)R * 3072 + c] = (bf16)f2bf(sigmoidf_(u[COL_G + c]));
        __syncthreads();
        for (int o = F.tid; o < 1024; o += 512) { const int g = o >> 8, oo = o & 255; int j = oo >> 1, odd = oo & 1; if (oo == 1) { j = 128; odd = 0; }
            const int m0 = odd ? 192 : 0; float acc = 0.f;
            for (int c = 0; c < 256; ++c) acc += sF[g * 256 + c] * sT[(j * c + m0) & 255];
            ZP[(size_t)R * 1024 + o] = (bf16)f2bf(acc); }
        __syncthreads();
    }
}

__device__ __forceinline__ void ph_conv(const Frame& F, const Args& A, int l) {
    const bf16* LXb = WSP(bf16, WS_LXB); bf16* UC = WSP(bf16, WS_UC);
    const float* cw = A.in[13] + l * 4096; const float* cb = A.in[14] + l * 1024;
    for (long i = F.gtid; i < (long)MROWS * 1024; i += F.NT) {
        const int R = (int)(i >> 10), ch = (int)(i & 1023), p = R % TPB; const int lo = p < CTX ? 0 : CTX, hi = p < CTX ? CTX : TPB;
        float acc = cb[ch];
#pragma unroll
        for (int j = 0; j < 4; ++j) { const int pp = p + j - 2; if (pp >= lo && pp < hi) acc += cw[j * 1024 + ch] * bf2f(LXb[(size_t)(R + j - 2) * 1024 + ch]); }
        UC[i] = (bf16)f2bf(acc);
    }
}
#if !FAST_LRU
__device__ __forceinline__ void ph_lrucoef(const Frame& F, const Args& A, int l) {
    const bf16* UC = WSP(bf16, WS_UC); unsigned* AB = WSP(unsigned, WS_AB);
    for (long i = F.gtid; i < 2L * MROWS * 1024; i += F.NT) {
        const int d = (int)(i / ((long)MROWS * 1024)); const long rem = i % ((long)MROWS * 1024); const int R = (int)(rem >> 10), ch = (int)(rem & 1023), blk = ch >> 6, e = ch & 63;
        const float* wa = A.in[15] + ((size_t)(l * 2 + d) * 16 + blk) * 4096 + e; const float* wi = A.in[17] + ((size_t)(l * 2 + d) * 16 + blk) * 4096 + e;
        float r = A.in[16][(l * 2 + d) * 1024 + ch], ig = A.in[18][(l * 2 + d) * 1024 + ch];
        const bf16* ur = UC + (size_t)R * 1024 + blk * 64;
        for (int dd = 0; dd < 64; ++dd) { const float x = bf2f(ur[dd]); r += x * wa[dd * 64]; ig += x * wi[dd * 64]; }
        const float lam = A.in[19][(l * 2 + d) * 1024 + ch]; const float sp = log1pf(expf(-lam));
        const float la = -8.f * sigmoidf_(r) * sp; const float mult = sqrtf(-expm1f(2.f * la));
        const float bc = mult * sigmoidf_(ig) * bf2f(ur[e]);
        AB[i] = pk2(la, bc);
    }
}
#endif
struct LruSched {
    const char* uc; const char* w; int G, c;
    __device__ __forceinline__ bool next(int i, pg8::UnitG& U) const {
        const long id = (long)i * G + c; if (id >= 66 * 16) return false;
        const int pm = (int)(id >> 4), pn = (int)(id & 15);
        U.a = uc + ((size_t)pm * 256 * 1024 + 256 * ((pn & 7) >> 1)) * 2; U.b = w + (size_t)pn * 256 * 256 * 2; U.row0 = pm * 256; U.pn = pn; U.e = 0; U.valid = 256; U.rows = nullptr; return true;
    }
};
struct EpiLru {
    static constexpr bool PERM = false;
    unsigned* AB; const bf16* UC; const float* ba; const float* bi; const float* sp;
    __device__ __forceinline__ void operator()(const f32x4 (&acc)[2][2][4][2], const pg8::UnitG& u, int wr, int wc, int fr, int fq) const {
        const int d = u.pn >> 3, cb = u.pn & 7, ch0 = 128 * cb + wc * 32 + 4 * fq;
        f32x4 vba[2], vbi[2], vsp[2];
#pragma unroll
        for (int n = 0; n < 2; ++n) { vba[n] = *(const f32x4*)(ba + d * 1024 + ch0 + 16 * n); vbi[n] = *(const f32x4*)(bi + d * 1024 + ch0 + 16 * n); vsp[n] = *(const f32x4*)(sp + d * 1024 + ch0 + 16 * n); }
#pragma unroll
        for (int ai = 0; ai < 2; ++ai)
#pragma unroll
            for (int m = 0; m < 4; ++m) { const size_t R = (size_t)u.row0 + ai * 128 + wr * 64 + m * 16 + fr;
#pragma unroll
                for (int n = 0; n < 2; ++n) { const int ch = ch0 + 16 * n;
                    const unsigned long long ux = *(const unsigned long long*)(UC + R * 1024 + ch);
                    const float x[4] = {bf2f((unsigned)ux & 0xffffu), bf2f(((unsigned)ux) >> 16), bf2f((unsigned)(ux >> 32) & 0xffffu), bf2f((unsigned)(ux >> 48))};
                    const f32x4 r = acc[ai][0][m][n] + vba[n], g = acc[ai][1][m][n] + vbi[n]; v4u o;
#pragma unroll
                    for (int e = 0; e < 4; ++e) { const float la = -8.f * sigmoidf_(r[e]) * vsp[n][e]; const float mult = sqrtf(fmaxf(1.f - __expf(2.f * la), 0.f));
                        o[e] = pk2(la, mult * sigmoidf_(g[e]) * x[e]); }
                    *(v4u*)(AB + ((size_t)d * MROWS + R) * 1024 + ch) = o; }
                asm volatile("" ::: "memory"); }
    }
};
__device__ __forceinline__ void ph_lru_gemm(const Frame& F, const Args& A, int l) {
    const int vcu = (F.G % 8 == 0) ? (F.bid % 8) * (F.G / 8) + F.bid / 8 : F.bid;
    LruSched S{(const char*)WSP(bf16, WS_UC), (const char*)WLP(l, WO_LRU), F.G, vcu};
    EpiLru E{WSP(unsigned, WS_AB), WSP(bf16, WS_UC), A.in[16] + l * 2048, A.in[18] + l * 2048, (const float*)(A.ws + WS_W + WO_TAB + 262144) + l * 2048};
    pg8::gemm_phase_g<EpiLru, LruSched, false>(F.lds, 256, 1024, 256, S, E);
}
struct FftSched {
    const char* x; const char* w; int nunits, G, c;
    __device__ __forceinline__ bool next(int i, pg8::UnitG& U) const {
        const long id = (long)i * G + c; if (id >= nunits) return false;
        U.a = x + (size_t)id * 256 * 256 * 2; U.b = w; U.row0 = (int)id * 256; U.pn = 0; U.e = 0; U.valid = 256; U.rows = nullptr; return true;
    }
};
struct EpiFftA {
    static constexpr bool PERM = false;
    unsigned* XB;
    __device__ __forceinline__ void operator()(const f32x4 (&acc)[2][2][4][2], const pg8::UnitG& u, int wr, int wc, int fr, int fq) const {
#pragma unroll
        for (int ai = 0; ai < 2; ++ai)
#pragma unroll
            for (int m = 0; m < 4; ++m) { int r0 = u.row0; asm volatile("" : "+s"(r0));
                const int row = r0 + ai * 128 + wr * 64 + m * 16 + fr, t2 = row & 63; const size_t bc = (size_t)(row >> 6);
#pragma unroll
                for (int bj = 0; bj < 2; ++bj)
#pragma unroll
                    for (int n = 0; n < 2; ++n) { const int k1 = 64 * bj + 16 * wc + 8 * n + 2 * fq; const f32x4 v = acc[ai][bj][m][n];
#pragma unroll
                        for (int q = 0; q < 2; ++q) { const int kk = k1 + q; const float rev = (float)(kk * t2) * (1.f / 8192.f);
                            const float cs = __builtin_amdgcn_cosf(rev), sn = __builtin_amdgcn_sinf(rev); const float yr = v[2 * q], yi = v[2 * q + 1];
                            XB[(bc * 64 + (kk >> 1)) * 128 + (kk & 1) * 64 + t2] = pk2(yr * cs + yi * sn, yi * cs - yr * sn); } }
                asm volatile("" ::: "memory"); }
    }
};
struct EpiBf16Plain {
    static constexpr bool PERM = true;
    bf16* C; int ldc;
    __device__ __forceinline__ void operator()(const f32x4 (&acc)[2][2][4][2], const pg8::UnitG& u, int wr, int wc, int fr, int fq) const {
#pragma unroll
        for (int ai = 0; ai < 2; ++ai)
#pragma unroll
            for (int m = 0; m < 4; ++m) { bf16* rowp = C + (size_t)(u.row0 + ai * 128 + wr * 64 + m * 16 + fr) * ldc + u.pn * 256 + wc * 32 + 8 * fq;
#pragma unroll
                for (int bj = 0; bj < 2; ++bj) { const f32x4 v0 = acc[ai][bj][m][0], v1 = acc[ai][bj][m][1];
                    v4u o; o.x = pk2(v0[0], v0[1]); o.y = pk2(v0[2], v0[3]); o.z = pk2(v1[0], v1[1]); o.w = pk2(v1[2], v1[3]);
                    *(v4u*)(rowp + bj * 128) = o; } }
    }
};
__device__ __forceinline__ void ph_fft_a_gemm(const Frame& F, const Args& A) {
    FftSched S{(const char*)WSP(bf16, WS_XA), (const char*)WLP(0, WO_TAB), 256, F.G, F.bid};
    EpiFftA E{WSP(unsigned, WS_XB)};
    pg8::gemm_phase_g<EpiFftA, FftSched, false>(F.lds, 256, 256, 256, S, E);
}
__device__ __forceinline__ void ph_fft_b_gemm(const Frame& F, const Args& A) {
    FftSched S{(const char*)WSP(bf16, WS_XB), (const char*)(WLP(0, WO_TAB) + 65536), 256, F.G, F.bid};
    EpiBf16Plain E{WSP(bf16, WS_GB), 256};
    pg8::gemm_phase_g<EpiBf16Plain, FftSched, false>(F.lds, 256, 256, 256, S, E);
}
__device__ __forceinline__ void ph_scan1(const Frame& F, const Args& A) {
    const unsigned* AB = WSP(unsigned, WS_AB); float2* SUMM = WSP(float2, WS_SUMM);
    for (int it = F.gw; it < NB * 2 * NCHUNK * 16; it += F.NGW) {
        const int cg = it & 15, ck = (it >> 4) % NCHUNK, bd = (it >> 4) / NCHUNK, b = bd >> 1, d = bd & 1, ch = cg * 64 + F.lane;
        const unsigned* ab = AB + ((size_t)d * MROWS + (size_t)b * TPB + ck * 64) * 1024 + ch;
        float ac = 1.f, h = 0.f;
#pragma unroll 8
        for (int i = 0; i < 64; ++i) { const int ii = d ? 63 - i : i; const unsigned w = ab[(size_t)ii * 1024]; const float a = __expf(bf2f(w & 0xffffu)); h = a * h + bf2f(w >> 16); ac *= a; }
        SUMM[((size_t)bd * NCHUNK + ck) * 1024 + ch] = make_float2(ac, h);
    }
}
__device__ __forceinline__ void ph_scan2(const Frame& F, const Args& A) {
    const float2* SUMM = WSP(float2, WS_SUMM); float* CARRY = WSP(float, WS_CARRY);
    if (F.gtid < 4096) {
        const int bd = (int)(F.gtid >> 10), ch = (int)(F.gtid & 1023), d = bd & 1; float h = 0.f;
        for (int s = 0; s < NCHUNK; ++s) { const int ck = d ? (s < 4 ? 3 - s : NCHUNK + 3 - s) : s;
            const size_t o = ((size_t)bd * NCHUNK + ck) * 1024 + ch; CARRY[o] = h; const float2 v = SUMM[o]; h = v.x * h + v.y; }
    }
}
__device__ __forceinline__ void ph_scan3(const Frame& F, const Args& A) {
    const unsigned* AB = WSP(unsigned, WS_AB); const float* CARRY = WSP(float, WS_CARRY); const bf16* GLG = WSP(bf16, WS_GLG); bf16* MX = WSP(bf16, WS_MIXIN);
    for (int it = F.gw; it < NB * NCHUNK * 16; it += F.NGW) {
        const int cg = it & 15, ck = (it >> 4) % NCHUNK, b = (it >> 4) / NCHUNK, ch = cg * 64 + F.lane; const size_t R0 = (size_t)b * TPB + ck * 64;
        const unsigned* ab0 = AB + R0 * 1024 + ch; const unsigned* ab1 = AB + ((size_t)MROWS + R0) * 1024 + ch;
        float hf[64]; float h = CARRY[((size_t)(b * 2 + 0) * NCHUNK + ck) * 1024 + ch];
#pragma unroll
        for (int i = 0; i < 64; ++i) { const unsigned w = ab0[(size_t)i * 1024]; h = __expf(bf2f(w & 0xffffu)) * h + bf2f(w >> 16); hf[i] = h; }
        h = CARRY[((size_t)(b * 2 + 1) * NCHUNK + ck) * 1024 + ch];
#pragma unroll
        for (int i = 63; i >= 0; --i) { const unsigned w = ab1[(size_t)i * 1024]; h = __expf(bf2f(w & 0xffffu)) * h + bf2f(w >> 16);
            MX[(R0 + i) * 3072 + 1024 + ch] = (bf16)f2bf((hf[i] + h) * bf2f(GLG[(R0 + i) * 1024 + ch])); }
    }
}

__device__ __forceinline__ void ph_fft_t1(const Frame& F, const Args& A) {
    const unsigned* ZP = WSP(unsigned, WS_ZP); unsigned* XA = WSP(unsigned, WS_XA);
    for (long i = F.gtid; i < (long)NB * 512 * 8192; i += F.NT) {
        const int t1 = (int)(i & 127), t2 = (int)((i >> 7) & 63), cc = (int)((i >> 13) & 511), b = (int)(i >> 22);
        XA[i] = ZP[((size_t)b * TPB + CTX + 64 * t1 + t2) * 512 + cc];
    }
}
#if !FAST_FFT
__device__ __forceinline__ void ph_fft_a(const Frame& F, const Args& A) {
    const unsigned* XA = WSP(unsigned, WS_XA); unsigned* XB = WSP(unsigned, WS_XB);
    for (long i = F.gtid; i < (long)NB * 512 * 8192; i += F.NT) {
        const int k1 = (int)(i & 127); const long row = i >> 7; const int t2 = (int)(row & 63); const long bc = row >> 6;
        const unsigned* x = XA + row * 128; float yr = 0.f, yi = 0.f;
        for (int t1 = 0; t1 < 128; ++t1) { const unsigned w = x[t1]; const float wr = bf2f(w & 0xffffu), wi = bf2f(w >> 16);
            float sn, cs; sincospif((float)((k1 * t1) & 127) / 64.0f, &sn, &cs);
            yr += wr * cs + wi * sn; yi += wi * cs - wr * sn; }
        float sn, cs; sincospif((float)(k1 * t2) / 4096.0f, &sn, &cs);
        const float zr = yr * cs + yi * sn, zi = yi * cs - yr * sn;
        XB[(bc * 64 + (k1 >> 1)) * 128 + (k1 & 1) * 64 + t2] = pk2(zr, zi);
    }
}
#endif
#if !FAST_FFT
__device__ __forceinline__ void ph_fft_b(const Frame& F, const Args& A) {
    const unsigned* XB = WSP(unsigned, WS_XB); unsigned* GB = WSP(unsigned, WS_GB);
    for (long i = F.gtid; i < (long)NB * 512 * 8192; i += F.NT) {
        const int k2 = (int)(i & 63); const long hrow = i >> 6;
        const unsigned* x = XB + hrow * 64; float yr = 0.f, yi = 0.f;
        for (int t2 = 0; t2 < 64; ++t2) { const unsigned w = x[t2]; const float wr = bf2f(w & 0xffffu), wi = bf2f(w >> 16);
            float sn, cs; sincospif((float)((k2 * t2) & 63) / 32.0f, &sn, &cs);
            yr += wr * cs + wi * sn; yi += wi * cs - wr * sn; }
        GB[hrow * 64 + k2] = pk2(yr, yi);
    }
}
#endif
__device__ __forceinline__ void ph_fft_c(const Frame& F, const Args& A) {
    const unsigned* ZP = WSP(unsigned, WS_ZP); float2* GC = WSP(float2, WS_GC);
    for (long i = F.gtid; i < (long)NB * 512 * 256; i += F.NT) {
        const int cc = (int)(i & 511), k = (int)((i >> 9) & 255), b = (int)(i >> 17);
        float yr = 0.f, yi = 0.f;
        for (int t = 0; t < 256; ++t) { const unsigned w = ZP[((size_t)b * TPB + t) * 512 + cc]; const float wr = bf2f(w & 0xffffu), wi = bf2f(w >> 16);
            const float rev = (float)((k * t) & 255) * (1.f / 256.f); const float sn = __builtin_amdgcn_sinf(rev), cs = __builtin_amdgcn_cosf(rev);
            yr += wr * cs + wi * sn; yi += wi * cs - wr * sn; }
        GC[((size_t)b * 512 + cc) * 256 + k] = make_float2(yr, yi);
    }
}
__device__ __forceinline__ void ph_fft_t2(const Frame& F, const Args& A) {
    const unsigned* GB = WSP(unsigned, WS_GB); const float2* GC = WSP(float2, WS_GC); bf16* MX = WSP(bf16, WS_MIXIN);
    for (long i = F.gtid; i < (long)MROWS * 1024; i += F.NT) {
        const int R = (int)(i >> 10), col = (int)(i & 1023), g = col >> 8, jc = col & 255, b = R / TPB, p = R % TPB;
        const bool lat = p >= CTX; const int T = lat ? SEQ : CTX, k = lat ? p - CTX : p, km = (T - k) & (T - 1);
        const int j = (jc == 0 || jc == 128) ? 0 : (jc < 128 ? jc : 256 - jc); const int cc = g * 128 + j;
        float vr, vi, mr, mi;
        if (lat) { const size_t base = ((size_t)b * 512 + cc) * 64;
            const unsigned w = GB[(base + ((k & 127) >> 1)) * 128 + (k & 1) * 64 + (k >> 7)], wm = GB[(base + ((km & 127) >> 1)) * 128 + (km & 1) * 64 + (km >> 7)];
            vr = bf2f(w & 0xffffu); vi = bf2f(w >> 16); mr = bf2f(wm & 0xffffu); mi = bf2f(wm >> 16); }
        else { const float2 w = GC[((size_t)b * 512 + cc) * 256 + k], wm = GC[((size_t)b * 512 + cc) * 256 + km]; vr = w.x; vi = w.y; mr = wm.x; mi = wm.y; }
        float o;
        if (jc == 0) o = 0.5f * (vr + mr); else if (jc == 128) o = 0.5f * (vi + mi); else if (jc < 128) o = mr; else o = vr;
        o *= lat ? 6.9053396600248786e-4f : 3.90625e-3f;
        MX[(size_t)R * 3072 + 2048 + col] = (bf16)f2bf(o);
    }
}

#if !FAST_ATTN
__device__ __forceinline__ void ph_attn_naive(const Frame& F, const Args& A, int l) {
    const bf16 *Kb = WSP(bf16, WS_KB), *Vb = WSP(bf16, WS_VB), *Qb = WSP(bf16, WS_QB); bf16* MX = WSP(bf16, WS_MIXIN);
    const float* lq = A.in[10] + l * 256; float d01 = 0.f, d23 = 0.f;
    for (int i = 0; i < 64; ++i) { d01 += lq[i] * lq[64 + i]; d23 += lq[128 + i] * lq[192 + i]; }
    const float lam_init = 0.8f - 0.6f * expf(-0.3f * (float)l), lam = expf(d01) - expf(d23) + lam_init;
    LAS float* Ks = (LAS float*)F.lds; LAS float* Vs = Ks + 64 * 132; LAS float* Qs = Vs + 64 * 132; LAS float* Ws = Qs + 16 * 128;
    const int r = F.tid >> 5, tl = F.tid & 31;
    for (int u = F.bid; u < 16 * 528; u += F.G) {
        const int bh = u / 528, qb = u % 528, b = bh >> 3, h = bh & 7; const size_t R0 = (size_t)b * TPB + qb * 16; const int nkeys = qb < 16 ? CTX : TPB;
        __syncthreads();
        for (int e = F.tid; e < 2048; e += 512) Qs[e] = bf2f(Qb[(R0 + (e >> 7)) * 1024 + h * 128 + (e & 127)]);
        float m0 = -1e30f, l0 = 0.f, m1 = -1e30f, l1 = 0.f;
        for (int pass = 0; pass < 2; ++pass) {
            float inv0 = 0.f, inv1 = 0.f;
            if (pass == 1) {
#pragma unroll
                for (int o = 1; o < 32; o <<= 1) { float mo = __shfl_xor(m0, o), lo = __shfl_xor(l0, o), mn = fmaxf(m0, mo); l0 = l0 * exp2f(m0 - mn) + lo * exp2f(mo - mn); m0 = mn;
                    mo = __shfl_xor(m1, o); lo = __shfl_xor(l1, o); mn = fmaxf(m1, mo); l1 = l1 * exp2f(m1 - mn) + lo * exp2f(mo - mn); m1 = mn; }
                inv0 = 1.f / l0; inv1 = lam / l1;
            }
            float o4[4] = {0.f, 0.f, 0.f, 0.f};
            for (int kt = 0; kt < nkeys; kt += 64) {
                __syncthreads();
                for (int e = F.tid; e < 1024; e += 512) { const int kk = e >> 4, c8 = (e & 15) * 8; const size_t src = ((size_t)b * TPB + kt + kk) * 1024 + h * 128 + c8;
                    const v4u kv = *(const v4u*)(Kb + src);
                    Ks[kk * 132 + c8 + 0] = bf2f(kv.x & 0xffffu); Ks[kk * 132 + c8 + 1] = bf2f(kv.x >> 16); Ks[kk * 132 + c8 + 2] = bf2f(kv.y & 0xffffu); Ks[kk * 132 + c8 + 3] = bf2f(kv.y >> 16);
                    Ks[kk * 132 + c8 + 4] = bf2f(kv.z & 0xffffu); Ks[kk * 132 + c8 + 5] = bf2f(kv.z >> 16); Ks[kk * 132 + c8 + 6] = bf2f(kv.w & 0xffffu); Ks[kk * 132 + c8 + 7] = bf2f(kv.w >> 16);
                    if (pass == 1) { const v4u vv = *(const v4u*)(Vb + src);
                        Vs[kk * 132 + c8 + 0] = bf2f(vv.x & 0xffffu); Vs[kk * 132 + c8 + 1] = bf2f(vv.x >> 16); Vs[kk * 132 + c8 + 2] = bf2f(vv.y & 0xffffu); Vs[kk * 132 + c8 + 3] = bf2f(vv.y >> 16);
                        Vs[kk * 132 + c8 + 4] = bf2f(vv.z & 0xffffu); Vs[kk * 132 + c8 + 5] = bf2f(vv.z >> 16); Vs[kk * 132 + c8 + 6] = bf2f(vv.w & 0xffffu); Vs[kk * 132 + c8 + 7] = bf2f(vv.w >> 16); } }
                __syncthreads();
#pragma unroll
                for (int kq = 0; kq < 2; ++kq) { const int kk = tl + 32 * kq; float s0 = 0.f, s1 = 0.f;
                    for (int d = 0; d < 64; d += 4) { const f32x4 q0 = *(const LAS f32x4*)(Qs + r * 128 + d), q1 = *(const LAS f32x4*)(Qs + r * 128 + 64 + d), k0 = *(const LAS f32x4*)(Ks + kk * 132 + d), k1 = *(const LAS f32x4*)(Ks + kk * 132 + 64 + d);
                        s0 += q0.x * k0.x + q0.y * k0.y + q0.z * k0.z + q0.w * k0.w; s1 += q1.x * k1.x + q1.y * k1.y + q1.z * k1.z + q1.w * k1.w; }
                    if (pass == 0) { float mn = fmaxf(m0, s0); l0 = l0 * exp2f(m0 - mn) + exp2f(s0 - mn); m0 = mn; mn = fmaxf(m1, s1); l1 = l1 * exp2f(m1 - mn) + exp2f(s1 - mn); m1 = mn; }
                    else Ws[r * 64 + kk] = exp2f(s0 - m0) * inv0 - exp2f(s1 - m1) * inv1; }
                if (pass == 1) { __syncthreads();
                    for (int kk = 0; kk < 64; ++kk) { const float w = Ws[r * 64 + kk];
#pragma unroll
                        for (int i = 0; i < 4; ++i) o4[i] += w * Vs[kk * 132 + tl + 32 * i]; } }
            }
            if (pass == 1) { float ss = o4[0] * o4[0] + o4[1] * o4[1] + o4[2] * o4[2] + o4[3] * o4[3];
#pragma unroll
                for (int o = 1; o < 32; o <<= 1) ss += __shfl_xor(ss, o);
                const float sc = rsqrtf(ss * (1.f / 128.f) + EPS) * (1.f - lam_init);
#pragma unroll
                for (int i = 0; i < 4; ++i) MX[(R0 + r) * 3072 + h * 128 + tl + 32 * i] = (bf16)f2bf(o4[i] * sc * A.in[11][l * 128 + tl + 32 * i]); }
        }
    }
}

#endif
namespace da {
using bf16x8 = __attribute__((ext_vector_type(8))) short;
using s16x4  = __attribute__((ext_vector_type(4))) short;
using f32x16 = __attribute__((ext_vector_type(16))) float;
using u32x4  = __attribute__((ext_vector_type(4))) unsigned;
constexpr int KVBLK = 64, LDK = 1024;
constexpr size_t SHM_V = KVBLK * 128 * 2, SHM_K = KVBLK * 128 * 2;
constexpr float THR = 8.f;
#define DA_KSWZ(row, colB) ((row) * 256 + ((colB) ^ (((row) & 7) << 4)))
#define DA_SBAR() __builtin_amdgcn_sched_barrier(0)
__device__ __forceinline__ int crow(int r, int hi) { return (r & 3) + 8 * (r >> 2) + 4 * hi; }
__device__ __forceinline__ unsigned cvtpk(float lo, float hi) { unsigned r; asm volatile("v_cvt_pk_bf16_f32 %0, %1, %2" : "=v"(r) : "v"(lo), "v"(hi)); return r; }
__device__ __forceinline__ void partialSM(f32x16& p0, f32x16& p1, float& m_reg, float& mn, float& alpha) {
  float pmax = p0[0]; for (int r = 1; r < 16; ++r) pmax = fmaxf(pmax, p0[r]); for (int r = 0; r < 16; ++r) pmax = fmaxf(pmax, p1[r]);
  { auto rr = __builtin_amdgcn_permlane32_swap(__float_as_uint(pmax), __float_as_uint(pmax), false, false);
    pmax = fmaxf(__uint_as_float(rr[0]), __uint_as_float(rr[1])); }
  if (__builtin_expect(__all(pmax - m_reg <= THR), 1)) { mn = m_reg; alpha = 1.f; }
  else { mn = fmaxf(m_reg, pmax); alpha = __builtin_amdgcn_exp2f(m_reg - mn); m_reg = mn; }
  for (int r = 0; r < 16; ++r) p0[r] = p0[r] - mn; for (int r = 0; r < 16; ++r) p1[r] = p1[r] - mn;
  for (int r = 0; r < 16; ++r) p0[r] = __builtin_amdgcn_exp2f(p0[r]);
}
__device__ __forceinline__ void finishSM(f32x16& p0, f32x16& p1, float alpha, float& l_reg, bf16x8& pa0, bf16x8& pa1, bf16x8& pa2, bf16x8& pa3) {
  for (int r = 0; r < 16; ++r) p1[r] = __builtin_amdgcn_exp2f(p1[r]);
  float ps = 0; for (int r = 0; r < 16; ++r) ps += p0[r]; for (int r = 0; r < 16; ++r) ps += p1[r];
  { auto rr = __builtin_amdgcn_permlane32_swap(__float_as_uint(ps), __float_as_uint(ps), false, false);
    ps = __uint_as_float(rr[0]) + __uint_as_float(rr[1]); }
  l_reg = l_reg * alpha + ps;
#define DA_PK4(P, BASE, OUT) do { unsigned a0 = cvtpk(P[BASE + 0], P[BASE + 1]), a1 = cvtpk(P[BASE + 2], P[BASE + 3]);   \
    unsigned b0 = cvtpk(P[BASE + 4], P[BASE + 5]), b1 = cvtpk(P[BASE + 6], P[BASE + 7]);                              \
    auto r0 = __builtin_amdgcn_permlane32_swap(a0, b0, false, false); auto r1 = __builtin_amdgcn_permlane32_swap(a1, b1, false, false); \
    u32x4 w = {r0[0], r1[0], r0[1], r1[1]}; OUT = *reinterpret_cast<bf16x8*>(&w); } while (0)
  DA_PK4(p0, 0, pa0); DA_PK4(p0, 8, pa1); DA_PK4(p1, 0, pa2); DA_PK4(p1, 8, pa3);
#undef DA_PK4
}
__device__ __forceinline__ void qkt(f32x16& p0, f32x16& p1, const char* Ks, const bf16x8* qr, int r32, int hi, int cbm) {
  p0 = f32x16{}; p1 = f32x16{};
#pragma unroll
  for (int d0 = 0; d0 < 4; ++d0) { const int cb = cbm + (d0 * 16 + hi * 8) * 2;
    bf16x8 b0 = *reinterpret_cast<const bf16x8*>(Ks + DA_KSWZ(r32, cb));
    bf16x8 b1 = *reinterpret_cast<const bf16x8*>(Ks + DA_KSWZ(32 + r32, cb));
    p0 = __builtin_amdgcn_mfma_f32_32x32x16_bf16(b0, qr[d0], p0, 0, 0, 0);
    p1 = __builtin_amdgcn_mfma_f32_32x32x16_bf16(b1, qr[d0], p1, 0, 0, 0); }
}
__device__ __forceinline__ int v_st(int k, int c) { const int kk = (k & ~0xC) | ((k & 4) << 1) | ((k & 8) >> 1); return ((kk >> 3) * 4 + (c >> 5)) * 512 + ((kk & 7) * 32 + (c & 31)) * 2; }
__device__ __forceinline__ int v_rd_base(int lane) { return ((lane & 3) << 3) | (((lane >> 2) & 3) << 6) | (((lane >> 4) & 1) << 5) | (((lane >> 5) & 1) << 8); }
constexpr int v_rd_off(int d0, int ks, int half) { return d0 * 512 + ks * 4096 + half * 2048; }
template <int OFF> __device__ __forceinline__ s16x4 tr_read(int vb) {
  s16x4 r; asm volatile("ds_read_b64_tr_b16 %0, %1 offset:%2" : "=&v"(r) : "v"(vb), "i"(OFF) : "memory"); return r;
}
template <int D0> __device__ __forceinline__ void pv_one(f32x16& od, int vb, bf16x8 pa0, bf16x8 pa1, bf16x8 pa2, bf16x8 pa3) {
  const s16x4 l0 = tr_read<v_rd_off(D0, 0, 0)>(vb), h0 = tr_read<v_rd_off(D0, 0, 1)>(vb), l1 = tr_read<v_rd_off(D0, 1, 0)>(vb), h1 = tr_read<v_rd_off(D0, 1, 1)>(vb);
  const s16x4 l2 = tr_read<v_rd_off(D0, 2, 0)>(vb), h2 = tr_read<v_rd_off(D0, 2, 1)>(vb), l3 = tr_read<v_rd_off(D0, 3, 0)>(vb), h3 = tr_read<v_rd_off(D0, 3, 1)>(vb);
  asm volatile("s_waitcnt lgkmcnt(0)" ::: "memory"); DA_SBAR();
#define DA_PK(L, H) (bf16x8){L[0], L[1], L[2], L[3], H[0], H[1], H[2], H[3]}
  od = __builtin_amdgcn_mfma_f32_32x32x16_bf16(pa0, DA_PK(l0, h0), od, 0, 0, 0);
  od = __builtin_amdgcn_mfma_f32_32x32x16_bf16(pa1, DA_PK(l1, h1), od, 0, 0, 0);
  od = __builtin_amdgcn_mfma_f32_32x32x16_bf16(pa2, DA_PK(l2, h2), od, 0, 0, 0);
  od = __builtin_amdgcn_mfma_f32_32x32x16_bf16(pa3, DA_PK(l3, h3), od, 0, 0, 0);
#undef DA_PK
}
__device__ __forceinline__ void pv_d0(f32x16* o, int vb, bf16x8 pa0, bf16x8 pa1, bf16x8 pa2, bf16x8 pa3) {
  pv_one<0>(o[0], vb, pa0, pa1, pa2, pa3); pv_one<1>(o[1], vb, pa0, pa1, pa2, pa3); pv_one<2>(o[2], vb, pa0, pa1, pa2, pa3); pv_one<3>(o[3], vb, pa0, pa1, pa2, pa3);
}
__device__ __forceinline__ void unit(const unsigned short* __restrict__ Qb, const unsigned short* __restrict__ Kh, const unsigned short* __restrict__ Vh,
                                     unsigned short* __restrict__ Ob, int ldo, int seq, float lam, float oscale, const float* __restrict__ subg, char* lds) {
  const int tid = otid(), wid = tid >> 6, lane = tid & 63, r32 = lane & 31, hi = lane >> 5, mp = wid >> 2, wq = wid & 3;
  char* V_lds = lds; char* K_lds = lds + 2 * SHM_V;
  float* ws = (float*)(lds + 2 * SHM_V + 2 * SHM_K) + wid * 64; float* li_l = ws; float* al_l = ws + 32;
  float m_reg = -1e30f, l_reg = 0; f32x16 o[4] = {}; bf16x8 qr[4];
  const unsigned short* Qw = Qb + (long)(wq * 32 + r32) * 1024 + mp * 64 + hi * 8;
#pragma unroll
  for (int d0 = 0; d0 < 4; ++d0) qr[d0] = *reinterpret_cast<const bf16x8*>(Qw + d0 * 16);
  const int cbm = mp * 128;
  const int sr = tid >> 4, sc = (tid & 15) * 8, vst0 = v_st(sr, sc), vst1 = v_st(32 + sr, sc);
  const int vb0 = (int)(uintptr_t)V_lds + v_rd_base(lane);
  struct { bf16x8 vs0, vs1, ks0, ks1; } sr_[2];
#define DA_SLOAD(i, k0) do { sr_[i].vs0 = *reinterpret_cast<const bf16x8*>(&Vh[(long)((k0) + sr) * LDK + sc]); sr_[i].vs1 = *reinterpret_cast<const bf16x8*>(&Vh[(long)((k0) + 32 + sr) * LDK + sc]); \
    sr_[i].ks0 = *reinterpret_cast<const bf16x8*>(&Kh[(long)((k0) + sr) * LDK + sc]); sr_[i].ks1 = *reinterpret_cast<const bf16x8*>(&Kh[(long)((k0) + 32 + sr) * LDK + sc]); } while (0)
#define DA_SWRITE(b, i) do { *(bf16x8*)(V_lds + (b) * SHM_V + vst0) = sr_[i].vs0;          \
    *(bf16x8*)(V_lds + (b) * SHM_V + vst1) = sr_[i].vs1; int kc = sc * 2;               \
    *(bf16x8*)(K_lds + (b) * SHM_K + DA_KSWZ(sr, kc)) = sr_[i].ks0;                       \
    *(bf16x8*)(K_lds + (b) * SHM_K + DA_KSWZ(32 + sr, kc)) = sr_[i].ks1; } while (0)
#define DA_SWAIT() asm volatile("s_waitcnt vmcnt(4)" ::: "memory")
#define DA_RESC(a) do { if (__any((a) < 1.f)) { if (hi == 0) al_l[r32] = (a); asm volatile("s_waitcnt lgkmcnt(0)" ::: "memory"); \
    for (int d = 0; d < 4; ++d) for (int r = 0; r < 16; ++r) o[d][r] *= al_l[crow(r, hi)]; } } while (0)
  f32x16 pA0, pA1, pB0, pB1; float mnA, mnB, alA, alB; bf16x8 pa0, pa1, pa2, pa3; const int NT = seq / KVBLK;
  constexpr int SE = 0, SO = 1;
  DA_SLOAD(SE, 0); asm volatile("s_waitcnt vmcnt(0)" ::: "memory"); DA_SWRITE(0, SE); __syncthreads();
  qkt(pA0, pA1, K_lds, qr, r32, hi, cbm); partialSM(pA0, pA1, m_reg, mnA, alA);
  DA_SLOAD(SO, KVBLK); if (2 < NT) DA_SLOAD(SE, 2 * KVBLK);
  DA_SWAIT(); DA_SWRITE(1, SO); __syncthreads();
  for (int j = 1; j + 1 < NT; j += 2) {
    DA_SBAR(); qkt(pB0, pB1, K_lds + SHM_K, qr, r32, hi, cbm);
    finishSM(pA0, pA1, alA, l_reg, pa0, pa1, pa2, pa3); DA_SBAR();
    DA_SLOAD(SO, (j + 2) * KVBLK); DA_SBAR();
    pv_d0(o, vb0, pa0, pa1, pa2, pa3); partialSM(pB0, pB1, m_reg, mnB, alB);
    __syncthreads(); DA_SWAIT(); DA_SWRITE(0, SE);
    DA_RESC(alB); __syncthreads();
    DA_SBAR(); qkt(pA0, pA1, K_lds, qr, r32, hi, cbm);
    finishSM(pB0, pB1, alB, l_reg, pa0, pa1, pa2, pa3); DA_SBAR();
    if (j + 3 < NT) DA_SLOAD(SE, (j + 3) * KVBLK); DA_SBAR();
    pv_d0(o, vb0 + (int)SHM_V, pa0, pa1, pa2, pa3); partialSM(pA0, pA1, m_reg, mnA, alA);
    __syncthreads(); DA_SWAIT(); DA_SWRITE(1, SO);
    DA_RESC(alA); __syncthreads();
  }
  DA_SBAR(); qkt(pB0, pB1, K_lds + SHM_K, qr, r32, hi, cbm);
  finishSM(pA0, pA1, alA, l_reg, pa0, pa1, pa2, pa3); DA_SBAR();
  pv_d0(o, vb0, pa0, pa1, pa2, pa3); partialSM(pB0, pB1, m_reg, mnB, alB);
  __syncthreads(); DA_RESC(alB);
  finishSM(pB0, pB1, alB, l_reg, pa0, pa1, pa2, pa3); DA_SBAR();
  pv_d0(o, vb0 + (int)SHM_V, pa0, pa1, pa2, pa3);
  if (hi == 0) li_l[r32] = l_reg; asm volatile("s_waitcnt lgkmcnt(0)" ::: "memory");
  const float sgn = mp ? lam : 1.f;
#pragma unroll
  for (int r = 0; r < 16; ++r) { const float rl = sgn * __builtin_amdgcn_rcpf(li_l[crow(r, hi)]);
#pragma unroll
    for (int d0 = 0; d0 < 4; ++d0) o[d0][r] *= rl; }
  __syncthreads();
  int xb = wq * 4096 + lane; asm volatile("" : "+v"(xb));
  float* X = (float*)lds + xb;
  if (mp == 1) {
#pragma unroll
    for (int d0 = 0; d0 < 4; ++d0)
#pragma unroll
      for (int r = 0; r < 16; ++r) X[(d0 * 16 + r) * 64] = o[d0][r];
  }
  __syncthreads();
  if (mp == 0) {
    float gg[4];
#pragma unroll
    for (int d0 = 0; d0 < 4; ++d0) gg[d0] = subg[d0 * 32 + r32] * oscale;
    int ob = (wq * 32 + 4 * hi) * ldo + r32; asm volatile("" : "+v"(ob));
    unsigned short* Ow = Ob + ob;
#pragma unroll
    for (int r = 0; r < 16; ++r) { float a = 0.f; float v[4];
#pragma unroll
      for (int d0 = 0; d0 < 4; ++d0) { v[d0] = o[d0][r] - X[(d0 * 16 + r) * 64]; a += v[d0] * v[d0]; }
      a += sx<1>(a); a += sx<2>(a); a += sx<4>(a); a += sx<8>(a); a += sx<16>(a);
      a = rsqrtf(a * (1.f / 128.f) + EPS);
      const int orow = (r & 3) + 8 * (r >> 2);
#pragma unroll
      for (int d0 = 0; d0 < 4; ++d0) Ow[orow * ldo + d0 * 32] = (unsigned short)f2bf(v[d0] * a * gg[d0]); }
  }
  __syncthreads();
#undef DA_SLOAD
#undef DA_SWRITE
#undef DA_SWAIT
#undef DA_RESC
}
}
__device__ __forceinline__ void ph_attn(const Frame& F, const Args& A, int l) {
    const bf16 *Kb = WSP(bf16, WS_KB), *Vb = WSP(bf16, WS_VB), *Qb = WSP(bf16, WS_QB); bf16* MX = WSP(bf16, WS_MIXIN);
    const float* lq = A.in[10] + l * 256; float d01 = 0.f, d23 = 0.f;
    for (int i = 0; i < 64; ++i) { d01 += lq[i] * lq[64 + i]; d23 += lq[128 + i] * lq[192 + i]; }
    const float lam_init = 0.8f - 0.6f * expf(-0.3f * (float)l); float lam = expf(d01) - expf(d23) + lam_init;
    lam = __uint_as_float(__builtin_amdgcn_readfirstlane(__float_as_uint(lam))); const float osc = __uint_as_float(__builtin_amdgcn_readfirstlane(__float_as_uint(1.f - lam_init)));
    const int vcu = (F.G % 8 == 0) ? (F.bid % 8) * (F.G / 8) + F.bid / 8 : F.bid;
    for (int u = vcu; u < 16 * 66; u += F.G) {
        const int bh = (u % 1024) / 64 , b = bh >> 3, h = bh & 7;
        int qb; int bb = b, hh = h;
        if (u < 1024) qb = 2 + (u & 63); else { const int v = u - 1024; bb = v >> 4; hh = (v >> 1) & 7; qb = v & 1; }
        const size_t R0 = (size_t)bb * TPB + qb * 128; const int seq = qb < 2 ? CTX : TPB;
        da::unit(Qb + R0 * 1024 + hh * 128, Kb + (size_t)bb * TPB * 1024 + hh * 128, Vb + (size_t)bb * TPB * 1024 + hh * 128,
                 MX + R0 * 3072 + hh * 128, 3072, seq, lam, osc, A.in[11] + l * 128, (char*)F.lds);
    }
}

__device__ __forceinline__ void ph_mix(const Frame& F, const Args& A) {
    const float *PA = WSP(float, WS_PA), *PR = WSP(float, WS_PR), *PF = WSP(float, WS_PF); const bf16* GT = WSP(bf16, WS_GATES); bf16* MD = WSP(bf16, WS_MIXED);
    for (long i = F.gtid; i < (long)MROWS * 1024; i += F.NT) { const size_t R = (size_t)(i >> 10); const int c = (int)(i & 1023);
        MD[i] = (bf16)f2bf(bf2f(GT[R * 3072 + c]) * PA[i] + bf2f(GT[R * 3072 + 1024 + c]) * PR[i] + bf2f(GT[R * 3072 + 2048 + c]) * PF[i]); }
}
__device__ __forceinline__ void ph_resid_norm2(const Frame& F, const Args& A, int l) {
    float* X = WSP(float, WS_XALL); const float* Y1 = WSP(float, WS_Y1); bf16* TOK = WSP(bf16, WS_TOK);
    for (int R = F.gw; R < MROWS; R += F.NGW) {
        const int b = R / TPB, p = R % TPB, s = (p < CTX) ? 2 : b; const float* g1 = MODP(l, s, 2);
        f32x4 v[4];
#pragma unroll
        for (int j = 0; j < 4; ++j) { const int c = 4 * F.lane + 256 * j; const f32x4 x = *(const f32x4*)(X + (size_t)R * 1024 + c), y = *(const f32x4*)(Y1 + (size_t)R * 1024 + c), gg = *(const f32x4*)(g1 + c);
            v[j] = x + gg * y; *(f32x4*)(X + (size_t)R * 1024 + c) = v[j]; }
        norm_mod_row(v, A.in[23] + l * 1024, MODP(l, s, 4), MODP(l, s, 3), TOK + (size_t)R * 1024, F.lane);
    }
}
__device__ __forceinline__ void ph_topk(const Frame& F, const Args& A, int l) {
    const float* LG = WSP(float, WS_LOG); const float* SGU = WSP(float, WS_SGU); bf16* SH = WSP(bf16, WS_SH);
    int* LIST = WSP(int, WS_LIST); float* TOPW = WSP(float, WS_TOPW); int* CNT = (int*)(A.ws + WS_CTL) + CW_CNT + l * 256;
    const float NEG = -__builtin_inff();
    for (int R = F.gw; R < MROWS; R += F.NGW) {
        const f32x4 lg4 = *(const f32x4*)(LG + (size_t)R * 256 + 4 * F.lane); const f32x4 rb4 = *(const f32x4*)(A.in[25] + l * 256 + 4 * F.lane);
        float sc[4] = {sigmoidf_(lg4.x), sigmoidf_(lg4.y), sigmoidf_(lg4.z), sigmoidf_(lg4.w)};
        float bi[4] = {sc[0] + rb4.x, sc[1] + rb4.y, sc[2] + rb4.z, sc[3] + rb4.w};
        float t1 = NEG, t2 = NEG;
#pragma unroll
        for (int q = 0; q < 4; ++q) { const float v = bi[q]; if (v > t1) { t2 = t1; t1 = v; } else if (v > t2) t2 = v; }
#define TK_M2(M) { const float o1 = sx<M>(t1), o2 = sx<M>(t2); const float n1 = fmaxf(t1, o1), n2 = fmaxf(fminf(t1, o1), fmaxf(t2, o2)); t1 = n1; t2 = n2; }
        TK_M2(1) TK_M2(2) TK_M2(4)
#undef TK_M2
        const float gs = t1 + t2; const int mygrp = F.lane >> 3; int rank = 0;
#pragma unroll
        for (int j = 0; j < 8; ++j) { const float sj = __uint_as_float(__builtin_amdgcn_readlane(__float_as_uint(gs), j * 8)); rank += (sj > gs || (sj == gs && j < mygrp)) ? 1 : 0; }
        const bool sel = rank < 4;
        float cand[4];
#pragma unroll
        for (int q = 0; q < 4; ++q) cand[q] = sel ? bi[q] : NEG;
        int my_e = 0; float my_s = 0.f, ssum = 0.f;
#pragma unroll
        for (int k = 0; k < 8; ++k) {
            float bv = cand[0]; int bq = 0;
#pragma unroll
            for (int q = 1; q < 4; ++q) if (cand[q] > bv) { bv = cand[q]; bq = q; }
            float v = bv; int e = 4 * F.lane + bq;
#define TK_AM(M) { const float ov = sx<M>(v); const int oe = sxi<M>(e); if (ov > v || (ov == v && oe < e)) { v = ov; e = oe; } }
            TK_AM(1) TK_AM(2) TK_AM(4) TK_AM(8) TK_AM(16) TK_AM(32)
#undef TK_AM
            e = __builtin_amdgcn_readfirstlane(e);
            const int ol = e >> 2, oq = e & 3; float sv = 0.f;
#pragma unroll
            for (int q = 0; q < 4; ++q) if (oq == q) { sv = sc[q]; if (F.lane == ol) cand[q] = NEG; }
            sv = __uint_as_float(__builtin_amdgcn_readlane(__float_as_uint(sv), ol)); ssum += sv;
            if (F.lane == k) { my_e = e; my_s = sv; }
        }
        if (F.lane < 8) { const int pos = atomicAdd(CNT + my_e, 1); LIST[(size_t)my_e * LCAP + pos] = R * 8 + F.lane; TOPW[(size_t)R * 8 + F.lane] = my_s / ssum * 2.5f; }
#pragma unroll
        for (int j = 0; j < 4; ++j) { const int f = F.lane + 64 * j; SH[(size_t)R * 256 + f] = (bf16)f2bf(siluf_(SGU[(size_t)R * 512 + f]) * SGU[(size_t)R * 512 + 256 + f]); }
    }
}
__device__ __forceinline__ void ph_experts_naive(const Frame& F, const Args& A, int l) {
    const bf16* TOK = WSP(bf16, WS_TOK); const int* LIST = WSP(int, WS_LIST); const float* TOPW = WSP(float, WS_TOPW); float* YB = WSP(float, WS_YB);
    const int* CNT = (const int*)(A.ws + WS_CTL) + CW_CNT + l * 256;
    LAS bf16* Xs = (LAS bf16*)F.lds;
    LAS float* Hs = (LAS float*)(F.lds + 65536);
    LAS int* pref = (LAS int*)(F.lds + 98304);
    LAS int* sPair = pref + 320; LAS float* sW = (LAS float*)(sPair + 32);
    __syncthreads();
    if (F.tid == 0) { int s = 0; for (int e = 0; e < 256; ++e) { pref[e] = s; s += (CNT[e] + 31) >> 5; } pref[256] = s; }
    __syncthreads();
    const int total = pref[256];
    for (int id = F.bid; id < total; id += F.G) {
        int lo = 0, hi = 255; while (lo < hi) { const int mid = (lo + hi + 1) >> 1; if (pref[mid] <= id) lo = mid; else hi = mid - 1; }
        const int e = lo, c = id - pref[e], n = min(32, CNT[e] - c * 32);
        __syncthreads();
        if (F.tid < 32) { const int pr = F.tid < n ? LIST[(size_t)e * LCAP + c * 32 + F.tid] : -1; sPair[F.tid] = pr; sW[F.tid] = pr >= 0 ? TOPW[pr] : 0.f; }
        __syncthreads();
        for (int pc = F.tid; pc < 4096; pc += 512) { const int row = pc >> 7, c8 = (pc & 127) * 8, pr = sPair[row];
            v4u v = {0u, 0u, 0u, 0u}; if (pr >= 0) v = *(const v4u*)(TOK + (size_t)(pr >> 3) * 1024 + c8);
            *(LAS v4u*)(Xs + row * 1024 + c8) = v; }
        __syncthreads();
        { const int f = F.tid & 255, gu = F.tid >> 8; const float* W = (gu ? A.in[27] : A.in[26]) + ((size_t)(l * 256 + e) * 1024) * 256 + f;
          float acc[32];
#pragma unroll
          for (int r = 0; r < 32; ++r) acc[r] = 0.f;
          for (int k = 0; k < 1024; ++k) { const float w = W[(size_t)k * 256];
#pragma unroll
              for (int r = 0; r < 32; ++r) acc[r] += bf2f(Xs[r * 1024 + k]) * w; }
          if (gu == 0) {
#pragma unroll
              for (int r = 0; r < 32; ++r) Hs[r * 256 + f] = siluf_(acc[r]); }
          __syncthreads();
          if (gu == 1) {
#pragma unroll
              for (int r = 0; r < 32; ++r) Hs[r * 256 + f] *= acc[r]; }
          __syncthreads(); }
        { const float* Wd = A.in[28] + ((size_t)(l * 256 + e) * 256) * 1024 + F.tid;
          float a0[32], a1[32];
#pragma unroll
          for (int r = 0; r < 32; ++r) { a0[r] = 0.f; a1[r] = 0.f; }
          for (int k = 0; k < 256; ++k) { const float w0 = Wd[(size_t)k * 1024], w1 = Wd[(size_t)k * 1024 + 512];
#pragma unroll
              for (int r = 0; r < 32; ++r) { const float hv = Hs[r * 256 + k]; a0[r] += hv * w0; a1[r] += hv * w1; } }
#pragma unroll
          for (int r = 0; r < 32; ++r) { const int pr = sPair[r]; if (pr >= 0) { const float w = sW[r]; YB[(size_t)pr * 1024 + F.tid] = a0[r] * w; YB[(size_t)pr * 1024 + 512 + F.tid] = a1[r] * w; } } }
    }
}
__device__ __forceinline__ void tr_tile(const float* W, int ldw, int k0, int n0, bf16* WT, int ldwt, int rowbase, LAS float* scr, int lane) {
#pragma unroll 8
    for (int i = 0; i < 32; ++i) { const int kk = 2 * i + (lane >> 5); scr[kk * 33 + (lane & 31)] = W[(size_t)(k0 + kk) * ldw + n0 + (lane & 31)]; }
    LDS_WAIT(); asm volatile("" ::: "memory");
    const int c = lane & 7;
#pragma unroll
    for (int j = 0; j < 4; ++j) { const int n = (lane >> 3) + 8 * j; const LAS float* sp = scr + (8 * c) * 33 + n;
        v4u o; o.x = pk2(sp[0 * 33], sp[1 * 33]); o.y = pk2(sp[2 * 33], sp[3 * 33]); o.z = pk2(sp[4 * 33], sp[5 * 33]); o.w = pk2(sp[6 * 33], sp[7 * 33]);
        *(v4u*)(WT + (size_t)(rowbase + n) * ldwt + k0 + 8 * c) = o; }
    LDS_WAIT(); asm volatile("" ::: "memory");
}
__device__ __forceinline__ void ph_expert_w(const Frame& F, const Args& A, int l) {
    LAS float* scr = (LAS float*)(F.lds + F.wave * 16384);
    for (int it = F.gw; it < 256 * 384; it += F.NGW) {
        const int e = it / 384, r = it % 384; bf16* E1 = (bf16*)(A.ws + WS_EW + (size_t)e * EW_STRIDE); bf16* E2 = E1 + 512 * 1024;
        if (r < 256) { const int up = r >> 7, q = r & 127, kb = q >> 3, nb = q & 7, n0 = 32 * nb;
            tr_tile((up ? A.in[27] : A.in[26]) + ((size_t)(l * 256 + e) * 1024) * 256, 256, 64 * kb, n0, E1, 1024, (n0 >> 7) * 256 + up * 128 + (n0 & 127), scr, F.lane); }
        else { const int q = r - 256, kb = q >> 5, nb = q & 31;
            tr_tile(A.in[28] + ((size_t)(l * 256 + e) * 256) * 1024, 1024, 64 * kb, 32 * nb, E2, 256, 32 * nb, scr, F.lane); }
    }
}
struct MoeSched {
    const LAS int* pref; const int* cnt; const int* list; const char* abase; const char* bbase; int npn, G, c, lda2; size_t b_pn_stride; bool gather;
    __device__ __forceinline__ bool next(int i, pg8::UnitG& U) const {
        const long id = (long)i * G + c; const int total = pref[256]; if (id >= (long)total * npn) return false;
        const int tau = (int)(id / npn), pn = (int)(id % npn);
        int lo = 0, hi = 255; while (lo < hi) { const int mid = (lo + hi + 1) >> 1; if (pref[mid] <= tau) lo = mid; else hi = mid - 1; }
        const int e = lo, t = tau - pref[e];
        U.e = e; U.pn = pn; U.valid = min(256, cnt[e] - t * 256); U.rows = list + (size_t)e * LCAP + t * 256; U.row0 = tau * 256;
        U.a = gather ? abase : abase + (size_t)tau * 256 * lda2; U.b = bbase + (size_t)e * EW_STRIDE + (size_t)pn * b_pn_stride; return true;
    }
};
__device__ __forceinline__ void moe_prefix(const Frame& F, const int* CNT, LAS int* pref) {
    __syncthreads();
    if (F.tid == 0) { int sum = 0; for (int e = 0; e < 256; ++e) { pref[e] = sum; sum += (CNT[e] + 255) >> 8; } pref[256] = sum; }
    __syncthreads();
}
struct EpiSwiGLU {
    static constexpr bool PERM = true;
    bf16* HB;
    __device__ __forceinline__ void operator()(const f32x4 (&acc)[2][2][4][2], const pg8::UnitG& u, int wr, int wc, int fr, int fq) const {
#pragma unroll
        for (int ai = 0; ai < 2; ++ai)
#pragma unroll
            for (int m = 0; m < 4; ++m) { const int r = ai * 128 + wr * 64 + m * 16 + fr;
                const f32x4 g0 = acc[ai][0][m][0], g1 = acc[ai][0][m][1], u0 = acc[ai][1][m][0], u1 = acc[ai][1][m][1];
                v4u w; w.x = pk2(siluf_(g0[0]) * u0[0], siluf_(g0[1]) * u0[1]); w.y = pk2(siluf_(g0[2]) * u0[2], siluf_(g0[3]) * u0[3]);
                w.z = pk2(siluf_(g1[0]) * u1[0], siluf_(g1[1]) * u1[1]); w.w = pk2(siluf_(g1[2]) * u1[2], siluf_(g1[3]) * u1[3]);
                *(v4u*)(HB + (size_t)(u.row0 + r) * 256 + u.pn * 128 + wc * 32 + 8 * fq) = w; }
    }
};
struct EpiScatter {
    static constexpr bool PERM = true;
    bf16* Y; const float* topw;
    __device__ __forceinline__ void operator()(const f32x4 (&acc)[2][2][4][2], const pg8::UnitG& u, int wr, int wc, int fr, int fq) const {
#pragma unroll
        for (int ai = 0; ai < 2; ++ai)
#pragma unroll
            for (int m = 0; m < 4; ++m) { const int r = ai * 128 + wr * 64 + m * 16 + fr;
                if (r < u.valid) { const int pr = u.rows[r]; const float w = topw[pr]; bf16* dst = Y + (size_t)pr * 1024 + u.pn * 256 + wc * 32 + 8 * fq;
#pragma unroll
                    for (int bj = 0; bj < 2; ++bj) { const f32x4 v0 = acc[ai][bj][m][0] * w, v1 = acc[ai][bj][m][1] * w;
                        v4u o; o.x = pk2(v0[0], v0[1]); o.y = pk2(v0[2], v0[3]); o.z = pk2(v1[0], v1[1]); o.w = pk2(v1[2], v1[3]);
                        *(v4u*)(dst + bj * 128) = o; } } }
    }
};
__device__ __forceinline__ void ph_experts_up(const Frame& F, const Args& A, int l) {
    const int* CNT = (const int*)(A.ws + WS_CTL) + CW_CNT + l * 256; LAS int* pref = (LAS int*)(F.lds + RING_BYTES + 1024);
    moe_prefix(F, CNT, pref);
    const int vcu = (F.G % 8 == 0) ? (F.bid % 8) * (F.G / 8) + F.bid / 8 : F.bid;
    MoeSched S{pref, CNT, WSP(int, WS_LIST), (const char*)WSP(bf16, WS_TOK), (const char*)(A.ws + WS_EW), 2, F.G, vcu, 2048, (size_t)256 * 1024 * 2, true};
    EpiSwiGLU E{WSP(bf16, WS_HB)};
    pg8::gemm_phase_g<EpiSwiGLU, MoeSched, true>(F.lds, 1024, 1024, 1024, S, E);
}
__device__ __forceinline__ void ph_experts_down(const Frame& F, const Args& A, int l) {
    const int* CNT = (const int*)(A.ws + WS_CTL) + CW_CNT + l * 256; LAS int* pref = (LAS int*)(F.lds + RING_BYTES + 1024);
    moe_prefix(F, CNT, pref);
    const int vcu = (F.G % 8 == 0) ? (F.bid % 8) * (F.G / 8) + F.bid / 8 : F.bid;
    MoeSched S{pref, CNT, WSP(int, WS_LIST), (const char*)WSP(bf16, WS_HB), (const char*)(A.ws + WS_EW + 512 * 1024 * 2), 4, F.G, vcu, 512, (size_t)256 * 256 * 2, false};
    EpiScatter E{WSP(bf16, WS_Y16), WSP(float, WS_TOPW)};
    pg8::gemm_phase_g<EpiScatter, MoeSched, false>(F.lds, 256, 256, 256, S, E);
}
__device__ __forceinline__ void ph_combine(const Frame& F, const Args& A, int l) {
    float* X = WSP(float, WS_XALL); const float* YB = WSP(float, WS_YB); const float* SD = WSP(float, WS_SD);
    for (int R = F.gw; R < MROWS; R += F.NGW) {
        const int b = R / TPB, p = R % TPB, s = (p < CTX) ? 2 : b; const float* g2 = MODP(l, s, 5);
#pragma unroll
        for (int j = 0; j < 4; ++j) { const int c = 4 * F.lane + 256 * j; f32x4 f = *(const f32x4*)(SD + (size_t)R * 1024 + c);
#pragma unroll
#if FAST_MOE
            for (int k = 0; k < 8; ++k) { const unsigned long long y = *(const unsigned long long*)(WSP(bf16, WS_Y16) + ((size_t)R * 8 + k) * 1024 + c);
                f += (f32x4){bf2f((unsigned)y & 0xffffu), bf2f(((unsigned)y) >> 16), bf2f((unsigned)(y >> 32) & 0xffffu), bf2f((unsigned)(y >> 48))}; }
#else
            for (int k = 0; k < 8; ++k) f += *(const f32x4*)(YB + ((size_t)R * 8 + k) * 1024 + c);
#endif
            const f32x4 x = *(const f32x4*)(X + (size_t)R * 1024 + c) + *(const f32x4*)(g2 + c) * f;
            *(f32x4*)(X + (size_t)R * 1024 + c) = x;
            if (l == DEPTH - 1 && p >= CTX) *(f32x4*)(A.out + ((size_t)b * SEQ + (p - CTX)) * 1024 + c) = x; }
    }
}

constexpr int PH_PER_L = 18, N_PHASES = 1 + DEPTH * PH_PER_L;
template <int P> __device__ __forceinline__ void run_phase(const Frame& F, const Args& A, int l) {
    if constexpr (P == -1) ph_prologue(F, A);
    if constexpr (P == 0) ph_norm1(F, A, l);
    if constexpr (P == 1) { pg8::Gemm g{WSP(bf16, WS_H), WLP(l, WO_WIN), MROWS, INW, 1024, 1024, 1024}; pg8::StaticOrder S; S.init(MROWS, INW, F.G, F.bid);
        pg8::EpiF32 E{WSP(float, WS_U), INW}; pg8::gemm_phase(F.lds, g, S, E); }
    if constexpr (P == 2) ph_uelem(F, A, l);
    if constexpr (P == 3) { ph_conv(F, A, l); ph_fft_t1(F, A); }
    if constexpr (P == 4) {
#if FAST_LRU
        ph_lru_gemm(F, A, l);
#else
        ph_lrucoef(F, A, l);
#endif
#if FAST_FFT_A
        ph_fft_a_gemm(F, A);
#else
        ph_fft_a(F, A);
#endif
        ph_fft_c(F, A);
    }
    if constexpr (P == 5) {
        ph_scan1(F, A);
#if FAST_FFT_B
        ph_fft_b_gemm(F, A);
#else
        ph_fft_b(F, A);
#endif
    }
    if constexpr (P == 6) { ph_scan2(F, A); ph_fft_t2(F, A); }
    if constexpr (P == 7) ph_scan3(F, A);
    if constexpr (P == 8) {
#if FAST_ATTN
        ph_attn(F, A, l);
#else
        ph_attn_naive(F, A, l);
#endif
        __syncthreads(); }
    if constexpr (P == 9) {
        { pg8::Gemm g{WSP(bf16, WS_MIXIN), WLP(l, WO_D1), MROWS, 1024, 1024, 3072, 3072}; pg8::StaticOrder S; S.init(MROWS, 1024, F.G, F.bid); pg8::EpiF32 E{WSP(float, WS_PA), 1024}; pg8::gemm_phase(F.lds, g, S, E); }
        { pg8::Gemm g{WSP(bf16, WS_MIXIN) + 1024, WLP(l, WO_D1) + 1024, MROWS, 1024, 1024, 3072, 3072}; pg8::StaticOrder S; S.init(MROWS, 1024, F.G, F.bid); pg8::EpiF32 E{WSP(float, WS_PR), 1024}; pg8::gemm_phase(F.lds, g, S, E); }
        { pg8::Gemm g{WSP(bf16, WS_MIXIN) + 2048, WLP(l, WO_D1) + 2048, MROWS, 1024, 1024, 3072, 3072}; pg8::StaticOrder S; S.init(MROWS, 1024, F.G, F.bid); pg8::EpiF32 E{WSP(float, WS_PF), 1024}; pg8::gemm_phase(F.lds, g, S, E); } }
    if constexpr (P == 10) ph_mix(F, A);
    if constexpr (P == 11) { pg8::Gemm g{WSP(bf16, WS_MIXED), WLP(l, WO_OUT), MROWS, 1024, 1024, 1024, 1024}; pg8::StaticOrder S; S.init(MROWS, 1024, F.G, F.bid);
        pg8::EpiF32 E{WSP(float, WS_Y1), 1024}; pg8::gemm_phase(F.lds, g, S, E); }
    if constexpr (P == 12) ph_resid_norm2(F, A, l);
    if constexpr (P == 13) {
        { pg8::Gemm g{WSP(bf16, WS_TOK), WLP(l, WO_R), MROWS, 256, 1024, 1024, 1024}; pg8::StaticOrder S; S.init(MROWS, 256, F.G, F.bid); pg8::EpiF32 E{WSP(float, WS_LOG), 256}; pg8::gemm_phase(F.lds, g, S, E); }
        { pg8::Gemm g{WSP(bf16, WS_TOK), WLP(l, WO_SGU), MROWS, 512, 1024, 1024, 1024}; pg8::StaticOrder S; S.init(MROWS, 512, F.G, F.bid); pg8::EpiF32 E{WSP(float, WS_SGU), 512}; pg8::gemm_phase(F.lds, g, S, E); } }
    if constexpr (P == 14) {
#if FAST_MOE
        ph_expert_w(F, A, l);
#endif
        ph_topk(F, A, l); }
    if constexpr (P == 15) {
#if FAST_MOE
        ph_experts_up(F, A, l);
#else
        ph_experts_naive(F, A, l); __syncthreads();
#endif

        { pg8::Gemm g{WSP(bf16, WS_SH), WLP(l, WO_SD), MROWS, 1024, 256, 256, 256}; pg8::StaticOrder S; S.init(MROWS, 1024, F.G, F.bid); pg8::EpiF32 E{WSP(float, WS_SD), 1024}; pg8::gemm_phase(F.lds, g, S, E); } }
    if constexpr (P == 16) {
#if FAST_MOE
        ph_experts_down(F, A, l);
#endif
    }
    if constexpr (P == 17) ph_combine(F, A, l);
}
__device__ __forceinline__ Frame make_frame(unsigned char* lds) {
    Frame F; F.lds = (LAS unsigned char*)lds; F.tid = otid(); F.lane = F.tid & 63; F.wave = __builtin_amdgcn_readfirstlane(F.tid >> 6);
    F.bid = obid(); F.G = ogrid(); F.gw = F.bid * NWAVES + F.wave; F.NGW = F.G * NWAVES; F.gtid = (long)F.bid * 512 + F.tid; F.NT = (long)F.G * 512;
    return F;
}
template <int P> __global__ void __launch_bounds__(NWAVES * 64, 2) mk_phase(Args A) {
    extern __shared__ __attribute__((aligned(16))) unsigned char lds[];
    const Frame F = make_frame(lds);
    run_phase<P>(F, A, A.ph_lo);
}
#if N_LAUNCH_MODE == 1
__device__ __forceinline__ const float* lds_ptr(const LAS unsigned long long* tab, int i) {
    const unsigned long long v = tab[i];
    const unsigned lo = __builtin_amdgcn_readfirstlane((unsigned)v), hi = __builtin_amdgcn_readfirstlane((unsigned)(v >> 32));
    return (const float*)(((unsigned long long)hi << 32) | lo);
}
__device__ __forceinline__ void load_args(Args& L, const LAS unsigned long long* tab) {
#pragma unroll
    for (int i = 0; i < 32; ++i) L.in[i] = lds_ptr(tab, i);
    L.out = (float*)lds_ptr(tab, 32); L.ws = (unsigned char*)lds_ptr(tab, 33); L.ph_lo = 0; L.ph_hi = 0;
}
__global__ void __launch_bounds__(NWAVES * 64, 2) mk_fwd(Args A) {
    extern __shared__ __attribute__((aligned(16))) unsigned char lds[];
    LAS unsigned char* L3 = (LAS unsigned char*)lds;
    volatile LAS unsigned* MISC = (volatile LAS unsigned*)(L3 + MISC_OFF);
    for (int u = threadIdx.x; u < (LDS_BYTES - RING_BYTES) / 4; u += NWAVES * 64) ((LAS unsigned*)(L3 + RING_BYTES))[u] = 0u;
    __syncthreads();
    LAS unsigned long long* tab = (LAS unsigned long long*)(L3 + RING_BYTES + 4096);
    if (threadIdx.x == 0) {
#define ST(i) tab[i] = (unsigned long long)A.in[i];
        ST(0) ST(1) ST(2) ST(3) ST(4) ST(5) ST(6) ST(7) ST(8) ST(9) ST(10) ST(11) ST(12) ST(13) ST(14) ST(15) ST(16) ST(17) ST(18) ST(19) ST(20) ST(21) ST(22) ST(23) ST(24) ST(25) ST(26) ST(27) ST(28) ST(29) ST(30) ST(31)
#undef ST
        tab[32] = (unsigned long long)A.out; tab[33] = (unsigned long long)A.ws;
    }
    __syncthreads();
    (void)xcd_barrier_post((unsigned*)(A.ws + WS_CTL) + CW_BAR, MISC + 8);
#define RUN(P) do { asm volatile("; PHASE_MARK " #P); { unsigned tb_ = RING_BYTES + 4096; asm volatile("" : "+v"(tb_)); Args L; load_args(L, (const LAS unsigned long long*)(L3 + tb_)); \
        const Frame F = make_frame(lds); run_phase<P>(F, L, l); \
        XcdBarrier bar; bar.bar = (unsigned*)(L.ws + WS_CTL) + CW_BAR; bar.x = xb_xcc_id(); { unsigned mo_ = MISC_OFF + 32; asm volatile("" : "+v"(mo_)); bar.st = (volatile LAS unsigned*)(L3 + mo_); } \
        xcd_barrier(bar); } } while (0)
    { const int l = 0; RUN(-1); }
    for (int l = 0; l < DEPTH; ++l) {
        RUN(0); RUN(1); RUN(2); RUN(3); RUN(4); RUN(5); RUN(6); RUN(7); RUN(8); RUN(9); RUN(10); RUN(11); RUN(12); RUN(13); RUN(14); RUN(15); RUN(16); RUN(17);
    }
#undef RUN
}
#endif

extern "C" void kernel_launch(void* const* d_in, const int* in_sizes, int n_in, void* d_out, int out_size, void* d_ws, size_t ws_size, hipStream_t stream) {
    static int grid = 0;
    if (grid == 0) {
        if (n_in != 32 || out_size != NB * SEQ * DM || ws_size < WS_END) { fprintf(stderr, "kernel_launch: unexpected shapes (n_in %d, out %d, ws %zu < %zu)\n", n_in, out_size, ws_size, (size_t)WS_END); grid = -1; return; }
        int dev = 0, cus = 0;
        if (hipGetDevice(&dev) != hipSuccess || hipDeviceGetAttribute(&cus, hipDeviceAttributeMultiprocessorCount, dev) != hipSuccess) { grid = -1; return; }
#define SETA(K) if (hipFuncSetAttribute((const void*)K, hipFuncAttributeMaxDynamicSharedMemorySize, LDS_BYTES) != hipSuccess) { fprintf(stderr, "kernel_launch: hipFuncSetAttribute failed\n"); grid = -1; return; }
#if N_LAUNCH_MODE == 1
        SETA(mk_fwd)
#else
        SETA(mk_phase<-1>) SETA(mk_phase<0>) SETA(mk_phase<1>) SETA(mk_phase<2>) SETA(mk_phase<3>) SETA(mk_phase<4>) SETA(mk_phase<5>) SETA(mk_phase<6>) SETA(mk_phase<7>) SETA(mk_phase<8>)
        SETA(mk_phase<9>) SETA(mk_phase<10>) SETA(mk_phase<11>) SETA(mk_phase<12>) SETA(mk_phase<13>) SETA(mk_phase<14>) SETA(mk_phase<15>) SETA(mk_phase<16>) SETA(mk_phase<17>)
#endif
#undef SETA
        int per_cu = 0;
        (void)per_cu;
        grid = cus;
    }
    if (grid < 0) return;
    (void)hipMemsetAsync((char*)d_ws + WS_CTL, 0, CTL_ZERO_BYTES, stream);
    Args a{};
    for (int i = 0; i < 32; ++i) a.in[i] = (const float*)d_in[i];
    a.out = (float*)d_out; a.ws = (unsigned char*)d_ws;
#if N_LAUNCH_MODE == 1
    a.ph_lo = 0; a.ph_hi = N_PHASES;
    hipLaunchKernelGGL(mk_fwd, dim3(grid), dim3(NWAVES * 64), LDS_BYTES, stream, a);
#else
#define LAUNCH_P(P) hipLaunchKernelGGL(mk_phase<P>, dim3(grid), dim3(NWAVES * 64), LDS_BYTES, stream, a)
    a.ph_lo = 0; a.ph_hi = 0; LAUNCH_P(-1);
    for (int l = 0; l < DEPTH; ++l) { a.ph_lo = l;
        LAUNCH_P(0); LAUNCH_P(1); LAUNCH_P(2); LAUNCH_P(3); LAUNCH_P(4); LAUNCH_P(5); LAUNCH_P(6); LAUNCH_P(7); LAUNCH_P(8); LAUNCH_P(9); LAUNCH_P(10); LAUNCH_P(11); LAUNCH_P(12); LAUNCH_P(13); LAUNCH_P(14); LAUNCH_P(15); LAUNCH_P(16); LAUNCH_P(17); }
#undef LAUNCH_P
#endif
    const hipError_t le = hipPeekAtLastError();
    if (le != hipSuccess) fprintf(stderr, "kernel_launch: launch failed: %s\n", hipGetErrorName(le));
}
```

```cpp
#include <hip/hip_runtime.h>
#include <cstdio>
#include <cstdint>

#ifndef REP_MASK
#define REP_MASK 0
#endif
#ifndef REP_N
#define REP_N 2
#endif
#ifndef FAST_MIX
#define FAST_MIX 1
#endif
#ifndef FAST_WIN
#define FAST_WIN 1
#endif
#ifndef FAST_LRU
#define FAST_LRU 1
#endif
#define FAST_FFT 0
#ifndef FAST_FFT_A
#define FAST_FFT_A 1
#endif
#ifndef FAST_FFT_B
#define FAST_FFT_B 1
#endif
#ifndef FAST_MOE
#define FAST_MOE 1
#endif
#ifndef FAST_ATTN
#define FAST_ATTN 1
#endif
#ifndef N_LAUNCH_MODE
#define N_LAUNCH_MODE 1
#endif

__device__ __forceinline__ int otid() { int t = threadIdx.x; asm volatile("" : "+v"(t)); return t; }
__device__ __forceinline__ int obid() { int b = blockIdx.x; asm volatile("" : "+s"(b)); return b; }
__device__ __forceinline__ int ogrid() { int g = gridDim.x; asm volatile("" : "+s"(g)); return g; }
template <int M> __device__ __forceinline__ float sx(float v) {
    static_assert(M == 1 || M == 2 || M == 4 || M == 8 || M == 16 || M == 32, "xor mask");
    if constexpr (M < 32) return __uint_as_float((unsigned)__builtin_amdgcn_ds_swizzle((int)__float_as_uint(v), (M << 10) | 0x1f));
    else { auto rr = __builtin_amdgcn_permlane32_swap(__float_as_uint(v), __float_as_uint(v), false, false); const unsigned a = rr[0], b = rr[1]; return __uint_as_float(a == __float_as_uint(v) ? b : a); }
}
template <int M> __device__ __forceinline__ int sxi(int v) { return (int)__float_as_uint(sx<M>(__uint_as_float((unsigned)v))); }
namespace pg8 {
#define PG8_LAS __attribute__((address_space(3)))
typedef unsigned short bf16_t;
typedef short bf16x8 __attribute__((ext_vector_type(8)));
typedef float f32x4 __attribute__((ext_vector_type(4)));
typedef unsigned u32x4 __attribute__((ext_vector_type(4)));
constexpr int BM = 256, BK = 64, HALF = 128, HTB = HALF * BK * 2, STAGE_BYTES = 8 * HTB, NXCD = 8, WGM = 8;
__host__ __device__ __forceinline__ int lds_byte(int r, int c) { const int st = (r >> 4) * 2 + (c >> 5), rr = r & 15, cc = c & 31, ob = rr * 64 + cc * 2; return st * 1024 + (ob ^ (((ob >> 9) & 1) << 5)); }
__host__ __device__ __forceinline__ void stage_rc(int b, int& R, int& C) { const int st = b / 1024, sb = b % 1024, swz = sb ^ (((sb >> 9) & 1) << 5); R = (st >> 1) * 16 + swz / 64; C = (st & 1) * 32 + (swz % 64) / 2; }
__host__ __device__ __forceinline__ int perm32(int rho) { const int n = rho >> 4, i = rho & 15; return 8 * (i >> 2) + 4 * n + (i & 3); }
struct Unit { int pm, pn; };
struct Gemm { const bf16_t* A; const bf16_t* Bt; int M, N, K, lda, ldb; };
struct StaticOrder {
    int nM, nN, nwg, G, c; bool skipctx;
    __host__ __device__ void init(int M, int N, int G_, int c_, bool skip = false) { nM = skip ? 64 : M / BM; nN = N / BM; nwg = nM * nN; G = G_; c = c_; skipctx = skip; }
    __host__ __device__ bool next(int i, Unit& u) const {
        const long L = (long)i * G + c; if (L >= nwg) return false;
        int wgid = (int)L; { const int q = nwg / NXCD, r = nwg % NXCD, xcd = wgid % NXCD, off = wgid / NXCD; wgid = (xcd < r ? xcd * (q + 1) : r * (q + 1) + (xcd - r) * q) + off; }
        const int nig = WGM * nN, gid = wgid / nig, fm = gid * WGM, gsz = (nM - fm) < WGM ? (nM - fm) : WGM;
        u.pm = fm + ((wgid % nig) % gsz); u.pn = (wgid % nig) / gsz;
        if (skipctx) u.pm += 1 + (u.pm >= 32 ? 1 : 0);
        return true;
    }
};
__device__ __forceinline__ unsigned cvt_pk_bf16(float lo, float hi) { unsigned r; asm volatile("v_cvt_pk_bf16_f32 %0, %1, %2" : "=v"(r) : "v"(lo), "v"(hi)); return r; }

struct EpiF32 {
    static constexpr bool PERM = false; static constexpr int MIDK = 0;
    float* C; int ldc;
    __device__ __forceinline__ void operator()(const f32x4 (&acc)[2][2][4][2], const Unit& u, int wr, int wc, int fr, int fq) const {
        const int row0 = u.pm * BM + wr * 64 + fr, col0 = u.pn * BM + wc * 32 + 4 * fq;
#pragma unroll
        for (int ai = 0; ai < 2; ++ai)
#pragma unroll
            for (int m = 0; m < 4; ++m) { float* rowp = C + (size_t)(row0 + ai * HALF + m * 16) * ldc + col0;
#pragma unroll
                for (int bj = 0; bj < 2; ++bj)
#pragma unroll
                    for (int n = 0; n < 2; ++n) *(f32x4*)(rowp + bj * HALF + n * 16) = acc[ai][bj][m][n]; }
    }
};

template <class Epi>
__device__ __forceinline__ void gemm_phase(PG8_LAS unsigned char* lds, const Gemm g, const StaticOrder& S, const Epi& E) {
    const int tid = otid(), wid = __builtin_amdgcn_readfirstlane(tid >> 6), lane = tid & 63, wr = wid >> 2, wc = wid & 3, fr = lane & 15, fq = lane >> 4;
    const int K = g.K, nt = K / BK;
    unsigned voffA[2], voffB[2];
#pragma unroll
    for (int i = 0; i < 2; ++i) { int R, C; stage_rc(tid * 16 + i * 8192, R, C); const int Rb = Epi::PERM ? ((R & ~31) + perm32(R & 31)) : R;
        voffA[i] = (unsigned)(R * g.lda + C) * 2u; voffB[i] = (unsigned)(Rb * g.ldb + C) * 2u; }
    const size_t kstep = (size_t)(BK * 2);
    const size_t hA = (size_t)HALF * g.lda * 2, hB = (size_t)HALF * g.ldb * 2;
    const size_t tA = 2 * hA, tB = 2 * hB;
    const unsigned ldsw = (unsigned)wid * 1024u;
    const int aoff = lds_byte(wr * 64 + fr, fq * 8), boff = lds_byte(wc * 32 + fr, fq * 8);
#define PG8_SA(b, h) (((b) * 2 + (h)) * HTB)
#define PG8_SB(b, h) ((4 + (b) * 2 + (h)) * HTB)
#define PG8_STAGE(bufoff, gbase, voff) do { _Pragma("unroll") for (int _i = 0; _i < 2; ++_i) \
        __builtin_amdgcn_global_load_lds((const unsigned*)((const char*)(gbase) + (voff)[_i]), (PG8_LAS unsigned*)(lds + (bufoff) + ldsw + _i * 8192), 16, 0, 0); } while (0)
#define PG8_LDA(dst, b, h) do { _Pragma("unroll") for (int m = 0; m < 4; ++m) _Pragma("unroll") for (int k = 0; k < 2; ++k) dst[m][k] = *(const PG8_LAS bf16x8*)(lds + PG8_SA(b, h) + aoff + m * 2048 + k * 1024); } while (0)
#define PG8_LDB(dst, b, h) do { _Pragma("unroll") for (int n = 0; n < 2; ++n) _Pragma("unroll") for (int k = 0; k < 2; ++k) dst[n][k] = *(const PG8_LAS bf16x8*)(lds + PG8_SB(b, h) + boff + n * 2048 + k * 1024); } while (0)
#define PG8_MMA(ai, bj, At, Bt) do { __builtin_amdgcn_s_setprio(1); _Pragma("unroll") for (int m = 0; m < 4; ++m) _Pragma("unroll") for (int n = 0; n < 2; ++n) _Pragma("unroll") for (int k = 0; k < 2; ++k) \
        acc[ai][bj][m][n] = __builtin_amdgcn_mfma_f32_16x16x32_bf16(Bt[n][k], At[m][k], acc[ai][bj][m][n], 0, 0, 0); __builtin_amdgcn_s_setprio(0); } while (0)
#define PG8_WAIT_V(n) asm volatile("s_waitcnt vmcnt(" #n ")" ::: "memory")
#define PG8_WAIT_L(n) asm volatile("s_waitcnt lgkmcnt(" #n ")" ::: "memory")
#define PG8_BAR __builtin_amdgcn_s_barrier()
#define PG8_SCHED __builtin_amdgcn_sched_barrier(0)
    Unit cur, nxt; int ui = 0;
    if (!S.next(0, cur)) return;
    f32x4 acc[2][2][4][2];
#pragma unroll
    for (int a = 0; a < 2; ++a)
#pragma unroll
        for (int b = 0; b < 2; ++b)
#pragma unroll
            for (int m = 0; m < 4; ++m)
#pragma unroll
                for (int n = 0; n < 2; ++n) acc[a][b][m][n] = (f32x4){0.f, 0.f, 0.f, 0.f};
    bf16x8 At[4][2], B0[2][2], B1[2][2];
    const char* cA = (const char*)g.A + (size_t)cur.pm * tA; const char* cB = (const char*)g.Bt + (size_t)cur.pn * tB;
    PG8_STAGE(PG8_SB(0, 0), cB, voffB); PG8_STAGE(PG8_SB(0, 1), cB + hB, voffB); PG8_STAGE(PG8_SA(0, 0), cA, voffA); PG8_STAGE(PG8_SA(0, 1), cA + hA, voffA);
    if (wr == 1) PG8_BAR;
    PG8_WAIT_V(2); PG8_BAR;
    PG8_STAGE(PG8_SB(1, 0), cB + kstep, voffB); PG8_STAGE(PG8_SA(1, 0), cA + kstep, voffA); PG8_STAGE(PG8_SB(1, 1), cB + hB + kstep, voffB);
    PG8_WAIT_V(6); PG8_BAR;
    for (;;) {
        const bool has_next = S.next(ui + 1, nxt);
        const char* nA = has_next ? (const char*)g.A + (size_t)nxt.pm * tA : cA; const char* nB = has_next ? (const char*)g.Bt + (size_t)nxt.pn * tB : cB;
#pragma unroll 1
        for (int t = 0; t < nt; t += 2) {
            if constexpr (Epi::MIDK > 0) { if (t > 0 && (t % Epi::MIDK) == 0) E.mid(acc, cur, wr, wc, fr, fq, t / Epi::MIDK); }
            const bool last = (t == nt - 2);
            const char* a1 = cA + (size_t)(t + 1) * kstep;
            const char* a2 = last ? nA : cA + (size_t)(t + 2) * kstep; const char* b2 = last ? nB : cB + (size_t)(t + 2) * kstep;
            const char* a3 = a2 + kstep; const char* b3 = b2 + kstep;
            PG8_LDB(B0, 0, 0); PG8_LDB(B1, 0, 1); PG8_SCHED; PG8_LDA(At, 0, 0); PG8_STAGE(PG8_SA(1, 1), a1 + hA, voffA);
            PG8_WAIT_V(8); PG8_WAIT_L(0); PG8_BAR; PG8_MMA(0, 0, At, B0); PG8_MMA(0, 1, At, B1); PG8_BAR; PG8_SCHED;
            PG8_LDA(At, 0, 1); PG8_STAGE(PG8_SB(0, 0), b2, voffB); PG8_STAGE(PG8_SB(0, 1), b2 + hB, voffB); PG8_STAGE(PG8_SA(0, 0), a2, voffA);
            PG8_WAIT_V(8); PG8_WAIT_L(0); PG8_BAR; PG8_MMA(1, 0, At, B0); PG8_MMA(1, 1, At, B1); PG8_BAR; PG8_SCHED;
            PG8_LDB(B0, 1, 0); PG8_LDB(B1, 1, 1); PG8_SCHED; PG8_LDA(At, 1, 0); PG8_STAGE(PG8_SA(0, 1), a2 + hA, voffA);
            PG8_WAIT_V(8); PG8_WAIT_L(0); PG8_BAR; PG8_MMA(0, 0, At, B0); PG8_MMA(0, 1, At, B1); PG8_BAR; PG8_SCHED;
            PG8_LDA(At, 1, 1); PG8_STAGE(PG8_SB(1, 0), b3, voffB); PG8_STAGE(PG8_SB(1, 1), b3 + hB, voffB); PG8_STAGE(PG8_SA(1, 0), a3, voffA);
            PG8_WAIT_V(8); PG8_WAIT_L(0); PG8_BAR; PG8_MMA(1, 0, At, B0); PG8_MMA(1, 1, At, B1); PG8_BAR; PG8_SCHED;
        }
        if (wr == 0) PG8_BAR;
        E(acc, cur, wr, wc, fr, fq);
        if (!has_next) break;
#pragma unroll
        for (int a = 0; a < 2; ++a)
#pragma unroll
            for (int b = 0; b < 2; ++b)
#pragma unroll
                for (int m = 0; m < 4; ++m)
#pragma unroll
                    for (int n = 0; n < 2; ++n) acc[a][b][m][n] = (f32x4){0.f, 0.f, 0.f, 0.f};
        cur = nxt; cA = nA; cB = nB; ++ui;
        if (wr == 1) PG8_BAR;
    }
    PG8_WAIT_V(0);
    PG8_BAR;
#undef PG8_SA
#undef PG8_SB
#undef PG8_STAGE
#undef PG8_LDA
#undef PG8_LDB
#undef PG8_MMA
#undef PG8_WAIT_V
#undef PG8_WAIT_L
#undef PG8_BAR
#undef PG8_SCHED
}

struct UnitG { const char* a; const char* b; int row0, pn, e, valid; const int* rows; };
template <class Epi, class Sched, bool GATHER>
__device__ __forceinline__ void gemm_phase_g(PG8_LAS unsigned char* lds, const int K, const int lda, const int ldb, const Sched& S, const Epi& E) {
    const int tid = otid(), wid = __builtin_amdgcn_readfirstlane(tid >> 6), lane = tid & 63, wr = wid >> 2, wc = wid & 3, fr = lane & 15, fq = lane >> 4;
    const int nt = K / BK;
    int RA[2], CA[2]; unsigned voffB[2];
#pragma unroll
    for (int i = 0; i < 2; ++i) { int R, C; stage_rc(tid * 16 + i * 8192, R, C); const int Rb = Epi::PERM ? ((R & ~31) + perm32(R & 31)) : R;
        RA[i] = R; CA[i] = C; voffB[i] = (unsigned)(Rb * ldb + C) * 2u; }
    const size_t kstep = (size_t)(BK * 2);
    const size_t hB = (size_t)HALF * ldb * 2;
    const unsigned ldsw = (unsigned)wid * 1024u;
    const int aoff = lds_byte(wr * 64 + fr, fq * 8), boff = lds_byte(wc * 32 + fr, fq * 8);
#define PG8_SA(b, h) (((b) * 2 + (h)) * HTB)
#define PG8_SB(b, h) ((4 + (b) * 2 + (h)) * HTB)
#define PG8_STAGE(bufoff, gbase, voff) do { _Pragma("unroll") for (int _i = 0; _i < 2; ++_i) \
        __builtin_amdgcn_global_load_lds((const unsigned*)((const char*)(gbase) + (voff)[_i]), (PG8_LAS unsigned*)(lds + (bufoff) + ldsw + _i * 8192), 16, 0, 0); } while (0)
#define PG8_LDA(dst, b, h) do { _Pragma("unroll") for (int m = 0; m < 4; ++m) _Pragma("unroll") for (int k = 0; k < 2; ++k) dst[m][k] = *(const PG8_LAS bf16x8*)(lds + PG8_SA(b, h) + aoff + m * 2048 + k * 1024); } while (0)
#define PG8_LDB(dst, b, h) do { _Pragma("unroll") for (int n = 0; n < 2; ++n) _Pragma("unroll") for (int k = 0; k < 2; ++k) dst[n][k] = *(const PG8_LAS bf16x8*)(lds + PG8_SB(b, h) + boff + n * 2048 + k * 1024); } while (0)
#define PG8_MMA(ai, bj, At, Bt) do { __builtin_amdgcn_s_setprio(1); _Pragma("unroll") for (int m = 0; m < 4; ++m) _Pragma("unroll") for (int n = 0; n < 2; ++n) _Pragma("unroll") for (int k = 0; k < 2; ++k) \
        acc[ai][bj][m][n] = __builtin_amdgcn_mfma_f32_16x16x32_bf16(Bt[n][k], At[m][k], acc[ai][bj][m][n], 0, 0, 0); __builtin_amdgcn_s_setprio(0); } while (0)
#define PG8_WAIT_V(n) asm volatile("s_waitcnt vmcnt(" #n ")" ::: "memory")
#define PG8_WAIT_L(n) asm volatile("s_waitcnt lgkmcnt(" #n ")" ::: "memory")
#define PG8_BAR __builtin_amdgcn_s_barrier()
#define PG8_SCHED __builtin_amdgcn_sched_barrier(0)
#define PG8_MKOFF(u, v) do { _Pragma("unroll") for (int _h = 0; _h < 2; ++_h) _Pragma("unroll") for (int _i = 0; _i < 2; ++_i) { const int _row = _h * HALF + RA[_i]; \
        if (GATHER) { const int _pr = _row < (u).valid ? (u).rows[_row] : 0; v[_h][_i] = (unsigned)(_pr >> 3) * (unsigned)(lda * 2) + (unsigned)(CA[_i] * 2); } \
        else v[_h][_i] = (unsigned)(_row * lda + CA[_i]) * 2u; } } while (0)
    UnitG cur, nxt; int ui = 0;
    if (!S.next(0, cur)) return;
    f32x4 acc[2][2][4][2];
#pragma unroll
    for (int a = 0; a < 2; ++a)
#pragma unroll
        for (int b = 0; b < 2; ++b)
#pragma unroll
            for (int m = 0; m < 4; ++m)
#pragma unroll
                for (int n = 0; n < 2; ++n) acc[a][b][m][n] = (f32x4){0.f, 0.f, 0.f, 0.f};
    bf16x8 At[4][2], B0[2][2], B1[2][2];
    unsigned vA[2][2], vN[2][2];
    PG8_MKOFF(cur, vA);
    const char* cA = cur.a; const char* cB = cur.b;
    PG8_STAGE(PG8_SB(0, 0), cB, voffB); PG8_STAGE(PG8_SB(0, 1), cB + hB, voffB); PG8_STAGE(PG8_SA(0, 0), cA, vA[0]); PG8_STAGE(PG8_SA(0, 1), cA, vA[1]);
    if (wr == 1) PG8_BAR;
    PG8_WAIT_V(2); PG8_BAR;
    PG8_STAGE(PG8_SB(1, 0), cB + kstep, voffB); PG8_STAGE(PG8_SA(1, 0), cA + kstep, vA[0]); PG8_STAGE(PG8_SB(1, 1), cB + hB + kstep, voffB);
    PG8_WAIT_V(6); PG8_BAR;
    for (;;) {
        const bool has_next = S.next(ui + 1, nxt);
        if constexpr (GATHER) { if (has_next) { PG8_MKOFF(nxt, vN); } else { vN[0][0] = vA[0][0]; vN[0][1] = vA[0][1]; vN[1][0] = vA[1][0]; vN[1][1] = vA[1][1]; } }
        const char* nA = has_next ? nxt.a : cA; const char* nB = has_next ? nxt.b : cB;
#pragma unroll 1
        for (int t = 0; t < nt; t += 2) {
            const bool last = (t == nt - 2);
            const char* a1 = cA + (size_t)(t + 1) * kstep;
            const char* a2 = last ? nA : cA + (size_t)(t + 2) * kstep; const char* b2 = last ? nB : cB + (size_t)(t + 2) * kstep;
            const char* a3 = a2 + kstep; const char* b3 = b2 + kstep;
            unsigned s0[2], s1[2];
            if constexpr (GATHER) { s0[0] = last ? vN[0][0] : vA[0][0]; s0[1] = last ? vN[0][1] : vA[0][1]; s1[0] = last ? vN[1][0] : vA[1][0]; s1[1] = last ? vN[1][1] : vA[1][1]; }
            else { s0[0] = vA[0][0]; s0[1] = vA[0][1]; s1[0] = vA[1][0]; s1[1] = vA[1][1]; }
            PG8_LDB(B0, 0, 0); PG8_LDB(B1, 0, 1); PG8_SCHED; PG8_LDA(At, 0, 0); PG8_STAGE(PG8_SA(1, 1), a1, vA[1]);
            PG8_WAIT_V(8); PG8_WAIT_L(0); PG8_BAR; PG8_MMA(0, 0, At, B0); PG8_MMA(0, 1, At, B1); PG8_BAR; PG8_SCHED;
            PG8_LDA(At, 0, 1); PG8_STAGE(PG8_SB(0, 0), b2, voffB); PG8_STAGE(PG8_SB(0, 1), b2 + hB, voffB); PG8_STAGE(PG8_SA(0, 0), a2, s0);
            PG8_WAIT_V(8); PG8_WAIT_L(0); PG8_BAR; PG8_MMA(1, 0, At, B0); PG8_MMA(1, 1, At, B1); PG8_BAR; PG8_SCHED;
            PG8_LDB(B0, 1, 0); PG8_LDB(B1, 1, 1); PG8_SCHED; PG8_LDA(At, 1, 0); PG8_STAGE(PG8_SA(0, 1), a2, s1);
            PG8_WAIT_V(8); PG8_WAIT_L(0); PG8_BAR; PG8_MMA(0, 0, At, B0); PG8_MMA(0, 1, At, B1); PG8_BAR; PG8_SCHED;
            PG8_LDA(At, 1, 1); PG8_STAGE(PG8_SB(1, 0), b3, voffB); PG8_STAGE(PG8_SB(1, 1), b3 + hB, voffB); PG8_STAGE(PG8_SA(1, 0), a3, s0);
            PG8_WAIT_V(8); PG8_WAIT_L(0); PG8_BAR; PG8_MMA(1, 0, At, B0); PG8_MMA(1, 1, At, B1); PG8_BAR; PG8_SCHED;
        }
        if (wr == 0) PG8_BAR;
        E(acc, cur, wr, wc, fr, fq);
        if (!has_next) break;
#pragma unroll
        for (int a = 0; a < 2; ++a)
#pragma unroll
            for (int b = 0; b < 2; ++b)
#pragma unroll
                for (int m = 0; m < 4; ++m)
#pragma unroll
                    for (int n = 0; n < 2; ++n) acc[a][b][m][n] = (f32x4){0.f, 0.f, 0.f, 0.f};
        cur = nxt; cA = nA; cB = nB; ++ui;
        if constexpr (GATHER) { vA[0][0] = vN[0][0]; vA[0][1] = vN[0][1]; vA[1][0] = vN[1][0]; vA[1][1] = vN[1][1]; }
        if (wr == 1) PG8_BAR;
    }
    PG8_WAIT_V(0);
    PG8_BAR;
#undef PG8_SA
#undef PG8_SB
#undef PG8_STAGE
#undef PG8_LDA
#undef PG8_LDB
#undef PG8_MMA
#undef PG8_WAIT_V
#undef PG8_WAIT_L
#undef PG8_BAR
#undef PG8_SCHED
#undef PG8_MKOFF
}
}

constexpr int DM = 1024, NB = 2, SEQ = 8192, CTX = 256, TPB = SEQ + CTX, MROWS = NB * TPB, DEPTH = 2;
constexpr int INW = 9216, COL_K = 0, COL_V = 1024, COL_LX = 2048, COL_Q = 3072, COL_LG = 4096, COL_F = 5120, COL_G = 6144;
constexpr int NE = 256, TOPK = 8, EFF = 256, NPAIR = MROWS * TOPK, LCAP = MROWS;
constexpr float EPS = 1e-6f;
constexpr float QSCALE = 0.125f * 1.4426950408889634f;
constexpr int NCHUNK = TPB / 64;
static_assert(MROWS % 256 == 0, "rows");

constexpr size_t MiB = 1u << 20;
constexpr size_t WS_CTL = 0, CTL_ZERO_BYTES = 1 * MiB;
constexpr size_t WS_W = 1 * MiB, WL_STRIDE = 32 * MiB;
constexpr size_t WO_TAB = 31 * MiB;
constexpr size_t WO_WIN = 0, WO_D1 = 18 * MiB, WO_OUT = 24 * MiB, WO_R = 26 * MiB, WO_SGU = 27 * MiB, WO_SD = 28 * MiB, WO_LRU = 29 * MiB;
constexpr size_t WS_XALL = 65 * MiB;
constexpr size_t WS_H = WS_XALL + 66 * MiB;
constexpr size_t WS_U = WS_H + 33 * MiB;
constexpr size_t WS_KB = WS_U + 594 * MiB, WS_VB = WS_KB + 33 * MiB, WS_QB = WS_VB + 33 * MiB, WS_LXB = WS_QB + 33 * MiB, WS_GLG = WS_LXB + 33 * MiB, WS_ZP = WS_GLG + 33 * MiB;
constexpr size_t WS_GATES = WS_ZP + 33 * MiB;
constexpr size_t WS_MIXIN = WS_GATES + 99 * MiB;
constexpr size_t WS_S = WS_MIXIN + 99 * MiB;
constexpr size_t WS_UC = WS_S, WS_AB = WS_UC + 33 * MiB, WS_SUMM = WS_AB + 132 * MiB, WS_CARRY = WS_SUMM + 5 * MiB, WS_XA = WS_CARRY + 3 * MiB, WS_XB = WS_XA + 32 * MiB, WS_GB = WS_XB + 32 * MiB, WS_GC = WS_GB + 32 * MiB;
constexpr size_t WS_PA = WS_S, WS_PR = WS_PA + 66 * MiB, WS_PF = WS_PR + 66 * MiB, WS_Y1 = WS_PF + 66 * MiB;
static_assert(WS_GC + 3 * MiB <= WS_S + 280 * MiB && WS_Y1 + 66 * MiB <= WS_S + 280 * MiB, "scratch S");
constexpr size_t WS_MIXED = WS_S + 280 * MiB, WS_TOK = WS_MIXED + 33 * MiB;
constexpr size_t WS_LOG = WS_TOK + 33 * MiB, WS_SGU = WS_LOG + 17 * MiB, WS_SH = WS_SGU + 33 * MiB, WS_LIST = WS_SH + 9 * MiB, WS_TOPW = WS_LIST + 17 * MiB, WS_SD = WS_TOPW + 1 * MiB;
constexpr size_t WS_YB = WS_U;
constexpr size_t WS_Y16 = WS_U, WS_HB = WS_U + 392 * MiB;
constexpr size_t WS_EP = WS_SUMM;
constexpr size_t WS_Y16_OLD = WS_U;
constexpr size_t WS_EW = WS_SD + 66 * MiB, EW_STRIDE = 3 * MiB / 2;
constexpr size_t WS_END = WS_EW + 384 * MiB;
static_assert(WS_END <= 2048 * MiB, "d_ws budget");
constexpr int CW_BAR = 4096;
constexpr int CW_CNT = 16384;
constexpr int CW_MOD = 65536;
static_assert((CW_MOD + 2 * 3 * 6144) * 4 <= (int)CTL_ZERO_BYTES, "ctl");

constexpr int LDS_BYTES = 147456, RING_BYTES = 131072, MISC_OFF = RING_BYTES + 320;
constexpr int NWAVES = 8;

#define GAS __attribute__((address_space(1)))
#define LAS __attribute__((address_space(3)))
typedef unsigned short bf16;
typedef unsigned v4u __attribute__((ext_vector_type(4)));
typedef float f32x4 __attribute__((ext_vector_type(4)));
typedef GAS unsigned gu32;
#define RLX_AGENT __ATOMIC_RELAXED, __HIP_MEMORY_SCOPE_AGENT
#define LDS_WAIT() asm volatile("s_waitcnt lgkmcnt(0)" ::: "memory")
__device__ __forceinline__ unsigned f2bf(float f) { unsigned u = __builtin_bit_cast(unsigned, f); return (u + 0x7fffu + ((u >> 16) & 1u)) >> 16; }
__device__ __forceinline__ unsigned pk2(float lo, float hi) { return f2bf(lo) | (f2bf(hi) << 16); }
__device__ __forceinline__ float bf2f(unsigned h) { return __uint_as_float(h << 16); }
__device__ __forceinline__ float sigmoidf_(float x) { return 1.f / (1.f + __expf(-x)); }
__device__ __forceinline__ float siluf_(float x) { return x / (1.f + __expf(-x)); }
__device__ __forceinline__ float gelu_tanh(float x) { const float u = 0.7978845608028654f * (x + 0.044715f * x * x * x); return x / (1.f + __expf(-2.f * u)); }

#define XB_TMO      128
#define XB_XCNT(j)  (256  + 64 * (j))
#define XB_XSUB(j)  (1280 + 64 * (j))
#define XB_XGEN(j)  (2304 + 64 * (j))
#define XB_TOP      3328
#define XB_TOPGEN   3392
#define XCD_BAR_WORDS 3456
#define XB_SPIN_CAP (1u << 18)
__device__ __forceinline__ unsigned xb_ld(unsigned* p)              { return __hip_atomic_load(p, __ATOMIC_RELAXED, __HIP_MEMORY_SCOPE_AGENT); }
__device__ __forceinline__ unsigned xb_add(unsigned* p, unsigned v) { return __hip_atomic_fetch_add(p, v, __ATOMIC_RELAXED, __HIP_MEMORY_SCOPE_AGENT); }
__device__ __forceinline__ unsigned xb_xcc_id() { return (unsigned)__builtin_amdgcn_s_getreg((3 << 11) | 20) & 0xFu; }
#define XB_SPIN(cond, bar) do { unsigned _sp = 0; while (cond) { __builtin_amdgcn_s_sleep(1); \
    if ((++_sp & 255u) == 0u) { if (xb_ld(&(bar)[XB_TMO])) break; if (_sp > XB_SPIN_CAP) { atomicAdd(&(bar)[XB_TMO], 1u); break; } } } } while (0)
struct XcdBarrier { unsigned* bar; unsigned x; volatile LAS unsigned* st; };
__device__ __forceinline__ XcdBarrier xcd_barrier_post(unsigned* bar, volatile LAS unsigned* st) {
    XcdBarrier b; b.bar = bar; b.x = xb_xcc_id(); b.st = st;
    if (threadIdx.x == 0) (void)xb_add(&bar[XB_XCNT(b.x)], 1u);
    return b;
}
__device__ __forceinline__ void xcd_barrier_complete(unsigned* bar, unsigned x, unsigned& nloc, unsigned& nx) {
    const unsigned G = gridDim.x * gridDim.y * gridDim.z;
    unsigned sum, cnt, mine, sp = 0u;
    for (;;) {
        sum = 0u; cnt = 0u; mine = 0u;
#pragma unroll
        for (unsigned j = 0; j < 16; ++j) { const unsigned c = xb_ld(&bar[XB_XCNT(j)]); sum += c; cnt += (c > 0u) ? 1u : 0u; mine = (j == x) ? c : mine; }
        if (sum == G) break;
        __builtin_amdgcn_s_sleep(1);
        if ((++sp & 255u) == 0u) { if (xb_ld(&bar[XB_TMO])) break; if (sp > XB_SPIN_CAP) { atomicAdd(&bar[XB_TMO], 1u); break; } }
    }
    nloc = mine > 0u ? mine : 1u; nx = cnt > 0u ? cnt : 1u;
}
__device__ __forceinline__ void xcd_barrier(const XcdBarrier& b) {
    asm volatile("s_waitcnt vmcnt(0)" ::: "memory");
    __syncthreads();
    if (threadIdx.x == 0) {
        unsigned* bar = b.bar; asm volatile("" : "+s"(bar));
        __builtin_amdgcn_s_waitcnt(0);
        unsigned nloc = b.st[0], nx = b.st[1];
        unsigned bx = b.x; asm volatile("" : "+s"(bx));
        if (nloc == 0u) { xcd_barrier_complete(bar, bx, nloc, nx); b.st[0] = nloc; b.st[1] = nx; }
        const unsigned old = xb_add(&bar[XB_XSUB(bx)], 1u);
        const unsigned gen = old / nloc;
        if (old + 1u == (gen + 1u) * nloc) {
            __builtin_amdgcn_fence(__ATOMIC_RELEASE, "agent");
            asm volatile("s_waitcnt vmcnt(0)" ::: "memory");
            const unsigned og = xb_add(&bar[XB_TOP], 1u);
            const unsigned tg = og / nx;
            if (og + 1u == (tg + 1u) * nx) xb_add(&bar[XB_TOPGEN], 1u);
            else XB_SPIN(xb_ld(&bar[XB_TOPGEN]) == tg, bar);
            __builtin_amdgcn_fence(__ATOMIC_ACQUIRE, "agent");
            xb_add(&bar[XB_XGEN(bx)], 1u);
            asm volatile("s_waitcnt vmcnt(0)" ::: "memory");
        } else {
            XB_SPIN(xb_ld(&bar[XB_XGEN(bx)]) == gen, bar);
            __builtin_amdgcn_fence(__ATOMIC_ACQUIRE, "agent");
            asm volatile("s_waitcnt vmcnt(0)" ::: "memory");
        }
    }
    __syncthreads();
}

struct Args { const float* in[32]; float* out; unsigned char* ws; int ph_lo, ph_hi; };
struct Frame { LAS unsigned char* lds; int tid, lane, wave, bid, G, gw, NGW; long gtid, NT; };
#define WSP(T, off) ((T*)(A.ws + (off)))
#define WLP(l, off) ((bf16*)(A.ws + WS_W + (size_t)(l) * WL_STRIDE + (off)))
#define MODP(l, s, j) ((const float*)(A.ws + WS_CTL) + CW_MOD + ((l) * 3 + (s)) * 6144 + (j) * 1024)

__device__ __forceinline__ float wave_sum(float v) {
    v += sx<1>(v); v += sx<2>(v); v += sx<4>(v); v += sx<8>(v); v += sx<16>(v); v += sx<32>(v);
    return v;
}
__device__ __forceinline__ int win_row(int c) {
    const int sec = c >> 10; if (sec != 0 && sec != 3) return c;
    const int L = c & 255, g = L >> 6, a = (L >> 5) & 1, x = (L >> 4) & 1, q = (L >> 2) & 3, e = L & 3;
    return (c & ~255) | (128 * a + 32 * g + 8 * q + 4 * x + e);
}
template <bool WINMAP = false>
__device__ __forceinline__ void p0_transpose_item(const float* W, int K, int N, bf16* WT, int ldwt, int row_off, int col_off, LAS float* scr, int item, int lane) {
    const int nblk = N / 32, kb = item / nblk, nb = item % nblk, k0 = 64 * kb, n0 = 32 * nb;
#pragma unroll 8
    for (int i = 0; i < 32; ++i) { const int kk = 2 * i + (lane >> 5); scr[kk * 33 + (lane & 31)] = W[(size_t)(k0 + kk) * N + n0 + (lane & 31)]; }
    LDS_WAIT(); asm volatile("" ::: "memory");
    const int c = lane & 7;
#pragma unroll
    for (int j = 0; j < 4; ++j) { const int n = (lane >> 3) + 8 * j; const LAS float* s = scr + (8 * c) * 33 + n;
        v4u o; o.x = pk2(s[0 * 33], s[1 * 33]); o.y = pk2(s[2 * 33], s[3 * 33]); o.z = pk2(s[4 * 33], s[5 * 33]); o.w = pk2(s[6 * 33], s[7 * 33]);
        const int rr = WINMAP ? win_row(n0 + n) : n0 + n;
        *(v4u*)(WT + (size_t)(row_off + rr) * ldwt + col_off + k0 + 8 * c) = o; }
    LDS_WAIT(); asm volatile("" ::: "memory");
}

__device__ __forceinline__ void ph_prologue(const Frame& F, const Args& A) {
    LAS float* scr = (LAS float*)(F.lds + F.wave * 16384);
    constexpr int I_WIN = 16 * 288, I_SQ = 16 * 32, I_R = 16 * 8, I_SD = 4 * 32;
    constexpr int PER_L = I_WIN + 4 * I_SQ + 3 * I_R + I_SD;
    for (int it = F.gw; it < 2 * PER_L; it += F.NGW) {
        const int l = it / PER_L; int r = it % PER_L;
        if (r < I_WIN) {
#if FAST_WIN
            const int nb = r % 288; if (nb >= 160 && nb < 192) continue;
            p0_transpose_item<true>(A.in[7] + (size_t)l * 1024 * 9216, 1024, 9216, WLP(l, WO_WIN), 1024, 0, 0, scr, r, F.lane); continue;
#else
            p0_transpose_item(A.in[7] + (size_t)l * 1024 * 9216, 1024, 9216, WLP(l, WO_WIN), 1024, 0, 0, scr, r, F.lane); continue;
#endif
        } r -= I_WIN;
        if (r < I_SQ) { p0_transpose_item(A.in[12] + (size_t)l * 1048576, 1024, 1024, WLP(l, WO_D1), 3072, 0, 0, scr, r, F.lane); continue; } r -= I_SQ;
        if (r < I_SQ) { p0_transpose_item(A.in[20] + (size_t)l * 1048576, 1024, 1024, WLP(l, WO_D1), 3072, 0, 1024, scr, r, F.lane); continue; } r -= I_SQ;
        if (r < I_SQ) { p0_transpose_item(A.in[21] + (size_t)l * 1048576, 1024, 1024, WLP(l, WO_D1), 3072, 0, 2048, scr, r, F.lane); continue; } r -= I_SQ;
        if (r < I_SQ) { p0_transpose_item(A.in[22] + (size_t)l * 1048576, 1024, 1024, WLP(l, WO_OUT), 1024, 0, 0, scr, r, F.lane); continue; } r -= I_SQ;
        if (r < I_R) { p0_transpose_item(A.in[24] + (size_t)l * 262144, 1024, 256, WLP(l, WO_R), 1024, 0, 0, scr, r, F.lane); continue; } r -= I_R;
        if (r < I_R) { p0_transpose_item(A.in[29] + (size_t)l * 262144, 1024, 256, WLP(l, WO_SGU), 1024, 0, 0, scr, r, F.lane); continue; } r -= I_R;
        if (r < I_R) { p0_transpose_item(A.in[30] + (size_t)l * 262144, 1024, 256, WLP(l, WO_SGU), 1024, 256, 0, scr, r, F.lane); continue; } r -= I_R;
        p0_transpose_item(A.in[31] + (size_t)l * 262144, 256, 1024, WLP(l, WO_SD), 256, 0, 0, scr, r, F.lane);
    }
#if FAST_WIN
    {
        LAS float* sW = (LAS float*)F.lds; LAS float* sT = sW + 32 * 256;
        __syncthreads();
        if (F.tid < 256) sT[F.tid] = cospif((float)F.tid / 128.0f);
        for (int it = F.bid; it < 2 * 4 * 32; it += F.G) {
            const int l = it >> 7, g = (it >> 5) & 3, k0 = (it & 31) * 32;
            __syncthreads();
            for (int e = F.tid; e < 32 * 256; e += 512) sW[e] = A.in[7][((size_t)l * 1024 + k0 + (e >> 8)) * 9216 + COL_F + g * 256 + (e & 255)];
            __syncthreads();
            const int o = F.tid & 255, kh = F.tid >> 8; int j = o >> 1, odd = o & 1; if (o == 1) { j = 128; odd = 0; }
            const int m0 = odd ? 192 : 0; float acc[16];
#pragma unroll
            for (int q = 0; q < 16; ++q) acc[q] = 0.f;
            for (int c = 0; c < 256; ++c) { const float r = sT[(j * c + m0) & 255];
#pragma unroll
                for (int q = 0; q < 16; ++q) acc[q] += sW[(kh * 16 + q) * 256 + c] * r; }
            bf16* dst = WLP(l, WO_WIN) + (size_t)(COL_F + g * 256 + o) * 1024 + k0 + kh * 16;
            v4u w0, w1; w0.x = pk2(acc[0], acc[1]); w0.y = pk2(acc[2], acc[3]); w0.z = pk2(acc[4], acc[5]); w0.w = pk2(acc[6], acc[7]);
            w1.x = pk2(acc[8], acc[9]); w1.y = pk2(acc[10], acc[11]); w1.z = pk2(acc[12], acc[13]); w1.w = pk2(acc[14], acc[15]);
            *(v4u*)dst = w0; *(v4u*)(dst + 8) = w1;
        }
        __syncthreads();
    }
#endif
    float* MOD = (float*)(A.ws + WS_CTL) + CW_MOD;
    LAS float* part = (LAS float*)(F.lds + 8 * 16384 - 8192);
    for (int it = F.bid; it < 2 * 96; it += F.G) {
        const int l = it / 96, nb = it % 96, n = nb * 64 + F.lane;
        const float* wm = A.in[4] + (size_t)l * 1024 * 6144 + n;
        float a0 = 0.f, a1 = 0.f, a2 = 0.f;
#pragma unroll 8
        for (int k = F.wave * 128; k < F.wave * 128 + 128; ++k) {
            const float w = wm[(size_t)k * 6144];
            a0 += siluf_(A.in[1][k]) * w; a1 += siluf_(A.in[1][1024 + k]) * w; a2 += siluf_(A.in[3][k]) * w;
        }
        __syncthreads();
        part[(F.wave * 3 + 0) * 64 + F.lane] = a0; part[(F.wave * 3 + 1) * 64 + F.lane] = a1; part[(F.wave * 3 + 2) * 64 + F.lane] = a2;
        __syncthreads();
        if (F.wave < 3) { float s = A.in[5][l * 6144 + n];
#pragma unroll
            for (int w = 0; w < 8; ++w) s += part[(w * 3 + F.wave) * 64 + F.lane];
            MOD[(l * 3 + F.wave) * 6144 + n] = s; }
    }
    for (long i = F.gtid; i < 2L * 4096 * 256; i += F.NT) {
        const int l = (int)(i >> 20), n = (int)((i >> 8) & 4095), kk = (int)(i & 255), pn = n >> 8, rr = n & 255, gate = rr >> 7, rho = rr & 127, d = pn >> 3, cb = pn & 7;
        const int cho = 128 * cb + rho, blk = cho >> 6, e = cho & 63, chi = 256 * (cb >> 1) + kk; float v = 0.f;
        if ((chi >> 6) == blk) v = (gate ? A.in[17] : A.in[15])[((size_t)(l * 2 + d) * 16 + blk) * 4096 + (chi & 63) * 64 + e];
        WLP(l, WO_LRU)[i & 0xFFFFF] = (bf16)f2bf(v);
    }
    for (long i = F.gtid; i < 2L * 65536; i += F.NT) {
        const int which = (int)(i >> 16), n = (int)((i >> 8) & 255), k = (int)(i & 255); float v;
        if (which == 0) { const int k1 = n >> 1, cp = n & 1, t1 = k >> 1, c = k & 1; const float rev = (float)((k1 * t1) & 127) * (1.f / 128.f);
            const float cs = __builtin_amdgcn_cosf(rev), sn = __builtin_amdgcn_sinf(rev); v = cp == 0 ? (c == 0 ? cs : sn) : (c == 0 ? -sn : cs); }
        else { const int h = n >> 7, k2 = (n >> 1) & 63, cp = n & 1, hp = k >> 7, t2 = (k >> 1) & 63, c = k & 1; const float rev = (float)((k2 * t2) & 63) * (1.f / 64.f);
            const float cs = __builtin_amdgcn_cosf(rev), sn = __builtin_amdgcn_sinf(rev); v = (h != hp) ? 0.f : (cp == 0 ? (c == 0 ? cs : sn) : (c == 0 ? -sn : cs)); }
        WLP(0, WO_TAB)[i] = (bf16)f2bf(v);
    }
    for (long i = F.gtid; i < 4096; i += F.NT) ((float*)(A.ws + WS_W + WO_TAB + 262144))[i] = log1pf(expf(-A.in[19][i]));
    f32x4* XA = WSP(f32x4, WS_XALL);
    for (long i = F.gtid; i < (long)MROWS * 256; i += F.NT) {
        const int R = (int)(i >> 8), c4 = (int)(i & 255), b = R / TPB, p = R % TPB;
        const f32x4* src = (p < CTX) ? (const f32x4*)(A.in[2] + ((size_t)b * CTX + p) * 1024) : (const f32x4*)(A.in[0] + ((size_t)b * SEQ + (p - CTX)) * 1024);
        XA[i] = src[c4];
    }
}

__device__ __forceinline__ void norm_mod_row(const f32x4 (&v)[4], const float* g, const float* sc, const float* sh, bf16* orow, int lane) {
    float s = 0.f;
#pragma unroll
    for (int j = 0; j < 4; ++j) s += (v[j].x * v[j].x + v[j].y * v[j].y) + (v[j].z * v[j].z + v[j].w * v[j].w);
    const float rs = rsqrtf(wave_sum(s) * (1.f / 1024.f) + EPS);
#pragma unroll
    for (int j = 0; j < 4; ++j) { const int c = 4 * lane + 256 * j;
        const f32x4 gg = *(const f32x4*)(g + c), s1 = *(const f32x4*)(sc + c), s0 = *(const f32x4*)(sh + c);
        const float y0 = v[j].x * rs * gg.x * (1.f + s1.x) + s0.x, y1 = v[j].y * rs * gg.y * (1.f + s1.y) + s0.y, y2 = v[j].z * rs * gg.z * (1.f + s1.z) + s0.z, y3 = v[j].w * rs * gg.w * (1.f + s1.w) + s0.w;
        *(unsigned long long*)(orow + c) = (unsigned long long)pk2(y0, y1) | ((unsigned long long)pk2(y2, y3) << 32); }
}
__device__ __forceinline__ void ph_norm1(const Frame& F, const Args& A, int l) {
    const float* X = WSP(float, WS_XALL); bf16* H = WSP(bf16, WS_H);
    for (int R = F.gw; R < MROWS; R += F.NGW) {
        const int b = R / TPB, p = R % TPB, s = (p < CTX) ? 2 : b;
        f32x4 v[4];
#pragma unroll
        for (int j = 0; j < 4; ++j) v[j] = *(const f32x4*)(X + (size_t)R * 1024 + 4 * F.lane + 256 * j);
        norm_mod_row(v, A.in[6] + l * 1024, MODP(l, s, 1), MODP(l, s, 0), H + (size_t)R * 1024, F.lane);
    }
}

__device__ __forceinline__ void ph_uelem(const Frame& F, const Args& A, int l) {
    const float* U = WSP(float, WS_U);
    bf16 *Kb = WSP(bf16, WS_KB), *Vb = WSP(bf16, WS_VB), *Qb = WSP(bf16, WS_QB), *LXb = WSP(bf16, WS_LXB), *GLG = WSP(bf16, WS_GLG), *ZP = WSP(bf16, WS_ZP), *GT = WSP(bf16, WS_GATES);
    LAS float* sF = (LAS float*)F.lds; LAS float* sT = sF + 1024;
    if (F.tid < 256) sT[F.tid] = cospif((float)F.tid / 128.0f);
    __syncthreads();
    for (int R = F.bid; R < MROWS; R += F.G) {
        const float* u = U + (size_t)R * INW; const int p = R % TPB; const bool lat = p >= CTX; const int t = p - CTX;
        for (int gi = F.wave; gi < 32; gi += 8) {
            const bool isq = gi >= 16; const int grp = gi & 15;
            const float v = u[(isq ? COL_Q : COL_K) + grp * 64 + F.lane];
            const float ss = wave_sum(v * v);
            float y = v * rsqrtf(ss * (1.f / 64.f) + EPS) * (isq ? A.in[8] : A.in[9])[l * 64 + F.lane];
            const float part = sx<16>(y);
            if (lat) { const int axis = F.lane >> 5, hf = (F.lane >> 4) & 1, f = F.lane & 15;
                const float pos = (float)(axis ? (t & 63) : (t >> 6)); const float inv = exp2f(-(float)f * (13.287712379549449f / 16.f));
                float sn, cs; sincosf(pos * inv, &sn, &cs);
                y = hf ? (part * sn + y * cs) : (y * cs - part * sn); }
            if (isq) y *= QSCALE;
            (isq ? Qb : Kb)[(size_t)R * 1024 + grp * 64 + F.lane] = (bf16)f2bf(y);
        }
        for (int c = F.tid; c < 1024; c += 512) { const size_t o = (size_t)R * 1024 + c;
            Vb[o] = (bf16)f2bf(u[COL_V + c]); LXb[o] = (bf16)f2bf(u[COL_LX + c]); GLG[o] = (bf16)f2bf(gelu_tanh(u[COL_LG + c])); sF[c] = u[COL_F + c]; }
        for (int c = F.tid; c < 3072; c += 512) GT[(size_t)R * 3072 + c] = (bf16)f2bf(sigmoidf_(u[COL_G + c]));
        __syncthreads();
        for (int o = F.tid; o < 1024; o += 512) { const int g = o >> 8, oo = o & 255; int j = oo >> 1, odd = oo & 1; if (oo == 1) { j = 128; odd = 0; }
            const int m0 = odd ? 192 : 0; float acc = 0.f;
            for (int c = 0; c < 256; ++c) acc += sF[g * 256 + c] * sT[(j * c + m0) & 255];
            ZP[(size_t)R * 1024 + o] = (bf16)f2bf(acc); }
        __syncthreads();
    }
}

__device__ __forceinline__ void ph_conv(const Frame& F, const Args& A, int l) {
    const bf16* LXb = WSP(bf16, WS_LXB); bf16* UC = WSP(bf16, WS_UC);
    const float* cw = A.in[13] + l * 4096; const float* cb = A.in[14] + l * 1024;
    for (long i = F.gtid; i < (long)MROWS * 1024; i += F.NT) {
        const int R = (int)(i >> 10), ch = (int)(i & 1023), p = R % TPB; const int lo = p < CTX ? 0 : CTX, hi = p < CTX ? CTX : TPB;
        float acc = cb[ch];
#pragma unroll
        for (int j = 0; j < 4; ++j) { const int pp = p + j - 2; if (pp >= lo && pp < hi) acc += cw[j * 1024 + ch] * bf2f(LXb[(size_t)(R + j - 2) * 1024 + ch]); }
        UC[i] = (bf16)f2bf(acc);
    }
}
#if !FAST_LRU
__device__ __forceinline__ void ph_lrucoef(const Frame& F, const Args& A, int l) {
    const bf16* UC = WSP(bf16, WS_UC); unsigned* AB = WSP(unsigned, WS_AB);
    for (long i = F.gtid; i < 2L * MROWS * 1024; i += F.NT) {
        const int d = (int)(i / ((long)MROWS * 1024)); const long rem = i % ((long)MROWS * 1024); const int R = (int)(rem >> 10), ch = (int)(rem & 1023), blk = ch >> 6, e = ch & 63;
        const float* wa = A.in[15] + ((size_t)(l * 2 + d) * 16 + blk) * 4096 + e; const float* wi = A.in[17] + ((size_t)(l * 2 + d) * 16 + blk) * 4096 + e;
        float r = A.in[16][(l * 2 + d) * 1024 + ch], ig = A.in[18][(l * 2 + d) * 1024 + ch];
        const bf16* ur = UC + (size_t)R * 1024 + blk * 64;
        for (int dd = 0; dd < 64; ++dd) { const float x = bf2f(ur[dd]); r += x * wa[dd * 64]; ig += x * wi[dd * 64]; }
        const float lam = A.in[19][(l * 2 + d) * 1024 + ch]; const float sp = log1pf(expf(-lam));
        const float la = -8.f * sigmoidf_(r) * sp; const float mult = sqrtf(-expm1f(2.f * la));
        const float bc = mult * sigmoidf_(ig) * bf2f(ur[e]);
        AB[i] = pk2(la, bc);
    }
}
#endif
struct LruSched {
    const char* uc; const char* w; int G, c;
    __device__ __forceinline__ bool next(int i, pg8::UnitG& U) const {
        const long id = (long)i * G + c; if (id >= 66 * 16) return false;
        const int pm = (int)(id >> 4), pn = (int)(id & 15);
        U.a = uc + ((size_t)pm * 256 * 1024 + 256 * ((pn & 7) >> 1)) * 2; U.b = w + (size_t)pn * 256 * 256 * 2; U.row0 = pm * 256; U.pn = pn; U.e = 0; U.valid = 256; U.rows = nullptr; return true;
    }
};
struct EpiLru {
    static constexpr bool PERM = false;
    unsigned* AB; const bf16* UC; const float* ba; const float* bi; const float* sp;
    __device__ __forceinline__ void operator()(const f32x4 (&acc)[2][2][4][2], const pg8::UnitG& u, int wr, int wc, int fr, int fq) const {
        const int d = u.pn >> 3, cb = u.pn & 7, ch0 = 128 * cb + wc * 32 + 4 * fq;
        f32x4 vba[2], vbi[2], vsp[2];
#pragma unroll
        for (int n = 0; n < 2; ++n) { vba[n] = *(const f32x4*)(ba + d * 1024 + ch0 + 16 * n); vbi[n] = *(const f32x4*)(bi + d * 1024 + ch0 + 16 * n); vsp[n] = *(const f32x4*)(sp + d * 1024 + ch0 + 16 * n); }
#pragma unroll
        for (int ai = 0; ai < 2; ++ai)
#pragma unroll
            for (int m = 0; m < 4; ++m) { const size_t R = (size_t)u.row0 + ai * 128 + wr * 64 + m * 16 + fr;
#pragma unroll
                for (int n = 0; n < 2; ++n) { const int ch = ch0 + 16 * n;
                    const unsigned long long ux = *(const unsigned long long*)(UC + R * 1024 + ch);
                    const float x[4] = {bf2f((unsigned)ux & 0xffffu), bf2f(((unsigned)ux) >> 16), bf2f((unsigned)(ux >> 32) & 0xffffu), bf2f((unsigned)(ux >> 48))};
                    const f32x4 r = acc[ai][0][m][n] + vba[n], g = acc[ai][1][m][n] + vbi[n]; v4u o;
#pragma unroll
                    for (int e = 0; e < 4; ++e) { const float la = -8.f * sigmoidf_(r[e]) * vsp[n][e]; const float mult = sqrtf(fmaxf(1.f - __expf(2.f * la), 0.f));
                        o[e] = pk2(la, mult * sigmoidf_(g[e]) * x[e]); }
                    *(v4u*)(AB + ((size_t)d * MROWS + R) * 1024 + ch) = o; }
                asm volatile("" ::: "memory"); }
    }
};
__device__ __forceinline__ void ph_lru_gemm(const Frame& F, const Args& A, int l) {
    const int vcu = (F.G % 8 == 0) ? (F.bid % 8) * (F.G / 8) + F.bid / 8 : F.bid;
    LruSched S{(const char*)WSP(bf16, WS_UC), (const char*)WLP(l, WO_LRU), F.G, vcu};
    EpiLru E{WSP(unsigned, WS_AB), WSP(bf16, WS_UC), A.in[16] + l * 2048, A.in[18] + l * 2048, (const float*)(A.ws + WS_W + WO_TAB + 262144) + l * 2048};
    pg8::gemm_phase_g<EpiLru, LruSched, false>(F.lds, 256, 1024, 256, S, E);
}
struct FftSched {
    const char* x; const char* w; int nunits, G, c;
    __device__ __forceinline__ bool next(int i, pg8::UnitG& U) const {
        const long id = (long)i * G + c; if (id >= nunits) return false;
        U.a = x + (size_t)id * 256 * 256 * 2; U.b = w; U.row0 = (int)id * 256; U.pn = 0; U.e = 0; U.valid = 256; U.rows = nullptr; return true;
    }
};
struct EpiFftA {
    static constexpr bool PERM = false;
    unsigned* XB;
    __device__ __forceinline__ void operator()(const f32x4 (&acc)[2][2][4][2], const pg8::UnitG& u, int wr, int wc, int fr, int fq) const {
#pragma unroll
        for (int ai = 0; ai < 2; ++ai)
#pragma unroll
            for (int m = 0; m < 4; ++m) { int r0 = u.row0; asm volatile("" : "+s"(r0));
                const int row = r0 + ai * 128 + wr * 64 + m * 16 + fr, t2 = row & 63; const size_t bc = (size_t)(row >> 6);
#pragma unroll
                for (int bj = 0; bj < 2; ++bj)
#pragma unroll
                    for (int n = 0; n < 2; ++n) { const int k1 = 64 * bj + 16 * wc + 8 * n + 2 * fq; const f32x4 v = acc[ai][bj][m][n];
#pragma unroll
                        for (int q = 0; q < 2; ++q) { const int kk = k1 + q; const float rev = (float)(kk * t2) * (1.f / 8192.f);
                            const float cs = __builtin_amdgcn_cosf(rev), sn = __builtin_amdgcn_sinf(rev); const float yr = v[2 * q], yi = v[2 * q + 1];
                            XB[(bc * 64 + (kk >> 1)) * 128 + (kk & 1) * 64 + t2] = pk2(yr * cs + yi * sn, yi * cs - yr * sn); } }
                asm volatile("" ::: "memory"); }
    }
};
struct EpiBf16Plain {
    static constexpr bool PERM = true;
    bf16* C; int ldc;
    __device__ __forceinline__ void operator()(const f32x4 (&acc)[2][2][4][2], const pg8::UnitG& u, int wr, int wc, int fr, int fq) const {
#pragma unroll
        for (int ai = 0; ai < 2; ++ai)
#pragma unroll
            for (int m = 0; m < 4; ++m) { bf16* rowp = C + (size_t)(u.row0 + ai * 128 + wr * 64 + m * 16 + fr) * ldc + u.pn * 256 + wc * 32 + 8 * fq;
#pragma unroll
                for (int bj = 0; bj < 2; ++bj) { const f32x4 v0 = acc[ai][bj][m][0], v1 = acc[ai][bj][m][1];
                    v4u o; o.x = pk2(v0[0], v0[1]); o.y = pk2(v0[2], v0[3]); o.z = pk2(v1[0], v1[1]); o.w = pk2(v1[2], v1[3]);
                    *(v4u*)(rowp + bj * 128) = o; } }
    }
};
__device__ __forceinline__ void ph_fft_a_gemm(const Frame& F, const Args& A) {
    FftSched S{(const char*)WSP(bf16, WS_XA), (const char*)WLP(0, WO_TAB), 256, F.G, F.bid};
    EpiFftA E{WSP(unsigned, WS_XB)};
    pg8::gemm_phase_g<EpiFftA, FftSched, false>(F.lds, 256, 256, 256, S, E);
}
__device__ __forceinline__ void ph_fft_b_gemm(const Frame& F, const Args& A) {
    FftSched S{(const char*)WSP(bf16, WS_XB), (const char*)(WLP(0, WO_TAB) + 65536), 256, F.G, F.bid};
    EpiBf16Plain E{WSP(bf16, WS_GB), 256};
    pg8::gemm_phase_g<EpiBf16Plain, FftSched, false>(F.lds, 256, 256, 256, S, E);
}
__device__ __forceinline__ void ph_scan1(const Frame& F, const Args& A) {
    const unsigned* AB = WSP(unsigned, WS_AB); float2* SUMM = WSP(float2, WS_SUMM);
    for (int it = F.gw; it < NB * 2 * NCHUNK * 16; it += F.NGW) {
        const int cg = it & 15, ck = (it >> 4) % NCHUNK, bd = (it >> 4) / NCHUNK, b = bd >> 1, d = bd & 1, ch = cg * 64 + F.lane;
        const unsigned* ab = AB + ((size_t)d * MROWS + (size_t)b * TPB + ck * 64) * 1024 + ch;
        float ac = 1.f, h = 0.f;
#pragma unroll 8
        for (int i = 0; i < 64; ++i) { const int ii = d ? 63 - i : i; const unsigned w = ab[(size_t)ii * 1024]; const float a = __expf(bf2f(w & 0xffffu)); h = a * h + bf2f(w >> 16); ac *= a; }
        SUMM[((size_t)bd * NCHUNK + ck) * 1024 + ch] = make_float2(ac, h);
    }
}
__device__ __forceinline__ void ph_scan2(const Frame& F, const Args& A) {
    const float2* SUMM = WSP(float2, WS_SUMM); float* CARRY = WSP(float, WS_CARRY);
    if (F.gtid < 4096) {
        const int bd = (int)(F.gtid >> 10), ch = (int)(F.gtid & 1023), d = bd & 1; float h = 0.f;
        for (int s = 0; s < NCHUNK; ++s) { const int ck = d ? (s < 4 ? 3 - s : NCHUNK + 3 - s) : s;
            const size_t o = ((size_t)bd * NCHUNK + ck) * 1024 + ch; CARRY[o] = h; const float2 v = SUMM[o]; h = v.x * h + v.y; }
    }
}
__device__ __forceinline__ void ph_scan3(const Frame& F, const Args& A) {
    const unsigned* AB = WSP(unsigned, WS_AB); const float* CARRY = WSP(float, WS_CARRY); const bf16* GLG = WSP(bf16, WS_GLG); bf16* MX = WSP(bf16, WS_MIXIN);
    for (int it = F.gw; it < NB * NCHUNK * 16; it += F.NGW) {
        const int cg = it & 15, ck = (it >> 4) % NCHUNK, b = (it >> 4) / NCHUNK, ch = cg * 64 + F.lane; const size_t R0 = (size_t)b * TPB + ck * 64;
        const unsigned* ab0 = AB + R0 * 1024 + ch; const unsigned* ab1 = AB + ((size_t)MROWS + R0) * 1024 + ch;
        float hf[64]; float h = CARRY[((size_t)(b * 2 + 0) * NCHUNK + ck) * 1024 + ch];
#pragma unroll
        for (int i = 0; i < 64; ++i) { const unsigned w = ab0[(size_t)i * 1024]; h = __expf(bf2f(w & 0xffffu)) * h + bf2f(w >> 16); hf[i] = h; }
        h = CARRY[((size_t)(b * 2 + 1) * NCHUNK + ck) * 1024 + ch];
#pragma unroll
        for (int i = 63; i >= 0; --i) { const unsigned w = ab1[(size_t)i * 1024]; h = __expf(bf2f(w & 0xffffu)) * h + bf2f(w >> 16);
            MX[(R0 + i) * 3072 + 1024 + ch] = (bf16)f2bf((hf[i] + h) * bf2f(GLG[(R0 + i) * 1024 + ch])); }
    }
}

__device__ __forceinline__ void ph_fft_t1_fast(const Frame& F, const Args& A) {
    const unsigned* ZP = WSP(unsigned, WS_ZP); unsigned* XA = WSP(unsigned, WS_XA); LAS unsigned* T = (LAS unsigned*)F.lds;
    for (int item = F.bid; item < 512; item += F.G) {
        const int b = item >> 8, t2 = (item >> 2) & 63, cq = item & 3;
        __syncthreads();
#pragma unroll
        for (int i = 0; i < 8; ++i) { const int p = F.tid + 512 * i, t1 = p >> 5, w4 = (p & 31) * 4;
            const v4u v = *(const v4u*)(ZP + ((size_t)b * TPB + CTX + 64 * t1 + t2) * 512 + cq * 128 + w4);
            T[t1 * 129 + w4] = v.x; T[t1 * 129 + w4 + 1] = v.y; T[t1 * 129 + w4 + 2] = v.z; T[t1 * 129 + w4 + 3] = v.w; }
        __syncthreads();
#pragma unroll
        for (int i = 0; i < 16; ++i) { const int p = F.tid + 512 * i, cc = p >> 6, t1 = (p & 63) * 2;
            const unsigned long long v = (unsigned long long)T[t1 * 129 + cc] | ((unsigned long long)T[(t1 + 1) * 129 + cc] << 32);
            *(unsigned long long*)(XA + (((size_t)b * 512 + cq * 128 + cc) * 64 + t2) * 128 + t1) = v; }
    }
    __syncthreads();
}
__device__ __forceinline__ void ph_fft_t2_fast(const Frame& F, const Args& A) {
    const unsigned* GB = WSP(unsigned, WS_GB); bf16* MX = WSP(bf16, WS_MIXIN); LAS unsigned* T = (LAS unsigned*)F.lds;
    for (int item = F.bid; item < 2 * 65 * 4; item += F.G) {
        const int b = item / 260, rem = item % 260, kp = rem >> 2, g = rem & 3, k1a = kp, k1b = (128 - kp) & 127;
        __syncthreads();
#pragma unroll
        for (int i = 0; i < 8; ++i) { const int p = F.tid + 512 * i, blk = p >> 11, cc = (p >> 4) & 127, w4 = (p & 15) * 4, kk = blk ? k1b : k1a;
            const v4u v = *(const v4u*)(GB + (((size_t)b * 512 + g * 128 + cc) * 64 + (kk >> 1)) * 128 + (kk & 1) * 64 + w4);
            LAS unsigned* d = T + blk * (128 * 65) + cc * 65 + w4; d[0] = v.x; d[1] = v.y; d[2] = v.z; d[3] = v.w; }
        __syncthreads();
        const int jc = F.tid & 255, j = (jc == 0 || jc == 128) ? 0 : (jc < 128 ? jc : 256 - jc);
        const int nset = (k1a == k1b) ? 1 : 2;
        for (int r = (F.tid >> 8); r < nset * 64; r += 2) { const int set = r >> 6, k2 = r & 63, ka = set ? k1b : k1a;
            const int mk2 = (ka == 0) ? ((64 - k2) & 63) : 63 - k2;
            const unsigned own = T[set * (128 * 65) + j * 65 + k2], mir = T[(nset == 1 ? 0 : (1 - set)) * (128 * 65) + j * 65 + mk2];
            float o; if (jc == 0) o = 0.5f * (bf2f(own & 0xffffu) + bf2f(mir & 0xffffu)); else if (jc == 128) o = 0.5f * (bf2f(own >> 16) + bf2f(mir >> 16)); else if (jc < 128) o = bf2f(mir & 0xffffu); else o = bf2f(own & 0xffffu);
            MX[((size_t)b * TPB + CTX + ka + 128 * k2) * 3072 + 2048 + g * 256 + jc] = (bf16)f2bf(o * 6.9053396600248786e-4f); }
    }
    __syncthreads();
    const float2* GC = WSP(float2, WS_GC);
    for (long i = F.gtid; i < (long)NB * CTX * 1024; i += F.NT) {
        const int col = (int)(i & 1023), k = (int)((i >> 10) & 255), b = (int)(i >> 18), g = col >> 8, jc = col & 255, km = (256 - k) & 255;
        const int j = (jc == 0 || jc == 128) ? 0 : (jc < 128 ? jc : 256 - jc); const size_t base = ((size_t)b * 512 + g * 128 + j) * 256;
        const float2 w = GC[base + k], wm = GC[base + km];
        float o; if (jc == 0) o = 0.5f * (w.x + wm.x); else if (jc == 128) o = 0.5f * (w.y + wm.y); else if (jc < 128) o = wm.x; else o = w.x;
        MX[((size_t)b * TPB + k) * 3072 + 2048 + col] = (bf16)f2bf(o * 3.90625e-3f);
    }
}
__device__ __forceinline__ void ph_scan2_fast(const Frame& F, const Args& A) {
    const float2* SUMM = WSP(float2, WS_SUMM); float* CARRY = WSP(float, WS_CARRY);
    for (int it = F.gw; it < 256; it += F.NGW) {
        const int bd = it >> 6, d = bd & 1, ch = (it & 63) * 16 + (F.lane & 15), seg = F.lane >> 4;
        float2 v[33]; float as = 1.f, hs = 0.f;
#pragma unroll
        for (int q = 0; q < 33; ++q) { const int sidx = seg * 33 + q, ck = d ? (sidx < 4 ? 3 - sidx : NCHUNK + 3 - sidx) : sidx; v[q] = SUMM[((size_t)bd * NCHUNK + ck) * 1024 + ch]; }
#pragma unroll
        for (int q = 0; q < 33; ++q) { hs = v[q].x * hs + v[q].y; as *= v[q].x; }
        const float a16 = sx<16>(as), h16 = sx<16>(hs), a32 = sx<32>(as), h32 = sx<32>(hs), a48 = sx<32>(a16), h48 = sx<32>(h16);
        float h = 0.f;
#pragma unroll
        for (int jx = 0; jx < 3; ++jx) { const int x = jx ^ seg;
            const float aj = x == 0 ? as : (x == 1 ? a16 : (x == 2 ? a32 : a48)), hj = x == 0 ? hs : (x == 1 ? h16 : (x == 2 ? h32 : h48));
            if (jx < seg) h = aj * h + hj; }
#pragma unroll
        for (int q = 0; q < 33; ++q) { const int sidx = seg * 33 + q, ck = d ? (sidx < 4 ? 3 - sidx : NCHUNK + 3 - sidx) : sidx; CARRY[((size_t)bd * NCHUNK + ck) * 1024 + ch] = h; h = v[q].x * h + v[q].y; }
    }
}

__device__ __forceinline__ void ph_fft_t1(const Frame& F, const Args& A) {
    const unsigned* ZP = WSP(unsigned, WS_ZP); unsigned* XA = WSP(unsigned, WS_XA);
    for (long i = F.gtid; i < (long)NB * 512 * 8192; i += F.NT) {
        const int t1 = (int)(i & 127), t2 = (int)((i >> 7) & 63), cc = (int)((i >> 13) & 511), b = (int)(i >> 22);
        XA[i] = ZP[((size_t)b * TPB + CTX + 64 * t1 + t2) * 512 + cc];
    }
}
#if !FAST_FFT
__device__ __forceinline__ void ph_fft_a(const Frame& F, const Args& A) {
    const unsigned* XA = WSP(unsigned, WS_XA); unsigned* XB = WSP(unsigned, WS_XB);
    for (long i = F.gtid; i < (long)NB * 512 * 8192; i += F.NT) {
        const int k1 = (int)(i & 127); const long row = i >> 7; const int t2 = (int)(row & 63); const long bc = row >> 6;
        const unsigned* x = XA + row * 128; float yr = 0.f, yi = 0.f;
        for (int t1 = 0; t1 < 128; ++t1) { const unsigned w = x[t1]; const float wr = bf2f(w & 0xffffu), wi = bf2f(w >> 16);
            float sn, cs; sincospif((float)((k1 * t1) & 127) / 64.0f, &sn, &cs);
            yr += wr * cs + wi * sn; yi += wi * cs - wr * sn; }
        float sn, cs; sincospif((float)(k1 * t2) / 4096.0f, &sn, &cs);
        const float zr = yr * cs + yi * sn, zi = yi * cs - yr * sn;
        XB[(bc * 64 + (k1 >> 1)) * 128 + (k1 & 1) * 64 + t2] = pk2(zr, zi);
    }
}
#endif
#if !FAST_FFT
__device__ __forceinline__ void ph_fft_b(const Frame& F, const Args& A) {
    const unsigned* XB = WSP(unsigned, WS_XB); unsigned* GB = WSP(unsigned, WS_GB);
    for (long i = F.gtid; i < (long)NB * 512 * 8192; i += F.NT) {
        const int k2 = (int)(i & 63); const long hrow = i >> 6;
        const unsigned* x = XB + hrow * 64; float yr = 0.f, yi = 0.f;
        for (int t2 = 0; t2 < 64; ++t2) { const unsigned w = x[t2]; const float wr = bf2f(w & 0xffffu), wi = bf2f(w >> 16);
            float sn, cs; sincospif((float)((k2 * t2) & 63) / 32.0f, &sn, &cs);
            yr += wr * cs + wi * sn; yi += wi * cs - wr * sn; }
        GB[hrow * 64 + k2] = pk2(yr, yi);
    }
}
#endif
__device__ __forceinline__ void ph_fft_c(const Frame& F, const Args& A) {
    const unsigned* ZP = WSP(unsigned, WS_ZP); float2* GC = WSP(float2, WS_GC);
    LAS unsigned* Z = (LAS unsigned*)F.lds; LAS float* TWc = (LAS float*)(F.lds + 16384); LAS float* TWs = TWc + 256;
    __syncthreads();
    if (F.tid < 256) { const float rev = (float)F.tid * (1.f / 256.f); TWc[F.tid] = __builtin_amdgcn_cosf(rev); TWs[F.tid] = __builtin_amdgcn_sinf(rev); }
    for (int item = F.bid; item < 64; item += F.G) {
        const int b = item >> 5, c0 = (item & 31) * 16;
        __syncthreads();
        for (int e = F.tid; e < 4096; e += 512) Z[e] = ZP[((size_t)b * TPB + (e >> 4)) * 512 + c0 + (e & 15)];
        __syncthreads();
        const int cc = F.tid & 15, kb = (F.tid >> 4) * 8; float ar[8], ai[8]; int m[8];
#pragma unroll
        for (int q = 0; q < 8; ++q) { ar[q] = 0.f; ai[q] = 0.f; m[q] = 0; }
        for (int t = 0; t < 256; ++t) { const unsigned w = Z[t * 16 + cc]; const float wr = bf2f(w & 0xffffu), wi = bf2f(w >> 16);
#pragma unroll
            for (int q = 0; q < 8; ++q) { const float tc = TWc[m[q]], ts = TWs[m[q]]; ar[q] += wr * tc + wi * ts; ai[q] += wi * tc - wr * ts; m[q] = (m[q] + kb + q) & 255; } }
#pragma unroll
        for (int q = 0; q < 8; ++q) GC[((size_t)b * 512 + c0 + cc) * 256 + kb + q] = make_float2(ar[q], ai[q]);
    }
    __syncthreads();
}
__device__ __forceinline__ void ph_fft_t2(const Frame& F, const Args& A) {
    const unsigned* GB = WSP(unsigned, WS_GB); const float2* GC = WSP(float2, WS_GC); bf16* MX = WSP(bf16, WS_MIXIN);
    for (long i = F.gtid; i < (long)MROWS * 1024; i += F.NT) {
        const int R = (int)(i >> 10), col = (int)(i & 1023), g = col >> 8, jc = col & 255, b = R / TPB, p = R % TPB;
        const bool lat = p >= CTX; const int T = lat ? SEQ : CTX, k = lat ? p - CTX : p, km = (T - k) & (T - 1);
        const int j = (jc == 0 || jc == 128) ? 0 : (jc < 128 ? jc : 256 - jc); const int cc = g * 128 + j;
        float vr, vi, mr, mi;
        if (lat) { const size_t base = ((size_t)b * 512 + cc) * 64;
            const unsigned w = GB[(base + ((k & 127) >> 1)) * 128 + (k & 1) * 64 + (k >> 7)], wm = GB[(base + ((km & 127) >> 1)) * 128 + (km & 1) * 64 + (km >> 7)];
            vr = bf2f(w & 0xffffu); vi = bf2f(w >> 16); mr = bf2f(wm & 0xffffu); mi = bf2f(wm >> 16); }
        else { const float2 w = GC[((size_t)b * 512 + cc) * 256 + k], wm = GC[((size_t)b * 512 + cc) * 256 + km]; vr = w.x; vi = w.y; mr = wm.x; mi = wm.y; }
        float o;
        if (jc == 0) o = 0.5f * (vr + mr); else if (jc == 128) o = 0.5f * (vi + mi); else if (jc < 128) o = mr; else o = vr;
        o *= lat ? 6.9053396600248786e-4f : 3.90625e-3f;
        MX[(size_t)R * 3072 + 2048 + col] = (bf16)f2bf(o);
    }
}

#if !FAST_ATTN
__device__ __forceinline__ void ph_attn_naive(const Frame& F, const Args& A, int l) {
    const bf16 *Kb = WSP(bf16, WS_KB), *Vb = WSP(bf16, WS_VB), *Qb = WSP(bf16, WS_QB); bf16* MX = WSP(bf16, WS_MIXIN);
    const float* lq = A.in[10] + l * 256; float d01 = 0.f, d23 = 0.f;
    for (int i = 0; i < 64; ++i) { d01 += lq[i] * lq[64 + i]; d23 += lq[128 + i] * lq[192 + i]; }
    const float lam_init = 0.8f - 0.6f * expf(-0.3f * (float)l), lam = expf(d01) - expf(d23) + lam_init;
    LAS float* Ks = (LAS float*)F.lds; LAS float* Vs = Ks + 64 * 132; LAS float* Qs = Vs + 64 * 132; LAS float* Ws = Qs + 16 * 128;
    const int r = F.tid >> 5, tl = F.tid & 31;
    for (int u = F.bid; u < 16 * 528; u += F.G) {
        const int bh = u / 528, qb = u % 528, b = bh >> 3, h = bh & 7; const size_t R0 = (size_t)b * TPB + qb * 16; const int nkeys = qb < 16 ? CTX : TPB;
        __syncthreads();
        for (int e = F.tid; e < 2048; e += 512) Qs[e] = bf2f(Qb[(R0 + (e >> 7)) * 1024 + h * 128 + (e & 127)]);
        float m0 = -1e30f, l0 = 0.f, m1 = -1e30f, l1 = 0.f;
        for (int pass = 0; pass < 2; ++pass) {
            float inv0 = 0.f, inv1 = 0.f;
            if (pass == 1) {
#pragma unroll
                for (int o = 1; o < 32; o <<= 1) { float mo = __shfl_xor(m0, o), lo = __shfl_xor(l0, o), mn = fmaxf(m0, mo); l0 = l0 * exp2f(m0 - mn) + lo * exp2f(mo - mn); m0 = mn;
                    mo = __shfl_xor(m1, o); lo = __shfl_xor(l1, o); mn = fmaxf(m1, mo); l1 = l1 * exp2f(m1 - mn) + lo * exp2f(mo - mn); m1 = mn; }
                inv0 = 1.f / l0; inv1 = lam / l1;
            }
            float o4[4] = {0.f, 0.f, 0.f, 0.f};
            for (int kt = 0; kt < nkeys; kt += 64) {
                __syncthreads();
                for (int e = F.tid; e < 1024; e += 512) { const int kk = e >> 4, c8 = (e & 15) * 8; const size_t src = ((size_t)b * TPB + kt + kk) * 1024 + h * 128 + c8;
                    const v4u kv = *(const v4u*)(Kb + src);
                    Ks[kk * 132 + c8 + 0] = bf2f(kv.x & 0xffffu); Ks[kk * 132 + c8 + 1] = bf2f(kv.x >> 16); Ks[kk * 132 + c8 + 2] = bf2f(kv.y & 0xffffu); Ks[kk * 132 + c8 + 3] = bf2f(kv.y >> 16);
                    Ks[kk * 132 + c8 + 4] = bf2f(kv.z & 0xffffu); Ks[kk * 132 + c8 + 5] = bf2f(kv.z >> 16); Ks[kk * 132 + c8 + 6] = bf2f(kv.w & 0xffffu); Ks[kk * 132 + c8 + 7] = bf2f(kv.w >> 16);
                    if (pass == 1) { const v4u vv = *(const v4u*)(Vb + src);
                        Vs[kk * 132 + c8 + 0] = bf2f(vv.x & 0xffffu); Vs[kk * 132 + c8 + 1] = bf2f(vv.x >> 16); Vs[kk * 132 + c8 + 2] = bf2f(vv.y & 0xffffu); Vs[kk * 132 + c8 + 3] = bf2f(vv.y >> 16);
                        Vs[kk * 132 + c8 + 4] = bf2f(vv.z & 0xffffu); Vs[kk * 132 + c8 + 5] = bf2f(vv.z >> 16); Vs[kk * 132 + c8 + 6] = bf2f(vv.w & 0xffffu); Vs[kk * 132 + c8 + 7] = bf2f(vv.w >> 16); } }
                __syncthreads();
#pragma unroll
                for (int kq = 0; kq < 2; ++kq) { const int kk = tl + 32 * kq; float s0 = 0.f, s1 = 0.f;
                    for (int d = 0; d < 64; d += 4) { const f32x4 q0 = *(const LAS f32x4*)(Qs + r * 128 + d), q1 = *(const LAS f32x4*)(Qs + r * 128 + 64 + d), k0 = *(const LAS f32x4*)(Ks + kk * 132 + d), k1 = *(const LAS f32x4*)(Ks + kk * 132 + 64 + d);
                        s0 += q0.x * k0.x + q0.y * k0.y + q0.z * k0.z + q0.w * k0.w; s1 += q1.x * k1.x + q1.y * k1.y + q1.z * k1.z + q1.w * k1.w; }
                    if (pass == 0) { float mn = fmaxf(m0, s0); l0 = l0 * exp2f(m0 - mn) + exp2f(s0 - mn); m0 = mn; mn = fmaxf(m1, s1); l1 = l1 * exp2f(m1 - mn) + exp2f(s1 - mn); m1 = mn; }
                    else Ws[r * 64 + kk] = exp2f(s0 - m0) * inv0 - exp2f(s1 - m1) * inv1; }
                if (pass == 1) { __syncthreads();
                    for (int kk = 0; kk < 64; ++kk) { const float w = Ws[r * 64 + kk];
#pragma unroll
                        for (int i = 0; i < 4; ++i) o4[i] += w * Vs[kk * 132 + tl + 32 * i]; } }
            }
            if (pass == 1) { float ss = o4[0] * o4[0] + o4[1] * o4[1] + o4[2] * o4[2] + o4[3] * o4[3];
#pragma unroll
                for (int o = 1; o < 32; o <<= 1) ss += __shfl_xor(ss, o);
                const float sc = rsqrtf(ss * (1.f / 128.f) + EPS) * (1.f - lam_init);
#pragma unroll
                for (int i = 0; i < 4; ++i) MX[(R0 + r) * 3072 + h * 128 + tl + 32 * i] = (bf16)f2bf(o4[i] * sc * A.in[11][l * 128 + tl + 32 * i]); }
        }
    }
}

#endif
namespace da {
using bf16x8 = __attribute__((ext_vector_type(8))) short;
using s16x4  = __attribute__((ext_vector_type(4))) short;
using f32x16 = __attribute__((ext_vector_type(16))) float;
using u32x4  = __attribute__((ext_vector_type(4))) unsigned;
constexpr int KVBLK = 64, LDK = 1024;
constexpr size_t SHM_V = KVBLK * 128 * 2, SHM_K = KVBLK * 128 * 2;
constexpr float THR = 8.f;
#define DA_KSWZ(row, colB) ((row) * 256 + ((colB) ^ (((row) & 7) << 4)))
#define DA_SBAR() __builtin_amdgcn_sched_barrier(0)
__device__ __forceinline__ int crow(int r, int hi) { return (r & 3) + 8 * (r >> 2) + 4 * hi; }
__device__ __forceinline__ unsigned cvtpk(float lo, float hi) { unsigned r; asm volatile("v_cvt_pk_bf16_f32 %0, %1, %2" : "=v"(r) : "v"(lo), "v"(hi)); return r; }
__device__ __forceinline__ void expSM(f32x16& p0, f32x16& p1, float soff) {
  for (int r = 0; r < 16; ++r) p0[r] = __builtin_amdgcn_exp2f(p0[r] - soff); for (int r = 0; r < 16; ++r) p1[r] = __builtin_amdgcn_exp2f(p1[r] - soff);
}
__device__ __forceinline__ void finishSM(f32x16& p0, f32x16& p1, float& l_reg, bf16x8& pa0, bf16x8& pa1, bf16x8& pa2, bf16x8& pa3) {
  float ps = 0; for (int r = 0; r < 16; ++r) ps += p0[r]; for (int r = 0; r < 16; ++r) ps += p1[r];
  l_reg += ps;
#define DA_PK4(P, BASE, OUT) do { unsigned a0 = cvtpk(P[BASE + 0], P[BASE + 1]), a1 = cvtpk(P[BASE + 2], P[BASE + 3]);   \
    unsigned b0 = cvtpk(P[BASE + 4], P[BASE + 5]), b1 = cvtpk(P[BASE + 6], P[BASE + 7]);                              \
    auto r0 = __builtin_amdgcn_permlane32_swap(a0, b0, false, false); auto r1 = __builtin_amdgcn_permlane32_swap(a1, b1, false, false); \
    u32x4 w = {r0[0], r1[0], r0[1], r1[1]}; OUT = *reinterpret_cast<bf16x8*>(&w); } while (0)
  DA_PK4(p0, 0, pa0); DA_PK4(p0, 8, pa1); DA_PK4(p1, 0, pa2); DA_PK4(p1, 8, pa3);
#undef DA_PK4
}
__device__ __forceinline__ void qkt(f32x16& p0, f32x16& p1, const char* Ks, const bf16x8* qr, int r32, int hi, int cbm) {
  p0 = f32x16{}; p1 = f32x16{};
#pragma unroll
  for (int d0 = 0; d0 < 4; ++d0) { const int cb = cbm + (d0 * 16 + hi * 8) * 2;
    bf16x8 b0 = *reinterpret_cast<const bf16x8*>(Ks + DA_KSWZ(r32, cb));
    bf16x8 b1 = *reinterpret_cast<const bf16x8*>(Ks + DA_KSWZ(32 + r32, cb));
    p0 = __builtin_amdgcn_mfma_f32_32x32x16_bf16(b0, qr[d0], p0, 0, 0, 0);
    p1 = __builtin_amdgcn_mfma_f32_32x32x16_bf16(b1, qr[d0], p1, 0, 0, 0); }
}
__device__ __forceinline__ int v_st(int k, int c) { const int kk = (k & ~0xC) | ((k & 4) << 1) | ((k & 8) >> 1); return ((kk >> 3) * 4 + (c >> 5)) * 512 + ((kk & 7) * 32 + (c & 31)) * 2; }
__device__ __forceinline__ int v_rd_base(int lane) { return ((lane & 3) << 3) | (((lane >> 2) & 3) << 6) | (((lane >> 4) & 1) << 5) | (((lane >> 5) & 1) << 8); }
constexpr int v_rd_off(int d0, int ks, int half) { return d0 * 512 + ks * 4096 + half * 2048; }
template <int OFF> __device__ __forceinline__ s16x4 tr_read(int vb) {
  s16x4 r; asm volatile("ds_read_b64_tr_b16 %0, %1 offset:%2" : "=&v"(r) : "v"(vb), "i"(OFF) : "memory"); return r;
}
template <int D0> __device__ __forceinline__ void pv_one(f32x16& od, int vb, bf16x8 pa0, bf16x8 pa1, bf16x8 pa2, bf16x8 pa3) {
  const s16x4 l0 = tr_read<v_rd_off(D0, 0, 0)>(vb), h0 = tr_read<v_rd_off(D0, 0, 1)>(vb), l1 = tr_read<v_rd_off(D0, 1, 0)>(vb), h1 = tr_read<v_rd_off(D0, 1, 1)>(vb);
  const s16x4 l2 = tr_read<v_rd_off(D0, 2, 0)>(vb), h2 = tr_read<v_rd_off(D0, 2, 1)>(vb), l3 = tr_read<v_rd_off(D0, 3, 0)>(vb), h3 = tr_read<v_rd_off(D0, 3, 1)>(vb);
  asm volatile("s_waitcnt lgkmcnt(0)" ::: "memory"); DA_SBAR();
#define DA_PK(L, H) (bf16x8){L[0], L[1], L[2], L[3], H[0], H[1], H[2], H[3]}
  od = __builtin_amdgcn_mfma_f32_32x32x16_bf16(pa0, DA_PK(l0, h0), od, 0, 0, 0);
  od = __builtin_amdgcn_mfma_f32_32x32x16_bf16(pa1, DA_PK(l1, h1), od, 0, 0, 0);
  od = __builtin_amdgcn_mfma_f32_32x32x16_bf16(pa2, DA_PK(l2, h2), od, 0, 0, 0);
  od = __builtin_amdgcn_mfma_f32_32x32x16_bf16(pa3, DA_PK(l3, h3), od, 0, 0, 0);
#undef DA_PK
}
__device__ __forceinline__ void pv_d0(f32x16* o, int vb, bf16x8 pa0, bf16x8 pa1, bf16x8 pa2, bf16x8 pa3) {
  pv_one<0>(o[0], vb, pa0, pa1, pa2, pa3); pv_one<1>(o[1], vb, pa0, pa1, pa2, pa3); pv_one<2>(o[2], vb, pa0, pa1, pa2, pa3); pv_one<3>(o[3], vb, pa0, pa1, pa2, pa3);
}
__device__ __forceinline__ void unit(const unsigned short* __restrict__ Qb, const unsigned short* __restrict__ Kh, const unsigned short* __restrict__ Vh,
                                     unsigned short* __restrict__ Ob, int ldo, int seq, float lam, float oscale, float soff, const float* __restrict__ subg, char* lds) {
  const int tid = otid(), wid = tid >> 6, lane = tid & 63, r32 = lane & 31, hi = lane >> 5, mp = wid >> 2, wq = wid & 3;
  char* V_lds = lds; char* K_lds = lds + 2 * SHM_V;
  float* ws = (float*)(lds + 2 * SHM_V + 2 * SHM_K) + wid * 64; float* li_l = ws;
  float l_reg = 0; f32x16 o[4] = {}; bf16x8 qr[4];
  const unsigned short* Qw = Qb + (long)(wq * 32 + r32) * 1024 + mp * 64 + hi * 8;
#pragma unroll
  for (int d0 = 0; d0 < 4; ++d0) qr[d0] = *reinterpret_cast<const bf16x8*>(Qw + d0 * 16);
  const int cbm = mp * 128;
  const int sr = tid >> 4, sc = (tid & 15) * 8, vst0 = v_st(sr, sc), vst1 = v_st(32 + sr, sc);
  const int vb0 = (int)(uintptr_t)V_lds + v_rd_base(lane);
  struct { bf16x8 vs0, vs1, ks0, ks1; } sr_[2];
#define DA_SLOAD(i, k0) do { sr_[i].vs0 = *reinterpret_cast<const bf16x8*>(&Vh[(long)((k0) + sr) * LDK + sc]); sr_[i].vs1 = *reinterpret_cast<const bf16x8*>(&Vh[(long)((k0) + 32 + sr) * LDK + sc]); \
    sr_[i].ks0 = *reinterpret_cast<const bf16x8*>(&Kh[(long)((k0) + sr) * LDK + sc]); sr_[i].ks1 = *reinterpret_cast<const bf16x8*>(&Kh[(long)((k0) + 32 + sr) * LDK + sc]); } while (0)
#define DA_SWRITE(b, i) do { *(bf16x8*)(V_lds + (b) * SHM_V + vst0) = sr_[i].vs0;          \
    *(bf16x8*)(V_lds + (b) * SHM_V + vst1) = sr_[i].vs1; int kc = sc * 2;               \
    *(bf16x8*)(K_lds + (b) * SHM_K + DA_KSWZ(sr, kc)) = sr_[i].ks0;                       \
    *(bf16x8*)(K_lds + (b) * SHM_K + DA_KSWZ(32 + sr, kc)) = sr_[i].ks1; } while (0)
#define DA_SWAIT() asm volatile("s_waitcnt vmcnt(4)" ::: "memory")
  f32x16 pA0, pA1, pB0, pB1; bf16x8 pa0, pa1, pa2, pa3; const int NT = seq / KVBLK;
  constexpr int SE = 0, SO = 1;
  DA_SLOAD(SE, 0); asm volatile("s_waitcnt vmcnt(0)" ::: "memory"); DA_SWRITE(0, SE); __syncthreads();
  qkt(pA0, pA1, K_lds, qr, r32, hi, cbm); expSM(pA0, pA1, soff);
  DA_SLOAD(SO, KVBLK); if (2 < NT) DA_SLOAD(SE, 2 * KVBLK);
  DA_SWAIT(); DA_SWRITE(1, SO); __syncthreads();
  for (int j = 1; j + 1 < NT; j += 2) {
    DA_SBAR(); qkt(pB0, pB1, K_lds + SHM_K, qr, r32, hi, cbm);
    finishSM(pA0, pA1, l_reg, pa0, pa1, pa2, pa3); DA_SBAR();
    DA_SLOAD(SO, (j + 2) * KVBLK); DA_SBAR();
    pv_d0(o, vb0, pa0, pa1, pa2, pa3); expSM(pB0, pB1, soff);
    __syncthreads(); DA_SWAIT(); DA_SWRITE(0, SE);
    __syncthreads();
    DA_SBAR(); qkt(pA0, pA1, K_lds, qr, r32, hi, cbm);
    finishSM(pB0, pB1, l_reg, pa0, pa1, pa2, pa3); DA_SBAR();
    if (j + 3 < NT) DA_SLOAD(SE, (j + 3) * KVBLK); DA_SBAR();
    pv_d0(o, vb0 + (int)SHM_V, pa0, pa1, pa2, pa3); expSM(pA0, pA1, soff);
    __syncthreads(); DA_SWAIT(); DA_SWRITE(1, SO);
    __syncthreads();
  }
  DA_SBAR(); qkt(pB0, pB1, K_lds + SHM_K, qr, r32, hi, cbm);
  finishSM(pA0, pA1, l_reg, pa0, pa1, pa2, pa3); DA_SBAR();
  pv_d0(o, vb0, pa0, pa1, pa2, pa3); expSM(pB0, pB1, soff);
  __syncthreads();
  finishSM(pB0, pB1, l_reg, pa0, pa1, pa2, pa3); DA_SBAR();
  pv_d0(o, vb0 + (int)SHM_V, pa0, pa1, pa2, pa3);
  { auto rr = __builtin_amdgcn_permlane32_swap(__float_as_uint(l_reg), __float_as_uint(l_reg), false, false); l_reg = __uint_as_float(rr[0]) + __uint_as_float(rr[1]); }
  if (hi == 0) li_l[r32] = l_reg; asm volatile("s_waitcnt lgkmcnt(0)" ::: "memory");
  const float sgn = mp ? lam : 1.f;
#pragma unroll
  for (int r = 0; r < 16; ++r) { const float rl = sgn * __builtin_amdgcn_rcpf(li_l[crow(r, hi)]);
#pragma unroll
    for (int d0 = 0; d0 < 4; ++d0) o[d0][r] *= rl; }
  __syncthreads();
  int xb = wq * 4096 + lane; asm volatile("" : "+v"(xb));
  float* X = (float*)lds + xb;
  if (mp == 1) {
#pragma unroll
    for (int d0 = 0; d0 < 4; ++d0)
#pragma unroll
      for (int r = 0; r < 16; ++r) X[(d0 * 16 + r) * 64] = o[d0][r];
  }
  __syncthreads();
  if (mp == 0) {
    float gg[4];
#pragma unroll
    for (int d0 = 0; d0 < 4; ++d0) gg[d0] = subg[d0 * 32 + r32] * oscale;
    int ob = (wq * 32 + 4 * hi) * ldo + r32; asm volatile("" : "+v"(ob));
    unsigned short* Ow = Ob + ob;
#pragma unroll
    for (int r = 0; r < 16; ++r) { float a = 0.f; float v[4];
#pragma unroll
      for (int d0 = 0; d0 < 4; ++d0) { v[d0] = o[d0][r] - X[(d0 * 16 + r) * 64]; a += v[d0] * v[d0]; }
      a += sx<1>(a); a += sx<2>(a); a += sx<4>(a); a += sx<8>(a); a += sx<16>(a);
      a = rsqrtf(a * (1.f / 128.f) + EPS);
      const int orow = (r & 3) + 8 * (r >> 2);
#pragma unroll
      for (int d0 = 0; d0 < 4; ++d0) Ow[orow * ldo + d0 * 32] = (unsigned short)f2bf(v[d0] * a * gg[d0]); }
  }
  __syncthreads();
#undef DA_SLOAD
#undef DA_SWRITE
#undef DA_SWAIT
}
}
__device__ __forceinline__ void ph_attn(const Frame& F, const Args& A, int l) {
    const bf16 *Kb = WSP(bf16, WS_KB), *Vb = WSP(bf16, WS_VB), *Qb = WSP(bf16, WS_QB); bf16* MX = WSP(bf16, WS_MIXIN);
    const float* lq = A.in[10] + l * 256; float d01 = 0.f, d23 = 0.f;
    for (int i = 0; i < 64; ++i) { d01 += lq[i] * lq[64 + i]; d23 += lq[128 + i] * lq[192 + i]; }
    const float lam_init = 0.8f - 0.6f * expf(-0.3f * (float)l); float lam = expf(d01) - expf(d23) + lam_init;
    float mq = 0.f, mk = 0.f;
    for (int i = 0; i < 64; ++i) { mq = fmaxf(mq, fabsf(A.in[8][l * 64 + i])); mk = fmaxf(mk, fabsf(A.in[9][l * 64 + i])); }
    const float soff = __uint_as_float(__builtin_amdgcn_readfirstlane(__float_as_uint(64.f * mq * mk * QSCALE)));
    lam = __uint_as_float(__builtin_amdgcn_readfirstlane(__float_as_uint(lam))); const float osc = __uint_as_float(__builtin_amdgcn_readfirstlane(__float_as_uint(1.f - lam_init)));
    const int vcu = (F.G % 8 == 0) ? (F.bid % 8) * (F.G / 8) + F.bid / 8 : F.bid;
    for (int u = vcu; u < (l == DEPTH - 1 ? 1024 : 16 * 66); u += F.G) {
        const int bh = (u % 1024) / 64 , b = bh >> 3, h = bh & 7;
        int qb; int bb = b, hh = h;
        if (u < 1024) qb = 2 + (u & 63); else { const int v = u - 1024; bb = v >> 4; hh = (v >> 1) & 7; qb = v & 1; }
        const size_t R0 = (size_t)bb * TPB + qb * 128; const int seq = qb < 2 ? CTX : TPB;
        da::unit(Qb + R0 * 1024 + hh * 128, Kb + (size_t)bb * TPB * 1024 + hh * 128, Vb + (size_t)bb * TPB * 1024 + hh * 128,
                 MX + R0 * 3072 + hh * 128, 3072, seq, lam, osc, soff, A.in[11] + l * 128, (char*)F.lds);
    }
}

__device__ __forceinline__ void ph_mix(const Frame& F, const Args& A) {
    const float *PA = WSP(float, WS_PA), *PR = WSP(float, WS_PR), *PF = WSP(float, WS_PF); const bf16* GT = WSP(bf16, WS_GATES); bf16* MD = WSP(bf16, WS_MIXED);
    for (long i = F.gtid; i < (long)MROWS * 1024; i += F.NT) { const size_t R = (size_t)(i >> 10); const int c = (int)(i & 1023);
        MD[i] = (bf16)f2bf(bf2f(GT[R * 3072 + c]) * PA[i] + bf2f(GT[R * 3072 + 1024 + c]) * PR[i] + bf2f(GT[R * 3072 + 2048 + c]) * PF[i]); }
}
__device__ __forceinline__ void ph_resid_norm2(const Frame& F, const Args& A, int l) {
    float* X = WSP(float, WS_XALL); const float* Y1 = WSP(float, WS_Y1); bf16* TOK = WSP(bf16, WS_TOK);
    for (int R = F.gw; R < MROWS; R += F.NGW) {
        const int b = R / TPB, p = R % TPB, s = (p < CTX) ? 2 : b; const float* g1 = MODP(l, s, 2);
        f32x4 v[4];
#pragma unroll
        for (int j = 0; j < 4; ++j) { const int c = 4 * F.lane + 256 * j; const f32x4 x = *(const f32x4*)(X + (size_t)R * 1024 + c), y = *(const f32x4*)(Y1 + (size_t)R * 1024 + c), gg = *(const f32x4*)(g1 + c);
            v[j] = x + gg * y; *(f32x4*)(X + (size_t)R * 1024 + c) = v[j]; }
        norm_mod_row(v, A.in[23] + l * 1024, MODP(l, s, 4), MODP(l, s, 3), TOK + (size_t)R * 1024, F.lane);
    }
}
__device__ __forceinline__ void ph_topk(const Frame& F, const Args& A, int l) {
    const float* LG = WSP(float, WS_LOG); const float* SGU = WSP(float, WS_SGU); bf16* SH = WSP(bf16, WS_SH);
    int* LIST = WSP(int, WS_LIST); float* TOPW = WSP(float, WS_TOPW); int* CNT = (int*)(A.ws + WS_CTL) + CW_CNT + l * 256;
    const float NEG = -__builtin_inff();
    for (int R = F.gw; R < MROWS; R += F.NGW) {
        if (l == DEPTH - 1 && (R % TPB) < CTX) continue;
        const f32x4 lg4 = *(const f32x4*)(LG + (size_t)R * 256 + 4 * F.lane); const f32x4 rb4 = *(const f32x4*)(A.in[25] + l * 256 + 4 * F.lane);
        float sc[4] = {sigmoidf_(lg4.x), sigmoidf_(lg4.y), sigmoidf_(lg4.z), sigmoidf_(lg4.w)};
        float bi[4] = {sc[0] + rb4.x, sc[1] + rb4.y, sc[2] + rb4.z, sc[3] + rb4.w};
        float t1 = NEG, t2 = NEG;
#pragma unroll
        for (int q = 0; q < 4; ++q) { const float v = bi[q]; if (v > t1) { t2 = t1; t1 = v; } else if (v > t2) t2 = v; }
#define TK_M2(M) { const float o1 = sx<M>(t1), o2 = sx<M>(t2); const float n1 = fmaxf(t1, o1), n2 = fmaxf(fminf(t1, o1), fmaxf(t2, o2)); t1 = n1; t2 = n2; }
        TK_M2(1) TK_M2(2) TK_M2(4)
#undef TK_M2
        const float gs = t1 + t2; const int mygrp = F.lane >> 3; int rank = 0;
#pragma unroll
        for (int j = 0; j < 8; ++j) { const float sj = __uint_as_float(__builtin_amdgcn_readlane(__float_as_uint(gs), j * 8)); rank += (sj > gs || (sj == gs && j < mygrp)) ? 1 : 0; }
        const bool sel = rank < 4;
        float cand[4];
#pragma unroll
        for (int q = 0; q < 4; ++q) cand[q] = sel ? bi[q] : NEG;
        int my_e = 0; float my_s = 0.f, ssum = 0.f;
#pragma unroll
        for (int k = 0; k < 8; ++k) {
            float bv = cand[0]; int bq = 0;
#pragma unroll
            for (int q = 1; q < 4; ++q) if (cand[q] > bv) { bv = cand[q]; bq = q; }
            float v = bv; int e = 4 * F.lane + bq;
#define TK_AM(M) { const float ov = sx<M>(v); const int oe = sxi<M>(e); if (ov > v || (ov == v && oe < e)) { v = ov; e = oe; } }
            TK_AM(1) TK_AM(2) TK_AM(4) TK_AM(8) TK_AM(16) TK_AM(32)
#undef TK_AM
            e = __builtin_amdgcn_readfirstlane(e);
            const int ol = e >> 2, oq = e & 3; float sv = 0.f;
#pragma unroll
            for (int q = 0; q < 4; ++q) if (oq == q) { sv = sc[q]; if (F.lane == ol) cand[q] = NEG; }
            sv = __uint_as_float(__builtin_amdgcn_readlane(__float_as_uint(sv), ol)); ssum += sv;
            if (F.lane == k) { my_e = e; my_s = sv; }
        }
        if (F.lane < 8) { const int pos = atomicAdd(CNT + my_e, 1); LIST[(size_t)my_e * LCAP + pos] = R * 8 + F.lane; TOPW[(size_t)R * 8 + F.lane] = my_s / ssum * 2.5f; WSP(int, WS_EP)[(size_t)R * 8 + F.lane] = my_e * LCAP + pos; }
#pragma unroll
        for (int j = 0; j < 4; ++j) { const int f = F.lane + 64 * j; SH[(size_t)R * 256 + f] = (bf16)f2bf(siluf_(SGU[(size_t)R * 512 + f]) * SGU[(size_t)R * 512 + 256 + f]); }
    }
}
__device__ __forceinline__ void ph_experts_naive(const Frame& F, const Args& A, int l) {
    const bf16* TOK = WSP(bf16, WS_TOK); const int* LIST = WSP(int, WS_LIST); const float* TOPW = WSP(float, WS_TOPW); float* YB = WSP(float, WS_YB);
    const int* CNT = (const int*)(A.ws + WS_CTL) + CW_CNT + l * 256;
    LAS bf16* Xs = (LAS bf16*)F.lds;
    LAS float* Hs = (LAS float*)(F.lds + 65536);
    LAS int* pref = (LAS int*)(F.lds + 98304);
    LAS int* sPair = pref + 320; LAS float* sW = (LAS float*)(sPair + 32);
    __syncthreads();
    if (F.tid == 0) { int s = 0; for (int e = 0; e < 256; ++e) { pref[e] = s; s += (CNT[e] + 31) >> 5; } pref[256] = s; }
    __syncthreads();
    const int total = pref[256];
    for (int id = F.bid; id < total; id += F.G) {
        int lo = 0, hi = 255; while (lo < hi) { const int mid = (lo + hi + 1) >> 1; if (pref[mid] <= id) lo = mid; else hi = mid - 1; }
        const int e = lo, c = id - pref[e], n = min(32, CNT[e] - c * 32);
        __syncthreads();
        if (F.tid < 32) { const int pr = F.tid < n ? LIST[(size_t)e * LCAP + c * 32 + F.tid] : -1; sPair[F.tid] = pr; sW[F.tid] = pr >= 0 ? TOPW[pr] : 0.f; }
        __syncthreads();
        for (int pc = F.tid; pc < 4096; pc += 512) { const int row = pc >> 7, c8 = (pc & 127) * 8, pr = sPair[row];
            v4u v = {0u, 0u, 0u, 0u}; if (pr >= 0) v = *(const v4u*)(TOK + (size_t)(pr >> 3) * 1024 + c8);
            *(LAS v4u*)(Xs + row * 1024 + c8) = v; }
        __syncthreads();
        { const int f = F.tid & 255, gu = F.tid >> 8; const float* W = (gu ? A.in[27] : A.in[26]) + ((size_t)(l * 256 + e) * 1024) * 256 + f;
          float acc[32];
#pragma unroll
          for (int r = 0; r < 32; ++r) acc[r] = 0.f;
          for (int k = 0; k < 1024; ++k) { const float w = W[(size_t)k * 256];
#pragma unroll
              for (int r = 0; r < 32; ++r) acc[r] += bf2f(Xs[r * 1024 + k]) * w; }
          if (gu == 0) {
#pragma unroll
              for (int r = 0; r < 32; ++r) Hs[r * 256 + f] = siluf_(acc[r]); }
          __syncthreads();
          if (gu == 1) {
#pragma unroll
              for (int r = 0; r < 32; ++r) Hs[r * 256 + f] *= acc[r]; }
          __syncthreads(); }
        { const float* Wd = A.in[28] + ((size_t)(l * 256 + e) * 256) * 1024 + F.tid;
          float a0[32], a1[32];
#pragma unroll
          for (int r = 0; r < 32; ++r) { a0[r] = 0.f; a1[r] = 0.f; }
          for (int k = 0; k < 256; ++k) { const float w0 = Wd[(size_t)k * 1024], w1 = Wd[(size_t)k * 1024 + 512];
#pragma unroll
              for (int r = 0; r < 32; ++r) { const float hv = Hs[r * 256 + k]; a0[r] += hv * w0; a1[r] += hv * w1; } }
#pragma unroll
          for (int r = 0; r < 32; ++r) { const int pr = sPair[r]; if (pr >= 0) { const float w = sW[r]; YB[(size_t)pr * 1024 + F.tid] = a0[r] * w; YB[(size_t)pr * 1024 + 512 + F.tid] = a1[r] * w; } } }
    }
}
__device__ __forceinline__ void tr_tile(const float* W, int ldw, int k0, int n0, bf16* WT, int ldwt, int rowbase, LAS float* scr, int lane) {
    f32x4 v[8]; const int rr = lane >> 3, c4 = (lane & 7) * 4;
#pragma unroll
    for (int i = 0; i < 8; ++i) v[i] = __builtin_nontemporal_load((const f32x4*)(W + (size_t)(k0 + 8 * i + rr) * ldw + n0 + c4));
#pragma unroll
    for (int i = 0; i < 8; ++i) { LAS float* d = scr + (8 * i + rr) * 33 + c4; d[0] = v[i].x; d[1] = v[i].y; d[2] = v[i].z; d[3] = v[i].w; }
    LDS_WAIT(); asm volatile("" ::: "memory");
    const int c = lane & 7;
#pragma unroll
    for (int j = 0; j < 4; ++j) { const int n = (lane >> 3) + 8 * j; const LAS float* sp = scr + (8 * c) * 33 + n;
        v4u o; o.x = pk2(sp[0 * 33], sp[1 * 33]); o.y = pk2(sp[2 * 33], sp[3 * 33]); o.z = pk2(sp[4 * 33], sp[5 * 33]); o.w = pk2(sp[6 * 33], sp[7 * 33]);
        *(v4u*)(WT + (size_t)(rowbase + n) * ldwt + k0 + 8 * c) = o; }
    LDS_WAIT(); asm volatile("" ::: "memory");
}
__device__ __forceinline__ void ph_expert_w(const Frame& F, const Args& A, int l) {
    LAS float* scr = (LAS float*)(F.lds + F.wave * 16384);
    for (int it = F.gw; it < 256 * 384; it += F.NGW) {
        const int e = it / 384, r = it % 384; bf16* E1 = (bf16*)(A.ws + WS_EW + (size_t)e * EW_STRIDE); bf16* E2 = E1 + 512 * 1024;
        if (r < 256) { const int up = r >> 7, q = r & 127, kb = q >> 3, nb = q & 7, n0 = 32 * nb;
            tr_tile((up ? A.in[27] : A.in[26]) + ((size_t)(l * 256 + e) * 1024) * 256, 256, 64 * kb, n0, E1, 1024, (n0 >> 7) * 256 + up * 128 + (n0 & 127), scr, F.lane); }
        else { const int q = r - 256, kb = q >> 5, nb = q & 31;
            tr_tile(A.in[28] + ((size_t)(l * 256 + e) * 256) * 1024, 1024, 64 * kb, 32 * nb, E2, 256, 32 * nb, scr, F.lane); }
    }
}
struct MoeSched {
    const LAS int* pref; const int* cnt; const int* list; const char* abase; const char* bbase; int npn, G, c, lda2; size_t b_pn_stride; bool gather;
    __device__ __forceinline__ bool next(int i, pg8::UnitG& U) const {
        const long id = (long)i * G + c; const int total = pref[256]; if (id >= (long)total * npn) return false;
        const int tau = (int)(id / npn), pn = (int)(id % npn);
        int lo = 0, hi = 255; while (lo < hi) { const int mid = (lo + hi + 1) >> 1; if (pref[mid] <= tau) lo = mid; else hi = mid - 1; }
        const int e = lo, t = tau - pref[e];
        U.e = e; U.pn = pn; U.valid = min(256, cnt[e] - t * 256); U.rows = list + (size_t)e * LCAP + t * 256; U.row0 = tau * 256;
        U.a = gather ? abase : abase + (size_t)tau * 256 * lda2; U.b = bbase + (size_t)e * EW_STRIDE + (size_t)pn * b_pn_stride; return true;
    }
};
__device__ __forceinline__ void moe_prefix(const Frame& F, const int* CNT, LAS int* pref) {
    __syncthreads();
    if (F.tid == 0) { int sum = 0; for (int e = 0; e < 256; ++e) { pref[e] = sum; sum += (CNT[e] + 255) >> 8; } pref[256] = sum; }
    __syncthreads();
}
struct EpiSwiGLU {
    static constexpr bool PERM = true;
    bf16* HB;
    __device__ __forceinline__ void operator()(const f32x4 (&acc)[2][2][4][2], const pg8::UnitG& u, int wr, int wc, int fr, int fq) const {
#pragma unroll
        for (int ai = 0; ai < 2; ++ai)
#pragma unroll
            for (int m = 0; m < 4; ++m) { const int r = ai * 128 + wr * 64 + m * 16 + fr;
                const f32x4 g0 = acc[ai][0][m][0], g1 = acc[ai][0][m][1], u0 = acc[ai][1][m][0], u1 = acc[ai][1][m][1];
                v4u w; w.x = pk2(siluf_(g0[0]) * u0[0], siluf_(g0[1]) * u0[1]); w.y = pk2(siluf_(g0[2]) * u0[2], siluf_(g0[3]) * u0[3]);
                w.z = pk2(siluf_(g1[0]) * u1[0], siluf_(g1[1]) * u1[1]); w.w = pk2(siluf_(g1[2]) * u1[2], siluf_(g1[3]) * u1[3]);
                *(v4u*)(HB + (size_t)(u.row0 + r) * 256 + u.pn * 128 + wc * 32 + 8 * fq) = w; }
    }
};
struct EpiScatter {
    static constexpr bool PERM = true;
    bf16* Y;
    __device__ __forceinline__ void operator()(const f32x4 (&acc)[2][2][4][2], const pg8::UnitG& u, int wr, int wc, int fr, int fq) const {
#pragma unroll
        for (int ai = 0; ai < 2; ++ai)
#pragma unroll
            for (int m = 0; m < 4; ++m) { const int r = ai * 128 + wr * 64 + m * 16 + fr;
                if (r < u.valid) { bf16* dst = Y + (size_t)(u.row0 + r) * 1024 + u.pn * 256 + wc * 32 + 8 * fq;
#pragma unroll
                    for (int bj = 0; bj < 2; ++bj) { const f32x4 v0 = acc[ai][bj][m][0], v1 = acc[ai][bj][m][1];
                        v4u o; o.x = pk2(v0[0], v0[1]); o.y = pk2(v0[2], v0[3]); o.z = pk2(v1[0], v1[1]); o.w = pk2(v1[2], v1[3]);
                        *(v4u*)(dst + bj * 128) = o; } } }
    }
};
__device__ __forceinline__ void ph_experts_up(const Frame& F, const Args& A, int l) {
    const int* CNT = (const int*)(A.ws + WS_CTL) + CW_CNT + l * 256; LAS int* pref = (LAS int*)(F.lds + RING_BYTES + 1024);
    moe_prefix(F, CNT, pref);
    const int vcu = (F.G % 8 == 0) ? (F.bid % 8) * (F.G / 8) + F.bid / 8 : F.bid;
    MoeSched S{pref, CNT, WSP(int, WS_LIST), (const char*)WSP(bf16, WS_TOK), (const char*)(A.ws + WS_EW), 2, F.G, vcu, 2048, (size_t)256 * 1024 * 2, true};
    EpiSwiGLU E{WSP(bf16, WS_HB)};
    pg8::gemm_phase_g<EpiSwiGLU, MoeSched, true>(F.lds, 1024, 1024, 1024, S, E);
}
__device__ __forceinline__ void ph_experts_down(const Frame& F, const Args& A, int l) {
    const int* CNT = (const int*)(A.ws + WS_CTL) + CW_CNT + l * 256; LAS int* pref = (LAS int*)(F.lds + RING_BYTES + 1024);
    moe_prefix(F, CNT, pref);
    const int vcu = (F.G % 8 == 0) ? (F.bid % 8) * (F.G / 8) + F.bid / 8 : F.bid;
    MoeSched S{pref, CNT, WSP(int, WS_LIST), (const char*)WSP(bf16, WS_HB), (const char*)(A.ws + WS_EW + 512 * 1024 * 2), 4, F.G, vcu, 512, (size_t)256 * 256 * 2, false};
    EpiScatter E{WSP(bf16, WS_Y16)};
    pg8::gemm_phase_g<EpiScatter, MoeSched, false>(F.lds, 256, 256, 256, S, E);
}
__device__ __forceinline__ void ph_combine(const Frame& F, const Args& A, int l) {
    float* X = WSP(float, WS_XALL); const float* SD = WSP(float, WS_SD); const bf16* YS = WSP(bf16, WS_Y16); const int* EP = WSP(int, WS_EP); const float* TOPW = WSP(float, WS_TOPW);
    const int* CNT = (const int*)(A.ws + WS_CTL) + CW_CNT + l * 256; LAS int* pref = (LAS int*)(F.lds + RING_BYTES + 1024);
    moe_prefix(F, CNT, pref);
    for (int R = F.gw; R < MROWS; R += F.NGW) {
        const int b = R / TPB, p = R % TPB, s = (p < CTX) ? 2 : b; const float* g2 = MODP(l, s, 5); f32x4 xv[4];
        if (l == DEPTH - 1 && p < CTX) continue;
        size_t so[8]; float wk[8];
#pragma unroll
        for (int k = 0; k < 8; ++k) { const int ep = EP[(size_t)R * 8 + k], e = ep / LCAP, pos = ep - e * LCAP; so[k] = ((size_t)pref[e] * 256 + pos) * 1024; wk[k] = TOPW[(size_t)R * 8 + k]; }
#pragma unroll
        for (int j = 0; j < 4; ++j) { const int c = 4 * F.lane + 256 * j; f32x4 f = *(const f32x4*)(SD + (size_t)R * 1024 + c);
#pragma unroll
            for (int k = 0; k < 8; ++k) { const unsigned long long y = *(const unsigned long long*)(YS + so[k] + c);
                f += (f32x4){bf2f((unsigned)y & 0xffffu), bf2f(((unsigned)y) >> 16), bf2f((unsigned)(y >> 32) & 0xffffu), bf2f((unsigned)(y >> 48))} * wk[k]; }
            const f32x4 x = *(const f32x4*)(X + (size_t)R * 1024 + c) + *(const f32x4*)(g2 + c) * f;
            *(f32x4*)(X + (size_t)R * 1024 + c) = x; xv[j] = x;
            if (l == DEPTH - 1) *(f32x4*)(A.out + ((size_t)b * SEQ + (p - CTX)) * 1024 + c) = x; }
        if (l + 1 < DEPTH) norm_mod_row(xv, A.in[6] + (l + 1) * 1024, MODP(l + 1, s, 1), MODP(l + 1, s, 0), WSP(bf16, WS_H) + (size_t)R * 1024, F.lane);
    }
}

struct EpiWin {
    static constexpr bool PERM = true; static constexpr int MIDK = 0;
    bf16 *Kb, *Vb, *Qb, *LXb, *GLG, *ZP, *GT; const float* qg; const float* kg;
    __device__ __forceinline__ void operator()(const f32x4 (&acc)[2][2][4][2], const pg8::Unit& u, int wr, int wc, int fr, int fq) const {
        const int pn = u.pn, sec = pn >> 2;
        if (sec == 0 || sec == 3) {
            const bool isq = sec == 3; const bool lat = (u.pm % 33) != 0;
            bf16* dst = (isq ? Qb : Kb) + (pn & 3) * 256 + wc * 64 + 4 * fq; const float* gn = isq ? qg : kg; const float gs = isq ? QSCALE : 1.f;
            f32x4 g[2][2]; float invf[4];
#pragma unroll
            for (int bj = 0; bj < 2; ++bj)
#pragma unroll
                for (int n = 0; n < 2; ++n) g[bj][n] = *(const f32x4*)(gn + 32 * bj + 16 * n + 4 * fq) * gs;
#pragma unroll
            for (int e = 0; e < 4; ++e) invf[e] = exp2f(-(float)(4 * fq + e) * (13.287712379549449f / 16.f)) * 0.15915494309189535f;
#pragma unroll
            for (int ai = 0; ai < 2; ++ai)
#pragma unroll
                for (int m = 0; m < 4; ++m) { const int R = u.pm * 256 + ai * 128 + wr * 64 + m * 16 + fr, t = (R % TPB) - CTX;
                    float ss = 0.f;
#pragma unroll
                    for (int bj = 0; bj < 2; ++bj)
#pragma unroll
                        for (int n = 0; n < 2; ++n) { const f32x4 v = acc[ai][bj][m][n]; ss += (v[0] * v[0] + v[1] * v[1]) + (v[2] * v[2] + v[3] * v[3]); }
                    ss += sx<16>(ss); ss += sx<32>(ss);
                    const float rs = rsqrtf(ss * (1.f / 64.f) + EPS);
#pragma unroll
                    for (int bj = 0; bj < 2; ++bj) { const float pos = (float)(bj ? (t & 63) : (t >> 6));
                        const f32x4 y1 = acc[ai][bj][m][0] * rs * g[bj][0], y2 = acc[ai][bj][m][1] * rs * g[bj][1]; f32x4 o1 = y1, o2 = y2;
                        if (lat) {
#pragma unroll
                            for (int e = 0; e < 4; ++e) { const float rev = pos * invf[e]; const float cs = __builtin_amdgcn_cosf(rev), sn = __builtin_amdgcn_sinf(rev);
                                o1[e] = y1[e] * cs - y2[e] * sn; o2[e] = y1[e] * sn + y2[e] * cs; } }
                        bf16* p = dst + (size_t)R * 1024 + 32 * bj;
                        *(unsigned long long*)p = (unsigned long long)pk2(o1[0], o1[1]) | ((unsigned long long)pk2(o1[2], o1[3]) << 32);
                        *(unsigned long long*)(p + 16) = (unsigned long long)pk2(o2[0], o2[1]) | ((unsigned long long)pk2(o2[2], o2[3]) << 32); }
                    asm volatile("" ::: "memory"); }
        } else {
            bf16* base; int ld = 1024, act = 0;
            if (sec == 1) base = Vb + (pn & 3) * 256; else if (sec == 2) base = LXb + (pn & 3) * 256; else if (sec == 4) { base = GLG + (pn & 3) * 256; act = 1; }
            else if (sec == 5) base = ZP + (pn & 3) * 256; else { base = GT + (pn - 24) * 256; ld = 3072; act = 2; }
            base += wc * 32 + 8 * fq;
#pragma unroll
            for (int ai = 0; ai < 2; ++ai)
#pragma unroll
                for (int m = 0; m < 4; ++m) { bf16* rowp = base + (size_t)(u.pm * 256 + ai * 128 + wr * 64 + m * 16 + fr) * ld;
#pragma unroll
                    for (int bj = 0; bj < 2; ++bj) { f32x4 v0 = acc[ai][bj][m][0], v1 = acc[ai][bj][m][1];
                        if (act == 1) {
#pragma unroll
                            for (int e = 0; e < 4; ++e) { v0[e] = gelu_tanh(v0[e]); v1[e] = gelu_tanh(v1[e]); } }
                        else if (act == 2) {
#pragma unroll
                            for (int e = 0; e < 4; ++e) { v0[e] = sigmoidf_(v0[e]); v1[e] = sigmoidf_(v1[e]); } }
                        v4u o; o.x = pk2(v0[0], v0[1]); o.y = pk2(v0[2], v0[3]); o.z = pk2(v1[0], v1[1]); o.w = pk2(v1[2], v1[3]);
                        *(v4u*)(rowp + bj * 128) = o; } }
        }
    }
};

struct EpiMix {
    static constexpr bool PERM = true; static constexpr int MIDK = 16;
    const bf16* GT; bf16* MD;
    __device__ __forceinline__ void mid(f32x4 (&acc)[2][2][4][2], const pg8::Unit& u, int wr, int wc, int fr, int fq, int seg) const {
        const bf16* gb = GT + (size_t)(u.pm * 256 + wr * 64 + fr) * 3072 + (seg - 1) * 1024 + u.pn * 256 + wc * 32 + 8 * fq;
#pragma unroll
        for (int ai = 0; ai < 2; ++ai)
#pragma unroll
            for (int m = 0; m < 4; ++m)
#pragma unroll
                for (int bj = 0; bj < 2; ++bj) { const bf16* p = gb + (size_t)(ai * 128 + m * 16) * 3072 + bj * 128;
                    const v4u a = *(const v4u*)p, b = *(const v4u*)(p + 1024);
                    const unsigned aw[4] = {a.x, a.y, a.z, a.w}, bw[4] = {b.x, b.y, b.z, b.w};
#pragma unroll
                    for (int q = 0; q < 4; ++q) { const float r0 = bf2f(aw[q] & 0xffffu) * __builtin_amdgcn_rcpf(fmaxf(bf2f(bw[q] & 0xffffu), 1e-30f)), r1 = bf2f(aw[q] >> 16) * __builtin_amdgcn_rcpf(fmaxf(bf2f(bw[q] >> 16), 1e-30f));
                        acc[ai][bj][m][q >> 1][(q & 1) * 2] *= r0; acc[ai][bj][m][q >> 1][(q & 1) * 2 + 1] *= r1; } }
    }
    __device__ __forceinline__ void operator()(const f32x4 (&acc)[2][2][4][2], const pg8::Unit& u, int wr, int wc, int fr, int fq) const {
        const size_t r0 = (size_t)(u.pm * 256 + wr * 64 + fr); const int c0 = u.pn * 256 + wc * 32 + 8 * fq;
#pragma unroll
        for (int ai = 0; ai < 2; ++ai)
#pragma unroll
            for (int m = 0; m < 4; ++m)
#pragma unroll
                for (int bj = 0; bj < 2; ++bj) { const size_t R = r0 + ai * 128 + m * 16; const v4u gv = *(const v4u*)(GT + R * 3072 + 2048 + c0 + bj * 128);
                    const f32x4 v0 = acc[ai][bj][m][0], v1 = acc[ai][bj][m][1]; v4u o;
                    o.x = pk2(v0[0] * bf2f(gv.x & 0xffffu), v0[1] * bf2f(gv.x >> 16)); o.y = pk2(v0[2] * bf2f(gv.y & 0xffffu), v0[3] * bf2f(gv.y >> 16));
                    o.z = pk2(v1[0] * bf2f(gv.z & 0xffffu), v1[1] * bf2f(gv.z >> 16)); o.w = pk2(v1[2] * bf2f(gv.w & 0xffffu), v1[3] * bf2f(gv.w >> 16));
                    *(v4u*)(MD + R * 1024 + c0 + bj * 128) = o; }
    }
};
struct EpiResid {
    static constexpr bool PERM = false; static constexpr int MIDK = 0;
    float* X; const float* mod;
    __device__ __forceinline__ void operator()(const f32x4 (&acc)[2][2][4][2], const pg8::Unit& u, int wr, int wc, int fr, int fq) const {
        const int src = (u.pm % 33 == 0) ? 2 : u.pm / 33; const float* g1 = mod + src * 6144 + 2 * 1024;
        const int col0 = u.pn * 256 + wc * 32 + 4 * fq;
        f32x4 gv[2][2];
#pragma unroll
        for (int bj = 0; bj < 2; ++bj)
#pragma unroll
            for (int n = 0; n < 2; ++n) gv[bj][n] = *(const f32x4*)(g1 + col0 + bj * 128 + n * 16);
#pragma unroll
        for (int ai = 0; ai < 2; ++ai)
#pragma unroll
            for (int m = 0; m < 4; ++m) { float* rowp = X + (size_t)(u.pm * 256 + ai * 128 + wr * 64 + m * 16 + fr) * 1024 + col0;
#pragma unroll
                for (int bj = 0; bj < 2; ++bj)
#pragma unroll
                    for (int n = 0; n < 2; ++n) { f32x4* p = (f32x4*)(rowp + bj * 128 + n * 16); *p = *p + gv[bj][n] * acc[ai][bj][m][n]; } }
    }
};
__device__ __forceinline__ void ph_norm2(const Frame& F, const Args& A, int l) {
    const float* X = WSP(float, WS_XALL); bf16* TOK = WSP(bf16, WS_TOK);
    for (int R = F.gw; R < MROWS; R += F.NGW) {
        const int b = R / TPB, p = R % TPB, s = (p < CTX) ? 2 : b;
        if (l == DEPTH - 1 && p < CTX) continue;
        f32x4 v[4];
#pragma unroll
        for (int j = 0; j < 4; ++j) v[j] = *(const f32x4*)(X + (size_t)R * 1024 + 4 * F.lane + 256 * j);
        norm_mod_row(v, A.in[23] + l * 1024, MODP(l, s, 4), MODP(l, s, 3), TOK + (size_t)R * 1024, F.lane);
    }
}

constexpr int PH_PER_L = 18, N_PHASES = 1 + DEPTH * PH_PER_L;
template <int P> __device__ __forceinline__ void run_phase(const Frame& F, const Args& A, int l) {
    if constexpr (P == -1) ph_prologue(F, A);
    if constexpr (P == 0) ph_norm1(F, A, l);
    if constexpr (P == 1) { pg8::Gemm g{WSP(bf16, WS_H), WLP(l, WO_WIN), MROWS, INW, 1024, 1024, 1024}; pg8::StaticOrder S; S.init(MROWS, INW, F.G, F.bid);
#if FAST_WIN
        EpiWin E{WSP(bf16, WS_KB), WSP(bf16, WS_VB), WSP(bf16, WS_QB), WSP(bf16, WS_LXB), WSP(bf16, WS_GLG), WSP(bf16, WS_ZP), WSP(bf16, WS_GATES), A.in[8] + l * 64, A.in[9] + l * 64};
        pg8::gemm_phase(F.lds, g, S, E); }
#else
        pg8::EpiF32 E{WSP(float, WS_U), INW}; pg8::gemm_phase(F.lds, g, S, E); }
    if constexpr (P == 2) ph_uelem(F, A, l);
#endif
    if constexpr (P == 3) { ph_conv(F, A, l); ph_fft_t1_fast(F, A);
#if FAST_MOE
        ph_expert_w(F, A, l);
#endif
    }
    if constexpr (P == 4) {
#if FAST_LRU
        ph_lru_gemm(F, A, l);
#else
        ph_lrucoef(F, A, l);
#endif
#if FAST_FFT_A
        ph_fft_a_gemm(F, A);
#else
        ph_fft_a(F, A);
#endif
        ph_fft_c(F, A);
    }
    if constexpr (P == 5) {
        ph_scan1(F, A);
#if FAST_FFT_B
        ph_fft_b_gemm(F, A);
#else
        ph_fft_b(F, A);
#endif
    }
    if constexpr (P == 6) { ph_scan2_fast(F, A); ph_fft_t2_fast(F, A); }
    if constexpr (P == 7) { ph_scan3(F, A);
#if FAST_ATTN
        ph_attn(F, A, l);
#endif
    }
    if constexpr (P == 8) {
#if !FAST_ATTN
        ph_attn_naive(F, A, l);
#endif
        __syncthreads(); }
#if FAST_MIX
    if constexpr (P == 9) { pg8::Gemm g{WSP(bf16, WS_MIXIN), WLP(l, WO_D1), MROWS, 1024, 3072, 3072, 3072}; pg8::StaticOrder S; S.init(MROWS, 1024, F.G, F.bid, l == DEPTH - 1);
        EpiMix E{WSP(bf16, WS_GATES), WSP(bf16, WS_MIXED)}; pg8::gemm_phase(F.lds, g, S, E); }
    if constexpr (P == 11) { pg8::Gemm g{WSP(bf16, WS_MIXED), WLP(l, WO_OUT), MROWS, 1024, 1024, 1024, 1024}; pg8::StaticOrder S; S.init(MROWS, 1024, F.G, F.bid, l == DEPTH - 1);
        EpiResid E{WSP(float, WS_XALL), (const float*)(A.ws + WS_CTL) + CW_MOD + l * 3 * 6144}; pg8::gemm_phase(F.lds, g, S, E); }
    if constexpr (P == 12) ph_norm2(F, A, l);
#else
    if constexpr (P == 9) {
        { pg8::Gemm g{WSP(bf16, WS_MIXIN), WLP(l, WO_D1), MROWS, 1024, 1024, 3072, 3072}; pg8::StaticOrder S; S.init(MROWS, 1024, F.G, F.bid); pg8::EpiF32 E{WSP(float, WS_PA), 1024}; pg8::gemm_phase(F.lds, g, S, E); }
        { pg8::Gemm g{WSP(bf16, WS_MIXIN) + 1024, WLP(l, WO_D1) + 1024, MROWS, 1024, 1024, 3072, 3072}; pg8::StaticOrder S; S.init(MROWS, 1024, F.G, F.bid); pg8::EpiF32 E{WSP(float, WS_PR), 1024}; pg8::gemm_phase(F.lds, g, S, E); }
        { pg8::Gemm g{WSP(bf16, WS_MIXIN) + 2048, WLP(l, WO_D1) + 2048, MROWS, 1024, 1024, 3072, 3072}; pg8::StaticOrder S; S.init(MROWS, 1024, F.G, F.bid); pg8::EpiF32 E{WSP(float, WS_PF), 1024}; pg8::gemm_phase(F.lds, g, S, E); } }
    if constexpr (P == 10) ph_mix(F, A);
    if constexpr (P == 11) { pg8::Gemm g{WSP(bf16, WS_MIXED), WLP(l, WO_OUT), MROWS, 1024, 1024, 1024, 1024}; pg8::StaticOrder S; S.init(MROWS, 1024, F.G, F.bid);
        pg8::EpiF32 E{WSP(float, WS_Y1), 1024}; pg8::gemm_phase(F.lds, g, S, E); }
    if constexpr (P == 12) ph_resid_norm2(F, A, l);
#endif
    if constexpr (P == 13) {
        { pg8::Gemm g{WSP(bf16, WS_TOK), WLP(l, WO_R), MROWS, 256, 1024, 1024, 1024}; pg8::StaticOrder S; S.init(MROWS, 256, F.G, F.bid, l == DEPTH - 1); pg8::EpiF32 E{WSP(float, WS_LOG), 256}; pg8::gemm_phase(F.lds, g, S, E); }
        { pg8::Gemm g{WSP(bf16, WS_TOK), WLP(l, WO_SGU), MROWS, 512, 1024, 1024, 1024}; pg8::StaticOrder S; S.init(MROWS, 512, F.G, F.bid, l == DEPTH - 1); pg8::EpiF32 E{WSP(float, WS_SGU), 512}; pg8::gemm_phase(F.lds, g, S, E); } }
    if constexpr (P == 14) ph_topk(F, A, l);
    if constexpr (P == 15) {
#if FAST_MOE
        ph_experts_up(F, A, l);
#else
        ph_experts_naive(F, A, l); __syncthreads();
#endif

        { pg8::Gemm g{WSP(bf16, WS_SH), WLP(l, WO_SD), MROWS, 1024, 256, 256, 256}; pg8::StaticOrder S; S.init(MROWS, 1024, F.G, F.bid, l == DEPTH - 1); pg8::EpiF32 E{WSP(float, WS_SD), 1024}; pg8::gemm_phase(F.lds, g, S, E); } }
    if constexpr (P == 16) {
#if FAST_MOE
        ph_experts_down(F, A, l);
#endif
    }
    if constexpr (P == 17) ph_combine(F, A, l);
}
__device__ __forceinline__ Frame make_frame(unsigned char* lds) {
    Frame F; F.lds = (LAS unsigned char*)lds; F.tid = otid(); F.lane = F.tid & 63; F.wave = __builtin_amdgcn_readfirstlane(F.tid >> 6);
    F.bid = obid(); F.G = ogrid(); F.gw = F.bid * NWAVES + F.wave; F.NGW = F.G * NWAVES; F.gtid = (long)F.bid * 512 + F.tid; F.NT = (long)F.G * 512;
    return F;
}
template <int P> __global__ void __launch_bounds__(NWAVES * 64, 2) mk_phase(Args A) {
    extern __shared__ __attribute__((aligned(16))) unsigned char lds[];
    const Frame F = make_frame(lds);
    run_phase<P>(F, A, A.ph_lo);
}
#if N_LAUNCH_MODE == 1
__device__ __forceinline__ const float* lds_ptr(const LAS unsigned long long* tab, int i) {
    const unsigned long long v = tab[i];
    const unsigned lo = __builtin_amdgcn_readfirstlane((unsigned)v), hi = __builtin_amdgcn_readfirstlane((unsigned)(v >> 32));
    return (const float*)(((unsigned long long)hi << 32) | lo);
}
__device__ __forceinline__ void load_args(Args& L, const LAS unsigned long long* tab) {
#pragma unroll
    for (int i = 0; i < 32; ++i) L.in[i] = lds_ptr(tab, i);
    L.out = (float*)lds_ptr(tab, 32); L.ws = (unsigned char*)lds_ptr(tab, 33); L.ph_lo = 0; L.ph_hi = 0;
}
__global__ void __launch_bounds__(NWAVES * 64, 2) mk_fwd(Args A) {
    extern __shared__ __attribute__((aligned(16))) unsigned char lds[];
    LAS unsigned char* L3 = (LAS unsigned char*)lds;
    volatile LAS unsigned* MISC = (volatile LAS unsigned*)(L3 + MISC_OFF);
    for (int u = threadIdx.x; u < (LDS_BYTES - RING_BYTES) / 4; u += NWAVES * 64) ((LAS unsigned*)(L3 + RING_BYTES))[u] = 0u;
    __syncthreads();
    LAS unsigned long long* tab = (LAS unsigned long long*)(L3 + RING_BYTES + 4096);
    if (threadIdx.x == 0) {
#define ST(i) tab[i] = (unsigned long long)A.in[i];
        ST(0) ST(1) ST(2) ST(3) ST(4) ST(5) ST(6) ST(7) ST(8) ST(9) ST(10) ST(11) ST(12) ST(13) ST(14) ST(15) ST(16) ST(17) ST(18) ST(19) ST(20) ST(21) ST(22) ST(23) ST(24) ST(25) ST(26) ST(27) ST(28) ST(29) ST(30) ST(31)
#undef ST
        tab[32] = (unsigned long long)A.out; tab[33] = (unsigned long long)A.ws;
    }
    __syncthreads();
    (void)xcd_barrier_post((unsigned*)(A.ws + WS_CTL) + CW_BAR, MISC + 8);
#define RUN(P) do { asm volatile("; PHASE_MARK " #P); { unsigned tb_ = RING_BYTES + 4096; asm volatile("" : "+v"(tb_)); Args L; load_args(L, (const LAS unsigned long long*)(L3 + tb_)); \
        const Frame F = make_frame(lds); run_phase<P>(F, L, l); \
        if constexpr (P >= 0 && ((REP_MASK >> (P < 0 ? 0 : P)) & 1)) { for (int rp_ = 0; rp_ < REP_N; ++rp_) { asm volatile("s_waitcnt vmcnt(0)" ::: "memory"); __syncthreads(); run_phase<P>(F, L, l); } } \
        XcdBarrier bar; bar.bar = (unsigned*)(L.ws + WS_CTL) + CW_BAR; bar.x = xb_xcc_id(); { unsigned mo_ = MISC_OFF + 32; asm volatile("" : "+v"(mo_)); bar.st = (volatile LAS unsigned*)(L3 + mo_); } \
        xcd_barrier(bar); } } while (0)
    { const int l = 0; RUN(-1); }
    for (int l = 0; l < DEPTH; ++l) {
        if (l == 0) RUN(0);
        RUN(1); RUN(3); RUN(4); RUN(5); RUN(6); RUN(7); RUN(9); RUN(11); RUN(12); RUN(13); RUN(14); RUN(15); RUN(16); RUN(17);
    }
#undef RUN
}
#endif

extern "C" void kernel_launch(void* const* d_in, const int* in_sizes, int n_in, void* d_out, int out_size, void* d_ws, size_t ws_size, hipStream_t stream) {
    static int grid = 0;
    if (grid == 0) {
        if (n_in != 32 || out_size != NB * SEQ * DM || ws_size < WS_END) { fprintf(stderr, "kernel_launch: unexpected shapes (n_in %d, out %d, ws %zu < %zu)\n", n_in, out_size, ws_size, (size_t)WS_END); grid = -1; return; }
        int dev = 0, cus = 0;
        if (hipGetDevice(&dev) != hipSuccess || hipDeviceGetAttribute(&cus, hipDeviceAttributeMultiprocessorCount, dev) != hipSuccess) { grid = -1; return; }
#define SETA(K) if (hipFuncSetAttribute((const void*)K, hipFuncAttributeMaxDynamicSharedMemorySize, LDS_BYTES) != hipSuccess) { fprintf(stderr, "kernel_launch: hipFuncSetAttribute failed\n"); grid = -1; return; }
#if N_LAUNCH_MODE == 1
        SETA(mk_fwd)
#else
        SETA(mk_phase<-1>) SETA(mk_phase<0>) SETA(mk_phase<1>) SETA(mk_phase<2>) SETA(mk_phase<3>) SETA(mk_phase<4>) SETA(mk_phase<5>) SETA(mk_phase<6>) SETA(mk_phase<7>) SETA(mk_phase<8>)
        SETA(mk_phase<9>) SETA(mk_phase<10>) SETA(mk_phase<11>) SETA(mk_phase<12>) SETA(mk_phase<13>) SETA(mk_phase<14>) SETA(mk_phase<15>) SETA(mk_phase<16>) SETA(mk_phase<17>)
#endif
#undef SETA
        int per_cu = 0;
        (void)per_cu;
        grid = cus;
    }
    if (grid < 0) return;
    (void)hipMemsetAsync((char*)d_ws + WS_CTL, 0, CTL_ZERO_BYTES, stream);
    Args a{};
    for (int i = 0; i < 32; ++i) a.in[i] = (const float*)d_in[i];
    a.out = (float*)d_out; a.ws = (unsigned char*)d_ws;
#if N_LAUNCH_MODE == 1
    a.ph_lo = 0; a.ph_hi = N_PHASES;
    hipLaunchKernelGGL(mk_fwd, dim3(grid), dim3(NWAVES * 64), LDS_BYTES, stream, a);
#else
#define LAUNCH_P(P) hipLaunchKernelGGL(mk_phase<P>, dim3(grid), dim3(NWAVES * 64), LDS_BYTES, stream, a)
    a.ph_lo = 0; a.ph_hi = 0; LAUNCH_P(-1);
    for (int l = 0; l < DEPTH; ++l) { a.ph_lo = l;
        LAUNCH_P(0); LAUNCH_P(1); LAUNCH_P(2); LAUNCH_P(3); LAUNCH_P(4); LAUNCH_P(5); LAUNCH_P(6); LAUNCH_P(7); LAUNCH_P(8); LAUNCH_P(9); LAUNCH_P(10); LAUNCH_P(11); LAUNCH_P(12); LAUNCH_P(13); LAUNCH_P(14); LAUNCH_P(15); LAUNCH_P(16); LAUNCH_P(17); }
#undef LAUNCH_P
#endif
    const hipError_t le = hipPeekAtLastError();
    if (le != hipSuccess) fprintf(stderr, "kernel_launch: launch failed: %s\n", hipGetErrorName(le));
}
```

```cpp
#include <hip/hip_runtime.h>
#include <cstdio>
#include <cstdint>

#ifndef ATTN_V2
#define ATTN_V2 5
#endif
#ifndef REP_PRO
#define REP_PRO 0
#endif
#ifndef REP_MASK
#define REP_MASK 0
#endif
#ifndef REP_N
#define REP_N 2
#endif
#ifndef FAST_MIX
#define FAST_MIX 1
#endif
#ifndef FAST_WIN
#define FAST_WIN 1
#endif
#ifndef FAST_LRU
#define FAST_LRU 1
#endif
#define FAST_FFT 0
#ifndef FAST_FFT_A
#define FAST_FFT_A 1
#endif
#ifndef FAST_FFT_B
#define FAST_FFT_B 1
#endif
#ifndef FAST_MOE
#define FAST_MOE 1
#endif
#ifndef FAST_ATTN
#define FAST_ATTN 1
#endif
#ifndef N_LAUNCH_MODE
#define N_LAUNCH_MODE 1
#endif

__device__ __forceinline__ int otid() { int t = threadIdx.x; asm volatile("" : "+v"(t)); return t; }
__device__ __forceinline__ int obid() { int b = blockIdx.x; asm volatile("" : "+s"(b)); return b; }
__device__ __forceinline__ int ogrid() { int g = gridDim.x; asm volatile("" : "+s"(g)); return g; }
template <int M> __device__ __forceinline__ float sx(float v) {
    static_assert(M == 1 || M == 2 || M == 4 || M == 8 || M == 16 || M == 32, "xor mask");
    if constexpr (M < 32) return __uint_as_float((unsigned)__builtin_amdgcn_ds_swizzle((int)__float_as_uint(v), (M << 10) | 0x1f));
    else { auto rr = __builtin_amdgcn_permlane32_swap(__float_as_uint(v), __float_as_uint(v), false, false); const unsigned a = rr[0], b = rr[1]; return __uint_as_float(a == __float_as_uint(v) ? b : a); }
}
template <int M> __device__ __forceinline__ int sxi(int v) { return (int)__float_as_uint(sx<M>(__uint_as_float((unsigned)v))); }
namespace pg8 {
#define PG8_LAS __attribute__((address_space(3)))
typedef unsigned short bf16_t;
typedef short bf16x8 __attribute__((ext_vector_type(8)));
typedef float f32x4 __attribute__((ext_vector_type(4)));
typedef unsigned u32x4 __attribute__((ext_vector_type(4)));
constexpr int BM = 256, BK = 64, HALF = 128, HTB = HALF * BK * 2, STAGE_BYTES = 8 * HTB, NXCD = 8, WGM = 8;
__host__ __device__ __forceinline__ int lds_byte(int r, int c) { const int st = (r >> 4) * 2 + (c >> 5), rr = r & 15, cc = c & 31, ob = rr * 64 + cc * 2; return st * 1024 + (ob ^ (((ob >> 9) & 1) << 5)); }
__host__ __device__ __forceinline__ void stage_rc(int b, int& R, int& C) { const int st = b / 1024, sb = b % 1024, swz = sb ^ (((sb >> 9) & 1) << 5); R = (st >> 1) * 16 + swz / 64; C = (st & 1) * 32 + (swz % 64) / 2; }
__host__ __device__ __forceinline__ int perm32(int rho) { const int n = rho >> 4, i = rho & 15; return 8 * (i >> 2) + 4 * n + (i & 3); }
struct Unit { int pm, pn; };
struct Gemm { const bf16_t* A; const bf16_t* Bt; int M, N, K, lda, ldb; };
struct StaticOrder {
    int nM, nN, nwg, G, c; bool skipctx;
    __host__ __device__ void init(int M, int N, int G_, int c_, bool skip = false) { nM = skip ? 64 : M / BM; nN = N / BM; nwg = nM * nN; G = G_; c = c_; skipctx = skip; }
    __host__ __device__ bool next(int i, Unit& u) const {
        const long L = (long)i * G + c; if (L >= nwg) return false;
        int wgid = (int)L; { const int q = nwg / NXCD, r = nwg % NXCD, xcd = wgid % NXCD, off = wgid / NXCD; wgid = (xcd < r ? xcd * (q + 1) : r * (q + 1) + (xcd - r) * q) + off; }
        const int nig = WGM * nN, gid = wgid / nig, fm = gid * WGM, gsz = (nM - fm) < WGM ? (nM - fm) : WGM;
        u.pm = fm + ((wgid % nig) % gsz); u.pn = (wgid % nig) / gsz;
        if (skipctx) u.pm += 1 + (u.pm >= 32 ? 1 : 0);
        return true;
    }
};
__device__ __forceinline__ unsigned cvt_pk_bf16(float lo, float hi) { unsigned r; asm volatile("v_cvt_pk_bf16_f32 %0, %1, %2" : "=v"(r) : "v"(lo), "v"(hi)); return r; }

struct EpiF32 {
    static constexpr bool PERM = false; static constexpr int MIDK = 0;
    float* C; int ldc;
    __device__ __forceinline__ void operator()(const f32x4 (&acc)[2][2][4][2], const Unit& u, int wr, int wc, int fr, int fq) const {
        const int row0 = u.pm * BM + wr * 64 + fr, col0 = u.pn * BM + wc * 32 + 4 * fq;
#pragma unroll
        for (int ai = 0; ai < 2; ++ai)
#pragma unroll
            for (int m = 0; m < 4; ++m) { float* rowp = C + (size_t)(row0 + ai * HALF + m * 16) * ldc + col0;
#pragma unroll
                for (int bj = 0; bj < 2; ++bj)
#pragma unroll
                    for (int n = 0; n < 2; ++n) *(f32x4*)(rowp + bj * HALF + n * 16) = acc[ai][bj][m][n]; }
    }
};

template <class Epi>
__device__ __forceinline__ void gemm_phase(PG8_LAS unsigned char* lds, const Gemm g, const StaticOrder& S, const Epi& E) {
    const int tid = otid(), wid = __builtin_amdgcn_readfirstlane(tid >> 6), lane = tid & 63, wr = wid >> 2, wc = wid & 3, fr = lane & 15, fq = lane >> 4;
    const int K = g.K, nt = K / BK;
    unsigned voffA[2], voffB[2];
#pragma unroll
    for (int i = 0; i < 2; ++i) { int R, C; stage_rc(tid * 16 + i * 8192, R, C); const int Rb = Epi::PERM ? ((R & ~31) + perm32(R & 31)) : R;
        voffA[i] = (unsigned)(R * g.lda + C) * 2u; voffB[i] = (unsigned)(Rb * g.ldb + C) * 2u; }
    const size_t kstep = (size_t)(BK * 2);
    const size_t hA = (size_t)HALF * g.lda * 2, hB = (size_t)HALF * g.ldb * 2;
    const size_t tA = 2 * hA, tB = 2 * hB;
    const unsigned ldsw = (unsigned)wid * 1024u;
    const int aoff = lds_byte(wr * 64 + fr, fq * 8), boff = lds_byte(wc * 32 + fr, fq * 8);
#define PG8_SA(b, h) (((b) * 2 + (h)) * HTB)
#define PG8_SB(b, h) ((4 + (b) * 2 + (h)) * HTB)
#define PG8_STAGE(bufoff, gbase, voff) do { _Pragma("unroll") for (int _i = 0; _i < 2; ++_i) \
        __builtin_amdgcn_global_load_lds((const unsigned*)((const char*)(gbase) + (voff)[_i]), (PG8_LAS unsigned*)(lds + (bufoff) + ldsw + _i * 8192), 16, 0, 0); } while (0)
#define PG8_LDA(dst, b, h) do { _Pragma("unroll") for (int m = 0; m < 4; ++m) _Pragma("unroll") for (int k = 0; k < 2; ++k) dst[m][k] = *(const PG8_LAS bf16x8*)(lds + PG8_SA(b, h) + aoff + m * 2048 + k * 1024); } while (0)
#define PG8_LDB(dst, b, h) do { _Pragma("unroll") for (int n = 0; n < 2; ++n) _Pragma("unroll") for (int k = 0; k < 2; ++k) dst[n][k] = *(const PG8_LAS bf16x8*)(lds + PG8_SB(b, h) + boff + n * 2048 + k * 1024); } while (0)
#define PG8_MMA(ai, bj, At, Bt) do { __builtin_amdgcn_s_setprio(1); _Pragma("unroll") for (int m = 0; m < 4; ++m) _Pragma("unroll") for (int n = 0; n < 2; ++n) _Pragma("unroll") for (int k = 0; k < 2; ++k) \
        acc[ai][bj][m][n] = __builtin_amdgcn_mfma_f32_16x16x32_bf16(Bt[n][k], At[m][k], acc[ai][bj][m][n], 0, 0, 0); __builtin_amdgcn_s_setprio(0); } while (0)
#define PG8_WAIT_V(n) asm volatile("s_waitcnt vmcnt(" #n ")" ::: "memory")
#define PG8_WAIT_L(n) asm volatile("s_waitcnt lgkmcnt(" #n ")" ::: "memory")
#define PG8_BAR __builtin_amdgcn_s_barrier()
#define PG8_SCHED __builtin_amdgcn_sched_barrier(0)
    Unit cur, nxt; int ui = 0;
    if (!S.next(0, cur)) return;
    f32x4 acc[2][2][4][2];
#pragma unroll
    for (int a = 0; a < 2; ++a)
#pragma unroll
        for (int b = 0; b < 2; ++b)
#pragma unroll
            for (int m = 0; m < 4; ++m)
#pragma unroll
                for (int n = 0; n < 2; ++n) acc[a][b][m][n] = (f32x4){0.f, 0.f, 0.f, 0.f};
    bf16x8 At[4][2], B0[2][2], B1[2][2];
    const char* cA = (const char*)g.A + (size_t)cur.pm * tA; const char* cB = (const char*)g.Bt + (size_t)cur.pn * tB;
    PG8_STAGE(PG8_SB(0, 0), cB, voffB); PG8_STAGE(PG8_SB(0, 1), cB + hB, voffB); PG8_STAGE(PG8_SA(0, 0), cA, voffA); PG8_STAGE(PG8_SA(0, 1), cA + hA, voffA);
    if (wr == 1) PG8_BAR;
    PG8_WAIT_V(2); PG8_BAR;
    PG8_STAGE(PG8_SB(1, 0), cB + kstep, voffB); PG8_STAGE(PG8_SA(1, 0), cA + kstep, voffA); PG8_STAGE(PG8_SB(1, 1), cB + hB + kstep, voffB);
    PG8_WAIT_V(6); PG8_BAR;
    for (;;) {
        const bool has_next = S.next(ui + 1, nxt);
        const char* nA = has_next ? (const char*)g.A + (size_t)nxt.pm * tA : cA; const char* nB = has_next ? (const char*)g.Bt + (size_t)nxt.pn * tB : cB;
#pragma unroll 1
        for (int t = 0; t < nt; t += 2) {
            if constexpr (Epi::MIDK > 0) { if (t > 0 && (t % Epi::MIDK) == 0) E.mid(acc, cur, wr, wc, fr, fq, t / Epi::MIDK); }
            const bool last = (t == nt - 2);
            const char* a1 = cA + (size_t)(t + 1) * kstep;
            const char* a2 = last ? nA : cA + (size_t)(t + 2) * kstep; const char* b2 = last ? nB : cB + (size_t)(t + 2) * kstep;
            const char* a3 = a2 + kstep; const char* b3 = b2 + kstep;
            PG8_LDB(B0, 0, 0); PG8_LDB(B1, 0, 1); PG8_SCHED; PG8_LDA(At, 0, 0); PG8_STAGE(PG8_SA(1, 1), a1 + hA, voffA);
            PG8_WAIT_V(8); PG8_WAIT_L(0); PG8_BAR; PG8_MMA(0, 0, At, B0); PG8_MMA(0, 1, At, B1); PG8_BAR; PG8_SCHED;
            PG8_LDA(At, 0, 1); PG8_STAGE(PG8_SB(0, 0), b2, voffB); PG8_STAGE(PG8_SB(0, 1), b2 + hB, voffB); PG8_STAGE(PG8_SA(0, 0), a2, voffA);
            PG8_WAIT_V(8); PG8_WAIT_L(0); PG8_BAR; PG8_MMA(1, 0, At, B0); PG8_MMA(1, 1, At, B1); PG8_BAR; PG8_SCHED;
            PG8_LDB(B0, 1, 0); PG8_LDB(B1, 1, 1); PG8_SCHED; PG8_LDA(At, 1, 0); PG8_STAGE(PG8_SA(0, 1), a2 + hA, voffA);
            PG8_WAIT_V(8); PG8_WAIT_L(0); PG8_BAR; PG8_MMA(0, 0, At, B0); PG8_MMA(0, 1, At, B1); PG8_BAR; PG8_SCHED;
            PG8_LDA(At, 1, 1); PG8_STAGE(PG8_SB(1, 0), b3, voffB); PG8_STAGE(PG8_SB(1, 1), b3 + hB, voffB); PG8_STAGE(PG8_SA(1, 0), a3, voffA);
            PG8_WAIT_V(8); PG8_WAIT_L(0); PG8_BAR; PG8_MMA(1, 0, At, B0); PG8_MMA(1, 1, At, B1); PG8_BAR; PG8_SCHED;
        }
        if (wr == 0) PG8_BAR;
        E(acc, cur, wr, wc, fr, fq);
        if (!has_next) break;
#pragma unroll
        for (int a = 0; a < 2; ++a)
#pragma unroll
            for (int b = 0; b < 2; ++b)
#pragma unroll
                for (int m = 0; m < 4; ++m)
#pragma unroll
                    for (int n = 0; n < 2; ++n) acc[a][b][m][n] = (f32x4){0.f, 0.f, 0.f, 0.f};
        cur = nxt; cA = nA; cB = nB; ++ui;
        if (wr == 1) PG8_BAR;
    }
    PG8_WAIT_V(0);
    PG8_BAR;
#undef PG8_SA
#undef PG8_SB
#undef PG8_STAGE
#undef PG8_LDA
#undef PG8_LDB
#undef PG8_MMA
#undef PG8_WAIT_V
#undef PG8_WAIT_L
#undef PG8_BAR
#undef PG8_SCHED
}

struct UnitG { const char* a; const char* b; int row0, pn, e, valid; const int* rows; };
template <class Epi, class Sched, bool GATHER>
__device__ __forceinline__ void gemm_phase_g(PG8_LAS unsigned char* lds, const int K, const int lda, const int ldb, const Sched& S, const Epi& E) {
    const int tid = otid(), wid = __builtin_amdgcn_readfirstlane(tid >> 6), lane = tid & 63, wr = wid >> 2, wc = wid & 3, fr = lane & 15, fq = lane >> 4;
    const int nt = K / BK;
    int RA[2], CA[2]; unsigned voffB[2];
#pragma unroll
    for (int i = 0; i < 2; ++i) { int R, C; stage_rc(tid * 16 + i * 8192, R, C); const int Rb = Epi::PERM ? ((R & ~31) + perm32(R & 31)) : R;
        RA[i] = R; CA[i] = C; voffB[i] = (unsigned)(Rb * ldb + C) * 2u; }
    const size_t kstep = (size_t)(BK * 2);
    const size_t hB = (size_t)HALF * ldb * 2;
    const unsigned ldsw = (unsigned)wid * 1024u;
    const int aoff = lds_byte(wr * 64 + fr, fq * 8), boff = lds_byte(wc * 32 + fr, fq * 8);
#define PG8_SA(b, h) (((b) * 2 + (h)) * HTB)
#define PG8_SB(b, h) ((4 + (b) * 2 + (h)) * HTB)
#define PG8_STAGE(bufoff, gbase, voff) do { _Pragma("unroll") for (int _i = 0; _i < 2; ++_i) \
        __builtin_amdgcn_global_load_lds((const unsigned*)((const char*)(gbase) + (voff)[_i]), (PG8_LAS unsigned*)(lds + (bufoff) + ldsw + _i * 8192), 16, 0, 0); } while (0)
#define PG8_LDA(dst, b, h) do { _Pragma("unroll") for (int m = 0; m < 4; ++m) _Pragma("unroll") for (int k = 0; k < 2; ++k) dst[m][k] = *(const PG8_LAS bf16x8*)(lds + PG8_SA(b, h) + aoff + m * 2048 + k * 1024); } while (0)
#define PG8_LDB(dst, b, h) do { _Pragma("unroll") for (int n = 0; n < 2; ++n) _Pragma("unroll") for (int k = 0; k < 2; ++k) dst[n][k] = *(const PG8_LAS bf16x8*)(lds + PG8_SB(b, h) + boff + n * 2048 + k * 1024); } while (0)
#define PG8_MMA(ai, bj, At, Bt) do { __builtin_amdgcn_s_setprio(1); _Pragma("unroll") for (int m = 0; m < 4; ++m) _Pragma("unroll") for (int n = 0; n < 2; ++n) _Pragma("unroll") for (int k = 0; k < 2; ++k) \
        acc[ai][bj][m][n] = __builtin_amdgcn_mfma_f32_16x16x32_bf16(Bt[n][k], At[m][k], acc[ai][bj][m][n], 0, 0, 0); __builtin_amdgcn_s_setprio(0); } while (0)
#define PG8_WAIT_V(n) asm volatile("s_waitcnt vmcnt(" #n ")" ::: "memory")
#define PG8_WAIT_L(n) asm volatile("s_waitcnt lgkmcnt(" #n ")" ::: "memory")
#define PG8_BAR __builtin_amdgcn_s_barrier()
#define PG8_SCHED __builtin_amdgcn_sched_barrier(0)
#define PG8_MKOFF(u, v) do { _Pragma("unroll") for (int _h = 0; _h < 2; ++_h) _Pragma("unroll") for (int _i = 0; _i < 2; ++_i) { const int _row = _h * HALF + RA[_i]; \
        if (GATHER) { const int _pr = _row < (u).valid ? (u).rows[_row] : 0; v[_h][_i] = (unsigned)(_pr >> 3) * (unsigned)(lda * 2) + (unsigned)(CA[_i] * 2); } \
        else v[_h][_i] = (unsigned)(_row * lda + CA[_i]) * 2u; } } while (0)
    UnitG cur, nxt; int ui = 0;
    if (!S.next(0, cur)) return;
    f32x4 acc[2][2][4][2];
#pragma unroll
    for (int a = 0; a < 2; ++a)
#pragma unroll
        for (int b = 0; b < 2; ++b)
#pragma unroll
            for (int m = 0; m < 4; ++m)
#pragma unroll
                for (int n = 0; n < 2; ++n) acc[a][b][m][n] = (f32x4){0.f, 0.f, 0.f, 0.f};
    bf16x8 At[4][2], B0[2][2], B1[2][2];
    unsigned vA[2][2], vN[2][2];
    PG8_MKOFF(cur, vA);
    const char* cA = cur.a; const char* cB = cur.b;
    PG8_STAGE(PG8_SB(0, 0), cB, voffB); PG8_STAGE(PG8_SB(0, 1), cB + hB, voffB); PG8_STAGE(PG8_SA(0, 0), cA, vA[0]); PG8_STAGE(PG8_SA(0, 1), cA, vA[1]);
    if (wr == 1) PG8_BAR;
    PG8_WAIT_V(2); PG8_BAR;
    PG8_STAGE(PG8_SB(1, 0), cB + kstep, voffB); PG8_STAGE(PG8_SA(1, 0), cA + kstep, vA[0]); PG8_STAGE(PG8_SB(1, 1), cB + hB + kstep, voffB);
    PG8_WAIT_V(6); PG8_BAR;
    for (;;) {
        const bool has_next = S.next(ui + 1, nxt);
        if constexpr (GATHER) { if (has_next) { PG8_MKOFF(nxt, vN); } else { vN[0][0] = vA[0][0]; vN[0][1] = vA[0][1]; vN[1][0] = vA[1][0]; vN[1][1] = vA[1][1]; } }
        const char* nA = has_next ? nxt.a : cA; const char* nB = has_next ? nxt.b : cB;
#pragma unroll 1
        for (int t = 0; t < nt; t += 2) {
            const bool last = (t == nt - 2);
            const char* a1 = cA + (size_t)(t + 1) * kstep;
            const char* a2 = last ? nA : cA + (size_t)(t + 2) * kstep; const char* b2 = last ? nB : cB + (size_t)(t + 2) * kstep;
            const char* a3 = a2 + kstep; const char* b3 = b2 + kstep;
            unsigned s0[2], s1[2];
            if constexpr (GATHER) { s0[0] = last ? vN[0][0] : vA[0][0]; s0[1] = last ? vN[0][1] : vA[0][1]; s1[0] = last ? vN[1][0] : vA[1][0]; s1[1] = last ? vN[1][1] : vA[1][1]; }
            else { s0[0] = vA[0][0]; s0[1] = vA[0][1]; s1[0] = vA[1][0]; s1[1] = vA[1][1]; }
            PG8_LDB(B0, 0, 0); PG8_LDB(B1, 0, 1); PG8_SCHED; PG8_LDA(At, 0, 0); PG8_STAGE(PG8_SA(1, 1), a1, vA[1]);
            PG8_WAIT_V(8); PG8_WAIT_L(0); PG8_BAR; PG8_MMA(0, 0, At, B0); PG8_MMA(0, 1, At, B1); PG8_BAR; PG8_SCHED;
            PG8_LDA(At, 0, 1); PG8_STAGE(PG8_SB(0, 0), b2, voffB); PG8_STAGE(PG8_SB(0, 1), b2 + hB, voffB); PG8_STAGE(PG8_SA(0, 0), a2, s0);
            PG8_WAIT_V(8); PG8_WAIT_L(0); PG8_BAR; PG8_MMA(1, 0, At, B0); PG8_MMA(1, 1, At, B1); PG8_BAR; PG8_SCHED;
            PG8_LDB(B0, 1, 0); PG8_LDB(B1, 1, 1); PG8_SCHED; PG8_LDA(At, 1, 0); PG8_STAGE(PG8_SA(0, 1), a2, s1);
            PG8_WAIT_V(8); PG8_WAIT_L(0); PG8_BAR; PG8_MMA(0, 0, At, B0); PG8_MMA(0, 1, At, B1); PG8_BAR; PG8_SCHED;
            PG8_LDA(At, 1, 1); PG8_STAGE(PG8_SB(1, 0), b3, voffB); PG8_STAGE(PG8_SB(1, 1), b3 + hB, voffB); PG8_STAGE(PG8_SA(1, 0), a3, s0);
            PG8_WAIT_V(8); PG8_WAIT_L(0); PG8_BAR; PG8_MMA(1, 0, At, B0); PG8_MMA(1, 1, At, B1); PG8_BAR; PG8_SCHED;
        }
        if (wr == 0) PG8_BAR;
        E(acc, cur, wr, wc, fr, fq);
        if (!has_next) break;
#pragma unroll
        for (int a = 0; a < 2; ++a)
#pragma unroll
            for (int b = 0; b < 2; ++b)
#pragma unroll
                for (int m = 0; m < 4; ++m)
#pragma unroll
                    for (int n = 0; n < 2; ++n) acc[a][b][m][n] = (f32x4){0.f, 0.f, 0.f, 0.f};
        cur = nxt; cA = nA; cB = nB; ++ui;
        if constexpr (GATHER) { vA[0][0] = vN[0][0]; vA[0][1] = vN[0][1]; vA[1][0] = vN[1][0]; vA[1][1] = vN[1][1]; }
        if (wr == 1) PG8_BAR;
    }
    PG8_WAIT_V(0);
    PG8_BAR;
#undef PG8_SA
#undef PG8_SB
#undef PG8_STAGE
#undef PG8_LDA
#undef PG8_LDB
#undef PG8_MMA
#undef PG8_WAIT_V
#undef PG8_WAIT_L
#undef PG8_BAR
#undef PG8_SCHED
#undef PG8_MKOFF
}
}

constexpr int DM = 1024, NB = 2, SEQ = 8192, CTX = 256, TPB = SEQ + CTX, MROWS = NB * TPB, DEPTH = 2;
constexpr int INW = 9216, COL_K = 0, COL_V = 1024, COL_LX = 2048, COL_Q = 3072, COL_LG = 4096, COL_F = 5120, COL_G = 6144;
constexpr int NE = 256, TOPK = 8, EFF = 256, NPAIR = MROWS * TOPK, LCAP = MROWS;
constexpr float EPS = 1e-6f;
constexpr float QSCALE = 0.125f * 1.4426950408889634f;
constexpr int NCHUNK = TPB / 64;
static_assert(MROWS % 256 == 0, "rows");

constexpr size_t MiB = 1u << 20;
constexpr size_t WS_CTL = 0, CTL_ZERO_BYTES = 1 * MiB;
constexpr size_t WS_W = 1 * MiB, WL_STRIDE = 32 * MiB;
constexpr size_t WO_TAB = 31 * MiB;
constexpr size_t WO_WIN = 0, WO_D1 = 18 * MiB, WO_OUT = 24 * MiB, WO_R = 26 * MiB, WO_SGU = 27 * MiB, WO_SD = 28 * MiB, WO_LRU = 29 * MiB;
constexpr size_t WS_XALL = 65 * MiB;
constexpr size_t WS_H = WS_XALL + 66 * MiB;
constexpr size_t WS_U = WS_H + 33 * MiB;
constexpr size_t WS_KB = WS_U + 594 * MiB, WS_VB = WS_KB + 33 * MiB, WS_QB = WS_VB + 33 * MiB, WS_LXB = WS_QB + 33 * MiB, WS_GLG = WS_LXB + 33 * MiB, WS_ZP = WS_GLG + 33 * MiB;
constexpr size_t WS_GATES = WS_ZP + 33 * MiB;
constexpr size_t WS_MIXIN = WS_GATES + 99 * MiB;
constexpr size_t WS_S = WS_MIXIN + 99 * MiB;
constexpr size_t WS_UC = WS_S, WS_AB = WS_UC + 33 * MiB, WS_SUMM = WS_AB + 132 * MiB, WS_CARRY = WS_SUMM + 5 * MiB, WS_XA = WS_CARRY + 3 * MiB, WS_XB = WS_XA + 32 * MiB, WS_GB = WS_XB + 32 * MiB, WS_GC = WS_GB + 32 * MiB;
constexpr size_t WS_PA = WS_S, WS_PR = WS_PA + 66 * MiB, WS_PF = WS_PR + 66 * MiB, WS_Y1 = WS_PF + 66 * MiB;
static_assert(WS_GC + 3 * MiB <= WS_S + 280 * MiB && WS_Y1 + 66 * MiB <= WS_S + 280 * MiB, "scratch S");
constexpr size_t WS_MIXED = WS_S + 280 * MiB, WS_TOK = WS_MIXED + 33 * MiB;
constexpr size_t WS_LOG = WS_TOK + 33 * MiB, WS_SGU = WS_LOG + 17 * MiB, WS_SH = WS_SGU + 33 * MiB, WS_LIST = WS_SH + 9 * MiB, WS_TOPW = WS_LIST + 17 * MiB, WS_SD = WS_TOPW + 1 * MiB;
constexpr size_t WS_YB = WS_U;
constexpr size_t WS_Y16 = WS_U, WS_HB = WS_U + 392 * MiB;
constexpr size_t WS_EP = WS_SUMM;
constexpr size_t WS_Y16_OLD = WS_U;
constexpr size_t WS_EW = WS_SD + 66 * MiB, EW_STRIDE = 3 * MiB / 2;
constexpr size_t WS_END = WS_EW + 384 * MiB;
static_assert(WS_END <= 2048 * MiB, "d_ws budget");
constexpr int CW_BAR = 4096;
constexpr int CW_CNT = 16384, CNT_STRIDE = 32;
constexpr int CW_MOD = 65536;
static_assert((CW_MOD + 2 * 3 * 6144) * 4 <= (int)CTL_ZERO_BYTES, "ctl");

constexpr int LDS_BYTES = 147456, RING_BYTES = 131072, MISC_OFF = RING_BYTES + 320;
constexpr int NWAVES = 8;

#define GAS __attribute__((address_space(1)))
#define LAS __attribute__((address_space(3)))
typedef unsigned short bf16;
typedef unsigned v4u __attribute__((ext_vector_type(4)));
typedef float f32x4 __attribute__((ext_vector_type(4)));
typedef GAS unsigned gu32;
#define RLX_AGENT __ATOMIC_RELAXED, __HIP_MEMORY_SCOPE_AGENT
#define LDS_WAIT() asm volatile("s_waitcnt lgkmcnt(0)" ::: "memory")
__device__ __forceinline__ unsigned f2bf(float f) { unsigned u = __builtin_bit_cast(unsigned, f); return (u + 0x7fffu + ((u >> 16) & 1u)) >> 16; }
__device__ __forceinline__ unsigned pk2(float lo, float hi) { return f2bf(lo) | (f2bf(hi) << 16); }
__device__ __forceinline__ float bf2f(unsigned h) { return __uint_as_float(h << 16); }
__device__ __forceinline__ float sigmoidf_(float x) { return 1.f / (1.f + __expf(-x)); }
__device__ __forceinline__ float siluf_(float x) { return x / (1.f + __expf(-x)); }
__device__ __forceinline__ float gelu_tanh(float x) { const float u = 0.7978845608028654f * (x + 0.044715f * x * x * x); return x / (1.f + __expf(-2.f * u)); }

#define XB_TMO      128
#define XB_XCNT(j)  (256  + 64 * (j))
#define XB_XSUB(j)  (1280 + 64 * (j))
#define XB_XGEN(j)  (2304 + 64 * (j))
#define XB_TOP      3328
#define XB_TOPGEN   3392
#define XCD_BAR_WORDS 3456
#define XB_SPIN_CAP (1u << 18)
__device__ __forceinline__ unsigned xb_ld(unsigned* p)              { return __hip_atomic_load(p, __ATOMIC_RELAXED, __HIP_MEMORY_SCOPE_AGENT); }
__device__ __forceinline__ unsigned xb_add(unsigned* p, unsigned v) { return __hip_atomic_fetch_add(p, v, __ATOMIC_RELAXED, __HIP_MEMORY_SCOPE_AGENT); }
__device__ __forceinline__ unsigned xb_xcc_id() { return (unsigned)__builtin_amdgcn_s_getreg((3 << 11) | 20) & 0xFu; }
#define XB_SPIN(cond, bar) do { unsigned _sp = 0; while (cond) { __builtin_amdgcn_s_sleep(1); \
    if ((++_sp & 255u) == 0u) { if (xb_ld(&(bar)[XB_TMO])) break; if (_sp > XB_SPIN_CAP) { atomicAdd(&(bar)[XB_TMO], 1u); break; } } } } while (0)
struct XcdBarrier { unsigned* bar; unsigned x; volatile LAS unsigned* st; };
__device__ __forceinline__ XcdBarrier xcd_barrier_post(unsigned* bar, volatile LAS unsigned* st) {
    XcdBarrier b; b.bar = bar; b.x = xb_xcc_id(); b.st = st;
    if (threadIdx.x == 0) (void)xb_add(&bar[XB_XCNT(b.x)], 1u);
    return b;
}
__device__ __forceinline__ void xcd_barrier_complete(unsigned* bar, unsigned x, unsigned& nloc, unsigned& nx) {
    const unsigned G = gridDim.x * gridDim.y * gridDim.z;
    unsigned sum, cnt, mine, sp = 0u;
    for (;;) {
        sum = 0u; cnt = 0u; mine = 0u;
#pragma unroll
        for (unsigned j = 0; j < 16; ++j) { const unsigned c = xb_ld(&bar[XB_XCNT(j)]); sum += c; cnt += (c > 0u) ? 1u : 0u; mine = (j == x) ? c : mine; }
        if (sum == G) break;
        __builtin_amdgcn_s_sleep(1);
        if ((++sp & 255u) == 0u) { if (xb_ld(&bar[XB_TMO])) break; if (sp > XB_SPIN_CAP) { atomicAdd(&bar[XB_TMO], 1u); break; } }
    }
    nloc = mine > 0u ? mine : 1u; nx = cnt > 0u ? cnt : 1u;
}
__device__ __forceinline__ void xcd_barrier(const XcdBarrier& b) {
    asm volatile("s_waitcnt vmcnt(0)" ::: "memory");
    __syncthreads();
    if (threadIdx.x == 0) {
        unsigned* bar = b.bar; asm volatile("" : "+s"(bar));
        __builtin_amdgcn_s_waitcnt(0);
        unsigned nloc = b.st[0], nx = b.st[1];
        unsigned bx = b.x; asm volatile("" : "+s"(bx));
        if (nloc == 0u) { xcd_barrier_complete(bar, bx, nloc, nx); b.st[0] = nloc; b.st[1] = nx; }
        const unsigned old = xb_add(&bar[XB_XSUB(bx)], 1u);
        const unsigned gen = old / nloc;
        if (old + 1u == (gen + 1u) * nloc) {
            __builtin_amdgcn_fence(__ATOMIC_RELEASE, "agent");
            asm volatile("s_waitcnt vmcnt(0)" ::: "memory");
            const unsigned og = xb_add(&bar[XB_TOP], 1u);
            const unsigned tg = og / nx;
            if (og + 1u == (tg + 1u) * nx) xb_add(&bar[XB_TOPGEN], 1u);
            else XB_SPIN(xb_ld(&bar[XB_TOPGEN]) == tg, bar);
            __builtin_amdgcn_fence(__ATOMIC_ACQUIRE, "agent");
            xb_add(&bar[XB_XGEN(bx)], 1u);
            asm volatile("s_waitcnt vmcnt(0)" ::: "memory");
        } else {
            XB_SPIN(xb_ld(&bar[XB_XGEN(bx)]) == gen, bar);
            __builtin_amdgcn_fence(__ATOMIC_ACQUIRE, "agent");
            asm volatile("s_waitcnt vmcnt(0)" ::: "memory");
        }
    }
    __syncthreads();
}

struct Args { const float* in[32]; float* out; unsigned char* ws; int ph_lo, ph_hi; };
struct Frame { LAS unsigned char* lds; int tid, lane, wave, bid, G, gw, NGW; long gtid, NT; };
#define WSP(T, off) ((T*)(A.ws + (off)))
#define WLP(l, off) ((bf16*)(A.ws + WS_W + (size_t)(l) * WL_STRIDE + (off)))
#define MODP(l, s, j) ((const float*)(A.ws + WS_CTL) + CW_MOD + ((l) * 3 + (s)) * 6144 + (j) * 1024)

__device__ __forceinline__ float wave_sum(float v) {
    v += sx<1>(v); v += sx<2>(v); v += sx<4>(v); v += sx<8>(v); v += sx<16>(v); v += sx<32>(v);
    return v;
}
__device__ __forceinline__ int win_row(int c) {
    const int sec = c >> 10; if (sec != 0 && sec != 3) return c;
    const int L = c & 255, g = L >> 6, a = (L >> 5) & 1, x = (L >> 4) & 1, q = (L >> 2) & 3, e = L & 3;
    return (c & ~255) | (128 * a + 32 * g + 8 * q + 4 * x + e);
}
template <bool WINMAP = false>
__device__ __forceinline__ void p0_transpose_item(const float* W, int K, int N, bf16* WT, int ldwt, int row_off, int col_off, LAS float* scr, int item, int lane) {
    const int nblk = N / 32, kb = item / nblk, nb = item % nblk, k0 = 64 * kb, n0 = 32 * nb;
    { f32x4 v[8]; const int rr = lane >> 3, c4 = (lane & 7) * 4;
#pragma unroll
      for (int i = 0; i < 8; ++i) v[i] = *(const f32x4*)(W + (size_t)(k0 + 8 * i + rr) * N + n0 + c4);
#pragma unroll
      for (int i = 0; i < 8; ++i) { LAS float* d = scr + (8 * i + rr) * 33 + c4; d[0] = v[i].x; d[1] = v[i].y; d[2] = v[i].z; d[3] = v[i].w; } }
    LDS_WAIT(); asm volatile("" ::: "memory");
    const int c = lane & 7;
#pragma unroll
    for (int j = 0; j < 4; ++j) { const int n = (lane >> 3) + 8 * j; const LAS float* s = scr + (8 * c) * 33 + n;
        v4u o; o.x = pk2(s[0 * 33], s[1 * 33]); o.y = pk2(s[2 * 33], s[3 * 33]); o.z = pk2(s[4 * 33], s[5 * 33]); o.w = pk2(s[6 * 33], s[7 * 33]);
        const int rr = WINMAP ? win_row(n0 + n) : n0 + n;
        *(v4u*)(WT + (size_t)(row_off + rr) * ldwt + col_off + k0 + 8 * c) = o; }
    LDS_WAIT(); asm volatile("" ::: "memory");
}

__device__ __forceinline__ void ph_prologue(const Frame& F, const Args& A) {
    LAS float* scr = (LAS float*)(F.lds + F.wave * 16384);
    constexpr int I_WIN = 16 * 288, I_SQ = 16 * 32, I_R = 16 * 8, I_SD = 4 * 32;
    constexpr int PER_L = I_WIN + 4 * I_SQ + 3 * I_R + I_SD;
    for (int it = F.gw; it < 2 * PER_L; it += F.NGW) {
        const int l = it / PER_L; int r = it % PER_L;
        if (r < I_WIN) {
#if FAST_WIN
            const int nb = r % 288; if (nb >= 160 && nb < 192) continue;
            p0_transpose_item<true>(A.in[7] + (size_t)l * 1024 * 9216, 1024, 9216, WLP(l, WO_WIN), 1024, 0, 0, scr, r, F.lane); continue;
#else
            p0_transpose_item(A.in[7] + (size_t)l * 1024 * 9216, 1024, 9216, WLP(l, WO_WIN), 1024, 0, 0, scr, r, F.lane); continue;
#endif
        } r -= I_WIN;
        if (r < I_SQ) { p0_transpose_item(A.in[12] + (size_t)l * 1048576, 1024, 1024, WLP(l, WO_D1), 3072, 0, 0, scr, r, F.lane); continue; } r -= I_SQ;
        if (r < I_SQ) { p0_transpose_item(A.in[20] + (size_t)l * 1048576, 1024, 1024, WLP(l, WO_D1), 3072, 0, 1024, scr, r, F.lane); continue; } r -= I_SQ;
        if (r < I_SQ) { p0_transpose_item(A.in[21] + (size_t)l * 1048576, 1024, 1024, WLP(l, WO_D1), 3072, 0, 2048, scr, r, F.lane); continue; } r -= I_SQ;
        if (r < I_SQ) { p0_transpose_item(A.in[22] + (size_t)l * 1048576, 1024, 1024, WLP(l, WO_OUT), 1024, 0, 0, scr, r, F.lane); continue; } r -= I_SQ;
        if (r < I_R) { p0_transpose_item(A.in[24] + (size_t)l * 262144, 1024, 256, WLP(l, WO_R), 1024, 0, 0, scr, r, F.lane); continue; } r -= I_R;
        if (r < I_R) { p0_transpose_item(A.in[29] + (size_t)l * 262144, 1024, 256, WLP(l, WO_SGU), 1024, 0, 0, scr, r, F.lane); continue; } r -= I_R;
        if (r < I_R) { p0_transpose_item(A.in[30] + (size_t)l * 262144, 1024, 256, WLP(l, WO_SGU), 1024, 256, 0, scr, r, F.lane); continue; } r -= I_R;
        p0_transpose_item(A.in[31] + (size_t)l * 262144, 256, 1024, WLP(l, WO_SD), 256, 0, 0, scr, r, F.lane);
    }
#if FAST_WIN
    {
        LAS float* sW = (LAS float*)F.lds; LAS float* sT = sW + 32 * 256;
        __syncthreads();
        if (F.tid < 256) sT[F.tid] = cospif((float)F.tid / 128.0f);
        for (int it = F.bid; it < 2 * 4 * 32; it += F.G) {
            const int l = it >> 7, g = (it >> 5) & 3, k0 = (it & 31) * 32;
            __syncthreads();
            for (int e = F.tid; e < 32 * 256; e += 512) sW[e] = A.in[7][((size_t)l * 1024 + k0 + (e >> 8)) * 9216 + COL_F + g * 256 + (e & 255)];
            __syncthreads();
            const int o = F.tid & 255, kh = F.tid >> 8; int j = o >> 1, odd = o & 1; if (o == 1) { j = 128; odd = 0; }
            const int m0 = odd ? 192 : 0; float acc[16];
#pragma unroll
            for (int q = 0; q < 16; ++q) acc[q] = 0.f;
            for (int c = 0; c < 256; ++c) { const float r = sT[(j * c + m0) & 255];
#pragma unroll
                for (int q = 0; q < 16; ++q) acc[q] += sW[(kh * 16 + q) * 256 + c] * r; }
            bf16* dst = WLP(l, WO_WIN) + (size_t)(COL_F + g * 256 + o) * 1024 + k0 + kh * 16;
            v4u w0, w1; w0.x = pk2(acc[0], acc[1]); w0.y = pk2(acc[2], acc[3]); w0.z = pk2(acc[4], acc[5]); w0.w = pk2(acc[6], acc[7]);
            w1.x = pk2(acc[8], acc[9]); w1.y = pk2(acc[10], acc[11]); w1.z = pk2(acc[12], acc[13]); w1.w = pk2(acc[14], acc[15]);
            *(v4u*)dst = w0; *(v4u*)(dst + 8) = w1;
        }
        __syncthreads();
    }
#endif
    float* MOD = (float*)(A.ws + WS_CTL) + CW_MOD;
    LAS float* part = (LAS float*)(F.lds + 8 * 16384 - 8192);
    for (int it = F.bid; it < 2 * 96; it += F.G) {
        const int l = it / 96, nb = it % 96, n = nb * 64 + F.lane;
        const float* wm = A.in[4] + (size_t)l * 1024 * 6144 + n;
        float a0 = 0.f, a1 = 0.f, a2 = 0.f;
#pragma unroll 8
        for (int k = F.wave * 128; k < F.wave * 128 + 128; ++k) {
            const float w = wm[(size_t)k * 6144];
            a0 += siluf_(A.in[1][k]) * w; a1 += siluf_(A.in[1][1024 + k]) * w; a2 += siluf_(A.in[3][k]) * w;
        }
        __syncthreads();
        part[(F.wave * 3 + 0) * 64 + F.lane] = a0; part[(F.wave * 3 + 1) * 64 + F.lane] = a1; part[(F.wave * 3 + 2) * 64 + F.lane] = a2;
        __syncthreads();
        if (F.wave < 3) { float s = A.in[5][l * 6144 + n];
#pragma unroll
            for (int w = 0; w < 8; ++w) s += part[(w * 3 + F.wave) * 64 + F.lane];
            MOD[(l * 3 + F.wave) * 6144 + n] = s; }
    }
    for (long i = F.gtid; i < 2L * 4096 * 256; i += F.NT) {
        const int l = (int)(i >> 20), n = (int)((i >> 8) & 4095), kk = (int)(i & 255), pn = n >> 8, rr = n & 255, gate = rr >> 7, rho = rr & 127, d = pn >> 3, cb = pn & 7;
        const int cho = 128 * cb + rho, blk = cho >> 6, e = cho & 63, chi = 256 * (cb >> 1) + kk; float v = 0.f;
        if ((chi >> 6) == blk) v = (gate ? A.in[17] : A.in[15])[((size_t)(l * 2 + d) * 16 + blk) * 4096 + (chi & 63) * 64 + e];
        WLP(l, WO_LRU)[i & 0xFFFFF] = (bf16)f2bf(v);
    }
    for (long i = F.gtid; i < 2L * 65536; i += F.NT) {
        const int which = (int)(i >> 16), n = (int)((i >> 8) & 255), k = (int)(i & 255); float v;
        if (which == 0) { const int k1 = n >> 1, cp = n & 1, t1 = k >> 1, c = k & 1; const float rev = (float)((k1 * t1) & 127) * (1.f / 128.f);
            const float cs = __builtin_amdgcn_cosf(rev), sn = __builtin_amdgcn_sinf(rev); v = cp == 0 ? (c == 0 ? cs : sn) : (c == 0 ? -sn : cs); }
        else { const int h = n >> 7, k2 = (n >> 1) & 63, cp = n & 1, hp = k >> 7, t2 = (k >> 1) & 63, c = k & 1; const float rev = (float)((k2 * t2) & 63) * (1.f / 64.f);
            const float cs = __builtin_amdgcn_cosf(rev), sn = __builtin_amdgcn_sinf(rev); v = (h != hp) ? 0.f : (cp == 0 ? (c == 0 ? cs : sn) : (c == 0 ? -sn : cs)); }
        WLP(0, WO_TAB)[i] = (bf16)f2bf(v);
    }
    for (long i = F.gtid; i < 4096; i += F.NT) ((float*)(A.ws + WS_W + WO_TAB + 262144))[i] = log1pf(expf(-A.in[19][i]));
    f32x4* XA = WSP(f32x4, WS_XALL);
    for (long i = F.gtid; i < (long)MROWS * 256; i += F.NT) {
        const int R = (int)(i >> 8), c4 = (int)(i & 255), b = R / TPB, p = R % TPB;
        const f32x4* src = (p < CTX) ? (const f32x4*)(A.in[2] + ((size_t)b * CTX + p) * 1024) : (const f32x4*)(A.in[0] + ((size_t)b * SEQ + (p - CTX)) * 1024);
        XA[i] = src[c4];
    }
}

__device__ __forceinline__ void norm_mod_row(const f32x4 (&v)[4], const float* g, const float* sc, const float* sh, bf16* orow, int lane) {
    float s = 0.f;
#pragma unroll
    for (int j = 0; j < 4; ++j) s += (v[j].x * v[j].x + v[j].y * v[j].y) + (v[j].z * v[j].z + v[j].w * v[j].w);
    const float rs = rsqrtf(wave_sum(s) * (1.f / 1024.f) + EPS);
#pragma unroll
    for (int j = 0; j < 4; ++j) { const int c = 4 * lane + 256 * j;
        const f32x4 gg = *(const f32x4*)(g + c), s1 = *(const f32x4*)(sc + c), s0 = *(const f32x4*)(sh + c);
        const float y0 = v[j].x * rs * gg.x * (1.f + s1.x) + s0.x, y1 = v[j].y * rs * gg.y * (1.f + s1.y) + s0.y, y2 = v[j].z * rs * gg.z * (1.f + s1.z) + s0.z, y3 = v[j].w * rs * gg.w * (1.f + s1.w) + s0.w;
        *(unsigned long long*)(orow + c) = (unsigned long long)pk2(y0, y1) | ((unsigned long long)pk2(y2, y3) << 32); }
}
__device__ __forceinline__ void ph_norm1(const Frame& F, const Args& A, int l) {
    const float* X = WSP(float, WS_XALL); bf16* H = WSP(bf16, WS_H);
    for (int R = F.gw; R < MROWS; R += F.NGW) {
        const int b = R / TPB, p = R % TPB, s = (p < CTX) ? 2 : b;
        f32x4 v[4];
#pragma unroll
        for (int j = 0; j < 4; ++j) v[j] = *(const f32x4*)(X + (size_t)R * 1024 + 4 * F.lane + 256 * j);
        norm_mod_row(v, A.in[6] + l * 1024, MODP(l, s, 1), MODP(l, s, 0), H + (size_t)R * 1024, F.lane);
    }
}

__device__ __forceinline__ void ph_uelem(const Frame& F, const Args& A, int l) {
    const float* U = WSP(float, WS_U);
    bf16 *Kb = WSP(bf16, WS_KB), *Vb = WSP(bf16, WS_VB), *Qb = WSP(bf16, WS_QB), *LXb = WSP(bf16, WS_LXB), *GLG = WSP(bf16, WS_GLG), *ZP = WSP(bf16, WS_ZP), *GT = WSP(bf16, WS_GATES);
    LAS float* sF = (LAS float*)F.lds; LAS float* sT = sF + 1024;
    if (F.tid < 256) sT[F.tid] = cospif((float)F.tid / 128.0f);
    __syncthreads();
    for (int R = F.bid; R < MROWS; R += F.G) {
        const float* u = U + (size_t)R * INW; const int p = R % TPB; const bool lat = p >= CTX; const int t = p - CTX;
        for (int gi = F.wave; gi < 32; gi += 8) {
            const bool isq = gi >= 16; const int grp = gi & 15;
            const float v = u[(isq ? COL_Q : COL_K) + grp * 64 + F.lane];
            const float ss = wave_sum(v * v);
            float y = v * rsqrtf(ss * (1.f / 64.f) + EPS) * (isq ? A.in[8] : A.in[9])[l * 64 + F.lane];
            const float part = sx<16>(y);
            if (lat) { const int axis = F.lane >> 5, hf = (F.lane >> 4) & 1, f = F.lane & 15;
                const float pos = (float)(axis ? (t & 63) : (t >> 6)); const float inv = exp2f(-(float)f * (13.287712379549449f / 16.f));
                float sn, cs; sincosf(pos * inv, &sn, &cs);
                y = hf ? (part * sn + y * cs) : (y * cs - part * sn); }
            if (isq) y *= QSCALE;
            (isq ? Qb : Kb)[(size_t)R * 1024 + grp * 64 + F.lane] = (bf16)f2bf(y);
        }
        for (int c = F.tid; c < 1024; c += 512) { const size_t o = (size_t)R * 1024 + c;
            Vb[o] = (bf16)f2bf(u[COL_V + c]); LXb[o] = (bf16)f2bf(u[COL_LX + c]); GLG[o] = (bf16)f2bf(gelu_tanh(u[COL_LG + c])); sF[c] = u[COL_F + c]; }
        for (int c = F.tid; c < 3072; c += 512) GT[(size_t)R * 3072 + c] = (bf16)f2bf(sigmoidf_(u[COL_G + c]));
        __syncthreads();
        for (int o = F.tid; o < 1024; o += 512) { const int g = o >> 8, oo = o & 255; int j = oo >> 1, odd = oo & 1; if (oo == 1) { j = 128; odd = 0; }
            const int m0 = odd ? 192 : 0; float acc = 0.f;
            for (int c = 0; c < 256; ++c) acc += sF[g * 256 + c] * sT[(j * c + m0) & 255];
            ZP[(size_t)R * 1024 + o] = (bf16)f2bf(acc); }
        __syncthreads();
    }
}

__device__ __forceinline__ void ph_conv(const Frame& F, const Args& A, int l) {
    const bf16* LXb = WSP(bf16, WS_LXB); bf16* UC = WSP(bf16, WS_UC);
    const float* cw = A.in[13] + l * 4096; const float* cb = A.in[14] + l * 1024;
    for (long i = F.gtid; i < (long)MROWS * 1024; i += F.NT) {
        const int R = (int)(i >> 10), ch = (int)(i & 1023), p = R % TPB; const int lo = p < CTX ? 0 : CTX, hi = p < CTX ? CTX : TPB;
        float acc = cb[ch];
#pragma unroll
        for (int j = 0; j < 4; ++j) { const int pp = p + j - 2; if (pp >= lo && pp < hi) acc += cw[j * 1024 + ch] * bf2f(LXb[(size_t)(R + j - 2) * 1024 + ch]); }
        UC[i] = (bf16)f2bf(acc);
    }
}
#if !FAST_LRU
__device__ __forceinline__ void ph_lrucoef(const Frame& F, const Args& A, int l) {
    const bf16* UC = WSP(bf16, WS_UC); unsigned* AB = WSP(unsigned, WS_AB);
    for (long i = F.gtid; i < 2L * MROWS * 1024; i += F.NT) {
        const int d = (int)(i / ((long)MROWS * 1024)); const long rem = i % ((long)MROWS * 1024); const int R = (int)(rem >> 10), ch = (int)(rem & 1023), blk = ch >> 6, e = ch & 63;
        const float* wa = A.in[15] + ((size_t)(l * 2 + d) * 16 + blk) * 4096 + e; const float* wi = A.in[17] + ((size_t)(l * 2 + d) * 16 + blk) * 4096 + e;
        float r = A.in[16][(l * 2 + d) * 1024 + ch], ig = A.in[18][(l * 2 + d) * 1024 + ch];
        const bf16* ur = UC + (size_t)R * 1024 + blk * 64;
        for (int dd = 0; dd < 64; ++dd) { const float x = bf2f(ur[dd]); r += x * wa[dd * 64]; ig += x * wi[dd * 64]; }
        const float lam = A.in[19][(l * 2 + d) * 1024 + ch]; const float sp = log1pf(expf(-lam));
        const float la = -8.f * sigmoidf_(r) * sp; const float mult = sqrtf(-expm1f(2.f * la));
        const float bc = mult * sigmoidf_(ig) * bf2f(ur[e]);
        AB[i] = pk2(la, bc);
    }
}
#endif
struct LruSched {
    const char* uc; const char* w; int G, c;
    __device__ __forceinline__ bool next(int i, pg8::UnitG& U) const {
        const long id = (long)i * G + c; if (id >= 66 * 16) return false;
        const int pm = (int)(id >> 4), pn = (int)(id & 15);
        U.a = uc + ((size_t)pm * 256 * 1024 + 256 * ((pn & 7) >> 1)) * 2; U.b = w + (size_t)pn * 256 * 256 * 2; U.row0 = pm * 256; U.pn = pn; U.e = 0; U.valid = 256; U.rows = nullptr; return true;
    }
};
struct EpiLru {
    static constexpr bool PERM = false;
    unsigned* AB; const bf16* UC; const float* ba; const float* bi; const float* sp;
    __device__ __forceinline__ void operator()(const f32x4 (&acc)[2][2][4][2], const pg8::UnitG& u, int wr, int wc, int fr, int fq) const {
        const int d = u.pn >> 3, cb = u.pn & 7, ch0 = 128 * cb + wc * 32 + 4 * fq;
        f32x4 vba[2], vbi[2], vsp[2];
#pragma unroll
        for (int n = 0; n < 2; ++n) { vba[n] = *(const f32x4*)(ba + d * 1024 + ch0 + 16 * n); vbi[n] = *(const f32x4*)(bi + d * 1024 + ch0 + 16 * n); vsp[n] = *(const f32x4*)(sp + d * 1024 + ch0 + 16 * n); }
#pragma unroll
        for (int ai = 0; ai < 2; ++ai)
#pragma unroll
            for (int m = 0; m < 4; ++m) { const size_t R = (size_t)u.row0 + ai * 128 + wr * 64 + m * 16 + fr;
#pragma unroll
                for (int n = 0; n < 2; ++n) { const int ch = ch0 + 16 * n;
                    const unsigned long long ux = *(const unsigned long long*)(UC + R * 1024 + ch);
                    const float x[4] = {bf2f((unsigned)ux & 0xffffu), bf2f(((unsigned)ux) >> 16), bf2f((unsigned)(ux >> 32) & 0xffffu), bf2f((unsigned)(ux >> 48))};
                    const f32x4 r = acc[ai][0][m][n] + vba[n], g = acc[ai][1][m][n] + vbi[n]; v4u o;
#pragma unroll
                    for (int e = 0; e < 4; ++e) { const float la = -8.f * sigmoidf_(r[e]) * vsp[n][e]; const float mult = sqrtf(fmaxf(1.f - __expf(2.f * la), 0.f));
                        o[e] = pk2(la, mult * sigmoidf_(g[e]) * x[e]); }
                    *(v4u*)(AB + ((size_t)d * MROWS + R) * 1024 + ch) = o; }
                asm volatile("" ::: "memory"); }
    }
};
__device__ __forceinline__ void ph_lru_gemm(const Frame& F, const Args& A, int l) {
    const int vcu = (F.G % 8 == 0) ? (F.bid % 8) * (F.G / 8) + F.bid / 8 : F.bid;
    LruSched S{(const char*)WSP(bf16, WS_UC), (const char*)WLP(l, WO_LRU), F.G, vcu};
    EpiLru E{WSP(unsigned, WS_AB), WSP(bf16, WS_UC), A.in[16] + l * 2048, A.in[18] + l * 2048, (const float*)(A.ws + WS_W + WO_TAB + 262144) + l * 2048};
    pg8::gemm_phase_g<EpiLru, LruSched, false>(F.lds, 256, 1024, 256, S, E);
}
struct FftSched {
    const char* x; const char* w; int nunits, G, c;
    __device__ __forceinline__ bool next(int i, pg8::UnitG& U) const {
        const long id = (long)i * G + c; if (id >= nunits) return false;
        U.a = x + (size_t)id * 256 * 256 * 2; U.b = w; U.row0 = (int)id * 256; U.pn = 0; U.e = 0; U.valid = 256; U.rows = nullptr; return true;
    }
};
struct EpiFftA {
    static constexpr bool PERM = false;
    unsigned* XB;
    __device__ __forceinline__ void operator()(const f32x4 (&acc)[2][2][4][2], const pg8::UnitG& u, int wr, int wc, int fr, int fq) const {
#pragma unroll
        for (int ai = 0; ai < 2; ++ai)
#pragma unroll
            for (int m = 0; m < 4; ++m) { int r0 = u.row0; asm volatile("" : "+s"(r0));
                const int row = r0 + ai * 128 + wr * 64 + m * 16 + fr, t2 = row & 63; const size_t bc = (size_t)(row >> 6);
#pragma unroll
                for (int bj = 0; bj < 2; ++bj)
#pragma unroll
                    for (int n = 0; n < 2; ++n) { const int k1 = 64 * bj + 16 * wc + 8 * n + 2 * fq; const f32x4 v = acc[ai][bj][m][n];
#pragma unroll
                        for (int q = 0; q < 2; ++q) { const int kk = k1 + q; const float rev = (float)(kk * t2) * (1.f / 8192.f);
                            const float cs = __builtin_amdgcn_cosf(rev), sn = __builtin_amdgcn_sinf(rev); const float yr = v[2 * q], yi = v[2 * q + 1];
                            XB[(bc * 64 + (kk >> 1)) * 128 + (kk & 1) * 64 + t2] = pk2(yr * cs + yi * sn, yi * cs - yr * sn); } }
                asm volatile("" ::: "memory"); }
    }
};
struct EpiBf16Plain {
    static constexpr bool PERM = true;
    bf16* C; int ldc;
    __device__ __forceinline__ void operator()(const f32x4 (&acc)[2][2][4][2], const pg8::UnitG& u, int wr, int wc, int fr, int fq) const {
#pragma unroll
        for (int ai = 0; ai < 2; ++ai)
#pragma unroll
            for (int m = 0; m < 4; ++m) { bf16* rowp = C + (size_t)(u.row0 + ai * 128 + wr * 64 + m * 16 + fr) * ldc + u.pn * 256 + wc * 32 + 8 * fq;
#pragma unroll
                for (int bj = 0; bj < 2; ++bj) { const f32x4 v0 = acc[ai][bj][m][0], v1 = acc[ai][bj][m][1];
                    v4u o; o.x = pk2(v0[0], v0[1]); o.y = pk2(v0[2], v0[3]); o.z = pk2(v1[0], v1[1]); o.w = pk2(v1[2], v1[3]);
                    *(v4u*)(rowp + bj * 128) = o; } }
    }
};
__device__ __forceinline__ void ph_fft_a_gemm(const Frame& F, const Args& A) {
    FftSched S{(const char*)WSP(bf16, WS_XA), (const char*)WLP(0, WO_TAB), 256, F.G, F.bid};
    EpiFftA E{WSP(unsigned, WS_XB)};
    pg8::gemm_phase_g<EpiFftA, FftSched, false>(F.lds, 256, 256, 256, S, E);
}
__device__ __forceinline__ void ph_fft_b_gemm(const Frame& F, const Args& A) {
    FftSched S{(const char*)WSP(bf16, WS_XB), (const char*)(WLP(0, WO_TAB) + 65536), 256, F.G, F.bid};
    EpiBf16Plain E{WSP(bf16, WS_GB), 256};
    pg8::gemm_phase_g<EpiBf16Plain, FftSched, false>(F.lds, 256, 256, 256, S, E);
}
__device__ __forceinline__ void ph_scan1(const Frame& F, const Args& A) {
    const unsigned* AB = WSP(unsigned, WS_AB); float2* SUMM = WSP(float2, WS_SUMM);
    for (int it = F.gw; it < NB * 2 * NCHUNK * 16; it += F.NGW) {
        const int cg = it & 15, ck = (it >> 4) % NCHUNK, bd = (it >> 4) / NCHUNK, b = bd >> 1, d = bd & 1, ch = cg * 64 + F.lane;
        const unsigned* ab = AB + ((size_t)d * MROWS + (size_t)b * TPB + ck * 64) * 1024 + ch;
        float ac = 1.f, h = 0.f;
#pragma unroll
        for (int q = 0; q < 4; ++q) { unsigned w[16];
#pragma unroll
            for (int k = 0; k < 16; ++k) { const int i = q * 16 + k, ii = d ? 63 - i : i; w[k] = ab[(size_t)ii * 1024]; }
#pragma unroll
            for (int k = 0; k < 16; ++k) { const float a = __expf(bf2f(w[k] & 0xffffu)); h = a * h + bf2f(w[k] >> 16); ac *= a; } }
        SUMM[((size_t)bd * NCHUNK + ck) * 1024 + ch] = make_float2(ac, h);
    }
}
__device__ __forceinline__ void ph_scan2(const Frame& F, const Args& A) {
    const float2* SUMM = WSP(float2, WS_SUMM); float* CARRY = WSP(float, WS_CARRY);
    if (F.gtid < 4096) {
        const int bd = (int)(F.gtid >> 10), ch = (int)(F.gtid & 1023), d = bd & 1; float h = 0.f;
        for (int s = 0; s < NCHUNK; ++s) { const int ck = d ? (s < 4 ? 3 - s : NCHUNK + 3 - s) : s;
            const size_t o = ((size_t)bd * NCHUNK + ck) * 1024 + ch; CARRY[o] = h; const float2 v = SUMM[o]; h = v.x * h + v.y; }
    }
}
__device__ __forceinline__ void ph_scan3(const Frame& F, const Args& A) {
    const unsigned* AB = WSP(unsigned, WS_AB); const float* CARRY = WSP(float, WS_CARRY); const bf16* GLG = WSP(bf16, WS_GLG); bf16* MX = WSP(bf16, WS_MIXIN);
    for (int it = F.gw; it < NB * NCHUNK * 16; it += F.NGW) {
        const int cg = it & 15, ck = (it >> 4) % NCHUNK, b = (it >> 4) / NCHUNK, ch = cg * 64 + F.lane; const size_t R0 = (size_t)b * TPB + ck * 64;
        const unsigned* ab0 = AB + R0 * 1024 + ch; const unsigned* ab1 = AB + ((size_t)MROWS + R0) * 1024 + ch;
        float hf[64]; float h = CARRY[((size_t)(b * 2 + 0) * NCHUNK + ck) * 1024 + ch];
#pragma unroll
        for (int q = 0; q < 4; ++q) { unsigned w[16];
#pragma unroll
            for (int k = 0; k < 16; ++k) w[k] = ab0[(size_t)(q * 16 + k) * 1024];
#pragma unroll
            for (int k = 0; k < 16; ++k) { h = __expf(bf2f(w[k] & 0xffffu)) * h + bf2f(w[k] >> 16); hf[q * 16 + k] = h; } }
        h = CARRY[((size_t)(b * 2 + 1) * NCHUNK + ck) * 1024 + ch];
#pragma unroll
        for (int q = 3; q >= 0; --q) { unsigned w[16]; bf16 g[16];
#pragma unroll
            for (int k = 0; k < 16; ++k) { const int i = q * 16 + 15 - k; w[k] = ab1[(size_t)i * 1024]; g[k] = GLG[(R0 + i) * 1024 + ch]; }
#pragma unroll
            for (int k = 0; k < 16; ++k) { const int i = q * 16 + 15 - k; h = __expf(bf2f(w[k] & 0xffffu)) * h + bf2f(w[k] >> 16);
                MX[(R0 + i) * 3072 + 1024 + ch] = (bf16)f2bf((hf[i] + h) * bf2f(g[k])); } }
    }
}

__device__ __forceinline__ void ph_fft_t1_fast(const Frame& F, const Args& A) {
    const unsigned* ZP = WSP(unsigned, WS_ZP); unsigned* XA = WSP(unsigned, WS_XA); LAS unsigned* T = (LAS unsigned*)F.lds;
    for (int item = F.bid; item < 512; item += F.G) {
        const int b = item >> 8, t2 = (item >> 2) & 63, cq = item & 3;
        __syncthreads();
#pragma unroll
        for (int i = 0; i < 8; ++i) { const int p = F.tid + 512 * i, t1 = p >> 5, w4 = (p & 31) * 4;
            const v4u v = *(const v4u*)(ZP + ((size_t)b * TPB + CTX + 64 * t1 + t2) * 512 + cq * 128 + w4);
            T[t1 * 129 + w4] = v.x; T[t1 * 129 + w4 + 1] = v.y; T[t1 * 129 + w4 + 2] = v.z; T[t1 * 129 + w4 + 3] = v.w; }
        __syncthreads();
#pragma unroll
        for (int i = 0; i < 16; ++i) { const int p = F.tid + 512 * i, cc = p >> 6, t1 = (p & 63) * 2;
            const unsigned long long v = (unsigned long long)T[t1 * 129 + cc] | ((unsigned long long)T[(t1 + 1) * 129 + cc] << 32);
            *(unsigned long long*)(XA + (((size_t)b * 512 + cq * 128 + cc) * 64 + t2) * 128 + t1) = v; }
    }
    __syncthreads();
}
__device__ __forceinline__ void ph_fft_t2_fast(const Frame& F, const Args& A) {
    const unsigned* GB = WSP(unsigned, WS_GB); bf16* MX = WSP(bf16, WS_MIXIN); LAS unsigned* T = (LAS unsigned*)F.lds;
    for (int item = F.bid; item < 2 * 65 * 4; item += F.G) {
        const int b = item / 260, rem = item % 260, kp = rem >> 2, g = rem & 3, k1a = kp, k1b = (128 - kp) & 127;
        __syncthreads();
#pragma unroll
        for (int i = 0; i < 8; ++i) { const int p = F.tid + 512 * i, blk = p >> 11, cc = (p >> 4) & 127, w4 = (p & 15) * 4, kk = blk ? k1b : k1a;
            const v4u v = *(const v4u*)(GB + (((size_t)b * 512 + g * 128 + cc) * 64 + (kk >> 1)) * 128 + (kk & 1) * 64 + w4);
            LAS unsigned* d = T + blk * (128 * 65) + cc * 65 + w4; d[0] = v.x; d[1] = v.y; d[2] = v.z; d[3] = v.w; }
        __syncthreads();
        const int jc = F.tid & 255, j = (jc == 0 || jc == 128) ? 0 : (jc < 128 ? jc : 256 - jc);
        const int nset = (k1a == k1b) ? 1 : 2;
        for (int r = (F.tid >> 8); r < nset * 64; r += 2) { const int set = r >> 6, k2 = r & 63, ka = set ? k1b : k1a;
            const int mk2 = (ka == 0) ? ((64 - k2) & 63) : 63 - k2;
            const unsigned own = T[set * (128 * 65) + j * 65 + k2], mir = T[(nset == 1 ? 0 : (1 - set)) * (128 * 65) + j * 65 + mk2];
            float o; if (jc == 0) o = 0.5f * (bf2f(own & 0xffffu) + bf2f(mir & 0xffffu)); else if (jc == 128) o = 0.5f * (bf2f(own >> 16) + bf2f(mir >> 16)); else if (jc < 128) o = bf2f(mir & 0xffffu); else o = bf2f(own & 0xffffu);
            MX[((size_t)b * TPB + CTX + ka + 128 * k2) * 3072 + 2048 + g * 256 + jc] = (bf16)f2bf(o * 6.9053396600248786e-4f); }
    }
    __syncthreads();
    const float2* GC = WSP(float2, WS_GC);
    for (long i = F.gtid; i < (long)NB * CTX * 1024; i += F.NT) {
        const int col = (int)(i & 1023), k = (int)((i >> 10) & 255), b = (int)(i >> 18), g = col >> 8, jc = col & 255, km = (256 - k) & 255;
        const int j = (jc == 0 || jc == 128) ? 0 : (jc < 128 ? jc : 256 - jc); const size_t base = ((size_t)b * 512 + g * 128 + j) * 256;
        const float2 w = GC[base + k], wm = GC[base + km];
        float o; if (jc == 0) o = 0.5f * (w.x + wm.x); else if (jc == 128) o = 0.5f * (w.y + wm.y); else if (jc < 128) o = wm.x; else o = w.x;
        MX[((size_t)b * TPB + k) * 3072 + 2048 + col] = (bf16)f2bf(o * 3.90625e-3f);
    }
}
__device__ __forceinline__ void ph_scan2_fast(const Frame& F, const Args& A) {
    const float2* SUMM = WSP(float2, WS_SUMM); float* CARRY = WSP(float, WS_CARRY);
    for (int it = F.gw; it < 256; it += F.NGW) {
        const int bd = it >> 6, d = bd & 1, ch = (it & 63) * 16 + (F.lane & 15), seg = F.lane >> 4;
        float2 v[33]; float as = 1.f, hs = 0.f;
#pragma unroll
        for (int q = 0; q < 33; ++q) { const int sidx = seg * 33 + q, ck = d ? (sidx < 4 ? 3 - sidx : NCHUNK + 3 - sidx) : sidx; v[q] = SUMM[((size_t)bd * NCHUNK + ck) * 1024 + ch]; }
#pragma unroll
        for (int q = 0; q < 33; ++q) { hs = v[q].x * hs + v[q].y; as *= v[q].x; }
        const float a16 = sx<16>(as), h16 = sx<16>(hs), a32 = sx<32>(as), h32 = sx<32>(hs), a48 = sx<32>(a16), h48 = sx<32>(h16);
        float h = 0.f;
#pragma unroll
        for (int jx = 0; jx < 3; ++jx) { const int x = jx ^ seg;
            const float aj = x == 0 ? as : (x == 1 ? a16 : (x == 2 ? a32 : a48)), hj = x == 0 ? hs : (x == 1 ? h16 : (x == 2 ? h32 : h48));
            if (jx < seg) h = aj * h + hj; }
#pragma unroll
        for (int q = 0; q < 33; ++q) { const int sidx = seg * 33 + q, ck = d ? (sidx < 4 ? 3 - sidx : NCHUNK + 3 - sidx) : sidx; CARRY[((size_t)bd * NCHUNK + ck) * 1024 + ch] = h; h = v[q].x * h + v[q].y; }
    }
}

__device__ __forceinline__ void ph_fft_t1(const Frame& F, const Args& A) {
    const unsigned* ZP = WSP(unsigned, WS_ZP); unsigned* XA = WSP(unsigned, WS_XA);
    for (long i = F.gtid; i < (long)NB * 512 * 8192; i += F.NT) {
        const int t1 = (int)(i & 127), t2 = (int)((i >> 7) & 63), cc = (int)((i >> 13) & 511), b = (int)(i >> 22);
        XA[i] = ZP[((size_t)b * TPB + CTX + 64 * t1 + t2) * 512 + cc];
    }
}
#if !FAST_FFT
__device__ __forceinline__ void ph_fft_a(const Frame& F, const Args& A) {
    const unsigned* XA = WSP(unsigned, WS_XA); unsigned* XB = WSP(unsigned, WS_XB);
    for (long i = F.gtid; i < (long)NB * 512 * 8192; i += F.NT) {
        const int k1 = (int)(i & 127); const long row = i >> 7; const int t2 = (int)(row & 63); const long bc = row >> 6;
        const unsigned* x = XA + row * 128; float yr = 0.f, yi = 0.f;
        for (int t1 = 0; t1 < 128; ++t1) { const unsigned w = x[t1]; const float wr = bf2f(w & 0xffffu), wi = bf2f(w >> 16);
            float sn, cs; sincospif((float)((k1 * t1) & 127) / 64.0f, &sn, &cs);
            yr += wr * cs + wi * sn; yi += wi * cs - wr * sn; }
        float sn, cs; sincospif((float)(k1 * t2) / 4096.0f, &sn, &cs);
        const float zr = yr * cs + yi * sn, zi = yi * cs - yr * sn;
        XB[(bc * 64 + (k1 >> 1)) * 128 + (k1 & 1) * 64 + t2] = pk2(zr, zi);
    }
}
#endif
#if !FAST_FFT
__device__ __forceinline__ void ph_fft_b(const Frame& F, const Args& A) {
    const unsigned* XB = WSP(unsigned, WS_XB); unsigned* GB = WSP(unsigned, WS_GB);
    for (long i = F.gtid; i < (long)NB * 512 * 8192; i += F.NT) {
        const int k2 = (int)(i & 63); const long hrow = i >> 6;
        const unsigned* x = XB + hrow * 64; float yr = 0.f, yi = 0.f;
        for (int t2 = 0; t2 < 64; ++t2) { const unsigned w = x[t2]; const float wr = bf2f(w & 0xffffu), wi = bf2f(w >> 16);
            float sn, cs; sincospif((float)((k2 * t2) & 63) / 32.0f, &sn, &cs);
            yr += wr * cs + wi * sn; yi += wi * cs - wr * sn; }
        GB[hrow * 64 + k2] = pk2(yr, yi);
    }
}
#endif
__device__ __forceinline__ void ph_fft_c(const Frame& F, const Args& A) {
    const unsigned* ZP = WSP(unsigned, WS_ZP); float2* GC = WSP(float2, WS_GC);
    LAS unsigned* Z = (LAS unsigned*)F.lds; LAS float* TWc = (LAS float*)(F.lds + 16384); LAS float* TWs = TWc + 256;
    __syncthreads();
    if (F.tid < 256) { const float rev = (float)F.tid * (1.f / 256.f); TWc[F.tid] = __builtin_amdgcn_cosf(rev); TWs[F.tid] = __builtin_amdgcn_sinf(rev); }
    for (int item = F.bid; item < 64; item += F.G) {
        const int b = item >> 5, c0 = (item & 31) * 16;
        __syncthreads();
        for (int e = F.tid; e < 4096; e += 512) Z[e] = ZP[((size_t)b * TPB + (e >> 4)) * 512 + c0 + (e & 15)];
        __syncthreads();
        const int cc = F.tid & 15, kb = (F.tid >> 4) * 8; float ar[8], ai[8]; int m[8];
#pragma unroll
        for (int q = 0; q < 8; ++q) { ar[q] = 0.f; ai[q] = 0.f; m[q] = 0; }
        for (int t = 0; t < 256; ++t) { const unsigned w = Z[t * 16 + cc]; const float wr = bf2f(w & 0xffffu), wi = bf2f(w >> 16);
#pragma unroll
            for (int q = 0; q < 8; ++q) { const float tc = TWc[m[q]], ts = TWs[m[q]]; ar[q] += wr * tc + wi * ts; ai[q] += wi * tc - wr * ts; m[q] = (m[q] + kb + q) & 255; } }
#pragma unroll
        for (int q = 0; q < 8; ++q) GC[((size_t)b * 512 + c0 + cc) * 256 + kb + q] = make_float2(ar[q], ai[q]);
    }
    __syncthreads();
}
__device__ __forceinline__ void ph_fft_t2(const Frame& F, const Args& A) {
    const unsigned* GB = WSP(unsigned, WS_GB); const float2* GC = WSP(float2, WS_GC); bf16* MX = WSP(bf16, WS_MIXIN);
    for (long i = F.gtid; i < (long)MROWS * 1024; i += F.NT) {
        const int R = (int)(i >> 10), col = (int)(i & 1023), g = col >> 8, jc = col & 255, b = R / TPB, p = R % TPB;
        const bool lat = p >= CTX; const int T = lat ? SEQ : CTX, k = lat ? p - CTX : p, km = (T - k) & (T - 1);
        const int j = (jc == 0 || jc == 128) ? 0 : (jc < 128 ? jc : 256 - jc); const int cc = g * 128 + j;
        float vr, vi, mr, mi;
        if (lat) { const size_t base = ((size_t)b * 512 + cc) * 64;
            const unsigned w = GB[(base + ((k & 127) >> 1)) * 128 + (k & 1) * 64 + (k >> 7)], wm = GB[(base + ((km & 127) >> 1)) * 128 + (km & 1) * 64 + (km >> 7)];
            vr = bf2f(w & 0xffffu); vi = bf2f(w >> 16); mr = bf2f(wm & 0xffffu); mi = bf2f(wm >> 16); }
        else { const float2 w = GC[((size_t)b * 512 + cc) * 256 + k], wm = GC[((size_t)b * 512 + cc) * 256 + km]; vr = w.x; vi = w.y; mr = wm.x; mi = wm.y; }
        float o;
        if (jc == 0) o = 0.5f * (vr + mr); else if (jc == 128) o = 0.5f * (vi + mi); else if (jc < 128) o = mr; else o = vr;
        o *= lat ? 6.9053396600248786e-4f : 3.90625e-3f;
        MX[(size_t)R * 3072 + 2048 + col] = (bf16)f2bf(o);
    }
}

#if !FAST_ATTN
__device__ __forceinline__ void ph_attn_naive(const Frame& F, const Args& A, int l) {
    const bf16 *Kb = WSP(bf16, WS_KB), *Vb = WSP(bf16, WS_VB), *Qb = WSP(bf16, WS_QB); bf16* MX = WSP(bf16, WS_MIXIN);
    const float* lq = A.in[10] + l * 256; float d01 = 0.f, d23 = 0.f;
    for (int i = 0; i < 64; ++i) { d01 += lq[i] * lq[64 + i]; d23 += lq[128 + i] * lq[192 + i]; }
    const float lam_init = 0.8f - 0.6f * expf(-0.3f * (float)l), lam = expf(d01) - expf(d23) + lam_init;
    LAS float* Ks = (LAS float*)F.lds; LAS float* Vs = Ks + 64 * 132; LAS float* Qs = Vs + 64 * 132; LAS float* Ws = Qs + 16 * 128;
    const int r = F.tid >> 5, tl = F.tid & 31;
    for (int u = F.bid; u < 16 * 528; u += F.G) {
        const int bh = u / 528, qb = u % 528, b = bh >> 3, h = bh & 7; const size_t R0 = (size_t)b * TPB + qb * 16; const int nkeys = qb < 16 ? CTX : TPB;
        __syncthreads();
        for (int e = F.tid; e < 2048; e += 512) Qs[e] = bf2f(Qb[(R0 + (e >> 7)) * 1024 + h * 128 + (e & 127)]);
        float m0 = -1e30f, l0 = 0.f, m1 = -1e30f, l1 = 0.f;
        for (int pass = 0; pass < 2; ++pass) {
            float inv0 = 0.f, inv1 = 0.f;
            if (pass == 1) {
#pragma unroll
                for (int o = 1; o < 32; o <<= 1) { float mo = __shfl_xor(m0, o), lo = __shfl_xor(l0, o), mn = fmaxf(m0, mo); l0 = l0 * exp2f(m0 - mn) + lo * exp2f(mo - mn); m0 = mn;
                    mo = __shfl_xor(m1, o); lo = __shfl_xor(l1, o); mn = fmaxf(m1, mo); l1 = l1 * exp2f(m1 - mn) + lo * exp2f(mo - mn); m1 = mn; }
                inv0 = 1.f / l0; inv1 = lam / l1;
            }
            float o4[4] = {0.f, 0.f, 0.f, 0.f};
            for (int kt = 0; kt < nkeys; kt += 64) {
                __syncthreads();
                for (int e = F.tid; e < 1024; e += 512) { const int kk = e >> 4, c8 = (e & 15) * 8; const size_t src = ((size_t)b * TPB + kt + kk) * 1024 + h * 128 + c8;
                    const v4u kv = *(const v4u*)(Kb + src);
                    Ks[kk * 132 + c8 + 0] = bf2f(kv.x & 0xffffu); Ks[kk * 132 + c8 + 1] = bf2f(kv.x >> 16); Ks[kk * 132 + c8 + 2] = bf2f(kv.y & 0xffffu); Ks[kk * 132 + c8 + 3] = bf2f(kv.y >> 16);
                    Ks[kk * 132 + c8 + 4] = bf2f(kv.z & 0xffffu); Ks[kk * 132 + c8 + 5] = bf2f(kv.z >> 16); Ks[kk * 132 + c8 + 6] = bf2f(kv.w & 0xffffu); Ks[kk * 132 + c8 + 7] = bf2f(kv.w >> 16);
                    if (pass == 1) { const v4u vv = *(const v4u*)(Vb + src);
                        Vs[kk * 132 + c8 + 0] = bf2f(vv.x & 0xffffu); Vs[kk * 132 + c8 + 1] = bf2f(vv.x >> 16); Vs[kk * 132 + c8 + 2] = bf2f(vv.y & 0xffffu); Vs[kk * 132 + c8 + 3] = bf2f(vv.y >> 16);
                        Vs[kk * 132 + c8 + 4] = bf2f(vv.z & 0xffffu); Vs[kk * 132 + c8 + 5] = bf2f(vv.z >> 16); Vs[kk * 132 + c8 + 6] = bf2f(vv.w & 0xffffu); Vs[kk * 132 + c8 + 7] = bf2f(vv.w >> 16); } }
                __syncthreads();
#pragma unroll
                for (int kq = 0; kq < 2; ++kq) { const int kk = tl + 32 * kq; float s0 = 0.f, s1 = 0.f;
                    for (int d = 0; d < 64; d += 4) { const f32x4 q0 = *(const LAS f32x4*)(Qs + r * 128 + d), q1 = *(const LAS f32x4*)(Qs + r * 128 + 64 + d), k0 = *(const LAS f32x4*)(Ks + kk * 132 + d), k1 = *(const LAS f32x4*)(Ks + kk * 132 + 64 + d);
                        s0 += q0.x * k0.x + q0.y * k0.y + q0.z * k0.z + q0.w * k0.w; s1 += q1.x * k1.x + q1.y * k1.y + q1.z * k1.z + q1.w * k1.w; }
                    if (pass == 0) { float mn = fmaxf(m0, s0); l0 = l0 * exp2f(m0 - mn) + exp2f(s0 - mn); m0 = mn; mn = fmaxf(m1, s1); l1 = l1 * exp2f(m1 - mn) + exp2f(s1 - mn); m1 = mn; }
                    else Ws[r * 64 + kk] = exp2f(s0 - m0) * inv0 - exp2f(s1 - m1) * inv1; }
                if (pass == 1) { __syncthreads();
                    for (int kk = 0; kk < 64; ++kk) { const float w = Ws[r * 64 + kk];
#pragma unroll
                        for (int i = 0; i < 4; ++i) o4[i] += w * Vs[kk * 132 + tl + 32 * i]; } }
            }
            if (pass == 1) { float ss = o4[0] * o4[0] + o4[1] * o4[1] + o4[2] * o4[2] + o4[3] * o4[3];
#pragma unroll
                for (int o = 1; o < 32; o <<= 1) ss += __shfl_xor(ss, o);
                const float sc = rsqrtf(ss * (1.f / 128.f) + EPS) * (1.f - lam_init);
#pragma unroll
                for (int i = 0; i < 4; ++i) MX[(R0 + r) * 3072 + h * 128 + tl + 32 * i] = (bf16)f2bf(o4[i] * sc * A.in[11][l * 128 + tl + 32 * i]); }
        }
    }
}

#endif
namespace da {
using bf16x8 = __attribute__((ext_vector_type(8))) short;
using s16x4  = __attribute__((ext_vector_type(4))) short;
using f32x16 = __attribute__((ext_vector_type(16))) float;
using u32x4  = __attribute__((ext_vector_type(4))) unsigned;
constexpr int KVBLK = 64, LDK = 1024;
constexpr size_t SHM_V = KVBLK * 128 * 2, SHM_K = KVBLK * 128 * 2;
constexpr float THR = 8.f;
#define DA_KSWZ(row, colB) ((row) * 256 + ((colB) ^ (((row) & 7) << 4)))
#define DA_SBAR() __builtin_amdgcn_sched_barrier(0)
__device__ __forceinline__ int crow(int r, int hi) { return (r & 3) + 8 * (r >> 2) + 4 * hi; }
__device__ __forceinline__ unsigned cvtpk(float lo, float hi) { unsigned r; asm volatile("v_cvt_pk_bf16_f32 %0, %1, %2" : "=v"(r) : "v"(lo), "v"(hi)); return r; }
__device__ __forceinline__ void expSM(f32x16& p0, f32x16& p1, float soff) {
  for (int r = 0; r < 16; ++r) p0[r] = __builtin_amdgcn_exp2f(p0[r] - soff); for (int r = 0; r < 16; ++r) p1[r] = __builtin_amdgcn_exp2f(p1[r] - soff);
}
__device__ __forceinline__ void finishSM(f32x16& p0, f32x16& p1, float& l_reg, bf16x8& pa0, bf16x8& pa1, bf16x8& pa2, bf16x8& pa3) {
  float ps = 0; for (int r = 0; r < 16; ++r) ps += p0[r]; for (int r = 0; r < 16; ++r) ps += p1[r];
  l_reg += ps;
#define DA_PK4(P, BASE, OUT) do { unsigned a0 = cvtpk(P[BASE + 0], P[BASE + 1]), a1 = cvtpk(P[BASE + 2], P[BASE + 3]);   \
    unsigned b0 = cvtpk(P[BASE + 4], P[BASE + 5]), b1 = cvtpk(P[BASE + 6], P[BASE + 7]);                              \
    auto r0 = __builtin_amdgcn_permlane32_swap(a0, b0, false, false); auto r1 = __builtin_amdgcn_permlane32_swap(a1, b1, false, false); \
    u32x4 w = {r0[0], r1[0], r0[1], r1[1]}; OUT = *reinterpret_cast<bf16x8*>(&w); } while (0)
  DA_PK4(p0, 0, pa0); DA_PK4(p0, 8, pa1); DA_PK4(p1, 0, pa2); DA_PK4(p1, 8, pa3);
#undef DA_PK4
}
__device__ __forceinline__ void qkt(f32x16& p0, f32x16& p1, const char* Ks, const bf16x8* qr, int r32, int hi, int cbm) {
  p0 = f32x16{}; p1 = f32x16{};
#pragma unroll
  for (int d0 = 0; d0 < 4; ++d0) { const int cb = cbm + (d0 * 16 + hi * 8) * 2;
    bf16x8 b0 = *reinterpret_cast<const bf16x8*>(Ks + DA_KSWZ(r32, cb));
    bf16x8 b1 = *reinterpret_cast<const bf16x8*>(Ks + DA_KSWZ(32 + r32, cb));
    p0 = __builtin_amdgcn_mfma_f32_32x32x16_bf16(b0, qr[d0], p0, 0, 0, 0);
    p1 = __builtin_amdgcn_mfma_f32_32x32x16_bf16(b1, qr[d0], p1, 0, 0, 0); }
}
__device__ __forceinline__ int v_st(int k, int c) { const int kk = (k & ~0xC) | ((k & 4) << 1) | ((k & 8) >> 1); return ((kk >> 3) * 4 + (c >> 5)) * 512 + ((kk & 7) * 32 + (c & 31)) * 2; }
__device__ __forceinline__ int v_rd_base(int lane) { return ((lane & 3) << 3) | (((lane >> 2) & 3) << 6) | (((lane >> 4) & 1) << 5) | (((lane >> 5) & 1) << 8); }
constexpr int v_rd_off(int d0, int ks, int half) { return d0 * 512 + ks * 4096 + half * 2048; }
template <int OFF> __device__ __forceinline__ s16x4 tr_read(int vb) {
  s16x4 r; asm volatile("ds_read_b64_tr_b16 %0, %1 offset:%2" : "=&v"(r) : "v"(vb), "i"(OFF) : "memory"); return r;
}
template <int D0> __device__ __forceinline__ void pv_one(f32x16& od, int vb, bf16x8 pa0, bf16x8 pa1, bf16x8 pa2, bf16x8 pa3) {
  const s16x4 l0 = tr_read<v_rd_off(D0, 0, 0)>(vb), h0 = tr_read<v_rd_off(D0, 0, 1)>(vb), l1 = tr_read<v_rd_off(D0, 1, 0)>(vb), h1 = tr_read<v_rd_off(D0, 1, 1)>(vb);
  const s16x4 l2 = tr_read<v_rd_off(D0, 2, 0)>(vb), h2 = tr_read<v_rd_off(D0, 2, 1)>(vb), l3 = tr_read<v_rd_off(D0, 3, 0)>(vb), h3 = tr_read<v_rd_off(D0, 3, 1)>(vb);
  asm volatile("s_waitcnt lgkmcnt(0)" ::: "memory"); DA_SBAR();
#define DA_PK(L, H) (bf16x8){L[0], L[1], L[2], L[3], H[0], H[1], H[2], H[3]}
  od = __builtin_amdgcn_mfma_f32_32x32x16_bf16(pa0, DA_PK(l0, h0), od, 0, 0, 0);
  od = __builtin_amdgcn_mfma_f32_32x32x16_bf16(pa1, DA_PK(l1, h1), od, 0, 0, 0);
  od = __builtin_amdgcn_mfma_f32_32x32x16_bf16(pa2, DA_PK(l2, h2), od, 0, 0, 0);
  od = __builtin_amdgcn_mfma_f32_32x32x16_bf16(pa3, DA_PK(l3, h3), od, 0, 0, 0);
#undef DA_PK
}
__device__ __forceinline__ void pv_d0(f32x16* o, int vb, bf16x8 pa0, bf16x8 pa1, bf16x8 pa2, bf16x8 pa3) {
  pv_one<0>(o[0], vb, pa0, pa1, pa2, pa3); pv_one<1>(o[1], vb, pa0, pa1, pa2, pa3); pv_one<2>(o[2], vb, pa0, pa1, pa2, pa3); pv_one<3>(o[3], vb, pa0, pa1, pa2, pa3);
}
__device__ __forceinline__ void unit(const unsigned short* __restrict__ Qb, const unsigned short* __restrict__ Kh, const unsigned short* __restrict__ Vh,
                                     unsigned short* __restrict__ Ob, int ldo, int seq, float lam, float oscale, float soff, const float* __restrict__ subg, char* lds) {
  const int tid = otid(), wid = tid >> 6, lane = tid & 63, r32 = lane & 31, hi = lane >> 5, mp = wid >> 2, wq = wid & 3;
  char* V_lds = lds; char* K_lds = lds + 2 * SHM_V;
  float* ws = (float*)(lds + 2 * SHM_V + 2 * SHM_K) + wid * 64; float* li_l = ws;
  float l_reg = 0; f32x16 o[4] = {}; bf16x8 qr[4];
  const unsigned short* Qw = Qb + (long)(wq * 32 + r32) * 1024 + mp * 64 + hi * 8;
#pragma unroll
  for (int d0 = 0; d0 < 4; ++d0) qr[d0] = *reinterpret_cast<const bf16x8*>(Qw + d0 * 16);
  const int cbm = mp * 128;
  const int sr = tid >> 4, sc = (tid & 15) * 8, vst0 = v_st(sr, sc), vst1 = v_st(32 + sr, sc);
  const int vb0 = (int)(uintptr_t)V_lds + v_rd_base(lane);
  struct { bf16x8 vs0, vs1, ks0, ks1; } sr_[2];
#define DA_SLOAD(i, k0) do { sr_[i].vs0 = *reinterpret_cast<const bf16x8*>(&Vh[(long)((k0) + sr) * LDK + sc]); sr_[i].vs1 = *reinterpret_cast<const bf16x8*>(&Vh[(long)((k0) + 32 + sr) * LDK + sc]); \
    sr_[i].ks0 = *reinterpret_cast<const bf16x8*>(&Kh[(long)((k0) + sr) * LDK + sc]); sr_[i].ks1 = *reinterpret_cast<const bf16x8*>(&Kh[(long)((k0) + 32 + sr) * LDK + sc]); } while (0)
#define DA_SWRITE(b, i) do { *(bf16x8*)(V_lds + (b) * SHM_V + vst0) = sr_[i].vs0;          \
    *(bf16x8*)(V_lds + (b) * SHM_V + vst1) = sr_[i].vs1; int kc = sc * 2;               \
    *(bf16x8*)(K_lds + (b) * SHM_K + DA_KSWZ(sr, kc)) = sr_[i].ks0;                       \
    *(bf16x8*)(K_lds + (b) * SHM_K + DA_KSWZ(32 + sr, kc)) = sr_[i].ks1; } while (0)
#define DA_SWAIT() asm volatile("s_waitcnt vmcnt(4)" ::: "memory")
  f32x16 pA0, pA1, pB0, pB1; bf16x8 pa0, pa1, pa2, pa3; const int NT = seq / KVBLK;
  constexpr int SE = 0, SO = 1;
  DA_SLOAD(SE, 0); asm volatile("s_waitcnt vmcnt(0)" ::: "memory"); DA_SWRITE(0, SE); __syncthreads();
  qkt(pA0, pA1, K_lds, qr, r32, hi, cbm); expSM(pA0, pA1, soff);
  DA_SLOAD(SO, KVBLK); if (2 < NT) DA_SLOAD(SE, 2 * KVBLK);
  DA_SWAIT(); DA_SWRITE(1, SO); __syncthreads();
  for (int j = 1; j + 1 < NT; j += 2) {
    DA_SBAR(); qkt(pB0, pB1, K_lds + SHM_K, qr, r32, hi, cbm);
    finishSM(pA0, pA1, l_reg, pa0, pa1, pa2, pa3); DA_SBAR();
    DA_SLOAD(SO, (j + 2) * KVBLK); DA_SBAR();
    pv_d0(o, vb0, pa0, pa1, pa2, pa3); expSM(pB0, pB1, soff);
    __syncthreads(); DA_SWAIT(); DA_SWRITE(0, SE);
    __syncthreads();
    DA_SBAR(); qkt(pA0, pA1, K_lds, qr, r32, hi, cbm);
    finishSM(pB0, pB1, l_reg, pa0, pa1, pa2, pa3); DA_SBAR();
    if (j + 3 < NT) DA_SLOAD(SE, (j + 3) * KVBLK); DA_SBAR();
    pv_d0(o, vb0 + (int)SHM_V, pa0, pa1, pa2, pa3); expSM(pA0, pA1, soff);
    __syncthreads(); DA_SWAIT(); DA_SWRITE(1, SO);
    __syncthreads();
  }
  DA_SBAR(); qkt(pB0, pB1, K_lds + SHM_K, qr, r32, hi, cbm);
  finishSM(pA0, pA1, l_reg, pa0, pa1, pa2, pa3); DA_SBAR();
  pv_d0(o, vb0, pa0, pa1, pa2, pa3); expSM(pB0, pB1, soff);
  __syncthreads();
  finishSM(pB0, pB1, l_reg, pa0, pa1, pa2, pa3); DA_SBAR();
  pv_d0(o, vb0 + (int)SHM_V, pa0, pa1, pa2, pa3);
  { auto rr = __builtin_amdgcn_permlane32_swap(__float_as_uint(l_reg), __float_as_uint(l_reg), false, false); l_reg = __uint_as_float(rr[0]) + __uint_as_float(rr[1]); }
  if (hi == 0) li_l[r32] = l_reg; asm volatile("s_waitcnt lgkmcnt(0)" ::: "memory");
  const float sgn = mp ? lam : 1.f;
#pragma unroll
  for (int r = 0; r < 16; ++r) { const float rl = sgn * __builtin_amdgcn_rcpf(li_l[crow(r, hi)]);
#pragma unroll
    for (int d0 = 0; d0 < 4; ++d0) o[d0][r] *= rl; }
  __syncthreads();
  int xb = wq * 4096 + lane; asm volatile("" : "+v"(xb));
  float* X = (float*)lds + xb;
  if (mp == 1) {
#pragma unroll
    for (int d0 = 0; d0 < 4; ++d0)
#pragma unroll
      for (int r = 0; r < 16; ++r) X[(d0 * 16 + r) * 64] = o[d0][r];
  }
  __syncthreads();
  if (mp == 0) {
    float gg[4];
#pragma unroll
    for (int d0 = 0; d0 < 4; ++d0) gg[d0] = subg[d0 * 32 + r32] * oscale;
    int ob = (wq * 32 + 4 * hi) * ldo + r32; asm volatile("" : "+v"(ob));
    unsigned short* Ow = Ob + ob;
#pragma unroll
    for (int r = 0; r < 16; ++r) { float a = 0.f; float v[4];
#pragma unroll
      for (int d0 = 0; d0 < 4; ++d0) { v[d0] = o[d0][r] - X[(d0 * 16 + r) * 64]; a += v[d0] * v[d0]; }
      a += sx<1>(a); a += sx<2>(a); a += sx<4>(a); a += sx<8>(a); a += sx<16>(a);
      a = rsqrtf(a * (1.f / 128.f) + EPS);
      const int orow = (r & 3) + 8 * (r >> 2);
#pragma unroll
      for (int d0 = 0; d0 < 4; ++d0) Ow[orow * ldo + d0 * 32] = (unsigned short)f2bf(v[d0] * a * gg[d0]); }
  }
  __syncthreads();
#undef DA_SLOAD
#undef DA_SWRITE
#undef DA_SWAIT
}

template <int D0> __device__ __forceinline__ void v_rd8(s16x4 (&f)[8], int vb) {
  f[0] = tr_read<v_rd_off(D0, 0, 0)>(vb); f[1] = tr_read<v_rd_off(D0, 0, 1)>(vb); f[2] = tr_read<v_rd_off(D0, 1, 0)>(vb); f[3] = tr_read<v_rd_off(D0, 1, 1)>(vb);
  f[4] = tr_read<v_rd_off(D0, 2, 0)>(vb); f[5] = tr_read<v_rd_off(D0, 2, 1)>(vb); f[6] = tr_read<v_rd_off(D0, 3, 0)>(vb); f[7] = tr_read<v_rd_off(D0, 3, 1)>(vb);
}
__device__ __forceinline__ void pv_mm(f32x16& od, const s16x4 (&f)[8], bf16x8 pa0, bf16x8 pa1, bf16x8 pa2, bf16x8 pa3) {
#define DA_PK(L, H) (bf16x8){L[0], L[1], L[2], L[3], H[0], H[1], H[2], H[3]}
  od = __builtin_amdgcn_mfma_f32_32x32x16_bf16(pa0, DA_PK(f[0], f[1]), od, 0, 0, 0);
  od = __builtin_amdgcn_mfma_f32_32x32x16_bf16(pa1, DA_PK(f[2], f[3]), od, 0, 0, 0);
  od = __builtin_amdgcn_mfma_f32_32x32x16_bf16(pa2, DA_PK(f[4], f[5]), od, 0, 0, 0);
  od = __builtin_amdgcn_mfma_f32_32x32x16_bf16(pa3, DA_PK(f[6], f[7]), od, 0, 0, 0);
#undef DA_PK
}
__device__ __forceinline__ void pv_pipe(f32x16* o, int vb, bf16x8 pa0, bf16x8 pa1, bf16x8 pa2, bf16x8 pa3) {
  s16x4 fa[8], fb[8];
  v_rd8<0>(fa, vb); v_rd8<1>(fb, vb);
  asm volatile("s_waitcnt lgkmcnt(8)" ::: "memory"); DA_SBAR(); pv_mm(o[0], fa, pa0, pa1, pa2, pa3); DA_SBAR();
  v_rd8<2>(fa, vb);
  asm volatile("s_waitcnt lgkmcnt(8)" ::: "memory"); DA_SBAR(); pv_mm(o[1], fb, pa0, pa1, pa2, pa3); DA_SBAR();
  v_rd8<3>(fb, vb);
  asm volatile("s_waitcnt lgkmcnt(8)" ::: "memory"); DA_SBAR(); pv_mm(o[2], fa, pa0, pa1, pa2, pa3); DA_SBAR();
  asm volatile("s_waitcnt lgkmcnt(0)" ::: "memory"); DA_SBAR(); pv_mm(o[3], fb, pa0, pa1, pa2, pa3); DA_SBAR();
}
__device__ __forceinline__ void unit2(const unsigned short* __restrict__ Qb, const unsigned short* __restrict__ Kh, const unsigned short* __restrict__ Vh,
                                      unsigned short* __restrict__ Ob, int ldo, int seq, float lam, float oscale, float soff, const float* __restrict__ subg, LAS unsigned char* ldsl) {
  const int tid = otid(), wid = __builtin_amdgcn_readfirstlane(tid >> 6), lane = tid & 63, r32 = lane & 31, hi = lane >> 5, mp = wid >> 2, wq = wid & 3;
  constexpr int SLOT = 16384;
  char* lds = (char*)ldsl; char* K_lds = lds; const int vbase = (int)(uintptr_t)(lds + 3 * SLOT) + v_rd_base(lane);
  float* li_l = (float*)(lds + 6 * SLOT) + wid * 64;
  float l_reg = 0; f32x16 o[4] = {}; bf16x8 qr[4];
  const unsigned short* Qw = Qb + (long)(wq * 32 + r32) * 1024 + mp * 64 + hi * 8;
#pragma unroll
  for (int d0 = 0; d0 < 4; ++d0) qr[d0] = *reinterpret_cast<const bf16x8*>(Qw + d0 * 16);
  asm volatile("s_waitcnt vmcnt(0)" ::: "memory");
  const int cbm = mp * 128;
  unsigned kso[2], vso[2];
#pragma unroll
  for (int i = 0; i < 2; ++i) { const int P = (i * 8 + wid) * 64 + lane;
    { const int row = P >> 4, chunk = (P & 15) ^ (row & 7); kso[i] = (unsigned)(row * LDK + chunk * 8) * 2u; }
    { const int sub = P >> 5, kk = (sub >> 2) * 8 + ((P & 31) >> 2), key = (kk & ~0xC) | ((kk & 4) << 1) | ((kk & 8) >> 1); vso[i] = (unsigned)(key * LDK + (sub & 3) * 32 + (P & 3) * 8) * 2u; } }
  const unsigned wl = (unsigned)wid * 1024u;
#define DA_DMA_K(t, slot) do { _Pragma("unroll") for (int i_ = 0; i_ < 2; ++i_) __builtin_amdgcn_global_load_lds((const unsigned*)((const char*)Kh + (size_t)(t) * (KVBLK * LDK * 2) + kso[i_]), \
      (LAS unsigned*)(ldsl + (slot) * SLOT + i_ * 8192 + wl), 16, 0, 0); } while (0)
#define DA_DMA_V(t, slot) do { _Pragma("unroll") for (int i_ = 0; i_ < 2; ++i_) __builtin_amdgcn_global_load_lds((const unsigned*)((const char*)Vh + (size_t)(t) * (KVBLK * LDK * 2) + vso[i_]), \
      (LAS unsigned*)(ldsl + (3 + (slot)) * SLOT + i_ * 8192 + wl), 16, 0, 0); } while (0)
#define DA_WAITBAR(N) do { asm volatile("s_waitcnt vmcnt(" #N ") lgkmcnt(0)" ::: "memory"); __builtin_amdgcn_s_barrier(); asm volatile("" ::: "memory"); } while (0)
  f32x16 pA0, pA1, pB0, pB1; bf16x8 pa0, pa1, pa2, pa3; const int NT = seq / KVBLK;
  DA_DMA_K(0, 0); DA_DMA_K(1, 1); DA_DMA_V(0, 0);
  DA_WAITBAR(4);
  qkt(pA0, pA1, K_lds, qr, r32, hi, cbm); expSM(pA0, pA1, soff);
  DA_DMA_K(2, 2); DA_DMA_V(1, 1);
  DA_WAITBAR(4);
  int kc = 1, vp = 0;
#define DA_ROT(x) ((x) == 2 ? 0 : (x) + 1)
#define DA_PRV(x) ((x) == 0 ? 2 : (x) - 1)
  for (int j = 1; j + 1 < NT; j += 2) {
    DA_DMA_K(j + 2, DA_PRV(kc)); DA_DMA_V(j + 1, DA_PRV(vp));
    DA_SBAR(); qkt(pB0, pB1, K_lds + kc * SLOT, qr, r32, hi, cbm);
    finishSM(pA0, pA1, l_reg, pa0, pa1, pa2, pa3); DA_SBAR();
    pv_pipe(o, vbase + vp * SLOT, pa0, pa1, pa2, pa3); expSM(pB0, pB1, soff);
    DA_WAITBAR(4);
    kc = DA_ROT(kc); vp = DA_ROT(vp);
    const bool more = j + 3 < NT;
    if (more) DA_DMA_K(j + 3, DA_PRV(kc));
    DA_DMA_V(j + 2, DA_PRV(vp));
    DA_SBAR(); qkt(pA0, pA1, K_lds + kc * SLOT, qr, r32, hi, cbm);
    finishSM(pB0, pB1, l_reg, pa0, pa1, pa2, pa3); DA_SBAR();
    pv_pipe(o, vbase + vp * SLOT, pa0, pa1, pa2, pa3); expSM(pA0, pA1, soff);
    if (more) DA_WAITBAR(4); else DA_WAITBAR(2);
    kc = DA_ROT(kc); vp = DA_ROT(vp);
  }
  DA_SBAR(); qkt(pB0, pB1, K_lds + kc * SLOT, qr, r32, hi, cbm);
  finishSM(pA0, pA1, l_reg, pa0, pa1, pa2, pa3); DA_SBAR();
  pv_pipe(o, vbase + vp * SLOT, pa0, pa1, pa2, pa3); expSM(pB0, pB1, soff);
  DA_WAITBAR(0);
  vp = DA_ROT(vp);
  finishSM(pB0, pB1, l_reg, pa0, pa1, pa2, pa3); DA_SBAR();
  pv_pipe(o, vbase + vp * SLOT, pa0, pa1, pa2, pa3);
  { auto rr = __builtin_amdgcn_permlane32_swap(__float_as_uint(l_reg), __float_as_uint(l_reg), false, false); l_reg = __uint_as_float(rr[0]) + __uint_as_float(rr[1]); }
  if (hi == 0) li_l[r32] = l_reg; asm volatile("s_waitcnt lgkmcnt(0)" ::: "memory");
  const float sgn = mp ? lam : 1.f;
#pragma unroll
  for (int r = 0; r < 16; ++r) { const float rl = sgn * __builtin_amdgcn_rcpf(li_l[crow(r, hi)]);
#pragma unroll
    for (int d0 = 0; d0 < 4; ++d0) o[d0][r] *= rl; }
  __syncthreads();
  int xb = wq * 4096 + lane; asm volatile("" : "+v"(xb));
  float* X = (float*)lds + xb;
  if (mp == 1) {
#pragma unroll
    for (int d0 = 0; d0 < 4; ++d0)
#pragma unroll
      for (int r = 0; r < 16; ++r) X[(d0 * 16 + r) * 64] = o[d0][r];
  }
  __syncthreads();
  if (mp == 0) {
    float gg[4];
#pragma unroll
    for (int d0 = 0; d0 < 4; ++d0) gg[d0] = subg[d0 * 32 + r32] * oscale;
    int ob = (wq * 32 + 4 * hi) * ldo + r32; asm volatile("" : "+v"(ob));
    unsigned short* Ow = Ob + ob;
#pragma unroll
    for (int r = 0; r < 16; ++r) { float a = 0.f; float v[4];
#pragma unroll
      for (int d0 = 0; d0 < 4; ++d0) { v[d0] = o[d0][r] - X[(d0 * 16 + r) * 64]; a += v[d0] * v[d0]; }
      a += sx<1>(a); a += sx<2>(a); a += sx<4>(a); a += sx<8>(a); a += sx<16>(a);
      a = rsqrtf(a * (1.f / 128.f) + EPS);
      const int orow = (r & 3) + 8 * (r >> 2);
#pragma unroll
      for (int d0 = 0; d0 < 4; ++d0) Ow[orow * ldo + d0 * 32] = (unsigned short)f2bf(v[d0] * a * gg[d0]); }
  }
  asm volatile("s_waitcnt vmcnt(0)" ::: "memory");
  __syncthreads();
#undef DA_DMA_K
#undef DA_DMA_V
#undef DA_WAITBAR
#undef DA_ROT
#undef DA_PRV
}
__device__ __forceinline__ void unit3(const unsigned short* __restrict__ Qb, const unsigned short* __restrict__ Kh, const unsigned short* __restrict__ Vh,
                                      unsigned short* __restrict__ Ob, int ldo, int seq, float lam, float oscale, float soff, const float* __restrict__ subg, LAS unsigned char* ldsl) {
  const int tid = otid(), wid = __builtin_amdgcn_readfirstlane(tid >> 6), lane = tid & 63, r32 = lane & 31, hi = lane >> 5, mp = wid >> 2, wq = wid & 3;
  constexpr int SLOT = 16384;
  char* lds = (char*)ldsl; char* K_lds = lds; const int vbase = (int)(uintptr_t)(lds + 3 * SLOT) + v_rd_base(lane);
  float* li_l = (float*)(lds + 6 * SLOT) + wid * 64;
  float l_reg = 0; f32x16 o[4] = {}; bf16x8 qr[4];
  const unsigned short* Qw = Qb + (long)(wq * 32 + r32) * 1024 + mp * 64 + hi * 8;
#pragma unroll
  for (int d0 = 0; d0 < 4; ++d0) qr[d0] = *reinterpret_cast<const bf16x8*>(Qw + d0 * 16);
  asm volatile("s_waitcnt vmcnt(0)" ::: "memory");
  const int cbm = mp * 128;
  const unsigned wl = (unsigned)wid * 1024u;
#define DA_DMA_K(t, slot) do { const unsigned to_ = (unsigned)(t) * (unsigned)(KVBLK * LDK * 2); int ln_ = lane; asm volatile("" : "+v"(ln_));   \
    _Pragma("unroll") for (int i_ = 0; i_ < 2; ++i_) { const int P = (i_ * 8 + wid) * 64 + ln_, row = P >> 4, chunk = (P & 15) ^ (row & 7); \
      __builtin_amdgcn_global_load_lds((const unsigned*)((const char*)Kh + ((unsigned)(row * LDK + chunk * 8) * 2u + to_)), (LAS unsigned*)(ldsl + (slot) * SLOT + i_ * 8192 + wl), 16, 0, 0); } } while (0)
#define DA_DMA_V(t, slot) do { const unsigned to_ = (unsigned)(t) * (unsigned)(KVBLK * LDK * 2); int ln_ = lane; asm volatile("" : "+v"(ln_)); \
    _Pragma("unroll") for (int i_ = 0; i_ < 2; ++i_) { const int P = (i_ * 8 + wid) * 64 + ln_, sub = P >> 5, kk = (sub >> 2) * 8 + ((P & 31) >> 2), key = (kk & ~0xC) | ((kk & 4) << 1) | ((kk & 8) >> 1); \
      __builtin_amdgcn_global_load_lds((const unsigned*)((const char*)Vh + ((unsigned)(key * LDK + (sub & 3) * 32 + (P & 3) * 8) * 2u + to_)), (LAS unsigned*)(ldsl + (3 + (slot)) * SLOT + i_ * 8192 + wl), 16, 0, 0); } } while (0)
#define DA_WAITBAR(N) do { asm volatile("s_waitcnt vmcnt(" #N ") lgkmcnt(0)" ::: "memory"); __builtin_amdgcn_s_barrier(); asm volatile("" ::: "memory"); } while (0)
  f32x16 pA0, pA1, pB0, pB1; bf16x8 pa0, pa1, pa2, pa3; const int NT = seq / KVBLK;
  bf16x8 kf[8];
#define DA_KLOAD(slot) do { int so_ = (slot) * SLOT; asm volatile("" : "+s"(so_)); const char* kb_ = K_lds + so_; int ln_ = lane; asm volatile("" : "+v"(ln_)); const int r_ = ln_ & 31, h_ = ln_ >> 5; \
    _Pragma("unroll") for (int d0 = 0; d0 < 4; ++d0) { const int cb = cbm + (d0 * 16 + h_ * 8) * 2; \
    kf[2 * d0] = *reinterpret_cast<const bf16x8*>(kb_ + DA_KSWZ(r_, cb)); kf[2 * d0 + 1] = *reinterpret_cast<const bf16x8*>(kb_ + DA_KSWZ(32 + r_, cb)); } } while (0)
#define DA_QKT(P0, P1) do { P0 = f32x16{}; P1 = f32x16{}; _Pragma("unroll") for (int d0 = 0; d0 < 4; ++d0) { \
    P0 = __builtin_amdgcn_mfma_f32_32x32x16_bf16(kf[2 * d0], qr[d0], P0, 0, 0, 0); P1 = __builtin_amdgcn_mfma_f32_32x32x16_bf16(kf[2 * d0 + 1], qr[d0], P1, 0, 0, 0); } } while (0)
  DA_DMA_K(0, 0); DA_DMA_K(1, 1); DA_DMA_V(0, 0);
  DA_WAITBAR(0);
  DA_DMA_K(2, 2);
  DA_KLOAD(0);
  DA_DMA_K(3, 0); DA_DMA_V(1, 1);
  DA_SBAR(); DA_QKT(pA0, pA1); DA_SBAR();
  DA_KLOAD(1);
  expSM(pA0, pA1, soff);
  DA_WAITBAR(4);
  int c = 1;
#define DA_ROT(x) ((x) == 2 ? 0 : (x) + 1)
#define DA_PRV(x) ((x) == 0 ? 2 : (x) - 1)
  for (int j = 1; j + 1 < NT; j += 2) {
    { const bool mk = j + 3 < NT;
      if (mk) DA_DMA_K(j + 3, c);
      DA_DMA_V(j + 1, DA_ROT(c));
      DA_SBAR(); DA_QKT(pB0, pB1); DA_SBAR();
      DA_KLOAD(DA_ROT(c));
      finishSM(pA0, pA1, l_reg, pa0, pa1, pa2, pa3); DA_SBAR();
      pv_d0(o, vbase + DA_PRV(c) * SLOT, pa0, pa1, pa2, pa3); expSM(pB0, pB1, soff);
      if (mk) DA_WAITBAR(4); else DA_WAITBAR(2);
      c = DA_ROT(c); }
    { const bool mk = j + 4 < NT;
      if (mk) DA_DMA_K(j + 4, c);
      DA_DMA_V(j + 2, DA_ROT(c));
      DA_SBAR(); DA_QKT(pA0, pA1); DA_SBAR();
      DA_KLOAD(DA_ROT(c));
      finishSM(pB0, pB1, l_reg, pa0, pa1, pa2, pa3); DA_SBAR();
      pv_d0(o, vbase + DA_PRV(c) * SLOT, pa0, pa1, pa2, pa3); expSM(pA0, pA1, soff);
      if (mk) DA_WAITBAR(4); else DA_WAITBAR(2);
      c = DA_ROT(c); }
  }
  DA_SBAR(); DA_QKT(pB0, pB1); DA_SBAR();
  finishSM(pA0, pA1, l_reg, pa0, pa1, pa2, pa3); DA_SBAR();
  pv_d0(o, vbase + DA_PRV(c) * SLOT, pa0, pa1, pa2, pa3); expSM(pB0, pB1, soff);
  DA_WAITBAR(0);
  finishSM(pB0, pB1, l_reg, pa0, pa1, pa2, pa3); DA_SBAR();
  pv_d0(o, vbase + c * SLOT, pa0, pa1, pa2, pa3);
#undef DA_KLOAD
#undef DA_QKT
  { auto rr = __builtin_amdgcn_permlane32_swap(__float_as_uint(l_reg), __float_as_uint(l_reg), false, false); l_reg = __uint_as_float(rr[0]) + __uint_as_float(rr[1]); }
  const int tid2 = otid(), wid2 = __builtin_amdgcn_readfirstlane(tid2 >> 6), lane2 = tid2 & 63; { const int r32 = lane2 & 31, hi = lane2 >> 5, mp = wid2 >> 2, wq = wid2 & 3, lane = lane2; float* li_l = (float*)(lds + 6 * SLOT) + wid2 * 64;
  if (hi == 0) li_l[r32] = l_reg; asm volatile("s_waitcnt lgkmcnt(0)" ::: "memory");
  const float sgn = mp ? lam : 1.f;
#pragma unroll
  for (int r = 0; r < 16; ++r) { const float rl = sgn * __builtin_amdgcn_rcpf(li_l[crow(r, hi)]);
#pragma unroll
    for (int d0 = 0; d0 < 4; ++d0) o[d0][r] *= rl; }
  __syncthreads();
  int xb = wq * 4096 + lane; asm volatile("" : "+v"(xb));
  float* X = (float*)lds + xb;
  if (mp == 1) {
#pragma unroll
    for (int d0 = 0; d0 < 4; ++d0)
#pragma unroll
      for (int r = 0; r < 16; ++r) X[(d0 * 16 + r) * 64] = o[d0][r];
  }
  __syncthreads();
  if (mp == 0) {
    float gg[4];
#pragma unroll
    for (int d0 = 0; d0 < 4; ++d0) gg[d0] = subg[d0 * 32 + r32] * oscale;
    int ob = (wq * 32 + 4 * hi) * ldo + r32; asm volatile("" : "+v"(ob));
    unsigned short* Ow = Ob + ob;
#pragma unroll
    for (int r = 0; r < 16; ++r) { float a = 0.f; float v[4];
#pragma unroll
      for (int d0 = 0; d0 < 4; ++d0) { v[d0] = o[d0][r] - X[(d0 * 16 + r) * 64]; a += v[d0] * v[d0]; }
      a += sx<1>(a); a += sx<2>(a); a += sx<4>(a); a += sx<8>(a); a += sx<16>(a);
      a = rsqrtf(a * (1.f / 128.f) + EPS);
      const int orow = (r & 3) + 8 * (r >> 2);
#pragma unroll
      for (int d0 = 0; d0 < 4; ++d0) Ow[orow * ldo + d0 * 32] = (unsigned short)f2bf(v[d0] * a * gg[d0]); }
  }
  }
  asm volatile("s_waitcnt vmcnt(0)" ::: "memory");
  __syncthreads();
#undef DA_DMA_K
#undef DA_DMA_V
#undef DA_WAITBAR
#undef DA_ROT
#undef DA_PRV
}
__device__ __forceinline__ void unit4(const unsigned short* __restrict__ Qb, const unsigned short* __restrict__ Kh, const unsigned short* __restrict__ Vh,
                                      unsigned short* __restrict__ Ob, int ldo, int seq, float lam, float oscale, float soff, const float* __restrict__ subg, LAS unsigned char* ldsl) {
  const int tid = otid(), wid = __builtin_amdgcn_readfirstlane(tid >> 6), lane = tid & 63, r32 = lane & 31, hi = lane >> 5, mp = wid >> 2, wq = wid & 3;
  constexpr int SLOT = 16384;
  char* lds = (char*)ldsl; char* K_lds = lds; const int vbase = (int)(uintptr_t)(lds + 3 * SLOT) + v_rd_base(lane);
  float* li_l = (float*)(lds + 6 * SLOT) + wid * 64;
  float l_reg = 0; f32x16 o[4] = {}; bf16x8 qr[4];
  const unsigned short* Qw = Qb + (long)(wq * 32 + r32) * 1024 + mp * 64 + hi * 8;
#pragma unroll
  for (int d0 = 0; d0 < 4; ++d0) qr[d0] = *reinterpret_cast<const bf16x8*>(Qw + d0 * 16);
  asm volatile("s_waitcnt vmcnt(0)" ::: "memory");
  const int cbm = mp * 128;
  const unsigned wl = (unsigned)wid * 1024u;
#define DA_DMA_K(t, slot) do { const unsigned to_ = (unsigned)(t) * (unsigned)(KVBLK * LDK * 2); int ln_ = lane; asm volatile("" : "+v"(ln_));   \
    _Pragma("unroll") for (int i_ = 0; i_ < 2; ++i_) { const int P = (i_ * 8 + wid) * 64 + ln_, row = P >> 4, chunk = (P & 15) ^ (row & 7); \
      __builtin_amdgcn_global_load_lds((const unsigned*)((const char*)Kh + ((unsigned)(row * LDK + chunk * 8) * 2u + to_)), (LAS unsigned*)(ldsl + (slot) * SLOT + i_ * 8192 + wl), 16, 0, 0); } } while (0)
#define DA_DMA_V(t, slot) do { const unsigned to_ = (unsigned)(t) * (unsigned)(KVBLK * LDK * 2); int ln_ = lane; asm volatile("" : "+v"(ln_)); \
    _Pragma("unroll") for (int i_ = 0; i_ < 2; ++i_) { const int P = (i_ * 8 + wid) * 64 + ln_, sub = P >> 5, kk = (sub >> 2) * 8 + ((P & 31) >> 2), key = (kk & ~0xC) | ((kk & 4) << 1) | ((kk & 8) >> 1); \
      __builtin_amdgcn_global_load_lds((const unsigned*)((const char*)Vh + ((unsigned)(key * LDK + (sub & 3) * 32 + (P & 3) * 8) * 2u + to_)), (LAS unsigned*)(ldsl + (3 + (slot)) * SLOT + i_ * 8192 + wl), 16, 0, 0); } } while (0)
#define DA_WAITBAR(N) do { asm volatile("s_waitcnt vmcnt(" #N ") lgkmcnt(0)" ::: "memory"); __builtin_amdgcn_s_barrier(); asm volatile("" ::: "memory"); } while (0)
  f32x16 p0, p1; bf16x8 pa0, pa1, pa2, pa3; const int NT = seq / KVBLK;
  bf16x8 kf[8];
#define DA_KLOAD(slot) do { int so_ = (slot) * SLOT; asm volatile("" : "+s"(so_)); const char* kb_ = K_lds + so_; _Pragma("unroll") for (int d0 = 0; d0 < 4; ++d0) { const int cb = cbm + (d0 * 16 + hi * 8) * 2; \
    kf[2 * d0] = *reinterpret_cast<const bf16x8*>(kb_ + DA_KSWZ(r32, cb)); kf[2 * d0 + 1] = *reinterpret_cast<const bf16x8*>(kb_ + DA_KSWZ(32 + r32, cb)); } } while (0)
#define DA_QKT(P0, P1) do { P0 = f32x16{}; P1 = f32x16{}; _Pragma("unroll") for (int d0 = 0; d0 < 4; ++d0) { \
    P0 = __builtin_amdgcn_mfma_f32_32x32x16_bf16(kf[2 * d0], qr[d0], P0, 0, 0, 0); P1 = __builtin_amdgcn_mfma_f32_32x32x16_bf16(kf[2 * d0 + 1], qr[d0], P1, 0, 0, 0); } } while (0)
#define DA_ROT(x) ((x) == 2 ? 0 : (x) + 1)
#define DA_PRV(x) ((x) == 0 ? 2 : (x) - 1)
  DA_DMA_K(0, 0); DA_DMA_V(0, 0); DA_DMA_K(1, 1); DA_DMA_V(1, 1);
  DA_WAITBAR(4);
  DA_KLOAD(0);
  DA_DMA_K(2, 2);
  DA_WAITBAR(2);
  int c = 0;
  for (int j = 0; j < NT; ++j) {
    const bool mk = j + 3 < NT, mv = j + 2 < NT;
    if (mk) DA_DMA_K(j + 3, c);
    if (mv) DA_DMA_V(j + 2, DA_PRV(c));
    DA_SBAR(); DA_QKT(p0, p1); DA_SBAR();
    if (j + 1 < NT) DA_KLOAD(DA_ROT(c));
    expSM(p0, p1, soff);
    finishSM(p0, p1, l_reg, pa0, pa1, pa2, pa3); DA_SBAR();
    pv_pipe(o, vbase + c * SLOT, pa0, pa1, pa2, pa3);
    if (mk) DA_WAITBAR(4); else if (mv) DA_WAITBAR(2); else DA_WAITBAR(0);
    c = DA_ROT(c);
  }
#undef DA_KLOAD
#undef DA_QKT
  { auto rr = __builtin_amdgcn_permlane32_swap(__float_as_uint(l_reg), __float_as_uint(l_reg), false, false); l_reg = __uint_as_float(rr[0]) + __uint_as_float(rr[1]); }
  const int tid2 = otid(), wid2 = __builtin_amdgcn_readfirstlane(tid2 >> 6), lane2 = tid2 & 63; { const int r32 = lane2 & 31, hi = lane2 >> 5, mp = wid2 >> 2, wq = wid2 & 3, lane = lane2; float* li_l = (float*)(lds + 6 * SLOT) + wid2 * 64;
  if (hi == 0) li_l[r32] = l_reg; asm volatile("s_waitcnt lgkmcnt(0)" ::: "memory");
  const float sgn = mp ? lam : 1.f;
#pragma unroll
  for (int r = 0; r < 16; ++r) { const float rl = sgn * __builtin_amdgcn_rcpf(li_l[crow(r, hi)]);
#pragma unroll
    for (int d0 = 0; d0 < 4; ++d0) o[d0][r] *= rl; }
  __syncthreads();
  int xb = wq * 4096 + lane; asm volatile("" : "+v"(xb));
  float* X = (float*)lds + xb;
  if (mp == 1) {
#pragma unroll
    for (int d0 = 0; d0 < 4; ++d0)
#pragma unroll
      for (int r = 0; r < 16; ++r) X[(d0 * 16 + r) * 64] = o[d0][r];
  }
  __syncthreads();
  if (mp == 0) {
    float gg[4];
#pragma unroll
    for (int d0 = 0; d0 < 4; ++d0) gg[d0] = subg[d0 * 32 + r32] * oscale;
    int ob = (wq * 32 + 4 * hi) * ldo + r32; asm volatile("" : "+v"(ob));
    unsigned short* Ow = Ob + ob;
#pragma unroll
    for (int r = 0; r < 16; ++r) { float a = 0.f; float v[4];
#pragma unroll
      for (int d0 = 0; d0 < 4; ++d0) { v[d0] = o[d0][r] - X[(d0 * 16 + r) * 64]; a += v[d0] * v[d0]; }
      a += sx<1>(a); a += sx<2>(a); a += sx<4>(a); a += sx<8>(a); a += sx<16>(a);
      a = rsqrtf(a * (1.f / 128.f) + EPS);
      const int orow = (r & 3) + 8 * (r >> 2);
#pragma unroll
      for (int d0 = 0; d0 < 4; ++d0) Ow[orow * ldo + d0 * 32] = (unsigned short)f2bf(v[d0] * a * gg[d0]); }
  }
  }
  asm volatile("s_waitcnt vmcnt(0)" ::: "memory");
  __syncthreads();
#undef DA_DMA_K
#undef DA_DMA_V
#undef DA_WAITBAR
#undef DA_ROT
#undef DA_PRV
}
__device__ __forceinline__ void unit5(const unsigned short* __restrict__ Qb, const unsigned short* __restrict__ Kh, const unsigned short* __restrict__ Vh,
                                      unsigned short* __restrict__ Ob, int ldo, int seq, float lam, float oscale, float soff, const float* __restrict__ subg, LAS unsigned char* ldsl) {
  const int tid = otid(), wid = __builtin_amdgcn_readfirstlane(tid >> 6), lane = tid & 63, r32 = lane & 31, hi = lane >> 5, mp = wid >> 2, wq = wid & 3;
  constexpr int SLOT = 16384;
  char* lds = (char*)ldsl; char* K_lds = lds; const int vbase = (int)(uintptr_t)(lds + 3 * SLOT) + v_rd_base(lane);
  float* li_l = (float*)(lds + 6 * SLOT) + wid * 64;
  float l_reg = 0; f32x16 o[4] = {}; bf16x8 qr[4];
  const unsigned short* Qw = Qb + (long)(wq * 32 + r32) * 1024 + mp * 64 + hi * 8;
#pragma unroll
  for (int d0 = 0; d0 < 4; ++d0) qr[d0] = *reinterpret_cast<const bf16x8*>(Qw + d0 * 16);
  asm volatile("s_waitcnt vmcnt(0)" ::: "memory");
  const int cbm = mp * 128;
  const unsigned wl = (unsigned)wid * 1024u;
#define DA_DMA_K(t, slot) do { const unsigned to_ = (unsigned)(t) * (unsigned)(KVBLK * LDK * 2); int ln_ = lane; asm volatile("" : "+v"(ln_));   \
    _Pragma("unroll") for (int i_ = 0; i_ < 2; ++i_) { const int P = (i_ * 8 + wid) * 64 + ln_, row = P >> 4, chunk = (P & 15) ^ (row & 7); \
      __builtin_amdgcn_global_load_lds((const unsigned*)((const char*)Kh + ((unsigned)(row * LDK + chunk * 8) * 2u + to_)), (LAS unsigned*)(ldsl + (slot) * SLOT + i_ * 8192 + wl), 16, 0, 0); } } while (0)
#define DA_DMA_V(t, slot) do { const unsigned to_ = (unsigned)(t) * (unsigned)(KVBLK * LDK * 2); int ln_ = lane; asm volatile("" : "+v"(ln_)); \
    _Pragma("unroll") for (int i_ = 0; i_ < 2; ++i_) { const int P = (i_ * 8 + wid) * 64 + ln_, sub = P >> 5, kk = (sub >> 2) * 8 + ((P & 31) >> 2), key = (kk & ~0xC) | ((kk & 4) << 1) | ((kk & 8) >> 1); \
      __builtin_amdgcn_global_load_lds((const unsigned*)((const char*)Vh + ((unsigned)(key * LDK + (sub & 3) * 32 + (P & 3) * 8) * 2u + to_)), (LAS unsigned*)(ldsl + (3 + (slot)) * SLOT + i_ * 8192 + wl), 16, 0, 0); } } while (0)
#define DA_WAITBAR(N) do { asm volatile("s_waitcnt vmcnt(" #N ") lgkmcnt(0)" ::: "memory"); __builtin_amdgcn_s_barrier(); asm volatile("" ::: "memory"); } while (0)
  f32x16 pA0, pA1, pB0, pB1; u32x4 pw0, pw1, pw2, pw3; const int NT = seq / KVBLK;
  bf16x8 kf[8];
#define U5_KADDR(d0) ((int)(uintptr_t)K_lds + r32 * 256 + ((((cbm >> 4) + 2 * (d0) + hi) ^ (r32 & 7)) * 16))
#define U5_KLOAD(slot) do { const int so_ = (slot) * SLOT; _Pragma("unroll") for (int d0 = 0; d0 < 4; ++d0) { const int ad_ = U5_KADDR(d0) + so_; \
    asm volatile("ds_read_b128 %0, %2\n\tds_read_b128 %1, %2 offset:8192" : "=&v"(kf[2 * d0]), "=&v"(kf[2 * d0 + 1]) : "v"(ad_) : "memory"); } } while (0)
#define U5_PIN(x) asm volatile("" : "+v"(x))
#define U5_EX(v) __builtin_amdgcn_exp2f((v) - soff)
#define U5_GAPA(MF, X, B4, PW, PWI, CV0, CV1) do { MF; sacc += X[B4]; sacc += X[B4 + 1]; sacc += X[B4 + 2]; sacc += X[B4 + 3]; U5_PIN(sacc); CV0; CV1; U5_PIN(PW); DA_SBAR(); } while (0)
#define U5_CVT(P, b) cvtpk(P[b], P[b + 1])
#define U5_PHASE_A(C0, C1, P0, P1) do { float sacc = 0.f; unsigned a0_, a1_, b0_, b1_; \
    U5_GAPA(C0 = __builtin_amdgcn_mfma_f32_32x32x16_bf16(kf[0], qr[0], f32x16{}, 0, 0, 0), P0, 0, a0_, 0, a0_ = U5_CVT(P0, 0), a1_ = U5_CVT(P0, 2)); \
    U5_GAPA(C1 = __builtin_amdgcn_mfma_f32_32x32x16_bf16(kf[1], qr[0], f32x16{}, 0, 0, 0), P0, 4, b0_, 0, b0_ = U5_CVT(P0, 4), b1_ = U5_CVT(P0, 6)); \
    { auto r0_ = __builtin_amdgcn_permlane32_swap(a0_, b0_, false, false); auto r1_ = __builtin_amdgcn_permlane32_swap(a1_, b1_, false, false); pw0 = (u32x4){r0_[0], r1_[0], r0_[1], r1_[1]}; } \
    U5_GAPA(C0 = __builtin_amdgcn_mfma_f32_32x32x16_bf16(kf[2], qr[1], C0, 0, 0, 0), P0, 8, a0_, 0, a0_ = U5_CVT(P0, 8), a1_ = U5_CVT(P0, 10)); \
    U5_GAPA(C1 = __builtin_amdgcn_mfma_f32_32x32x16_bf16(kf[3], qr[1], C1, 0, 0, 0), P0, 12, b0_, 0, b0_ = U5_CVT(P0, 12), b1_ = U5_CVT(P0, 14)); \
    { auto r0_ = __builtin_amdgcn_permlane32_swap(a0_, b0_, false, false); auto r1_ = __builtin_amdgcn_permlane32_swap(a1_, b1_, false, false); pw1 = (u32x4){r0_[0], r1_[0], r0_[1], r1_[1]}; } \
    U5_GAPA(C0 = __builtin_amdgcn_mfma_f32_32x32x16_bf16(kf[4], qr[2], C0, 0, 0, 0), P1, 0, a0_, 0, a0_ = U5_CVT(P1, 0), a1_ = U5_CVT(P1, 2)); \
    U5_GAPA(C1 = __builtin_amdgcn_mfma_f32_32x32x16_bf16(kf[5], qr[2], C1, 0, 0, 0), P1, 4, b0_, 0, b0_ = U5_CVT(P1, 4), b1_ = U5_CVT(P1, 6)); \
    { auto r0_ = __builtin_amdgcn_permlane32_swap(a0_, b0_, false, false); auto r1_ = __builtin_amdgcn_permlane32_swap(a1_, b1_, false, false); pw2 = (u32x4){r0_[0], r1_[0], r0_[1], r1_[1]}; } \
    U5_GAPA(C0 = __builtin_amdgcn_mfma_f32_32x32x16_bf16(kf[6], qr[3], C0, 0, 0, 0), P1, 8, a0_, 0, a0_ = U5_CVT(P1, 8), a1_ = U5_CVT(P1, 10)); \
    U5_GAPA(C1 = __builtin_amdgcn_mfma_f32_32x32x16_bf16(kf[7], qr[3], C1, 0, 0, 0), P1, 12, b0_, 0, b0_ = U5_CVT(P1, 12), b1_ = U5_CVT(P1, 14)); \
    { auto r0_ = __builtin_amdgcn_permlane32_swap(a0_, b0_, false, false); auto r1_ = __builtin_amdgcn_permlane32_swap(a1_, b1_, false, false); pw3 = (u32x4){r0_[0], r1_[0], r0_[1], r1_[1]}; } \
    l_reg += sacc; } while (0)
#define U5_VRD(L, H, m) do { asm volatile("ds_read_b64_tr_b16 %0, %1 offset:%2" : "=&v"(L) : "v"(vb_), "i"(v_rd_off((m) >> 2, (m) & 3, 0)) : "memory"); \
    asm volatile("ds_read_b64_tr_b16 %0, %1 offset:%2" : "=&v"(H) : "v"(vb_), "i"(v_rd_off((m) >> 2, (m) & 3, 1)) : "memory"); } while (0)
#define U5_PKV(L, H) (bf16x8){L[0], L[1], L[2], L[3], H[0], H[1], H[2], H[3]}
#define U5_PAF(k) __builtin_bit_cast(bf16x8, pw##k)
#define U5_GAPB(WAITN, OD, PK, L, H, X, B2, NEXT) do { asm volatile("s_waitcnt lgkmcnt(" #WAITN ")" ::: "memory"); DA_SBAR(); \
    OD = __builtin_amdgcn_mfma_f32_32x32x16_bf16(PK, U5_PKV(L, H), OD, 0, 0, 0); NEXT; X[B2] = U5_EX(X[B2]); X[B2 + 1] = U5_EX(X[B2 + 1]); U5_PIN(X); DA_SBAR(); } while (0)
#define U5_PHASE_B(C0, C1, VSLOT, KSLOT, DOK) do { const int vb_ = vbase + (VSLOT) * SLOT; s16x4 l0_, h0_, l1_, h1_, l2_, h2_; \
    U5_VRD(l0_, h0_, 0); U5_VRD(l1_, h1_, 1); \
    U5_GAPB(2, o[0], U5_PAF(0), l0_, h0_, C0, 0, U5_VRD(l2_, h2_, 2)); \
    U5_GAPB(2, o[0], U5_PAF(1), l1_, h1_, C0, 2, U5_VRD(l0_, h0_, 3)); \
    U5_GAPB(2, o[0], U5_PAF(2), l2_, h2_, C0, 4, U5_VRD(l1_, h1_, 4)); \
    U5_GAPB(2, o[0], U5_PAF(3), l0_, h0_, C0, 6, U5_VRD(l2_, h2_, 5)); \
    U5_GAPB(2, o[1], U5_PAF(0), l1_, h1_, C0, 8, U5_VRD(l0_, h0_, 6)); \
    U5_GAPB(2, o[1], U5_PAF(1), l2_, h2_, C0, 10, U5_VRD(l1_, h1_, 7)); \
    U5_GAPB(2, o[1], U5_PAF(2), l0_, h0_, C0, 12, U5_VRD(l2_, h2_, 8)); \
    U5_GAPB(2, o[1], U5_PAF(3), l1_, h1_, C0, 14, U5_VRD(l0_, h0_, 9)); \
    U5_GAPB(2, o[2], U5_PAF(0), l2_, h2_, C1, 0, U5_VRD(l1_, h1_, 10)); \
    U5_GAPB(2, o[2], U5_PAF(1), l0_, h0_, C1, 2, U5_VRD(l2_, h2_, 11)); \
    U5_GAPB(2, o[2], U5_PAF(2), l1_, h1_, C1, 4, U5_VRD(l0_, h0_, 12)); \
    U5_GAPB(2, o[2], U5_PAF(3), l2_, h2_, C1, 6, U5_VRD(l1_, h1_, 13)); \
    U5_GAPB(2, o[3], U5_PAF(0), l0_, h0_, C1, 8, U5_VRD(l2_, h2_, 14)); \
    U5_GAPB(2, o[3], U5_PAF(1), l1_, h1_, C1, 10, do { U5_VRD(l0_, h0_, 15); if (DOK) U5_KLOAD(KSLOT); } while (0)); \
    if (DOK) { U5_GAPB(10, o[3], U5_PAF(2), l2_, h2_, C1, 12, (void)0); U5_GAPB(8, o[3], U5_PAF(3), l0_, h0_, C1, 14, (void)0); } \
    else { U5_GAPB(2, o[3], U5_PAF(2), l2_, h2_, C1, 12, (void)0); U5_GAPB(0, o[3], U5_PAF(3), l0_, h0_, C1, 14, (void)0); } } while (0)
#define DA_ROT(x) ((x) == 2 ? 0 : (x) + 1)
#define DA_PRV(x) ((x) == 0 ? 2 : (x) - 1)
  DA_DMA_K(0, 0); DA_DMA_K(1, 1); DA_DMA_V(0, 0);
  DA_WAITBAR(0);
  U5_KLOAD(0); DA_DMA_K(2, 2); DA_DMA_V(1, 1);
  DA_WAITBAR(4);
  DA_DMA_K(3, 0);
  DA_SBAR();
  pA0 = f32x16{}; pA1 = f32x16{};
#pragma unroll
  for (int d0 = 0; d0 < 4; ++d0) { pA0 = __builtin_amdgcn_mfma_f32_32x32x16_bf16(kf[2 * d0], qr[d0], pA0, 0, 0, 0); pA1 = __builtin_amdgcn_mfma_f32_32x32x16_bf16(kf[2 * d0 + 1], qr[d0], pA1, 0, 0, 0); }
  DA_SBAR(); U5_KLOAD(1);
  expSM(pA0, pA1, soff);
  DA_WAITBAR(2);
  int c = 1;
  for (int j = 1; j + 1 < NT; j += 2) {
    { const bool mk = j + 3 < NT;
      if (mk) DA_DMA_K(j + 3, c);
      DA_DMA_V(j + 1, DA_ROT(c));
      DA_SBAR(); U5_PHASE_A(pB0, pB1, pA0, pA1);
      U5_PHASE_B(pB0, pB1, DA_PRV(c), DA_ROT(c), true);
      if (mk) DA_WAITBAR(4); else DA_WAITBAR(2);
      c = DA_ROT(c); }
    { const bool mk = j + 4 < NT;
      if (mk) DA_DMA_K(j + 4, c);
      DA_DMA_V(j + 2, DA_ROT(c));
      DA_SBAR(); U5_PHASE_A(pA0, pA1, pB0, pB1);
      U5_PHASE_B(pA0, pA1, DA_PRV(c), DA_ROT(c), true);
      if (mk) DA_WAITBAR(4); else DA_WAITBAR(2);
      c = DA_ROT(c); }
  }
  DA_SBAR(); U5_PHASE_A(pB0, pB1, pA0, pA1);
  U5_PHASE_B(pB0, pB1, DA_PRV(c), 0, false);
  DA_WAITBAR(0);
  { bf16x8 pa0, pa1, pa2, pa3; finishSM(pB0, pB1, l_reg, pa0, pa1, pa2, pa3); DA_SBAR();
    pv_d0(o, vbase + c * SLOT, pa0, pa1, pa2, pa3); }
#undef U5_KADDR
#undef U5_KLOAD
#undef U5_PIN
#undef U5_EX
#undef U5_GAPA
#undef U5_CVT
#undef U5_PHASE_A
#undef U5_VRD
#undef U5_PKV
#undef U5_PAF
#undef U5_GAPB
#undef U5_PHASE_B
  { auto rr = __builtin_amdgcn_permlane32_swap(__float_as_uint(l_reg), __float_as_uint(l_reg), false, false); l_reg = __uint_as_float(rr[0]) + __uint_as_float(rr[1]); }
  const int tid2 = otid(), wid2 = __builtin_amdgcn_readfirstlane(tid2 >> 6), lane2 = tid2 & 63; { const int r32 = lane2 & 31, hi = lane2 >> 5, mp = wid2 >> 2, wq = wid2 & 3, lane = lane2; float* li_l = (float*)(lds + 6 * SLOT) + wid2 * 64;
  if (hi == 0) li_l[r32] = l_reg; asm volatile("s_waitcnt lgkmcnt(0)" ::: "memory");
  const float sgn = mp ? lam : 1.f;
#pragma unroll
  for (int r = 0; r < 16; ++r) { const float rl = sgn * __builtin_amdgcn_rcpf(li_l[crow(r, hi)]);
#pragma unroll
    for (int d0 = 0; d0 < 4; ++d0) o[d0][r] *= rl; }
  __syncthreads();
  int xb = wq * 4096 + lane; asm volatile("" : "+v"(xb));
  float* X = (float*)lds + xb;
  if (mp == 1) {
#pragma unroll
    for (int d0 = 0; d0 < 4; ++d0)
#pragma unroll
      for (int r = 0; r < 16; ++r) X[(d0 * 16 + r) * 64] = o[d0][r];
  }
  __syncthreads();
  if (mp == 0) {
    float gg[4];
#pragma unroll
    for (int d0 = 0; d0 < 4; ++d0) gg[d0] = subg[d0 * 32 + r32] * oscale;
    int ob = (wq * 32 + 4 * hi) * ldo + r32; asm volatile("" : "+v"(ob));
    unsigned short* Ow = Ob + ob;
#pragma unroll
    for (int r = 0; r < 16; ++r) { float a = 0.f; float v[4];
#pragma unroll
      for (int d0 = 0; d0 < 4; ++d0) { v[d0] = o[d0][r] - X[(d0 * 16 + r) * 64]; a += v[d0] * v[d0]; }
      a += sx<1>(a); a += sx<2>(a); a += sx<4>(a); a += sx<8>(a); a += sx<16>(a);
      a = rsqrtf(a * (1.f / 128.f) + EPS);
      const int orow = (r & 3) + 8 * (r >> 2);
#pragma unroll
      for (int d0 = 0; d0 < 4; ++d0) Ow[orow * ldo + d0 * 32] = (unsigned short)f2bf(v[d0] * a * gg[d0]); }
  }
  }
  asm volatile("s_waitcnt vmcnt(0)" ::: "memory");
  __syncthreads();
#undef DA_DMA_K
#undef DA_DMA_V
#undef DA_WAITBAR
#undef DA_ROT
#undef DA_PRV
}
}
__device__ __forceinline__ void ph_attn(const Frame& F, const Args& A, int l) {
    const bf16 *Kb = WSP(bf16, WS_KB), *Vb = WSP(bf16, WS_VB), *Qb = WSP(bf16, WS_QB); bf16* MX = WSP(bf16, WS_MIXIN);
    const float* lq = A.in[10] + l * 256; float d01 = 0.f, d23 = 0.f;
    for (int i = 0; i < 64; ++i) { d01 += lq[i] * lq[64 + i]; d23 += lq[128 + i] * lq[192 + i]; }
    const float lam_init = 0.8f - 0.6f * expf(-0.3f * (float)l); float lam = expf(d01) - expf(d23) + lam_init;
    float mq = 0.f, mk = 0.f;
    for (int i = 0; i < 64; ++i) { mq = fmaxf(mq, fabsf(A.in[8][l * 64 + i])); mk = fmaxf(mk, fabsf(A.in[9][l * 64 + i])); }
    const float soff = __uint_as_float(__builtin_amdgcn_readfirstlane(__float_as_uint(64.f * mq * mk * QSCALE)));
    lam = __uint_as_float(__builtin_amdgcn_readfirstlane(__float_as_uint(lam))); const float osc = __uint_as_float(__builtin_amdgcn_readfirstlane(__float_as_uint(1.f - lam_init)));
    const int vcu = (F.G % 8 == 0) ? (F.bid % 8) * (F.G / 8) + F.bid / 8 : F.bid;
    for (int u = vcu; u < (l == DEPTH - 1 ? 1024 : 16 * 66); u += F.G) {
        const int bh = (u % 1024) / 64 , b = bh >> 3, h = bh & 7;
        int qb; int bb = b, hh = h;
        if (u < 1024) qb = 2 + (u & 63); else { const int v = u - 1024; bb = v >> 4; hh = (v >> 1) & 7; qb = v & 1; }
        const size_t R0 = (size_t)bb * TPB + qb * 128; const int seq = qb < 2 ? CTX : TPB;
#if ATTN_V2 == 5
        da::unit5(Qb + R0 * 1024 + hh * 128, Kb + (size_t)bb * TPB * 1024 + hh * 128, Vb + (size_t)bb * TPB * 1024 + hh * 128,
                  MX + R0 * 3072 + hh * 128, 3072, seq, lam, osc, soff, A.in[11] + l * 128, F.lds);
#elif ATTN_V2 == 4
        da::unit4(Qb + R0 * 1024 + hh * 128, Kb + (size_t)bb * TPB * 1024 + hh * 128, Vb + (size_t)bb * TPB * 1024 + hh * 128,
                  MX + R0 * 3072 + hh * 128, 3072, seq, lam, osc, soff, A.in[11] + l * 128, F.lds);
#elif ATTN_V2 == 3
        da::unit3(Qb + R0 * 1024 + hh * 128, Kb + (size_t)bb * TPB * 1024 + hh * 128, Vb + (size_t)bb * TPB * 1024 + hh * 128,
                  MX + R0 * 3072 + hh * 128, 3072, seq, lam, osc, soff, A.in[11] + l * 128, F.lds);
#elif ATTN_V2 == 1
        da::unit2(Qb + R0 * 1024 + hh * 128, Kb + (size_t)bb * TPB * 1024 + hh * 128, Vb + (size_t)bb * TPB * 1024 + hh * 128,
                  MX + R0 * 3072 + hh * 128, 3072, seq, lam, osc, soff, A.in[11] + l * 128, F.lds);
#else
        da::unit(Qb + R0 * 1024 + hh * 128, Kb + (size_t)bb * TPB * 1024 + hh * 128, Vb + (size_t)bb * TPB * 1024 + hh * 128,
                 MX + R0 * 3072 + hh * 128, 3072, seq, lam, osc, soff, A.in[11] + l * 128, (char*)F.lds);
#endif
    }
}

__device__ __forceinline__ void ph_mix(const Frame& F, const Args& A) {
    const float *PA = WSP(float, WS_PA), *PR = WSP(float, WS_PR), *PF = WSP(float, WS_PF); const bf16* GT = WSP(bf16, WS_GATES); bf16* MD = WSP(bf16, WS_MIXED);
    for (long i = F.gtid; i < (long)MROWS * 1024; i += F.NT) { const size_t R = (size_t)(i >> 10); const int c = (int)(i & 1023);
        MD[i] = (bf16)f2bf(bf2f(GT[R * 3072 + c]) * PA[i] + bf2f(GT[R * 3072 + 1024 + c]) * PR[i] + bf2f(GT[R * 3072 + 2048 + c]) * PF[i]); }
}
__device__ __forceinline__ void ph_resid_norm2(const Frame& F, const Args& A, int l) {
    float* X = WSP(float, WS_XALL); const float* Y1 = WSP(float, WS_Y1); bf16* TOK = WSP(bf16, WS_TOK);
    for (int R = F.gw; R < MROWS; R += F.NGW) {
        const int b = R / TPB, p = R % TPB, s = (p < CTX) ? 2 : b; const float* g1 = MODP(l, s, 2);
        f32x4 v[4];
#pragma unroll
        for (int j = 0; j < 4; ++j) { const int c = 4 * F.lane + 256 * j; const f32x4 x = *(const f32x4*)(X + (size_t)R * 1024 + c), y = *(const f32x4*)(Y1 + (size_t)R * 1024 + c), gg = *(const f32x4*)(g1 + c);
            v[j] = x + gg * y; *(f32x4*)(X + (size_t)R * 1024 + c) = v[j]; }
        norm_mod_row(v, A.in[23] + l * 1024, MODP(l, s, 4), MODP(l, s, 3), TOK + (size_t)R * 1024, F.lane);
    }
}
__device__ __forceinline__ void ph_topk(const Frame& F, const Args& A, int l) {
    const float* LG = WSP(float, WS_LOG); const float* SGU = WSP(float, WS_SGU); bf16* SH = WSP(bf16, WS_SH);
    int* LIST = WSP(int, WS_LIST); float* TOPW = WSP(float, WS_TOPW); int* CNT = (int*)(A.ws + WS_CTL) + CW_CNT + l * 256 * CNT_STRIDE;
    const float NEG = -__builtin_inff();
    for (int R = F.gw; R < MROWS; R += F.NGW) {
        if (l == DEPTH - 1 && (R % TPB) < CTX) continue;
        const f32x4 lg4 = *(const f32x4*)(LG + (size_t)R * 256 + 4 * F.lane); const f32x4 rb4 = *(const f32x4*)(A.in[25] + l * 256 + 4 * F.lane);
        float sc[4] = {sigmoidf_(lg4.x), sigmoidf_(lg4.y), sigmoidf_(lg4.z), sigmoidf_(lg4.w)};
        float bi[4] = {sc[0] + rb4.x, sc[1] + rb4.y, sc[2] + rb4.z, sc[3] + rb4.w};
        float t1 = NEG, t2 = NEG;
#pragma unroll
        for (int q = 0; q < 4; ++q) { const float v = bi[q]; if (v > t1) { t2 = t1; t1 = v; } else if (v > t2) t2 = v; }
#define TK_M2(M) { const float o1 = sx<M>(t1), o2 = sx<M>(t2); const float n1 = fmaxf(t1, o1), n2 = fmaxf(fminf(t1, o1), fmaxf(t2, o2)); t1 = n1; t2 = n2; }
        TK_M2(1) TK_M2(2) TK_M2(4)
#undef TK_M2
        const float gs = t1 + t2; const int mygrp = F.lane >> 3; int rank = 0;
#pragma unroll
        for (int j = 0; j < 8; ++j) { const float sj = __uint_as_float(__builtin_amdgcn_readlane(__float_as_uint(gs), j * 8)); rank += (sj > gs || (sj == gs && j < mygrp)) ? 1 : 0; }
        const bool sel = rank < 4;
        float cand[4];
#pragma unroll
        for (int q = 0; q < 4; ++q) cand[q] = sel ? bi[q] : NEG;
        int my_e = 0; float my_s = 0.f, ssum = 0.f;
#pragma unroll
        for (int k = 0; k < 8; ++k) {
            float bv = cand[0]; int bq = 0;
#pragma unroll
            for (int q = 1; q < 4; ++q) if (cand[q] > bv) { bv = cand[q]; bq = q; }
            float v = bv; int e = 4 * F.lane + bq;
#define TK_AM(M) { const float ov = sx<M>(v); const int oe = sxi<M>(e); if (ov > v || (ov == v && oe < e)) { v = ov; e = oe; } }
            TK_AM(1) TK_AM(2) TK_AM(4) TK_AM(8) TK_AM(16) TK_AM(32)
#undef TK_AM
            e = __builtin_amdgcn_readfirstlane(e);
            const int ol = e >> 2, oq = e & 3; float sv = 0.f;
#pragma unroll
            for (int q = 0; q < 4; ++q) if (oq == q) { sv = sc[q]; if (F.lane == ol) cand[q] = NEG; }
            sv = __uint_as_float(__builtin_amdgcn_readlane(__float_as_uint(sv), ol)); ssum += sv;
            if (F.lane == k) { my_e = e; my_s = sv; }
        }
        if (F.lane < 8) { const int pos = atomicAdd(CNT + my_e * CNT_STRIDE, 1); LIST[(size_t)my_e * LCAP + pos] = R * 8 + F.lane; TOPW[(size_t)R * 8 + F.lane] = my_s / ssum * 2.5f; WSP(int, WS_EP)[(size_t)R * 8 + F.lane] = my_e * LCAP + pos; }
#pragma unroll
        for (int j = 0; j < 4; ++j) { const int f = F.lane + 64 * j; SH[(size_t)R * 256 + f] = (bf16)f2bf(siluf_(SGU[(size_t)R * 512 + f]) * SGU[(size_t)R * 512 + 256 + f]); }
    }
}
__device__ __forceinline__ void ph_experts_naive(const Frame& F, const Args& A, int l) {
    const bf16* TOK = WSP(bf16, WS_TOK); const int* LIST = WSP(int, WS_LIST); const float* TOPW = WSP(float, WS_TOPW); float* YB = WSP(float, WS_YB);
    const int* CNT = (const int*)(A.ws + WS_CTL) + CW_CNT + l * 256 * CNT_STRIDE;
    LAS bf16* Xs = (LAS bf16*)F.lds;
    LAS float* Hs = (LAS float*)(F.lds + 65536);
    LAS int* pref = (LAS int*)(F.lds + 98304);
    LAS int* sPair = pref + 320; LAS float* sW = (LAS float*)(sPair + 32);
    __syncthreads();
    if (F.tid == 0) { int s = 0; for (int e = 0; e < 256; ++e) { pref[e] = s; s += (CNT[e] + 31) >> 5; } pref[256] = s; }
    __syncthreads();
    const int total = pref[256];
    for (int id = F.bid; id < total; id += F.G) {
        int lo = 0, hi = 255; while (lo < hi) { const int mid = (lo + hi + 1) >> 1; if (pref[mid] <= id) lo = mid; else hi = mid - 1; }
        const int e = lo, c = id - pref[e], n = min(32, CNT[e] - c * 32);
        __syncthreads();
        if (F.tid < 32) { const int pr = F.tid < n ? LIST[(size_t)e * LCAP + c * 32 + F.tid] : -1; sPair[F.tid] = pr; sW[F.tid] = pr >= 0 ? TOPW[pr] : 0.f; }
        __syncthreads();
        for (int pc = F.tid; pc < 4096; pc += 512) { const int row = pc >> 7, c8 = (pc & 127) * 8, pr = sPair[row];
            v4u v = {0u, 0u, 0u, 0u}; if (pr >= 0) v = *(const v4u*)(TOK + (size_t)(pr >> 3) * 1024 + c8);
            *(LAS v4u*)(Xs + row * 1024 + c8) = v; }
        __syncthreads();
        { const int f = F.tid & 255, gu = F.tid >> 8; const float* W = (gu ? A.in[27] : A.in[26]) + ((size_t)(l * 256 + e) * 1024) * 256 + f;
          float acc[32];
#pragma unroll
          for (int r = 0; r < 32; ++r) acc[r] = 0.f;
          for (int k = 0; k < 1024; ++k) { const float w = W[(size_t)k * 256];
#pragma unroll
              for (int r = 0; r < 32; ++r) acc[r] += bf2f(Xs[r * 1024 + k]) * w; }
          if (gu == 0) {
#pragma unroll
              for (int r = 0; r < 32; ++r) Hs[r * 256 + f] = siluf_(acc[r]); }
          __syncthreads();
          if (gu == 1) {
#pragma unroll
              for (int r = 0; r < 32; ++r) Hs[r * 256 + f] *= acc[r]; }
          __syncthreads(); }
        { const float* Wd = A.in[28] + ((size_t)(l * 256 + e) * 256) * 1024 + F.tid;
          float a0[32], a1[32];
#pragma unroll
          for (int r = 0; r < 32; ++r) { a0[r] = 0.f; a1[r] = 0.f; }
          for (int k = 0; k < 256; ++k) { const float w0 = Wd[(size_t)k * 1024], w1 = Wd[(size_t)k * 1024 + 512];
#pragma unroll
              for (int r = 0; r < 32; ++r) { const float hv = Hs[r * 256 + k]; a0[r] += hv * w0; a1[r] += hv * w1; } }
#pragma unroll
          for (int r = 0; r < 32; ++r) { const int pr = sPair[r]; if (pr >= 0) { const float w = sW[r]; YB[(size_t)pr * 1024 + F.tid] = a0[r] * w; YB[(size_t)pr * 1024 + 512 + F.tid] = a1[r] * w; } } }
    }
}
struct TrItem { const float* W; bf16* WT; int ldw, k0, n0, ldwt, rowbase; };
__device__ __forceinline__ void tr_load(const TrItem& t, f32x4 (&v)[8], int lane) {
    const int rr = lane >> 3, c4 = (lane & 7) * 4;
#pragma unroll
    for (int i = 0; i < 8; ++i) v[i] = __builtin_nontemporal_load((const f32x4*)(t.W + (size_t)(t.k0 + 8 * i + rr) * t.ldw + t.n0 + c4));
}
__device__ __forceinline__ void tr_store(const TrItem& t, const f32x4 (&v)[8], LAS float* scr, int lane) {
    const int rr = lane >> 3, c4 = (lane & 7) * 4;
#pragma unroll
    for (int i = 0; i < 8; ++i) { LAS float* d = scr + (8 * i + rr) * 33 + c4; d[0] = v[i].x; d[1] = v[i].y; d[2] = v[i].z; d[3] = v[i].w; }
    LDS_WAIT(); asm volatile("" ::: "memory");
    const int c = lane & 7;
#pragma unroll
    for (int j = 0; j < 4; ++j) { const int n = (lane >> 3) + 8 * j; const LAS float* sp = scr + (8 * c) * 33 + n;
        v4u o; o.x = pk2(sp[0 * 33], sp[1 * 33]); o.y = pk2(sp[2 * 33], sp[3 * 33]); o.z = pk2(sp[4 * 33], sp[5 * 33]); o.w = pk2(sp[6 * 33], sp[7 * 33]);
        *(v4u*)(t.WT + (size_t)(t.rowbase + n) * t.ldwt + t.k0 + 8 * c) = o; }
    LDS_WAIT(); asm volatile("" ::: "memory");
}
__device__ __forceinline__ TrItem expert_item(const Args& A, int l, int it) {
    const int e = it / 384, r = it % 384; bf16* E1 = (bf16*)(A.ws + WS_EW + (size_t)e * EW_STRIDE); TrItem t;
    if (r < 256) { const int up = r >> 7, q = r & 127, kb = q >> 3, nb = q & 7, n0 = 32 * nb;
        t.W = (up ? A.in[27] : A.in[26]) + ((size_t)(l * 256 + e) * 1024) * 256; t.ldw = 256; t.k0 = 64 * kb; t.n0 = n0; t.WT = E1; t.ldwt = 1024; t.rowbase = (n0 >> 7) * 256 + up * 128 + (n0 & 127); }
    else { const int q = r - 256, kb = q >> 5, nb = q & 31;
        t.W = A.in[28] + ((size_t)(l * 256 + e) * 256) * 1024; t.ldw = 1024; t.k0 = 64 * kb; t.n0 = 32 * nb; t.WT = E1 + 512 * 1024; t.ldwt = 256; t.rowbase = 32 * nb; }
    return t;
}
__device__ __forceinline__ void ph_expert_w(const Frame& F, const Args& A, int l) {
    LAS float* scr = (LAS float*)(F.lds + F.wave * 16384);
    int it = F.gw; if (it >= 256 * 384) return;
    TrItem cur = expert_item(A, l, it); f32x4 va[8], vb[8]; tr_load(cur, va, F.lane);
    for (;;) {
        const int nx = it + F.NGW; const bool has = nx < 256 * 384; TrItem nxt = cur;
        if (has) { nxt = expert_item(A, l, nx); tr_load(nxt, vb, F.lane); }
        tr_store(cur, va, scr, F.lane);
        if (!has) break;
#pragma unroll
        for (int i = 0; i < 8; ++i) va[i] = vb[i];
        cur = nxt; it = nx;
    }
}
struct MoeSched {
    const LAS int* pref; const int* cnt; const int* list; const char* abase; const char* bbase; int npn, G, c, lda2; size_t b_pn_stride; bool gather;
    __device__ __forceinline__ bool next(int i, pg8::UnitG& U) const {
        const long id = (long)i * G + c; const int total = pref[256]; if (id >= (long)total * npn) return false;
        const int tau = (int)(id / npn), pn = (int)(id % npn);
        int lo = 0, hi = 255; while (lo < hi) { const int mid = (lo + hi + 1) >> 1; if (pref[mid] <= tau) lo = mid; else hi = mid - 1; }
        const int e = lo, t = tau - pref[e];
        U.e = e; U.pn = pn; U.valid = min(256, cnt[e * CNT_STRIDE] - t * 256); U.rows = list + (size_t)e * LCAP + t * 256; U.row0 = tau * 256;
        U.a = gather ? abase : abase + (size_t)tau * 256 * lda2; U.b = bbase + (size_t)e * EW_STRIDE + (size_t)pn * b_pn_stride; return true;
    }
};
__device__ __forceinline__ void moe_prefix(const Frame& F, const int* CNT, LAS int* pref) {
    LAS int* tmp = pref + 320;
    __syncthreads();
    if (F.tid < 256) tmp[F.tid] = (CNT[F.tid * CNT_STRIDE] + 255) >> 8;
    __syncthreads();
    if (F.tid <= 256) { int sum = 0; for (int e = 0; e < F.tid; ++e) sum += tmp[e]; pref[F.tid] = sum; }
    __syncthreads();
}
struct EpiSwiGLU {
    static constexpr bool PERM = true;
    bf16* HB;
    __device__ __forceinline__ void operator()(const f32x4 (&acc)[2][2][4][2], const pg8::UnitG& u, int wr, int wc, int fr, int fq) const {
#pragma unroll
        for (int ai = 0; ai < 2; ++ai)
#pragma unroll
            for (int m = 0; m < 4; ++m) { const int r = ai * 128 + wr * 64 + m * 16 + fr;
                const f32x4 g0 = acc[ai][0][m][0], g1 = acc[ai][0][m][1], u0 = acc[ai][1][m][0], u1 = acc[ai][1][m][1];
                v4u w; w.x = pk2(siluf_(g0[0]) * u0[0], siluf_(g0[1]) * u0[1]); w.y = pk2(siluf_(g0[2]) * u0[2], siluf_(g0[3]) * u0[3]);
                w.z = pk2(siluf_(g1[0]) * u1[0], siluf_(g1[1]) * u1[1]); w.w = pk2(siluf_(g1[2]) * u1[2], siluf_(g1[3]) * u1[3]);
                *(v4u*)(HB + (size_t)(u.row0 + r) * 256 + u.pn * 128 + wc * 32 + 8 * fq) = w; }
    }
};
struct EpiScatter {
    static constexpr bool PERM = true;
    bf16* Y;
    __device__ __forceinline__ void operator()(const f32x4 (&acc)[2][2][4][2], const pg8::UnitG& u, int wr, int wc, int fr, int fq) const {
#pragma unroll
        for (int ai = 0; ai < 2; ++ai)
#pragma unroll
            for (int m = 0; m < 4; ++m) { const int r = ai * 128 + wr * 64 + m * 16 + fr;
                if (r < u.valid) { bf16* dst = Y + (size_t)(u.row0 + r) * 1024 + u.pn * 256 + wc * 32 + 8 * fq;
#pragma unroll
                    for (int bj = 0; bj < 2; ++bj) { const f32x4 v0 = acc[ai][bj][m][0], v1 = acc[ai][bj][m][1];
                        v4u o; o.x = pk2(v0[0], v0[1]); o.y = pk2(v0[2], v0[3]); o.z = pk2(v1[0], v1[1]); o.w = pk2(v1[2], v1[3]);
                        *(v4u*)(dst + bj * 128) = o; } } }
    }
};
__device__ __forceinline__ void ph_experts_up(const Frame& F, const Args& A, int l) {
    const int* CNT = (const int*)(A.ws + WS_CTL) + CW_CNT + l * 256 * CNT_STRIDE; LAS int* pref = (LAS int*)(F.lds + RING_BYTES + 1024);
    moe_prefix(F, CNT, pref);
    const int vcu = (F.G % 8 == 0) ? (F.bid % 8) * (F.G / 8) + F.bid / 8 : F.bid;
    MoeSched S{pref, CNT, WSP(int, WS_LIST), (const char*)WSP(bf16, WS_TOK), (const char*)(A.ws + WS_EW), 2, F.G, vcu, 2048, (size_t)256 * 1024 * 2, true};
    EpiSwiGLU E{WSP(bf16, WS_HB)};
    pg8::gemm_phase_g<EpiSwiGLU, MoeSched, true>(F.lds, 1024, 1024, 1024, S, E);
}
__device__ __forceinline__ void ph_experts_down(const Frame& F, const Args& A, int l) {
    const int* CNT = (const int*)(A.ws + WS_CTL) + CW_CNT + l * 256 * CNT_STRIDE; LAS int* pref = (LAS int*)(F.lds + RING_BYTES + 1024);
    moe_prefix(F, CNT, pref);
    const int vcu = (F.G % 8 == 0) ? (F.bid % 8) * (F.G / 8) + F.bid / 8 : F.bid;
    MoeSched S{pref, CNT, WSP(int, WS_LIST), (const char*)WSP(bf16, WS_HB), (const char*)(A.ws + WS_EW + 512 * 1024 * 2), 4, F.G, vcu, 512, (size_t)256 * 256 * 2, false};
    EpiScatter E{WSP(bf16, WS_Y16)};
    pg8::gemm_phase_g<EpiScatter, MoeSched, false>(F.lds, 256, 256, 256, S, E);
}
__device__ __forceinline__ void ph_combine(const Frame& F, const Args& A, int l) {
    float* X = WSP(float, WS_XALL); const float* SD = WSP(float, WS_SD); const bf16* YS = WSP(bf16, WS_Y16); const int* EP = WSP(int, WS_EP); const float* TOPW = WSP(float, WS_TOPW);
    const int* CNT = (const int*)(A.ws + WS_CTL) + CW_CNT + l * 256 * CNT_STRIDE; LAS int* pref = (LAS int*)(F.lds + RING_BYTES + 1024);
    moe_prefix(F, CNT, pref);
    for (int R = F.gw; R < MROWS; R += F.NGW) {
        const int b = R / TPB, p = R % TPB, s = (p < CTX) ? 2 : b; const float* g2 = MODP(l, s, 5); f32x4 xv[4];
        if (l == DEPTH - 1 && p < CTX) continue;
        size_t so[8]; float wk[8];
#pragma unroll
        for (int k = 0; k < 8; ++k) { const int ep = EP[(size_t)R * 8 + k], e = ep / LCAP, pos = ep - e * LCAP; so[k] = ((size_t)pref[e] * 256 + pos) * 1024; wk[k] = TOPW[(size_t)R * 8 + k]; }
#pragma unroll
        for (int j = 0; j < 4; ++j) { const int c = 4 * F.lane + 256 * j; f32x4 f = *(const f32x4*)(SD + (size_t)R * 1024 + c);
#pragma unroll
            for (int k = 0; k < 8; ++k) { const unsigned long long y = *(const unsigned long long*)(YS + so[k] + c);
                f += (f32x4){bf2f((unsigned)y & 0xffffu), bf2f(((unsigned)y) >> 16), bf2f((unsigned)(y >> 32) & 0xffffu), bf2f((unsigned)(y >> 48))} * wk[k]; }
            const f32x4 x = *(const f32x4*)(X + (size_t)R * 1024 + c) + *(const f32x4*)(g2 + c) * f;
            *(f32x4*)(X + (size_t)R * 1024 + c) = x; xv[j] = x;
            if (l == DEPTH - 1) *(f32x4*)(A.out + ((size_t)b * SEQ + (p - CTX)) * 1024 + c) = x; }
        if (l + 1 < DEPTH) norm_mod_row(xv, A.in[6] + (l + 1) * 1024, MODP(l + 1, s, 1), MODP(l + 1, s, 0), WSP(bf16, WS_H) + (size_t)R * 1024, F.lane);
    }
}

struct EpiWin {
    static constexpr bool PERM = true; static constexpr int MIDK = 0;
    bf16 *Kb, *Vb, *Qb, *LXb, *GLG, *ZP, *GT; const float* qg; const float* kg;
    __device__ __forceinline__ void operator()(const f32x4 (&acc)[2][2][4][2], const pg8::Unit& u, int wr, int wc, int fr, int fq) const {
        const int pn = u.pn, sec = pn >> 2;
        if (sec == 0 || sec == 3) {
            const bool isq = sec == 3; const bool lat = (u.pm % 33) != 0;
            bf16* dst = (isq ? Qb : Kb) + (pn & 3) * 256 + wc * 64 + 4 * fq; const float* gn = isq ? qg : kg; const float gs = isq ? QSCALE : 1.f;
            f32x4 g[2][2]; float invf[4];
#pragma unroll
            for (int bj = 0; bj < 2; ++bj)
#pragma unroll
                for (int n = 0; n < 2; ++n) g[bj][n] = *(const f32x4*)(gn + 32 * bj + 16 * n + 4 * fq) * gs;
#pragma unroll
            for (int e = 0; e < 4; ++e) invf[e] = exp2f(-(float)(4 * fq + e) * (13.287712379549449f / 16.f)) * 0.15915494309189535f;
#pragma unroll
            for (int ai = 0; ai < 2; ++ai)
#pragma unroll
                for (int m = 0; m < 4; ++m) { const int R = u.pm * 256 + ai * 128 + wr * 64 + m * 16 + fr, t = (R % TPB) - CTX;
                    float ss = 0.f;
#pragma unroll
                    for (int bj = 0; bj < 2; ++bj)
#pragma unroll
                        for (int n = 0; n < 2; ++n) { const f32x4 v = acc[ai][bj][m][n]; ss += (v[0] * v[0] + v[1] * v[1]) + (v[2] * v[2] + v[3] * v[3]); }
                    ss += sx<16>(ss); ss += sx<32>(ss);
                    const float rs = rsqrtf(ss * (1.f / 64.f) + EPS);
#pragma unroll
                    for (int bj = 0; bj < 2; ++bj) { const float pos = (float)(bj ? (t & 63) : (t >> 6));
                        const f32x4 y1 = acc[ai][bj][m][0] * rs * g[bj][0], y2 = acc[ai][bj][m][1] * rs * g[bj][1]; f32x4 o1 = y1, o2 = y2;
                        if (lat) {
#pragma unroll
                            for (int e = 0; e < 4; ++e) { const float rev = pos * invf[e]; const float cs = __builtin_amdgcn_cosf(rev), sn = __builtin_amdgcn_sinf(rev);
                                o1[e] = y1[e] * cs - y2[e] * sn; o2[e] = y1[e] * sn + y2[e] * cs; } }
                        bf16* p = dst + (size_t)R * 1024 + 32 * bj;
                        *(unsigned long long*)p = (unsigned long long)pk2(o1[0], o1[1]) | ((unsigned long long)pk2(o1[2], o1[3]) << 32);
                        *(unsigned long long*)(p + 16) = (unsigned long long)pk2(o2[0], o2[1]) | ((unsigned long long)pk2(o2[2], o2[3]) << 32); }
                    asm volatile("" ::: "memory"); }
        } else {
            bf16* base; int ld = 1024, act = 0;
            if (sec == 1) base = Vb + (pn & 3) * 256; else if (sec == 2) base = LXb + (pn & 3) * 256; else if (sec == 4) { base = GLG + (pn & 3) * 256; act = 1; }
            else if (sec == 5) base = ZP + (pn & 3) * 256; else { base = GT + (pn - 24) * 256; ld = 3072; act = 2; }
            base += wc * 32 + 8 * fq;
#pragma unroll
            for (int ai = 0; ai < 2; ++ai)
#pragma unroll
                for (int m = 0; m < 4; ++m) { bf16* rowp = base + (size_t)(u.pm * 256 + ai * 128 + wr * 64 + m * 16 + fr) * ld;
#pragma unroll
                    for (int bj = 0; bj < 2; ++bj) { f32x4 v0 = acc[ai][bj][m][0], v1 = acc[ai][bj][m][1];
                        if (act == 1) {
#pragma unroll
                            for (int e = 0; e < 4; ++e) { v0[e] = gelu_tanh(v0[e]); v1[e] = gelu_tanh(v1[e]); } }
                        else if (act == 2) {
#pragma unroll
                            for (int e = 0; e < 4; ++e) { v0[e] = sigmoidf_(v0[e]); v1[e] = sigmoidf_(v1[e]); } }
                        v4u o; o.x = pk2(v0[0], v0[1]); o.y = pk2(v0[2], v0[3]); o.z = pk2(v1[0], v1[1]); o.w = pk2(v1[2], v1[3]);
                        *(v4u*)(rowp + bj * 128) = o; } }
        }
    }
};

struct EpiMix {
    static constexpr bool PERM = true; static constexpr int MIDK = 16;
    const bf16* GT; bf16* MD;
    __device__ __forceinline__ void mid(f32x4 (&acc)[2][2][4][2], const pg8::Unit& u, int wr, int wc, int fr, int fq, int seg) const {
        const bf16* gb = GT + (size_t)(u.pm * 256 + wr * 64 + fr) * 3072 + (seg - 1) * 1024 + u.pn * 256 + wc * 32 + 8 * fq;
#pragma unroll
        for (int ai = 0; ai < 2; ++ai)
#pragma unroll
            for (int m = 0; m < 4; ++m)
#pragma unroll
                for (int bj = 0; bj < 2; ++bj) { const bf16* p = gb + (size_t)(ai * 128 + m * 16) * 3072 + bj * 128;
                    const v4u a = *(const v4u*)p, b = *(const v4u*)(p + 1024);
                    const unsigned aw[4] = {a.x, a.y, a.z, a.w}, bw[4] = {b.x, b.y, b.z, b.w};
#pragma unroll
                    for (int q = 0; q < 4; ++q) { const float r0 = bf2f(aw[q] & 0xffffu) * __builtin_amdgcn_rcpf(fmaxf(bf2f(bw[q] & 0xffffu), 1e-30f)), r1 = bf2f(aw[q] >> 16) * __builtin_amdgcn_rcpf(fmaxf(bf2f(bw[q] >> 16), 1e-30f));
                        acc[ai][bj][m][q >> 1][(q & 1) * 2] *= r0; acc[ai][bj][m][q >> 1][(q & 1) * 2 + 1] *= r1; } }
    }
    __device__ __forceinline__ void operator()(const f32x4 (&acc)[2][2][4][2], const pg8::Unit& u, int wr, int wc, int fr, int fq) const {
        const size_t r0 = (size_t)(u.pm * 256 + wr * 64 + fr); const int c0 = u.pn * 256 + wc * 32 + 8 * fq;
#pragma unroll
        for (int ai = 0; ai < 2; ++ai)
#pragma unroll
            for (int m = 0; m < 4; ++m)
#pragma unroll
                for (int bj = 0; bj < 2; ++bj) { const size_t R = r0 + ai * 128 + m * 16; const v4u gv = *(const v4u*)(GT + R * 3072 + 2048 + c0 + bj * 128);
                    const f32x4 v0 = acc[ai][bj][m][0], v1 = acc[ai][bj][m][1]; v4u o;
                    o.x = pk2(v0[0] * bf2f(gv.x & 0xffffu), v0[1] * bf2f(gv.x >> 16)); o.y = pk2(v0[2] * bf2f(gv.y & 0xffffu), v0[3] * bf2f(gv.y >> 16));
                    o.z = pk2(v1[0] * bf2f(gv.z & 0xffffu), v1[1] * bf2f(gv.z >> 16)); o.w = pk2(v1[2] * bf2f(gv.w & 0xffffu), v1[3] * bf2f(gv.w >> 16));
                    *(v4u*)(MD + R * 1024 + c0 + bj * 128) = o; }
    }
};
struct EpiResid {
    static constexpr bool PERM = false; static constexpr int MIDK = 0;
    float* X; const float* mod;
    __device__ __forceinline__ void operator()(const f32x4 (&acc)[2][2][4][2], const pg8::Unit& u, int wr, int wc, int fr, int fq) const {
        const int src = (u.pm % 33 == 0) ? 2 : u.pm / 33; const float* g1 = mod + src * 6144 + 2 * 1024;
        const int col0 = u.pn * 256 + wc * 32 + 4 * fq;
        f32x4 gv[2][2];
#pragma unroll
        for (int bj = 0; bj < 2; ++bj)
#pragma unroll
            for (int n = 0; n < 2; ++n) gv[bj][n] = *(const f32x4*)(g1 + col0 + bj * 128 + n * 16);
#pragma unroll
        for (int ai = 0; ai < 2; ++ai)
#pragma unroll
            for (int m = 0; m < 4; ++m) { float* rowp = X + (size_t)(u.pm * 256 + ai * 128 + wr * 64 + m * 16 + fr) * 1024 + col0;
#pragma unroll
                for (int bj = 0; bj < 2; ++bj)
#pragma unroll
                    for (int n = 0; n < 2; ++n) { f32x4* p = (f32x4*)(rowp + bj * 128 + n * 16); *p = *p + gv[bj][n] * acc[ai][bj][m][n]; } }
    }
};
__device__ __forceinline__ void ph_norm2(const Frame& F, const Args& A, int l) {
    const float* X = WSP(float, WS_XALL); bf16* TOK = WSP(bf16, WS_TOK);
    for (int R = F.gw; R < MROWS; R += F.NGW) {
        const int b = R / TPB, p = R % TPB, s = (p < CTX) ? 2 : b;
        if (l == DEPTH - 1 && p < CTX) continue;
        f32x4 v[4];
#pragma unroll
        for (int j = 0; j < 4; ++j) v[j] = *(const f32x4*)(X + (size_t)R * 1024 + 4 * F.lane + 256 * j);
        norm_mod_row(v, A.in[23] + l * 1024, MODP(l, s, 4), MODP(l, s, 3), TOK + (size_t)R * 1024, F.lane);
    }
}

constexpr int PH_PER_L = 18, N_PHASES = 1 + DEPTH * PH_PER_L;
template <int P> __device__ __forceinline__ void run_phase(const Frame& F, const Args& A, int l) {
    if constexpr (P == -1) ph_prologue(F, A);
    if constexpr (P == 0) ph_norm1(F, A, l);
    if constexpr (P == 1) { pg8::Gemm g{WSP(bf16, WS_H), WLP(l, WO_WIN), MROWS, INW, 1024, 1024, 1024}; pg8::StaticOrder S; S.init(MROWS, INW, F.G, F.bid);
#if FAST_WIN
        EpiWin E{WSP(bf16, WS_KB), WSP(bf16, WS_VB), WSP(bf16, WS_QB), WSP(bf16, WS_LXB), WSP(bf16, WS_GLG), WSP(bf16, WS_ZP), WSP(bf16, WS_GATES), A.in[8] + l * 64, A.in[9] + l * 64};
        pg8::gemm_phase(F.lds, g, S, E); }
#else
        pg8::EpiF32 E{WSP(float, WS_U), INW}; pg8::gemm_phase(F.lds, g, S, E); }
    if constexpr (P == 2) ph_uelem(F, A, l);
#endif
    if constexpr (P == 3) { ph_conv(F, A, l); ph_fft_t1_fast(F, A);
#if FAST_MOE
        ph_expert_w(F, A, l);
#endif
    }
    if constexpr (P == 4) {
#if FAST_LRU
        ph_lru_gemm(F, A, l);
#else
        ph_lrucoef(F, A, l);
#endif
#if FAST_FFT_A
        ph_fft_a_gemm(F, A);
#else
        ph_fft_a(F, A);
#endif
        ph_fft_c(F, A);
    }
    if constexpr (P == 5) {
        ph_scan1(F, A);
#if FAST_FFT_B
        ph_fft_b_gemm(F, A);
#else
        ph_fft_b(F, A);
#endif
    }
    if constexpr (P == 6) { ph_scan2_fast(F, A); ph_fft_t2_fast(F, A); }
    if constexpr (P == 7) { ph_scan3(F, A);
#if FAST_ATTN
        ph_attn(F, A, l);
#endif
    }
    if constexpr (P == 8) {
#if !FAST_ATTN
        ph_attn_naive(F, A, l);
#endif
        __syncthreads(); }
#if FAST_MIX
    if constexpr (P == 9) { pg8::Gemm g{WSP(bf16, WS_MIXIN), WLP(l, WO_D1), MROWS, 1024, 3072, 3072, 3072}; pg8::StaticOrder S; S.init(MROWS, 1024, F.G, F.bid, l == DEPTH - 1);
        EpiMix E{WSP(bf16, WS_GATES), WSP(bf16, WS_MIXED)}; pg8::gemm_phase(F.lds, g, S, E); }
    if constexpr (P == 11) { pg8::Gemm g{WSP(bf16, WS_MIXED), WLP(l, WO_OUT), MROWS, 1024, 1024, 1024, 1024}; pg8::StaticOrder S; S.init(MROWS, 1024, F.G, F.bid, l == DEPTH - 1);
        EpiResid E{WSP(float, WS_XALL), (const float*)(A.ws + WS_CTL) + CW_MOD + l * 3 * 6144}; pg8::gemm_phase(F.lds, g, S, E); }
    if constexpr (P == 12) ph_norm2(F, A, l);
#else
    if constexpr (P == 9) {
        { pg8::Gemm g{WSP(bf16, WS_MIXIN), WLP(l, WO_D1), MROWS, 1024, 1024, 3072, 3072}; pg8::StaticOrder S; S.init(MROWS, 1024, F.G, F.bid); pg8::EpiF32 E{WSP(float, WS_PA), 1024}; pg8::gemm_phase(F.lds, g, S, E); }
        { pg8::Gemm g{WSP(bf16, WS_MIXIN) + 1024, WLP(l, WO_D1) + 1024, MROWS, 1024, 1024, 3072, 3072}; pg8::StaticOrder S; S.init(MROWS, 1024, F.G, F.bid); pg8::EpiF32 E{WSP(float, WS_PR), 1024}; pg8::gemm_phase(F.lds, g, S, E); }
        { pg8::Gemm g{WSP(bf16, WS_MIXIN) + 2048, WLP(l, WO_D1) + 2048, MROWS, 1024, 1024, 3072, 3072}; pg8::StaticOrder S; S.init(MROWS, 1024, F.G, F.bid); pg8::EpiF32 E{WSP(float, WS_PF), 1024}; pg8::gemm_phase(F.lds, g, S, E); } }
    if constexpr (P == 10) ph_mix(F, A);
    if constexpr (P == 11) { pg8::Gemm g{WSP(bf16, WS_MIXED), WLP(l, WO_OUT), MROWS, 1024, 1024, 1024, 1024}; pg8::StaticOrder S; S.init(MROWS, 1024, F.G, F.bid);
        pg8::EpiF32 E{WSP(float, WS_Y1), 1024}; pg8::gemm_phase(F.lds, g, S, E); }
    if constexpr (P == 12) ph_resid_norm2(F, A, l);
#endif
    if constexpr (P == 13) {
        { pg8::Gemm g{WSP(bf16, WS_TOK), WLP(l, WO_R), MROWS, 256, 1024, 1024, 1024}; pg8::StaticOrder S; S.init(MROWS, 256, F.G, F.bid, l == DEPTH - 1); pg8::EpiF32 E{WSP(float, WS_LOG), 256}; pg8::gemm_phase(F.lds, g, S, E); }
        { pg8::Gemm g{WSP(bf16, WS_TOK), WLP(l, WO_SGU), MROWS, 512, 1024, 1024, 1024}; pg8::StaticOrder S; S.init(MROWS, 512, F.G, F.bid, l == DEPTH - 1); pg8::EpiF32 E{WSP(float, WS_SGU), 512}; pg8::gemm_phase(F.lds, g, S, E); } }
    if constexpr (P == 14) ph_topk(F, A, l);
    if constexpr (P == 15) {
#if FAST_MOE
        ph_experts_up(F, A, l);
#else
        ph_experts_naive(F, A, l); __syncthreads();
#endif

        { pg8::Gemm g{WSP(bf16, WS_SH), WLP(l, WO_SD), MROWS, 1024, 256, 256, 256}; pg8::StaticOrder S; S.init(MROWS, 1024, F.G, F.bid, l == DEPTH - 1); pg8::EpiF32 E{WSP(float, WS_SD), 1024}; pg8::gemm_phase(F.lds, g, S, E); } }
    if constexpr (P == 16) {
#if FAST_MOE
        ph_experts_down(F, A, l);
#endif
    }
    if constexpr (P == 17) ph_combine(F, A, l);
}
__device__ __forceinline__ Frame make_frame(unsigned char* lds) {
    Frame F; F.lds = (LAS unsigned char*)lds; F.tid = otid(); F.lane = F.tid & 63; F.wave = __builtin_amdgcn_readfirstlane(F.tid >> 6);
    F.bid = obid(); F.G = ogrid(); F.gw = F.bid * NWAVES + F.wave; F.NGW = F.G * NWAVES; F.gtid = (long)F.bid * 512 + F.tid; F.NT = (long)F.G * 512;
    return F;
}
template <int P> __global__ void __launch_bounds__(NWAVES * 64, 2) mk_phase(Args A) {
    extern __shared__ __attribute__((aligned(16))) unsigned char lds[];
    const Frame F = make_frame(lds);
    run_phase<P>(F, A, A.ph_lo);
}
#if N_LAUNCH_MODE == 1
__device__ __forceinline__ const float* lds_ptr(const LAS unsigned long long* tab, int i) {
    const unsigned long long v = tab[i];
    const unsigned lo = __builtin_amdgcn_readfirstlane((unsigned)v), hi = __builtin_amdgcn_readfirstlane((unsigned)(v >> 32));
    return (const float*)(((unsigned long long)hi << 32) | lo);
}
__device__ __forceinline__ void load_args(Args& L, const LAS unsigned long long* tab) {
#pragma unroll
    for (int i = 0; i < 32; ++i) L.in[i] = lds_ptr(tab, i);
    L.out = (float*)lds_ptr(tab, 32); L.ws = (unsigned char*)lds_ptr(tab, 33); L.ph_lo = 0; L.ph_hi = 0;
}
__global__ void __launch_bounds__(NWAVES * 64, 2) mk_fwd(Args A) {
    extern __shared__ __attribute__((aligned(16))) unsigned char lds[];
    LAS unsigned char* L3 = (LAS unsigned char*)lds;
    volatile LAS unsigned* MISC = (volatile LAS unsigned*)(L3 + MISC_OFF);
    for (int u = threadIdx.x; u < (LDS_BYTES - RING_BYTES) / 4; u += NWAVES * 64) ((LAS unsigned*)(L3 + RING_BYTES))[u] = 0u;
    __syncthreads();
    LAS unsigned long long* tab = (LAS unsigned long long*)(L3 + RING_BYTES + 4096);
    if (threadIdx.x == 0) {
#define ST(i) tab[i] = (unsigned long long)A.in[i];
        ST(0) ST(1) ST(2) ST(3) ST(4) ST(5) ST(6) ST(7) ST(8) ST(9) ST(10) ST(11) ST(12) ST(13) ST(14) ST(15) ST(16) ST(17) ST(18) ST(19) ST(20) ST(21) ST(22) ST(23) ST(24) ST(25) ST(26) ST(27) ST(28) ST(29) ST(30) ST(31)
#undef ST
        tab[32] = (unsigned long long)A.out; tab[33] = (unsigned long long)A.ws;
    }
    __syncthreads();
    (void)xcd_barrier_post((unsigned*)(A.ws + WS_CTL) + CW_BAR, MISC + 8);
#define RUN(P) do { asm volatile("; PHASE_MARK " #P); { unsigned tb_ = RING_BYTES + 4096; asm volatile("" : "+v"(tb_)); Args L; load_args(L, (const LAS unsigned long long*)(L3 + tb_)); \
        const Frame F = make_frame(lds); run_phase<P>(F, L, l); \
        if constexpr (P >= 0 && ((REP_MASK >> (P < 0 ? 0 : P)) & 1)) { for (int rp_ = 0; rp_ < REP_N; ++rp_) { asm volatile("s_waitcnt vmcnt(0)" ::: "memory"); __syncthreads(); run_phase<P>(F, L, l); } } \
        XcdBarrier bar; bar.bar = (unsigned*)(L.ws + WS_CTL) + CW_BAR; bar.x = xb_xcc_id(); { unsigned mo_ = MISC_OFF + 32; asm volatile("" : "+v"(mo_)); bar.st = (volatile LAS unsigned*)(L3 + mo_); } \
        xcd_barrier(bar); } } while (0)
    { const int l = 0; RUN(-1);
#if REP_PRO
      for (int rp_ = 0; rp_ < 2; ++rp_) { RUN(-1); }
#endif
    }
    for (int l = 0; l < DEPTH; ++l) {
        if (l == 0) RUN(0);
        RUN(1); RUN(3); RUN(4); RUN(5); RUN(6); RUN(7); RUN(9); RUN(11); RUN(12); RUN(13); RUN(14); RUN(15); RUN(16); RUN(17);
    }
#undef RUN
}
#endif

extern "C" void kernel_launch(void* const* d_in, const int* in_sizes, int n_in, void* d_out, int out_size, void* d_ws, size_t ws_size, hipStream_t stream) {
    static int grid = 0;
    if (grid == 0) {
        if (n_in != 32 || out_size != NB * SEQ * DM || ws_size < WS_END) { fprintf(stderr, "kernel_launch: unexpected shapes (n_in %d, out %d, ws %zu < %zu)\n", n_in, out_size, ws_size, (size_t)WS_END); grid = -1; return; }
        int dev = 0, cus = 0;
        if (hipGetDevice(&dev) != hipSuccess || hipDeviceGetAttribute(&cus, hipDeviceAttributeMultiprocessorCount, dev) != hipSuccess) { grid = -1; return; }
#define SETA(K) if (hipFuncSetAttribute((const void*)K, hipFuncAttributeMaxDynamicSharedMemorySize, LDS_BYTES) != hipSuccess) { fprintf(stderr, "kernel_launch: hipFuncSetAttribute failed\n"); grid = -1; return; }
#if N_LAUNCH_MODE == 1
        SETA(mk_fwd)
#else
        SETA(mk_phase<-1>) SETA(mk_phase<0>) SETA(mk_phase<1>) SETA(mk_phase<2>) SETA(mk_phase<3>) SETA(mk_phase<4>) SETA(mk_phase<5>) SETA(mk_phase<6>) SETA(mk_phase<7>) SETA(mk_phase<8>)
        SETA(mk_phase<9>) SETA(mk_phase<10>) SETA(mk_phase<11>) SETA(mk_phase<12>) SETA(mk_phase<13>) SETA(mk_phase<14>) SETA(mk_phase<15>) SETA(mk_phase<16>) SETA(mk_phase<17>)
#endif
#undef SETA
        int per_cu = 0;
        (void)per_cu;
        grid = cus;
    }
    if (grid < 0) return;
    (void)hipMemsetAsync((char*)d_ws + WS_CTL, 0, CTL_ZERO_BYTES, stream);
    Args a{};
    for (int i = 0; i < 32; ++i) a.in[i] = (const float*)d_in[i];
    a.out = (float*)d_out; a.ws = (unsigned char*)d_ws;
#if N_LAUNCH_MODE == 1
    a.ph_lo = 0; a.ph_hi = N_PHASES;
    hipLaunchKernelGGL(mk_fwd, dim3(grid), dim3(NWAVES * 64), LDS_BYTES, stream, a);
#else
#define LAUNCH_P(P) hipLaunchKernelGGL(mk_phase<P>, dim3(grid), dim3(NWAVES * 64), LDS_BYTES, stream, a)
    a.ph_lo = 0; a.ph_hi = 0; LAUNCH_P(-1);
    for (int l = 0; l < DEPTH; ++l) { a.ph_lo = l;
        LAUNCH_P(0); LAUNCH_P(1); LAUNCH_P(2); LAUNCH_P(3); LAUNCH_P(4); LAUNCH_P(5); LAUNCH_P(6); LAUNCH_P(7); LAUNCH_P(8); LAUNCH_P(9); LAUNCH_P(10); LAUNCH_P(11); LAUNCH_P(12); LAUNCH_P(13); LAUNCH_P(14); LAUNCH_P(15); LAUNCH_P(16); LAUNCH_P(17); }
#undef LAUNCH_P
#endif
    const hipError_t le = hipPeekAtLastError();
    if (le != hipSuccess) fprintf(stderr, "kernel_launch: launch failed: %s\n", hipGetErrorName(le));
}
```

```cpp
#include <hip/hip_runtime.h>
#include <cstdio>
#include <cstdint>

#ifndef ATTN_V2
#define ATTN_V2 8
#endif
#ifndef REP_PRO
#define REP_PRO 0
#endif
#ifndef REP_MASK
#define REP_MASK 0
#endif
#ifndef REP_N
#define REP_N 2
#endif
#ifndef FAST_MIX
#define FAST_MIX 1
#endif
#ifndef FAST_WIN
#define FAST_WIN 1
#endif
#ifndef FAST_LRU
#define FAST_LRU 1
#endif
#define FAST_FFT 0
#ifndef FAST_FFT_A
#define FAST_FFT_A 1
#endif
#ifndef FAST_FFT_B
#define FAST_FFT_B 1
#endif
#ifndef FAST_MOE
#define FAST_MOE 1
#endif
#ifndef FAST_ATTN
#define FAST_ATTN 1
#endif
#ifndef N_LAUNCH_MODE
#define N_LAUNCH_MODE 1
#endif

__device__ __forceinline__ int otid() { int t = threadIdx.x; asm volatile("" : "+v"(t)); return t; }
__device__ __forceinline__ int obid() { int b = blockIdx.x; asm volatile("" : "+s"(b)); return b; }
__device__ __forceinline__ int ogrid() { int g = gridDim.x; asm volatile("" : "+s"(g)); return g; }
template <int M> __device__ __forceinline__ float sx(float v) {
    static_assert(M == 1 || M == 2 || M == 4 || M == 8 || M == 16 || M == 32, "xor mask");
    if constexpr (M < 32) return __uint_as_float((unsigned)__builtin_amdgcn_ds_swizzle((int)__float_as_uint(v), (M << 10) | 0x1f));
    else { auto rr = __builtin_amdgcn_permlane32_swap(__float_as_uint(v), __float_as_uint(v), false, false); const unsigned a = rr[0], b = rr[1]; return __uint_as_float(a == __float_as_uint(v) ? b : a); }
}
template <int M> __device__ __forceinline__ int sxi(int v) { return (int)__float_as_uint(sx<M>(__uint_as_float((unsigned)v))); }
namespace pg8 {
#define PG8_LAS __attribute__((address_space(3)))
typedef unsigned short bf16_t;
typedef short bf16x8 __attribute__((ext_vector_type(8)));
typedef float f32x4 __attribute__((ext_vector_type(4)));
typedef unsigned u32x4 __attribute__((ext_vector_type(4)));
constexpr int BM = 256, BK = 64, HALF = 128, HTB = HALF * BK * 2, STAGE_BYTES = 8 * HTB, NXCD = 8, WGM = 8;
__host__ __device__ __forceinline__ int lds_byte(int r, int c) { const int st = (r >> 4) * 2 + (c >> 5), rr = r & 15, cc = c & 31, ob = rr * 64 + cc * 2; return st * 1024 + (ob ^ (((ob >> 9) & 1) << 5)); }
__host__ __device__ __forceinline__ void stage_rc(int b, int& R, int& C) { const int st = b / 1024, sb = b % 1024, swz = sb ^ (((sb >> 9) & 1) << 5); R = (st >> 1) * 16 + swz / 64; C = (st & 1) * 32 + (swz % 64) / 2; }
__host__ __device__ __forceinline__ int perm32(int rho) { const int n = rho >> 4, i = rho & 15; return 8 * (i >> 2) + 4 * n + (i & 3); }
struct Unit { int pm, pn; };
struct Gemm { const bf16_t* A; const bf16_t* Bt; int M, N, K, lda, ldb; };
struct StaticOrder {
    int nM, nN, nwg, G, c; bool skipctx;
    __host__ __device__ void init(int M, int N, int G_, int c_, bool skip = false) { nM = skip ? 64 : M / BM; nN = N / BM; nwg = nM * nN; G = G_; c = c_; skipctx = skip; }
    __host__ __device__ bool next(int i, Unit& u) const {
        const long L = (long)i * G + c; if (L >= nwg) return false;
        int wgid = (int)L; { const int q = nwg / NXCD, r = nwg % NXCD, xcd = wgid % NXCD, off = wgid / NXCD; wgid = (xcd < r ? xcd * (q + 1) : r * (q + 1) + (xcd - r) * q) + off; }
        const int nig = WGM * nN, gid = wgid / nig, fm = gid * WGM, gsz = (nM - fm) < WGM ? (nM - fm) : WGM;
        u.pm = fm + ((wgid % nig) % gsz); u.pn = (wgid % nig) / gsz;
        if (skipctx) u.pm += 1 + (u.pm >= 32 ? 1 : 0);
        return true;
    }
};
__device__ __forceinline__ unsigned cvt_pk_bf16(float lo, float hi) { unsigned r; asm volatile("v_cvt_pk_bf16_f32 %0, %1, %2" : "=v"(r) : "v"(lo), "v"(hi)); return r; }

struct EpiF32 {
    static constexpr bool PERM = false; static constexpr int MIDK = 0;
    float* C; int ldc;
    __device__ __forceinline__ void operator()(const f32x4 (&acc)[2][2][4][2], const Unit& u, int wr, int wc, int fr, int fq) const {
        const int row0 = u.pm * BM + wr * 64 + fr, col0 = u.pn * BM + wc * 32 + 4 * fq;
#pragma unroll
        for (int ai = 0; ai < 2; ++ai)
#pragma unroll
            for (int m = 0; m < 4; ++m) { float* rowp = C + (size_t)(row0 + ai * HALF + m * 16) * ldc + col0;
#pragma unroll
                for (int bj = 0; bj < 2; ++bj)
#pragma unroll
                    for (int n = 0; n < 2; ++n) *(f32x4*)(rowp + bj * HALF + n * 16) = acc[ai][bj][m][n]; }
    }
};

template <class Epi>
__device__ __forceinline__ void gemm_phase(PG8_LAS unsigned char* lds, const Gemm g, const StaticOrder& S, const Epi& E) {
    const int tid = otid(), wid = __builtin_amdgcn_readfirstlane(tid >> 6), lane = tid & 63, wr = wid >> 2, wc = wid & 3, fr = lane & 15, fq = lane >> 4;
    const int K = g.K, nt = K / BK;
    unsigned voffA[2], voffB[2];
#pragma unroll
    for (int i = 0; i < 2; ++i) { int R, C; stage_rc(tid * 16 + i * 8192, R, C); const int Rb = Epi::PERM ? ((R & ~31) + perm32(R & 31)) : R;
        voffA[i] = (unsigned)(R * g.lda + C) * 2u; voffB[i] = (unsigned)(Rb * g.ldb + C) * 2u; }
    const size_t kstep = (size_t)(BK * 2);
    const size_t hA = (size_t)HALF * g.lda * 2, hB = (size_t)HALF * g.ldb * 2;
    const size_t tA = 2 * hA, tB = 2 * hB;
    const unsigned ldsw = (unsigned)wid * 1024u;
    const int aoff = lds_byte(wr * 64 + fr, fq * 8), boff = lds_byte(wc * 32 + fr, fq * 8);
#define PG8_SA(b, h) (((b) * 2 + (h)) * HTB)
#define PG8_SB(b, h) ((4 + (b) * 2 + (h)) * HTB)
#define PG8_STAGE(bufoff, gbase, voff) do { _Pragma("unroll") for (int _i = 0; _i < 2; ++_i) \
        __builtin_amdgcn_global_load_lds((const unsigned*)((const char*)(gbase) + (voff)[_i]), (PG8_LAS unsigned*)(lds + (bufoff) + ldsw + _i * 8192), 16, 0, 0); } while (0)
#define PG8_LDA(dst, b, h) do { _Pragma("unroll") for (int m = 0; m < 4; ++m) _Pragma("unroll") for (int k = 0; k < 2; ++k) dst[m][k] = *(const PG8_LAS bf16x8*)(lds + PG8_SA(b, h) + aoff + m * 2048 + k * 1024); } while (0)
#define PG8_LDB(dst, b, h) do { _Pragma("unroll") for (int n = 0; n < 2; ++n) _Pragma("unroll") for (int k = 0; k < 2; ++k) dst[n][k] = *(const PG8_LAS bf16x8*)(lds + PG8_SB(b, h) + boff + n * 2048 + k * 1024); } while (0)
#define PG8_MMA(ai, bj, At, Bt) do { __builtin_amdgcn_s_setprio(1); _Pragma("unroll") for (int m = 0; m < 4; ++m) _Pragma("unroll") for (int n = 0; n < 2; ++n) _Pragma("unroll") for (int k = 0; k < 2; ++k) \
        acc[ai][bj][m][n] = __builtin_amdgcn_mfma_f32_16x16x32_bf16(Bt[n][k], At[m][k], acc[ai][bj][m][n], 0, 0, 0); __builtin_amdgcn_s_setprio(0); } while (0)
#define PG8_WAIT_V(n) asm volatile("s_waitcnt vmcnt(" #n ")" ::: "memory")
#define PG8_WAIT_L(n) asm volatile("s_waitcnt lgkmcnt(" #n ")" ::: "memory")
#define PG8_BAR __builtin_amdgcn_s_barrier()
#define PG8_SCHED __builtin_amdgcn_sched_barrier(0)
    Unit cur, nxt; int ui = 0;
    if (!S.next(0, cur)) return;
    f32x4 acc[2][2][4][2];
#pragma unroll
    for (int a = 0; a < 2; ++a)
#pragma unroll
        for (int b = 0; b < 2; ++b)
#pragma unroll
            for (int m = 0; m < 4; ++m)
#pragma unroll
                for (int n = 0; n < 2; ++n) acc[a][b][m][n] = (f32x4){0.f, 0.f, 0.f, 0.f};
    bf16x8 At[4][2], B0[2][2], B1[2][2];
    const char* cA = (const char*)g.A + (size_t)cur.pm * tA; const char* cB = (const char*)g.Bt + (size_t)cur.pn * tB;
    PG8_STAGE(PG8_SB(0, 0), cB, voffB); PG8_STAGE(PG8_SB(0, 1), cB + hB, voffB); PG8_STAGE(PG8_SA(0, 0), cA, voffA); PG8_STAGE(PG8_SA(0, 1), cA + hA, voffA);
    if (wr == 1) PG8_BAR;
    PG8_WAIT_V(2); PG8_BAR;
    PG8_STAGE(PG8_SB(1, 0), cB + kstep, voffB); PG8_STAGE(PG8_SA(1, 0), cA + kstep, voffA); PG8_STAGE(PG8_SB(1, 1), cB + hB + kstep, voffB);
    PG8_WAIT_V(6); PG8_BAR;
    for (;;) {
        const bool has_next = S.next(ui + 1, nxt);
        const char* nA = has_next ? (const char*)g.A + (size_t)nxt.pm * tA : cA; const char* nB = has_next ? (const char*)g.Bt + (size_t)nxt.pn * tB : cB;
#pragma unroll 1
        for (int t = 0; t < nt; t += 2) {
            if constexpr (Epi::MIDK > 0) { if (t > 0 && (t % Epi::MIDK) == 0) E.mid(acc, cur, wr, wc, fr, fq, t / Epi::MIDK); }
            const bool last = (t == nt - 2);
            const char* a1 = cA + (size_t)(t + 1) * kstep;
            const char* a2 = last ? nA : cA + (size_t)(t + 2) * kstep; const char* b2 = last ? nB : cB + (size_t)(t + 2) * kstep;
            const char* a3 = a2 + kstep; const char* b3 = b2 + kstep;
            PG8_LDB(B0, 0, 0); PG8_LDB(B1, 0, 1); PG8_SCHED; PG8_LDA(At, 0, 0); PG8_STAGE(PG8_SA(1, 1), a1 + hA, voffA);
            PG8_WAIT_V(8); PG8_WAIT_L(0); PG8_BAR; PG8_MMA(0, 0, At, B0); PG8_MMA(0, 1, At, B1); PG8_BAR; PG8_SCHED;
            PG8_LDA(At, 0, 1); PG8_STAGE(PG8_SB(0, 0), b2, voffB); PG8_STAGE(PG8_SB(0, 1), b2 + hB, voffB); PG8_STAGE(PG8_SA(0, 0), a2, voffA);
            PG8_WAIT_V(8); PG8_WAIT_L(0); PG8_BAR; PG8_MMA(1, 0, At, B0); PG8_MMA(1, 1, At, B1); PG8_BAR; PG8_SCHED;
            PG8_LDB(B0, 1, 0); PG8_LDB(B1, 1, 1); PG8_SCHED; PG8_LDA(At, 1, 0); PG8_STAGE(PG8_SA(0, 1), a2 + hA, voffA);
            PG8_WAIT_V(8); PG8_WAIT_L(0); PG8_BAR; PG8_MMA(0, 0, At, B0); PG8_MMA(0, 1, At, B1); PG8_BAR; PG8_SCHED;
            PG8_LDA(At, 1, 1); PG8_STAGE(PG8_SB(1, 0), b3, voffB); PG8_STAGE(PG8_SB(1, 1), b3 + hB, voffB); PG8_STAGE(PG8_SA(1, 0), a3, voffA);
            PG8_WAIT_V(8); PG8_WAIT_L(0); PG8_BAR; PG8_MMA(1, 0, At, B0); PG8_MMA(1, 1, At, B1); PG8_BAR; PG8_SCHED;
        }
        if (wr == 0) PG8_BAR;
        E(acc, cur, wr, wc, fr, fq);
        if (!has_next) break;
#pragma unroll
        for (int a = 0; a < 2; ++a)
#pragma unroll
            for (int b = 0; b < 2; ++b)
#pragma unroll
                for (int m = 0; m < 4; ++m)
#pragma unroll
                    for (int n = 0; n < 2; ++n) acc[a][b][m][n] = (f32x4){0.f, 0.f, 0.f, 0.f};
        cur = nxt; cA = nA; cB = nB; ++ui;
        if (wr == 1) PG8_BAR;
    }
    PG8_WAIT_V(0);
    PG8_BAR;
#undef PG8_SA
#undef PG8_SB
#undef PG8_STAGE
#undef PG8_LDA
#undef PG8_LDB
#undef PG8_MMA
#undef PG8_WAIT_V
#undef PG8_WAIT_L
#undef PG8_BAR
#undef PG8_SCHED
}

struct UnitG { const char* a; const char* b; int row0, pn, e, valid; const int* rows; const PG8_LAS int* lrows; };
template <class Epi, class Sched, bool GATHER>
__device__ __forceinline__ void gemm_phase_g(PG8_LAS unsigned char* lds, const int K, const int lda, const int ldb, const Sched& S, const Epi& E) {
    const int tid = otid(), wid = __builtin_amdgcn_readfirstlane(tid >> 6), lane = tid & 63, wr = wid >> 2, wc = wid & 3, fr = lane & 15, fq = lane >> 4;
    const int nt = K / BK;
    int RA[2], CA[2]; unsigned voffB[2];
#pragma unroll
    for (int i = 0; i < 2; ++i) { int R, C; stage_rc(tid * 16 + i * 8192, R, C); const int Rb = Epi::PERM ? ((R & ~31) + perm32(R & 31)) : R;
        RA[i] = R; CA[i] = C; voffB[i] = (unsigned)(Rb * ldb + C) * 2u; }
    const size_t kstep = (size_t)(BK * 2);
    const size_t hB = (size_t)HALF * ldb * 2;
    const unsigned ldsw = (unsigned)wid * 1024u;
    const int aoff = lds_byte(wr * 64 + fr, fq * 8), boff = lds_byte(wc * 32 + fr, fq * 8);
#define PG8_SA(b, h) (((b) * 2 + (h)) * HTB)
#define PG8_SB(b, h) ((4 + (b) * 2 + (h)) * HTB)
#define PG8_STAGE(bufoff, gbase, voff) do { _Pragma("unroll") for (int _i = 0; _i < 2; ++_i) \
        __builtin_amdgcn_global_load_lds((const unsigned*)((const char*)(gbase) + (voff)[_i]), (PG8_LAS unsigned*)(lds + (bufoff) + ldsw + _i * 8192), 16, 0, 0); } while (0)
#define PG8_LDA(dst, b, h) do { _Pragma("unroll") for (int m = 0; m < 4; ++m) _Pragma("unroll") for (int k = 0; k < 2; ++k) dst[m][k] = *(const PG8_LAS bf16x8*)(lds + PG8_SA(b, h) + aoff + m * 2048 + k * 1024); } while (0)
#define PG8_LDB(dst, b, h) do { _Pragma("unroll") for (int n = 0; n < 2; ++n) _Pragma("unroll") for (int k = 0; k < 2; ++k) dst[n][k] = *(const PG8_LAS bf16x8*)(lds + PG8_SB(b, h) + boff + n * 2048 + k * 1024); } while (0)
#define PG8_MMA(ai, bj, At, Bt) do { __builtin_amdgcn_s_setprio(1); _Pragma("unroll") for (int m = 0; m < 4; ++m) _Pragma("unroll") for (int n = 0; n < 2; ++n) _Pragma("unroll") for (int k = 0; k < 2; ++k) \
        acc[ai][bj][m][n] = __builtin_amdgcn_mfma_f32_16x16x32_bf16(Bt[n][k], At[m][k], acc[ai][bj][m][n], 0, 0, 0); __builtin_amdgcn_s_setprio(0); } while (0)
#define PG8_WAIT_V(n) asm volatile("s_waitcnt vmcnt(" #n ")" ::: "memory")
#define PG8_WAIT_L(n) asm volatile("s_waitcnt lgkmcnt(" #n ")" ::: "memory")
#define PG8_BAR __builtin_amdgcn_s_barrier()
#define PG8_SCHED __builtin_amdgcn_sched_barrier(0)
#define PG8_MKOFF(u, v) do { _Pragma("unroll") for (int _h = 0; _h < 2; ++_h) _Pragma("unroll") for (int _i = 0; _i < 2; ++_i) { const int _row = _h * HALF + RA[_i]; \
        if (GATHER) { const int _pr = (u).lrows[_row]; v[_h][_i] = (unsigned)(_pr >> 3) * (unsigned)(lda * 2) + (unsigned)(CA[_i] * 2); } \
        else v[_h][_i] = (unsigned)(_row * lda + CA[_i]) * 2u; } } while (0)
    UnitG cur, nxt; int ui = 0;
    if (!S.next(0, cur)) return;
    f32x4 acc[2][2][4][2];
#pragma unroll
    for (int a = 0; a < 2; ++a)
#pragma unroll
        for (int b = 0; b < 2; ++b)
#pragma unroll
            for (int m = 0; m < 4; ++m)
#pragma unroll
                for (int n = 0; n < 2; ++n) acc[a][b][m][n] = (f32x4){0.f, 0.f, 0.f, 0.f};
    bf16x8 At[4][2], B0[2][2], B1[2][2];
    unsigned vA[2][2], vN[2][2];
    PG8_MKOFF(cur, vA);
    const char* cA = cur.a; const char* cB = cur.b;
    PG8_STAGE(PG8_SB(0, 0), cB, voffB); PG8_STAGE(PG8_SB(0, 1), cB + hB, voffB); PG8_STAGE(PG8_SA(0, 0), cA, vA[0]); PG8_STAGE(PG8_SA(0, 1), cA, vA[1]);
    if (wr == 1) PG8_BAR;
    PG8_WAIT_V(2); PG8_BAR;
    PG8_STAGE(PG8_SB(1, 0), cB + kstep, voffB); PG8_STAGE(PG8_SA(1, 0), cA + kstep, vA[0]); PG8_STAGE(PG8_SB(1, 1), cB + hB + kstep, voffB);
    PG8_WAIT_V(6); PG8_BAR;
    for (;;) {
        const bool has_next = S.next(ui + 1, nxt);
        if constexpr (GATHER) { if (has_next) { PG8_MKOFF(nxt, vN); } else { vN[0][0] = vA[0][0]; vN[0][1] = vA[0][1]; vN[1][0] = vA[1][0]; vN[1][1] = vA[1][1]; } }
        const char* nA = has_next ? nxt.a : cA; const char* nB = has_next ? nxt.b : cB;
#pragma unroll 1
        for (int t = 0; t < nt; t += 2) {
            const bool last = (t == nt - 2);
            const char* a1 = cA + (size_t)(t + 1) * kstep;
            const char* a2 = last ? nA : cA + (size_t)(t + 2) * kstep; const char* b2 = last ? nB : cB + (size_t)(t + 2) * kstep;
            const char* a3 = a2 + kstep; const char* b3 = b2 + kstep;
            unsigned s0[2], s1[2];
            if constexpr (GATHER) { s0[0] = last ? vN[0][0] : vA[0][0]; s0[1] = last ? vN[0][1] : vA[0][1]; s1[0] = last ? vN[1][0] : vA[1][0]; s1[1] = last ? vN[1][1] : vA[1][1]; }
            else { s0[0] = vA[0][0]; s0[1] = vA[0][1]; s1[0] = vA[1][0]; s1[1] = vA[1][1]; }
            PG8_LDB(B0, 0, 0); PG8_LDB(B1, 0, 1); PG8_SCHED; PG8_LDA(At, 0, 0); PG8_STAGE(PG8_SA(1, 1), a1, vA[1]);
            PG8_WAIT_V(8); PG8_WAIT_L(0); PG8_BAR; PG8_MMA(0, 0, At, B0); PG8_MMA(0, 1, At, B1); PG8_BAR; PG8_SCHED;
            PG8_LDA(At, 0, 1); PG8_STAGE(PG8_SB(0, 0), b2, voffB); PG8_STAGE(PG8_SB(0, 1), b2 + hB, voffB); PG8_STAGE(PG8_SA(0, 0), a2, s0);
            PG8_WAIT_V(8); PG8_WAIT_L(0); PG8_BAR; PG8_MMA(1, 0, At, B0); PG8_MMA(1, 1, At, B1); PG8_BAR; PG8_SCHED;
            PG8_LDB(B0, 1, 0); PG8_LDB(B1, 1, 1); PG8_SCHED; PG8_LDA(At, 1, 0); PG8_STAGE(PG8_SA(0, 1), a2, s1);
            PG8_WAIT_V(8); PG8_WAIT_L(0); PG8_BAR; PG8_MMA(0, 0, At, B0); PG8_MMA(0, 1, At, B1); PG8_BAR; PG8_SCHED;
            PG8_LDA(At, 1, 1); PG8_STAGE(PG8_SB(1, 0), b3, voffB); PG8_STAGE(PG8_SB(1, 1), b3 + hB, voffB); PG8_STAGE(PG8_SA(1, 0), a3, s0);
            PG8_WAIT_V(8); PG8_WAIT_L(0); PG8_BAR; PG8_MMA(1, 0, At, B0); PG8_MMA(1, 1, At, B1); PG8_BAR; PG8_SCHED;
        }
        if (wr == 0) PG8_BAR;
        E(acc, cur, wr, wc, fr, fq);
        if (!has_next) break;
#pragma unroll
        for (int a = 0; a < 2; ++a)
#pragma unroll
            for (int b = 0; b < 2; ++b)
#pragma unroll
                for (int m = 0; m < 4; ++m)
#pragma unroll
                    for (int n = 0; n < 2; ++n) acc[a][b][m][n] = (f32x4){0.f, 0.f, 0.f, 0.f};
        cur = nxt; cA = nA; cB = nB; ++ui;
        if constexpr (GATHER) { vA[0][0] = vN[0][0]; vA[0][1] = vN[0][1]; vA[1][0] = vN[1][0]; vA[1][1] = vN[1][1]; }
        if (wr == 1) PG8_BAR;
    }
    PG8_WAIT_V(0);
    PG8_BAR;
#undef PG8_SA
#undef PG8_SB
#undef PG8_STAGE
#undef PG8_LDA
#undef PG8_LDB
#undef PG8_MMA
#undef PG8_WAIT_V
#undef PG8_WAIT_L
#undef PG8_BAR
#undef PG8_SCHED
#undef PG8_MKOFF
}
}

constexpr int DM = 1024, NB = 2, SEQ = 8192, CTX = 256, TPB = SEQ + CTX, MROWS = NB * TPB, DEPTH = 2;
constexpr int INW = 9216, COL_K = 0, COL_V = 1024, COL_LX = 2048, COL_Q = 3072, COL_LG = 4096, COL_F = 5120, COL_G = 6144;
constexpr int NE = 256, TOPK = 8, EFF = 256, NPAIR = MROWS * TOPK, LCAP = MROWS;
constexpr float EPS = 1e-6f;
constexpr float QSCALE = 0.125f * 1.4426950408889634f;
constexpr int NCHUNK = TPB / 64;
static_assert(MROWS % 256 == 0, "rows");

constexpr size_t MiB = 1u << 20;
constexpr size_t WS_CTL = 0, CTL_ZERO_BYTES = 1 * MiB;
constexpr size_t WS_W = 1 * MiB, WL_STRIDE = 32 * MiB;
constexpr size_t WO_TAB = 31 * MiB;
constexpr size_t WO_WIN = 0, WO_D1 = 18 * MiB, WO_OUT = 24 * MiB, WO_R = 26 * MiB, WO_SGU = 27 * MiB, WO_SD = 28 * MiB, WO_LRU = 29 * MiB;
constexpr size_t WS_XALL = 65 * MiB;
constexpr size_t WS_H = WS_XALL + 66 * MiB;
constexpr size_t WS_U = WS_H + 33 * MiB;
constexpr size_t WS_KB = WS_U + 594 * MiB, WS_VB = WS_KB + 33 * MiB, WS_QB = WS_VB + 33 * MiB, WS_LXB = WS_QB + 33 * MiB, WS_GLG = WS_LXB + 33 * MiB, WS_ZP = WS_GLG + 33 * MiB;
constexpr size_t WS_GATES = WS_ZP + 33 * MiB;
constexpr size_t WS_MIXIN = WS_GATES + 99 * MiB;
constexpr size_t WS_S = WS_MIXIN + 99 * MiB;
constexpr size_t WS_UC = WS_S, WS_AB = WS_UC + 33 * MiB, WS_SUMM = WS_AB + 132 * MiB, WS_CARRY = WS_SUMM + 5 * MiB, WS_XA = WS_CARRY + 3 * MiB, WS_XB = WS_XA + 32 * MiB, WS_GB = WS_XB + 32 * MiB, WS_GC = WS_GB + 32 * MiB;
constexpr size_t WS_PA = WS_S, WS_PR = WS_PA + 66 * MiB, WS_PF = WS_PR + 66 * MiB, WS_Y1 = WS_PF + 66 * MiB;
static_assert(WS_GC + 3 * MiB <= WS_S + 280 * MiB && WS_Y1 + 66 * MiB <= WS_S + 280 * MiB, "scratch S");
constexpr size_t WS_MIXED = WS_S + 280 * MiB, WS_TOK = WS_MIXED + 33 * MiB;
constexpr size_t WS_LOG = WS_TOK + 33 * MiB, WS_SGU = WS_LOG + 17 * MiB, WS_SH = WS_SGU + 33 * MiB, WS_LIST = WS_SH + 9 * MiB, WS_TOPW = WS_LIST + 17 * MiB, WS_SD = WS_TOPW + 1 * MiB;
constexpr size_t WS_YB = WS_U;
constexpr size_t WS_Y16 = WS_KB, WS_HB = WS_S;
constexpr size_t WS_EP = WS_SUMM;
constexpr size_t WS_Y16_OLD = WS_U;
constexpr size_t WS_EW = WS_SD + 66 * MiB, WS_EW1 = WS_U, EW_STRIDE = 3 * MiB / 2;
#define EWL(l) (((l) & 1) ? WS_EW1 : WS_EW)
static_assert(WS_KB + 396 * MiB == WS_S && 392 * MiB <= 396 * MiB && WS_U + 384 * MiB <= WS_KB, "overlays");
constexpr size_t WS_END = WS_EW + 384 * MiB;
static_assert(WS_END <= 2048 * MiB, "d_ws budget");
constexpr int CW_BAR = 4096;
constexpr int CW_CNT = 16384, CNT_STRIDE = 32;
constexpr int CW_MOD = 65536;
static_assert((CW_MOD + 2 * 3 * 6144) * 4 <= (int)CTL_ZERO_BYTES, "ctl");

constexpr int LDS_BYTES = 147456, RING_BYTES = 131072, MISC_OFF = RING_BYTES + 320;
constexpr int NWAVES = 8;

#define GAS __attribute__((address_space(1)))
#define LAS __attribute__((address_space(3)))
typedef unsigned short bf16;
typedef unsigned v4u __attribute__((ext_vector_type(4)));
typedef float f32x4 __attribute__((ext_vector_type(4)));
typedef GAS unsigned gu32;
#define RLX_AGENT __ATOMIC_RELAXED, __HIP_MEMORY_SCOPE_AGENT
#define LDS_WAIT() asm volatile("s_waitcnt lgkmcnt(0)" ::: "memory")
typedef float f32x2_t __attribute__((ext_vector_type(2))); typedef __bf16 bf16x2_t __attribute__((ext_vector_type(2)));
__device__ __forceinline__ unsigned pk2(float lo, float hi) { const f32x2_t v = {lo, hi}; const bf16x2_t b = __builtin_convertvector(v, bf16x2_t); return __builtin_bit_cast(unsigned, b); }
__device__ __forceinline__ unsigned f2bf(float f) { return pk2(f, f) & 0xffffu; }
__device__ __forceinline__ float bf2f(unsigned h) { return __uint_as_float(h << 16); }
__device__ __forceinline__ float sigmoidf_(float x) { return __builtin_amdgcn_rcpf(1.f + __expf(-x)); }
__device__ __forceinline__ float siluf_(float x) { return x * __builtin_amdgcn_rcpf(1.f + __expf(-x)); }
__device__ __forceinline__ float gelu_tanh(float x) { const float u = 0.7978845608028654f * (x + 0.044715f * x * x * x); return x * __builtin_amdgcn_rcpf(1.f + __expf(-2.f * u)); }

#define XB_TMO      128
#define XB_XCNT(j)  (256  + 64 * (j))
#define XB_XSUB(j)  (1280 + 64 * (j))
#define XB_XGEN(j)  (2304 + 64 * (j))
#define XB_TOP      3328
#define XB_TOPGEN   3392
#define XCD_BAR_WORDS 3456
#define XB_SPIN_CAP (1u << 18)
__device__ __forceinline__ unsigned xb_ld(unsigned* p)              { return __hip_atomic_load(p, __ATOMIC_RELAXED, __HIP_MEMORY_SCOPE_AGENT); }
__device__ __forceinline__ unsigned xb_add(unsigned* p, unsigned v) { return __hip_atomic_fetch_add(p, v, __ATOMIC_RELAXED, __HIP_MEMORY_SCOPE_AGENT); }
__device__ __forceinline__ unsigned xb_xcc_id() { return (unsigned)__builtin_amdgcn_s_getreg((3 << 11) | 20) & 0xFu; }
#define XB_SPIN(cond, bar) do { unsigned _sp = 0; while (cond) { __builtin_amdgcn_s_sleep(1); \
    if ((++_sp & 255u) == 0u) { if (xb_ld(&(bar)[XB_TMO])) break; if (_sp > XB_SPIN_CAP) { atomicAdd(&(bar)[XB_TMO], 1u); break; } } } } while (0)
struct XcdBarrier { unsigned* bar; unsigned x; volatile LAS unsigned* st; };
__device__ __forceinline__ XcdBarrier xcd_barrier_post(unsigned* bar, volatile LAS unsigned* st) {
    XcdBarrier b; b.bar = bar; b.x = xb_xcc_id(); b.st = st;
    if (threadIdx.x == 0) (void)xb_add(&bar[XB_XCNT(b.x)], 1u);
    return b;
}
__device__ __forceinline__ void xcd_barrier_complete(unsigned* bar, unsigned x, unsigned& nloc, unsigned& nx) {
    const unsigned G = gridDim.x * gridDim.y * gridDim.z;
    unsigned sum, cnt, mine, sp = 0u;
    for (;;) {
        sum = 0u; cnt = 0u; mine = 0u;
#pragma unroll
        for (unsigned j = 0; j < 16; ++j) { const unsigned c = xb_ld(&bar[XB_XCNT(j)]); sum += c; cnt += (c > 0u) ? 1u : 0u; mine = (j == x) ? c : mine; }
        if (sum == G) break;
        __builtin_amdgcn_s_sleep(1);
        if ((++sp & 255u) == 0u) { if (xb_ld(&bar[XB_TMO])) break; if (sp > XB_SPIN_CAP) { atomicAdd(&bar[XB_TMO], 1u); break; } }
    }
    nloc = mine > 0u ? mine : 1u; nx = cnt > 0u ? cnt : 1u;
}
__device__ __forceinline__ void xcd_barrier(const XcdBarrier& b) {
    asm volatile("s_waitcnt vmcnt(0)" ::: "memory");
    __syncthreads();
    if (threadIdx.x == 0) {
        unsigned* bar = b.bar; asm volatile("" : "+s"(bar));
        __builtin_amdgcn_s_waitcnt(0);
        unsigned nloc = b.st[0], nx = b.st[1];
        unsigned bx = b.x; asm volatile("" : "+s"(bx));
        if (nloc == 0u) { xcd_barrier_complete(bar, bx, nloc, nx); b.st[0] = nloc; b.st[1] = nx; }
        const unsigned old = xb_add(&bar[XB_XSUB(bx)], 1u);
        const unsigned gen = old / nloc;
        if (old + 1u == (gen + 1u) * nloc) {
            __builtin_amdgcn_fence(__ATOMIC_RELEASE, "agent");
            asm volatile("s_waitcnt vmcnt(0)" ::: "memory");
            const unsigned og = xb_add(&bar[XB_TOP], 1u);
            const unsigned tg = og / nx;
            if (og + 1u == (tg + 1u) * nx) xb_add(&bar[XB_TOPGEN], 1u);
            else XB_SPIN(xb_ld(&bar[XB_TOPGEN]) == tg, bar);
            __builtin_amdgcn_fence(__ATOMIC_ACQUIRE, "agent");
            xb_add(&bar[XB_XGEN(bx)], 1u);
            asm volatile("s_waitcnt vmcnt(0)" ::: "memory");
        } else {
            XB_SPIN(xb_ld(&bar[XB_XGEN(bx)]) == gen, bar);
            __builtin_amdgcn_fence(__ATOMIC_ACQUIRE, "agent");
            asm volatile("s_waitcnt vmcnt(0)" ::: "memory");
        }
    }
    __syncthreads();
}

struct Args { const float* in[32]; float* out; unsigned char* ws; int ph_lo, ph_hi; };
struct Frame { LAS unsigned char* lds; int tid, lane, wave, bid, G, gw, NGW; long gtid, NT; };
#define WSP(T, off) ((T*)(A.ws + (off)))
#define WLP(l, off) ((bf16*)(A.ws + WS_W + (size_t)(l) * WL_STRIDE + (off)))
#define MODP(l, s, j) ((const float*)(A.ws + WS_CTL) + CW_MOD + ((l) * 3 + (s)) * 6144 + (j) * 1024)

__device__ __forceinline__ float wave_sum(float v) {
    v += sx<1>(v); v += sx<2>(v); v += sx<4>(v); v += sx<8>(v); v += sx<16>(v); v += sx<32>(v);
    return v;
}
__device__ __forceinline__ int win_row(int c) {
    const int sec = c >> 10; if (sec != 0 && sec != 3) return c;
    const int L = c & 255, g = L >> 6, a = (L >> 5) & 1, x = (L >> 4) & 1, q = (L >> 2) & 3, e = L & 3;
    return (c & ~255) | (128 * a + 32 * g + 8 * q + 4 * x + e);
}
template <bool WINMAP = false>
__device__ __forceinline__ void p0_transpose_item(const float* W, int K, int N, bf16* WT, int ldwt, int row_off, int col_off, LAS float* scr, int item, int lane) {
    const int nblk = N / 32, kb = item / nblk, nb = item % nblk, k0 = 64 * kb, n0 = 32 * nb;
    { f32x4 v[8]; const int rr = lane >> 3, c4 = (lane & 7) * 4;
#pragma unroll
      for (int i = 0; i < 8; ++i) v[i] = *(const f32x4*)(W + (size_t)(k0 + 8 * i + rr) * N + n0 + c4);
#pragma unroll
      for (int i = 0; i < 8; ++i) { LAS float* d = scr + (8 * i + rr) * 33 + c4; d[0] = v[i].x; d[1] = v[i].y; d[2] = v[i].z; d[3] = v[i].w; } }
    LDS_WAIT(); asm volatile("" ::: "memory");
    const int c = lane & 7;
#pragma unroll
    for (int j = 0; j < 4; ++j) { const int n = (lane >> 3) + 8 * j; const LAS float* s = scr + (8 * c) * 33 + n;
        v4u o; o.x = pk2(s[0 * 33], s[1 * 33]); o.y = pk2(s[2 * 33], s[3 * 33]); o.z = pk2(s[4 * 33], s[5 * 33]); o.w = pk2(s[6 * 33], s[7 * 33]);
        const int rr = WINMAP ? win_row(n0 + n) : n0 + n;
        *(v4u*)(WT + (size_t)(row_off + rr) * ldwt + col_off + k0 + 8 * c) = o; }
    LDS_WAIT(); asm volatile("" ::: "memory");
}

struct PItem { const float* W; bf16* WT; int N, ldwt, k0, n0, rowbase; bool winmap, skip; };
constexpr int PRO_I_WIN = 16 * 288, PRO_I_SQ = 16 * 32, PRO_I_R = 16 * 8, PRO_I_SD = 4 * 32, PRO_PER_L = PRO_I_WIN + 4 * PRO_I_SQ + 3 * PRO_I_R + PRO_I_SD;
__device__ __forceinline__ void pi_set(PItem& t, const float* W, int N, bf16* WT, int ldwt, int row_off, int col_off, int item) {
    const int nblk = N / 32, kb = item / nblk, nb = item % nblk; t.W = W; t.N = N; t.WT = WT + col_off; t.ldwt = ldwt; t.k0 = 64 * kb; t.n0 = 32 * nb; t.rowbase = row_off; }
__device__ __forceinline__ PItem pro_item(const Args& A, int it) {
    const int l = it / PRO_PER_L; int r = it % PRO_PER_L; PItem t; t.winmap = false; t.skip = false;
    if (r < PRO_I_WIN) { const int nb = r % 288; t.skip = nb >= 160 && nb < 192; t.winmap = true;
        pi_set(t, A.in[7] + (size_t)l * 1024 * 9216, 9216, WLP(l, WO_WIN), 1024, 0, 0, r); return t; } r -= PRO_I_WIN;
    if (r < PRO_I_SQ) { pi_set(t, A.in[12] + (size_t)l * 1048576, 1024, WLP(l, WO_D1), 3072, 0, 0, r); return t; } r -= PRO_I_SQ;
    if (r < PRO_I_SQ) { pi_set(t, A.in[20] + (size_t)l * 1048576, 1024, WLP(l, WO_D1), 3072, 0, 1024, r); return t; } r -= PRO_I_SQ;
    if (r < PRO_I_SQ) { pi_set(t, A.in[21] + (size_t)l * 1048576, 1024, WLP(l, WO_D1), 3072, 0, 2048, r); return t; } r -= PRO_I_SQ;
    if (r < PRO_I_SQ) { pi_set(t, A.in[22] + (size_t)l * 1048576, 1024, WLP(l, WO_OUT), 1024, 0, 0, r); return t; } r -= PRO_I_SQ;
    if (r < PRO_I_R) { pi_set(t, A.in[24] + (size_t)l * 262144, 256, WLP(l, WO_R), 1024, 0, 0, r); return t; } r -= PRO_I_R;
    if (r < PRO_I_R) { pi_set(t, A.in[29] + (size_t)l * 262144, 256, WLP(l, WO_R), 1024, 256 + ((r % 8) >> 2) * 128, 0, r); return t; } r -= PRO_I_R;
    if (r < PRO_I_R) { pi_set(t, A.in[30] + (size_t)l * 262144, 256, WLP(l, WO_R), 1024, 384 + ((r % 8) >> 2) * 128, 0, r); return t; } r -= PRO_I_R;
    pi_set(t, A.in[31] + (size_t)l * 262144, 1024, WLP(l, WO_SD), 256, 0, 0, r); return t;
}
__device__ __forceinline__ void pi_load(const PItem& t, f32x4 (&v)[8], int lane) {
    const int rr = lane >> 3, c4 = (lane & 7) * 4;
#pragma unroll
    for (int i = 0; i < 8; ++i) v[i] = *(const f32x4*)(t.W + (size_t)(t.k0 + 8 * i + rr) * t.N + t.n0 + c4);
}
__device__ __forceinline__ void pi_store(const PItem& t, const f32x4 (&v)[8], LAS float* scr, int lane) {
    const int rr = lane >> 3, c4 = (lane & 7) * 4;
#pragma unroll
    for (int i = 0; i < 8; ++i) { LAS float* d = scr + (8 * i + rr) * 33 + c4; d[0] = v[i].x; d[1] = v[i].y; d[2] = v[i].z; d[3] = v[i].w; }
    LDS_WAIT(); asm volatile("" ::: "memory");
    const int c = lane & 7;
#pragma unroll
    for (int j = 0; j < 4; ++j) { const int n = (lane >> 3) + 8 * j; const LAS float* sp = scr + (8 * c) * 33 + n;
        v4u o; o.x = pk2(sp[0 * 33], sp[1 * 33]); o.y = pk2(sp[2 * 33], sp[3 * 33]); o.z = pk2(sp[4 * 33], sp[5 * 33]); o.w = pk2(sp[6 * 33], sp[7 * 33]);
        const int row = t.winmap ? win_row(t.n0 + n) : t.n0 + n;
        *(v4u*)(t.WT + (size_t)(t.rowbase + row) * t.ldwt + t.k0 + 8 * c) = o; }
    LDS_WAIT(); asm volatile("" ::: "memory");
}

__device__ __forceinline__ void ph_prologue(const Frame& F, const Args& A) {
    LAS float* scr = (LAS float*)(F.lds + F.wave * 16384);
    { const int stride = F.NGW, hi = 2 * PRO_PER_L; int it = F.gw;
      if (it < hi) { PItem t0 = pro_item(A, it), t1 = t0; f32x4 v0[8], v1[8]; bool h1 = it + stride < hi;
        if (!t0.skip) pi_load(t0, v0, F.lane);
        for (;;) {
            if (h1) { t1 = pro_item(A, it + stride); if (!t1.skip) pi_load(t1, v1, F.lane); }
            if (!t0.skip) pi_store(t0, v0, scr, F.lane);
            if (!h1) break;
#pragma unroll
            for (int i = 0; i < 8; ++i) v0[i] = v1[i];
            t0 = t1; it += stride; h1 = it + stride < hi; } } }
#if FAST_WIN
    {
        LAS float* sW = (LAS float*)F.lds; LAS float* sT = sW + 32 * 256;
        __syncthreads();
        if (F.tid < 256) sT[F.tid] = cospif((float)F.tid / 128.0f);
        for (int it = F.bid; it < 2 * 4 * 32; it += F.G) {
            const int l = it >> 7, g = (it >> 5) & 3, k0 = (it & 31) * 32;
            __syncthreads();
            for (int e = F.tid; e < 32 * 256; e += 512) sW[e] = A.in[7][((size_t)l * 1024 + k0 + (e >> 8)) * 9216 + COL_F + g * 256 + (e & 255)];
            __syncthreads();
            const int o = F.tid & 255, kh = F.tid >> 8; int j = o >> 1, odd = o & 1; if (o == 1) { j = 128; odd = 0; }
            const int m0 = odd ? 192 : 0; float acc[16];
#pragma unroll
            for (int q = 0; q < 16; ++q) acc[q] = 0.f;
            for (int c = 0; c < 256; c += 4) { const float r0 = sT[(j * c + m0) & 255], r1 = sT[(j * (c + 1) + m0) & 255], r2 = sT[(j * (c + 2) + m0) & 255], r3 = sT[(j * (c + 3) + m0) & 255];
#pragma unroll
                for (int q = 0; q < 16; ++q) { const f32x4 w = *(const LAS f32x4*)(sW + (kh * 16 + q) * 256 + c); acc[q] += w.x * r0; acc[q] += w.y * r1; acc[q] += w.z * r2; acc[q] += w.w * r3; } }
            bf16* dst = WLP(l, WO_WIN) + (size_t)(COL_F + g * 256 + o) * 1024 + k0 + kh * 16;
            v4u w0, w1; w0.x = pk2(acc[0], acc[1]); w0.y = pk2(acc[2], acc[3]); w0.z = pk2(acc[4], acc[5]); w0.w = pk2(acc[6], acc[7]);
            w1.x = pk2(acc[8], acc[9]); w1.y = pk2(acc[10], acc[11]); w1.z = pk2(acc[12], acc[13]); w1.w = pk2(acc[14], acc[15]);
            *(v4u*)dst = w0; *(v4u*)(dst + 8) = w1;
        }
        __syncthreads();
    }
#endif
    float* MOD = (float*)(A.ws + WS_CTL) + CW_MOD;
    LAS float* part = (LAS float*)(F.lds + 8 * 16384 - 8192);
    LAS float* ssil = (LAS float*)(F.lds + 8 * 16384 - 8192 - 12288);
    if (F.bid < 2 * 96) { for (int e = F.tid; e < 3072; e += NWAVES * 64) { const int k = e & 1023; ssil[e] = siluf_(e < 1024 ? A.in[1][k] : e < 2048 ? A.in[1][1024 + k] : A.in[3][k]); } }
    __syncthreads();
    for (int it = F.bid; it < 2 * 96; it += F.G) {
        const int l = it / 96, nb = it % 96, n = nb * 64 + F.lane;
        const float* wm = A.in[4] + (size_t)l * 1024 * 6144 + n;
        float a0 = 0.f, a1 = 0.f, a2 = 0.f;
#pragma unroll 32
        for (int k = F.wave * 128; k < F.wave * 128 + 128; ++k) {
            const float w = wm[(size_t)k * 6144];
            a0 += ssil[k] * w; a1 += ssil[1024 + k] * w; a2 += ssil[2048 + k] * w;
        }
        __syncthreads();
        part[(F.wave * 3 + 0) * 64 + F.lane] = a0; part[(F.wave * 3 + 1) * 64 + F.lane] = a1; part[(F.wave * 3 + 2) * 64 + F.lane] = a2;
        __syncthreads();
        if (F.wave < 3) { float s = A.in[5][l * 6144 + n];
#pragma unroll
            for (int w = 0; w < 8; ++w) s += part[(w * 3 + F.wave) * 64 + F.lane];
            MOD[(l * 3 + F.wave) * 6144 + n] = s; }
    }
    for (long i = F.gtid; i < 2L * 4096 * 256; i += F.NT) {
        const int l = (int)(i >> 20), n = (int)((i >> 8) & 4095), kk = (int)(i & 255), pn = n >> 8, rr = n & 255, gate = rr >> 7, rho = rr & 127, d = pn >> 3, cb = pn & 7;
        const int cho = 128 * cb + rho, blk = cho >> 6, e = cho & 63, chi = 256 * (cb >> 1) + kk; float v = 0.f;
        if ((chi >> 6) == blk) v = (gate ? A.in[17] : A.in[15])[((size_t)(l * 2 + d) * 16 + blk) * 4096 + (chi & 63) * 64 + e];
        WLP(l, WO_LRU)[i & 0xFFFFF] = (bf16)f2bf(v);
    }
    for (long i = F.gtid; i < 2L * 65536; i += F.NT) {
        const int which = (int)(i >> 16), n = (int)((i >> 8) & 255), k = (int)(i & 255); float v;
        if (which == 0) { const int k1 = n >> 1, cp = n & 1, t1 = k >> 1, c = k & 1; const float rev = (float)((k1 * t1) & 127) * (1.f / 128.f);
            const float cs = __builtin_amdgcn_cosf(rev), sn = __builtin_amdgcn_sinf(rev); v = cp == 0 ? (c == 0 ? cs : sn) : (c == 0 ? -sn : cs); }
        else { const int h = n >> 7, k2 = (n >> 1) & 63, cp = n & 1, hp = k >> 7, t2 = (k >> 1) & 63, c = k & 1; const float rev = (float)((k2 * t2) & 63) * (1.f / 64.f);
            const float cs = __builtin_amdgcn_cosf(rev), sn = __builtin_amdgcn_sinf(rev); v = (h != hp) ? 0.f : (cp == 0 ? (c == 0 ? cs : sn) : (c == 0 ? -sn : cs)); }
        WLP(0, WO_TAB)[i] = (bf16)f2bf(v);
    }
    for (long i = F.gtid; i < 4096; i += F.NT) ((float*)(A.ws + WS_W + WO_TAB + 262144))[i] = log1pf(expf(-A.in[19][i]));
}

__device__ __forceinline__ void norm_mod_row(const f32x4 (&v)[4], const float* g, const float* sc, const float* sh, bf16* orow, int lane) {
    float s = 0.f;
#pragma unroll
    for (int j = 0; j < 4; ++j) s += (v[j].x * v[j].x + v[j].y * v[j].y) + (v[j].z * v[j].z + v[j].w * v[j].w);
    const float rs = rsqrtf(wave_sum(s) * (1.f / 1024.f) + EPS);
#pragma unroll
    for (int j = 0; j < 4; ++j) { const int c = 4 * lane + 256 * j;
        const f32x4 gg = *(const f32x4*)(g + c), s1 = *(const f32x4*)(sc + c), s0 = *(const f32x4*)(sh + c);
        const float y0 = v[j].x * rs * gg.x * (1.f + s1.x) + s0.x, y1 = v[j].y * rs * gg.y * (1.f + s1.y) + s0.y, y2 = v[j].z * rs * gg.z * (1.f + s1.z) + s0.z, y3 = v[j].w * rs * gg.w * (1.f + s1.w) + s0.w;
        *(unsigned long long*)(orow + c) = (unsigned long long)pk2(y0, y1) | ((unsigned long long)pk2(y2, y3) << 32); }
}
__device__ __forceinline__ void ph_norm1(const Frame& F, const Args& A, int l) {
    bf16* H = WSP(bf16, WS_H);
    for (int R0 = F.gw; R0 < MROWS; R0 += 2 * F.NGW) {
        const int R1 = R0 + F.NGW; const bool ok1 = R1 < MROWS; const int Rb = ok1 ? R1 : R0;
        const int b0 = R0 / TPB, p0 = R0 % TPB, b1 = Rb / TPB, p1 = Rb % TPB;
        const float* X0 = (p0 < CTX) ? A.in[2] + ((size_t)b0 * CTX + p0) * 1024 : A.in[0] + ((size_t)b0 * SEQ + (p0 - CTX)) * 1024;
        const float* X1 = (p1 < CTX) ? A.in[2] + ((size_t)b1 * CTX + p1) * 1024 : A.in[0] + ((size_t)b1 * SEQ + (p1 - CTX)) * 1024;
        f32x4 v0[4], v1[4];
#pragma unroll
        for (int j = 0; j < 4; ++j) v0[j] = *(const f32x4*)(X0 + 4 * F.lane + 256 * j);
#pragma unroll
        for (int j = 0; j < 4; ++j) v1[j] = *(const f32x4*)(X1 + 4 * F.lane + 256 * j);
        { const int s = (p0 < CTX) ? 2 : b0; norm_mod_row(v0, A.in[6] + l * 1024, MODP(l, s, 1), MODP(l, s, 0), H + (size_t)R0 * 1024, F.lane); }
        if (ok1) { const int s = (p1 < CTX) ? 2 : b1; norm_mod_row(v1, A.in[6] + l * 1024, MODP(l, s, 1), MODP(l, s, 0), H + (size_t)R1 * 1024, F.lane); }
    }
}

__device__ __forceinline__ void ph_uelem(const Frame& F, const Args& A, int l) {
    const float* U = WSP(float, WS_U);
    bf16 *Kb = WSP(bf16, WS_KB), *Vb = WSP(bf16, WS_VB), *Qb = WSP(bf16, WS_QB), *LXb = WSP(bf16, WS_LXB), *GLG = WSP(bf16, WS_GLG), *ZP = WSP(bf16, WS_ZP), *GT = WSP(bf16, WS_GATES);
    LAS float* sF = (LAS float*)F.lds; LAS float* sT = sF + 1024;
    if (F.tid < 256) sT[F.tid] = cospif((float)F.tid / 128.0f);
    __syncthreads();
    for (int R = F.bid; R < MROWS; R += F.G) {
        const float* u = U + (size_t)R * INW; const int p = R % TPB; const bool lat = p >= CTX; const int t = p - CTX;
        for (int gi = F.wave; gi < 32; gi += 8) {
            const bool isq = gi >= 16; const int grp = gi & 15;
            const float v = u[(isq ? COL_Q : COL_K) + grp * 64 + F.lane];
            const float ss = wave_sum(v * v);
            float y = v * rsqrtf(ss * (1.f / 64.f) + EPS) * (isq ? A.in[8] : A.in[9])[l * 64 + F.lane];
            const float part = sx<16>(y);
            if (lat) { const int axis = F.lane >> 5, hf = (F.lane >> 4) & 1, f = F.lane & 15;
                const float pos = (float)(axis ? (t & 63) : (t >> 6)); const float inv = exp2f(-(float)f * (13.287712379549449f / 16.f));
                float sn, cs; sincosf(pos * inv, &sn, &cs);
                y = hf ? (part * sn + y * cs) : (y * cs - part * sn); }
            if (isq) y *= QSCALE;
            (isq ? Qb : Kb)[(size_t)R * 1024 + grp * 64 + F.lane] = (bf16)f2bf(y);
        }
        for (int c = F.tid; c < 1024; c += 512) { const size_t o = (size_t)R * 1024 + c;
            Vb[o] = (bf16)f2bf(u[COL_V + c]); LXb[o] = (bf16)f2bf(u[COL_LX + c]); GLG[o] = (bf16)f2bf(gelu_tanh(u[COL_LG + c])); sF[c] = u[COL_F + c]; }
        for (int c = F.tid; c < 3072; c += 512) GT[(size_t)R * 3072 + c] = (bf16)f2bf(sigmoidf_(u[COL_G + c]));
        __syncthreads();
        for (int o = F.tid; o < 1024; o += 512) { const int g = o >> 8, oo = o & 255; int j = oo >> 1, odd = oo & 1; if (oo == 1) { j = 128; odd = 0; }
            const int m0 = odd ? 192 : 0; float acc = 0.f;
            for (int c = 0; c < 256; ++c) acc += sF[g * 256 + c] * sT[(j * c + m0) & 255];
            ZP[(size_t)R * 1024 + o] = (bf16)f2bf(acc); }
        __syncthreads();
    }
}

__device__ __forceinline__ void ph_conv(const Frame& F, const Args& A, int l) {
    const bf16* LXb = WSP(bf16, WS_LXB); bf16* UC = WSP(bf16, WS_UC);
    const int c8 = (int)(F.gtid & 127) * 8, r0 = (int)(F.gtid >> 7), rstep = (int)(F.NT >> 7);
    float w[4][8], bia[8];
#pragma unroll
    for (int j = 0; j < 4; ++j) { const f32x4 a = *(const f32x4*)(A.in[13] + l * 4096 + j * 1024 + c8), b = *(const f32x4*)(A.in[13] + l * 4096 + j * 1024 + c8 + 4);
        w[j][0] = a.x; w[j][1] = a.y; w[j][2] = a.z; w[j][3] = a.w; w[j][4] = b.x; w[j][5] = b.y; w[j][6] = b.z; w[j][7] = b.w; }
    { const f32x4 a = *(const f32x4*)(A.in[14] + l * 1024 + c8), b = *(const f32x4*)(A.in[14] + l * 1024 + c8 + 4);
      bia[0] = a.x; bia[1] = a.y; bia[2] = a.z; bia[3] = a.w; bia[4] = b.x; bia[5] = b.y; bia[6] = b.z; bia[7] = b.w; }
    for (int Rb = r0; Rb < MROWS; Rb += 4 * rstep) {
        v4u x[4][4];
#pragma unroll
        for (int u = 0; u < 4; ++u) { const int R = Rb + u * rstep; if (R < MROWS) { const int p = R % TPB, lo = p < CTX ? 0 : CTX, hi = p < CTX ? CTX : TPB;
#pragma unroll
            for (int j = 0; j < 4; ++j) { const int pp = p + j - 2; x[u][j] = (pp >= lo && pp < hi) ? *(const v4u*)(LXb + (size_t)(R + j - 2) * 1024 + c8) : (v4u){0u, 0u, 0u, 0u}; } } }
#pragma unroll
        for (int u = 0; u < 4; ++u) { const int R = Rb + u * rstep; if (R < MROWS) { float acc[8];
#pragma unroll
            for (int e = 0; e < 8; ++e) acc[e] = bia[e];
#pragma unroll
            for (int j = 0; j < 4; ++j) { const unsigned xs[4] = {x[u][j].x, x[u][j].y, x[u][j].z, x[u][j].w};
#pragma unroll
                for (int q = 0; q < 4; ++q) { acc[2 * q] += w[j][2 * q] * bf2f(xs[q] & 0xffffu); acc[2 * q + 1] += w[j][2 * q + 1] * bf2f(xs[q] >> 16); } }
            v4u o; o.x = pk2(acc[0], acc[1]); o.y = pk2(acc[2], acc[3]); o.z = pk2(acc[4], acc[5]); o.w = pk2(acc[6], acc[7]);
            *(v4u*)(UC + (size_t)R * 1024 + c8) = o; } }
    }
}
#if !FAST_LRU
__device__ __forceinline__ void ph_lrucoef(const Frame& F, const Args& A, int l) {
    const bf16* UC = WSP(bf16, WS_UC); unsigned* AB = WSP(unsigned, WS_AB);
    for (long i = F.gtid; i < 2L * MROWS * 1024; i += F.NT) {
        const int d = (int)(i / ((long)MROWS * 1024)); const long rem = i % ((long)MROWS * 1024); const int R = (int)(rem >> 10), ch = (int)(rem & 1023), blk = ch >> 6, e = ch & 63;
        const float* wa = A.in[15] + ((size_t)(l * 2 + d) * 16 + blk) * 4096 + e; const float* wi = A.in[17] + ((size_t)(l * 2 + d) * 16 + blk) * 4096 + e;
        float r = A.in[16][(l * 2 + d) * 1024 + ch], ig = A.in[18][(l * 2 + d) * 1024 + ch];
        const bf16* ur = UC + (size_t)R * 1024 + blk * 64;
        for (int dd = 0; dd < 64; ++dd) { const float x = bf2f(ur[dd]); r += x * wa[dd * 64]; ig += x * wi[dd * 64]; }
        const float lam = A.in[19][(l * 2 + d) * 1024 + ch]; const float sp = log1pf(expf(-lam));
        const float la = -8.f * sigmoidf_(r) * sp; const float mult = sqrtf(-expm1f(2.f * la));
        const float bc = mult * sigmoidf_(ig) * bf2f(ur[e]);
        AB[i] = pk2(la, bc);
    }
}
#endif
struct LruSched {
    const char* uc; const char* w; int G, c;
    __device__ __forceinline__ bool next(int i, pg8::UnitG& U) const {
        const long id = (long)i * G + c; if (id >= 66 * 16) return false;
        const int pm = (int)(id >> 4), pn = (int)(id & 15);
        U.a = uc + ((size_t)pm * 256 * 1024 + 256 * ((pn & 7) >> 1)) * 2; U.b = w + (size_t)pn * 256 * 256 * 2; U.row0 = pm * 256; U.pn = pn; U.e = 0; U.valid = 256; U.rows = nullptr; return true;
    }
};
struct EpiLru {
    static constexpr bool PERM = false;
    unsigned* AB; const bf16* UC; const float* ba; const float* bi; const float* sp;
    __device__ __forceinline__ void operator()(const f32x4 (&acc)[2][2][4][2], const pg8::UnitG& u, int wr, int wc, int fr, int fq) const {
        const int d = u.pn >> 3, cb = u.pn & 7, ch0 = 128 * cb + wc * 32 + 4 * fq;
        f32x4 vba[2], vbi[2], vsp[2];
#pragma unroll
        for (int n = 0; n < 2; ++n) { vba[n] = *(const f32x4*)(ba + d * 1024 + ch0 + 16 * n); vbi[n] = *(const f32x4*)(bi + d * 1024 + ch0 + 16 * n); vsp[n] = *(const f32x4*)(sp + d * 1024 + ch0 + 16 * n); }
#pragma unroll
        for (int ai = 0; ai < 2; ++ai) { unsigned long long uxs[4][2];
#pragma unroll
            for (int m = 0; m < 4; ++m)
#pragma unroll
                for (int n = 0; n < 2; ++n) uxs[m][n] = *(const unsigned long long*)(UC + ((size_t)u.row0 + ai * 128 + wr * 64 + m * 16 + fr) * 1024 + ch0 + 16 * n);
#pragma unroll
            for (int m = 0; m < 4; ++m) { const size_t R = (size_t)u.row0 + ai * 128 + wr * 64 + m * 16 + fr;
#pragma unroll
                for (int n = 0; n < 2; ++n) { const int ch = ch0 + 16 * n;
                    const unsigned long long ux = uxs[m][n];
                    const float x[4] = {bf2f((unsigned)ux & 0xffffu), bf2f(((unsigned)ux) >> 16), bf2f((unsigned)(ux >> 32) & 0xffffu), bf2f((unsigned)(ux >> 48))};
                    const f32x4 r = acc[ai][0][m][n] + vba[n], g = acc[ai][1][m][n] + vbi[n]; v4u o;
#pragma unroll
                    for (int e = 0; e < 4; ++e) { const float la = -8.f * sigmoidf_(r[e]) * vsp[n][e]; const float mult = __builtin_amdgcn_sqrtf(fmaxf(1.f - __expf(2.f * la), 0.f));
                        o[e] = pk2(la, mult * sigmoidf_(g[e]) * x[e]); }
                    *(v4u*)(AB + ((size_t)d * MROWS + R) * 1024 + ch) = o; } }
            asm volatile("" ::: "memory"); }
    }
};
__device__ __forceinline__ void ph_lru_gemm(const Frame& F, const Args& A, int l, int Ge) {
    LruSched S{(const char*)WSP(bf16, WS_UC), (const char*)WLP(l, WO_LRU), Ge, F.bid};
    EpiLru E{WSP(unsigned, WS_AB), WSP(bf16, WS_UC), A.in[16] + l * 2048, A.in[18] + l * 2048, (const float*)(A.ws + WS_W + WO_TAB + 262144) + l * 2048};
    pg8::gemm_phase_g<EpiLru, LruSched, false>(F.lds, 256, 1024, 256, S, E);
}
struct FftSched {
    const char* x; const char* w; int nunits, G, c;
    __device__ __forceinline__ bool next(int i, pg8::UnitG& U) const {
        const long id = (long)i * G + c; if (id >= nunits) return false;
        U.a = x + (size_t)id * 256 * 256 * 2; U.b = w; U.row0 = (int)id * 256; U.pn = 0; U.e = 0; U.valid = 256; U.rows = nullptr; return true;
    }
};
struct EpiFftA {
    static constexpr bool PERM = false;
    unsigned* XB;
    __device__ __forceinline__ void operator()(const f32x4 (&acc)[2][2][4][2], const pg8::UnitG& u, int wr, int wc, int fr, int fq) const {
#pragma unroll
        for (int ai = 0; ai < 2; ++ai)
#pragma unroll
            for (int m = 0; m < 4; ++m) { int r0 = u.row0; asm volatile("" : "+s"(r0));
                const int row = r0 + ai * 128 + wr * 64 + m * 16 + fr, t2 = row & 63; const size_t bc = (size_t)(row >> 6);
#pragma unroll
                for (int bj = 0; bj < 2; ++bj)
#pragma unroll
                    for (int n = 0; n < 2; ++n) { const int k1 = 64 * bj + 16 * wc + 8 * n + 2 * fq; const f32x4 v = acc[ai][bj][m][n];
#pragma unroll
                        for (int q = 0; q < 2; ++q) { const int kk = k1 + q; const float rev = (float)(kk * t2) * (1.f / 8192.f);
                            const float cs = __builtin_amdgcn_cosf(rev), sn = __builtin_amdgcn_sinf(rev); const float yr = v[2 * q], yi = v[2 * q + 1];
                            XB[(bc * 64 + (kk >> 1)) * 128 + (kk & 1) * 64 + t2] = pk2(yr * cs + yi * sn, yi * cs - yr * sn); } }
                asm volatile("" ::: "memory"); }
    }
};
struct EpiBf16Plain {
    static constexpr bool PERM = true;
    bf16* C; int ldc;
    __device__ __forceinline__ void operator()(const f32x4 (&acc)[2][2][4][2], const pg8::UnitG& u, int wr, int wc, int fr, int fq) const {
#pragma unroll
        for (int ai = 0; ai < 2; ++ai)
#pragma unroll
            for (int m = 0; m < 4; ++m) { bf16* rowp = C + (size_t)(u.row0 + ai * 128 + wr * 64 + m * 16 + fr) * ldc + u.pn * 256 + wc * 32 + 8 * fq;
#pragma unroll
                for (int bj = 0; bj < 2; ++bj) { const f32x4 v0 = acc[ai][bj][m][0], v1 = acc[ai][bj][m][1];
                    v4u o; o.x = pk2(v0[0], v0[1]); o.y = pk2(v0[2], v0[3]); o.z = pk2(v1[0], v1[1]); o.w = pk2(v1[2], v1[3]);
                    *(v4u*)(rowp + bj * 128) = o; } }
    }
};
struct EpiBf16U {
    static constexpr bool PERM = true; static constexpr int MIDK = 0;
    bf16* C; int ldc;
    __device__ __forceinline__ void operator()(const f32x4 (&acc)[2][2][4][2], const pg8::Unit& u, int wr, int wc, int fr, int fq) const {
#pragma unroll
        for (int ai = 0; ai < 2; ++ai)
#pragma unroll
            for (int m = 0; m < 4; ++m) { bf16* rowp = C + (size_t)(u.pm * 256 + ai * 128 + wr * 64 + m * 16 + fr) * ldc + u.pn * 256 + wc * 32 + 8 * fq;
#pragma unroll
                for (int bj = 0; bj < 2; ++bj) { const f32x4 v0 = acc[ai][bj][m][0], v1 = acc[ai][bj][m][1];
                    v4u o; o.x = pk2(v0[0], v0[1]); o.y = pk2(v0[2], v0[3]); o.z = pk2(v1[0], v1[1]); o.w = pk2(v1[2], v1[3]);
                    *(v4u*)(rowp + bj * 128) = o; } }
    }
};
__device__ __forceinline__ void ph_fft_a_gemm(const Frame& F, const Args& A) {
    FftSched S{(const char*)WSP(bf16, WS_XA), (const char*)WLP(0, WO_TAB), 256, F.G, F.bid};
    EpiFftA E{WSP(unsigned, WS_XB)};
    pg8::gemm_phase_g<EpiFftA, FftSched, false>(F.lds, 256, 256, 256, S, E);
}
__device__ __forceinline__ void ph_fft_b_gemm(const Frame& F, const Args& A) {
    FftSched S{(const char*)WSP(bf16, WS_XB), (const char*)(WLP(0, WO_TAB) + 65536), 256, F.G, F.bid};
    EpiBf16Plain E{WSP(bf16, WS_GB), 256};
    pg8::gemm_phase_g<EpiBf16Plain, FftSched, false>(F.lds, 256, 256, 256, S, E);
}
__device__ __forceinline__ void ph_scan1(const Frame& F, const Args& A) {
    const unsigned* AB = WSP(unsigned, WS_AB); float2* SUMM = WSP(float2, WS_SUMM);
    for (int it = F.gw; it < NB * 2 * NCHUNK * 16; it += F.NGW) {
        const int cg = it & 15, ck = (it >> 4) % NCHUNK, bd = (it >> 4) / NCHUNK, b = bd >> 1, d = bd & 1, ch = cg * 64 + F.lane;
        const unsigned* ab = AB + ((size_t)d * MROWS + (size_t)b * TPB + ck * 64) * 1024 + ch;
        float ac = 1.f, h = 0.f;
#pragma unroll
        for (int q = 0; q < 4; ++q) { unsigned w[16];
#pragma unroll
            for (int k = 0; k < 16; ++k) { const int i = q * 16 + k, ii = d ? 63 - i : i; w[k] = ab[(size_t)ii * 1024]; }
#pragma unroll
            for (int k = 0; k < 16; ++k) { const float a = __expf(bf2f(w[k] & 0xffffu)); h = a * h + bf2f(w[k] >> 16); ac *= a; } }
        SUMM[((size_t)bd * NCHUNK + ck) * 1024 + ch] = make_float2(ac, h);
    }
}
__device__ __forceinline__ void ph_scan2(const Frame& F, const Args& A) {
    const float2* SUMM = WSP(float2, WS_SUMM); float* CARRY = WSP(float, WS_CARRY);
    if (F.gtid < 4096) {
        const int bd = (int)(F.gtid >> 10), ch = (int)(F.gtid & 1023), d = bd & 1; float h = 0.f;
        for (int s = 0; s < NCHUNK; ++s) { const int ck = d ? (s < 4 ? 3 - s : NCHUNK + 3 - s) : s;
            const size_t o = ((size_t)bd * NCHUNK + ck) * 1024 + ch; CARRY[o] = h; const float2 v = SUMM[o]; h = v.x * h + v.y; }
    }
}
__device__ __forceinline__ void ph_scan3(const Frame& F, const Args& A) {
    const unsigned* AB = WSP(unsigned, WS_AB); const float* CARRY = WSP(float, WS_CARRY); const bf16* GLG = WSP(bf16, WS_GLG); bf16* MX = WSP(bf16, WS_MIXIN);
    for (int it = F.gw; it < NB * NCHUNK * 16; it += F.NGW) {
        const int cg = it & 15, ck = (it >> 4) % NCHUNK, b = (it >> 4) / NCHUNK, ch = cg * 64 + F.lane; const size_t R0 = (size_t)b * TPB + ck * 64;
        const unsigned* ab0 = AB + R0 * 1024 + ch; const unsigned* ab1 = AB + ((size_t)MROWS + R0) * 1024 + ch;
        float hf[64]; float h = CARRY[((size_t)(b * 2 + 0) * NCHUNK + ck) * 1024 + ch];
#pragma unroll
        for (int q = 0; q < 4; ++q) { unsigned w[16];
#pragma unroll
            for (int k = 0; k < 16; ++k) w[k] = ab0[(size_t)(q * 16 + k) * 1024];
#pragma unroll
            for (int k = 0; k < 16; ++k) { h = __expf(bf2f(w[k] & 0xffffu)) * h + bf2f(w[k] >> 16); hf[q * 16 + k] = h; } }
        h = CARRY[((size_t)(b * 2 + 1) * NCHUNK + ck) * 1024 + ch];
#pragma unroll
        for (int q = 3; q >= 0; --q) { unsigned w[16]; bf16 g[16];
#pragma unroll
            for (int k = 0; k < 16; ++k) { const int i = q * 16 + 15 - k; w[k] = ab1[(size_t)i * 1024]; g[k] = GLG[(R0 + i) * 1024 + ch]; }
#pragma unroll
            for (int k = 0; k < 16; ++k) { const int i = q * 16 + 15 - k; h = __expf(bf2f(w[k] & 0xffffu)) * h + bf2f(w[k] >> 16);
                MX[(R0 + i) * 3072 + 1024 + ch] = (bf16)f2bf((hf[i] + h) * bf2f(g[k])); } }
    }
}

__device__ __forceinline__ void ph_fft_t1_fast(const Frame& F, const Args& A) {
    const unsigned* ZP = WSP(unsigned, WS_ZP); unsigned* XA = WSP(unsigned, WS_XA); LAS unsigned* T = (LAS unsigned*)F.lds;
    for (int item = F.bid; item < 512; item += F.G) {
        const int b = item >> 8, t2 = (item >> 2) & 63, cq = item & 3;
        __syncthreads();
#pragma unroll
        for (int i = 0; i < 8; ++i) { const int p = F.tid + 512 * i, t1 = p >> 5, w4 = (p & 31) * 4;
            const v4u v = *(const v4u*)(ZP + ((size_t)b * TPB + CTX + 64 * t1 + t2) * 512 + cq * 128 + w4);
            T[t1 * 129 + w4] = v.x; T[t1 * 129 + w4 + 1] = v.y; T[t1 * 129 + w4 + 2] = v.z; T[t1 * 129 + w4 + 3] = v.w; }
        __syncthreads();
#pragma unroll
        for (int i = 0; i < 16; ++i) { const int p = F.tid + 512 * i, cc = p >> 6, t1 = (p & 63) * 2;
            const unsigned long long v = (unsigned long long)T[t1 * 129 + cc] | ((unsigned long long)T[(t1 + 1) * 129 + cc] << 32);
            *(unsigned long long*)(XA + (((size_t)b * 512 + cq * 128 + cc) * 64 + t2) * 128 + t1) = v; }
    }
    __syncthreads();
}
__device__ __forceinline__ void ph_fft_t2_fast(const Frame& F, const Args& A) {
    const unsigned* GB = WSP(unsigned, WS_GB); bf16* MX = WSP(bf16, WS_MIXIN); LAS unsigned* T = (LAS unsigned*)F.lds;
    for (int item = F.bid; item < 2 * 65 * 4; item += F.G) {
        const int b = item / 260, rem = item % 260, kp = rem >> 2, g = rem & 3, k1a = kp, k1b = (128 - kp) & 127;
        __syncthreads();
#pragma unroll
        for (int i = 0; i < 8; ++i) { const int p = F.tid + 512 * i, blk = p >> 11, cc = (p >> 4) & 127, w4 = (p & 15) * 4, kk = blk ? k1b : k1a;
            const v4u v = *(const v4u*)(GB + (((size_t)b * 512 + g * 128 + cc) * 64 + (kk >> 1)) * 128 + (kk & 1) * 64 + w4);
            LAS unsigned* d = T + blk * (128 * 65) + cc * 65 + w4; d[0] = v.x; d[1] = v.y; d[2] = v.z; d[3] = v.w; }
        __syncthreads();
        const int jc = F.tid & 255, j = (jc == 0 || jc == 128) ? 0 : (jc < 128 ? jc : 256 - jc);
        const int nset = (k1a == k1b) ? 1 : 2;
        for (int r = (F.tid >> 8); r < nset * 64; r += 2) { const int set = r >> 6, k2 = r & 63, ka = set ? k1b : k1a;
            const int mk2 = (ka == 0) ? ((64 - k2) & 63) : 63 - k2;
            const unsigned own = T[set * (128 * 65) + j * 65 + k2], mir = T[(nset == 1 ? 0 : (1 - set)) * (128 * 65) + j * 65 + mk2];
            float o; if (jc == 0) o = 0.5f * (bf2f(own & 0xffffu) + bf2f(mir & 0xffffu)); else if (jc == 128) o = 0.5f * (bf2f(own >> 16) + bf2f(mir >> 16)); else if (jc < 128) o = bf2f(mir & 0xffffu); else o = bf2f(own & 0xffffu);
            MX[((size_t)b * TPB + CTX + ka + 128 * k2) * 3072 + 2048 + g * 256 + jc] = (bf16)f2bf(o * 6.9053396600248786e-4f); }
    }
    __syncthreads();
    const float2* GC = WSP(float2, WS_GC);
    for (long i = F.gtid; i < (long)NB * CTX * 1024; i += F.NT) {
        const int col = (int)(i & 1023), k = (int)((i >> 10) & 255), b = (int)(i >> 18), g = col >> 8, jc = col & 255, km = (256 - k) & 255;
        const int j = (jc == 0 || jc == 128) ? 0 : (jc < 128 ? jc : 256 - jc); const size_t base = ((size_t)b * 512 + g * 128 + j) * 256;
        const float2 w = GC[base + k], wm = GC[base + km];
        float o; if (jc == 0) o = 0.5f * (w.x + wm.x); else if (jc == 128) o = 0.5f * (w.y + wm.y); else if (jc < 128) o = wm.x; else o = w.x;
        MX[((size_t)b * TPB + k) * 3072 + 2048 + col] = (bf16)f2bf(o * 3.90625e-3f);
    }
}
__device__ __forceinline__ void ph_scan2_fast(const Frame& F, const Args& A) {
    const float2* SUMM = WSP(float2, WS_SUMM); float* CARRY = WSP(float, WS_CARRY);
    for (int it = F.gw; it < 256; it += F.NGW) {
        const int bd = it >> 6, d = bd & 1, ch = (it & 63) * 16 + (F.lane & 15), seg = F.lane >> 4;
        float2 v[33]; float as = 1.f, hs = 0.f;
#pragma unroll
        for (int q = 0; q < 33; ++q) { const int sidx = seg * 33 + q, ck = d ? (sidx < 4 ? 3 - sidx : NCHUNK + 3 - sidx) : sidx; v[q] = SUMM[((size_t)bd * NCHUNK + ck) * 1024 + ch]; }
#pragma unroll
        for (int q = 0; q < 33; ++q) { hs = v[q].x * hs + v[q].y; as *= v[q].x; }
        const float a16 = sx<16>(as), h16 = sx<16>(hs), a32 = sx<32>(as), h32 = sx<32>(hs), a48 = sx<32>(a16), h48 = sx<32>(h16);
        float h = 0.f;
#pragma unroll
        for (int jx = 0; jx < 3; ++jx) { const int x = jx ^ seg;
            const float aj = x == 0 ? as : (x == 1 ? a16 : (x == 2 ? a32 : a48)), hj = x == 0 ? hs : (x == 1 ? h16 : (x == 2 ? h32 : h48));
            if (jx < seg) h = aj * h + hj; }
#pragma unroll
        for (int q = 0; q < 33; ++q) { const int sidx = seg * 33 + q, ck = d ? (sidx < 4 ? 3 - sidx : NCHUNK + 3 - sidx) : sidx; CARRY[((size_t)bd * NCHUNK + ck) * 1024 + ch] = h; h = v[q].x * h + v[q].y; }
    }
}

__device__ __forceinline__ void ph_fft_t1(const Frame& F, const Args& A) {
    const unsigned* ZP = WSP(unsigned, WS_ZP); unsigned* XA = WSP(unsigned, WS_XA);
    for (long i = F.gtid; i < (long)NB * 512 * 8192; i += F.NT) {
        const int t1 = (int)(i & 127), t2 = (int)((i >> 7) & 63), cc = (int)((i >> 13) & 511), b = (int)(i >> 22);
        XA[i] = ZP[((size_t)b * TPB + CTX + 64 * t1 + t2) * 512 + cc];
    }
}
#if !FAST_FFT
__device__ __forceinline__ void ph_fft_a(const Frame& F, const Args& A) {
    const unsigned* XA = WSP(unsigned, WS_XA); unsigned* XB = WSP(unsigned, WS_XB);
    for (long i = F.gtid; i < (long)NB * 512 * 8192; i += F.NT) {
        const int k1 = (int)(i & 127); const long row = i >> 7; const int t2 = (int)(row & 63); const long bc = row >> 6;
        const unsigned* x = XA + row * 128; float yr = 0.f, yi = 0.f;
        for (int t1 = 0; t1 < 128; ++t1) { const unsigned w = x[t1]; const float wr = bf2f(w & 0xffffu), wi = bf2f(w >> 16);
            float sn, cs; sincospif((float)((k1 * t1) & 127) / 64.0f, &sn, &cs);
            yr += wr * cs + wi * sn; yi += wi * cs - wr * sn; }
        float sn, cs; sincospif((float)(k1 * t2) / 4096.0f, &sn, &cs);
        const float zr = yr * cs + yi * sn, zi = yi * cs - yr * sn;
        XB[(bc * 64 + (k1 >> 1)) * 128 + (k1 & 1) * 64 + t2] = pk2(zr, zi);
    }
}
#endif
#if !FAST_FFT
__device__ __forceinline__ void ph_fft_b(const Frame& F, const Args& A) {
    const unsigned* XB = WSP(unsigned, WS_XB); unsigned* GB = WSP(unsigned, WS_GB);
    for (long i = F.gtid; i < (long)NB * 512 * 8192; i += F.NT) {
        const int k2 = (int)(i & 63); const long hrow = i >> 6;
        const unsigned* x = XB + hrow * 64; float yr = 0.f, yi = 0.f;
        for (int t2 = 0; t2 < 64; ++t2) { const unsigned w = x[t2]; const float wr = bf2f(w & 0xffffu), wi = bf2f(w >> 16);
            float sn, cs; sincospif((float)((k2 * t2) & 63) / 32.0f, &sn, &cs);
            yr += wr * cs + wi * sn; yi += wi * cs - wr * sn; }
        GB[hrow * 64 + k2] = pk2(yr, yi);
    }
}
#endif
__device__ __forceinline__ void ph_fft_c(const Frame& F, const Args& A) {
    const unsigned* ZP = WSP(unsigned, WS_ZP); float2* GC = WSP(float2, WS_GC);
    LAS unsigned* Z = (LAS unsigned*)F.lds; LAS float* TWc = (LAS float*)(F.lds + 16384); LAS float* TWs = TWc + 256;
    __syncthreads();
    if (F.tid < 256) { const float rev = (float)F.tid * (1.f / 256.f); TWc[F.tid] = __builtin_amdgcn_cosf(rev); TWs[F.tid] = __builtin_amdgcn_sinf(rev); }
    for (int item = F.bid; item < 64; item += F.G) {
        const int b = item >> 5, c0 = (item & 31) * 16;
        __syncthreads();
        for (int e = F.tid; e < 4096; e += 512) Z[e] = ZP[((size_t)b * TPB + (e >> 4)) * 512 + c0 + (e & 15)];
        __syncthreads();
        const int cc = F.tid & 15, kb = (F.tid >> 4) * 8; float ar[8], ai[8]; int m[8];
#pragma unroll
        for (int q = 0; q < 8; ++q) { ar[q] = 0.f; ai[q] = 0.f; m[q] = 0; }
        for (int t = 0; t < 256; ++t) { const unsigned w = Z[t * 16 + cc]; const float wr = bf2f(w & 0xffffu), wi = bf2f(w >> 16);
#pragma unroll
            for (int q = 0; q < 8; ++q) { const float tc = TWc[m[q]], ts = TWs[m[q]]; ar[q] += wr * tc + wi * ts; ai[q] += wi * tc - wr * ts; m[q] = (m[q] + kb + q) & 255; } }
#pragma unroll
        for (int q = 0; q < 8; ++q) GC[((size_t)b * 512 + c0 + cc) * 256 + kb + q] = make_float2(ar[q], ai[q]);
    }
    __syncthreads();
}
__device__ __forceinline__ void ph_fft_t2(const Frame& F, const Args& A) {
    const unsigned* GB = WSP(unsigned, WS_GB); const float2* GC = WSP(float2, WS_GC); bf16* MX = WSP(bf16, WS_MIXIN);
    for (long i = F.gtid; i < (long)MROWS * 1024; i += F.NT) {
        const int R = (int)(i >> 10), col = (int)(i & 1023), g = col >> 8, jc = col & 255, b = R / TPB, p = R % TPB;
        const bool lat = p >= CTX; const int T = lat ? SEQ : CTX, k = lat ? p - CTX : p, km = (T - k) & (T - 1);
        const int j = (jc == 0 || jc == 128) ? 0 : (jc < 128 ? jc : 256 - jc); const int cc = g * 128 + j;
        float vr, vi, mr, mi;
        if (lat) { const size_t base = ((size_t)b * 512 + cc) * 64;
            const unsigned w = GB[(base + ((k & 127) >> 1)) * 128 + (k & 1) * 64 + (k >> 7)], wm = GB[(base + ((km & 127) >> 1)) * 128 + (km & 1) * 64 + (km >> 7)];
            vr = bf2f(w & 0xffffu); vi = bf2f(w >> 16); mr = bf2f(wm & 0xffffu); mi = bf2f(wm >> 16); }
        else { const float2 w = GC[((size_t)b * 512 + cc) * 256 + k], wm = GC[((size_t)b * 512 + cc) * 256 + km]; vr = w.x; vi = w.y; mr = wm.x; mi = wm.y; }
        float o;
        if (jc == 0) o = 0.5f * (vr + mr); else if (jc == 128) o = 0.5f * (vi + mi); else if (jc < 128) o = mr; else o = vr;
        o *= lat ? 6.9053396600248786e-4f : 3.90625e-3f;
        MX[(size_t)R * 3072 + 2048 + col] = (bf16)f2bf(o);
    }
}

#if !FAST_ATTN
__device__ __forceinline__ void ph_attn_naive(const Frame& F, const Args& A, int l) {
    const bf16 *Kb = WSP(bf16, WS_KB), *Vb = WSP(bf16, WS_VB), *Qb = WSP(bf16, WS_QB); bf16* MX = WSP(bf16, WS_MIXIN);
    const float* lq = A.in[10] + l * 256; float d01 = 0.f, d23 = 0.f;
    for (int i = 0; i < 64; ++i) { d01 += lq[i] * lq[64 + i]; d23 += lq[128 + i] * lq[192 + i]; }
    const float lam_init = 0.8f - 0.6f * expf(-0.3f * (float)l), lam = expf(d01) - expf(d23) + lam_init;
    LAS float* Ks = (LAS float*)F.lds; LAS float* Vs = Ks + 64 * 132; LAS float* Qs = Vs + 64 * 132; LAS float* Ws = Qs + 16 * 128;
    const int r = F.tid >> 5, tl = F.tid & 31;
    for (int u = F.bid; u < 16 * 528; u += F.G) {
        const int bh = u / 528, qb = u % 528, b = bh >> 3, h = bh & 7; const size_t R0 = (size_t)b * TPB + qb * 16; const int nkeys = qb < 16 ? CTX : TPB;
        __syncthreads();
        for (int e = F.tid; e < 2048; e += 512) Qs[e] = bf2f(Qb[(R0 + (e >> 7)) * 1024 + h * 128 + (e & 127)]);
        float m0 = -1e30f, l0 = 0.f, m1 = -1e30f, l1 = 0.f;
        for (int pass = 0; pass < 2; ++pass) {
            float inv0 = 0.f, inv1 = 0.f;
            if (pass == 1) {
#pragma unroll
                for (int o = 1; o < 32; o <<= 1) { float mo = __shfl_xor(m0, o), lo = __shfl_xor(l0, o), mn = fmaxf(m0, mo); l0 = l0 * exp2f(m0 - mn) + lo * exp2f(mo - mn); m0 = mn;
                    mo = __shfl_xor(m1, o); lo = __shfl_xor(l1, o); mn = fmaxf(m1, mo); l1 = l1 * exp2f(m1 - mn) + lo * exp2f(mo - mn); m1 = mn; }
                inv0 = 1.f / l0; inv1 = lam / l1;
            }
            float o4[4] = {0.f, 0.f, 0.f, 0.f};
            for (int kt = 0; kt < nkeys; kt += 64) {
                __syncthreads();
                for (int e = F.tid; e < 1024; e += 512) { const int kk = e >> 4, c8 = (e & 15) * 8; const size_t src = ((size_t)b * TPB + kt + kk) * 1024 + h * 128 + c8;
                    const v4u kv = *(const v4u*)(Kb + src);
                    Ks[kk * 132 + c8 + 0] = bf2f(kv.x & 0xffffu); Ks[kk * 132 + c8 + 1] = bf2f(kv.x >> 16); Ks[kk * 132 + c8 + 2] = bf2f(kv.y & 0xffffu); Ks[kk * 132 + c8 + 3] = bf2f(kv.y >> 16);
                    Ks[kk * 132 + c8 + 4] = bf2f(kv.z & 0xffffu); Ks[kk * 132 + c8 + 5] = bf2f(kv.z >> 16); Ks[kk * 132 + c8 + 6] = bf2f(kv.w & 0xffffu); Ks[kk * 132 + c8 + 7] = bf2f(kv.w >> 16);
                    if (pass == 1) { const v4u vv = *(const v4u*)(Vb + src);
                        Vs[kk * 132 + c8 + 0] = bf2f(vv.x & 0xffffu); Vs[kk * 132 + c8 + 1] = bf2f(vv.x >> 16); Vs[kk * 132 + c8 + 2] = bf2f(vv.y & 0xffffu); Vs[kk * 132 + c8 + 3] = bf2f(vv.y >> 16);
                        Vs[kk * 132 + c8 + 4] = bf2f(vv.z & 0xffffu); Vs[kk * 132 + c8 + 5] = bf2f(vv.z >> 16); Vs[kk * 132 + c8 + 6] = bf2f(vv.w & 0xffffu); Vs[kk * 132 + c8 + 7] = bf2f(vv.w >> 16); } }
                __syncthreads();
#pragma unroll
                for (int kq = 0; kq < 2; ++kq) { const int kk = tl + 32 * kq; float s0 = 0.f, s1 = 0.f;
                    for (int d = 0; d < 64; d += 4) { const f32x4 q0 = *(const LAS f32x4*)(Qs + r * 128 + d), q1 = *(const LAS f32x4*)(Qs + r * 128 + 64 + d), k0 = *(const LAS f32x4*)(Ks + kk * 132 + d), k1 = *(const LAS f32x4*)(Ks + kk * 132 + 64 + d);
                        s0 += q0.x * k0.x + q0.y * k0.y + q0.z * k0.z + q0.w * k0.w; s1 += q1.x * k1.x + q1.y * k1.y + q1.z * k1.z + q1.w * k1.w; }
                    if (pass == 0) { float mn = fmaxf(m0, s0); l0 = l0 * exp2f(m0 - mn) + exp2f(s0 - mn); m0 = mn; mn = fmaxf(m1, s1); l1 = l1 * exp2f(m1 - mn) + exp2f(s1 - mn); m1 = mn; }
                    else Ws[r * 64 + kk] = exp2f(s0 - m0) * inv0 - exp2f(s1 - m1) * inv1; }
                if (pass == 1) { __syncthreads();
                    for (int kk = 0; kk < 64; ++kk) { const float w = Ws[r * 64 + kk];
#pragma unroll
                        for (int i = 0; i < 4; ++i) o4[i] += w * Vs[kk * 132 + tl + 32 * i]; } }
            }
            if (pass == 1) { float ss = o4[0] * o4[0] + o4[1] * o4[1] + o4[2] * o4[2] + o4[3] * o4[3];
#pragma unroll
                for (int o = 1; o < 32; o <<= 1) ss += __shfl_xor(ss, o);
                const float sc = rsqrtf(ss * (1.f / 128.f) + EPS) * (1.f - lam_init);
#pragma unroll
                for (int i = 0; i < 4; ++i) MX[(R0 + r) * 3072 + h * 128 + tl + 32 * i] = (bf16)f2bf(o4[i] * sc * A.in[11][l * 128 + tl + 32 * i]); }
        }
    }
}

#endif
namespace da {
using bf16x8 = __attribute__((ext_vector_type(8))) short;
using s16x4  = __attribute__((ext_vector_type(4))) short;
using f32x16 = __attribute__((ext_vector_type(16))) float;
using u32x4  = __attribute__((ext_vector_type(4))) unsigned;
constexpr int KVBLK = 64, LDK = 1024;
constexpr size_t SHM_V = KVBLK * 128 * 2, SHM_K = KVBLK * 128 * 2;
constexpr float THR = 8.f;
#define DA_KSWZ(row, colB) ((row) * 256 + ((colB) ^ (((row) & 7) << 4)))
#define DA_SBAR() __builtin_amdgcn_sched_barrier(0)
__device__ __forceinline__ int crow(int r, int hi) { return (r & 3) + 8 * (r >> 2) + 4 * hi; }
__device__ __forceinline__ unsigned cvtpk(float lo, float hi) { unsigned r; asm volatile("v_cvt_pk_bf16_f32 %0, %1, %2" : "=v"(r) : "v"(lo), "v"(hi)); return r; }
__device__ __forceinline__ void expSM(f32x16& p0, f32x16& p1, float soff) {
  for (int r = 0; r < 16; ++r) p0[r] = __builtin_amdgcn_exp2f(p0[r] - soff); for (int r = 0; r < 16; ++r) p1[r] = __builtin_amdgcn_exp2f(p1[r] - soff);
}
__device__ __forceinline__ void finishSM(f32x16& p0, f32x16& p1, float& l_reg, bf16x8& pa0, bf16x8& pa1, bf16x8& pa2, bf16x8& pa3) {
  float ps = 0; for (int r = 0; r < 16; ++r) ps += p0[r]; for (int r = 0; r < 16; ++r) ps += p1[r];
  l_reg += ps;
#define DA_PK4(P, BASE, OUT) do { unsigned a0 = cvtpk(P[BASE + 0], P[BASE + 1]), a1 = cvtpk(P[BASE + 2], P[BASE + 3]);   \
    unsigned b0 = cvtpk(P[BASE + 4], P[BASE + 5]), b1 = cvtpk(P[BASE + 6], P[BASE + 7]);                              \
    auto r0 = __builtin_amdgcn_permlane32_swap(a0, b0, false, false); auto r1 = __builtin_amdgcn_permlane32_swap(a1, b1, false, false); \
    u32x4 w = {r0[0], r1[0], r0[1], r1[1]}; OUT = *reinterpret_cast<bf16x8*>(&w); } while (0)
  DA_PK4(p0, 0, pa0); DA_PK4(p0, 8, pa1); DA_PK4(p1, 0, pa2); DA_PK4(p1, 8, pa3);
#undef DA_PK4
}
__device__ __forceinline__ void qkt(f32x16& p0, f32x16& p1, const char* Ks, const bf16x8* qr, int r32, int hi, int cbm) {
  p0 = f32x16{}; p1 = f32x16{};
#pragma unroll
  for (int d0 = 0; d0 < 4; ++d0) { const int cb = cbm + (d0 * 16 + hi * 8) * 2;
    bf16x8 b0 = *reinterpret_cast<const bf16x8*>(Ks + DA_KSWZ(r32, cb));
    bf16x8 b1 = *reinterpret_cast<const bf16x8*>(Ks + DA_KSWZ(32 + r32, cb));
    p0 = __builtin_amdgcn_mfma_f32_32x32x16_bf16(b0, qr[d0], p0, 0, 0, 0);
    p1 = __builtin_amdgcn_mfma_f32_32x32x16_bf16(b1, qr[d0], p1, 0, 0, 0); }
}
__device__ __forceinline__ int v_st(int k, int c) { const int kk = (k & ~0xC) | ((k & 4) << 1) | ((k & 8) >> 1); return ((kk >> 3) * 4 + (c >> 5)) * 512 + ((kk & 7) * 32 + (c & 31)) * 2; }
__device__ __forceinline__ int v_rd_base(int lane) { return ((lane & 3) << 3) | (((lane >> 2) & 3) << 6) | (((lane >> 4) & 1) << 5) | (((lane >> 5) & 1) << 8); }
constexpr int v_rd_off(int d0, int ks, int half) { return d0 * 512 + ks * 4096 + half * 2048; }
template <int OFF> __device__ __forceinline__ s16x4 tr_read(int vb) {
  s16x4 r; asm volatile("ds_read_b64_tr_b16 %0, %1 offset:%2" : "=&v"(r) : "v"(vb), "i"(OFF) : "memory"); return r;
}
template <int D0> __device__ __forceinline__ void pv_one(f32x16& od, int vb, bf16x8 pa0, bf16x8 pa1, bf16x8 pa2, bf16x8 pa3) {
  const s16x4 l0 = tr_read<v_rd_off(D0, 0, 0)>(vb), h0 = tr_read<v_rd_off(D0, 0, 1)>(vb), l1 = tr_read<v_rd_off(D0, 1, 0)>(vb), h1 = tr_read<v_rd_off(D0, 1, 1)>(vb);
  const s16x4 l2 = tr_read<v_rd_off(D0, 2, 0)>(vb), h2 = tr_read<v_rd_off(D0, 2, 1)>(vb), l3 = tr_read<v_rd_off(D0, 3, 0)>(vb), h3 = tr_read<v_rd_off(D0, 3, 1)>(vb);
  asm volatile("s_waitcnt lgkmcnt(0)" ::: "memory"); DA_SBAR();
#define DA_PK(L, H) (bf16x8){L[0], L[1], L[2], L[3], H[0], H[1], H[2], H[3]}
  od = __builtin_amdgcn_mfma_f32_32x32x16_bf16(pa0, DA_PK(l0, h0), od, 0, 0, 0);
  od = __builtin_amdgcn_mfma_f32_32x32x16_bf16(pa1, DA_PK(l1, h1), od, 0, 0, 0);
  od = __builtin_amdgcn_mfma_f32_32x32x16_bf16(pa2, DA_PK(l2, h2), od, 0, 0, 0);
  od = __builtin_amdgcn_mfma_f32_32x32x16_bf16(pa3, DA_PK(l3, h3), od, 0, 0, 0);
#undef DA_PK
}
__device__ __forceinline__ void pv_d0(f32x16* o, int vb, bf16x8 pa0, bf16x8 pa1, bf16x8 pa2, bf16x8 pa3) {
  pv_one<0>(o[0], vb, pa0, pa1, pa2, pa3); pv_one<1>(o[1], vb, pa0, pa1, pa2, pa3); pv_one<2>(o[2], vb, pa0, pa1, pa2, pa3); pv_one<3>(o[3], vb, pa0, pa1, pa2, pa3);
}
__device__ __forceinline__ void unit(const unsigned short* __restrict__ Qb, const unsigned short* __restrict__ Kh, const unsigned short* __restrict__ Vh,
                                     unsigned short* __restrict__ Ob, int ldo, int seq, float lam, float oscale, float soff, const float* __restrict__ subg, char* lds) {
  const int tid = otid(), wid = tid >> 6, lane = tid & 63, r32 = lane & 31, hi = lane >> 5, mp = wid >> 2, wq = wid & 3;
  char* V_lds = lds; char* K_lds = lds + 2 * SHM_V;
  float* ws = (float*)(lds + 2 * SHM_V + 2 * SHM_K) + wid * 64; float* li_l = ws;
  float l_reg = 0; f32x16 o[4] = {}; bf16x8 qr[4];
  const unsigned short* Qw = Qb + (long)(wq * 32 + r32) * 1024 + mp * 64 + hi * 8;
#pragma unroll
  for (int d0 = 0; d0 < 4; ++d0) qr[d0] = *reinterpret_cast<const bf16x8*>(Qw + d0 * 16);
  const int cbm = mp * 128;
  const int sr = tid >> 4, sc = (tid & 15) * 8, vst0 = v_st(sr, sc), vst1 = v_st(32 + sr, sc);
  const int vb0 = (int)(uintptr_t)V_lds + v_rd_base(lane);
  struct { bf16x8 vs0, vs1, ks0, ks1; } sr_[2];
#define DA_SLOAD(i, k0) do { sr_[i].vs0 = *reinterpret_cast<const bf16x8*>(&Vh[(long)((k0) + sr) * LDK + sc]); sr_[i].vs1 = *reinterpret_cast<const bf16x8*>(&Vh[(long)((k0) + 32 + sr) * LDK + sc]); \
    sr_[i].ks0 = *reinterpret_cast<const bf16x8*>(&Kh[(long)((k0) + sr) * LDK + sc]); sr_[i].ks1 = *reinterpret_cast<const bf16x8*>(&Kh[(long)((k0) + 32 + sr) * LDK + sc]); } while (0)
#define DA_SWRITE(b, i) do { *(bf16x8*)(V_lds + (b) * SHM_V + vst0) = sr_[i].vs0;          \
    *(bf16x8*)(V_lds + (b) * SHM_V + vst1) = sr_[i].vs1; int kc = sc * 2;               \
    *(bf16x8*)(K_lds + (b) * SHM_K + DA_KSWZ(sr, kc)) = sr_[i].ks0;                       \
    *(bf16x8*)(K_lds + (b) * SHM_K + DA_KSWZ(32 + sr, kc)) = sr_[i].ks1; } while (0)
#define DA_SWAIT() asm volatile("s_waitcnt vmcnt(4)" ::: "memory")
  f32x16 pA0, pA1, pB0, pB1; bf16x8 pa0, pa1, pa2, pa3; const int NT = seq / KVBLK;
  constexpr int SE = 0, SO = 1;
  DA_SLOAD(SE, 0); asm volatile("s_waitcnt vmcnt(0)" ::: "memory"); DA_SWRITE(0, SE); __syncthreads();
  qkt(pA0, pA1, K_lds, qr, r32, hi, cbm); expSM(pA0, pA1, soff);
  DA_SLOAD(SO, KVBLK); if (2 < NT) DA_SLOAD(SE, 2 * KVBLK);
  DA_SWAIT(); DA_SWRITE(1, SO); __syncthreads();
  for (int j = 1; j + 1 < NT; j += 2) {
    DA_SBAR(); qkt(pB0, pB1, K_lds + SHM_K, qr, r32, hi, cbm);
    finishSM(pA0, pA1, l_reg, pa0, pa1, pa2, pa3); DA_SBAR();
    DA_SLOAD(SO, (j + 2) * KVBLK); DA_SBAR();
    pv_d0(o, vb0, pa0, pa1, pa2, pa3); expSM(pB0, pB1, soff);
    __syncthreads(); DA_SWAIT(); DA_SWRITE(0, SE);
    __syncthreads();
    DA_SBAR(); qkt(pA0, pA1, K_lds, qr, r32, hi, cbm);
    finishSM(pB0, pB1, l_reg, pa0, pa1, pa2, pa3); DA_SBAR();
    if (j + 3 < NT) DA_SLOAD(SE, (j + 3) * KVBLK); DA_SBAR();
    pv_d0(o, vb0 + (int)SHM_V, pa0, pa1, pa2, pa3); expSM(pA0, pA1, soff);
    __syncthreads(); DA_SWAIT(); DA_SWRITE(1, SO);
    __syncthreads();
  }
  DA_SBAR(); qkt(pB0, pB1, K_lds + SHM_K, qr, r32, hi, cbm);
  finishSM(pA0, pA1, l_reg, pa0, pa1, pa2, pa3); DA_SBAR();
  pv_d0(o, vb0, pa0, pa1, pa2, pa3); expSM(pB0, pB1, soff);
  __syncthreads();
  finishSM(pB0, pB1, l_reg, pa0, pa1, pa2, pa3); DA_SBAR();
  pv_d0(o, vb0 + (int)SHM_V, pa0, pa1, pa2, pa3);
  { auto rr = __builtin_amdgcn_permlane32_swap(__float_as_uint(l_reg), __float_as_uint(l_reg), false, false); l_reg = __uint_as_float(rr[0]) + __uint_as_float(rr[1]); }
  if (hi == 0) li_l[r32] = l_reg; asm volatile("s_waitcnt lgkmcnt(0)" ::: "memory");
  const float sgn = mp ? lam : 1.f;
#pragma unroll
  for (int r = 0; r < 16; ++r) { const float rl = sgn * __builtin_amdgcn_rcpf(li_l[crow(r, hi)]);
#pragma unroll
    for (int d0 = 0; d0 < 4; ++d0) o[d0][r] *= rl; }
  __syncthreads();
  int xb = wq * 4096 + lane; asm volatile("" : "+v"(xb));
  float* X = (float*)lds + xb;
  if (mp == 1) {
#pragma unroll
    for (int d0 = 0; d0 < 4; ++d0)
#pragma unroll
      for (int r = 0; r < 16; ++r) X[(d0 * 16 + r) * 64] = o[d0][r];
  }
  __syncthreads();
  if (mp == 0) {
    float gg[4];
#pragma unroll
    for (int d0 = 0; d0 < 4; ++d0) gg[d0] = subg[d0 * 32 + r32] * oscale;
    int ob = (wq * 32 + 4 * hi) * ldo + r32; asm volatile("" : "+v"(ob));
    unsigned short* Ow = Ob + ob;
#pragma unroll
    for (int r = 0; r < 16; ++r) { float a = 0.f; float v[4];
#pragma unroll
      for (int d0 = 0; d0 < 4; ++d0) { v[d0] = o[d0][r] - X[(d0 * 16 + r) * 64]; a += v[d0] * v[d0]; }
      a += sx<1>(a); a += sx<2>(a); a += sx<4>(a); a += sx<8>(a); a += sx<16>(a);
      a = rsqrtf(a * (1.f / 128.f) + EPS);
      const int orow = (r & 3) + 8 * (r >> 2);
#pragma unroll
      for (int d0 = 0; d0 < 4; ++d0) Ow[orow * ldo + d0 * 32] = (unsigned short)f2bf(v[d0] * a * gg[d0]); }
  }
  __syncthreads();
#undef DA_SLOAD
#undef DA_SWRITE
#undef DA_SWAIT
}

template <int D0> __device__ __forceinline__ void v_rd8(s16x4 (&f)[8], int vb) {
  f[0] = tr_read<v_rd_off(D0, 0, 0)>(vb); f[1] = tr_read<v_rd_off(D0, 0, 1)>(vb); f[2] = tr_read<v_rd_off(D0, 1, 0)>(vb); f[3] = tr_read<v_rd_off(D0, 1, 1)>(vb);
  f[4] = tr_read<v_rd_off(D0, 2, 0)>(vb); f[5] = tr_read<v_rd_off(D0, 2, 1)>(vb); f[6] = tr_read<v_rd_off(D0, 3, 0)>(vb); f[7] = tr_read<v_rd_off(D0, 3, 1)>(vb);
}
__device__ __forceinline__ void pv_mm(f32x16& od, const s16x4 (&f)[8], bf16x8 pa0, bf16x8 pa1, bf16x8 pa2, bf16x8 pa3) {
#define DA_PK(L, H) (bf16x8){L[0], L[1], L[2], L[3], H[0], H[1], H[2], H[3]}
  od = __builtin_amdgcn_mfma_f32_32x32x16_bf16(pa0, DA_PK(f[0], f[1]), od, 0, 0, 0);
  od = __builtin_amdgcn_mfma_f32_32x32x16_bf16(pa1, DA_PK(f[2], f[3]), od, 0, 0, 0);
  od = __builtin_amdgcn_mfma_f32_32x32x16_bf16(pa2, DA_PK(f[4], f[5]), od, 0, 0, 0);
  od = __builtin_amdgcn_mfma_f32_32x32x16_bf16(pa3, DA_PK(f[6], f[7]), od, 0, 0, 0);
#undef DA_PK
}
__device__ __forceinline__ void pv_pipe(f32x16* o, int vb, bf16x8 pa0, bf16x8 pa1, bf16x8 pa2, bf16x8 pa3) {
  s16x4 fa[8], fb[8];
  v_rd8<0>(fa, vb); v_rd8<1>(fb, vb);
  asm volatile("s_waitcnt lgkmcnt(8)" ::: "memory"); DA_SBAR(); pv_mm(o[0], fa, pa0, pa1, pa2, pa3); DA_SBAR();
  v_rd8<2>(fa, vb);
  asm volatile("s_waitcnt lgkmcnt(8)" ::: "memory"); DA_SBAR(); pv_mm(o[1], fb, pa0, pa1, pa2, pa3); DA_SBAR();
  v_rd8<3>(fb, vb);
  asm volatile("s_waitcnt lgkmcnt(8)" ::: "memory"); DA_SBAR(); pv_mm(o[2], fa, pa0, pa1, pa2, pa3); DA_SBAR();
  asm volatile("s_waitcnt lgkmcnt(0)" ::: "memory"); DA_SBAR(); pv_mm(o[3], fb, pa0, pa1, pa2, pa3); DA_SBAR();
}
__device__ __forceinline__ void unit8(const unsigned short* __restrict__ Qb, const unsigned short* __restrict__ Kh, const unsigned short* __restrict__ Vh,
                                      unsigned short* __restrict__ Ob, int ldo, int seq, float lam, float oscale, float soff, const float* __restrict__ subg, LAS unsigned char* ldsl) {
  const int tid = otid(), wid = __builtin_amdgcn_readfirstlane(tid >> 6), lane = tid & 63, r32 = lane & 31, hi = lane >> 5, mp = wid >> 2, wq = wid & 3;
  constexpr int SLOT = 16384;
  char* lds = (char*)ldsl; char* K_lds = lds; const int vbase = (int)(uintptr_t)(lds + 3 * SLOT) + v_rd_base(lane);
  float* li_l = (float*)(lds + 6 * SLOT) + wid * 64;
  f32x16 o[4] = {}; bf16x8 qr[4];
  const unsigned short* Qw = Qb + (long)(wq * 32 + r32) * 1024 + mp * 64 + hi * 8;
#pragma unroll
  for (int d0 = 0; d0 < 4; ++d0) qr[d0] = *reinterpret_cast<const bf16x8*>(Qw + d0 * 16);
  asm volatile("s_waitcnt vmcnt(0)" ::: "memory");
  const int cbm = mp * 128;
  const unsigned wl = (unsigned)wid * 1024u;
  unsigned kso[2], vso[2];
#pragma unroll
  for (int i = 0; i < 2; ++i) { const int P = (i * 8 + wid) * 64 + lane;
    { const int row = P >> 4, chunk = (P & 15) ^ (row & 7); kso[i] = (unsigned)(row * LDK + chunk * 8) * 2u; }
    { const int sub = P >> 5, kk = (sub >> 2) * 8 + ((P & 31) >> 2), key = (kk & ~0xC) | ((kk & 4) << 1) | ((kk & 8) >> 1); vso[i] = (unsigned)(key * LDK + (sub & 3) * 32 + (P & 3) * 8) * 2u; } }
#define DA_DMA_K(t, slot) do { const unsigned to_ = (unsigned)(t) * (unsigned)(KVBLK * LDK * 2); _Pragma("unroll") for (int i_ = 0; i_ < 2; ++i_) \
      __builtin_amdgcn_global_load_lds((const unsigned*)((const char*)Kh + (kso[i_] + to_)), (LAS unsigned*)(ldsl + (slot) * SLOT + i_ * 8192 + wl), 16, 0, 0); } while (0)
#define DA_DMA_V(t, slot) do { const unsigned to_ = (unsigned)(t) * (unsigned)(KVBLK * LDK * 2); _Pragma("unroll") for (int i_ = 0; i_ < 2; ++i_) \
      __builtin_amdgcn_global_load_lds((const unsigned*)((const char*)Vh + (vso[i_] + to_)), (LAS unsigned*)(ldsl + (3 + (slot)) * SLOT + i_ * 8192 + wl), 16, 0, 0); } while (0)
#define U8_PK(t, slot, i_) __builtin_amdgcn_global_load_lds((const unsigned*)((const char*)Kh + (kso[i_] + (unsigned)(t) * (unsigned)(KVBLK * LDK * 2))), (LAS unsigned*)(ldsl + (slot) * SLOT + (i_) * 8192 + wl), 16, 0, 0)
#define U8_PV(t, slot, i_) __builtin_amdgcn_global_load_lds((const unsigned*)((const char*)Vh + (vso[i_] + (unsigned)(t) * (unsigned)(KVBLK * LDK * 2))), (LAS unsigned*)(ldsl + (3 + (slot)) * SLOT + (i_) * 8192 + wl), 16, 0, 0)
#define DA_WAITBAR(N) do { asm volatile("s_waitcnt vmcnt(" #N ") lgkmcnt(0)" ::: "memory"); __builtin_amdgcn_s_barrier(); asm volatile("" ::: "memory"); } while (0)
  f32x16 pA0, pA1, pB0, pB1; u32x4 pw0, pw1, pw2, pw3; const int NT = seq / KVBLK;
  bf16x8 kf[8];
  f32x16 negm, ol = {};
#pragma unroll
  for (int r = 0; r < 16; ++r) negm[r] = -soff;
  const bf16x8 ones = {0x3F80, 0x3F80, 0x3F80, 0x3F80, 0x3F80, 0x3F80, 0x3F80, 0x3F80};
  const int pkr = ((r32 & 3) + 4 * (r32 >> 3)), pk = (pkr & 7) + 16 * (pkr >> 3) + 8 * ((r32 >> 2) & 1);
#define U5_KADDR(d0) ((int)(uintptr_t)K_lds + pk * 256 + ((((cbm >> 4) + 2 * (d0) + hi) ^ (pk & 7)) * 16))
#define U5_KLOAD(slot) do { const int so_ = (slot) * SLOT; _Pragma("unroll") for (int d0 = 0; d0 < 4; ++d0) { const int ad_ = U5_KADDR(d0) + so_; \
    asm volatile("ds_read_b128 %0, %2\n\tds_read_b128 %1, %2 offset:8192" : "=&v"(kf[2 * d0]), "=&v"(kf[2 * d0 + 1]) : "v"(ad_) : "memory"); } } while (0)
#define U5_PIN(x) asm volatile("" : "+v"(x))
#define U5_EX(v) __builtin_amdgcn_exp2f(v)
#define U5_VRD(L, H, m) do { asm volatile("ds_read_b64_tr_b16 %0, %1 offset:%2" : "=&v"(L) : "v"(vb_), "i"(v_rd_off((m) >> 2, (m) & 3, 0)) : "memory"); \
    asm volatile("ds_read_b64_tr_b16 %0, %1 offset:%2" : "=&v"(H) : "v"(vb_), "i"(v_rd_off((m) >> 2, (m) & 3, 1)) : "memory"); } while (0)
#define U5_GAPA(MF, X, B4, PW, VR, CV0, CV1) do { MF; VR; CV0; CV1; U5_PIN(PW); DA_SBAR(); } while (0)
#define U5_CVT(P, b) cvtpk(P[b], P[b + 1])
#define U5_PHASE_A(C0, C1, P0, P1, VSLOT, HK0, HK1, HV0, HV1) do { const int vb_ = vbase + (VSLOT) * SLOT; \
    U5_GAPA(C0 = __builtin_amdgcn_mfma_f32_32x32x16_bf16(kf[0], qr[0], negm, 0, 0, 0), P0, 0, pw0, HK0, pw0[0] = U5_CVT(P0, 0), pw0[1] = U5_CVT(P0, 2)); \
    U5_GAPA(C1 = __builtin_amdgcn_mfma_f32_32x32x16_bf16(kf[1], qr[0], negm, 0, 0, 0), P0, 4, pw0, HK1, pw0[2] = U5_CVT(P0, 4), pw0[3] = U5_CVT(P0, 6)); \
    U5_GAPA(C0 = __builtin_amdgcn_mfma_f32_32x32x16_bf16(kf[2], qr[1], C0, 0, 0, 0), P0, 8, pw1, do { HV0; HV1; } while (0), pw1[0] = U5_CVT(P0, 8), pw1[1] = U5_CVT(P0, 10)); \
    U5_GAPA(C1 = __builtin_amdgcn_mfma_f32_32x32x16_bf16(kf[3], qr[1], C1, 0, 0, 0), P0, 12, pw1, U5_VRD(vl0, vh0, 0), pw1[2] = U5_CVT(P0, 12), pw1[3] = U5_CVT(P0, 14)); \
    U5_GAPA(C0 = __builtin_amdgcn_mfma_f32_32x32x16_bf16(kf[4], qr[2], C0, 0, 0, 0), P1, 0, pw2, U5_VRD(vl1, vh1, 1), pw2[0] = U5_CVT(P1, 0), pw2[1] = U5_CVT(P1, 2)); \
    U5_GAPA(C1 = __builtin_amdgcn_mfma_f32_32x32x16_bf16(kf[5], qr[2], C1, 0, 0, 0), P1, 4, pw2, U5_VRD(vl2, vh2, 2), pw2[2] = U5_CVT(P1, 4), pw2[3] = U5_CVT(P1, 6)); \
    U5_GAPA(C0 = __builtin_amdgcn_mfma_f32_32x32x16_bf16(kf[6], qr[3], C0, 0, 0, 0), P1, 8, pw3, U5_VRD(vl3, vh3, 3), pw3[0] = U5_CVT(P1, 8), pw3[1] = U5_CVT(P1, 10)); \
    U5_GAPA(C1 = __builtin_amdgcn_mfma_f32_32x32x16_bf16(kf[7], qr[3], C1, 0, 0, 0), P1, 12, pw3, U5_VRD(vl4, vh4, 4), pw3[2] = U5_CVT(P1, 12), pw3[3] = U5_CVT(P1, 14)); \
    } while (0)
#define U5_PKV(L, H) (bf16x8){L[0], L[1], L[2], L[3], H[0], H[1], H[2], H[3]}
#define U5_PAF(k) __builtin_bit_cast(bf16x8, pw##k)
#define U5_GAPB(WAITN, OD, PK, L, H, X, B2, NEXT) do { asm volatile("s_waitcnt lgkmcnt(" #WAITN ")" ::: "memory"); DA_SBAR(); \
    OD = __builtin_amdgcn_mfma_f32_32x32x16_bf16(PK, U5_PKV(L, H), OD, 0, 0, 0); NEXT; X[B2] = U5_EX(X[B2]); X[B2 + 1] = U5_EX(X[B2 + 1]); U5_PIN(X); DA_SBAR(); } while (0)
#define U5_GAPS(PK, X, B2) do { ol = __builtin_amdgcn_mfma_f32_32x32x16_bf16(PK, ones, ol, 0, 0, 0); X[B2] = U5_EX(X[B2]); X[B2 + 1] = U5_EX(X[B2 + 1]); U5_PIN(X); DA_SBAR(); } while (0)
#define U5_GAPN(WAITN, OD, PK, L, H, NEXT) do { asm volatile("s_waitcnt lgkmcnt(" #WAITN ")" ::: "memory"); DA_SBAR(); \
    OD = __builtin_amdgcn_mfma_f32_32x32x16_bf16(PK, U5_PKV(L, H), OD, 0, 0, 0); NEXT; DA_SBAR(); } while (0)
#define U5_PHASE_B(C0, C1, VSLOT, KSLOT, DOK) do { const int vb_ = vbase + (VSLOT) * SLOT; \
    U5_GAPS(U5_PAF(0), C0, 0); U5_GAPS(U5_PAF(1), C0, 2); U5_GAPS(U5_PAF(2), C0, 4); U5_GAPS(U5_PAF(3), C0, 6); \
    U5_GAPB(8, o[0], U5_PAF(0), vl0, vh0, C0, 8, U5_VRD(vl5, vh5, 5)); \
    U5_GAPB(8, o[0], U5_PAF(1), vl1, vh1, C0, 10, U5_VRD(vl0, vh0, 6)); \
    U5_GAPB(8, o[0], U5_PAF(2), vl2, vh2, C0, 12, U5_VRD(vl1, vh1, 7)); \
    U5_GAPB(8, o[0], U5_PAF(3), vl3, vh3, C0, 14, U5_VRD(vl2, vh2, 8)); \
    U5_GAPB(8, o[1], U5_PAF(0), vl4, vh4, C1, 0, U5_VRD(vl3, vh3, 9)); \
    U5_GAPB(8, o[1], U5_PAF(1), vl5, vh5, C1, 2, U5_VRD(vl4, vh4, 10)); \
    U5_GAPB(8, o[1], U5_PAF(2), vl0, vh0, C1, 4, U5_VRD(vl5, vh5, 11)); \
    U5_GAPB(8, o[1], U5_PAF(3), vl1, vh1, C1, 6, U5_VRD(vl0, vh0, 12)); \
    U5_GAPB(8, o[2], U5_PAF(0), vl2, vh2, C1, 8, U5_VRD(vl1, vh1, 13)); \
    U5_GAPB(8, o[2], U5_PAF(1), vl3, vh3, C1, 10, U5_VRD(vl2, vh2, 14)); \
    U5_GAPB(8, o[2], U5_PAF(2), vl4, vh4, C1, 12, U5_VRD(vl3, vh3, 15)); \
    U5_GAPB(8, o[2], U5_PAF(3), vl5, vh5, C1, 14, (void)0); \
    U5_GAPN(6, o[3], U5_PAF(0), vl0, vh0, (void)0); \
    if (DOK) { U5_GAPN(4, o[3], U5_PAF(1), vl1, vh1, U5_KLOAD(KSLOT)); U5_GAPN(10, o[3], U5_PAF(2), vl2, vh2, (void)0); U5_GAPN(8, o[3], U5_PAF(3), vl3, vh3, (void)0); } \
    else { U5_GAPN(4, o[3], U5_PAF(1), vl1, vh1, (void)0); U5_GAPN(2, o[3], U5_PAF(2), vl2, vh2, (void)0); U5_GAPN(0, o[3], U5_PAF(3), vl3, vh3, (void)0); } } while (0)
#define DA_ROT(x) ((x) == 2 ? 0 : (x) + 1)
#define DA_PRV(x) ((x) == 0 ? 2 : (x) - 1)
  s16x4 vl0, vh0, vl1, vh1, vl2, vh2, vl3, vh3, vl4, vh4, vl5, vh5;
  DA_DMA_K(0, 0); DA_DMA_K(1, 1); DA_DMA_V(0, 0);
  DA_WAITBAR(0);
  U5_KLOAD(0); DA_DMA_K(2, 2); DA_DMA_V(1, 1);
  DA_WAITBAR(4);
  DA_DMA_K(3, 0);
  DA_SBAR();
  pA0 = negm; pA1 = negm;
#pragma unroll
  for (int d0 = 0; d0 < 4; ++d0) { pA0 = __builtin_amdgcn_mfma_f32_32x32x16_bf16(kf[2 * d0], qr[d0], pA0, 0, 0, 0); pA1 = __builtin_amdgcn_mfma_f32_32x32x16_bf16(kf[2 * d0 + 1], qr[d0], pA1, 0, 0, 0); }
  DA_SBAR(); U5_KLOAD(1);
  expSM(pA0, pA1, 0.f);
  DA_WAITBAR(2);
  int c = 1;
  for (int j = 1; j + 1 < NT; j += 2) {
    { const bool mk = j + 3 < NT;
      DA_SBAR(); U5_PHASE_A(pB0, pB1, pA0, pA1, DA_PRV(c), if (mk) U8_PK(j + 3, c, 0), if (mk) U8_PK(j + 3, c, 1), U8_PV(j + 1, DA_ROT(c), 0), U8_PV(j + 1, DA_ROT(c), 1));
      U5_PHASE_B(pB0, pB1, DA_PRV(c), DA_ROT(c), true);
      if (mk) DA_WAITBAR(4); else DA_WAITBAR(2);
      c = DA_ROT(c); }
    { const bool mk = j + 4 < NT;
      DA_SBAR(); U5_PHASE_A(pA0, pA1, pB0, pB1, DA_PRV(c), if (mk) U8_PK(j + 4, c, 0), if (mk) U8_PK(j + 4, c, 1), U8_PV(j + 2, DA_ROT(c), 0), U8_PV(j + 2, DA_ROT(c), 1));
      U5_PHASE_B(pA0, pA1, DA_PRV(c), DA_ROT(c), true);
      if (mk) DA_WAITBAR(4); else DA_WAITBAR(2);
      c = DA_ROT(c); }
  }
  DA_SBAR(); U5_PHASE_A(pB0, pB1, pA0, pA1, DA_PRV(c), (void)0, (void)0, (void)0, (void)0);
  U5_PHASE_B(pB0, pB1, DA_PRV(c), 0, false);
  DA_WAITBAR(0);
  { u32x4 w0 = {cvtpk(pB0[0], pB0[1]), cvtpk(pB0[2], pB0[3]), cvtpk(pB0[4], pB0[5]), cvtpk(pB0[6], pB0[7])}, w1 = {cvtpk(pB0[8], pB0[9]), cvtpk(pB0[10], pB0[11]), cvtpk(pB0[12], pB0[13]), cvtpk(pB0[14], pB0[15])};
    u32x4 w2 = {cvtpk(pB1[0], pB1[1]), cvtpk(pB1[2], pB1[3]), cvtpk(pB1[4], pB1[5]), cvtpk(pB1[6], pB1[7])}, w3 = {cvtpk(pB1[8], pB1[9]), cvtpk(pB1[10], pB1[11]), cvtpk(pB1[12], pB1[13]), cvtpk(pB1[14], pB1[15])};
    const bf16x8 pa0 = __builtin_bit_cast(bf16x8, w0), pa1 = __builtin_bit_cast(bf16x8, w1), pa2 = __builtin_bit_cast(bf16x8, w2), pa3 = __builtin_bit_cast(bf16x8, w3); DA_SBAR();
    ol = __builtin_amdgcn_mfma_f32_32x32x16_bf16(pa0, ones, ol, 0, 0, 0); ol = __builtin_amdgcn_mfma_f32_32x32x16_bf16(pa1, ones, ol, 0, 0, 0);
    ol = __builtin_amdgcn_mfma_f32_32x32x16_bf16(pa2, ones, ol, 0, 0, 0); ol = __builtin_amdgcn_mfma_f32_32x32x16_bf16(pa3, ones, ol, 0, 0, 0);
    pv_d0(o, vbase + c * SLOT, pa0, pa1, pa2, pa3); }
#undef U5_KADDR
#undef U5_KLOAD
#undef U5_PIN
#undef U5_EX
#undef U5_GAPA
#undef U5_CVT
#undef U5_PHASE_A
#undef U5_VRD
#undef U5_PKV
#undef U5_PAF
#undef U5_GAPB
#undef U5_GAPS
#undef U5_GAPN
#undef U5_PHASE_B
  const int tid2 = otid(), wid2 = __builtin_amdgcn_readfirstlane(tid2 >> 6), lane2 = tid2 & 63; { const int r32 = lane2 & 31, hi = lane2 >> 5, mp = wid2 >> 2, wq = wid2 & 3, lane = lane2; float* li_l = (float*)(lds + 6 * SLOT) + wid2 * 64;
  const float sgn = mp ? lam : 1.f;
#pragma unroll
  for (int r = 0; r < 16; ++r) { const float rl = sgn * __builtin_amdgcn_rcpf(ol[r]);
#pragma unroll
    for (int d0 = 0; d0 < 4; ++d0) o[d0][r] *= rl; }
  __syncthreads();
  int xb = wq * 4096 + lane; asm volatile("" : "+v"(xb));
  float* X = (float*)lds + xb;
  if (mp == 1) {
#pragma unroll
    for (int d0 = 0; d0 < 4; ++d0)
#pragma unroll
      for (int r = 0; r < 16; ++r) X[(d0 * 16 + r) * 64] = o[d0][r];
  }
  __syncthreads();
  if (mp == 0) {
    float gg[4];
#pragma unroll
    for (int d0 = 0; d0 < 4; ++d0) gg[d0] = subg[d0 * 32 + r32] * oscale;
    int ob = (wq * 32 + 4 * hi) * ldo + r32; asm volatile("" : "+v"(ob));
    unsigned short* Ow = Ob + ob;
#pragma unroll
    for (int r = 0; r < 16; ++r) { float a = 0.f; float v[4];
#pragma unroll
      for (int d0 = 0; d0 < 4; ++d0) { v[d0] = o[d0][r] - X[(d0 * 16 + r) * 64]; a += v[d0] * v[d0]; }
      a += sx<1>(a); a += sx<2>(a); a += sx<4>(a); a += sx<8>(a); a += sx<16>(a);
      a = rsqrtf(a * (1.f / 128.f) + EPS);
      const int orow = (r & 3) + 8 * (r >> 2);
#pragma unroll
      for (int d0 = 0; d0 < 4; ++d0) Ow[orow * ldo + d0 * 32] = (unsigned short)f2bf(v[d0] * a * gg[d0]); }
  }
  }
  asm volatile("s_waitcnt vmcnt(0)" ::: "memory");
  __syncthreads();
#undef DA_DMA_K
#undef DA_DMA_V
#undef DA_WAITBAR
#undef DA_ROT
#undef DA_PRV
}
}
__device__ __forceinline__ void ph_attn(const Frame& F, const Args& A, int l) {
    const bf16 *Kb = WSP(bf16, WS_KB), *Vb = WSP(bf16, WS_VB), *Qb = WSP(bf16, WS_QB); bf16* MX = WSP(bf16, WS_MIXIN);
    const float* lq = A.in[10] + l * 256; float d01 = 0.f, d23 = 0.f;
    for (int i = 0; i < 64; ++i) { d01 += lq[i] * lq[64 + i]; d23 += lq[128 + i] * lq[192 + i]; }
    const float lam_init = 0.8f - 0.6f * expf(-0.3f * (float)l); float lam = expf(d01) - expf(d23) + lam_init;
    float mq = 0.f, mk = 0.f;
    for (int i = 0; i < 64; ++i) { mq = fmaxf(mq, fabsf(A.in[8][l * 64 + i])); mk = fmaxf(mk, fabsf(A.in[9][l * 64 + i])); }
    const float soff = __uint_as_float(__builtin_amdgcn_readfirstlane(__float_as_uint(64.f * mq * mk * QSCALE)));
    lam = __uint_as_float(__builtin_amdgcn_readfirstlane(__float_as_uint(lam))); const float osc = __uint_as_float(__builtin_amdgcn_readfirstlane(__float_as_uint(1.f - lam_init)));
    const int vcu = (F.G % 8 == 0) ? (F.bid % 8) * (F.G / 8) + F.bid / 8 : F.bid;
    for (int u = vcu; u < (l == DEPTH - 1 ? 1024 : 16 * 66); u += F.G) {
        const int bh = (u % 1024) / 64 , b = bh >> 3, h = bh & 7;
        int qb; int bb = b, hh = h;
        if (u < 1024) qb = 2 + (u & 63); else { const int v = u - 1024; bb = v >> 4; hh = (v >> 1) & 7; qb = v & 1; }
        const size_t R0 = (size_t)bb * TPB + qb * 128; const int seq = qb < 2 ? CTX : TPB;
#if ATTN_V2 == 8
        da::unit8(Qb + R0 * 1024 + hh * 128, Kb + (size_t)bb * TPB * 1024 + hh * 128, Vb + (size_t)bb * TPB * 1024 + hh * 128,
                  MX + R0 * 3072 + hh * 128, 3072, seq, lam, osc, soff, A.in[11] + l * 128, F.lds);
#else
        da::unit(Qb + R0 * 1024 + hh * 128, Kb + (size_t)bb * TPB * 1024 + hh * 128, Vb + (size_t)bb * TPB * 1024 + hh * 128,
                 MX + R0 * 3072 + hh * 128, 3072, seq, lam, osc, soff, A.in[11] + l * 128, (char*)F.lds);
#endif
    }
}

__device__ __forceinline__ void ph_mix(const Frame& F, const Args& A) {
    const float *PA = WSP(float, WS_PA), *PR = WSP(float, WS_PR), *PF = WSP(float, WS_PF); const bf16* GT = WSP(bf16, WS_GATES); bf16* MD = WSP(bf16, WS_MIXED);
    for (long i = F.gtid; i < (long)MROWS * 1024; i += F.NT) { const size_t R = (size_t)(i >> 10); const int c = (int)(i & 1023);
        MD[i] = (bf16)f2bf(bf2f(GT[R * 3072 + c]) * PA[i] + bf2f(GT[R * 3072 + 1024 + c]) * PR[i] + bf2f(GT[R * 3072 + 2048 + c]) * PF[i]); }
}
__device__ __forceinline__ void ph_resid_norm2(const Frame& F, const Args& A, int l) {
    float* X = WSP(float, WS_XALL); const float* Y1 = WSP(float, WS_Y1); bf16* TOK = WSP(bf16, WS_TOK);
    for (int R = F.gw; R < MROWS; R += F.NGW) {
        const int b = R / TPB, p = R % TPB, s = (p < CTX) ? 2 : b; const float* g1 = MODP(l, s, 2);
        f32x4 v[4];
#pragma unroll
        for (int j = 0; j < 4; ++j) { const int c = 4 * F.lane + 256 * j; const f32x4 x = *(const f32x4*)(X + (size_t)R * 1024 + c), y = *(const f32x4*)(Y1 + (size_t)R * 1024 + c), gg = *(const f32x4*)(g1 + c);
            v[j] = x + gg * y; *(f32x4*)(X + (size_t)R * 1024 + c) = v[j]; }
        norm_mod_row(v, A.in[23] + l * 1024, MODP(l, s, 4), MODP(l, s, 3), TOK + (size_t)R * 1024, F.lane);
    }
}
#define G1(T) __attribute__((address_space(1))) T
template <int CTRL, int RM = 0xf> __device__ __forceinline__ float dpp_f(float v) {
    return __uint_as_float(__builtin_amdgcn_update_dpp(__float_as_uint(v), __float_as_uint(v), CTRL, RM, 0xf, false)); }
__device__ __forceinline__ float wave_max63(float v) {
    asm volatile("s_nop 1\n\tv_max_f32_dpp %0, %0, %0 row_ror:1 row_mask:0xf bank_mask:0xf\n\ts_nop 1\n\tv_max_f32_dpp %0, %0, %0 row_ror:2 row_mask:0xf bank_mask:0xf\n\t"
                 "s_nop 1\n\tv_max_f32_dpp %0, %0, %0 row_ror:4 row_mask:0xf bank_mask:0xf\n\ts_nop 1\n\tv_max_f32_dpp %0, %0, %0 row_ror:8 row_mask:0xf bank_mask:0xf\n\t"
                 "s_nop 1\n\tv_max_f32_dpp %0, %0, %0 row_bcast:15 row_mask:0xa bank_mask:0xf\n\ts_nop 1\n\tv_max_f32_dpp %0, %0, %0 row_bcast:31 row_mask:0xc bank_mask:0xf\n\ts_nop 1" : "+v"(v));
    return v; }
template <bool DRY = false> __device__ __forceinline__ void ph_topk(const Frame& F, const Args& A, int l) {
    const float* LG = WSP(float, WS_LOG);
    int* LIST = DRY ? WSP(int, WS_PR) : WSP(int, WS_LIST); float* TOPW = DRY ? WSP(float, WS_PR + 18 * MiB) : WSP(float, WS_TOPW); int* EPO = DRY ? WSP(int, WS_PR + 19 * MiB) : WSP(int, WS_EP);
    int* CNT = (int*)(A.ws + WS_CTL) + CW_CNT + (DRY ? 2 : l) * 256 * CNT_STRIDE;
    const float NEG = -__builtin_inff();
    const bool skipctx = l == DEPTH - 1;
    const f32x4 rb4 = *(const G1(f32x4)*)(A.in[25] + l * 256 + 4 * F.lane);
    constexpr int SLOTS = 9;
    for (int base = F.gw; base < MROWS; base += SLOTS * F.NGW) {
        f32x4 lg[SLOTS]; int es[SLOTS], ps[SLOTS]; float wt[SLOTS];
#pragma unroll
        for (int i = 0; i < SLOTS; ++i) { const int R = base + i * F.NGW; lg[i] = f32x4{0.f, 0.f, 0.f, 0.f}; es[i] = 0; ps[i] = 0; wt[i] = 0.f;
            if (R < MROWS && !(skipctx && (R % TPB) < CTX)) lg[i] = *(const G1(f32x4)*)(LG + (size_t)R * 256 + 4 * F.lane); }
#pragma unroll
        for (int i = 0; i < SLOTS; ++i) { const int R = base + i * F.NGW;
            if (R < MROWS && !(skipctx && (R % TPB) < CTX)) {
                const float sc[4] = {sigmoidf_(lg[i].x), sigmoidf_(lg[i].y), sigmoidf_(lg[i].z), sigmoidf_(lg[i].w)};
                const float bi[4] = {sc[0] + rb4.x, sc[1] + rb4.y, sc[2] + rb4.z, sc[3] + rb4.w};
                float t1 = fmaxf(bi[0], bi[1]), t2 = fminf(bi[0], bi[1]);
                { const float u1 = fmaxf(bi[2], bi[3]), u2 = fminf(bi[2], bi[3]); const float n1 = fmaxf(t1, u1), n2 = fmaxf(fminf(t1, u1), fmaxf(t2, u2)); t1 = n1; t2 = n2; }
#define TK_M2(C) { const float o1 = dpp_f<C>(t1), o2 = dpp_f<C>(t2); const float n1 = fmaxf(t1, o1), n2 = fmaxf(fminf(t1, o1), fmaxf(t2, o2)); t1 = n1; t2 = n2; }
                TK_M2(0xB1) TK_M2(0x4E) TK_M2(0x141)
#undef TK_M2
                const float gs = t1 + t2; const int mygrp = F.lane >> 3; int rank = 0;
#pragma unroll
                for (int j = 0; j < 8; ++j) { const float sj = __uint_as_float(__builtin_amdgcn_readlane(__float_as_uint(gs), j * 8)); rank += (int)(sj > gs) | ((int)(sj == gs) & (int)(j < mygrp)); }
                const bool sel = rank < 4;
                float cand[4];
#pragma unroll
                for (int q = 0; q < 4; ++q) cand[q] = sel ? bi[q] : NEG;
                int my_e = 0; float my_s = 0.f, ssum = 0.f;
#pragma unroll
                for (int k = 0; k < 8; ++k) {
                    float bv = cand[0], bs = sc[0]; int bq = 0;
#pragma unroll
                    for (int q = 1; q < 4; ++q) { const bool g = cand[q] > bv; bv = g ? cand[q] : bv; bs = g ? sc[q] : bs; bq = g ? q : bq; }
                    const float mx = __uint_as_float(__builtin_amdgcn_readlane(__float_as_uint(wave_max63(bv)), 63));
                    const int ol = (int)__builtin_ctzll(__ballot(bv == mx));
                    const int oq = __builtin_amdgcn_readlane(bq, ol); const float sv = __uint_as_float(__builtin_amdgcn_readlane(__float_as_uint(bs), ol));
                    const bool me = F.lane == ol;
#pragma unroll
                    for (int q = 0; q < 4; ++q) cand[q] = (me & (oq == q)) ? NEG : cand[q];
                    ssum += sv;
                    { const int ev = 4 * ol + oq; asm volatile("v_writelane_b32 %0, %1, %2" : "+v"(my_e) : "s"(ev), "n"(k)); asm volatile("v_writelane_b32 %0, %1, %2" : "+v"(my_s) : "s"(sv), "n"(k)); }
                }
                es[i] = my_e; wt[i] = my_s * __builtin_amdgcn_rcpf(ssum) * 2.5f;
            } }
#pragma unroll
        for (int i = 0; i < SLOTS; ++i) { const int R = base + i * F.NGW;
            if (R < MROWS && !(skipctx && (R % TPB) < CTX) && F.lane < 8) ps[i] = __hip_atomic_fetch_add((G1(int)*)(CNT + es[i] * CNT_STRIDE), 1, __ATOMIC_RELAXED, __HIP_MEMORY_SCOPE_AGENT); }
#pragma unroll
        for (int i = 0; i < SLOTS; ++i) { const int R = base + i * F.NGW;
            if (R < MROWS && !(skipctx && (R % TPB) < CTX) && F.lane < 8) {
                *(G1(int)*)(LIST + (size_t)es[i] * LCAP + ps[i]) = R * 8 + F.lane; *(G1(float)*)(TOPW + (size_t)R * 8 + F.lane) = wt[i]; *(G1(int)*)(EPO + (size_t)R * 8 + F.lane) = es[i] * LCAP + ps[i]; } }
    }
}
__device__ __forceinline__ void ph_experts_naive(const Frame& F, const Args& A, int l) {
    const bf16* TOK = WSP(bf16, WS_TOK); const int* LIST = WSP(int, WS_LIST); const float* TOPW = WSP(float, WS_TOPW); float* YB = WSP(float, WS_YB);
    const int* CNT = (const int*)(A.ws + WS_CTL) + CW_CNT + l * 256 * CNT_STRIDE;
    LAS bf16* Xs = (LAS bf16*)F.lds;
    LAS float* Hs = (LAS float*)(F.lds + 65536);
    LAS int* pref = (LAS int*)(F.lds + 98304);
    LAS int* sPair = pref + 320; LAS float* sW = (LAS float*)(sPair + 32);
    __syncthreads();
    if (F.tid == 0) { int s = 0; for (int e = 0; e < 256; ++e) { pref[e] = s; s += (CNT[e] + 31) >> 5; } pref[256] = s; }
    __syncthreads();
    const int total = pref[256];
    for (int id = F.bid; id < total; id += F.G) {
        int lo = 0, hi = 255; while (lo < hi) { const int mid = (lo + hi + 1) >> 1; if (pref[mid] <= id) lo = mid; else hi = mid - 1; }
        const int e = lo, c = id - pref[e], n = min(32, CNT[e] - c * 32);
        __syncthreads();
        if (F.tid < 32) { const int pr = F.tid < n ? LIST[(size_t)e * LCAP + c * 32 + F.tid] : -1; sPair[F.tid] = pr; sW[F.tid] = pr >= 0 ? TOPW[pr] : 0.f; }
        __syncthreads();
        for (int pc = F.tid; pc < 4096; pc += 512) { const int row = pc >> 7, c8 = (pc & 127) * 8, pr = sPair[row];
            v4u v = {0u, 0u, 0u, 0u}; if (pr >= 0) v = *(const v4u*)(TOK + (size_t)(pr >> 3) * 1024 + c8);
            *(LAS v4u*)(Xs + row * 1024 + c8) = v; }
        __syncthreads();
        { const int f = F.tid & 255, gu = F.tid >> 8; const float* W = (gu ? A.in[27] : A.in[26]) + ((size_t)(l * 256 + e) * 1024) * 256 + f;
          float acc[32];
#pragma unroll
          for (int r = 0; r < 32; ++r) acc[r] = 0.f;
          for (int k = 0; k < 1024; ++k) { const float w = W[(size_t)k * 256];
#pragma unroll
              for (int r = 0; r < 32; ++r) acc[r] += bf2f(Xs[r * 1024 + k]) * w; }
          if (gu == 0) {
#pragma unroll
              for (int r = 0; r < 32; ++r) Hs[r * 256 + f] = siluf_(acc[r]); }
          __syncthreads();
          if (gu == 1) {
#pragma unroll
              for (int r = 0; r < 32; ++r) Hs[r * 256 + f] *= acc[r]; }
          __syncthreads(); }
        { const float* Wd = A.in[28] + ((size_t)(l * 256 + e) * 256) * 1024 + F.tid;
          float a0[32], a1[32];
#pragma unroll
          for (int r = 0; r < 32; ++r) { a0[r] = 0.f; a1[r] = 0.f; }
          for (int k = 0; k < 256; ++k) { const float w0 = Wd[(size_t)k * 1024], w1 = Wd[(size_t)k * 1024 + 512];
#pragma unroll
              for (int r = 0; r < 32; ++r) { const float hv = Hs[r * 256 + k]; a0[r] += hv * w0; a1[r] += hv * w1; } }
#pragma unroll
          for (int r = 0; r < 32; ++r) { const int pr = sPair[r]; if (pr >= 0) { const float w = sW[r]; YB[(size_t)pr * 1024 + F.tid] = a0[r] * w; YB[(size_t)pr * 1024 + 512 + F.tid] = a1[r] * w; } } }
    }
}
struct TrItem { const float* W; bf16* WT; int ldw, k0, n0, ldwt, rowbase; };
__device__ __forceinline__ void tr_load(const TrItem& t, f32x4 (&v)[8], int lane) {
    const int rr = lane >> 3, c4 = (lane & 7) * 4;
#pragma unroll
    for (int i = 0; i < 8; ++i) v[i] = __builtin_nontemporal_load((const f32x4*)(t.W + (size_t)(t.k0 + 8 * i + rr) * t.ldw + t.n0 + c4));
}
__device__ __forceinline__ void tr_store(const TrItem& t, const f32x4 (&v)[8], LAS float* scr, int lane) {
    const int rr = lane >> 3, c4 = (lane & 7) * 4;
#pragma unroll
    for (int i = 0; i < 8; ++i) { LAS float* d = scr + (8 * i + rr) * 33 + c4; d[0] = v[i].x; d[1] = v[i].y; d[2] = v[i].z; d[3] = v[i].w; }
    LDS_WAIT(); asm volatile("" ::: "memory");
    const int c = lane & 7;
#pragma unroll
    for (int j = 0; j < 4; ++j) { const int n = (lane >> 3) + 8 * j; const LAS float* sp = scr + (8 * c) * 33 + n;
        v4u o; o.x = pk2(sp[0 * 33], sp[1 * 33]); o.y = pk2(sp[2 * 33], sp[3 * 33]); o.z = pk2(sp[4 * 33], sp[5 * 33]); o.w = pk2(sp[6 * 33], sp[7 * 33]);
        *(v4u*)(t.WT + (size_t)(t.rowbase + n) * t.ldwt + t.k0 + 8 * c) = o; }
    LDS_WAIT(); asm volatile("" ::: "memory");
}
__device__ __forceinline__ TrItem expert_item(const Args& A, int l, int it) {
    const int e = it / 384, r = it % 384; bf16* E1 = (bf16*)(A.ws + EWL(l) + (size_t)e * EW_STRIDE); TrItem t;
    if (r < 256) { const int up = r >> 7, q = r & 127, kb = q >> 3, nb = q & 7, n0 = 32 * nb;
        t.W = (up ? A.in[27] : A.in[26]) + ((size_t)(l * 256 + e) * 1024) * 256; t.ldw = 256; t.k0 = 64 * kb; t.n0 = n0; t.WT = E1; t.ldwt = 1024; t.rowbase = (n0 >> 7) * 256 + up * 128 + (n0 & 127); }
    else { const int q = r - 256, kb = q >> 5, nb = q & 31;
        t.W = A.in[28] + ((size_t)(l * 256 + e) * 256) * 1024; t.ldw = 1024; t.k0 = 64 * kb; t.n0 = 32 * nb; t.WT = E1 + 512 * 1024; t.ldwt = 256; t.rowbase = 32 * nb; }
    return t;
}
__device__ __forceinline__ void ph_expert_w_idx(const Frame& F, const Args& A, int l, int lo, int hi, int ci, int nblk) {
    if (ci < 0 || ci >= nblk) return;
    LAS float* scr = (LAS float*)(F.lds + F.wave * 16384);
    const int stride = nblk * NWAVES; int it = lo + ci * NWAVES + F.wave; if (it >= hi) return;
    TrItem t0 = expert_item(A, l, it), t1 = t0, t2 = t0; f32x4 v0[8], v1[8], v2[8]; bool h1 = it + stride < hi, h2 = it + 2 * stride < hi;
    tr_load(t0, v0, F.lane);
    if (h1) { t1 = expert_item(A, l, it + stride); tr_load(t1, v1, F.lane); }
    for (;;) {
        if (h2) { t2 = expert_item(A, l, it + 2 * stride); tr_load(t2, v2, F.lane); }
        tr_store(t0, v0, scr, F.lane);
        if (!h1) break;
#pragma unroll
        for (int i = 0; i < 8; ++i) { v0[i] = v1[i]; v1[i] = v2[i]; }
        t0 = t1; t1 = t2; it += stride; h1 = h2; h2 = it + 2 * stride < hi;
    }
}
__device__ __forceinline__ void ph_expert_w(const Frame& F, const Args& A, int l, int lo, int hi, int blk0, int nblk) { ph_expert_w_idx(F, A, l, lo, hi, F.bid - blk0, nblk); }
constexpr int EWI_N = 256 * 384, EWI_A = 9800, EWI_B = 20800, EWI_C = 75000, EWI_D = 90000;
constexpr int KCONV_WIN = 18, KCONV_LRU = 44, KCONV_D = 124;
constexpr int KCONV_RS = 58, Q13 = 12, Q15 = 72, Q16 = 48;
__device__ __forceinline__ int moe_geff(int units, int G) { if (units <= 0) return G; const int rounds = (units + G - 1) / G; return (units + rounds - 1) / rounds; }
constexpr int MOE_MAXU = 11;
struct MoeSched {
    const LAS int* pref; const LAS int* cnt; const int* list; const char* abase; const char* bbase; int npn, G, c, lda2; size_t b_pn_stride; bool gather; LAS int* idx;
    __device__ __forceinline__ bool next(int i, pg8::UnitG& U) const {
        const long id = (long)i * G + c; const int total = pref[256]; if (id >= (long)total * npn) return false;
        const int tau = (int)(id / npn), pn = (int)(id % npn);
        int lo = 0, hi = 255; while (lo < hi) { const int mid = (lo + hi + 1) >> 1; if (pref[mid] <= tau) lo = mid; else hi = mid - 1; }
        const int e = lo, t = tau - pref[e];
        U.e = e; U.pn = pn; U.valid = min(256, cnt[e] - t * 256); U.rows = list + (size_t)e * LCAP + t * 256; U.row0 = tau * 256; U.lrows = idx ? idx + (i % MOE_MAXU) * 256 : nullptr;
        U.a = gather ? abase : abase + (size_t)tau * 256 * lda2; U.b = bbase + (size_t)e * EW_STRIDE + (size_t)pn * b_pn_stride; return true;
    }
};
__device__ __forceinline__ void moe_prefix(const Frame& F, const int* CNT, LAS int* pref) {
    LAS int* tmp = pref + 320;
    __syncthreads();
    if (F.tid < 256) tmp[F.tid] = CNT[F.tid * CNT_STRIDE];
    __syncthreads();
    if (F.tid <= 256) { int sum = 0; for (int e = 0; e < F.tid; ++e) sum += (tmp[e] + 255) >> 8; pref[F.tid] = sum; }
    __syncthreads();
}
struct EpiSwiGLU {
    static constexpr bool PERM = true;
    bf16* HB;
    __device__ __forceinline__ void operator()(const f32x4 (&acc)[2][2][4][2], const pg8::UnitG& u, int wr, int wc, int fr, int fq) const {
#pragma unroll
        for (int ai = 0; ai < 2; ++ai)
#pragma unroll
            for (int m = 0; m < 4; ++m) { const int r = ai * 128 + wr * 64 + m * 16 + fr;
                const f32x4 g0 = acc[ai][0][m][0], g1 = acc[ai][0][m][1], u0 = acc[ai][1][m][0], u1 = acc[ai][1][m][1];
                v4u w; w.x = pk2(siluf_(g0[0]) * u0[0], siluf_(g0[1]) * u0[1]); w.y = pk2(siluf_(g0[2]) * u0[2], siluf_(g0[3]) * u0[3]);
                w.z = pk2(siluf_(g1[0]) * u1[0], siluf_(g1[1]) * u1[1]); w.w = pk2(siluf_(g1[2]) * u1[2], siluf_(g1[3]) * u1[3]);
                *(v4u*)(HB + (size_t)(u.row0 + r) * 256 + u.pn * 128 + wc * 32 + 8 * fq) = w; }
    }
};
struct EpiScatter {
    static constexpr bool PERM = true;
    bf16* Y;
    __device__ __forceinline__ void operator()(const f32x4 (&acc)[2][2][4][2], const pg8::UnitG& u, int wr, int wc, int fr, int fq) const {
#pragma unroll
        for (int ai = 0; ai < 2; ++ai)
#pragma unroll
            for (int m = 0; m < 4; ++m) { const int r = ai * 128 + wr * 64 + m * 16 + fr;
                if (r < u.valid) { bf16* dst = Y + (size_t)(u.row0 + r) * 1024 + u.pn * 256 + wc * 32 + 8 * fq;
#pragma unroll
                    for (int bj = 0; bj < 2; ++bj) { const f32x4 v0 = acc[ai][bj][m][0], v1 = acc[ai][bj][m][1];
                        v4u o; o.x = pk2(v0[0], v0[1]); o.y = pk2(v0[2], v0[3]); o.z = pk2(v1[0], v1[1]); o.w = pk2(v1[2], v1[3]);
                        *(v4u*)(dst + bj * 128) = o; } } }
    }
};
__device__ __forceinline__ int conv_base(const Frame& F, const Args& A, int l) {
    if (l == 0) return 0;
    const int* CNT = (const int*)(A.ws + WS_CTL) + CW_CNT + (l - 1) * 256 * CNT_STRIDE; LAS int* pref = (LAS int*)(F.lds + RING_BYTES + 1024);
    moe_prefix(F, CNT, pref);
    const int tiles = pref[256], k15 = F.G - moe_geff(2 * tiles, F.G), k16 = F.G - moe_geff(4 * tiles, F.G);
    int base = KCONV_RS * NWAVES * Q13 + k15 * NWAVES * Q15 + k16 * NWAVES * Q16;
    __syncthreads();
    return base < EWI_N ? base : EWI_N;
}
__device__ __forceinline__ void ph_experts_up(const Frame& F, const Args& A, int l) {
    const int* CNT = (const int*)(A.ws + WS_CTL) + CW_CNT + l * 256 * CNT_STRIDE; LAS int* pref = (LAS int*)(F.lds + RING_BYTES + 1024);
    moe_prefix(F, CNT, pref);
    const int vcu = (F.G % 8 == 0) ? (F.bid % 8) * (F.G / 8) + F.bid / 8 : F.bid;
    const bool early = l + 1 < DEPTH; const int tiles = pref[256], Ge = early ? moe_geff(2 * tiles, F.G) : F.G;
    if (vcu < Ge) {
        LAS int* idx = (LAS int*)(F.lds + RING_BYTES + 4608);
        MoeSched S{pref, pref + 320, WSP(int, WS_LIST), (const char*)WSP(bf16, WS_TOK), (const char*)(A.ws + EWL(l)), 2, Ge, vcu, 2048, (size_t)256 * 1024 * 2, true, idx};
        { int vals[MOE_MAXU];
#pragma unroll
          for (int i = 0; i < MOE_MAXU; ++i) { pg8::UnitG U; vals[i] = 0; if (S.next(i, U) && F.tid < 256) vals[i] = *(const G1(int)*)(U.rows + min(F.tid, U.valid - 1)); }
#pragma unroll
          for (int i = 0; i < MOE_MAXU; ++i) if (F.tid < 256) idx[i * 256 + F.tid] = vals[i]; }
        __syncthreads();
        EpiSwiGLU E{WSP(bf16, WS_HB)};
        pg8::gemm_phase_g<EpiSwiGLU, MoeSched, true>(F.lds, 1024, 1024, 1024, S, E);
    } else { const int k = F.G - Ge, lo = KCONV_RS * NWAVES * Q13; ph_expert_w_idx(F, A, l + 1, lo, min(EWI_N, lo + k * NWAVES * Q15), vcu - Ge, k); }
    __syncthreads();
}
__device__ __forceinline__ void ph_experts_down(const Frame& F, const Args& A, int l) {
    const int* CNT = (const int*)(A.ws + WS_CTL) + CW_CNT + l * 256 * CNT_STRIDE; LAS int* pref = (LAS int*)(F.lds + RING_BYTES + 1024);
    moe_prefix(F, CNT, pref);
    const int vcu = (F.G % 8 == 0) ? (F.bid % 8) * (F.G / 8) + F.bid / 8 : F.bid;
    const bool early = l + 1 < DEPTH; const int tiles = pref[256], Ge = early ? moe_geff(4 * tiles, F.G) : F.G;
    if (vcu < Ge) {
        MoeSched S{pref, pref + 320, WSP(int, WS_LIST), (const char*)WSP(bf16, WS_HB), (const char*)(A.ws + EWL(l) + 512 * 1024 * 2), 4, Ge, vcu, 512, (size_t)256 * 256 * 2, false, nullptr};
        EpiScatter E{WSP(bf16, WS_Y16)};
        pg8::gemm_phase_g<EpiScatter, MoeSched, false>(F.lds, 256, 256, 256, S, E);
    } else { const int k = F.G - Ge, k15 = F.G - moe_geff(2 * tiles, F.G), lo = KCONV_RS * NWAVES * Q13 + k15 * NWAVES * Q15;
        ph_expert_w_idx(F, A, l + 1, min(EWI_N, lo), min(EWI_N, lo + k * NWAVES * Q16), vcu - Ge, k); }
}
template <bool DRY = false> __device__ __forceinline__ void ph_combine(const Frame& F, const Args& A, int l) {
    const float* X = WSP(float, WS_XALL); float* XO = DRY ? WSP(float, WS_U + 492 * MiB) : WSP(float, WS_XALL); bf16* HO = DRY ? WSP(bf16, WS_U + 558 * MiB) : WSP(bf16, WS_H); const bf16* SD = WSP(bf16, WS_SD); const bf16* YS = WSP(bf16, WS_Y16); const int* EP = WSP(int, WS_EP); const float* TOPW = WSP(float, WS_TOPW);
    const int* CNT = (const int*)(A.ws + WS_CTL) + CW_CNT + l * 256 * CNT_STRIDE; LAS int* pref = (LAS int*)(F.lds + RING_BYTES + 1024);
    moe_prefix(F, CNT, pref);
    for (int R = F.gw; R < MROWS; R += F.NGW) {
        const int b = R / TPB, p = R % TPB, s = (p < CTX) ? 2 : b; const float* g2 = MODP(l, s, 5);
        if (l == DEPTH - 1 && p < CTX) continue;
        size_t so[8]; float wk[8];
#pragma unroll
        for (int k = 0; k < 8; ++k) { const int ep = EP[(size_t)R * 8 + k], e = ep / LCAP, pos = ep - e * LCAP; so[k] = ((size_t)pref[e] * 256 + pos) * 1024; wk[k] = TOPW[(size_t)R * 8 + k]; }
        v4u yv[2][8], sd[2]; f32x4 xin[2][2];
#pragma unroll
        for (int j = 0; j < 2; ++j) { const int c = 8 * F.lane + 512 * j;
#pragma unroll
            for (int k = 0; k < 8; ++k) yv[j][k] = *(const v4u*)(YS + so[k] + c);
            sd[j] = *(const v4u*)(SD + (size_t)R * 1024 + c);
            xin[j][0] = *(const f32x4*)(X + (size_t)R * 1024 + c); xin[j][1] = *(const f32x4*)(X + (size_t)R * 1024 + c + 4); }
        float xo[2][8]; float ss = 0.f;
#pragma unroll
        for (int j = 0; j < 2; ++j) { const int c = 8 * F.lane + 512 * j; float f[8] = {bf2f(sd[j].x & 0xffffu), bf2f(sd[j].x >> 16), bf2f(sd[j].y & 0xffffu), bf2f(sd[j].y >> 16), bf2f(sd[j].z & 0xffffu), bf2f(sd[j].z >> 16), bf2f(sd[j].w & 0xffffu), bf2f(sd[j].w >> 16)};
#pragma unroll
            for (int k = 0; k < 8; ++k) { const unsigned ws[4] = {yv[j][k].x, yv[j][k].y, yv[j][k].z, yv[j][k].w};
#pragma unroll
                for (int q = 0; q < 4; ++q) { f[2 * q] += wk[k] * bf2f(ws[q] & 0xffffu); f[2 * q + 1] += wk[k] * bf2f(ws[q] >> 16); } }
            const f32x4 ga = *(const f32x4*)(g2 + c), gb = *(const f32x4*)(g2 + c + 4);
            const f32x4 xa = xin[j][0] + ga * (f32x4){f[0], f[1], f[2], f[3]}, xb = xin[j][1] + gb * (f32x4){f[4], f[5], f[6], f[7]};
            if (l + 1 < DEPTH || DRY) { *(f32x4*)(XO + (size_t)R * 1024 + c) = xa; *(f32x4*)(XO + (size_t)R * 1024 + c + 4) = xb; }
            if (l == DEPTH - 1 && !DRY) { *(f32x4*)(A.out + ((size_t)b * SEQ + (p - CTX)) * 1024 + c) = xa; *(f32x4*)(A.out + ((size_t)b * SEQ + (p - CTX)) * 1024 + c + 4) = xb; }
            xo[j][0] = xa.x; xo[j][1] = xa.y; xo[j][2] = xa.z; xo[j][3] = xa.w; xo[j][4] = xb.x; xo[j][5] = xb.y; xo[j][6] = xb.z; xo[j][7] = xb.w;
#pragma unroll
            for (int e = 0; e < 8; ++e) ss += xo[j][e] * xo[j][e]; }
        if (l + 1 < DEPTH || DRY) {
            const int ln = DRY ? 0 : l + 1; const float rs = rsqrtf(wave_sum(ss) * (1.f / 1024.f) + EPS);
            const float* gn = A.in[6] + ln * 1024; const float* sc1 = MODP(ln, s, 1); const float* sh1 = MODP(ln, s, 0);
#pragma unroll
            for (int j = 0; j < 2; ++j) { const int c = 8 * F.lane + 512 * j; float y[8];
#pragma unroll
                for (int h = 0; h < 2; ++h) { const f32x4 gg = *(const f32x4*)(gn + c + 4 * h), s1 = *(const f32x4*)(sc1 + c + 4 * h), s0 = *(const f32x4*)(sh1 + c + 4 * h);
                    y[4 * h] = xo[j][4 * h] * rs * gg.x * (1.f + s1.x) + s0.x; y[4 * h + 1] = xo[j][4 * h + 1] * rs * gg.y * (1.f + s1.y) + s0.y;
                    y[4 * h + 2] = xo[j][4 * h + 2] * rs * gg.z * (1.f + s1.z) + s0.z; y[4 * h + 3] = xo[j][4 * h + 3] * rs * gg.w * (1.f + s1.w) + s0.w; }
                v4u o; o.x = pk2(y[0], y[1]); o.y = pk2(y[2], y[3]); o.z = pk2(y[4], y[5]); o.w = pk2(y[6], y[7]);
                *(v4u*)(HO + (size_t)R * 1024 + c) = o; } }
    }
}

struct EpiWin {
    static constexpr bool PERM = true; static constexpr int MIDK = 0;
    bf16 *Kb, *Vb, *Qb, *LXb, *GLG, *ZP, *GT; const float* qg; const float* kg;
    __device__ __forceinline__ void operator()(const f32x4 (&acc)[2][2][4][2], const pg8::Unit& u, int wr, int wc, int fr, int fq) const {
        const int pn = u.pn, sec = pn >> 2;
        if (sec == 0 || sec == 3) {
            const bool isq = sec == 3; const bool lat = (u.pm % 33) != 0;
            bf16* dst = (isq ? Qb : Kb) + (pn & 3) * 256 + wc * 64 + 4 * fq; const float* gn = isq ? qg : kg; const float gs = isq ? QSCALE : 1.f;
            f32x4 g[2][2]; float invf[4];
#pragma unroll
            for (int bj = 0; bj < 2; ++bj)
#pragma unroll
                for (int n = 0; n < 2; ++n) g[bj][n] = *(const f32x4*)(gn + 32 * bj + 16 * n + 4 * fq) * gs;
#pragma unroll
            for (int e = 0; e < 4; ++e) invf[e] = exp2f(-(float)(4 * fq + e) * (13.287712379549449f / 16.f)) * 0.15915494309189535f;
#pragma unroll
            for (int ai = 0; ai < 2; ++ai)
#pragma unroll
                for (int m = 0; m < 4; ++m) { const int R = u.pm * 256 + ai * 128 + wr * 64 + m * 16 + fr, t = (R % TPB) - CTX;
                    float ss = 0.f;
#pragma unroll
                    for (int bj = 0; bj < 2; ++bj)
#pragma unroll
                        for (int n = 0; n < 2; ++n) { const f32x4 v = acc[ai][bj][m][n]; ss += (v[0] * v[0] + v[1] * v[1]) + (v[2] * v[2] + v[3] * v[3]); }
                    ss += sx<16>(ss); ss += sx<32>(ss);
                    const float rs = rsqrtf(ss * (1.f / 64.f) + EPS);
#pragma unroll
                    for (int bj = 0; bj < 2; ++bj) { const float pos = (float)(bj ? (t & 63) : (t >> 6));
                        const f32x4 y1 = acc[ai][bj][m][0] * rs * g[bj][0], y2 = acc[ai][bj][m][1] * rs * g[bj][1]; f32x4 o1 = y1, o2 = y2;
                        if (lat) {
#pragma unroll
                            for (int e = 0; e < 4; ++e) { const float rev = pos * invf[e]; const float cs = __builtin_amdgcn_cosf(rev), sn = __builtin_amdgcn_sinf(rev);
                                o1[e] = y1[e] * cs - y2[e] * sn; o2[e] = y1[e] * sn + y2[e] * cs; } }
                        bf16* p = dst + (size_t)R * 1024 + 32 * bj;
                        *(unsigned long long*)p = (unsigned long long)pk2(o1[0], o1[1]) | ((unsigned long long)pk2(o1[2], o1[3]) << 32);
                        *(unsigned long long*)(p + 16) = (unsigned long long)pk2(o2[0], o2[1]) | ((unsigned long long)pk2(o2[2], o2[3]) << 32); }
                    asm volatile("" ::: "memory"); }
        } else {
            bf16* base; int ld = 1024, act = 0;
            if (sec == 1) base = Vb + (pn & 3) * 256; else if (sec == 2) base = LXb + (pn & 3) * 256; else if (sec == 4) { base = GLG + (pn & 3) * 256; act = 1; }
            else if (sec == 5) base = ZP + (pn & 3) * 256; else { base = GT + (pn - 24) * 256; ld = 3072; act = 2; }
            base += wc * 32 + 8 * fq;
#pragma unroll
            for (int ai = 0; ai < 2; ++ai)
#pragma unroll
                for (int m = 0; m < 4; ++m) { bf16* rowp = base + (size_t)(u.pm * 256 + ai * 128 + wr * 64 + m * 16 + fr) * ld;
#pragma unroll
                    for (int bj = 0; bj < 2; ++bj) { f32x4 v0 = acc[ai][bj][m][0], v1 = acc[ai][bj][m][1];
                        if (act == 1) {
#pragma unroll
                            for (int e = 0; e < 4; ++e) { v0[e] = gelu_tanh(v0[e]); v1[e] = gelu_tanh(v1[e]); } }
                        else if (act == 2) {
#pragma unroll
                            for (int e = 0; e < 4; ++e) { v0[e] = sigmoidf_(v0[e]); v1[e] = sigmoidf_(v1[e]); } }
                        v4u o; o.x = pk2(v0[0], v0[1]); o.y = pk2(v0[2], v0[3]); o.z = pk2(v1[0], v1[1]); o.w = pk2(v1[2], v1[3]);
                        *(v4u*)(rowp + bj * 128) = o; } }
        }
    }
};

struct EpiMix {
    static constexpr bool PERM = true; static constexpr int MIDK = 16;
    const bf16* GT; bf16* MD;
    __device__ __forceinline__ void mid(f32x4 (&acc)[2][2][4][2], const pg8::Unit& u, int wr, int wc, int fr, int fq, int seg) const {
        const bf16* gb = GT + (size_t)(u.pm * 256 + wr * 64 + fr) * 3072 + (seg - 1) * 1024 + u.pn * 256 + wc * 32 + 8 * fq;
#pragma unroll
        for (int ai = 0; ai < 2; ++ai)
#pragma unroll
            for (int m = 0; m < 4; ++m)
#pragma unroll
                for (int bj = 0; bj < 2; ++bj) { const bf16* p = gb + (size_t)(ai * 128 + m * 16) * 3072 + bj * 128;
                    const v4u a = *(const v4u*)p, b = *(const v4u*)(p + 1024);
                    const unsigned aw[4] = {a.x, a.y, a.z, a.w}, bw[4] = {b.x, b.y, b.z, b.w};
#pragma unroll
                    for (int q = 0; q < 4; ++q) { const float r0 = bf2f(aw[q] & 0xffffu) * __builtin_amdgcn_rcpf(fmaxf(bf2f(bw[q] & 0xffffu), 1e-30f)), r1 = bf2f(aw[q] >> 16) * __builtin_amdgcn_rcpf(fmaxf(bf2f(bw[q] >> 16), 1e-30f));
                        acc[ai][bj][m][q >> 1][(q & 1) * 2] *= r0; acc[ai][bj][m][q >> 1][(q & 1) * 2 + 1] *= r1; } }
    }
    __device__ __forceinline__ void operator()(const f32x4 (&acc)[2][2][4][2], const pg8::Unit& u, int wr, int wc, int fr, int fq) const {
        const size_t r0 = (size_t)(u.pm * 256 + wr * 64 + fr); const int c0 = u.pn * 256 + wc * 32 + 8 * fq;
#pragma unroll
        for (int ai = 0; ai < 2; ++ai)
#pragma unroll
            for (int m = 0; m < 4; ++m)
#pragma unroll
                for (int bj = 0; bj < 2; ++bj) { const size_t R = r0 + ai * 128 + m * 16; const v4u gv = *(const v4u*)(GT + R * 3072 + 2048 + c0 + bj * 128);
                    const f32x4 v0 = acc[ai][bj][m][0], v1 = acc[ai][bj][m][1]; v4u o;
                    o.x = pk2(v0[0] * bf2f(gv.x & 0xffffu), v0[1] * bf2f(gv.x >> 16)); o.y = pk2(v0[2] * bf2f(gv.y & 0xffffu), v0[3] * bf2f(gv.y >> 16));
                    o.z = pk2(v1[0] * bf2f(gv.z & 0xffffu), v1[1] * bf2f(gv.z >> 16)); o.w = pk2(v1[2] * bf2f(gv.w & 0xffffu), v1[3] * bf2f(gv.w >> 16));
                    *(v4u*)(MD + R * 1024 + c0 + bj * 128) = o; }
    }
};
struct EpiResid {
    static constexpr bool PERM = false; static constexpr int MIDK = 0;
    float* X; const float* mod;
    const float* Xin; const float* Cin;
    __device__ __forceinline__ void operator()(const f32x4 (&acc)[2][2][4][2], const pg8::Unit& u, int wr, int wc, int fr, int fq) const {
        const int src = (u.pm % 33 == 0) ? 2 : u.pm / 33; const float* g1 = mod + src * 6144 + 2 * 1024;
        const float* sbase = Xin ? ((u.pm % 33 == 0) ? Cin + (size_t)(u.pm / 33) * CTX * 1024 : Xin + ((size_t)(u.pm / 33) * SEQ + (size_t)(u.pm % 33 - 1) * 256) * 1024) : X + (size_t)u.pm * 256 * 1024;
        const int col0 = u.pn * 256 + wc * 32 + 4 * fq;
        f32x4 gv[2][2];
#pragma unroll
        for (int bj = 0; bj < 2; ++bj)
#pragma unroll
            for (int n = 0; n < 2; ++n) gv[bj][n] = *(const f32x4*)(g1 + col0 + bj * 128 + n * 16);
#pragma unroll
        for (int ai = 0; ai < 2; ++ai)
#pragma unroll
            for (int m = 0; m < 4; ++m) { const size_t ro = (size_t)(ai * 128 + wr * 64 + m * 16 + fr) * 1024 + col0; float* rowp = X + (size_t)u.pm * 256 * 1024 + ro; const float* srow = sbase + ro;
#pragma unroll
                for (int bj = 0; bj < 2; ++bj)
#pragma unroll
                    for (int n = 0; n < 2; ++n) { *(f32x4*)(rowp + bj * 128 + n * 16) = *(const f32x4*)(srow + bj * 128 + n * 16) + gv[bj][n] * acc[ai][bj][m][n]; } }
    }
};
struct EpiRS {
    static constexpr bool PERM = true; static constexpr int MIDK = 0;
    float* LG; bf16* SH;
    __device__ __forceinline__ void operator()(const f32x4 (&acc)[2][2][4][2], const pg8::Unit& u, int wr, int wc, int fr, int fq) const {
#pragma unroll
        for (int ai = 0; ai < 2; ++ai)
#pragma unroll
            for (int m = 0; m < 4; ++m) { const size_t R = (size_t)u.pm * 256 + ai * 128 + wr * 64 + m * 16 + fr;
                if (u.pn == 0) {
#pragma unroll
                    for (int bj = 0; bj < 2; ++bj) { float* p = LG + R * 256 + bj * 128 + wc * 32 + 8 * fq; *(f32x4*)p = acc[ai][bj][m][0]; *(f32x4*)(p + 4) = acc[ai][bj][m][1]; } }
                else { const f32x4 g0 = acc[ai][0][m][0], g1 = acc[ai][0][m][1], u0 = acc[ai][1][m][0], u1 = acc[ai][1][m][1];
                    v4u w; w.x = pk2(siluf_(g0[0]) * u0[0], siluf_(g0[1]) * u0[1]); w.y = pk2(siluf_(g0[2]) * u0[2], siluf_(g0[3]) * u0[3]);
                    w.z = pk2(siluf_(g1[0]) * u1[0], siluf_(g1[1]) * u1[1]); w.w = pk2(siluf_(g1[2]) * u1[2], siluf_(g1[3]) * u1[3]);
                    *(v4u*)(SH + R * 256 + (u.pn - 1) * 128 + wc * 32 + 8 * fq) = w; } }
    }
};
__device__ __forceinline__ void ph_norm2(const Frame& F, const Args& A, int l) {
    const float* X = WSP(float, WS_XALL); bf16* TOK = WSP(bf16, WS_TOK);
    for (int R0 = F.gw; R0 < MROWS; R0 += 2 * F.NGW) {
        const int R1 = R0 + F.NGW; const int p0 = R0 % TPB, p1 = R1 % TPB;
        const bool ok0 = !(l == DEPTH - 1 && p0 < CTX), ok1 = R1 < MROWS && !(l == DEPTH - 1 && p1 < CTX);
        f32x4 v0[4], v1[4];
#pragma unroll
        for (int j = 0; j < 4; ++j) { v0[j] = f32x4{0.f, 0.f, 0.f, 0.f}; v1[j] = v0[j]; }
        if (ok0) {
#pragma unroll
            for (int j = 0; j < 4; ++j) v0[j] = *(const f32x4*)(X + (size_t)R0 * 1024 + 4 * F.lane + 256 * j); }
        if (ok1) {
#pragma unroll
            for (int j = 0; j < 4; ++j) v1[j] = *(const f32x4*)(X + (size_t)R1 * 1024 + 4 * F.lane + 256 * j); }
        if (ok0) { const int s = (p0 < CTX) ? 2 : R0 / TPB; norm_mod_row(v0, A.in[23] + l * 1024, MODP(l, s, 4), MODP(l, s, 3), TOK + (size_t)R0 * 1024, F.lane); }
        if (ok1) { const int s = (p1 < CTX) ? 2 : R1 / TPB; norm_mod_row(v1, A.in[23] + l * 1024, MODP(l, s, 4), MODP(l, s, 3), TOK + (size_t)R1 * 1024, F.lane); }
    }
}

constexpr int PH_PER_L = 18, N_PHASES = 1 + DEPTH * PH_PER_L;
template <int P, bool DRY = false> __device__ __forceinline__ void run_phase(const Frame& F, const Args& A, int l) {
    if constexpr (P == -1) ph_prologue(F, A);
    if constexpr (P == 0) ph_norm1(F, A, l);
#if !FAST_WIN
#error oracle w_in path removed
#endif
    if constexpr (P == 1) { const int Ge = F.G - KCONV_WIN; const int cb = conv_base(F, A, l);
        if (F.bid < Ge) { pg8::Gemm g{WSP(bf16, WS_H), WLP(l, WO_WIN), MROWS, INW, 1024, 1024, 1024}; pg8::StaticOrder S; S.init(MROWS, INW, Ge, F.bid);
            EpiWin E{WSP(bf16, WS_KB), WSP(bf16, WS_VB), WSP(bf16, WS_QB), WSP(bf16, WS_LXB), WSP(bf16, WS_GLG), WSP(bf16, WS_ZP), WSP(bf16, WS_GATES), A.in[8] + l * 64, A.in[9] + l * 64};
            pg8::gemm_phase(F.lds, g, S, E); }
        else ph_expert_w(F, A, l, min(EWI_N, cb), min(EWI_N, cb + EWI_A), Ge, KCONV_WIN); }
    if constexpr (P == 3) { ph_conv(F, A, l); ph_fft_t1_fast(F, A);
        { const int cb = conv_base(F, A, l); ph_expert_w(F, A, l, min(EWI_N, cb + (l == 0 ? EWI_D : EWI_B)), EWI_N, 0, F.G); } }
    if constexpr (P == 4) {
        { const int cb = conv_base(F, A, l);
          if (F.bid < F.G - KCONV_LRU) ph_lru_gemm(F, A, l, F.G - KCONV_LRU); else ph_expert_w(F, A, l, min(EWI_N, cb + EWI_A), min(EWI_N, cb + EWI_B), F.G - KCONV_LRU, KCONV_LRU); }
        __syncthreads();
#if FAST_FFT_A
        ph_fft_a_gemm(F, A);
#else
        ph_fft_a(F, A);
#endif
        ph_fft_c(F, A);
    }
    if constexpr (P == 5) {
        ph_scan1(F, A);
#if FAST_FFT_B
        ph_fft_b_gemm(F, A);
#else
        ph_fft_b(F, A);
#endif
    }
    if constexpr (P == 6) { ph_scan2_fast(F, A); ph_fft_t2_fast(F, A); }
    if constexpr (P == 7) { ph_scan3(F, A);
#if FAST_ATTN
        ph_attn(F, A, l);
#endif
    }
    if constexpr (P == 8) {
#if !FAST_ATTN
        ph_attn_naive(F, A, l);
#endif
        __syncthreads(); }
#if FAST_MIX
    if constexpr (P == 9) { const bool sp = (l == 0) && F.G > 2 * KCONV_D; const int Ge = sp ? F.G - KCONV_D : F.G;
        if (F.bid < Ge) { pg8::Gemm g{WSP(bf16, WS_MIXIN), WLP(l, WO_D1), MROWS, 1024, 3072, 3072, 3072}; pg8::StaticOrder S; S.init(MROWS, 1024, Ge, F.bid, l == DEPTH - 1);
            EpiMix E{WSP(bf16, WS_GATES), WSP(bf16, WS_MIXED)}; pg8::gemm_phase(F.lds, g, S, E); }
        else ph_expert_w(F, A, l, EWI_B, EWI_C, Ge, KCONV_D); }
    if constexpr (P == 11) { const bool sp = (l == 0) && F.G > 2 * KCONV_D; const int Ge = sp ? F.G - KCONV_D : F.G;
        if (F.bid < Ge) { pg8::Gemm g{WSP(bf16, WS_MIXED), WLP(l, WO_OUT), MROWS, 1024, 1024, 1024, 1024}; pg8::StaticOrder S; S.init(MROWS, 1024, Ge, F.bid, l == DEPTH - 1);
            EpiResid E{WSP(float, WS_XALL), (const float*)(A.ws + WS_CTL) + CW_MOD + l * 3 * 6144, l == 0 ? A.in[0] : nullptr, l == 0 ? A.in[2] : nullptr}; pg8::gemm_phase(F.lds, g, S, E); }
        else ph_expert_w(F, A, l, EWI_C, EWI_D, Ge, KCONV_D); }
    if constexpr (P == 12) ph_norm2(F, A, l);
#else
    if constexpr (P == 9) {
        { pg8::Gemm g{WSP(bf16, WS_MIXIN), WLP(l, WO_D1), MROWS, 1024, 1024, 3072, 3072}; pg8::StaticOrder S; S.init(MROWS, 1024, F.G, F.bid); pg8::EpiF32 E{WSP(float, WS_PA), 1024}; pg8::gemm_phase(F.lds, g, S, E); }
        { pg8::Gemm g{WSP(bf16, WS_MIXIN) + 1024, WLP(l, WO_D1) + 1024, MROWS, 1024, 1024, 3072, 3072}; pg8::StaticOrder S; S.init(MROWS, 1024, F.G, F.bid); pg8::EpiF32 E{WSP(float, WS_PR), 1024}; pg8::gemm_phase(F.lds, g, S, E); }
        { pg8::Gemm g{WSP(bf16, WS_MIXIN) + 2048, WLP(l, WO_D1) + 2048, MROWS, 1024, 1024, 3072, 3072}; pg8::StaticOrder S; S.init(MROWS, 1024, F.G, F.bid); pg8::EpiF32 E{WSP(float, WS_PF), 1024}; pg8::gemm_phase(F.lds, g, S, E); } }
    if constexpr (P == 10) ph_mix(F, A);
    if constexpr (P == 11) { pg8::Gemm g{WSP(bf16, WS_MIXED), WLP(l, WO_OUT), MROWS, 1024, 1024, 1024, 1024}; pg8::StaticOrder S; S.init(MROWS, 1024, F.G, F.bid);
        pg8::EpiF32 E{WSP(float, WS_Y1), 1024}; pg8::gemm_phase(F.lds, g, S, E); }
    if constexpr (P == 12) ph_resid_norm2(F, A, l);
#endif
    if constexpr (P == 13) { const bool early = l + 1 < DEPTH; const int Ge = early ? F.G - KCONV_RS : F.G;
        if (F.bid < Ge) { pg8::Gemm g{WSP(bf16, WS_TOK), WLP(l, WO_R), MROWS, 768, 1024, 1024, 1024}; pg8::StaticOrder S; S.init(MROWS, 768, Ge, F.bid, l == DEPTH - 1);
            EpiRS E{WSP(float, WS_LOG), WSP(bf16, WS_SH)}; pg8::gemm_phase(F.lds, g, S, E); }
        else ph_expert_w(F, A, l + 1, 0, KCONV_RS * NWAVES * Q13, Ge, KCONV_RS); }
    if constexpr (P == 14) ph_topk<DRY>(F, A, l);
    if constexpr (P == 15) {
#if FAST_MOE
        ph_experts_up(F, A, l);
#else
        ph_experts_naive(F, A, l); __syncthreads();
#endif

        { pg8::Gemm g{WSP(bf16, WS_SH), WLP(l, WO_SD), MROWS, 1024, 256, 256, 256}; pg8::StaticOrder S; S.init(MROWS, 1024, F.G, F.bid, l == DEPTH - 1); EpiBf16U E{WSP(bf16, WS_SD), 1024}; pg8::gemm_phase(F.lds, g, S, E); } }
    if constexpr (P == 16) {
#if FAST_MOE
        ph_experts_down(F, A, l);
#endif
    }
    if constexpr (P == 17) ph_combine<DRY>(F, A, l);
}
__device__ __forceinline__ Frame make_frame(unsigned char* lds) {
    Frame F; F.lds = (LAS unsigned char*)lds; F.tid = otid(); F.lane = F.tid & 63; F.wave = __builtin_amdgcn_readfirstlane(F.tid >> 6);
    F.bid = obid(); F.G = ogrid(); F.gw = F.bid * NWAVES + F.wave; F.NGW = F.G * NWAVES; F.gtid = (long)F.bid * 512 + F.tid; F.NT = (long)F.G * 512;
    return F;
}
template <int P> __global__ void __launch_bounds__(NWAVES * 64, 2) mk_phase(Args A) {
    extern __shared__ __attribute__((aligned(16))) unsigned char lds[];
    const Frame F = make_frame(lds);
    run_phase<P>(F, A, A.ph_lo);
}
#if N_LAUNCH_MODE == 1
__device__ __forceinline__ const float* lds_ptr(const LAS unsigned long long* tab, int i) {
    const unsigned long long v = tab[i];
    const unsigned lo = __builtin_amdgcn_readfirstlane((unsigned)v), hi = __builtin_amdgcn_readfirstlane((unsigned)(v >> 32));
    return (const float*)(const __attribute__((address_space(1))) float*)(((unsigned long long)hi << 32) | lo);
}
__device__ __forceinline__ void load_args(Args& L, const LAS unsigned long long* tab) {
#pragma unroll
    for (int i = 0; i < 32; ++i) L.in[i] = lds_ptr(tab, i);
    L.out = (float*)lds_ptr(tab, 32); L.ws = (unsigned char*)lds_ptr(tab, 33); L.ph_lo = 0; L.ph_hi = 0;
}
__global__ void __launch_bounds__(NWAVES * 64, 2) mk_fwd(Args A) {
    extern __shared__ __attribute__((aligned(16))) unsigned char lds[];
    LAS unsigned char* L3 = (LAS unsigned char*)lds;
    volatile LAS unsigned* MISC = (volatile LAS unsigned*)(L3 + MISC_OFF);
    for (int u = threadIdx.x; u < (LDS_BYTES - RING_BYTES) / 4; u += NWAVES * 64) ((LAS unsigned*)(L3 + RING_BYTES))[u] = 0u;
    __syncthreads();
    LAS unsigned long long* tab = (LAS unsigned long long*)(L3 + RING_BYTES + 4096);
    if (threadIdx.x == 0) {
#define ST(i) tab[i] = (unsigned long long)A.in[i];
        ST(0) ST(1) ST(2) ST(3) ST(4) ST(5) ST(6) ST(7) ST(8) ST(9) ST(10) ST(11) ST(12) ST(13) ST(14) ST(15) ST(16) ST(17) ST(18) ST(19) ST(20) ST(21) ST(22) ST(23) ST(24) ST(25) ST(26) ST(27) ST(28) ST(29) ST(30) ST(31)
#undef ST
        tab[32] = (unsigned long long)A.out; tab[33] = (unsigned long long)A.ws;
    }
    __syncthreads();
    (void)xcd_barrier_post((unsigned*)(A.ws + WS_CTL) + CW_BAR, MISC + 8);
#define RUN(P) do { asm volatile("; PHASE_MARK " #P); { unsigned tb_ = RING_BYTES + 4096; asm volatile("" : "+v"(tb_)); Args L; load_args(L, (const LAS unsigned long long*)(L3 + tb_)); \
        const Frame F = make_frame(lds); run_phase<P>(F, L, l); \
        if constexpr (P >= 0 && ((REP_MASK >> (P < 0 ? 0 : P)) & 1)) { for (int rp_ = 0; rp_ < REP_N; ++rp_) { asm volatile("s_waitcnt vmcnt(0)" ::: "memory"); __syncthreads(); run_phase<P, true>(F, L, l); } } \
        XcdBarrier bar; bar.bar = (unsigned*)(L.ws + WS_CTL) + CW_BAR; bar.x = xb_xcc_id(); { unsigned mo_ = MISC_OFF + 32; asm volatile("" : "+v"(mo_)); bar.st = (volatile LAS unsigned*)(L3 + mo_); } \
        xcd_barrier(bar); } } while (0)
    { const int l = 0; RUN(-1);
#if REP_PRO
      for (int rp_ = 0; rp_ < 2; ++rp_) { RUN(-1); }
#endif
    }
    for (int l = 0; l < DEPTH; ++l) {
        if (l == 0) RUN(0);
        RUN(1); RUN(3); RUN(4); RUN(5); RUN(6); RUN(7); RUN(9); RUN(11); RUN(12); RUN(13); RUN(14); RUN(15); RUN(16); RUN(17);
    }
#undef RUN
}
#endif

extern "C" void kernel_launch(void* const* d_in, const int* in_sizes, int n_in, void* d_out, int out_size, void* d_ws, size_t ws_size, hipStream_t stream) {
    static int grid = 0;
    if (grid == 0) {
        if (n_in != 32 || out_size != NB * SEQ * DM || ws_size < WS_END) { fprintf(stderr, "kernel_launch: unexpected shapes (n_in %d, out %d, ws %zu < %zu)\n", n_in, out_size, ws_size, (size_t)WS_END); grid = -1; return; }
        int dev = 0, cus = 0;
        if (hipGetDevice(&dev) != hipSuccess || hipDeviceGetAttribute(&cus, hipDeviceAttributeMultiprocessorCount, dev) != hipSuccess) { grid = -1; return; }
#define SETA(K) if (hipFuncSetAttribute((const void*)K, hipFuncAttributeMaxDynamicSharedMemorySize, LDS_BYTES) != hipSuccess) { fprintf(stderr, "kernel_launch: hipFuncSetAttribute failed\n"); grid = -1; return; }
#if N_LAUNCH_MODE == 1
        SETA(mk_fwd)
#else
        SETA(mk_phase<-1>) SETA(mk_phase<0>) SETA(mk_phase<1>) SETA(mk_phase<2>) SETA(mk_phase<3>) SETA(mk_phase<4>) SETA(mk_phase<5>) SETA(mk_phase<6>) SETA(mk_phase<7>) SETA(mk_phase<8>)
        SETA(mk_phase<9>) SETA(mk_phase<10>) SETA(mk_phase<11>) SETA(mk_phase<12>) SETA(mk_phase<13>) SETA(mk_phase<14>) SETA(mk_phase<15>) SETA(mk_phase<16>) SETA(mk_phase<17>)
#endif
#undef SETA
        int per_cu = 0;
        (void)per_cu;
        if (cus * MOE_MAXU < 2 * (NPAIR / 256 + 256)) { fprintf(stderr, "kernel_launch: too few CUs (%d) for the staged MoE row lists\n", cus); grid = -1; return; }
        grid = cus;
    }
    if (grid < 0) return;
    (void)hipMemsetAsync((char*)d_ws + WS_CTL, 0, CTL_ZERO_BYTES, stream);
    Args a{};
    for (int i = 0; i < 32; ++i) a.in[i] = (const float*)d_in[i];
    a.out = (float*)d_out; a.ws = (unsigned char*)d_ws;
#if N_LAUNCH_MODE == 1
    a.ph_lo = 0; a.ph_hi = N_PHASES;
    hipLaunchKernelGGL(mk_fwd, dim3(grid), dim3(NWAVES * 64), LDS_BYTES, stream, a);
#else
#define LAUNCH_P(P) hipLaunchKernelGGL(mk_phase<P>, dim3(grid), dim3(NWAVES * 64), LDS_BYTES, stream, a)
    a.ph_lo = 0; a.ph_hi = 0; LAUNCH_P(-1);
    for (int l = 0; l < DEPTH; ++l) { a.ph_lo = l;
        LAUNCH_P(0); LAUNCH_P(1); LAUNCH_P(2); LAUNCH_P(3); LAUNCH_P(4); LAUNCH_P(5); LAUNCH_P(6); LAUNCH_P(7); LAUNCH_P(8); LAUNCH_P(9); LAUNCH_P(10); LAUNCH_P(11); LAUNCH_P(12); LAUNCH_P(13); LAUNCH_P(14); LAUNCH_P(15); LAUNCH_P(16); LAUNCH_P(17); }
#undef LAUNCH_P
#endif
    const hipError_t le = hipPeekAtLastError();
    if (le != hipSuccess) fprintf(stderr, "kernel_launch: launch failed: %s\n", hipGetErrorName(le));
}
```

```cpp
#include <hip/hip_runtime.h>
#include <cstdio>
#include <cstdint>

#ifndef ATTN_V2
#define ATTN_V2 8
#endif
#ifndef REP_PRO
#define REP_PRO 0
#endif
#ifndef REP_MASK
#define REP_MASK 0
#endif
#ifndef REP_N
#define REP_N 2
#endif
#ifndef FAST_MIX
#define FAST_MIX 1
#endif
#ifndef FAST_WIN
#define FAST_WIN 1
#endif
#ifndef FAST_LRU
#define FAST_LRU 1
#endif
#define FAST_FFT 0
#ifndef FAST_FFT_A
#define FAST_FFT_A 1
#endif
#ifndef FAST_FFT_B
#define FAST_FFT_B 1
#endif
#ifndef FAST_MOE
#define FAST_MOE 1
#endif
#ifndef FAST_ATTN
#define FAST_ATTN 1
#endif
#ifndef N_LAUNCH_MODE
#define N_LAUNCH_MODE 1
#endif

__device__ __forceinline__ int otid() { int t = threadIdx.x; asm volatile("" : "+v"(t)); return t; }
__device__ __forceinline__ int obid() { int b = blockIdx.x; asm volatile("" : "+s"(b)); return b; }
__device__ __forceinline__ int ogrid() { int g = gridDim.x; asm volatile("" : "+s"(g)); return g; }
template <int M> __device__ __forceinline__ float sx(float v) {
    static_assert(M == 1 || M == 2 || M == 4 || M == 8 || M == 16 || M == 32, "xor mask");
    if constexpr (M < 32) return __uint_as_float((unsigned)__builtin_amdgcn_ds_swizzle((int)__float_as_uint(v), (M << 10) | 0x1f));
    else { auto rr = __builtin_amdgcn_permlane32_swap(__float_as_uint(v), __float_as_uint(v), false, false); const unsigned a = rr[0], b = rr[1]; return __uint_as_float(a == __float_as_uint(v) ? b : a); }
}
template <int M> __device__ __forceinline__ int sxi(int v) { return (int)__float_as_uint(sx<M>(__uint_as_float((unsigned)v))); }
namespace pg8 {
#define PG8_LAS __attribute__((address_space(3)))
typedef unsigned short bf16_t;
typedef short bf16x8 __attribute__((ext_vector_type(8)));
typedef float f32x4 __attribute__((ext_vector_type(4)));
typedef unsigned u32x4 __attribute__((ext_vector_type(4)));
constexpr int BM = 256, BK = 64, HALF = 128, HTB = HALF * BK * 2, STAGE_BYTES = 8 * HTB, NXCD = 8, WGM = 8;
__host__ __device__ __forceinline__ int lds_byte(int r, int c) { const int st = (r >> 4) * 2 + (c >> 5), rr = r & 15, cc = c & 31, ob = rr * 64 + cc * 2; return st * 1024 + (ob ^ (((ob >> 9) & 1) << 5)); }
__host__ __device__ __forceinline__ void stage_rc(int b, int& R, int& C) { const int st = b / 1024, sb = b % 1024, swz = sb ^ (((sb >> 9) & 1) << 5); R = (st >> 1) * 16 + swz / 64; C = (st & 1) * 32 + (swz % 64) / 2; }
__host__ __device__ __forceinline__ int perm32(int rho) { const int n = rho >> 4, i = rho & 15; return 8 * (i >> 2) + 4 * n + (i & 3); }
struct Unit { int pm, pn; };
struct Gemm { const bf16_t* A; const bf16_t* Bt; int M, N, K, lda, ldb; };
struct StaticOrder {
    int nM, nN, nwg, G, c; bool skipctx;
    __host__ __device__ void init(int M, int N, int G_, int c_, bool skip = false) { nM = skip ? 64 : M / BM; nN = N / BM; nwg = nM * nN; G = G_; c = c_; skipctx = skip; }
    __host__ __device__ bool next(int i, Unit& u) const {
        const long L = (long)i * G + c; if (L >= nwg) return false;
        int wgid = (int)L; { const int q = nwg / NXCD, r = nwg % NXCD, xcd = wgid % NXCD, off = wgid / NXCD; wgid = (xcd < r ? xcd * (q + 1) : r * (q + 1) + (xcd - r) * q) + off; }
        const int nig = WGM * nN, gid = wgid / nig, fm = gid * WGM, gsz = (nM - fm) < WGM ? (nM - fm) : WGM;
        u.pm = fm + ((wgid % nig) % gsz); u.pn = (wgid % nig) / gsz;
        if (skipctx) u.pm += 1 + (u.pm >= 32 ? 1 : 0);
        return true;
    }
};
__device__ __forceinline__ unsigned cvt_pk_bf16(float lo, float hi) { unsigned r; asm volatile("v_cvt_pk_bf16_f32 %0, %1, %2" : "=v"(r) : "v"(lo), "v"(hi)); return r; }

struct EpiF32 {
    static constexpr bool PERM = false; static constexpr int MIDK = 0;
    float* C; int ldc;
    __device__ __forceinline__ void operator()(const f32x4 (&acc)[2][2][4][2], const Unit& u, int wr, int wc, int fr, int fq) const {
        const int row0 = u.pm * BM + wr * 64 + fr, col0 = u.pn * BM + wc * 32 + 4 * fq;
#pragma unroll
        for (int ai = 0; ai < 2; ++ai)
#pragma unroll
            for (int m = 0; m < 4; ++m) { float* rowp = C + (size_t)(row0 + ai * HALF + m * 16) * ldc + col0;
#pragma unroll
                for (int bj = 0; bj < 2; ++bj)
#pragma unroll
                    for (int n = 0; n < 2; ++n) *(f32x4*)(rowp + bj * HALF + n * 16) = acc[ai][bj][m][n]; }
    }
};

template <class Epi>
__device__ __forceinline__ void gemm_phase(PG8_LAS unsigned char* lds, const Gemm g, const StaticOrder& S, const Epi& E) {
    const int tid = otid(), wid = __builtin_amdgcn_readfirstlane(tid >> 6), lane = tid & 63, wr = wid >> 2, wc = wid & 3, fr = lane & 15, fq = lane >> 4;
    const int K = g.K, nt = K / BK;
    unsigned voffA[2], voffB[2];
#pragma unroll
    for (int i = 0; i < 2; ++i) { int R, C; stage_rc(tid * 16 + i * 8192, R, C); const int Rb = Epi::PERM ? ((R & ~31) + perm32(R & 31)) : R;
        voffA[i] = (unsigned)(R * g.lda + C) * 2u; voffB[i] = (unsigned)(Rb * g.ldb + C) * 2u; }
    const size_t kstep = (size_t)(BK * 2);
    const size_t hA = (size_t)HALF * g.lda * 2, hB = (size_t)HALF * g.ldb * 2;
    const size_t tA = 2 * hA, tB = 2 * hB;
    const unsigned ldsw = (unsigned)wid * 1024u;
    const int aoff = lds_byte(wr * 64 + fr, fq * 8), boff = lds_byte(wc * 32 + fr, fq * 8);
#define PG8_SA(b, h) (((b) * 2 + (h)) * HTB)
#define PG8_SB(b, h) ((4 + (b) * 2 + (h)) * HTB)
#define PG8_STAGE(bufoff, gbase, voff) do { _Pragma("unroll") for (int _i = 0; _i < 2; ++_i) \
        __builtin_amdgcn_global_load_lds((const unsigned*)((const char*)(gbase) + (voff)[_i]), (PG8_LAS unsigned*)(lds + (bufoff) + ldsw + _i * 8192), 16, 0, 0); } while (0)
#define PG8_LDA(dst, b, h) do { _Pragma("unroll") for (int m = 0; m < 4; ++m) _Pragma("unroll") for (int k = 0; k < 2; ++k) dst[m][k] = *(const PG8_LAS bf16x8*)(lds + PG8_SA(b, h) + aoff + m * 2048 + k * 1024); } while (0)
#define PG8_LDB(dst, b, h) do { _Pragma("unroll") for (int n = 0; n < 2; ++n) _Pragma("unroll") for (int k = 0; k < 2; ++k) dst[n][k] = *(const PG8_LAS bf16x8*)(lds + PG8_SB(b, h) + boff + n * 2048 + k * 1024); } while (0)
#define PG8_MMA(ai, bj, At, Bt) do { __builtin_amdgcn_s_setprio(1); _Pragma("unroll") for (int m = 0; m < 4; ++m) _Pragma("unroll") for (int n = 0; n < 2; ++n) _Pragma("unroll") for (int k = 0; k < 2; ++k) \
        acc[ai][bj][m][n] = __builtin_amdgcn_mfma_f32_16x16x32_bf16(Bt[n][k], At[m][k], acc[ai][bj][m][n], 0, 0, 0); __builtin_amdgcn_s_setprio(0); } while (0)
#define PG8_WAIT_V(n) asm volatile("s_waitcnt vmcnt(" #n ")" ::: "memory")
#define PG8_WAIT_L(n) asm volatile("s_waitcnt lgkmcnt(" #n ")" ::: "memory")
#define PG8_BAR __builtin_amdgcn_s_barrier()
#define PG8_SCHED __builtin_amdgcn_sched_barrier(0)
    Unit cur, nxt; int ui = 0;
    if (!S.next(0, cur)) return;
    f32x4 acc[2][2][4][2];
#pragma unroll
    for (int a = 0; a < 2; ++a)
#pragma unroll
        for (int b = 0; b < 2; ++b)
#pragma unroll
            for (int m = 0; m < 4; ++m)
#pragma unroll
                for (int n = 0; n < 2; ++n) acc[a][b][m][n] = (f32x4){0.f, 0.f, 0.f, 0.f};
    bf16x8 At[4][2], B0[2][2], B1[2][2];
    const char* cA = (const char*)g.A + (size_t)cur.pm * tA; const char* cB = (const char*)g.Bt + (size_t)cur.pn * tB;
    PG8_STAGE(PG8_SB(0, 0), cB, voffB); PG8_STAGE(PG8_SB(0, 1), cB + hB, voffB); PG8_STAGE(PG8_SA(0, 0), cA, voffA); PG8_STAGE(PG8_SA(0, 1), cA + hA, voffA);
    if (wr == 1) PG8_BAR;
    PG8_WAIT_V(2); PG8_BAR;
    PG8_STAGE(PG8_SB(1, 0), cB + kstep, voffB); PG8_STAGE(PG8_SA(1, 0), cA + kstep, voffA); PG8_STAGE(PG8_SB(1, 1), cB + hB + kstep, voffB);
    PG8_WAIT_V(6); PG8_BAR;
    for (;;) {
        const bool has_next = S.next(ui + 1, nxt);
        const char* nA = has_next ? (const char*)g.A + (size_t)nxt.pm * tA : cA; const char* nB = has_next ? (const char*)g.Bt + (size_t)nxt.pn * tB : cB;
#pragma unroll 1
        for (int t = 0; t < nt; t += 2) {
            if constexpr (Epi::MIDK > 0) { if (t > 0 && (t % Epi::MIDK) == 0) E.mid(acc, cur, wr, wc, fr, fq, t / Epi::MIDK); }
            const bool last = (t == nt - 2);
            const char* a1 = cA + (size_t)(t + 1) * kstep;
            const char* a2 = last ? nA : cA + (size_t)(t + 2) * kstep; const char* b2 = last ? nB : cB + (size_t)(t + 2) * kstep;
            const char* a3 = a2 + kstep; const char* b3 = b2 + kstep;
            PG8_LDB(B0, 0, 0); PG8_LDB(B1, 0, 1); PG8_SCHED; PG8_LDA(At, 0, 0); PG8_STAGE(PG8_SA(1, 1), a1 + hA, voffA);
            PG8_WAIT_V(8); PG8_WAIT_L(0); PG8_BAR; PG8_MMA(0, 0, At, B0); PG8_MMA(0, 1, At, B1); PG8_BAR; PG8_SCHED;
            PG8_LDA(At, 0, 1); PG8_STAGE(PG8_SB(0, 0), b2, voffB); PG8_STAGE(PG8_SB(0, 1), b2 + hB, voffB); PG8_STAGE(PG8_SA(0, 0), a2, voffA);
            PG8_WAIT_V(8); PG8_WAIT_L(0); PG8_BAR; PG8_MMA(1, 0, At, B0); PG8_MMA(1, 1, At, B1); PG8_BAR; PG8_SCHED;
            PG8_LDB(B0, 1, 0); PG8_LDB(B1, 1, 1); PG8_SCHED; PG8_LDA(At, 1, 0); PG8_STAGE(PG8_SA(0, 1), a2 + hA, voffA);
            PG8_WAIT_V(8); PG8_WAIT_L(0); PG8_BAR; PG8_MMA(0, 0, At, B0); PG8_MMA(0, 1, At, B1); PG8_BAR; PG8_SCHED;
            PG8_LDA(At, 1, 1); PG8_STAGE(PG8_SB(1, 0), b3, voffB); PG8_STAGE(PG8_SB(1, 1), b3 + hB, voffB); PG8_STAGE(PG8_SA(1, 0), a3, voffA);
            PG8_WAIT_V(8); PG8_WAIT_L(0); PG8_BAR; PG8_MMA(1, 0, At, B0); PG8_MMA(1, 1, At, B1); PG8_BAR; PG8_SCHED;
        }
        if (wr == 0) PG8_BAR;
        E(acc, cur, wr, wc, fr, fq);
        if (!has_next) break;
#pragma unroll
        for (int a = 0; a < 2; ++a)
#pragma unroll
            for (int b = 0; b < 2; ++b)
#pragma unroll
                for (int m = 0; m < 4; ++m)
#pragma unroll
                    for (int n = 0; n < 2; ++n) acc[a][b][m][n] = (f32x4){0.f, 0.f, 0.f, 0.f};
        cur = nxt; cA = nA; cB = nB; ++ui;
        if (wr == 1) PG8_BAR;
    }
    PG8_WAIT_V(0);
    PG8_BAR;
#undef PG8_SA
#undef PG8_SB
#undef PG8_STAGE
#undef PG8_LDA
#undef PG8_LDB
#undef PG8_MMA
#undef PG8_WAIT_V
#undef PG8_WAIT_L
#undef PG8_BAR
#undef PG8_SCHED
}

struct UnitG { const char* a; const char* b; int row0, pn, e, valid; const int* rows; const PG8_LAS int* lrows; };
template <class Epi, class Sched, bool GATHER>
__device__ __forceinline__ void gemm_phase_g(PG8_LAS unsigned char* lds, const int K, const int lda, const int ldb, const Sched& S, const Epi& E) {
    const int tid = otid(), wid = __builtin_amdgcn_readfirstlane(tid >> 6), lane = tid & 63, wr = wid >> 2, wc = wid & 3, fr = lane & 15, fq = lane >> 4;
    const int nt = K / BK;
    int RA[2], CA[2]; unsigned voffB[2];
#pragma unroll
    for (int i = 0; i < 2; ++i) { int R, C; stage_rc(tid * 16 + i * 8192, R, C); const int Rb = Epi::PERM ? ((R & ~31) + perm32(R & 31)) : R;
        RA[i] = R; CA[i] = C; voffB[i] = (unsigned)(Rb * ldb + C) * 2u; }
    const size_t kstep = (size_t)(BK * 2);
    const size_t hB = (size_t)HALF * ldb * 2;
    const unsigned ldsw = (unsigned)wid * 1024u;
    const int aoff = lds_byte(wr * 64 + fr, fq * 8), boff = lds_byte(wc * 32 + fr, fq * 8);
#define PG8_SA(b, h) (((b) * 2 + (h)) * HTB)
#define PG8_SB(b, h) ((4 + (b) * 2 + (h)) * HTB)
#define PG8_STAGE(bufoff, gbase, voff) do { _Pragma("unroll") for (int _i = 0; _i < 2; ++_i) \
        __builtin_amdgcn_global_load_lds((const unsigned*)((const char*)(gbase) + (voff)[_i]), (PG8_LAS unsigned*)(lds + (bufoff) + ldsw + _i * 8192), 16, 0, 0); } while (0)
#define PG8_LDA(dst, b, h) do { _Pragma("unroll") for (int m = 0; m < 4; ++m) _Pragma("unroll") for (int k = 0; k < 2; ++k) dst[m][k] = *(const PG8_LAS bf16x8*)(lds + PG8_SA(b, h) + aoff + m * 2048 + k * 1024); } while (0)
#define PG8_LDB(dst, b, h) do { _Pragma("unroll") for (int n = 0; n < 2; ++n) _Pragma("unroll") for (int k = 0; k < 2; ++k) dst[n][k] = *(const PG8_LAS bf16x8*)(lds + PG8_SB(b, h) + boff + n * 2048 + k * 1024); } while (0)
#define PG8_MMA(ai, bj, At, Bt) do { __builtin_amdgcn_s_setprio(1); _Pragma("unroll") for (int m = 0; m < 4; ++m) _Pragma("unroll") for (int n = 0; n < 2; ++n) _Pragma("unroll") for (int k = 0; k < 2; ++k) \
        acc[ai][bj][m][n] = __builtin_amdgcn_mfma_f32_16x16x32_bf16(Bt[n][k], At[m][k], acc[ai][bj][m][n], 0, 0, 0); __builtin_amdgcn_s_setprio(0); } while (0)
#define PG8_WAIT_V(n) asm volatile("s_waitcnt vmcnt(" #n ")" ::: "memory")
#define PG8_WAIT_L(n) asm volatile("s_waitcnt lgkmcnt(" #n ")" ::: "memory")
#define PG8_BAR __builtin_amdgcn_s_barrier()
#define PG8_SCHED __builtin_amdgcn_sched_barrier(0)
#define PG8_MKOFF(u, v) do { _Pragma("unroll") for (int _h = 0; _h < 2; ++_h) _Pragma("unroll") for (int _i = 0; _i < 2; ++_i) { const int _row = _h * HALF + RA[_i]; \
        if (GATHER) { const int _pr = (u).lrows[_row]; v[_h][_i] = (unsigned)(_pr >> 3) * (unsigned)(lda * 2) + (unsigned)(CA[_i] * 2); } \
        else v[_h][_i] = (unsigned)(_row * lda + CA[_i]) * 2u; } } while (0)
    UnitG cur, nxt; int ui = 0;
    if (!S.next(0, cur)) return;
    f32x4 acc[2][2][4][2];
#pragma unroll
    for (int a = 0; a < 2; ++a)
#pragma unroll
        for (int b = 0; b < 2; ++b)
#pragma unroll
            for (int m = 0; m < 4; ++m)
#pragma unroll
                for (int n = 0; n < 2; ++n) acc[a][b][m][n] = (f32x4){0.f, 0.f, 0.f, 0.f};
    bf16x8 At[4][2], B0[2][2], B1[2][2];
    unsigned vA[2][2], vN[2][2];
    PG8_MKOFF(cur, vA);
    const char* cA = cur.a; const char* cB = cur.b;
    PG8_STAGE(PG8_SB(0, 0), cB, voffB); PG8_STAGE(PG8_SB(0, 1), cB + hB, voffB); PG8_STAGE(PG8_SA(0, 0), cA, vA[0]); PG8_STAGE(PG8_SA(0, 1), cA, vA[1]);
    if (wr == 1) PG8_BAR;
    PG8_WAIT_V(2); PG8_BAR;
    PG8_STAGE(PG8_SB(1, 0), cB + kstep, voffB); PG8_STAGE(PG8_SA(1, 0), cA + kstep, vA[0]); PG8_STAGE(PG8_SB(1, 1), cB + hB + kstep, voffB);
    PG8_WAIT_V(6); PG8_BAR;
    for (;;) {
        const bool has_next = S.next(ui + 1, nxt);
        if constexpr (GATHER) { if (has_next) { PG8_MKOFF(nxt, vN); } else { vN[0][0] = vA[0][0]; vN[0][1] = vA[0][1]; vN[1][0] = vA[1][0]; vN[1][1] = vA[1][1]; } }
        const char* nA = has_next ? nxt.a : cA; const char* nB = has_next ? nxt.b : cB;
#pragma unroll 1
        for (int t = 0; t < nt; t += 2) {
            const bool last = (t == nt - 2);
            const char* a1 = cA + (size_t)(t + 1) * kstep;
            const char* a2 = last ? nA : cA + (size_t)(t + 2) * kstep; const char* b2 = last ? nB : cB + (size_t)(t + 2) * kstep;
            const char* a3 = a2 + kstep; const char* b3 = b2 + kstep;
            unsigned s0[2], s1[2];
            if constexpr (GATHER) { s0[0] = last ? vN[0][0] : vA[0][0]; s0[1] = last ? vN[0][1] : vA[0][1]; s1[0] = last ? vN[1][0] : vA[1][0]; s1[1] = last ? vN[1][1] : vA[1][1]; }
            else { s0[0] = vA[0][0]; s0[1] = vA[0][1]; s1[0] = vA[1][0]; s1[1] = vA[1][1]; }
            PG8_LDB(B0, 0, 0); PG8_LDB(B1, 0, 1); PG8_SCHED; PG8_LDA(At, 0, 0); PG8_STAGE(PG8_SA(1, 1), a1, vA[1]);
            PG8_WAIT_V(8); PG8_WAIT_L(0); PG8_BAR; PG8_MMA(0, 0, At, B0); PG8_MMA(0, 1, At, B1); PG8_BAR; PG8_SCHED;
            PG8_LDA(At, 0, 1); PG8_STAGE(PG8_SB(0, 0), b2, voffB); PG8_STAGE(PG8_SB(0, 1), b2 + hB, voffB); PG8_STAGE(PG8_SA(0, 0), a2, s0);
            PG8_WAIT_V(8); PG8_WAIT_L(0); PG8_BAR; PG8_MMA(1, 0, At, B0); PG8_MMA(1, 1, At, B1); PG8_BAR; PG8_SCHED;
            PG8_LDB(B0, 1, 0); PG8_LDB(B1, 1, 1); PG8_SCHED; PG8_LDA(At, 1, 0); PG8_STAGE(PG8_SA(0, 1), a2, s1);
            PG8_WAIT_V(8); PG8_WAIT_L(0); PG8_BAR; PG8_MMA(0, 0, At, B0); PG8_MMA(0, 1, At, B1); PG8_BAR; PG8_SCHED;
            PG8_LDA(At, 1, 1); PG8_STAGE(PG8_SB(1, 0), b3, voffB); PG8_STAGE(PG8_SB(1, 1), b3 + hB, voffB); PG8_STAGE(PG8_SA(1, 0), a3, s0);
            PG8_WAIT_V(8); PG8_WAIT_L(0); PG8_BAR; PG8_MMA(1, 0, At, B0); PG8_MMA(1, 1, At, B1); PG8_BAR; PG8_SCHED;
        }
        if (wr == 0) PG8_BAR;
        E(acc, cur, wr, wc, fr, fq);
        if (!has_next) break;
#pragma unroll
        for (int a = 0; a < 2; ++a)
#pragma unroll
            for (int b = 0; b < 2; ++b)
#pragma unroll
                for (int m = 0; m < 4; ++m)
#pragma unroll
                    for (int n = 0; n < 2; ++n) acc[a][b][m][n] = (f32x4){0.f, 0.f, 0.f, 0.f};
        cur = nxt; cA = nA; cB = nB; ++ui;
        if constexpr (GATHER) { vA[0][0] = vN[0][0]; vA[0][1] = vN[0][1]; vA[1][0] = vN[1][0]; vA[1][1] = vN[1][1]; }
        if (wr == 1) PG8_BAR;
    }
    PG8_WAIT_V(0);
    PG8_BAR;
#undef PG8_SA
#undef PG8_SB
#undef PG8_STAGE
#undef PG8_LDA
#undef PG8_LDB
#undef PG8_MMA
#undef PG8_WAIT_V
#undef PG8_WAIT_L
#undef PG8_BAR
#undef PG8_SCHED
#undef PG8_MKOFF
}
}

constexpr int DM = 1024, NB = 2, SEQ = 8192, CTX = 256, TPB = SEQ + CTX, MROWS = NB * TPB, DEPTH = 2;
constexpr int INW = 9216, COL_K = 0, COL_V = 1024, COL_LX = 2048, COL_Q = 3072, COL_LG = 4096, COL_F = 5120, COL_G = 6144;
constexpr int NE = 256, TOPK = 8, EFF = 256, NPAIR = MROWS * TOPK, LCAP = MROWS;
constexpr float EPS = 1e-6f;
constexpr float QSCALE = 0.125f * 1.4426950408889634f;
constexpr int NCHUNK = TPB / 64;
static_assert(MROWS % 256 == 0, "rows");

constexpr size_t MiB = 1u << 20;
constexpr size_t WS_CTL = 0, CTL_ZERO_BYTES = 1 * MiB;
constexpr size_t WS_W = 1 * MiB, WL_STRIDE = 32 * MiB;
constexpr size_t WO_TAB = 31 * MiB;
constexpr size_t WO_WIN = 0, WO_D1 = 18 * MiB, WO_OUT = 24 * MiB, WO_R = 26 * MiB, WO_SGU = 27 * MiB, WO_SD = 28 * MiB, WO_LRU = 29 * MiB;
constexpr size_t WS_XALL = 65 * MiB;
constexpr size_t WS_H = WS_XALL + 66 * MiB;
constexpr size_t WS_U = WS_H + 33 * MiB;
constexpr size_t WS_KB = WS_U + 594 * MiB, WS_VB = WS_KB + 33 * MiB, WS_QB = WS_VB + 33 * MiB, WS_LXB = WS_QB + 33 * MiB, WS_GLG = WS_LXB + 33 * MiB, WS_ZP = WS_GLG + 33 * MiB;
constexpr size_t WS_GATES = WS_ZP + 33 * MiB;
constexpr size_t WS_MIXIN = WS_GATES + 99 * MiB;
constexpr size_t WS_S = WS_MIXIN + 99 * MiB;
constexpr size_t WS_UC = WS_S, WS_AB = WS_UC + 33 * MiB, WS_SUMM = WS_AB + 132 * MiB, WS_CARRY = WS_SUMM + 5 * MiB, WS_XA = WS_CARRY + 3 * MiB, WS_XB = WS_XA + 32 * MiB, WS_GB = WS_XB + 32 * MiB, WS_GC = WS_GB + 32 * MiB;
constexpr size_t WS_PA = WS_S, WS_PR = WS_PA + 66 * MiB, WS_PF = WS_PR + 66 * MiB, WS_Y1 = WS_PF + 66 * MiB;
static_assert(WS_GC + 3 * MiB <= WS_S + 280 * MiB && WS_Y1 + 66 * MiB <= WS_S + 280 * MiB, "scratch S");
constexpr size_t WS_MIXED = WS_S + 280 * MiB, WS_TOK = WS_MIXED + 33 * MiB;
constexpr size_t WS_LOG = WS_TOK + 33 * MiB, WS_SGU = WS_LOG + 17 * MiB, WS_SH = WS_SGU + 33 * MiB, WS_LIST = WS_SH + 9 * MiB, WS_TOPW = WS_LIST + 17 * MiB, WS_SD = WS_TOPW + 1 * MiB;
constexpr size_t WS_YB = WS_U;
constexpr size_t WS_Y16 = WS_KB, WS_HB = WS_S;
constexpr size_t WS_EP = WS_SUMM;
constexpr size_t WS_Y16_OLD = WS_U;
constexpr size_t WS_EW = WS_SD + 66 * MiB, WS_EW1 = WS_U, EW_STRIDE = 3 * MiB / 2;
#define EWL(l) (((l) & 1) ? WS_EW1 : WS_EW)
static_assert(WS_KB + 396 * MiB == WS_S && 392 * MiB <= 396 * MiB && WS_U + 384 * MiB <= WS_KB, "overlays");
constexpr size_t WS_END = WS_EW + 384 * MiB;
static_assert(WS_END <= 2048 * MiB, "d_ws budget");
constexpr int CW_BAR = 4096;
constexpr int CW_CNT = 16384, CNT_STRIDE = 32;
constexpr int CW_MOD = 65536;
static_assert((CW_MOD + 2 * 3 * 6144) * 4 <= (int)CTL_ZERO_BYTES, "ctl");

constexpr int LDS_BYTES = 147456, RING_BYTES = 131072, MISC_OFF = RING_BYTES + 320;
constexpr int NWAVES = 8;

#define GAS __attribute__((address_space(1)))
#define LAS __attribute__((address_space(3)))
typedef unsigned short bf16;
typedef unsigned v4u __attribute__((ext_vector_type(4)));
typedef float f32x4 __attribute__((ext_vector_type(4)));
typedef GAS unsigned gu32;
#define RLX_AGENT __ATOMIC_RELAXED, __HIP_MEMORY_SCOPE_AGENT
#define LDS_WAIT() asm volatile("s_waitcnt lgkmcnt(0)" ::: "memory")
typedef float f32x2_t __attribute__((ext_vector_type(2))); typedef __bf16 bf16x2_t __attribute__((ext_vector_type(2)));
__device__ __forceinline__ unsigned pk2(float lo, float hi) { const f32x2_t v = {lo, hi}; const bf16x2_t b = __builtin_convertvector(v, bf16x2_t); return __builtin_bit_cast(unsigned, b); }
__device__ __forceinline__ unsigned f2bf(float f) { return pk2(f, f) & 0xffffu; }
__device__ __forceinline__ float bf2f(unsigned h) { return __uint_as_float(h << 16); }
__device__ __forceinline__ float sigmoidf_(float x) { return __builtin_amdgcn_rcpf(1.f + __expf(-x)); }
__device__ __forceinline__ float siluf_(float x) { return x * __builtin_amdgcn_rcpf(1.f + __expf(-x)); }
__device__ __forceinline__ float gelu_tanh(float x) { const float u = 0.7978845608028654f * (x + 0.044715f * x * x * x); return x * __builtin_amdgcn_rcpf(1.f + __expf(-2.f * u)); }

#define XB_TMO      128
#define XB_XCNT(j)  (256  + 64 * (j))
#define XB_XSUB(j)  (1280 + 64 * (j))
#define XB_XGEN(j)  (2304 + 64 * (j))
#define XB_TOP      3328
#define XB_TOPGEN   3392
#define XCD_BAR_WORDS 3456
#define XB_SPIN_CAP (1u << 18)
__device__ __forceinline__ unsigned xb_ld(unsigned* p)              { return __hip_atomic_load(p, __ATOMIC_RELAXED, __HIP_MEMORY_SCOPE_AGENT); }
__device__ __forceinline__ unsigned xb_add(unsigned* p, unsigned v) { return __hip_atomic_fetch_add(p, v, __ATOMIC_RELAXED, __HIP_MEMORY_SCOPE_AGENT); }
__device__ __forceinline__ unsigned xb_xcc_id() { return (unsigned)__builtin_amdgcn_s_getreg((3 << 11) | 20) & 0xFu; }
#define XB_SPIN(cond, bar) do { unsigned _sp = 0; while (cond) { __builtin_amdgcn_s_sleep(1); \
    if ((++_sp & 255u) == 0u) { if (xb_ld(&(bar)[XB_TMO])) break; if (_sp > XB_SPIN_CAP) { atomicAdd(&(bar)[XB_TMO], 1u); break; } } } } while (0)
struct XcdBarrier { unsigned* bar; unsigned x; volatile LAS unsigned* st; };
__device__ __forceinline__ XcdBarrier xcd_barrier_post(unsigned* bar, volatile LAS unsigned* st) {
    XcdBarrier b; b.bar = bar; b.x = xb_xcc_id(); b.st = st;
    if (threadIdx.x == 0) (void)xb_add(&bar[XB_XCNT(b.x)], 1u);
    return b;
}
__device__ __forceinline__ void xcd_barrier_complete(unsigned* bar, unsigned x, unsigned& nloc, unsigned& nx) {
    const unsigned G = gridDim.x * gridDim.y * gridDim.z;
    unsigned sum, cnt, mine, sp = 0u;
    for (;;) {
        sum = 0u; cnt = 0u; mine = 0u;
#pragma unroll
        for (unsigned j = 0; j < 16; ++j) { const unsigned c = xb_ld(&bar[XB_XCNT(j)]); sum += c; cnt += (c > 0u) ? 1u : 0u; mine = (j == x) ? c : mine; }
        if (sum == G) break;
        __builtin_amdgcn_s_sleep(1);
        if ((++sp & 255u) == 0u) { if (xb_ld(&bar[XB_TMO])) break; if (sp > XB_SPIN_CAP) { atomicAdd(&bar[XB_TMO], 1u); break; } }
    }
    nloc = mine > 0u ? mine : 1u; nx = cnt > 0u ? cnt : 1u;
}
__device__ __forceinline__ void xcd_barrier(const XcdBarrier& b) {
    asm volatile("s_waitcnt vmcnt(0)" ::: "memory");
    __syncthreads();
    if (threadIdx.x == 0) {
        unsigned* bar = b.bar; asm volatile("" : "+s"(bar));
        __builtin_amdgcn_s_waitcnt(0);
        unsigned nloc = b.st[0], nx = b.st[1];
        unsigned bx = b.x; asm volatile("" : "+s"(bx));
        if (nloc == 0u) { xcd_barrier_complete(bar, bx, nloc, nx); b.st[0] = nloc; b.st[1] = nx; }
        const unsigned old = xb_add(&bar[XB_XSUB(bx)], 1u);
        const unsigned gen = old / nloc;
        if (old + 1u == (gen + 1u) * nloc) {
            __builtin_amdgcn_fence(__ATOMIC_RELEASE, "agent");
            asm volatile("s_waitcnt vmcnt(0)" ::: "memory");
            const unsigned og = xb_add(&bar[XB_TOP], 1u);
            const unsigned tg = og / nx;
            if (og + 1u == (tg + 1u) * nx) xb_add(&bar[XB_TOPGEN], 1u);
            else XB_SPIN(xb_ld(&bar[XB_TOPGEN]) == tg, bar);
            __builtin_amdgcn_fence(__ATOMIC_ACQUIRE, "agent");
            xb_add(&bar[XB_XGEN(bx)], 1u);
            asm volatile("s_waitcnt vmcnt(0)" ::: "memory");
        } else {
            XB_SPIN(xb_ld(&bar[XB_XGEN(bx)]) == gen, bar);
            __builtin_amdgcn_fence(__ATOMIC_ACQUIRE, "agent");
            asm volatile("s_waitcnt vmcnt(0)" ::: "memory");
        }
    }
    __syncthreads();
}

struct Args { const float* in[32]; float* out; unsigned char* ws; int ph_lo, ph_hi; };
struct Frame { LAS unsigned char* lds; int tid, lane, wave, bid, G, gw, NGW; long gtid, NT; };
#define WSP(T, off) ((T*)(A.ws + (off)))
#define WLP(l, off) ((bf16*)(A.ws + WS_W + (size_t)(l) * WL_STRIDE + (off)))
#define MODP(l, s, j) ((const float*)(A.ws + WS_CTL) + CW_MOD + ((l) * 3 + (s)) * 6144 + (j) * 1024)

__device__ __forceinline__ float wave_sum(float v) {
    v += sx<1>(v); v += sx<2>(v); v += sx<4>(v); v += sx<8>(v); v += sx<16>(v); v += sx<32>(v);
    return v;
}
__device__ __forceinline__ int win_row(int c) {
    const int sec = c >> 10; if (sec != 0 && sec != 3) return c;
    const int L = c & 255, g = L >> 6, a = (L >> 5) & 1, x = (L >> 4) & 1, q = (L >> 2) & 3, e = L & 3;
    return (c & ~255) | (128 * a + 32 * g + 8 * q + 4 * x + e);
}
template <bool WINMAP = false>
__device__ __forceinline__ void p0_transpose_item(const float* W, int K, int N, bf16* WT, int ldwt, int row_off, int col_off, LAS float* scr, int item, int lane) {
    const int nblk = N / 32, kb = item / nblk, nb = item % nblk, k0 = 64 * kb, n0 = 32 * nb;
    { f32x4 v[8]; const int rr = lane >> 3, c4 = (lane & 7) * 4;
#pragma unroll
      for (int i = 0; i < 8; ++i) v[i] = *(const f32x4*)(W + (size_t)(k0 + 8 * i + rr) * N + n0 + c4);
#pragma unroll
      for (int i = 0; i < 8; ++i) { LAS float* d = scr + (8 * i + rr) * 33 + c4; d[0] = v[i].x; d[1] = v[i].y; d[2] = v[i].z; d[3] = v[i].w; } }
    LDS_WAIT(); asm volatile("" ::: "memory");
    const int c = lane & 7;
#pragma unroll
    for (int j = 0; j < 4; ++j) { const int n = (lane >> 3) + 8 * j; const LAS float* s = scr + (8 * c) * 33 + n;
        v4u o; o.x = pk2(s[0 * 33], s[1 * 33]); o.y = pk2(s[2 * 33], s[3 * 33]); o.z = pk2(s[4 * 33], s[5 * 33]); o.w = pk2(s[6 * 33], s[7 * 33]);
        const int rr = WINMAP ? win_row(n0 + n) : n0 + n;
        *(v4u*)(WT + (size_t)(row_off + rr) * ldwt + col_off + k0 + 8 * c) = o; }
    LDS_WAIT(); asm volatile("" ::: "memory");
}

struct PItem { const float* W; bf16* WT; int N, ldwt, k0, n0, rowbase; bool winmap, skip; };
constexpr int PRO_I_WIN = 16 * 288, PRO_I_SQ = 16 * 32, PRO_I_R = 16 * 8, PRO_I_SD = 4 * 32, PRO_PER_L = PRO_I_WIN + 4 * PRO_I_SQ + 3 * PRO_I_R + PRO_I_SD;
__device__ __forceinline__ void pi_set(PItem& t, const float* W, int N, bf16* WT, int ldwt, int row_off, int col_off, int item) {
    const int nblk = N / 32, kb = item / nblk, nb = item % nblk; t.W = W; t.N = N; t.WT = WT + col_off; t.ldwt = ldwt; t.k0 = 64 * kb; t.n0 = 32 * nb; t.rowbase = row_off; }
__device__ __forceinline__ PItem pro_item(const Args& A, int it) {
    const int l = it / PRO_PER_L; int r = it % PRO_PER_L; PItem t; t.winmap = false; t.skip = false;
    if (r < PRO_I_WIN) { const int nb = r % 288; t.skip = nb >= 160 && nb < 192; t.winmap = true;
        pi_set(t, A.in[7] + (size_t)l * 1024 * 9216, 9216, WLP(l, WO_WIN), 1024, 0, 0, r); return t; } r -= PRO_I_WIN;
    if (r < PRO_I_SQ) { pi_set(t, A.in[12] + (size_t)l * 1048576, 1024, WLP(l, WO_D1), 3072, 0, 0, r); return t; } r -= PRO_I_SQ;
    if (r < PRO_I_SQ) { pi_set(t, A.in[20] + (size_t)l * 1048576, 1024, WLP(l, WO_D1), 3072, 0, 1024, r); return t; } r -= PRO_I_SQ;
    if (r < PRO_I_SQ) { pi_set(t, A.in[21] + (size_t)l * 1048576, 1024, WLP(l, WO_D1), 3072, 0, 2048, r); return t; } r -= PRO_I_SQ;
    if (r < PRO_I_SQ) { pi_set(t, A.in[22] + (size_t)l * 1048576, 1024, WLP(l, WO_OUT), 1024, 0, 0, r); return t; } r -= PRO_I_SQ;
    if (r < PRO_I_R) { pi_set(t, A.in[24] + (size_t)l * 262144, 256, WLP(l, WO_R), 1024, 0, 0, r); return t; } r -= PRO_I_R;
    if (r < PRO_I_R) { pi_set(t, A.in[29] + (size_t)l * 262144, 256, WLP(l, WO_R), 1024, 256 + ((r % 8) >> 2) * 128, 0, r); return t; } r -= PRO_I_R;
    if (r < PRO_I_R) { pi_set(t, A.in[30] + (size_t)l * 262144, 256, WLP(l, WO_R), 1024, 384 + ((r % 8) >> 2) * 128, 0, r); return t; } r -= PRO_I_R;
    pi_set(t, A.in[31] + (size_t)l * 262144, 1024, WLP(l, WO_SD), 256, 0, 0, r); return t;
}
__device__ __forceinline__ void pi_load(const PItem& t, f32x4 (&v)[8], int lane) {
    const int rr = lane >> 3, c4 = (lane & 7) * 4;
#pragma unroll
    for (int i = 0; i < 8; ++i) v[i] = *(const f32x4*)(t.W + (size_t)(t.k0 + 8 * i + rr) * t.N + t.n0 + c4);
}
__device__ __forceinline__ void pi_store(const PItem& t, const f32x4 (&v)[8], LAS float* scr, int lane) {
    const int rr = lane >> 3, c4 = (lane & 7) * 4;
#pragma unroll
    for (int i = 0; i < 8; ++i) { LAS float* d = scr + (8 * i + rr) * 33 + c4; d[0] = v[i].x; d[1] = v[i].y; d[2] = v[i].z; d[3] = v[i].w; }
    LDS_WAIT(); asm volatile("" ::: "memory");
    const int c = lane & 7;
#pragma unroll
    for (int j = 0; j < 4; ++j) { const int n = (lane >> 3) + 8 * j; const LAS float* sp = scr + (8 * c) * 33 + n;
        v4u o; o.x = pk2(sp[0 * 33], sp[1 * 33]); o.y = pk2(sp[2 * 33], sp[3 * 33]); o.z = pk2(sp[4 * 33], sp[5 * 33]); o.w = pk2(sp[6 * 33], sp[7 * 33]);
        const int row = t.winmap ? win_row(t.n0 + n) : t.n0 + n;
        *(v4u*)(t.WT + (size_t)(t.rowbase + row) * t.ldwt + t.k0 + 8 * c) = o; }
    LDS_WAIT(); asm volatile("" ::: "memory");
}

__device__ __forceinline__ void ph_prologue(const Frame& F, const Args& A) {
    LAS float* scr = (LAS float*)(F.lds + F.wave * 16384);
    { const int stride = F.NGW, hi = 2 * PRO_PER_L; int it = F.gw;
      if (it < hi) { PItem t0 = pro_item(A, it), t1 = t0; f32x4 v0[8], v1[8]; bool h1 = it + stride < hi;
        if (!t0.skip) pi_load(t0, v0, F.lane);
        for (;;) {
            if (h1) { t1 = pro_item(A, it + stride); if (!t1.skip) pi_load(t1, v1, F.lane); }
            if (!t0.skip) pi_store(t0, v0, scr, F.lane);
            if (!h1) break;
#pragma unroll
            for (int i = 0; i < 8; ++i) v0[i] = v1[i];
            t0 = t1; it += stride; h1 = it + stride < hi; } } }
#if FAST_WIN
    {
        LAS float* sW = (LAS float*)F.lds; LAS float* sT = sW + 32 * 256;
        __syncthreads();
        if (F.tid < 256) sT[F.tid] = cospif((float)F.tid / 128.0f);
        for (int it = F.bid; it < 2 * 4 * 32; it += F.G) {
            const int l = it >> 7, g = (it >> 5) & 3, k0 = (it & 31) * 32;
            __syncthreads();
            for (int e = F.tid; e < 32 * 256; e += 512) sW[e] = A.in[7][((size_t)l * 1024 + k0 + (e >> 8)) * 9216 + COL_F + g * 256 + (e & 255)];
            __syncthreads();
            const int o = F.tid & 255, kh = F.tid >> 8; int j = o >> 1, odd = o & 1; if (o == 1) { j = 128; odd = 0; }
            const int m0 = odd ? 192 : 0; float acc[16];
#pragma unroll
            for (int q = 0; q < 16; ++q) acc[q] = 0.f;
            for (int c = 0; c < 256; c += 4) { const float r0 = sT[(j * c + m0) & 255], r1 = sT[(j * (c + 1) + m0) & 255], r2 = sT[(j * (c + 2) + m0) & 255], r3 = sT[(j * (c + 3) + m0) & 255];
#pragma unroll
                for (int q = 0; q < 16; ++q) { const f32x4 w = *(const LAS f32x4*)(sW + (kh * 16 + q) * 256 + c); acc[q] += w.x * r0; acc[q] += w.y * r1; acc[q] += w.z * r2; acc[q] += w.w * r3; } }
            bf16* dst = WLP(l, WO_WIN) + (size_t)(COL_F + g * 256 + o) * 1024 + k0 + kh * 16;
            v4u w0, w1; w0.x = pk2(acc[0], acc[1]); w0.y = pk2(acc[2], acc[3]); w0.z = pk2(acc[4], acc[5]); w0.w = pk2(acc[6], acc[7]);
            w1.x = pk2(acc[8], acc[9]); w1.y = pk2(acc[10], acc[11]); w1.z = pk2(acc[12], acc[13]); w1.w = pk2(acc[14], acc[15]);
            *(v4u*)dst = w0; *(v4u*)(dst + 8) = w1;
        }
        __syncthreads();
    }
#endif
    float* MOD = (float*)(A.ws + WS_CTL) + CW_MOD;
    LAS float* part = (LAS float*)(F.lds + 8 * 16384 - 8192);
    LAS float* ssil = (LAS float*)(F.lds + 8 * 16384 - 8192 - 12288);
    if (F.bid < 2 * 96) { for (int e = F.tid; e < 3072; e += NWAVES * 64) { const int k = e & 1023; ssil[e] = siluf_(e < 1024 ? A.in[1][k] : e < 2048 ? A.in[1][1024 + k] : A.in[3][k]); } }
    __syncthreads();
    for (int it = F.bid; it < 2 * 96; it += F.G) {
        const int l = it / 96, nb = it % 96, n = nb * 64 + F.lane;
        const float* wm = A.in[4] + (size_t)l * 1024 * 6144 + n;
        float a0 = 0.f, a1 = 0.f, a2 = 0.f;
#pragma unroll 32
        for (int k = F.wave * 128; k < F.wave * 128 + 128; ++k) {
            const float w = wm[(size_t)k * 6144];
            a0 += ssil[k] * w; a1 += ssil[1024 + k] * w; a2 += ssil[2048 + k] * w;
        }
        __syncthreads();
        part[(F.wave * 3 + 0) * 64 + F.lane] = a0; part[(F.wave * 3 + 1) * 64 + F.lane] = a1; part[(F.wave * 3 + 2) * 64 + F.lane] = a2;
        __syncthreads();
        if (F.wave < 3) { float s = A.in[5][l * 6144 + n];
#pragma unroll
            for (int w = 0; w < 8; ++w) s += part[(w * 3 + F.wave) * 64 + F.lane];
            MOD[(l * 3 + F.wave) * 6144 + n] = s; }
    }
    for (long i = F.gtid; i < 2L * 4096 * 256; i += F.NT) {
        const int l = (int)(i >> 20), n = (int)((i >> 8) & 4095), kk = (int)(i & 255), pn = n >> 8, rr = n & 255, gate = rr >> 7, rho = rr & 127, d = pn >> 3, cb = pn & 7;
        const int cho = 128 * cb + rho, blk = cho >> 6, e = cho & 63, chi = 256 * (cb >> 1) + kk; float v = 0.f;
        if ((chi >> 6) == blk) v = (gate ? A.in[17] : A.in[15])[((size_t)(l * 2 + d) * 16 + blk) * 4096 + (chi & 63) * 64 + e];
        WLP(l, WO_LRU)[i & 0xFFFFF] = (bf16)f2bf(v);
    }
    for (long i = F.gtid; i < 2L * 65536; i += F.NT) {
        const int which = (int)(i >> 16), n = (int)((i >> 8) & 255), k = (int)(i & 255); float v;
        if (which == 0) { const int k1 = n >> 1, cp = n & 1, t1 = k >> 1, c = k & 1; const float rev = (float)((k1 * t1) & 127) * (1.f / 128.f);
            const float cs = __builtin_amdgcn_cosf(rev), sn = __builtin_amdgcn_sinf(rev); v = cp == 0 ? (c == 0 ? cs : sn) : (c == 0 ? -sn : cs); }
        else { const int h = n >> 7, k2 = (n >> 1) & 63, cp = n & 1, hp = k >> 7, t2 = (k >> 1) & 63, c = k & 1; const float rev = (float)((k2 * t2) & 63) * (1.f / 64.f);
            const float cs = __builtin_amdgcn_cosf(rev), sn = __builtin_amdgcn_sinf(rev); v = (h != hp) ? 0.f : (cp == 0 ? (c == 0 ? cs : sn) : (c == 0 ? -sn : cs)); }
        WLP(0, WO_TAB)[i] = (bf16)f2bf(v);
    }
    for (long i = F.gtid; i < 4096; i += F.NT) ((float*)(A.ws + WS_W + WO_TAB + 262144))[i] = log1pf(expf(-A.in[19][i]));
}

__device__ __forceinline__ void norm_mod_row(const f32x4 (&v)[4], const float* g, const float* sc, const float* sh, bf16* orow, int lane) {
    float s = 0.f;
#pragma unroll
    for (int j = 0; j < 4; ++j) s += (v[j].x * v[j].x + v[j].y * v[j].y) + (v[j].z * v[j].z + v[j].w * v[j].w);
    const float rs = rsqrtf(wave_sum(s) * (1.f / 1024.f) + EPS);
#pragma unroll
    for (int j = 0; j < 4; ++j) { const int c = 4 * lane + 256 * j;
        const f32x4 gg = *(const f32x4*)(g + c), s1 = *(const f32x4*)(sc + c), s0 = *(const f32x4*)(sh + c);
        const float y0 = v[j].x * rs * gg.x * (1.f + s1.x) + s0.x, y1 = v[j].y * rs * gg.y * (1.f + s1.y) + s0.y, y2 = v[j].z * rs * gg.z * (1.f + s1.z) + s0.z, y3 = v[j].w * rs * gg.w * (1.f + s1.w) + s0.w;
        *(unsigned long long*)(orow + c) = (unsigned long long)pk2(y0, y1) | ((unsigned long long)pk2(y2, y3) << 32); }
}
__device__ __forceinline__ void ph_norm1(const Frame& F, const Args& A, int l) {
    bf16* H = WSP(bf16, WS_H);
    for (int R = F.gw; R < MROWS; R += F.NGW) {
        const int b = R / TPB, p = R % TPB, s = (p < CTX) ? 2 : b;
        const float* X = (p < CTX) ? A.in[2] + ((size_t)b * CTX + p) * 1024 : A.in[0] + ((size_t)b * SEQ + (p - CTX)) * 1024;
        f32x4 v[4];
#pragma unroll
        for (int j = 0; j < 4; ++j) v[j] = *(const f32x4*)(X + 4 * F.lane + 256 * j);
        norm_mod_row(v, A.in[6] + l * 1024, MODP(l, s, 1), MODP(l, s, 0), H + (size_t)R * 1024, F.lane);
    }
}

__device__ __forceinline__ void ph_uelem(const Frame& F, const Args& A, int l) {
    const float* U = WSP(float, WS_U);
    bf16 *Kb = WSP(bf16, WS_KB), *Vb = WSP(bf16, WS_VB), *Qb = WSP(bf16, WS_QB), *LXb = WSP(bf16, WS_LXB), *GLG = WSP(bf16, WS_GLG), *ZP = WSP(bf16, WS_ZP), *GT = WSP(bf16, WS_GATES);
    LAS float* sF = (LAS float*)F.lds; LAS float* sT = sF + 1024;
    if (F.tid < 256) sT[F.tid] = cospif((float)F.tid / 128.0f);
    __syncthreads();
    for (int R = F.bid; R < MROWS; R += F.G) {
        const float* u = U + (size_t)R * INW; const int p = R % TPB; const bool lat = p >= CTX; const int t = p - CTX;
        for (int gi = F.wave; gi < 32; gi += 8) {
            const bool isq = gi >= 16; const int grp = gi & 15;
            const float v = u[(isq ? COL_Q : COL_K) + grp * 64 + F.lane];
            const float ss = wave_sum(v * v);
            float y = v * rsqrtf(ss * (1.f / 64.f) + EPS) * (isq ? A.in[8] : A.in[9])[l * 64 + F.lane];
            const float part = sx<16>(y);
            if (lat) { const int axis = F.lane >> 5, hf = (F.lane >> 4) & 1, f = F.lane & 15;
                const float pos = (float)(axis ? (t & 63) : (t >> 6)); const float inv = exp2f(-(float)f * (13.287712379549449f / 16.f));
                float sn, cs; sincosf(pos * inv, &sn, &cs);
                y = hf ? (part * sn + y * cs) : (y * cs - part * sn); }
            if (isq) y *= QSCALE;
            (isq ? Qb : Kb)[(size_t)R * 1024 + grp * 64 + F.lane] = (bf16)f2bf(y);
        }
        for (int c = F.tid; c < 1024; c += 512) { const size_t o = (size_t)R * 1024 + c;
            Vb[o] = (bf16)f2bf(u[COL_V + c]); LXb[o] = (bf16)f2bf(u[COL_LX + c]); GLG[o] = (bf16)f2bf(gelu_tanh(u[COL_LG + c])); sF[c] = u[COL_F + c]; }
        for (int c = F.tid; c < 3072; c += 512) GT[(size_t)R * 3072 + c] = (bf16)f2bf(sigmoidf_(u[COL_G + c]));
        __syncthreads();
        for (int o = F.tid; o < 1024; o += 512) { const int g = o >> 8, oo = o & 255; int j = oo >> 1, odd = oo & 1; if (oo == 1) { j = 128; odd = 0; }
            const int m0 = odd ? 192 : 0; float acc = 0.f;
            for (int c = 0; c < 256; ++c) acc += sF[g * 256 + c] * sT[(j * c + m0) & 255];
            ZP[(size_t)R * 1024 + o] = (bf16)f2bf(acc); }
        __syncthreads();
    }
}

__device__ __forceinline__ void ph_conv(const Frame& F, const Args& A, int l) {
    const bf16* LXb = WSP(bf16, WS_LXB); bf16* UC = WSP(bf16, WS_UC);
    const int c8 = (int)(F.gtid & 127) * 8, r0 = (int)(F.gtid >> 7), rstep = (int)(F.NT >> 7);
    float w[4][8], bia[8];
#pragma unroll
    for (int j = 0; j < 4; ++j) { const f32x4 a = *(const f32x4*)(A.in[13] + l * 4096 + j * 1024 + c8), b = *(const f32x4*)(A.in[13] + l * 4096 + j * 1024 + c8 + 4);
        w[j][0] = a.x; w[j][1] = a.y; w[j][2] = a.z; w[j][3] = a.w; w[j][4] = b.x; w[j][5] = b.y; w[j][6] = b.z; w[j][7] = b.w; }
    { const f32x4 a = *(const f32x4*)(A.in[14] + l * 1024 + c8), b = *(const f32x4*)(A.in[14] + l * 1024 + c8 + 4);
      bia[0] = a.x; bia[1] = a.y; bia[2] = a.z; bia[3] = a.w; bia[4] = b.x; bia[5] = b.y; bia[6] = b.z; bia[7] = b.w; }
    for (int Rb = r0; Rb < MROWS; Rb += 4 * rstep) {
        v4u x[4][4];
#pragma unroll
        for (int u = 0; u < 4; ++u) { const int R = Rb + u * rstep; if (R < MROWS) { const int p = R % TPB, lo = p < CTX ? 0 : CTX, hi = p < CTX ? CTX : TPB;
#pragma unroll
            for (int j = 0; j < 4; ++j) { const int pp = p + j - 2; x[u][j] = (pp >= lo && pp < hi) ? *(const v4u*)(LXb + (size_t)(R + j - 2) * 1024 + c8) : (v4u){0u, 0u, 0u, 0u}; } } }
#pragma unroll
        for (int u = 0; u < 4; ++u) { const int R = Rb + u * rstep; if (R < MROWS) { float acc[8];
#pragma unroll
            for (int e = 0; e < 8; ++e) acc[e] = bia[e];
#pragma unroll
            for (int j = 0; j < 4; ++j) { const unsigned xs[4] = {x[u][j].x, x[u][j].y, x[u][j].z, x[u][j].w};
#pragma unroll
                for (int q = 0; q < 4; ++q) { acc[2 * q] += w[j][2 * q] * bf2f(xs[q] & 0xffffu); acc[2 * q + 1] += w[j][2 * q + 1] * bf2f(xs[q] >> 16); } }
            v4u o; o.x = pk2(acc[0], acc[1]); o.y = pk2(acc[2], acc[3]); o.z = pk2(acc[4], acc[5]); o.w = pk2(acc[6], acc[7]);
            *(v4u*)(UC + (size_t)R * 1024 + c8) = o; } }
    }
}
#if !FAST_LRU
__device__ __forceinline__ void ph_lrucoef(const Frame& F, const Args& A, int l) {
    const bf16* UC = WSP(bf16, WS_UC); unsigned* AB = WSP(unsigned, WS_AB);
    for (long i = F.gtid; i < 2L * MROWS * 1024; i += F.NT) {
        const int d = (int)(i / ((long)MROWS * 1024)); const long rem = i % ((long)MROWS * 1024); const int R = (int)(rem >> 10), ch = (int)(rem & 1023), blk = ch >> 6, e = ch & 63;
        const float* wa = A.in[15] + ((size_t)(l * 2 + d) * 16 + blk) * 4096 + e; const float* wi = A.in[17] + ((size_t)(l * 2 + d) * 16 + blk) * 4096 + e;
        float r = A.in[16][(l * 2 + d) * 1024 + ch], ig = A.in[18][(l * 2 + d) * 1024 + ch];
        const bf16* ur = UC + (size_t)R * 1024 + blk * 64;
        for (int dd = 0; dd < 64; ++dd) { const float x = bf2f(ur[dd]); r += x * wa[dd * 64]; ig += x * wi[dd * 64]; }
        const float lam = A.in[19][(l * 2 + d) * 1024 + ch]; const float sp = log1pf(expf(-lam));
        const float la = -8.f * sigmoidf_(r) * sp; const float mult = sqrtf(-expm1f(2.f * la));
        const float bc = mult * sigmoidf_(ig) * bf2f(ur[e]);
        AB[i] = pk2(la, bc);
    }
}
#endif
struct LruSched {
    const char* uc; const char* w; int G, c;
    __device__ __forceinline__ bool next(int i, pg8::UnitG& U) const {
        const long id = (long)i * G + c; if (id >= 66 * 16) return false;
        const int pm = (int)(id >> 4), pn = (int)(id & 15);
        U.a = uc + ((size_t)pm * 256 * 1024 + 256 * ((pn & 7) >> 1)) * 2; U.b = w + (size_t)pn * 256 * 256 * 2; U.row0 = pm * 256; U.pn = pn; U.e = 0; U.valid = 256; U.rows = nullptr; return true;
    }
};
struct EpiLru {
    static constexpr bool PERM = false;
    unsigned* AB; const bf16* UC; const float* ba; const float* bi; const float* sp;
    __device__ __forceinline__ void operator()(const f32x4 (&acc)[2][2][4][2], const pg8::UnitG& u, int wr, int wc, int fr, int fq) const {
        const int d = u.pn >> 3, cb = u.pn & 7, ch0 = 128 * cb + wc * 32 + 4 * fq;
        f32x4 vba[2], vbi[2], vsp[2];
#pragma unroll
        for (int n = 0; n < 2; ++n) { vba[n] = *(const f32x4*)(ba + d * 1024 + ch0 + 16 * n); vbi[n] = *(const f32x4*)(bi + d * 1024 + ch0 + 16 * n); vsp[n] = *(const f32x4*)(sp + d * 1024 + ch0 + 16 * n); }
#pragma unroll
        for (int ai = 0; ai < 2; ++ai) { unsigned long long uxs[4][2];
#pragma unroll
            for (int m = 0; m < 4; ++m)
#pragma unroll
                for (int n = 0; n < 2; ++n) uxs[m][n] = *(const unsigned long long*)(UC + ((size_t)u.row0 + ai * 128 + wr * 64 + m * 16 + fr) * 1024 + ch0 + 16 * n);
#pragma unroll
            for (int m = 0; m < 4; ++m) { const size_t R = (size_t)u.row0 + ai * 128 + wr * 64 + m * 16 + fr;
#pragma unroll
                for (int n = 0; n < 2; ++n) { const int ch = ch0 + 16 * n;
                    const unsigned long long ux = uxs[m][n];
                    const float x[4] = {bf2f((unsigned)ux & 0xffffu), bf2f(((unsigned)ux) >> 16), bf2f((unsigned)(ux >> 32) & 0xffffu), bf2f((unsigned)(ux >> 48))};
                    const f32x4 r = acc[ai][0][m][n] + vba[n], g = acc[ai][1][m][n] + vbi[n]; v4u o;
#pragma unroll
                    for (int e = 0; e < 4; ++e) { const float la = -8.f * sigmoidf_(r[e]) * vsp[n][e]; const float mult = __builtin_amdgcn_sqrtf(fmaxf(1.f - __expf(2.f * la), 0.f));
                        o[e] = pk2(la, mult * sigmoidf_(g[e]) * x[e]); }
                    *(v4u*)(AB + ((size_t)d * MROWS + R) * 1024 + ch) = o; } }
            asm volatile("" ::: "memory"); }
    }
};
__device__ __forceinline__ void ph_lru_gemm(const Frame& F, const Args& A, int l, int Ge) {
    LruSched S{(const char*)WSP(bf16, WS_UC), (const char*)WLP(l, WO_LRU), Ge, F.bid};
    EpiLru E{WSP(unsigned, WS_AB), WSP(bf16, WS_UC), A.in[16] + l * 2048, A.in[18] + l * 2048, (const float*)(A.ws + WS_W + WO_TAB + 262144) + l * 2048};
    pg8::gemm_phase_g<EpiLru, LruSched, false>(F.lds, 256, 1024, 256, S, E);
}
struct FftSched {
    const char* x; const char* w; int nunits, G, c;
    __device__ __forceinline__ bool next(int i, pg8::UnitG& U) const {
        const long id = (long)i * G + c; if (id >= nunits) return false;
        U.a = x + (size_t)id * 256 * 256 * 2; U.b = w; U.row0 = (int)id * 256; U.pn = 0; U.e = 0; U.valid = 256; U.rows = nullptr; return true;
    }
};
struct EpiFftA {
    static constexpr bool PERM = false;
    unsigned* XB;
    __device__ __forceinline__ void operator()(const f32x4 (&acc)[2][2][4][2], const pg8::UnitG& u, int wr, int wc, int fr, int fq) const {
#pragma unroll
        for (int ai = 0; ai < 2; ++ai)
#pragma unroll
            for (int m = 0; m < 4; ++m) { int r0 = u.row0; asm volatile("" : "+s"(r0));
                const int row = r0 + ai * 128 + wr * 64 + m * 16 + fr, t2 = row & 63; const size_t bc = (size_t)(row >> 6);
#pragma unroll
                for (int bj = 0; bj < 2; ++bj)
#pragma unroll
                    for (int n = 0; n < 2; ++n) { const int k1 = 64 * bj + 16 * wc + 8 * n + 2 * fq; const f32x4 v = acc[ai][bj][m][n];
#pragma unroll
                        for (int q = 0; q < 2; ++q) { const int kk = k1 + q; const float rev = (float)(kk * t2) * (1.f / 8192.f);
                            const float cs = __builtin_amdgcn_cosf(rev), sn = __builtin_amdgcn_sinf(rev); const float yr = v[2 * q], yi = v[2 * q + 1];
                            XB[(bc * 64 + (kk >> 1)) * 128 + (kk & 1) * 64 + t2] = pk2(yr * cs + yi * sn, yi * cs - yr * sn); } }
                asm volatile("" ::: "memory"); }
    }
};
struct EpiBf16Plain {
    static constexpr bool PERM = true;
    bf16* C; int ldc;
    __device__ __forceinline__ void operator()(const f32x4 (&acc)[2][2][4][2], const pg8::UnitG& u, int wr, int wc, int fr, int fq) const {
#pragma unroll
        for (int ai = 0; ai < 2; ++ai)
#pragma unroll
            for (int m = 0; m < 4; ++m) { bf16* rowp = C + (size_t)(u.row0 + ai * 128 + wr * 64 + m * 16 + fr) * ldc + u.pn * 256 + wc * 32 + 8 * fq;
#pragma unroll
                for (int bj = 0; bj < 2; ++bj) { const f32x4 v0 = acc[ai][bj][m][0], v1 = acc[ai][bj][m][1];
                    v4u o; o.x = pk2(v0[0], v0[1]); o.y = pk2(v0[2], v0[3]); o.z = pk2(v1[0], v1[1]); o.w = pk2(v1[2], v1[3]);
                    *(v4u*)(rowp + bj * 128) = o; } }
    }
};
struct EpiBf16U {
    static constexpr bool PERM = true; static constexpr int MIDK = 0;
    bf16* C; int ldc;
    __device__ __forceinline__ void operator()(const f32x4 (&acc)[2][2][4][2], const pg8::Unit& u, int wr, int wc, int fr, int fq) const {
#pragma unroll
        for (int ai = 0; ai < 2; ++ai)
#pragma unroll
            for (int m = 0; m < 4; ++m) { bf16* rowp = C + (size_t)(u.pm * 256 + ai * 128 + wr * 64 + m * 16 + fr) * ldc + u.pn * 256 + wc * 32 + 8 * fq;
#pragma unroll
                for (int bj = 0; bj < 2; ++bj) { const f32x4 v0 = acc[ai][bj][m][0], v1 = acc[ai][bj][m][1];
                    v4u o; o.x = pk2(v0[0], v0[1]); o.y = pk2(v0[2], v0[3]); o.z = pk2(v1[0], v1[1]); o.w = pk2(v1[2], v1[3]);
                    *(v4u*)(rowp + bj * 128) = o; } }
    }
};
__device__ __forceinline__ void ph_fft_a_gemm(const Frame& F, const Args& A) {
    FftSched S{(const char*)WSP(bf16, WS_XA), (const char*)WLP(0, WO_TAB), 256, F.G, F.bid};
    EpiFftA E{WSP(unsigned, WS_XB)};
    pg8::gemm_phase_g<EpiFftA, FftSched, false>(F.lds, 256, 256, 256, S, E);
}
__device__ __forceinline__ void ph_fft_b_gemm(const Frame& F, const Args& A) {
    FftSched S{(const char*)WSP(bf16, WS_XB), (const char*)(WLP(0, WO_TAB) + 65536), 256, F.G, F.bid};
    EpiBf16Plain E{WSP(bf16, WS_GB), 256};
    pg8::gemm_phase_g<EpiBf16Plain, FftSched, false>(F.lds, 256, 256, 256, S, E);
}
__device__ __forceinline__ void ph_scan1(const Frame& F, const Args& A) {
    const unsigned* AB = WSP(unsigned, WS_AB); float2* SUMM = WSP(float2, WS_SUMM);
    for (int it = F.gw; it < NB * 2 * NCHUNK * 16; it += F.NGW) {
        const int cg = it & 15, ck = (it >> 4) % NCHUNK, bd = (it >> 4) / NCHUNK, b = bd >> 1, d = bd & 1, ch = cg * 64 + F.lane;
        const unsigned* ab = AB + ((size_t)d * MROWS + (size_t)b * TPB + ck * 64) * 1024 + ch;
        float ac = 1.f, h = 0.f;
#pragma unroll
        for (int q = 0; q < 4; ++q) { unsigned w[16];
#pragma unroll
            for (int k = 0; k < 16; ++k) { const int i = q * 16 + k, ii = d ? 63 - i : i; w[k] = ab[(size_t)ii * 1024]; }
#pragma unroll
            for (int k = 0; k < 16; ++k) { const float a = __expf(bf2f(w[k] & 0xffffu)); h = a * h + bf2f(w[k] >> 16); ac *= a; } }
        SUMM[((size_t)bd * NCHUNK + ck) * 1024 + ch] = make_float2(ac, h);
    }
}
__device__ __forceinline__ void ph_scan2(const Frame& F, const Args& A) {
    const float2* SUMM = WSP(float2, WS_SUMM); float* CARRY = WSP(float, WS_CARRY);
    if (F.gtid < 4096) {
        const int bd = (int)(F.gtid >> 10), ch = (int)(F.gtid & 1023), d = bd & 1; float h = 0.f;
        for (int s = 0; s < NCHUNK; ++s) { const int ck = d ? (s < 4 ? 3 - s : NCHUNK + 3 - s) : s;
            const size_t o = ((size_t)bd * NCHUNK + ck) * 1024 + ch; CARRY[o] = h; const float2 v = SUMM[o]; h = v.x * h + v.y; }
    }
}
__device__ __forceinline__ void ph_scan3(const Frame& F, const Args& A) {
    const unsigned* AB = WSP(unsigned, WS_AB); const float* CARRY = WSP(float, WS_CARRY); const bf16* GLG = WSP(bf16, WS_GLG); bf16* MX = WSP(bf16, WS_MIXIN);
    for (int it = F.gw; it < NB * NCHUNK * 16; it += F.NGW) {
        const int cg = it & 15, ck = (it >> 4) % NCHUNK, b = (it >> 4) / NCHUNK, ch = cg * 64 + F.lane; const size_t R0 = (size_t)b * TPB + ck * 64;
        const unsigned* ab0 = AB + R0 * 1024 + ch; const unsigned* ab1 = AB + ((size_t)MROWS + R0) * 1024 + ch;
        float hf[64]; float h = CARRY[((size_t)(b * 2 + 0) * NCHUNK + ck) * 1024 + ch];
#pragma unroll
        for (int q = 0; q < 4; ++q) { unsigned w[16];
#pragma unroll
            for (int k = 0; k < 16; ++k) w[k] = ab0[(size_t)(q * 16 + k) * 1024];
#pragma unroll
            for (int k = 0; k < 16; ++k) { h = __expf(bf2f(w[k] & 0xffffu)) * h + bf2f(w[k] >> 16); hf[q * 16 + k] = h; } }
        h = CARRY[((size_t)(b * 2 + 1) * NCHUNK + ck) * 1024 + ch];
#pragma unroll
        for (int q = 3; q >= 0; --q) { unsigned w[16]; bf16 g[16];
#pragma unroll
            for (int k = 0; k < 16; ++k) { const int i = q * 16 + 15 - k; w[k] = ab1[(size_t)i * 1024]; g[k] = GLG[(R0 + i) * 1024 + ch]; }
#pragma unroll
            for (int k = 0; k < 16; ++k) { const int i = q * 16 + 15 - k; h = __expf(bf2f(w[k] & 0xffffu)) * h + bf2f(w[k] >> 16);
                MX[(R0 + i) * 3072 + 1024 + ch] = (bf16)f2bf((hf[i] + h) * bf2f(g[k])); } }
    }
}

__device__ __forceinline__ void ph_fft_t1_fast(const Frame& F, const Args& A) {
    const unsigned* ZP = WSP(unsigned, WS_ZP); unsigned* XA = WSP(unsigned, WS_XA); LAS unsigned* T = (LAS unsigned*)F.lds;
    for (int item = F.bid; item < 512; item += F.G) {
        const int b = item >> 8, t2 = (item >> 2) & 63, cq = item & 3;
        __syncthreads();
#pragma unroll
        for (int i = 0; i < 8; ++i) { const int p = F.tid + 512 * i, t1 = p >> 5, w4 = (p & 31) * 4;
            const v4u v = *(const v4u*)(ZP + ((size_t)b * TPB + CTX + 64 * t1 + t2) * 512 + cq * 128 + w4);
            T[t1 * 129 + w4] = v.x; T[t1 * 129 + w4 + 1] = v.y; T[t1 * 129 + w4 + 2] = v.z; T[t1 * 129 + w4 + 3] = v.w; }
        __syncthreads();
#pragma unroll
        for (int i = 0; i < 16; ++i) { const int p = F.tid + 512 * i, cc = p >> 6, t1 = (p & 63) * 2;
            const unsigned long long v = (unsigned long long)T[t1 * 129 + cc] | ((unsigned long long)T[(t1 + 1) * 129 + cc] << 32);
            *(unsigned long long*)(XA + (((size_t)b * 512 + cq * 128 + cc) * 64 + t2) * 128 + t1) = v; }
    }
    __syncthreads();
}
__device__ __forceinline__ void ph_fft_t2_fast(const Frame& F, const Args& A) {
    const unsigned* GB = WSP(unsigned, WS_GB); bf16* MX = WSP(bf16, WS_MIXIN); LAS unsigned* T = (LAS unsigned*)F.lds;
    for (int item = F.bid; item < 2 * 65 * 4; item += F.G) {
        const int b = item / 260, rem = item % 260, kp = rem >> 2, g = rem & 3, k1a = kp, k1b = (128 - kp) & 127;
        __syncthreads();
#pragma unroll
        for (int i = 0; i < 8; ++i) { const int p = F.tid + 512 * i, blk = p >> 11, cc = (p >> 4) & 127, w4 = (p & 15) * 4, kk = blk ? k1b : k1a;
            const v4u v = *(const v4u*)(GB + (((size_t)b * 512 + g * 128 + cc) * 64 + (kk >> 1)) * 128 + (kk & 1) * 64 + w4);
            LAS unsigned* d = T + blk * (128 * 65) + cc * 65 + w4; d[0] = v.x; d[1] = v.y; d[2] = v.z; d[3] = v.w; }
        __syncthreads();
        const int jc = F.tid & 255, j = (jc == 0 || jc == 128) ? 0 : (jc < 128 ? jc : 256 - jc);
        const int nset = (k1a == k1b) ? 1 : 2;
        for (int r = (F.tid >> 8); r < nset * 64; r += 2) { const int set = r >> 6, k2 = r & 63, ka = set ? k1b : k1a;
            const int mk2 = (ka == 0) ? ((64 - k2) & 63) : 63 - k2;
            const unsigned own = T[set * (128 * 65) + j * 65 + k2], mir = T[(nset == 1 ? 0 : (1 - set)) * (128 * 65) + j * 65 + mk2];
            float o; if (jc == 0) o = 0.5f * (bf2f(own & 0xffffu) + bf2f(mir & 0xffffu)); else if (jc == 128) o = 0.5f * (bf2f(own >> 16) + bf2f(mir >> 16)); else if (jc < 128) o = bf2f(mir & 0xffffu); else o = bf2f(own & 0xffffu);
            MX[((size_t)b * TPB + CTX + ka + 128 * k2) * 3072 + 2048 + g * 256 + jc] = (bf16)f2bf(o * 6.9053396600248786e-4f); }
    }
    __syncthreads();
    const float2* GC = WSP(float2, WS_GC);
    for (long i = F.gtid; i < (long)NB * CTX * 1024; i += F.NT) {
        const int col = (int)(i & 1023), k = (int)((i >> 10) & 255), b = (int)(i >> 18), g = col >> 8, jc = col & 255, km = (256 - k) & 255;
        const int j = (jc == 0 || jc == 128) ? 0 : (jc < 128 ? jc : 256 - jc); const size_t base = ((size_t)b * 512 + g * 128 + j) * 256;
        const float2 w = GC[base + k], wm = GC[base + km];
        float o; if (jc == 0) o = 0.5f * (w.x + wm.x); else if (jc == 128) o = 0.5f * (w.y + wm.y); else if (jc < 128) o = wm.x; else o = w.x;
        MX[((size_t)b * TPB + k) * 3072 + 2048 + col] = (bf16)f2bf(o * 3.90625e-3f);
    }
}
__device__ __forceinline__ void ph_scan2_fast(const Frame& F, const Args& A) {
    const float2* SUMM = WSP(float2, WS_SUMM); float* CARRY = WSP(float, WS_CARRY);
    for (int it = F.gw; it < 256; it += F.NGW) {
        const int bd = it >> 6, d = bd & 1, ch = (it & 63) * 16 + (F.lane & 15), seg = F.lane >> 4;
        float2 v[33]; float as = 1.f, hs = 0.f;
#pragma unroll
        for (int q = 0; q < 33; ++q) { const int sidx = seg * 33 + q, ck = d ? (sidx < 4 ? 3 - sidx : NCHUNK + 3 - sidx) : sidx; v[q] = SUMM[((size_t)bd * NCHUNK + ck) * 1024 + ch]; }
#pragma unroll
        for (int q = 0; q < 33; ++q) { hs = v[q].x * hs + v[q].y; as *= v[q].x; }
        const float a16 = sx<16>(as), h16 = sx<16>(hs), a32 = sx<32>(as), h32 = sx<32>(hs), a48 = sx<32>(a16), h48 = sx<32>(h16);
        float h = 0.f;
#pragma unroll
        for (int jx = 0; jx < 3; ++jx) { const int x = jx ^ seg;
            const float aj = x == 0 ? as : (x == 1 ? a16 : (x == 2 ? a32 : a48)), hj = x == 0 ? hs : (x == 1 ? h16 : (x == 2 ? h32 : h48));
            if (jx < seg) h = aj * h + hj; }
#pragma unroll
        for (int q = 0; q < 33; ++q) { const int sidx = seg * 33 + q, ck = d ? (sidx < 4 ? 3 - sidx : NCHUNK + 3 - sidx) : sidx; CARRY[((size_t)bd * NCHUNK + ck) * 1024 + ch] = h; h = v[q].x * h + v[q].y; }
    }
}

__device__ __forceinline__ void ph_fft_t1(const Frame& F, const Args& A) {
    const unsigned* ZP = WSP(unsigned, WS_ZP); unsigned* XA = WSP(unsigned, WS_XA);
    for (long i = F.gtid; i < (long)NB * 512 * 8192; i += F.NT) {
        const int t1 = (int)(i & 127), t2 = (int)((i >> 7) & 63), cc = (int)((i >> 13) & 511), b = (int)(i >> 22);
        XA[i] = ZP[((size_t)b * TPB + CTX + 64 * t1 + t2) * 512 + cc];
    }
}
#if !FAST_FFT
__device__ __forceinline__ void ph_fft_a(const Frame& F, const Args& A) {
    const unsigned* XA = WSP(unsigned, WS_XA); unsigned* XB = WSP(unsigned, WS_XB);
    for (long i = F.gtid; i < (long)NB * 512 * 8192; i += F.NT) {
        const int k1 = (int)(i & 127); const long row = i >> 7; const int t2 = (int)(row & 63); const long bc = row >> 6;
        const unsigned* x = XA + row * 128; float yr = 0.f, yi = 0.f;
        for (int t1 = 0; t1 < 128; ++t1) { const unsigned w = x[t1]; const float wr = bf2f(w & 0xffffu), wi = bf2f(w >> 16);
            float sn, cs; sincospif((float)((k1 * t1) & 127) / 64.0f, &sn, &cs);
            yr += wr * cs + wi * sn; yi += wi * cs - wr * sn; }
        float sn, cs; sincospif((float)(k1 * t2) / 4096.0f, &sn, &cs);
        const float zr = yr * cs + yi * sn, zi = yi * cs - yr * sn;
        XB[(bc * 64 + (k1 >> 1)) * 128 + (k1 & 1) * 64 + t2] = pk2(zr, zi);
    }
}
#endif
#if !FAST_FFT
__device__ __forceinline__ void ph_fft_b(const Frame& F, const Args& A) {
    const unsigned* XB = WSP(unsigned, WS_XB); unsigned* GB = WSP(unsigned, WS_GB);
    for (long i = F.gtid; i < (long)NB * 512 * 8192; i += F.NT) {
        const int k2 = (int)(i & 63); const long hrow = i >> 6;
        const unsigned* x = XB + hrow * 64; float yr = 0.f, yi = 0.f;
        for (int t2 = 0; t2 < 64; ++t2) { const unsigned w = x[t2]; const float wr = bf2f(w & 0xffffu), wi = bf2f(w >> 16);
            float sn, cs; sincospif((float)((k2 * t2) & 63) / 32.0f, &sn, &cs);
            yr += wr * cs + wi * sn; yi += wi * cs - wr * sn; }
        GB[hrow * 64 + k2] = pk2(yr, yi);
    }
}
#endif
__device__ __forceinline__ void ph_fft_c(const Frame& F, const Args& A) {
    const unsigned* ZP = WSP(unsigned, WS_ZP); float2* GC = WSP(float2, WS_GC);
    LAS unsigned* Z = (LAS unsigned*)F.lds; LAS float* TWc = (LAS float*)(F.lds + 16384); LAS float* TWs = TWc + 256;
    __syncthreads();
    if (F.tid < 256) { const float rev = (float)F.tid * (1.f / 256.f); TWc[F.tid] = __builtin_amdgcn_cosf(rev); TWs[F.tid] = __builtin_amdgcn_sinf(rev); }
    for (int item = F.bid; item < 64; item += F.G) {
        const int b = item >> 5, c0 = (item & 31) * 16;
        __syncthreads();
        for (int e = F.tid; e < 4096; e += 512) Z[e] = ZP[((size_t)b * TPB + (e >> 4)) * 512 + c0 + (e & 15)];
        __syncthreads();
        const int cc = F.tid & 15, kb = (F.tid >> 4) * 8; float ar[8], ai[8]; int m[8];
#pragma unroll
        for (int q = 0; q < 8; ++q) { ar[q] = 0.f; ai[q] = 0.f; m[q] = 0; }
        for (int t = 0; t < 256; ++t) { const unsigned w = Z[t * 16 + cc]; const float wr = bf2f(w & 0xffffu), wi = bf2f(w >> 16);
#pragma unroll
            for (int q = 0; q < 8; ++q) { const float tc = TWc[m[q]], ts = TWs[m[q]]; ar[q] += wr * tc + wi * ts; ai[q] += wi * tc - wr * ts; m[q] = (m[q] + kb + q) & 255; } }
#pragma unroll
        for (int q = 0; q < 8; ++q) GC[((size_t)b * 512 + c0 + cc) * 256 + kb + q] = make_float2(ar[q], ai[q]);
    }
    __syncthreads();
}
__device__ __forceinline__ void ph_fft_t2(const Frame& F, const Args& A) {
    const unsigned* GB = WSP(unsigned, WS_GB); const float2* GC = WSP(float2, WS_GC); bf16* MX = WSP(bf16, WS_MIXIN);
    for (long i = F.gtid; i < (long)MROWS * 1024; i += F.NT) {
        const int R = (int)(i >> 10), col = (int)(i & 1023), g = col >> 8, jc = col & 255, b = R / TPB, p = R % TPB;
        const bool lat = p >= CTX; const int T = lat ? SEQ : CTX, k = lat ? p - CTX : p, km = (T - k) & (T - 1);
        const int j = (jc == 0 || jc == 128) ? 0 : (jc < 128 ? jc : 256 - jc); const int cc = g * 128 + j;
        float vr, vi, mr, mi;
        if (lat) { const size_t base = ((size_t)b * 512 + cc) * 64;
            const unsigned w = GB[(base + ((k & 127) >> 1)) * 128 + (k & 1) * 64 + (k >> 7)], wm = GB[(base + ((km & 127) >> 1)) * 128 + (km & 1) * 64 + (km >> 7)];
            vr = bf2f(w & 0xffffu); vi = bf2f(w >> 16); mr = bf2f(wm & 0xffffu); mi = bf2f(wm >> 16); }
        else { const float2 w = GC[((size_t)b * 512 + cc) * 256 + k], wm = GC[((size_t)b * 512 + cc) * 256 + km]; vr = w.x; vi = w.y; mr = wm.x; mi = wm.y; }
        float o;
        if (jc == 0) o = 0.5f * (vr + mr); else if (jc == 128) o = 0.5f * (vi + mi); else if (jc < 128) o = mr; else o = vr;
        o *= lat ? 6.9053396600248786e-4f : 3.90625e-3f;
        MX[(size_t)R * 3072 + 2048 + col] = (bf16)f2bf(o);
    }
}

#if !FAST_ATTN
__device__ __forceinline__ void ph_attn_naive(const Frame& F, const Args& A, int l) {
    const bf16 *Kb = WSP(bf16, WS_KB), *Vb = WSP(bf16, WS_VB), *Qb = WSP(bf16, WS_QB); bf16* MX = WSP(bf16, WS_MIXIN);
    const float* lq = A.in[10] + l * 256; float d01 = 0.f, d23 = 0.f;
    for (int i = 0; i < 64; ++i) { d01 += lq[i] * lq[64 + i]; d23 += lq[128 + i] * lq[192 + i]; }
    const float lam_init = 0.8f - 0.6f * expf(-0.3f * (float)l), lam = expf(d01) - expf(d23) + lam_init;
    LAS float* Ks = (LAS float*)F.lds; LAS float* Vs = Ks + 64 * 132; LAS float* Qs = Vs + 64 * 132; LAS float* Ws = Qs + 16 * 128;
    const int r = F.tid >> 5, tl = F.tid & 31;
    for (int u = F.bid; u < 16 * 528; u += F.G) {
        const int bh = u / 528, qb = u % 528, b = bh >> 3, h = bh & 7; const size_t R0 = (size_t)b * TPB + qb * 16; const int nkeys = qb < 16 ? CTX : TPB;
        __syncthreads();
        for (int e = F.tid; e < 2048; e += 512) Qs[e] = bf2f(Qb[(R0 + (e >> 7)) * 1024 + h * 128 + (e & 127)]);
        float m0 = -1e30f, l0 = 0.f, m1 = -1e30f, l1 = 0.f;
        for (int pass = 0; pass < 2; ++pass) {
            float inv0 = 0.f, inv1 = 0.f;
            if (pass == 1) {
#pragma unroll
                for (int o = 1; o < 32; o <<= 1) { float mo = __shfl_xor(m0, o), lo = __shfl_xor(l0, o), mn = fmaxf(m0, mo); l0 = l0 * exp2f(m0 - mn) + lo * exp2f(mo - mn); m0 = mn;
                    mo = __shfl_xor(m1, o); lo = __shfl_xor(l1, o); mn = fmaxf(m1, mo); l1 = l1 * exp2f(m1 - mn) + lo * exp2f(mo - mn); m1 = mn; }
                inv0 = 1.f / l0; inv1 = lam / l1;
            }
            float o4[4] = {0.f, 0.f, 0.f, 0.f};
            for (int kt = 0; kt < nkeys; kt += 64) {
                __syncthreads();
                for (int e = F.tid; e < 1024; e += 512) { const int kk = e >> 4, c8 = (e & 15) * 8; const size_t src = ((size_t)b * TPB + kt + kk) * 1024 + h * 128 + c8;
                    const v4u kv = *(const v4u*)(Kb + src);
                    Ks[kk * 132 + c8 + 0] = bf2f(kv.x & 0xffffu); Ks[kk * 132 + c8 + 1] = bf2f(kv.x >> 16); Ks[kk * 132 + c8 + 2] = bf2f(kv.y & 0xffffu); Ks[kk * 132 + c8 + 3] = bf2f(kv.y >> 16);
                    Ks[kk * 132 + c8 + 4] = bf2f(kv.z & 0xffffu); Ks[kk * 132 + c8 + 5] = bf2f(kv.z >> 16); Ks[kk * 132 + c8 + 6] = bf2f(kv.w & 0xffffu); Ks[kk * 132 + c8 + 7] = bf2f(kv.w >> 16);
                    if (pass == 1) { const v4u vv = *(const v4u*)(Vb + src);
                        Vs[kk * 132 + c8 + 0] = bf2f(vv.x & 0xffffu); Vs[kk * 132 + c8 + 1] = bf2f(vv.x >> 16); Vs[kk * 132 + c8 + 2] = bf2f(vv.y & 0xffffu); Vs[kk * 132 + c8 + 3] = bf2f(vv.y >> 16);
                        Vs[kk * 132 + c8 + 4] = bf2f(vv.z & 0xffffu); Vs[kk * 132 + c8 + 5] = bf2f(vv.z >> 16); Vs[kk * 132 + c8 + 6] = bf2f(vv.w & 0xffffu); Vs[kk * 132 + c8 + 7] = bf2f(vv.w >> 16); } }
                __syncthreads();
#pragma unroll
                for (int kq = 0; kq < 2; ++kq) { const int kk = tl + 32 * kq; float s0 = 0.f, s1 = 0.f;
                    for (int d = 0; d < 64; d += 4) { const f32x4 q0 = *(const LAS f32x4*)(Qs + r * 128 + d), q1 = *(const LAS f32x4*)(Qs + r * 128 + 64 + d), k0 = *(const LAS f32x4*)(Ks + kk * 132 + d), k1 = *(const LAS f32x4*)(Ks + kk * 132 + 64 + d);
                        s0 += q0.x * k0.x + q0.y * k0.y + q0.z * k0.z + q0.w * k0.w; s1 += q1.x * k1.x + q1.y * k1.y + q1.z * k1.z + q1.w * k1.w; }
                    if (pass == 0) { float mn = fmaxf(m0, s0); l0 = l0 * exp2f(m0 - mn) + exp2f(s0 - mn); m0 = mn; mn = fmaxf(m1, s1); l1 = l1 * exp2f(m1 - mn) + exp2f(s1 - mn); m1 = mn; }
                    else Ws[r * 64 + kk] = exp2f(s0 - m0) * inv0 - exp2f(s1 - m1) * inv1; }
                if (pass == 1) { __syncthreads();
                    for (int kk = 0; kk < 64; ++kk) { const float w = Ws[r * 64 + kk];
#pragma unroll
                        for (int i = 0; i < 4; ++i) o4[i] += w * Vs[kk * 132 + tl + 32 * i]; } }
            }
            if (pass == 1) { float ss = o4[0] * o4[0] + o4[1] * o4[1] + o4[2] * o4[2] + o4[3] * o4[3];
#pragma unroll
                for (int o = 1; o < 32; o <<= 1) ss += __shfl_xor(ss, o);
                const float sc = rsqrtf(ss * (1.f / 128.f) + EPS) * (1.f - lam_init);
#pragma unroll
                for (int i = 0; i < 4; ++i) MX[(R0 + r) * 3072 + h * 128 + tl + 32 * i] = (bf16)f2bf(o4[i] * sc * A.in[11][l * 128 + tl + 32 * i]); }
        }
    }
}

#endif
namespace da {
using bf16x8 = __attribute__((ext_vector_type(8))) short;
using s16x4  = __attribute__((ext_vector_type(4))) short;
using f32x16 = __attribute__((ext_vector_type(16))) float;
using u32x4  = __attribute__((ext_vector_type(4))) unsigned;
constexpr int KVBLK = 64, LDK = 1024;
constexpr size_t SHM_V = KVBLK * 128 * 2, SHM_K = KVBLK * 128 * 2;
constexpr float THR = 8.f;
#define DA_KSWZ(row, colB) ((row) * 256 + ((colB) ^ (((row) & 7) << 4)))
#define DA_SBAR() __builtin_amdgcn_sched_barrier(0)
__device__ __forceinline__ int crow(int r, int hi) { return (r & 3) + 8 * (r >> 2) + 4 * hi; }
__device__ __forceinline__ unsigned cvtpk(float lo, float hi) { unsigned r; asm volatile("v_cvt_pk_bf16_f32 %0, %1, %2" : "=v"(r) : "v"(lo), "v"(hi)); return r; }
__device__ __forceinline__ void expSM(f32x16& p0, f32x16& p1, float soff) {
  for (int r = 0; r < 16; ++r) p0[r] = __builtin_amdgcn_exp2f(p0[r] - soff); for (int r = 0; r < 16; ++r) p1[r] = __builtin_amdgcn_exp2f(p1[r] - soff);
}
__device__ __forceinline__ void finishSM(f32x16& p0, f32x16& p1, float& l_reg, bf16x8& pa0, bf16x8& pa1, bf16x8& pa2, bf16x8& pa3) {
  float ps = 0; for (int r = 0; r < 16; ++r) ps += p0[r]; for (int r = 0; r < 16; ++r) ps += p1[r];
  l_reg += ps;
#define DA_PK4(P, BASE, OUT) do { unsigned a0 = cvtpk(P[BASE + 0], P[BASE + 1]), a1 = cvtpk(P[BASE + 2], P[BASE + 3]);   \
    unsigned b0 = cvtpk(P[BASE + 4], P[BASE + 5]), b1 = cvtpk(P[BASE + 6], P[BASE + 7]);                              \
    auto r0 = __builtin_amdgcn_permlane32_swap(a0, b0, false, false); auto r1 = __builtin_amdgcn_permlane32_swap(a1, b1, false, false); \
    u32x4 w = {r0[0], r1[0], r0[1], r1[1]}; OUT = *reinterpret_cast<bf16x8*>(&w); } while (0)
  DA_PK4(p0, 0, pa0); DA_PK4(p0, 8, pa1); DA_PK4(p1, 0, pa2); DA_PK4(p1, 8, pa3);
#undef DA_PK4
}
__device__ __forceinline__ void qkt(f32x16& p0, f32x16& p1, const char* Ks, const bf16x8* qr, int r32, int hi, int cbm) {
  p0 = f32x16{}; p1 = f32x16{};
#pragma unroll
  for (int d0 = 0; d0 < 4; ++d0) { const int cb = cbm + (d0 * 16 + hi * 8) * 2;
    bf16x8 b0 = *reinterpret_cast<const bf16x8*>(Ks + DA_KSWZ(r32, cb));
    bf16x8 b1 = *reinterpret_cast<const bf16x8*>(Ks + DA_KSWZ(32 + r32, cb));
    p0 = __builtin_amdgcn_mfma_f32_32x32x16_bf16(b0, qr[d0], p0, 0, 0, 0);
    p1 = __builtin_amdgcn_mfma_f32_32x32x16_bf16(b1, qr[d0], p1, 0, 0, 0); }
}
__device__ __forceinline__ int v_st(int k, int c) { const int kk = (k & ~0xC) | ((k & 4) << 1) | ((k & 8) >> 1); return ((kk >> 3) * 4 + (c >> 5)) * 512 + ((kk & 7) * 32 + (c & 31)) * 2; }
__device__ __forceinline__ int v_rd_base(int lane) { return ((lane & 3) << 3) | (((lane >> 2) & 3) << 6) | (((lane >> 4) & 1) << 5) | (((lane >> 5) & 1) << 8); }
constexpr int v_rd_off(int d0, int ks, int half) { return d0 * 512 + ks * 4096 + half * 2048; }
template <int OFF> __device__ __forceinline__ s16x4 tr_read(int vb) {
  s16x4 r; asm volatile("ds_read_b64_tr_b16 %0, %1 offset:%2" : "=&v"(r) : "v"(vb), "i"(OFF) : "memory"); return r;
}
template <int D0> __device__ __forceinline__ void pv_one(f32x16& od, int vb, bf16x8 pa0, bf16x8 pa1, bf16x8 pa2, bf16x8 pa3) {
  const s16x4 l0 = tr_read<v_rd_off(D0, 0, 0)>(vb), h0 = tr_read<v_rd_off(D0, 0, 1)>(vb), l1 = tr_read<v_rd_off(D0, 1, 0)>(vb), h1 = tr_read<v_rd_off(D0, 1, 1)>(vb);
  const s16x4 l2 = tr_read<v_rd_off(D0, 2, 0)>(vb), h2 = tr_read<v_rd_off(D0, 2, 1)>(vb), l3 = tr_read<v_rd_off(D0, 3, 0)>(vb), h3 = tr_read<v_rd_off(D0, 3, 1)>(vb);
  asm volatile("s_waitcnt lgkmcnt(0)" ::: "memory"); DA_SBAR();
#define DA_PK(L, H) (bf16x8){L[0], L[1], L[2], L[3], H[0], H[1], H[2], H[3]}
  od = __builtin_amdgcn_mfma_f32_32x32x16_bf16(pa0, DA_PK(l0, h0), od, 0, 0, 0);
  od = __builtin_amdgcn_mfma_f32_32x32x16_bf16(pa1, DA_PK(l1, h1), od, 0, 0, 0);
  od = __builtin_amdgcn_mfma_f32_32x32x16_bf16(pa2, DA_PK(l2, h2), od, 0, 0, 0);
  od = __builtin_amdgcn_mfma_f32_32x32x16_bf16(pa3, DA_PK(l3, h3), od, 0, 0, 0);
#undef DA_PK
}
__device__ __forceinline__ void pv_d0(f32x16* o, int vb, bf16x8 pa0, bf16x8 pa1, bf16x8 pa2, bf16x8 pa3) {
  pv_one<0>(o[0], vb, pa0, pa1, pa2, pa3); pv_one<1>(o[1], vb, pa0, pa1, pa2, pa3); pv_one<2>(o[2], vb, pa0, pa1, pa2, pa3); pv_one<3>(o[3], vb, pa0, pa1, pa2, pa3);
}
__device__ __forceinline__ void unit(const unsigned short* __restrict__ Qb, const unsigned short* __restrict__ Kh, const unsigned short* __restrict__ Vh,
                                     unsigned short* __restrict__ Ob, int ldo, int seq, float lam, float oscale, float soff, const float* __restrict__ subg, char* lds) {
  const int tid = otid(), wid = tid >> 6, lane = tid & 63, r32 = lane & 31, hi = lane >> 5, mp = wid >> 2, wq = wid & 3;
  char* V_lds = lds; char* K_lds = lds + 2 * SHM_V;
  float* ws = (float*)(lds + 2 * SHM_V + 2 * SHM_K) + wid * 64; float* li_l = ws;
  float l_reg = 0; f32x16 o[4] = {}; bf16x8 qr[4];
  const unsigned short* Qw = Qb + (long)(wq * 32 + r32) * 1024 + mp * 64 + hi * 8;
#pragma unroll
  for (int d0 = 0; d0 < 4; ++d0) qr[d0] = *reinterpret_cast<const bf16x8*>(Qw + d0 * 16);
  const int cbm = mp * 128;
  const int sr = tid >> 4, sc = (tid & 15) * 8, vst0 = v_st(sr, sc), vst1 = v_st(32 + sr, sc);
  const int vb0 = (int)(uintptr_t)V_lds + v_rd_base(lane);
  struct { bf16x8 vs0, vs1, ks0, ks1; } sr_[2];
#define DA_SLOAD(i, k0) do { sr_[i].vs0 = *reinterpret_cast<const bf16x8*>(&Vh[(long)((k0) + sr) * LDK + sc]); sr_[i].vs1 = *reinterpret_cast<const bf16x8*>(&Vh[(long)((k0) + 32 + sr) * LDK + sc]); \
    sr_[i].ks0 = *reinterpret_cast<const bf16x8*>(&Kh[(long)((k0) + sr) * LDK + sc]); sr_[i].ks1 = *reinterpret_cast<const bf16x8*>(&Kh[(long)((k0) + 32 + sr) * LDK + sc]); } while (0)
#define DA_SWRITE(b, i) do { *(bf16x8*)(V_lds + (b) * SHM_V + vst0) = sr_[i].vs0;          \
    *(bf16x8*)(V_lds + (b) * SHM_V + vst1) = sr_[i].vs1; int kc = sc * 2;               \
    *(bf16x8*)(K_lds + (b) * SHM_K + DA_KSWZ(sr, kc)) = sr_[i].ks0;                       \
    *(bf16x8*)(K_lds + (b) * SHM_K + DA_KSWZ(32 + sr, kc)) = sr_[i].ks1; } while (0)
#define DA_SWAIT() asm volatile("s_waitcnt vmcnt(4)" ::: "memory")
  f32x16 pA0, pA1, pB0, pB1; bf16x8 pa0, pa1, pa2, pa3; const int NT = seq / KVBLK;
  constexpr int SE = 0, SO = 1;
  DA_SLOAD(SE, 0); asm volatile("s_waitcnt vmcnt(0)" ::: "memory"); DA_SWRITE(0, SE); __syncthreads();
  qkt(pA0, pA1, K_lds, qr, r32, hi, cbm); expSM(pA0, pA1, soff);
  DA_SLOAD(SO, KVBLK); if (2 < NT) DA_SLOAD(SE, 2 * KVBLK);
  DA_SWAIT(); DA_SWRITE(1, SO); __syncthreads();
  for (int j = 1; j + 1 < NT; j += 2) {
    DA_SBAR(); qkt(pB0, pB1, K_lds + SHM_K, qr, r32, hi, cbm);
    finishSM(pA0, pA1, l_reg, pa0, pa1, pa2, pa3); DA_SBAR();
    DA_SLOAD(SO, (j + 2) * KVBLK); DA_SBAR();
    pv_d0(o, vb0, pa0, pa1, pa2, pa3); expSM(pB0, pB1, soff);
    __syncthreads(); DA_SWAIT(); DA_SWRITE(0, SE);
    __syncthreads();
    DA_SBAR(); qkt(pA0, pA1, K_lds, qr, r32, hi, cbm);
    finishSM(pB0, pB1, l_reg, pa0, pa1, pa2, pa3); DA_SBAR();
    if (j + 3 < NT) DA_SLOAD(SE, (j + 3) * KVBLK); DA_SBAR();
    pv_d0(o, vb0 + (int)SHM_V, pa0, pa1, pa2, pa3); expSM(pA0, pA1, soff);
    __syncthreads(); DA_SWAIT(); DA_SWRITE(1, SO);
    __syncthreads();
  }
  DA_SBAR(); qkt(pB0, pB1, K_lds + SHM_K, qr, r32, hi, cbm);
  finishSM(pA0, pA1, l_reg, pa0, pa1, pa2, pa3); DA_SBAR();
  pv_d0(o, vb0, pa0, pa1, pa2, pa3); expSM(pB0, pB1, soff);
  __syncthreads();
  finishSM(pB0, pB1, l_reg, pa0, pa1, pa2, pa3); DA_SBAR();
  pv_d0(o, vb0 + (int)SHM_V, pa0, pa1, pa2, pa3);
  { auto rr = __builtin_amdgcn_permlane32_swap(__float_as_uint(l_reg), __float_as_uint(l_reg), false, false); l_reg = __uint_as_float(rr[0]) + __uint_as_float(rr[1]); }
  if (hi == 0) li_l[r32] = l_reg; asm volatile("s_waitcnt lgkmcnt(0)" ::: "memory");
  const float sgn = mp ? lam : 1.f;
#pragma unroll
  for (int r = 0; r < 16; ++r) { const float rl = sgn * __builtin_amdgcn_rcpf(li_l[crow(r, hi)]);
#pragma unroll
    for (int d0 = 0; d0 < 4; ++d0) o[d0][r] *= rl; }
  __syncthreads();
  int xb = wq * 4096 + lane; asm volatile("" : "+v"(xb));
  float* X = (float*)lds + xb;
  if (mp == 1) {
#pragma unroll
    for (int d0 = 0; d0 < 4; ++d0)
#pragma unroll
      for (int r = 0; r < 16; ++r) X[(d0 * 16 + r) * 64] = o[d0][r];
  }
  __syncthreads();
  if (mp == 0) {
    float gg[4];
#pragma unroll
    for (int d0 = 0; d0 < 4; ++d0) gg[d0] = subg[d0 * 32 + r32] * oscale;
    int ob = (wq * 32 + 4 * hi) * ldo + r32; asm volatile("" : "+v"(ob));
    unsigned short* Ow = Ob + ob;
#pragma unroll
    for (int r = 0; r < 16; ++r) { float a = 0.f; float v[4];
#pragma unroll
      for (int d0 = 0; d0 < 4; ++d0) { v[d0] = o[d0][r] - X[(d0 * 16 + r) * 64]; a += v[d0] * v[d0]; }
      a += sx<1>(a); a += sx<2>(a); a += sx<4>(a); a += sx<8>(a); a += sx<16>(a);
      a = rsqrtf(a * (1.f / 128.f) + EPS);
      const int orow = (r & 3) + 8 * (r >> 2);
#pragma unroll
      for (int d0 = 0; d0 < 4; ++d0) Ow[orow * ldo + d0 * 32] = (unsigned short)f2bf(v[d0] * a * gg[d0]); }
  }
  __syncthreads();
#undef DA_SLOAD
#undef DA_SWRITE
#undef DA_SWAIT
}

template <int D0> __device__ __forceinline__ void v_rd8(s16x4 (&f)[8], int vb) {
  f[0] = tr_read<v_rd_off(D0, 0, 0)>(vb); f[1] = tr_read<v_rd_off(D0, 0, 1)>(vb); f[2] = tr_read<v_rd_off(D0, 1, 0)>(vb); f[3] = tr_read<v_rd_off(D0, 1, 1)>(vb);
  f[4] = tr_read<v_rd_off(D0, 2, 0)>(vb); f[5] = tr_read<v_rd_off(D0, 2, 1)>(vb); f[6] = tr_read<v_rd_off(D0, 3, 0)>(vb); f[7] = tr_read<v_rd_off(D0, 3, 1)>(vb);
}
__device__ __forceinline__ void pv_mm(f32x16& od, const s16x4 (&f)[8], bf16x8 pa0, bf16x8 pa1, bf16x8 pa2, bf16x8 pa3) {
#define DA_PK(L, H) (bf16x8){L[0], L[1], L[2], L[3], H[0], H[1], H[2], H[3]}
  od = __builtin_amdgcn_mfma_f32_32x32x16_bf16(pa0, DA_PK(f[0], f[1]), od, 0, 0, 0);
  od = __builtin_amdgcn_mfma_f32_32x32x16_bf16(pa1, DA_PK(f[2], f[3]), od, 0, 0, 0);
  od = __builtin_amdgcn_mfma_f32_32x32x16_bf16(pa2, DA_PK(f[4], f[5]), od, 0, 0, 0);
  od = __builtin_amdgcn_mfma_f32_32x32x16_bf16(pa3, DA_PK(f[6], f[7]), od, 0, 0, 0);
#undef DA_PK
}
__device__ __forceinline__ void pv_pipe(f32x16* o, int vb, bf16x8 pa0, bf16x8 pa1, bf16x8 pa2, bf16x8 pa3) {
  s16x4 fa[8], fb[8];
  v_rd8<0>(fa, vb); v_rd8<1>(fb, vb);
  asm volatile("s_waitcnt lgkmcnt(8)" ::: "memory"); DA_SBAR(); pv_mm(o[0], fa, pa0, pa1, pa2, pa3); DA_SBAR();
  v_rd8<2>(fa, vb);
  asm volatile("s_waitcnt lgkmcnt(8)" ::: "memory"); DA_SBAR(); pv_mm(o[1], fb, pa0, pa1, pa2, pa3); DA_SBAR();
  v_rd8<3>(fb, vb);
  asm volatile("s_waitcnt lgkmcnt(8)" ::: "memory"); DA_SBAR(); pv_mm(o[2], fa, pa0, pa1, pa2, pa3); DA_SBAR();
  asm volatile("s_waitcnt lgkmcnt(0)" ::: "memory"); DA_SBAR(); pv_mm(o[3], fb, pa0, pa1, pa2, pa3); DA_SBAR();
}
__device__ __forceinline__ void unit8(const unsigned short* __restrict__ Qb, const unsigned short* __restrict__ Kh, const unsigned short* __restrict__ Vh,
                                      unsigned short* __restrict__ Ob, int ldo, int seq, float lam, float oscale, float soff, const float* __restrict__ subg, LAS unsigned char* ldsl) {
  const int tid = otid(), wid = __builtin_amdgcn_readfirstlane(tid >> 6), lane = tid & 63, r32 = lane & 31, hi = lane >> 5, mp = wid >> 2, wq = wid & 3;
  constexpr int SLOT = 16384;
  char* lds = (char*)ldsl; char* K_lds = lds; const int vbase = (int)(uintptr_t)(lds + 3 * SLOT) + v_rd_base(lane);
  float* li_l = (float*)(lds + 6 * SLOT) + wid * 64;
  f32x16 o[4] = {}; bf16x8 qr[4];
  const unsigned short* Qw = Qb + (long)(wq * 32 + r32) * 1024 + mp * 64 + hi * 8;
#pragma unroll
  for (int d0 = 0; d0 < 4; ++d0) qr[d0] = *reinterpret_cast<const bf16x8*>(Qw + d0 * 16);
  asm volatile("s_waitcnt vmcnt(0)" ::: "memory");
  const int cbm = mp * 128;
  const unsigned wl = (unsigned)wid * 1024u;
  unsigned kso[2], vso[2];
#pragma unroll
  for (int i = 0; i < 2; ++i) { const int P = (i * 8 + wid) * 64 + lane;
    { const int row = P >> 4, chunk = (P & 15) ^ (row & 7); kso[i] = (unsigned)(row * LDK + chunk * 8) * 2u; }
    { const int sub = P >> 5, kk = (sub >> 2) * 8 + ((P & 31) >> 2), key = (kk & ~0xC) | ((kk & 4) << 1) | ((kk & 8) >> 1); vso[i] = (unsigned)(key * LDK + (sub & 3) * 32 + (P & 3) * 8) * 2u; } }
#define DA_DMA_K(t, slot) do { const unsigned to_ = (unsigned)(t) * (unsigned)(KVBLK * LDK * 2); _Pragma("unroll") for (int i_ = 0; i_ < 2; ++i_) \
      __builtin_amdgcn_global_load_lds((const unsigned*)((const char*)Kh + (kso[i_] + to_)), (LAS unsigned*)(ldsl + (slot) * SLOT + i_ * 8192 + wl), 16, 0, 0); } while (0)
#define DA_DMA_V(t, slot) do { const unsigned to_ = (unsigned)(t) * (unsigned)(KVBLK * LDK * 2); _Pragma("unroll") for (int i_ = 0; i_ < 2; ++i_) \
      __builtin_amdgcn_global_load_lds((const unsigned*)((const char*)Vh + (vso[i_] + to_)), (LAS unsigned*)(ldsl + (3 + (slot)) * SLOT + i_ * 8192 + wl), 16, 0, 0); } while (0)
#define U8_PK(t, slot, i_) __builtin_amdgcn_global_load_lds((const unsigned*)((const char*)Kh + (kso[i_] + (unsigned)(t) * (unsigned)(KVBLK * LDK * 2))), (LAS unsigned*)(ldsl + (slot) * SLOT + (i_) * 8192 + wl), 16, 0, 0)
#define U8_PV(t, slot, i_) __builtin_amdgcn_global_load_lds((const unsigned*)((const char*)Vh + (vso[i_] + (unsigned)(t) * (unsigned)(KVBLK * LDK * 2))), (LAS unsigned*)(ldsl + (3 + (slot)) * SLOT + (i_) * 8192 + wl), 16, 0, 0)
#define DA_WAITBAR(N) do { asm volatile("s_waitcnt vmcnt(" #N ") lgkmcnt(0)" ::: "memory"); __builtin_amdgcn_s_barrier(); asm volatile("" ::: "memory"); } while (0)
  f32x16 pA0, pA1, pB0, pB1; u32x4 pw0, pw1, pw2, pw3; const int NT = seq / KVBLK;
  bf16x8 kf[8];
  f32x16 negm, ol = {};
#pragma unroll
  for (int r = 0; r < 16; ++r) negm[r] = -soff;
  const bf16x8 ones = {0x3F80, 0x3F80, 0x3F80, 0x3F80, 0x3F80, 0x3F80, 0x3F80, 0x3F80};
  const int pkr = ((r32 & 3) + 4 * (r32 >> 3)), pk = (pkr & 7) + 16 * (pkr >> 3) + 8 * ((r32 >> 2) & 1);
#define U5_KADDR(d0) ((int)(uintptr_t)K_lds + pk * 256 + ((((cbm >> 4) + 2 * (d0) + hi) ^ (pk & 7)) * 16))
#define U5_KLOAD(slot) do { const int so_ = (slot) * SLOT; _Pragma("unroll") for (int d0 = 0; d0 < 4; ++d0) { const int ad_ = U5_KADDR(d0) + so_; \
    asm volatile("ds_read_b128 %0, %2\n\tds_read_b128 %1, %2 offset:8192" : "=&v"(kf[2 * d0]), "=&v"(kf[2 * d0 + 1]) : "v"(ad_) : "memory"); } } while (0)
#define U5_PIN(x) asm volatile("" : "+v"(x))
#define U5_EX(v) __builtin_amdgcn_exp2f(v)
#define U5_VRD(L, H, m) do { asm volatile("ds_read_b64_tr_b16 %0, %1 offset:%2" : "=&v"(L) : "v"(vb_), "i"(v_rd_off((m) >> 2, (m) & 3, 0)) : "memory"); \
    asm volatile("ds_read_b64_tr_b16 %0, %1 offset:%2" : "=&v"(H) : "v"(vb_), "i"(v_rd_off((m) >> 2, (m) & 3, 1)) : "memory"); } while (0)
#define U5_GAPA(MF, X, B4, PW, VR, CV0, CV1) do { MF; VR; CV0; CV1; U5_PIN(PW); DA_SBAR(); } while (0)
#define U5_CVT(P, b) cvtpk(P[b], P[b + 1])
#define U5_PHASE_A(C0, C1, P0, P1, VSLOT, HK0, HK1, HV0, HV1) do { const int vb_ = vbase + (VSLOT) * SLOT; \
    U5_GAPA(C0 = __builtin_amdgcn_mfma_f32_32x32x16_bf16(kf[0], qr[0], negm, 0, 0, 0), P0, 0, pw0, HK0, pw0[0] = U5_CVT(P0, 0), pw0[1] = U5_CVT(P0, 2)); \
    U5_GAPA(C1 = __builtin_amdgcn_mfma_f32_32x32x16_bf16(kf[1], qr[0], negm, 0, 0, 0), P0, 4, pw0, HK1, pw0[2] = U5_CVT(P0, 4), pw0[3] = U5_CVT(P0, 6)); \
    U5_GAPA(C0 = __builtin_amdgcn_mfma_f32_32x32x16_bf16(kf[2], qr[1], C0, 0, 0, 0), P0, 8, pw1, do { HV0; HV1; } while (0), pw1[0] = U5_CVT(P0, 8), pw1[1] = U5_CVT(P0, 10)); \
    U5_GAPA(C1 = __builtin_amdgcn_mfma_f32_32x32x16_bf16(kf[3], qr[1], C1, 0, 0, 0), P0, 12, pw1, U5_VRD(vl0, vh0, 0), pw1[2] = U5_CVT(P0, 12), pw1[3] = U5_CVT(P0, 14)); \
    U5_GAPA(C0 = __builtin_amdgcn_mfma_f32_32x32x16_bf16(kf[4], qr[2], C0, 0, 0, 0), P1, 0, pw2, U5_VRD(vl1, vh1, 1), pw2[0] = U5_CVT(P1, 0), pw2[1] = U5_CVT(P1, 2)); \
    U5_GAPA(C1 = __builtin_amdgcn_mfma_f32_32x32x16_bf16(kf[5], qr[2], C1, 0, 0, 0), P1, 4, pw2, U5_VRD(vl2, vh2, 2), pw2[2] = U5_CVT(P1, 4), pw2[3] = U5_CVT(P1, 6)); \
    U5_GAPA(C0 = __builtin_amdgcn_mfma_f32_32x32x16_bf16(kf[6], qr[3], C0, 0, 0, 0), P1, 8, pw3, U5_VRD(vl3, vh3, 3), pw3[0] = U5_CVT(P1, 8), pw3[1] = U5_CVT(P1, 10)); \
    U5_GAPA(C1 = __builtin_amdgcn_mfma_f32_32x32x16_bf16(kf[7], qr[3], C1, 0, 0, 0), P1, 12, pw3, U5_VRD(vl4, vh4, 4), pw3[2] = U5_CVT(P1, 12), pw3[3] = U5_CVT(P1, 14)); \
    } while (0)
#define U5_PKV(L, H) (bf16x8){L[0], L[1], L[2], L[3], H[0], H[1], H[2], H[3]}
#define U5_PAF(k) __builtin_bit_cast(bf16x8, pw##k)
#define U5_GAPB(WAITN, OD, PK, L, H, X, B2, NEXT) do { asm volatile("s_waitcnt lgkmcnt(" #WAITN ")" ::: "memory"); DA_SBAR(); \
    OD = __builtin_amdgcn_mfma_f32_32x32x16_bf16(PK, U5_PKV(L, H), OD, 0, 0, 0); NEXT; X[B2] = U5_EX(X[B2]); X[B2 + 1] = U5_EX(X[B2 + 1]); U5_PIN(X); DA_SBAR(); } while (0)
#define U5_GAPS(PK, X, B2) do { ol = __builtin_amdgcn_mfma_f32_32x32x16_bf16(PK, ones, ol, 0, 0, 0); X[B2] = U5_EX(X[B2]); X[B2 + 1] = U5_EX(X[B2 + 1]); U5_PIN(X); DA_SBAR(); } while (0)
#define U5_GAPN(WAITN, OD, PK, L, H, NEXT) do { asm volatile("s_waitcnt lgkmcnt(" #WAITN ")" ::: "memory"); DA_SBAR(); \
    OD = __builtin_amdgcn_mfma_f32_32x32x16_bf16(PK, U5_PKV(L, H), OD, 0, 0, 0); NEXT; DA_SBAR(); } while (0)
#define U5_PHASE_B(C0, C1, VSLOT, KSLOT, DOK) do { const int vb_ = vbase + (VSLOT) * SLOT; \
    U5_GAPS(U5_PAF(0), C0, 0); U5_GAPS(U5_PAF(1), C0, 2); U5_GAPS(U5_PAF(2), C0, 4); U5_GAPS(U5_PAF(3), C0, 6); \
    U5_GAPB(8, o[0], U5_PAF(0), vl0, vh0, C0, 8, U5_VRD(vl5, vh5, 5)); \
    U5_GAPB(8, o[0], U5_PAF(1), vl1, vh1, C0, 10, U5_VRD(vl0, vh0, 6)); \
    U5_GAPB(8, o[0], U5_PAF(2), vl2, vh2, C0, 12, U5_VRD(vl1, vh1, 7)); \
    U5_GAPB(8, o[0], U5_PAF(3), vl3, vh3, C0, 14, U5_VRD(vl2, vh2, 8)); \
    U5_GAPB(8, o[1], U5_PAF(0), vl4, vh4, C1, 0, U5_VRD(vl3, vh3, 9)); \
    U5_GAPB(8, o[1], U5_PAF(1), vl5, vh5, C1, 2, U5_VRD(vl4, vh4, 10)); \
    U5_GAPB(8, o[1], U5_PAF(2), vl0, vh0, C1, 4, U5_VRD(vl5, vh5, 11)); \
    U5_GAPB(8, o[1], U5_PAF(3), vl1, vh1, C1, 6, U5_VRD(vl0, vh0, 12)); \
    U5_GAPB(8, o[2], U5_PAF(0), vl2, vh2, C1, 8, U5_VRD(vl1, vh1, 13)); \
    U5_GAPB(8, o[2], U5_PAF(1), vl3, vh3, C1, 10, U5_VRD(vl2, vh2, 14)); \
    U5_GAPB(8, o[2], U5_PAF(2), vl4, vh4, C1, 12, U5_VRD(vl3, vh3, 15)); \
    U5_GAPB(8, o[2], U5_PAF(3), vl5, vh5, C1, 14, (void)0); \
    U5_GAPN(6, o[3], U5_PAF(0), vl0, vh0, (void)0); \
    if (DOK) { U5_GAPN(4, o[3], U5_PAF(1), vl1, vh1, U5_KLOAD(KSLOT)); U5_GAPN(10, o[3], U5_PAF(2), vl2, vh2, (void)0); U5_GAPN(8, o[3], U5_PAF(3), vl3, vh3, (void)0); } \
    else { U5_GAPN(4, o[3], U5_PAF(1), vl1, vh1, (void)0); U5_GAPN(2, o[3], U5_PAF(2), vl2, vh2, (void)0); U5_GAPN(0, o[3], U5_PAF(3), vl3, vh3, (void)0); } } while (0)
#define DA_ROT(x) ((x) == 2 ? 0 : (x) + 1)
#define DA_PRV(x) ((x) == 0 ? 2 : (x) - 1)
  s16x4 vl0, vh0, vl1, vh1, vl2, vh2, vl3, vh3, vl4, vh4, vl5, vh5;
  DA_DMA_K(0, 0); DA_DMA_K(1, 1); DA_DMA_V(0, 0);
  DA_WAITBAR(0);
  U5_KLOAD(0); DA_DMA_K(2, 2); DA_DMA_V(1, 1);
  DA_WAITBAR(4);
  DA_DMA_K(3, 0);
  DA_SBAR();
  pA0 = negm; pA1 = negm;
#pragma unroll
  for (int d0 = 0; d0 < 4; ++d0) { pA0 = __builtin_amdgcn_mfma_f32_32x32x16_bf16(kf[2 * d0], qr[d0], pA0, 0, 0, 0); pA1 = __builtin_amdgcn_mfma_f32_32x32x16_bf16(kf[2 * d0 + 1], qr[d0], pA1, 0, 0, 0); }
  DA_SBAR(); U5_KLOAD(1);
  expSM(pA0, pA1, 0.f);
  DA_WAITBAR(2);
  int c = 1;
  for (int j = 1; j + 1 < NT; j += 2) {
    { const bool mk = j + 3 < NT;
      DA_SBAR(); U5_PHASE_A(pB0, pB1, pA0, pA1, DA_PRV(c), if (mk) U8_PK(j + 3, c, 0), if (mk) U8_PK(j + 3, c, 1), U8_PV(j + 1, DA_ROT(c), 0), U8_PV(j + 1, DA_ROT(c), 1));
      U5_PHASE_B(pB0, pB1, DA_PRV(c), DA_ROT(c), true);
      if (mk) DA_WAITBAR(4); else DA_WAITBAR(2);
      c = DA_ROT(c); }
    { const bool mk = j + 4 < NT;
      DA_SBAR(); U5_PHASE_A(pA0, pA1, pB0, pB1, DA_PRV(c), if (mk) U8_PK(j + 4, c, 0), if (mk) U8_PK(j + 4, c, 1), U8_PV(j + 2, DA_ROT(c), 0), U8_PV(j + 2, DA_ROT(c), 1));
      U5_PHASE_B(pA0, pA1, DA_PRV(c), DA_ROT(c), true);
      if (mk) DA_WAITBAR(4); else DA_WAITBAR(2);
      c = DA_ROT(c); }
  }
  DA_SBAR(); U5_PHASE_A(pB0, pB1, pA0, pA1, DA_PRV(c), (void)0, (void)0, (void)0, (void)0);
  U5_PHASE_B(pB0, pB1, DA_PRV(c), 0, false);
  DA_WAITBAR(0);
  { u32x4 w0 = {cvtpk(pB0[0], pB0[1]), cvtpk(pB0[2], pB0[3]), cvtpk(pB0[4], pB0[5]), cvtpk(pB0[6], pB0[7])}, w1 = {cvtpk(pB0[8], pB0[9]), cvtpk(pB0[10], pB0[11]), cvtpk(pB0[12], pB0[13]), cvtpk(pB0[14], pB0[15])};
    u32x4 w2 = {cvtpk(pB1[0], pB1[1]), cvtpk(pB1[2], pB1[3]), cvtpk(pB1[4], pB1[5]), cvtpk(pB1[6], pB1[7])}, w3 = {cvtpk(pB1[8], pB1[9]), cvtpk(pB1[10], pB1[11]), cvtpk(pB1[12], pB1[13]), cvtpk(pB1[14], pB1[15])};
    const bf16x8 pa0 = __builtin_bit_cast(bf16x8, w0), pa1 = __builtin_bit_cast(bf16x8, w1), pa2 = __builtin_bit_cast(bf16x8, w2), pa3 = __builtin_bit_cast(bf16x8, w3); DA_SBAR();
    ol = __builtin_amdgcn_mfma_f32_32x32x16_bf16(pa0, ones, ol, 0, 0, 0); ol = __builtin_amdgcn_mfma_f32_32x32x16_bf16(pa1, ones, ol, 0, 0, 0);
    ol = __builtin_amdgcn_mfma_f32_32x32x16_bf16(pa2, ones, ol, 0, 0, 0); ol = __builtin_amdgcn_mfma_f32_32x32x16_bf16(pa3, ones, ol, 0, 0, 0);
    pv_d0(o, vbase + c * SLOT, pa0, pa1, pa2, pa3); }
#undef U5_KADDR
#undef U5_KLOAD
#undef U5_PIN
#undef U5_EX
#undef U5_GAPA
#undef U5_CVT
#undef U5_PHASE_A
#undef U5_VRD
#undef U5_PKV
#undef U5_PAF
#undef U5_GAPB
#undef U5_GAPS
#undef U5_GAPN
#undef U5_PHASE_B
  const int tid2 = otid(), wid2 = __builtin_amdgcn_readfirstlane(tid2 >> 6), lane2 = tid2 & 63; { const int r32 = lane2 & 31, hi = lane2 >> 5, mp = wid2 >> 2, wq = wid2 & 3, lane = lane2; float* li_l = (float*)(lds + 6 * SLOT) + wid2 * 64;
  const float sgn = mp ? lam : 1.f;
#pragma unroll
  for (int r = 0; r < 16; ++r) { const float rl = sgn * __builtin_amdgcn_rcpf(ol[r]);
#pragma unroll
    for (int d0 = 0; d0 < 4; ++d0) o[d0][r] *= rl; }
  __syncthreads();
  int xb = wq * 4096 + lane; asm volatile("" : "+v"(xb));
  float* X = (float*)lds + xb;
  if (mp == 1) {
#pragma unroll
    for (int d0 = 0; d0 < 4; ++d0)
#pragma unroll
      for (int r = 0; r < 16; ++r) X[(d0 * 16 + r) * 64] = o[d0][r];
  }
  __syncthreads();
  if (mp == 0) {
    float gg[4];
#pragma unroll
    for (int d0 = 0; d0 < 4; ++d0) gg[d0] = subg[d0 * 32 + r32] * oscale;
    int ob = (wq * 32 + 4 * hi) * ldo + r32; asm volatile("" : "+v"(ob));
    unsigned short* Ow = Ob + ob;
#pragma unroll
    for (int r = 0; r < 16; ++r) { float a = 0.f; float v[4];
#pragma unroll
      for (int d0 = 0; d0 < 4; ++d0) { v[d0] = o[d0][r] - X[(d0 * 16 + r) * 64]; a += v[d0] * v[d0]; }
      a += sx<1>(a); a += sx<2>(a); a += sx<4>(a); a += sx<8>(a); a += sx<16>(a);
      a = rsqrtf(a * (1.f / 128.f) + EPS);
      const int orow = (r & 3) + 8 * (r >> 2);
#pragma unroll
      for (int d0 = 0; d0 < 4; ++d0) Ow[orow * ldo + d0 * 32] = (unsigned short)f2bf(v[d0] * a * gg[d0]); }
  }
  }
  asm volatile("s_waitcnt vmcnt(0)" ::: "memory");
  __syncthreads();
#undef DA_DMA_K
#undef DA_DMA_V
#undef DA_WAITBAR
#undef DA_ROT
#undef DA_PRV
}
}
__device__ __forceinline__ void ph_attn(const Frame& F, const Args& A, int l) {
    const bf16 *Kb = WSP(bf16, WS_KB), *Vb = WSP(bf16, WS_VB), *Qb = WSP(bf16, WS_QB); bf16* MX = WSP(bf16, WS_MIXIN);
    const float* lq = A.in[10] + l * 256; float d01 = 0.f, d23 = 0.f;
    for (int i = 0; i < 64; ++i) { d01 += lq[i] * lq[64 + i]; d23 += lq[128 + i] * lq[192 + i]; }
    const float lam_init = 0.8f - 0.6f * expf(-0.3f * (float)l); float lam = expf(d01) - expf(d23) + lam_init;
    float mq = 0.f, mk = 0.f;
    for (int i = 0; i < 64; ++i) { mq = fmaxf(mq, fabsf(A.in[8][l * 64 + i])); mk = fmaxf(mk, fabsf(A.in[9][l * 64 + i])); }
    const float soff = __uint_as_float(__builtin_amdgcn_readfirstlane(__float_as_uint(64.f * mq * mk * QSCALE)));
    lam = __uint_as_float(__builtin_amdgcn_readfirstlane(__float_as_uint(lam))); const float osc = __uint_as_float(__builtin_amdgcn_readfirstlane(__float_as_uint(1.f - lam_init)));
    const int vcu = (F.G % 8 == 0) ? (F.bid % 8) * (F.G / 8) + F.bid / 8 : F.bid;
    for (int u = vcu; u < (l == DEPTH - 1 ? 1024 : 16 * 66); u += F.G) {
        const int bh = (u % 1024) / 64 , b = bh >> 3, h = bh & 7;
        int qb; int bb = b, hh = h;
        if (u < 1024) qb = 2 + (u & 63); else { const int v = u - 1024; bb = v >> 4; hh = (v >> 1) & 7; qb = v & 1; }
        const size_t R0 = (size_t)bb * TPB + qb * 128; const int seq = qb < 2 ? CTX : TPB;
#if ATTN_V2 == 8
        da::unit8(Qb + R0 * 1024 + hh * 128, Kb + (size_t)bb * TPB * 1024 + hh * 128, Vb + (size_t)bb * TPB * 1024 + hh * 128,
                  MX + R0 * 3072 + hh * 128, 3072, seq, lam, osc, soff, A.in[11] + l * 128, F.lds);
#else
        da::unit(Qb + R0 * 1024 + hh * 128, Kb + (size_t)bb * TPB * 1024 + hh * 128, Vb + (size_t)bb * TPB * 1024 + hh * 128,
                 MX + R0 * 3072 + hh * 128, 3072, seq, lam, osc, soff, A.in[11] + l * 128, (char*)F.lds);
#endif
    }
}

__device__ __forceinline__ void ph_mix(const Frame& F, const Args& A) {
    const float *PA = WSP(float, WS_PA), *PR = WSP(float, WS_PR), *PF = WSP(float, WS_PF); const bf16* GT = WSP(bf16, WS_GATES); bf16* MD = WSP(bf16, WS_MIXED);
    for (long i = F.gtid; i < (long)MROWS * 1024; i += F.NT) { const size_t R = (size_t)(i >> 10); const int c = (int)(i & 1023);
        MD[i] = (bf16)f2bf(bf2f(GT[R * 3072 + c]) * PA[i] + bf2f(GT[R * 3072 + 1024 + c]) * PR[i] + bf2f(GT[R * 3072 + 2048 + c]) * PF[i]); }
}
__device__ __forceinline__ void ph_resid_norm2(const Frame& F, const Args& A, int l) {
    float* X = WSP(float, WS_XALL); const float* Y1 = WSP(float, WS_Y1); bf16* TOK = WSP(bf16, WS_TOK);
    for (int R = F.gw; R < MROWS; R += F.NGW) {
        const int b = R / TPB, p = R % TPB, s = (p < CTX) ? 2 : b; const float* g1 = MODP(l, s, 2);
        f32x4 v[4];
#pragma unroll
        for (int j = 0; j < 4; ++j) { const int c = 4 * F.lane + 256 * j; const f32x4 x = *(const f32x4*)(X + (size_t)R * 1024 + c), y = *(const f32x4*)(Y1 + (size_t)R * 1024 + c), gg = *(const f32x4*)(g1 + c);
            v[j] = x + gg * y; *(f32x4*)(X + (size_t)R * 1024 + c) = v[j]; }
        norm_mod_row(v, A.in[23] + l * 1024, MODP(l, s, 4), MODP(l, s, 3), TOK + (size_t)R * 1024, F.lane);
    }
}
#define G1(T) __attribute__((address_space(1))) T
template <int CTRL, int RM = 0xf> __device__ __forceinline__ float dpp_f(float v) {
    return __uint_as_float(__builtin_amdgcn_update_dpp(__float_as_uint(v), __float_as_uint(v), CTRL, RM, 0xf, false)); }
__device__ __forceinline__ float wave_max63(float v) {
    asm volatile("s_nop 1\n\tv_max_f32_dpp %0, %0, %0 row_ror:1 row_mask:0xf bank_mask:0xf\n\ts_nop 1\n\tv_max_f32_dpp %0, %0, %0 row_ror:2 row_mask:0xf bank_mask:0xf\n\t"
                 "s_nop 1\n\tv_max_f32_dpp %0, %0, %0 row_ror:4 row_mask:0xf bank_mask:0xf\n\ts_nop 1\n\tv_max_f32_dpp %0, %0, %0 row_ror:8 row_mask:0xf bank_mask:0xf\n\t"
                 "s_nop 1\n\tv_max_f32_dpp %0, %0, %0 row_bcast:15 row_mask:0xa bank_mask:0xf\n\ts_nop 1\n\tv_max_f32_dpp %0, %0, %0 row_bcast:31 row_mask:0xc bank_mask:0xf\n\ts_nop 1" : "+v"(v));
    return v; }
template <bool DRY = false> __device__ __forceinline__ void ph_topk(const Frame& F, const Args& A, int l) {
    const float* LG = WSP(float, WS_LOG);
    int* LIST = DRY ? WSP(int, WS_PR) : WSP(int, WS_LIST); float* TOPW = DRY ? WSP(float, WS_PR + 18 * MiB) : WSP(float, WS_TOPW); int* EPO = DRY ? WSP(int, WS_PR + 19 * MiB) : WSP(int, WS_EP);
    int* CNT = (int*)(A.ws + WS_CTL) + CW_CNT + (DRY ? 2 : l) * 256 * CNT_STRIDE;
    const float NEG = -__builtin_inff();
    const bool skipctx = l == DEPTH - 1;
    const f32x4 rb4 = *(const G1(f32x4)*)(A.in[25] + l * 256 + 4 * F.lane);
    constexpr int SLOTS = 9;
    for (int base = F.gw; base < MROWS; base += SLOTS * F.NGW) {
        f32x4 lg[SLOTS]; int es[SLOTS], ps[SLOTS]; float wt[SLOTS];
#pragma unroll
        for (int i = 0; i < SLOTS; ++i) { const int R = base + i * F.NGW; lg[i] = f32x4{0.f, 0.f, 0.f, 0.f}; es[i] = 0; ps[i] = 0; wt[i] = 0.f;
            if (R < MROWS && !(skipctx && (R % TPB) < CTX)) lg[i] = *(const G1(f32x4)*)(LG + (size_t)R * 256 + 4 * F.lane); }
#pragma unroll
        for (int i = 0; i < SLOTS; ++i) { const int R = base + i * F.NGW;
            if (R < MROWS && !(skipctx && (R % TPB) < CTX)) {
                const float sc[4] = {sigmoidf_(lg[i].x), sigmoidf_(lg[i].y), sigmoidf_(lg[i].z), sigmoidf_(lg[i].w)};
                const float bi[4] = {sc[0] + rb4.x, sc[1] + rb4.y, sc[2] + rb4.z, sc[3] + rb4.w};
                float t1 = fmaxf(bi[0], bi[1]), t2 = fminf(bi[0], bi[1]);
                { const float u1 = fmaxf(bi[2], bi[3]), u2 = fminf(bi[2], bi[3]); const float n1 = fmaxf(t1, u1), n2 = fmaxf(fminf(t1, u1), fmaxf(t2, u2)); t1 = n1; t2 = n2; }
#define TK_M2(C) { const float o1 = dpp_f<C>(t1), o2 = dpp_f<C>(t2); const float n1 = fmaxf(t1, o1), n2 = fmaxf(fminf(t1, o1), fmaxf(t2, o2)); t1 = n1; t2 = n2; }
                TK_M2(0xB1) TK_M2(0x4E) TK_M2(0x141)
#undef TK_M2
                const float gs = t1 + t2; const int mygrp = F.lane >> 3; int rank = 0;
#pragma unroll
                for (int j = 0; j < 8; ++j) { const float sj = __uint_as_float(__builtin_amdgcn_readlane(__float_as_uint(gs), j * 8)); rank += (int)(sj > gs) | ((int)(sj == gs) & (int)(j < mygrp)); }
                const bool sel = rank < 4;
                float cand[4];
#pragma unroll
                for (int q = 0; q < 4; ++q) cand[q] = sel ? bi[q] : NEG;
                int my_e = 0; float my_s = 0.f, ssum = 0.f;
#pragma unroll
                for (int k = 0; k < 8; ++k) {
                    float bv = cand[0], bs = sc[0]; int bq = 0;
#pragma unroll
                    for (int q = 1; q < 4; ++q) { const bool g = cand[q] > bv; bv = g ? cand[q] : bv; bs = g ? sc[q] : bs; bq = g ? q : bq; }
                    const float mx = __uint_as_float(__builtin_amdgcn_readlane(__float_as_uint(wave_max63(bv)), 63));
                    const int ol = (int)__builtin_ctzll(__ballot(bv == mx));
                    const int oq = __builtin_amdgcn_readlane(bq, ol); const float sv = __uint_as_float(__builtin_amdgcn_readlane(__float_as_uint(bs), ol));
                    const bool me = F.lane == ol;
#pragma unroll
                    for (int q = 0; q < 4; ++q) cand[q] = (me & (oq == q)) ? NEG : cand[q];
                    ssum += sv;
                    { const int ev = 4 * ol + oq; asm volatile("v_writelane_b32 %0, %1, %2" : "+v"(my_e) : "s"(ev), "n"(k)); asm volatile("v_writelane_b32 %0, %1, %2" : "+v"(my_s) : "s"(sv), "n"(k)); }
                }
                es[i] = my_e; wt[i] = my_s * __builtin_amdgcn_rcpf(ssum) * 2.5f;
            } }
#pragma unroll
        for (int i = 0; i < SLOTS; ++i) { const int R = base + i * F.NGW;
            if (R < MROWS && !(skipctx && (R % TPB) < CTX) && F.lane < 8) ps[i] = __hip_atomic_fetch_add((G1(int)*)(CNT + es[i] * CNT_STRIDE), 1, __ATOMIC_RELAXED, __HIP_MEMORY_SCOPE_AGENT); }
#pragma unroll
        for (int i = 0; i < SLOTS; ++i) { const int R = base + i * F.NGW;
            if (R < MROWS && !(skipctx && (R % TPB) < CTX) && F.lane < 8) {
                *(G1(int)*)(LIST + (size_t)es[i] * LCAP + ps[i]) = R * 8 + F.lane; *(G1(float)*)(TOPW + (size_t)R * 8 + F.lane) = wt[i]; *(G1(int)*)(EPO + (size_t)R * 8 + F.lane) = es[i] * LCAP + ps[i]; } }
    }
}
__device__ __forceinline__ void ph_experts_naive(const Frame& F, const Args& A, int l) {
    const bf16* TOK = WSP(bf16, WS_TOK); const int* LIST = WSP(int, WS_LIST); const float* TOPW = WSP(float, WS_TOPW); float* YB = WSP(float, WS_YB);
    const int* CNT = (const int*)(A.ws + WS_CTL) + CW_CNT + l * 256 * CNT_STRIDE;
    LAS bf16* Xs = (LAS bf16*)F.lds;
    LAS float* Hs = (LAS float*)(F.lds + 65536);
    LAS int* pref = (LAS int*)(F.lds + 98304);
    LAS int* sPair = pref + 320; LAS float* sW = (LAS float*)(sPair + 32);
    __syncthreads();
    if (F.tid == 0) { int s = 0; for (int e = 0; e < 256; ++e) { pref[e] = s; s += (CNT[e] + 31) >> 5; } pref[256] = s; }
    __syncthreads();
    const int total = pref[256];
    for (int id = F.bid; id < total; id += F.G) {
        int lo = 0, hi = 255; while (lo < hi) { const int mid = (lo + hi + 1) >> 1; if (pref[mid] <= id) lo = mid; else hi = mid - 1; }
        const int e = lo, c = id - pref[e], n = min(32, CNT[e] - c * 32);
        __syncthreads();
        if (F.tid < 32) { const int pr = F.tid < n ? LIST[(size_t)e * LCAP + c * 32 + F.tid] : -1; sPair[F.tid] = pr; sW[F.tid] = pr >= 0 ? TOPW[pr] : 0.f; }
        __syncthreads();
        for (int pc = F.tid; pc < 4096; pc += 512) { const int row = pc >> 7, c8 = (pc & 127) * 8, pr = sPair[row];
            v4u v = {0u, 0u, 0u, 0u}; if (pr >= 0) v = *(const v4u*)(TOK + (size_t)(pr >> 3) * 1024 + c8);
            *(LAS v4u*)(Xs + row * 1024 + c8) = v; }
        __syncthreads();
        { const int f = F.tid & 255, gu = F.tid >> 8; const float* W = (gu ? A.in[27] : A.in[26]) + ((size_t)(l * 256 + e) * 1024) * 256 + f;
          float acc[32];
#pragma unroll
          for (int r = 0; r < 32; ++r) acc[r] = 0.f;
          for (int k = 0; k < 1024; ++k) { const float w = W[(size_t)k * 256];
#pragma unroll
              for (int r = 0; r < 32; ++r) acc[r] += bf2f(Xs[r * 1024 + k]) * w; }
          if (gu == 0) {
#pragma unroll
              for (int r = 0; r < 32; ++r) Hs[r * 256 + f] = siluf_(acc[r]); }
          __syncthreads();
          if (gu == 1) {
#pragma unroll
              for (int r = 0; r < 32; ++r) Hs[r * 256 + f] *= acc[r]; }
          __syncthreads(); }
        { const float* Wd = A.in[28] + ((size_t)(l * 256 + e) * 256) * 1024 + F.tid;
          float a0[32], a1[32];
#pragma unroll
          for (int r = 0; r < 32; ++r) { a0[r] = 0.f; a1[r] = 0.f; }
          for (int k = 0; k < 256; ++k) { const float w0 = Wd[(size_t)k * 1024], w1 = Wd[(size_t)k * 1024 + 512];
#pragma unroll
              for (int r = 0; r < 32; ++r) { const float hv = Hs[r * 256 + k]; a0[r] += hv * w0; a1[r] += hv * w1; } }
#pragma unroll
          for (int r = 0; r < 32; ++r) { const int pr = sPair[r]; if (pr >= 0) { const float w = sW[r]; YB[(size_t)pr * 1024 + F.tid] = a0[r] * w; YB[(size_t)pr * 1024 + 512 + F.tid] = a1[r] * w; } } }
    }
}
struct TrItem { const float* W; bf16* WT; int ldw, k0, n0, ldwt, rowbase; };
__device__ __forceinline__ void tr_load(const TrItem& t, f32x4 (&v)[8], int lane) {
    const int rr = lane >> 3, c4 = (lane & 7) * 4;
#pragma unroll
    for (int i = 0; i < 8; ++i) v[i] = __builtin_nontemporal_load((const f32x4*)(t.W + (size_t)(t.k0 + 8 * i + rr) * t.ldw + t.n0 + c4));
}
__device__ __forceinline__ void tr_load_a(const TrItem& t, f32x4 (&v)[8], int lane) {
    const int rr = lane >> 3, c4 = (lane & 7) * 4;
#pragma unroll
    for (int i = 0; i < 8; ++i) { const float* p = t.W + (size_t)(t.k0 + 8 * i + rr) * t.ldw + t.n0 + c4; asm volatile("global_load_dwordx4 %0, %1, off nt" : "=v"(v[i]) : "v"(p) : "memory"); }
}
__device__ __forceinline__ void tr_store(const TrItem& t, const f32x4 (&v)[8], LAS float* scr, int lane) {
    const int rr = lane >> 3, c4 = (lane & 7) * 4;
#pragma unroll
    for (int i = 0; i < 8; ++i) { LAS float* d = scr + (8 * i + rr) * 33 + c4; d[0] = v[i].x; d[1] = v[i].y; d[2] = v[i].z; d[3] = v[i].w; }
    LDS_WAIT(); asm volatile("" ::: "memory");
    const int c = lane & 7;
#pragma unroll
    for (int j = 0; j < 4; ++j) { const int n = (lane >> 3) + 8 * j; const LAS float* sp = scr + (8 * c) * 33 + n;
        v4u o; o.x = pk2(sp[0 * 33], sp[1 * 33]); o.y = pk2(sp[2 * 33], sp[3 * 33]); o.z = pk2(sp[4 * 33], sp[5 * 33]); o.w = pk2(sp[6 * 33], sp[7 * 33]);
        __builtin_nontemporal_store(o, (v4u*)(t.WT + (size_t)(t.rowbase + n) * t.ldwt + t.k0 + 8 * c)); }
    LDS_WAIT(); asm volatile("" ::: "memory");
}
__device__ __forceinline__ TrItem expert_item(const Args& A, int l, int it) {
    const int e = it / 384, r = it % 384; bf16* E1 = (bf16*)(A.ws + EWL(l) + (size_t)e * EW_STRIDE); TrItem t;
    if (r < 256) { const int up = r >> 7, q = r & 127, kb = q >> 3, nb = q & 7, n0 = 32 * nb;
        t.W = (up ? A.in[27] : A.in[26]) + ((size_t)(l * 256 + e) * 1024) * 256; t.ldw = 256; t.k0 = 64 * kb; t.n0 = n0; t.WT = E1; t.ldwt = 1024; t.rowbase = (n0 >> 7) * 256 + up * 128 + (n0 & 127); }
    else { const int q = r - 256, kb = q >> 5, nb = q & 31;
        t.W = A.in[28] + ((size_t)(l * 256 + e) * 256) * 1024; t.ldw = 1024; t.k0 = 64 * kb; t.n0 = 32 * nb; t.WT = E1 + 512 * 1024; t.ldwt = 256; t.rowbase = 32 * nb; }
    return t;
}
__device__ __forceinline__ void ph_expert_w_idx(const Frame& F, const Args& A, int l, int lo, int hi, int ci, int nblk) {
    if (ci < 0 || ci >= nblk) return;
    LAS float* scr = (LAS float*)(F.lds + F.wave * 16384);
    const int stride = nblk * NWAVES; int it = lo + ci * NWAVES + F.wave; if (it >= hi) return;
    f32x4 va[8], vb[8], vc[8]; TrItem ta = expert_item(A, l, it), tb = ta, tc = ta;
    tr_load_a(ta, va, F.lane);
    if (it + stride < hi) { tb = expert_item(A, l, it + stride); tr_load_a(tb, vb, F.lane); }
#define EW_STEP(TP, VP, TS, VS) { if (it + 2 * stride < hi) { TP = expert_item(A, l, it + 2 * stride); tr_load_a(TP, VP, F.lane); asm volatile("s_waitcnt vmcnt(16)" ::: "memory"); } \
        else asm volatile("s_waitcnt vmcnt(0)" ::: "memory"); \
        tr_store(TS, VS, scr, F.lane); it += stride; if (it >= hi) break; }
    for (;;) {
        EW_STEP(tc, vc, ta, va)
        EW_STEP(ta, va, tb, vb)
        EW_STEP(tb, vb, tc, vc)
    }
#undef EW_STEP
}
__device__ __forceinline__ void ph_expert_w(const Frame& F, const Args& A, int l, int lo, int hi, int blk0, int nblk) { ph_expert_w_idx(F, A, l, lo, hi, F.bid - blk0, nblk); }
constexpr int EWI_N = 256 * 384, EWI_A = 9800, EWI_B = 20800, EWI_C = 75000, EWI_D = 90000;
constexpr int KCONV_WIN = 18, KCONV_LRU = 44, KCONV_D = 124;
constexpr int KCONV_RS = 58, Q13 = 12, Q15 = 72, Q16 = 48;
__device__ __forceinline__ int moe_geff(int units, int G) { if (units <= 0) return G; const int rounds = (units + G - 1) / G; return (units + rounds - 1) / rounds; }
constexpr int MOE_MAXU = 11;
struct MoeSched {
    const LAS int* pref; const LAS int* cnt; const int* list; const char* abase; const char* bbase; int npn, G, c, lda2; size_t b_pn_stride; bool gather; LAS int* idx;
    __device__ __forceinline__ bool next(int i, pg8::UnitG& U) const {
        const long id = (long)i * G + c; const int total = pref[256]; if (id >= (long)total * npn) return false;
        const int tau = (int)(id / npn), pn = (int)(id % npn);
        int lo = 0, hi = 255; while (lo < hi) { const int mid = (lo + hi + 1) >> 1; if (pref[mid] <= tau) lo = mid; else hi = mid - 1; }
        const int e = lo, t = tau - pref[e];
        U.e = e; U.pn = pn; U.valid = min(256, cnt[e] - t * 256); U.rows = list + (size_t)e * LCAP + t * 256; U.row0 = tau * 256; U.lrows = idx ? idx + (i % MOE_MAXU) * 256 : nullptr;
        U.a = gather ? abase : abase + (size_t)tau * 256 * lda2; U.b = bbase + (size_t)e * EW_STRIDE + (size_t)pn * b_pn_stride; return true;
    }
};
__device__ __forceinline__ void moe_prefix(const Frame& F, const int* CNT, LAS int* pref) {
    LAS int* tmp = pref + 320;
    __syncthreads();
    if (F.tid < 256) tmp[F.tid] = CNT[F.tid * CNT_STRIDE];
    __syncthreads();
    if (F.tid <= 256) { int sum = 0; for (int e = 0; e < F.tid; ++e) sum += (tmp[e] + 255) >> 8; pref[F.tid] = sum; }
    __syncthreads();
}
struct EpiSwiGLU {
    static constexpr bool PERM = true;
    bf16* HB;
    __device__ __forceinline__ void operator()(const f32x4 (&acc)[2][2][4][2], const pg8::UnitG& u, int wr, int wc, int fr, int fq) const {
#pragma unroll
        for (int ai = 0; ai < 2; ++ai)
#pragma unroll
            for (int m = 0; m < 4; ++m) { const int r = ai * 128 + wr * 64 + m * 16 + fr;
                const f32x4 g0 = acc[ai][0][m][0], g1 = acc[ai][0][m][1], u0 = acc[ai][1][m][0], u1 = acc[ai][1][m][1];
                v4u w; w.x = pk2(siluf_(g0[0]) * u0[0], siluf_(g0[1]) * u0[1]); w.y = pk2(siluf_(g0[2]) * u0[2], siluf_(g0[3]) * u0[3]);
                w.z = pk2(siluf_(g1[0]) * u1[0], siluf_(g1[1]) * u1[1]); w.w = pk2(siluf_(g1[2]) * u1[2], siluf_(g1[3]) * u1[3]);
                *(v4u*)(HB + (size_t)(u.row0 + r) * 256 + u.pn * 128 + wc * 32 + 8 * fq) = w; }
    }
};
struct EpiScatter {
    static constexpr bool PERM = true;
    bf16* Y;
    __device__ __forceinline__ void operator()(const f32x4 (&acc)[2][2][4][2], const pg8::UnitG& u, int wr, int wc, int fr, int fq) const {
#pragma unroll
        for (int ai = 0; ai < 2; ++ai)
#pragma unroll
            for (int m = 0; m < 4; ++m) { const int r = ai * 128 + wr * 64 + m * 16 + fr;
                if (r < u.valid) { bf16* dst = Y + (size_t)(u.row0 + r) * 1024 + u.pn * 256 + wc * 32 + 8 * fq;
#pragma unroll
                    for (int bj = 0; bj < 2; ++bj) { const f32x4 v0 = acc[ai][bj][m][0], v1 = acc[ai][bj][m][1];
                        v4u o; o.x = pk2(v0[0], v0[1]); o.y = pk2(v0[2], v0[3]); o.z = pk2(v1[0], v1[1]); o.w = pk2(v1[2], v1[3]);
                        *(v4u*)(dst + bj * 128) = o; } } }
    }
};
__device__ __forceinline__ int conv_base(const Frame& F, const Args& A, int l) {
    if (l == 0) return 0;
    const int* CNT = (const int*)(A.ws + WS_CTL) + CW_CNT + (l - 1) * 256 * CNT_STRIDE; LAS int* pref = (LAS int*)(F.lds + RING_BYTES + 1024);
    moe_prefix(F, CNT, pref);
    const int tiles = pref[256], k15 = F.G - moe_geff(2 * tiles, F.G), k16 = F.G - moe_geff(4 * tiles, F.G);
    int base = KCONV_RS * NWAVES * Q13 + k15 * NWAVES * Q15 + k16 * NWAVES * Q16;
    __syncthreads();
    return base < EWI_N ? base : EWI_N;
}
__device__ __forceinline__ void ph_experts_up(const Frame& F, const Args& A, int l) {
    const int* CNT = (const int*)(A.ws + WS_CTL) + CW_CNT + l * 256 * CNT_STRIDE; LAS int* pref = (LAS int*)(F.lds + RING_BYTES + 1024);
    moe_prefix(F, CNT, pref);
    const int vcu = (F.G % 8 == 0) ? (F.bid % 8) * (F.G / 8) + F.bid / 8 : F.bid;
    const bool early = l + 1 < DEPTH; const int tiles = pref[256], Ge = early ? moe_geff(2 * tiles, F.G) : F.G;
    if (vcu < Ge) {
        LAS int* idx = (LAS int*)(F.lds + RING_BYTES + 4608);
        MoeSched S{pref, pref + 320, WSP(int, WS_LIST), (const char*)WSP(bf16, WS_TOK), (const char*)(A.ws + EWL(l)), 2, Ge, vcu, 2048, (size_t)256 * 1024 * 2, true, idx};
        { int vals[MOE_MAXU];
#pragma unroll
          for (int i = 0; i < MOE_MAXU; ++i) { pg8::UnitG U; vals[i] = 0; if (S.next(i, U) && F.tid < 256) vals[i] = *(const G1(int)*)(U.rows + min(F.tid, U.valid - 1)); }
#pragma unroll
          for (int i = 0; i < MOE_MAXU; ++i) if (F.tid < 256) idx[i * 256 + F.tid] = vals[i]; }
        __syncthreads();
        EpiSwiGLU E{WSP(bf16, WS_HB)};
        pg8::gemm_phase_g<EpiSwiGLU, MoeSched, true>(F.lds, 1024, 1024, 1024, S, E);
    } else { const int k = F.G - Ge, lo = KCONV_RS * NWAVES * Q13; ph_expert_w_idx(F, A, l + 1, lo, min(EWI_N, lo + k * NWAVES * Q15), vcu - Ge, k); }
    __syncthreads();
}
__device__ __forceinline__ void ph_experts_down(const Frame& F, const Args& A, int l) {
    const int* CNT = (const int*)(A.ws + WS_CTL) + CW_CNT + l * 256 * CNT_STRIDE; LAS int* pref = (LAS int*)(F.lds + RING_BYTES + 1024);
    moe_prefix(F, CNT, pref);
    const int vcu = (F.G % 8 == 0) ? (F.bid % 8) * (F.G / 8) + F.bid / 8 : F.bid;
    const bool early = l + 1 < DEPTH; const int tiles = pref[256], Ge = early ? moe_geff(4 * tiles, F.G) : F.G;
    if (vcu < Ge) {
        MoeSched S{pref, pref + 320, WSP(int, WS_LIST), (const char*)WSP(bf16, WS_HB), (const char*)(A.ws + EWL(l) + 512 * 1024 * 2), 4, Ge, vcu, 512, (size_t)256 * 256 * 2, false, nullptr};
        EpiScatter E{WSP(bf16, WS_Y16)};
        pg8::gemm_phase_g<EpiScatter, MoeSched, false>(F.lds, 256, 256, 256, S, E);
    } else { const int k = F.G - Ge, k15 = F.G - moe_geff(2 * tiles, F.G), lo = KCONV_RS * NWAVES * Q13 + k15 * NWAVES * Q15;
        ph_expert_w_idx(F, A, l + 1, min(EWI_N, lo), min(EWI_N, lo + k * NWAVES * Q16), vcu - Ge, k); }
}
template <bool DRY = false> __device__ __forceinline__ void ph_combine(const Frame& F, const Args& A, int l) {
    const float* X = WSP(float, WS_XALL); float* XO = DRY ? WSP(float, WS_U + 492 * MiB) : WSP(float, WS_XALL); bf16* HO = DRY ? WSP(bf16, WS_U + 558 * MiB) : WSP(bf16, WS_H); const bf16* SD = WSP(bf16, WS_SD); const bf16* YS = WSP(bf16, WS_Y16); const int* EP = WSP(int, WS_EP); const float* TOPW = WSP(float, WS_TOPW);
    const int* CNT = (const int*)(A.ws + WS_CTL) + CW_CNT + l * 256 * CNT_STRIDE; LAS int* pref = (LAS int*)(F.lds + RING_BYTES + 1024);
    moe_prefix(F, CNT, pref);
    for (int R = F.gw; R < MROWS; R += F.NGW) {
        const int b = R / TPB, p = R % TPB, s = (p < CTX) ? 2 : b; const float* g2 = MODP(l, s, 5);
        if (l == DEPTH - 1 && p < CTX) continue;
        size_t so[8]; float wk[8];
#pragma unroll
        for (int k = 0; k < 8; ++k) { const int ep = EP[(size_t)R * 8 + k], e = ep / LCAP, pos = ep - e * LCAP; so[k] = ((size_t)pref[e] * 256 + pos) * 1024; wk[k] = TOPW[(size_t)R * 8 + k]; }
        v4u yv[2][8], sd[2]; f32x4 xin[2][2];
#pragma unroll
        for (int j = 0; j < 2; ++j) { const int c = 8 * F.lane + 512 * j;
#pragma unroll
            for (int k = 0; k < 8; ++k) yv[j][k] = *(const v4u*)(YS + so[k] + c);
            sd[j] = *(const v4u*)(SD + (size_t)R * 1024 + c);
            xin[j][0] = *(const f32x4*)(X + (size_t)R * 1024 + c); xin[j][1] = *(const f32x4*)(X + (size_t)R * 1024 + c + 4); }
        float xo[2][8]; float ss = 0.f;
#pragma unroll
        for (int j = 0; j < 2; ++j) { const int c = 8 * F.lane + 512 * j; float f[8] = {bf2f(sd[j].x & 0xffffu), bf2f(sd[j].x >> 16), bf2f(sd[j].y & 0xffffu), bf2f(sd[j].y >> 16), bf2f(sd[j].z & 0xffffu), bf2f(sd[j].z >> 16), bf2f(sd[j].w & 0xffffu), bf2f(sd[j].w >> 16)};
#pragma unroll
            for (int k = 0; k < 8; ++k) { const unsigned ws[4] = {yv[j][k].x, yv[j][k].y, yv[j][k].z, yv[j][k].w};
#pragma unroll
                for (int q = 0; q < 4; ++q) { f[2 * q] += wk[k] * bf2f(ws[q] & 0xffffu); f[2 * q + 1] += wk[k] * bf2f(ws[q] >> 16); } }
            const f32x4 ga = *(const f32x4*)(g2 + c), gb = *(const f32x4*)(g2 + c + 4);
            const f32x4 xa = xin[j][0] + ga * (f32x4){f[0], f[1], f[2], f[3]}, xb = xin[j][1] + gb * (f32x4){f[4], f[5], f[6], f[7]};
            if (l + 1 < DEPTH || DRY) { *(f32x4*)(XO + (size_t)R * 1024 + c) = xa; *(f32x4*)(XO + (size_t)R * 1024 + c + 4) = xb; }
            if (l == DEPTH - 1 && !DRY) { *(f32x4*)(A.out + ((size_t)b * SEQ + (p - CTX)) * 1024 + c) = xa; *(f32x4*)(A.out + ((size_t)b * SEQ + (p - CTX)) * 1024 + c + 4) = xb; }
            xo[j][0] = xa.x; xo[j][1] = xa.y; xo[j][2] = xa.z; xo[j][3] = xa.w; xo[j][4] = xb.x; xo[j][5] = xb.y; xo[j][6] = xb.z; xo[j][7] = xb.w;
#pragma unroll
            for (int e = 0; e < 8; ++e) ss += xo[j][e] * xo[j][e]; }
        if (l + 1 < DEPTH || DRY) {
            const int ln = DRY ? 0 : l + 1; const float rs = rsqrtf(wave_sum(ss) * (1.f / 1024.f) + EPS);
            const float* gn = A.in[6] + ln * 1024; const float* sc1 = MODP(ln, s, 1); const float* sh1 = MODP(ln, s, 0);
#pragma unroll
            for (int j = 0; j < 2; ++j) { const int c = 8 * F.lane + 512 * j; float y[8];
#pragma unroll
                for (int h = 0; h < 2; ++h) { const f32x4 gg = *(const f32x4*)(gn + c + 4 * h), s1 = *(const f32x4*)(sc1 + c + 4 * h), s0 = *(const f32x4*)(sh1 + c + 4 * h);
                    y[4 * h] = xo[j][4 * h] * rs * gg.x * (1.f + s1.x) + s0.x; y[4 * h + 1] = xo[j][4 * h + 1] * rs * gg.y * (1.f + s1.y) + s0.y;
                    y[4 * h + 2] = xo[j][4 * h + 2] * rs * gg.z * (1.f + s1.z) + s0.z; y[4 * h + 3] = xo[j][4 * h + 3] * rs * gg.w * (1.f + s1.w) + s0.w; }
                v4u o; o.x = pk2(y[0], y[1]); o.y = pk2(y[2], y[3]); o.z = pk2(y[4], y[5]); o.w = pk2(y[6], y[7]);
                *(v4u*)(HO + (size_t)R * 1024 + c) = o; } }
    }
}

struct EpiWin {
    static constexpr bool PERM = true; static constexpr int MIDK = 0;
    bf16 *Kb, *Vb, *Qb, *LXb, *GLG, *ZP, *GT; const float* qg; const float* kg;
    __device__ __forceinline__ void operator()(const f32x4 (&acc)[2][2][4][2], const pg8::Unit& u, int wr, int wc, int fr, int fq) const {
        const int pn = u.pn, sec = pn >> 2;
        if (sec == 0 || sec == 3) {
            const bool isq = sec == 3; const bool lat = (u.pm % 33) != 0;
            bf16* dst = (isq ? Qb : Kb) + (pn & 3) * 256 + wc * 64 + 4 * fq; const float* gn = isq ? qg : kg; const float gs = isq ? QSCALE : 1.f;
            f32x4 g[2][2]; float invf[4];
#pragma unroll
            for (int bj = 0; bj < 2; ++bj)
#pragma unroll
                for (int n = 0; n < 2; ++n) g[bj][n] = *(const f32x4*)(gn + 32 * bj + 16 * n + 4 * fq) * gs;
#pragma unroll
            for (int e = 0; e < 4; ++e) invf[e] = exp2f(-(float)(4 * fq + e) * (13.287712379549449f / 16.f)) * 0.15915494309189535f;
#pragma unroll
            for (int ai = 0; ai < 2; ++ai)
#pragma unroll
                for (int m = 0; m < 4; ++m) { const int R = u.pm * 256 + ai * 128 + wr * 64 + m * 16 + fr, t = (R % TPB) - CTX;
                    float ss = 0.f;
#pragma unroll
                    for (int bj = 0; bj < 2; ++bj)
#pragma unroll
                        for (int n = 0; n < 2; ++n) { const f32x4 v = acc[ai][bj][m][n]; ss += (v[0] * v[0] + v[1] * v[1]) + (v[2] * v[2] + v[3] * v[3]); }
                    ss += sx<16>(ss); ss += sx<32>(ss);
                    const float rs = rsqrtf(ss * (1.f / 64.f) + EPS);
#pragma unroll
                    for (int bj = 0; bj < 2; ++bj) { const float pos = (float)(bj ? (t & 63) : (t >> 6));
                        const f32x4 y1 = acc[ai][bj][m][0] * rs * g[bj][0], y2 = acc[ai][bj][m][1] * rs * g[bj][1]; f32x4 o1 = y1, o2 = y2;
                        if (lat) {
#pragma unroll
                            for (int e = 0; e < 4; ++e) { const float rev = pos * invf[e]; const float cs = __builtin_amdgcn_cosf(rev), sn = __builtin_amdgcn_sinf(rev);
                                o1[e] = y1[e] * cs - y2[e] * sn; o2[e] = y1[e] * sn + y2[e] * cs; } }
                        bf16* p = dst + (size_t)R * 1024 + 32 * bj;
                        *(unsigned long long*)p = (unsigned long long)pk2(o1[0], o1[1]) | ((unsigned long long)pk2(o1[2], o1[3]) << 32);
                        *(unsigned long long*)(p + 16) = (unsigned long long)pk2(o2[0], o2[1]) | ((unsigned long long)pk2(o2[2], o2[3]) << 32); }
                    asm volatile("" ::: "memory"); }
        } else {
            bf16* base; int ld = 1024, act = 0;
            if (sec == 1) base = Vb + (pn & 3) * 256; else if (sec == 2) base = LXb + (pn & 3) * 256; else if (sec == 4) { base = GLG + (pn & 3) * 256; act = 1; }
            else if (sec == 5) base = ZP + (pn & 3) * 256; else { base = GT + (pn - 24) * 256; ld = 3072; act = 2; }
            base += wc * 32 + 8 * fq;
#pragma unroll
            for (int ai = 0; ai < 2; ++ai)
#pragma unroll
                for (int m = 0; m < 4; ++m) { bf16* rowp = base + (size_t)(u.pm * 256 + ai * 128 + wr * 64 + m * 16 + fr) * ld;
#pragma unroll
                    for (int bj = 0; bj < 2; ++bj) { f32x4 v0 = acc[ai][bj][m][0], v1 = acc[ai][bj][m][1];
                        if (act == 1) {
#pragma unroll
                            for (int e = 0; e < 4; ++e) { v0[e] = gelu_tanh(v0[e]); v1[e] = gelu_tanh(v1[e]); } }
                        else if (act == 2) {
#pragma unroll
                            for (int e = 0; e < 4; ++e) { v0[e] = sigmoidf_(v0[e]); v1[e] = sigmoidf_(v1[e]); } }
                        v4u o; o.x = pk2(v0[0], v0[1]); o.y = pk2(v0[2], v0[3]); o.z = pk2(v1[0], v1[1]); o.w = pk2(v1[2], v1[3]);
                        *(v4u*)(rowp + bj * 128) = o; } }
        }
    }
};

struct EpiMix {
    static constexpr bool PERM = true; static constexpr int MIDK = 16;
    const bf16* GT; bf16* MD;
    __device__ __forceinline__ void mid(f32x4 (&acc)[2][2][4][2], const pg8::Unit& u, int wr, int wc, int fr, int fq, int seg) const {
        const bf16* gb = GT + (size_t)(u.pm * 256 + wr * 64 + fr) * 3072 + (seg - 1) * 1024 + u.pn * 256 + wc * 32 + 8 * fq;
#pragma unroll
        for (int ai = 0; ai < 2; ++ai)
#pragma unroll
            for (int m = 0; m < 4; ++m)
#pragma unroll
                for (int bj = 0; bj < 2; ++bj) { const bf16* p = gb + (size_t)(ai * 128 + m * 16) * 3072 + bj * 128;
                    const v4u a = *(const v4u*)p, b = *(const v4u*)(p + 1024);
                    const unsigned aw[4] = {a.x, a.y, a.z, a.w}, bw[4] = {b.x, b.y, b.z, b.w};
#pragma unroll
                    for (int q = 0; q < 4; ++q) { const float r0 = bf2f(aw[q] & 0xffffu) * __builtin_amdgcn_rcpf(fmaxf(bf2f(bw[q] & 0xffffu), 1e-30f)), r1 = bf2f(aw[q] >> 16) * __builtin_amdgcn_rcpf(fmaxf(bf2f(bw[q] >> 16), 1e-30f));
                        acc[ai][bj][m][q >> 1][(q & 1) * 2] *= r0; acc[ai][bj][m][q >> 1][(q & 1) * 2 + 1] *= r1; } }
    }
    __device__ __forceinline__ void operator()(const f32x4 (&acc)[2][2][4][2], const pg8::Unit& u, int wr, int wc, int fr, int fq) const {
        const size_t r0 = (size_t)(u.pm * 256 + wr * 64 + fr); const int c0 = u.pn * 256 + wc * 32 + 8 * fq;
#pragma unroll
        for (int ai = 0; ai < 2; ++ai)
#pragma unroll
            for (int m = 0; m < 4; ++m)
#pragma unroll
                for (int bj = 0; bj < 2; ++bj) { const size_t R = r0 + ai * 128 + m * 16; const v4u gv = *(const v4u*)(GT + R * 3072 + 2048 + c0 + bj * 128);
                    const f32x4 v0 = acc[ai][bj][m][0], v1 = acc[ai][bj][m][1]; v4u o;
                    o.x = pk2(v0[0] * bf2f(gv.x & 0xffffu), v0[1] * bf2f(gv.x >> 16)); o.y = pk2(v0[2] * bf2f(gv.y & 0xffffu), v0[3] * bf2f(gv.y >> 16));
                    o.z = pk2(v1[0] * bf2f(gv.z & 0xffffu), v1[1] * bf2f(gv.z >> 16)); o.w = pk2(v1[2] * bf2f(gv.w & 0xffffu), v1[3] * bf2f(gv.w >> 16));
                    *(v4u*)(MD + R * 1024 + c0 + bj * 128) = o; }
    }
};
struct EpiResid {
    static constexpr bool PERM = false; static constexpr int MIDK = 0;
    float* X; const float* mod;
    const float* Xin; const float* Cin;
    __device__ __forceinline__ void operator()(const f32x4 (&acc)[2][2][4][2], const pg8::Unit& u, int wr, int wc, int fr, int fq) const {
        const int src = (u.pm % 33 == 0) ? 2 : u.pm / 33; const float* g1 = mod + src * 6144 + 2 * 1024;
        const float* sbase = Xin ? ((u.pm % 33 == 0) ? Cin + (size_t)(u.pm / 33) * CTX * 1024 : Xin + ((size_t)(u.pm / 33) * SEQ + (size_t)(u.pm % 33 - 1) * 256) * 1024) : X + (size_t)u.pm * 256 * 1024;
        const int col0 = u.pn * 256 + wc * 32 + 4 * fq;
        f32x4 gv[2][2];
#pragma unroll
        for (int bj = 0; bj < 2; ++bj)
#pragma unroll
            for (int n = 0; n < 2; ++n) gv[bj][n] = *(const f32x4*)(g1 + col0 + bj * 128 + n * 16);
#pragma unroll
        for (int ai = 0; ai < 2; ++ai)
#pragma unroll
            for (int m = 0; m < 4; ++m) { const size_t ro = (size_t)(ai * 128 + wr * 64 + m * 16 + fr) * 1024 + col0; float* rowp = X + (size_t)u.pm * 256 * 1024 + ro; const float* srow = sbase + ro;
#pragma unroll
                for (int bj = 0; bj < 2; ++bj)
#pragma unroll
                    for (int n = 0; n < 2; ++n) { *(f32x4*)(rowp + bj * 128 + n * 16) = *(const f32x4*)(srow + bj * 128 + n * 16) + gv[bj][n] * acc[ai][bj][m][n]; } }
    }
};
struct EpiRS {
    static constexpr bool PERM = true; static constexpr int MIDK = 0;
    float* LG; bf16* SH;
    __device__ __forceinline__ void operator()(const f32x4 (&acc)[2][2][4][2], const pg8::Unit& u, int wr, int wc, int fr, int fq) const {
#pragma unroll
        for (int ai = 0; ai < 2; ++ai)
#pragma unroll
            for (int m = 0; m < 4; ++m) { const size_t R = (size_t)u.pm * 256 + ai * 128 + wr * 64 + m * 16 + fr;
                if (u.pn == 0) {
#pragma unroll
                    for (int bj = 0; bj < 2; ++bj) { float* p = LG + R * 256 + bj * 128 + wc * 32 + 8 * fq; *(f32x4*)p = acc[ai][bj][m][0]; *(f32x4*)(p + 4) = acc[ai][bj][m][1]; } }
                else { const f32x4 g0 = acc[ai][0][m][0], g1 = acc[ai][0][m][1], u0 = acc[ai][1][m][0], u1 = acc[ai][1][m][1];
                    v4u w; w.x = pk2(siluf_(g0[0]) * u0[0], siluf_(g0[1]) * u0[1]); w.y = pk2(siluf_(g0[2]) * u0[2], siluf_(g0[3]) * u0[3]);
                    w.z = pk2(siluf_(g1[0]) * u1[0], siluf_(g1[1]) * u1[1]); w.w = pk2(siluf_(g1[2]) * u1[2], siluf_(g1[3]) * u1[3]);
                    *(v4u*)(SH + R * 256 + (u.pn - 1) * 128 + wc * 32 + 8 * fq) = w; } }
    }
};
__device__ __forceinline__ void ph_norm2(const Frame& F, const Args& A, int l) {
    const float* X = WSP(float, WS_XALL); bf16* TOK = WSP(bf16, WS_TOK);
    for (int R = F.gw; R < MROWS; R += F.NGW) {
        const int b = R / TPB, p = R % TPB, s = (p < CTX) ? 2 : b;
        if (l == DEPTH - 1 && p < CTX) continue;
        f32x4 v[4];
#pragma unroll
        for (int j = 0; j < 4; ++j) v[j] = *(const f32x4*)(X + (size_t)R * 1024 + 4 * F.lane + 256 * j);
        norm_mod_row(v, A.in[23] + l * 1024, MODP(l, s, 4), MODP(l, s, 3), TOK + (size_t)R * 1024, F.lane);
    }
}

constexpr int PH_PER_L = 18, N_PHASES = 1 + DEPTH * PH_PER_L;
template <int P, bool DRY = false> __device__ __forceinline__ void run_phase(const Frame& F, const Args& A, int l) {
    if constexpr (P == -1) ph_prologue(F, A);
    if constexpr (P == 0) ph_norm1(F, A, l);
#if !FAST_WIN
#error oracle w_in path removed
#endif
    if constexpr (P == 1) { const int Ge = F.G - KCONV_WIN; const int cb = conv_base(F, A, l);
        if (F.bid < Ge) { pg8::Gemm g{WSP(bf16, WS_H), WLP(l, WO_WIN), MROWS, INW, 1024, 1024, 1024}; pg8::StaticOrder S; S.init(MROWS, INW, Ge, F.bid);
            EpiWin E{WSP(bf16, WS_KB), WSP(bf16, WS_VB), WSP(bf16, WS_QB), WSP(bf16, WS_LXB), WSP(bf16, WS_GLG), WSP(bf16, WS_ZP), WSP(bf16, WS_GATES), A.in[8] + l * 64, A.in[9] + l * 64};
            pg8::gemm_phase(F.lds, g, S, E); }
        else ph_expert_w(F, A, l, min(EWI_N, cb), min(EWI_N, cb + EWI_A), Ge, KCONV_WIN); }
    if constexpr (P == 3) { ph_conv(F, A, l); ph_fft_t1_fast(F, A);
        { const int cb = conv_base(F, A, l); ph_expert_w(F, A, l, min(EWI_N, cb + (l == 0 ? EWI_D : EWI_B)), EWI_N, 0, F.G); } }
    if constexpr (P == 4) {
        { const int cb = conv_base(F, A, l);
          if (F.bid < F.G - KCONV_LRU) ph_lru_gemm(F, A, l, F.G - KCONV_LRU); else ph_expert_w(F, A, l, min(EWI_N, cb + EWI_A), min(EWI_N, cb + EWI_B), F.G - KCONV_LRU, KCONV_LRU); }
        __syncthreads();
#if FAST_FFT_A
        ph_fft_a_gemm(F, A);
#else
        ph_fft_a(F, A);
#endif
        ph_fft_c(F, A);
    }
    if constexpr (P == 5) {
        ph_scan1(F, A);
#if FAST_FFT_B
        ph_fft_b_gemm(F, A);
#else
        ph_fft_b(F, A);
#endif
    }
    if constexpr (P == 6) { ph_scan2_fast(F, A); ph_fft_t2_fast(F, A); }
    if constexpr (P == 7) { ph_scan3(F, A);
#if FAST_ATTN
        ph_attn(F, A, l);
#endif
    }
    if constexpr (P == 8) {
#if !FAST_ATTN
        ph_attn_naive(F, A, l);
#endif
        __syncthreads(); }
#if FAST_MIX
    if constexpr (P == 9) { const bool sp = (l == 0) && F.G > 2 * KCONV_D; const int Ge = sp ? F.G - KCONV_D : F.G;
        if (F.bid < Ge) { pg8::Gemm g{WSP(bf16, WS_MIXIN), WLP(l, WO_D1), MROWS, 1024, 3072, 3072, 3072}; pg8::StaticOrder S; S.init(MROWS, 1024, Ge, F.bid, l == DEPTH - 1);
            EpiMix E{WSP(bf16, WS_GATES), WSP(bf16, WS_MIXED)}; pg8::gemm_phase(F.lds, g, S, E); }
        else ph_expert_w(F, A, l, EWI_B, EWI_C, Ge, KCONV_D); }
    if constexpr (P == 11) { const bool sp = (l == 0) && F.G > 2 * KCONV_D; const int Ge = sp ? F.G - KCONV_D : F.G;
        if (F.bid < Ge) { pg8::Gemm g{WSP(bf16, WS_MIXED), WLP(l, WO_OUT), MROWS, 1024, 1024, 1024, 1024}; pg8::StaticOrder S; S.init(MROWS, 1024, Ge, F.bid, l == DEPTH - 1);
            EpiResid E{WSP(float, WS_XALL), (const float*)(A.ws + WS_CTL) + CW_MOD + l * 3 * 6144, l == 0 ? A.in[0] : nullptr, l == 0 ? A.in[2] : nullptr}; pg8::gemm_phase(F.lds, g, S, E); }
        else ph_expert_w(F, A, l, EWI_C, EWI_D, Ge, KCONV_D); }
    if constexpr (P == 12) ph_norm2(F, A, l);
#else
    if constexpr (P == 9) {
        { pg8::Gemm g{WSP(bf16, WS_MIXIN), WLP(l, WO_D1), MROWS, 1024, 1024, 3072, 3072}; pg8::StaticOrder S; S.init(MROWS, 1024, F.G, F.bid); pg8::EpiF32 E{WSP(float, WS_PA), 1024}; pg8::gemm_phase(F.lds, g, S, E); }
        { pg8::Gemm g{WSP(bf16, WS_MIXIN) + 1024, WLP(l, WO_D1) + 1024, MROWS, 1024, 1024, 3072, 3072}; pg8::StaticOrder S; S.init(MROWS, 1024, F.G, F.bid); pg8::EpiF32 E{WSP(float, WS_PR), 1024}; pg8::gemm_phase(F.lds, g, S, E); }
        { pg8::Gemm g{WSP(bf16, WS_MIXIN) + 2048, WLP(l, WO_D1) + 2048, MROWS, 1024, 1024, 3072, 3072}; pg8::StaticOrder S; S.init(MROWS, 1024, F.G, F.bid); pg8::EpiF32 E{WSP(float, WS_PF), 1024}; pg8::gemm_phase(F.lds, g, S, E); } }
    if constexpr (P == 10) ph_mix(F, A);
    if constexpr (P == 11) { pg8::Gemm g{WSP(bf16, WS_MIXED), WLP(l, WO_OUT), MROWS, 1024, 1024, 1024, 1024}; pg8::StaticOrder S; S.init(MROWS, 1024, F.G, F.bid);
        pg8::EpiF32 E{WSP(float, WS_Y1), 1024}; pg8::gemm_phase(F.lds, g, S, E); }
    if constexpr (P == 12) ph_resid_norm2(F, A, l);
#endif
    if constexpr (P == 13) { const bool early = l + 1 < DEPTH; const int Ge = early ? F.G - KCONV_RS : F.G;
        if (F.bid < Ge) { pg8::Gemm g{WSP(bf16, WS_TOK), WLP(l, WO_R), MROWS, 768, 1024, 1024, 1024}; pg8::StaticOrder S; S.init(MROWS, 768, Ge, F.bid, l == DEPTH - 1);
            EpiRS E{WSP(float, WS_LOG), WSP(bf16, WS_SH)}; pg8::gemm_phase(F.lds, g, S, E); }
        else ph_expert_w(F, A, l + 1, 0, KCONV_RS * NWAVES * Q13, Ge, KCONV_RS); }
    if constexpr (P == 14) ph_topk<DRY>(F, A, l);
    if constexpr (P == 15) {
#if FAST_MOE
        ph_experts_up(F, A, l);
#else
        ph_experts_naive(F, A, l); __syncthreads();
#endif

        { pg8::Gemm g{WSP(bf16, WS_SH), WLP(l, WO_SD), MROWS, 1024, 256, 256, 256}; pg8::StaticOrder S; S.init(MROWS, 1024, F.G, F.bid, l == DEPTH - 1); EpiBf16U E{WSP(bf16, WS_SD), 1024}; pg8::gemm_phase(F.lds, g, S, E); } }
    if constexpr (P == 16) {
#if FAST_MOE
        ph_experts_down(F, A, l);
#endif
    }
    if constexpr (P == 17) ph_combine<DRY>(F, A, l);
}
__device__ __forceinline__ Frame make_frame(unsigned char* lds) {
    Frame F; F.lds = (LAS unsigned char*)lds; F.tid = otid(); F.lane = F.tid & 63; F.wave = __builtin_amdgcn_readfirstlane(F.tid >> 6);
    F.bid = obid(); F.G = ogrid(); F.gw = F.bid * NWAVES + F.wave; F.NGW = F.G * NWAVES; F.gtid = (long)F.bid * 512 + F.tid; F.NT = (long)F.G * 512;
    return F;
}
template <int P> __global__ void __launch_bounds__(NWAVES * 64, 2) mk_phase(Args A) {
    extern __shared__ __attribute__((aligned(16))) unsigned char lds[];
    const Frame F = make_frame(lds);
    run_phase<P>(F, A, A.ph_lo);
}
#if N_LAUNCH_MODE == 1
__device__ __forceinline__ const float* lds_ptr(const LAS unsigned long long* tab, int i) {
    const unsigned long long v = tab[i];
    const unsigned lo = __builtin_amdgcn_readfirstlane((unsigned)v), hi = __builtin_amdgcn_readfirstlane((unsigned)(v >> 32));
    return (const float*)(const __attribute__((address_space(1))) float*)(((unsigned long long)hi << 32) | lo);
}
__device__ __forceinline__ void load_args(Args& L, const LAS unsigned long long* tab) {
#pragma unroll
    for (int i = 0; i < 32; ++i) L.in[i] = lds_ptr(tab, i);
    L.out = (float*)lds_ptr(tab, 32); L.ws = (unsigned char*)lds_ptr(tab, 33); L.ph_lo = 0; L.ph_hi = 0;
}
__global__ void __launch_bounds__(NWAVES * 64, 2) mk_fwd(Args A) {
    extern __shared__ __attribute__((aligned(16))) unsigned char lds[];
    LAS unsigned char* L3 = (LAS unsigned char*)lds;
    volatile LAS unsigned* MISC = (volatile LAS unsigned*)(L3 + MISC_OFF);
    for (int u = threadIdx.x; u < (LDS_BYTES - RING_BYTES) / 4; u += NWAVES * 64) ((LAS unsigned*)(L3 + RING_BYTES))[u] = 0u;
    __syncthreads();
    LAS unsigned long long* tab = (LAS unsigned long long*)(L3 + RING_BYTES + 4096);
    if (threadIdx.x == 0) {
#define ST(i) tab[i] = (unsigned long long)A.in[i];
        ST(0) ST(1) ST(2) ST(3) ST(4) ST(5) ST(6) ST(7) ST(8) ST(9) ST(10) ST(11) ST(12) ST(13) ST(14) ST(15) ST(16) ST(17) ST(18) ST(19) ST(20) ST(21) ST(22) ST(23) ST(24) ST(25) ST(26) ST(27) ST(28) ST(29) ST(30) ST(31)
#undef ST
        tab[32] = (unsigned long long)A.out; tab[33] = (unsigned long long)A.ws;
    }
    __syncthreads();
    (void)xcd_barrier_post((unsigned*)(A.ws + WS_CTL) + CW_BAR, MISC + 8);
#define RUN(P) do { asm volatile("; PHASE_MARK " #P); { unsigned tb_ = RING_BYTES + 4096; asm volatile("" : "+v"(tb_)); Args L; load_args(L, (const LAS unsigned long long*)(L3 + tb_)); \
        const Frame F = make_frame(lds); run_phase<P>(F, L, l); \
        if constexpr (P >= 0 && ((REP_MASK >> (P < 0 ? 0 : P)) & 1)) { for (int rp_ = 0; rp_ < REP_N; ++rp_) { asm volatile("s_waitcnt vmcnt(0)" ::: "memory"); __syncthreads(); run_phase<P, true>(F, L, l); } } \
        XcdBarrier bar; bar.bar = (unsigned*)(L.ws + WS_CTL) + CW_BAR; bar.x = xb_xcc_id(); { unsigned mo_ = MISC_OFF + 32; asm volatile("" : "+v"(mo_)); bar.st = (volatile LAS unsigned*)(L3 + mo_); } \
        xcd_barrier(bar); } } while (0)
    { const int l = 0; RUN(-1);
#if REP_PRO
      for (int rp_ = 0; rp_ < 2; ++rp_) { RUN(-1); }
#endif
    }
    for (int l = 0; l < DEPTH; ++l) {
        if (l == 0) RUN(0);
        RUN(1); RUN(3); RUN(4); RUN(5); RUN(6); RUN(7); RUN(9); RUN(11); RUN(12); RUN(13); RUN(14); RUN(15); RUN(16); RUN(17);
    }
#undef RUN
}
#endif

extern "C" void kernel_launch(void* const* d_in, const int* in_sizes, int n_in, void* d_out, int out_size, void* d_ws, size_t ws_size, hipStream_t stream) {
    static int grid = 0;
    if (grid == 0) {
        if (n_in != 32 || out_size != NB * SEQ * DM || ws_size < WS_END) { fprintf(stderr, "kernel_launch: unexpected shapes (n_in %d, out %d, ws %zu < %zu)\n", n_in, out_size, ws_size, (size_t)WS_END); grid = -1; return; }
        int dev = 0, cus = 0;
        if (hipGetDevice(&dev) != hipSuccess || hipDeviceGetAttribute(&cus, hipDeviceAttributeMultiprocessorCount, dev) != hipSuccess) { grid = -1; return; }
#define SETA(K) if (hipFuncSetAttribute((const void*)K, hipFuncAttributeMaxDynamicSharedMemorySize, LDS_BYTES) != hipSuccess) { fprintf(stderr, "kernel_launch: hipFuncSetAttribute failed\n"); grid = -1; return; }
#if N_LAUNCH_MODE == 1
        SETA(mk_fwd)
#else
        SETA(mk_phase<-1>) SETA(mk_phase<0>) SETA(mk_phase<1>) SETA(mk_phase<2>) SETA(mk_phase<3>) SETA(mk_phase<4>) SETA(mk_phase<5>) SETA(mk_phase<6>) SETA(mk_phase<7>) SETA(mk_phase<8>)
        SETA(mk_phase<9>) SETA(mk_phase<10>) SETA(mk_phase<11>) SETA(mk_phase<12>) SETA(mk_phase<13>) SETA(mk_phase<14>) SETA(mk_phase<15>) SETA(mk_phase<16>) SETA(mk_phase<17>)
#endif
#undef SETA
        int per_cu = 0;
        (void)per_cu;
        if (cus * MOE_MAXU < 2 * (NPAIR / 256 + 256)) { fprintf(stderr, "kernel_launch: too few CUs (%d) for the staged MoE row lists\n", cus); grid = -1; return; }
        grid = cus;
    }
    if (grid < 0) return;
    (void)hipMemsetAsync((char*)d_ws + WS_CTL, 0, CTL_ZERO_BYTES, stream);
    Args a{};
    for (int i = 0; i < 32; ++i) a.in[i] = (const float*)d_in[i];
    a.out = (float*)d_out; a.ws = (unsigned char*)d_ws;
#if N_LAUNCH_MODE == 1
    a.ph_lo = 0; a.ph_hi = N_PHASES;
    hipLaunchKernelGGL(mk_fwd, dim3(grid), dim3(NWAVES * 64), LDS_BYTES, stream, a);
#else
#define LAUNCH_P(P) hipLaunchKernelGGL(mk_phase<P>, dim3(grid), dim3(NWAVES * 64), LDS_BYTES, stream, a)
    a.ph_lo = 0; a.ph_hi = 0; LAUNCH_P(-1);
    for (int l = 0; l < DEPTH; ++l) { a.ph_lo = l;
        LAUNCH_P(0); LAUNCH_P(1); LAUNCH_P(2); LAUNCH_P(3); LAUNCH_P(4); LAUNCH_P(5); LAUNCH_P(6); LAUNCH_P(7); LAUNCH_P(8); LAUNCH_P(9); LAUNCH_P(10); LAUNCH_P(11); LAUNCH_P(12); LAUNCH_P(13); LAUNCH_P(14); LAUNCH_P(15); LAUNCH_P(16); LAUNCH_P(17); }
#undef LAUNCH_P
#endif
    const hipError_t le = hipPeekAtLastError();
    if (le != hipSuccess) fprintf(stderr, "kernel_launch: launch failed: %s\n", hipGetErrorName(le));
}
```

```cpp
#include <hip/hip_runtime.h>
#include <cstdio>
#include <cstdint>

#ifndef ATTN_V2
#define ATTN_V2 8
#endif
#ifndef REP_PRO
#define REP_PRO 0
#endif
#ifndef REP_MASK
#define REP_MASK 0
#endif
#ifndef REP_N
#define REP_N 2
#endif
#ifndef FAST_MIX
#define FAST_MIX 1
#endif
#ifndef FAST_WIN
#define FAST_WIN 1
#endif
#ifndef FAST_LRU
#define FAST_LRU 1
#endif
#define FAST_FFT 0
#ifndef FAST_FFT_A
#define FAST_FFT_A 1
#endif
#ifndef FAST_FFT_B
#define FAST_FFT_B 1
#endif
#ifndef FAST_MOE
#define FAST_MOE 1
#endif
#ifndef FAST_ATTN
#define FAST_ATTN 1
#endif
#ifndef N_LAUNCH_MODE
#define N_LAUNCH_MODE 1
#endif

__device__ __forceinline__ int otid() { int t = threadIdx.x; asm volatile("" : "+v"(t)); return t; }
__device__ __forceinline__ int obid() { int b = blockIdx.x; asm volatile("" : "+s"(b)); return b; }
__device__ __forceinline__ int ogrid() { int g = gridDim.x; asm volatile("" : "+s"(g)); return g; }
template <int M> __device__ __forceinline__ float sx(float v) {
    static_assert(M == 1 || M == 2 || M == 4 || M == 8 || M == 16 || M == 32, "xor mask");
    if constexpr (M < 32) return __uint_as_float((unsigned)__builtin_amdgcn_ds_swizzle((int)__float_as_uint(v), (M << 10) | 0x1f));
    else { auto rr = __builtin_amdgcn_permlane32_swap(__float_as_uint(v), __float_as_uint(v), false, false); const unsigned a = rr[0], b = rr[1]; return __uint_as_float(a == __float_as_uint(v) ? b : a); }
}
template <int M> __device__ __forceinline__ int sxi(int v) { return (int)__float_as_uint(sx<M>(__uint_as_float((unsigned)v))); }
namespace pg8 {
#define PG8_LAS __attribute__((address_space(3)))
typedef unsigned short bf16_t;
typedef short bf16x8 __attribute__((ext_vector_type(8)));
typedef float f32x4 __attribute__((ext_vector_type(4)));
typedef unsigned u32x4 __attribute__((ext_vector_type(4)));
constexpr int BM = 256, BK = 64, HALF = 128, HTB = HALF * BK * 2, STAGE_BYTES = 8 * HTB, NXCD = 8, WGM = 8;
__host__ __device__ __forceinline__ int lds_byte(int r, int c) { const int st = (r >> 4) * 2 + (c >> 5), rr = r & 15, cc = c & 31, ob = rr * 64 + cc * 2; return st * 1024 + (ob ^ (((ob >> 9) & 1) << 5)); }
__host__ __device__ __forceinline__ void stage_rc(int b, int& R, int& C) { const int st = b / 1024, sb = b % 1024, swz = sb ^ (((sb >> 9) & 1) << 5); R = (st >> 1) * 16 + swz / 64; C = (st & 1) * 32 + (swz % 64) / 2; }
__host__ __device__ __forceinline__ int perm32(int rho) { const int n = rho >> 4, i = rho & 15; return 8 * (i >> 2) + 4 * n + (i & 3); }
struct Unit { int pm, pn; };
struct Gemm { const bf16_t* A; const bf16_t* Bt; int M, N, K, lda, ldb; };
struct StaticOrder {
    int nM, nN, nwg, G, c; bool skipctx;
    __host__ __device__ void init(int M, int N, int G_, int c_, bool skip = false) { nM = skip ? 64 : M / BM; nN = N / BM; nwg = nM * nN; G = G_; c = c_; skipctx = skip; }
    __host__ __device__ bool next(int i, Unit& u) const {
        const long L = (long)i * G + c; if (L >= nwg) return false;
        int wgid = (int)L; { const int q = nwg / NXCD, r = nwg % NXCD, xcd = wgid % NXCD, off = wgid / NXCD; wgid = (xcd < r ? xcd * (q + 1) : r * (q + 1) + (xcd - r) * q) + off; }
        const int nig = WGM * nN, gid = wgid / nig, fm = gid * WGM, gsz = (nM - fm) < WGM ? (nM - fm) : WGM;
        u.pm = fm + ((wgid % nig) % gsz); u.pn = (wgid % nig) / gsz;
        if (skipctx) u.pm += 1 + (u.pm >= 32 ? 1 : 0);
        return true;
    }
};
__device__ __forceinline__ unsigned cvt_pk_bf16(float lo, float hi) { unsigned r; asm volatile("v_cvt_pk_bf16_f32 %0, %1, %2" : "=v"(r) : "v"(lo), "v"(hi)); return r; }

struct EpiF32 {
    static constexpr bool PERM = false; static constexpr int MIDK = 0;
    float* C; int ldc;
    __device__ __forceinline__ void operator()(const f32x4 (&acc)[2][2][4][2], const Unit& u, int wr, int wc, int fr, int fq) const {
        const int row0 = u.pm * BM + wr * 64 + fr, col0 = u.pn * BM + wc * 32 + 4 * fq;
#pragma unroll
        for (int ai = 0; ai < 2; ++ai)
#pragma unroll
            for (int m = 0; m < 4; ++m) { float* rowp = C + (size_t)(row0 + ai * HALF + m * 16) * ldc + col0;
#pragma unroll
                for (int bj = 0; bj < 2; ++bj)
#pragma unroll
                    for (int n = 0; n < 2; ++n) *(f32x4*)(rowp + bj * HALF + n * 16) = acc[ai][bj][m][n]; }
    }
};

template <class Epi>
__device__ __forceinline__ void gemm_phase(PG8_LAS unsigned char* lds, const Gemm g, const StaticOrder& S, const Epi& E) {
    const int tid = otid(), wid = __builtin_amdgcn_readfirstlane(tid >> 6), lane = tid & 63, wr = wid >> 2, wc = wid & 3, fr = lane & 15, fq = lane >> 4;
    const int K = g.K, nt = K / BK;
    unsigned voffA[2], voffB[2];
#pragma unroll
    for (int i = 0; i < 2; ++i) { int R, C; stage_rc(tid * 16 + i * 8192, R, C); const int Rb = Epi::PERM ? ((R & ~31) + perm32(R & 31)) : R;
        voffA[i] = (unsigned)(R * g.lda + C) * 2u; voffB[i] = (unsigned)(Rb * g.ldb + C) * 2u; }
    const size_t kstep = (size_t)(BK * 2);
    const size_t hA = (size_t)HALF * g.lda * 2, hB = (size_t)HALF * g.ldb * 2;
    const size_t tA = 2 * hA, tB = 2 * hB;
    const unsigned ldsw = (unsigned)wid * 1024u;
    const int aoff = lds_byte(wr * 64 + fr, fq * 8), boff = lds_byte(wc * 32 + fr, fq * 8);
#define PG8_SA(b, h) (((b) * 2 + (h)) * HTB)
#define PG8_SB(b, h) ((4 + (b) * 2 + (h)) * HTB)
#define PG8_STAGE(bufoff, gbase, voff) do { _Pragma("unroll") for (int _i = 0; _i < 2; ++_i) \
        __builtin_amdgcn_global_load_lds((const unsigned*)((const char*)(gbase) + (voff)[_i]), (PG8_LAS unsigned*)(lds + (bufoff) + ldsw + _i * 8192), 16, 0, 0); } while (0)
#define PG8_LDA(dst, b, h) do { _Pragma("unroll") for (int m = 0; m < 4; ++m) _Pragma("unroll") for (int k = 0; k < 2; ++k) dst[m][k] = *(const PG8_LAS bf16x8*)(lds + PG8_SA(b, h) + aoff + m * 2048 + k * 1024); } while (0)
#define PG8_LDB(dst, b, h) do { _Pragma("unroll") for (int n = 0; n < 2; ++n) _Pragma("unroll") for (int k = 0; k < 2; ++k) dst[n][k] = *(const PG8_LAS bf16x8*)(lds + PG8_SB(b, h) + boff + n * 2048 + k * 1024); } while (0)
#define PG8_MMA(ai, bj, At, Bt) do { __builtin_amdgcn_s_setprio(1); _Pragma("unroll") for (int m = 0; m < 4; ++m) _Pragma("unroll") for (int n = 0; n < 2; ++n) _Pragma("unroll") for (int k = 0; k < 2; ++k) \
        acc[ai][bj][m][n] = __builtin_amdgcn_mfma_f32_16x16x32_bf16(Bt[n][k], At[m][k], acc[ai][bj][m][n], 0, 0, 0); __builtin_amdgcn_s_setprio(0); } while (0)
#define PG8_WAIT_V(n) asm volatile("s_waitcnt vmcnt(" #n ")" ::: "memory")
#define PG8_WAIT_L(n) asm volatile("s_waitcnt lgkmcnt(" #n ")" ::: "memory")
#define PG8_BAR __builtin_amdgcn_s_barrier()
#define PG8_SCHED __builtin_amdgcn_sched_barrier(0)
    Unit cur, nxt; int ui = 0;
    if (!S.next(0, cur)) return;
    f32x4 acc[2][2][4][2];
#pragma unroll
    for (int a = 0; a < 2; ++a)
#pragma unroll
        for (int b = 0; b < 2; ++b)
#pragma unroll
            for (int m = 0; m < 4; ++m)
#pragma unroll
                for (int n = 0; n < 2; ++n) acc[a][b][m][n] = (f32x4){0.f, 0.f, 0.f, 0.f};
    bf16x8 At[4][2], B0[2][2], B1[2][2];
    const char* cA = (const char*)g.A + (size_t)cur.pm * tA; const char* cB = (const char*)g.Bt + (size_t)cur.pn * tB;
    PG8_STAGE(PG8_SB(0, 0), cB, voffB); PG8_STAGE(PG8_SB(0, 1), cB + hB, voffB); PG8_STAGE(PG8_SA(0, 0), cA, voffA); PG8_STAGE(PG8_SA(0, 1), cA + hA, voffA);
    if (wr == 1) PG8_BAR;
    PG8_WAIT_V(2); PG8_BAR;
    PG8_STAGE(PG8_SB(1, 0), cB + kstep, voffB); PG8_STAGE(PG8_SA(1, 0), cA + kstep, voffA); PG8_STAGE(PG8_SB(1, 1), cB + hB + kstep, voffB);
    PG8_WAIT_V(6); PG8_BAR;
    for (;;) {
        const bool has_next = S.next(ui + 1, nxt);
        const char* nA = has_next ? (const char*)g.A + (size_t)nxt.pm * tA : cA; const char* nB = has_next ? (const char*)g.Bt + (size_t)nxt.pn * tB : cB;
#pragma unroll 1
        for (int t = 0; t < nt; t += 2) {
            if constexpr (Epi::MIDK > 0) { if (t > 0 && (t % Epi::MIDK) == 0) E.mid(acc, cur, wr, wc, fr, fq, t / Epi::MIDK); }
            const bool last = (t == nt - 2);
            const char* a1 = cA + (size_t)(t + 1) * kstep;
            const char* a2 = last ? nA : cA + (size_t)(t + 2) * kstep; const char* b2 = last ? nB : cB + (size_t)(t + 2) * kstep;
            const char* a3 = a2 + kstep; const char* b3 = b2 + kstep;
            PG8_LDB(B0, 0, 0); PG8_LDB(B1, 0, 1); PG8_SCHED; PG8_LDA(At, 0, 0); PG8_STAGE(PG8_SA(1, 1), a1 + hA, voffA);
            PG8_WAIT_V(8); PG8_WAIT_L(0); PG8_BAR; PG8_MMA(0, 0, At, B0); PG8_MMA(0, 1, At, B1); PG8_BAR; PG8_SCHED;
            PG8_LDA(At, 0, 1); PG8_STAGE(PG8_SB(0, 0), b2, voffB); PG8_STAGE(PG8_SB(0, 1), b2 + hB, voffB); PG8_STAGE(PG8_SA(0, 0), a2, voffA);
            PG8_WAIT_V(8); PG8_WAIT_L(0); PG8_BAR; PG8_MMA(1, 0, At, B0); PG8_MMA(1, 1, At, B1); PG8_BAR; PG8_SCHED;
            PG8_LDB(B0, 1, 0); PG8_LDB(B1, 1, 1); PG8_SCHED; PG8_LDA(At, 1, 0); PG8_STAGE(PG8_SA(0, 1), a2 + hA, voffA);
            PG8_WAIT_V(8); PG8_WAIT_L(0); PG8_BAR; PG8_MMA(0, 0, At, B0); PG8_MMA(0, 1, At, B1); PG8_BAR; PG8_SCHED;
            PG8_LDA(At, 1, 1); PG8_STAGE(PG8_SB(1, 0), b3, voffB); PG8_STAGE(PG8_SB(1, 1), b3 + hB, voffB); PG8_STAGE(PG8_SA(1, 0), a3, voffA);
            PG8_WAIT_V(8); PG8_WAIT_L(0); PG8_BAR; PG8_MMA(1, 0, At, B0); PG8_MMA(1, 1, At, B1); PG8_BAR; PG8_SCHED;
        }
        if (wr == 0) PG8_BAR;
        E(acc, cur, wr, wc, fr, fq);
        if (!has_next) break;
#pragma unroll
        for (int a = 0; a < 2; ++a)
#pragma unroll
            for (int b = 0; b < 2; ++b)
#pragma unroll
                for (int m = 0; m < 4; ++m)
#pragma unroll
                    for (int n = 0; n < 2; ++n) acc[a][b][m][n] = (f32x4){0.f, 0.f, 0.f, 0.f};
        cur = nxt; cA = nA; cB = nB; ++ui;
        if (wr == 1) PG8_BAR;
    }
    PG8_WAIT_V(0);
    PG8_BAR;
#undef PG8_SA
#undef PG8_SB
#undef PG8_STAGE
#undef PG8_LDA
#undef PG8_LDB
#undef PG8_MMA
#undef PG8_WAIT_V
#undef PG8_WAIT_L
#undef PG8_BAR
#undef PG8_SCHED
}

struct UnitG { const char* a; const char* b; int row0, pn, e, valid; const int* rows; const PG8_LAS int* lrows; };
template <class Epi, class Sched, bool GATHER>
__device__ __forceinline__ void gemm_phase_g(PG8_LAS unsigned char* lds, const int K, const int lda, const int ldb, const Sched& S, const Epi& E) {
    const int tid = otid(), wid = __builtin_amdgcn_readfirstlane(tid >> 6), lane = tid & 63, wr = wid >> 2, wc = wid & 3, fr = lane & 15, fq = lane >> 4;
    const int nt = K / BK;
    int RA[2], CA[2]; unsigned voffB[2];
#pragma unroll
    for (int i = 0; i < 2; ++i) { int R, C; stage_rc(tid * 16 + i * 8192, R, C); const int Rb = Epi::PERM ? ((R & ~31) + perm32(R & 31)) : R;
        RA[i] = R; CA[i] = C; voffB[i] = (unsigned)(Rb * ldb + C) * 2u; }
    const size_t kstep = (size_t)(BK * 2);
    const size_t hB = (size_t)HALF * ldb * 2;
    const unsigned ldsw = (unsigned)wid * 1024u;
    const int aoff = lds_byte(wr * 64 + fr, fq * 8), boff = lds_byte(wc * 32 + fr, fq * 8);
#define PG8_SA(b, h) (((b) * 2 + (h)) * HTB)
#define PG8_SB(b, h) ((4 + (b) * 2 + (h)) * HTB)
#define PG8_STAGE(bufoff, gbase, voff) do { _Pragma("unroll") for (int _i = 0; _i < 2; ++_i) \
        __builtin_amdgcn_global_load_lds((const unsigned*)((const char*)(gbase) + (voff)[_i]), (PG8_LAS unsigned*)(lds + (bufoff) + ldsw + _i * 8192), 16, 0, 0); } while (0)
#define PG8_LDA(dst, b, h) do { _Pragma("unroll") for (int m = 0; m < 4; ++m) _Pragma("unroll") for (int k = 0; k < 2; ++k) dst[m][k] = *(const PG8_LAS bf16x8*)(lds + PG8_SA(b, h) + aoff + m * 2048 + k * 1024); } while (0)
#define PG8_LDB(dst, b, h) do { _Pragma("unroll") for (int n = 0; n < 2; ++n) _Pragma("unroll") for (int k = 0; k < 2; ++k) dst[n][k] = *(const PG8_LAS bf16x8*)(lds + PG8_SB(b, h) + boff + n * 2048 + k * 1024); } while (0)
#define PG8_MMA(ai, bj, At, Bt) do { __builtin_amdgcn_s_setprio(1); _Pragma("unroll") for (int m = 0; m < 4; ++m) _Pragma("unroll") for (int n = 0; n < 2; ++n) _Pragma("unroll") for (int k = 0; k < 2; ++k) \
        acc[ai][bj][m][n] = __builtin_amdgcn_mfma_f32_16x16x32_bf16(Bt[n][k], At[m][k], acc[ai][bj][m][n], 0, 0, 0); __builtin_amdgcn_s_setprio(0); } while (0)
#define PG8_WAIT_V(n) asm volatile("s_waitcnt vmcnt(" #n ")" ::: "memory")
#define PG8_WAIT_L(n) asm volatile("s_waitcnt lgkmcnt(" #n ")" ::: "memory")
#define PG8_BAR __builtin_amdgcn_s_barrier()
#define PG8_SCHED __builtin_amdgcn_sched_barrier(0)
#define PG8_MKOFF(u, v) do { _Pragma("unroll") for (int _h = 0; _h < 2; ++_h) _Pragma("unroll") for (int _i = 0; _i < 2; ++_i) { const int _row = _h * HALF + RA[_i]; \
        if (GATHER) { const int _pr = (u).lrows[_row]; v[_h][_i] = (unsigned)(_pr >> 3) * (unsigned)(lda * 2) + (unsigned)(CA[_i] * 2); } \
        else v[_h][_i] = (unsigned)(_row * lda + CA[_i]) * 2u; } } while (0)
    UnitG cur, nxt; int ui = 0;
    if (!S.next(0, cur)) return;
    f32x4 acc[2][2][4][2];
#pragma unroll
    for (int a = 0; a < 2; ++a)
#pragma unroll
        for (int b = 0; b < 2; ++b)
#pragma unroll
            for (int m = 0; m < 4; ++m)
#pragma unroll
                for (int n = 0; n < 2; ++n) acc[a][b][m][n] = (f32x4){0.f, 0.f, 0.f, 0.f};
    bf16x8 At[4][2], B0[2][2], B1[2][2];
    unsigned vA[2][2], vN[2][2];
    PG8_MKOFF(cur, vA);
    const char* cA = cur.a; const char* cB = cur.b;
    PG8_STAGE(PG8_SB(0, 0), cB, voffB); PG8_STAGE(PG8_SB(0, 1), cB + hB, voffB); PG8_STAGE(PG8_SA(0, 0), cA, vA[0]); PG8_STAGE(PG8_SA(0, 1), cA, vA[1]);
    if (wr == 1) PG8_BAR;
    PG8_WAIT_V(2); PG8_BAR;
    PG8_STAGE(PG8_SB(1, 0), cB + kstep, voffB); PG8_STAGE(PG8_SA(1, 0), cA + kstep, vA[0]); PG8_STAGE(PG8_SB(1, 1), cB + hB + kstep, voffB);
    PG8_WAIT_V(6); PG8_BAR;
    for (;;) {
        const bool has_next = S.next(ui + 1, nxt);
        if constexpr (GATHER) { if (has_next) { PG8_MKOFF(nxt, vN); } else { vN[0][0] = vA[0][0]; vN[0][1] = vA[0][1]; vN[1][0] = vA[1][0]; vN[1][1] = vA[1][1]; } }
        const char* nA = has_next ? nxt.a : cA; const char* nB = has_next ? nxt.b : cB;
#pragma unroll 1
        for (int t = 0; t < nt; t += 2) {
            const bool last = (t == nt - 2);
            const char* a1 = cA + (size_t)(t + 1) * kstep;
            const char* a2 = last ? nA : cA + (size_t)(t + 2) * kstep; const char* b2 = last ? nB : cB + (size_t)(t + 2) * kstep;
            const char* a3 = a2 + kstep; const char* b3 = b2 + kstep;
            unsigned s0[2], s1[2];
            if constexpr (GATHER) { s0[0] = last ? vN[0][0] : vA[0][0]; s0[1] = last ? vN[0][1] : vA[0][1]; s1[0] = last ? vN[1][0] : vA[1][0]; s1[1] = last ? vN[1][1] : vA[1][1]; }
            else { s0[0] = vA[0][0]; s0[1] = vA[0][1]; s1[0] = vA[1][0]; s1[1] = vA[1][1]; }
            PG8_LDB(B0, 0, 0); PG8_LDB(B1, 0, 1); PG8_SCHED; PG8_LDA(At, 0, 0); PG8_STAGE(PG8_SA(1, 1), a1, vA[1]);
            PG8_WAIT_V(8); PG8_WAIT_L(0); PG8_BAR; PG8_MMA(0, 0, At, B0); PG8_MMA(0, 1, At, B1); PG8_BAR; PG8_SCHED;
            PG8_LDA(At, 0, 1); PG8_STAGE(PG8_SB(0, 0), b2, voffB); PG8_STAGE(PG8_SB(0, 1), b2 + hB, voffB); PG8_STAGE(PG8_SA(0, 0), a2, s0);
            PG8_WAIT_V(8); PG8_WAIT_L(0); PG8_BAR; PG8_MMA(1, 0, At, B0); PG8_MMA(1, 1, At, B1); PG8_BAR; PG8_SCHED;
            PG8_LDB(B0, 1, 0); PG8_LDB(B1, 1, 1); PG8_SCHED; PG8_LDA(At, 1, 0); PG8_STAGE(PG8_SA(0, 1), a2, s1);
            PG8_WAIT_V(8); PG8_WAIT_L(0); PG8_BAR; PG8_MMA(0, 0, At, B0); PG8_MMA(0, 1, At, B1); PG8_BAR; PG8_SCHED;
            PG8_LDA(At, 1, 1); PG8_STAGE(PG8_SB(1, 0), b3, voffB); PG8_STAGE(PG8_SB(1, 1), b3 + hB, voffB); PG8_STAGE(PG8_SA(1, 0), a3, s0);
            PG8_WAIT_V(8); PG8_WAIT_L(0); PG8_BAR; PG8_MMA(1, 0, At, B0); PG8_MMA(1, 1, At, B1); PG8_BAR; PG8_SCHED;
        }
        if (wr == 0) PG8_BAR;
        E(acc, cur, wr, wc, fr, fq);
        if (!has_next) break;
#pragma unroll
        for (int a = 0; a < 2; ++a)
#pragma unroll
            for (int b = 0; b < 2; ++b)
#pragma unroll
                for (int m = 0; m < 4; ++m)
#pragma unroll
                    for (int n = 0; n < 2; ++n) acc[a][b][m][n] = (f32x4){0.f, 0.f, 0.f, 0.f};
        cur = nxt; cA = nA; cB = nB; ++ui;
        if constexpr (GATHER) { vA[0][0] = vN[0][0]; vA[0][1] = vN[0][1]; vA[1][0] = vN[1][0]; vA[1][1] = vN[1][1]; }
        if (wr == 1) PG8_BAR;
    }
    PG8_WAIT_V(0);
    PG8_BAR;
#undef PG8_SA
#undef PG8_SB
#undef PG8_STAGE
#undef PG8_LDA
#undef PG8_LDB
#undef PG8_MMA
#undef PG8_WAIT_V
#undef PG8_WAIT_L
#undef PG8_BAR
#undef PG8_SCHED
#undef PG8_MKOFF
}
}

constexpr int DM = 1024, NB = 2, SEQ = 8192, CTX = 256, TPB = SEQ + CTX, MROWS = NB * TPB, DEPTH = 2;
constexpr int INW = 9216, COL_K = 0, COL_V = 1024, COL_LX = 2048, COL_Q = 3072, COL_LG = 4096, COL_F = 5120, COL_G = 6144;
constexpr int NE = 256, TOPK = 8, EFF = 256, NPAIR = MROWS * TOPK, LCAP = MROWS;
constexpr float EPS = 1e-6f;
constexpr float QSCALE = 0.125f * 1.4426950408889634f;
constexpr int NCHUNK = TPB / 64;
static_assert(MROWS % 256 == 0, "rows");

constexpr size_t MiB = 1u << 20;
constexpr size_t WS_CTL = 0, CTL_ZERO_BYTES = 1 * MiB;
constexpr size_t WS_W = 1 * MiB, WL_STRIDE = 32 * MiB;
constexpr size_t WO_TAB = 31 * MiB;
constexpr size_t WO_WIN = 0, WO_D1 = 18 * MiB, WO_OUT = 24 * MiB, WO_R = 26 * MiB, WO_SGU = 27 * MiB, WO_SD = 28 * MiB, WO_LRU = 29 * MiB;
constexpr size_t WS_XALL = 65 * MiB;
constexpr size_t WS_H = WS_XALL + 66 * MiB;
constexpr size_t WS_U = WS_H + 33 * MiB;
constexpr size_t WS_KB = WS_U + 594 * MiB, WS_VB = WS_KB + 33 * MiB, WS_QB = WS_VB + 33 * MiB, WS_LXB = WS_QB + 33 * MiB, WS_GLG = WS_LXB + 33 * MiB, WS_ZP = WS_GLG + 33 * MiB;
constexpr size_t WS_GATES = WS_ZP + 33 * MiB;
constexpr size_t WS_MIXIN = WS_GATES + 99 * MiB;
constexpr size_t WS_S = WS_MIXIN + 99 * MiB;
constexpr size_t WS_UC = WS_S, WS_AB = WS_UC + 33 * MiB, WS_SUMM = WS_AB + 132 * MiB, WS_CARRY = WS_SUMM + 5 * MiB, WS_XA = WS_CARRY + 3 * MiB, WS_XB = WS_XA + 32 * MiB, WS_GB = WS_XB + 32 * MiB, WS_GC = WS_GB + 32 * MiB;
constexpr size_t WS_PA = WS_S, WS_PR = WS_PA + 66 * MiB, WS_PF = WS_PR + 66 * MiB, WS_Y1 = WS_PF + 66 * MiB;
static_assert(WS_GC + 3 * MiB <= WS_S + 280 * MiB && WS_Y1 + 66 * MiB <= WS_S + 280 * MiB, "scratch S");
constexpr size_t WS_MIXED = WS_S + 280 * MiB, WS_TOK = WS_MIXED + 33 * MiB;
constexpr size_t WS_LOG = WS_TOK + 33 * MiB, WS_SGU = WS_LOG + 17 * MiB, WS_SH = WS_SGU + 33 * MiB, WS_LIST = WS_SH + 9 * MiB, WS_TOPW = WS_LIST + 17 * MiB, WS_SD = WS_TOPW + 1 * MiB;
constexpr size_t WS_YB = WS_U;
constexpr size_t WS_Y16 = WS_KB, WS_HB = WS_S;
constexpr size_t WS_EP = WS_SUMM;
constexpr size_t WS_Y16_OLD = WS_U;
constexpr size_t WS_EW = WS_SD + 66 * MiB, WS_EW1 = WS_U, EW_STRIDE = 3 * MiB / 2;
#define EWL(l) (((l) & 1) ? WS_EW1 : WS_EW)
static_assert(WS_KB + 396 * MiB == WS_S && 392 * MiB <= 396 * MiB && WS_U + 384 * MiB <= WS_KB, "overlays");
constexpr size_t WS_END = WS_EW + 384 * MiB;
static_assert(WS_END <= 2048 * MiB, "d_ws budget");
constexpr int CW_BAR = 4096;
constexpr int CW_CNT = 16384, CNT_STRIDE = 32;
constexpr int CW_MOD = 65536;
static_assert((CW_MOD + 2 * 3 * 6144) * 4 <= (int)CTL_ZERO_BYTES, "ctl");

constexpr int LDS_BYTES = 147456, RING_BYTES = 131072, MISC_OFF = RING_BYTES + 320;
constexpr int NWAVES = 8;

#define GAS __attribute__((address_space(1)))
#define LAS __attribute__((address_space(3)))
typedef unsigned short bf16;
typedef unsigned v4u __attribute__((ext_vector_type(4)));
typedef float f32x4 __attribute__((ext_vector_type(4)));
typedef GAS unsigned gu32;
#define RLX_AGENT __ATOMIC_RELAXED, __HIP_MEMORY_SCOPE_AGENT
#define LDS_WAIT() asm volatile("s_waitcnt lgkmcnt(0)" ::: "memory")
typedef float f32x2_t __attribute__((ext_vector_type(2))); typedef __bf16 bf16x2_t __attribute__((ext_vector_type(2)));
__device__ __forceinline__ unsigned pk2(float lo, float hi) { const f32x2_t v = {lo, hi}; const bf16x2_t b = __builtin_convertvector(v, bf16x2_t); return __builtin_bit_cast(unsigned, b); }
__device__ __forceinline__ unsigned f2bf(float f) { return pk2(f, f) & 0xffffu; }
__device__ __forceinline__ float bf2f(unsigned h) { return __uint_as_float(h << 16); }
__device__ __forceinline__ float sigmoidf_(float x) { return __builtin_amdgcn_rcpf(1.f + __expf(-x)); }
__device__ __forceinline__ float siluf_(float x) { return x * __builtin_amdgcn_rcpf(1.f + __expf(-x)); }
__device__ __forceinline__ float gelu_tanh(float x) { const float u = 0.7978845608028654f * (x + 0.044715f * x * x * x); return x * __builtin_amdgcn_rcpf(1.f + __expf(-2.f * u)); }

#define XB_TMO      128
#define XB_XCNT(j)  (256  + 64 * (j))
#define XB_XSUB(j)  (1280 + 64 * (j))
#define XB_XGEN(j)  (2304 + 64 * (j))
#define XB_TOP      3328
#define XB_TOPGEN   3392
#define XCD_BAR_WORDS 3456
#define XB_SPIN_CAP (1u << 18)
__device__ __forceinline__ unsigned xb_ld(unsigned* p)              { return __hip_atomic_load(p, __ATOMIC_RELAXED, __HIP_MEMORY_SCOPE_AGENT); }
__device__ __forceinline__ unsigned xb_add(unsigned* p, unsigned v) { return __hip_atomic_fetch_add(p, v, __ATOMIC_RELAXED, __HIP_MEMORY_SCOPE_AGENT); }
__device__ __forceinline__ unsigned xb_xcc_id() { return (unsigned)__builtin_amdgcn_s_getreg((3 << 11) | 20) & 0xFu; }
#define XB_SPIN(cond, bar) do { unsigned _sp = 0; while (cond) { __builtin_amdgcn_s_sleep(1); \
    if ((++_sp & 255u) == 0u) { if (xb_ld(&(bar)[XB_TMO])) break; if (_sp > XB_SPIN_CAP) { atomicAdd(&(bar)[XB_TMO], 1u); break; } } } } while (0)
struct XcdBarrier { unsigned* bar; unsigned x; volatile LAS unsigned* st; };
__device__ __forceinline__ XcdBarrier xcd_barrier_post(unsigned* bar, volatile LAS unsigned* st) {
    XcdBarrier b; b.bar = bar; b.x = xb_xcc_id(); b.st = st;
    if (threadIdx.x == 0) (void)xb_add(&bar[XB_XCNT(b.x)], 1u);
    return b;
}
__device__ __forceinline__ void xcd_barrier_complete(unsigned* bar, unsigned x, unsigned& nloc, unsigned& nx) {
    const unsigned G = gridDim.x * gridDim.y * gridDim.z;
    unsigned sum, cnt, mine, sp = 0u;
    for (;;) {
        sum = 0u; cnt = 0u; mine = 0u;
#pragma unroll
        for (unsigned j = 0; j < 16; ++j) { const unsigned c = xb_ld(&bar[XB_XCNT(j)]); sum += c; cnt += (c > 0u) ? 1u : 0u; mine = (j == x) ? c : mine; }
        if (sum == G) break;
        __builtin_amdgcn_s_sleep(1);
        if ((++sp & 255u) == 0u) { if (xb_ld(&bar[XB_TMO])) break; if (sp > XB_SPIN_CAP) { atomicAdd(&bar[XB_TMO], 1u); break; } }
    }
    nloc = mine > 0u ? mine : 1u; nx = cnt > 0u ? cnt : 1u;
}
__device__ __forceinline__ void xcd_barrier(const XcdBarrier& b) {
    asm volatile("s_waitcnt vmcnt(0)" ::: "memory");
    __syncthreads();
    if (threadIdx.x == 0) {
        unsigned* bar = b.bar; asm volatile("" : "+s"(bar));
        __builtin_amdgcn_s_waitcnt(0);
        unsigned nloc = b.st[0], nx = b.st[1];
        unsigned bx = b.x; asm volatile("" : "+s"(bx));
        if (nloc == 0u) { xcd_barrier_complete(bar, bx, nloc, nx); b.st[0] = nloc; b.st[1] = nx; }
        const unsigned old = xb_add(&bar[XB_XSUB(bx)], 1u);
        const unsigned gen = old / nloc;
        if (old + 1u == (gen + 1u) * nloc) {
            __builtin_amdgcn_fence(__ATOMIC_RELEASE, "agent");
            asm volatile("s_waitcnt vmcnt(0)" ::: "memory");
            const unsigned og = xb_add(&bar[XB_TOP], 1u);
            const unsigned tg = og / nx;
            if (og + 1u == (tg + 1u) * nx) xb_add(&bar[XB_TOPGEN], 1u);
            else XB_SPIN(xb_ld(&bar[XB_TOPGEN]) == tg, bar);
            __builtin_amdgcn_fence(__ATOMIC_ACQUIRE, "agent");
            xb_add(&bar[XB_XGEN(bx)], 1u);
            asm volatile("s_waitcnt vmcnt(0)" ::: "memory");
        } else {
            XB_SPIN(xb_ld(&bar[XB_XGEN(bx)]) == gen, bar);
            __builtin_amdgcn_fence(__ATOMIC_ACQUIRE, "agent");
            asm volatile("s_waitcnt vmcnt(0)" ::: "memory");
        }
    }
    __syncthreads();
}

struct Args { const float* in[32]; float* out; unsigned char* ws; int ph_lo, ph_hi; };
struct Frame { LAS unsigned char* lds; int tid, lane, wave, bid, G, gw, NGW; long gtid, NT; };
#define WSP(T, off) ((T*)(A.ws + (off)))
#define WLP(l, off) ((bf16*)(A.ws + WS_W + (size_t)(l) * WL_STRIDE + (off)))
#define MODP(l, s, j) ((const float*)(A.ws + WS_CTL) + CW_MOD + ((l) * 3 + (s)) * 6144 + (j) * 1024)

__device__ __forceinline__ float wave_sum(float v) {
    v += sx<1>(v); v += sx<2>(v); v += sx<4>(v); v += sx<8>(v); v += sx<16>(v); v += sx<32>(v);
    return v;
}
__device__ __forceinline__ int win_row(int c) {
    const int sec = c >> 10; if (sec != 0 && sec != 3) return c;
    const int L = c & 255, g = L >> 6, a = (L >> 5) & 1, x = (L >> 4) & 1, q = (L >> 2) & 3, e = L & 3;
    return (c & ~255) | (128 * a + 32 * g + 8 * q + 4 * x + e);
}
template <bool WINMAP = false>
__device__ __forceinline__ void p0_transpose_item(const float* W, int K, int N, bf16* WT, int ldwt, int row_off, int col_off, LAS float* scr, int item, int lane) {
    const int nblk = N / 32, kb = item / nblk, nb = item % nblk, k0 = 64 * kb, n0 = 32 * nb;
    { f32x4 v[8]; const int rr = lane >> 3, c4 = (lane & 7) * 4;
#pragma unroll
      for (int i = 0; i < 8; ++i) v[i] = *(const f32x4*)(W + (size_t)(k0 + 8 * i + rr) * N + n0 + c4);
#pragma unroll
      for (int i = 0; i < 8; ++i) { LAS float* d = scr + (8 * i + rr) * 33 + c4; d[0] = v[i].x; d[1] = v[i].y; d[2] = v[i].z; d[3] = v[i].w; } }
    LDS_WAIT(); asm volatile("" ::: "memory");
    const int c = lane & 7;
#pragma unroll
    for (int j = 0; j < 4; ++j) { const int n = (lane >> 3) + 8 * j; const LAS float* s = scr + (8 * c) * 33 + n;
        v4u o; o.x = pk2(s[0 * 33], s[1 * 33]); o.y = pk2(s[2 * 33], s[3 * 33]); o.z = pk2(s[4 * 33], s[5 * 33]); o.w = pk2(s[6 * 33], s[7 * 33]);
        const int rr = WINMAP ? win_row(n0 + n) : n0 + n;
        *(v4u*)(WT + (size_t)(row_off + rr) * ldwt + col_off + k0 + 8 * c) = o; }
    LDS_WAIT(); asm volatile("" ::: "memory");
}

struct PItem { const float* W; bf16* WT; int N, ldwt, k0, n0, rowbase; bool winmap, skip; };
constexpr int PRO_I_WIN = 16 * 288, PRO_I_SQ = 16 * 32, PRO_I_R = 16 * 8, PRO_I_SD = 4 * 32, PRO_PER_L = PRO_I_WIN + 4 * PRO_I_SQ + 3 * PRO_I_R + PRO_I_SD;
__device__ __forceinline__ void pi_set(PItem& t, const float* W, int N, bf16* WT, int ldwt, int row_off, int col_off, int item) {
    const int nblk = N / 32, kb = item / nblk, nb = item % nblk; t.W = W; t.N = N; t.WT = WT + col_off; t.ldwt = ldwt; t.k0 = 64 * kb; t.n0 = 32 * nb; t.rowbase = row_off; }
__device__ __forceinline__ PItem pro_item(const Args& A, int it) {
    const int l = it / PRO_PER_L; int r = it % PRO_PER_L; PItem t; t.winmap = false; t.skip = false;
    if (r < PRO_I_WIN) { const int nb = r % 288; t.skip = nb >= 160 && nb < 192; t.winmap = true;
        pi_set(t, A.in[7] + (size_t)l * 1024 * 9216, 9216, WLP(l, WO_WIN), 1024, 0, 0, r); return t; } r -= PRO_I_WIN;
    if (r < PRO_I_SQ) { pi_set(t, A.in[12] + (size_t)l * 1048576, 1024, WLP(l, WO_D1), 3072, 0, 0, r); return t; } r -= PRO_I_SQ;
    if (r < PRO_I_SQ) { pi_set(t, A.in[20] + (size_t)l * 1048576, 1024, WLP(l, WO_D1), 3072, 0, 1024, r); return t; } r -= PRO_I_SQ;
    if (r < PRO_I_SQ) { pi_set(t, A.in[21] + (size_t)l * 1048576, 1024, WLP(l, WO_D1), 3072, 0, 2048, r); return t; } r -= PRO_I_SQ;
    if (r < PRO_I_SQ) { pi_set(t, A.in[22] + (size_t)l * 1048576, 1024, WLP(l, WO_OUT), 1024, 0, 0, r); return t; } r -= PRO_I_SQ;
    if (r < PRO_I_R) { pi_set(t, A.in[24] + (size_t)l * 262144, 256, WLP(l, WO_R), 1024, 0, 0, r); return t; } r -= PRO_I_R;
    if (r < PRO_I_R) { pi_set(t, A.in[29] + (size_t)l * 262144, 256, WLP(l, WO_R), 1024, 256 + ((r % 8) >> 2) * 128, 0, r); return t; } r -= PRO_I_R;
    if (r < PRO_I_R) { pi_set(t, A.in[30] + (size_t)l * 262144, 256, WLP(l, WO_R), 1024, 384 + ((r % 8) >> 2) * 128, 0, r); return t; } r -= PRO_I_R;
    pi_set(t, A.in[31] + (size_t)l * 262144, 1024, WLP(l, WO_SD), 256, 0, 0, r); return t;
}
__device__ __forceinline__ void pi_load(const PItem& t, f32x4 (&v)[8], int lane) {
    const int rr = lane >> 3, c4 = (lane & 7) * 4;
#pragma unroll
    for (int i = 0; i < 8; ++i) v[i] = *(const f32x4*)(t.W + (size_t)(t.k0 + 8 * i + rr) * t.N + t.n0 + c4);
}
__device__ __forceinline__ void pi_store(const PItem& t, const f32x4 (&v)[8], LAS float* scr, int lane) {
    const int rr = lane >> 3, c4 = (lane & 7) * 4;
#pragma unroll
    for (int i = 0; i < 8; ++i) { LAS float* d = scr + (8 * i + rr) * 33 + c4; d[0] = v[i].x; d[1] = v[i].y; d[2] = v[i].z; d[3] = v[i].w; }
    LDS_WAIT(); asm volatile("" ::: "memory");
    const int c = lane & 7;
#pragma unroll
    for (int j = 0; j < 4; ++j) { const int n = (lane >> 3) + 8 * j; const LAS float* sp = scr + (8 * c) * 33 + n;
        v4u o; o.x = pk2(sp[0 * 33], sp[1 * 33]); o.y = pk2(sp[2 * 33], sp[3 * 33]); o.z = pk2(sp[4 * 33], sp[5 * 33]); o.w = pk2(sp[6 * 33], sp[7 * 33]);
        const int row = t.winmap ? win_row(t.n0 + n) : t.n0 + n;
        *(v4u*)(t.WT + (size_t)(t.rowbase + row) * t.ldwt + t.k0 + 8 * c) = o; }
    LDS_WAIT(); asm volatile("" ::: "memory");
}

__device__ __forceinline__ void ph_prologue(const Frame& F, const Args& A) {
    LAS float* scr = (LAS float*)(F.lds + F.wave * 16384);
    { const int stride = F.NGW, hi = 2 * PRO_PER_L; int it = F.gw;
      if (it < hi) { PItem t0 = pro_item(A, it), t1 = t0; f32x4 v0[8], v1[8]; bool h1 = it + stride < hi;
        if (!t0.skip) pi_load(t0, v0, F.lane);
        for (;;) {
            if (h1) { t1 = pro_item(A, it + stride); if (!t1.skip) pi_load(t1, v1, F.lane); }
            if (!t0.skip) pi_store(t0, v0, scr, F.lane);
            if (!h1) break;
#pragma unroll
            for (int i = 0; i < 8; ++i) v0[i] = v1[i];
            t0 = t1; it += stride; h1 = it + stride < hi; } } }
#if FAST_WIN
    {
        LAS float* sW = (LAS float*)F.lds; LAS float* sT = sW + 32 * 256;
        __syncthreads();
        if (F.tid < 256) sT[F.tid] = cospif((float)F.tid / 128.0f);
        for (int it = F.bid; it < 2 * 4 * 32; it += F.G) {
            const int l = it >> 7, g = (it >> 5) & 3, k0 = (it & 31) * 32;
            __syncthreads();
            for (int e = F.tid; e < 32 * 256; e += 512) sW[e] = A.in[7][((size_t)l * 1024 + k0 + (e >> 8)) * 9216 + COL_F + g * 256 + (e & 255)];
            __syncthreads();
            const int o = F.tid & 255, kh = F.tid >> 8; int j = o >> 1, odd = o & 1; if (o == 1) { j = 128; odd = 0; }
            const int m0 = odd ? 192 : 0; float acc[16];
#pragma unroll
            for (int q = 0; q < 16; ++q) acc[q] = 0.f;
            for (int c = 0; c < 256; c += 4) { const float r0 = sT[(j * c + m0) & 255], r1 = sT[(j * (c + 1) + m0) & 255], r2 = sT[(j * (c + 2) + m0) & 255], r3 = sT[(j * (c + 3) + m0) & 255];
#pragma unroll
                for (int q = 0; q < 16; ++q) { const f32x4 w = *(const LAS f32x4*)(sW + (kh * 16 + q) * 256 + c); acc[q] += w.x * r0; acc[q] += w.y * r1; acc[q] += w.z * r2; acc[q] += w.w * r3; } }
            bf16* dst = WLP(l, WO_WIN) + (size_t)(COL_F + g * 256 + o) * 1024 + k0 + kh * 16;
            v4u w0, w1; w0.x = pk2(acc[0], acc[1]); w0.y = pk2(acc[2], acc[3]); w0.z = pk2(acc[4], acc[5]); w0.w = pk2(acc[6], acc[7]);
            w1.x = pk2(acc[8], acc[9]); w1.y = pk2(acc[10], acc[11]); w1.z = pk2(acc[12], acc[13]); w1.w = pk2(acc[14], acc[15]);
            *(v4u*)dst = w0; *(v4u*)(dst + 8) = w1;
        }
        __syncthreads();
    }
#endif
    float* MOD = (float*)(A.ws + WS_CTL) + CW_MOD;
    LAS float* part = (LAS float*)(F.lds + 8 * 16384 - 8192);
    LAS float* ssil = (LAS float*)(F.lds + 8 * 16384 - 8192 - 12288);
    if (F.bid < 2 * 96) { for (int e = F.tid; e < 3072; e += NWAVES * 64) { const int k = e & 1023; ssil[e] = siluf_(e < 1024 ? A.in[1][k] : e < 2048 ? A.in[1][1024 + k] : A.in[3][k]); } }
    __syncthreads();
    for (int it = F.bid; it < 2 * 96; it += F.G) {
        const int l = it / 96, nb = it % 96, n = nb * 64 + F.lane;
        const float* wm = A.in[4] + (size_t)l * 1024 * 6144 + n;
        float a0 = 0.f, a1 = 0.f, a2 = 0.f;
#pragma unroll 32
        for (int k = F.wave * 128; k < F.wave * 128 + 128; ++k) {
            const float w = wm[(size_t)k * 6144];
            a0 += ssil[k] * w; a1 += ssil[1024 + k] * w; a2 += ssil[2048 + k] * w;
        }
        __syncthreads();
        part[(F.wave * 3 + 0) * 64 + F.lane] = a0; part[(F.wave * 3 + 1) * 64 + F.lane] = a1; part[(F.wave * 3 + 2) * 64 + F.lane] = a2;
        __syncthreads();
        if (F.wave < 3) { float s = A.in[5][l * 6144 + n];
#pragma unroll
            for (int w = 0; w < 8; ++w) s += part[(w * 3 + F.wave) * 64 + F.lane];
            MOD[(l * 3 + F.wave) * 6144 + n] = s; }
    }
    for (long i = F.gtid; i < 2L * 4096 * 256; i += F.NT) {
        const int l = (int)(i >> 20), n = (int)((i >> 8) & 4095), kk = (int)(i & 255), pn = n >> 8, rr = n & 255, gate = rr >> 7, rho = rr & 127, d = pn >> 3, cb = pn & 7;
        const int cho = 128 * cb + rho, blk = cho >> 6, e = cho & 63, chi = 256 * (cb >> 1) + kk; float v = 0.f;
        if ((chi >> 6) == blk) v = (gate ? A.in[17] : A.in[15])[((size_t)(l * 2 + d) * 16 + blk) * 4096 + (chi & 63) * 64 + e];
        WLP(l, WO_LRU)[i & 0xFFFFF] = (bf16)f2bf(v);
    }
    for (long i = F.gtid; i < 2L * 65536; i += F.NT) {
        const int which = (int)(i >> 16), n = (int)((i >> 8) & 255), k = (int)(i & 255); float v;
        if (which == 0) { const int k1 = n >> 1, cp = n & 1, t1 = k >> 1, c = k & 1; const float rev = (float)((k1 * t1) & 127) * (1.f / 128.f);
            const float cs = __builtin_amdgcn_cosf(rev), sn = __builtin_amdgcn_sinf(rev); v = cp == 0 ? (c == 0 ? cs : sn) : (c == 0 ? -sn : cs); }
        else { const int h = n >> 7, k2 = (n >> 1) & 63, cp = n & 1, hp = k >> 7, t2 = (k >> 1) & 63, c = k & 1; const float rev = (float)((k2 * t2) & 63) * (1.f / 64.f);
            const float cs = __builtin_amdgcn_cosf(rev), sn = __builtin_amdgcn_sinf(rev); v = (h != hp) ? 0.f : (cp == 0 ? (c == 0 ? cs : sn) : (c == 0 ? -sn : cs)); }
        WLP(0, WO_TAB)[i] = (bf16)f2bf(v);
    }
    for (long i = F.gtid; i < 4096; i += F.NT) ((float*)(A.ws + WS_W + WO_TAB + 262144))[i] = log1pf(expf(-A.in[19][i]));
}

__device__ __forceinline__ void norm_mod_row(const f32x4 (&v)[4], const float* g, const float* sc, const float* sh, bf16* orow, int lane) {
    float s = 0.f;
#pragma unroll
    for (int j = 0; j < 4; ++j) s += (v[j].x * v[j].x + v[j].y * v[j].y) + (v[j].z * v[j].z + v[j].w * v[j].w);
    const float rs = rsqrtf(wave_sum(s) * (1.f / 1024.f) + EPS);
#pragma unroll
    for (int j = 0; j < 4; ++j) { const int c = 4 * lane + 256 * j;
        const f32x4 gg = *(const f32x4*)(g + c), s1 = *(const f32x4*)(sc + c), s0 = *(const f32x4*)(sh + c);
        const float y0 = v[j].x * rs * gg.x * (1.f + s1.x) + s0.x, y1 = v[j].y * rs * gg.y * (1.f + s1.y) + s0.y, y2 = v[j].z * rs * gg.z * (1.f + s1.z) + s0.z, y3 = v[j].w * rs * gg.w * (1.f + s1.w) + s0.w;
        *(unsigned long long*)(orow + c) = (unsigned long long)pk2(y0, y1) | ((unsigned long long)pk2(y2, y3) << 32); }
}
__device__ __forceinline__ void ph_norm1(const Frame& F, const Args& A, int l) {
    bf16* H = WSP(bf16, WS_H);
    for (int R = F.gw; R < MROWS; R += F.NGW) {
        const int b = R / TPB, p = R % TPB, s = (p < CTX) ? 2 : b;
        const float* X = (p < CTX) ? A.in[2] + ((size_t)b * CTX + p) * 1024 : A.in[0] + ((size_t)b * SEQ + (p - CTX)) * 1024;
        f32x4 v[4];
#pragma unroll
        for (int j = 0; j < 4; ++j) v[j] = *(const f32x4*)(X + 4 * F.lane + 256 * j);
        norm_mod_row(v, A.in[6] + l * 1024, MODP(l, s, 1), MODP(l, s, 0), H + (size_t)R * 1024, F.lane);
    }
}

__device__ __forceinline__ void ph_uelem(const Frame& F, const Args& A, int l) {
    const float* U = WSP(float, WS_U);
    bf16 *Kb = WSP(bf16, WS_KB), *Vb = WSP(bf16, WS_VB), *Qb = WSP(bf16, WS_QB), *LXb = WSP(bf16, WS_LXB), *GLG = WSP(bf16, WS_GLG), *ZP = WSP(bf16, WS_ZP), *GT = WSP(bf16, WS_GATES);
    LAS float* sF = (LAS float*)F.lds; LAS float* sT = sF + 1024;
    if (F.tid < 256) sT[F.tid] = cospif((float)F.tid / 128.0f);
    __syncthreads();
    for (int R = F.bid; R < MROWS; R += F.G) {
        const float* u = U + (size_t)R * INW; const int p = R % TPB; const bool lat = p >= CTX; const int t = p - CTX;
        for (int gi = F.wave; gi < 32; gi += 8) {
            const bool isq = gi >= 16; const int grp = gi & 15;
            const float v = u[(isq ? COL_Q : COL_K) + grp * 64 + F.lane];
            const float ss = wave_sum(v * v);
            float y = v * rsqrtf(ss * (1.f / 64.f) + EPS) * (isq ? A.in[8] : A.in[9])[l * 64 + F.lane];
            const float part = sx<16>(y);
            if (lat) { const int axis = F.lane >> 5, hf = (F.lane >> 4) & 1, f = F.lane & 15;
                const float pos = (float)(axis ? (t & 63) : (t >> 6)); const float inv = exp2f(-(float)f * (13.287712379549449f / 16.f));
                float sn, cs; sincosf(pos * inv, &sn, &cs);
                y = hf ? (part * sn + y * cs) : (y * cs - part * sn); }
            if (isq) y *= QSCALE;
            (isq ? Qb : Kb)[(size_t)R * 1024 + grp * 64 + F.lane] = (bf16)f2bf(y);
        }
        for (int c = F.tid; c < 1024; c += 512) { const size_t o = (size_t)R * 1024 + c;
            Vb[o] = (bf16)f2bf(u[COL_V + c]); LXb[o] = (bf16)f2bf(u[COL_LX + c]); GLG[o] = (bf16)f2bf(gelu_tanh(u[COL_LG + c])); sF[c] = u[COL_F + c]; }
        for (int c = F.tid; c < 3072; c += 512) GT[(size_t)R * 3072 + c] = (bf16)f2bf(sigmoidf_(u[COL_G + c]));
        __syncthreads();
        for (int o = F.tid; o < 1024; o += 512) { const int g = o >> 8, oo = o & 255; int j = oo >> 1, odd = oo & 1; if (oo == 1) { j = 128; odd = 0; }
            const int m0 = odd ? 192 : 0; float acc = 0.f;
            for (int c = 0; c < 256; ++c) acc += sF[g * 256 + c] * sT[(j * c + m0) & 255];
            ZP[(size_t)R * 1024 + o] = (bf16)f2bf(acc); }
        __syncthreads();
    }
}

__device__ __forceinline__ void ph_conv(const Frame& F, const Args& A, int l) {
    const bf16* LXb = WSP(bf16, WS_LXB); bf16* UC = WSP(bf16, WS_UC);
    const int c8 = (int)(F.gtid & 127) * 8, r0 = (int)(F.gtid >> 7), rstep = (int)(F.NT >> 7);
    float w[4][8], bia[8];
#pragma unroll
    for (int j = 0; j < 4; ++j) { const f32x4 a = *(const f32x4*)(A.in[13] + l * 4096 + j * 1024 + c8), b = *(const f32x4*)(A.in[13] + l * 4096 + j * 1024 + c8 + 4);
        w[j][0] = a.x; w[j][1] = a.y; w[j][2] = a.z; w[j][3] = a.w; w[j][4] = b.x; w[j][5] = b.y; w[j][6] = b.z; w[j][7] = b.w; }
    { const f32x4 a = *(const f32x4*)(A.in[14] + l * 1024 + c8), b = *(const f32x4*)(A.in[14] + l * 1024 + c8 + 4);
      bia[0] = a.x; bia[1] = a.y; bia[2] = a.z; bia[3] = a.w; bia[4] = b.x; bia[5] = b.y; bia[6] = b.z; bia[7] = b.w; }
    for (int Rb = r0; Rb < MROWS; Rb += 4 * rstep) {
        v4u x[4][4];
#pragma unroll
        for (int u = 0; u < 4; ++u) { const int R = Rb + u * rstep; if (R < MROWS) { const int p = R % TPB, lo = p < CTX ? 0 : CTX, hi = p < CTX ? CTX : TPB;
#pragma unroll
            for (int j = 0; j < 4; ++j) { const int pp = p + j - 2; x[u][j] = (pp >= lo && pp < hi) ? *(const v4u*)(LXb + (size_t)(R + j - 2) * 1024 + c8) : (v4u){0u, 0u, 0u, 0u}; } } }
#pragma unroll
        for (int u = 0; u < 4; ++u) { const int R = Rb + u * rstep; if (R < MROWS) { float acc[8];
#pragma unroll
            for (int e = 0; e < 8; ++e) acc[e] = bia[e];
#pragma unroll
            for (int j = 0; j < 4; ++j) { const unsigned xs[4] = {x[u][j].x, x[u][j].y, x[u][j].z, x[u][j].w};
#pragma unroll
                for (int q = 0; q < 4; ++q) { acc[2 * q] += w[j][2 * q] * bf2f(xs[q] & 0xffffu); acc[2 * q + 1] += w[j][2 * q + 1] * bf2f(xs[q] >> 16); } }
            v4u o; o.x = pk2(acc[0], acc[1]); o.y = pk2(acc[2], acc[3]); o.z = pk2(acc[4], acc[5]); o.w = pk2(acc[6], acc[7]);
            *(v4u*)(UC + (size_t)R * 1024 + c8) = o; } }
    }
}
#if !FAST_LRU
__device__ __forceinline__ void ph_lrucoef(const Frame& F, const Args& A, int l) {
    const bf16* UC = WSP(bf16, WS_UC); unsigned* AB = WSP(unsigned, WS_AB);
    for (long i = F.gtid; i < 2L * MROWS * 1024; i += F.NT) {
        const int d = (int)(i / ((long)MROWS * 1024)); const long rem = i % ((long)MROWS * 1024); const int R = (int)(rem >> 10), ch = (int)(rem & 1023), blk = ch >> 6, e = ch & 63;
        const float* wa = A.in[15] + ((size_t)(l * 2 + d) * 16 + blk) * 4096 + e; const float* wi = A.in[17] + ((size_t)(l * 2 + d) * 16 + blk) * 4096 + e;
        float r = A.in[16][(l * 2 + d) * 1024 + ch], ig = A.in[18][(l * 2 + d) * 1024 + ch];
        const bf16* ur = UC + (size_t)R * 1024 + blk * 64;
        for (int dd = 0; dd < 64; ++dd) { const float x = bf2f(ur[dd]); r += x * wa[dd * 64]; ig += x * wi[dd * 64]; }
        const float lam = A.in[19][(l * 2 + d) * 1024 + ch]; const float sp = log1pf(expf(-lam));
        const float la = -8.f * sigmoidf_(r) * sp; const float mult = sqrtf(-expm1f(2.f * la));
        const float bc = mult * sigmoidf_(ig) * bf2f(ur[e]);
        AB[i] = pk2(la, bc);
    }
}
#endif
struct LruSched {
    const char* uc; const char* w; int G, c;
    __device__ __forceinline__ bool next(int i, pg8::UnitG& U) const {
        const long id = (long)i * G + c; if (id >= 66 * 16) return false;
        const int pm = (int)(id >> 4), pn = (int)(id & 15);
        U.a = uc + ((size_t)pm * 256 * 1024 + 256 * ((pn & 7) >> 1)) * 2; U.b = w + (size_t)pn * 256 * 256 * 2; U.row0 = pm * 256; U.pn = pn; U.e = 0; U.valid = 256; U.rows = nullptr; return true;
    }
};
struct EpiLru {
    static constexpr bool PERM = false;
    unsigned* AB; const bf16* UC; const float* ba; const float* bi; const float* sp;
    __device__ __forceinline__ void operator()(const f32x4 (&acc)[2][2][4][2], const pg8::UnitG& u, int wr, int wc, int fr, int fq) const {
        const int d = u.pn >> 3, cb = u.pn & 7, ch0 = 128 * cb + wc * 32 + 4 * fq;
        f32x4 vba[2], vbi[2], vsp[2];
#pragma unroll
        for (int n = 0; n < 2; ++n) { vba[n] = *(const f32x4*)(ba + d * 1024 + ch0 + 16 * n) * -1.4426950408889634f; vbi[n] = *(const f32x4*)(bi + d * 1024 + ch0 + 16 * n) * -1.4426950408889634f; vsp[n] = *(const f32x4*)(sp + d * 1024 + ch0 + 16 * n) * -8.f; }
#pragma unroll
        for (int ai = 0; ai < 2; ++ai) { unsigned long long uxs[4][2];
#pragma unroll
            for (int m = 0; m < 4; ++m)
#pragma unroll
                for (int n = 0; n < 2; ++n) uxs[m][n] = *(const unsigned long long*)(UC + ((size_t)u.row0 + ai * 128 + wr * 64 + m * 16 + fr) * 1024 + ch0 + 16 * n);
#pragma unroll
            for (int m = 0; m < 4; ++m) { const size_t R = (size_t)u.row0 + ai * 128 + wr * 64 + m * 16 + fr;
#pragma unroll
                for (int n = 0; n < 2; ++n) { const int ch = ch0 + 16 * n;
                    const unsigned long long ux = uxs[m][n];
                    const float x[4] = {bf2f((unsigned)ux & 0xffffu), bf2f(((unsigned)ux) >> 16), bf2f((unsigned)(ux >> 32) & 0xffffu), bf2f((unsigned)(ux >> 48))};
                    const f32x4 r = acc[ai][0][m][n], g = acc[ai][1][m][n]; v4u o;
#pragma unroll
                    for (int e = 0; e < 4; ++e) {
                        const float la = vsp[n][e] * __builtin_amdgcn_rcpf(1.f + __builtin_amdgcn_exp2f(__builtin_fmaf(r[e], -1.4426950408889634f, vba[n][e])));
                        const float mult = __builtin_amdgcn_sqrtf(1.f - __builtin_amdgcn_exp2f(la * 2.8853900817779268f));
                        o[e] = pk2(la, mult * __builtin_amdgcn_rcpf(1.f + __builtin_amdgcn_exp2f(__builtin_fmaf(g[e], -1.4426950408889634f, vbi[n][e]))) * x[e]); }
                    *(v4u*)(AB + ((size_t)d * MROWS + R) * 1024 + ch) = o; } }
            asm volatile("" ::: "memory"); }
    }
};
__device__ __forceinline__ void ph_lru_gemm(const Frame& F, const Args& A, int l, int Ge) {
    LruSched S{(const char*)WSP(bf16, WS_UC), (const char*)WLP(l, WO_LRU), Ge, F.bid};
    EpiLru E{WSP(unsigned, WS_AB), WSP(bf16, WS_UC), A.in[16] + l * 2048, A.in[18] + l * 2048, (const float*)(A.ws + WS_W + WO_TAB + 262144) + l * 2048};
    pg8::gemm_phase_g<EpiLru, LruSched, false>(F.lds, 256, 1024, 256, S, E);
}
struct FftSched {
    const char* x; const char* w; int nunits, G, c;
    __device__ __forceinline__ bool next(int i, pg8::UnitG& U) const {
        const long id = (long)i * G + c; if (id >= nunits) return false;
        U.a = x + (size_t)id * 256 * 256 * 2; U.b = w; U.row0 = (int)id * 256; U.pn = 0; U.e = 0; U.valid = 256; U.rows = nullptr; return true;
    }
};
struct EpiFftA {
    static constexpr bool PERM = false;
    unsigned* XB;
    __device__ __forceinline__ void operator()(const f32x4 (&acc)[2][2][4][2], const pg8::UnitG& u, int wr, int wc, int fr, int fq) const {
#pragma unroll
        for (int ai = 0; ai < 2; ++ai)
#pragma unroll
            for (int m = 0; m < 4; ++m) { int r0 = u.row0; asm volatile("" : "+s"(r0));
                const int row = r0 + ai * 128 + wr * 64 + m * 16 + fr, t2 = row & 63; const size_t bc = (size_t)(row >> 6);
#pragma unroll
                for (int bj = 0; bj < 2; ++bj)
#pragma unroll
                    for (int n = 0; n < 2; ++n) { const int k1 = 64 * bj + 16 * wc + 8 * n + 2 * fq; const f32x4 v = acc[ai][bj][m][n];
#pragma unroll
                        for (int q = 0; q < 2; ++q) { const int kk = k1 + q; const float rev = (float)(kk * t2) * (1.f / 8192.f);
                            const float cs = __builtin_amdgcn_cosf(rev), sn = __builtin_amdgcn_sinf(rev); const float yr = v[2 * q], yi = v[2 * q + 1];
                            XB[(bc * 64 + (kk >> 1)) * 128 + (kk & 1) * 64 + t2] = pk2(yr * cs + yi * sn, yi * cs - yr * sn); } }
                asm volatile("" ::: "memory"); }
    }
};
struct EpiBf16Plain {
    static constexpr bool PERM = true;
    bf16* C; int ldc;
    __device__ __forceinline__ void operator()(const f32x4 (&acc)[2][2][4][2], const pg8::UnitG& u, int wr, int wc, int fr, int fq) const {
#pragma unroll
        for (int ai = 0; ai < 2; ++ai)
#pragma unroll
            for (int m = 0; m < 4; ++m) { bf16* rowp = C + (size_t)(u.row0 + ai * 128 + wr * 64 + m * 16 + fr) * ldc + u.pn * 256 + wc * 32 + 8 * fq;
#pragma unroll
                for (int bj = 0; bj < 2; ++bj) { const f32x4 v0 = acc[ai][bj][m][0], v1 = acc[ai][bj][m][1];
                    v4u o; o.x = pk2(v0[0], v0[1]); o.y = pk2(v0[2], v0[3]); o.z = pk2(v1[0], v1[1]); o.w = pk2(v1[2], v1[3]);
                    *(v4u*)(rowp + bj * 128) = o; } }
    }
};
struct EpiBf16U {
    static constexpr bool PERM = true; static constexpr int MIDK = 0;
    bf16* C; int ldc;
    __device__ __forceinline__ void operator()(const f32x4 (&acc)[2][2][4][2], const pg8::Unit& u, int wr, int wc, int fr, int fq) const {
#pragma unroll
        for (int ai = 0; ai < 2; ++ai)
#pragma unroll
            for (int m = 0; m < 4; ++m) { bf16* rowp = C + (size_t)(u.pm * 256 + ai * 128 + wr * 64 + m * 16 + fr) * ldc + u.pn * 256 + wc * 32 + 8 * fq;
#pragma unroll
                for (int bj = 0; bj < 2; ++bj) { const f32x4 v0 = acc[ai][bj][m][0], v1 = acc[ai][bj][m][1];
                    v4u o; o.x = pk2(v0[0], v0[1]); o.y = pk2(v0[2], v0[3]); o.z = pk2(v1[0], v1[1]); o.w = pk2(v1[2], v1[3]);
                    *(v4u*)(rowp + bj * 128) = o; } }
    }
};
__device__ __forceinline__ void ph_fft_a_gemm(const Frame& F, const Args& A) {
    FftSched S{(const char*)WSP(bf16, WS_XA), (const char*)WLP(0, WO_TAB), 256, F.G, F.bid};
    EpiFftA E{WSP(unsigned, WS_XB)};
    pg8::gemm_phase_g<EpiFftA, FftSched, false>(F.lds, 256, 256, 256, S, E);
}
__device__ __forceinline__ void ph_fft_b_gemm(const Frame& F, const Args& A) {
    FftSched S{(const char*)WSP(bf16, WS_XB), (const char*)(WLP(0, WO_TAB) + 65536), 256, F.G, F.bid};
    EpiBf16Plain E{WSP(bf16, WS_GB), 256};
    pg8::gemm_phase_g<EpiBf16Plain, FftSched, false>(F.lds, 256, 256, 256, S, E);
}
__device__ __forceinline__ void ph_scan1(const Frame& F, const Args& A) {
    const unsigned* AB = WSP(unsigned, WS_AB); float2* SUMM = WSP(float2, WS_SUMM);
    for (int it = F.gw; it < NB * 2 * NCHUNK * 16; it += F.NGW) {
        const int cg = it & 15, ck = (it >> 4) % NCHUNK, bd = (it >> 4) / NCHUNK, b = bd >> 1, d = bd & 1, ch = cg * 64 + F.lane;
        const unsigned* ab = AB + ((size_t)d * MROWS + (size_t)b * TPB + ck * 64) * 1024 + ch;
        float ac = 1.f, h = 0.f;
#pragma unroll
        for (int q = 0; q < 4; ++q) { unsigned w[16];
#pragma unroll
            for (int k = 0; k < 16; ++k) { const int i = q * 16 + k, ii = d ? 63 - i : i; w[k] = ab[(size_t)ii * 1024]; }
#pragma unroll
            for (int k = 0; k < 16; ++k) { const float a = __expf(bf2f(w[k] & 0xffffu)); h = a * h + bf2f(w[k] >> 16); ac *= a; } }
        SUMM[((size_t)bd * NCHUNK + ck) * 1024 + ch] = make_float2(ac, h);
    }
}
__device__ __forceinline__ void ph_scan2(const Frame& F, const Args& A) {
    const float2* SUMM = WSP(float2, WS_SUMM); float* CARRY = WSP(float, WS_CARRY);
    if (F.gtid < 4096) {
        const int bd = (int)(F.gtid >> 10), ch = (int)(F.gtid & 1023), d = bd & 1; float h = 0.f;
        for (int s = 0; s < NCHUNK; ++s) { const int ck = d ? (s < 4 ? 3 - s : NCHUNK + 3 - s) : s;
            const size_t o = ((size_t)bd * NCHUNK + ck) * 1024 + ch; CARRY[o] = h; const float2 v = SUMM[o]; h = v.x * h + v.y; }
    }
}
__device__ __forceinline__ void ph_scan3(const Frame& F, const Args& A) {
    const unsigned* AB = WSP(unsigned, WS_AB); const float* CARRY = WSP(float, WS_CARRY); const bf16* GLG = WSP(bf16, WS_GLG); bf16* MX = WSP(bf16, WS_MIXIN);
    for (int it = F.gw; it < NB * NCHUNK * 16; it += F.NGW) {
        const int cg = it & 15, ck = (it >> 4) % NCHUNK, b = (it >> 4) / NCHUNK, ch = cg * 64 + F.lane; const size_t R0 = (size_t)b * TPB + ck * 64;
        const unsigned* ab0 = AB + R0 * 1024 + ch; const unsigned* ab1 = AB + ((size_t)MROWS + R0) * 1024 + ch;
        float hf[64]; float h = CARRY[((size_t)(b * 2 + 0) * NCHUNK + ck) * 1024 + ch];
#pragma unroll
        for (int q = 0; q < 4; ++q) { unsigned w[16];
#pragma unroll
            for (int k = 0; k < 16; ++k) w[k] = ab0[(size_t)(q * 16 + k) * 1024];
#pragma unroll
            for (int k = 0; k < 16; ++k) { h = __expf(bf2f(w[k] & 0xffffu)) * h + bf2f(w[k] >> 16); hf[q * 16 + k] = h; } }
        h = CARRY[((size_t)(b * 2 + 1) * NCHUNK + ck) * 1024 + ch];
#pragma unroll
        for (int q = 3; q >= 0; --q) { unsigned w[16]; bf16 g[16];
#pragma unroll
            for (int k = 0; k < 16; ++k) { const int i = q * 16 + 15 - k; w[k] = ab1[(size_t)i * 1024]; g[k] = GLG[(R0 + i) * 1024 + ch]; }
#pragma unroll
            for (int k = 0; k < 16; ++k) { const int i = q * 16 + 15 - k; h = __expf(bf2f(w[k] & 0xffffu)) * h + bf2f(w[k] >> 16);
                MX[(R0 + i) * 3072 + 1024 + ch] = (bf16)f2bf((hf[i] + h) * bf2f(g[k])); } }
    }
}

__device__ __forceinline__ void ph_fft_t1_fast(const Frame& F, const Args& A) {
    const unsigned* ZP = WSP(unsigned, WS_ZP); unsigned* XA = WSP(unsigned, WS_XA); LAS unsigned* T = (LAS unsigned*)F.lds;
    for (int item = F.bid; item < 512; item += F.G) {
        const int b = item >> 8, t2 = (item >> 2) & 63, cq = item & 3;
        __syncthreads();
#pragma unroll
        for (int i = 0; i < 8; ++i) { const int p = F.tid + 512 * i, t1 = p >> 5, w4 = (p & 31) * 4;
            const v4u v = *(const v4u*)(ZP + ((size_t)b * TPB + CTX + 64 * t1 + t2) * 512 + cq * 128 + w4);
            T[t1 * 129 + w4] = v.x; T[t1 * 129 + w4 + 1] = v.y; T[t1 * 129 + w4 + 2] = v.z; T[t1 * 129 + w4 + 3] = v.w; }
        __syncthreads();
#pragma unroll
        for (int i = 0; i < 16; ++i) { const int p = F.tid + 512 * i, cc = p >> 6, t1 = (p & 63) * 2;
            const unsigned long long v = (unsigned long long)T[t1 * 129 + cc] | ((unsigned long long)T[(t1 + 1) * 129 + cc] << 32);
            *(unsigned long long*)(XA + (((size_t)b * 512 + cq * 128 + cc) * 64 + t2) * 128 + t1) = v; }
    }
    __syncthreads();
}
__device__ __forceinline__ void ph_fft_t2_fast(const Frame& F, const Args& A) {
    const unsigned* GB = WSP(unsigned, WS_GB); bf16* MX = WSP(bf16, WS_MIXIN); LAS unsigned* T = (LAS unsigned*)F.lds;
    for (int item = F.bid; item < 2 * 65 * 4; item += F.G) {
        const int b = item / 260, rem = item % 260, kp = rem >> 2, g = rem & 3, k1a = kp, k1b = (128 - kp) & 127;
        __syncthreads();
#pragma unroll
        for (int i = 0; i < 8; ++i) { const int p = F.tid + 512 * i, blk = p >> 11, cc = (p >> 4) & 127, w4 = (p & 15) * 4, kk = blk ? k1b : k1a;
            const v4u v = *(const v4u*)(GB + (((size_t)b * 512 + g * 128 + cc) * 64 + (kk >> 1)) * 128 + (kk & 1) * 64 + w4);
            LAS unsigned* d = T + blk * (128 * 65) + cc * 65 + w4; d[0] = v.x; d[1] = v.y; d[2] = v.z; d[3] = v.w; }
        __syncthreads();
        const int jc = F.tid & 255, j = (jc == 0 || jc == 128) ? 0 : (jc < 128 ? jc : 256 - jc);
        const int nset = (k1a == k1b) ? 1 : 2;
        for (int r = (F.tid >> 8); r < nset * 64; r += 2) { const int set = r >> 6, k2 = r & 63, ka = set ? k1b : k1a;
            const int mk2 = (ka == 0) ? ((64 - k2) & 63) : 63 - k2;
            const unsigned own = T[set * (128 * 65) + j * 65 + k2], mir = T[(nset == 1 ? 0 : (1 - set)) * (128 * 65) + j * 65 + mk2];
            float o; if (jc == 0) o = 0.5f * (bf2f(own & 0xffffu) + bf2f(mir & 0xffffu)); else if (jc == 128) o = 0.5f * (bf2f(own >> 16) + bf2f(mir >> 16)); else if (jc < 128) o = bf2f(mir & 0xffffu); else o = bf2f(own & 0xffffu);
            MX[((size_t)b * TPB + CTX + ka + 128 * k2) * 3072 + 2048 + g * 256 + jc] = (bf16)f2bf(o * 6.9053396600248786e-4f); }
    }
    __syncthreads();
    const float2* GC = WSP(float2, WS_GC);
    for (long i = F.gtid; i < (long)NB * CTX * 1024; i += F.NT) {
        const int col = (int)(i & 1023), k = (int)((i >> 10) & 255), b = (int)(i >> 18), g = col >> 8, jc = col & 255, km = (256 - k) & 255;
        const int j = (jc == 0 || jc == 128) ? 0 : (jc < 128 ? jc : 256 - jc); const size_t base = ((size_t)b * 512 + g * 128 + j) * 256;
        const float2 w = GC[base + k], wm = GC[base + km];
        float o; if (jc == 0) o = 0.5f * (w.x + wm.x); else if (jc == 128) o = 0.5f * (w.y + wm.y); else if (jc < 128) o = wm.x; else o = w.x;
        MX[((size_t)b * TPB + k) * 3072 + 2048 + col] = (bf16)f2bf(o * 3.90625e-3f);
    }
}
__device__ __forceinline__ void ph_scan2_fast(const Frame& F, const Args& A) {
    const float2* SUMM = WSP(float2, WS_SUMM); float* CARRY = WSP(float, WS_CARRY);
    for (int it = F.gw; it < 256; it += F.NGW) {
        const int bd = it >> 6, d = bd & 1, ch = (it & 63) * 16 + (F.lane & 15), seg = F.lane >> 4;
        float2 v[33]; float as = 1.f, hs = 0.f;
#pragma unroll
        for (int q = 0; q < 33; ++q) { const int sidx = seg * 33 + q, ck = d ? (sidx < 4 ? 3 - sidx : NCHUNK + 3 - sidx) : sidx; v[q] = SUMM[((size_t)bd * NCHUNK + ck) * 1024 + ch]; }
#pragma unroll
        for (int q = 0; q < 33; ++q) { hs = v[q].x * hs + v[q].y; as *= v[q].x; }
        const float a16 = sx<16>(as), h16 = sx<16>(hs), a32 = sx<32>(as), h32 = sx<32>(hs), a48 = sx<32>(a16), h48 = sx<32>(h16);
        float h = 0.f;
#pragma unroll
        for (int jx = 0; jx < 3; ++jx) { const int x = jx ^ seg;
            const float aj = x == 0 ? as : (x == 1 ? a16 : (x == 2 ? a32 : a48)), hj = x == 0 ? hs : (x == 1 ? h16 : (x == 2 ? h32 : h48));
            if (jx < seg) h = aj * h + hj; }
#pragma unroll
        for (int q = 0; q < 33; ++q) { const int sidx = seg * 33 + q, ck = d ? (sidx < 4 ? 3 - sidx : NCHUNK + 3 - sidx) : sidx; CARRY[((size_t)bd * NCHUNK + ck) * 1024 + ch] = h; h = v[q].x * h + v[q].y; }
    }
}

__device__ __forceinline__ void ph_fft_t1(const Frame& F, const Args& A) {
    const unsigned* ZP = WSP(unsigned, WS_ZP); unsigned* XA = WSP(unsigned, WS_XA);
    for (long i = F.gtid; i < (long)NB * 512 * 8192; i += F.NT) {
        const int t1 = (int)(i & 127), t2 = (int)((i >> 7) & 63), cc = (int)((i >> 13) & 511), b = (int)(i >> 22);
        XA[i] = ZP[((size_t)b * TPB + CTX + 64 * t1 + t2) * 512 + cc];
    }
}
#if !FAST_FFT
__device__ __forceinline__ void ph_fft_a(const Frame& F, const Args& A) {
    const unsigned* XA = WSP(unsigned, WS_XA); unsigned* XB = WSP(unsigned, WS_XB);
    for (long i = F.gtid; i < (long)NB * 512 * 8192; i += F.NT) {
        const int k1 = (int)(i & 127); const long row = i >> 7; const int t2 = (int)(row & 63); const long bc = row >> 6;
        const unsigned* x = XA + row * 128; float yr = 0.f, yi = 0.f;
        for (int t1 = 0; t1 < 128; ++t1) { const unsigned w = x[t1]; const float wr = bf2f(w & 0xffffu), wi = bf2f(w >> 16);
            float sn, cs; sincospif((float)((k1 * t1) & 127) / 64.0f, &sn, &cs);
            yr += wr * cs + wi * sn; yi += wi * cs - wr * sn; }
        float sn, cs; sincospif((float)(k1 * t2) / 4096.0f, &sn, &cs);
        const float zr = yr * cs + yi * sn, zi = yi * cs - yr * sn;
        XB[(bc * 64 + (k1 >> 1)) * 128 + (k1 & 1) * 64 + t2] = pk2(zr, zi);
    }
}
#endif
#if !FAST_FFT
__device__ __forceinline__ void ph_fft_b(const Frame& F, const Args& A) {
    const unsigned* XB = WSP(unsigned, WS_XB); unsigned* GB = WSP(unsigned, WS_GB);
    for (long i = F.gtid; i < (long)NB * 512 * 8192; i += F.NT) {
        const int k2 = (int)(i & 63); const long hrow = i >> 6;
        const unsigned* x = XB + hrow * 64; float yr = 0.f, yi = 0.f;
        for (int t2 = 0; t2 < 64; ++t2) { const unsigned w = x[t2]; const float wr = bf2f(w & 0xffffu), wi = bf2f(w >> 16);
            float sn, cs; sincospif((float)((k2 * t2) & 63) / 32.0f, &sn, &cs);
            yr += wr * cs + wi * sn; yi += wi * cs - wr * sn; }
        GB[hrow * 64 + k2] = pk2(yr, yi);
    }
}
#endif
__device__ __forceinline__ void ph_fft_c(const Frame& F, const Args& A) {
    const unsigned* ZP = WSP(unsigned, WS_ZP); float2* GC = WSP(float2, WS_GC);
    LAS unsigned* Z = (LAS unsigned*)F.lds; LAS float* TWc = (LAS float*)(F.lds + 16384); LAS float* TWs = TWc + 256;
    __syncthreads();
    if (F.tid < 256) { const float rev = (float)F.tid * (1.f / 256.f); TWc[F.tid] = __builtin_amdgcn_cosf(rev); TWs[F.tid] = __builtin_amdgcn_sinf(rev); }
    for (int item = F.bid; item < 256; item += F.G) {
        const int b = item >> 7, c0 = ((item >> 2) & 31) * 16, kq = item & 3;
        __syncthreads();
        for (int e = F.tid; e < 4096; e += 512) Z[e] = ZP[((size_t)b * TPB + (e >> 4)) * 512 + c0 + (e & 15)];
        __syncthreads();
        const int cc = F.tid & 15, kb = kq * 64 + (F.tid >> 4) * 2; float ar[2], ai[2]; int m[2];
#pragma unroll
        for (int q = 0; q < 2; ++q) { ar[q] = 0.f; ai[q] = 0.f; m[q] = 0; }
#pragma unroll 4
        for (int t = 0; t < 256; ++t) { const unsigned w = Z[t * 16 + cc]; const float wr = bf2f(w & 0xffffu), wi = bf2f(w >> 16);
#pragma unroll
            for (int q = 0; q < 2; ++q) { const float tc = TWc[m[q]], ts = TWs[m[q]]; ar[q] += wr * tc + wi * ts; ai[q] += wi * tc - wr * ts; m[q] = (m[q] + kb + q) & 255; } }
#pragma unroll
        for (int q = 0; q < 2; ++q) GC[((size_t)b * 512 + c0 + cc) * 256 + kb + q] = make_float2(ar[q], ai[q]);
    }
    __syncthreads();
}
__device__ __forceinline__ void ph_fft_t2(const Frame& F, const Args& A) {
    const unsigned* GB = WSP(unsigned, WS_GB); const float2* GC = WSP(float2, WS_GC); bf16* MX = WSP(bf16, WS_MIXIN);
    for (long i = F.gtid; i < (long)MROWS * 1024; i += F.NT) {
        const int R = (int)(i >> 10), col = (int)(i & 1023), g = col >> 8, jc = col & 255, b = R / TPB, p = R % TPB;
        const bool lat = p >= CTX; const int T = lat ? SEQ : CTX, k = lat ? p - CTX : p, km = (T - k) & (T - 1);
        const int j = (jc == 0 || jc == 128) ? 0 : (jc < 128 ? jc : 256 - jc); const int cc = g * 128 + j;
        float vr, vi, mr, mi;
        if (lat) { const size_t base = ((size_t)b * 512 + cc) * 64;
            const unsigned w = GB[(base + ((k & 127) >> 1)) * 128 + (k & 1) * 64 + (k >> 7)], wm = GB[(base + ((km & 127) >> 1)) * 128 + (km & 1) * 64 + (km >> 7)];
            vr = bf2f(w & 0xffffu); vi = bf2f(w >> 16); mr = bf2f(wm & 0xffffu); mi = bf2f(wm >> 16); }
        else { const float2 w = GC[((size_t)b * 512 + cc) * 256 + k], wm = GC[((size_t)b * 512 + cc) * 256 + km]; vr = w.x; vi = w.y; mr = wm.x; mi = wm.y; }
        float o;
        if (jc == 0) o = 0.5f * (vr + mr); else if (jc == 128) o = 0.5f * (vi + mi); else if (jc < 128) o = mr; else o = vr;
        o *= lat ? 6.9053396600248786e-4f : 3.90625e-3f;
        MX[(size_t)R * 3072 + 2048 + col] = (bf16)f2bf(o);
    }
}

#if !FAST_ATTN
__device__ __forceinline__ void ph_attn_naive(const Frame& F, const Args& A, int l) {
    const bf16 *Kb = WSP(bf16, WS_KB), *Vb = WSP(bf16, WS_VB), *Qb = WSP(bf16, WS_QB); bf16* MX = WSP(bf16, WS_MIXIN);
    const float* lq = A.in[10] + l * 256; float d01 = 0.f, d23 = 0.f;
    for (int i = 0; i < 64; ++i) { d01 += lq[i] * lq[64 + i]; d23 += lq[128 + i] * lq[192 + i]; }
    const float lam_init = 0.8f - 0.6f * expf(-0.3f * (float)l), lam = expf(d01) - expf(d23) + lam_init;
    LAS float* Ks = (LAS float*)F.lds; LAS float* Vs = Ks + 64 * 132; LAS float* Qs = Vs + 64 * 132; LAS float* Ws = Qs + 16 * 128;
    const int r = F.tid >> 5, tl = F.tid & 31;
    for (int u = F.bid; u < 16 * 528; u += F.G) {
        const int bh = u / 528, qb = u % 528, b = bh >> 3, h = bh & 7; const size_t R0 = (size_t)b * TPB + qb * 16; const int nkeys = qb < 16 ? CTX : TPB;
        __syncthreads();
        for (int e = F.tid; e < 2048; e += 512) Qs[e] = bf2f(Qb[(R0 + (e >> 7)) * 1024 + h * 128 + (e & 127)]);
        float m0 = -1e30f, l0 = 0.f, m1 = -1e30f, l1 = 0.f;
        for (int pass = 0; pass < 2; ++pass) {
            float inv0 = 0.f, inv1 = 0.f;
            if (pass == 1) {
#pragma unroll
                for (int o = 1; o < 32; o <<= 1) { float mo = __shfl_xor(m0, o), lo = __shfl_xor(l0, o), mn = fmaxf(m0, mo); l0 = l0 * exp2f(m0 - mn) + lo * exp2f(mo - mn); m0 = mn;
                    mo = __shfl_xor(m1, o); lo = __shfl_xor(l1, o); mn = fmaxf(m1, mo); l1 = l1 * exp2f(m1 - mn) + lo * exp2f(mo - mn); m1 = mn; }
                inv0 = 1.f / l0; inv1 = lam / l1;
            }
            float o4[4] = {0.f, 0.f, 0.f, 0.f};
            for (int kt = 0; kt < nkeys; kt += 64) {
                __syncthreads();
                for (int e = F.tid; e < 1024; e += 512) { const int kk = e >> 4, c8 = (e & 15) * 8; const size_t src = ((size_t)b * TPB + kt + kk) * 1024 + h * 128 + c8;
                    const v4u kv = *(const v4u*)(Kb + src);
                    Ks[kk * 132 + c8 + 0] = bf2f(kv.x & 0xffffu); Ks[kk * 132 + c8 + 1] = bf2f(kv.x >> 16); Ks[kk * 132 + c8 + 2] = bf2f(kv.y & 0xffffu); Ks[kk * 132 + c8 + 3] = bf2f(kv.y >> 16);
                    Ks[kk * 132 + c8 + 4] = bf2f(kv.z & 0xffffu); Ks[kk * 132 + c8 + 5] = bf2f(kv.z >> 16); Ks[kk * 132 + c8 + 6] = bf2f(kv.w & 0xffffu); Ks[kk * 132 + c8 + 7] = bf2f(kv.w >> 16);
                    if (pass == 1) { const v4u vv = *(const v4u*)(Vb + src);
                        Vs[kk * 132 + c8 + 0] = bf2f(vv.x & 0xffffu); Vs[kk * 132 + c8 + 1] = bf2f(vv.x >> 16); Vs[kk * 132 + c8 + 2] = bf2f(vv.y & 0xffffu); Vs[kk * 132 + c8 + 3] = bf2f(vv.y >> 16);
                        Vs[kk * 132 + c8 + 4] = bf2f(vv.z & 0xffffu); Vs[kk * 132 + c8 + 5] = bf2f(vv.z >> 16); Vs[kk * 132 + c8 + 6] = bf2f(vv.w & 0xffffu); Vs[kk * 132 + c8 + 7] = bf2f(vv.w >> 16); } }
                __syncthreads();
#pragma unroll
                for (int kq = 0; kq < 2; ++kq) { const int kk = tl + 32 * kq; float s0 = 0.f, s1 = 0.f;
                    for (int d = 0; d < 64; d += 4) { const f32x4 q0 = *(const LAS f32x4*)(Qs + r * 128 + d), q1 = *(const LAS f32x4*)(Qs + r * 128 + 64 + d), k0 = *(const LAS f32x4*)(Ks + kk * 132 + d), k1 = *(const LAS f32x4*)(Ks + kk * 132 + 64 + d);
                        s0 += q0.x * k0.x + q0.y * k0.y + q0.z * k0.z + q0.w * k0.w; s1 += q1.x * k1.x + q1.y * k1.y + q1.z * k1.z + q1.w * k1.w; }
                    if (pass == 0) { float mn = fmaxf(m0, s0); l0 = l0 * exp2f(m0 - mn) + exp2f(s0 - mn); m0 = mn; mn = fmaxf(m1, s1); l1 = l1 * exp2f(m1 - mn) + exp2f(s1 - mn); m1 = mn; }
                    else Ws[r * 64 + kk] = exp2f(s0 - m0) * inv0 - exp2f(s1 - m1) * inv1; }
                if (pass == 1) { __syncthreads();
                    for (int kk = 0; kk < 64; ++kk) { const float w = Ws[r * 64 + kk];
#pragma unroll
                        for (int i = 0; i < 4; ++i) o4[i] += w * Vs[kk * 132 + tl + 32 * i]; } }
            }
            if (pass == 1) { float ss = o4[0] * o4[0] + o4[1] * o4[1] + o4[2] * o4[2] + o4[3] * o4[3];
#pragma unroll
                for (int o = 1; o < 32; o <<= 1) ss += __shfl_xor(ss, o);
                const float sc = rsqrtf(ss * (1.f / 128.f) + EPS) * (1.f - lam_init);
#pragma unroll
                for (int i = 0; i < 4; ++i) MX[(R0 + r) * 3072 + h * 128 + tl + 32 * i] = (bf16)f2bf(o4[i] * sc * A.in[11][l * 128 + tl + 32 * i]); }
        }
    }
}

#endif
namespace da {
using bf16x8 = __attribute__((ext_vector_type(8))) short;
using s16x4  = __attribute__((ext_vector_type(4))) short;
using f32x16 = __attribute__((ext_vector_type(16))) float;
using u32x4  = __attribute__((ext_vector_type(4))) unsigned;
constexpr int KVBLK = 64, LDK = 1024;
constexpr size_t SHM_V = KVBLK * 128 * 2, SHM_K = KVBLK * 128 * 2;
constexpr float THR = 8.f;
#define DA_KSWZ(row, colB) ((row) * 256 + ((colB) ^ (((row) & 7) << 4)))
#define DA_SBAR() __builtin_amdgcn_sched_barrier(0)
__device__ __forceinline__ int crow(int r, int hi) { return (r & 3) + 8 * (r >> 2) + 4 * hi; }
__device__ __forceinline__ unsigned cvtpk(float lo, float hi) { unsigned r; asm volatile("v_cvt_pk_bf16_f32 %0, %1, %2" : "=v"(r) : "v"(lo), "v"(hi)); return r; }
__device__ __forceinline__ void expSM(f32x16& p0, f32x16& p1, float soff) {
  for (int r = 0; r < 16; ++r) p0[r] = __builtin_amdgcn_exp2f(p0[r] - soff); for (int r = 0; r < 16; ++r) p1[r] = __builtin_amdgcn_exp2f(p1[r] - soff);
}
__device__ __forceinline__ void finishSM(f32x16& p0, f32x16& p1, float& l_reg, bf16x8& pa0, bf16x8& pa1, bf16x8& pa2, bf16x8& pa3) {
  float ps = 0; for (int r = 0; r < 16; ++r) ps += p0[r]; for (int r = 0; r < 16; ++r) ps += p1[r];
  l_reg += ps;
#define DA_PK4(P, BASE, OUT) do { unsigned a0 = cvtpk(P[BASE + 0], P[BASE + 1]), a1 = cvtpk(P[BASE + 2], P[BASE + 3]);   \
    unsigned b0 = cvtpk(P[BASE + 4], P[BASE + 5]), b1 = cvtpk(P[BASE + 6], P[BASE + 7]);                              \
    auto r0 = __builtin_amdgcn_permlane32_swap(a0, b0, false, false); auto r1 = __builtin_amdgcn_permlane32_swap(a1, b1, false, false); \
    u32x4 w = {r0[0], r1[0], r0[1], r1[1]}; OUT = *reinterpret_cast<bf16x8*>(&w); } while (0)
  DA_PK4(p0, 0, pa0); DA_PK4(p0, 8, pa1); DA_PK4(p1, 0, pa2); DA_PK4(p1, 8, pa3);
#undef DA_PK4
}
__device__ __forceinline__ void qkt(f32x16& p0, f32x16& p1, const char* Ks, const bf16x8* qr, int r32, int hi, int cbm) {
  p0 = f32x16{}; p1 = f32x16{};
#pragma unroll
  for (int d0 = 0; d0 < 4; ++d0) { const int cb = cbm + (d0 * 16 + hi * 8) * 2;
    bf16x8 b0 = *reinterpret_cast<const bf16x8*>(Ks + DA_KSWZ(r32, cb));
    bf16x8 b1 = *reinterpret_cast<const bf16x8*>(Ks + DA_KSWZ(32 + r32, cb));
    p0 = __builtin_amdgcn_mfma_f32_32x32x16_bf16(b0, qr[d0], p0, 0, 0, 0);
    p1 = __builtin_amdgcn_mfma_f32_32x32x16_bf16(b1, qr[d0], p1, 0, 0, 0); }
}
__device__ __forceinline__ int v_st(int k, int c) { const int kk = (k & ~0xC) | ((k & 4) << 1) | ((k & 8) >> 1); return ((kk >> 3) * 4 + (c >> 5)) * 512 + ((kk & 7) * 32 + (c & 31)) * 2; }
__device__ __forceinline__ int v_rd_base(int lane) { return ((lane & 3) << 3) | (((lane >> 2) & 3) << 6) | (((lane >> 4) & 1) << 5) | (((lane >> 5) & 1) << 8); }
constexpr int v_rd_off(int d0, int ks, int half) { return d0 * 512 + ks * 4096 + half * 2048; }
template <int OFF> __device__ __forceinline__ s16x4 tr_read(int vb) {
  s16x4 r; asm volatile("ds_read_b64_tr_b16 %0, %1 offset:%2" : "=&v"(r) : "v"(vb), "i"(OFF) : "memory"); return r;
}
template <int D0> __device__ __forceinline__ void pv_one(f32x16& od, int vb, bf16x8 pa0, bf16x8 pa1, bf16x8 pa2, bf16x8 pa3) {
  const s16x4 l0 = tr_read<v_rd_off(D0, 0, 0)>(vb), h0 = tr_read<v_rd_off(D0, 0, 1)>(vb), l1 = tr_read<v_rd_off(D0, 1, 0)>(vb), h1 = tr_read<v_rd_off(D0, 1, 1)>(vb);
  const s16x4 l2 = tr_read<v_rd_off(D0, 2, 0)>(vb), h2 = tr_read<v_rd_off(D0, 2, 1)>(vb), l3 = tr_read<v_rd_off(D0, 3, 0)>(vb), h3 = tr_read<v_rd_off(D0, 3, 1)>(vb);
  asm volatile("s_waitcnt lgkmcnt(0)" ::: "memory"); DA_SBAR();
#define DA_PK(L, H) (bf16x8){L[0], L[1], L[2], L[3], H[0], H[1], H[2], H[3]}
  od = __builtin_amdgcn_mfma_f32_32x32x16_bf16(pa0, DA_PK(l0, h0), od, 0, 0, 0);
  od = __builtin_amdgcn_mfma_f32_32x32x16_bf16(pa1, DA_PK(l1, h1), od, 0, 0, 0);
  od = __builtin_amdgcn_mfma_f32_32x32x16_bf16(pa2, DA_PK(l2, h2), od, 0, 0, 0);
  od = __builtin_amdgcn_mfma_f32_32x32x16_bf16(pa3, DA_PK(l3, h3), od, 0, 0, 0);
#undef DA_PK
}
__device__ __forceinline__ void pv_d0(f32x16* o, int vb, bf16x8 pa0, bf16x8 pa1, bf16x8 pa2, bf16x8 pa3) {
  pv_one<0>(o[0], vb, pa0, pa1, pa2, pa3); pv_one<1>(o[1], vb, pa0, pa1, pa2, pa3); pv_one<2>(o[2], vb, pa0, pa1, pa2, pa3); pv_one<3>(o[3], vb, pa0, pa1, pa2, pa3);
}
__device__ __forceinline__ void unit(const unsigned short* __restrict__ Qb, const unsigned short* __restrict__ Kh, const unsigned short* __restrict__ Vh,
                                     unsigned short* __restrict__ Ob, int ldo, int seq, float lam, float oscale, float soff, const float* __restrict__ subg, char* lds) {
  const int tid = otid(), wid = tid >> 6, lane = tid & 63, r32 = lane & 31, hi = lane >> 5, mp = wid >> 2, wq = wid & 3;
  char* V_lds = lds; char* K_lds = lds + 2 * SHM_V;
  float* ws = (float*)(lds + 2 * SHM_V + 2 * SHM_K) + wid * 64; float* li_l = ws;
  float l_reg = 0; f32x16 o[4] = {}; bf16x8 qr[4];
  const unsigned short* Qw = Qb + (long)(wq * 32 + r32) * 1024 + mp * 64 + hi * 8;
#pragma unroll
  for (int d0 = 0; d0 < 4; ++d0) qr[d0] = *reinterpret_cast<const bf16x8*>(Qw + d0 * 16);
  const int cbm = mp * 128;
  const int sr = tid >> 4, sc = (tid & 15) * 8, vst0 = v_st(sr, sc), vst1 = v_st(32 + sr, sc);
  const int vb0 = (int)(uintptr_t)V_lds + v_rd_base(lane);
  struct { bf16x8 vs0, vs1, ks0, ks1; } sr_[2];
#define DA_SLOAD(i, k0) do { sr_[i].vs0 = *reinterpret_cast<const bf16x8*>(&Vh[(long)((k0) + sr) * LDK + sc]); sr_[i].vs1 = *reinterpret_cast<const bf16x8*>(&Vh[(long)((k0) + 32 + sr) * LDK + sc]); \
    sr_[i].ks0 = *reinterpret_cast<const bf16x8*>(&Kh[(long)((k0) + sr) * LDK + sc]); sr_[i].ks1 = *reinterpret_cast<const bf16x8*>(&Kh[(long)((k0) + 32 + sr) * LDK + sc]); } while (0)
#define DA_SWRITE(b, i) do { *(bf16x8*)(V_lds + (b) * SHM_V + vst0) = sr_[i].vs0;          \
    *(bf16x8*)(V_lds + (b) * SHM_V + vst1) = sr_[i].vs1; int kc = sc * 2;               \
    *(bf16x8*)(K_lds + (b) * SHM_K + DA_KSWZ(sr, kc)) = sr_[i].ks0;                       \
    *(bf16x8*)(K_lds + (b) * SHM_K + DA_KSWZ(32 + sr, kc)) = sr_[i].ks1; } while (0)
#define DA_SWAIT() asm volatile("s_waitcnt vmcnt(4)" ::: "memory")
  f32x16 pA0, pA1, pB0, pB1; bf16x8 pa0, pa1, pa2, pa3; const int NT = seq / KVBLK;
  constexpr int SE = 0, SO = 1;
  DA_SLOAD(SE, 0); asm volatile("s_waitcnt vmcnt(0)" ::: "memory"); DA_SWRITE(0, SE); __syncthreads();
  qkt(pA0, pA1, K_lds, qr, r32, hi, cbm); expSM(pA0, pA1, soff);
  DA_SLOAD(SO, KVBLK); if (2 < NT) DA_SLOAD(SE, 2 * KVBLK);
  DA_SWAIT(); DA_SWRITE(1, SO); __syncthreads();
  for (int j = 1; j + 1 < NT; j += 2) {
    DA_SBAR(); qkt(pB0, pB1, K_lds + SHM_K, qr, r32, hi, cbm);
    finishSM(pA0, pA1, l_reg, pa0, pa1, pa2, pa3); DA_SBAR();
    DA_SLOAD(SO, (j + 2) * KVBLK); DA_SBAR();
    pv_d0(o, vb0, pa0, pa1, pa2, pa3); expSM(pB0, pB1, soff);
    __syncthreads(); DA_SWAIT(); DA_SWRITE(0, SE);
    __syncthreads();
    DA_SBAR(); qkt(pA0, pA1, K_lds, qr, r32, hi, cbm);
    finishSM(pB0, pB1, l_reg, pa0, pa1, pa2, pa3); DA_SBAR();
    if (j + 3 < NT) DA_SLOAD(SE, (j + 3) * KVBLK); DA_SBAR();
    pv_d0(o, vb0 + (int)SHM_V, pa0, pa1, pa2, pa3); expSM(pA0, pA1, soff);
    __syncthreads(); DA_SWAIT(); DA_SWRITE(1, SO);
    __syncthreads();
  }
  DA_SBAR(); qkt(pB0, pB1, K_lds + SHM_K, qr, r32, hi, cbm);
  finishSM(pA0, pA1, l_reg, pa0, pa1, pa2, pa3); DA_SBAR();
  pv_d0(o, vb0, pa0, pa1, pa2, pa3); expSM(pB0, pB1, soff);
  __syncthreads();
  finishSM(pB0, pB1, l_reg, pa0, pa1, pa2, pa3); DA_SBAR();
  pv_d0(o, vb0 + (int)SHM_V, pa0, pa1, pa2, pa3);
  { auto rr = __builtin_amdgcn_permlane32_swap(__float_as_uint(l_reg), __float_as_uint(l_reg), false, false); l_reg = __uint_as_float(rr[0]) + __uint_as_float(rr[1]); }
  if (hi == 0) li_l[r32] = l_reg; asm volatile("s_waitcnt lgkmcnt(0)" ::: "memory");
  const float sgn = mp ? lam : 1.f;
#pragma unroll
  for (int r = 0; r < 16; ++r) { const float rl = sgn * __builtin_amdgcn_rcpf(li_l[crow(r, hi)]);
#pragma unroll
    for (int d0 = 0; d0 < 4; ++d0) o[d0][r] *= rl; }
  __syncthreads();
  int xb = wq * 4096 + lane; asm volatile("" : "+v"(xb));
  float* X = (float*)lds + xb;
  if (mp == 1) {
#pragma unroll
    for (int d0 = 0; d0 < 4; ++d0)
#pragma unroll
      for (int r = 0; r < 16; ++r) X[(d0 * 16 + r) * 64] = o[d0][r];
  }
  __syncthreads();
  if (mp == 0) {
    float gg[4];
#pragma unroll
    for (int d0 = 0; d0 < 4; ++d0) gg[d0] = subg[d0 * 32 + r32] * oscale;
    int ob = (wq * 32 + 4 * hi) * ldo + r32; asm volatile("" : "+v"(ob));
    unsigned short* Ow = Ob + ob;
#pragma unroll
    for (int r = 0; r < 16; ++r) { float a = 0.f; float v[4];
#pragma unroll
      for (int d0 = 0; d0 < 4; ++d0) { v[d0] = o[d0][r] - X[(d0 * 16 + r) * 64]; a += v[d0] * v[d0]; }
      a += sx<1>(a); a += sx<2>(a); a += sx<4>(a); a += sx<8>(a); a += sx<16>(a);
      a = rsqrtf(a * (1.f / 128.f) + EPS);
      const int orow = (r & 3) + 8 * (r >> 2);
#pragma unroll
      for (int d0 = 0; d0 < 4; ++d0) Ow[orow * ldo + d0 * 32] = (unsigned short)f2bf(v[d0] * a * gg[d0]); }
  }
  __syncthreads();
#undef DA_SLOAD
#undef DA_SWRITE
#undef DA_SWAIT
}

template <int D0> __device__ __forceinline__ void v_rd8(s16x4 (&f)[8], int vb) {
  f[0] = tr_read<v_rd_off(D0, 0, 0)>(vb); f[1] = tr_read<v_rd_off(D0, 0, 1)>(vb); f[2] = tr_read<v_rd_off(D0, 1, 0)>(vb); f[3] = tr_read<v_rd_off(D0, 1, 1)>(vb);
  f[4] = tr_read<v_rd_off(D0, 2, 0)>(vb); f[5] = tr_read<v_rd_off(D0, 2, 1)>(vb); f[6] = tr_read<v_rd_off(D0, 3, 0)>(vb); f[7] = tr_read<v_rd_off(D0, 3, 1)>(vb);
}
__device__ __forceinline__ void pv_mm(f32x16& od, const s16x4 (&f)[8], bf16x8 pa0, bf16x8 pa1, bf16x8 pa2, bf16x8 pa3) {
#define DA_PK(L, H) (bf16x8){L[0], L[1], L[2], L[3], H[0], H[1], H[2], H[3]}
  od = __builtin_amdgcn_mfma_f32_32x32x16_bf16(pa0, DA_PK(f[0], f[1]), od, 0, 0, 0);
  od = __builtin_amdgcn_mfma_f32_32x32x16_bf16(pa1, DA_PK(f[2], f[3]), od, 0, 0, 0);
  od = __builtin_amdgcn_mfma_f32_32x32x16_bf16(pa2, DA_PK(f[4], f[5]), od, 0, 0, 0);
  od = __builtin_amdgcn_mfma_f32_32x32x16_bf16(pa3, DA_PK(f[6], f[7]), od, 0, 0, 0);
#undef DA_PK
}
__device__ __forceinline__ void pv_pipe(f32x16* o, int vb, bf16x8 pa0, bf16x8 pa1, bf16x8 pa2, bf16x8 pa3) {
  s16x4 fa[8], fb[8];
  v_rd8<0>(fa, vb); v_rd8<1>(fb, vb);
  asm volatile("s_waitcnt lgkmcnt(8)" ::: "memory"); DA_SBAR(); pv_mm(o[0], fa, pa0, pa1, pa2, pa3); DA_SBAR();
  v_rd8<2>(fa, vb);
  asm volatile("s_waitcnt lgkmcnt(8)" ::: "memory"); DA_SBAR(); pv_mm(o[1], fb, pa0, pa1, pa2, pa3); DA_SBAR();
  v_rd8<3>(fb, vb);
  asm volatile("s_waitcnt lgkmcnt(8)" ::: "memory"); DA_SBAR(); pv_mm(o[2], fa, pa0, pa1, pa2, pa3); DA_SBAR();
  asm volatile("s_waitcnt lgkmcnt(0)" ::: "memory"); DA_SBAR(); pv_mm(o[3], fb, pa0, pa1, pa2, pa3); DA_SBAR();
}
__device__ __forceinline__ void unit8(const unsigned short* __restrict__ Qb, const unsigned short* __restrict__ Kh, const unsigned short* __restrict__ Vh,
                                      unsigned short* __restrict__ Ob, int ldo, int seq, float lam, float oscale, float soff, const float* __restrict__ subg, LAS unsigned char* ldsl) {
  const int tid = otid(), wid = __builtin_amdgcn_readfirstlane(tid >> 6), lane = tid & 63, r32 = lane & 31, hi = lane >> 5, mp = wid >> 2, wq = wid & 3;
  constexpr int SLOT = 16384;
  char* lds = (char*)ldsl; char* K_lds = lds; const int vbase = (int)(uintptr_t)(lds + 3 * SLOT) + v_rd_base(lane);
  float* li_l = (float*)(lds + 6 * SLOT) + wid * 64;
  f32x16 o[4] = {}; bf16x8 qr[4];
  const unsigned short* Qw = Qb + (long)(wq * 32 + r32) * 1024 + mp * 64 + hi * 8;
#pragma unroll
  for (int d0 = 0; d0 < 4; ++d0) qr[d0] = *reinterpret_cast<const bf16x8*>(Qw + d0 * 16);
  asm volatile("s_waitcnt vmcnt(0)" ::: "memory");
  const int cbm = mp * 128;
  const unsigned wl = (unsigned)wid * 1024u;
  unsigned kso[2], vso[2];
#pragma unroll
  for (int i = 0; i < 2; ++i) { const int P = (i * 8 + wid) * 64 + lane;
    { const int row = P >> 4, chunk = (P & 15) ^ (row & 7); kso[i] = (unsigned)(row * LDK + chunk * 8) * 2u; }
    { const int sub = P >> 5, kk = (sub >> 2) * 8 + ((P & 31) >> 2), key = (kk & ~0xC) | ((kk & 4) << 1) | ((kk & 8) >> 1); vso[i] = (unsigned)(key * LDK + (sub & 3) * 32 + (P & 3) * 8) * 2u; } }
#define DA_DMA_K(t, slot) do { const unsigned to_ = (unsigned)(t) * (unsigned)(KVBLK * LDK * 2); _Pragma("unroll") for (int i_ = 0; i_ < 2; ++i_) \
      __builtin_amdgcn_global_load_lds((const unsigned*)((const char*)Kh + (kso[i_] + to_)), (LAS unsigned*)(ldsl + (slot) * SLOT + i_ * 8192 + wl), 16, 0, 0); } while (0)
#define DA_DMA_V(t, slot) do { const unsigned to_ = (unsigned)(t) * (unsigned)(KVBLK * LDK * 2); _Pragma("unroll") for (int i_ = 0; i_ < 2; ++i_) \
      __builtin_amdgcn_global_load_lds((const unsigned*)((const char*)Vh + (vso[i_] + to_)), (LAS unsigned*)(ldsl + (3 + (slot)) * SLOT + i_ * 8192 + wl), 16, 0, 0); } while (0)
#define U8_PK(t, slot, i_) __builtin_amdgcn_global_load_lds((const unsigned*)((const char*)Kh + (kso[i_] + (unsigned)(t) * (unsigned)(KVBLK * LDK * 2))), (LAS unsigned*)(ldsl + (slot) * SLOT + (i_) * 8192 + wl), 16, 0, 0)
#define U8_PV(t, slot, i_) __builtin_amdgcn_global_load_lds((const unsigned*)((const char*)Vh + (vso[i_] + (unsigned)(t) * (unsigned)(KVBLK * LDK * 2))), (LAS unsigned*)(ldsl + (3 + (slot)) * SLOT + (i_) * 8192 + wl), 16, 0, 0)
#define DA_WAITBAR(N) do { asm volatile("s_waitcnt vmcnt(" #N ") lgkmcnt(0)" ::: "memory"); __builtin_amdgcn_s_barrier(); asm volatile("" ::: "memory"); } while (0)
  f32x16 pA0, pA1, pB0, pB1; u32x4 pw0, pw1, pw2, pw3; const int NT = seq / KVBLK;
  bf16x8 kf[8];
  f32x16 negm, ol = {};
#pragma unroll
  for (int r = 0; r < 16; ++r) negm[r] = -soff;
  const bf16x8 ones = {0x3F80, 0x3F80, 0x3F80, 0x3F80, 0x3F80, 0x3F80, 0x3F80, 0x3F80};
  const int pkr = ((r32 & 3) + 4 * (r32 >> 3)), pk = (pkr & 7) + 16 * (pkr >> 3) + 8 * ((r32 >> 2) & 1);
#define U5_KADDR(d0) ((int)(uintptr_t)K_lds + pk * 256 + ((((cbm >> 4) + 2 * (d0) + hi) ^ (pk & 7)) * 16))
#define U5_KLOAD(slot) do { const int so_ = (slot) * SLOT; _Pragma("unroll") for (int d0 = 0; d0 < 4; ++d0) { const int ad_ = U5_KADDR(d0) + so_; \
    asm volatile("ds_read_b128 %0, %2\n\tds_read_b128 %1, %2 offset:8192" : "=&v"(kf[2 * d0]), "=&v"(kf[2 * d0 + 1]) : "v"(ad_) : "memory"); } } while (0)
#define U5_PIN(x) asm volatile("" : "+v"(x))
#define U5_EX(v) __builtin_amdgcn_exp2f(v)
#define U5_VRD(L, H, m) do { asm volatile("ds_read_b64_tr_b16 %0, %1 offset:%2" : "=&v"(L) : "v"(vb_), "i"(v_rd_off((m) >> 2, (m) & 3, 0)) : "memory"); \
    asm volatile("ds_read_b64_tr_b16 %0, %1 offset:%2" : "=&v"(H) : "v"(vb_), "i"(v_rd_off((m) >> 2, (m) & 3, 1)) : "memory"); } while (0)
#define U5_GAPA(MF, X, B4, PW, VR, CV0, CV1) do { MF; VR; CV0; CV1; U5_PIN(PW); DA_SBAR(); } while (0)
#define U5_CVT(P, b) cvtpk(P[b], P[b + 1])
#define U5_PHASE_A(C0, C1, P0, P1, VSLOT, HK0, HK1, HV0, HV1) do { const int vb_ = vbase + (VSLOT) * SLOT; \
    U5_GAPA(C0 = __builtin_amdgcn_mfma_f32_32x32x16_bf16(kf[0], qr[0], negm, 0, 0, 0), P0, 0, pw0, HK0, pw0[0] = U5_CVT(P0, 0), pw0[1] = U5_CVT(P0, 2)); \
    U5_GAPA(C1 = __builtin_amdgcn_mfma_f32_32x32x16_bf16(kf[1], qr[0], negm, 0, 0, 0), P0, 4, pw0, HK1, pw0[2] = U5_CVT(P0, 4), pw0[3] = U5_CVT(P0, 6)); \
    U5_GAPA(C0 = __builtin_amdgcn_mfma_f32_32x32x16_bf16(kf[2], qr[1], C0, 0, 0, 0), P0, 8, pw1, do { HV0; HV1; } while (0), pw1[0] = U5_CVT(P0, 8), pw1[1] = U5_CVT(P0, 10)); \
    U5_GAPA(C1 = __builtin_amdgcn_mfma_f32_32x32x16_bf16(kf[3], qr[1], C1, 0, 0, 0), P0, 12, pw1, U5_VRD(vl0, vh0, 0), pw1[2] = U5_CVT(P0, 12), pw1[3] = U5_CVT(P0, 14)); \
    U5_GAPA(C0 = __builtin_amdgcn_mfma_f32_32x32x16_bf16(kf[4], qr[2], C0, 0, 0, 0), P1, 0, pw2, U5_VRD(vl1, vh1, 1), pw2[0] = U5_CVT(P1, 0), pw2[1] = U5_CVT(P1, 2)); \
    U5_GAPA(C1 = __builtin_amdgcn_mfma_f32_32x32x16_bf16(kf[5], qr[2], C1, 0, 0, 0), P1, 4, pw2, U5_VRD(vl2, vh2, 2), pw2[2] = U5_CVT(P1, 4), pw2[3] = U5_CVT(P1, 6)); \
    U5_GAPA(C0 = __builtin_amdgcn_mfma_f32_32x32x16_bf16(kf[6], qr[3], C0, 0, 0, 0), P1, 8, pw3, U5_VRD(vl3, vh3, 3), pw3[0] = U5_CVT(P1, 8), pw3[1] = U5_CVT(P1, 10)); \
    U5_GAPA(C1 = __builtin_amdgcn_mfma_f32_32x32x16_bf16(kf[7], qr[3], C1, 0, 0, 0), P1, 12, pw3, U5_VRD(vl4, vh4, 4), pw3[2] = U5_CVT(P1, 12), pw3[3] = U5_CVT(P1, 14)); \
    } while (0)
#define U5_PKV(L, H) (bf16x8){L[0], L[1], L[2], L[3], H[0], H[1], H[2], H[3]}
#define U5_PAF(k) __builtin_bit_cast(bf16x8, pw##k)
#define U5_GAPB(WAITN, OD, PK, L, H, X, B2, NEXT) do { asm volatile("s_waitcnt lgkmcnt(" #WAITN ")" ::: "memory"); DA_SBAR(); \
    OD = __builtin_amdgcn_mfma_f32_32x32x16_bf16(PK, U5_PKV(L, H), OD, 0, 0, 0); NEXT; X[B2] = U5_EX(X[B2]); X[B2 + 1] = U5_EX(X[B2 + 1]); U5_PIN(X); DA_SBAR(); } while (0)
#define U5_GAPS(PK, X, B2) do { ol = __builtin_amdgcn_mfma_f32_32x32x16_bf16(PK, ones, ol, 0, 0, 0); X[B2] = U5_EX(X[B2]); X[B2 + 1] = U5_EX(X[B2 + 1]); U5_PIN(X); DA_SBAR(); } while (0)
#define U5_GAPN(WAITN, OD, PK, L, H, NEXT) do { asm volatile("s_waitcnt lgkmcnt(" #WAITN ")" ::: "memory"); DA_SBAR(); \
    OD = __builtin_amdgcn_mfma_f32_32x32x16_bf16(PK, U5_PKV(L, H), OD, 0, 0, 0); NEXT; DA_SBAR(); } while (0)
#define U5_PHASE_B(C0, C1, VSLOT, KSLOT, DOK) do { const int vb_ = vbase + (VSLOT) * SLOT; \
    U5_GAPS(U5_PAF(0), C0, 0); U5_GAPS(U5_PAF(1), C0, 2); U5_GAPS(U5_PAF(2), C0, 4); U5_GAPS(U5_PAF(3), C0, 6); \
    U5_GAPB(8, o[0], U5_PAF(0), vl0, vh0, C0, 8, U5_VRD(vl5, vh5, 5)); \
    U5_GAPB(8, o[0], U5_PAF(1), vl1, vh1, C0, 10, U5_VRD(vl0, vh0, 6)); \
    U5_GAPB(8, o[0], U5_PAF(2), vl2, vh2, C0, 12, U5_VRD(vl1, vh1, 7)); \
    U5_GAPB(8, o[0], U5_PAF(3), vl3, vh3, C0, 14, U5_VRD(vl2, vh2, 8)); \
    U5_GAPB(8, o[1], U5_PAF(0), vl4, vh4, C1, 0, U5_VRD(vl3, vh3, 9)); \
    U5_GAPB(8, o[1], U5_PAF(1), vl5, vh5, C1, 2, U5_VRD(vl4, vh4, 10)); \
    U5_GAPB(8, o[1], U5_PAF(2), vl0, vh0, C1, 4, U5_VRD(vl5, vh5, 11)); \
    U5_GAPB(8, o[1], U5_PAF(3), vl1, vh1, C1, 6, U5_VRD(vl0, vh0, 12)); \
    U5_GAPB(8, o[2], U5_PAF(0), vl2, vh2, C1, 8, U5_VRD(vl1, vh1, 13)); \
    U5_GAPB(8, o[2], U5_PAF(1), vl3, vh3, C1, 10, U5_VRD(vl2, vh2, 14)); \
    U5_GAPB(8, o[2], U5_PAF(2), vl4, vh4, C1, 12, U5_VRD(vl3, vh3, 15)); \
    U5_GAPB(8, o[2], U5_PAF(3), vl5, vh5, C1, 14, (void)0); \
    U5_GAPN(6, o[3], U5_PAF(0), vl0, vh0, (void)0); \
    if (DOK) { U5_GAPN(4, o[3], U5_PAF(1), vl1, vh1, U5_KLOAD(KSLOT)); U5_GAPN(10, o[3], U5_PAF(2), vl2, vh2, (void)0); U5_GAPN(8, o[3], U5_PAF(3), vl3, vh3, (void)0); } \
    else { U5_GAPN(4, o[3], U5_PAF(1), vl1, vh1, (void)0); U5_GAPN(2, o[3], U5_PAF(2), vl2, vh2, (void)0); U5_GAPN(0, o[3], U5_PAF(3), vl3, vh3, (void)0); } } while (0)
#define DA_ROT(x) ((x) == 2 ? 0 : (x) + 1)
#define DA_PRV(x) ((x) == 0 ? 2 : (x) - 1)
  s16x4 vl0, vh0, vl1, vh1, vl2, vh2, vl3, vh3, vl4, vh4, vl5, vh5;
  DA_DMA_K(0, 0); DA_DMA_K(1, 1); DA_DMA_V(0, 0);
  DA_WAITBAR(0);
  U5_KLOAD(0); DA_DMA_K(2, 2); DA_DMA_V(1, 1);
  DA_WAITBAR(4);
  DA_DMA_K(3, 0);
  DA_SBAR();
  pA0 = negm; pA1 = negm;
#pragma unroll
  for (int d0 = 0; d0 < 4; ++d0) { pA0 = __builtin_amdgcn_mfma_f32_32x32x16_bf16(kf[2 * d0], qr[d0], pA0, 0, 0, 0); pA1 = __builtin_amdgcn_mfma_f32_32x32x16_bf16(kf[2 * d0 + 1], qr[d0], pA1, 0, 0, 0); }
  DA_SBAR(); U5_KLOAD(1);
  expSM(pA0, pA1, 0.f);
  DA_WAITBAR(2);
  int c = 1;
  for (int j = 1; j + 1 < NT; j += 2) {
    { const bool mk = j + 3 < NT;
      DA_SBAR(); U5_PHASE_A(pB0, pB1, pA0, pA1, DA_PRV(c), if (mk) U8_PK(j + 3, c, 0), if (mk) U8_PK(j + 3, c, 1), U8_PV(j + 1, DA_ROT(c), 0), U8_PV(j + 1, DA_ROT(c), 1));
      U5_PHASE_B(pB0, pB1, DA_PRV(c), DA_ROT(c), true);
      if (mk) DA_WAITBAR(4); else DA_WAITBAR(2);
      c = DA_ROT(c); }
    { const bool mk = j + 4 < NT;
      DA_SBAR(); U5_PHASE_A(pA0, pA1, pB0, pB1, DA_PRV(c), if (mk) U8_PK(j + 4, c, 0), if (mk) U8_PK(j + 4, c, 1), U8_PV(j + 2, DA_ROT(c), 0), U8_PV(j + 2, DA_ROT(c), 1));
      U5_PHASE_B(pA0, pA1, DA_PRV(c), DA_ROT(c), true);
      if (mk) DA_WAITBAR(4); else DA_WAITBAR(2);
      c = DA_ROT(c); }
  }
  DA_SBAR(); U5_PHASE_A(pB0, pB1, pA0, pA1, DA_PRV(c), (void)0, (void)0, (void)0, (void)0);
  U5_PHASE_B(pB0, pB1, DA_PRV(c), 0, false);
  DA_WAITBAR(0);
  { u32x4 w0 = {cvtpk(pB0[0], pB0[1]), cvtpk(pB0[2], pB0[3]), cvtpk(pB0[4], pB0[5]), cvtpk(pB0[6], pB0[7])}, w1 = {cvtpk(pB0[8], pB0[9]), cvtpk(pB0[10], pB0[11]), cvtpk(pB0[12], pB0[13]), cvtpk(pB0[14], pB0[15])};
    u32x4 w2 = {cvtpk(pB1[0], pB1[1]), cvtpk(pB1[2], pB1[3]), cvtpk(pB1[4], pB1[5]), cvtpk(pB1[6], pB1[7])}, w3 = {cvtpk(pB1[8], pB1[9]), cvtpk(pB1[10], pB1[11]), cvtpk(pB1[12], pB1[13]), cvtpk(pB1[14], pB1[15])};
    const bf16x8 pa0 = __builtin_bit_cast(bf16x8, w0), pa1 = __builtin_bit_cast(bf16x8, w1), pa2 = __builtin_bit_cast(bf16x8, w2), pa3 = __builtin_bit_cast(bf16x8, w3); DA_SBAR();
    ol = __builtin_amdgcn_mfma_f32_32x32x16_bf16(pa0, ones, ol, 0, 0, 0); ol = __builtin_amdgcn_mfma_f32_32x32x16_bf16(pa1, ones, ol, 0, 0, 0);
    ol = __builtin_amdgcn_mfma_f32_32x32x16_bf16(pa2, ones, ol, 0, 0, 0); ol = __builtin_amdgcn_mfma_f32_32x32x16_bf16(pa3, ones, ol, 0, 0, 0);
    pv_d0(o, vbase + c * SLOT, pa0, pa1, pa2, pa3); }
#undef U5_KADDR
#undef U5_KLOAD
#undef U5_PIN
#undef U5_EX
#undef U5_GAPA
#undef U5_CVT
#undef U5_PHASE_A
#undef U5_VRD
#undef U5_PKV
#undef U5_PAF
#undef U5_GAPB
#undef U5_GAPS
#undef U5_GAPN
#undef U5_PHASE_B
  const int tid2 = otid(), wid2 = __builtin_amdgcn_readfirstlane(tid2 >> 6), lane2 = tid2 & 63; { const int r32 = lane2 & 31, hi = lane2 >> 5, mp = wid2 >> 2, wq = wid2 & 3, lane = lane2; float* li_l = (float*)(lds + 6 * SLOT) + wid2 * 64;
  const float sgn = mp ? lam : 1.f;
#pragma unroll
  for (int r = 0; r < 16; ++r) { const float rl = sgn * __builtin_amdgcn_rcpf(ol[r]);
#pragma unroll
    for (int d0 = 0; d0 < 4; ++d0) o[d0][r] *= rl; }
  __syncthreads();
  int xb = wq * 4096 + lane; asm volatile("" : "+v"(xb));
  float* X = (float*)lds + xb;
  if (mp == 1) {
#pragma unroll
    for (int d0 = 0; d0 < 4; ++d0)
#pragma unroll
      for (int r = 0; r < 16; ++r) X[(d0 * 16 + r) * 64] = o[d0][r];
  }
  __syncthreads();
  if (mp == 0) {
    float gg[4];
#pragma unroll
    for (int d0 = 0; d0 < 4; ++d0) gg[d0] = subg[d0 * 32 + r32] * oscale;
    int ob = (wq * 32 + 4 * hi) * ldo + r32; asm volatile("" : "+v"(ob));
    unsigned short* Ow = Ob + ob;
#pragma unroll
    for (int r = 0; r < 16; ++r) { float a = 0.f; float v[4];
#pragma unroll
      for (int d0 = 0; d0 < 4; ++d0) { v[d0] = o[d0][r] - X[(d0 * 16 + r) * 64]; a += v[d0] * v[d0]; }
      a += sx<1>(a); a += sx<2>(a); a += sx<4>(a); a += sx<8>(a); a += sx<16>(a);
      a = rsqrtf(a * (1.f / 128.f) + EPS);
      const int orow = (r & 3) + 8 * (r >> 2);
#pragma unroll
      for (int d0 = 0; d0 < 4; ++d0) Ow[orow * ldo + d0 * 32] = (unsigned short)f2bf(v[d0] * a * gg[d0]); }
  }
  }
  asm volatile("s_waitcnt vmcnt(0)" ::: "memory");
  __syncthreads();
#undef DA_DMA_K
#undef DA_DMA_V
#undef DA_WAITBAR
#undef DA_ROT
#undef DA_PRV
}
}
__device__ __forceinline__ void ph_attn(const Frame& F, const Args& A, int l) {
    const bf16 *Kb = WSP(bf16, WS_KB), *Vb = WSP(bf16, WS_VB), *Qb = WSP(bf16, WS_QB); bf16* MX = WSP(bf16, WS_MIXIN);
    const float* lq = A.in[10] + l * 256; float d01 = 0.f, d23 = 0.f;
    for (int i = 0; i < 64; ++i) { d01 += lq[i] * lq[64 + i]; d23 += lq[128 + i] * lq[192 + i]; }
    const float lam_init = 0.8f - 0.6f * expf(-0.3f * (float)l); float lam = expf(d01) - expf(d23) + lam_init;
    float mq = 0.f, mk = 0.f;
    for (int i = 0; i < 64; ++i) { mq = fmaxf(mq, fabsf(A.in[8][l * 64 + i])); mk = fmaxf(mk, fabsf(A.in[9][l * 64 + i])); }
    const float soff = __uint_as_float(__builtin_amdgcn_readfirstlane(__float_as_uint(64.f * mq * mk * QSCALE)));
    lam = __uint_as_float(__builtin_amdgcn_readfirstlane(__float_as_uint(lam))); const float osc = __uint_as_float(__builtin_amdgcn_readfirstlane(__float_as_uint(1.f - lam_init)));
    const int vcu = (F.G % 8 == 0) ? (F.bid % 8) * (F.G / 8) + F.bid / 8 : F.bid;
    for (int u = vcu; u < (l == DEPTH - 1 ? 1024 : 16 * 66); u += F.G) {
        const int bh = (u % 1024) / 64 , b = bh >> 3, h = bh & 7;
        int qb; int bb = b, hh = h;
        if (u < 1024) qb = 2 + (u & 63); else { const int v = u - 1024; bb = v >> 4; hh = (v >> 1) & 7; qb = v & 1; }
        const size_t R0 = (size_t)bb * TPB + qb * 128; const int seq = qb < 2 ? CTX : TPB;
#if ATTN_V2 == 8
        da::unit8(Qb + R0 * 1024 + hh * 128, Kb + (size_t)bb * TPB * 1024 + hh * 128, Vb + (size_t)bb * TPB * 1024 + hh * 128,
                  MX + R0 * 3072 + hh * 128, 3072, seq, lam, osc, soff, A.in[11] + l * 128, F.lds);
#else
        da::unit(Qb + R0 * 1024 + hh * 128, Kb + (size_t)bb * TPB * 1024 + hh * 128, Vb + (size_t)bb * TPB * 1024 + hh * 128,
                 MX + R0 * 3072 + hh * 128, 3072, seq, lam, osc, soff, A.in[11] + l * 128, (char*)F.lds);
#endif
    }
}

__device__ __forceinline__ void ph_mix(const Frame& F, const Args& A) {
    const float *PA = WSP(float, WS_PA), *PR = WSP(float, WS_PR), *PF = WSP(float, WS_PF); const bf16* GT = WSP(bf16, WS_GATES); bf16* MD = WSP(bf16, WS_MIXED);
    for (long i = F.gtid; i < (long)MROWS * 1024; i += F.NT) { const size_t R = (size_t)(i >> 10); const int c = (int)(i & 1023);
        MD[i] = (bf16)f2bf(bf2f(GT[R * 3072 + c]) * PA[i] + bf2f(GT[R * 3072 + 1024 + c]) * PR[i] + bf2f(GT[R * 3072 + 2048 + c]) * PF[i]); }
}
__device__ __forceinline__ void ph_resid_norm2(const Frame& F, const Args& A, int l) {
    float* X = WSP(float, WS_XALL); const float* Y1 = WSP(float, WS_Y1); bf16* TOK = WSP(bf16, WS_TOK);
    for (int R = F.gw; R < MROWS; R += F.NGW) {
        const int b = R / TPB, p = R % TPB, s = (p < CTX) ? 2 : b; const float* g1 = MODP(l, s, 2);
        f32x4 v[4];
#pragma unroll
        for (int j = 0; j < 4; ++j) { const int c = 4 * F.lane + 256 * j; const f32x4 x = *(const f32x4*)(X + (size_t)R * 1024 + c), y = *(const f32x4*)(Y1 + (size_t)R * 1024 + c), gg = *(const f32x4*)(g1 + c);
            v[j] = x + gg * y; *(f32x4*)(X + (size_t)R * 1024 + c) = v[j]; }
        norm_mod_row(v, A.in[23] + l * 1024, MODP(l, s, 4), MODP(l, s, 3), TOK + (size_t)R * 1024, F.lane);
    }
}
#define G1(T) __attribute__((address_space(1))) T
template <int CTRL, int RM = 0xf> __device__ __forceinline__ float dpp_f(float v) {
    return __uint_as_float(__builtin_amdgcn_update_dpp(__float_as_uint(v), __float_as_uint(v), CTRL, RM, 0xf, false)); }
__device__ __forceinline__ float wave_max63(float v) {
    asm volatile("s_nop 1\n\tv_max_f32_dpp %0, %0, %0 row_ror:1 row_mask:0xf bank_mask:0xf\n\ts_nop 1\n\tv_max_f32_dpp %0, %0, %0 row_ror:2 row_mask:0xf bank_mask:0xf\n\t"
                 "s_nop 1\n\tv_max_f32_dpp %0, %0, %0 row_ror:4 row_mask:0xf bank_mask:0xf\n\ts_nop 1\n\tv_max_f32_dpp %0, %0, %0 row_ror:8 row_mask:0xf bank_mask:0xf\n\t"
                 "s_nop 1\n\tv_max_f32_dpp %0, %0, %0 row_bcast:15 row_mask:0xa bank_mask:0xf\n\ts_nop 1\n\tv_max_f32_dpp %0, %0, %0 row_bcast:31 row_mask:0xc bank_mask:0xf\n\ts_nop 1" : "+v"(v));
    return v; }
template <bool DRY = false> __device__ __forceinline__ void ph_topk(const Frame& F, const Args& A, int l) {
    const float* LG = WSP(float, WS_LOG);
    int* LIST = DRY ? WSP(int, WS_PR) : WSP(int, WS_LIST); float* TOPW = DRY ? WSP(float, WS_PR + 18 * MiB) : WSP(float, WS_TOPW); int* EPO = DRY ? WSP(int, WS_PR + 19 * MiB) : WSP(int, WS_EP);
    int* CNT = (int*)(A.ws + WS_CTL) + CW_CNT + (DRY ? 2 : l) * 256 * CNT_STRIDE;
    const float NEG = -__builtin_inff();
    const bool skipctx = l == DEPTH - 1;
    const f32x4 rb4 = *(const G1(f32x4)*)(A.in[25] + l * 256 + 4 * F.lane);
    constexpr int SLOTS = 9;
    for (int base = F.gw; base < MROWS; base += SLOTS * F.NGW) {
        f32x4 lg[SLOTS]; int es[SLOTS], ps[SLOTS]; float wt[SLOTS];
#pragma unroll
        for (int i = 0; i < SLOTS; ++i) { const int R = base + i * F.NGW; lg[i] = f32x4{0.f, 0.f, 0.f, 0.f}; es[i] = 0; ps[i] = 0; wt[i] = 0.f;
            if (R < MROWS && !(skipctx && (R % TPB) < CTX)) lg[i] = *(const G1(f32x4)*)(LG + (size_t)R * 256 + 4 * F.lane); }
#pragma unroll
        for (int i = 0; i < SLOTS; ++i) { const int R = base + i * F.NGW;
            if (R < MROWS && !(skipctx && (R % TPB) < CTX)) {
                const float sc[4] = {sigmoidf_(lg[i].x), sigmoidf_(lg[i].y), sigmoidf_(lg[i].z), sigmoidf_(lg[i].w)};
                const float bi[4] = {sc[0] + rb4.x, sc[1] + rb4.y, sc[2] + rb4.z, sc[3] + rb4.w};
                float t1 = fmaxf(bi[0], bi[1]), t2 = fminf(bi[0], bi[1]);
                { const float u1 = fmaxf(bi[2], bi[3]), u2 = fminf(bi[2], bi[3]); const float n1 = fmaxf(t1, u1), n2 = fmaxf(fminf(t1, u1), fmaxf(t2, u2)); t1 = n1; t2 = n2; }
#define TK_M2(C) { const float o1 = dpp_f<C>(t1), o2 = dpp_f<C>(t2); const float n1 = fmaxf(t1, o1), n2 = fmaxf(fminf(t1, o1), fmaxf(t2, o2)); t1 = n1; t2 = n2; }
                TK_M2(0xB1) TK_M2(0x4E) TK_M2(0x141)
#undef TK_M2
                const float gs = t1 + t2; const int mygrp = F.lane >> 3; int rank = 0;
#pragma unroll
                for (int j = 0; j < 8; ++j) { const float sj = __uint_as_float(__builtin_amdgcn_readlane(__float_as_uint(gs), j * 8)); rank += (int)(sj > gs) | ((int)(sj == gs) & (int)(j < mygrp)); }
                const bool sel = rank < 4;
                float cand[4];
#pragma unroll
                for (int q = 0; q < 4; ++q) cand[q] = sel ? bi[q] : NEG;
                int my_e = 0; float my_s = 0.f, ssum = 0.f;
#pragma unroll
                for (int k = 0; k < 8; ++k) {
                    float bv = cand[0], bs = sc[0]; int bq = 0;
#pragma unroll
                    for (int q = 1; q < 4; ++q) { const bool g = cand[q] > bv; bv = g ? cand[q] : bv; bs = g ? sc[q] : bs; bq = g ? q : bq; }
                    const float mx = __uint_as_float(__builtin_amdgcn_readlane(__float_as_uint(wave_max63(bv)), 63));
                    const int ol = (int)__builtin_ctzll(__ballot(bv == mx));
                    const int oq = __builtin_amdgcn_readlane(bq, ol); const float sv = __uint_as_float(__builtin_amdgcn_readlane(__float_as_uint(bs), ol));
                    const bool me = F.lane == ol;
#pragma unroll
                    for (int q = 0; q < 4; ++q) cand[q] = (me & (oq == q)) ? NEG : cand[q];
                    ssum += sv;
                    { const int ev = 4 * ol + oq; asm volatile("v_writelane_b32 %0, %1, %2" : "+v"(my_e) : "s"(ev), "n"(k)); asm volatile("v_writelane_b32 %0, %1, %2" : "+v"(my_s) : "s"(sv), "n"(k)); }
                }
                es[i] = my_e; wt[i] = my_s * __builtin_amdgcn_rcpf(ssum) * 2.5f;
            } }
#pragma unroll
        for (int i = 0; i < SLOTS; ++i) { const int R = base + i * F.NGW;
            if (R < MROWS && !(skipctx && (R % TPB) < CTX) && F.lane < 8) ps[i] = __hip_atomic_fetch_add((G1(int)*)(CNT + es[i] * CNT_STRIDE), 1, __ATOMIC_RELAXED, __HIP_MEMORY_SCOPE_AGENT); }
#pragma unroll
        for (int i = 0; i < SLOTS; ++i) { const int R = base + i * F.NGW;
            if (R < MROWS && !(skipctx && (R % TPB) < CTX) && F.lane < 8) {
                *(G1(int)*)(LIST + (size_t)es[i] * LCAP + ps[i]) = R * 8 + F.lane; *(G1(float)*)(TOPW + (size_t)R * 8 + F.lane) = wt[i]; *(G1(int)*)(EPO + (size_t)R * 8 + F.lane) = es[i] * LCAP + ps[i]; } }
    }
}
__device__ __forceinline__ void ph_experts_naive(const Frame& F, const Args& A, int l) {
    const bf16* TOK = WSP(bf16, WS_TOK); const int* LIST = WSP(int, WS_LIST); const float* TOPW = WSP(float, WS_TOPW); float* YB = WSP(float, WS_YB);
    const int* CNT = (const int*)(A.ws + WS_CTL) + CW_CNT + l * 256 * CNT_STRIDE;
    LAS bf16* Xs = (LAS bf16*)F.lds;
    LAS float* Hs = (LAS float*)(F.lds + 65536);
    LAS int* pref = (LAS int*)(F.lds + 98304);
    LAS int* sPair = pref + 320; LAS float* sW = (LAS float*)(sPair + 32);
    __syncthreads();
    if (F.tid == 0) { int s = 0; for (int e = 0; e < 256; ++e) { pref[e] = s; s += (CNT[e] + 31) >> 5; } pref[256] = s; }
    __syncthreads();
    const int total = pref[256];
    for (int id = F.bid; id < total; id += F.G) {
        int lo = 0, hi = 255; while (lo < hi) { const int mid = (lo + hi + 1) >> 1; if (pref[mid] <= id) lo = mid; else hi = mid - 1; }
        const int e = lo, c = id - pref[e], n = min(32, CNT[e] - c * 32);
        __syncthreads();
        if (F.tid < 32) { const int pr = F.tid < n ? LIST[(size_t)e * LCAP + c * 32 + F.tid] : -1; sPair[F.tid] = pr; sW[F.tid] = pr >= 0 ? TOPW[pr] : 0.f; }
        __syncthreads();
        for (int pc = F.tid; pc < 4096; pc += 512) { const int row = pc >> 7, c8 = (pc & 127) * 8, pr = sPair[row];
            v4u v = {0u, 0u, 0u, 0u}; if (pr >= 0) v = *(const v4u*)(TOK + (size_t)(pr >> 3) * 1024 + c8);
            *(LAS v4u*)(Xs + row * 1024 + c8) = v; }
        __syncthreads();
        { const int f = F.tid & 255, gu = F.tid >> 8; const float* W = (gu ? A.in[27] : A.in[26]) + ((size_t)(l * 256 + e) * 1024) * 256 + f;
          float acc[32];
#pragma unroll
          for (int r = 0; r < 32; ++r) acc[r] = 0.f;
          for (int k = 0; k < 1024; ++k) { const float w = W[(size_t)k * 256];
#pragma unroll
              for (int r = 0; r < 32; ++r) acc[r] += bf2f(Xs[r * 1024 + k]) * w; }
          if (gu == 0) {
#pragma unroll
              for (int r = 0; r < 32; ++r) Hs[r * 256 + f] = siluf_(acc[r]); }
          __syncthreads();
          if (gu == 1) {
#pragma unroll
              for (int r = 0; r < 32; ++r) Hs[r * 256 + f] *= acc[r]; }
          __syncthreads(); }
        { const float* Wd = A.in[28] + ((size_t)(l * 256 + e) * 256) * 1024 + F.tid;
          float a0[32], a1[32];
#pragma unroll
          for (int r = 0; r < 32; ++r) { a0[r] = 0.f; a1[r] = 0.f; }
          for (int k = 0; k < 256; ++k) { const float w0 = Wd[(size_t)k * 1024], w1 = Wd[(size_t)k * 1024 + 512];
#pragma unroll
              for (int r = 0; r < 32; ++r) { const float hv = Hs[r * 256 + k]; a0[r] += hv * w0; a1[r] += hv * w1; } }
#pragma unroll
          for (int r = 0; r < 32; ++r) { const int pr = sPair[r]; if (pr >= 0) { const float w = sW[r]; YB[(size_t)pr * 1024 + F.tid] = a0[r] * w; YB[(size_t)pr * 1024 + 512 + F.tid] = a1[r] * w; } } }
    }
}
struct TrItem { const float* W; bf16* WT; int ldw, k0, n0, ldwt, rowbase; };
__device__ __forceinline__ void tr_load(const TrItem& t, f32x4 (&v)[8], int lane) {
    const int rr = lane >> 3, c4 = (lane & 7) * 4;
#pragma unroll
    for (int i = 0; i < 8; ++i) v[i] = __builtin_nontemporal_load((const f32x4*)(t.W + (size_t)(t.k0 + 8 * i + rr) * t.ldw + t.n0 + c4));
}
__device__ __forceinline__ void tr_load_a(const TrItem& t, f32x4 (&v)[8], int lane) {
    const int rr = lane >> 3, c4 = (lane & 7) * 4;
#pragma unroll
    for (int i = 0; i < 8; ++i) { const float* p = t.W + (size_t)(t.k0 + 8 * i + rr) * t.ldw + t.n0 + c4; asm volatile("global_load_dwordx4 %0, %1, off nt" : "=v"(v[i]) : "v"(p) : "memory"); }
}
__device__ __forceinline__ void tr_store(const TrItem& t, const f32x4 (&v)[8], LAS float* scr, int lane) {
    const int rr = lane >> 3, c4 = (lane & 7) * 4;
#pragma unroll
    for (int i = 0; i < 8; ++i) { LAS float* d = scr + (8 * i + rr) * 33 + c4; d[0] = v[i].x; d[1] = v[i].y; d[2] = v[i].z; d[3] = v[i].w; }
    LDS_WAIT(); asm volatile("" ::: "memory");
    const int c = lane & 7;
#pragma unroll
    for (int j = 0; j < 4; ++j) { const int n = (lane >> 3) + 8 * j; const LAS float* sp = scr + (8 * c) * 33 + n;
        v4u o; o.x = pk2(sp[0 * 33], sp[1 * 33]); o.y = pk2(sp[2 * 33], sp[3 * 33]); o.z = pk2(sp[4 * 33], sp[5 * 33]); o.w = pk2(sp[6 * 33], sp[7 * 33]);
        __builtin_nontemporal_store(o, (v4u*)(t.WT + (size_t)(t.rowbase + n) * t.ldwt + t.k0 + 8 * c)); }
    LDS_WAIT(); asm volatile("" ::: "memory");
}
__device__ __forceinline__ TrItem expert_item(const Args& A, int l, int it) {
    const int e = it / 384, r = it % 384; bf16* E1 = (bf16*)(A.ws + EWL(l) + (size_t)e * EW_STRIDE); TrItem t;
    if (r < 256) { const int up = r >> 7, q = r & 127, kb = q >> 3, nb = q & 7, n0 = 32 * nb;
        t.W = (up ? A.in[27] : A.in[26]) + ((size_t)(l * 256 + e) * 1024) * 256; t.ldw = 256; t.k0 = 64 * kb; t.n0 = n0; t.WT = E1; t.ldwt = 1024; t.rowbase = (n0 >> 7) * 256 + up * 128 + (n0 & 127); }
    else { const int q = r - 256, kb = q >> 5, nb = q & 31;
        t.W = A.in[28] + ((size_t)(l * 256 + e) * 256) * 1024; t.ldw = 1024; t.k0 = 64 * kb; t.n0 = 32 * nb; t.WT = E1 + 512 * 1024; t.ldwt = 256; t.rowbase = 32 * nb; }
    return t;
}
__device__ __forceinline__ void ph_expert_w_idx(const Frame& F, const Args& A, int l, int lo, int hi, int ci, int nblk) {
    if (ci < 0 || ci >= nblk) return;
    LAS float* scr = (LAS float*)(F.lds + F.wave * 16384);
    const int stride = nblk * NWAVES; int it = lo + ci * NWAVES + F.wave; if (it >= hi) return;
    f32x4 va[8], vb[8], vc[8]; TrItem ta = expert_item(A, l, it), tb = ta, tc = ta;
    tr_load_a(ta, va, F.lane);
    if (it + stride < hi) { tb = expert_item(A, l, it + stride); tr_load_a(tb, vb, F.lane); }
#define EW_STEP(TP, VP, TS, VS) { if (it + 2 * stride < hi) { TP = expert_item(A, l, it + 2 * stride); tr_load_a(TP, VP, F.lane); asm volatile("s_waitcnt vmcnt(16)" ::: "memory"); } \
        else asm volatile("s_waitcnt vmcnt(0)" ::: "memory"); \
        tr_store(TS, VS, scr, F.lane); it += stride; if (it >= hi) break; }
    for (;;) {
        EW_STEP(tc, vc, ta, va)
        EW_STEP(ta, va, tb, vb)
        EW_STEP(tb, vb, tc, vc)
    }
#undef EW_STEP
}
__device__ __forceinline__ void ph_expert_w(const Frame& F, const Args& A, int l, int lo, int hi, int blk0, int nblk) { ph_expert_w_idx(F, A, l, lo, hi, F.bid - blk0, nblk); }
constexpr int EWI_N = 256 * 384, EWI_A = 9800, EWI_B = 20800, EWI_C = 75000, EWI_D = 90000;
constexpr int KCONV_WIN = 18, KCONV_LRU = 44, KCONV_D = 124;
constexpr int KCONV_RS = 58, Q13 = 12, Q15 = 72, Q16 = 48;
__device__ __forceinline__ int moe_geff(int units, int G) { if (units <= 0) return G; const int rounds = (units + G - 1) / G; return (units + rounds - 1) / rounds; }
constexpr int MOE_MAXU = 11;
struct MoeSched {
    const LAS int* pref; const LAS int* cnt; const int* list; const char* abase; const char* bbase; int npn, G, c, lda2; size_t b_pn_stride; bool gather; LAS int* idx;
    __device__ __forceinline__ bool next(int i, pg8::UnitG& U) const {
        const long id = (long)i * G + c; const int total = pref[256]; if (id >= (long)total * npn) return false;
        const int tau = (int)(id / npn), pn = (int)(id % npn);
        int lo = 0, hi = 255; while (lo < hi) { const int mid = (lo + hi + 1) >> 1; if (pref[mid] <= tau) lo = mid; else hi = mid - 1; }
        const int e = lo, t = tau - pref[e];
        U.e = e; U.pn = pn; U.valid = min(256, cnt[e] - t * 256); U.rows = list + (size_t)e * LCAP + t * 256; U.row0 = tau * 256; U.lrows = idx ? idx + (i % MOE_MAXU) * 256 : nullptr;
        U.a = gather ? abase : abase + (size_t)tau * 256 * lda2; U.b = bbase + (size_t)e * EW_STRIDE + (size_t)pn * b_pn_stride; return true;
    }
};
__device__ __forceinline__ void moe_prefix(const Frame& F, const int* CNT, LAS int* pref) {
    LAS int* tmp = pref + 320;
    __syncthreads();
    if (F.tid < 256) tmp[F.tid] = CNT[F.tid * CNT_STRIDE];
    __syncthreads();
    if (F.tid <= 256) { int sum = 0; for (int e = 0; e < F.tid; ++e) sum += (tmp[e] + 255) >> 8; pref[F.tid] = sum; }
    __syncthreads();
}
struct EpiSwiGLU {
    static constexpr bool PERM = true;
    bf16* HB;
    __device__ __forceinline__ void operator()(const f32x4 (&acc)[2][2][4][2], const pg8::UnitG& u, int wr, int wc, int fr, int fq) const {
#pragma unroll
        for (int ai = 0; ai < 2; ++ai)
#pragma unroll
            for (int m = 0; m < 4; ++m) { const int r = ai * 128 + wr * 64 + m * 16 + fr;
                const f32x4 g0 = acc[ai][0][m][0], g1 = acc[ai][0][m][1], u0 = acc[ai][1][m][0], u1 = acc[ai][1][m][1];
                v4u w; w.x = pk2(siluf_(g0[0]) * u0[0], siluf_(g0[1]) * u0[1]); w.y = pk2(siluf_(g0[2]) * u0[2], siluf_(g0[3]) * u0[3]);
                w.z = pk2(siluf_(g1[0]) * u1[0], siluf_(g1[1]) * u1[1]); w.w = pk2(siluf_(g1[2]) * u1[2], siluf_(g1[3]) * u1[3]);
                *(v4u*)(HB + (size_t)(u.row0 + r) * 256 + u.pn * 128 + wc * 32 + 8 * fq) = w; }
    }
};
struct EpiScatter {
    static constexpr bool PERM = true;
    bf16* Y;
    __device__ __forceinline__ void operator()(const f32x4 (&acc)[2][2][4][2], const pg8::UnitG& u, int wr, int wc, int fr, int fq) const {
#pragma unroll
        for (int ai = 0; ai < 2; ++ai)
#pragma unroll
            for (int m = 0; m < 4; ++m) { const int r = ai * 128 + wr * 64 + m * 16 + fr;
                if (r < u.valid) { bf16* dst = Y + (size_t)(u.row0 + r) * 1024 + u.pn * 256 + wc * 32 + 8 * fq;
#pragma unroll
                    for (int bj = 0; bj < 2; ++bj) { const f32x4 v0 = acc[ai][bj][m][0], v1 = acc[ai][bj][m][1];
                        v4u o; o.x = pk2(v0[0], v0[1]); o.y = pk2(v0[2], v0[3]); o.z = pk2(v1[0], v1[1]); o.w = pk2(v1[2], v1[3]);
                        *(v4u*)(dst + bj * 128) = o; } } }
    }
};
__device__ __forceinline__ int conv_base(const Frame& F, const Args& A, int l) {
    if (l == 0) return 0;
    const int* CNT = (const int*)(A.ws + WS_CTL) + CW_CNT + (l - 1) * 256 * CNT_STRIDE; LAS int* pref = (LAS int*)(F.lds + RING_BYTES + 1024);
    moe_prefix(F, CNT, pref);
    const int tiles = pref[256], k15 = F.G - moe_geff(2 * tiles, F.G), k16 = F.G - moe_geff(4 * tiles, F.G);
    int base = KCONV_RS * NWAVES * Q13 + k15 * NWAVES * Q15 + k16 * NWAVES * Q16;
    __syncthreads();
    return base < EWI_N ? base : EWI_N;
}
__device__ __forceinline__ void ph_experts_up(const Frame& F, const Args& A, int l) {
    const int* CNT = (const int*)(A.ws + WS_CTL) + CW_CNT + l * 256 * CNT_STRIDE; LAS int* pref = (LAS int*)(F.lds + RING_BYTES + 1024);
    moe_prefix(F, CNT, pref);
    const int vcu = (F.G % 8 == 0) ? (F.bid % 8) * (F.G / 8) + F.bid / 8 : F.bid;
    const bool early = l + 1 < DEPTH; const int tiles = pref[256], Ge = early ? moe_geff(2 * tiles, F.G) : F.G;
    if (vcu < Ge) {
        LAS int* idx = (LAS int*)(F.lds + RING_BYTES + 4608);
        MoeSched S{pref, pref + 320, WSP(int, WS_LIST), (const char*)WSP(bf16, WS_TOK), (const char*)(A.ws + EWL(l)), 2, Ge, vcu, 2048, (size_t)256 * 1024 * 2, true, idx};
        { int vals[MOE_MAXU];
#pragma unroll
          for (int i = 0; i < MOE_MAXU; ++i) { pg8::UnitG U; vals[i] = 0; if (S.next(i, U) && F.tid < 256) vals[i] = *(const G1(int)*)(U.rows + min(F.tid, U.valid - 1)); }
#pragma unroll
          for (int i = 0; i < MOE_MAXU; ++i) if (F.tid < 256) idx[i * 256 + F.tid] = vals[i]; }
        __syncthreads();
        EpiSwiGLU E{WSP(bf16, WS_HB)};
        pg8::gemm_phase_g<EpiSwiGLU, MoeSched, true>(F.lds, 1024, 1024, 1024, S, E);
    } else { const int k = F.G - Ge, lo = KCONV_RS * NWAVES * Q13; ph_expert_w_idx(F, A, l + 1, lo, min(EWI_N, lo + k * NWAVES * Q15), vcu - Ge, k); }
    __syncthreads();
}
__device__ __forceinline__ void ph_experts_down(const Frame& F, const Args& A, int l) {
    const int* CNT = (const int*)(A.ws + WS_CTL) + CW_CNT + l * 256 * CNT_STRIDE; LAS int* pref = (LAS int*)(F.lds + RING_BYTES + 1024);
    moe_prefix(F, CNT, pref);
    const int vcu = (F.G % 8 == 0) ? (F.bid % 8) * (F.G / 8) + F.bid / 8 : F.bid;
    const bool early = l + 1 < DEPTH; const int tiles = pref[256], Ge = early ? moe_geff(4 * tiles, F.G) : F.G;
    if (vcu < Ge) {
        MoeSched S{pref, pref + 320, WSP(int, WS_LIST), (const char*)WSP(bf16, WS_HB), (const char*)(A.ws + EWL(l) + 512 * 1024 * 2), 4, Ge, vcu, 512, (size_t)256 * 256 * 2, false, nullptr};
        EpiScatter E{WSP(bf16, WS_Y16)};
        pg8::gemm_phase_g<EpiScatter, MoeSched, false>(F.lds, 256, 256, 256, S, E);
    } else { const int k = F.G - Ge, k15 = F.G - moe_geff(2 * tiles, F.G), lo = KCONV_RS * NWAVES * Q13 + k15 * NWAVES * Q15;
        ph_expert_w_idx(F, A, l + 1, min(EWI_N, lo), min(EWI_N, lo + k * NWAVES * Q16), vcu - Ge, k); }
}
template <bool DRY = false> __device__ __forceinline__ void ph_combine(const Frame& F, const Args& A, int l) {
    const float* X = WSP(float, WS_XALL); float* XO = DRY ? WSP(float, WS_U + 492 * MiB) : WSP(float, WS_XALL); bf16* HO = DRY ? WSP(bf16, WS_U + 558 * MiB) : WSP(bf16, WS_H); const bf16* SD = WSP(bf16, WS_SD); const bf16* YS = WSP(bf16, WS_Y16); const int* EP = WSP(int, WS_EP); const float* TOPW = WSP(float, WS_TOPW);
    const int* CNT = (const int*)(A.ws + WS_CTL) + CW_CNT + l * 256 * CNT_STRIDE; LAS int* pref = (LAS int*)(F.lds + RING_BYTES + 1024);
    moe_prefix(F, CNT, pref);
    for (int R = F.gw; R < MROWS; R += F.NGW) {
        const int b = R / TPB, p = R % TPB, s = (p < CTX) ? 2 : b; const float* g2 = MODP(l, s, 5);
        if (l == DEPTH - 1 && p < CTX) continue;
        size_t so[8]; float wk[8];
#pragma unroll
        for (int k = 0; k < 8; ++k) { const int ep = EP[(size_t)R * 8 + k], e = ep / LCAP, pos = ep - e * LCAP; so[k] = ((size_t)pref[e] * 256 + pos) * 1024; wk[k] = TOPW[(size_t)R * 8 + k]; }
        v4u yv[2][8], sd[2]; f32x4 xin[2][2];
#pragma unroll
        for (int j = 0; j < 2; ++j) { const int c = 8 * F.lane + 512 * j;
#pragma unroll
            for (int k = 0; k < 8; ++k) yv[j][k] = *(const v4u*)(YS + so[k] + c);
            sd[j] = *(const v4u*)(SD + (size_t)R * 1024 + c);
            xin[j][0] = *(const f32x4*)(X + (size_t)R * 1024 + c); xin[j][1] = *(const f32x4*)(X + (size_t)R * 1024 + c + 4); }
        float xo[2][8]; float ss = 0.f;
#pragma unroll
        for (int j = 0; j < 2; ++j) { const int c = 8 * F.lane + 512 * j; float f[8] = {bf2f(sd[j].x & 0xffffu), bf2f(sd[j].x >> 16), bf2f(sd[j].y & 0xffffu), bf2f(sd[j].y >> 16), bf2f(sd[j].z & 0xffffu), bf2f(sd[j].z >> 16), bf2f(sd[j].w & 0xffffu), bf2f(sd[j].w >> 16)};
#pragma unroll
            for (int k = 0; k < 8; ++k) { const unsigned ws[4] = {yv[j][k].x, yv[j][k].y, yv[j][k].z, yv[j][k].w};
#pragma unroll
                for (int q = 0; q < 4; ++q) { f[2 * q] += wk[k] * bf2f(ws[q] & 0xffffu); f[2 * q + 1] += wk[k] * bf2f(ws[q] >> 16); } }
            const f32x4 ga = *(const f32x4*)(g2 + c), gb = *(const f32x4*)(g2 + c + 4);
            const f32x4 xa = xin[j][0] + ga * (f32x4){f[0], f[1], f[2], f[3]}, xb = xin[j][1] + gb * (f32x4){f[4], f[5], f[6], f[7]};
            if (l + 1 < DEPTH || DRY) { *(f32x4*)(XO + (size_t)R * 1024 + c) = xa; *(f32x4*)(XO + (size_t)R * 1024 + c + 4) = xb; }
            if (l == DEPTH - 1 && !DRY) { *(f32x4*)(A.out + ((size_t)b * SEQ + (p - CTX)) * 1024 + c) = xa; *(f32x4*)(A.out + ((size_t)b * SEQ + (p - CTX)) * 1024 + c + 4) = xb; }
            xo[j][0] = xa.x; xo[j][1] = xa.y; xo[j][2] = xa.z; xo[j][3] = xa.w; xo[j][4] = xb.x; xo[j][5] = xb.y; xo[j][6] = xb.z; xo[j][7] = xb.w;
#pragma unroll
            for (int e = 0; e < 8; ++e) ss += xo[j][e] * xo[j][e]; }
        if (l + 1 < DEPTH || DRY) {
            const int ln = DRY ? 0 : l + 1; const float rs = rsqrtf(wave_sum(ss) * (1.f / 1024.f) + EPS);
            const float* gn = A.in[6] + ln * 1024; const float* sc1 = MODP(ln, s, 1); const float* sh1 = MODP(ln, s, 0);
#pragma unroll
            for (int j = 0; j < 2; ++j) { const int c = 8 * F.lane + 512 * j; float y[8];
#pragma unroll
                for (int h = 0; h < 2; ++h) { const f32x4 gg = *(const f32x4*)(gn + c + 4 * h), s1 = *(const f32x4*)(sc1 + c + 4 * h), s0 = *(const f32x4*)(sh1 + c + 4 * h);
                    y[4 * h] = xo[j][4 * h] * rs * gg.x * (1.f + s1.x) + s0.x; y[4 * h + 1] = xo[j][4 * h + 1] * rs * gg.y * (1.f + s1.y) + s0.y;
                    y[4 * h + 2] = xo[j][4 * h + 2] * rs * gg.z * (1.f + s1.z) + s0.z; y[4 * h + 3] = xo[j][4 * h + 3] * rs * gg.w * (1.f + s1.w) + s0.w; }
                v4u o; o.x = pk2(y[0], y[1]); o.y = pk2(y[2], y[3]); o.z = pk2(y[4], y[5]); o.w = pk2(y[6], y[7]);
                *(v4u*)(HO + (size_t)R * 1024 + c) = o; } }
    }
}

struct EpiWin {
    static constexpr bool PERM = true; static constexpr int MIDK = 0;
    bf16 *Kb, *Vb, *Qb, *LXb, *GLG, *ZP, *GT; const float* qg; const float* kg;
    __device__ __forceinline__ void operator()(const f32x4 (&acc)[2][2][4][2], const pg8::Unit& u, int wr, int wc, int fr, int fq) const {
        const int pn = u.pn, sec = pn >> 2;
        if (sec == 0 || sec == 3) {
            const bool isq = sec == 3; const bool lat = (u.pm % 33) != 0;
            bf16* dst = (isq ? Qb : Kb) + (pn & 3) * 256 + wc * 64 + 4 * fq; const float* gn = isq ? qg : kg; const float gs = isq ? QSCALE : 1.f;
            f32x4 g[2][2]; float invf[4];
#pragma unroll
            for (int bj = 0; bj < 2; ++bj)
#pragma unroll
                for (int n = 0; n < 2; ++n) g[bj][n] = *(const f32x4*)(gn + 32 * bj + 16 * n + 4 * fq) * gs;
#pragma unroll
            for (int e = 0; e < 4; ++e) invf[e] = exp2f(-(float)(4 * fq + e) * (13.287712379549449f / 16.f)) * 0.15915494309189535f;
#pragma unroll
            for (int ai = 0; ai < 2; ++ai)
#pragma unroll
                for (int m = 0; m < 4; ++m) { const int R = u.pm * 256 + ai * 128 + wr * 64 + m * 16 + fr, t = (R % TPB) - CTX;
                    float ss = 0.f;
#pragma unroll
                    for (int bj = 0; bj < 2; ++bj)
#pragma unroll
                        for (int n = 0; n < 2; ++n) { const f32x4 v = acc[ai][bj][m][n]; ss += (v[0] * v[0] + v[1] * v[1]) + (v[2] * v[2] + v[3] * v[3]); }
                    ss += sx<16>(ss); ss += sx<32>(ss);
                    const float rs = rsqrtf(ss * (1.f / 64.f) + EPS);
#pragma unroll
                    for (int bj = 0; bj < 2; ++bj) { const float pos = (float)(bj ? (t & 63) : (t >> 6));
                        const f32x4 y1 = acc[ai][bj][m][0] * rs * g[bj][0], y2 = acc[ai][bj][m][1] * rs * g[bj][1]; f32x4 o1 = y1, o2 = y2;
                        if (lat) {
#pragma unroll
                            for (int e = 0; e < 4; ++e) { const float rev = pos * invf[e]; const float cs = __builtin_amdgcn_cosf(rev), sn = __builtin_amdgcn_sinf(rev);
                                o1[e] = y1[e] * cs - y2[e] * sn; o2[e] = y1[e] * sn + y2[e] * cs; } }
                        bf16* p = dst + (size_t)R * 1024 + 32 * bj;
                        *(unsigned long long*)p = (unsigned long long)pk2(o1[0], o1[1]) | ((unsigned long long)pk2(o1[2], o1[3]) << 32);
                        *(unsigned long long*)(p + 16) = (unsigned long long)pk2(o2[0], o2[1]) | ((unsigned long long)pk2(o2[2], o2[3]) << 32); }
                    asm volatile("" ::: "memory"); }
        } else {
            bf16* base; int ld = 1024, act = 0;
            if (sec == 1) base = Vb + (pn & 3) * 256; else if (sec == 2) base = LXb + (pn & 3) * 256; else if (sec == 4) { base = GLG + (pn & 3) * 256; act = 1; }
            else if (sec == 5) base = ZP + (pn & 3) * 256; else { base = GT + (pn - 24) * 256; ld = 3072; act = 2; }
            base += wc * 32 + 8 * fq;
#pragma unroll
            for (int ai = 0; ai < 2; ++ai)
#pragma unroll
                for (int m = 0; m < 4; ++m) { bf16* rowp = base + (size_t)(u.pm * 256 + ai * 128 + wr * 64 + m * 16 + fr) * ld;
#pragma unroll
                    for (int bj = 0; bj < 2; ++bj) { f32x4 v0 = acc[ai][bj][m][0], v1 = acc[ai][bj][m][1];
                        if (act == 1) {
#pragma unroll
                            for (int e = 0; e < 4; ++e) { v0[e] = gelu_tanh(v0[e]); v1[e] = gelu_tanh(v1[e]); } }
                        else if (act == 2) {
#pragma unroll
                            for (int e = 0; e < 4; ++e) { v0[e] = sigmoidf_(v0[e]); v1[e] = sigmoidf_(v1[e]); } }
                        v4u o; o.x = pk2(v0[0], v0[1]); o.y = pk2(v0[2], v0[3]); o.z = pk2(v1[0], v1[1]); o.w = pk2(v1[2], v1[3]);
                        *(v4u*)(rowp + bj * 128) = o; } }
        }
    }
};

struct EpiMix {
    static constexpr bool PERM = true; static constexpr int MIDK = 16;
    const bf16* GT; bf16* MD;
    __device__ __forceinline__ void mid(f32x4 (&acc)[2][2][4][2], const pg8::Unit& u, int wr, int wc, int fr, int fq, int seg) const {
        const bf16* gb = GT + (size_t)(u.pm * 256 + wr * 64 + fr) * 3072 + (seg - 1) * 1024 + u.pn * 256 + wc * 32 + 8 * fq;
#pragma unroll
        for (int ai = 0; ai < 2; ++ai)
#pragma unroll
            for (int m = 0; m < 4; ++m)
#pragma unroll
                for (int bj = 0; bj < 2; ++bj) { const bf16* p = gb + (size_t)(ai * 128 + m * 16) * 3072 + bj * 128;
                    const v4u a = *(const v4u*)p, b = *(const v4u*)(p + 1024);
                    const unsigned aw[4] = {a.x, a.y, a.z, a.w}, bw[4] = {b.x, b.y, b.z, b.w};
#pragma unroll
                    for (int q = 0; q < 4; ++q) { const float r0 = bf2f(aw[q] & 0xffffu) * __builtin_amdgcn_rcpf(fmaxf(bf2f(bw[q] & 0xffffu), 1e-30f)), r1 = bf2f(aw[q] >> 16) * __builtin_amdgcn_rcpf(fmaxf(bf2f(bw[q] >> 16), 1e-30f));
                        acc[ai][bj][m][q >> 1][(q & 1) * 2] *= r0; acc[ai][bj][m][q >> 1][(q & 1) * 2 + 1] *= r1; } }
    }
    __device__ __forceinline__ void operator()(const f32x4 (&acc)[2][2][4][2], const pg8::Unit& u, int wr, int wc, int fr, int fq) const {
        const size_t r0 = (size_t)(u.pm * 256 + wr * 64 + fr); const int c0 = u.pn * 256 + wc * 32 + 8 * fq;
#pragma unroll
        for (int ai = 0; ai < 2; ++ai)
#pragma unroll
            for (int m = 0; m < 4; ++m)
#pragma unroll
                for (int bj = 0; bj < 2; ++bj) { const size_t R = r0 + ai * 128 + m * 16; const v4u gv = *(const v4u*)(GT + R * 3072 + 2048 + c0 + bj * 128);
                    const f32x4 v0 = acc[ai][bj][m][0], v1 = acc[ai][bj][m][1]; v4u o;
                    o.x = pk2(v0[0] * bf2f(gv.x & 0xffffu), v0[1] * bf2f(gv.x >> 16)); o.y = pk2(v0[2] * bf2f(gv.y & 0xffffu), v0[3] * bf2f(gv.y >> 16));
                    o.z = pk2(v1[0] * bf2f(gv.z & 0xffffu), v1[1] * bf2f(gv.z >> 16)); o.w = pk2(v1[2] * bf2f(gv.w & 0xffffu), v1[3] * bf2f(gv.w >> 16));
                    *(v4u*)(MD + R * 1024 + c0 + bj * 128) = o; }
    }
};
struct EpiResid {
    static constexpr bool PERM = false; static constexpr int MIDK = 0;
    float* X; const float* mod;
    const float* Xin; const float* Cin;
    __device__ __forceinline__ void operator()(const f32x4 (&acc)[2][2][4][2], const pg8::Unit& u, int wr, int wc, int fr, int fq) const {
        const int src = (u.pm % 33 == 0) ? 2 : u.pm / 33; const float* g1 = mod + src * 6144 + 2 * 1024;
        const float* sbase = Xin ? ((u.pm % 33 == 0) ? Cin + (size_t)(u.pm / 33) * CTX * 1024 : Xin + ((size_t)(u.pm / 33) * SEQ + (size_t)(u.pm % 33 - 1) * 256) * 1024) : X + (size_t)u.pm * 256 * 1024;
        const int col0 = u.pn * 256 + wc * 32 + 4 * fq;
        f32x4 gv[2][2];
#pragma unroll
        for (int bj = 0; bj < 2; ++bj)
#pragma unroll
            for (int n = 0; n < 2; ++n) gv[bj][n] = *(const f32x4*)(g1 + col0 + bj * 128 + n * 16);
#pragma unroll
        for (int ai = 0; ai < 2; ++ai)
#pragma unroll
            for (int m = 0; m < 4; ++m) { const size_t ro = (size_t)(ai * 128 + wr * 64 + m * 16 + fr) * 1024 + col0; float* rowp = X + (size_t)u.pm * 256 * 1024 + ro; const float* srow = sbase + ro;
#pragma unroll
                for (int bj = 0; bj < 2; ++bj)
#pragma unroll
                    for (int n = 0; n < 2; ++n) { *(f32x4*)(rowp + bj * 128 + n * 16) = *(const f32x4*)(srow + bj * 128 + n * 16) + gv[bj][n] * acc[ai][bj][m][n]; } }
    }
};
struct EpiRS {
    static constexpr bool PERM = true; static constexpr int MIDK = 0;
    float* LG; bf16* SH;
    __device__ __forceinline__ void operator()(const f32x4 (&acc)[2][2][4][2], const pg8::Unit& u, int wr, int wc, int fr, int fq) const {
#pragma unroll
        for (int ai = 0; ai < 2; ++ai)
#pragma unroll
            for (int m = 0; m < 4; ++m) { const size_t R = (size_t)u.pm * 256 + ai * 128 + wr * 64 + m * 16 + fr;
                if (u.pn == 0) {
#pragma unroll
                    for (int bj = 0; bj < 2; ++bj) { float* p = LG + R * 256 + bj * 128 + wc * 32 + 8 * fq; *(f32x4*)p = acc[ai][bj][m][0]; *(f32x4*)(p + 4) = acc[ai][bj][m][1]; } }
                else { const f32x4 g0 = acc[ai][0][m][0], g1 = acc[ai][0][m][1], u0 = acc[ai][1][m][0], u1 = acc[ai][1][m][1];
                    v4u w; w.x = pk2(siluf_(g0[0]) * u0[0], siluf_(g0[1]) * u0[1]); w.y = pk2(siluf_(g0[2]) * u0[2], siluf_(g0[3]) * u0[3]);
                    w.z = pk2(siluf_(g1[0]) * u1[0], siluf_(g1[1]) * u1[1]); w.w = pk2(siluf_(g1[2]) * u1[2], siluf_(g1[3]) * u1[3]);
                    *(v4u*)(SH + R * 256 + (u.pn - 1) * 128 + wc * 32 + 8 * fq) = w; } }
    }
};
__device__ __forceinline__ void ph_norm2(const Frame& F, const Args& A, int l) {
    const float* X = WSP(float, WS_XALL); bf16* TOK = WSP(bf16, WS_TOK);
    for (int R = F.gw; R < MROWS; R += F.NGW) {
        const int b = R / TPB, p = R % TPB, s = (p < CTX) ? 2 : b;
        if (l == DEPTH - 1 && p < CTX) continue;
        f32x4 v[4];
#pragma unroll
        for (int j = 0; j < 4; ++j) v[j] = *(const f32x4*)(X + (size_t)R * 1024 + 4 * F.lane + 256 * j);
        norm_mod_row(v, A.in[23] + l * 1024, MODP(l, s, 4), MODP(l, s, 3), TOK + (size_t)R * 1024, F.lane);
    }
}

constexpr int PH_PER_L = 18, N_PHASES = 1 + DEPTH * PH_PER_L;
template <int P, bool DRY = false> __device__ __forceinline__ void run_phase(const Frame& F, const Args& A, int l) {
    if constexpr (P == -1) ph_prologue(F, A);
    if constexpr (P == 0) ph_norm1(F, A, l);
#if !FAST_WIN
#error oracle w_in path removed
#endif
    if constexpr (P == 1) { const int Ge = F.G - KCONV_WIN; const int cb = conv_base(F, A, l);
        if (F.bid < Ge) { pg8::Gemm g{WSP(bf16, WS_H), WLP(l, WO_WIN), MROWS, INW, 1024, 1024, 1024}; pg8::StaticOrder S; S.init(MROWS, INW, Ge, F.bid);
            EpiWin E{WSP(bf16, WS_KB), WSP(bf16, WS_VB), WSP(bf16, WS_QB), WSP(bf16, WS_LXB), WSP(bf16, WS_GLG), WSP(bf16, WS_ZP), WSP(bf16, WS_GATES), A.in[8] + l * 64, A.in[9] + l * 64};
            pg8::gemm_phase(F.lds, g, S, E); }
        else ph_expert_w(F, A, l, min(EWI_N, cb), min(EWI_N, cb + EWI_A), Ge, KCONV_WIN); }
    if constexpr (P == 3) { ph_conv(F, A, l); ph_fft_t1_fast(F, A);
        { const int cb = conv_base(F, A, l); ph_expert_w(F, A, l, min(EWI_N, cb + (l == 0 ? EWI_D : EWI_B)), EWI_N, 0, F.G); } }
    if constexpr (P == 4) {
        { const int cb = conv_base(F, A, l);
          if (F.bid < F.G - KCONV_LRU) ph_lru_gemm(F, A, l, F.G - KCONV_LRU); else ph_expert_w(F, A, l, min(EWI_N, cb + EWI_A), min(EWI_N, cb + EWI_B), F.G - KCONV_LRU, KCONV_LRU); }
        __syncthreads();
#if FAST_FFT_A
        ph_fft_a_gemm(F, A);
#else
        ph_fft_a(F, A);
#endif
        ph_fft_c(F, A);
    }
    if constexpr (P == 5) {
        ph_scan1(F, A);
#if FAST_FFT_B
        ph_fft_b_gemm(F, A);
#else
        ph_fft_b(F, A);
#endif
    }
    if constexpr (P == 6) { ph_scan2_fast(F, A); ph_fft_t2_fast(F, A); }
    if constexpr (P == 7) { ph_scan3(F, A);
#if FAST_ATTN
        ph_attn(F, A, l);
#endif
    }
    if constexpr (P == 8) {
#if !FAST_ATTN
        ph_attn_naive(F, A, l);
#endif
        __syncthreads(); }
#if FAST_MIX
    if constexpr (P == 9) { const bool sp = (l == 0) && F.G > 2 * KCONV_D; const int Ge = sp ? F.G - KCONV_D : F.G;
        if (F.bid < Ge) { pg8::Gemm g{WSP(bf16, WS_MIXIN), WLP(l, WO_D1), MROWS, 1024, 3072, 3072, 3072}; pg8::StaticOrder S; S.init(MROWS, 1024, Ge, F.bid, l == DEPTH - 1);
            EpiMix E{WSP(bf16, WS_GATES), WSP(bf16, WS_MIXED)}; pg8::gemm_phase(F.lds, g, S, E); }
        else ph_expert_w(F, A, l, EWI_B, EWI_C, Ge, KCONV_D); }
    if constexpr (P == 11) { const bool sp = (l == 0) && F.G > 2 * KCONV_D; const int Ge = sp ? F.G - KCONV_D : F.G;
        if (F.bid < Ge) { pg8::Gemm g{WSP(bf16, WS_MIXED), WLP(l, WO_OUT), MROWS, 1024, 1024, 1024, 1024}; pg8::StaticOrder S; S.init(MROWS, 1024, Ge, F.bid, l == DEPTH - 1);
            EpiResid E{WSP(float, WS_XALL), (const float*)(A.ws + WS_CTL) + CW_MOD + l * 3 * 6144, l == 0 ? A.in[0] : nullptr, l == 0 ? A.in[2] : nullptr}; pg8::gemm_phase(F.lds, g, S, E); }
        else ph_expert_w(F, A, l, EWI_C, EWI_D, Ge, KCONV_D); }
    if constexpr (P == 12) ph_norm2(F, A, l);
#else
    if constexpr (P == 9) {
        { pg8::Gemm g{WSP(bf16, WS_MIXIN), WLP(l, WO_D1), MROWS, 1024, 1024, 3072, 3072}; pg8::StaticOrder S; S.init(MROWS, 1024, F.G, F.bid); pg8::EpiF32 E{WSP(float, WS_PA), 1024}; pg8::gemm_phase(F.lds, g, S, E); }
        { pg8::Gemm g{WSP(bf16, WS_MIXIN) + 1024, WLP(l, WO_D1) + 1024, MROWS, 1024, 1024, 3072, 3072}; pg8::StaticOrder S; S.init(MROWS, 1024, F.G, F.bid); pg8::EpiF32 E{WSP(float, WS_PR), 1024}; pg8::gemm_phase(F.lds, g, S, E); }
        { pg8::Gemm g{WSP(bf16, WS_MIXIN) + 2048, WLP(l, WO_D1) + 2048, MROWS, 1024, 1024, 3072, 3072}; pg8::StaticOrder S; S.init(MROWS, 1024, F.G, F.bid); pg8::EpiF32 E{WSP(float, WS_PF), 1024}; pg8::gemm_phase(F.lds, g, S, E); } }
    if constexpr (P == 10) ph_mix(F, A);
    if constexpr (P == 11) { pg8::Gemm g{WSP(bf16, WS_MIXED), WLP(l, WO_OUT), MROWS, 1024, 1024, 1024, 1024}; pg8::StaticOrder S; S.init(MROWS, 1024, F.G, F.bid);
        pg8::EpiF32 E{WSP(float, WS_Y1), 1024}; pg8::gemm_phase(F.lds, g, S, E); }
    if constexpr (P == 12) ph_resid_norm2(F, A, l);
#endif
    if constexpr (P == 13) { const bool early = l + 1 < DEPTH; const int Ge = early ? F.G - KCONV_RS : F.G;
        if (F.bid < Ge) { pg8::Gemm g{WSP(bf16, WS_TOK), WLP(l, WO_R), MROWS, 768, 1024, 1024, 1024}; pg8::StaticOrder S; S.init(MROWS, 768, Ge, F.bid, l == DEPTH - 1);
            EpiRS E{WSP(float, WS_LOG), WSP(bf16, WS_SH)}; pg8::gemm_phase(F.lds, g, S, E); }
        else ph_expert_w(F, A, l + 1, 0, KCONV_RS * NWAVES * Q13, Ge, KCONV_RS); }
    if constexpr (P == 14) ph_topk<DRY>(F, A, l);
    if constexpr (P == 15) {
#if FAST_MOE
        ph_experts_up(F, A, l);
#else
        ph_experts_naive(F, A, l); __syncthreads();
#endif

        { pg8::Gemm g{WSP(bf16, WS_SH), WLP(l, WO_SD), MROWS, 1024, 256, 256, 256}; pg8::StaticOrder S; S.init(MROWS, 1024, F.G, F.bid, l == DEPTH - 1); EpiBf16U E{WSP(bf16, WS_SD), 1024}; pg8::gemm_phase(F.lds, g, S, E); } }
    if constexpr (P == 16) {
#if FAST_MOE
        ph_experts_down(F, A, l);
#endif
    }
    if constexpr (P == 17) ph_combine<DRY>(F, A, l);
}
__device__ __forceinline__ Frame make_frame(unsigned char* lds) {
    Frame F; F.lds = (LAS unsigned char*)lds; F.tid = otid(); F.lane = F.tid & 63; F.wave = __builtin_amdgcn_readfirstlane(F.tid >> 6);
    F.bid = obid(); F.G = ogrid(); F.gw = F.bid * NWAVES + F.wave; F.NGW = F.G * NWAVES; F.gtid = (long)F.bid * 512 + F.tid; F.NT = (long)F.G * 512;
    return F;
}
template <int P> __global__ void __launch_bounds__(NWAVES * 64, 2) mk_phase(Args A) {
    extern __shared__ __attribute__((aligned(16))) unsigned char lds[];
    const Frame F = make_frame(lds);
    run_phase<P>(F, A, A.ph_lo);
}
#if N_LAUNCH_MODE == 1
__device__ __forceinline__ const float* lds_ptr(const LAS unsigned long long* tab, int i) {
    const unsigned long long v = tab[i];
    const unsigned lo = __builtin_amdgcn_readfirstlane((unsigned)v), hi = __builtin_amdgcn_readfirstlane((unsigned)(v >> 32));
    return (const float*)(const __attribute__((address_space(1))) float*)(((unsigned long long)hi << 32) | lo);
}
__device__ __forceinline__ void load_args(Args& L, const LAS unsigned long long* tab) {
#pragma unroll
    for (int i = 0; i < 32; ++i) L.in[i] = lds_ptr(tab, i);
    L.out = (float*)lds_ptr(tab, 32); L.ws = (unsigned char*)lds_ptr(tab, 33); L.ph_lo = 0; L.ph_hi = 0;
}
__global__ void __launch_bounds__(NWAVES * 64, 2) mk_fwd(Args A) {
    extern __shared__ __attribute__((aligned(16))) unsigned char lds[];
    LAS unsigned char* L3 = (LAS unsigned char*)lds;
    volatile LAS unsigned* MISC = (volatile LAS unsigned*)(L3 + MISC_OFF);
    for (int u = threadIdx.x; u < (LDS_BYTES - RING_BYTES) / 4; u += NWAVES * 64) ((LAS unsigned*)(L3 + RING_BYTES))[u] = 0u;
    __syncthreads();
    LAS unsigned long long* tab = (LAS unsigned long long*)(L3 + RING_BYTES + 4096);
    if (threadIdx.x == 0) {
#define ST(i) tab[i] = (unsigned long long)A.in[i];
        ST(0) ST(1) ST(2) ST(3) ST(4) ST(5) ST(6) ST(7) ST(8) ST(9) ST(10) ST(11) ST(12) ST(13) ST(14) ST(15) ST(16) ST(17) ST(18) ST(19) ST(20) ST(21) ST(22) ST(23) ST(24) ST(25) ST(26) ST(27) ST(28) ST(29) ST(30) ST(31)
#undef ST
        tab[32] = (unsigned long long)A.out; tab[33] = (unsigned long long)A.ws;
    }
    __syncthreads();
    (void)xcd_barrier_post((unsigned*)(A.ws + WS_CTL) + CW_BAR, MISC + 8);
#define RUN(P) do { asm volatile("; PHASE_MARK " #P); { unsigned tb_ = RING_BYTES + 4096; asm volatile("" : "+v"(tb_)); Args L; load_args(L, (const LAS unsigned long long*)(L3 + tb_)); \
        const Frame F = make_frame(lds); run_phase<P>(F, L, l); \
        if constexpr (P >= 0 && ((REP_MASK >> (P < 0 ? 0 : P)) & 1)) { for (int rp_ = 0; rp_ < REP_N; ++rp_) { asm volatile("s_waitcnt vmcnt(0)" ::: "memory"); __syncthreads(); run_phase<P, true>(F, L, l); } } \
        XcdBarrier bar; bar.bar = (unsigned*)(L.ws + WS_CTL) + CW_BAR; bar.x = xb_xcc_id(); { unsigned mo_ = MISC_OFF + 32; asm volatile("" : "+v"(mo_)); bar.st = (volatile LAS unsigned*)(L3 + mo_); } \
        xcd_barrier(bar); } } while (0)
    { const int l = 0; RUN(-1);
#if REP_PRO
      for (int rp_ = 0; rp_ < 2; ++rp_) { RUN(-1); }
#endif
    }
    for (int l = 0; l < DEPTH; ++l) {
        if (l == 0) RUN(0);
        RUN(1); RUN(3); RUN(4); RUN(5); RUN(6); RUN(7); RUN(9); RUN(11); RUN(12); RUN(13); RUN(14); RUN(15); RUN(16); RUN(17);
    }
#undef RUN
}
#endif

extern "C" void kernel_launch(void* const* d_in, const int* in_sizes, int n_in, void* d_out, int out_size, void* d_ws, size_t ws_size, hipStream_t stream) {
    static int grid = 0;
    if (grid == 0) {
        if (n_in != 32 || out_size != NB * SEQ * DM || ws_size < WS_END) { fprintf(stderr, "kernel_launch: unexpected shapes (n_in %d, out %d, ws %zu < %zu)\n", n_in, out_size, ws_size, (size_t)WS_END); grid = -1; return; }
        int dev = 0, cus = 0;
        if (hipGetDevice(&dev) != hipSuccess || hipDeviceGetAttribute(&cus, hipDeviceAttributeMultiprocessorCount, dev) != hipSuccess) { grid = -1; return; }
#define SETA(K) if (hipFuncSetAttribute((const void*)K, hipFuncAttributeMaxDynamicSharedMemorySize, LDS_BYTES) != hipSuccess) { fprintf(stderr, "kernel_launch: hipFuncSetAttribute failed\n"); grid = -1; return; }
#if N_LAUNCH_MODE == 1
        SETA(mk_fwd)
#else
        SETA(mk_phase<-1>) SETA(mk_phase<0>) SETA(mk_phase<1>) SETA(mk_phase<2>) SETA(mk_phase<3>) SETA(mk_phase<4>) SETA(mk_phase<5>) SETA(mk_phase<6>) SETA(mk_phase<7>) SETA(mk_phase<8>)
        SETA(mk_phase<9>) SETA(mk_phase<10>) SETA(mk_phase<11>) SETA(mk_phase<12>) SETA(mk_phase<13>) SETA(mk_phase<14>) SETA(mk_phase<15>) SETA(mk_phase<16>) SETA(mk_phase<17>)
#endif
#undef SETA
        int per_cu = 0;
        (void)per_cu;
        if (cus * MOE_MAXU < 2 * (NPAIR / 256 + 256)) { fprintf(stderr, "kernel_launch: too few CUs (%d) for the staged MoE row lists\n", cus); grid = -1; return; }
        grid = cus;
    }
    if (grid < 0) return;
    (void)hipMemsetAsync((char*)d_ws + WS_CTL, 0, CTL_ZERO_BYTES, stream);
    Args a{};
    for (int i = 0; i < 32; ++i) a.in[i] = (const float*)d_in[i];
    a.out = (float*)d_out; a.ws = (unsigned char*)d_ws;
#if N_LAUNCH_MODE == 1
    a.ph_lo = 0; a.ph_hi = N_PHASES;
    hipLaunchKernelGGL(mk_fwd, dim3(grid), dim3(NWAVES * 64), LDS_BYTES, stream, a);
#else
#define LAUNCH_P(P) hipLaunchKernelGGL(mk_phase<P>, dim3(grid), dim3(NWAVES * 64), LDS_BYTES, stream, a)
    a.ph_lo = 0; a.ph_hi = 0; LAUNCH_P(-1);
    for (int l = 0; l < DEPTH; ++l) { a.ph_lo = l;
        LAUNCH_P(0); LAUNCH_P(1); LAUNCH_P(2); LAUNCH_P(3); LAUNCH_P(4); LAUNCH_P(5); LAUNCH_P(6); LAUNCH_P(7); LAUNCH_P(8); LAUNCH_P(9); LAUNCH_P(10); LAUNCH_P(11); LAUNCH_P(12); LAUNCH_P(13); LAUNCH_P(14); LAUNCH_P(15); LAUNCH_P(16); LAUNCH_P(17); }
#undef LAUNCH_P
#endif
    const hipError_t le = hipPeekAtLastError();
    if (le != hipSuccess) fprintf(stderr, "kernel_launch: launch failed: %s\n", hipGetErrorName(le));
}
```

```cpp
#include <hip/hip_runtime.h>
#include <cstdio>
#include <cstdint>

#ifndef ATTN_V2
#define ATTN_V2 8
#endif
#ifndef REP_PRO
#define REP_PRO 0
#endif
#ifndef REP_MASK
#define REP_MASK 0
#endif
#ifndef REP_N
#define REP_N 2
#endif
#ifndef FAST_MIX
#define FAST_MIX 1
#endif
#ifndef FAST_WIN
#define FAST_WIN 1
#endif
#ifndef FAST_LRU
#define FAST_LRU 1
#endif
#define FAST_FFT 0
#ifndef FAST_FFT_A
#define FAST_FFT_A 1
#endif
#ifndef FAST_FFT_B
#define FAST_FFT_B 1
#endif
#ifndef FAST_MOE
#define FAST_MOE 1
#endif
#ifndef FAST_ATTN
#define FAST_ATTN 1
#endif
#ifndef N_LAUNCH_MODE
#define N_LAUNCH_MODE 1
#endif

__device__ __forceinline__ int otid() { int t = threadIdx.x; asm volatile("" : "+v"(t)); return t; }
__device__ __forceinline__ int obid() { int b = blockIdx.x; asm volatile("" : "+s"(b)); return b; }
__device__ __forceinline__ int ogrid() { int g = gridDim.x; asm volatile("" : "+s"(g)); return g; }
template <int M> __device__ __forceinline__ float sx(float v) {
    static_assert(M == 1 || M == 2 || M == 4 || M == 8 || M == 16 || M == 32, "xor mask");
    if constexpr (M < 32) return __uint_as_float((unsigned)__builtin_amdgcn_ds_swizzle((int)__float_as_uint(v), (M << 10) | 0x1f));
    else { auto rr = __builtin_amdgcn_permlane32_swap(__float_as_uint(v), __float_as_uint(v), false, false); const unsigned a = rr[0], b = rr[1]; return __uint_as_float(a == __float_as_uint(v) ? b : a); }
}
template <int M> __device__ __forceinline__ int sxi(int v) { return (int)__float_as_uint(sx<M>(__uint_as_float((unsigned)v))); }
namespace pg8 {
#define PG8_LAS __attribute__((address_space(3)))
typedef unsigned short bf16_t;
typedef short bf16x8 __attribute__((ext_vector_type(8)));
typedef float f32x4 __attribute__((ext_vector_type(4)));
typedef unsigned u32x4 __attribute__((ext_vector_type(4)));
constexpr int BM = 256, BK = 64, HALF = 128, HTB = HALF * BK * 2, STAGE_BYTES = 8 * HTB, NXCD = 8, WGM = 8;
__host__ __device__ __forceinline__ int lds_byte(int r, int c) { const int st = (r >> 4) * 2 + (c >> 5), rr = r & 15, cc = c & 31, ob = rr * 64 + cc * 2; return st * 1024 + (ob ^ (((ob >> 9) & 1) << 5)); }
__host__ __device__ __forceinline__ void stage_rc(int b, int& R, int& C) { const int st = b / 1024, sb = b % 1024, swz = sb ^ (((sb >> 9) & 1) << 5); R = (st >> 1) * 16 + swz / 64; C = (st & 1) * 32 + (swz % 64) / 2; }
__host__ __device__ __forceinline__ int perm32(int rho) { const int n = rho >> 4, i = rho & 15; return 8 * (i >> 2) + 4 * n + (i & 3); }
struct Unit { int pm, pn; };
struct Gemm { const bf16_t* A; const bf16_t* Bt; int M, N, K, lda, ldb; };
struct StaticOrder {
    int nM, nN, nwg, G, c; bool skipctx;
    __host__ __device__ void init(int M, int N, int G_, int c_, bool skip = false) { nM = skip ? 64 : M / BM; nN = N / BM; nwg = nM * nN; G = G_; c = c_; skipctx = skip; }
    __host__ __device__ bool next(int i, Unit& u) const {
        const long L = (long)i * G + c; if (L >= nwg) return false;
        int wgid = (int)L; { const int q = nwg / NXCD, r = nwg % NXCD, xcd = wgid % NXCD, off = wgid / NXCD; wgid = (xcd < r ? xcd * (q + 1) : r * (q + 1) + (xcd - r) * q) + off; }
        const int nig = WGM * nN, gid = wgid / nig, fm = gid * WGM, gsz = (nM - fm) < WGM ? (nM - fm) : WGM;
        u.pm = fm + ((wgid % nig) % gsz); u.pn = (wgid % nig) / gsz;
        if (skipctx) u.pm += 1 + (u.pm >= 32 ? 1 : 0);
        return true;
    }
};
__device__ __forceinline__ unsigned cvt_pk_bf16(float lo, float hi) { unsigned r; asm volatile("v_cvt_pk_bf16_f32 %0, %1, %2" : "=v"(r) : "v"(lo), "v"(hi)); return r; }

struct EpiF32 {
    static constexpr bool PERM = false; static constexpr int MIDK = 0;
    float* C; int ldc;
    __device__ __forceinline__ void operator()(const f32x4 (&acc)[2][2][4][2], const Unit& u, int wr, int wc, int fr, int fq) const {
        const int row0 = u.pm * BM + wr * 64 + fr, col0 = u.pn * BM + wc * 32 + 4 * fq;
#pragma unroll
        for (int ai = 0; ai < 2; ++ai)
#pragma unroll
            for (int m = 0; m < 4; ++m) { float* rowp = C + (size_t)(row0 + ai * HALF + m * 16) * ldc + col0;
#pragma unroll
                for (int bj = 0; bj < 2; ++bj)
#pragma unroll
                    for (int n = 0; n < 2; ++n) *(f32x4*)(rowp + bj * HALF + n * 16) = acc[ai][bj][m][n]; }
    }
};

template <class Epi>
__device__ __forceinline__ void gemm_phase(PG8_LAS unsigned char* lds, const Gemm g, const StaticOrder& S, const Epi& E) {
    const int tid = otid(), wid = __builtin_amdgcn_readfirstlane(tid >> 6), lane = tid & 63, wr = wid >> 2, wc = wid & 3, fr = lane & 15, fq = lane >> 4;
    const int K = g.K, nt = K / BK;
    unsigned voffA[2], voffB[2];
#pragma unroll
    for (int i = 0; i < 2; ++i) { int R, C; stage_rc(tid * 16 + i * 8192, R, C); const int Rb = Epi::PERM ? ((R & ~31) + perm32(R & 31)) : R;
        voffA[i] = (unsigned)(R * g.lda + C) * 2u; voffB[i] = (unsigned)(Rb * g.ldb + C) * 2u; }
    const size_t kstep = (size_t)(BK * 2);
    const size_t hA = (size_t)HALF * g.lda * 2, hB = (size_t)HALF * g.ldb * 2;
    const size_t tA = 2 * hA, tB = 2 * hB;
    const unsigned ldsw = (unsigned)wid * 1024u;
    const int aoff = lds_byte(wr * 64 + fr, fq * 8), boff = lds_byte(wc * 32 + fr, fq * 8);
#define PG8_SA(b, h) (((b) * 2 + (h)) * HTB)
#define PG8_SB(b, h) ((4 + (b) * 2 + (h)) * HTB)
#define PG8_STAGE(bufoff, gbase, voff) do { _Pragma("unroll") for (int _i = 0; _i < 2; ++_i) \
        __builtin_amdgcn_global_load_lds((const unsigned*)((const char*)(gbase) + (voff)[_i]), (PG8_LAS unsigned*)(lds + (bufoff) + ldsw + _i * 8192), 16, 0, 0); } while (0)
#define PG8_LDA(dst, b, h) do { _Pragma("unroll") for (int m = 0; m < 4; ++m) _Pragma("unroll") for (int k = 0; k < 2; ++k) dst[m][k] = *(const PG8_LAS bf16x8*)(lds + PG8_SA(b, h) + aoff + m * 2048 + k * 1024); } while (0)
#define PG8_LDB(dst, b, h) do { _Pragma("unroll") for (int n = 0; n < 2; ++n) _Pragma("unroll") for (int k = 0; k < 2; ++k) dst[n][k] = *(const PG8_LAS bf16x8*)(lds + PG8_SB(b, h) + boff + n * 2048 + k * 1024); } while (0)
#define PG8_MMA(ai, bj, At, Bt) do { __builtin_amdgcn_s_setprio(1); _Pragma("unroll") for (int m = 0; m < 4; ++m) _Pragma("unroll") for (int n = 0; n < 2; ++n) _Pragma("unroll") for (int k = 0; k < 2; ++k) \
        acc[ai][bj][m][n] = __builtin_amdgcn_mfma_f32_16x16x32_bf16(Bt[n][k], At[m][k], acc[ai][bj][m][n], 0, 0, 0); __builtin_amdgcn_s_setprio(0); } while (0)
#define PG8_WAIT_V(n) asm volatile("s_waitcnt vmcnt(" #n ")" ::: "memory")
#define PG8_WAIT_L(n) asm volatile("s_waitcnt lgkmcnt(" #n ")" ::: "memory")
#define PG8_BAR __builtin_amdgcn_s_barrier()
#define PG8_SCHED __builtin_amdgcn_sched_barrier(0)
    Unit cur, nxt; int ui = 0;
    if (!S.next(0, cur)) return;
    f32x4 acc[2][2][4][2];
#pragma unroll
    for (int a = 0; a < 2; ++a)
#pragma unroll
        for (int b = 0; b < 2; ++b)
#pragma unroll
            for (int m = 0; m < 4; ++m)
#pragma unroll
                for (int n = 0; n < 2; ++n) acc[a][b][m][n] = (f32x4){0.f, 0.f, 0.f, 0.f};
    bf16x8 At[4][2], B0[2][2], B1[2][2];
    const char* cA = (const char*)g.A + (size_t)cur.pm * tA; const char* cB = (const char*)g.Bt + (size_t)cur.pn * tB;
    PG8_STAGE(PG8_SB(0, 0), cB, voffB); PG8_STAGE(PG8_SB(0, 1), cB + hB, voffB); PG8_STAGE(PG8_SA(0, 0), cA, voffA); PG8_STAGE(PG8_SA(0, 1), cA + hA, voffA);
    if (wr == 1) PG8_BAR;
    PG8_WAIT_V(2); PG8_BAR;
    PG8_STAGE(PG8_SB(1, 0), cB + kstep, voffB); PG8_STAGE(PG8_SA(1, 0), cA + kstep, voffA); PG8_STAGE(PG8_SB(1, 1), cB + hB + kstep, voffB);
    PG8_WAIT_V(6); PG8_BAR;
    for (;;) {
        const bool has_next = S.next(ui + 1, nxt);
        const char* nA = has_next ? (const char*)g.A + (size_t)nxt.pm * tA : cA; const char* nB = has_next ? (const char*)g.Bt + (size_t)nxt.pn * tB : cB;
#pragma unroll 1
        for (int t = 0; t < nt; t += 2) {
            if constexpr (Epi::MIDK > 0) { if (t > 0 && (t % Epi::MIDK) == 0) E.mid(acc, cur, wr, wc, fr, fq, t / Epi::MIDK); }
            const bool last = (t == nt - 2);
            const char* a1 = cA + (size_t)(t + 1) * kstep;
            const char* a2 = last ? nA : cA + (size_t)(t + 2) * kstep; const char* b2 = last ? nB : cB + (size_t)(t + 2) * kstep;
            const char* a3 = a2 + kstep; const char* b3 = b2 + kstep;
            PG8_LDB(B0, 0, 0); PG8_LDB(B1, 0, 1); PG8_SCHED; PG8_LDA(At, 0, 0); PG8_STAGE(PG8_SA(1, 1), a1 + hA, voffA);
            PG8_WAIT_V(8); PG8_WAIT_L(0); PG8_BAR; PG8_MMA(0, 0, At, B0); PG8_MMA(0, 1, At, B1); PG8_BAR; PG8_SCHED;
            PG8_LDA(At, 0, 1); PG8_STAGE(PG8_SB(0, 0), b2, voffB); PG8_STAGE(PG8_SB(0, 1), b2 + hB, voffB); PG8_STAGE(PG8_SA(0, 0), a2, voffA);
            PG8_WAIT_V(8); PG8_WAIT_L(0); PG8_BAR; PG8_MMA(1, 0, At, B0); PG8_MMA(1, 1, At, B1); PG8_BAR; PG8_SCHED;
            PG8_LDB(B0, 1, 0); PG8_LDB(B1, 1, 1); PG8_SCHED; PG8_LDA(At, 1, 0); PG8_STAGE(PG8_SA(0, 1), a2 + hA, voffA);
            PG8_WAIT_V(8); PG8_WAIT_L(0); PG8_BAR; PG8_MMA(0, 0, At, B0); PG8_MMA(0, 1, At, B1); PG8_BAR; PG8_SCHED;
            PG8_LDA(At, 1, 1); PG8_STAGE(PG8_SB(1, 0), b3, voffB); PG8_STAGE(PG8_SB(1, 1), b3 + hB, voffB); PG8_STAGE(PG8_SA(1, 0), a3, voffA);
            PG8_WAIT_V(8); PG8_WAIT_L(0); PG8_BAR; PG8_MMA(1, 0, At, B0); PG8_MMA(1, 1, At, B1); PG8_BAR; PG8_SCHED;
        }
        if (wr == 0) PG8_BAR;
        E(acc, cur, wr, wc, fr, fq);
        if (!has_next) break;
#pragma unroll
        for (int a = 0; a < 2; ++a)
#pragma unroll
            for (int b = 0; b < 2; ++b)
#pragma unroll
                for (int m = 0; m < 4; ++m)
#pragma unroll
                    for (int n = 0; n < 2; ++n) acc[a][b][m][n] = (f32x4){0.f, 0.f, 0.f, 0.f};
        cur = nxt; cA = nA; cB = nB; ++ui;
        if (wr == 1) PG8_BAR;
    }
    PG8_WAIT_V(0);
    PG8_BAR;
#undef PG8_SA
#undef PG8_SB
#undef PG8_STAGE
#undef PG8_LDA
#undef PG8_LDB
#undef PG8_MMA
#undef PG8_WAIT_V
#undef PG8_WAIT_L
#undef PG8_BAR
#undef PG8_SCHED
}

struct UnitG { const char* a; const char* b; int row0, pn, e, valid; const int* rows; const PG8_LAS int* lrows; };
template <class Epi, class Sched, bool GATHER>
__device__ __forceinline__ void gemm_phase_g(PG8_LAS unsigned char* lds, const int K, const int lda, const int ldb, const Sched& S, const Epi& E) {
    const int tid = otid(), wid = __builtin_amdgcn_readfirstlane(tid >> 6), lane = tid & 63, wr = wid >> 2, wc = wid & 3, fr = lane & 15, fq = lane >> 4;
    const int nt = K / BK;
    int RA[2], CA[2]; unsigned voffB[2];
#pragma unroll
    for (int i = 0; i < 2; ++i) { int R, C; stage_rc(tid * 16 + i * 8192, R, C); const int Rb = Epi::PERM ? ((R & ~31) + perm32(R & 31)) : R;
        RA[i] = R; CA[i] = C; voffB[i] = (unsigned)(Rb * ldb + C) * 2u; }
    const size_t kstep = (size_t)(BK * 2);
    const size_t hB = (size_t)HALF * ldb * 2;
    const unsigned ldsw = (unsigned)wid * 1024u;
    const int aoff = lds_byte(wr * 64 + fr, fq * 8), boff = lds_byte(wc * 32 + fr, fq * 8);
#define PG8_SA(b, h) (((b) * 2 + (h)) * HTB)
#define PG8_SB(b, h) ((4 + (b) * 2 + (h)) * HTB)
#define PG8_STAGE(bufoff, gbase, voff) do { _Pragma("unroll") for (int _i = 0; _i < 2; ++_i) \
        __builtin_amdgcn_global_load_lds((const unsigned*)((const char*)(gbase) + (voff)[_i]), (PG8_LAS unsigned*)(lds + (bufoff) + ldsw + _i * 8192), 16, 0, 0); } while (0)
#define PG8_LDA(dst, b, h) do { _Pragma("unroll") for (int m = 0; m < 4; ++m) _Pragma("unroll") for (int k = 0; k < 2; ++k) dst[m][k] = *(const PG8_LAS bf16x8*)(lds + PG8_SA(b, h) + aoff + m * 2048 + k * 1024); } while (0)
#define PG8_LDB(dst, b, h) do { _Pragma("unroll") for (int n = 0; n < 2; ++n) _Pragma("unroll") for (int k = 0; k < 2; ++k) dst[n][k] = *(const PG8_LAS bf16x8*)(lds + PG8_SB(b, h) + boff + n * 2048 + k * 1024); } while (0)
#define PG8_MMA(ai, bj, At, Bt) do { __builtin_amdgcn_s_setprio(1); _Pragma("unroll") for (int m = 0; m < 4; ++m) _Pragma("unroll") for (int n = 0; n < 2; ++n) _Pragma("unroll") for (int k = 0; k < 2; ++k) \
        acc[ai][bj][m][n] = __builtin_amdgcn_mfma_f32_16x16x32_bf16(Bt[n][k], At[m][k], acc[ai][bj][m][n], 0, 0, 0); __builtin_amdgcn_s_setprio(0); } while (0)
#define PG8_WAIT_V(n) asm volatile("s_waitcnt vmcnt(" #n ")" ::: "memory")
#define PG8_WAIT_L(n) asm volatile("s_waitcnt lgkmcnt(" #n ")" ::: "memory")
#define PG8_BAR __builtin_amdgcn_s_barrier()
#define PG8_SCHED __builtin_amdgcn_sched_barrier(0)
#define PG8_MKOFF(u, v) do { _Pragma("unroll") for (int _h = 0; _h < 2; ++_h) _Pragma("unroll") for (int _i = 0; _i < 2; ++_i) { const int _row = _h * HALF + RA[_i]; \
        if (GATHER) { const int _pr = (u).lrows[_row]; v[_h][_i] = (unsigned)(_pr >> 3) * (unsigned)(lda * 2) + (unsigned)(CA[_i] * 2); } \
        else v[_h][_i] = (unsigned)(_row * lda + CA[_i]) * 2u; } } while (0)
    UnitG cur, nxt; int ui = 0;
    if (!S.next(0, cur)) return;
    f32x4 acc[2][2][4][2];
#pragma unroll
    for (int a = 0; a < 2; ++a)
#pragma unroll
        for (int b = 0; b < 2; ++b)
#pragma unroll
            for (int m = 0; m < 4; ++m)
#pragma unroll
                for (int n = 0; n < 2; ++n) acc[a][b][m][n] = (f32x4){0.f, 0.f, 0.f, 0.f};
    bf16x8 At[4][2], B0[2][2], B1[2][2];
    unsigned vA[2][2], vN[2][2];
    PG8_MKOFF(cur, vA);
    const char* cA = cur.a; const char* cB = cur.b;
    PG8_STAGE(PG8_SB(0, 0), cB, voffB); PG8_STAGE(PG8_SB(0, 1), cB + hB, voffB); PG8_STAGE(PG8_SA(0, 0), cA, vA[0]); PG8_STAGE(PG8_SA(0, 1), cA, vA[1]);
    if (wr == 1) PG8_BAR;
    PG8_WAIT_V(2); PG8_BAR;
    PG8_STAGE(PG8_SB(1, 0), cB + kstep, voffB); PG8_STAGE(PG8_SA(1, 0), cA + kstep, vA[0]); PG8_STAGE(PG8_SB(1, 1), cB + hB + kstep, voffB);
    PG8_WAIT_V(6); PG8_BAR;
    for (;;) {
        const bool has_next = S.next(ui + 1, nxt);
        if constexpr (GATHER) { if (has_next) { PG8_MKOFF(nxt, vN); } else { vN[0][0] = vA[0][0]; vN[0][1] = vA[0][1]; vN[1][0] = vA[1][0]; vN[1][1] = vA[1][1]; } }
        const char* nA = has_next ? nxt.a : cA; const char* nB = has_next ? nxt.b : cB;
#pragma unroll 1
        for (int t = 0; t < nt; t += 2) {
            const bool last = (t == nt - 2);
            const char* a1 = cA + (size_t)(t + 1) * kstep;
            const char* a2 = last ? nA : cA + (size_t)(t + 2) * kstep; const char* b2 = last ? nB : cB + (size_t)(t + 2) * kstep;
            const char* a3 = a2 + kstep; const char* b3 = b2 + kstep;
            unsigned s0[2], s1[2];
            if constexpr (GATHER) { s0[0] = last ? vN[0][0] : vA[0][0]; s0[1] = last ? vN[0][1] : vA[0][1]; s1[0] = last ? vN[1][0] : vA[1][0]; s1[1] = last ? vN[1][1] : vA[1][1]; }
            else { s0[0] = vA[0][0]; s0[1] = vA[0][1]; s1[0] = vA[1][0]; s1[1] = vA[1][1]; }
            PG8_LDB(B0, 0, 0); PG8_LDB(B1, 0, 1); PG8_SCHED; PG8_LDA(At, 0, 0); PG8_STAGE(PG8_SA(1, 1), a1, vA[1]);
            PG8_WAIT_V(8); PG8_WAIT_L(0); PG8_BAR; PG8_MMA(0, 0, At, B0); PG8_MMA(0, 1, At, B1); PG8_BAR; PG8_SCHED;
            PG8_LDA(At, 0, 1); PG8_STAGE(PG8_SB(0, 0), b2, voffB); PG8_STAGE(PG8_SB(0, 1), b2 + hB, voffB); PG8_STAGE(PG8_SA(0, 0), a2, s0);
            PG8_WAIT_V(8); PG8_WAIT_L(0); PG8_BAR; PG8_MMA(1, 0, At, B0); PG8_MMA(1, 1, At, B1); PG8_BAR; PG8_SCHED;
            PG8_LDB(B0, 1, 0); PG8_LDB(B1, 1, 1); PG8_SCHED; PG8_LDA(At, 1, 0); PG8_STAGE(PG8_SA(0, 1), a2, s1);
            PG8_WAIT_V(8); PG8_WAIT_L(0); PG8_BAR; PG8_MMA(0, 0, At, B0); PG8_MMA(0, 1, At, B1); PG8_BAR; PG8_SCHED;
            PG8_LDA(At, 1, 1); PG8_STAGE(PG8_SB(1, 0), b3, voffB); PG8_STAGE(PG8_SB(1, 1), b3 + hB, voffB); PG8_STAGE(PG8_SA(1, 0), a3, s0);
            PG8_WAIT_V(8); PG8_WAIT_L(0); PG8_BAR; PG8_MMA(1, 0, At, B0); PG8_MMA(1, 1, At, B1); PG8_BAR; PG8_SCHED;
        }
        if (wr == 0) PG8_BAR;
        E(acc, cur, wr, wc, fr, fq);
        if (!has_next) break;
#pragma unroll
        for (int a = 0; a < 2; ++a)
#pragma unroll
            for (int b = 0; b < 2; ++b)
#pragma unroll
                for (int m = 0; m < 4; ++m)
#pragma unroll
                    for (int n = 0; n < 2; ++n) acc[a][b][m][n] = (f32x4){0.f, 0.f, 0.f, 0.f};
        cur = nxt; cA = nA; cB = nB; ++ui;
        if constexpr (GATHER) { vA[0][0] = vN[0][0]; vA[0][1] = vN[0][1]; vA[1][0] = vN[1][0]; vA[1][1] = vN[1][1]; }
        if (wr == 1) PG8_BAR;
    }
    PG8_WAIT_V(0);
    PG8_BAR;
#undef PG8_SA
#undef PG8_SB
#undef PG8_STAGE
#undef PG8_LDA
#undef PG8_LDB
#undef PG8_MMA
#undef PG8_WAIT_V
#undef PG8_WAIT_L
#undef PG8_BAR
#undef PG8_SCHED
#undef PG8_MKOFF
}
}

constexpr int DM = 1024, NB = 2, SEQ = 8192, CTX = 256, TPB = SEQ + CTX, MROWS = NB * TPB, DEPTH = 2;
constexpr int INW = 9216, COL_K = 0, COL_V = 1024, COL_LX = 2048, COL_Q = 3072, COL_LG = 4096, COL_F = 5120, COL_G = 6144;
constexpr int NE = 256, TOPK = 8, EFF = 256, NPAIR = MROWS * TOPK, LCAP = MROWS;
constexpr float EPS = 1e-6f;
constexpr float QSCALE = 0.125f * 1.4426950408889634f;
constexpr int NCHUNK = TPB / 64;
static_assert(MROWS % 256 == 0, "rows");

constexpr size_t MiB = 1u << 20;
constexpr size_t WS_CTL = 0, CTL_ZERO_BYTES = 1 * MiB;
constexpr size_t WS_W = 1 * MiB, WL_STRIDE = 32 * MiB;
constexpr size_t WO_TAB = 31 * MiB;
constexpr size_t WO_WIN = 0, WO_D1 = 18 * MiB, WO_OUT = 24 * MiB, WO_R = 26 * MiB, WO_SGU = 27 * MiB, WO_SD = 28 * MiB, WO_LRU = 29 * MiB;
constexpr size_t WS_XALL = 65 * MiB;
constexpr size_t WS_H = WS_XALL + 66 * MiB;
constexpr size_t WS_U = WS_H + 33 * MiB;
constexpr size_t WS_KB = WS_U + 594 * MiB, WS_VB = WS_KB + 33 * MiB, WS_QB = WS_VB + 33 * MiB, WS_LXB = WS_QB + 33 * MiB, WS_GLG = WS_LXB + 33 * MiB, WS_ZP = WS_GLG + 33 * MiB;
constexpr size_t WS_GATES = WS_ZP + 33 * MiB;
constexpr size_t WS_MIXIN = WS_GATES + 99 * MiB;
constexpr size_t WS_S = WS_MIXIN + 99 * MiB;
constexpr size_t WS_UC = WS_S, WS_AB = WS_UC + 33 * MiB, WS_SUMM = WS_AB + 132 * MiB, WS_CARRY = WS_SUMM + 5 * MiB, WS_XA = WS_CARRY + 3 * MiB, WS_XB = WS_XA + 32 * MiB, WS_GB = WS_XB + 32 * MiB, WS_GC = WS_GB + 32 * MiB;
constexpr size_t WS_PA = WS_S, WS_PR = WS_PA + 66 * MiB, WS_PF = WS_PR + 66 * MiB, WS_Y1 = WS_PF + 66 * MiB;
static_assert(WS_GC + 3 * MiB <= WS_S + 280 * MiB && WS_Y1 + 66 * MiB <= WS_S + 280 * MiB, "scratch S");
constexpr size_t WS_MIXED = WS_S + 280 * MiB, WS_TOK = WS_MIXED + 33 * MiB;
constexpr size_t WS_LOG = WS_TOK + 33 * MiB, WS_SGU = WS_LOG + 17 * MiB, WS_SH = WS_SGU + 33 * MiB, WS_LIST = WS_SH + 9 * MiB, WS_TOPW = WS_LIST + 17 * MiB, WS_SD = WS_TOPW + 1 * MiB;
constexpr size_t WS_YB = WS_U;
constexpr size_t WS_Y16 = WS_KB, WS_HB = WS_S;
constexpr size_t WS_EP = WS_SUMM;
constexpr size_t WS_Y16_OLD = WS_U;
constexpr size_t WS_EW = WS_SD + 66 * MiB, WS_EW1 = WS_U, EW_STRIDE = 3 * MiB / 2;
#define EWL(l) (((l) & 1) ? WS_EW1 : WS_EW)
static_assert(WS_KB + 396 * MiB == WS_S && 392 * MiB <= 396 * MiB && WS_U + 384 * MiB <= WS_KB, "overlays");
constexpr size_t WS_END = WS_EW + 384 * MiB;
static_assert(WS_END <= 2048 * MiB, "d_ws budget");
constexpr int CW_BAR = 4096;
constexpr int CW_CNT = 16384, CNT_STRIDE = 32;
constexpr int CW_MOD = 65536;
static_assert((CW_MOD + 2 * 3 * 6144) * 4 <= (int)CTL_ZERO_BYTES, "ctl");

constexpr int LDS_BYTES = 147456, RING_BYTES = 131072, MISC_OFF = RING_BYTES + 320;
constexpr int NWAVES = 8;

#define GAS __attribute__((address_space(1)))
#define LAS __attribute__((address_space(3)))
typedef unsigned short bf16;
typedef unsigned v4u __attribute__((ext_vector_type(4)));
typedef float f32x4 __attribute__((ext_vector_type(4)));
typedef GAS unsigned gu32;
#define RLX_AGENT __ATOMIC_RELAXED, __HIP_MEMORY_SCOPE_AGENT
#define LDS_WAIT() asm volatile("s_waitcnt lgkmcnt(0)" ::: "memory")
typedef float f32x2_t __attribute__((ext_vector_type(2))); typedef __bf16 bf16x2_t __attribute__((ext_vector_type(2)));
__device__ __forceinline__ unsigned pk2(float lo, float hi) { const f32x2_t v = {lo, hi}; const bf16x2_t b = __builtin_convertvector(v, bf16x2_t); return __builtin_bit_cast(unsigned, b); }
__device__ __forceinline__ unsigned f2bf(float f) { return pk2(f, f) & 0xffffu; }
__device__ __forceinline__ float bf2f(unsigned h) { return __uint_as_float(h << 16); }
__device__ __forceinline__ float sigmoidf_(float x) { return __builtin_amdgcn_rcpf(1.f + __expf(-x)); }
__device__ __forceinline__ float siluf_(float x) { return x * __builtin_amdgcn_rcpf(1.f + __expf(-x)); }
__device__ __forceinline__ float gelu_tanh(float x) { const float u = 0.7978845608028654f * (x + 0.044715f * x * x * x); return x * __builtin_amdgcn_rcpf(1.f + __expf(-2.f * u)); }

#define XB_TMO      128
#define XB_XCNT(j)  (256  + 64 * (j))
#define XB_XSUB(j)  (1280 + 64 * (j))
#define XB_XGEN(j)  (2304 + 64 * (j))
#define XB_TOP      3328
#define XB_TOPGEN   3392
#define XCD_BAR_WORDS 3456
#define XB_SPIN_CAP (1u << 18)
__device__ __forceinline__ unsigned xb_ld(unsigned* p)              { return __hip_atomic_load(p, __ATOMIC_RELAXED, __HIP_MEMORY_SCOPE_AGENT); }
__device__ __forceinline__ unsigned xb_add(unsigned* p, unsigned v) { return __hip_atomic_fetch_add(p, v, __ATOMIC_RELAXED, __HIP_MEMORY_SCOPE_AGENT); }
__device__ __forceinline__ unsigned xb_xcc_id() { return (unsigned)__builtin_amdgcn_s_getreg((3 << 11) | 20) & 0xFu; }
#define XB_SPIN(cond, bar) do { unsigned _sp = 0; while (cond) { __builtin_amdgcn_s_sleep(1); \
    if ((++_sp & 255u) == 0u) { if (xb_ld(&(bar)[XB_TMO])) break; if (_sp > XB_SPIN_CAP) { atomicAdd(&(bar)[XB_TMO], 1u); break; } } } } while (0)
struct XcdBarrier { unsigned* bar; unsigned x; volatile LAS unsigned* st; };
__device__ __forceinline__ XcdBarrier xcd_barrier_post(unsigned* bar, volatile LAS unsigned* st) {
    XcdBarrier b; b.bar = bar; b.x = xb_xcc_id(); b.st = st;
    if (threadIdx.x == 0) (void)xb_add(&bar[XB_XCNT(b.x)], 1u);
    return b;
}
__device__ __forceinline__ void xcd_barrier_complete(unsigned* bar, unsigned x, unsigned& nloc, unsigned& nx) {
    const unsigned G = gridDim.x * gridDim.y * gridDim.z;
    unsigned sum, cnt, mine, sp = 0u;
    for (;;) {
        sum = 0u; cnt = 0u; mine = 0u;
#pragma unroll
        for (unsigned j = 0; j < 16; ++j) { const unsigned c = xb_ld(&bar[XB_XCNT(j)]); sum += c; cnt += (c > 0u) ? 1u : 0u; mine = (j == x) ? c : mine; }
        if (sum == G) break;
        __builtin_amdgcn_s_sleep(1);
        if ((++sp & 255u) == 0u) { if (xb_ld(&bar[XB_TMO])) break; if (sp > XB_SPIN_CAP) { atomicAdd(&bar[XB_TMO], 1u); break; } }
    }
    nloc = mine > 0u ? mine : 1u; nx = cnt > 0u ? cnt : 1u;
}
__device__ __forceinline__ void xcd_barrier(const XcdBarrier& b) {
    asm volatile("s_waitcnt vmcnt(0)" ::: "memory");
    __syncthreads();
    if (threadIdx.x == 0) {
        unsigned* bar = b.bar; asm volatile("" : "+s"(bar));
        __builtin_amdgcn_s_waitcnt(0);
        unsigned nloc = b.st[0], nx = b.st[1];
        unsigned bx = b.x; asm volatile("" : "+s"(bx));
        if (nloc == 0u) { xcd_barrier_complete(bar, bx, nloc, nx); b.st[0] = nloc; b.st[1] = nx; }
        const unsigned old = xb_add(&bar[XB_XSUB(bx)], 1u);
        const unsigned gen = old / nloc;
        if (old + 1u == (gen + 1u) * nloc) {
            __builtin_amdgcn_fence(__ATOMIC_RELEASE, "agent");
            asm volatile("s_waitcnt vmcnt(0)" ::: "memory");
            const unsigned og = xb_add(&bar[XB_TOP], 1u);
            const unsigned tg = og / nx;
            if (og + 1u == (tg + 1u) * nx) xb_add(&bar[XB_TOPGEN], 1u);
            else XB_SPIN(xb_ld(&bar[XB_TOPGEN]) == tg, bar);
            __builtin_amdgcn_fence(__ATOMIC_ACQUIRE, "agent");
            xb_add(&bar[XB_XGEN(bx)], 1u);
            asm volatile("s_waitcnt vmcnt(0)" ::: "memory");
        } else {
            XB_SPIN(xb_ld(&bar[XB_XGEN(bx)]) == gen, bar);
            __builtin_amdgcn_fence(__ATOMIC_ACQUIRE, "agent");
            asm volatile("s_waitcnt vmcnt(0)" ::: "memory");
        }
    }
    __syncthreads();
}

struct Args { const float* in[32]; float* out; unsigned char* ws; int ph_lo, ph_hi; };
struct Frame { LAS unsigned char* lds; int tid, lane, wave, bid, G, gw, NGW; long gtid, NT; };
#define WSP(T, off) ((T*)(A.ws + (off)))
#define WLP(l, off) ((bf16*)(A.ws + WS_W + (size_t)(l) * WL_STRIDE + (off)))
#define MODP(l, s, j) ((const float*)(A.ws + WS_CTL) + CW_MOD + ((l) * 3 + (s)) * 6144 + (j) * 1024)

__device__ __forceinline__ float wave_sum(float v) {
    v += sx<1>(v); v += sx<2>(v); v += sx<4>(v); v += sx<8>(v); v += sx<16>(v); v += sx<32>(v);
    return v;
}
__device__ __forceinline__ int win_row(int c) {
    const int sec = c >> 10; if (sec != 0 && sec != 3) return c;
    const int L = c & 255, g = L >> 6, a = (L >> 5) & 1, x = (L >> 4) & 1, q = (L >> 2) & 3, e = L & 3;
    return (c & ~255) | (128 * a + 32 * g + 8 * q + 4 * x + e);
}
template <bool WINMAP = false>
__device__ __forceinline__ void p0_transpose_item(const float* W, int K, int N, bf16* WT, int ldwt, int row_off, int col_off, LAS float* scr, int item, int lane) {
    const int nblk = N / 32, kb = item / nblk, nb = item % nblk, k0 = 64 * kb, n0 = 32 * nb;
    { f32x4 v[8]; const int rr = lane >> 3, c4 = (lane & 7) * 4;
#pragma unroll
      for (int i = 0; i < 8; ++i) v[i] = *(const f32x4*)(W + (size_t)(k0 + 8 * i + rr) * N + n0 + c4);
#pragma unroll
      for (int i = 0; i < 8; ++i) { LAS float* d = scr + (8 * i + rr) * 33 + c4; d[0] = v[i].x; d[1] = v[i].y; d[2] = v[i].z; d[3] = v[i].w; } }
    LDS_WAIT(); asm volatile("" ::: "memory");
    const int c = lane & 7;
#pragma unroll
    for (int j = 0; j < 4; ++j) { const int n = (lane >> 3) + 8 * j; const LAS float* s = scr + (8 * c) * 33 + n;
        v4u o; o.x = pk2(s[0 * 33], s[1 * 33]); o.y = pk2(s[2 * 33], s[3 * 33]); o.z = pk2(s[4 * 33], s[5 * 33]); o.w = pk2(s[6 * 33], s[7 * 33]);
        const int rr = WINMAP ? win_row(n0 + n) : n0 + n;
        *(v4u*)(WT + (size_t)(row_off + rr) * ldwt + col_off + k0 + 8 * c) = o; }
    LDS_WAIT(); asm volatile("" ::: "memory");
}

struct PItem { const float* W; bf16* WT; int N, ldwt, k0, n0, rowbase; bool winmap, skip; };
constexpr int PRO_I_WIN = 16 * 288, PRO_I_SQ = 16 * 32, PRO_I_R = 16 * 8, PRO_I_SD = 4 * 32, PRO_PER_L = PRO_I_WIN + 4 * PRO_I_SQ + 3 * PRO_I_R + PRO_I_SD;
__device__ __forceinline__ void pi_set(PItem& t, const float* W, int N, bf16* WT, int ldwt, int row_off, int col_off, int item) {
    const int nblk = N / 32, kb = item / nblk, nb = item % nblk; t.W = W; t.N = N; t.WT = WT + col_off; t.ldwt = ldwt; t.k0 = 64 * kb; t.n0 = 32 * nb; t.rowbase = row_off; }
__device__ __forceinline__ PItem pro_item(const Args& A, int it) {
    const int l = it / PRO_PER_L; int r = it % PRO_PER_L; PItem t; t.winmap = false; t.skip = false;
    if (r < PRO_I_WIN) { const int nb = r % 288; t.skip = nb >= 160 && nb < 192; t.winmap = true;
        pi_set(t, A.in[7] + (size_t)l * 1024 * 9216, 9216, WLP(l, WO_WIN), 1024, 0, 0, r); return t; } r -= PRO_I_WIN;
    if (r < PRO_I_SQ) { pi_set(t, A.in[12] + (size_t)l * 1048576, 1024, WLP(l, WO_D1), 3072, 0, 0, r); return t; } r -= PRO_I_SQ;
    if (r < PRO_I_SQ) { pi_set(t, A.in[20] + (size_t)l * 1048576, 1024, WLP(l, WO_D1), 3072, 0, 1024, r); return t; } r -= PRO_I_SQ;
    if (r < PRO_I_SQ) { pi_set(t, A.in[21] + (size_t)l * 1048576, 1024, WLP(l, WO_D1), 3072, 0, 2048, r); return t; } r -= PRO_I_SQ;
    if (r < PRO_I_SQ) { pi_set(t, A.in[22] + (size_t)l * 1048576, 1024, WLP(l, WO_OUT), 1024, 0, 0, r); return t; } r -= PRO_I_SQ;
    if (r < PRO_I_R) { pi_set(t, A.in[24] + (size_t)l * 262144, 256, WLP(l, WO_R), 1024, 0, 0, r); return t; } r -= PRO_I_R;
    if (r < PRO_I_R) { pi_set(t, A.in[29] + (size_t)l * 262144, 256, WLP(l, WO_R), 1024, 256 + ((r % 8) >> 2) * 128, 0, r); return t; } r -= PRO_I_R;
    if (r < PRO_I_R) { pi_set(t, A.in[30] + (size_t)l * 262144, 256, WLP(l, WO_R), 1024, 384 + ((r % 8) >> 2) * 128, 0, r); return t; } r -= PRO_I_R;
    pi_set(t, A.in[31] + (size_t)l * 262144, 1024, WLP(l, WO_SD), 256, 0, 0, r); return t;
}
__device__ __forceinline__ void pi_load(const PItem& t, f32x4 (&v)[8], int lane) {
    const int rr = lane >> 3, c4 = (lane & 7) * 4;
#pragma unroll
    for (int i = 0; i < 8; ++i) v[i] = *(const f32x4*)(t.W + (size_t)(t.k0 + 8 * i + rr) * t.N + t.n0 + c4);
}
__device__ __forceinline__ void pi_store(const PItem& t, const f32x4 (&v)[8], LAS float* scr, int lane) {
    const int rr = lane >> 3, c4 = (lane & 7) * 4;
#pragma unroll
    for (int i = 0; i < 8; ++i) { LAS float* d = scr + (8 * i + rr) * 33 + c4; d[0] = v[i].x; d[1] = v[i].y; d[2] = v[i].z; d[3] = v[i].w; }
    LDS_WAIT(); asm volatile("" ::: "memory");
    const int c = lane & 7;
#pragma unroll
    for (int j = 0; j < 4; ++j) { const int n = (lane >> 3) + 8 * j; const LAS float* sp = scr + (8 * c) * 33 + n;
        v4u o; o.x = pk2(sp[0 * 33], sp[1 * 33]); o.y = pk2(sp[2 * 33], sp[3 * 33]); o.z = pk2(sp[4 * 33], sp[5 * 33]); o.w = pk2(sp[6 * 33], sp[7 * 33]);
        const int row = t.winmap ? win_row(t.n0 + n) : t.n0 + n;
        *(v4u*)(t.WT + (size_t)(t.rowbase + row) * t.ldwt + t.k0 + 8 * c) = o; }
    LDS_WAIT(); asm volatile("" ::: "memory");
}

__device__ __forceinline__ void ph_prologue(const Frame& F, const Args& A) {
    LAS float* scr = (LAS float*)(F.lds + F.wave * 16384);
    { const int stride = F.NGW, hi = 2 * PRO_PER_L; int it = F.gw;
      if (it < hi) { PItem t0 = pro_item(A, it), t1 = t0; f32x4 v0[8], v1[8]; bool h1 = it + stride < hi;
        if (!t0.skip) pi_load(t0, v0, F.lane);
        for (;;) {
            if (h1) { t1 = pro_item(A, it + stride); if (!t1.skip) pi_load(t1, v1, F.lane); }
            if (!t0.skip) pi_store(t0, v0, scr, F.lane);
            if (!h1) break;
#pragma unroll
            for (int i = 0; i < 8; ++i) v0[i] = v1[i];
            t0 = t1; it += stride; h1 = it + stride < hi; } } }
#if FAST_WIN
    {
        LAS float* sW = (LAS float*)F.lds; LAS float* sT = sW + 32 * 256;
        __syncthreads();
        if (F.tid < 256) sT[F.tid] = cospif((float)F.tid / 128.0f);
        for (int it = F.bid; it < 2 * 4 * 32; it += F.G) {
            const int l = it >> 7, g = (it >> 5) & 3, k0 = (it & 31) * 32;
            __syncthreads();
            for (int e = F.tid; e < 32 * 256; e += 512) sW[e] = A.in[7][((size_t)l * 1024 + k0 + (e >> 8)) * 9216 + COL_F + g * 256 + (e & 255)];
            __syncthreads();
            const int o = F.tid & 255, kh = F.tid >> 8; int j = o >> 1, odd = o & 1; if (o == 1) { j = 128; odd = 0; }
            const int m0 = odd ? 192 : 0; float acc[16];
#pragma unroll
            for (int q = 0; q < 16; ++q) acc[q] = 0.f;
            for (int c = 0; c < 256; c += 4) { const float r0 = sT[(j * c + m0) & 255], r1 = sT[(j * (c + 1) + m0) & 255], r2 = sT[(j * (c + 2) + m0) & 255], r3 = sT[(j * (c + 3) + m0) & 255];
#pragma unroll
                for (int q = 0; q < 16; ++q) { const f32x4 w = *(const LAS f32x4*)(sW + (kh * 16 + q) * 256 + c); acc[q] += w.x * r0; acc[q] += w.y * r1; acc[q] += w.z * r2; acc[q] += w.w * r3; } }
            bf16* dst = WLP(l, WO_WIN) + (size_t)(COL_F + g * 256 + o) * 1024 + k0 + kh * 16;
            v4u w0, w1; w0.x = pk2(acc[0], acc[1]); w0.y = pk2(acc[2], acc[3]); w0.z = pk2(acc[4], acc[5]); w0.w = pk2(acc[6], acc[7]);
            w1.x = pk2(acc[8], acc[9]); w1.y = pk2(acc[10], acc[11]); w1.z = pk2(acc[12], acc[13]); w1.w = pk2(acc[14], acc[15]);
            *(v4u*)dst = w0; *(v4u*)(dst + 8) = w1;
        }
        __syncthreads();
    }
#endif
    float* MOD = (float*)(A.ws + WS_CTL) + CW_MOD;
    LAS float* part = (LAS float*)(F.lds + 8 * 16384 - 8192);
    LAS float* ssil = (LAS float*)(F.lds + 8 * 16384 - 8192 - 12288);
    if (F.bid < 2 * 96) { for (int e = F.tid; e < 3072; e += NWAVES * 64) { const int k = e & 1023; ssil[e] = siluf_(e < 1024 ? A.in[1][k] : e < 2048 ? A.in[1][1024 + k] : A.in[3][k]); } }
    __syncthreads();
    for (int it = F.bid; it < 2 * 96; it += F.G) {
        const int l = it / 96, nb = it % 96, n = nb * 64 + F.lane;
        const float* wm = A.in[4] + (size_t)l * 1024 * 6144 + n;
        float a0 = 0.f, a1 = 0.f, a2 = 0.f;
#pragma unroll 32
        for (int k = F.wave * 128; k < F.wave * 128 + 128; ++k) {
            const float w = wm[(size_t)k * 6144];
            a0 += ssil[k] * w; a1 += ssil[1024 + k] * w; a2 += ssil[2048 + k] * w;
        }
        __syncthreads();
        part[(F.wave * 3 + 0) * 64 + F.lane] = a0; part[(F.wave * 3 + 1) * 64 + F.lane] = a1; part[(F.wave * 3 + 2) * 64 + F.lane] = a2;
        __syncthreads();
        if (F.wave < 3) { float s = A.in[5][l * 6144 + n];
#pragma unroll
            for (int w = 0; w < 8; ++w) s += part[(w * 3 + F.wave) * 64 + F.lane];
            MOD[(l * 3 + F.wave) * 6144 + n] = s; }
    }
    for (long i = F.gtid; i < 2L * 4096 * 256; i += F.NT) {
        const int l = (int)(i >> 20), n = (int)((i >> 8) & 4095), kk = (int)(i & 255), pn = n >> 8, rr = n & 255, gate = rr >> 7, rho = rr & 127, d = pn >> 3, cb = pn & 7;
        const int cho = 128 * cb + rho, blk = cho >> 6, e = cho & 63, chi = 256 * (cb >> 1) + kk; float v = 0.f;
        if ((chi >> 6) == blk) v = (gate ? A.in[17] : A.in[15])[((size_t)(l * 2 + d) * 16 + blk) * 4096 + (chi & 63) * 64 + e];
        WLP(l, WO_LRU)[i & 0xFFFFF] = (bf16)f2bf(v);
    }
    for (long i = F.gtid; i < 2L * 65536; i += F.NT) {
        const int which = (int)(i >> 16), n = (int)((i >> 8) & 255), k = (int)(i & 255); float v;
        if (which == 0) { const int k1 = n >> 1, cp = n & 1, t1 = k >> 1, c = k & 1; const float rev = (float)((k1 * t1) & 127) * (1.f / 128.f);
            const float cs = __builtin_amdgcn_cosf(rev), sn = __builtin_amdgcn_sinf(rev); v = cp == 0 ? (c == 0 ? cs : sn) : (c == 0 ? -sn : cs); }
        else { const int h = n >> 7, k2 = (n >> 1) & 63, cp = n & 1, hp = k >> 7, t2 = (k >> 1) & 63, c = k & 1; const float rev = (float)((k2 * t2) & 63) * (1.f / 64.f);
            const float cs = __builtin_amdgcn_cosf(rev), sn = __builtin_amdgcn_sinf(rev); v = (h != hp) ? 0.f : (cp == 0 ? (c == 0 ? cs : sn) : (c == 0 ? -sn : cs)); }
        WLP(0, WO_TAB)[i] = (bf16)f2bf(v);
    }
    for (long i = F.gtid; i < 4096; i += F.NT) ((float*)(A.ws + WS_W + WO_TAB + 262144))[i] = log1pf(expf(-A.in[19][i]));
}

__device__ __forceinline__ void norm_mod_row(const f32x4 (&v)[4], const float* g, const float* sc, const float* sh, bf16* orow, int lane) {
    float s = 0.f;
#pragma unroll
    for (int j = 0; j < 4; ++j) s += (v[j].x * v[j].x + v[j].y * v[j].y) + (v[j].z * v[j].z + v[j].w * v[j].w);
    const float rs = rsqrtf(wave_sum(s) * (1.f / 1024.f) + EPS);
#pragma unroll
    for (int j = 0; j < 4; ++j) { const int c = 4 * lane + 256 * j;
        const f32x4 gg = *(const f32x4*)(g + c), s1 = *(const f32x4*)(sc + c), s0 = *(const f32x4*)(sh + c);
        const float y0 = v[j].x * rs * gg.x * (1.f + s1.x) + s0.x, y1 = v[j].y * rs * gg.y * (1.f + s1.y) + s0.y, y2 = v[j].z * rs * gg.z * (1.f + s1.z) + s0.z, y3 = v[j].w * rs * gg.w * (1.f + s1.w) + s0.w;
        *(unsigned long long*)(orow + c) = (unsigned long long)pk2(y0, y1) | ((unsigned long long)pk2(y2, y3) << 32); }
}
__device__ __forceinline__ void ph_norm1(const Frame& F, const Args& A, int l) {
    bf16* H = WSP(bf16, WS_H);
    for (int R = F.gw; R < MROWS; R += F.NGW) {
        const int b = R / TPB, p = R % TPB, s = (p < CTX) ? 2 : b;
        const float* X = (p < CTX) ? A.in[2] + ((size_t)b * CTX + p) * 1024 : A.in[0] + ((size_t)b * SEQ + (p - CTX)) * 1024;
        f32x4 v[4];
#pragma unroll
        for (int j = 0; j < 4; ++j) v[j] = *(const f32x4*)(X + 4 * F.lane + 256 * j);
        norm_mod_row(v, A.in[6] + l * 1024, MODP(l, s, 1), MODP(l, s, 0), H + (size_t)R * 1024, F.lane);
    }
}

__device__ __forceinline__ void ph_uelem(const Frame& F, const Args& A, int l) {
    const float* U = WSP(float, WS_U);
    bf16 *Kb = WSP(bf16, WS_KB), *Vb = WSP(bf16, WS_VB), *Qb = WSP(bf16, WS_QB), *LXb = WSP(bf16, WS_LXB), *GLG = WSP(bf16, WS_GLG), *ZP = WSP(bf16, WS_ZP), *GT = WSP(bf16, WS_GATES);
    LAS float* sF = (LAS float*)F.lds; LAS float* sT = sF + 1024;
    if (F.tid < 256) sT[F.tid] = cospif((float)F.tid / 128.0f);
    __syncthreads();
    for (int R = F.bid; R < MROWS; R += F.G) {
        const float* u = U + (size_t)R * INW; const int p = R % TPB; const bool lat = p >= CTX; const int t = p - CTX;
        for (int gi = F.wave; gi < 32; gi += 8) {
            const bool isq = gi >= 16; const int grp = gi & 15;
            const float v = u[(isq ? COL_Q : COL_K) + grp * 64 + F.lane];
            const float ss = wave_sum(v * v);
            float y = v * rsqrtf(ss * (1.f / 64.f) + EPS) * (isq ? A.in[8] : A.in[9])[l * 64 + F.lane];
            const float part = sx<16>(y);
            if (lat) { const int axis = F.lane >> 5, hf = (F.lane >> 4) & 1, f = F.lane & 15;
                const float pos = (float)(axis ? (t & 63) : (t >> 6)); const float inv = exp2f(-(float)f * (13.287712379549449f / 16.f));
                float sn, cs; sincosf(pos * inv, &sn, &cs);
                y = hf ? (part * sn + y * cs) : (y * cs - part * sn); }
            if (isq) y *= QSCALE;
            (isq ? Qb : Kb)[(size_t)R * 1024 + grp * 64 + F.lane] = (bf16)f2bf(y);
        }
        for (int c = F.tid; c < 1024; c += 512) { const size_t o = (size_t)R * 1024 + c;
            Vb[o] = (bf16)f2bf(u[COL_V + c]); LXb[o] = (bf16)f2bf(u[COL_LX + c]); GLG[o] = (bf16)f2bf(gelu_tanh(u[COL_LG + c])); sF[c] = u[COL_F + c]; }
        for (int c = F.tid; c < 3072; c += 512) GT[(size_t)R * 3072 + c] = (bf16)f2bf(sigmoidf_(u[COL_G + c]));
        __syncthreads();
        for (int o = F.tid; o < 1024; o += 512) { const int g = o >> 8, oo = o & 255; int j = oo >> 1, odd = oo & 1; if (oo == 1) { j = 128; odd = 0; }
            const int m0 = odd ? 192 : 0; float acc = 0.f;
            for (int c = 0; c < 256; ++c) acc += sF[g * 256 + c] * sT[(j * c + m0) & 255];
            ZP[(size_t)R * 1024 + o] = (bf16)f2bf(acc); }
        __syncthreads();
    }
}

__device__ __forceinline__ void ph_conv(const Frame& F, const Args& A, int l) {
    const bf16* LXb = WSP(bf16, WS_LXB); bf16* UC = WSP(bf16, WS_UC);
    const int c8 = (int)(F.gtid & 127) * 8, r0 = (int)(F.gtid >> 7), rstep = (int)(F.NT >> 7);
    float w[4][8], bia[8];
#pragma unroll
    for (int j = 0; j < 4; ++j) { const f32x4 a = *(const f32x4*)(A.in[13] + l * 4096 + j * 1024 + c8), b = *(const f32x4*)(A.in[13] + l * 4096 + j * 1024 + c8 + 4);
        w[j][0] = a.x; w[j][1] = a.y; w[j][2] = a.z; w[j][3] = a.w; w[j][4] = b.x; w[j][5] = b.y; w[j][6] = b.z; w[j][7] = b.w; }
    { const f32x4 a = *(const f32x4*)(A.in[14] + l * 1024 + c8), b = *(const f32x4*)(A.in[14] + l * 1024 + c8 + 4);
      bia[0] = a.x; bia[1] = a.y; bia[2] = a.z; bia[3] = a.w; bia[4] = b.x; bia[5] = b.y; bia[6] = b.z; bia[7] = b.w; }
    for (int Rb = r0; Rb < MROWS; Rb += 4 * rstep) {
        v4u x[4][4];
#pragma unroll
        for (int u = 0; u < 4; ++u) { const int R = Rb + u * rstep; if (R < MROWS) { const int p = R % TPB, lo = p < CTX ? 0 : CTX, hi = p < CTX ? CTX : TPB;
#pragma unroll
            for (int j = 0; j < 4; ++j) { const int pp = p + j - 2; x[u][j] = (pp >= lo && pp < hi) ? *(const v4u*)(LXb + (size_t)(R + j - 2) * 1024 + c8) : (v4u){0u, 0u, 0u, 0u}; } } }
#pragma unroll
        for (int u = 0; u < 4; ++u) { const int R = Rb + u * rstep; if (R < MROWS) { float acc[8];
#pragma unroll
            for (int e = 0; e < 8; ++e) acc[e] = bia[e];
#pragma unroll
            for (int j = 0; j < 4; ++j) { const unsigned xs[4] = {x[u][j].x, x[u][j].y, x[u][j].z, x[u][j].w};
#pragma unroll
                for (int q = 0; q < 4; ++q) { acc[2 * q] += w[j][2 * q] * bf2f(xs[q] & 0xffffu); acc[2 * q + 1] += w[j][2 * q + 1] * bf2f(xs[q] >> 16); } }
            v4u o; o.x = pk2(acc[0], acc[1]); o.y = pk2(acc[2], acc[3]); o.z = pk2(acc[4], acc[5]); o.w = pk2(acc[6], acc[7]);
            *(v4u*)(UC + (size_t)R * 1024 + c8) = o; } }
    }
}
#if !FAST_LRU
__device__ __forceinline__ void ph_lrucoef(const Frame& F, const Args& A, int l) {
    const bf16* UC = WSP(bf16, WS_UC); unsigned* AB = WSP(unsigned, WS_AB);
    for (long i = F.gtid; i < 2L * MROWS * 1024; i += F.NT) {
        const int d = (int)(i / ((long)MROWS * 1024)); const long rem = i % ((long)MROWS * 1024); const int R = (int)(rem >> 10), ch = (int)(rem & 1023), blk = ch >> 6, e = ch & 63;
        const float* wa = A.in[15] + ((size_t)(l * 2 + d) * 16 + blk) * 4096 + e; const float* wi = A.in[17] + ((size_t)(l * 2 + d) * 16 + blk) * 4096 + e;
        float r = A.in[16][(l * 2 + d) * 1024 + ch], ig = A.in[18][(l * 2 + d) * 1024 + ch];
        const bf16* ur = UC + (size_t)R * 1024 + blk * 64;
        for (int dd = 0; dd < 64; ++dd) { const float x = bf2f(ur[dd]); r += x * wa[dd * 64]; ig += x * wi[dd * 64]; }
        const float lam = A.in[19][(l * 2 + d) * 1024 + ch]; const float sp = log1pf(expf(-lam));
        const float la = -8.f * sigmoidf_(r) * sp; const float mult = sqrtf(-expm1f(2.f * la));
        const float bc = mult * sigmoidf_(ig) * bf2f(ur[e]);
        AB[i] = pk2(la, bc);
    }
}
#endif
struct LruSched {
    const char* uc; const char* w; int G, c;
    __device__ __forceinline__ bool next(int i, pg8::UnitG& U) const {
        const long id = (long)i * G + c; if (id >= 66 * 16) return false;
        const int pm = (int)(id >> 4), pn = (int)(id & 15);
        U.a = uc + ((size_t)pm * 256 * 1024 + 256 * ((pn & 7) >> 1)) * 2; U.b = w + (size_t)pn * 256 * 256 * 2; U.row0 = pm * 256; U.pn = pn; U.e = 0; U.valid = 256; U.rows = nullptr; return true;
    }
};
struct EpiLru {
    static constexpr bool PERM = false;
    unsigned* AB; const bf16* UC; const float* ba; const float* bi; const float* sp;
    __device__ __forceinline__ void operator()(const f32x4 (&acc)[2][2][4][2], const pg8::UnitG& u, int wr, int wc, int fr, int fq) const {
        const int d = u.pn >> 3, cb = u.pn & 7, ch0 = 128 * cb + wc * 32 + 4 * fq;
        f32x4 vba[2], vbi[2], vsp[2];
#pragma unroll
        for (int n = 0; n < 2; ++n) { vba[n] = *(const f32x4*)(ba + d * 1024 + ch0 + 16 * n) * -1.4426950408889634f; vbi[n] = *(const f32x4*)(bi + d * 1024 + ch0 + 16 * n) * -1.4426950408889634f; vsp[n] = *(const f32x4*)(sp + d * 1024 + ch0 + 16 * n) * -8.f; }
#pragma unroll
        for (int ai = 0; ai < 2; ++ai) { unsigned long long uxs[4][2];
#pragma unroll
            for (int m = 0; m < 4; ++m)
#pragma unroll
                for (int n = 0; n < 2; ++n) uxs[m][n] = *(const unsigned long long*)(UC + ((size_t)u.row0 + ai * 128 + wr * 64 + m * 16 + fr) * 1024 + ch0 + 16 * n);
#pragma unroll
            for (int m = 0; m < 4; ++m) { const size_t R = (size_t)u.row0 + ai * 128 + wr * 64 + m * 16 + fr;
#pragma unroll
                for (int n = 0; n < 2; ++n) { const int ch = ch0 + 16 * n;
                    const unsigned long long ux = uxs[m][n];
                    const float x[4] = {bf2f((unsigned)ux & 0xffffu), bf2f(((unsigned)ux) >> 16), bf2f((unsigned)(ux >> 32) & 0xffffu), bf2f((unsigned)(ux >> 48))};
                    const f32x4 r = acc[ai][0][m][n], g = acc[ai][1][m][n]; v4u o;
#pragma unroll
                    for (int e = 0; e < 4; ++e) {
                        const float la = vsp[n][e] * __builtin_amdgcn_rcpf(1.f + __builtin_amdgcn_exp2f(__builtin_fmaf(r[e], -1.4426950408889634f, vba[n][e])));
                        const float mult = __builtin_amdgcn_sqrtf(1.f - __builtin_amdgcn_exp2f(la * 2.8853900817779268f));
                        o[e] = pk2(la, mult * __builtin_amdgcn_rcpf(1.f + __builtin_amdgcn_exp2f(__builtin_fmaf(g[e], -1.4426950408889634f, vbi[n][e]))) * x[e]); }
                    *(v4u*)(AB + ((size_t)d * MROWS + R) * 1024 + ch) = o; } }
            asm volatile("" ::: "memory"); }
    }
};
__device__ __forceinline__ void ph_lru_gemm(const Frame& F, const Args& A, int l, int Ge) {
    LruSched S{(const char*)WSP(bf16, WS_UC), (const char*)WLP(l, WO_LRU), Ge, F.bid};
    EpiLru E{WSP(unsigned, WS_AB), WSP(bf16, WS_UC), A.in[16] + l * 2048, A.in[18] + l * 2048, (const float*)(A.ws + WS_W + WO_TAB + 262144) + l * 2048};
    pg8::gemm_phase_g<EpiLru, LruSched, false>(F.lds, 256, 1024, 256, S, E);
}
struct FftSched {
    const char* x; const char* w; int nunits, G, c;
    __device__ __forceinline__ bool next(int i, pg8::UnitG& U) const {
        const long id = (long)i * G + c; if (id >= nunits) return false;
        U.a = x + (size_t)id * 256 * 256 * 2; U.b = w; U.row0 = (int)id * 256; U.pn = 0; U.e = 0; U.valid = 256; U.rows = nullptr; return true;
    }
};
struct EpiFftA {
    static constexpr bool PERM = false;
    unsigned* XB;
    __device__ __forceinline__ void operator()(const f32x4 (&acc)[2][2][4][2], const pg8::UnitG& u, int wr, int wc, int fr, int fq) const {
#pragma unroll
        for (int ai = 0; ai < 2; ++ai)
#pragma unroll
            for (int m = 0; m < 4; ++m) { int r0 = u.row0; asm volatile("" : "+s"(r0));
                const int row = r0 + ai * 128 + wr * 64 + m * 16 + fr, t2 = row & 63; const size_t bc = (size_t)(row >> 6);
#pragma unroll
                for (int bj = 0; bj < 2; ++bj)
#pragma unroll
                    for (int n = 0; n < 2; ++n) { const int k1 = 64 * bj + 16 * wc + 8 * n + 2 * fq; const f32x4 v = acc[ai][bj][m][n];
#pragma unroll
                        for (int q = 0; q < 2; ++q) { const int kk = k1 + q; const float rev = (float)(kk * t2) * (1.f / 8192.f);
                            const float cs = __builtin_amdgcn_cosf(rev), sn = __builtin_amdgcn_sinf(rev); const float yr = v[2 * q], yi = v[2 * q + 1];
                            XB[(bc * 64 + (kk >> 1)) * 128 + (kk & 1) * 64 + t2] = pk2(yr * cs + yi * sn, yi * cs - yr * sn); } }
                asm volatile("" ::: "memory"); }
    }
};
struct EpiBf16Plain {
    static constexpr bool PERM = true;
    bf16* C; int ldc;
    __device__ __forceinline__ void operator()(const f32x4 (&acc)[2][2][4][2], const pg8::UnitG& u, int wr, int wc, int fr, int fq) const {
#pragma unroll
        for (int ai = 0; ai < 2; ++ai)
#pragma unroll
            for (int m = 0; m < 4; ++m) { bf16* rowp = C + (size_t)(u.row0 + ai * 128 + wr * 64 + m * 16 + fr) * ldc + u.pn * 256 + wc * 32 + 8 * fq;
#pragma unroll
                for (int bj = 0; bj < 2; ++bj) { const f32x4 v0 = acc[ai][bj][m][0], v1 = acc[ai][bj][m][1];
                    v4u o; o.x = pk2(v0[0], v0[1]); o.y = pk2(v0[2], v0[3]); o.z = pk2(v1[0], v1[1]); o.w = pk2(v1[2], v1[3]);
                    *(v4u*)(rowp + bj * 128) = o; } }
    }
};
struct EpiBf16U {
    static constexpr bool PERM = true; static constexpr int MIDK = 0;
    bf16* C; int ldc;
    __device__ __forceinline__ void operator()(const f32x4 (&acc)[2][2][4][2], const pg8::Unit& u, int wr, int wc, int fr, int fq) const {
#pragma unroll
        for (int ai = 0; ai < 2; ++ai)
#pragma unroll
            for (int m = 0; m < 4; ++m) { bf16* rowp = C + (size_t)(u.pm * 256 + ai * 128 + wr * 64 + m * 16 + fr) * ldc + u.pn * 256 + wc * 32 + 8 * fq;
#pragma unroll
                for (int bj = 0; bj < 2; ++bj) { const f32x4 v0 = acc[ai][bj][m][0], v1 = acc[ai][bj][m][1];
                    v4u o; o.x = pk2(v0[0], v0[1]); o.y = pk2(v0[2], v0[3]); o.z = pk2(v1[0], v1[1]); o.w = pk2(v1[2], v1[3]);
                    *(v4u*)(rowp + bj * 128) = o; } }
    }
};
__device__ __forceinline__ void ph_fft_a_gemm(const Frame& F, const Args& A) {
    FftSched S{(const char*)WSP(bf16, WS_XA), (const char*)WLP(0, WO_TAB), 256, F.G, F.bid};
    EpiFftA E{WSP(unsigned, WS_XB)};
    pg8::gemm_phase_g<EpiFftA, FftSched, false>(F.lds, 256, 256, 256, S, E);
}
__device__ __forceinline__ void ph_fft_b_gemm(const Frame& F, const Args& A) {
    FftSched S{(const char*)WSP(bf16, WS_XB), (const char*)(WLP(0, WO_TAB) + 65536), 256, F.G, F.bid};
    EpiBf16Plain E{WSP(bf16, WS_GB), 256};
    pg8::gemm_phase_g<EpiBf16Plain, FftSched, false>(F.lds, 256, 256, 256, S, E);
}
__device__ __forceinline__ void ph_scan1(const Frame& F, const Args& A) {
    const unsigned* AB = WSP(unsigned, WS_AB); float2* SUMM = WSP(float2, WS_SUMM);
    for (int it = F.gw; it < NB * 2 * NCHUNK * 16; it += F.NGW) {
        const int cg = it & 15, ck = (it >> 4) % NCHUNK, bd = (it >> 4) / NCHUNK, b = bd >> 1, d = bd & 1, ch = cg * 64 + F.lane;
        const unsigned* ab = AB + ((size_t)d * MROWS + (size_t)b * TPB + ck * 64) * 1024 + ch;
        float ac = 1.f, h = 0.f;
#pragma unroll
        for (int q = 0; q < 4; ++q) { unsigned w[16];
#pragma unroll
            for (int k = 0; k < 16; ++k) { const int i = q * 16 + k, ii = d ? 63 - i : i; w[k] = ab[(size_t)ii * 1024]; }
#pragma unroll
            for (int k = 0; k < 16; ++k) { const float a = __expf(bf2f(w[k] & 0xffffu)); h = a * h + bf2f(w[k] >> 16); ac *= a; } }
        SUMM[((size_t)bd * NCHUNK + ck) * 1024 + ch] = make_float2(ac, h);
    }
}
__device__ __forceinline__ void ph_scan2(const Frame& F, const Args& A) {
    const float2* SUMM = WSP(float2, WS_SUMM); float* CARRY = WSP(float, WS_CARRY);
    if (F.gtid < 4096) {
        const int bd = (int)(F.gtid >> 10), ch = (int)(F.gtid & 1023), d = bd & 1; float h = 0.f;
        for (int s = 0; s < NCHUNK; ++s) { const int ck = d ? (s < 4 ? 3 - s : NCHUNK + 3 - s) : s;
            const size_t o = ((size_t)bd * NCHUNK + ck) * 1024 + ch; CARRY[o] = h; const float2 v = SUMM[o]; h = v.x * h + v.y; }
    }
}
__device__ __forceinline__ void ph_scan3(const Frame& F, const Args& A) {
    const unsigned* AB = WSP(unsigned, WS_AB); const float* CARRY = WSP(float, WS_CARRY); const bf16* GLG = WSP(bf16, WS_GLG); bf16* MX = WSP(bf16, WS_MIXIN);
    for (int it = F.gw; it < NB * NCHUNK * 16; it += F.NGW) {
        const int cg = it & 15, ck = (it >> 4) % NCHUNK, b = (it >> 4) / NCHUNK, ch = cg * 64 + F.lane; const size_t R0 = (size_t)b * TPB + ck * 64;
        const unsigned* ab0 = AB + R0 * 1024 + ch; const unsigned* ab1 = AB + ((size_t)MROWS + R0) * 1024 + ch;
        float hf[64]; float h = CARRY[((size_t)(b * 2 + 0) * NCHUNK + ck) * 1024 + ch];
#pragma unroll
        for (int q = 0; q < 4; ++q) { unsigned w[16];
#pragma unroll
            for (int k = 0; k < 16; ++k) w[k] = ab0[(size_t)(q * 16 + k) * 1024];
#pragma unroll
            for (int k = 0; k < 16; ++k) { h = __expf(bf2f(w[k] & 0xffffu)) * h + bf2f(w[k] >> 16); hf[q * 16 + k] = h; } }
        h = CARRY[((size_t)(b * 2 + 1) * NCHUNK + ck) * 1024 + ch];
#pragma unroll
        for (int q = 3; q >= 0; --q) { unsigned w[16]; bf16 g[16];
#pragma unroll
            for (int k = 0; k < 16; ++k) { const int i = q * 16 + 15 - k; w[k] = ab1[(size_t)i * 1024]; g[k] = GLG[(R0 + i) * 1024 + ch]; }
#pragma unroll
            for (int k = 0; k < 16; ++k) { const int i = q * 16 + 15 - k; h = __expf(bf2f(w[k] & 0xffffu)) * h + bf2f(w[k] >> 16);
                MX[(R0 + i) * 3072 + 1024 + ch] = (bf16)f2bf((hf[i] + h) * bf2f(g[k])); } }
    }
}

__device__ __forceinline__ void ph_fft_t1_fast(const Frame& F, const Args& A) {
    const unsigned* ZP = WSP(unsigned, WS_ZP); unsigned* XA = WSP(unsigned, WS_XA); LAS unsigned* T = (LAS unsigned*)F.lds;
    for (int item = F.bid; item < 512; item += F.G) {
        const int b = item >> 8, t2 = (item >> 2) & 63, cq = item & 3;
        __syncthreads();
#pragma unroll
        for (int i = 0; i < 8; ++i) { const int p = F.tid + 512 * i, t1 = p >> 5, w4 = (p & 31) * 4;
            const v4u v = *(const v4u*)(ZP + ((size_t)b * TPB + CTX + 64 * t1 + t2) * 512 + cq * 128 + w4);
            T[t1 * 129 + w4] = v.x; T[t1 * 129 + w4 + 1] = v.y; T[t1 * 129 + w4 + 2] = v.z; T[t1 * 129 + w4 + 3] = v.w; }
        __syncthreads();
#pragma unroll
        for (int i = 0; i < 16; ++i) { const int p = F.tid + 512 * i, cc = p >> 6, t1 = (p & 63) * 2;
            const unsigned long long v = (unsigned long long)T[t1 * 129 + cc] | ((unsigned long long)T[(t1 + 1) * 129 + cc] << 32);
            *(unsigned long long*)(XA + (((size_t)b * 512 + cq * 128 + cc) * 64 + t2) * 128 + t1) = v; }
    }
    __syncthreads();
}
__device__ __forceinline__ void ph_fft_t2_fast(const Frame& F, const Args& A) {
    const unsigned* GB = WSP(unsigned, WS_GB); bf16* MX = WSP(bf16, WS_MIXIN); LAS unsigned* T = (LAS unsigned*)F.lds;
    LAS unsigned short* OUTS = (LAS unsigned short*)(F.lds + 2 * 128 * 65 * 4);
    const bool bal = F.G == 256; const int nmine = bal ? (F.bid < 252 ? 2 : 4) : (520 - F.bid + F.G - 1) / F.G;
    for (int ii = 0; ii < nmine; ++ii) {
        int b, kp, g;
        if (bal) { if (F.bid < 252) { const int f = 2 * F.bid + ii; b = f / 252; const int rem = f % 252; kp = 1 + (rem >> 2); g = rem & 3; }
                   else { const int h = 4 * (F.bid - 252) + ii; b = h >> 3; kp = ((h >> 2) & 1) ? 64 : 0; g = h & 3; } }
        else { const int item = F.bid + ii * F.G; b = item / 260; const int rem = item % 260; kp = rem >> 2; g = rem & 3; }
        const int k1a = kp, k1b = (128 - kp) & 127;
        __syncthreads();
#pragma unroll
        for (int i = 0; i < 8; ++i) { const int p = F.tid + 512 * i, blk = p >> 11, cc = (p >> 4) & 127, w4 = (p & 15) * 4, kk = blk ? k1b : k1a;
            const v4u v = *(const v4u*)(GB + (((size_t)b * 512 + g * 128 + cc) * 64 + (kk >> 1)) * 128 + (kk & 1) * 64 + w4);
            LAS unsigned* d = T + blk * (128 * 65) + cc * 65 + w4; d[0] = v.x; d[1] = v.y; d[2] = v.z; d[3] = v.w; }
        __syncthreads();
        const int jc = F.tid & 255, j = (jc == 0 || jc == 128) ? 0 : (jc < 128 ? jc : 256 - jc);
        const int nset = (k1a == k1b) ? 1 : 2;
        for (int set = 0; set < nset; ++set) { const int ka = set ? k1b : k1a;
            for (int k2 = (F.tid >> 8); k2 < 64; k2 += 2) {
                const int mk2 = (ka == 0) ? ((64 - k2) & 63) : 63 - k2;
                const unsigned own = T[set * (128 * 65) + j * 65 + k2], mir = T[(nset == 1 ? 0 : (1 - set)) * (128 * 65) + j * 65 + mk2];
                float o; if (jc == 0) o = 0.5f * (bf2f(own & 0xffffu) + bf2f(mir & 0xffffu)); else if (jc == 128) o = 0.5f * (bf2f(own >> 16) + bf2f(mir >> 16)); else if (jc < 128) o = bf2f(mir & 0xffffu); else o = bf2f(own & 0xffffu);
                OUTS[k2 * 256 + jc] = (unsigned short)f2bf(o * 6.9053396600248786e-4f); }
            __syncthreads();
#pragma unroll
            for (int i = 0; i < 4; ++i) { const int p = F.tid + 512 * i, k2 = p >> 5, c8 = (p & 31) * 8;
                *(v4u*)(MX + ((size_t)b * TPB + CTX + ka + 128 * k2) * 3072 + 2048 + g * 256 + c8) = *(const LAS v4u*)(OUTS + k2 * 256 + c8); }
            __syncthreads(); }
    }
    __syncthreads();
    const float2* GC = WSP(float2, WS_GC);
    for (long i = F.gtid; i < (long)NB * CTX * 1024; i += F.NT) {
        const int col = (int)(i & 1023), k = (int)((i >> 10) & 255), b = (int)(i >> 18), g = col >> 8, jc = col & 255, km = (256 - k) & 255;
        const int j = (jc == 0 || jc == 128) ? 0 : (jc < 128 ? jc : 256 - jc); const size_t base = ((size_t)b * 512 + g * 128 + j) * 256;
        const float2 w = GC[base + k], wm = GC[base + km];
        float o; if (jc == 0) o = 0.5f * (w.x + wm.x); else if (jc == 128) o = 0.5f * (w.y + wm.y); else if (jc < 128) o = wm.x; else o = w.x;
        MX[((size_t)b * TPB + k) * 3072 + 2048 + col] = (bf16)f2bf(o * 3.90625e-3f);
    }
}
__device__ __forceinline__ void ph_scan2_fast(const Frame& F, const Args& A) {
    const float2* SUMM = WSP(float2, WS_SUMM); float* CARRY = WSP(float, WS_CARRY);
    for (int it = F.gw; it < 256; it += F.NGW) {
        const int bd = it >> 6, d = bd & 1, ch = (it & 63) * 16 + (F.lane & 15), seg = F.lane >> 4;
        float2 v[33]; float as = 1.f, hs = 0.f;
#pragma unroll
        for (int q = 0; q < 33; ++q) { const int sidx = seg * 33 + q, ck = d ? (sidx < 4 ? 3 - sidx : NCHUNK + 3 - sidx) : sidx; v[q] = SUMM[((size_t)bd * NCHUNK + ck) * 1024 + ch]; }
#pragma unroll
        for (int q = 0; q < 33; ++q) { hs = v[q].x * hs + v[q].y; as *= v[q].x; }
        const float a16 = sx<16>(as), h16 = sx<16>(hs), a32 = sx<32>(as), h32 = sx<32>(hs), a48 = sx<32>(a16), h48 = sx<32>(h16);
        float h = 0.f;
#pragma unroll
        for (int jx = 0; jx < 3; ++jx) { const int x = jx ^ seg;
            const float aj = x == 0 ? as : (x == 1 ? a16 : (x == 2 ? a32 : a48)), hj = x == 0 ? hs : (x == 1 ? h16 : (x == 2 ? h32 : h48));
            if (jx < seg) h = aj * h + hj; }
#pragma unroll
        for (int q = 0; q < 33; ++q) { const int sidx = seg * 33 + q, ck = d ? (sidx < 4 ? 3 - sidx : NCHUNK + 3 - sidx) : sidx; CARRY[((size_t)bd * NCHUNK + ck) * 1024 + ch] = h; h = v[q].x * h + v[q].y; }
    }
}

__device__ __forceinline__ void ph_fft_t1(const Frame& F, const Args& A) {
    const unsigned* ZP = WSP(unsigned, WS_ZP); unsigned* XA = WSP(unsigned, WS_XA);
    for (long i = F.gtid; i < (long)NB * 512 * 8192; i += F.NT) {
        const int t1 = (int)(i & 127), t2 = (int)((i >> 7) & 63), cc = (int)((i >> 13) & 511), b = (int)(i >> 22);
        XA[i] = ZP[((size_t)b * TPB + CTX + 64 * t1 + t2) * 512 + cc];
    }
}
#if !FAST_FFT
__device__ __forceinline__ void ph_fft_a(const Frame& F, const Args& A) {
    const unsigned* XA = WSP(unsigned, WS_XA); unsigned* XB = WSP(unsigned, WS_XB);
    for (long i = F.gtid; i < (long)NB * 512 * 8192; i += F.NT) {
        const int k1 = (int)(i & 127); const long row = i >> 7; const int t2 = (int)(row & 63); const long bc = row >> 6;
        const unsigned* x = XA + row * 128; float yr = 0.f, yi = 0.f;
        for (int t1 = 0; t1 < 128; ++t1) { const unsigned w = x[t1]; const float wr = bf2f(w & 0xffffu), wi = bf2f(w >> 16);
            float sn, cs; sincospif((float)((k1 * t1) & 127) / 64.0f, &sn, &cs);
            yr += wr * cs + wi * sn; yi += wi * cs - wr * sn; }
        float sn, cs; sincospif((float)(k1 * t2) / 4096.0f, &sn, &cs);
        const float zr = yr * cs + yi * sn, zi = yi * cs - yr * sn;
        XB[(bc * 64 + (k1 >> 1)) * 128 + (k1 & 1) * 64 + t2] = pk2(zr, zi);
    }
}
#endif
#if !FAST_FFT
__device__ __forceinline__ void ph_fft_b(const Frame& F, const Args& A) {
    const unsigned* XB = WSP(unsigned, WS_XB); unsigned* GB = WSP(unsigned, WS_GB);
    for (long i = F.gtid; i < (long)NB * 512 * 8192; i += F.NT) {
        const int k2 = (int)(i & 63); const long hrow = i >> 6;
        const unsigned* x = XB + hrow * 64; float yr = 0.f, yi = 0.f;
        for (int t2 = 0; t2 < 64; ++t2) { const unsigned w = x[t2]; const float wr = bf2f(w & 0xffffu), wi = bf2f(w >> 16);
            float sn, cs; sincospif((float)((k2 * t2) & 63) / 32.0f, &sn, &cs);
            yr += wr * cs + wi * sn; yi += wi * cs - wr * sn; }
        GB[hrow * 64 + k2] = pk2(yr, yi);
    }
}
#endif
__device__ __forceinline__ void ph_fft_c(const Frame& F, const Args& A) {
    const unsigned* ZP = WSP(unsigned, WS_ZP); float2* GC = WSP(float2, WS_GC);
    LAS unsigned* Z = (LAS unsigned*)F.lds; LAS float* TWc = (LAS float*)(F.lds + 16384); LAS float* TWs = TWc + 256;
    __syncthreads();
    if (F.tid < 256) { const float rev = (float)F.tid * (1.f / 256.f); TWc[F.tid] = __builtin_amdgcn_cosf(rev); TWs[F.tid] = __builtin_amdgcn_sinf(rev); }
    for (int item = F.bid; item < 256; item += F.G) {
        const int b = item >> 7, c0 = ((item >> 2) & 31) * 16, kq = item & 3;
        __syncthreads();
        for (int e = F.tid; e < 4096; e += 512) Z[e] = ZP[((size_t)b * TPB + (e >> 4)) * 512 + c0 + (e & 15)];
        __syncthreads();
        const int cc = F.tid & 15, kb = kq * 64 + (F.tid >> 4) * 2; float ar[2], ai[2]; int m[2];
#pragma unroll
        for (int q = 0; q < 2; ++q) { ar[q] = 0.f; ai[q] = 0.f; m[q] = 0; }
#pragma unroll 4
        for (int t = 0; t < 256; ++t) { const unsigned w = Z[t * 16 + cc]; const float wr = bf2f(w & 0xffffu), wi = bf2f(w >> 16);
#pragma unroll
            for (int q = 0; q < 2; ++q) { const float tc = TWc[m[q]], ts = TWs[m[q]]; ar[q] += wr * tc + wi * ts; ai[q] += wi * tc - wr * ts; m[q] = (m[q] + kb + q) & 255; } }
#pragma unroll
        for (int q = 0; q < 2; ++q) GC[((size_t)b * 512 + c0 + cc) * 256 + kb + q] = make_float2(ar[q], ai[q]);
    }
    __syncthreads();
}
__device__ __forceinline__ void ph_fft_t2(const Frame& F, const Args& A) {
    const unsigned* GB = WSP(unsigned, WS_GB); const float2* GC = WSP(float2, WS_GC); bf16* MX = WSP(bf16, WS_MIXIN);
    for (long i = F.gtid; i < (long)MROWS * 1024; i += F.NT) {
        const int R = (int)(i >> 10), col = (int)(i & 1023), g = col >> 8, jc = col & 255, b = R / TPB, p = R % TPB;
        const bool lat = p >= CTX; const int T = lat ? SEQ : CTX, k = lat ? p - CTX : p, km = (T - k) & (T - 1);
        const int j = (jc == 0 || jc == 128) ? 0 : (jc < 128 ? jc : 256 - jc); const int cc = g * 128 + j;
        float vr, vi, mr, mi;
        if (lat) { const size_t base = ((size_t)b * 512 + cc) * 64;
            const unsigned w = GB[(base + ((k & 127) >> 1)) * 128 + (k & 1) * 64 + (k >> 7)], wm = GB[(base + ((km & 127) >> 1)) * 128 + (km & 1) * 64 + (km >> 7)];
            vr = bf2f(w & 0xffffu); vi = bf2f(w >> 16); mr = bf2f(wm & 0xffffu); mi = bf2f(wm >> 16); }
        else { const float2 w = GC[((size_t)b * 512 + cc) * 256 + k], wm = GC[((size_t)b * 512 + cc) * 256 + km]; vr = w.x; vi = w.y; mr = wm.x; mi = wm.y; }
        float o;
        if (jc == 0) o = 0.5f * (vr + mr); else if (jc == 128) o = 0.5f * (vi + mi); else if (jc < 128) o = mr; else o = vr;
        o *= lat ? 6.9053396600248786e-4f : 3.90625e-3f;
        MX[(size_t)R * 3072 + 2048 + col] = (bf16)f2bf(o);
    }
}

#if !FAST_ATTN
__device__ __forceinline__ void ph_attn_naive(const Frame& F, const Args& A, int l) {
    const bf16 *Kb = WSP(bf16, WS_KB), *Vb = WSP(bf16, WS_VB), *Qb = WSP(bf16, WS_QB); bf16* MX = WSP(bf16, WS_MIXIN);
    const float* lq = A.in[10] + l * 256; float d01 = 0.f, d23 = 0.f;
    for (int i = 0; i < 64; ++i) { d01 += lq[i] * lq[64 + i]; d23 += lq[128 + i] * lq[192 + i]; }
    const float lam_init = 0.8f - 0.6f * expf(-0.3f * (float)l), lam = expf(d01) - expf(d23) + lam_init;
    LAS float* Ks = (LAS float*)F.lds; LAS float* Vs = Ks + 64 * 132; LAS float* Qs = Vs + 64 * 132; LAS float* Ws = Qs + 16 * 128;
    const int r = F.tid >> 5, tl = F.tid & 31;
    for (int u = F.bid; u < 16 * 528; u += F.G) {
        const int bh = u / 528, qb = u % 528, b = bh >> 3, h = bh & 7; const size_t R0 = (size_t)b * TPB + qb * 16; const int nkeys = qb < 16 ? CTX : TPB;
        __syncthreads();
        for (int e = F.tid; e < 2048; e += 512) Qs[e] = bf2f(Qb[(R0 + (e >> 7)) * 1024 + h * 128 + (e & 127)]);
        float m0 = -1e30f, l0 = 0.f, m1 = -1e30f, l1 = 0.f;
        for (int pass = 0; pass < 2; ++pass) {
            float inv0 = 0.f, inv1 = 0.f;
            if (pass == 1) {
#pragma unroll
                for (int o = 1; o < 32; o <<= 1) { float mo = __shfl_xor(m0, o), lo = __shfl_xor(l0, o), mn = fmaxf(m0, mo); l0 = l0 * exp2f(m0 - mn) + lo * exp2f(mo - mn); m0 = mn;
                    mo = __shfl_xor(m1, o); lo = __shfl_xor(l1, o); mn = fmaxf(m1, mo); l1 = l1 * exp2f(m1 - mn) + lo * exp2f(mo - mn); m1 = mn; }
                inv0 = 1.f / l0; inv1 = lam / l1;
            }
            float o4[4] = {0.f, 0.f, 0.f, 0.f};
            for (int kt = 0; kt < nkeys; kt += 64) {
                __syncthreads();
                for (int e = F.tid; e < 1024; e += 512) { const int kk = e >> 4, c8 = (e & 15) * 8; const size_t src = ((size_t)b * TPB + kt + kk) * 1024 + h * 128 + c8;
                    const v4u kv = *(const v4u*)(Kb + src);
                    Ks[kk * 132 + c8 + 0] = bf2f(kv.x & 0xffffu); Ks[kk * 132 + c8 + 1] = bf2f(kv.x >> 16); Ks[kk * 132 + c8 + 2] = bf2f(kv.y & 0xffffu); Ks[kk * 132 + c8 + 3] = bf2f(kv.y >> 16);
                    Ks[kk * 132 + c8 + 4] = bf2f(kv.z & 0xffffu); Ks[kk * 132 + c8 + 5] = bf2f(kv.z >> 16); Ks[kk * 132 + c8 + 6] = bf2f(kv.w & 0xffffu); Ks[kk * 132 + c8 + 7] = bf2f(kv.w >> 16);
                    if (pass == 1) { const v4u vv = *(const v4u*)(Vb + src);
                        Vs[kk * 132 + c8 + 0] = bf2f(vv.x & 0xffffu); Vs[kk * 132 + c8 + 1] = bf2f(vv.x >> 16); Vs[kk * 132 + c8 + 2] = bf2f(vv.y & 0xffffu); Vs[kk * 132 + c8 + 3] = bf2f(vv.y >> 16);
                        Vs[kk * 132 + c8 + 4] = bf2f(vv.z & 0xffffu); Vs[kk * 132 + c8 + 5] = bf2f(vv.z >> 16); Vs[kk * 132 + c8 + 6] = bf2f(vv.w & 0xffffu); Vs[kk * 132 + c8 + 7] = bf2f(vv.w >> 16); } }
                __syncthreads();
#pragma unroll
                for (int kq = 0; kq < 2; ++kq) { const int kk = tl + 32 * kq; float s0 = 0.f, s1 = 0.f;
                    for (int d = 0; d < 64; d += 4) { const f32x4 q0 = *(const LAS f32x4*)(Qs + r * 128 + d), q1 = *(const LAS f32x4*)(Qs + r * 128 + 64 + d), k0 = *(const LAS f32x4*)(Ks + kk * 132 + d), k1 = *(const LAS f32x4*)(Ks + kk * 132 + 64 + d);
                        s0 += q0.x * k0.x + q0.y * k0.y + q0.z * k0.z + q0.w * k0.w; s1 += q1.x * k1.x + q1.y * k1.y + q1.z * k1.z + q1.w * k1.w; }
                    if (pass == 0) { float mn = fmaxf(m0, s0); l0 = l0 * exp2f(m0 - mn) + exp2f(s0 - mn); m0 = mn; mn = fmaxf(m1, s1); l1 = l1 * exp2f(m1 - mn) + exp2f(s1 - mn); m1 = mn; }
                    else Ws[r * 64 + kk] = exp2f(s0 - m0) * inv0 - exp2f(s1 - m1) * inv1; }
                if (pass == 1) { __syncthreads();
                    for (int kk = 0; kk < 64; ++kk) { const float w = Ws[r * 64 + kk];
#pragma unroll
                        for (int i = 0; i < 4; ++i) o4[i] += w * Vs[kk * 132 + tl + 32 * i]; } }
            }
            if (pass == 1) { float ss = o4[0] * o4[0] + o4[1] * o4[1] + o4[2] * o4[2] + o4[3] * o4[3];
#pragma unroll
                for (int o = 1; o < 32; o <<= 1) ss += __shfl_xor(ss, o);
                const float sc = rsqrtf(ss * (1.f / 128.f) + EPS) * (1.f - lam_init);
#pragma unroll
                for (int i = 0; i < 4; ++i) MX[(R0 + r) * 3072 + h * 128 + tl + 32 * i] = (bf16)f2bf(o4[i] * sc * A.in[11][l * 128 + tl + 32 * i]); }
        }
    }
}

#endif
namespace da {
using bf16x8 = __attribute__((ext_vector_type(8))) short;
using s16x4  = __attribute__((ext_vector_type(4))) short;
using f32x16 = __attribute__((ext_vector_type(16))) float;
using u32x4  = __attribute__((ext_vector_type(4))) unsigned;
constexpr int KVBLK = 64, LDK = 1024;
constexpr size_t SHM_V = KVBLK * 128 * 2, SHM_K = KVBLK * 128 * 2;
constexpr float THR = 8.f;
#define DA_KSWZ(row, colB) ((row) * 256 + ((colB) ^ (((row) & 7) << 4)))
#define DA_SBAR() __builtin_amdgcn_sched_barrier(0)
__device__ __forceinline__ int crow(int r, int hi) { return (r & 3) + 8 * (r >> 2) + 4 * hi; }
__device__ __forceinline__ unsigned cvtpk(float lo, float hi) { unsigned r; asm volatile("v_cvt_pk_bf16_f32 %0, %1, %2" : "=v"(r) : "v"(lo), "v"(hi)); return r; }
__device__ __forceinline__ void expSM(f32x16& p0, f32x16& p1, float soff) {
  for (int r = 0; r < 16; ++r) p0[r] = __builtin_amdgcn_exp2f(p0[r] - soff); for (int r = 0; r < 16; ++r) p1[r] = __builtin_amdgcn_exp2f(p1[r] - soff);
}
__device__ __forceinline__ void finishSM(f32x16& p0, f32x16& p1, float& l_reg, bf16x8& pa0, bf16x8& pa1, bf16x8& pa2, bf16x8& pa3) {
  float ps = 0; for (int r = 0; r < 16; ++r) ps += p0[r]; for (int r = 0; r < 16; ++r) ps += p1[r];
  l_reg += ps;
#define DA_PK4(P, BASE, OUT) do { unsigned a0 = cvtpk(P[BASE + 0], P[BASE + 1]), a1 = cvtpk(P[BASE + 2], P[BASE + 3]);   \
    unsigned b0 = cvtpk(P[BASE + 4], P[BASE + 5]), b1 = cvtpk(P[BASE + 6], P[BASE + 7]);                              \
    auto r0 = __builtin_amdgcn_permlane32_swap(a0, b0, false, false); auto r1 = __builtin_amdgcn_permlane32_swap(a1, b1, false, false); \
    u32x4 w = {r0[0], r1[0], r0[1], r1[1]}; OUT = *reinterpret_cast<bf16x8*>(&w); } while (0)
  DA_PK4(p0, 0, pa0); DA_PK4(p0, 8, pa1); DA_PK4(p1, 0, pa2); DA_PK4(p1, 8, pa3);
#undef DA_PK4
}
__device__ __forceinline__ void qkt(f32x16& p0, f32x16& p1, const char* Ks, const bf16x8* qr, int r32, int hi, int cbm) {
  p0 = f32x16{}; p1 = f32x16{};
#pragma unroll
  for (int d0 = 0; d0 < 4; ++d0) { const int cb = cbm + (d0 * 16 + hi * 8) * 2;
    bf16x8 b0 = *reinterpret_cast<const bf16x8*>(Ks + DA_KSWZ(r32, cb));
    bf16x8 b1 = *reinterpret_cast<const bf16x8*>(Ks + DA_KSWZ(32 + r32, cb));
    p0 = __builtin_amdgcn_mfma_f32_32x32x16_bf16(b0, qr[d0], p0, 0, 0, 0);
    p1 = __builtin_amdgcn_mfma_f32_32x32x16_bf16(b1, qr[d0], p1, 0, 0, 0); }
}
__device__ __forceinline__ int v_st(int k, int c) { const int kk = (k & ~0xC) | ((k & 4) << 1) | ((k & 8) >> 1); return ((kk >> 3) * 4 + (c >> 5)) * 512 + ((kk & 7) * 32 + (c & 31)) * 2; }
__device__ __forceinline__ int v_rd_base(int lane) { return ((lane & 3) << 3) | (((lane >> 2) & 3) << 6) | (((lane >> 4) & 1) << 5) | (((lane >> 5) & 1) << 8); }
constexpr int v_rd_off(int d0, int ks, int half) { return d0 * 512 + ks * 4096 + half * 2048; }
template <int OFF> __device__ __forceinline__ s16x4 tr_read(int vb) {
  s16x4 r; asm volatile("ds_read_b64_tr_b16 %0, %1 offset:%2" : "=&v"(r) : "v"(vb), "i"(OFF) : "memory"); return r;
}
template <int D0> __device__ __forceinline__ void pv_one(f32x16& od, int vb, bf16x8 pa0, bf16x8 pa1, bf16x8 pa2, bf16x8 pa3) {
  const s16x4 l0 = tr_read<v_rd_off(D0, 0, 0)>(vb), h0 = tr_read<v_rd_off(D0, 0, 1)>(vb), l1 = tr_read<v_rd_off(D0, 1, 0)>(vb), h1 = tr_read<v_rd_off(D0, 1, 1)>(vb);
  const s16x4 l2 = tr_read<v_rd_off(D0, 2, 0)>(vb), h2 = tr_read<v_rd_off(D0, 2, 1)>(vb), l3 = tr_read<v_rd_off(D0, 3, 0)>(vb), h3 = tr_read<v_rd_off(D0, 3, 1)>(vb);
  asm volatile("s_waitcnt lgkmcnt(0)" ::: "memory"); DA_SBAR();
#define DA_PK(L, H) (bf16x8){L[0], L[1], L[2], L[3], H[0], H[1], H[2], H[3]}
  od = __builtin_amdgcn_mfma_f32_32x32x16_bf16(pa0, DA_PK(l0, h0), od, 0, 0, 0);
  od = __builtin_amdgcn_mfma_f32_32x32x16_bf16(pa1, DA_PK(l1, h1), od, 0, 0, 0);
  od = __builtin_amdgcn_mfma_f32_32x32x16_bf16(pa2, DA_PK(l2, h2), od, 0, 0, 0);
  od = __builtin_amdgcn_mfma_f32_32x32x16_bf16(pa3, DA_PK(l3, h3), od, 0, 0, 0);
#undef DA_PK
}
__device__ __forceinline__ void pv_d0(f32x16* o, int vb, bf16x8 pa0, bf16x8 pa1, bf16x8 pa2, bf16x8 pa3) {
  pv_one<0>(o[0], vb, pa0, pa1, pa2, pa3); pv_one<1>(o[1], vb, pa0, pa1, pa2, pa3); pv_one<2>(o[2], vb, pa0, pa1, pa2, pa3); pv_one<3>(o[3], vb, pa0, pa1, pa2, pa3);
}
__device__ __forceinline__ void unit(const unsigned short* __restrict__ Qb, const unsigned short* __restrict__ Kh, const unsigned short* __restrict__ Vh,
                                     unsigned short* __restrict__ Ob, int ldo, int seq, float lam, float oscale, float soff, const float* __restrict__ subg, char* lds) {
  const int tid = otid(), wid = tid >> 6, lane = tid & 63, r32 = lane & 31, hi = lane >> 5, mp = wid >> 2, wq = wid & 3;
  char* V_lds = lds; char* K_lds = lds + 2 * SHM_V;
  float* ws = (float*)(lds + 2 * SHM_V + 2 * SHM_K) + wid * 64; float* li_l = ws;
  float l_reg = 0; f32x16 o[4] = {}; bf16x8 qr[4];
  const unsigned short* Qw = Qb + (long)(wq * 32 + r32) * 1024 + mp * 64 + hi * 8;
#pragma unroll
  for (int d0 = 0; d0 < 4; ++d0) qr[d0] = *reinterpret_cast<const bf16x8*>(Qw + d0 * 16);
  const int cbm = mp * 128;
  const int sr = tid >> 4, sc = (tid & 15) * 8, vst0 = v_st(sr, sc), vst1 = v_st(32 + sr, sc);
  const int vb0 = (int)(uintptr_t)V_lds + v_rd_base(lane);
  struct { bf16x8 vs0, vs1, ks0, ks1; } sr_[2];
#define DA_SLOAD(i, k0) do { sr_[i].vs0 = *reinterpret_cast<const bf16x8*>(&Vh[(long)((k0) + sr) * LDK + sc]); sr_[i].vs1 = *reinterpret_cast<const bf16x8*>(&Vh[(long)((k0) + 32 + sr) * LDK + sc]); \
    sr_[i].ks0 = *reinterpret_cast<const bf16x8*>(&Kh[(long)((k0) + sr) * LDK + sc]); sr_[i].ks1 = *reinterpret_cast<const bf16x8*>(&Kh[(long)((k0) + 32 + sr) * LDK + sc]); } while (0)
#define DA_SWRITE(b, i) do { *(bf16x8*)(V_lds + (b) * SHM_V + vst0) = sr_[i].vs0;          \
    *(bf16x8*)(V_lds + (b) * SHM_V + vst1) = sr_[i].vs1; int kc = sc * 2;               \
    *(bf16x8*)(K_lds + (b) * SHM_K + DA_KSWZ(sr, kc)) = sr_[i].ks0;                       \
    *(bf16x8*)(K_lds + (b) * SHM_K + DA_KSWZ(32 + sr, kc)) = sr_[i].ks1; } while (0)
#define DA_SWAIT() asm volatile("s_waitcnt vmcnt(4)" ::: "memory")
  f32x16 pA0, pA1, pB0, pB1; bf16x8 pa0, pa1, pa2, pa3; const int NT = seq / KVBLK;
  constexpr int SE = 0, SO = 1;
  DA_SLOAD(SE, 0); asm volatile("s_waitcnt vmcnt(0)" ::: "memory"); DA_SWRITE(0, SE); __syncthreads();
  qkt(pA0, pA1, K_lds, qr, r32, hi, cbm); expSM(pA0, pA1, soff);
  DA_SLOAD(SO, KVBLK); if (2 < NT) DA_SLOAD(SE, 2 * KVBLK);
  DA_SWAIT(); DA_SWRITE(1, SO); __syncthreads();
  for (int j = 1; j + 1 < NT; j += 2) {
    DA_SBAR(); qkt(pB0, pB1, K_lds + SHM_K, qr, r32, hi, cbm);
    finishSM(pA0, pA1, l_reg, pa0, pa1, pa2, pa3); DA_SBAR();
    DA_SLOAD(SO, (j + 2) * KVBLK); DA_SBAR();
    pv_d0(o, vb0, pa0, pa1, pa2, pa3); expSM(pB0, pB1, soff);
    __syncthreads(); DA_SWAIT(); DA_SWRITE(0, SE);
    __syncthreads();
    DA_SBAR(); qkt(pA0, pA1, K_lds, qr, r32, hi, cbm);
    finishSM(pB0, pB1, l_reg, pa0, pa1, pa2, pa3); DA_SBAR();
    if (j + 3 < NT) DA_SLOAD(SE, (j + 3) * KVBLK); DA_SBAR();
    pv_d0(o, vb0 + (int)SHM_V, pa0, pa1, pa2, pa3); expSM(pA0, pA1, soff);
    __syncthreads(); DA_SWAIT(); DA_SWRITE(1, SO);
    __syncthreads();
  }
  DA_SBAR(); qkt(pB0, pB1, K_lds + SHM_K, qr, r32, hi, cbm);
  finishSM(pA0, pA1, l_reg, pa0, pa1, pa2, pa3); DA_SBAR();
  pv_d0(o, vb0, pa0, pa1, pa2, pa3); expSM(pB0, pB1, soff);
  __syncthreads();
  finishSM(pB0, pB1, l_reg, pa0, pa1, pa2, pa3); DA_SBAR();
  pv_d0(o, vb0 + (int)SHM_V, pa0, pa1, pa2, pa3);
  { auto rr = __builtin_amdgcn_permlane32_swap(__float_as_uint(l_reg), __float_as_uint(l_reg), false, false); l_reg = __uint_as_float(rr[0]) + __uint_as_float(rr[1]); }
  if (hi == 0) li_l[r32] = l_reg; asm volatile("s_waitcnt lgkmcnt(0)" ::: "memory");
  const float sgn = mp ? lam : 1.f;
#pragma unroll
  for (int r = 0; r < 16; ++r) { const float rl = sgn * __builtin_amdgcn_rcpf(li_l[crow(r, hi)]);
#pragma unroll
    for (int d0 = 0; d0 < 4; ++d0) o[d0][r] *= rl; }
  __syncthreads();
  int xb = wq * 4096 + lane; asm volatile("" : "+v"(xb));
  float* X = (float*)lds + xb;
  if (mp == 1) {
#pragma unroll
    for (int d0 = 0; d0 < 4; ++d0)
#pragma unroll
      for (int r = 0; r < 16; ++r) X[(d0 * 16 + r) * 64] = o[d0][r];
  }
  __syncthreads();
  if (mp == 0) {
    float gg[4];
#pragma unroll
    for (int d0 = 0; d0 < 4; ++d0) gg[d0] = subg[d0 * 32 + r32] * oscale;
    int ob = (wq * 32 + 4 * hi) * ldo + r32; asm volatile("" : "+v"(ob));
    unsigned short* Ow = Ob + ob;
#pragma unroll
    for (int r = 0; r < 16; ++r) { float a = 0.f; float v[4];
#pragma unroll
      for (int d0 = 0; d0 < 4; ++d0) { v[d0] = o[d0][r] - X[(d0 * 16 + r) * 64]; a += v[d0] * v[d0]; }
      a += sx<1>(a); a += sx<2>(a); a += sx<4>(a); a += sx<8>(a); a += sx<16>(a);
      a = rsqrtf(a * (1.f / 128.f) + EPS);
      const int orow = (r & 3) + 8 * (r >> 2);
#pragma unroll
      for (int d0 = 0; d0 < 4; ++d0) Ow[orow * ldo + d0 * 32] = (unsigned short)f2bf(v[d0] * a * gg[d0]); }
  }
  __syncthreads();
#undef DA_SLOAD
#undef DA_SWRITE
#undef DA_SWAIT
}

template <int D0> __device__ __forceinline__ void v_rd8(s16x4 (&f)[8], int vb) {
  f[0] = tr_read<v_rd_off(D0, 0, 0)>(vb); f[1] = tr_read<v_rd_off(D0, 0, 1)>(vb); f[2] = tr_read<v_rd_off(D0, 1, 0)>(vb); f[3] = tr_read<v_rd_off(D0, 1, 1)>(vb);
  f[4] = tr_read<v_rd_off(D0, 2, 0)>(vb); f[5] = tr_read<v_rd_off(D0, 2, 1)>(vb); f[6] = tr_read<v_rd_off(D0, 3, 0)>(vb); f[7] = tr_read<v_rd_off(D0, 3, 1)>(vb);
}
__device__ __forceinline__ void pv_mm(f32x16& od, const s16x4 (&f)[8], bf16x8 pa0, bf16x8 pa1, bf16x8 pa2, bf16x8 pa3) {
#define DA_PK(L, H) (bf16x8){L[0], L[1], L[2], L[3], H[0], H[1], H[2], H[3]}
  od = __builtin_amdgcn_mfma_f32_32x32x16_bf16(pa0, DA_PK(f[0], f[1]), od, 0, 0, 0);
  od = __builtin_amdgcn_mfma_f32_32x32x16_bf16(pa1, DA_PK(f[2], f[3]), od, 0, 0, 0);
  od = __builtin_amdgcn_mfma_f32_32x32x16_bf16(pa2, DA_PK(f[4], f[5]), od, 0, 0, 0);
  od = __builtin_amdgcn_mfma_f32_32x32x16_bf16(pa3, DA_PK(f[6], f[7]), od, 0, 0, 0);
#undef DA_PK
}
__device__ __forceinline__ void pv_pipe(f32x16* o, int vb, bf16x8 pa0, bf16x8 pa1, bf16x8 pa2, bf16x8 pa3) {
  s16x4 fa[8], fb[8];
  v_rd8<0>(fa, vb); v_rd8<1>(fb, vb);
  asm volatile("s_waitcnt lgkmcnt(8)" ::: "memory"); DA_SBAR(); pv_mm(o[0], fa, pa0, pa1, pa2, pa3); DA_SBAR();
  v_rd8<2>(fa, vb);
  asm volatile("s_waitcnt lgkmcnt(8)" ::: "memory"); DA_SBAR(); pv_mm(o[1], fb, pa0, pa1, pa2, pa3); DA_SBAR();
  v_rd8<3>(fb, vb);
  asm volatile("s_waitcnt lgkmcnt(8)" ::: "memory"); DA_SBAR(); pv_mm(o[2], fa, pa0, pa1, pa2, pa3); DA_SBAR();
  asm volatile("s_waitcnt lgkmcnt(0)" ::: "memory"); DA_SBAR(); pv_mm(o[3], fb, pa0, pa1, pa2, pa3); DA_SBAR();
}
__device__ __forceinline__ void unit8(const unsigned short* __restrict__ Qb, const unsigned short* __restrict__ Kh, const unsigned short* __restrict__ Vh,
                                      unsigned short* __restrict__ Ob, int ldo, int seq, float lam, float oscale, float soff, const float* __restrict__ subg, LAS unsigned char* ldsl) {
  const int tid = otid(), wid = __builtin_amdgcn_readfirstlane(tid >> 6), lane = tid & 63, r32 = lane & 31, hi = lane >> 5, mp = wid >> 2, wq = wid & 3;
  constexpr int SLOT = 16384;
  char* lds = (char*)ldsl; char* K_lds = lds; const int vbase = (int)(uintptr_t)(lds + 3 * SLOT) + v_rd_base(lane);
  float* li_l = (float*)(lds + 6 * SLOT) + wid * 64;
  f32x16 o[4] = {}; bf16x8 qr[4];
  const unsigned short* Qw = Qb + (long)(wq * 32 + r32) * 1024 + mp * 64 + hi * 8;
#pragma unroll
  for (int d0 = 0; d0 < 4; ++d0) qr[d0] = *reinterpret_cast<const bf16x8*>(Qw + d0 * 16);
  asm volatile("s_waitcnt vmcnt(0)" ::: "memory");
  const int cbm = mp * 128;
  const unsigned wl = (unsigned)wid * 1024u;
  unsigned kso[2], vso[2];
#pragma unroll
  for (int i = 0; i < 2; ++i) { const int P = (i * 8 + wid) * 64 + lane;
    { const int row = P >> 4, chunk = (P & 15) ^ (row & 7); kso[i] = (unsigned)(row * LDK + chunk * 8) * 2u; }
    { const int sub = P >> 5, kk = (sub >> 2) * 8 + ((P & 31) >> 2), key = (kk & ~0xC) | ((kk & 4) << 1) | ((kk & 8) >> 1); vso[i] = (unsigned)(key * LDK + (sub & 3) * 32 + (P & 3) * 8) * 2u; } }
#define DA_DMA_K(t, slot) do { const unsigned to_ = (unsigned)(t) * (unsigned)(KVBLK * LDK * 2); _Pragma("unroll") for (int i_ = 0; i_ < 2; ++i_) \
      __builtin_amdgcn_global_load_lds((const unsigned*)((const char*)Kh + (kso[i_] + to_)), (LAS unsigned*)(ldsl + (slot) * SLOT + i_ * 8192 + wl), 16, 0, 0); } while (0)
#define DA_DMA_V(t, slot) do { const unsigned to_ = (unsigned)(t) * (unsigned)(KVBLK * LDK * 2); _Pragma("unroll") for (int i_ = 0; i_ < 2; ++i_) \
      __builtin_amdgcn_global_load_lds((const unsigned*)((const char*)Vh + (vso[i_] + to_)), (LAS unsigned*)(ldsl + (3 + (slot)) * SLOT + i_ * 8192 + wl), 16, 0, 0); } while (0)
#define U8_PK(t, slot, i_) __builtin_amdgcn_global_load_lds((const unsigned*)((const char*)Kh + (kso[i_] + (unsigned)(t) * (unsigned)(KVBLK * LDK * 2))), (LAS unsigned*)(ldsl + (slot) * SLOT + (i_) * 8192 + wl), 16, 0, 0)
#define U8_PV(t, slot, i_) __builtin_amdgcn_global_load_lds((const unsigned*)((const char*)Vh + (vso[i_] + (unsigned)(t) * (unsigned)(KVBLK * LDK * 2))), (LAS unsigned*)(ldsl + (3 + (slot)) * SLOT + (i_) * 8192 + wl), 16, 0, 0)
#define DA_WAITBAR(N) do { asm volatile("s_waitcnt vmcnt(" #N ") lgkmcnt(0)" ::: "memory"); __builtin_amdgcn_s_barrier(); asm volatile("" ::: "memory"); } while (0)
  f32x16 pA0, pA1, pB0, pB1; u32x4 pw0, pw1, pw2, pw3; const int NT = seq / KVBLK;
  bf16x8 kf[8];
  f32x16 negm, ol = {};
#pragma unroll
  for (int r = 0; r < 16; ++r) negm[r] = -soff;
  const bf16x8 ones = {0x3F80, 0x3F80, 0x3F80, 0x3F80, 0x3F80, 0x3F80, 0x3F80, 0x3F80};
  const int pkr = ((r32 & 3) + 4 * (r32 >> 3)), pk = (pkr & 7) + 16 * (pkr >> 3) + 8 * ((r32 >> 2) & 1);
#define U5_KADDR(d0) ((int)(uintptr_t)K_lds + pk * 256 + ((((cbm >> 4) + 2 * (d0) + hi) ^ (pk & 7)) * 16))
#define U5_KLOAD(slot) do { const int so_ = (slot) * SLOT; _Pragma("unroll") for (int d0 = 0; d0 < 4; ++d0) { const int ad_ = U5_KADDR(d0) + so_; \
    asm volatile("ds_read_b128 %0, %2\n\tds_read_b128 %1, %2 offset:8192" : "=&v"(kf[2 * d0]), "=&v"(kf[2 * d0 + 1]) : "v"(ad_) : "memory"); } } while (0)
#define U5_PIN(x) asm volatile("" : "+v"(x))
#define U5_EX(v) __builtin_amdgcn_exp2f(v)
#define U5_VRD(L, H, m) do { asm volatile("ds_read_b64_tr_b16 %0, %1 offset:%2" : "=&v"(L) : "v"(vb_), "i"(v_rd_off((m) >> 2, (m) & 3, 0)) : "memory"); \
    asm volatile("ds_read_b64_tr_b16 %0, %1 offset:%2" : "=&v"(H) : "v"(vb_), "i"(v_rd_off((m) >> 2, (m) & 3, 1)) : "memory"); } while (0)
#define U5_GAPA(MF, X, B4, PW, VR, CV0, CV1) do { MF; VR; CV0; CV1; U5_PIN(PW); DA_SBAR(); } while (0)
#define U5_CVT(P, b) cvtpk(P[b], P[b + 1])
#define U5_PHASE_A(C0, C1, P0, P1, VSLOT, HK0, HK1, HV0, HV1) do { const int vb_ = vbase + (VSLOT) * SLOT; \
    U5_GAPA(C0 = __builtin_amdgcn_mfma_f32_32x32x16_bf16(kf[0], qr[0], negm, 0, 0, 0), P0, 0, pw0, HK0, pw0[0] = U5_CVT(P0, 0), pw0[1] = U5_CVT(P0, 2)); \
    U5_GAPA(C1 = __builtin_amdgcn_mfma_f32_32x32x16_bf16(kf[1], qr[0], negm, 0, 0, 0), P0, 4, pw0, HK1, pw0[2] = U5_CVT(P0, 4), pw0[3] = U5_CVT(P0, 6)); \
    U5_GAPA(C0 = __builtin_amdgcn_mfma_f32_32x32x16_bf16(kf[2], qr[1], C0, 0, 0, 0), P0, 8, pw1, do { HV0; HV1; } while (0), pw1[0] = U5_CVT(P0, 8), pw1[1] = U5_CVT(P0, 10)); \
    U5_GAPA(C1 = __builtin_amdgcn_mfma_f32_32x32x16_bf16(kf[3], qr[1], C1, 0, 0, 0), P0, 12, pw1, U5_VRD(vl0, vh0, 0), pw1[2] = U5_CVT(P0, 12), pw1[3] = U5_CVT(P0, 14)); \
    U5_GAPA(C0 = __builtin_amdgcn_mfma_f32_32x32x16_bf16(kf[4], qr[2], C0, 0, 0, 0), P1, 0, pw2, U5_VRD(vl1, vh1, 1), pw2[0] = U5_CVT(P1, 0), pw2[1] = U5_CVT(P1, 2)); \
    U5_GAPA(C1 = __builtin_amdgcn_mfma_f32_32x32x16_bf16(kf[5], qr[2], C1, 0, 0, 0), P1, 4, pw2, U5_VRD(vl2, vh2, 2), pw2[2] = U5_CVT(P1, 4), pw2[3] = U5_CVT(P1, 6)); \
    U5_GAPA(C0 = __builtin_amdgcn_mfma_f32_32x32x16_bf16(kf[6], qr[3], C0, 0, 0, 0), P1, 8, pw3, U5_VRD(vl3, vh3, 3), pw3[0] = U5_CVT(P1, 8), pw3[1] = U5_CVT(P1, 10)); \
    U5_GAPA(C1 = __builtin_amdgcn_mfma_f32_32x32x16_bf16(kf[7], qr[3], C1, 0, 0, 0), P1, 12, pw3, U5_VRD(vl4, vh4, 4), pw3[2] = U5_CVT(P1, 12), pw3[3] = U5_CVT(P1, 14)); \
    } while (0)
#define U5_PKV(L, H) (bf16x8){L[0], L[1], L[2], L[3], H[0], H[1], H[2], H[3]}
#define U5_PAF(k) __builtin_bit_cast(bf16x8, pw##k)
#define U5_GAPB(WAITN, OD, PK, L, H, X, B2, NEXT) do { asm volatile("s_waitcnt lgkmcnt(" #WAITN ")" ::: "memory"); DA_SBAR(); \
    OD = __builtin_amdgcn_mfma_f32_32x32x16_bf16(PK, U5_PKV(L, H), OD, 0, 0, 0); NEXT; X[B2] = U5_EX(X[B2]); X[B2 + 1] = U5_EX(X[B2 + 1]); U5_PIN(X); DA_SBAR(); } while (0)
#define U5_GAPS(PK, X, B2) do { ol = __builtin_amdgcn_mfma_f32_32x32x16_bf16(PK, ones, ol, 0, 0, 0); X[B2] = U5_EX(X[B2]); X[B2 + 1] = U5_EX(X[B2 + 1]); U5_PIN(X); DA_SBAR(); } while (0)
#define U5_GAPN(WAITN, OD, PK, L, H, NEXT) do { asm volatile("s_waitcnt lgkmcnt(" #WAITN ")" ::: "memory"); DA_SBAR(); \
    OD = __builtin_amdgcn_mfma_f32_32x32x16_bf16(PK, U5_PKV(L, H), OD, 0, 0, 0); NEXT; DA_SBAR(); } while (0)
#define U5_PHASE_B(C0, C1, VSLOT, KSLOT, DOK) do { const int vb_ = vbase + (VSLOT) * SLOT; \
    U5_GAPS(U5_PAF(0), C0, 0); U5_GAPS(U5_PAF(1), C0, 2); U5_GAPS(U5_PAF(2), C0, 4); U5_GAPS(U5_PAF(3), C0, 6); \
    U5_GAPB(8, o[0], U5_PAF(0), vl0, vh0, C0, 8, U5_VRD(vl5, vh5, 5)); \
    U5_GAPB(8, o[0], U5_PAF(1), vl1, vh1, C0, 10, U5_VRD(vl0, vh0, 6)); \
    U5_GAPB(8, o[0], U5_PAF(2), vl2, vh2, C0, 12, U5_VRD(vl1, vh1, 7)); \
    U5_GAPB(8, o[0], U5_PAF(3), vl3, vh3, C0, 14, U5_VRD(vl2, vh2, 8)); \
    U5_GAPB(8, o[1], U5_PAF(0), vl4, vh4, C1, 0, U5_VRD(vl3, vh3, 9)); \
    U5_GAPB(8, o[1], U5_PAF(1), vl5, vh5, C1, 2, U5_VRD(vl4, vh4, 10)); \
    U5_GAPB(8, o[1], U5_PAF(2), vl0, vh0, C1, 4, U5_VRD(vl5, vh5, 11)); \
    U5_GAPB(8, o[1], U5_PAF(3), vl1, vh1, C1, 6, U5_VRD(vl0, vh0, 12)); \
    U5_GAPB(8, o[2], U5_PAF(0), vl2, vh2, C1, 8, U5_VRD(vl1, vh1, 13)); \
    U5_GAPB(8, o[2], U5_PAF(1), vl3, vh3, C1, 10, U5_VRD(vl2, vh2, 14)); \
    U5_GAPB(8, o[2], U5_PAF(2), vl4, vh4, C1, 12, U5_VRD(vl3, vh3, 15)); \
    U5_GAPB(8, o[2], U5_PAF(3), vl5, vh5, C1, 14, (void)0); \
    U5_GAPN(6, o[3], U5_PAF(0), vl0, vh0, (void)0); \
    if (DOK) { U5_GAPN(4, o[3], U5_PAF(1), vl1, vh1, U5_KLOAD(KSLOT)); U5_GAPN(10, o[3], U5_PAF(2), vl2, vh2, (void)0); U5_GAPN(8, o[3], U5_PAF(3), vl3, vh3, (void)0); } \
    else { U5_GAPN(4, o[3], U5_PAF(1), vl1, vh1, (void)0); U5_GAPN(2, o[3], U5_PAF(2), vl2, vh2, (void)0); U5_GAPN(0, o[3], U5_PAF(3), vl3, vh3, (void)0); } } while (0)
#define DA_ROT(x) ((x) == 2 ? 0 : (x) + 1)
#define DA_PRV(x) ((x) == 0 ? 2 : (x) - 1)
  s16x4 vl0, vh0, vl1, vh1, vl2, vh2, vl3, vh3, vl4, vh4, vl5, vh5;
  DA_DMA_K(0, 0); DA_DMA_K(1, 1); DA_DMA_V(0, 0);
  DA_WAITBAR(0);
  U5_KLOAD(0); DA_DMA_K(2, 2); DA_DMA_V(1, 1);
  DA_WAITBAR(4);
  DA_DMA_K(3, 0);
  DA_SBAR();
  pA0 = negm; pA1 = negm;
#pragma unroll
  for (int d0 = 0; d0 < 4; ++d0) { pA0 = __builtin_amdgcn_mfma_f32_32x32x16_bf16(kf[2 * d0], qr[d0], pA0, 0, 0, 0); pA1 = __builtin_amdgcn_mfma_f32_32x32x16_bf16(kf[2 * d0 + 1], qr[d0], pA1, 0, 0, 0); }
  DA_SBAR(); U5_KLOAD(1);
  expSM(pA0, pA1, 0.f);
  DA_WAITBAR(2);
  int c = 1;
  for (int j = 1; j + 1 < NT; j += 2) {
    { const bool mk = j + 3 < NT;
      DA_SBAR(); U5_PHASE_A(pB0, pB1, pA0, pA1, DA_PRV(c), if (mk) U8_PK(j + 3, c, 0), if (mk) U8_PK(j + 3, c, 1), U8_PV(j + 1, DA_ROT(c), 0), U8_PV(j + 1, DA_ROT(c), 1));
      U5_PHASE_B(pB0, pB1, DA_PRV(c), DA_ROT(c), true);
      if (mk) DA_WAITBAR(4); else DA_WAITBAR(2);
      c = DA_ROT(c); }
    { const bool mk = j + 4 < NT;
      DA_SBAR(); U5_PHASE_A(pA0, pA1, pB0, pB1, DA_PRV(c), if (mk) U8_PK(j + 4, c, 0), if (mk) U8_PK(j + 4, c, 1), U8_PV(j + 2, DA_ROT(c), 0), U8_PV(j + 2, DA_ROT(c), 1));
      U5_PHASE_B(pA0, pA1, DA_PRV(c), DA_ROT(c), true);
      if (mk) DA_WAITBAR(4); else DA_WAITBAR(2);
      c = DA_ROT(c); }
  }
  DA_SBAR(); U5_PHASE_A(pB0, pB1, pA0, pA1, DA_PRV(c), (void)0, (void)0, (void)0, (void)0);
  U5_PHASE_B(pB0, pB1, DA_PRV(c), 0, false);
  DA_WAITBAR(0);
  { u32x4 w0 = {cvtpk(pB0[0], pB0[1]), cvtpk(pB0[2], pB0[3]), cvtpk(pB0[4], pB0[5]), cvtpk(pB0[6], pB0[7])}, w1 = {cvtpk(pB0[8], pB0[9]), cvtpk(pB0[10], pB0[11]), cvtpk(pB0[12], pB0[13]), cvtpk(pB0[14], pB0[15])};
    u32x4 w2 = {cvtpk(pB1[0], pB1[1]), cvtpk(pB1[2], pB1[3]), cvtpk(pB1[4], pB1[5]), cvtpk(pB1[6], pB1[7])}, w3 = {cvtpk(pB1[8], pB1[9]), cvtpk(pB1[10], pB1[11]), cvtpk(pB1[12], pB1[13]), cvtpk(pB1[14], pB1[15])};
    const bf16x8 pa0 = __builtin_bit_cast(bf16x8, w0), pa1 = __builtin_bit_cast(bf16x8, w1), pa2 = __builtin_bit_cast(bf16x8, w2), pa3 = __builtin_bit_cast(bf16x8, w3); DA_SBAR();
    ol = __builtin_amdgcn_mfma_f32_32x32x16_bf16(pa0, ones, ol, 0, 0, 0); ol = __builtin_amdgcn_mfma_f32_32x32x16_bf16(pa1, ones, ol, 0, 0, 0);
    ol = __builtin_amdgcn_mfma_f32_32x32x16_bf16(pa2, ones, ol, 0, 0, 0); ol = __builtin_amdgcn_mfma_f32_32x32x16_bf16(pa3, ones, ol, 0, 0, 0);
    pv_d0(o, vbase + c * SLOT, pa0, pa1, pa2, pa3); }
#undef U5_KADDR
#undef U5_KLOAD
#undef U5_PIN
#undef U5_EX
#undef U5_GAPA
#undef U5_CVT
#undef U5_PHASE_A
#undef U5_VRD
#undef U5_PKV
#undef U5_PAF
#undef U5_GAPB
#undef U5_GAPS
#undef U5_GAPN
#undef U5_PHASE_B
  const int tid2 = otid(), wid2 = __builtin_amdgcn_readfirstlane(tid2 >> 6), lane2 = tid2 & 63; { const int r32 = lane2 & 31, hi = lane2 >> 5, mp = wid2 >> 2, wq = wid2 & 3, lane = lane2; float* li_l = (float*)(lds + 6 * SLOT) + wid2 * 64;
  const float sgn = mp ? lam : 1.f;
#pragma unroll
  for (int r = 0; r < 16; ++r) { const float rl = sgn * __builtin_amdgcn_rcpf(ol[r]);
#pragma unroll
    for (int d0 = 0; d0 < 4; ++d0) o[d0][r] *= rl; }
  __syncthreads();
  int xb = wq * 4096 + lane; asm volatile("" : "+v"(xb));
  float* X = (float*)lds + xb;
  if (mp == 1) {
#pragma unroll
    for (int d0 = 0; d0 < 4; ++d0)
#pragma unroll
      for (int r = 0; r < 16; ++r) X[(d0 * 16 + r) * 64] = o[d0][r];
  }
  __syncthreads();
  if (mp == 0) {
    float gg[4];
#pragma unroll
    for (int d0 = 0; d0 < 4; ++d0) gg[d0] = subg[d0 * 32 + r32] * oscale;
    int ob = (wq * 32 + 4 * hi) * ldo + r32; asm volatile("" : "+v"(ob));
    unsigned short* Ow = Ob + ob;
#pragma unroll
    for (int r = 0; r < 16; ++r) { float a = 0.f; float v[4];
#pragma unroll
      for (int d0 = 0; d0 < 4; ++d0) { v[d0] = o[d0][r] - X[(d0 * 16 + r) * 64]; a += v[d0] * v[d0]; }
      a += sx<1>(a); a += sx<2>(a); a += sx<4>(a); a += sx<8>(a); a += sx<16>(a);
      a = rsqrtf(a * (1.f / 128.f) + EPS);
      const int orow = (r & 3) + 8 * (r >> 2);
#pragma unroll
      for (int d0 = 0; d0 < 4; ++d0) Ow[orow * ldo + d0 * 32] = (unsigned short)f2bf(v[d0] * a * gg[d0]); }
  }
  }
  asm volatile("s_waitcnt vmcnt(0)" ::: "memory");
  __syncthreads();
#undef DA_DMA_K
#undef DA_DMA_V
#undef DA_WAITBAR
#undef DA_ROT
#undef DA_PRV
}
}
__device__ __forceinline__ void ph_attn(const Frame& F, const Args& A, int l) {
    const bf16 *Kb = WSP(bf16, WS_KB), *Vb = WSP(bf16, WS_VB), *Qb = WSP(bf16, WS_QB); bf16* MX = WSP(bf16, WS_MIXIN);
    const float* lq = A.in[10] + l * 256; float d01 = 0.f, d23 = 0.f;
    for (int i = 0; i < 64; ++i) { d01 += lq[i] * lq[64 + i]; d23 += lq[128 + i] * lq[192 + i]; }
    const float lam_init = 0.8f - 0.6f * expf(-0.3f * (float)l); float lam = expf(d01) - expf(d23) + lam_init;
    float mq = 0.f, mk = 0.f;
    for (int i = 0; i < 64; ++i) { mq = fmaxf(mq, fabsf(A.in[8][l * 64 + i])); mk = fmaxf(mk, fabsf(A.in[9][l * 64 + i])); }
    const float soff = __uint_as_float(__builtin_amdgcn_readfirstlane(__float_as_uint(64.f * mq * mk * QSCALE)));
    lam = __uint_as_float(__builtin_amdgcn_readfirstlane(__float_as_uint(lam))); const float osc = __uint_as_float(__builtin_amdgcn_readfirstlane(__float_as_uint(1.f - lam_init)));
    const int vcu = (F.G % 8 == 0) ? (F.bid % 8) * (F.G / 8) + F.bid / 8 : F.bid;
    for (int u = vcu; u < (l == DEPTH - 1 ? 1024 : 16 * 66); u += F.G) {
        const int bh = (u % 1024) / 64 , b = bh >> 3, h = bh & 7;
        int qb; int bb = b, hh = h;
        if (u < 1024) qb = 2 + (u & 63); else { const int v = u - 1024; bb = v >> 4; hh = (v >> 1) & 7; qb = v & 1; }
        const size_t R0 = (size_t)bb * TPB + qb * 128; const int seq = qb < 2 ? CTX : TPB;
#if ATTN_V2 == 8
        da::unit8(Qb + R0 * 1024 + hh * 128, Kb + (size_t)bb * TPB * 1024 + hh * 128, Vb + (size_t)bb * TPB * 1024 + hh * 128,
                  MX + R0 * 3072 + hh * 128, 3072, seq, lam, osc, soff, A.in[11] + l * 128, F.lds);
#else
        da::unit(Qb + R0 * 1024 + hh * 128, Kb + (size_t)bb * TPB * 1024 + hh * 128, Vb + (size_t)bb * TPB * 1024 + hh * 128,
                 MX + R0 * 3072 + hh * 128, 3072, seq, lam, osc, soff, A.in[11] + l * 128, (char*)F.lds);
#endif
    }
}

__device__ __forceinline__ void ph_mix(const Frame& F, const Args& A) {
    const float *PA = WSP(float, WS_PA), *PR = WSP(float, WS_PR), *PF = WSP(float, WS_PF); const bf16* GT = WSP(bf16, WS_GATES); bf16* MD = WSP(bf16, WS_MIXED);
    for (long i = F.gtid; i < (long)MROWS * 1024; i += F.NT) { const size_t R = (size_t)(i >> 10); const int c = (int)(i & 1023);
        MD[i] = (bf16)f2bf(bf2f(GT[R * 3072 + c]) * PA[i] + bf2f(GT[R * 3072 + 1024 + c]) * PR[i] + bf2f(GT[R * 3072 + 2048 + c]) * PF[i]); }
}
__device__ __forceinline__ void ph_resid_norm2(const Frame& F, const Args& A, int l) {
    float* X = WSP(float, WS_XALL); const float* Y1 = WSP(float, WS_Y1); bf16* TOK = WSP(bf16, WS_TOK);
    for (int R = F.gw; R < MROWS; R += F.NGW) {
        const int b = R / TPB, p = R % TPB, s = (p < CTX) ? 2 : b; const float* g1 = MODP(l, s, 2);
        f32x4 v[4];
#pragma unroll
        for (int j = 0; j < 4; ++j) { const int c = 4 * F.lane + 256 * j; const f32x4 x = *(const f32x4*)(X + (size_t)R * 1024 + c), y = *(const f32x4*)(Y1 + (size_t)R * 1024 + c), gg = *(const f32x4*)(g1 + c);
            v[j] = x + gg * y; *(f32x4*)(X + (size_t)R * 1024 + c) = v[j]; }
        norm_mod_row(v, A.in[23] + l * 1024, MODP(l, s, 4), MODP(l, s, 3), TOK + (size_t)R * 1024, F.lane);
    }
}
#define G1(T) __attribute__((address_space(1))) T
template <int CTRL, int RM = 0xf> __device__ __forceinline__ float dpp_f(float v) {
    return __uint_as_float(__builtin_amdgcn_update_dpp(__float_as_uint(v), __float_as_uint(v), CTRL, RM, 0xf, false)); }
__device__ __forceinline__ float wave_max63(float v) {
    asm volatile("s_nop 1\n\tv_max_f32_dpp %0, %0, %0 row_ror:1 row_mask:0xf bank_mask:0xf\n\ts_nop 1\n\tv_max_f32_dpp %0, %0, %0 row_ror:2 row_mask:0xf bank_mask:0xf\n\t"
                 "s_nop 1\n\tv_max_f32_dpp %0, %0, %0 row_ror:4 row_mask:0xf bank_mask:0xf\n\ts_nop 1\n\tv_max_f32_dpp %0, %0, %0 row_ror:8 row_mask:0xf bank_mask:0xf\n\t"
                 "s_nop 1\n\tv_max_f32_dpp %0, %0, %0 row_bcast:15 row_mask:0xa bank_mask:0xf\n\ts_nop 1\n\tv_max_f32_dpp %0, %0, %0 row_bcast:31 row_mask:0xc bank_mask:0xf\n\ts_nop 1" : "+v"(v));
    return v; }
template <bool DRY = false> __device__ __forceinline__ void ph_topk(const Frame& F, const Args& A, int l) {
    const float* LG = WSP(float, WS_LOG);
    int* LIST = DRY ? WSP(int, WS_PR) : WSP(int, WS_LIST); float* TOPW = DRY ? WSP(float, WS_PR + 18 * MiB) : WSP(float, WS_TOPW); int* EPO = DRY ? WSP(int, WS_PR + 19 * MiB) : WSP(int, WS_EP);
    int* CNT = (int*)(A.ws + WS_CTL) + CW_CNT + (DRY ? 2 : l) * 256 * CNT_STRIDE;
    const float NEG = -__builtin_inff();
    const bool skipctx = l == DEPTH - 1;
    const f32x4 rb4 = *(const G1(f32x4)*)(A.in[25] + l * 256 + 4 * F.lane);
    constexpr int SLOTS = 9;
    for (int base = F.gw; base < MROWS; base += SLOTS * F.NGW) {
        f32x4 lg[SLOTS]; int es[SLOTS], ps[SLOTS]; float wt[SLOTS];
#pragma unroll
        for (int i = 0; i < SLOTS; ++i) { const int R = base + i * F.NGW; lg[i] = f32x4{0.f, 0.f, 0.f, 0.f}; es[i] = 0; ps[i] = 0; wt[i] = 0.f;
            if (R < MROWS && !(skipctx && (R % TPB) < CTX)) lg[i] = *(const G1(f32x4)*)(LG + (size_t)R * 256 + 4 * F.lane); }
#pragma unroll
        for (int i = 0; i < SLOTS; ++i) { const int R = base + i * F.NGW;
            if (R < MROWS && !(skipctx && (R % TPB) < CTX)) {
                const float sc[4] = {sigmoidf_(lg[i].x), sigmoidf_(lg[i].y), sigmoidf_(lg[i].z), sigmoidf_(lg[i].w)};
                const float bi[4] = {sc[0] + rb4.x, sc[1] + rb4.y, sc[2] + rb4.z, sc[3] + rb4.w};
                float t1 = fmaxf(bi[0], bi[1]), t2 = fminf(bi[0], bi[1]);
                { const float u1 = fmaxf(bi[2], bi[3]), u2 = fminf(bi[2], bi[3]); const float n1 = fmaxf(t1, u1), n2 = fmaxf(fminf(t1, u1), fmaxf(t2, u2)); t1 = n1; t2 = n2; }
#define TK_M2(C) { const float o1 = dpp_f<C>(t1), o2 = dpp_f<C>(t2); const float n1 = fmaxf(t1, o1), n2 = fmaxf(fminf(t1, o1), fmaxf(t2, o2)); t1 = n1; t2 = n2; }
                TK_M2(0xB1) TK_M2(0x4E) TK_M2(0x141)
#undef TK_M2
                const float gs = t1 + t2; const int mygrp = F.lane >> 3; int rank = 0;
#pragma unroll
                for (int j = 0; j < 8; ++j) { const float sj = __uint_as_float(__builtin_amdgcn_readlane(__float_as_uint(gs), j * 8)); rank += (int)(sj > gs) | ((int)(sj == gs) & (int)(j < mygrp)); }
                const bool sel = rank < 4;
                float cand[4];
#pragma unroll
                for (int q = 0; q < 4; ++q) cand[q] = sel ? bi[q] : NEG;
                int my_e = 0; float my_s = 0.f, ssum = 0.f;
#pragma unroll
                for (int k = 0; k < 8; ++k) {
                    float bv = cand[0], bs = sc[0]; int bq = 0;
#pragma unroll
                    for (int q = 1; q < 4; ++q) { const bool g = cand[q] > bv; bv = g ? cand[q] : bv; bs = g ? sc[q] : bs; bq = g ? q : bq; }
                    const float mx = __uint_as_float(__builtin_amdgcn_readlane(__float_as_uint(wave_max63(bv)), 63));
                    const int ol = (int)__builtin_ctzll(__ballot(bv == mx));
                    const int oq = __builtin_amdgcn_readlane(bq, ol); const float sv = __uint_as_float(__builtin_amdgcn_readlane(__float_as_uint(bs), ol));
                    const bool me = F.lane == ol;
#pragma unroll
                    for (int q = 0; q < 4; ++q) cand[q] = (me & (oq == q)) ? NEG : cand[q];
                    ssum += sv;
                    { const int ev = 4 * ol + oq; asm volatile("v_writelane_b32 %0, %1, %2" : "+v"(my_e) : "s"(ev), "n"(k)); asm volatile("v_writelane_b32 %0, %1, %2" : "+v"(my_s) : "s"(sv), "n"(k)); }
                }
                es[i] = my_e; wt[i] = my_s * __builtin_amdgcn_rcpf(ssum) * 2.5f;
            } }
#pragma unroll
        for (int i = 0; i < SLOTS; ++i) { const int R = base + i * F.NGW;
            if (R < MROWS && !(skipctx && (R % TPB) < CTX) && F.lane < 8) ps[i] = __hip_atomic_fetch_add((G1(int)*)(CNT + es[i] * CNT_STRIDE), 1, __ATOMIC_RELAXED, __HIP_MEMORY_SCOPE_AGENT); }
#pragma unroll
        for (int i = 0; i < SLOTS; ++i) { const int R = base + i * F.NGW;
            if (R < MROWS && !(skipctx && (R % TPB) < CTX) && F.lane < 8) {
                *(G1(int)*)(LIST + (size_t)es[i] * LCAP + ps[i]) = R * 8 + F.lane; *(G1(float)*)(TOPW + (size_t)R * 8 + F.lane) = wt[i]; *(G1(int)*)(EPO + (size_t)R * 8 + F.lane) = es[i] * LCAP + ps[i]; } }
    }
}
__device__ __forceinline__ void ph_experts_naive(const Frame& F, const Args& A, int l) {
    const bf16* TOK = WSP(bf16, WS_TOK); const int* LIST = WSP(int, WS_LIST); const float* TOPW = WSP(float, WS_TOPW); float* YB = WSP(float, WS_YB);
    const int* CNT = (const int*)(A.ws + WS_CTL) + CW_CNT + l * 256 * CNT_STRIDE;
    LAS bf16* Xs = (LAS bf16*)F.lds;
    LAS float* Hs = (LAS float*)(F.lds + 65536);
    LAS int* pref = (LAS int*)(F.lds + 98304);
    LAS int* sPair = pref + 320; LAS float* sW = (LAS float*)(sPair + 32);
    __syncthreads();
    if (F.tid == 0) { int s = 0; for (int e = 0; e < 256; ++e) { pref[e] = s; s += (CNT[e] + 31) >> 5; } pref[256] = s; }
    __syncthreads();
    const int total = pref[256];
    for (int id = F.bid; id < total; id += F.G) {
        int lo = 0, hi = 255; while (lo < hi) { const int mid = (lo + hi + 1) >> 1; if (pref[mid] <= id) lo = mid; else hi = mid - 1; }
        const int e = lo, c = id - pref[e], n = min(32, CNT[e] - c * 32);
        __syncthreads();
        if (F.tid < 32) { const int pr = F.tid < n ? LIST[(size_t)e * LCAP + c * 32 + F.tid] : -1; sPair[F.tid] = pr; sW[F.tid] = pr >= 0 ? TOPW[pr] : 0.f; }
        __syncthreads();
        for (int pc = F.tid; pc < 4096; pc += 512) { const int row = pc >> 7, c8 = (pc & 127) * 8, pr = sPair[row];
            v4u v = {0u, 0u, 0u, 0u}; if (pr >= 0) v = *(const v4u*)(TOK + (size_t)(pr >> 3) * 1024 + c8);
            *(LAS v4u*)(Xs + row * 1024 + c8) = v; }
        __syncthreads();
        { const int f = F.tid & 255, gu = F.tid >> 8; const float* W = (gu ? A.in[27] : A.in[26]) + ((size_t)(l * 256 + e) * 1024) * 256 + f;
          float acc[32];
#pragma unroll
          for (int r = 0; r < 32; ++r) acc[r] = 0.f;
          for (int k = 0; k < 1024; ++k) { const float w = W[(size_t)k * 256];
#pragma unroll
              for (int r = 0; r < 32; ++r) acc[r] += bf2f(Xs[r * 1024 + k]) * w; }
          if (gu == 0) {
#pragma unroll
              for (int r = 0; r < 32; ++r) Hs[r * 256 + f] = siluf_(acc[r]); }
          __syncthreads();
          if (gu == 1) {
#pragma unroll
              for (int r = 0; r < 32; ++r) Hs[r * 256 + f] *= acc[r]; }
          __syncthreads(); }
        { const float* Wd = A.in[28] + ((size_t)(l * 256 + e) * 256) * 1024 + F.tid;
          float a0[32], a1[32];
#pragma unroll
          for (int r = 0; r < 32; ++r) { a0[r] = 0.f; a1[r] = 0.f; }
          for (int k = 0; k < 256; ++k) { const float w0 = Wd[(size_t)k * 1024], w1 = Wd[(size_t)k * 1024 + 512];
#pragma unroll
              for (int r = 0; r < 32; ++r) { const float hv = Hs[r * 256 + k]; a0[r] += hv * w0; a1[r] += hv * w1; } }
#pragma unroll
          for (int r = 0; r < 32; ++r) { const int pr = sPair[r]; if (pr >= 0) { const float w = sW[r]; YB[(size_t)pr * 1024 + F.tid] = a0[r] * w; YB[(size_t)pr * 1024 + 512 + F.tid] = a1[r] * w; } } }
    }
}
struct TrItem { const float* W; bf16* WT; int ldw, k0, n0, ldwt, rowbase; };
__device__ __forceinline__ void tr_load(const TrItem& t, f32x4 (&v)[8], int lane) {
    const int rr = lane >> 3, c4 = (lane & 7) * 4;
#pragma unroll
    for (int i = 0; i < 8; ++i) v[i] = __builtin_nontemporal_load((const f32x4*)(t.W + (size_t)(t.k0 + 8 * i + rr) * t.ldw + t.n0 + c4));
}
__device__ __forceinline__ void tr_load_a(const TrItem& t, f32x4 (&v)[8], int lane) {
    const int rr = lane >> 3, c4 = (lane & 7) * 4;
#pragma unroll
    for (int i = 0; i < 8; ++i) { const float* p = t.W + (size_t)(t.k0 + 8 * i + rr) * t.ldw + t.n0 + c4; asm volatile("global_load_dwordx4 %0, %1, off nt" : "=v"(v[i]) : "v"(p) : "memory"); }
}
__device__ __forceinline__ void tr_store(const TrItem& t, const f32x4 (&v)[8], LAS float* scr, int lane) {
    const int rr = lane >> 3, c4 = (lane & 7) * 4;
#pragma unroll
    for (int i = 0; i < 8; ++i) { LAS float* d = scr + (8 * i + rr) * 33 + c4; d[0] = v[i].x; d[1] = v[i].y; d[2] = v[i].z; d[3] = v[i].w; }
    LDS_WAIT(); asm volatile("" ::: "memory");
    const int c = lane & 7;
#pragma unroll
    for (int j = 0; j < 4; ++j) { const int n = (lane >> 3) + 8 * j; const LAS float* sp = scr + (8 * c) * 33 + n;
        v4u o; o.x = pk2(sp[0 * 33], sp[1 * 33]); o.y = pk2(sp[2 * 33], sp[3 * 33]); o.z = pk2(sp[4 * 33], sp[5 * 33]); o.w = pk2(sp[6 * 33], sp[7 * 33]);
        __builtin_nontemporal_store(o, (v4u*)(t.WT + (size_t)(t.rowbase + n) * t.ldwt + t.k0 + 8 * c)); }
    LDS_WAIT(); asm volatile("" ::: "memory");
}
__device__ __forceinline__ TrItem expert_item(const Args& A, int l, int it) {
    const int e = it / 384, r = it % 384; bf16* E1 = (bf16*)(A.ws + EWL(l) + (size_t)e * EW_STRIDE); TrItem t;
    if (r < 256) { const int up = r >> 7, q = r & 127, kb = q >> 3, nb = q & 7, n0 = 32 * nb;
        t.W = (up ? A.in[27] : A.in[26]) + ((size_t)(l * 256 + e) * 1024) * 256; t.ldw = 256; t.k0 = 64 * kb; t.n0 = n0; t.WT = E1; t.ldwt = 1024; t.rowbase = (n0 >> 7) * 256 + up * 128 + (n0 & 127); }
    else { const int q = r - 256, kb = q >> 5, nb = q & 31;
        t.W = A.in[28] + ((size_t)(l * 256 + e) * 256) * 1024; t.ldw = 1024; t.k0 = 64 * kb; t.n0 = 32 * nb; t.WT = E1 + 512 * 1024; t.ldwt = 256; t.rowbase = 32 * nb; }
    return t;
}
__device__ __forceinline__ void ph_expert_w_idx(const Frame& F, const Args& A, int l, int lo, int hi, int ci, int nblk) {
    if (ci < 0 || ci >= nblk) return;
    LAS float* scr = (LAS float*)(F.lds + F.wave * 16384);
    const int stride = nblk * NWAVES; int it = lo + ci * NWAVES + F.wave; if (it >= hi) return;
    f32x4 va[8], vb[8], vc[8]; TrItem ta = expert_item(A, l, it), tb = ta, tc = ta;
    tr_load_a(ta, va, F.lane);
    if (it + stride < hi) { tb = expert_item(A, l, it + stride); tr_load_a(tb, vb, F.lane); }
#define EW_STEP(TP, VP, TS, VS) { if (it + 2 * stride < hi) { TP = expert_item(A, l, it + 2 * stride); tr_load_a(TP, VP, F.lane); asm volatile("s_waitcnt vmcnt(16)" ::: "memory"); } \
        else asm volatile("s_waitcnt vmcnt(0)" ::: "memory"); \
        tr_store(TS, VS, scr, F.lane); it += stride; if (it >= hi) break; }
    for (;;) {
        EW_STEP(tc, vc, ta, va)
        EW_STEP(ta, va, tb, vb)
        EW_STEP(tb, vb, tc, vc)
    }
#undef EW_STEP
}
__device__ __forceinline__ void ph_expert_w(const Frame& F, const Args& A, int l, int lo, int hi, int blk0, int nblk) { ph_expert_w_idx(F, A, l, lo, hi, F.bid - blk0, nblk); }
constexpr int EWI_N = 256 * 384, EWI_A = 9800, EWI_B = 20800, EWI_C = 75000, EWI_D = 90000;
constexpr int KCONV_WIN = 18, KCONV_LRU = 44, KCONV_D = 124;
constexpr int KCONV_RS = 58, Q13 = 12, Q15 = 72, Q16 = 48;
__device__ __forceinline__ int moe_geff(int units, int G) { if (units <= 0) return G; const int rounds = (units + G - 1) / G; return (units + rounds - 1) / rounds; }
constexpr int MOE_MAXU = 11;
struct MoeSched {
    const LAS int* pref; const LAS int* cnt; const int* list; const char* abase; const char* bbase; int npn, G, c, lda2; size_t b_pn_stride; bool gather; LAS int* idx;
    __device__ __forceinline__ bool next(int i, pg8::UnitG& U) const {
        const long id = (long)i * G + c; const int total = pref[256]; if (id >= (long)total * npn) return false;
        const int tau = (int)(id / npn), pn = (int)(id % npn);
        int lo = 0, hi = 255; while (lo < hi) { const int mid = (lo + hi + 1) >> 1; if (pref[mid] <= tau) lo = mid; else hi = mid - 1; }
        const int e = lo, t = tau - pref[e];
        U.e = e; U.pn = pn; U.valid = min(256, cnt[e] - t * 256); U.rows = list + (size_t)e * LCAP + t * 256; U.row0 = tau * 256; U.lrows = idx ? idx + (i % MOE_MAXU) * 256 : nullptr;
        U.a = gather ? abase : abase + (size_t)tau * 256 * lda2; U.b = bbase + (size_t)e * EW_STRIDE + (size_t)pn * b_pn_stride; return true;
    }
};
__device__ __forceinline__ void moe_prefix(const Frame& F, const int* CNT, LAS int* pref) {
    LAS int* tmp = pref + 320;
    __syncthreads();
    if (F.tid < 256) tmp[F.tid] = CNT[F.tid * CNT_STRIDE];
    __syncthreads();
    if (F.tid <= 256) { int sum = 0; for (int e = 0; e < F.tid; ++e) sum += (tmp[e] + 255) >> 8; pref[F.tid] = sum; }
    __syncthreads();
}
struct EpiSwiGLU {
    static constexpr bool PERM = true;
    bf16* HB;
    __device__ __forceinline__ void operator()(const f32x4 (&acc)[2][2][4][2], const pg8::UnitG& u, int wr, int wc, int fr, int fq) const {
#pragma unroll
        for (int ai = 0; ai < 2; ++ai)
#pragma unroll
            for (int m = 0; m < 4; ++m) { const int r = ai * 128 + wr * 64 + m * 16 + fr;
                const f32x4 g0 = acc[ai][0][m][0], g1 = acc[ai][0][m][1], u0 = acc[ai][1][m][0], u1 = acc[ai][1][m][1];
                v4u w; w.x = pk2(siluf_(g0[0]) * u0[0], siluf_(g0[1]) * u0[1]); w.y = pk2(siluf_(g0[2]) * u0[2], siluf_(g0[3]) * u0[3]);
                w.z = pk2(siluf_(g1[0]) * u1[0], siluf_(g1[1]) * u1[1]); w.w = pk2(siluf_(g1[2]) * u1[2], siluf_(g1[3]) * u1[3]);
                *(v4u*)(HB + (size_t)(u.row0 + r) * 256 + u.pn * 128 + wc * 32 + 8 * fq) = w; }
    }
};
struct EpiScatter {
    static constexpr bool PERM = true;
    bf16* Y;
    __device__ __forceinline__ void operator()(const f32x4 (&acc)[2][2][4][2], const pg8::UnitG& u, int wr, int wc, int fr, int fq) const {
#pragma unroll
        for (int ai = 0; ai < 2; ++ai)
#pragma unroll
            for (int m = 0; m < 4; ++m) { const int r = ai * 128 + wr * 64 + m * 16 + fr;
                if (r < u.valid) { bf16* dst = Y + (size_t)(u.row0 + r) * 1024 + u.pn * 256 + wc * 32 + 8 * fq;
#pragma unroll
                    for (int bj = 0; bj < 2; ++bj) { const f32x4 v0 = acc[ai][bj][m][0], v1 = acc[ai][bj][m][1];
                        v4u o; o.x = pk2(v0[0], v0[1]); o.y = pk2(v0[2], v0[3]); o.z = pk2(v1[0], v1[1]); o.w = pk2(v1[2], v1[3]);
                        *(v4u*)(dst + bj * 128) = o; } } }
    }
};
__device__ __forceinline__ int conv_base(const Frame& F, const Args& A, int l) {
    if (l == 0) return 0;
    const int* CNT = (const int*)(A.ws + WS_CTL) + CW_CNT + (l - 1) * 256 * CNT_STRIDE; LAS int* pref = (LAS int*)(F.lds + RING_BYTES + 1024);
    moe_prefix(F, CNT, pref);
    const int tiles = pref[256], k15 = F.G - moe_geff(2 * tiles, F.G), k16 = F.G - moe_geff(4 * tiles, F.G);
    int base = KCONV_RS * NWAVES * Q13 + k15 * NWAVES * Q15 + k16 * NWAVES * Q16;
    __syncthreads();
    return base < EWI_N ? base : EWI_N;
}
__device__ __forceinline__ void ph_experts_up(const Frame& F, const Args& A, int l) {
    const int* CNT = (const int*)(A.ws + WS_CTL) + CW_CNT + l * 256 * CNT_STRIDE; LAS int* pref = (LAS int*)(F.lds + RING_BYTES + 1024);
    moe_prefix(F, CNT, pref);
    const int vcu = (F.G % 8 == 0) ? (F.bid % 8) * (F.G / 8) + F.bid / 8 : F.bid;
    const bool early = l + 1 < DEPTH; const int tiles = pref[256], Ge = early ? moe_geff(2 * tiles, F.G) : F.G;
    if (vcu < Ge) {
        LAS int* idx = (LAS int*)(F.lds + RING_BYTES + 4608);
        MoeSched S{pref, pref + 320, WSP(int, WS_LIST), (const char*)WSP(bf16, WS_TOK), (const char*)(A.ws + EWL(l)), 2, Ge, vcu, 2048, (size_t)256 * 1024 * 2, true, idx};
        { int vals[MOE_MAXU];
#pragma unroll
          for (int i = 0; i < MOE_MAXU; ++i) { pg8::UnitG U; vals[i] = 0; if (S.next(i, U) && F.tid < 256) vals[i] = *(const G1(int)*)(U.rows + min(F.tid, U.valid - 1)); }
#pragma unroll
          for (int i = 0; i < MOE_MAXU; ++i) if (F.tid < 256) idx[i * 256 + F.tid] = vals[i]; }
        __syncthreads();
        EpiSwiGLU E{WSP(bf16, WS_HB)};
        pg8::gemm_phase_g<EpiSwiGLU, MoeSched, true>(F.lds, 1024, 1024, 1024, S, E);
    } else { const int k = F.G - Ge, lo = KCONV_RS * NWAVES * Q13; ph_expert_w_idx(F, A, l + 1, lo, min(EWI_N, lo + k * NWAVES * Q15), vcu - Ge, k); }
    __syncthreads();
}
__device__ __forceinline__ void ph_experts_down(const Frame& F, const Args& A, int l) {
    const int* CNT = (const int*)(A.ws + WS_CTL) + CW_CNT + l * 256 * CNT_STRIDE; LAS int* pref = (LAS int*)(F.lds + RING_BYTES + 1024);
    moe_prefix(F, CNT, pref);
    const int vcu = (F.G % 8 == 0) ? (F.bid % 8) * (F.G / 8) + F.bid / 8 : F.bid;
    const bool early = l + 1 < DEPTH; const int tiles = pref[256], Ge = early ? moe_geff(4 * tiles, F.G) : F.G;
    if (vcu < Ge) {
        MoeSched S{pref, pref + 320, WSP(int, WS_LIST), (const char*)WSP(bf16, WS_HB), (const char*)(A.ws + EWL(l) + 512 * 1024 * 2), 4, Ge, vcu, 512, (size_t)256 * 256 * 2, false, nullptr};
        EpiScatter E{WSP(bf16, WS_Y16)};
        pg8::gemm_phase_g<EpiScatter, MoeSched, false>(F.lds, 256, 256, 256, S, E);
    } else { const int k = F.G - Ge, k15 = F.G - moe_geff(2 * tiles, F.G), lo = KCONV_RS * NWAVES * Q13 + k15 * NWAVES * Q15;
        ph_expert_w_idx(F, A, l + 1, min(EWI_N, lo), min(EWI_N, lo + k * NWAVES * Q16), vcu - Ge, k); }
}
template <bool DRY = false> __device__ __forceinline__ void ph_combine(const Frame& F, const Args& A, int l) {
    const float* X = WSP(float, WS_XALL); float* XO = DRY ? WSP(float, WS_U + 492 * MiB) : WSP(float, WS_XALL); bf16* HO = DRY ? WSP(bf16, WS_U + 558 * MiB) : WSP(bf16, WS_H); const bf16* SD = WSP(bf16, WS_SD); const bf16* YS = WSP(bf16, WS_Y16); const int* EP = WSP(int, WS_EP); const float* TOPW = WSP(float, WS_TOPW);
    const int* CNT = (const int*)(A.ws + WS_CTL) + CW_CNT + l * 256 * CNT_STRIDE; LAS int* pref = (LAS int*)(F.lds + RING_BYTES + 1024);
    moe_prefix(F, CNT, pref);
    for (int R = F.gw; R < MROWS; R += F.NGW) {
        const int b = R / TPB, p = R % TPB, s = (p < CTX) ? 2 : b; const float* g2 = MODP(l, s, 5);
        if (l == DEPTH - 1 && p < CTX) continue;
        size_t so[8]; float wk[8];
#pragma unroll
        for (int k = 0; k < 8; ++k) { const int ep = EP[(size_t)R * 8 + k], e = ep / LCAP, pos = ep - e * LCAP; so[k] = ((size_t)pref[e] * 256 + pos) * 1024; wk[k] = TOPW[(size_t)R * 8 + k]; }
        v4u yv[2][8], sd[2]; f32x4 xin[2][2];
#pragma unroll
        for (int j = 0; j < 2; ++j) { const int c = 8 * F.lane + 512 * j;
#pragma unroll
            for (int k = 0; k < 8; ++k) yv[j][k] = *(const v4u*)(YS + so[k] + c);
            sd[j] = *(const v4u*)(SD + (size_t)R * 1024 + c);
            xin[j][0] = *(const f32x4*)(X + (size_t)R * 1024 + c); xin[j][1] = *(const f32x4*)(X + (size_t)R * 1024 + c + 4); }
        float xo[2][8]; float ss = 0.f;
#pragma unroll
        for (int j = 0; j < 2; ++j) { const int c = 8 * F.lane + 512 * j; float f[8] = {bf2f(sd[j].x & 0xffffu), bf2f(sd[j].x >> 16), bf2f(sd[j].y & 0xffffu), bf2f(sd[j].y >> 16), bf2f(sd[j].z & 0xffffu), bf2f(sd[j].z >> 16), bf2f(sd[j].w & 0xffffu), bf2f(sd[j].w >> 16)};
#pragma unroll
            for (int k = 0; k < 8; ++k) { const unsigned ws[4] = {yv[j][k].x, yv[j][k].y, yv[j][k].z, yv[j][k].w};
#pragma unroll
                for (int q = 0; q < 4; ++q) { f[2 * q] += wk[k] * bf2f(ws[q] & 0xffffu); f[2 * q + 1] += wk[k] * bf2f(ws[q] >> 16); } }
            const f32x4 ga = *(const f32x4*)(g2 + c), gb = *(const f32x4*)(g2 + c + 4);
            const f32x4 xa = xin[j][0] + ga * (f32x4){f[0], f[1], f[2], f[3]}, xb = xin[j][1] + gb * (f32x4){f[4], f[5], f[6], f[7]};
            if (l + 1 < DEPTH || DRY) { *(f32x4*)(XO + (size_t)R * 1024 + c) = xa; *(f32x4*)(XO + (size_t)R * 1024 + c + 4) = xb; }
            if (l == DEPTH - 1 && !DRY) { *(f32x4*)(A.out + ((size_t)b * SEQ + (p - CTX)) * 1024 + c) = xa; *(f32x4*)(A.out + ((size_t)b * SEQ + (p - CTX)) * 1024 + c + 4) = xb; }
            xo[j][0] = xa.x; xo[j][1] = xa.y; xo[j][2] = xa.z; xo[j][3] = xa.w; xo[j][4] = xb.x; xo[j][5] = xb.y; xo[j][6] = xb.z; xo[j][7] = xb.w;
#pragma unroll
            for (int e = 0; e < 8; ++e) ss += xo[j][e] * xo[j][e]; }
        if (l + 1 < DEPTH || DRY) {
            const int ln = DRY ? 0 : l + 1; const float rs = rsqrtf(wave_sum(ss) * (1.f / 1024.f) + EPS);
            const float* gn = A.in[6] + ln * 1024; const float* sc1 = MODP(ln, s, 1); const float* sh1 = MODP(ln, s, 0);
#pragma unroll
            for (int j = 0; j < 2; ++j) { const int c = 8 * F.lane + 512 * j; float y[8];
#pragma unroll
                for (int h = 0; h < 2; ++h) { const f32x4 gg = *(const f32x4*)(gn + c + 4 * h), s1 = *(const f32x4*)(sc1 + c + 4 * h), s0 = *(const f32x4*)(sh1 + c + 4 * h);
                    y[4 * h] = xo[j][4 * h] * rs * gg.x * (1.f + s1.x) + s0.x; y[4 * h + 1] = xo[j][4 * h + 1] * rs * gg.y * (1.f + s1.y) + s0.y;
                    y[4 * h + 2] = xo[j][4 * h + 2] * rs * gg.z * (1.f + s1.z) + s0.z; y[4 * h + 3] = xo[j][4 * h + 3] * rs * gg.w * (1.f + s1.w) + s0.w; }
                v4u o; o.x = pk2(y[0], y[1]); o.y = pk2(y[2], y[3]); o.z = pk2(y[4], y[5]); o.w = pk2(y[6], y[7]);
                *(v4u*)(HO + (size_t)R * 1024 + c) = o; } }
    }
}

struct EpiWin {
    static constexpr bool PERM = true; static constexpr int MIDK = 0;
    bf16 *Kb, *Vb, *Qb, *LXb, *GLG, *ZP, *GT; const float* qg; const float* kg;
    __device__ __forceinline__ void operator()(const f32x4 (&acc)[2][2][4][2], const pg8::Unit& u, int wr, int wc, int fr, int fq) const {
        const int pn = u.pn, sec = pn >> 2;
        if (sec == 0 || sec == 3) {
            const bool isq = sec == 3; const bool lat = (u.pm % 33) != 0;
            bf16* dst = (isq ? Qb : Kb) + (pn & 3) * 256 + wc * 64 + 4 * fq; const float* gn = isq ? qg : kg; const float gs = isq ? QSCALE : 1.f;
            f32x4 g[2][2]; float invf[4];
#pragma unroll
            for (int bj = 0; bj < 2; ++bj)
#pragma unroll
                for (int n = 0; n < 2; ++n) g[bj][n] = *(const f32x4*)(gn + 32 * bj + 16 * n + 4 * fq) * gs;
#pragma unroll
            for (int e = 0; e < 4; ++e) invf[e] = exp2f(-(float)(4 * fq + e) * (13.287712379549449f / 16.f)) * 0.15915494309189535f;
#pragma unroll
            for (int ai = 0; ai < 2; ++ai)
#pragma unroll
                for (int m = 0; m < 4; ++m) { const int R = u.pm * 256 + ai * 128 + wr * 64 + m * 16 + fr, t = (R % TPB) - CTX;
                    float ss = 0.f;
#pragma unroll
                    for (int bj = 0; bj < 2; ++bj)
#pragma unroll
                        for (int n = 0; n < 2; ++n) { const f32x4 v = acc[ai][bj][m][n]; ss += (v[0] * v[0] + v[1] * v[1]) + (v[2] * v[2] + v[3] * v[3]); }
                    ss += sx<16>(ss); ss += sx<32>(ss);
                    const float rs = rsqrtf(ss * (1.f / 64.f) + EPS);
#pragma unroll
                    for (int bj = 0; bj < 2; ++bj) { const float pos = (float)(bj ? (t & 63) : (t >> 6));
                        const f32x4 y1 = acc[ai][bj][m][0] * rs * g[bj][0], y2 = acc[ai][bj][m][1] * rs * g[bj][1]; f32x4 o1 = y1, o2 = y2;
                        if (lat) {
#pragma unroll
                            for (int e = 0; e < 4; ++e) { const float rev = pos * invf[e]; const float cs = __builtin_amdgcn_cosf(rev), sn = __builtin_amdgcn_sinf(rev);
                                o1[e] = y1[e] * cs - y2[e] * sn; o2[e] = y1[e] * sn + y2[e] * cs; } }
                        bf16* p = dst + (size_t)R * 1024 + 32 * bj;
                        *(unsigned long long*)p = (unsigned long long)pk2(o1[0], o1[1]) | ((unsigned long long)pk2(o1[2], o1[3]) << 32);
                        *(unsigned long long*)(p + 16) = (unsigned long long)pk2(o2[0], o2[1]) | ((unsigned long long)pk2(o2[2], o2[3]) << 32); }
                    asm volatile("" ::: "memory"); }
        } else {
            bf16* base; int ld = 1024, act = 0;
            if (sec == 1) base = Vb + (pn & 3) * 256; else if (sec == 2) base = LXb + (pn & 3) * 256; else if (sec == 4) { base = GLG + (pn & 3) * 256; act = 1; }
            else if (sec == 5) base = ZP + (pn & 3) * 256; else { base = GT + (pn - 24) * 256; ld = 3072; act = 2; }
            base += wc * 32 + 8 * fq;
#pragma unroll
            for (int ai = 0; ai < 2; ++ai)
#pragma unroll
                for (int m = 0; m < 4; ++m) { bf16* rowp = base + (size_t)(u.pm * 256 + ai * 128 + wr * 64 + m * 16 + fr) * ld;
#pragma unroll
                    for (int bj = 0; bj < 2; ++bj) { f32x4 v0 = acc[ai][bj][m][0], v1 = acc[ai][bj][m][1];
                        if (act == 1) {
#pragma unroll
                            for (int e = 0; e < 4; ++e) { v0[e] = gelu_tanh(v0[e]); v1[e] = gelu_tanh(v1[e]); } }
                        else if (act == 2) {
#pragma unroll
                            for (int e = 0; e < 4; ++e) { v0[e] = sigmoidf_(v0[e]); v1[e] = sigmoidf_(v1[e]); } }
                        v4u o; o.x = pk2(v0[0], v0[1]); o.y = pk2(v0[2], v0[3]); o.z = pk2(v1[0], v1[1]); o.w = pk2(v1[2], v1[3]);
                        *(v4u*)(rowp + bj * 128) = o; } }
        }
    }
};

struct EpiMix {
    static constexpr bool PERM = true; static constexpr int MIDK = 16;
    const bf16* GT; bf16* MD;
    __device__ __forceinline__ void mid(f32x4 (&acc)[2][2][4][2], const pg8::Unit& u, int wr, int wc, int fr, int fq, int seg) const {
        const bf16* gb = GT + (size_t)(u.pm * 256 + wr * 64 + fr) * 3072 + (seg - 1) * 1024 + u.pn * 256 + wc * 32 + 8 * fq;
#pragma unroll
        for (int ai = 0; ai < 2; ++ai)
#pragma unroll
            for (int m = 0; m < 4; ++m)
#pragma unroll
                for (int bj = 0; bj < 2; ++bj) { const bf16* p = gb + (size_t)(ai * 128 + m * 16) * 3072 + bj * 128;
                    const v4u a = *(const v4u*)p, b = *(const v4u*)(p + 1024);
                    const unsigned aw[4] = {a.x, a.y, a.z, a.w}, bw[4] = {b.x, b.y, b.z, b.w};
#pragma unroll
                    for (int q = 0; q < 4; ++q) { const float r0 = bf2f(aw[q] & 0xffffu) * __builtin_amdgcn_rcpf(fmaxf(bf2f(bw[q] & 0xffffu), 1e-30f)), r1 = bf2f(aw[q] >> 16) * __builtin_amdgcn_rcpf(fmaxf(bf2f(bw[q] >> 16), 1e-30f));
                        acc[ai][bj][m][q >> 1][(q & 1) * 2] *= r0; acc[ai][bj][m][q >> 1][(q & 1) * 2 + 1] *= r1; } }
    }
    __device__ __forceinline__ void operator()(const f32x4 (&acc)[2][2][4][2], const pg8::Unit& u, int wr, int wc, int fr, int fq) const {
        const size_t r0 = (size_t)(u.pm * 256 + wr * 64 + fr); const int c0 = u.pn * 256 + wc * 32 + 8 * fq;
#pragma unroll
        for (int ai = 0; ai < 2; ++ai)
#pragma unroll
            for (int m = 0; m < 4; ++m)
#pragma unroll
                for (int bj = 0; bj < 2; ++bj) { const size_t R = r0 + ai * 128 + m * 16; const v4u gv = *(const v4u*)(GT + R * 3072 + 2048 + c0 + bj * 128);
                    const f32x4 v0 = acc[ai][bj][m][0], v1 = acc[ai][bj][m][1]; v4u o;
                    o.x = pk2(v0[0] * bf2f(gv.x & 0xffffu), v0[1] * bf2f(gv.x >> 16)); o.y = pk2(v0[2] * bf2f(gv.y & 0xffffu), v0[3] * bf2f(gv.y >> 16));
                    o.z = pk2(v1[0] * bf2f(gv.z & 0xffffu), v1[1] * bf2f(gv.z >> 16)); o.w = pk2(v1[2] * bf2f(gv.w & 0xffffu), v1[3] * bf2f(gv.w >> 16));
                    *(v4u*)(MD + R * 1024 + c0 + bj * 128) = o; }
    }
};
struct EpiResid {
    static constexpr bool PERM = false; static constexpr int MIDK = 0;
    float* X; const float* mod;
    const float* Xin; const float* Cin;
    __device__ __forceinline__ void operator()(const f32x4 (&acc)[2][2][4][2], const pg8::Unit& u, int wr, int wc, int fr, int fq) const {
        const int src = (u.pm % 33 == 0) ? 2 : u.pm / 33; const float* g1 = mod + src * 6144 + 2 * 1024;
        const float* sbase = Xin ? ((u.pm % 33 == 0) ? Cin + (size_t)(u.pm / 33) * CTX * 1024 : Xin + ((size_t)(u.pm / 33) * SEQ + (size_t)(u.pm % 33 - 1) * 256) * 1024) : X + (size_t)u.pm * 256 * 1024;
        const int col0 = u.pn * 256 + wc * 32 + 4 * fq;
        f32x4 gv[2][2];
#pragma unroll
        for (int bj = 0; bj < 2; ++bj)
#pragma unroll
            for (int n = 0; n < 2; ++n) gv[bj][n] = *(const f32x4*)(g1 + col0 + bj * 128 + n * 16);
#pragma unroll
        for (int ai = 0; ai < 2; ++ai)
#pragma unroll
            for (int m = 0; m < 4; ++m) { const size_t ro = (size_t)(ai * 128 + wr * 64 + m * 16 + fr) * 1024 + col0; float* rowp = X + (size_t)u.pm * 256 * 1024 + ro; const float* srow = sbase + ro;
#pragma unroll
                for (int bj = 0; bj < 2; ++bj)
#pragma unroll
                    for (int n = 0; n < 2; ++n) { *(f32x4*)(rowp + bj * 128 + n * 16) = *(const f32x4*)(srow + bj * 128 + n * 16) + gv[bj][n] * acc[ai][bj][m][n]; } }
    }
};
struct EpiRS {
    static constexpr bool PERM = true; static constexpr int MIDK = 0;
    float* LG; bf16* SH;
    __device__ __forceinline__ void operator()(const f32x4 (&acc)[2][2][4][2], const pg8::Unit& u, int wr, int wc, int fr, int fq) const {
#pragma unroll
        for (int ai = 0; ai < 2; ++ai)
#pragma unroll
            for (int m = 0; m < 4; ++m) { const size_t R = (size_t)u.pm * 256 + ai * 128 + wr * 64 + m * 16 + fr;
                if (u.pn == 0) {
#pragma unroll
                    for (int bj = 0; bj < 2; ++bj) { float* p = LG + R * 256 + bj * 128 + wc * 32 + 8 * fq; *(f32x4*)p = acc[ai][bj][m][0]; *(f32x4*)(p + 4) = acc[ai][bj][m][1]; } }
                else { const f32x4 g0 = acc[ai][0][m][0], g1 = acc[ai][0][m][1], u0 = acc[ai][1][m][0], u1 = acc[ai][1][m][1];
                    v4u w; w.x = pk2(siluf_(g0[0]) * u0[0], siluf_(g0[1]) * u0[1]); w.y = pk2(siluf_(g0[2]) * u0[2], siluf_(g0[3]) * u0[3]);
                    w.z = pk2(siluf_(g1[0]) * u1[0], siluf_(g1[1]) * u1[1]); w.w = pk2(siluf_(g1[2]) * u1[2], siluf_(g1[3]) * u1[3]);
                    *(v4u*)(SH + R * 256 + (u.pn - 1) * 128 + wc * 32 + 8 * fq) = w; } }
    }
};
__device__ __forceinline__ void ph_norm2(const Frame& F, const Args& A, int l) {
    const float* X = WSP(float, WS_XALL); bf16* TOK = WSP(bf16, WS_TOK);
    for (int R = F.gw; R < MROWS; R += F.NGW) {
        const int b = R / TPB, p = R % TPB, s = (p < CTX) ? 2 : b;
        if (l == DEPTH - 1 && p < CTX) continue;
        f32x4 v[4];
#pragma unroll
        for (int j = 0; j < 4; ++j) v[j] = *(const f32x4*)(X + (size_t)R * 1024 + 4 * F.lane + 256 * j);
        norm_mod_row(v, A.in[23] + l * 1024, MODP(l, s, 4), MODP(l, s, 3), TOK + (size_t)R * 1024, F.lane);
    }
}

constexpr int PH_PER_L = 18, N_PHASES = 1 + DEPTH * PH_PER_L;
template <int P, bool DRY = false> __device__ __forceinline__ void run_phase(const Frame& F, const Args& A, int l) {
    if constexpr (P == -1) ph_prologue(F, A);
    if constexpr (P == 0) ph_norm1(F, A, l);
#if !FAST_WIN
#error oracle w_in path removed
#endif
    if constexpr (P == 1) { const int Ge = F.G - KCONV_WIN; const int cb = conv_base(F, A, l);
        if (F.bid < Ge) { pg8::Gemm g{WSP(bf16, WS_H), WLP(l, WO_WIN), MROWS, INW, 1024, 1024, 1024}; pg8::StaticOrder S; S.init(MROWS, INW, Ge, F.bid);
            EpiWin E{WSP(bf16, WS_KB), WSP(bf16, WS_VB), WSP(bf16, WS_QB), WSP(bf16, WS_LXB), WSP(bf16, WS_GLG), WSP(bf16, WS_ZP), WSP(bf16, WS_GATES), A.in[8] + l * 64, A.in[9] + l * 64};
            pg8::gemm_phase(F.lds, g, S, E); }
        else ph_expert_w(F, A, l, min(EWI_N, cb), min(EWI_N, cb + EWI_A), Ge, KCONV_WIN); }
    if constexpr (P == 3) { ph_conv(F, A, l); ph_fft_t1_fast(F, A);
        { const int cb = conv_base(F, A, l); ph_expert_w(F, A, l, min(EWI_N, cb + (l == 0 ? EWI_D : EWI_B)), EWI_N, 0, F.G); } }
    if constexpr (P == 4) {
        { const int cb = conv_base(F, A, l);
          if (F.bid < F.G - KCONV_LRU) ph_lru_gemm(F, A, l, F.G - KCONV_LRU); else ph_expert_w(F, A, l, min(EWI_N, cb + EWI_A), min(EWI_N, cb + EWI_B), F.G - KCONV_LRU, KCONV_LRU); }
        __syncthreads();
#if FAST_FFT_A
        ph_fft_a_gemm(F, A);
#else
        ph_fft_a(F, A);
#endif
        ph_fft_c(F, A);
    }
    if constexpr (P == 5) {
        ph_scan1(F, A);
#if FAST_FFT_B
        ph_fft_b_gemm(F, A);
#else
        ph_fft_b(F, A);
#endif
    }
    if constexpr (P == 6) { ph_scan2_fast(F, A); ph_fft_t2_fast(F, A); }
    if constexpr (P == 7) { ph_scan3(F, A);
#if FAST_ATTN
        ph_attn(F, A, l);
#endif
    }
    if constexpr (P == 8) {
#if !FAST_ATTN
        ph_attn_naive(F, A, l);
#endif
        __syncthreads(); }
#if FAST_MIX
    if constexpr (P == 9) { const bool sp = (l == 0) && F.G > 2 * KCONV_D; const int Ge = sp ? F.G - KCONV_D : F.G;
        if (F.bid < Ge) { pg8::Gemm g{WSP(bf16, WS_MIXIN), WLP(l, WO_D1), MROWS, 1024, 3072, 3072, 3072}; pg8::StaticOrder S; S.init(MROWS, 1024, Ge, F.bid, l == DEPTH - 1);
            EpiMix E{WSP(bf16, WS_GATES), WSP(bf16, WS_MIXED)}; pg8::gemm_phase(F.lds, g, S, E); }
        else ph_expert_w(F, A, l, EWI_B, EWI_C, Ge, KCONV_D); }
    if constexpr (P == 11) { const bool sp = (l == 0) && F.G > 2 * KCONV_D; const int Ge = sp ? F.G - KCONV_D : F.G;
        if (F.bid < Ge) { pg8::Gemm g{WSP(bf16, WS_MIXED), WLP(l, WO_OUT), MROWS, 1024, 1024, 1024, 1024}; pg8::StaticOrder S; S.init(MROWS, 1024, Ge, F.bid, l == DEPTH - 1);
            EpiResid E{WSP(float, WS_XALL), (const float*)(A.ws + WS_CTL) + CW_MOD + l * 3 * 6144, l == 0 ? A.in[0] : nullptr, l == 0 ? A.in[2] : nullptr}; pg8::gemm_phase(F.lds, g, S, E); }
        else ph_expert_w(F, A, l, EWI_C, EWI_D, Ge, KCONV_D); }
    if constexpr (P == 12) ph_norm2(F, A, l);
#else
    if constexpr (P == 9) {
        { pg8::Gemm g{WSP(bf16, WS_MIXIN), WLP(l, WO_D1), MROWS, 1024, 1024, 3072, 3072}; pg8::StaticOrder S; S.init(MROWS, 1024, F.G, F.bid); pg8::EpiF32 E{WSP(float, WS_PA), 1024}; pg8::gemm_phase(F.lds, g, S, E); }
        { pg8::Gemm g{WSP(bf16, WS_MIXIN) + 1024, WLP(l, WO_D1) + 1024, MROWS, 1024, 1024, 3072, 3072}; pg8::StaticOrder S; S.init(MROWS, 1024, F.G, F.bid); pg8::EpiF32 E{WSP(float, WS_PR), 1024}; pg8::gemm_phase(F.lds, g, S, E); }
        { pg8::Gemm g{WSP(bf16, WS_MIXIN) + 2048, WLP(l, WO_D1) + 2048, MROWS, 1024, 1024, 3072, 3072}; pg8::StaticOrder S; S.init(MROWS, 1024, F.G, F.bid); pg8::EpiF32 E{WSP(float, WS_PF), 1024}; pg8::gemm_phase(F.lds, g, S, E); } }
    if constexpr (P == 10) ph_mix(F, A);
    if constexpr (P == 11) { pg8::Gemm g{WSP(bf16, WS_MIXED), WLP(l, WO_OUT), MROWS, 1024, 1024, 1024, 1024}; pg8::StaticOrder S; S.init(MROWS, 1024, F.G, F.bid);
        pg8::EpiF32 E{WSP(float, WS_Y1), 1024}; pg8::gemm_phase(F.lds, g, S, E); }
    if constexpr (P == 12) ph_resid_norm2(F, A, l);
#endif
    if constexpr (P == 13) { const bool early = l + 1 < DEPTH; const int Ge = early ? F.G - KCONV_RS : F.G;
        if (F.bid < Ge) { pg8::Gemm g{WSP(bf16, WS_TOK), WLP(l, WO_R), MROWS, 768, 1024, 1024, 1024}; pg8::StaticOrder S; S.init(MROWS, 768, Ge, F.bid, l == DEPTH - 1);
            EpiRS E{WSP(float, WS_LOG), WSP(bf16, WS_SH)}; pg8::gemm_phase(F.lds, g, S, E); }
        else ph_expert_w(F, A, l + 1, 0, KCONV_RS * NWAVES * Q13, Ge, KCONV_RS); }
    if constexpr (P == 14) ph_topk<DRY>(F, A, l);
    if constexpr (P == 15) {
#if FAST_MOE
        ph_experts_up(F, A, l);
#else
        ph_experts_naive(F, A, l); __syncthreads();
#endif

        { pg8::Gemm g{WSP(bf16, WS_SH), WLP(l, WO_SD), MROWS, 1024, 256, 256, 256}; pg8::StaticOrder S; S.init(MROWS, 1024, F.G, F.bid, l == DEPTH - 1); EpiBf16U E{WSP(bf16, WS_SD), 1024}; pg8::gemm_phase(F.lds, g, S, E); } }
    if constexpr (P == 16) {
#if FAST_MOE
        ph_experts_down(F, A, l);
#endif
    }
    if constexpr (P == 17) ph_combine<DRY>(F, A, l);
}
__device__ __forceinline__ Frame make_frame(unsigned char* lds) {
    Frame F; F.lds = (LAS unsigned char*)lds; F.tid = otid(); F.lane = F.tid & 63; F.wave = __builtin_amdgcn_readfirstlane(F.tid >> 6);
    F.bid = obid(); F.G = ogrid(); F.gw = F.bid * NWAVES + F.wave; F.NGW = F.G * NWAVES; F.gtid = (long)F.bid * 512 + F.tid; F.NT = (long)F.G * 512;
    return F;
}
template <int P> __global__ void __launch_bounds__(NWAVES * 64, 2) mk_phase(Args A) {
    extern __shared__ __attribute__((aligned(16))) unsigned char lds[];
    const Frame F = make_frame(lds);
    run_phase<P>(F, A, A.ph_lo);
}
#if N_LAUNCH_MODE == 1
__device__ __forceinline__ const float* lds_ptr(const LAS unsigned long long* tab, int i) {
    const unsigned long long v = tab[i];
    const unsigned lo = __builtin_amdgcn_readfirstlane((unsigned)v), hi = __builtin_amdgcn_readfirstlane((unsigned)(v >> 32));
    return (const float*)(const __attribute__((address_space(1))) float*)(((unsigned long long)hi << 32) | lo);
}
__device__ __forceinline__ void load_args(Args& L, const LAS unsigned long long* tab) {
#pragma unroll
    for (int i = 0; i < 32; ++i) L.in[i] = lds_ptr(tab, i);
    L.out = (float*)lds_ptr(tab, 32); L.ws = (unsigned char*)lds_ptr(tab, 33); L.ph_lo = 0; L.ph_hi = 0;
}
__global__ void __launch_bounds__(NWAVES * 64, 2) mk_fwd(Args A) {
    extern __shared__ __attribute__((aligned(16))) unsigned char lds[];
    LAS unsigned char* L3 = (LAS unsigned char*)lds;
    volatile LAS unsigned* MISC = (volatile LAS unsigned*)(L3 + MISC_OFF);
    for (int u = threadIdx.x; u < (LDS_BYTES - RING_BYTES) / 4; u += NWAVES * 64) ((LAS unsigned*)(L3 + RING_BYTES))[u] = 0u;
    __syncthreads();
    LAS unsigned long long* tab = (LAS unsigned long long*)(L3 + RING_BYTES + 4096);
    if (threadIdx.x == 0) {
#define ST(i) tab[i] = (unsigned long long)A.in[i];
        ST(0) ST(1) ST(2) ST(3) ST(4) ST(5) ST(6) ST(7) ST(8) ST(9) ST(10) ST(11) ST(12) ST(13) ST(14) ST(15) ST(16) ST(17) ST(18) ST(19) ST(20) ST(21) ST(22) ST(23) ST(24) ST(25) ST(26) ST(27) ST(28) ST(29) ST(30) ST(31)
#undef ST
        tab[32] = (unsigned long long)A.out; tab[33] = (unsigned long long)A.ws;
    }
    __syncthreads();
    (void)xcd_barrier_post((unsigned*)(A.ws + WS_CTL) + CW_BAR, MISC + 8);
#define RUN(P) do { asm volatile("; PHASE_MARK " #P); { unsigned tb_ = RING_BYTES + 4096; asm volatile("" : "+v"(tb_)); Args L; load_args(L, (const LAS unsigned long long*)(L3 + tb_)); \
        const Frame F = make_frame(lds); run_phase<P>(F, L, l); \
        if constexpr (P >= 0 && ((REP_MASK >> (P < 0 ? 0 : P)) & 1)) { for (int rp_ = 0; rp_ < REP_N; ++rp_) { asm volatile("s_waitcnt vmcnt(0)" ::: "memory"); __syncthreads(); run_phase<P, true>(F, L, l); } } \
        XcdBarrier bar; bar.bar = (unsigned*)(L.ws + WS_CTL) + CW_BAR; bar.x = xb_xcc_id(); { unsigned mo_ = MISC_OFF + 32; asm volatile("" : "+v"(mo_)); bar.st = (volatile LAS unsigned*)(L3 + mo_); } \
        xcd_barrier(bar); } } while (0)
    { const int l = 0; RUN(-1);
#if REP_PRO
      for (int rp_ = 0; rp_ < 2; ++rp_) { RUN(-1); }
#endif
    }
    for (int l = 0; l < DEPTH; ++l) {
        if (l == 0) RUN(0);
        RUN(1); RUN(3); RUN(4); RUN(5); RUN(6); RUN(7); RUN(9); RUN(11); RUN(12); RUN(13); RUN(14); RUN(15); RUN(16); RUN(17);
    }
#undef RUN
}
#endif

extern "C" void kernel_launch(void* const* d_in, const int* in_sizes, int n_in, void* d_out, int out_size, void* d_ws, size_t ws_size, hipStream_t stream) {
    static int grid = 0;
    if (grid == 0) {
        if (n_in != 32 || out_size != NB * SEQ * DM || ws_size < WS_END) { fprintf(stderr, "kernel_launch: unexpected shapes (n_in %d, out %d, ws %zu < %zu)\n", n_in, out_size, ws_size, (size_t)WS_END); grid = -1; return; }
        int dev = 0, cus = 0;
        if (hipGetDevice(&dev) != hipSuccess || hipDeviceGetAttribute(&cus, hipDeviceAttributeMultiprocessorCount, dev) != hipSuccess) { grid = -1; return; }
#define SETA(K) if (hipFuncSetAttribute((const void*)K, hipFuncAttributeMaxDynamicSharedMemorySize, LDS_BYTES) != hipSuccess) { fprintf(stderr, "kernel_launch: hipFuncSetAttribute failed\n"); grid = -1; return; }
#if N_LAUNCH_MODE == 1
        SETA(mk_fwd)
#else
        SETA(mk_phase<-1>) SETA(mk_phase<0>) SETA(mk_phase<1>) SETA(mk_phase<2>) SETA(mk_phase<3>) SETA(mk_phase<4>) SETA(mk_phase<5>) SETA(mk_phase<6>) SETA(mk_phase<7>) SETA(mk_phase<8>)
        SETA(mk_phase<9>) SETA(mk_phase<10>) SETA(mk_phase<11>) SETA(mk_phase<12>) SETA(mk_phase<13>) SETA(mk_phase<14>) SETA(mk_phase<15>) SETA(mk_phase<16>) SETA(mk_phase<17>)
#endif
#undef SETA
        int per_cu = 0;
        (void)per_cu;
        if (cus * MOE_MAXU < 2 * (NPAIR / 256 + 256)) { fprintf(stderr, "kernel_launch: too few CUs (%d) for the staged MoE row lists\n", cus); grid = -1; return; }
        grid = cus;
    }
    if (grid < 0) return;
    (void)hipMemsetAsync((char*)d_ws + WS_CTL, 0, CTL_ZERO_BYTES, stream);
    Args a{};
    for (int i = 0; i < 32; ++i) a.in[i] = (const float*)d_in[i];
    a.out = (float*)d_out; a.ws = (unsigned char*)d_ws;
#if N_LAUNCH_MODE == 1
    a.ph_lo = 0; a.ph_hi = N_PHASES;
    hipLaunchKernelGGL(mk_fwd, dim3(grid), dim3(NWAVES * 64), LDS_BYTES, stream, a);
#else
#define LAUNCH_P(P) hipLaunchKernelGGL(mk_phase<P>, dim3(grid), dim3(NWAVES * 64), LDS_BYTES, stream, a)
    a.ph_lo = 0; a.ph_hi = 0; LAUNCH_P(-1);
    for (int l = 0; l < DEPTH; ++l) { a.ph_lo = l;
        LAUNCH_P(0); LAUNCH_P(1); LAUNCH_P(2); LAUNCH_P(3); LAUNCH_P(4); LAUNCH_P(5); LAUNCH_P(6); LAUNCH_P(7); LAUNCH_P(8); LAUNCH_P(9); LAUNCH_P(10); LAUNCH_P(11); LAUNCH_P(12); LAUNCH_P(13); LAUNCH_P(14); LAUNCH_P(15); LAUNCH_P(16); LAUNCH_P(17); }
#undef LAUNCH_P
#endif
    const hipError_t le = hipPeekAtLastError();
    if (le != hipSuccess) fprintf(stderr, "kernel_launch: launch failed: %s\n", hipGetErrorName(le));
}
```

```cpp
#include <hip/hip_runtime.h>
#include <cstdio>
#include <cstdint>

#ifndef ATTN_V2
#define ATTN_V2 8
#endif
#ifndef REP_PRO
#define REP_PRO 0
#endif
#ifndef REP_MASK
#define REP_MASK 0
#endif
#ifndef REP_N
#define REP_N 2
#endif
#ifndef FAST_MIX
#define FAST_MIX 1
#endif
#ifndef FAST_WIN
#define FAST_WIN 1
#endif
#ifndef FAST_LRU
#define FAST_LRU 1
#endif
#define FAST_FFT 0
#ifndef FAST_FFT_A
#define FAST_FFT_A 1
#endif
#ifndef FAST_FFT_B
#define FAST_FFT_B 1
#endif
#ifndef FAST_MOE
#define FAST_MOE 1
#endif
#ifndef FAST_ATTN
#define FAST_ATTN 1
#endif
#ifndef N_LAUNCH_MODE
#define N_LAUNCH_MODE 1
#endif

__device__ __forceinline__ int otid() { int t = threadIdx.x; asm volatile("" : "+v"(t)); return t; }
__device__ __forceinline__ int obid() { int b = blockIdx.x; asm volatile("" : "+s"(b)); return b; }
__device__ __forceinline__ int ogrid() { int g = gridDim.x; asm volatile("" : "+s"(g)); return g; }
template <int M> __device__ __forceinline__ float sx(float v) {
    static_assert(M == 1 || M == 2 || M == 4 || M == 8 || M == 16 || M == 32, "xor mask");
    if constexpr (M < 32) return __uint_as_float((unsigned)__builtin_amdgcn_ds_swizzle((int)__float_as_uint(v), (M << 10) | 0x1f));
    else { auto rr = __builtin_amdgcn_permlane32_swap(__float_as_uint(v), __float_as_uint(v), false, false); const unsigned a = rr[0], b = rr[1]; return __uint_as_float(a == __float_as_uint(v) ? b : a); }
}
template <int M> __device__ __forceinline__ int sxi(int v) { return (int)__float_as_uint(sx<M>(__uint_as_float((unsigned)v))); }
namespace pg8 {
#define PG8_LAS __attribute__((address_space(3)))
typedef unsigned short bf16_t;
typedef short bf16x8 __attribute__((ext_vector_type(8)));
typedef float f32x4 __attribute__((ext_vector_type(4)));
typedef unsigned u32x4 __attribute__((ext_vector_type(4)));
constexpr int BM = 256, BK = 64, HALF = 128, HTB = HALF * BK * 2, STAGE_BYTES = 8 * HTB, NXCD = 8, WGM = 8;
__host__ __device__ __forceinline__ int lds_byte(int r, int c) { const int st = (r >> 4) * 2 + (c >> 5), rr = r & 15, cc = c & 31, ob = rr * 64 + cc * 2; return st * 1024 + (ob ^ (((ob >> 9) & 1) << 5)); }
__host__ __device__ __forceinline__ void stage_rc(int b, int& R, int& C) { const int st = b / 1024, sb = b % 1024, swz = sb ^ (((sb >> 9) & 1) << 5); R = (st >> 1) * 16 + swz / 64; C = (st & 1) * 32 + (swz % 64) / 2; }
__host__ __device__ __forceinline__ int perm32(int rho) { const int n = rho >> 4, i = rho & 15; return 8 * (i >> 2) + 4 * n + (i & 3); }
struct Unit { int pm, pn; };
struct Gemm { const bf16_t* A; const bf16_t* Bt; int M, N, K, lda, ldb; };
struct StaticOrder {
    int nM, nN, nwg, G, c; bool skipctx;
    __host__ __device__ void init(int M, int N, int G_, int c_, bool skip = false) { nM = skip ? 64 : M / BM; nN = N / BM; nwg = nM * nN; G = G_; c = c_; skipctx = skip; }
    __host__ __device__ bool next(int i, Unit& u) const {
        const long L = (long)i * G + c; if (L >= nwg) return false;
        int wgid = (int)L; { const int q = nwg / NXCD, r = nwg % NXCD, xcd = wgid % NXCD, off = wgid / NXCD; wgid = (xcd < r ? xcd * (q + 1) : r * (q + 1) + (xcd - r) * q) + off; }
        const int nig = WGM * nN, gid = wgid / nig, fm = gid * WGM, gsz = (nM - fm) < WGM ? (nM - fm) : WGM;
        u.pm = fm + ((wgid % nig) % gsz); u.pn = (wgid % nig) / gsz;
        if (skipctx) u.pm += 1 + (u.pm >= 32 ? 1 : 0);
        return true;
    }
};
__device__ __forceinline__ unsigned cvt_pk_bf16(float lo, float hi) { unsigned r; asm volatile("v_cvt_pk_bf16_f32 %0, %1, %2" : "=v"(r) : "v"(lo), "v"(hi)); return r; }

struct EpiF32 {
    static constexpr bool PERM = false; static constexpr int MIDK = 0;
    float* C; int ldc;
    __device__ __forceinline__ void operator()(const f32x4 (&acc)[2][2][4][2], const Unit& u, int wr, int wc, int fr, int fq) const {
        const int row0 = u.pm * BM + wr * 64 + fr, col0 = u.pn * BM + wc * 32 + 4 * fq;
#pragma unroll
        for (int ai = 0; ai < 2; ++ai)
#pragma unroll
            for (int m = 0; m < 4; ++m) { float* rowp = C + (size_t)(row0 + ai * HALF + m * 16) * ldc + col0;
#pragma unroll
                for (int bj = 0; bj < 2; ++bj)
#pragma unroll
                    for (int n = 0; n < 2; ++n) *(f32x4*)(rowp + bj * HALF + n * 16) = acc[ai][bj][m][n]; }
    }
};

template <class Epi>
__device__ __forceinline__ void gemm_phase(PG8_LAS unsigned char* lds, const Gemm g, const StaticOrder& S, const Epi& E) {
    const int tid = otid(), wid = __builtin_amdgcn_readfirstlane(tid >> 6), lane = tid & 63, wr = wid >> 2, wc = wid & 3, fr = lane & 15, fq = lane >> 4;
    const int K = g.K, nt = K / BK;
    unsigned voffA[2], voffB[2];
#pragma unroll
    for (int i = 0; i < 2; ++i) { int R, C; stage_rc(tid * 16 + i * 8192, R, C); const int Rb = Epi::PERM ? ((R & ~31) + perm32(R & 31)) : R;
        voffA[i] = (unsigned)(R * g.lda + C) * 2u; voffB[i] = (unsigned)(Rb * g.ldb + C) * 2u; }
    const size_t kstep = (size_t)(BK * 2);
    const size_t hA = (size_t)HALF * g.lda * 2, hB = (size_t)HALF * g.ldb * 2;
    const size_t tA = 2 * hA, tB = 2 * hB;
    const unsigned ldsw = (unsigned)wid * 1024u;
    const int aoff = lds_byte(wr * 64 + fr, fq * 8), boff = lds_byte(wc * 32 + fr, fq * 8);
#define PG8_SA(b, h) (((b) * 2 + (h)) * HTB)
#define PG8_SB(b, h) ((4 + (b) * 2 + (h)) * HTB)
#define PG8_STAGE(bufoff, gbase, voff) do { _Pragma("unroll") for (int _i = 0; _i < 2; ++_i) \
        __builtin_amdgcn_global_load_lds((const unsigned*)((const char*)(gbase) + (voff)[_i]), (PG8_LAS unsigned*)(lds + (bufoff) + ldsw + _i * 8192), 16, 0, 0); } while (0)
#define PG8_LDA(dst, b, h) do { _Pragma("unroll") for (int m = 0; m < 4; ++m) _Pragma("unroll") for (int k = 0; k < 2; ++k) dst[m][k] = *(const PG8_LAS bf16x8*)(lds + PG8_SA(b, h) + aoff + m * 2048 + k * 1024); } while (0)
#define PG8_LDB(dst, b, h) do { _Pragma("unroll") for (int n = 0; n < 2; ++n) _Pragma("unroll") for (int k = 0; k < 2; ++k) dst[n][k] = *(const PG8_LAS bf16x8*)(lds + PG8_SB(b, h) + boff + n * 2048 + k * 1024); } while (0)
#define PG8_MMA(ai, bj, At, Bt) do { __builtin_amdgcn_s_setprio(1); _Pragma("unroll") for (int m = 0; m < 4; ++m) _Pragma("unroll") for (int n = 0; n < 2; ++n) _Pragma("unroll") for (int k = 0; k < 2; ++k) \
        acc[ai][bj][m][n] = __builtin_amdgcn_mfma_f32_16x16x32_bf16(Bt[n][k], At[m][k], acc[ai][bj][m][n], 0, 0, 0); __builtin_amdgcn_s_setprio(0); } while (0)
#define PG8_WAIT_V(n) asm volatile("s_waitcnt vmcnt(" #n ")" ::: "memory")
#define PG8_WAIT_L(n) asm volatile("s_waitcnt lgkmcnt(" #n ")" ::: "memory")
#define PG8_BAR __builtin_amdgcn_s_barrier()
#define PG8_SCHED __builtin_amdgcn_sched_barrier(0)
    Unit cur, nxt; int ui = 0;
    if (!S.next(0, cur)) return;
    f32x4 acc[2][2][4][2];
#pragma unroll
    for (int a = 0; a < 2; ++a)
#pragma unroll
        for (int b = 0; b < 2; ++b)
#pragma unroll
            for (int m = 0; m < 4; ++m)
#pragma unroll
                for (int n = 0; n < 2; ++n) acc[a][b][m][n] = (f32x4){0.f, 0.f, 0.f, 0.f};
    bf16x8 At[4][2], B0[2][2], B1[2][2];
    const char* cA = (const char*)g.A + (size_t)cur.pm * tA; const char* cB = (const char*)g.Bt + (size_t)cur.pn * tB;
    PG8_STAGE(PG8_SB(0, 0), cB, voffB); PG8_STAGE(PG8_SB(0, 1), cB + hB, voffB); PG8_STAGE(PG8_SA(0, 0), cA, voffA); PG8_STAGE(PG8_SA(0, 1), cA + hA, voffA);
    if (wr == 1) PG8_BAR;
    PG8_WAIT_V(2); PG8_BAR;
    PG8_STAGE(PG8_SB(1, 0), cB + kstep, voffB); PG8_STAGE(PG8_SA(1, 0), cA + kstep, voffA); PG8_STAGE(PG8_SB(1, 1), cB + hB + kstep, voffB);
    PG8_WAIT_V(6); PG8_BAR;
    for (;;) {
        const bool has_next = S.next(ui + 1, nxt);
        const char* nA = has_next ? (const char*)g.A + (size_t)nxt.pm * tA : cA; const char* nB = has_next ? (const char*)g.Bt + (size_t)nxt.pn * tB : cB;
#pragma unroll 1
        for (int t = 0; t < nt; t += 2) {
            if constexpr (Epi::MIDK > 0) { if (t > 0 && (t % Epi::MIDK) == 0) E.mid(acc, cur, wr, wc, fr, fq, t / Epi::MIDK); }
            const bool last = (t == nt - 2);
            const char* a1 = cA + (size_t)(t + 1) * kstep;
            const char* a2 = last ? nA : cA + (size_t)(t + 2) * kstep; const char* b2 = last ? nB : cB + (size_t)(t + 2) * kstep;
            const char* a3 = a2 + kstep; const char* b3 = b2 + kstep;
            PG8_LDB(B0, 0, 0); PG8_LDB(B1, 0, 1); PG8_SCHED; PG8_LDA(At, 0, 0); PG8_STAGE(PG8_SA(1, 1), a1 + hA, voffA);
            PG8_WAIT_V(8); PG8_WAIT_L(0); PG8_BAR; PG8_MMA(0, 0, At, B0); PG8_MMA(0, 1, At, B1); PG8_BAR; PG8_SCHED;
            PG8_LDA(At, 0, 1); PG8_STAGE(PG8_SB(0, 0), b2, voffB); PG8_STAGE(PG8_SB(0, 1), b2 + hB, voffB); PG8_STAGE(PG8_SA(0, 0), a2, voffA);
            PG8_WAIT_V(8); PG8_WAIT_L(0); PG8_BAR; PG8_MMA(1, 0, At, B0); PG8_MMA(1, 1, At, B1); PG8_BAR; PG8_SCHED;
            PG8_LDB(B0, 1, 0); PG8_LDB(B1, 1, 1); PG8_SCHED; PG8_LDA(At, 1, 0); PG8_STAGE(PG8_SA(0, 1), a2 + hA, voffA);
            PG8_WAIT_V(8); PG8_WAIT_L(0); PG8_BAR; PG8_MMA(0, 0, At, B0); PG8_MMA(0, 1, At, B1); PG8_BAR; PG8_SCHED;
            PG8_LDA(At, 1, 1); PG8_STAGE(PG8_SB(1, 0), b3, voffB); PG8_STAGE(PG8_SB(1, 1), b3 + hB, voffB); PG8_STAGE(PG8_SA(1, 0), a3, voffA);
            PG8_WAIT_V(8); PG8_WAIT_L(0); PG8_BAR; PG8_MMA(1, 0, At, B0); PG8_MMA(1, 1, At, B1); PG8_BAR; PG8_SCHED;
        }
        if (wr == 0) PG8_BAR;
        E(acc, cur, wr, wc, fr, fq);
        if (!has_next) break;
#pragma unroll
        for (int a = 0; a < 2; ++a)
#pragma unroll
            for (int b = 0; b < 2; ++b)
#pragma unroll
                for (int m = 0; m < 4; ++m)
#pragma unroll
                    for (int n = 0; n < 2; ++n) acc[a][b][m][n] = (f32x4){0.f, 0.f, 0.f, 0.f};
        cur = nxt; cA = nA; cB = nB; ++ui;
        if (wr == 1) PG8_BAR;
    }
    PG8_WAIT_V(0);
    PG8_BAR;
#undef PG8_SA
#undef PG8_SB
#undef PG8_STAGE
#undef PG8_LDA
#undef PG8_LDB
#undef PG8_MMA
#undef PG8_WAIT_V
#undef PG8_WAIT_L
#undef PG8_BAR
#undef PG8_SCHED
}

struct UnitG { const char* a; const char* b; int row0, pn, e, valid; const int* rows; const PG8_LAS int* lrows; };
template <class Epi, class Sched, bool GATHER>
__device__ __forceinline__ void gemm_phase_g(PG8_LAS unsigned char* lds, const int K, const int lda, const int ldb, const Sched& S, const Epi& E) {
    const int tid = otid(), wid = __builtin_amdgcn_readfirstlane(tid >> 6), lane = tid & 63, wr = wid >> 2, wc = wid & 3, fr = lane & 15, fq = lane >> 4;
    const int nt = K / BK;
    int RA[2], CA[2]; unsigned voffB[2];
#pragma unroll
    for (int i = 0; i < 2; ++i) { int R, C; stage_rc(tid * 16 + i * 8192, R, C); const int Rb = Epi::PERM ? ((R & ~31) + perm32(R & 31)) : R;
        RA[i] = R; CA[i] = C; voffB[i] = (unsigned)(Rb * ldb + C) * 2u; }
    const size_t kstep = (size_t)(BK * 2);
    const size_t hB = (size_t)HALF * ldb * 2;
    const unsigned ldsw = (unsigned)wid * 1024u;
    const int aoff = lds_byte(wr * 64 + fr, fq * 8), boff = lds_byte(wc * 32 + fr, fq * 8);
#define PG8_SA(b, h) (((b) * 2 + (h)) * HTB)
#define PG8_SB(b, h) ((4 + (b) * 2 + (h)) * HTB)
#define PG8_STAGE(bufoff, gbase, voff) do { _Pragma("unroll") for (int _i = 0; _i < 2; ++_i) \
        __builtin_amdgcn_global_load_lds((const unsigned*)((const char*)(gbase) + (voff)[_i]), (PG8_LAS unsigned*)(lds + (bufoff) + ldsw + _i * 8192), 16, 0, 0); } while (0)
#define PG8_LDA(dst, b, h) do { _Pragma("unroll") for (int m = 0; m < 4; ++m) _Pragma("unroll") for (int k = 0; k < 2; ++k) dst[m][k] = *(const PG8_LAS bf16x8*)(lds + PG8_SA(b, h) + aoff + m * 2048 + k * 1024); } while (0)
#define PG8_LDB(dst, b, h) do { _Pragma("unroll") for (int n = 0; n < 2; ++n) _Pragma("unroll") for (int k = 0; k < 2; ++k) dst[n][k] = *(const PG8_LAS bf16x8*)(lds + PG8_SB(b, h) + boff + n * 2048 + k * 1024); } while (0)
#define PG8_MMA(ai, bj, At, Bt) do { __builtin_amdgcn_s_setprio(1); _Pragma("unroll") for (int m = 0; m < 4; ++m) _Pragma("unroll") for (int n = 0; n < 2; ++n) _Pragma("unroll") for (int k = 0; k < 2; ++k) \
        acc[ai][bj][m][n] = __builtin_amdgcn_mfma_f32_16x16x32_bf16(Bt[n][k], At[m][k], acc[ai][bj][m][n], 0, 0, 0); __builtin_amdgcn_s_setprio(0); } while (0)
#define PG8_WAIT_V(n) asm volatile("s_waitcnt vmcnt(" #n ")" ::: "memory")
#define PG8_WAIT_L(n) asm volatile("s_waitcnt lgkmcnt(" #n ")" ::: "memory")
#define PG8_BAR __builtin_amdgcn_s_barrier()
#define PG8_SCHED __builtin_amdgcn_sched_barrier(0)
#define PG8_MKOFF(u, v) do { _Pragma("unroll") for (int _h = 0; _h < 2; ++_h) _Pragma("unroll") for (int _i = 0; _i < 2; ++_i) { const int _row = _h * HALF + RA[_i]; \
        if (GATHER) { const int _pr = (u).lrows[_row]; v[_h][_i] = (unsigned)(_pr >> 3) * (unsigned)(lda * 2) + (unsigned)(CA[_i] * 2); } \
        else v[_h][_i] = (unsigned)(_row * lda + CA[_i]) * 2u; } } while (0)
    UnitG cur, nxt; int ui = 0;
    if (!S.next(0, cur)) return;
    f32x4 acc[2][2][4][2];
#pragma unroll
    for (int a = 0; a < 2; ++a)
#pragma unroll
        for (int b = 0; b < 2; ++b)
#pragma unroll
            for (int m = 0; m < 4; ++m)
#pragma unroll
                for (int n = 0; n < 2; ++n) acc[a][b][m][n] = (f32x4){0.f, 0.f, 0.f, 0.f};
    bf16x8 At[4][2], B0[2][2], B1[2][2];
    unsigned vA[2][2], vN[2][2];
    PG8_MKOFF(cur, vA);
    const char* cA = cur.a; const char* cB = cur.b;
    PG8_STAGE(PG8_SB(0, 0), cB, voffB); PG8_STAGE(PG8_SB(0, 1), cB + hB, voffB); PG8_STAGE(PG8_SA(0, 0), cA, vA[0]); PG8_STAGE(PG8_SA(0, 1), cA, vA[1]);
    if (wr == 1) PG8_BAR;
    PG8_WAIT_V(2); PG8_BAR;
    PG8_STAGE(PG8_SB(1, 0), cB + kstep, voffB); PG8_STAGE(PG8_SA(1, 0), cA + kstep, vA[0]); PG8_STAGE(PG8_SB(1, 1), cB + hB + kstep, voffB);
    PG8_WAIT_V(6); PG8_BAR;
    for (;;) {
        const bool has_next = S.next(ui + 1, nxt);
        if constexpr (GATHER) { if (has_next) { PG8_MKOFF(nxt, vN); } else { vN[0][0] = vA[0][0]; vN[0][1] = vA[0][1]; vN[1][0] = vA[1][0]; vN[1][1] = vA[1][1]; } }
        const char* nA = has_next ? nxt.a : cA; const char* nB = has_next ? nxt.b : cB;
#pragma unroll 1
        for (int t = 0; t < nt; t += 2) {
            const bool last = (t == nt - 2);
            const char* a1 = cA + (size_t)(t + 1) * kstep;
            const char* a2 = last ? nA : cA + (size_t)(t + 2) * kstep; const char* b2 = last ? nB : cB + (size_t)(t + 2) * kstep;
            const char* a3 = a2 + kstep; const char* b3 = b2 + kstep;
            unsigned s0[2], s1[2];
            if constexpr (GATHER) { s0[0] = last ? vN[0][0] : vA[0][0]; s0[1] = last ? vN[0][1] : vA[0][1]; s1[0] = last ? vN[1][0] : vA[1][0]; s1[1] = last ? vN[1][1] : vA[1][1]; }
            else { s0[0] = vA[0][0]; s0[1] = vA[0][1]; s1[0] = vA[1][0]; s1[1] = vA[1][1]; }
            PG8_LDB(B0, 0, 0); PG8_LDB(B1, 0, 1); PG8_SCHED; PG8_LDA(At, 0, 0); PG8_STAGE(PG8_SA(1, 1), a1, vA[1]);
            PG8_WAIT_V(8); PG8_WAIT_L(0); PG8_BAR; PG8_MMA(0, 0, At, B0); PG8_MMA(0, 1, At, B1); PG8_BAR; PG8_SCHED;
            PG8_LDA(At, 0, 1); PG8_STAGE(PG8_SB(0, 0), b2, voffB); PG8_STAGE(PG8_SB(0, 1), b2 + hB, voffB); PG8_STAGE(PG8_SA(0, 0), a2, s0);
            PG8_WAIT_V(8); PG8_WAIT_L(0); PG8_BAR; PG8_MMA(1, 0, At, B0); PG8_MMA(1, 1, At, B1); PG8_BAR; PG8_SCHED;
            PG8_LDB(B0, 1, 0); PG8_LDB(B1, 1, 1); PG8_SCHED; PG8_LDA(At, 1, 0); PG8_STAGE(PG8_SA(0, 1), a2, s1);
            PG8_WAIT_V(8); PG8_WAIT_L(0); PG8_BAR; PG8_MMA(0, 0, At, B0); PG8_MMA(0, 1, At, B1); PG8_BAR; PG8_SCHED;
            PG8_LDA(At, 1, 1); PG8_STAGE(PG8_SB(1, 0), b3, voffB); PG8_STAGE(PG8_SB(1, 1), b3 + hB, voffB); PG8_STAGE(PG8_SA(1, 0), a3, s0);
            PG8_WAIT_V(8); PG8_WAIT_L(0); PG8_BAR; PG8_MMA(1, 0, At, B0); PG8_MMA(1, 1, At, B1); PG8_BAR; PG8_SCHED;
        }
        if (wr == 0) PG8_BAR;
        E(acc, cur, wr, wc, fr, fq);
        if (!has_next) break;
#pragma unroll
        for (int a = 0; a < 2; ++a)
#pragma unroll
            for (int b = 0; b < 2; ++b)
#pragma unroll
                for (int m = 0; m < 4; ++m)
#pragma unroll
                    for (int n = 0; n < 2; ++n) acc[a][b][m][n] = (f32x4){0.f, 0.f, 0.f, 0.f};
        cur = nxt; cA = nA; cB = nB; ++ui;
        if constexpr (GATHER) { vA[0][0] = vN[0][0]; vA[0][1] = vN[0][1]; vA[1][0] = vN[1][0]; vA[1][1] = vN[1][1]; }
        if (wr == 1) PG8_BAR;
    }
    PG8_WAIT_V(0);
    PG8_BAR;
#undef PG8_SA
#undef PG8_SB
#undef PG8_STAGE
#undef PG8_LDA
#undef PG8_LDB
#undef PG8_MMA
#undef PG8_WAIT_V
#undef PG8_WAIT_L
#undef PG8_BAR
#undef PG8_SCHED
#undef PG8_MKOFF
}
}

constexpr int DM = 1024, NB = 2, SEQ = 8192, CTX = 256, TPB = SEQ + CTX, MROWS = NB * TPB, DEPTH = 2;
constexpr int INW = 9216, COL_K = 0, COL_V = 1024, COL_LX = 2048, COL_Q = 3072, COL_LG = 4096, COL_F = 5120, COL_G = 6144;
constexpr int NE = 256, TOPK = 8, EFF = 256, NPAIR = MROWS * TOPK, LCAP = MROWS;
constexpr float EPS = 1e-6f;
constexpr float QSCALE = 0.125f * 1.4426950408889634f;
constexpr int NCHUNK = TPB / 64;
static_assert(MROWS % 256 == 0, "rows");

constexpr size_t MiB = 1u << 20;
constexpr size_t WS_CTL = 0, CTL_ZERO_BYTES = 1 * MiB;
constexpr size_t WS_W = 1 * MiB, WL_STRIDE = 32 * MiB;
constexpr size_t WO_TAB = 31 * MiB;
constexpr size_t WO_WIN = 0, WO_D1 = 18 * MiB, WO_OUT = 24 * MiB, WO_R = 26 * MiB, WO_SGU = 27 * MiB, WO_SD = 28 * MiB, WO_LRU = 29 * MiB;
constexpr size_t WS_XALL = 65 * MiB;
constexpr size_t WS_H = WS_XALL + 66 * MiB;
constexpr size_t WS_U = WS_H + 33 * MiB;
constexpr size_t WS_KB = WS_U + 594 * MiB, WS_VB = WS_KB + 33 * MiB, WS_QB = WS_VB + 33 * MiB, WS_LXB = WS_QB + 33 * MiB, WS_GLG = WS_LXB + 33 * MiB, WS_ZP = WS_GLG + 33 * MiB;
constexpr size_t WS_GATES = WS_ZP + 33 * MiB;
constexpr size_t WS_MIXIN = WS_GATES + 99 * MiB;
constexpr size_t WS_S = WS_MIXIN + 99 * MiB;
constexpr size_t WS_UC = WS_S, WS_AB = WS_UC + 33 * MiB, WS_SUMM = WS_AB + 132 * MiB, WS_CARRY = WS_SUMM + 5 * MiB, WS_XA = WS_CARRY + 3 * MiB, WS_XB = WS_XA + 32 * MiB, WS_GB = WS_XB + 32 * MiB, WS_GC = WS_GB + 32 * MiB;
constexpr size_t WS_PA = WS_S, WS_PR = WS_PA + 66 * MiB, WS_PF = WS_PR + 66 * MiB, WS_Y1 = WS_PF + 66 * MiB;
static_assert(WS_GC + 3 * MiB <= WS_S + 280 * MiB && WS_Y1 + 66 * MiB <= WS_S + 280 * MiB, "scratch S");
constexpr size_t WS_MIXED = WS_S + 280 * MiB, WS_TOK = WS_MIXED + 33 * MiB;
constexpr size_t WS_LOG = WS_TOK + 33 * MiB, WS_SGU = WS_LOG + 17 * MiB, WS_SH = WS_SGU + 33 * MiB, WS_LIST = WS_SH + 9 * MiB, WS_TOPW = WS_LIST + 17 * MiB, WS_SD = WS_TOPW + 1 * MiB;
constexpr size_t WS_YB = WS_U;
constexpr size_t WS_Y16 = WS_KB, WS_HB = WS_S;
constexpr size_t WS_EP = WS_SUMM;
constexpr size_t WS_Y16_OLD = WS_U;
constexpr size_t WS_EW = WS_SD + 66 * MiB, WS_EW1 = WS_U, EW_STRIDE = 3 * MiB / 2;
#define EWL(l) (((l) & 1) ? WS_EW1 : WS_EW)
static_assert(WS_KB + 396 * MiB == WS_S && 392 * MiB <= 396 * MiB && WS_U + 384 * MiB <= WS_KB, "overlays");
constexpr size_t WS_END = WS_EW + 384 * MiB;
static_assert(WS_END <= 2048 * MiB, "d_ws budget");
constexpr int CW_BAR = 4096;
constexpr int CW_CNT = 16384, CNT_STRIDE = 32;
constexpr int CW_MOD = 65536;
static_assert((CW_MOD + 2 * 3 * 6144) * 4 <= (int)CTL_ZERO_BYTES, "ctl");

constexpr int LDS_BYTES = 147456, RING_BYTES = 131072, MISC_OFF = RING_BYTES + 320;
constexpr int NWAVES = 8;

#define GAS __attribute__((address_space(1)))
#define LAS __attribute__((address_space(3)))
typedef unsigned short bf16;
typedef unsigned v4u __attribute__((ext_vector_type(4)));
typedef float f32x4 __attribute__((ext_vector_type(4)));
typedef GAS unsigned gu32;
#define RLX_AGENT __ATOMIC_RELAXED, __HIP_MEMORY_SCOPE_AGENT
#define LDS_WAIT() asm volatile("s_waitcnt lgkmcnt(0)" ::: "memory")
typedef float f32x2_t __attribute__((ext_vector_type(2))); typedef __bf16 bf16x2_t __attribute__((ext_vector_type(2)));
__device__ __forceinline__ unsigned pk2(float lo, float hi) { const f32x2_t v = {lo, hi}; const bf16x2_t b = __builtin_convertvector(v, bf16x2_t); return __builtin_bit_cast(unsigned, b); }
__device__ __forceinline__ unsigned f2bf(float f) { return pk2(f, f) & 0xffffu; }
__device__ __forceinline__ float bf2f(unsigned h) { return __uint_as_float(h << 16); }
__device__ __forceinline__ float sigmoidf_(float x) { return __builtin_amdgcn_rcpf(1.f + __expf(-x)); }
__device__ __forceinline__ float siluf_(float x) { return x * __builtin_amdgcn_rcpf(1.f + __expf(-x)); }
__device__ __forceinline__ float gelu_tanh(float x) { const float u = 0.7978845608028654f * (x + 0.044715f * x * x * x); return x * __builtin_amdgcn_rcpf(1.f + __expf(-2.f * u)); }

#define XB_TMO      128
#define XB_XCNT(j)  (256  + 64 * (j))
#define XB_XSUB(j)  (1280 + 64 * (j))
#define XB_XGEN(j)  (2304 + 64 * (j))
#define XB_TOP      3328
#define XB_TOPGEN   3392
#define XCD_BAR_WORDS 3456
#define XB_SPIN_CAP (1u << 18)
__device__ __forceinline__ unsigned xb_ld(unsigned* p)              { return __hip_atomic_load(p, __ATOMIC_RELAXED, __HIP_MEMORY_SCOPE_AGENT); }
__device__ __forceinline__ unsigned xb_add(unsigned* p, unsigned v) { return __hip_atomic_fetch_add(p, v, __ATOMIC_RELAXED, __HIP_MEMORY_SCOPE_AGENT); }
__device__ __forceinline__ unsigned xb_xcc_id() { return (unsigned)__builtin_amdgcn_s_getreg((3 << 11) | 20) & 0xFu; }
#define XB_SPIN(cond, bar) do { unsigned _sp = 0; while (cond) { __builtin_amdgcn_s_sleep(1); \
    if ((++_sp & 255u) == 0u) { if (xb_ld(&(bar)[XB_TMO])) break; if (_sp > XB_SPIN_CAP) { atomicAdd(&(bar)[XB_TMO], 1u); break; } } } } while (0)
struct XcdBarrier { unsigned* bar; unsigned x; volatile LAS unsigned* st; };
__device__ __forceinline__ XcdBarrier xcd_barrier_post(unsigned* bar, volatile LAS unsigned* st) {
    XcdBarrier b; b.bar = bar; b.x = xb_xcc_id(); b.st = st;
    if (threadIdx.x == 0) (void)xb_add(&bar[XB_XCNT(b.x)], 1u);
    return b;
}
__device__ __forceinline__ void xcd_barrier_complete(unsigned* bar, unsigned x, unsigned& nloc, unsigned& nx) {
    const unsigned G = gridDim.x * gridDim.y * gridDim.z;
    unsigned sum, cnt, mine, sp = 0u;
    for (;;) {
        sum = 0u; cnt = 0u; mine = 0u;
#pragma unroll
        for (unsigned j = 0; j < 16; ++j) { const unsigned c = xb_ld(&bar[XB_XCNT(j)]); sum += c; cnt += (c > 0u) ? 1u : 0u; mine = (j == x) ? c : mine; }
        if (sum == G) break;
        __builtin_amdgcn_s_sleep(1);
        if ((++sp & 255u) == 0u) { if (xb_ld(&bar[XB_TMO])) break; if (sp > XB_SPIN_CAP) { atomicAdd(&bar[XB_TMO], 1u); break; } }
    }
    nloc = mine > 0u ? mine : 1u; nx = cnt > 0u ? cnt : 1u;
}
__device__ __forceinline__ void xcd_barrier(const XcdBarrier& b) {
    asm volatile("s_waitcnt vmcnt(0)" ::: "memory");
    __syncthreads();
    if (threadIdx.x == 0) {
        unsigned* bar = b.bar; asm volatile("" : "+s"(bar));
        __builtin_amdgcn_s_waitcnt(0);
        unsigned nloc = b.st[0], nx = b.st[1];
        unsigned bx = b.x; asm volatile("" : "+s"(bx));
        if (nloc == 0u) { xcd_barrier_complete(bar, bx, nloc, nx); b.st[0] = nloc; b.st[1] = nx; }
        const unsigned old = xb_add(&bar[XB_XSUB(bx)], 1u);
        const unsigned gen = old / nloc;
        if (old + 1u == (gen + 1u) * nloc) {
            __builtin_amdgcn_fence(__ATOMIC_RELEASE, "agent");
            asm volatile("s_waitcnt vmcnt(0)" ::: "memory");
            const unsigned og = xb_add(&bar[XB_TOP], 1u);
            const unsigned tg = og / nx;
            if (og + 1u == (tg + 1u) * nx) xb_add(&bar[XB_TOPGEN], 1u);
            else XB_SPIN(xb_ld(&bar[XB_TOPGEN]) == tg, bar);
            __builtin_amdgcn_fence(__ATOMIC_ACQUIRE, "agent");
            xb_add(&bar[XB_XGEN(bx)], 1u);
            asm volatile("s_waitcnt vmcnt(0)" ::: "memory");
        } else {
            XB_SPIN(xb_ld(&bar[XB_XGEN(bx)]) == gen, bar);
            __builtin_amdgcn_fence(__ATOMIC_ACQUIRE, "agent");
            asm volatile("s_waitcnt vmcnt(0)" ::: "memory");
        }
    }
    __syncthreads();
}

struct Args { const float* in[32]; float* out; unsigned char* ws; int ph_lo, ph_hi; };
struct Frame { LAS unsigned char* lds; int tid, lane, wave, bid, G, gw, NGW; long gtid, NT; };
#define WSP(T, off) ((T*)(A.ws + (off)))
#define WLP(l, off) ((bf16*)(A.ws + WS_W + (size_t)(l) * WL_STRIDE + (off)))
#define MODP(l, s, j) ((const float*)(A.ws + WS_CTL) + CW_MOD + ((l) * 3 + (s)) * 6144 + (j) * 1024)

__device__ __forceinline__ float wave_sum(float v) {
    v += sx<1>(v); v += sx<2>(v); v += sx<4>(v); v += sx<8>(v); v += sx<16>(v); v += sx<32>(v);
    return v;
}
__device__ __forceinline__ int win_row(int c) {
    const int sec = c >> 10; if (sec != 0 && sec != 3) return c;
    const int L = c & 255, g = L >> 6, a = (L >> 5) & 1, x = (L >> 4) & 1, q = (L >> 2) & 3, e = L & 3;
    return (c & ~255) | (128 * a + 32 * g + 8 * q + 4 * x + e);
}
template <bool WINMAP = false>
__device__ __forceinline__ void p0_transpose_item(const float* W, int K, int N, bf16* WT, int ldwt, int row_off, int col_off, LAS float* scr, int item, int lane) {
    const int nblk = N / 32, kb = item / nblk, nb = item % nblk, k0 = 64 * kb, n0 = 32 * nb;
    { f32x4 v[8]; const int rr = lane >> 3, c4 = (lane & 7) * 4;
#pragma unroll
      for (int i = 0; i < 8; ++i) v[i] = *(const f32x4*)(W + (size_t)(k0 + 8 * i + rr) * N + n0 + c4);
#pragma unroll
      for (int i = 0; i < 8; ++i) { LAS float* d = scr + (8 * i + rr) * 33 + c4; d[0] = v[i].x; d[1] = v[i].y; d[2] = v[i].z; d[3] = v[i].w; } }
    LDS_WAIT(); asm volatile("" ::: "memory");
    const int c = lane & 7;
#pragma unroll
    for (int j = 0; j < 4; ++j) { const int n = (lane >> 3) + 8 * j; const LAS float* s = scr + (8 * c) * 33 + n;
        v4u o; o.x = pk2(s[0 * 33], s[1 * 33]); o.y = pk2(s[2 * 33], s[3 * 33]); o.z = pk2(s[4 * 33], s[5 * 33]); o.w = pk2(s[6 * 33], s[7 * 33]);
        const int rr = WINMAP ? win_row(n0 + n) : n0 + n;
        *(v4u*)(WT + (size_t)(row_off + rr) * ldwt + col_off + k0 + 8 * c) = o; }
    LDS_WAIT(); asm volatile("" ::: "memory");
}

struct PItem { const float* W; bf16* WT; int N, ldwt, k0, n0, rowbase; bool winmap, skip; };
constexpr int PRO_I_WIN = 16 * 288, PRO_I_SQ = 16 * 32, PRO_I_R = 16 * 8, PRO_I_SD = 4 * 32, PRO_PER_L = PRO_I_WIN + 4 * PRO_I_SQ + 3 * PRO_I_R + PRO_I_SD;
__device__ __forceinline__ void pi_set(PItem& t, const float* W, int N, bf16* WT, int ldwt, int row_off, int col_off, int item) {
    const int nblk = N / 32, kb = item / nblk, nb = item % nblk; t.W = W; t.N = N; t.WT = WT + col_off; t.ldwt = ldwt; t.k0 = 64 * kb; t.n0 = 32 * nb; t.rowbase = row_off; }
__device__ __forceinline__ PItem pro_item(const Args& A, int it) {
    const int l = it / PRO_PER_L; int r = it % PRO_PER_L; PItem t; t.winmap = false; t.skip = false;
    if (r < PRO_I_WIN) { const int nb = r % 288; t.skip = nb >= 160 && nb < 192; t.winmap = true;
        pi_set(t, A.in[7] + (size_t)l * 1024 * 9216, 9216, WLP(l, WO_WIN), 1024, 0, 0, r); return t; } r -= PRO_I_WIN;
    if (r < PRO_I_SQ) { pi_set(t, A.in[12] + (size_t)l * 1048576, 1024, WLP(l, WO_D1), 3072, 0, 0, r); return t; } r -= PRO_I_SQ;
    if (r < PRO_I_SQ) { pi_set(t, A.in[20] + (size_t)l * 1048576, 1024, WLP(l, WO_D1), 3072, 0, 1024, r); return t; } r -= PRO_I_SQ;
    if (r < PRO_I_SQ) { pi_set(t, A.in[21] + (size_t)l * 1048576, 1024, WLP(l, WO_D1), 3072, 0, 2048, r); return t; } r -= PRO_I_SQ;
    if (r < PRO_I_SQ) { pi_set(t, A.in[22] + (size_t)l * 1048576, 1024, WLP(l, WO_OUT), 1024, 0, 0, r); return t; } r -= PRO_I_SQ;
    if (r < PRO_I_R) { pi_set(t, A.in[24] + (size_t)l * 262144, 256, WLP(l, WO_R), 1024, 0, 0, r); return t; } r -= PRO_I_R;
    if (r < PRO_I_R) { pi_set(t, A.in[29] + (size_t)l * 262144, 256, WLP(l, WO_R), 1024, 256 + ((r % 8) >> 2) * 128, 0, r); return t; } r -= PRO_I_R;
    if (r < PRO_I_R) { pi_set(t, A.in[30] + (size_t)l * 262144, 256, WLP(l, WO_R), 1024, 384 + ((r % 8) >> 2) * 128, 0, r); return t; } r -= PRO_I_R;
    pi_set(t, A.in[31] + (size_t)l * 262144, 1024, WLP(l, WO_SD), 256, 0, 0, r); return t;
}
__device__ __forceinline__ void pi_load(const PItem& t, f32x4 (&v)[8], int lane) {
    const int rr = lane >> 3, c4 = (lane & 7) * 4;
#pragma unroll
    for (int i = 0; i < 8; ++i) v[i] = *(const f32x4*)(t.W + (size_t)(t.k0 + 8 * i + rr) * t.N + t.n0 + c4);
}
__device__ __forceinline__ void pi_load_a(const PItem& t, f32x4 (&v)[8], int lane) {
    const int rr = lane >> 3, c4 = (lane & 7) * 4;
#pragma unroll
    for (int i = 0; i < 8; ++i) { const float* p = t.W + (size_t)(t.k0 + 8 * i + rr) * t.N + t.n0 + c4; asm volatile("global_load_dwordx4 %0, %1, off" : "=v"(v[i]) : "v"(p) : "memory"); }
}
__device__ __forceinline__ void pi_store(const PItem& t, const f32x4 (&v)[8], LAS float* scr, int lane) {
    const int rr = lane >> 3, c4 = (lane & 7) * 4;
#pragma unroll
    for (int i = 0; i < 8; ++i) { LAS float* d = scr + (8 * i + rr) * 33 + c4; d[0] = v[i].x; d[1] = v[i].y; d[2] = v[i].z; d[3] = v[i].w; }
    LDS_WAIT(); asm volatile("" ::: "memory");
    const int c = lane & 7;
#pragma unroll
    for (int j = 0; j < 4; ++j) { const int n = (lane >> 3) + 8 * j; const LAS float* sp = scr + (8 * c) * 33 + n;
        v4u o; o.x = pk2(sp[0 * 33], sp[1 * 33]); o.y = pk2(sp[2 * 33], sp[3 * 33]); o.z = pk2(sp[4 * 33], sp[5 * 33]); o.w = pk2(sp[6 * 33], sp[7 * 33]);
        const int row = t.winmap ? win_row(t.n0 + n) : t.n0 + n;
        *(v4u*)(t.WT + (size_t)(t.rowbase + row) * t.ldwt + t.k0 + 8 * c) = o; }
    LDS_WAIT(); asm volatile("" ::: "memory");
}

__device__ __forceinline__ void ph_prologue(const Frame& F, const Args& A) {
    LAS float* scr = (LAS float*)(F.lds + F.wave * 16384);
    { const int stride = F.NGW, hi = 2 * PRO_PER_L; int it = F.gw;
      if (it < hi) { f32x4 va[8], vb[8], vc[8]; PItem ta = pro_item(A, it), tb = ta, tc = ta;
        pi_load_a(ta, va, F.lane);
        if (it + stride < hi) { tb = pro_item(A, it + stride); pi_load_a(tb, vb, F.lane); }
#define PRO_STEP(TP, VP, TS, VS) { if (it + 2 * stride < hi) { TP = pro_item(A, it + 2 * stride); pi_load_a(TP, VP, F.lane); asm volatile("s_waitcnt vmcnt(16)" ::: "memory"); } \
            else asm volatile("s_waitcnt vmcnt(0)" ::: "memory"); \
            if (!TS.skip) pi_store(TS, VS, scr, F.lane); it += stride; if (it >= hi) break; }
        for (;;) {
            PRO_STEP(tc, vc, ta, va)
            PRO_STEP(ta, va, tb, vb)
            PRO_STEP(tb, vb, tc, vc)
        }
#undef PRO_STEP
      } }
#if FAST_WIN
    {
        LAS float* sW = (LAS float*)F.lds; LAS float* sT = sW + 32 * 256;
        __syncthreads();
        if (F.tid < 256) sT[F.tid] = cospif((float)F.tid / 128.0f);
        for (int it = F.bid; it < 2 * 4 * 32; it += F.G) {
            const int l = it >> 7, g = (it >> 5) & 3, k0 = (it & 31) * 32;
            __syncthreads();
            for (int e = F.tid; e < 32 * 256; e += 512) sW[e] = A.in[7][((size_t)l * 1024 + k0 + (e >> 8)) * 9216 + COL_F + g * 256 + (e & 255)];
            __syncthreads();
            const int o = F.tid & 255, kh = F.tid >> 8; int j = o >> 1, odd = o & 1; if (o == 1) { j = 128; odd = 0; }
            const int m0 = odd ? 192 : 0; float acc[16];
#pragma unroll
            for (int q = 0; q < 16; ++q) acc[q] = 0.f;
            for (int c = 0; c < 256; c += 4) { const float r0 = sT[(j * c + m0) & 255], r1 = sT[(j * (c + 1) + m0) & 255], r2 = sT[(j * (c + 2) + m0) & 255], r3 = sT[(j * (c + 3) + m0) & 255];
#pragma unroll
                for (int q = 0; q < 16; ++q) { const f32x4 w = *(const LAS f32x4*)(sW + (kh * 16 + q) * 256 + c); acc[q] += w.x * r0; acc[q] += w.y * r1; acc[q] += w.z * r2; acc[q] += w.w * r3; } }
            bf16* dst = WLP(l, WO_WIN) + (size_t)(COL_F + g * 256 + o) * 1024 + k0 + kh * 16;
            v4u w0, w1; w0.x = pk2(acc[0], acc[1]); w0.y = pk2(acc[2], acc[3]); w0.z = pk2(acc[4], acc[5]); w0.w = pk2(acc[6], acc[7]);
            w1.x = pk2(acc[8], acc[9]); w1.y = pk2(acc[10], acc[11]); w1.z = pk2(acc[12], acc[13]); w1.w = pk2(acc[14], acc[15]);
            *(v4u*)dst = w0; *(v4u*)(dst + 8) = w1;
        }
        __syncthreads();
    }
#endif
    float* MOD = (float*)(A.ws + WS_CTL) + CW_MOD;
    LAS float* part = (LAS float*)(F.lds + 8 * 16384 - 8192);
    LAS float* ssil = (LAS float*)(F.lds + 8 * 16384 - 8192 - 12288);
    if (F.bid < 2 * 96) { for (int e = F.tid; e < 3072; e += NWAVES * 64) { const int k = e & 1023; ssil[e] = siluf_(e < 1024 ? A.in[1][k] : e < 2048 ? A.in[1][1024 + k] : A.in[3][k]); } }
    __syncthreads();
    for (int it = F.bid; it < 2 * 96; it += F.G) {
        const int l = it / 96, nb = it % 96, n = nb * 64 + F.lane;
        const float* wm = A.in[4] + (size_t)l * 1024 * 6144 + n;
        float a0 = 0.f, a1 = 0.f, a2 = 0.f;
#pragma unroll 32
        for (int k = F.wave * 128; k < F.wave * 128 + 128; ++k) {
            const float w = wm[(size_t)k * 6144];
            a0 += ssil[k] * w; a1 += ssil[1024 + k] * w; a2 += ssil[2048 + k] * w;
        }
        __syncthreads();
        part[(F.wave * 3 + 0) * 64 + F.lane] = a0; part[(F.wave * 3 + 1) * 64 + F.lane] = a1; part[(F.wave * 3 + 2) * 64 + F.lane] = a2;
        __syncthreads();
        if (F.wave < 3) { float s = A.in[5][l * 6144 + n];
#pragma unroll
            for (int w = 0; w < 8; ++w) s += part[(w * 3 + F.wave) * 64 + F.lane];
            MOD[(l * 3 + F.wave) * 6144 + n] = s; }
    }
    for (long i = F.gtid; i < 2L * 4096 * 256; i += F.NT) {
        const int l = (int)(i >> 20), n = (int)((i >> 8) & 4095), kk = (int)(i & 255), pn = n >> 8, rr = n & 255, gate = rr >> 7, rho = rr & 127, d = pn >> 3, cb = pn & 7;
        const int cho = 128 * cb + rho, blk = cho >> 6, e = cho & 63, chi = 256 * (cb >> 1) + kk; float v = 0.f;
        if ((chi >> 6) == blk) v = (gate ? A.in[17] : A.in[15])[((size_t)(l * 2 + d) * 16 + blk) * 4096 + (chi & 63) * 64 + e];
        WLP(l, WO_LRU)[i & 0xFFFFF] = (bf16)f2bf(v);
    }
    for (long i = F.gtid; i < 2L * 65536; i += F.NT) {
        const int which = (int)(i >> 16), n = (int)((i >> 8) & 255), k = (int)(i & 255); float v;
        if (which == 0) { const int k1 = n >> 1, cp = n & 1, t1 = k >> 1, c = k & 1; const float rev = (float)((k1 * t1) & 127) * (1.f / 128.f);
            const float cs = __builtin_amdgcn_cosf(rev), sn = __builtin_amdgcn_sinf(rev); v = cp == 0 ? (c == 0 ? cs : sn) : (c == 0 ? -sn : cs); }
        else { const int h = n >> 7, k2 = (n >> 1) & 63, cp = n & 1, hp = k >> 7, t2 = (k >> 1) & 63, c = k & 1; const float rev = (float)((k2 * t2) & 63) * (1.f / 64.f);
            const float cs = __builtin_amdgcn_cosf(rev), sn = __builtin_amdgcn_sinf(rev); v = (h != hp) ? 0.f : (cp == 0 ? (c == 0 ? cs : sn) : (c == 0 ? -sn : cs)); }
        WLP(0, WO_TAB)[i] = (bf16)f2bf(v);
    }
    for (long i = F.gtid; i < 4096; i += F.NT) ((float*)(A.ws + WS_W + WO_TAB + 262144))[i] = log1pf(expf(-A.in[19][i]));
}

__device__ __forceinline__ void norm_mod_row(const f32x4 (&v)[4], const float* g, const float* sc, const float* sh, bf16* orow, int lane) {
    float s = 0.f;
#pragma unroll
    for (int j = 0; j < 4; ++j) s += (v[j].x * v[j].x + v[j].y * v[j].y) + (v[j].z * v[j].z + v[j].w * v[j].w);
    const float rs = rsqrtf(wave_sum(s) * (1.f / 1024.f) + EPS);
#pragma unroll
    for (int j = 0; j < 4; ++j) { const int c = 4 * lane + 256 * j;
        const f32x4 gg = *(const f32x4*)(g + c), s1 = *(const f32x4*)(sc + c), s0 = *(const f32x4*)(sh + c);
        const float y0 = v[j].x * rs * gg.x * (1.f + s1.x) + s0.x, y1 = v[j].y * rs * gg.y * (1.f + s1.y) + s0.y, y2 = v[j].z * rs * gg.z * (1.f + s1.z) + s0.z, y3 = v[j].w * rs * gg.w * (1.f + s1.w) + s0.w;
        *(unsigned long long*)(orow + c) = (unsigned long long)pk2(y0, y1) | ((unsigned long long)pk2(y2, y3) << 32); }
}
__device__ __forceinline__ void ph_norm1(const Frame& F, const Args& A, int l) {
    bf16* H = WSP(bf16, WS_H);
    for (int R = F.gw; R < MROWS; R += F.NGW) {
        const int b = R / TPB, p = R % TPB, s = (p < CTX) ? 2 : b;
        const float* X = (p < CTX) ? A.in[2] + ((size_t)b * CTX + p) * 1024 : A.in[0] + ((size_t)b * SEQ + (p - CTX)) * 1024;
        f32x4 v[4];
#pragma unroll
        for (int j = 0; j < 4; ++j) v[j] = *(const f32x4*)(X + 4 * F.lane + 256 * j);
        norm_mod_row(v, A.in[6] + l * 1024, MODP(l, s, 1), MODP(l, s, 0), H + (size_t)R * 1024, F.lane);
    }
}

__device__ __forceinline__ void ph_uelem(const Frame& F, const Args& A, int l) {
    const float* U = WSP(float, WS_U);
    bf16 *Kb = WSP(bf16, WS_KB), *Vb = WSP(bf16, WS_VB), *Qb = WSP(bf16, WS_QB), *LXb = WSP(bf16, WS_LXB), *GLG = WSP(bf16, WS_GLG), *ZP = WSP(bf16, WS_ZP), *GT = WSP(bf16, WS_GATES);
    LAS float* sF = (LAS float*)F.lds; LAS float* sT = sF + 1024;
    if (F.tid < 256) sT[F.tid] = cospif((float)F.tid / 128.0f);
    __syncthreads();
    for (int R = F.bid; R < MROWS; R += F.G) {
        const float* u = U + (size_t)R * INW; const int p = R % TPB; const bool lat = p >= CTX; const int t = p - CTX;
        for (int gi = F.wave; gi < 32; gi += 8) {
            const bool isq = gi >= 16; const int grp = gi & 15;
            const float v = u[(isq ? COL_Q : COL_K) + grp * 64 + F.lane];
            const float ss = wave_sum(v * v);
            float y = v * rsqrtf(ss * (1.f / 64.f) + EPS) * (isq ? A.in[8] : A.in[9])[l * 64 + F.lane];
            const float part = sx<16>(y);
            if (lat) { const int axis = F.lane >> 5, hf = (F.lane >> 4) & 1, f = F.lane & 15;
                const float pos = (float)(axis ? (t & 63) : (t >> 6)); const float inv = exp2f(-(float)f * (13.287712379549449f / 16.f));
                float sn, cs; sincosf(pos * inv, &sn, &cs);
                y = hf ? (part * sn + y * cs) : (y * cs - part * sn); }
            if (isq) y *= QSCALE;
            (isq ? Qb : Kb)[(size_t)R * 1024 + grp * 64 + F.lane] = (bf16)f2bf(y);
        }
        for (int c = F.tid; c < 1024; c += 512) { const size_t o = (size_t)R * 1024 + c;
            Vb[o] = (bf16)f2bf(u[COL_V + c]); LXb[o] = (bf16)f2bf(u[COL_LX + c]); GLG[o] = (bf16)f2bf(gelu_tanh(u[COL_LG + c])); sF[c] = u[COL_F + c]; }
        for (int c = F.tid; c < 3072; c += 512) GT[(size_t)R * 3072 + c] = (bf16)f2bf(sigmoidf_(u[COL_G + c]));
        __syncthreads();
        for (int o = F.tid; o < 1024; o += 512) { const int g = o >> 8, oo = o & 255; int j = oo >> 1, odd = oo & 1; if (oo == 1) { j = 128; odd = 0; }
            const int m0 = odd ? 192 : 0; float acc = 0.f;
            for (int c = 0; c < 256; ++c) acc += sF[g * 256 + c] * sT[(j * c + m0) & 255];
            ZP[(size_t)R * 1024 + o] = (bf16)f2bf(acc); }
        __syncthreads();
    }
}

__device__ __forceinline__ void ph_conv(const Frame& F, const Args& A, int l) {
    const bf16* LXb = WSP(bf16, WS_LXB); bf16* UC = WSP(bf16, WS_UC);
    const int c8 = (int)(F.gtid & 127) * 8, r0 = (int)(F.gtid >> 7), rstep = (int)(F.NT >> 7);
    float w[4][8], bia[8];
#pragma unroll
    for (int j = 0; j < 4; ++j) { const f32x4 a = *(const f32x4*)(A.in[13] + l * 4096 + j * 1024 + c8), b = *(const f32x4*)(A.in[13] + l * 4096 + j * 1024 + c8 + 4);
        w[j][0] = a.x; w[j][1] = a.y; w[j][2] = a.z; w[j][3] = a.w; w[j][4] = b.x; w[j][5] = b.y; w[j][6] = b.z; w[j][7] = b.w; }
    { const f32x4 a = *(const f32x4*)(A.in[14] + l * 1024 + c8), b = *(const f32x4*)(A.in[14] + l * 1024 + c8 + 4);
      bia[0] = a.x; bia[1] = a.y; bia[2] = a.z; bia[3] = a.w; bia[4] = b.x; bia[5] = b.y; bia[6] = b.z; bia[7] = b.w; }
    for (int Rb = r0; Rb < MROWS; Rb += 4 * rstep) {
        v4u x[4][4];
#pragma unroll
        for (int u = 0; u < 4; ++u) { const int R = Rb + u * rstep; if (R < MROWS) { const int p = R % TPB, lo = p < CTX ? 0 : CTX, hi = p < CTX ? CTX : TPB;
#pragma unroll
            for (int j = 0; j < 4; ++j) { const int pp = p + j - 2; x[u][j] = (pp >= lo && pp < hi) ? *(const v4u*)(LXb + (size_t)(R + j - 2) * 1024 + c8) : (v4u){0u, 0u, 0u, 0u}; } } }
#pragma unroll
        for (int u = 0; u < 4; ++u) { const int R = Rb + u * rstep; if (R < MROWS) { float acc[8];
#pragma unroll
            for (int e = 0; e < 8; ++e) acc[e] = bia[e];
#pragma unroll
            for (int j = 0; j < 4; ++j) { const unsigned xs[4] = {x[u][j].x, x[u][j].y, x[u][j].z, x[u][j].w};
#pragma unroll
                for (int q = 0; q < 4; ++q) { acc[2 * q] += w[j][2 * q] * bf2f(xs[q] & 0xffffu); acc[2 * q + 1] += w[j][2 * q + 1] * bf2f(xs[q] >> 16); } }
            v4u o; o.x = pk2(acc[0], acc[1]); o.y = pk2(acc[2], acc[3]); o.z = pk2(acc[4], acc[5]); o.w = pk2(acc[6], acc[7]);
            *(v4u*)(UC + (size_t)R * 1024 + c8) = o; } }
    }
}
#if !FAST_LRU
__device__ __forceinline__ void ph_lrucoef(const Frame& F, const Args& A, int l) {
    const bf16* UC = WSP(bf16, WS_UC); unsigned* AB = WSP(unsigned, WS_AB);
    for (long i = F.gtid; i < 2L * MROWS * 1024; i += F.NT) {
        const int d = (int)(i / ((long)MROWS * 1024)); const long rem = i % ((long)MROWS * 1024); const int R = (int)(rem >> 10), ch = (int)(rem & 1023), blk = ch >> 6, e = ch & 63;
        const float* wa = A.in[15] + ((size_t)(l * 2 + d) * 16 + blk) * 4096 + e; const float* wi = A.in[17] + ((size_t)(l * 2 + d) * 16 + blk) * 4096 + e;
        float r = A.in[16][(l * 2 + d) * 1024 + ch], ig = A.in[18][(l * 2 + d) * 1024 + ch];
        const bf16* ur = UC + (size_t)R * 1024 + blk * 64;
        for (int dd = 0; dd < 64; ++dd) { const float x = bf2f(ur[dd]); r += x * wa[dd * 64]; ig += x * wi[dd * 64]; }
        const float lam = A.in[19][(l * 2 + d) * 1024 + ch]; const float sp = log1pf(expf(-lam));
        const float la = -8.f * sigmoidf_(r) * sp; const float mult = sqrtf(-expm1f(2.f * la));
        const float bc = mult * sigmoidf_(ig) * bf2f(ur[e]);
        AB[i] = pk2(la, bc);
    }
}
#endif
struct LruSched {
    const char* uc; const char* w; int G, c;
    __device__ __forceinline__ bool next(int i, pg8::UnitG& U) const {
        const long id = (long)i * G + c; if (id >= 66 * 16) return false;
        const int pm = (int)(id >> 4), pn = (int)(id & 15);
        U.a = uc + ((size_t)pm * 256 * 1024 + 256 * ((pn & 7) >> 1)) * 2; U.b = w + (size_t)pn * 256 * 256 * 2; U.row0 = pm * 256; U.pn = pn; U.e = 0; U.valid = 256; U.rows = nullptr; return true;
    }
};
struct EpiLru {
    static constexpr bool PERM = false;
    unsigned* AB; const bf16* UC; const float* ba; const float* bi; const float* sp;
    __device__ __forceinline__ void operator()(const f32x4 (&acc)[2][2][4][2], const pg8::UnitG& u, int wr, int wc, int fr, int fq) const {
        const int d = u.pn >> 3, cb = u.pn & 7, ch0 = 128 * cb + wc * 32 + 4 * fq;
        f32x4 vba[2], vbi[2], vsp[2];
#pragma unroll
        for (int n = 0; n < 2; ++n) { vba[n] = *(const f32x4*)(ba + d * 1024 + ch0 + 16 * n) * -1.4426950408889634f; vbi[n] = *(const f32x4*)(bi + d * 1024 + ch0 + 16 * n) * -1.4426950408889634f; vsp[n] = *(const f32x4*)(sp + d * 1024 + ch0 + 16 * n) * -8.f; }
#pragma unroll
        for (int ai = 0; ai < 2; ++ai) { unsigned long long uxs[4][2];
#pragma unroll
            for (int m = 0; m < 4; ++m)
#pragma unroll
                for (int n = 0; n < 2; ++n) uxs[m][n] = *(const unsigned long long*)(UC + ((size_t)u.row0 + ai * 128 + wr * 64 + m * 16 + fr) * 1024 + ch0 + 16 * n);
#pragma unroll
            for (int m = 0; m < 4; ++m) { const size_t R = (size_t)u.row0 + ai * 128 + wr * 64 + m * 16 + fr;
#pragma unroll
                for (int n = 0; n < 2; ++n) { const int ch = ch0 + 16 * n;
                    const unsigned long long ux = uxs[m][n];
                    const float x[4] = {bf2f((unsigned)ux & 0xffffu), bf2f(((unsigned)ux) >> 16), bf2f((unsigned)(ux >> 32) & 0xffffu), bf2f((unsigned)(ux >> 48))};
                    const f32x4 r = acc[ai][0][m][n], g = acc[ai][1][m][n]; v4u o;
#pragma unroll
                    for (int e = 0; e < 4; ++e) {
                        const float la = vsp[n][e] * __builtin_amdgcn_rcpf(1.f + __builtin_amdgcn_exp2f(__builtin_fmaf(r[e], -1.4426950408889634f, vba[n][e])));
                        const float mult = __builtin_amdgcn_sqrtf(1.f - __builtin_amdgcn_exp2f(la * 2.8853900817779268f));
                        o[e] = pk2(la, mult * __builtin_amdgcn_rcpf(1.f + __builtin_amdgcn_exp2f(__builtin_fmaf(g[e], -1.4426950408889634f, vbi[n][e]))) * x[e]); }
                    *(v4u*)(AB + ((size_t)d * MROWS + R) * 1024 + ch) = o; } }
            asm volatile("" ::: "memory"); }
    }
};
__device__ __forceinline__ void ph_lru_gemm(const Frame& F, const Args& A, int l, int Ge) {
    LruSched S{(const char*)WSP(bf16, WS_UC), (const char*)WLP(l, WO_LRU), Ge, F.bid};
    EpiLru E{WSP(unsigned, WS_AB), WSP(bf16, WS_UC), A.in[16] + l * 2048, A.in[18] + l * 2048, (const float*)(A.ws + WS_W + WO_TAB + 262144) + l * 2048};
    pg8::gemm_phase_g<EpiLru, LruSched, false>(F.lds, 256, 1024, 256, S, E);
}
struct FftSched {
    const char* x; const char* w; int nunits, G, c;
    __device__ __forceinline__ bool next(int i, pg8::UnitG& U) const {
        const long id = (long)i * G + c; if (id >= nunits) return false;
        U.a = x + (size_t)id * 256 * 256 * 2; U.b = w; U.row0 = (int)id * 256; U.pn = 0; U.e = 0; U.valid = 256; U.rows = nullptr; return true;
    }
};
struct EpiFftA {
    static constexpr bool PERM = false;
    unsigned* XB;
    __device__ __forceinline__ void operator()(const f32x4 (&acc)[2][2][4][2], const pg8::UnitG& u, int wr, int wc, int fr, int fq) const {
#pragma unroll
        for (int ai = 0; ai < 2; ++ai)
#pragma unroll
            for (int m = 0; m < 4; ++m) { int r0 = u.row0; asm volatile("" : "+s"(r0));
                const int row = r0 + ai * 128 + wr * 64 + m * 16 + fr, t2 = row & 63; const size_t bc = (size_t)(row >> 6);
#pragma unroll
                for (int bj = 0; bj < 2; ++bj)
#pragma unroll
                    for (int n = 0; n < 2; ++n) { const int k1 = 64 * bj + 16 * wc + 8 * n + 2 * fq; const f32x4 v = acc[ai][bj][m][n];
#pragma unroll
                        for (int q = 0; q < 2; ++q) { const int kk = k1 + q; const float rev = (float)(kk * t2) * (1.f / 8192.f);
                            const float cs = __builtin_amdgcn_cosf(rev), sn = __builtin_amdgcn_sinf(rev); const float yr = v[2 * q], yi = v[2 * q + 1];
                            XB[(bc * 64 + (kk >> 1)) * 128 + (kk & 1) * 64 + t2] = pk2(yr * cs + yi * sn, yi * cs - yr * sn); } }
                asm volatile("" ::: "memory"); }
    }
};
struct EpiBf16Plain {
    static constexpr bool PERM = true;
    bf16* C; int ldc;
    __device__ __forceinline__ void operator()(const f32x4 (&acc)[2][2][4][2], const pg8::UnitG& u, int wr, int wc, int fr, int fq) const {
#pragma unroll
        for (int ai = 0; ai < 2; ++ai)
#pragma unroll
            for (int m = 0; m < 4; ++m) { bf16* rowp = C + (size_t)(u.row0 + ai * 128 + wr * 64 + m * 16 + fr) * ldc + u.pn * 256 + wc * 32 + 8 * fq;
#pragma unroll
                for (int bj = 0; bj < 2; ++bj) { const f32x4 v0 = acc[ai][bj][m][0], v1 = acc[ai][bj][m][1];
                    v4u o; o.x = pk2(v0[0], v0[1]); o.y = pk2(v0[2], v0[3]); o.z = pk2(v1[0], v1[1]); o.w = pk2(v1[2], v1[3]);
                    *(v4u*)(rowp + bj * 128) = o; } }
    }
};
struct EpiBf16U {
    static constexpr bool PERM = true; static constexpr int MIDK = 0;
    bf16* C; int ldc;
    __device__ __forceinline__ void operator()(const f32x4 (&acc)[2][2][4][2], const pg8::Unit& u, int wr, int wc, int fr, int fq) const {
#pragma unroll
        for (int ai = 0; ai < 2; ++ai)
#pragma unroll
            for (int m = 0; m < 4; ++m) { bf16* rowp = C + (size_t)(u.pm * 256 + ai * 128 + wr * 64 + m * 16 + fr) * ldc + u.pn * 256 + wc * 32 + 8 * fq;
#pragma unroll
                for (int bj = 0; bj < 2; ++bj) { const f32x4 v0 = acc[ai][bj][m][0], v1 = acc[ai][bj][m][1];
                    v4u o; o.x = pk2(v0[0], v0[1]); o.y = pk2(v0[2], v0[3]); o.z = pk2(v1[0], v1[1]); o.w = pk2(v1[2], v1[3]);
                    *(v4u*)(rowp + bj * 128) = o; } }
    }
};
__device__ __forceinline__ void ph_fft_a_gemm(const Frame& F, const Args& A) {
    FftSched S{(const char*)WSP(bf16, WS_XA), (const char*)WLP(0, WO_TAB), 256, F.G, F.bid};
    EpiFftA E{WSP(unsigned, WS_XB)};
    pg8::gemm_phase_g<EpiFftA, FftSched, false>(F.lds, 256, 256, 256, S, E);
}
__device__ __forceinline__ void ph_fft_b_gemm(const Frame& F, const Args& A) {
    FftSched S{(const char*)WSP(bf16, WS_XB), (const char*)(WLP(0, WO_TAB) + 65536), 256, F.G, F.bid};
    EpiBf16Plain E{WSP(bf16, WS_GB), 256};
    pg8::gemm_phase_g<EpiBf16Plain, FftSched, false>(F.lds, 256, 256, 256, S, E);
}
__device__ __forceinline__ void ph_scan1(const Frame& F, const Args& A) {
    const unsigned* AB = WSP(unsigned, WS_AB); float2* SUMM = WSP(float2, WS_SUMM);
    for (int it = F.gw; it < NB * 2 * NCHUNK * 16; it += F.NGW) {
        const int cg = it & 15, ck = (it >> 4) % NCHUNK, bd = (it >> 4) / NCHUNK, b = bd >> 1, d = bd & 1, ch = cg * 64 + F.lane;
        const unsigned* ab = AB + ((size_t)d * MROWS + (size_t)b * TPB + ck * 64) * 1024 + ch;
        float ac = 1.f, h = 0.f;
#pragma unroll
        for (int q = 0; q < 4; ++q) { unsigned w[16];
#pragma unroll
            for (int k = 0; k < 16; ++k) { const int i = q * 16 + k, ii = d ? 63 - i : i; w[k] = ab[(size_t)ii * 1024]; }
#pragma unroll
            for (int k = 0; k < 16; ++k) { const float a = __expf(bf2f(w[k] & 0xffffu)); h = a * h + bf2f(w[k] >> 16); ac *= a; } }
        SUMM[((size_t)bd * NCHUNK + ck) * 1024 + ch] = make_float2(ac, h);
    }
}
__device__ __forceinline__ void ph_scan2(const Frame& F, const Args& A) {
    const float2* SUMM = WSP(float2, WS_SUMM); float* CARRY = WSP(float, WS_CARRY);
    if (F.gtid < 4096) {
        const int bd = (int)(F.gtid >> 10), ch = (int)(F.gtid & 1023), d = bd & 1; float h = 0.f;
        for (int s = 0; s < NCHUNK; ++s) { const int ck = d ? (s < 4 ? 3 - s : NCHUNK + 3 - s) : s;
            const size_t o = ((size_t)bd * NCHUNK + ck) * 1024 + ch; CARRY[o] = h; const float2 v = SUMM[o]; h = v.x * h + v.y; }
    }
}
__device__ __forceinline__ void ph_scan3(const Frame& F, const Args& A) {
    const unsigned* AB = WSP(unsigned, WS_AB); const float* CARRY = WSP(float, WS_CARRY); const bf16* GLG = WSP(bf16, WS_GLG); bf16* MX = WSP(bf16, WS_MIXIN);
    for (int it = F.gw; it < NB * NCHUNK * 16; it += F.NGW) {
        const int cg = it & 15, ck = (it >> 4) % NCHUNK, b = (it >> 4) / NCHUNK, ch = cg * 64 + F.lane; const size_t R0 = (size_t)b * TPB + ck * 64;
        const unsigned* ab0 = AB + R0 * 1024 + ch; const unsigned* ab1 = AB + ((size_t)MROWS + R0) * 1024 + ch;
        float hf[64]; float h = CARRY[((size_t)(b * 2 + 0) * NCHUNK + ck) * 1024 + ch];
#pragma unroll
        for (int q = 0; q < 4; ++q) { unsigned w[16];
#pragma unroll
            for (int k = 0; k < 16; ++k) w[k] = ab0[(size_t)(q * 16 + k) * 1024];
#pragma unroll
            for (int k = 0; k < 16; ++k) { h = __expf(bf2f(w[k] & 0xffffu)) * h + bf2f(w[k] >> 16); hf[q * 16 + k] = h; } }
        h = CARRY[((size_t)(b * 2 + 1) * NCHUNK + ck) * 1024 + ch];
#pragma unroll
        for (int q = 3; q >= 0; --q) { unsigned w[16]; bf16 g[16];
#pragma unroll
            for (int k = 0; k < 16; ++k) { const int i = q * 16 + 15 - k; w[k] = ab1[(size_t)i * 1024]; g[k] = GLG[(R0 + i) * 1024 + ch]; }
#pragma unroll
            for (int k = 0; k < 16; ++k) { const int i = q * 16 + 15 - k; h = __expf(bf2f(w[k] & 0xffffu)) * h + bf2f(w[k] >> 16);
                MX[(R0 + i) * 3072 + 1024 + ch] = (bf16)f2bf((hf[i] + h) * bf2f(g[k])); } }
    }
}

__device__ __forceinline__ void ph_fft_t1_fast(const Frame& F, const Args& A) {
    const unsigned* ZP = WSP(unsigned, WS_ZP); unsigned* XA = WSP(unsigned, WS_XA); LAS unsigned* T = (LAS unsigned*)F.lds;
    for (int item = F.bid; item < 512; item += F.G) {
        const int b = item >> 8, t2 = (item >> 2) & 63, cq = item & 3;
        __syncthreads();
#pragma unroll
        for (int i = 0; i < 8; ++i) { const int p = F.tid + 512 * i, t1 = p >> 5, w4 = (p & 31) * 4;
            const v4u v = *(const v4u*)(ZP + ((size_t)b * TPB + CTX + 64 * t1 + t2) * 512 + cq * 128 + w4);
            T[t1 * 129 + w4] = v.x; T[t1 * 129 + w4 + 1] = v.y; T[t1 * 129 + w4 + 2] = v.z; T[t1 * 129 + w4 + 3] = v.w; }
        __syncthreads();
#pragma unroll
        for (int i = 0; i < 16; ++i) { const int p = F.tid + 512 * i, cc = p >> 6, t1 = (p & 63) * 2;
            const unsigned long long v = (unsigned long long)T[t1 * 129 + cc] | ((unsigned long long)T[(t1 + 1) * 129 + cc] << 32);
            *(unsigned long long*)(XA + (((size_t)b * 512 + cq * 128 + cc) * 64 + t2) * 128 + t1) = v; }
    }
    __syncthreads();
}
__device__ __forceinline__ void ph_fft_t2_fast(const Frame& F, const Args& A) {
    const unsigned* GB = WSP(unsigned, WS_GB); bf16* MX = WSP(bf16, WS_MIXIN); LAS unsigned* T = (LAS unsigned*)F.lds;
    LAS unsigned short* OUTS = (LAS unsigned short*)(F.lds + 2 * 128 * 65 * 4);
    const bool bal = F.G == 256; const int nmine = bal ? (F.bid < 252 ? 2 : 4) : (520 - F.bid + F.G - 1) / F.G;
    for (int ii = 0; ii < nmine; ++ii) {
        int b, kp, g;
        if (bal) { if (F.bid < 252) { const int f = 2 * F.bid + ii; b = f / 252; const int rem = f % 252; kp = 1 + (rem >> 2); g = rem & 3; }
                   else { const int h = 4 * (F.bid - 252) + ii; b = h >> 3; kp = ((h >> 2) & 1) ? 64 : 0; g = h & 3; } }
        else { const int item = F.bid + ii * F.G; b = item / 260; const int rem = item % 260; kp = rem >> 2; g = rem & 3; }
        const int k1a = kp, k1b = (128 - kp) & 127;
        __syncthreads();
#pragma unroll
        for (int i = 0; i < 8; ++i) { const int p = F.tid + 512 * i, blk = p >> 11, cc = (p >> 4) & 127, w4 = (p & 15) * 4, kk = blk ? k1b : k1a;
            const v4u v = *(const v4u*)(GB + (((size_t)b * 512 + g * 128 + cc) * 64 + (kk >> 1)) * 128 + (kk & 1) * 64 + w4);
            LAS unsigned* d = T + blk * (128 * 65) + cc * 65 + w4; d[0] = v.x; d[1] = v.y; d[2] = v.z; d[3] = v.w; }
        __syncthreads();
        const int jc = F.tid & 255, j = (jc == 0 || jc == 128) ? 0 : (jc < 128 ? jc : 256 - jc);
        const int nset = (k1a == k1b) ? 1 : 2;
        for (int set = 0; set < nset; ++set) { const int ka = set ? k1b : k1a;
            for (int k2 = (F.tid >> 8); k2 < 64; k2 += 2) {
                const int mk2 = (ka == 0) ? ((64 - k2) & 63) : 63 - k2;
                const unsigned own = T[set * (128 * 65) + j * 65 + k2], mir = T[(nset == 1 ? 0 : (1 - set)) * (128 * 65) + j * 65 + mk2];
                float o; if (jc == 0) o = 0.5f * (bf2f(own & 0xffffu) + bf2f(mir & 0xffffu)); else if (jc == 128) o = 0.5f * (bf2f(own >> 16) + bf2f(mir >> 16)); else if (jc < 128) o = bf2f(mir & 0xffffu); else o = bf2f(own & 0xffffu);
                OUTS[k2 * 256 + jc] = (unsigned short)f2bf(o * 6.9053396600248786e-4f); }
            __syncthreads();
#pragma unroll
            for (int i = 0; i < 4; ++i) { const int p = F.tid + 512 * i, k2 = p >> 5, c8 = (p & 31) * 8;
                *(v4u*)(MX + ((size_t)b * TPB + CTX + ka + 128 * k2) * 3072 + 2048 + g * 256 + c8) = *(const LAS v4u*)(OUTS + k2 * 256 + c8); }
            __syncthreads(); }
    }
    __syncthreads();
    const float2* GC = WSP(float2, WS_GC);
    for (long i = F.gtid; i < (long)NB * CTX * 1024; i += F.NT) {
        const int col = (int)(i & 1023), k = (int)((i >> 10) & 255), b = (int)(i >> 18), g = col >> 8, jc = col & 255, km = (256 - k) & 255;
        const int j = (jc == 0 || jc == 128) ? 0 : (jc < 128 ? jc : 256 - jc); const size_t base = ((size_t)b * 512 + g * 128 + j) * 256;
        const float2 w = GC[base + k], wm = GC[base + km];
        float o; if (jc == 0) o = 0.5f * (w.x + wm.x); else if (jc == 128) o = 0.5f * (w.y + wm.y); else if (jc < 128) o = wm.x; else o = w.x;
        MX[((size_t)b * TPB + k) * 3072 + 2048 + col] = (bf16)f2bf(o * 3.90625e-3f);
    }
}
__device__ __forceinline__ void ph_scan2_fast(const Frame& F, const Args& A) {
    const float2* SUMM = WSP(float2, WS_SUMM); float* CARRY = WSP(float, WS_CARRY);
    for (int it = F.gw; it < 256; it += F.NGW) {
        const int bd = it >> 6, d = bd & 1, ch = (it & 63) * 16 + (F.lane & 15), seg = F.lane >> 4;
        float2 v[33]; float as = 1.f, hs = 0.f;
#pragma unroll
        for (int q = 0; q < 33; ++q) { const int sidx = seg * 33 + q, ck = d ? (sidx < 4 ? 3 - sidx : NCHUNK + 3 - sidx) : sidx; v[q] = SUMM[((size_t)bd * NCHUNK + ck) * 1024 + ch]; }
#pragma unroll
        for (int q = 0; q < 33; ++q) { hs = v[q].x * hs + v[q].y; as *= v[q].x; }
        const float a16 = sx<16>(as), h16 = sx<16>(hs), a32 = sx<32>(as), h32 = sx<32>(hs), a48 = sx<32>(a16), h48 = sx<32>(h16);
        float h = 0.f;
#pragma unroll
        for (int jx = 0; jx < 3; ++jx) { const int x = jx ^ seg;
            const float aj = x == 0 ? as : (x == 1 ? a16 : (x == 2 ? a32 : a48)), hj = x == 0 ? hs : (x == 1 ? h16 : (x == 2 ? h32 : h48));
            if (jx < seg) h = aj * h + hj; }
#pragma unroll
        for (int q = 0; q < 33; ++q) { const int sidx = seg * 33 + q, ck = d ? (sidx < 4 ? 3 - sidx : NCHUNK + 3 - sidx) : sidx; CARRY[((size_t)bd * NCHUNK + ck) * 1024 + ch] = h; h = v[q].x * h + v[q].y; }
    }
}

__device__ __forceinline__ void ph_fft_t1(const Frame& F, const Args& A) {
    const unsigned* ZP = WSP(unsigned, WS_ZP); unsigned* XA = WSP(unsigned, WS_XA);
    for (long i = F.gtid; i < (long)NB * 512 * 8192; i += F.NT) {
        const int t1 = (int)(i & 127), t2 = (int)((i >> 7) & 63), cc = (int)((i >> 13) & 511), b = (int)(i >> 22);
        XA[i] = ZP[((size_t)b * TPB + CTX + 64 * t1 + t2) * 512 + cc];
    }
}
#if !FAST_FFT
__device__ __forceinline__ void ph_fft_a(const Frame& F, const Args& A) {
    const unsigned* XA = WSP(unsigned, WS_XA); unsigned* XB = WSP(unsigned, WS_XB);
    for (long i = F.gtid; i < (long)NB * 512 * 8192; i += F.NT) {
        const int k1 = (int)(i & 127); const long row = i >> 7; const int t2 = (int)(row & 63); const long bc = row >> 6;
        const unsigned* x = XA + row * 128; float yr = 0.f, yi = 0.f;
        for (int t1 = 0; t1 < 128; ++t1) { const unsigned w = x[t1]; const float wr = bf2f(w & 0xffffu), wi = bf2f(w >> 16);
            float sn, cs; sincospif((float)((k1 * t1) & 127) / 64.0f, &sn, &cs);
            yr += wr * cs + wi * sn; yi += wi * cs - wr * sn; }
        float sn, cs; sincospif((float)(k1 * t2) / 4096.0f, &sn, &cs);
        const float zr = yr * cs + yi * sn, zi = yi * cs - yr * sn;
        XB[(bc * 64 + (k1 >> 1)) * 128 + (k1 & 1) * 64 + t2] = pk2(zr, zi);
    }
}
#endif
#if !FAST_FFT
__device__ __forceinline__ void ph_fft_b(const Frame& F, const Args& A) {
    const unsigned* XB = WSP(unsigned, WS_XB); unsigned* GB = WSP(unsigned, WS_GB);
    for (long i = F.gtid; i < (long)NB * 512 * 8192; i += F.NT) {
        const int k2 = (int)(i & 63); const long hrow = i >> 6;
        const unsigned* x = XB + hrow * 64; float yr = 0.f, yi = 0.f;
        for (int t2 = 0; t2 < 64; ++t2) { const unsigned w = x[t2]; const float wr = bf2f(w & 0xffffu), wi = bf2f(w >> 16);
            float sn, cs; sincospif((float)((k2 * t2) & 63) / 32.0f, &sn, &cs);
            yr += wr * cs + wi * sn; yi += wi * cs - wr * sn; }
        GB[hrow * 64 + k2] = pk2(yr, yi);
    }
}
#endif
__device__ __forceinline__ void ph_fft_c(const Frame& F, const Args& A) {
    const unsigned* ZP = WSP(unsigned, WS_ZP); float2* GC = WSP(float2, WS_GC);
    LAS unsigned* Z = (LAS unsigned*)F.lds; LAS float* TWc = (LAS float*)(F.lds + 16384); LAS float* TWs = TWc + 256;
    __syncthreads();
    if (F.tid < 256) { const float rev = (float)F.tid * (1.f / 256.f); TWc[F.tid] = __builtin_amdgcn_cosf(rev); TWs[F.tid] = __builtin_amdgcn_sinf(rev); }
    for (int item = F.bid; item < 256; item += F.G) {
        const int b = item >> 7, c0 = ((item >> 2) & 31) * 16, kq = item & 3;
        __syncthreads();
        for (int e = F.tid; e < 4096; e += 512) Z[e] = ZP[((size_t)b * TPB + (e >> 4)) * 512 + c0 + (e & 15)];
        __syncthreads();
        const int cc = F.tid & 15, kb = kq * 64 + (F.tid >> 4) * 2; float ar[2], ai[2]; int m[2];
#pragma unroll
        for (int q = 0; q < 2; ++q) { ar[q] = 0.f; ai[q] = 0.f; m[q] = 0; }
#pragma unroll 4
        for (int t = 0; t < 256; ++t) { const unsigned w = Z[t * 16 + cc]; const float wr = bf2f(w & 0xffffu), wi = bf2f(w >> 16);
#pragma unroll
            for (int q = 0; q < 2; ++q) { const float tc = TWc[m[q]], ts = TWs[m[q]]; ar[q] += wr * tc + wi * ts; ai[q] += wi * tc - wr * ts; m[q] = (m[q] + kb + q) & 255; } }
#pragma unroll
        for (int q = 0; q < 2; ++q) GC[((size_t)b * 512 + c0 + cc) * 256 + kb + q] = make_float2(ar[q], ai[q]);
    }
    __syncthreads();
}
__device__ __forceinline__ void ph_fft_t2(const Frame& F, const Args& A) {
    const unsigned* GB = WSP(unsigned, WS_GB); const float2* GC = WSP(float2, WS_GC); bf16* MX = WSP(bf16, WS_MIXIN);
    for (long i = F.gtid; i < (long)MROWS * 1024; i += F.NT) {
        const int R = (int)(i >> 10), col = (int)(i & 1023), g = col >> 8, jc = col & 255, b = R / TPB, p = R % TPB;
        const bool lat = p >= CTX; const int T = lat ? SEQ : CTX, k = lat ? p - CTX : p, km = (T - k) & (T - 1);
        const int j = (jc == 0 || jc == 128) ? 0 : (jc < 128 ? jc : 256 - jc); const int cc = g * 128 + j;
        float vr, vi, mr, mi;
        if (lat) { const size_t base = ((size_t)b * 512 + cc) * 64;
            const unsigned w = GB[(base + ((k & 127) >> 1)) * 128 + (k & 1) * 64 + (k >> 7)], wm = GB[(base + ((km & 127) >> 1)) * 128 + (km & 1) * 64 + (km >> 7)];
            vr = bf2f(w & 0xffffu); vi = bf2f(w >> 16); mr = bf2f(wm & 0xffffu); mi = bf2f(wm >> 16); }
        else { const float2 w = GC[((size_t)b * 512 + cc) * 256 + k], wm = GC[((size_t)b * 512 + cc) * 256 + km]; vr = w.x; vi = w.y; mr = wm.x; mi = wm.y; }
        float o;
        if (jc == 0) o = 0.5f * (vr + mr); else if (jc == 128) o = 0.5f * (vi + mi); else if (jc < 128) o = mr; else o = vr;
        o *= lat ? 6.9053396600248786e-4f : 3.90625e-3f;
        MX[(size_t)R * 3072 + 2048 + col] = (bf16)f2bf(o);
    }
}

#if !FAST_ATTN
__device__ __forceinline__ void ph_attn_naive(const Frame& F, const Args& A, int l) {
    const bf16 *Kb = WSP(bf16, WS_KB), *Vb = WSP(bf16, WS_VB), *Qb = WSP(bf16, WS_QB); bf16* MX = WSP(bf16, WS_MIXIN);
    const float* lq = A.in[10] + l * 256; float d01 = 0.f, d23 = 0.f;
    for (int i = 0; i < 64; ++i) { d01 += lq[i] * lq[64 + i]; d23 += lq[128 + i] * lq[192 + i]; }
    const float lam_init = 0.8f - 0.6f * expf(-0.3f * (float)l), lam = expf(d01) - expf(d23) + lam_init;
    LAS float* Ks = (LAS float*)F.lds; LAS float* Vs = Ks + 64 * 132; LAS float* Qs = Vs + 64 * 132; LAS float* Ws = Qs + 16 * 128;
    const int r = F.tid >> 5, tl = F.tid & 31;
    for (int u = F.bid; u < 16 * 528; u += F.G) {
        const int bh = u / 528, qb = u % 528, b = bh >> 3, h = bh & 7; const size_t R0 = (size_t)b * TPB + qb * 16; const int nkeys = qb < 16 ? CTX : TPB;
        __syncthreads();
        for (int e = F.tid; e < 2048; e += 512) Qs[e] = bf2f(Qb[(R0 + (e >> 7)) * 1024 + h * 128 + (e & 127)]);
        float m0 = -1e30f, l0 = 0.f, m1 = -1e30f, l1 = 0.f;
        for (int pass = 0; pass < 2; ++pass) {
            float inv0 = 0.f, inv1 = 0.f;
            if (pass == 1) {
#pragma unroll
                for (int o = 1; o < 32; o <<= 1) { float mo = __shfl_xor(m0, o), lo = __shfl_xor(l0, o), mn = fmaxf(m0, mo); l0 = l0 * exp2f(m0 - mn) + lo * exp2f(mo - mn); m0 = mn;
                    mo = __shfl_xor(m1, o); lo = __shfl_xor(l1, o); mn = fmaxf(m1, mo); l1 = l1 * exp2f(m1 - mn) + lo * exp2f(mo - mn); m1 = mn; }
                inv0 = 1.f / l0; inv1 = lam / l1;
            }
            float o4[4] = {0.f, 0.f, 0.f, 0.f};
            for (int kt = 0; kt < nkeys; kt += 64) {
                __syncthreads();
                for (int e = F.tid; e < 1024; e += 512) { const int kk = e >> 4, c8 = (e & 15) * 8; const size_t src = ((size_t)b * TPB + kt + kk) * 1024 + h * 128 + c8;
                    const v4u kv = *(const v4u*)(Kb + src);
                    Ks[kk * 132 + c8 + 0] = bf2f(kv.x & 0xffffu); Ks[kk * 132 + c8 + 1] = bf2f(kv.x >> 16); Ks[kk * 132 + c8 + 2] = bf2f(kv.y & 0xffffu); Ks[kk * 132 + c8 + 3] = bf2f(kv.y >> 16);
                    Ks[kk * 132 + c8 + 4] = bf2f(kv.z & 0xffffu); Ks[kk * 132 + c8 + 5] = bf2f(kv.z >> 16); Ks[kk * 132 + c8 + 6] = bf2f(kv.w & 0xffffu); Ks[kk * 132 + c8 + 7] = bf2f(kv.w >> 16);
                    if (pass == 1) { const v4u vv = *(const v4u*)(Vb + src);
                        Vs[kk * 132 + c8 + 0] = bf2f(vv.x & 0xffffu); Vs[kk * 132 + c8 + 1] = bf2f(vv.x >> 16); Vs[kk * 132 + c8 + 2] = bf2f(vv.y & 0xffffu); Vs[kk * 132 + c8 + 3] = bf2f(vv.y >> 16);
                        Vs[kk * 132 + c8 + 4] = bf2f(vv.z & 0xffffu); Vs[kk * 132 + c8 + 5] = bf2f(vv.z >> 16); Vs[kk * 132 + c8 + 6] = bf2f(vv.w & 0xffffu); Vs[kk * 132 + c8 + 7] = bf2f(vv.w >> 16); } }
                __syncthreads();
#pragma unroll
                for (int kq = 0; kq < 2; ++kq) { const int kk = tl + 32 * kq; float s0 = 0.f, s1 = 0.f;
                    for (int d = 0; d < 64; d += 4) { const f32x4 q0 = *(const LAS f32x4*)(Qs + r * 128 + d), q1 = *(const LAS f32x4*)(Qs + r * 128 + 64 + d), k0 = *(const LAS f32x4*)(Ks + kk * 132 + d), k1 = *(const LAS f32x4*)(Ks + kk * 132 + 64 + d);
                        s0 += q0.x * k0.x + q0.y * k0.y + q0.z * k0.z + q0.w * k0.w; s1 += q1.x * k1.x + q1.y * k1.y + q1.z * k1.z + q1.w * k1.w; }
                    if (pass == 0) { float mn = fmaxf(m0, s0); l0 = l0 * exp2f(m0 - mn) + exp2f(s0 - mn); m0 = mn; mn = fmaxf(m1, s1); l1 = l1 * exp2f(m1 - mn) + exp2f(s1 - mn); m1 = mn; }
                    else Ws[r * 64 + kk] = exp2f(s0 - m0) * inv0 - exp2f(s1 - m1) * inv1; }
                if (pass == 1) { __syncthreads();
                    for (int kk = 0; kk < 64; ++kk) { const float w = Ws[r * 64 + kk];
#pragma unroll
                        for (int i = 0; i < 4; ++i) o4[i] += w * Vs[kk * 132 + tl + 32 * i]; } }
            }
            if (pass == 1) { float ss = o4[0] * o4[0] + o4[1] * o4[1] + o4[2] * o4[2] + o4[3] * o4[3];
#pragma unroll
                for (int o = 1; o < 32; o <<= 1) ss += __shfl_xor(ss, o);
                const float sc = rsqrtf(ss * (1.f / 128.f) + EPS) * (1.f - lam_init);
#pragma unroll
                for (int i = 0; i < 4; ++i) MX[(R0 + r) * 3072 + h * 128 + tl + 32 * i] = (bf16)f2bf(o4[i] * sc * A.in[11][l * 128 + tl + 32 * i]); }
        }
    }
}

#endif
namespace da {
using bf16x8 = __attribute__((ext_vector_type(8))) short;
using s16x4  = __attribute__((ext_vector_type(4))) short;
using f32x16 = __attribute__((ext_vector_type(16))) float;
using u32x4  = __attribute__((ext_vector_type(4))) unsigned;
constexpr int KVBLK = 64, LDK = 1024;
constexpr size_t SHM_V = KVBLK * 128 * 2, SHM_K = KVBLK * 128 * 2;
constexpr float THR = 8.f;
#define DA_KSWZ(row, colB) ((row) * 256 + ((colB) ^ (((row) & 7) << 4)))
#define DA_SBAR() __builtin_amdgcn_sched_barrier(0)
__device__ __forceinline__ int crow(int r, int hi) { return (r & 3) + 8 * (r >> 2) + 4 * hi; }
__device__ __forceinline__ unsigned cvtpk(float lo, float hi) { unsigned r; asm volatile("v_cvt_pk_bf16_f32 %0, %1, %2" : "=v"(r) : "v"(lo), "v"(hi)); return r; }
__device__ __forceinline__ void expSM(f32x16& p0, f32x16& p1, float soff) {
  for (int r = 0; r < 16; ++r) p0[r] = __builtin_amdgcn_exp2f(p0[r] - soff); for (int r = 0; r < 16; ++r) p1[r] = __builtin_amdgcn_exp2f(p1[r] - soff);
}
__device__ __forceinline__ void finishSM(f32x16& p0, f32x16& p1, float& l_reg, bf16x8& pa0, bf16x8& pa1, bf16x8& pa2, bf16x8& pa3) {
  float ps = 0; for (int r = 0; r < 16; ++r) ps += p0[r]; for (int r = 0; r < 16; ++r) ps += p1[r];
  l_reg += ps;
#define DA_PK4(P, BASE, OUT) do { unsigned a0 = cvtpk(P[BASE + 0], P[BASE + 1]), a1 = cvtpk(P[BASE + 2], P[BASE + 3]);   \
    unsigned b0 = cvtpk(P[BASE + 4], P[BASE + 5]), b1 = cvtpk(P[BASE + 6], P[BASE + 7]);                              \
    auto r0 = __builtin_amdgcn_permlane32_swap(a0, b0, false, false); auto r1 = __builtin_amdgcn_permlane32_swap(a1, b1, false, false); \
    u32x4 w = {r0[0], r1[0], r0[1], r1[1]}; OUT = *reinterpret_cast<bf16x8*>(&w); } while (0)
  DA_PK4(p0, 0, pa0); DA_PK4(p0, 8, pa1); DA_PK4(p1, 0, pa2); DA_PK4(p1, 8, pa3);
#undef DA_PK4
}
__device__ __forceinline__ void qkt(f32x16& p0, f32x16& p1, const char* Ks, const bf16x8* qr, int r32, int hi, int cbm) {
  p0 = f32x16{}; p1 = f32x16{};
#pragma unroll
  for (int d0 = 0; d0 < 4; ++d0) { const int cb = cbm + (d0 * 16 + hi * 8) * 2;
    bf16x8 b0 = *reinterpret_cast<const bf16x8*>(Ks + DA_KSWZ(r32, cb));
    bf16x8 b1 = *reinterpret_cast<const bf16x8*>(Ks + DA_KSWZ(32 + r32, cb));
    p0 = __builtin_amdgcn_mfma_f32_32x32x16_bf16(b0, qr[d0], p0, 0, 0, 0);
    p1 = __builtin_amdgcn_mfma_f32_32x32x16_bf16(b1, qr[d0], p1, 0, 0, 0); }
}
__device__ __forceinline__ int v_st(int k, int c) { const int kk = (k & ~0xC) | ((k & 4) << 1) | ((k & 8) >> 1); return ((kk >> 3) * 4 + (c >> 5)) * 512 + ((kk & 7) * 32 + (c & 31)) * 2; }
__device__ __forceinline__ int v_rd_base(int lane) { return ((lane & 3) << 3) | (((lane >> 2) & 3) << 6) | (((lane >> 4) & 1) << 5) | (((lane >> 5) & 1) << 8); }
constexpr int v_rd_off(int d0, int ks, int half) { return d0 * 512 + ks * 4096 + half * 2048; }
template <int OFF> __device__ __forceinline__ s16x4 tr_read(int vb) {
  s16x4 r; asm volatile("ds_read_b64_tr_b16 %0, %1 offset:%2" : "=&v"(r) : "v"(vb), "i"(OFF) : "memory"); return r;
}
template <int D0> __device__ __forceinline__ void pv_one(f32x16& od, int vb, bf16x8 pa0, bf16x8 pa1, bf16x8 pa2, bf16x8 pa3) {
  const s16x4 l0 = tr_read<v_rd_off(D0, 0, 0)>(vb), h0 = tr_read<v_rd_off(D0, 0, 1)>(vb), l1 = tr_read<v_rd_off(D0, 1, 0)>(vb), h1 = tr_read<v_rd_off(D0, 1, 1)>(vb);
  const s16x4 l2 = tr_read<v_rd_off(D0, 2, 0)>(vb), h2 = tr_read<v_rd_off(D0, 2, 1)>(vb), l3 = tr_read<v_rd_off(D0, 3, 0)>(vb), h3 = tr_read<v_rd_off(D0, 3, 1)>(vb);
  asm volatile("s_waitcnt lgkmcnt(0)" ::: "memory"); DA_SBAR();
#define DA_PK(L, H) (bf16x8){L[0], L[1], L[2], L[3], H[0], H[1], H[2], H[3]}
  od = __builtin_amdgcn_mfma_f32_32x32x16_bf16(pa0, DA_PK(l0, h0), od, 0, 0, 0);
  od = __builtin_amdgcn_mfma_f32_32x32x16_bf16(pa1, DA_PK(l1, h1), od, 0, 0, 0);
  od = __builtin_amdgcn_mfma_f32_32x32x16_bf16(pa2, DA_PK(l2, h2), od, 0, 0, 0);
  od = __builtin_amdgcn_mfma_f32_32x32x16_bf16(pa3, DA_PK(l3, h3), od, 0, 0, 0);
#undef DA_PK
}
__device__ __forceinline__ void pv_d0(f32x16* o, int vb, bf16x8 pa0, bf16x8 pa1, bf16x8 pa2, bf16x8 pa3) {
  pv_one<0>(o[0], vb, pa0, pa1, pa2, pa3); pv_one<1>(o[1], vb, pa0, pa1, pa2, pa3); pv_one<2>(o[2], vb, pa0, pa1, pa2, pa3); pv_one<3>(o[3], vb, pa0, pa1, pa2, pa3);
}
__device__ __forceinline__ void unit(const unsigned short* __restrict__ Qb, const unsigned short* __restrict__ Kh, const unsigned short* __restrict__ Vh,
                                     unsigned short* __restrict__ Ob, int ldo, int seq, float lam, float oscale, float soff, const float* __restrict__ subg, char* lds) {
  const int tid = otid(), wid = tid >> 6, lane = tid & 63, r32 = lane & 31, hi = lane >> 5, mp = wid >> 2, wq = wid & 3;
  char* V_lds = lds; char* K_lds = lds + 2 * SHM_V;
  float* ws = (float*)(lds + 2 * SHM_V + 2 * SHM_K) + wid * 64; float* li_l = ws;
  float l_reg = 0; f32x16 o[4] = {}; bf16x8 qr[4];
  const unsigned short* Qw = Qb + (long)(wq * 32 + r32) * 1024 + mp * 64 + hi * 8;
#pragma unroll
  for (int d0 = 0; d0 < 4; ++d0) qr[d0] = *reinterpret_cast<const bf16x8*>(Qw + d0 * 16);
  const int cbm = mp * 128;
  const int sr = tid >> 4, sc = (tid & 15) * 8, vst0 = v_st(sr, sc), vst1 = v_st(32 + sr, sc);
  const int vb0 = (int)(uintptr_t)V_lds + v_rd_base(lane);
  struct { bf16x8 vs0, vs1, ks0, ks1; } sr_[2];
#define DA_SLOAD(i, k0) do { sr_[i].vs0 = *reinterpret_cast<const bf16x8*>(&Vh[(long)((k0) + sr) * LDK + sc]); sr_[i].vs1 = *reinterpret_cast<const bf16x8*>(&Vh[(long)((k0) + 32 + sr) * LDK + sc]); \
    sr_[i].ks0 = *reinterpret_cast<const bf16x8*>(&Kh[(long)((k0) + sr) * LDK + sc]); sr_[i].ks1 = *reinterpret_cast<const bf16x8*>(&Kh[(long)((k0) + 32 + sr) * LDK + sc]); } while (0)
#define DA_SWRITE(b, i) do { *(bf16x8*)(V_lds + (b) * SHM_V + vst0) = sr_[i].vs0;          \
    *(bf16x8*)(V_lds + (b) * SHM_V + vst1) = sr_[i].vs1; int kc = sc * 2;               \
    *(bf16x8*)(K_lds + (b) * SHM_K + DA_KSWZ(sr, kc)) = sr_[i].ks0;                       \
    *(bf16x8*)(K_lds + (b) * SHM_K + DA_KSWZ(32 + sr, kc)) = sr_[i].ks1; } while (0)
#define DA_SWAIT() asm volatile("s_waitcnt vmcnt(4)" ::: "memory")
  f32x16 pA0, pA1, pB0, pB1; bf16x8 pa0, pa1, pa2, pa3; const int NT = seq / KVBLK;
  constexpr int SE = 0, SO = 1;
  DA_SLOAD(SE, 0); asm volatile("s_waitcnt vmcnt(0)" ::: "memory"); DA_SWRITE(0, SE); __syncthreads();
  qkt(pA0, pA1, K_lds, qr, r32, hi, cbm); expSM(pA0, pA1, soff);
  DA_SLOAD(SO, KVBLK); if (2 < NT) DA_SLOAD(SE, 2 * KVBLK);
  DA_SWAIT(); DA_SWRITE(1, SO); __syncthreads();
  for (int j = 1; j + 1 < NT; j += 2) {
    DA_SBAR(); qkt(pB0, pB1, K_lds + SHM_K, qr, r32, hi, cbm);
    finishSM(pA0, pA1, l_reg, pa0, pa1, pa2, pa3); DA_SBAR();
    DA_SLOAD(SO, (j + 2) * KVBLK); DA_SBAR();
    pv_d0(o, vb0, pa0, pa1, pa2, pa3); expSM(pB0, pB1, soff);
    __syncthreads(); DA_SWAIT(); DA_SWRITE(0, SE);
    __syncthreads();
    DA_SBAR(); qkt(pA0, pA1, K_lds, qr, r32, hi, cbm);
    finishSM(pB0, pB1, l_reg, pa0, pa1, pa2, pa3); DA_SBAR();
    if (j + 3 < NT) DA_SLOAD(SE, (j + 3) * KVBLK); DA_SBAR();
    pv_d0(o, vb0 + (int)SHM_V, pa0, pa1, pa2, pa3); expSM(pA0, pA1, soff);
    __syncthreads(); DA_SWAIT(); DA_SWRITE(1, SO);
    __syncthreads();
  }
  DA_SBAR(); qkt(pB0, pB1, K_lds + SHM_K, qr, r32, hi, cbm);
  finishSM(pA0, pA1, l_reg, pa0, pa1, pa2, pa3); DA_SBAR();
  pv_d0(o, vb0, pa0, pa1, pa2, pa3); expSM(pB0, pB1, soff);
  __syncthreads();
  finishSM(pB0, pB1, l_reg, pa0, pa1, pa2, pa3); DA_SBAR();
  pv_d0(o, vb0 + (int)SHM_V, pa0, pa1, pa2, pa3);
  { auto rr = __builtin_amdgcn_permlane32_swap(__float_as_uint(l_reg), __float_as_uint(l_reg), false, false); l_reg = __uint_as_float(rr[0]) + __uint_as_float(rr[1]); }
  if (hi == 0) li_l[r32] = l_reg; asm volatile("s_waitcnt lgkmcnt(0)" ::: "memory");
  const float sgn = mp ? lam : 1.f;
#pragma unroll
  for (int r = 0; r < 16; ++r) { const float rl = sgn * __builtin_amdgcn_rcpf(li_l[crow(r, hi)]);
#pragma unroll
    for (int d0 = 0; d0 < 4; ++d0) o[d0][r] *= rl; }
  __syncthreads();
  int xb = wq * 4096 + lane; asm volatile("" : "+v"(xb));
  float* X = (float*)lds + xb;
  if (mp == 1) {
#pragma unroll
    for (int d0 = 0; d0 < 4; ++d0)
#pragma unroll
      for (int r = 0; r < 16; ++r) X[(d0 * 16 + r) * 64] = o[d0][r];
  }
  __syncthreads();
  if (mp == 0) {
    float gg[4];
#pragma unroll
    for (int d0 = 0; d0 < 4; ++d0) gg[d0] = subg[d0 * 32 + r32] * oscale;
    int ob = (wq * 32 + 4 * hi) * ldo + r32; asm volatile("" : "+v"(ob));
    unsigned short* Ow = Ob + ob;
#pragma unroll
    for (int r = 0; r < 16; ++r) { float a = 0.f; float v[4];
#pragma unroll
      for (int d0 = 0; d0 < 4; ++d0) { v[d0] = o[d0][r] - X[(d0 * 16 + r) * 64]; a += v[d0] * v[d0]; }
      a += sx<1>(a); a += sx<2>(a); a += sx<4>(a); a += sx<8>(a); a += sx<16>(a);
      a = rsqrtf(a * (1.f / 128.f) + EPS);
      const int orow = (r & 3) + 8 * (r >> 2);
#pragma unroll
      for (int d0 = 0; d0 < 4; ++d0) Ow[orow * ldo + d0 * 32] = (unsigned short)f2bf(v[d0] * a * gg[d0]); }
  }
  __syncthreads();
#undef DA_SLOAD
#undef DA_SWRITE
#undef DA_SWAIT
}

template <int D0> __device__ __forceinline__ void v_rd8(s16x4 (&f)[8], int vb) {
  f[0] = tr_read<v_rd_off(D0, 0, 0)>(vb); f[1] = tr_read<v_rd_off(D0, 0, 1)>(vb); f[2] = tr_read<v_rd_off(D0, 1, 0)>(vb); f[3] = tr_read<v_rd_off(D0, 1, 1)>(vb);
  f[4] = tr_read<v_rd_off(D0, 2, 0)>(vb); f[5] = tr_read<v_rd_off(D0, 2, 1)>(vb); f[6] = tr_read<v_rd_off(D0, 3, 0)>(vb); f[7] = tr_read<v_rd_off(D0, 3, 1)>(vb);
}
__device__ __forceinline__ void pv_mm(f32x16& od, const s16x4 (&f)[8], bf16x8 pa0, bf16x8 pa1, bf16x8 pa2, bf16x8 pa3) {
#define DA_PK(L, H) (bf16x8){L[0], L[1], L[2], L[3], H[0], H[1], H[2], H[3]}
  od = __builtin_amdgcn_mfma_f32_32x32x16_bf16(pa0, DA_PK(f[0], f[1]), od, 0, 0, 0);
  od = __builtin_amdgcn_mfma_f32_32x32x16_bf16(pa1, DA_PK(f[2], f[3]), od, 0, 0, 0);
  od = __builtin_amdgcn_mfma_f32_32x32x16_bf16(pa2, DA_PK(f[4], f[5]), od, 0, 0, 0);
  od = __builtin_amdgcn_mfma_f32_32x32x16_bf16(pa3, DA_PK(f[6], f[7]), od, 0, 0, 0);
#undef DA_PK
}
__device__ __forceinline__ void pv_pipe(f32x16* o, int vb, bf16x8 pa0, bf16x8 pa1, bf16x8 pa2, bf16x8 pa3) {
  s16x4 fa[8], fb[8];
  v_rd8<0>(fa, vb); v_rd8<1>(fb, vb);
  asm volatile("s_waitcnt lgkmcnt(8)" ::: "memory"); DA_SBAR(); pv_mm(o[0], fa, pa0, pa1, pa2, pa3); DA_SBAR();
  v_rd8<2>(fa, vb);
  asm volatile("s_waitcnt lgkmcnt(8)" ::: "memory"); DA_SBAR(); pv_mm(o[1], fb, pa0, pa1, pa2, pa3); DA_SBAR();
  v_rd8<3>(fb, vb);
  asm volatile("s_waitcnt lgkmcnt(8)" ::: "memory"); DA_SBAR(); pv_mm(o[2], fa, pa0, pa1, pa2, pa3); DA_SBAR();
  asm volatile("s_waitcnt lgkmcnt(0)" ::: "memory"); DA_SBAR(); pv_mm(o[3], fb, pa0, pa1, pa2, pa3); DA_SBAR();
}
__device__ __forceinline__ void unit8(const unsigned short* __restrict__ Qb, const unsigned short* __restrict__ Kh, const unsigned short* __restrict__ Vh,
                                      unsigned short* __restrict__ Ob, int ldo, int seq, float lam, float oscale, float soff, const float* __restrict__ subg, LAS unsigned char* ldsl) {
  const int tid = otid(), wid = __builtin_amdgcn_readfirstlane(tid >> 6), lane = tid & 63, r32 = lane & 31, hi = lane >> 5, mp = wid >> 2, wq = wid & 3;
  constexpr int SLOT = 16384;
  char* lds = (char*)ldsl; char* K_lds = lds; const int vbase = (int)(uintptr_t)(lds + 3 * SLOT) + v_rd_base(lane);
  float* li_l = (float*)(lds + 6 * SLOT) + wid * 64;
  f32x16 o[4] = {}; bf16x8 qr[4];
  const unsigned short* Qw = Qb + (long)(wq * 32 + r32) * 1024 + mp * 64 + hi * 8;
#pragma unroll
  for (int d0 = 0; d0 < 4; ++d0) qr[d0] = *reinterpret_cast<const bf16x8*>(Qw + d0 * 16);
  asm volatile("s_waitcnt vmcnt(0)" ::: "memory");
  const int cbm = mp * 128;
  const unsigned wl = (unsigned)wid * 1024u;
  unsigned kso[2], vso[2];
#pragma unroll
  for (int i = 0; i < 2; ++i) { const int P = (i * 8 + wid) * 64 + lane;
    { const int row = P >> 4, chunk = (P & 15) ^ (row & 7); kso[i] = (unsigned)(row * LDK + chunk * 8) * 2u; }
    { const int sub = P >> 5, kk = (sub >> 2) * 8 + ((P & 31) >> 2), key = (kk & ~0xC) | ((kk & 4) << 1) | ((kk & 8) >> 1); vso[i] = (unsigned)(key * LDK + (sub & 3) * 32 + (P & 3) * 8) * 2u; } }
#define DA_DMA_K(t, slot) do { const unsigned to_ = (unsigned)(t) * (unsigned)(KVBLK * LDK * 2); _Pragma("unroll") for (int i_ = 0; i_ < 2; ++i_) \
      __builtin_amdgcn_global_load_lds((const unsigned*)((const char*)Kh + (kso[i_] + to_)), (LAS unsigned*)(ldsl + (slot) * SLOT + i_ * 8192 + wl), 16, 0, 0); } while (0)
#define DA_DMA_V(t, slot) do { const unsigned to_ = (unsigned)(t) * (unsigned)(KVBLK * LDK * 2); _Pragma("unroll") for (int i_ = 0; i_ < 2; ++i_) \
      __builtin_amdgcn_global_load_lds((const unsigned*)((const char*)Vh + (vso[i_] + to_)), (LAS unsigned*)(ldsl + (3 + (slot)) * SLOT + i_ * 8192 + wl), 16, 0, 0); } while (0)
#define U8_PK(t, slot, i_) __builtin_amdgcn_global_load_lds((const unsigned*)((const char*)Kh + (kso[i_] + (unsigned)(t) * (unsigned)(KVBLK * LDK * 2))), (LAS unsigned*)(ldsl + (slot) * SLOT + (i_) * 8192 + wl), 16, 0, 0)
#define U8_PV(t, slot, i_) __builtin_amdgcn_global_load_lds((const unsigned*)((const char*)Vh + (vso[i_] + (unsigned)(t) * (unsigned)(KVBLK * LDK * 2))), (LAS unsigned*)(ldsl + (3 + (slot)) * SLOT + (i_) * 8192 + wl), 16, 0, 0)
#define DA_WAITBAR(N) do { asm volatile("s_waitcnt vmcnt(" #N ") lgkmcnt(0)" ::: "memory"); __builtin_amdgcn_s_barrier(); asm volatile("" ::: "memory"); } while (0)
  f32x16 pA0, pA1, pB0, pB1; u32x4 pw0, pw1, pw2, pw3; const int NT = seq / KVBLK;
  bf16x8 kf[8];
  f32x16 negm, ol = {};
#pragma unroll
  for (int r = 0; r < 16; ++r) negm[r] = -soff;
  const bf16x8 ones = {0x3F80, 0x3F80, 0x3F80, 0x3F80, 0x3F80, 0x3F80, 0x3F80, 0x3F80};
  const int pkr = ((r32 & 3) + 4 * (r32 >> 3)), pk = (pkr & 7) + 16 * (pkr >> 3) + 8 * ((r32 >> 2) & 1);
#define U5_KADDR(d0) ((int)(uintptr_t)K_lds + pk * 256 + ((((cbm >> 4) + 2 * (d0) + hi) ^ (pk & 7)) * 16))
#define U5_KLOAD(slot) do { const int so_ = (slot) * SLOT; _Pragma("unroll") for (int d0 = 0; d0 < 4; ++d0) { const int ad_ = U5_KADDR(d0) + so_; \
    asm volatile("ds_read_b128 %0, %2\n\tds_read_b128 %1, %2 offset:8192" : "=&v"(kf[2 * d0]), "=&v"(kf[2 * d0 + 1]) : "v"(ad_) : "memory"); } } while (0)
#define U5_PIN(x) asm volatile("" : "+v"(x))
#define U5_EX(v) __builtin_amdgcn_exp2f(v)
#define U5_VRD(L, H, m) do { asm volatile("ds_read_b64_tr_b16 %0, %1 offset:%2" : "=&v"(L) : "v"(vb_), "i"(v_rd_off((m) >> 2, (m) & 3, 0)) : "memory"); \
    asm volatile("ds_read_b64_tr_b16 %0, %1 offset:%2" : "=&v"(H) : "v"(vb_), "i"(v_rd_off((m) >> 2, (m) & 3, 1)) : "memory"); } while (0)
#define U5_GAPA(MF, X, B4, PW, VR, CV0, CV1) do { MF; VR; CV0; CV1; U5_PIN(PW); DA_SBAR(); } while (0)
#define U5_CVT(P, b) cvtpk(P[b], P[b + 1])
#define U5_PHASE_A(C0, C1, P0, P1, VSLOT, HK0, HK1, HV0, HV1) do { const int vb_ = vbase + (VSLOT) * SLOT; \
    U5_GAPA(C0 = __builtin_amdgcn_mfma_f32_32x32x16_bf16(kf[0], qr[0], negm, 0, 0, 0), P0, 0, pw0, HK0, pw0[0] = U5_CVT(P0, 0), pw0[1] = U5_CVT(P0, 2)); \
    U5_GAPA(C1 = __builtin_amdgcn_mfma_f32_32x32x16_bf16(kf[1], qr[0], negm, 0, 0, 0), P0, 4, pw0, HK1, pw0[2] = U5_CVT(P0, 4), pw0[3] = U5_CVT(P0, 6)); \
    U5_GAPA(C0 = __builtin_amdgcn_mfma_f32_32x32x16_bf16(kf[2], qr[1], C0, 0, 0, 0), P0, 8, pw1, do { HV0; HV1; } while (0), pw1[0] = U5_CVT(P0, 8), pw1[1] = U5_CVT(P0, 10)); \
    U5_GAPA(C1 = __builtin_amdgcn_mfma_f32_32x32x16_bf16(kf[3], qr[1], C1, 0, 0, 0), P0, 12, pw1, U5_VRD(vl0, vh0, 0), pw1[2] = U5_CVT(P0, 12), pw1[3] = U5_CVT(P0, 14)); \
    U5_GAPA(C0 = __builtin_amdgcn_mfma_f32_32x32x16_bf16(kf[4], qr[2], C0, 0, 0, 0), P1, 0, pw2, U5_VRD(vl1, vh1, 1), pw2[0] = U5_CVT(P1, 0), pw2[1] = U5_CVT(P1, 2)); \
    U5_GAPA(C1 = __builtin_amdgcn_mfma_f32_32x32x16_bf16(kf[5], qr[2], C1, 0, 0, 0), P1, 4, pw2, U5_VRD(vl2, vh2, 2), pw2[2] = U5_CVT(P1, 4), pw2[3] = U5_CVT(P1, 6)); \
    U5_GAPA(C0 = __builtin_amdgcn_mfma_f32_32x32x16_bf16(kf[6], qr[3], C0, 0, 0, 0), P1, 8, pw3, U5_VRD(vl3, vh3, 3), pw3[0] = U5_CVT(P1, 8), pw3[1] = U5_CVT(P1, 10)); \
    U5_GAPA(C1 = __builtin_amdgcn_mfma_f32_32x32x16_bf16(kf[7], qr[3], C1, 0, 0, 0), P1, 12, pw3, U5_VRD(vl4, vh4, 4), pw3[2] = U5_CVT(P1, 12), pw3[3] = U5_CVT(P1, 14)); \
    } while (0)
#define U5_PKV(L, H) (bf16x8){L[0], L[1], L[2], L[3], H[0], H[1], H[2], H[3]}
#define U5_PAF(k) __builtin_bit_cast(bf16x8, pw##k)
#define U5_GAPB(WAITN, OD, PK, L, H, X, B2, NEXT) do { asm volatile("s_waitcnt lgkmcnt(" #WAITN ")" ::: "memory"); DA_SBAR(); \
    OD = __builtin_amdgcn_mfma_f32_32x32x16_bf16(PK, U5_PKV(L, H), OD, 0, 0, 0); NEXT; X[B2] = U5_EX(X[B2]); X[B2 + 1] = U5_EX(X[B2 + 1]); U5_PIN(X); DA_SBAR(); } while (0)
#define U5_GAPS(PK, X, B2) do { ol = __builtin_amdgcn_mfma_f32_32x32x16_bf16(PK, ones, ol, 0, 0, 0); X[B2] = U5_EX(X[B2]); X[B2 + 1] = U5_EX(X[B2 + 1]); U5_PIN(X); DA_SBAR(); } while (0)
#define U5_GAPN(WAITN, OD, PK, L, H, NEXT) do { asm volatile("s_waitcnt lgkmcnt(" #WAITN ")" ::: "memory"); DA_SBAR(); \
    OD = __builtin_amdgcn_mfma_f32_32x32x16_bf16(PK, U5_PKV(L, H), OD, 0, 0, 0); NEXT; DA_SBAR(); } while (0)
#define U5_PHASE_B(C0, C1, VSLOT, KSLOT, DOK) do { const int vb_ = vbase + (VSLOT) * SLOT; \
    U5_GAPS(U5_PAF(0), C0, 0); U5_GAPS(U5_PAF(1), C0, 2); U5_GAPS(U5_PAF(2), C0, 4); U5_GAPS(U5_PAF(3), C0, 6); \
    U5_GAPB(8, o[0], U5_PAF(0), vl0, vh0, C0, 8, U5_VRD(vl5, vh5, 5)); \
    U5_GAPB(8, o[0], U5_PAF(1), vl1, vh1, C0, 10, U5_VRD(vl0, vh0, 6)); \
    U5_GAPB(8, o[0], U5_PAF(2), vl2, vh2, C0, 12, U5_VRD(vl1, vh1, 7)); \
    U5_GAPB(8, o[0], U5_PAF(3), vl3, vh3, C0, 14, U5_VRD(vl2, vh2, 8)); \
    U5_GAPB(8, o[1], U5_PAF(0), vl4, vh4, C1, 0, U5_VRD(vl3, vh3, 9)); \
    U5_GAPB(8, o[1], U5_PAF(1), vl5, vh5, C1, 2, U5_VRD(vl4, vh4, 10)); \
    U5_GAPB(8, o[1], U5_PAF(2), vl0, vh0, C1, 4, U5_VRD(vl5, vh5, 11)); \
    U5_GAPB(8, o[1], U5_PAF(3), vl1, vh1, C1, 6, U5_VRD(vl0, vh0, 12)); \
    U5_GAPB(8, o[2], U5_PAF(0), vl2, vh2, C1, 8, U5_VRD(vl1, vh1, 13)); \
    U5_GAPB(8, o[2], U5_PAF(1), vl3, vh3, C1, 10, U5_VRD(vl2, vh2, 14)); \
    U5_GAPB(8, o[2], U5_PAF(2), vl4, vh4, C1, 12, U5_VRD(vl3, vh3, 15)); \
    U5_GAPB(8, o[2], U5_PAF(3), vl5, vh5, C1, 14, (void)0); \
    U5_GAPN(6, o[3], U5_PAF(0), vl0, vh0, (void)0); \
    if (DOK) { U5_GAPN(4, o[3], U5_PAF(1), vl1, vh1, U5_KLOAD(KSLOT)); U5_GAPN(10, o[3], U5_PAF(2), vl2, vh2, (void)0); U5_GAPN(8, o[3], U5_PAF(3), vl3, vh3, (void)0); } \
    else { U5_GAPN(4, o[3], U5_PAF(1), vl1, vh1, (void)0); U5_GAPN(2, o[3], U5_PAF(2), vl2, vh2, (void)0); U5_GAPN(0, o[3], U5_PAF(3), vl3, vh3, (void)0); } } while (0)
#define DA_ROT(x) ((x) == 2 ? 0 : (x) + 1)
#define DA_PRV(x) ((x) == 0 ? 2 : (x) - 1)
  s16x4 vl0, vh0, vl1, vh1, vl2, vh2, vl3, vh3, vl4, vh4, vl5, vh5;
  DA_DMA_K(0, 0); DA_DMA_K(1, 1); DA_DMA_V(0, 0);
  DA_WAITBAR(0);
  U5_KLOAD(0); DA_DMA_K(2, 2); DA_DMA_V(1, 1);
  DA_WAITBAR(4);
  DA_DMA_K(3, 0);
  DA_SBAR();
  pA0 = negm; pA1 = negm;
#pragma unroll
  for (int d0 = 0; d0 < 4; ++d0) { pA0 = __builtin_amdgcn_mfma_f32_32x32x16_bf16(kf[2 * d0], qr[d0], pA0, 0, 0, 0); pA1 = __builtin_amdgcn_mfma_f32_32x32x16_bf16(kf[2 * d0 + 1], qr[d0], pA1, 0, 0, 0); }
  DA_SBAR(); U5_KLOAD(1);
  expSM(pA0, pA1, 0.f);
  DA_WAITBAR(2);
  int c = 1;
  for (int j = 1; j + 1 < NT; j += 2) {
    { const bool mk = j + 3 < NT;
      DA_SBAR(); U5_PHASE_A(pB0, pB1, pA0, pA1, DA_PRV(c), if (mk) U8_PK(j + 3, c, 0), if (mk) U8_PK(j + 3, c, 1), U8_PV(j + 1, DA_ROT(c), 0), U8_PV(j + 1, DA_ROT(c), 1));
      U5_PHASE_B(pB0, pB1, DA_PRV(c), DA_ROT(c), true);
      if (mk) DA_WAITBAR(4); else DA_WAITBAR(2);
      c = DA_ROT(c); }
    { const bool mk = j + 4 < NT;
      DA_SBAR(); U5_PHASE_A(pA0, pA1, pB0, pB1, DA_PRV(c), if (mk) U8_PK(j + 4, c, 0), if (mk) U8_PK(j + 4, c, 1), U8_PV(j + 2, DA_ROT(c), 0), U8_PV(j + 2, DA_ROT(c), 1));
      U5_PHASE_B(pA0, pA1, DA_PRV(c), DA_ROT(c), true);
      if (mk) DA_WAITBAR(4); else DA_WAITBAR(2);
      c = DA_ROT(c); }
  }
  DA_SBAR(); U5_PHASE_A(pB0, pB1, pA0, pA1, DA_PRV(c), (void)0, (void)0, (void)0, (void)0);
  U5_PHASE_B(pB0, pB1, DA_PRV(c), 0, false);
  DA_WAITBAR(0);
  { u32x4 w0 = {cvtpk(pB0[0], pB0[1]), cvtpk(pB0[2], pB0[3]), cvtpk(pB0[4], pB0[5]), cvtpk(pB0[6], pB0[7])}, w1 = {cvtpk(pB0[8], pB0[9]), cvtpk(pB0[10], pB0[11]), cvtpk(pB0[12], pB0[13]), cvtpk(pB0[14], pB0[15])};
    u32x4 w2 = {cvtpk(pB1[0], pB1[1]), cvtpk(pB1[2], pB1[3]), cvtpk(pB1[4], pB1[5]), cvtpk(pB1[6], pB1[7])}, w3 = {cvtpk(pB1[8], pB1[9]), cvtpk(pB1[10], pB1[11]), cvtpk(pB1[12], pB1[13]), cvtpk(pB1[14], pB1[15])};
    const bf16x8 pa0 = __builtin_bit_cast(bf16x8, w0), pa1 = __builtin_bit_cast(bf16x8, w1), pa2 = __builtin_bit_cast(bf16x8, w2), pa3 = __builtin_bit_cast(bf16x8, w3); DA_SBAR();
    ol = __builtin_amdgcn_mfma_f32_32x32x16_bf16(pa0, ones, ol, 0, 0, 0); ol = __builtin_amdgcn_mfma_f32_32x32x16_bf16(pa1, ones, ol, 0, 0, 0);
    ol = __builtin_amdgcn_mfma_f32_32x32x16_bf16(pa2, ones, ol, 0, 0, 0); ol = __builtin_amdgcn_mfma_f32_32x32x16_bf16(pa3, ones, ol, 0, 0, 0);
    pv_d0(o, vbase + c * SLOT, pa0, pa1, pa2, pa3); }
#undef U5_KADDR
#undef U5_KLOAD
#undef U5_PIN
#undef U5_EX
#undef U5_GAPA
#undef U5_CVT
#undef U5_PHASE_A
#undef U5_VRD
#undef U5_PKV
#undef U5_PAF
#undef U5_GAPB
#undef U5_GAPS
#undef U5_GAPN
#undef U5_PHASE_B
  const int tid2 = otid(), wid2 = __builtin_amdgcn_readfirstlane(tid2 >> 6), lane2 = tid2 & 63; { const int r32 = lane2 & 31, hi = lane2 >> 5, mp = wid2 >> 2, wq = wid2 & 3, lane = lane2; float* li_l = (float*)(lds + 6 * SLOT) + wid2 * 64;
  const float sgn = mp ? lam : 1.f;
#pragma unroll
  for (int r = 0; r < 16; ++r) { const float rl = sgn * __builtin_amdgcn_rcpf(ol[r]);
#pragma unroll
    for (int d0 = 0; d0 < 4; ++d0) o[d0][r] *= rl; }
  __syncthreads();
  int xb = wq * 4096 + lane; asm volatile("" : "+v"(xb));
  float* X = (float*)lds + xb;
  if (mp == 1) {
#pragma unroll
    for (int d0 = 0; d0 < 4; ++d0)
#pragma unroll
      for (int r = 0; r < 16; ++r) X[(d0 * 16 + r) * 64] = o[d0][r];
  }
  __syncthreads();
  if (mp == 0) {
    float gg[4];
#pragma unroll
    for (int d0 = 0; d0 < 4; ++d0) gg[d0] = subg[d0 * 32 + r32] * oscale;
    int ob = (wq * 32 + 4 * hi) * ldo + r32; asm volatile("" : "+v"(ob));
    unsigned short* Ow = Ob + ob;
#pragma unroll
    for (int r = 0; r < 16; ++r) { float a = 0.f; float v[4];
#pragma unroll
      for (int d0 = 0; d0 < 4; ++d0) { v[d0] = o[d0][r] - X[(d0 * 16 + r) * 64]; a += v[d0] * v[d0]; }
      a += sx<1>(a); a += sx<2>(a); a += sx<4>(a); a += sx<8>(a); a += sx<16>(a);
      a = rsqrtf(a * (1.f / 128.f) + EPS);
      const int orow = (r & 3) + 8 * (r >> 2);
#pragma unroll
      for (int d0 = 0; d0 < 4; ++d0) Ow[orow * ldo + d0 * 32] = (unsigned short)f2bf(v[d0] * a * gg[d0]); }
  }
  }
  asm volatile("s_waitcnt vmcnt(0)" ::: "memory");
  __syncthreads();
#undef DA_DMA_K
#undef DA_DMA_V
#undef DA_WAITBAR
#undef DA_ROT
#undef DA_PRV
}
}
__device__ __forceinline__ void ph_attn(const Frame& F, const Args& A, int l) {
    const bf16 *Kb = WSP(bf16, WS_KB), *Vb = WSP(bf16, WS_VB), *Qb = WSP(bf16, WS_QB); bf16* MX = WSP(bf16, WS_MIXIN);
    const float* lq = A.in[10] + l * 256; float d01 = 0.f, d23 = 0.f;
    for (int i = 0; i < 64; ++i) { d01 += lq[i] * lq[64 + i]; d23 += lq[128 + i] * lq[192 + i]; }
    const float lam_init = 0.8f - 0.6f * expf(-0.3f * (float)l); float lam = expf(d01) - expf(d23) + lam_init;
    float mq = 0.f, mk = 0.f;
    for (int i = 0; i < 64; ++i) { mq = fmaxf(mq, fabsf(A.in[8][l * 64 + i])); mk = fmaxf(mk, fabsf(A.in[9][l * 64 + i])); }
    const float soff = __uint_as_float(__builtin_amdgcn_readfirstlane(__float_as_uint(64.f * mq * mk * QSCALE)));
    lam = __uint_as_float(__builtin_amdgcn_readfirstlane(__float_as_uint(lam))); const float osc = __uint_as_float(__builtin_amdgcn_readfirstlane(__float_as_uint(1.f - lam_init)));
    const int vcu = (F.G % 8 == 0) ? (F.bid % 8) * (F.G / 8) + F.bid / 8 : F.bid;
    for (int u = vcu; u < (l == DEPTH - 1 ? 1024 : 16 * 66); u += F.G) {
        const int bh = (u % 1024) / 64 , b = bh >> 3, h = bh & 7;
        int qb; int bb = b, hh = h;
        if (u < 1024) qb = 2 + (u & 63); else { const int v = u - 1024; bb = v >> 4; hh = (v >> 1) & 7; qb = v & 1; }
        const size_t R0 = (size_t)bb * TPB + qb * 128; const int seq = qb < 2 ? CTX : TPB;
#if ATTN_V2 == 8
        da::unit8(Qb + R0 * 1024 + hh * 128, Kb + (size_t)bb * TPB * 1024 + hh * 128, Vb + (size_t)bb * TPB * 1024 + hh * 128,
                  MX + R0 * 3072 + hh * 128, 3072, seq, lam, osc, soff, A.in[11] + l * 128, F.lds);
#else
        da::unit(Qb + R0 * 1024 + hh * 128, Kb + (size_t)bb * TPB * 1024 + hh * 128, Vb + (size_t)bb * TPB * 1024 + hh * 128,
                 MX + R0 * 3072 + hh * 128, 3072, seq, lam, osc, soff, A.in[11] + l * 128, (char*)F.lds);
#endif
    }
}

__device__ __forceinline__ void ph_mix(const Frame& F, const Args& A) {
    const float *PA = WSP(float, WS_PA), *PR = WSP(float, WS_PR), *PF = WSP(float, WS_PF); const bf16* GT = WSP(bf16, WS_GATES); bf16* MD = WSP(bf16, WS_MIXED);
    for (long i = F.gtid; i < (long)MROWS * 1024; i += F.NT) { const size_t R = (size_t)(i >> 10); const int c = (int)(i & 1023);
        MD[i] = (bf16)f2bf(bf2f(GT[R * 3072 + c]) * PA[i] + bf2f(GT[R * 3072 + 1024 + c]) * PR[i] + bf2f(GT[R * 3072 + 2048 + c]) * PF[i]); }
}
__device__ __forceinline__ void ph_resid_norm2(const Frame& F, const Args& A, int l) {
    float* X = WSP(float, WS_XALL); const float* Y1 = WSP(float, WS_Y1); bf16* TOK = WSP(bf16, WS_TOK);
    for (int R = F.gw; R < MROWS; R += F.NGW) {
        const int b = R / TPB, p = R % TPB, s = (p < CTX) ? 2 : b; const float* g1 = MODP(l, s, 2);
        f32x4 v[4];
#pragma unroll
        for (int j = 0; j < 4; ++j) { const int c = 4 * F.lane + 256 * j; const f32x4 x = *(const f32x4*)(X + (size_t)R * 1024 + c), y = *(const f32x4*)(Y1 + (size_t)R * 1024 + c), gg = *(const f32x4*)(g1 + c);
            v[j] = x + gg * y; *(f32x4*)(X + (size_t)R * 1024 + c) = v[j]; }
        norm_mod_row(v, A.in[23] + l * 1024, MODP(l, s, 4), MODP(l, s, 3), TOK + (size_t)R * 1024, F.lane);
    }
}
#define G1(T) __attribute__((address_space(1))) T
template <int CTRL, int RM = 0xf> __device__ __forceinline__ float dpp_f(float v) {
    return __uint_as_float(__builtin_amdgcn_update_dpp(__float_as_uint(v), __float_as_uint(v), CTRL, RM, 0xf, false)); }
__device__ __forceinline__ float wave_max63(float v) {
    asm volatile("s_nop 1\n\tv_max_f32_dpp %0, %0, %0 row_ror:1 row_mask:0xf bank_mask:0xf\n\ts_nop 1\n\tv_max_f32_dpp %0, %0, %0 row_ror:2 row_mask:0xf bank_mask:0xf\n\t"
                 "s_nop 1\n\tv_max_f32_dpp %0, %0, %0 row_ror:4 row_mask:0xf bank_mask:0xf\n\ts_nop 1\n\tv_max_f32_dpp %0, %0, %0 row_ror:8 row_mask:0xf bank_mask:0xf\n\t"
                 "s_nop 1\n\tv_max_f32_dpp %0, %0, %0 row_bcast:15 row_mask:0xa bank_mask:0xf\n\ts_nop 1\n\tv_max_f32_dpp %0, %0, %0 row_bcast:31 row_mask:0xc bank_mask:0xf\n\ts_nop 1" : "+v"(v));
    return v; }
template <bool DRY = false> __device__ __forceinline__ void ph_topk(const Frame& F, const Args& A, int l) {
    const float* LG = WSP(float, WS_LOG);
    int* LIST = DRY ? WSP(int, WS_PR) : WSP(int, WS_LIST); float* TOPW = DRY ? WSP(float, WS_PR + 18 * MiB) : WSP(float, WS_TOPW); int* EPO = DRY ? WSP(int, WS_PR + 19 * MiB) : WSP(int, WS_EP);
    int* CNT = (int*)(A.ws + WS_CTL) + CW_CNT + (DRY ? 2 : l) * 256 * CNT_STRIDE;
    const float NEG = -__builtin_inff();
    const bool skipctx = l == DEPTH - 1;
    const f32x4 rb4 = *(const G1(f32x4)*)(A.in[25] + l * 256 + 4 * F.lane);
    constexpr int SLOTS = 9;
    for (int base = F.gw; base < MROWS; base += SLOTS * F.NGW) {
        f32x4 lg[SLOTS]; int es[SLOTS], ps[SLOTS]; float wt[SLOTS];
#pragma unroll
        for (int i = 0; i < SLOTS; ++i) { const int R = base + i * F.NGW; lg[i] = f32x4{0.f, 0.f, 0.f, 0.f}; es[i] = 0; ps[i] = 0; wt[i] = 0.f;
            if (R < MROWS && !(skipctx && (R % TPB) < CTX)) lg[i] = *(const G1(f32x4)*)(LG + (size_t)R * 256 + 4 * F.lane); }
#pragma unroll
        for (int i = 0; i < SLOTS; ++i) { const int R = base + i * F.NGW;
            if (R < MROWS && !(skipctx && (R % TPB) < CTX)) {
                const float sc[4] = {sigmoidf_(lg[i].x), sigmoidf_(lg[i].y), sigmoidf_(lg[i].z), sigmoidf_(lg[i].w)};
                const float bi[4] = {sc[0] + rb4.x, sc[1] + rb4.y, sc[2] + rb4.z, sc[3] + rb4.w};
                float t1 = fmaxf(bi[0], bi[1]), t2 = fminf(bi[0], bi[1]);
                { const float u1 = fmaxf(bi[2], bi[3]), u2 = fminf(bi[2], bi[3]); const float n1 = fmaxf(t1, u1), n2 = fmaxf(fminf(t1, u1), fmaxf(t2, u2)); t1 = n1; t2 = n2; }
#define TK_M2(C) { const float o1 = dpp_f<C>(t1), o2 = dpp_f<C>(t2); const float n1 = fmaxf(t1, o1), n2 = fmaxf(fminf(t1, o1), fmaxf(t2, o2)); t1 = n1; t2 = n2; }
                TK_M2(0xB1) TK_M2(0x4E) TK_M2(0x141)
#undef TK_M2
                const float gs = t1 + t2; const int mygrp = F.lane >> 3; int rank = 0;
#pragma unroll
                for (int j = 0; j < 8; ++j) { const float sj = __uint_as_float(__builtin_amdgcn_readlane(__float_as_uint(gs), j * 8)); rank += (int)(sj > gs) | ((int)(sj == gs) & (int)(j < mygrp)); }
                const bool sel = rank < 4;
                float cand[4];
#pragma unroll
                for (int q = 0; q < 4; ++q) cand[q] = sel ? bi[q] : NEG;
                int my_e = 0; float my_s = 0.f, ssum = 0.f;
#pragma unroll
                for (int k = 0; k < 8; ++k) {
                    float bv = cand[0], bs = sc[0]; int bq = 0;
#pragma unroll
                    for (int q = 1; q < 4; ++q) { const bool g = cand[q] > bv; bv = g ? cand[q] : bv; bs = g ? sc[q] : bs; bq = g ? q : bq; }
                    const float mx = __uint_as_float(__builtin_amdgcn_readlane(__float_as_uint(wave_max63(bv)), 63));
                    const int ol = (int)__builtin_ctzll(__ballot(bv == mx));
                    const int oq = __builtin_amdgcn_readlane(bq, ol); const float sv = __uint_as_float(__builtin_amdgcn_readlane(__float_as_uint(bs), ol));
                    const bool me = F.lane == ol;
#pragma unroll
                    for (int q = 0; q < 4; ++q) cand[q] = (me & (oq == q)) ? NEG : cand[q];
                    ssum += sv;
                    { const int ev = 4 * ol + oq; asm volatile("v_writelane_b32 %0, %1, %2" : "+v"(my_e) : "s"(ev), "n"(k)); asm volatile("v_writelane_b32 %0, %1, %2" : "+v"(my_s) : "s"(sv), "n"(k)); }
                }
                es[i] = my_e; wt[i] = my_s * __builtin_amdgcn_rcpf(ssum) * 2.5f;
            } }
#pragma unroll
        for (int i = 0; i < SLOTS; ++i) { const int R = base + i * F.NGW;
            if (R < MROWS && !(skipctx && (R % TPB) < CTX) && F.lane < 8) ps[i] = __hip_atomic_fetch_add((G1(int)*)(CNT + es[i] * CNT_STRIDE), 1, __ATOMIC_RELAXED, __HIP_MEMORY_SCOPE_AGENT); }
#pragma unroll
        for (int i = 0; i < SLOTS; ++i) { const int R = base + i * F.NGW;
            if (R < MROWS && !(skipctx && (R % TPB) < CTX) && F.lane < 8) {
                *(G1(int)*)(LIST + (size_t)es[i] * LCAP + ps[i]) = R * 8 + F.lane; *(G1(float)*)(TOPW + (size_t)R * 8 + F.lane) = wt[i]; *(G1(int)*)(EPO + (size_t)R * 8 + F.lane) = es[i] * LCAP + ps[i]; } }
    }
}
__device__ __forceinline__ void ph_experts_naive(const Frame& F, const Args& A, int l) {
    const bf16* TOK = WSP(bf16, WS_TOK); const int* LIST = WSP(int, WS_LIST); const float* TOPW = WSP(float, WS_TOPW); float* YB = WSP(float, WS_YB);
    const int* CNT = (const int*)(A.ws + WS_CTL) + CW_CNT + l * 256 * CNT_STRIDE;
    LAS bf16* Xs = (LAS bf16*)F.lds;
    LAS float* Hs = (LAS float*)(F.lds + 65536);
    LAS int* pref = (LAS int*)(F.lds + 98304);
    LAS int* sPair = pref + 320; LAS float* sW = (LAS float*)(sPair + 32);
    __syncthreads();
    if (F.tid == 0) { int s = 0; for (int e = 0; e < 256; ++e) { pref[e] = s; s += (CNT[e] + 31) >> 5; } pref[256] = s; }
    __syncthreads();
    const int total = pref[256];
    for (int id = F.bid; id < total; id += F.G) {
        int lo = 0, hi = 255; while (lo < hi) { const int mid = (lo + hi + 1) >> 1; if (pref[mid] <= id) lo = mid; else hi = mid - 1; }
        const int e = lo, c = id - pref[e], n = min(32, CNT[e] - c * 32);
        __syncthreads();
        if (F.tid < 32) { const int pr = F.tid < n ? LIST[(size_t)e * LCAP + c * 32 + F.tid] : -1; sPair[F.tid] = pr; sW[F.tid] = pr >= 0 ? TOPW[pr] : 0.f; }
        __syncthreads();
        for (int pc = F.tid; pc < 4096; pc += 512) { const int row = pc >> 7, c8 = (pc & 127) * 8, pr = sPair[row];
            v4u v = {0u, 0u, 0u, 0u}; if (pr >= 0) v = *(const v4u*)(TOK + (size_t)(pr >> 3) * 1024 + c8);
            *(LAS v4u*)(Xs + row * 1024 + c8) = v; }
        __syncthreads();
        { const int f = F.tid & 255, gu = F.tid >> 8; const float* W = (gu ? A.in[27] : A.in[26]) + ((size_t)(l * 256 + e) * 1024) * 256 + f;
          float acc[32];
#pragma unroll
          for (int r = 0; r < 32; ++r) acc[r] = 0.f;
          for (int k = 0; k < 1024; ++k) { const float w = W[(size_t)k * 256];
#pragma unroll
              for (int r = 0; r < 32; ++r) acc[r] += bf2f(Xs[r * 1024 + k]) * w; }
          if (gu == 0) {
#pragma unroll
              for (int r = 0; r < 32; ++r) Hs[r * 256 + f] = siluf_(acc[r]); }
          __syncthreads();
          if (gu == 1) {
#pragma unroll
              for (int r = 0; r < 32; ++r) Hs[r * 256 + f] *= acc[r]; }
          __syncthreads(); }
        { const float* Wd = A.in[28] + ((size_t)(l * 256 + e) * 256) * 1024 + F.tid;
          float a0[32], a1[32];
#pragma unroll
          for (int r = 0; r < 32; ++r) { a0[r] = 0.f; a1[r] = 0.f; }
          for (int k = 0; k < 256; ++k) { const float w0 = Wd[(size_t)k * 1024], w1 = Wd[(size_t)k * 1024 + 512];
#pragma unroll
              for (int r = 0; r < 32; ++r) { const float hv = Hs[r * 256 + k]; a0[r] += hv * w0; a1[r] += hv * w1; } }
#pragma unroll
          for (int r = 0; r < 32; ++r) { const int pr = sPair[r]; if (pr >= 0) { const float w = sW[r]; YB[(size_t)pr * 1024 + F.tid] = a0[r] * w; YB[(size_t)pr * 1024 + 512 + F.tid] = a1[r] * w; } } }
    }
}
struct TrItem { const float* W; bf16* WT; int ldw, k0, n0, ldwt, rowbase; };
__device__ __forceinline__ void tr_load(const TrItem& t, f32x4 (&v)[8], int lane) {
    const int rr = lane >> 3, c4 = (lane & 7) * 4;
#pragma unroll
    for (int i = 0; i < 8; ++i) v[i] = __builtin_nontemporal_load((const f32x4*)(t.W + (size_t)(t.k0 + 8 * i + rr) * t.ldw + t.n0 + c4));
}
__device__ __forceinline__ void tr_load_a(const TrItem& t, f32x4 (&v)[8], int lane) {
    const int rr = lane >> 3, c4 = (lane & 7) * 4;
#pragma unroll
    for (int i = 0; i < 8; ++i) { const float* p = t.W + (size_t)(t.k0 + 8 * i + rr) * t.ldw + t.n0 + c4; asm volatile("global_load_dwordx4 %0, %1, off nt" : "=v"(v[i]) : "v"(p) : "memory"); }
}
__device__ __forceinline__ void tr_store(const TrItem& t, const f32x4 (&v)[8], LAS float* scr, int lane) {
    const int rr = lane >> 3, c4 = (lane & 7) * 4;
#pragma unroll
    for (int i = 0; i < 8; ++i) { LAS float* d = scr + (8 * i + rr) * 33 + c4; d[0] = v[i].x; d[1] = v[i].y; d[2] = v[i].z; d[3] = v[i].w; }
    LDS_WAIT(); asm volatile("" ::: "memory");
    const int c = lane & 7;
#pragma unroll
    for (int j = 0; j < 4; ++j) { const int n = (lane >> 3) + 8 * j; const LAS float* sp = scr + (8 * c) * 33 + n;
        v4u o; o.x = pk2(sp[0 * 33], sp[1 * 33]); o.y = pk2(sp[2 * 33], sp[3 * 33]); o.z = pk2(sp[4 * 33], sp[5 * 33]); o.w = pk2(sp[6 * 33], sp[7 * 33]);
        __builtin_nontemporal_store(o, (v4u*)(t.WT + (size_t)(t.rowbase + n) * t.ldwt + t.k0 + 8 * c)); }
    LDS_WAIT(); asm volatile("" ::: "memory");
}
__device__ __forceinline__ TrItem expert_item(const Args& A, int l, int it) {
    const int e = it / 384, r = it % 384; bf16* E1 = (bf16*)(A.ws + EWL(l) + (size_t)e * EW_STRIDE); TrItem t;
    if (r < 256) { const int up = r >> 7, q = r & 127, kb = q >> 3, nb = q & 7, n0 = 32 * nb;
        t.W = (up ? A.in[27] : A.in[26]) + ((size_t)(l * 256 + e) * 1024) * 256; t.ldw = 256; t.k0 = 64 * kb; t.n0 = n0; t.WT = E1; t.ldwt = 1024; t.rowbase = (n0 >> 7) * 256 + up * 128 + (n0 & 127); }
    else { const int q = r - 256, kb = q >> 5, nb = q & 31;
        t.W = A.in[28] + ((size_t)(l * 256 + e) * 256) * 1024; t.ldw = 1024; t.k0 = 64 * kb; t.n0 = 32 * nb; t.WT = E1 + 512 * 1024; t.ldwt = 256; t.rowbase = 32 * nb; }
    return t;
}
__device__ __forceinline__ void ph_expert_w_idx(const Frame& F, const Args& A, int l, int lo, int hi, int ci, int nblk) {
    if (ci < 0 || ci >= nblk) return;
    LAS float* scr = (LAS float*)(F.lds + F.wave * 16384);
    const int stride = nblk * NWAVES; int it = lo + ci * NWAVES + F.wave; if (it >= hi) return;
    f32x4 va[8], vb[8], vc[8]; TrItem ta = expert_item(A, l, it), tb = ta, tc = ta;
    tr_load_a(ta, va, F.lane);
    if (it + stride < hi) { tb = expert_item(A, l, it + stride); tr_load_a(tb, vb, F.lane); }
#define EW_STEP(TP, VP, TS, VS) { if (it + 2 * stride < hi) { TP = expert_item(A, l, it + 2 * stride); tr_load_a(TP, VP, F.lane); asm volatile("s_waitcnt vmcnt(16)" ::: "memory"); } \
        else asm volatile("s_waitcnt vmcnt(0)" ::: "memory"); \
        tr_store(TS, VS, scr, F.lane); it += stride; if (it >= hi) break; }
    for (;;) {
        EW_STEP(tc, vc, ta, va)
        EW_STEP(ta, va, tb, vb)
        EW_STEP(tb, vb, tc, vc)
    }
#undef EW_STEP
}
__device__ __forceinline__ void ph_expert_w(const Frame& F, const Args& A, int l, int lo, int hi, int blk0, int nblk) { ph_expert_w_idx(F, A, l, lo, hi, F.bid - blk0, nblk); }
constexpr int EWI_N = 256 * 384, EWI_A = 9800, EWI_B = 20800, EWI_C = 75000, EWI_D = 90000;
constexpr int KCONV_WIN = 18, KCONV_LRU = 44, KCONV_D = 124;
constexpr int KCONV_RS = 58, Q13 = 12, Q15 = 72, Q16 = 48;
__device__ __forceinline__ int moe_geff(int units, int G) { if (units <= 0) return G; const int rounds = (units + G - 1) / G; return (units + rounds - 1) / rounds; }
constexpr int MOE_MAXU = 11;
struct MoeSched {
    const LAS int* pref; const LAS int* cnt; const int* list; const char* abase; const char* bbase; int npn, G, c, lda2; size_t b_pn_stride; bool gather; LAS int* idx;
    __device__ __forceinline__ bool next(int i, pg8::UnitG& U) const {
        const long id = (long)i * G + c; const int total = pref[256]; if (id >= (long)total * npn) return false;
        const int tau = (int)(id / npn), pn = (int)(id % npn);
        int lo = 0, hi = 255; while (lo < hi) { const int mid = (lo + hi + 1) >> 1; if (pref[mid] <= tau) lo = mid; else hi = mid - 1; }
        const int e = lo, t = tau - pref[e];
        U.e = e; U.pn = pn; U.valid = min(256, cnt[e] - t * 256); U.rows = list + (size_t)e * LCAP + t * 256; U.row0 = tau * 256; U.lrows = idx ? idx + (i % MOE_MAXU) * 256 : nullptr;
        U.a = gather ? abase : abase + (size_t)tau * 256 * lda2; U.b = bbase + (size_t)e * EW_STRIDE + (size_t)pn * b_pn_stride; return true;
    }
};
__device__ __forceinline__ void moe_prefix(const Frame& F, const int* CNT, LAS int* pref) {
    LAS int* tmp = pref + 320;
    __syncthreads();
    if (F.tid < 256) tmp[F.tid] = CNT[F.tid * CNT_STRIDE];
    __syncthreads();
    if (F.tid <= 256) { int sum = 0; for (int e = 0; e < F.tid; ++e) sum += (tmp[e] + 255) >> 8; pref[F.tid] = sum; }
    __syncthreads();
}
struct EpiSwiGLU {
    static constexpr bool PERM = true;
    bf16* HB;
    __device__ __forceinline__ void operator()(const f32x4 (&acc)[2][2][4][2], const pg8::UnitG& u, int wr, int wc, int fr, int fq) const {
#pragma unroll
        for (int ai = 0; ai < 2; ++ai)
#pragma unroll
            for (int m = 0; m < 4; ++m) { const int r = ai * 128 + wr * 64 + m * 16 + fr;
                const f32x4 g0 = acc[ai][0][m][0], g1 = acc[ai][0][m][1], u0 = acc[ai][1][m][0], u1 = acc[ai][1][m][1];
                v4u w; w.x = pk2(siluf_(g0[0]) * u0[0], siluf_(g0[1]) * u0[1]); w.y = pk2(siluf_(g0[2]) * u0[2], siluf_(g0[3]) * u0[3]);
                w.z = pk2(siluf_(g1[0]) * u1[0], siluf_(g1[1]) * u1[1]); w.w = pk2(siluf_(g1[2]) * u1[2], siluf_(g1[3]) * u1[3]);
                *(v4u*)(HB + (size_t)(u.row0 + r) * 256 + u.pn * 128 + wc * 32 + 8 * fq) = w; }
    }
};
struct EpiScatter {
    static constexpr bool PERM = true;
    bf16* Y;
    __device__ __forceinline__ void operator()(const f32x4 (&acc)[2][2][4][2], const pg8::UnitG& u, int wr, int wc, int fr, int fq) const {
#pragma unroll
        for (int ai = 0; ai < 2; ++ai)
#pragma unroll
            for (int m = 0; m < 4; ++m) { const int r = ai * 128 + wr * 64 + m * 16 + fr;
                if (r < u.valid) { bf16* dst = Y + (size_t)(u.row0 + r) * 1024 + u.pn * 256 + wc * 32 + 8 * fq;
#pragma unroll
                    for (int bj = 0; bj < 2; ++bj) { const f32x4 v0 = acc[ai][bj][m][0], v1 = acc[ai][bj][m][1];
                        v4u o; o.x = pk2(v0[0], v0[1]); o.y = pk2(v0[2], v0[3]); o.z = pk2(v1[0], v1[1]); o.w = pk2(v1[2], v1[3]);
                        *(v4u*)(dst + bj * 128) = o; } } }
    }
};
__device__ __forceinline__ int conv_base(const Frame& F, const Args& A, int l) {
    if (l == 0) return 0;
    const int* CNT = (const int*)(A.ws + WS_CTL) + CW_CNT + (l - 1) * 256 * CNT_STRIDE; LAS int* pref = (LAS int*)(F.lds + RING_BYTES + 1024);
    moe_prefix(F, CNT, pref);
    const int tiles = pref[256], k15 = F.G - moe_geff(2 * tiles, F.G), k16 = F.G - moe_geff(4 * tiles, F.G);
    int base = KCONV_RS * NWAVES * Q13 + k15 * NWAVES * Q15 + k16 * NWAVES * Q16;
    __syncthreads();
    return base < EWI_N ? base : EWI_N;
}
__device__ __forceinline__ void ph_experts_up(const Frame& F, const Args& A, int l) {
    const int* CNT = (const int*)(A.ws + WS_CTL) + CW_CNT + l * 256 * CNT_STRIDE; LAS int* pref = (LAS int*)(F.lds + RING_BYTES + 1024);
    moe_prefix(F, CNT, pref);
    const int vcu = (F.G % 8 == 0) ? (F.bid % 8) * (F.G / 8) + F.bid / 8 : F.bid;
    const bool early = l + 1 < DEPTH; const int tiles = pref[256], Ge = early ? moe_geff(2 * tiles, F.G) : F.G;
    if (vcu < Ge) {
        LAS int* idx = (LAS int*)(F.lds + RING_BYTES + 4608);
        MoeSched S{pref, pref + 320, WSP(int, WS_LIST), (const char*)WSP(bf16, WS_TOK), (const char*)(A.ws + EWL(l)), 2, Ge, vcu, 2048, (size_t)256 * 1024 * 2, true, idx};
        { int vals[MOE_MAXU];
#pragma unroll
          for (int i = 0; i < MOE_MAXU; ++i) { pg8::UnitG U; vals[i] = 0; if (S.next(i, U) && F.tid < 256) vals[i] = *(const G1(int)*)(U.rows + min(F.tid, U.valid - 1)); }
#pragma unroll
          for (int i = 0; i < MOE_MAXU; ++i) if (F.tid < 256) idx[i * 256 + F.tid] = vals[i]; }
        __syncthreads();
        EpiSwiGLU E{WSP(bf16, WS_HB)};
        pg8::gemm_phase_g<EpiSwiGLU, MoeSched, true>(F.lds, 1024, 1024, 1024, S, E);
    } else { const int k = F.G - Ge, lo = KCONV_RS * NWAVES * Q13; ph_expert_w_idx(F, A, l + 1, lo, min(EWI_N, lo + k * NWAVES * Q15), vcu - Ge, k); }
    __syncthreads();
}
__device__ __forceinline__ void ph_experts_down(const Frame& F, const Args& A, int l) {
    const int* CNT = (const int*)(A.ws + WS_CTL) + CW_CNT + l * 256 * CNT_STRIDE; LAS int* pref = (LAS int*)(F.lds + RING_BYTES + 1024);
    moe_prefix(F, CNT, pref);
    const int vcu = (F.G % 8 == 0) ? (F.bid % 8) * (F.G / 8) + F.bid / 8 : F.bid;
    const bool early = l + 1 < DEPTH; const int tiles = pref[256], Ge = early ? moe_geff(4 * tiles, F.G) : F.G;
    if (vcu < Ge) {
        MoeSched S{pref, pref + 320, WSP(int, WS_LIST), (const char*)WSP(bf16, WS_HB), (const char*)(A.ws + EWL(l) + 512 * 1024 * 2), 4, Ge, vcu, 512, (size_t)256 * 256 * 2, false, nullptr};
        EpiScatter E{WSP(bf16, WS_Y16)};
        pg8::gemm_phase_g<EpiScatter, MoeSched, false>(F.lds, 256, 256, 256, S, E);
    } else { const int k = F.G - Ge, k15 = F.G - moe_geff(2 * tiles, F.G), lo = KCONV_RS * NWAVES * Q13 + k15 * NWAVES * Q15;
        ph_expert_w_idx(F, A, l + 1, min(EWI_N, lo), min(EWI_N, lo + k * NWAVES * Q16), vcu - Ge, k); }
}
template <bool DRY = false> __device__ __forceinline__ void ph_combine(const Frame& F, const Args& A, int l) {
    const float* X = WSP(float, WS_XALL); float* XO = DRY ? WSP(float, WS_U + 492 * MiB) : WSP(float, WS_XALL); bf16* HO = DRY ? WSP(bf16, WS_U + 558 * MiB) : WSP(bf16, WS_H); const bf16* SD = WSP(bf16, WS_SD); const bf16* YS = WSP(bf16, WS_Y16); const int* EP = WSP(int, WS_EP); const float* TOPW = WSP(float, WS_TOPW);
    const int* CNT = (const int*)(A.ws + WS_CTL) + CW_CNT + l * 256 * CNT_STRIDE; LAS int* pref = (LAS int*)(F.lds + RING_BYTES + 1024);
    moe_prefix(F, CNT, pref);
    for (int R = F.gw; R < MROWS; R += F.NGW) {
        const int b = R / TPB, p = R % TPB, s = (p < CTX) ? 2 : b; const float* g2 = MODP(l, s, 5);
        if (l == DEPTH - 1 && p < CTX) continue;
        size_t so[8]; float wk[8];
#pragma unroll
        for (int k = 0; k < 8; ++k) { const int ep = EP[(size_t)R * 8 + k], e = ep / LCAP, pos = ep - e * LCAP; so[k] = ((size_t)pref[e] * 256 + pos) * 1024; wk[k] = TOPW[(size_t)R * 8 + k]; }
        v4u yv[2][8], sd[2]; f32x4 xin[2][2];
#pragma unroll
        for (int j = 0; j < 2; ++j) { const int c = 8 * F.lane + 512 * j;
#pragma unroll
            for (int k = 0; k < 8; ++k) yv[j][k] = *(const v4u*)(YS + so[k] + c);
            sd[j] = *(const v4u*)(SD + (size_t)R * 1024 + c);
            xin[j][0] = *(const f32x4*)(X + (size_t)R * 1024 + c); xin[j][1] = *(const f32x4*)(X + (size_t)R * 1024 + c + 4); }
        float xo[2][8]; float ss = 0.f;
#pragma unroll
        for (int j = 0; j < 2; ++j) { const int c = 8 * F.lane + 512 * j; float f[8] = {bf2f(sd[j].x & 0xffffu), bf2f(sd[j].x >> 16), bf2f(sd[j].y & 0xffffu), bf2f(sd[j].y >> 16), bf2f(sd[j].z & 0xffffu), bf2f(sd[j].z >> 16), bf2f(sd[j].w & 0xffffu), bf2f(sd[j].w >> 16)};
#pragma unroll
            for (int k = 0; k < 8; ++k) { const unsigned ws[4] = {yv[j][k].x, yv[j][k].y, yv[j][k].z, yv[j][k].w};
#pragma unroll
                for (int q = 0; q < 4; ++q) { f[2 * q] += wk[k] * bf2f(ws[q] & 0xffffu); f[2 * q + 1] += wk[k] * bf2f(ws[q] >> 16); } }
            const f32x4 ga = *(const f32x4*)(g2 + c), gb = *(const f32x4*)(g2 + c + 4);
            const f32x4 xa = xin[j][0] + ga * (f32x4){f[0], f[1], f[2], f[3]}, xb = xin[j][1] + gb * (f32x4){f[4], f[5], f[6], f[7]};
            if (l + 1 < DEPTH || DRY) { *(f32x4*)(XO + (size_t)R * 1024 + c) = xa; *(f32x4*)(XO + (size_t)R * 1024 + c + 4) = xb; }
            if (l == DEPTH - 1 && !DRY) { *(f32x4*)(A.out + ((size_t)b * SEQ + (p - CTX)) * 1024 + c) = xa; *(f32x4*)(A.out + ((size_t)b * SEQ + (p - CTX)) * 1024 + c + 4) = xb; }
            xo[j][0] = xa.x; xo[j][1] = xa.y; xo[j][2] = xa.z; xo[j][3] = xa.w; xo[j][4] = xb.x; xo[j][5] = xb.y; xo[j][6] = xb.z; xo[j][7] = xb.w;
#pragma unroll
            for (int e = 0; e < 8; ++e) ss += xo[j][e] * xo[j][e]; }
        if (l + 1 < DEPTH || DRY) {
            const int ln = DRY ? 0 : l + 1; const float rs = rsqrtf(wave_sum(ss) * (1.f / 1024.f) + EPS);
            const float* gn = A.in[6] + ln * 1024; const float* sc1 = MODP(ln, s, 1); const float* sh1 = MODP(ln, s, 0);
#pragma unroll
            for (int j = 0; j < 2; ++j) { const int c = 8 * F.lane + 512 * j; float y[8];
#pragma unroll
                for (int h = 0; h < 2; ++h) { const f32x4 gg = *(const f32x4*)(gn + c + 4 * h), s1 = *(const f32x4*)(sc1 + c + 4 * h), s0 = *(const f32x4*)(sh1 + c + 4 * h);
                    y[4 * h] = xo[j][4 * h] * rs * gg.x * (1.f + s1.x) + s0.x; y[4 * h + 1] = xo[j][4 * h + 1] * rs * gg.y * (1.f + s1.y) + s0.y;
                    y[4 * h + 2] = xo[j][4 * h + 2] * rs * gg.z * (1.f + s1.z) + s0.z; y[4 * h + 3] = xo[j][4 * h + 3] * rs * gg.w * (1.f + s1.w) + s0.w; }
                v4u o; o.x = pk2(y[0], y[1]); o.y = pk2(y[2], y[3]); o.z = pk2(y[4], y[5]); o.w = pk2(y[6], y[7]);
                *(v4u*)(HO + (size_t)R * 1024 + c) = o; } }
    }
}

struct EpiWin {
    static constexpr bool PERM = true; static constexpr int MIDK = 0;
    bf16 *Kb, *Vb, *Qb, *LXb, *GLG, *ZP, *GT; const float* qg; const float* kg;
    __device__ __forceinline__ void operator()(const f32x4 (&acc)[2][2][4][2], const pg8::Unit& u, int wr, int wc, int fr, int fq) const {
        const int pn = u.pn, sec = pn >> 2;
        if (sec == 0 || sec == 3) {
            const bool isq = sec == 3; const bool lat = (u.pm % 33) != 0;
            bf16* dst = (isq ? Qb : Kb) + (pn & 3) * 256 + wc * 64 + 4 * fq; const float* gn = isq ? qg : kg; const float gs = isq ? QSCALE : 1.f;
            f32x4 g[2][2]; float invf[4];
#pragma unroll
            for (int bj = 0; bj < 2; ++bj)
#pragma unroll
                for (int n = 0; n < 2; ++n) g[bj][n] = *(const f32x4*)(gn + 32 * bj + 16 * n + 4 * fq) * gs;
#pragma unroll
            for (int e = 0; e < 4; ++e) invf[e] = exp2f(-(float)(4 * fq + e) * (13.287712379549449f / 16.f)) * 0.15915494309189535f;
#pragma unroll
            for (int ai = 0; ai < 2; ++ai)
#pragma unroll
                for (int m = 0; m < 4; ++m) { const int R = u.pm * 256 + ai * 128 + wr * 64 + m * 16 + fr, t = (R % TPB) - CTX;
                    float ss = 0.f;
#pragma unroll
                    for (int bj = 0; bj < 2; ++bj)
#pragma unroll
                        for (int n = 0; n < 2; ++n) { const f32x4 v = acc[ai][bj][m][n]; ss += (v[0] * v[0] + v[1] * v[1]) + (v[2] * v[2] + v[3] * v[3]); }
                    ss += sx<16>(ss); ss += sx<32>(ss);
                    const float rs = rsqrtf(ss * (1.f / 64.f) + EPS);
#pragma unroll
                    for (int bj = 0; bj < 2; ++bj) { const float pos = (float)(bj ? (t & 63) : (t >> 6));
                        const f32x4 y1 = acc[ai][bj][m][0] * rs * g[bj][0], y2 = acc[ai][bj][m][1] * rs * g[bj][1]; f32x4 o1 = y1, o2 = y2;
                        if (lat) {
#pragma unroll
                            for (int e = 0; e < 4; ++e) { const float rev = pos * invf[e]; const float cs = __builtin_amdgcn_cosf(rev), sn = __builtin_amdgcn_sinf(rev);
                                o1[e] = y1[e] * cs - y2[e] * sn; o2[e] = y1[e] * sn + y2[e] * cs; } }
                        bf16* p = dst + (size_t)R * 1024 + 32 * bj;
                        *(unsigned long long*)p = (unsigned long long)pk2(o1[0], o1[1]) | ((unsigned long long)pk2(o1[2], o1[3]) << 32);
                        *(unsigned long long*)(p + 16) = (unsigned long long)pk2(o2[0], o2[1]) | ((unsigned long long)pk2(o2[2], o2[3]) << 32); }
                    asm volatile("" ::: "memory"); }
        } else {
            bf16* base; int ld = 1024, act = 0;
            if (sec == 1) base = Vb + (pn & 3) * 256; else if (sec == 2) base = LXb + (pn & 3) * 256; else if (sec == 4) { base = GLG + (pn & 3) * 256; act = 1; }
            else if (sec == 5) base = ZP + (pn & 3) * 256; else { base = GT + (pn - 24) * 256; ld = 3072; act = 2; }
            base += wc * 32 + 8 * fq;
#pragma unroll
            for (int ai = 0; ai < 2; ++ai)
#pragma unroll
                for (int m = 0; m < 4; ++m) { bf16* rowp = base + (size_t)(u.pm * 256 + ai * 128 + wr * 64 + m * 16 + fr) * ld;
#pragma unroll
                    for (int bj = 0; bj < 2; ++bj) { f32x4 v0 = acc[ai][bj][m][0], v1 = acc[ai][bj][m][1];
                        if (act == 1) {
#pragma unroll
                            for (int e = 0; e < 4; ++e) { v0[e] = gelu_tanh(v0[e]); v1[e] = gelu_tanh(v1[e]); } }
                        else if (act == 2) {
#pragma unroll
                            for (int e = 0; e < 4; ++e) { v0[e] = sigmoidf_(v0[e]); v1[e] = sigmoidf_(v1[e]); } }
                        v4u o; o.x = pk2(v0[0], v0[1]); o.y = pk2(v0[2], v0[3]); o.z = pk2(v1[0], v1[1]); o.w = pk2(v1[2], v1[3]);
                        *(v4u*)(rowp + bj * 128) = o; } }
        }
    }
};

struct EpiMix {
    static constexpr bool PERM = true; static constexpr int MIDK = 16;
    const bf16* GT; bf16* MD;
    __device__ __forceinline__ void mid(f32x4 (&acc)[2][2][4][2], const pg8::Unit& u, int wr, int wc, int fr, int fq, int seg) const {
        const bf16* gb = GT + (size_t)(u.pm * 256 + wr * 64 + fr) * 3072 + (seg - 1) * 1024 + u.pn * 256 + wc * 32 + 8 * fq;
#pragma unroll
        for (int ai = 0; ai < 2; ++ai)
#pragma unroll
            for (int m = 0; m < 4; ++m)
#pragma unroll
                for (int bj = 0; bj < 2; ++bj) { const bf16* p = gb + (size_t)(ai * 128 + m * 16) * 3072 + bj * 128;
                    const v4u a = *(const v4u*)p, b = *(const v4u*)(p + 1024);
                    const unsigned aw[4] = {a.x, a.y, a.z, a.w}, bw[4] = {b.x, b.y, b.z, b.w};
#pragma unroll
                    for (int q = 0; q < 4; ++q) { const float r0 = bf2f(aw[q] & 0xffffu) * __builtin_amdgcn_rcpf(fmaxf(bf2f(bw[q] & 0xffffu), 1e-30f)), r1 = bf2f(aw[q] >> 16) * __builtin_amdgcn_rcpf(fmaxf(bf2f(bw[q] >> 16), 1e-30f));
                        acc[ai][bj][m][q >> 1][(q & 1) * 2] *= r0; acc[ai][bj][m][q >> 1][(q & 1) * 2 + 1] *= r1; } }
    }
    __device__ __forceinline__ void operator()(const f32x4 (&acc)[2][2][4][2], const pg8::Unit& u, int wr, int wc, int fr, int fq) const {
        const size_t r0 = (size_t)(u.pm * 256 + wr * 64 + fr); const int c0 = u.pn * 256 + wc * 32 + 8 * fq;
#pragma unroll
        for (int ai = 0; ai < 2; ++ai)
#pragma unroll
            for (int m = 0; m < 4; ++m)
#pragma unroll
                for (int bj = 0; bj < 2; ++bj) { const size_t R = r0 + ai * 128 + m * 16; const v4u gv = *(const v4u*)(GT + R * 3072 + 2048 + c0 + bj * 128);
                    const f32x4 v0 = acc[ai][bj][m][0], v1 = acc[ai][bj][m][1]; v4u o;
                    o.x = pk2(v0[0] * bf2f(gv.x & 0xffffu), v0[1] * bf2f(gv.x >> 16)); o.y = pk2(v0[2] * bf2f(gv.y & 0xffffu), v0[3] * bf2f(gv.y >> 16));
                    o.z = pk2(v1[0] * bf2f(gv.z & 0xffffu), v1[1] * bf2f(gv.z >> 16)); o.w = pk2(v1[2] * bf2f(gv.w & 0xffffu), v1[3] * bf2f(gv.w >> 16));
                    *(v4u*)(MD + R * 1024 + c0 + bj * 128) = o; }
    }
};
struct EpiResid {
    static constexpr bool PERM = false; static constexpr int MIDK = 0;
    float* X; const float* mod;
    const float* Xin; const float* Cin;
    __device__ __forceinline__ void operator()(const f32x4 (&acc)[2][2][4][2], const pg8::Unit& u, int wr, int wc, int fr, int fq) const {
        const int src = (u.pm % 33 == 0) ? 2 : u.pm / 33; const float* g1 = mod + src * 6144 + 2 * 1024;
        const float* sbase = Xin ? ((u.pm % 33 == 0) ? Cin + (size_t)(u.pm / 33) * CTX * 1024 : Xin + ((size_t)(u.pm / 33) * SEQ + (size_t)(u.pm % 33 - 1) * 256) * 1024) : X + (size_t)u.pm * 256 * 1024;
        const int col0 = u.pn * 256 + wc * 32 + 4 * fq;
        f32x4 gv[2][2];
#pragma unroll
        for (int bj = 0; bj < 2; ++bj)
#pragma unroll
            for (int n = 0; n < 2; ++n) gv[bj][n] = *(const f32x4*)(g1 + col0 + bj * 128 + n * 16);
#pragma unroll
        for (int ai = 0; ai < 2; ++ai)
#pragma unroll
            for (int m = 0; m < 4; ++m) { const size_t ro = (size_t)(ai * 128 + wr * 64 + m * 16 + fr) * 1024 + col0; float* rowp = X + (size_t)u.pm * 256 * 1024 + ro; const float* srow = sbase + ro;
#pragma unroll
                for (int bj = 0; bj < 2; ++bj)
#pragma unroll
                    for (int n = 0; n < 2; ++n) { *(f32x4*)(rowp + bj * 128 + n * 16) = *(const f32x4*)(srow + bj * 128 + n * 16) + gv[bj][n] * acc[ai][bj][m][n]; } }
    }
};
struct EpiRS {
    static constexpr bool PERM = true; static constexpr int MIDK = 0;
    float* LG; bf16* SH;
    __device__ __forceinline__ void operator()(const f32x4 (&acc)[2][2][4][2], const pg8::Unit& u, int wr, int wc, int fr, int fq) const {
#pragma unroll
        for (int ai = 0; ai < 2; ++ai)
#pragma unroll
            for (int m = 0; m < 4; ++m) { const size_t R = (size_t)u.pm * 256 + ai * 128 + wr * 64 + m * 16 + fr;
                if (u.pn == 0) {
#pragma unroll
                    for (int bj = 0; bj < 2; ++bj) { float* p = LG + R * 256 + bj * 128 + wc * 32 + 8 * fq; *(f32x4*)p = acc[ai][bj][m][0]; *(f32x4*)(p + 4) = acc[ai][bj][m][1]; } }
                else { const f32x4 g0 = acc[ai][0][m][0], g1 = acc[ai][0][m][1], u0 = acc[ai][1][m][0], u1 = acc[ai][1][m][1];
                    v4u w; w.x = pk2(siluf_(g0[0]) * u0[0], siluf_(g0[1]) * u0[1]); w.y = pk2(siluf_(g0[2]) * u0[2], siluf_(g0[3]) * u0[3]);
                    w.z = pk2(siluf_(g1[0]) * u1[0], siluf_(g1[1]) * u1[1]); w.w = pk2(siluf_(g1[2]) * u1[2], siluf_(g1[3]) * u1[3]);
                    *(v4u*)(SH + R * 256 + (u.pn - 1) * 128 + wc * 32 + 8 * fq) = w; } }
    }
};
__device__ __forceinline__ void ph_norm2(const Frame& F, const Args& A, int l) {
    const float* X = WSP(float, WS_XALL); bf16* TOK = WSP(bf16, WS_TOK);
    for (int R = F.gw; R < MROWS; R += F.NGW) {
        const int b = R / TPB, p = R % TPB, s = (p < CTX) ? 2 : b;
        if (l == DEPTH - 1 && p < CTX) continue;
        f32x4 v[4];
#pragma unroll
        for (int j = 0; j < 4; ++j) v[j] = *(const f32x4*)(X + (size_t)R * 1024 + 4 * F.lane + 256 * j);
        norm_mod_row(v, A.in[23] + l * 1024, MODP(l, s, 4), MODP(l, s, 3), TOK + (size_t)R * 1024, F.lane);
    }
}

constexpr int PH_PER_L = 18, N_PHASES = 1 + DEPTH * PH_PER_L;
template <int P, bool DRY = false> __device__ __forceinline__ void run_phase(const Frame& F, const Args& A, int l) {
    if constexpr (P == -1) ph_prologue(F, A);
    if constexpr (P == 0) ph_norm1(F, A, l);
#if !FAST_WIN
#error oracle w_in path removed
#endif
    if constexpr (P == 1) { const int Ge = F.G - KCONV_WIN; const int cb = conv_base(F, A, l);
        if (F.bid < Ge) { pg8::Gemm g{WSP(bf16, WS_H), WLP(l, WO_WIN), MROWS, INW, 1024, 1024, 1024}; pg8::StaticOrder S; S.init(MROWS, INW, Ge, F.bid);
            EpiWin E{WSP(bf16, WS_KB), WSP(bf16, WS_VB), WSP(bf16, WS_QB), WSP(bf16, WS_LXB), WSP(bf16, WS_GLG), WSP(bf16, WS_ZP), WSP(bf16, WS_GATES), A.in[8] + l * 64, A.in[9] + l * 64};
            pg8::gemm_phase(F.lds, g, S, E); }
        else ph_expert_w(F, A, l, min(EWI_N, cb), min(EWI_N, cb + EWI_A), Ge, KCONV_WIN); }
    if constexpr (P == 3) { ph_conv(F, A, l); ph_fft_t1_fast(F, A);
        { const int cb = conv_base(F, A, l); ph_expert_w(F, A, l, min(EWI_N, cb + (l == 0 ? EWI_D : EWI_B)), EWI_N, 0, F.G); } }
    if constexpr (P == 4) {
        { const int cb = conv_base(F, A, l);
          if (F.bid < F.G - KCONV_LRU) ph_lru_gemm(F, A, l, F.G - KCONV_LRU); else ph_expert_w(F, A, l, min(EWI_N, cb + EWI_A), min(EWI_N, cb + EWI_B), F.G - KCONV_LRU, KCONV_LRU); }
        __syncthreads();
#if FAST_FFT_A
        ph_fft_a_gemm(F, A);
#else
        ph_fft_a(F, A);
#endif
        ph_fft_c(F, A);
    }
    if constexpr (P == 5) {
        ph_scan1(F, A);
#if FAST_FFT_B
        ph_fft_b_gemm(F, A);
#else
        ph_fft_b(F, A);
#endif
    }
    if constexpr (P == 6) { ph_scan2_fast(F, A); ph_fft_t2_fast(F, A); }
    if constexpr (P == 7) { ph_scan3(F, A);
#if FAST_ATTN
        ph_attn(F, A, l);
#endif
    }
    if constexpr (P == 8) {
#if !FAST_ATTN
        ph_attn_naive(F, A, l);
#endif
        __syncthreads(); }
#if FAST_MIX
    if constexpr (P == 9) { const bool sp = (l == 0) && F.G > 2 * KCONV_D; const int Ge = sp ? F.G - KCONV_D : F.G;
        if (F.bid < Ge) { pg8::Gemm g{WSP(bf16, WS_MIXIN), WLP(l, WO_D1), MROWS, 1024, 3072, 3072, 3072}; pg8::StaticOrder S; S.init(MROWS, 1024, Ge, F.bid, l == DEPTH - 1);
            EpiMix E{WSP(bf16, WS_GATES), WSP(bf16, WS_MIXED)}; pg8::gemm_phase(F.lds, g, S, E); }
        else ph_expert_w(F, A, l, EWI_B, EWI_C, Ge, KCONV_D); }
    if constexpr (P == 11) { const bool sp = (l == 0) && F.G > 2 * KCONV_D; const int Ge = sp ? F.G - KCONV_D : F.G;
        if (F.bid < Ge) { pg8::Gemm g{WSP(bf16, WS_MIXED), WLP(l, WO_OUT), MROWS, 1024, 1024, 1024, 1024}; pg8::StaticOrder S; S.init(MROWS, 1024, Ge, F.bid, l == DEPTH - 1);
            EpiResid E{WSP(float, WS_XALL), (const float*)(A.ws + WS_CTL) + CW_MOD + l * 3 * 6144, l == 0 ? A.in[0] : nullptr, l == 0 ? A.in[2] : nullptr}; pg8::gemm_phase(F.lds, g, S, E); }
        else ph_expert_w(F, A, l, EWI_C, EWI_D, Ge, KCONV_D); }
    if constexpr (P == 12) ph_norm2(F, A, l);
#else
    if constexpr (P == 9) {
        { pg8::Gemm g{WSP(bf16, WS_MIXIN), WLP(l, WO_D1), MROWS, 1024, 1024, 3072, 3072}; pg8::StaticOrder S; S.init(MROWS, 1024, F.G, F.bid); pg8::EpiF32 E{WSP(float, WS_PA), 1024}; pg8::gemm_phase(F.lds, g, S, E); }
        { pg8::Gemm g{WSP(bf16, WS_MIXIN) + 1024, WLP(l, WO_D1) + 1024, MROWS, 1024, 1024, 3072, 3072}; pg8::StaticOrder S; S.init(MROWS, 1024, F.G, F.bid); pg8::EpiF32 E{WSP(float, WS_PR), 1024}; pg8::gemm_phase(F.lds, g, S, E); }
        { pg8::Gemm g{WSP(bf16, WS_MIXIN) + 2048, WLP(l, WO_D1) + 2048, MROWS, 1024, 1024, 3072, 3072}; pg8::StaticOrder S; S.init(MROWS, 1024, F.G, F.bid); pg8::EpiF32 E{WSP(float, WS_PF), 1024}; pg8::gemm_phase(F.lds, g, S, E); } }
    if constexpr (P == 10) ph_mix(F, A);
    if constexpr (P == 11) { pg8::Gemm g{WSP(bf16, WS_MIXED), WLP(l, WO_OUT), MROWS, 1024, 1024, 1024, 1024}; pg8::StaticOrder S; S.init(MROWS, 1024, F.G, F.bid);
        pg8::EpiF32 E{WSP(float, WS_Y1), 1024}; pg8::gemm_phase(F.lds, g, S, E); }
    if constexpr (P == 12) ph_resid_norm2(F, A, l);
#endif
    if constexpr (P == 13) { const bool early = l + 1 < DEPTH; const int Ge = early ? F.G - KCONV_RS : F.G;
        if (F.bid < Ge) { pg8::Gemm g{WSP(bf16, WS_TOK), WLP(l, WO_R), MROWS, 768, 1024, 1024, 1024}; pg8::StaticOrder S; S.init(MROWS, 768, Ge, F.bid, l == DEPTH - 1);
            EpiRS E{WSP(float, WS_LOG), WSP(bf16, WS_SH)}; pg8::gemm_phase(F.lds, g, S, E); }
        else ph_expert_w(F, A, l + 1, 0, KCONV_RS * NWAVES * Q13, Ge, KCONV_RS); }
    if constexpr (P == 14) ph_topk<DRY>(F, A, l);
    if constexpr (P == 15) {
#if FAST_MOE
        ph_experts_up(F, A, l);
#else
        ph_experts_naive(F, A, l); __syncthreads();
#endif

        { pg8::Gemm g{WSP(bf16, WS_SH), WLP(l, WO_SD), MROWS, 1024, 256, 256, 256}; pg8::StaticOrder S; S.init(MROWS, 1024, F.G, F.bid, l == DEPTH - 1); EpiBf16U E{WSP(bf16, WS_SD), 1024}; pg8::gemm_phase(F.lds, g, S, E); } }
    if constexpr (P == 16) {
#if FAST_MOE
        ph_experts_down(F, A, l);
#endif
    }
    if constexpr (P == 17) ph_combine<DRY>(F, A, l);
}
__device__ __forceinline__ Frame make_frame(unsigned char* lds) {
    Frame F; F.lds = (LAS unsigned char*)lds; F.tid = otid(); F.lane = F.tid & 63; F.wave = __builtin_amdgcn_readfirstlane(F.tid >> 6);
    F.bid = obid(); F.G = ogrid(); F.gw = F.bid * NWAVES + F.wave; F.NGW = F.G * NWAVES; F.gtid = (long)F.bid * 512 + F.tid; F.NT = (long)F.G * 512;
    return F;
}
template <int P> __global__ void __launch_bounds__(NWAVES * 64, 2) mk_phase(Args A) {
    extern __shared__ __attribute__((aligned(16))) unsigned char lds[];
    const Frame F = make_frame(lds);
    run_phase<P>(F, A, A.ph_lo);
}
#if N_LAUNCH_MODE == 1
__device__ __forceinline__ const float* lds_ptr(const LAS unsigned long long* tab, int i) {
    const unsigned long long v = tab[i];
    const unsigned lo = __builtin_amdgcn_readfirstlane((unsigned)v), hi = __builtin_amdgcn_readfirstlane((unsigned)(v >> 32));
    return (const float*)(const __attribute__((address_space(1))) float*)(((unsigned long long)hi << 32) | lo);
}
__device__ __forceinline__ void load_args(Args& L, const LAS unsigned long long* tab) {
#pragma unroll
    for (int i = 0; i < 32; ++i) L.in[i] = lds_ptr(tab, i);
    L.out = (float*)lds_ptr(tab, 32); L.ws = (unsigned char*)lds_ptr(tab, 33); L.ph_lo = 0; L.ph_hi = 0;
}
__global__ void __launch_bounds__(NWAVES * 64, 2) mk_fwd(Args A) {
    extern __shared__ __attribute__((aligned(16))) unsigned char lds[];
    LAS unsigned char* L3 = (LAS unsigned char*)lds;
    volatile LAS unsigned* MISC = (volatile LAS unsigned*)(L3 + MISC_OFF);
    for (int u = threadIdx.x; u < (LDS_BYTES - RING_BYTES) / 4; u += NWAVES * 64) ((LAS unsigned*)(L3 + RING_BYTES))[u] = 0u;
    __syncthreads();
    LAS unsigned long long* tab = (LAS unsigned long long*)(L3 + RING_BYTES + 4096);
    if (threadIdx.x == 0) {
#define ST(i) tab[i] = (unsigned long long)A.in[i];
        ST(0) ST(1) ST(2) ST(3) ST(4) ST(5) ST(6) ST(7) ST(8) ST(9) ST(10) ST(11) ST(12) ST(13) ST(14) ST(15) ST(16) ST(17) ST(18) ST(19) ST(20) ST(21) ST(22) ST(23) ST(24) ST(25) ST(26) ST(27) ST(28) ST(29) ST(30) ST(31)
#undef ST
        tab[32] = (unsigned long long)A.out; tab[33] = (unsigned long long)A.ws;
    }
    __syncthreads();
    (void)xcd_barrier_post((unsigned*)(A.ws + WS_CTL) + CW_BAR, MISC + 8);
#define RUN(P) do { asm volatile("; PHASE_MARK " #P); { unsigned tb_ = RING_BYTES + 4096; asm volatile("" : "+v"(tb_)); Args L; load_args(L, (const LAS unsigned long long*)(L3 + tb_)); \
        const Frame F = make_frame(lds); run_phase<P>(F, L, l); \
        if constexpr (P >= 0 && ((REP_MASK >> (P < 0 ? 0 : P)) & 1)) { for (int rp_ = 0; rp_ < REP_N; ++rp_) { asm volatile("s_waitcnt vmcnt(0)" ::: "memory"); __syncthreads(); run_phase<P, true>(F, L, l); } } \
        XcdBarrier bar; bar.bar = (unsigned*)(L.ws + WS_CTL) + CW_BAR; bar.x = xb_xcc_id(); { unsigned mo_ = MISC_OFF + 32; asm volatile("" : "+v"(mo_)); bar.st = (volatile LAS unsigned*)(L3 + mo_); } \
        xcd_barrier(bar); } } while (0)
    { const int l = 0; RUN(-1);
#if REP_PRO
      for (int rp_ = 0; rp_ < 2; ++rp_) { RUN(-1); }
#endif
    }
    for (int l = 0; l < DEPTH; ++l) {
        if (l == 0) RUN(0);
        RUN(1); RUN(3); RUN(4); RUN(5); RUN(6); RUN(7); RUN(9); RUN(11); RUN(12); RUN(13); RUN(14); RUN(15); RUN(16); RUN(17);
    }
#undef RUN
}
#endif

extern "C" void kernel_launch(void* const* d_in, const int* in_sizes, int n_in, void* d_out, int out_size, void* d_ws, size_t ws_size, hipStream_t stream) {
    static int grid = 0;
    if (grid == 0) {
        if (n_in != 32 || out_size != NB * SEQ * DM || ws_size < WS_END) { fprintf(stderr, "kernel_launch: unexpected shapes (n_in %d, out %d, ws %zu < %zu)\n", n_in, out_size, ws_size, (size_t)WS_END); grid = -1; return; }
        int dev = 0, cus = 0;
        if (hipGetDevice(&dev) != hipSuccess || hipDeviceGetAttribute(&cus, hipDeviceAttributeMultiprocessorCount, dev) != hipSuccess) { grid = -1; return; }
#define SETA(K) if (hipFuncSetAttribute((const void*)K, hipFuncAttributeMaxDynamicSharedMemorySize, LDS_BYTES) != hipSuccess) { fprintf(stderr, "kernel_launch: hipFuncSetAttribute failed\n"); grid = -1; return; }
#if N_LAUNCH_MODE == 1
        SETA(mk_fwd)
#else
        SETA(mk_phase<-1>) SETA(mk_phase<0>) SETA(mk_phase<1>) SETA(mk_phase<2>) SETA(mk_phase<3>) SETA(mk_phase<4>) SETA(mk_phase<5>) SETA(mk_phase<6>) SETA(mk_phase<7>) SETA(mk_phase<8>)
        SETA(mk_phase<9>) SETA(mk_phase<10>) SETA(mk_phase<11>) SETA(mk_phase<12>) SETA(mk_phase<13>) SETA(mk_phase<14>) SETA(mk_phase<15>) SETA(mk_phase<16>) SETA(mk_phase<17>)
#endif
#undef SETA
        int per_cu = 0;
        (void)per_cu;
        if (cus * MOE_MAXU < 2 * (NPAIR / 256 + 256)) { fprintf(stderr, "kernel_launch: too few CUs (%d) for the staged MoE row lists\n", cus); grid = -1; return; }
        grid = cus;
    }
    if (grid < 0) return;
    (void)hipMemsetAsync((char*)d_ws + WS_CTL, 0, CTL_ZERO_BYTES, stream);
    Args a{};
    for (int i = 0; i < 32; ++i) a.in[i] = (const float*)d_in[i];
    a.out = (float*)d_out; a.ws = (unsigned char*)d_ws;
#if N_LAUNCH_MODE == 1
    a.ph_lo = 0; a.ph_hi = N_PHASES;
    hipLaunchKernelGGL(mk_fwd, dim3(grid), dim3(NWAVES * 64), LDS_BYTES, stream, a);
#else
#define LAUNCH_P(P) hipLaunchKernelGGL(mk_phase<P>, dim3(grid), dim3(NWAVES * 64), LDS_BYTES, stream, a)
    a.ph_lo = 0; a.ph_hi = 0; LAUNCH_P(-1);
    for (int l = 0; l < DEPTH; ++l) { a.ph_lo = l;
        LAUNCH_P(0); LAUNCH_P(1); LAUNCH_P(2); LAUNCH_P(3); LAUNCH_P(4); LAUNCH_P(5); LAUNCH_P(6); LAUNCH_P(7); LAUNCH_P(8); LAUNCH_P(9); LAUNCH_P(10); LAUNCH_P(11); LAUNCH_P(12); LAUNCH_P(13); LAUNCH_P(14); LAUNCH_P(15); LAUNCH_P(16); LAUNCH_P(17); }
#undef LAUNCH_P
#endif
    const hipError_t le = hipPeekAtLastError();
    if (le != hipSuccess) fprintf(stderr, "kernel_launch: launch failed: %s\n", hipGetErrorName(le));
}
```

```cpp
#include <hip/hip_runtime.h>
#include <cstdio>
#include <cstdint>

#ifndef ATTN_V2
#define ATTN_V2 8
#endif
#ifndef REP_PRO
#define REP_PRO 0
#endif
#ifndef REP_MASK
#define REP_MASK 0
#endif
#ifndef REP_N
#define REP_N 2
#endif
#ifndef FAST_MIX
#define FAST_MIX 1
#endif
#ifndef FAST_WIN
#define FAST_WIN 1
#endif
#ifndef FAST_LRU
#define FAST_LRU 1
#endif
#define FAST_FFT 0
#ifndef FAST_FFT_A
#define FAST_FFT_A 1
#endif
#ifndef FAST_FFT_B
#define FAST_FFT_B 1
#endif
#ifndef FAST_MOE
#define FAST_MOE 1
#endif
#ifndef FAST_ATTN
#define FAST_ATTN 1
#endif
#ifndef N_LAUNCH_MODE
#define N_LAUNCH_MODE 1
#endif

__device__ __forceinline__ int otid() { int t = threadIdx.x; asm volatile("" : "+v"(t)); return t; }
__device__ __forceinline__ int obid() { int b = blockIdx.x; asm volatile("" : "+s"(b)); return b; }
__device__ __forceinline__ int ogrid() { int g = gridDim.x; asm volatile("" : "+s"(g)); return g; }
template <int M> __device__ __forceinline__ float sx(float v) {
    static_assert(M == 1 || M == 2 || M == 4 || M == 8 || M == 16 || M == 32, "xor mask");
    if constexpr (M < 32) return __uint_as_float((unsigned)__builtin_amdgcn_ds_swizzle((int)__float_as_uint(v), (M << 10) | 0x1f));
    else { auto rr = __builtin_amdgcn_permlane32_swap(__float_as_uint(v), __float_as_uint(v), false, false); const unsigned a = rr[0], b = rr[1]; return __uint_as_float(a == __float_as_uint(v) ? b : a); }
}
template <int M> __device__ __forceinline__ int sxi(int v) { return (int)__float_as_uint(sx<M>(__uint_as_float((unsigned)v))); }
namespace pg8 {
#define PG8_LAS __attribute__((address_space(3)))
typedef unsigned short bf16_t;
typedef short bf16x8 __attribute__((ext_vector_type(8)));
typedef float f32x4 __attribute__((ext_vector_type(4)));
typedef unsigned u32x4 __attribute__((ext_vector_type(4)));
constexpr int BM = 256, BK = 64, HALF = 128, HTB = HALF * BK * 2, STAGE_BYTES = 8 * HTB, NXCD = 8, WGM = 8;
__host__ __device__ __forceinline__ int lds_byte(int r, int c) { const int st = (r >> 4) * 2 + (c >> 5), rr = r & 15, cc = c & 31, ob = rr * 64 + cc * 2; return st * 1024 + (ob ^ (((ob >> 9) & 1) << 5)); }
__host__ __device__ __forceinline__ void stage_rc(int b, int& R, int& C) { const int st = b / 1024, sb = b % 1024, swz = sb ^ (((sb >> 9) & 1) << 5); R = (st >> 1) * 16 + swz / 64; C = (st & 1) * 32 + (swz % 64) / 2; }
__host__ __device__ __forceinline__ int perm32(int rho) { const int n = rho >> 4, i = rho & 15; return 8 * (i >> 2) + 4 * n + (i & 3); }
struct Unit { int pm, pn; };
struct Gemm { const bf16_t* A; const bf16_t* Bt; int M, N, K, lda, ldb; };
struct StaticOrder {
    int nM, nN, nwg, G, c; bool skipctx;
    __host__ __device__ void init(int M, int N, int G_, int c_, bool skip = false) { nM = skip ? 64 : M / BM; nN = N / BM; nwg = nM * nN; G = G_; c = c_; skipctx = skip; }
    __host__ __device__ bool next(int i, Unit& u) const {
        const long L = (long)i * G + c; if (L >= nwg) return false;
        int wgid = (int)L; { const int q = nwg / NXCD, r = nwg % NXCD, xcd = wgid % NXCD, off = wgid / NXCD; wgid = (xcd < r ? xcd * (q + 1) : r * (q + 1) + (xcd - r) * q) + off; }
        const int nig = WGM * nN, gid = wgid / nig, fm = gid * WGM, gsz = (nM - fm) < WGM ? (nM - fm) : WGM;
        u.pm = fm + ((wgid % nig) % gsz); u.pn = (wgid % nig) / gsz;
        if (skipctx) u.pm += 1 + (u.pm >= 32 ? 1 : 0);
        return true;
    }
};
__device__ __forceinline__ unsigned cvt_pk_bf16(float lo, float hi) { unsigned r; asm volatile("v_cvt_pk_bf16_f32 %0, %1, %2" : "=v"(r) : "v"(lo), "v"(hi)); return r; }

struct EpiF32 {
    static constexpr bool PERM = false; static constexpr int MIDK = 0;
    float* C; int ldc;
    __device__ __forceinline__ void operator()(const f32x4 (&acc)[2][2][4][2], const Unit& u, int wr, int wc, int fr, int fq) const {
        const int row0 = u.pm * BM + wr * 64 + fr, col0 = u.pn * BM + wc * 32 + 4 * fq;
#pragma unroll
        for (int ai = 0; ai < 2; ++ai)
#pragma unroll
            for (int m = 0; m < 4; ++m) { float* rowp = C + (size_t)(row0 + ai * HALF + m * 16) * ldc + col0;
#pragma unroll
                for (int bj = 0; bj < 2; ++bj)
#pragma unroll
                    for (int n = 0; n < 2; ++n) *(f32x4*)(rowp + bj * HALF + n * 16) = acc[ai][bj][m][n]; }
    }
};

template <class Epi>
__device__ __forceinline__ void gemm_phase(PG8_LAS unsigned char* lds, const Gemm g, const StaticOrder& S, const Epi& E) {
    const int tid = otid(), wid = __builtin_amdgcn_readfirstlane(tid >> 6), lane = tid & 63, wr = wid >> 2, wc = wid & 3, fr = lane & 15, fq = lane >> 4;
    const int K = g.K, nt = K / BK;
    unsigned voffA[2], voffB[2];
#pragma unroll
    for (int i = 0; i < 2; ++i) { int R, C; stage_rc(tid * 16 + i * 8192, R, C); const int Rb = Epi::PERM ? ((R & ~31) + perm32(R & 31)) : R;
        voffA[i] = (unsigned)(R * g.lda + C) * 2u; voffB[i] = (unsigned)(Rb * g.ldb + C) * 2u; }
    const size_t kstep = (size_t)(BK * 2);
    const size_t hA = (size_t)HALF * g.lda * 2, hB = (size_t)HALF * g.ldb * 2;
    const size_t tA = 2 * hA, tB = 2 * hB;
    const unsigned ldsw = (unsigned)wid * 1024u;
    const int aoff = lds_byte(wr * 64 + fr, fq * 8), boff = lds_byte(wc * 32 + fr, fq * 8);
#define PG8_SA(b, h) (((b) * 2 + (h)) * HTB)
#define PG8_SB(b, h) ((4 + (b) * 2 + (h)) * HTB)
#define PG8_STAGE(bufoff, gbase, voff) do { _Pragma("unroll") for (int _i = 0; _i < 2; ++_i) \
        __builtin_amdgcn_global_load_lds((const unsigned*)((const char*)(gbase) + (voff)[_i]), (PG8_LAS unsigned*)(lds + (bufoff) + ldsw + _i * 8192), 16, 0, 0); } while (0)
#define PG8_LDA(dst, b, h) do { _Pragma("unroll") for (int m = 0; m < 4; ++m) _Pragma("unroll") for (int k = 0; k < 2; ++k) dst[m][k] = *(const PG8_LAS bf16x8*)(lds + PG8_SA(b, h) + aoff + m * 2048 + k * 1024); } while (0)
#define PG8_LDB(dst, b, h) do { _Pragma("unroll") for (int n = 0; n < 2; ++n) _Pragma("unroll") for (int k = 0; k < 2; ++k) dst[n][k] = *(const PG8_LAS bf16x8*)(lds + PG8_SB(b, h) + boff + n * 2048 + k * 1024); } while (0)
#define PG8_MMA(ai, bj, At, Bt) do { __builtin_amdgcn_s_setprio(1); _Pragma("unroll") for (int m = 0; m < 4; ++m) _Pragma("unroll") for (int n = 0; n < 2; ++n) _Pragma("unroll") for (int k = 0; k < 2; ++k) \
        acc[ai][bj][m][n] = __builtin_amdgcn_mfma_f32_16x16x32_bf16(Bt[n][k], At[m][k], acc[ai][bj][m][n], 0, 0, 0); __builtin_amdgcn_s_setprio(0); } while (0)
#define PG8_WAIT_V(n) asm volatile("s_waitcnt vmcnt(" #n ")" ::: "memory")
#define PG8_WAIT_L(n) asm volatile("s_waitcnt lgkmcnt(" #n ")" ::: "memory")
#define PG8_BAR __builtin_amdgcn_s_barrier()
#define PG8_SCHED __builtin_amdgcn_sched_barrier(0)
    Unit cur, nxt; int ui = 0;
    if (!S.next(0, cur)) return;
    f32x4 acc[2][2][4][2];
#pragma unroll
    for (int a = 0; a < 2; ++a)
#pragma unroll
        for (int b = 0; b < 2; ++b)
#pragma unroll
            for (int m = 0; m < 4; ++m)
#pragma unroll
                for (int n = 0; n < 2; ++n) acc[a][b][m][n] = (f32x4){0.f, 0.f, 0.f, 0.f};
    bf16x8 At[4][2], B0[2][2], B1[2][2];
    const char* cA = (const char*)g.A + (size_t)cur.pm * tA; const char* cB = (const char*)g.Bt + (size_t)cur.pn * tB;
    PG8_STAGE(PG8_SB(0, 0), cB, voffB); PG8_STAGE(PG8_SB(0, 1), cB + hB, voffB); PG8_STAGE(PG8_SA(0, 0), cA, voffA); PG8_STAGE(PG8_SA(0, 1), cA + hA, voffA);
    if (wr == 1) PG8_BAR;
    PG8_WAIT_V(2); PG8_BAR;
    PG8_STAGE(PG8_SB(1, 0), cB + kstep, voffB); PG8_STAGE(PG8_SA(1, 0), cA + kstep, voffA); PG8_STAGE(PG8_SB(1, 1), cB + hB + kstep, voffB);
    PG8_WAIT_V(6); PG8_BAR;
    for (;;) {
        const bool has_next = S.next(ui + 1, nxt);
        const char* nA = has_next ? (const char*)g.A + (size_t)nxt.pm * tA : cA; const char* nB = has_next ? (const char*)g.Bt + (size_t)nxt.pn * tB : cB;
#pragma unroll 1
        for (int t = 0; t < nt; t += 2) {
            if constexpr (Epi::MIDK > 0) { if (t > 0 && (t % Epi::MIDK) == 0) E.mid(acc, cur, wr, wc, fr, fq, t / Epi::MIDK); }
            const bool last = (t == nt - 2);
            const char* a1 = cA + (size_t)(t + 1) * kstep;
            const char* a2 = last ? nA : cA + (size_t)(t + 2) * kstep; const char* b2 = last ? nB : cB + (size_t)(t + 2) * kstep;
            const char* a3 = a2 + kstep; const char* b3 = b2 + kstep;
            PG8_LDB(B0, 0, 0); PG8_LDB(B1, 0, 1); PG8_SCHED; PG8_LDA(At, 0, 0); PG8_STAGE(PG8_SA(1, 1), a1 + hA, voffA);
            PG8_WAIT_V(8); PG8_WAIT_L(0); PG8_BAR; PG8_MMA(0, 0, At, B0); PG8_MMA(0, 1, At, B1); PG8_BAR; PG8_SCHED;
            PG8_LDA(At, 0, 1); PG8_STAGE(PG8_SB(0, 0), b2, voffB); PG8_STAGE(PG8_SB(0, 1), b2 + hB, voffB); PG8_STAGE(PG8_SA(0, 0), a2, voffA);
            PG8_WAIT_V(8); PG8_WAIT_L(0); PG8_BAR; PG8_MMA(1, 0, At, B0); PG8_MMA(1, 1, At, B1); PG8_BAR; PG8_SCHED;
            PG8_LDB(B0, 1, 0); PG8_LDB(B1, 1, 1); PG8_SCHED; PG8_LDA(At, 1, 0); PG8_STAGE(PG8_SA(0, 1), a2 + hA, voffA);
            PG8_WAIT_V(8); PG8_WAIT_L(0); PG8_BAR; PG8_MMA(0, 0, At, B0); PG8_MMA(0, 1, At, B1); PG8_BAR; PG8_SCHED;
            PG8_LDA(At, 1, 1); PG8_STAGE(PG8_SB(1, 0), b3, voffB); PG8_STAGE(PG8_SB(1, 1), b3 + hB, voffB); PG8_STAGE(PG8_SA(1, 0), a3, voffA);
            PG8_WAIT_V(8); PG8_WAIT_L(0); PG8_BAR; PG8_MMA(1, 0, At, B0); PG8_MMA(1, 1, At, B1); PG8_BAR; PG8_SCHED;
        }
        if (wr == 0) PG8_BAR;
        E(acc, cur, wr, wc, fr, fq);
        if (!has_next) break;
#pragma unroll
        for (int a = 0; a < 2; ++a)
#pragma unroll
            for (int b = 0; b < 2; ++b)
#pragma unroll
                for (int m = 0; m < 4; ++m)
#pragma unroll
                    for (int n = 0; n < 2; ++n) acc[a][b][m][n] = (f32x4){0.f, 0.f, 0.f, 0.f};
        cur = nxt; cA = nA; cB = nB; ++ui;
        if (wr == 1) PG8_BAR;
    }
    PG8_WAIT_V(0);
    PG8_BAR;
#undef PG8_SA
#undef PG8_SB
#undef PG8_STAGE
#undef PG8_LDA
#undef PG8_LDB
#undef PG8_MMA
#undef PG8_WAIT_V
#undef PG8_WAIT_L
#undef PG8_BAR
#undef PG8_SCHED
}

struct UnitG { const char* a; const char* b; int row0, pn, e, valid; const int* rows; const PG8_LAS int* lrows; };
template <class Epi, class Sched, bool GATHER>
__device__ __forceinline__ void gemm_phase_g(PG8_LAS unsigned char* lds, const int K, const int lda, const int ldb, const Sched& S, const Epi& E) {
    const int tid = otid(), wid = __builtin_amdgcn_readfirstlane(tid >> 6), lane = tid & 63, wr = wid >> 2, wc = wid & 3, fr = lane & 15, fq = lane >> 4;
    const int nt = K / BK;
    int RA[2], CA[2]; unsigned voffB[2];
#pragma unroll
    for (int i = 0; i < 2; ++i) { int R, C; stage_rc(tid * 16 + i * 8192, R, C); const int Rb = Epi::PERM ? ((R & ~31) + perm32(R & 31)) : R;
        RA[i] = R; CA[i] = C; voffB[i] = (unsigned)(Rb * ldb + C) * 2u; }
    const size_t kstep = (size_t)(BK * 2);
    const size_t hB = (size_t)HALF * ldb * 2;
    const unsigned ldsw = (unsigned)wid * 1024u;
    const int aoff = lds_byte(wr * 64 + fr, fq * 8), boff = lds_byte(wc * 32 + fr, fq * 8);
#define PG8_SA(b, h) (((b) * 2 + (h)) * HTB)
#define PG8_SB(b, h) ((4 + (b) * 2 + (h)) * HTB)
#define PG8_STAGE(bufoff, gbase, voff) do { _Pragma("unroll") for (int _i = 0; _i < 2; ++_i) \
        __builtin_amdgcn_global_load_lds((const unsigned*)((const char*)(gbase) + (voff)[_i]), (PG8_LAS unsigned*)(lds + (bufoff) + ldsw + _i * 8192), 16, 0, 0); } while (0)
#define PG8_LDA(dst, b, h) do { _Pragma("unroll") for (int m = 0; m < 4; ++m) _Pragma("unroll") for (int k = 0; k < 2; ++k) dst[m][k] = *(const PG8_LAS bf16x8*)(lds + PG8_SA(b, h) + aoff + m * 2048 + k * 1024); } while (0)
#define PG8_LDB(dst, b, h) do { _Pragma("unroll") for (int n = 0; n < 2; ++n) _Pragma("unroll") for (int k = 0; k < 2; ++k) dst[n][k] = *(const PG8_LAS bf16x8*)(lds + PG8_SB(b, h) + boff + n * 2048 + k * 1024); } while (0)
#define PG8_MMA(ai, bj, At, Bt) do { __builtin_amdgcn_s_setprio(1); _Pragma("unroll") for (int m = 0; m < 4; ++m) _Pragma("unroll") for (int n = 0; n < 2; ++n) _Pragma("unroll") for (int k = 0; k < 2; ++k) \
        acc[ai][bj][m][n] = __builtin_amdgcn_mfma_f32_16x16x32_bf16(Bt[n][k], At[m][k], acc[ai][bj][m][n], 0, 0, 0); __builtin_amdgcn_s_setprio(0); } while (0)
#define PG8_WAIT_V(n) asm volatile("s_waitcnt vmcnt(" #n ")" ::: "memory")
#define PG8_WAIT_L(n) asm volatile("s_waitcnt lgkmcnt(" #n ")" ::: "memory")
#define PG8_BAR __builtin_amdgcn_s_barrier()
#define PG8_SCHED __builtin_amdgcn_sched_barrier(0)
#define PG8_MKOFF(u, v) do { _Pragma("unroll") for (int _h = 0; _h < 2; ++_h) _Pragma("unroll") for (int _i = 0; _i < 2; ++_i) { const int _row = _h * HALF + RA[_i]; \
        if (GATHER) { const int _pr = (u).lrows[_row]; v[_h][_i] = (unsigned)(_pr >> 3) * (unsigned)(lda * 2) + (unsigned)(CA[_i] * 2); } \
        else v[_h][_i] = (unsigned)(_row * lda + CA[_i]) * 2u; } } while (0)
    UnitG cur, nxt; int ui = 0;
    if (!S.next(0, cur)) return;
    f32x4 acc[2][2][4][2];
#pragma unroll
    for (int a = 0; a < 2; ++a)
#pragma unroll
        for (int b = 0; b < 2; ++b)
#pragma unroll
            for (int m = 0; m < 4; ++m)
#pragma unroll
                for (int n = 0; n < 2; ++n) acc[a][b][m][n] = (f32x4){0.f, 0.f, 0.f, 0.f};
    bf16x8 At[4][2], B0[2][2], B1[2][2];
    unsigned vA[2][2], vN[2][2];
    PG8_MKOFF(cur, vA);
    const char* cA = cur.a; const char* cB = cur.b;
    PG8_STAGE(PG8_SB(0, 0), cB, voffB); PG8_STAGE(PG8_SB(0, 1), cB + hB, voffB); PG8_STAGE(PG8_SA(0, 0), cA, vA[0]); PG8_STAGE(PG8_SA(0, 1), cA, vA[1]);
    if (wr == 1) PG8_BAR;
    PG8_WAIT_V(2); PG8_BAR;
    PG8_STAGE(PG8_SB(1, 0), cB + kstep, voffB); PG8_STAGE(PG8_SA(1, 0), cA + kstep, vA[0]); PG8_STAGE(PG8_SB(1, 1), cB + hB + kstep, voffB);
    PG8_WAIT_V(6); PG8_BAR;
    for (;;) {
        const bool has_next = S.next(ui + 1, nxt);
        if constexpr (GATHER) { if (has_next) { PG8_MKOFF(nxt, vN); } else { vN[0][0] = vA[0][0]; vN[0][1] = vA[0][1]; vN[1][0] = vA[1][0]; vN[1][1] = vA[1][1]; } }
        const char* nA = has_next ? nxt.a : cA; const char* nB = has_next ? nxt.b : cB;
#pragma unroll 1
        for (int t = 0; t < nt; t += 2) {
            const bool last = (t == nt - 2);
            const char* a1 = cA + (size_t)(t + 1) * kstep;
            const char* a2 = last ? nA : cA + (size_t)(t + 2) * kstep; const char* b2 = last ? nB : cB + (size_t)(t + 2) * kstep;
            const char* a3 = a2 + kstep; const char* b3 = b2 + kstep;
            unsigned s0[2], s1[2];
            if constexpr (GATHER) { s0[0] = last ? vN[0][0] : vA[0][0]; s0[1] = last ? vN[0][1] : vA[0][1]; s1[0] = last ? vN[1][0] : vA[1][0]; s1[1] = last ? vN[1][1] : vA[1][1]; }
            else { s0[0] = vA[0][0]; s0[1] = vA[0][1]; s1[0] = vA[1][0]; s1[1] = vA[1][1]; }
            PG8_LDB(B0, 0, 0); PG8_LDB(B1, 0, 1); PG8_SCHED; PG8_LDA(At, 0, 0); PG8_STAGE(PG8_SA(1, 1), a1, vA[1]);
            PG8_WAIT_V(8); PG8_WAIT_L(0); PG8_BAR; PG8_MMA(0, 0, At, B0); PG8_MMA(0, 1, At, B1); PG8_BAR; PG8_SCHED;
            PG8_LDA(At, 0, 1); PG8_STAGE(PG8_SB(0, 0), b2, voffB); PG8_STAGE(PG8_SB(0, 1), b2 + hB, voffB); PG8_STAGE(PG8_SA(0, 0), a2, s0);
            PG8_WAIT_V(8); PG8_WAIT_L(0); PG8_BAR; PG8_MMA(1, 0, At, B0); PG8_MMA(1, 1, At, B1); PG8_BAR; PG8_SCHED;
            PG8_LDB(B0, 1, 0); PG8_LDB(B1, 1, 1); PG8_SCHED; PG8_LDA(At, 1, 0); PG8_STAGE(PG8_SA(0, 1), a2, s1);
            PG8_WAIT_V(8); PG8_WAIT_L(0); PG8_BAR; PG8_MMA(0, 0, At, B0); PG8_MMA(0, 1, At, B1); PG8_BAR; PG8_SCHED;
            PG8_LDA(At, 1, 1); PG8_STAGE(PG8_SB(1, 0), b3, voffB); PG8_STAGE(PG8_SB(1, 1), b3 + hB, voffB); PG8_STAGE(PG8_SA(1, 0), a3, s0);
            PG8_WAIT_V(8); PG8_WAIT_L(0); PG8_BAR; PG8_MMA(1, 0, At, B0); PG8_MMA(1, 1, At, B1); PG8_BAR; PG8_SCHED;
        }
        if (wr == 0) PG8_BAR;
        E(acc, cur, wr, wc, fr, fq);
        if (!has_next) break;
#pragma unroll
        for (int a = 0; a < 2; ++a)
#pragma unroll
            for (int b = 0; b < 2; ++b)
#pragma unroll
                for (int m = 0; m < 4; ++m)
#pragma unroll
                    for (int n = 0; n < 2; ++n) acc[a][b][m][n] = (f32x4){0.f, 0.f, 0.f, 0.f};
        cur = nxt; cA = nA; cB = nB; ++ui;
        if constexpr (GATHER) { vA[0][0] = vN[0][0]; vA[0][1] = vN[0][1]; vA[1][0] = vN[1][0]; vA[1][1] = vN[1][1]; }
        if (wr == 1) PG8_BAR;
    }
    PG8_WAIT_V(0);
    PG8_BAR;
#undef PG8_SA
#undef PG8_SB
#undef PG8_STAGE
#undef PG8_LDA
#undef PG8_LDB
#undef PG8_MMA
#undef PG8_WAIT_V
#undef PG8_WAIT_L
#undef PG8_BAR
#undef PG8_SCHED
#undef PG8_MKOFF
}
}

constexpr int DM = 1024, NB = 2, SEQ = 8192, CTX = 256, TPB = SEQ + CTX, MROWS = NB * TPB, DEPTH = 2;
constexpr int INW = 9216, COL_K = 0, COL_V = 1024, COL_LX = 2048, COL_Q = 3072, COL_LG = 4096, COL_F = 5120, COL_G = 6144;
constexpr int NE = 256, TOPK = 8, EFF = 256, NPAIR = MROWS * TOPK, LCAP = MROWS;
constexpr float EPS = 1e-6f;
constexpr float QSCALE = 0.125f * 1.4426950408889634f;
constexpr int NCHUNK = TPB / 64;
static_assert(MROWS % 256 == 0, "rows");

constexpr size_t MiB = 1u << 20;
constexpr size_t WS_CTL = 0, CTL_ZERO_BYTES = 1 * MiB;
constexpr size_t WS_W = 1 * MiB, WL_STRIDE = 32 * MiB;
constexpr size_t WO_TAB = 31 * MiB;
constexpr size_t WO_WIN = 0, WO_D1 = 18 * MiB, WO_OUT = 24 * MiB, WO_R = 26 * MiB, WO_SGU = 27 * MiB, WO_SD = 28 * MiB, WO_LRU = 29 * MiB;
constexpr size_t WS_XALL = 65 * MiB;
constexpr size_t WS_H = WS_XALL + 66 * MiB;
constexpr size_t WS_U = WS_H + 33 * MiB;
constexpr size_t WS_KB = WS_U + 594 * MiB, WS_VB = WS_KB + 33 * MiB, WS_QB = WS_VB + 33 * MiB, WS_LXB = WS_QB + 33 * MiB, WS_GLG = WS_LXB + 33 * MiB, WS_ZP = WS_GLG + 33 * MiB;
constexpr size_t WS_GATES = WS_ZP + 33 * MiB;
constexpr size_t WS_MIXIN = WS_GATES + 99 * MiB;
constexpr size_t WS_S = WS_MIXIN + 99 * MiB;
constexpr size_t WS_UC = WS_S, WS_AB = WS_UC + 33 * MiB, WS_SUMM = WS_AB + 132 * MiB, WS_CARRY = WS_SUMM + 5 * MiB, WS_XA = WS_CARRY + 3 * MiB, WS_XB = WS_XA + 32 * MiB, WS_GB = WS_XB + 32 * MiB, WS_GC = WS_GB + 32 * MiB;
constexpr size_t WS_PA = WS_S, WS_PR = WS_PA + 66 * MiB, WS_PF = WS_PR + 66 * MiB, WS_Y1 = WS_PF + 66 * MiB;
static_assert(WS_GC + 3 * MiB <= WS_S + 280 * MiB && WS_Y1 + 66 * MiB <= WS_S + 280 * MiB, "scratch S");
constexpr size_t WS_MIXED = WS_S + 280 * MiB, WS_TOK = WS_MIXED + 33 * MiB;
constexpr size_t WS_LOG = WS_TOK + 33 * MiB, WS_SGU = WS_LOG + 17 * MiB, WS_SH = WS_SGU + 33 * MiB, WS_LIST = WS_SH + 9 * MiB, WS_TOPW = WS_LIST + 17 * MiB, WS_SD = WS_TOPW + 1 * MiB;
constexpr size_t WS_YB = WS_U;
constexpr size_t WS_Y16 = WS_KB, WS_HB = WS_S;
constexpr size_t WS_EP = WS_SUMM;
constexpr size_t WS_Y16_OLD = WS_U;
constexpr size_t WS_EW = WS_SD + 66 * MiB, WS_EW1 = WS_U, EW_STRIDE = 3 * MiB / 2;
#define EWL(l) (((l) & 1) ? WS_EW1 : WS_EW)
static_assert(WS_KB + 396 * MiB == WS_S && 392 * MiB <= 396 * MiB && WS_U + 384 * MiB <= WS_KB, "overlays");
constexpr size_t WS_END = WS_EW + 384 * MiB;
static_assert(WS_END <= 2048 * MiB, "d_ws budget");
constexpr int CW_BAR = 4096;
constexpr int CW_CNT = 16384, CNT_STRIDE = 32;
constexpr int CW_MOD = 65536;
static_assert((CW_MOD + 2 * 3 * 6144) * 4 <= (int)CTL_ZERO_BYTES, "ctl");

constexpr int LDS_BYTES = 147456, RING_BYTES = 131072, MISC_OFF = RING_BYTES + 320;
constexpr int NWAVES = 8;

#define GAS __attribute__((address_space(1)))
#define LAS __attribute__((address_space(3)))
typedef unsigned short bf16;
typedef unsigned v4u __attribute__((ext_vector_type(4)));
typedef float f32x4 __attribute__((ext_vector_type(4)));
typedef GAS unsigned gu32;
#define RLX_AGENT __ATOMIC_RELAXED, __HIP_MEMORY_SCOPE_AGENT
#define LDS_WAIT() asm volatile("s_waitcnt lgkmcnt(0)" ::: "memory")
typedef float f32x2_t __attribute__((ext_vector_type(2))); typedef __bf16 bf16x2_t __attribute__((ext_vector_type(2)));
__device__ __forceinline__ unsigned pk2(float lo, float hi) { const f32x2_t v = {lo, hi}; const bf16x2_t b = __builtin_convertvector(v, bf16x2_t); return __builtin_bit_cast(unsigned, b); }
__device__ __forceinline__ unsigned f2bf(float f) { return pk2(f, f) & 0xffffu; }
__device__ __forceinline__ float bf2f(unsigned h) { return __uint_as_float(h << 16); }
__device__ __forceinline__ float sigmoidf_(float x) { return __builtin_amdgcn_rcpf(1.f + __expf(-x)); }
__device__ __forceinline__ float siluf_(float x) { return x * __builtin_amdgcn_rcpf(1.f + __expf(-x)); }
__device__ __forceinline__ float gelu_tanh(float x) { const float u = 0.7978845608028654f * (x + 0.044715f * x * x * x); return x * __builtin_amdgcn_rcpf(1.f + __expf(-2.f * u)); }

#define XB_TMO      128
#define XB_XCNT(j)  (256  + 64 * (j))
#define XB_XSUB(j)  (1280 + 64 * (j))
#define XB_XGEN(j)  (2304 + 64 * (j))
#define XB_TOP      3328
#define XB_TOPGEN   3392
#define XCD_BAR_WORDS 3456
#define XB_SPIN_CAP (1u << 18)
__device__ __forceinline__ unsigned xb_ld(unsigned* p)              { return __hip_atomic_load(p, __ATOMIC_RELAXED, __HIP_MEMORY_SCOPE_AGENT); }
__device__ __forceinline__ unsigned xb_add(unsigned* p, unsigned v) { return __hip_atomic_fetch_add(p, v, __ATOMIC_RELAXED, __HIP_MEMORY_SCOPE_AGENT); }
__device__ __forceinline__ unsigned xb_xcc_id() { return (unsigned)__builtin_amdgcn_s_getreg((3 << 11) | 20) & 0xFu; }
#define XB_SPIN(cond, bar) do { unsigned _sp = 0; while (cond) { __builtin_amdgcn_s_sleep(1); \
    if ((++_sp & 255u) == 0u) { if (xb_ld(&(bar)[XB_TMO])) break; if (_sp > XB_SPIN_CAP) { atomicAdd(&(bar)[XB_TMO], 1u); break; } } } } while (0)
struct XcdBarrier { unsigned* bar; unsigned x; volatile LAS unsigned* st; };
__device__ __forceinline__ XcdBarrier xcd_barrier_post(unsigned* bar, volatile LAS unsigned* st) {
    XcdBarrier b; b.bar = bar; b.x = xb_xcc_id(); b.st = st;
    if (threadIdx.x == 0) (void)xb_add(&bar[XB_XCNT(b.x)], 1u);
    return b;
}
__device__ __forceinline__ void xcd_barrier_complete(unsigned* bar, unsigned x, unsigned& nloc, unsigned& nx) {
    const unsigned G = gridDim.x * gridDim.y * gridDim.z;
    unsigned sum, cnt, mine, sp = 0u;
    for (;;) {
        sum = 0u; cnt = 0u; mine = 0u;
#pragma unroll
        for (unsigned j = 0; j < 16; ++j) { const unsigned c = xb_ld(&bar[XB_XCNT(j)]); sum += c; cnt += (c > 0u) ? 1u : 0u; mine = (j == x) ? c : mine; }
        if (sum == G) break;
        __builtin_amdgcn_s_sleep(1);
        if ((++sp & 255u) == 0u) { if (xb_ld(&bar[XB_TMO])) break; if (sp > XB_SPIN_CAP) { atomicAdd(&bar[XB_TMO], 1u); break; } }
    }
    nloc = mine > 0u ? mine : 1u; nx = cnt > 0u ? cnt : 1u;
}
__device__ __forceinline__ void xcd_barrier(const XcdBarrier& b) {
    asm volatile("s_waitcnt vmcnt(0)" ::: "memory");
    __syncthreads();
    if (threadIdx.x == 0) {
        unsigned* bar = b.bar; asm volatile("" : "+s"(bar));
        __builtin_amdgcn_s_waitcnt(0);
        unsigned nloc = b.st[0], nx = b.st[1];
        unsigned bx = b.x; asm volatile("" : "+s"(bx));
        if (nloc == 0u) { xcd_barrier_complete(bar, bx, nloc, nx); b.st[0] = nloc; b.st[1] = nx; }
        const unsigned old = xb_add(&bar[XB_XSUB(bx)], 1u);
        const unsigned gen = old / nloc;
        if (old + 1u == (gen + 1u) * nloc) {
            __builtin_amdgcn_fence(__ATOMIC_RELEASE, "agent");
            asm volatile("s_waitcnt vmcnt(0)" ::: "memory");
            const unsigned og = xb_add(&bar[XB_TOP], 1u);
            const unsigned tg = og / nx;
            if (og + 1u == (tg + 1u) * nx) xb_add(&bar[XB_TOPGEN], 1u);
            else XB_SPIN(xb_ld(&bar[XB_TOPGEN]) == tg, bar);
            __builtin_amdgcn_fence(__ATOMIC_ACQUIRE, "agent");
            xb_add(&bar[XB_XGEN(bx)], 1u);
            asm volatile("s_waitcnt vmcnt(0)" ::: "memory");
        } else {
            XB_SPIN(xb_ld(&bar[XB_XGEN(bx)]) == gen, bar);
            __builtin_amdgcn_fence(__ATOMIC_ACQUIRE, "agent");
            asm volatile("s_waitcnt vmcnt(0)" ::: "memory");
        }
    }
    __syncthreads();
}

struct Args { const float* in[32]; float* out; unsigned char* ws; int ph_lo, ph_hi; };
struct Frame { LAS unsigned char* lds; int tid, lane, wave, bid, G, gw, NGW; long gtid, NT; };
#define WSP(T, off) ((T*)(A.ws + (off)))
#define WLP(l, off) ((bf16*)(A.ws + WS_W + (size_t)(l) * WL_STRIDE + (off)))
#define MODP(l, s, j) ((const float*)(A.ws + WS_CTL) + CW_MOD + ((l) * 3 + (s)) * 6144 + (j) * 1024)

__device__ __forceinline__ float wave_sum(float v) {
    v += sx<1>(v); v += sx<2>(v); v += sx<4>(v); v += sx<8>(v); v += sx<16>(v); v += sx<32>(v);
    return v;
}
__device__ __forceinline__ int win_row(int c) {
    const int sec = c >> 10; if (sec != 0 && sec != 3) return c;
    const int L = c & 255, g = L >> 6, a = (L >> 5) & 1, x = (L >> 4) & 1, q = (L >> 2) & 3, e = L & 3;
    return (c & ~255) | (128 * a + 32 * g + 8 * q + 4 * x + e);
}
template <bool WINMAP = false>
__device__ __forceinline__ void p0_transpose_item(const float* W, int K, int N, bf16* WT, int ldwt, int row_off, int col_off, LAS float* scr, int item, int lane) {
    const int nblk = N / 32, kb = item / nblk, nb = item % nblk, k0 = 64 * kb, n0 = 32 * nb;
    { f32x4 v[8]; const int rr = lane >> 3, c4 = (lane & 7) * 4;
#pragma unroll
      for (int i = 0; i < 8; ++i) v[i] = *(const f32x4*)(W + (size_t)(k0 + 8 * i + rr) * N + n0 + c4);
#pragma unroll
      for (int i = 0; i < 8; ++i) { LAS float* d = scr + (8 * i + rr) * 33 + c4; d[0] = v[i].x; d[1] = v[i].y; d[2] = v[i].z; d[3] = v[i].w; } }
    LDS_WAIT(); asm volatile("" ::: "memory");
    const int c = lane & 7;
#pragma unroll
    for (int j = 0; j < 4; ++j) { const int n = (lane >> 3) + 8 * j; const LAS float* s = scr + (8 * c) * 33 + n;
        v4u o; o.x = pk2(s[0 * 33], s[1 * 33]); o.y = pk2(s[2 * 33], s[3 * 33]); o.z = pk2(s[4 * 33], s[5 * 33]); o.w = pk2(s[6 * 33], s[7 * 33]);
        const int rr = WINMAP ? win_row(n0 + n) : n0 + n;
        *(v4u*)(WT + (size_t)(row_off + rr) * ldwt + col_off + k0 + 8 * c) = o; }
    LDS_WAIT(); asm volatile("" ::: "memory");
}

struct PItem { const float* W; bf16* WT; int N, ldwt, k0, n0, rowbase; bool winmap, skip; };
constexpr int PRO_I_WIN = 16 * 288, PRO_I_SQ = 16 * 32, PRO_I_R = 16 * 8, PRO_I_SD = 4 * 32, PRO_PER_L = PRO_I_WIN + 4 * PRO_I_SQ + 3 * PRO_I_R + PRO_I_SD;
__device__ __forceinline__ void pi_set(PItem& t, const float* W, int N, bf16* WT, int ldwt, int row_off, int col_off, int item) {
    const int nblk = N / 32, kb = item / nblk, nb = item % nblk; t.W = W; t.N = N; t.WT = WT + col_off; t.ldwt = ldwt; t.k0 = 64 * kb; t.n0 = 32 * nb; t.rowbase = row_off; }
__device__ __forceinline__ PItem pro_item(const Args& A, int it) {
    const int l = it / PRO_PER_L; int r = it % PRO_PER_L; PItem t; t.winmap = false; t.skip = false;
    if (r < PRO_I_WIN) { const int nb = r % 288; t.skip = nb >= 160 && nb < 192; t.winmap = true;
        pi_set(t, A.in[7] + (size_t)l * 1024 * 9216, 9216, WLP(l, WO_WIN), 1024, 0, 0, r); return t; } r -= PRO_I_WIN;
    if (r < PRO_I_SQ) { pi_set(t, A.in[12] + (size_t)l * 1048576, 1024, WLP(l, WO_D1), 3072, 0, 0, r); return t; } r -= PRO_I_SQ;
    if (r < PRO_I_SQ) { pi_set(t, A.in[20] + (size_t)l * 1048576, 1024, WLP(l, WO_D1), 3072, 0, 1024, r); return t; } r -= PRO_I_SQ;
    if (r < PRO_I_SQ) { pi_set(t, A.in[21] + (size_t)l * 1048576, 1024, WLP(l, WO_D1), 3072, 0, 2048, r); return t; } r -= PRO_I_SQ;
    if (r < PRO_I_SQ) { pi_set(t, A.in[22] + (size_t)l * 1048576, 1024, WLP(l, WO_OUT), 1024, 0, 0, r); return t; } r -= PRO_I_SQ;
    if (r < PRO_I_R) { pi_set(t, A.in[24] + (size_t)l * 262144, 256, WLP(l, WO_R), 1024, 0, 0, r); return t; } r -= PRO_I_R;
    if (r < PRO_I_R) { pi_set(t, A.in[29] + (size_t)l * 262144, 256, WLP(l, WO_R), 1024, 256 + ((r % 8) >> 2) * 128, 0, r); return t; } r -= PRO_I_R;
    if (r < PRO_I_R) { pi_set(t, A.in[30] + (size_t)l * 262144, 256, WLP(l, WO_R), 1024, 384 + ((r % 8) >> 2) * 128, 0, r); return t; } r -= PRO_I_R;
    pi_set(t, A.in[31] + (size_t)l * 262144, 1024, WLP(l, WO_SD), 256, 0, 0, r); return t;
}
__device__ __forceinline__ void pi_load(const PItem& t, f32x4 (&v)[8], int lane) {
    const int rr = lane >> 3, c4 = (lane & 7) * 4;
#pragma unroll
    for (int i = 0; i < 8; ++i) v[i] = *(const f32x4*)(t.W + (size_t)(t.k0 + 8 * i + rr) * t.N + t.n0 + c4);
}
__device__ __forceinline__ void pi_load_a(const PItem& t, f32x4 (&v)[8], int lane) {
    const int rr = lane >> 3, c4 = (lane & 7) * 4;
#pragma unroll
    for (int i = 0; i < 8; ++i) { const float* p = t.W + (size_t)(t.k0 + 8 * i + rr) * t.N + t.n0 + c4; asm volatile("global_load_dwordx4 %0, %1, off" : "=v"(v[i]) : "v"(p) : "memory"); }
}
__device__ __forceinline__ void pi_store(const PItem& t, const f32x4 (&v)[8], LAS float* scr, int lane) {
    const int rr = lane >> 3, c4 = (lane & 7) * 4;
#pragma unroll
    for (int i = 0; i < 8; ++i) { LAS float* d = scr + (8 * i + rr) * 33 + c4; d[0] = v[i].x; d[1] = v[i].y; d[2] = v[i].z; d[3] = v[i].w; }
    LDS_WAIT(); asm volatile("" ::: "memory");
    const int c = lane & 7;
#pragma unroll
    for (int j = 0; j < 4; ++j) { const int n = (lane >> 3) + 8 * j; const LAS float* sp = scr + (8 * c) * 33 + n;
        v4u o; o.x = pk2(sp[0 * 33], sp[1 * 33]); o.y = pk2(sp[2 * 33], sp[3 * 33]); o.z = pk2(sp[4 * 33], sp[5 * 33]); o.w = pk2(sp[6 * 33], sp[7 * 33]);
        const int row = t.winmap ? win_row(t.n0 + n) : t.n0 + n;
        *(v4u*)(t.WT + (size_t)(t.rowbase + row) * t.ldwt + t.k0 + 8 * c) = o; }
    LDS_WAIT(); asm volatile("" ::: "memory");
}

__device__ __forceinline__ void ph_prologue(const Frame& F, const Args& A) {
    LAS float* scr = (LAS float*)(F.lds + F.wave * 16384);
    { const int stride = F.NGW, hi = 2 * PRO_PER_L; int it = F.gw;
      if (it < hi) { f32x4 va[8], vb[8], vc[8]; PItem ta = pro_item(A, it), tb = ta, tc = ta;
        pi_load_a(ta, va, F.lane);
        if (it + stride < hi) { tb = pro_item(A, it + stride); pi_load_a(tb, vb, F.lane); }
#define PRO_STEP(TP, VP, TS, VS) { if (it + 2 * stride < hi) { TP = pro_item(A, it + 2 * stride); pi_load_a(TP, VP, F.lane); asm volatile("s_waitcnt vmcnt(16)" ::: "memory"); } \
            else asm volatile("s_waitcnt vmcnt(0)" ::: "memory"); \
            if (!TS.skip) pi_store(TS, VS, scr, F.lane); it += stride; if (it >= hi) break; }
        for (;;) {
            PRO_STEP(tc, vc, ta, va)
            PRO_STEP(ta, va, tb, vb)
            PRO_STEP(tb, vb, tc, vc)
        }
#undef PRO_STEP
      } }
#if FAST_WIN
    {
        LAS float* sW = (LAS float*)F.lds; LAS float* sT = sW + 32 * 256;
        __syncthreads();
        if (F.tid < 256) sT[F.tid] = cospif((float)F.tid / 128.0f);
        for (int it = F.bid; it < 2 * 4 * 32; it += F.G) {
            const int l = it >> 7, g = (it >> 5) & 3, k0 = (it & 31) * 32;
            __syncthreads();
            for (int e = F.tid; e < 32 * 256; e += 512) sW[e] = A.in[7][((size_t)l * 1024 + k0 + (e >> 8)) * 9216 + COL_F + g * 256 + (e & 255)];
            __syncthreads();
            const int o = F.tid & 255, kh = F.tid >> 8; int j = o >> 1, odd = o & 1; if (o == 1) { j = 128; odd = 0; }
            const int m0 = odd ? 192 : 0; float acc[16];
#pragma unroll
            for (int q = 0; q < 16; ++q) acc[q] = 0.f;
            for (int c = 0; c < 256; c += 4) { const float r0 = sT[(j * c + m0) & 255], r1 = sT[(j * (c + 1) + m0) & 255], r2 = sT[(j * (c + 2) + m0) & 255], r3 = sT[(j * (c + 3) + m0) & 255];
#pragma unroll
                for (int q = 0; q < 16; ++q) { const f32x4 w = *(const LAS f32x4*)(sW + (kh * 16 + q) * 256 + c); acc[q] += w.x * r0; acc[q] += w.y * r1; acc[q] += w.z * r2; acc[q] += w.w * r3; } }
            bf16* dst = WLP(l, WO_WIN) + (size_t)(COL_F + g * 256 + o) * 1024 + k0 + kh * 16;
            v4u w0, w1; w0.x = pk2(acc[0], acc[1]); w0.y = pk2(acc[2], acc[3]); w0.z = pk2(acc[4], acc[5]); w0.w = pk2(acc[6], acc[7]);
            w1.x = pk2(acc[8], acc[9]); w1.y = pk2(acc[10], acc[11]); w1.z = pk2(acc[12], acc[13]); w1.w = pk2(acc[14], acc[15]);
            *(v4u*)dst = w0; *(v4u*)(dst + 8) = w1;
        }
        __syncthreads();
    }
#endif
    float* MOD = (float*)(A.ws + WS_CTL) + CW_MOD;
    LAS float* part = (LAS float*)(F.lds + 8 * 16384 - 8192);
    LAS float* ssil = (LAS float*)(F.lds + 8 * 16384 - 8192 - 12288);
    if (F.bid < 2 * 96) { for (int e = F.tid; e < 3072; e += NWAVES * 64) { const int k = e & 1023; ssil[e] = siluf_(e < 1024 ? A.in[1][k] : e < 2048 ? A.in[1][1024 + k] : A.in[3][k]); } }
    __syncthreads();
    for (int it = F.bid; it < 2 * 96; it += F.G) {
        const int l = it / 96, nb = it % 96, n = nb * 64 + F.lane;
        const float* wm = A.in[4] + (size_t)l * 1024 * 6144 + n;
        float a0 = 0.f, a1 = 0.f, a2 = 0.f;
#pragma unroll 32
        for (int k = F.wave * 128; k < F.wave * 128 + 128; ++k) {
            const float w = wm[(size_t)k * 6144];
            a0 += ssil[k] * w; a1 += ssil[1024 + k] * w; a2 += ssil[2048 + k] * w;
        }
        __syncthreads();
        part[(F.wave * 3 + 0) * 64 + F.lane] = a0; part[(F.wave * 3 + 1) * 64 + F.lane] = a1; part[(F.wave * 3 + 2) * 64 + F.lane] = a2;
        __syncthreads();
        if (F.wave < 3) { float s = A.in[5][l * 6144 + n];
#pragma unroll
            for (int w = 0; w < 8; ++w) s += part[(w * 3 + F.wave) * 64 + F.lane];
            MOD[(l * 3 + F.wave) * 6144 + n] = s; }
    }
    for (long i = F.gtid; i < 2L * 4096 * 256; i += F.NT) {
        const int l = (int)(i >> 20), n = (int)((i >> 8) & 4095), kk = (int)(i & 255), pn = n >> 8, rr = n & 255, gate = rr >> 7, rho = rr & 127, d = pn >> 3, cb = pn & 7;
        const int cho = 128 * cb + rho, blk = cho >> 6, e = cho & 63, chi = 256 * (cb >> 1) + kk; float v = 0.f;
        if ((chi >> 6) == blk) v = (gate ? A.in[17] : A.in[15])[((size_t)(l * 2 + d) * 16 + blk) * 4096 + (chi & 63) * 64 + e];
        WLP(l, WO_LRU)[i & 0xFFFFF] = (bf16)f2bf(v);
    }
    for (long i = F.gtid; i < 2L * 65536; i += F.NT) {
        const int which = (int)(i >> 16), n = (int)((i >> 8) & 255), k = (int)(i & 255); float v;
        if (which == 0) { const int k1 = n >> 1, cp = n & 1, t1 = k >> 1, c = k & 1; const float rev = (float)((k1 * t1) & 127) * (1.f / 128.f);
            const float cs = __builtin_amdgcn_cosf(rev), sn = __builtin_amdgcn_sinf(rev); v = cp == 0 ? (c == 0 ? cs : sn) : (c == 0 ? -sn : cs); }
        else { const int h = n >> 7, k2 = (n >> 1) & 63, cp = n & 1, hp = k >> 7, t2 = (k >> 1) & 63, c = k & 1; const float rev = (float)((k2 * t2) & 63) * (1.f / 64.f);
            const float cs = __builtin_amdgcn_cosf(rev), sn = __builtin_amdgcn_sinf(rev); v = (h != hp) ? 0.f : (cp == 0 ? (c == 0 ? cs : sn) : (c == 0 ? -sn : cs)); }
        WLP(0, WO_TAB)[i] = (bf16)f2bf(v);
    }
    for (long i = F.gtid; i < 4096; i += F.NT) ((float*)(A.ws + WS_W + WO_TAB + 262144))[i] = log1pf(expf(-A.in[19][i]));
}

__device__ __forceinline__ void norm_mod_row(const f32x4 (&v)[4], const float* g, const float* sc, const float* sh, bf16* orow, int lane) {
    float s = 0.f;
#pragma unroll
    for (int j = 0; j < 4; ++j) s += (v[j].x * v[j].x + v[j].y * v[j].y) + (v[j].z * v[j].z + v[j].w * v[j].w);
    const float rs = rsqrtf(wave_sum(s) * (1.f / 1024.f) + EPS);
#pragma unroll
    for (int j = 0; j < 4; ++j) { const int c = 4 * lane + 256 * j;
        const f32x4 gg = *(const f32x4*)(g + c), s1 = *(const f32x4*)(sc + c), s0 = *(const f32x4*)(sh + c);
        const float y0 = v[j].x * rs * gg.x * (1.f + s1.x) + s0.x, y1 = v[j].y * rs * gg.y * (1.f + s1.y) + s0.y, y2 = v[j].z * rs * gg.z * (1.f + s1.z) + s0.z, y3 = v[j].w * rs * gg.w * (1.f + s1.w) + s0.w;
        *(unsigned long long*)(orow + c) = (unsigned long long)pk2(y0, y1) | ((unsigned long long)pk2(y2, y3) << 32); }
}
__device__ __forceinline__ void ph_norm1(const Frame& F, const Args& A, int l) {
    bf16* H = WSP(bf16, WS_H);
    for (int R = F.gw; R < MROWS; R += F.NGW) {
        const int b = R / TPB, p = R % TPB, s = (p < CTX) ? 2 : b;
        const float* X = (p < CTX) ? A.in[2] + ((size_t)b * CTX + p) * 1024 : A.in[0] + ((size_t)b * SEQ + (p - CTX)) * 1024;
        f32x4 v[4];
#pragma unroll
        for (int j = 0; j < 4; ++j) v[j] = *(const f32x4*)(X + 4 * F.lane + 256 * j);
        norm_mod_row(v, A.in[6] + l * 1024, MODP(l, s, 1), MODP(l, s, 0), H + (size_t)R * 1024, F.lane);
    }
}

__device__ __forceinline__ void ph_uelem(const Frame& F, const Args& A, int l) {
    const float* U = WSP(float, WS_U);
    bf16 *Kb = WSP(bf16, WS_KB), *Vb = WSP(bf16, WS_VB), *Qb = WSP(bf16, WS_QB), *LXb = WSP(bf16, WS_LXB), *GLG = WSP(bf16, WS_GLG), *ZP = WSP(bf16, WS_ZP), *GT = WSP(bf16, WS_GATES);
    LAS float* sF = (LAS float*)F.lds; LAS float* sT = sF + 1024;
    if (F.tid < 256) sT[F.tid] = cospif((float)F.tid / 128.0f);
    __syncthreads();
    for (int R = F.bid; R < MROWS; R += F.G) {
        const float* u = U + (size_t)R * INW; const int p = R % TPB; const bool lat = p >= CTX; const int t = p - CTX;
        for (int gi = F.wave; gi < 32; gi += 8) {
            const bool isq = gi >= 16; const int grp = gi & 15;
            const float v = u[(isq ? COL_Q : COL_K) + grp * 64 + F.lane];
            const float ss = wave_sum(v * v);
            float y = v * rsqrtf(ss * (1.f / 64.f) + EPS) * (isq ? A.in[8] : A.in[9])[l * 64 + F.lane];
            const float part = sx<16>(y);
            if (lat) { const int axis = F.lane >> 5, hf = (F.lane >> 4) & 1, f = F.lane & 15;
                const float pos = (float)(axis ? (t & 63) : (t >> 6)); const float inv = exp2f(-(float)f * (13.287712379549449f / 16.f));
                float sn, cs; sincosf(pos * inv, &sn, &cs);
                y = hf ? (part * sn + y * cs) : (y * cs - part * sn); }
            if (isq) y *= QSCALE;
            (isq ? Qb : Kb)[(size_t)R * 1024 + grp * 64 + F.lane] = (bf16)f2bf(y);
        }
        for (int c = F.tid; c < 1024; c += 512) { const size_t o = (size_t)R * 1024 + c;
            Vb[o] = (bf16)f2bf(u[COL_V + c]); LXb[o] = (bf16)f2bf(u[COL_LX + c]); GLG[o] = (bf16)f2bf(gelu_tanh(u[COL_LG + c])); sF[c] = u[COL_F + c]; }
        for (int c = F.tid; c < 3072; c += 512) GT[(size_t)R * 3072 + c] = (bf16)f2bf(sigmoidf_(u[COL_G + c]));
        __syncthreads();
        for (int o = F.tid; o < 1024; o += 512) { const int g = o >> 8, oo = o & 255; int j = oo >> 1, odd = oo & 1; if (oo == 1) { j = 128; odd = 0; }
            const int m0 = odd ? 192 : 0; float acc = 0.f;
            for (int c = 0; c < 256; ++c) acc += sF[g * 256 + c] * sT[(j * c + m0) & 255];
            ZP[(size_t)R * 1024 + o] = (bf16)f2bf(acc); }
        __syncthreads();
    }
}

__device__ __forceinline__ void ph_conv(const Frame& F, const Args& A, int l) {
    const bf16* LXb = WSP(bf16, WS_LXB); bf16* UC = WSP(bf16, WS_UC);
    const int c8 = (int)(F.gtid & 127) * 8, r0 = (int)(F.gtid >> 7), rstep = (int)(F.NT >> 7);
    float w[4][8], bia[8];
#pragma unroll
    for (int j = 0; j < 4; ++j) { const f32x4 a = *(const f32x4*)(A.in[13] + l * 4096 + j * 1024 + c8), b = *(const f32x4*)(A.in[13] + l * 4096 + j * 1024 + c8 + 4);
        w[j][0] = a.x; w[j][1] = a.y; w[j][2] = a.z; w[j][3] = a.w; w[j][4] = b.x; w[j][5] = b.y; w[j][6] = b.z; w[j][7] = b.w; }
    { const f32x4 a = *(const f32x4*)(A.in[14] + l * 1024 + c8), b = *(const f32x4*)(A.in[14] + l * 1024 + c8 + 4);
      bia[0] = a.x; bia[1] = a.y; bia[2] = a.z; bia[3] = a.w; bia[4] = b.x; bia[5] = b.y; bia[6] = b.z; bia[7] = b.w; }
    for (int Rb = r0; Rb < MROWS; Rb += 4 * rstep) {
        v4u x[4][4];
#pragma unroll
        for (int u = 0; u < 4; ++u) { const int R = Rb + u * rstep; if (R < MROWS) { const int p = R % TPB, lo = p < CTX ? 0 : CTX, hi = p < CTX ? CTX : TPB;
#pragma unroll
            for (int j = 0; j < 4; ++j) { const int pp = p + j - 2; x[u][j] = (pp >= lo && pp < hi) ? *(const v4u*)(LXb + (size_t)(R + j - 2) * 1024 + c8) : (v4u){0u, 0u, 0u, 0u}; } } }
#pragma unroll
        for (int u = 0; u < 4; ++u) { const int R = Rb + u * rstep; if (R < MROWS) { float acc[8];
#pragma unroll
            for (int e = 0; e < 8; ++e) acc[e] = bia[e];
#pragma unroll
            for (int j = 0; j < 4; ++j) { const unsigned xs[4] = {x[u][j].x, x[u][j].y, x[u][j].z, x[u][j].w};
#pragma unroll
                for (int q = 0; q < 4; ++q) { acc[2 * q] += w[j][2 * q] * bf2f(xs[q] & 0xffffu); acc[2 * q + 1] += w[j][2 * q + 1] * bf2f(xs[q] >> 16); } }
            v4u o; o.x = pk2(acc[0], acc[1]); o.y = pk2(acc[2], acc[3]); o.z = pk2(acc[4], acc[5]); o.w = pk2(acc[6], acc[7]);
            *(v4u*)(UC + (size_t)R * 1024 + c8) = o; } }
    }
}
#if !FAST_LRU
__device__ __forceinline__ void ph_lrucoef(const Frame& F, const Args& A, int l) {
    const bf16* UC = WSP(bf16, WS_UC); unsigned* AB = WSP(unsigned, WS_AB);
    for (long i = F.gtid; i < 2L * MROWS * 1024; i += F.NT) {
        const int d = (int)(i / ((long)MROWS * 1024)); const long rem = i % ((long)MROWS * 1024); const int R = (int)(rem >> 10), ch = (int)(rem & 1023), blk = ch >> 6, e = ch & 63;
        const float* wa = A.in[15] + ((size_t)(l * 2 + d) * 16 + blk) * 4096 + e; const float* wi = A.in[17] + ((size_t)(l * 2 + d) * 16 + blk) * 4096 + e;
        float r = A.in[16][(l * 2 + d) * 1024 + ch], ig = A.in[18][(l * 2 + d) * 1024 + ch];
        const bf16* ur = UC + (size_t)R * 1024 + blk * 64;
        for (int dd = 0; dd < 64; ++dd) { const float x = bf2f(ur[dd]); r += x * wa[dd * 64]; ig += x * wi[dd * 64]; }
        const float lam = A.in[19][(l * 2 + d) * 1024 + ch]; const float sp = log1pf(expf(-lam));
        const float la = -8.f * sigmoidf_(r) * sp; const float mult = sqrtf(-expm1f(2.f * la));
        const float bc = mult * sigmoidf_(ig) * bf2f(ur[e]);
        AB[i] = pk2(la, bc);
    }
}
#endif
struct LruSched {
    const char* uc; const char* w; int G, c;
    __device__ __forceinline__ bool next(int i, pg8::UnitG& U) const {
        const long id = (long)i * G + c; if (id >= 66 * 16) return false;
        const int pm = (int)(id >> 4), pn = (int)(id & 15);
        U.a = uc + ((size_t)pm * 256 * 1024 + 256 * ((pn & 7) >> 1)) * 2; U.b = w + (size_t)pn * 256 * 256 * 2; U.row0 = pm * 256; U.pn = pn; U.e = 0; U.valid = 256; U.rows = nullptr; return true;
    }
};
struct EpiLru {
    static constexpr bool PERM = false;
    unsigned* AB; const bf16* UC; const float* ba; const float* bi; const float* sp;
    __device__ __forceinline__ void operator()(const f32x4 (&acc)[2][2][4][2], const pg8::UnitG& u, int wr, int wc, int fr, int fq) const {
        const int d = u.pn >> 3, cb = u.pn & 7, ch0 = 128 * cb + wc * 32 + 4 * fq;
        f32x4 vba[2], vbi[2], vsp[2];
#pragma unroll
        for (int n = 0; n < 2; ++n) { vba[n] = *(const f32x4*)(ba + d * 1024 + ch0 + 16 * n) * -1.4426950408889634f; vbi[n] = *(const f32x4*)(bi + d * 1024 + ch0 + 16 * n) * -1.4426950408889634f; vsp[n] = *(const f32x4*)(sp + d * 1024 + ch0 + 16 * n) * -8.f; }
#pragma unroll
        for (int ai = 0; ai < 2; ++ai) { unsigned long long uxs[4][2];
#pragma unroll
            for (int m = 0; m < 4; ++m)
#pragma unroll
                for (int n = 0; n < 2; ++n) uxs[m][n] = *(const unsigned long long*)(UC + ((size_t)u.row0 + ai * 128 + wr * 64 + m * 16 + fr) * 1024 + ch0 + 16 * n);
#pragma unroll
            for (int m = 0; m < 4; ++m) { const size_t R = (size_t)u.row0 + ai * 128 + wr * 64 + m * 16 + fr;
#pragma unroll
                for (int n = 0; n < 2; ++n) { const int ch = ch0 + 16 * n;
                    const unsigned long long ux = uxs[m][n];
                    const float x[4] = {bf2f((unsigned)ux & 0xffffu), bf2f(((unsigned)ux) >> 16), bf2f((unsigned)(ux >> 32) & 0xffffu), bf2f((unsigned)(ux >> 48))};
                    const f32x4 r = acc[ai][0][m][n], g = acc[ai][1][m][n]; v4u o;
#pragma unroll
                    for (int e = 0; e < 4; ++e) {
                        const float la = vsp[n][e] * __builtin_amdgcn_rcpf(1.f + __builtin_amdgcn_exp2f(__builtin_fmaf(r[e], -1.4426950408889634f, vba[n][e])));
                        const float mult = __builtin_amdgcn_sqrtf(1.f - __builtin_amdgcn_exp2f(la * 2.8853900817779268f));
                        o[e] = pk2(la, mult * __builtin_amdgcn_rcpf(1.f + __builtin_amdgcn_exp2f(__builtin_fmaf(g[e], -1.4426950408889634f, vbi[n][e]))) * x[e]); }
                    *(v4u*)(AB + ((size_t)d * MROWS + R) * 1024 + ch) = o; } }
            asm volatile("" ::: "memory"); }
    }
};
__device__ __forceinline__ void ph_lru_gemm(const Frame& F, const Args& A, int l, int Ge) {
    LruSched S{(const char*)WSP(bf16, WS_UC), (const char*)WLP(l, WO_LRU), Ge, F.bid};
    EpiLru E{WSP(unsigned, WS_AB), WSP(bf16, WS_UC), A.in[16] + l * 2048, A.in[18] + l * 2048, (const float*)(A.ws + WS_W + WO_TAB + 262144) + l * 2048};
    pg8::gemm_phase_g<EpiLru, LruSched, false>(F.lds, 256, 1024, 256, S, E);
}
struct FftSched {
    const char* x; const char* w; int nunits, G, c;
    __device__ __forceinline__ bool next(int i, pg8::UnitG& U) const {
        const long id = (long)i * G + c; if (id >= nunits) return false;
        U.a = x + (size_t)id * 256 * 256 * 2; U.b = w; U.row0 = (int)id * 256; U.pn = 0; U.e = 0; U.valid = 256; U.rows = nullptr; return true;
    }
};
struct EpiFftA {
    static constexpr bool PERM = false;
    unsigned* XB;
    __device__ __forceinline__ void operator()(const f32x4 (&acc)[2][2][4][2], const pg8::UnitG& u, int wr, int wc, int fr, int fq) const {
#pragma unroll
        for (int ai = 0; ai < 2; ++ai)
#pragma unroll
            for (int m = 0; m < 4; ++m) { int r0 = u.row0; asm volatile("" : "+s"(r0));
                const int row = r0 + ai * 128 + wr * 64 + m * 16 + fr, t2 = row & 63; const size_t bc = (size_t)(row >> 6);
#pragma unroll
                for (int bj = 0; bj < 2; ++bj)
#pragma unroll
                    for (int n = 0; n < 2; ++n) { const int k1 = 64 * bj + 16 * wc + 8 * n + 2 * fq; const f32x4 v = acc[ai][bj][m][n];
#pragma unroll
                        for (int q = 0; q < 2; ++q) { const int kk = k1 + q; const float rev = (float)(kk * t2) * (1.f / 8192.f);
                            const float cs = __builtin_amdgcn_cosf(rev), sn = __builtin_amdgcn_sinf(rev); const float yr = v[2 * q], yi = v[2 * q + 1];
                            XB[(bc * 64 + (kk >> 1)) * 128 + (kk & 1) * 64 + t2] = pk2(yr * cs + yi * sn, yi * cs - yr * sn); } }
                asm volatile("" ::: "memory"); }
    }
};
struct EpiBf16Plain {
    static constexpr bool PERM = true;
    bf16* C; int ldc;
    __device__ __forceinline__ void operator()(const f32x4 (&acc)[2][2][4][2], const pg8::UnitG& u, int wr, int wc, int fr, int fq) const {
#pragma unroll
        for (int ai = 0; ai < 2; ++ai)
#pragma unroll
            for (int m = 0; m < 4; ++m) { bf16* rowp = C + (size_t)(u.row0 + ai * 128 + wr * 64 + m * 16 + fr) * ldc + u.pn * 256 + wc * 32 + 8 * fq;
#pragma unroll
                for (int bj = 0; bj < 2; ++bj) { const f32x4 v0 = acc[ai][bj][m][0], v1 = acc[ai][bj][m][1];
                    v4u o; o.x = pk2(v0[0], v0[1]); o.y = pk2(v0[2], v0[3]); o.z = pk2(v1[0], v1[1]); o.w = pk2(v1[2], v1[3]);
                    *(v4u*)(rowp + bj * 128) = o; } }
    }
};
struct EpiBf16U {
    static constexpr bool PERM = true; static constexpr int MIDK = 0;
    bf16* C; int ldc;
    __device__ __forceinline__ void operator()(const f32x4 (&acc)[2][2][4][2], const pg8::Unit& u, int wr, int wc, int fr, int fq) const {
#pragma unroll
        for (int ai = 0; ai < 2; ++ai)
#pragma unroll
            for (int m = 0; m < 4; ++m) { bf16* rowp = C + (size_t)(u.pm * 256 + ai * 128 + wr * 64 + m * 16 + fr) * ldc + u.pn * 256 + wc * 32 + 8 * fq;
#pragma unroll
                for (int bj = 0; bj < 2; ++bj) { const f32x4 v0 = acc[ai][bj][m][0], v1 = acc[ai][bj][m][1];
                    v4u o; o.x = pk2(v0[0], v0[1]); o.y = pk2(v0[2], v0[3]); o.z = pk2(v1[0], v1[1]); o.w = pk2(v1[2], v1[3]);
                    *(v4u*)(rowp + bj * 128) = o; } }
    }
};
__device__ __forceinline__ void ph_fft_a_gemm(const Frame& F, const Args& A) {
    FftSched S{(const char*)WSP(bf16, WS_XA), (const char*)WLP(0, WO_TAB), 256, F.G, F.bid};
    EpiFftA E{WSP(unsigned, WS_XB)};
    pg8::gemm_phase_g<EpiFftA, FftSched, false>(F.lds, 256, 256, 256, S, E);
}
__device__ __forceinline__ void ph_fft_b_gemm(const Frame& F, const Args& A) {
    FftSched S{(const char*)WSP(bf16, WS_XB), (const char*)(WLP(0, WO_TAB) + 65536), 256, F.G, F.bid};
    EpiBf16Plain E{WSP(bf16, WS_GB), 256};
    pg8::gemm_phase_g<EpiBf16Plain, FftSched, false>(F.lds, 256, 256, 256, S, E);
}
__device__ __forceinline__ void ph_scan1(const Frame& F, const Args& A) {
    const unsigned* AB = WSP(unsigned, WS_AB); float2* SUMM = WSP(float2, WS_SUMM);
    for (int it = F.gw; it < NB * 2 * NCHUNK * 16; it += F.NGW) {
        const int cg = it & 15, ck = (it >> 4) % NCHUNK, bd = (it >> 4) / NCHUNK, b = bd >> 1, d = bd & 1, ch = cg * 64 + F.lane;
        const unsigned* ab = AB + ((size_t)d * MROWS + (size_t)b * TPB + ck * 64) * 1024 + ch;
        float ac = 1.f, h = 0.f;
#pragma unroll
        for (int q = 0; q < 4; ++q) { unsigned w[16];
#pragma unroll
            for (int k = 0; k < 16; ++k) { const int i = q * 16 + k, ii = d ? 63 - i : i; w[k] = ab[(size_t)ii * 1024]; }
#pragma unroll
            for (int k = 0; k < 16; ++k) { const float a = __expf(bf2f(w[k] & 0xffffu)); h = a * h + bf2f(w[k] >> 16); ac *= a; } }
        SUMM[((size_t)bd * NCHUNK + ck) * 1024 + ch] = make_float2(ac, h);
    }
}
__device__ __forceinline__ void ph_scan2(const Frame& F, const Args& A) {
    const float2* SUMM = WSP(float2, WS_SUMM); float* CARRY = WSP(float, WS_CARRY);
    if (F.gtid < 4096) {
        const int bd = (int)(F.gtid >> 10), ch = (int)(F.gtid & 1023), d = bd & 1; float h = 0.f;
        for (int s = 0; s < NCHUNK; ++s) { const int ck = d ? (s < 4 ? 3 - s : NCHUNK + 3 - s) : s;
            const size_t o = ((size_t)bd * NCHUNK + ck) * 1024 + ch; CARRY[o] = h; const float2 v = SUMM[o]; h = v.x * h + v.y; }
    }
}
__device__ __forceinline__ void ph_scan3(const Frame& F, const Args& A, int l) {
    const unsigned* AB = WSP(unsigned, WS_AB); const float* CARRY = WSP(float, WS_CARRY); const bf16* GLG = WSP(bf16, WS_GLG); bf16* MX = WSP(bf16, WS_MIXIN);
    const int c0 = (l == DEPTH - 1) ? CTX / 64 : 0, nck = NCHUNK - c0;
    for (int it = F.gw; it < NB * nck * 16; it += F.NGW) {
        const int cg = it & 15, ck = c0 + (it >> 4) % nck, b = (it >> 4) / nck, ch = cg * 64 + F.lane; const size_t R0 = (size_t)b * TPB + ck * 64;
        const unsigned* ab0 = AB + R0 * 1024 + ch; const unsigned* ab1 = AB + ((size_t)MROWS + R0) * 1024 + ch;
        float hf[64]; float h = CARRY[((size_t)(b * 2 + 0) * NCHUNK + ck) * 1024 + ch];
#pragma unroll
        for (int q = 0; q < 4; ++q) { unsigned w[16];
#pragma unroll
            for (int k = 0; k < 16; ++k) w[k] = ab0[(size_t)(q * 16 + k) * 1024];
#pragma unroll
            for (int k = 0; k < 16; ++k) { h = __expf(bf2f(w[k] & 0xffffu)) * h + bf2f(w[k] >> 16); hf[q * 16 + k] = h; } }
        h = CARRY[((size_t)(b * 2 + 1) * NCHUNK + ck) * 1024 + ch];
#pragma unroll
        for (int q = 3; q >= 0; --q) { unsigned w[16]; bf16 g[16];
#pragma unroll
            for (int k = 0; k < 16; ++k) { const int i = q * 16 + 15 - k; w[k] = ab1[(size_t)i * 1024]; g[k] = GLG[(R0 + i) * 1024 + ch]; }
#pragma unroll
            for (int k = 0; k < 16; ++k) { const int i = q * 16 + 15 - k; h = __expf(bf2f(w[k] & 0xffffu)) * h + bf2f(w[k] >> 16);
                MX[(R0 + i) * 3072 + 1024 + ch] = (bf16)f2bf((hf[i] + h) * bf2f(g[k])); } }
    }
}

__device__ __forceinline__ void ph_fft_t1_fast(const Frame& F, const Args& A) {
    const unsigned* ZP = WSP(unsigned, WS_ZP); unsigned* XA = WSP(unsigned, WS_XA); LAS unsigned* T = (LAS unsigned*)F.lds;
    for (int item = F.bid; item < 512; item += F.G) {
        const int b = item >> 8, t2 = (item >> 2) & 63, cq = item & 3;
        __syncthreads();
#pragma unroll
        for (int i = 0; i < 8; ++i) { const int p = F.tid + 512 * i, t1 = p >> 5, w4 = (p & 31) * 4;
            const v4u v = *(const v4u*)(ZP + ((size_t)b * TPB + CTX + 64 * t1 + t2) * 512 + cq * 128 + w4);
            T[t1 * 129 + w4] = v.x; T[t1 * 129 + w4 + 1] = v.y; T[t1 * 129 + w4 + 2] = v.z; T[t1 * 129 + w4 + 3] = v.w; }
        __syncthreads();
#pragma unroll
        for (int i = 0; i < 16; ++i) { const int p = F.tid + 512 * i, cc = p >> 6, t1 = (p & 63) * 2;
            const unsigned long long v = (unsigned long long)T[t1 * 129 + cc] | ((unsigned long long)T[(t1 + 1) * 129 + cc] << 32);
            *(unsigned long long*)(XA + (((size_t)b * 512 + cq * 128 + cc) * 64 + t2) * 128 + t1) = v; }
    }
    __syncthreads();
}
__device__ __forceinline__ void ph_fft_t2_fast(const Frame& F, const Args& A, int l) {
    const unsigned* GB = WSP(unsigned, WS_GB); bf16* MX = WSP(bf16, WS_MIXIN); LAS unsigned* T = (LAS unsigned*)F.lds;
    LAS unsigned short* OUTS = (LAS unsigned short*)(F.lds + 2 * 128 * 65 * 4);
    const bool bal = F.G == 256; const int nmine = bal ? (F.bid < 252 ? 2 : 4) : (520 - F.bid + F.G - 1) / F.G;
    for (int ii = 0; ii < nmine; ++ii) {
        int b, kp, g;
        if (bal) { if (F.bid < 252) { const int f = 2 * F.bid + ii; b = f / 252; const int rem = f % 252; kp = 1 + (rem >> 2); g = rem & 3; }
                   else { const int h = 4 * (F.bid - 252) + ii; b = h >> 3; kp = ((h >> 2) & 1) ? 64 : 0; g = h & 3; } }
        else { const int item = F.bid + ii * F.G; b = item / 260; const int rem = item % 260; kp = rem >> 2; g = rem & 3; }
        const int k1a = kp, k1b = (128 - kp) & 127;
        __syncthreads();
#pragma unroll
        for (int i = 0; i < 8; ++i) { const int p = F.tid + 512 * i, blk = p >> 11, cc = (p >> 4) & 127, w4 = (p & 15) * 4, kk = blk ? k1b : k1a;
            const v4u v = *(const v4u*)(GB + (((size_t)b * 512 + g * 128 + cc) * 64 + (kk >> 1)) * 128 + (kk & 1) * 64 + w4);
            LAS unsigned* d = T + blk * (128 * 65) + cc * 65 + w4; d[0] = v.x; d[1] = v.y; d[2] = v.z; d[3] = v.w; }
        __syncthreads();
        const int jc = F.tid & 255, j = (jc == 0 || jc == 128) ? 0 : (jc < 128 ? jc : 256 - jc);
        const int nset = (k1a == k1b) ? 1 : 2;
        for (int set = 0; set < nset; ++set) { const int ka = set ? k1b : k1a;
            for (int k2 = (F.tid >> 8); k2 < 64; k2 += 2) {
                const int mk2 = (ka == 0) ? ((64 - k2) & 63) : 63 - k2;
                const unsigned own = T[set * (128 * 65) + j * 65 + k2], mir = T[(nset == 1 ? 0 : (1 - set)) * (128 * 65) + j * 65 + mk2];
                float o; if (jc == 0) o = 0.5f * (bf2f(own & 0xffffu) + bf2f(mir & 0xffffu)); else if (jc == 128) o = 0.5f * (bf2f(own >> 16) + bf2f(mir >> 16)); else if (jc < 128) o = bf2f(mir & 0xffffu); else o = bf2f(own & 0xffffu);
                OUTS[k2 * 256 + jc] = (unsigned short)f2bf(o * 6.9053396600248786e-4f); }
            __syncthreads();
#pragma unroll
            for (int i = 0; i < 4; ++i) { const int p = F.tid + 512 * i, k2 = p >> 5, c8 = (p & 31) * 8;
                *(v4u*)(MX + ((size_t)b * TPB + CTX + ka + 128 * k2) * 3072 + 2048 + g * 256 + c8) = *(const LAS v4u*)(OUTS + k2 * 256 + c8); }
            __syncthreads(); }
    }
    __syncthreads();
    const float2* GC = WSP(float2, WS_GC);
    if (l + 1 < DEPTH) for (long i = F.gtid; i < (long)NB * CTX * 1024; i += F.NT) {
        const int col = (int)(i & 1023), k = (int)((i >> 10) & 255), b = (int)(i >> 18), g = col >> 8, jc = col & 255, km = (256 - k) & 255;
        const int j = (jc == 0 || jc == 128) ? 0 : (jc < 128 ? jc : 256 - jc); const size_t base = ((size_t)b * 512 + g * 128 + j) * 256;
        const float2 w = GC[base + k], wm = GC[base + km];
        float o; if (jc == 0) o = 0.5f * (w.x + wm.x); else if (jc == 128) o = 0.5f * (w.y + wm.y); else if (jc < 128) o = wm.x; else o = w.x;
        MX[((size_t)b * TPB + k) * 3072 + 2048 + col] = (bf16)f2bf(o * 3.90625e-3f);
    }
}
__device__ __forceinline__ void ph_scan2_fast(const Frame& F, const Args& A) {
    const float2* SUMM = WSP(float2, WS_SUMM); float* CARRY = WSP(float, WS_CARRY);
    for (int it = F.gw; it < 256; it += F.NGW) {
        const int bd = it >> 6, d = bd & 1, ch = (it & 63) * 16 + (F.lane & 15), seg = F.lane >> 4;
        float2 v[33]; float as = 1.f, hs = 0.f;
#pragma unroll
        for (int q = 0; q < 33; ++q) { const int sidx = seg * 33 + q, ck = d ? (sidx < 4 ? 3 - sidx : NCHUNK + 3 - sidx) : sidx; v[q] = SUMM[((size_t)bd * NCHUNK + ck) * 1024 + ch]; }
#pragma unroll
        for (int q = 0; q < 33; ++q) { hs = v[q].x * hs + v[q].y; as *= v[q].x; }
        const float a16 = sx<16>(as), h16 = sx<16>(hs), a32 = sx<32>(as), h32 = sx<32>(hs), a48 = sx<32>(a16), h48 = sx<32>(h16);
        float h = 0.f;
#pragma unroll
        for (int jx = 0; jx < 3; ++jx) { const int x = jx ^ seg;
            const float aj = x == 0 ? as : (x == 1 ? a16 : (x == 2 ? a32 : a48)), hj = x == 0 ? hs : (x == 1 ? h16 : (x == 2 ? h32 : h48));
            if (jx < seg) h = aj * h + hj; }
#pragma unroll
        for (int q = 0; q < 33; ++q) { const int sidx = seg * 33 + q, ck = d ? (sidx < 4 ? 3 - sidx : NCHUNK + 3 - sidx) : sidx; CARRY[((size_t)bd * NCHUNK + ck) * 1024 + ch] = h; h = v[q].x * h + v[q].y; }
    }
}

__device__ __forceinline__ void ph_fft_t1(const Frame& F, const Args& A) {
    const unsigned* ZP = WSP(unsigned, WS_ZP); unsigned* XA = WSP(unsigned, WS_XA);
    for (long i = F.gtid; i < (long)NB * 512 * 8192; i += F.NT) {
        const int t1 = (int)(i & 127), t2 = (int)((i >> 7) & 63), cc = (int)((i >> 13) & 511), b = (int)(i >> 22);
        XA[i] = ZP[((size_t)b * TPB + CTX + 64 * t1 + t2) * 512 + cc];
    }
}
#if !FAST_FFT
__device__ __forceinline__ void ph_fft_a(const Frame& F, const Args& A) {
    const unsigned* XA = WSP(unsigned, WS_XA); unsigned* XB = WSP(unsigned, WS_XB);
    for (long i = F.gtid; i < (long)NB * 512 * 8192; i += F.NT) {
        const int k1 = (int)(i & 127); const long row = i >> 7; const int t2 = (int)(row & 63); const long bc = row >> 6;
        const unsigned* x = XA + row * 128; float yr = 0.f, yi = 0.f;
        for (int t1 = 0; t1 < 128; ++t1) { const unsigned w = x[t1]; const float wr = bf2f(w & 0xffffu), wi = bf2f(w >> 16);
            float sn, cs; sincospif((float)((k1 * t1) & 127) / 64.0f, &sn, &cs);
            yr += wr * cs + wi * sn; yi += wi * cs - wr * sn; }
        float sn, cs; sincospif((float)(k1 * t2) / 4096.0f, &sn, &cs);
        const float zr = yr * cs + yi * sn, zi = yi * cs - yr * sn;
        XB[(bc * 64 + (k1 >> 1)) * 128 + (k1 & 1) * 64 + t2] = pk2(zr, zi);
    }
}
#endif
#if !FAST_FFT
__device__ __forceinline__ void ph_fft_b(const Frame& F, const Args& A) {
    const unsigned* XB = WSP(unsigned, WS_XB); unsigned* GB = WSP(unsigned, WS_GB);
    for (long i = F.gtid; i < (long)NB * 512 * 8192; i += F.NT) {
        const int k2 = (int)(i & 63); const long hrow = i >> 6;
        const unsigned* x = XB + hrow * 64; float yr = 0.f, yi = 0.f;
        for (int t2 = 0; t2 < 64; ++t2) { const unsigned w = x[t2]; const float wr = bf2f(w & 0xffffu), wi = bf2f(w >> 16);
            float sn, cs; sincospif((float)((k2 * t2) & 63) / 32.0f, &sn, &cs);
            yr += wr * cs + wi * sn; yi += wi * cs - wr * sn; }
        GB[hrow * 64 + k2] = pk2(yr, yi);
    }
}
#endif
__device__ __forceinline__ void ph_fft_c(const Frame& F, const Args& A) {
    const unsigned* ZP = WSP(unsigned, WS_ZP); float2* GC = WSP(float2, WS_GC);
    LAS unsigned* Z = (LAS unsigned*)F.lds; LAS float* TWc = (LAS float*)(F.lds + 16384); LAS float* TWs = TWc + 256;
    __syncthreads();
    if (F.tid < 256) { const float rev = (float)F.tid * (1.f / 256.f); TWc[F.tid] = __builtin_amdgcn_cosf(rev); TWs[F.tid] = __builtin_amdgcn_sinf(rev); }
    for (int item = F.bid; item < 256; item += F.G) {
        const int b = item >> 7, c0 = ((item >> 2) & 31) * 16, kq = item & 3;
        __syncthreads();
        for (int e = F.tid; e < 4096; e += 512) Z[e] = ZP[((size_t)b * TPB + (e >> 4)) * 512 + c0 + (e & 15)];
        __syncthreads();
        const int cc = F.tid & 15, kb = kq * 64 + (F.tid >> 4) * 2; float ar[2], ai[2]; int m[2];
#pragma unroll
        for (int q = 0; q < 2; ++q) { ar[q] = 0.f; ai[q] = 0.f; m[q] = 0; }
#pragma unroll 4
        for (int t = 0; t < 256; ++t) { const unsigned w = Z[t * 16 + cc]; const float wr = bf2f(w & 0xffffu), wi = bf2f(w >> 16);
#pragma unroll
            for (int q = 0; q < 2; ++q) { const float tc = TWc[m[q]], ts = TWs[m[q]]; ar[q] += wr * tc + wi * ts; ai[q] += wi * tc - wr * ts; m[q] = (m[q] + kb + q) & 255; } }
#pragma unroll
        for (int q = 0; q < 2; ++q) GC[((size_t)b * 512 + c0 + cc) * 256 + kb + q] = make_float2(ar[q], ai[q]);
    }
    __syncthreads();
}
__device__ __forceinline__ void ph_fft_t2(const Frame& F, const Args& A) {
    const unsigned* GB = WSP(unsigned, WS_GB); const float2* GC = WSP(float2, WS_GC); bf16* MX = WSP(bf16, WS_MIXIN);
    for (long i = F.gtid; i < (long)MROWS * 1024; i += F.NT) {
        const int R = (int)(i >> 10), col = (int)(i & 1023), g = col >> 8, jc = col & 255, b = R / TPB, p = R % TPB;
        const bool lat = p >= CTX; const int T = lat ? SEQ : CTX, k = lat ? p - CTX : p, km = (T - k) & (T - 1);
        const int j = (jc == 0 || jc == 128) ? 0 : (jc < 128 ? jc : 256 - jc); const int cc = g * 128 + j;
        float vr, vi, mr, mi;
        if (lat) { const size_t base = ((size_t)b * 512 + cc) * 64;
            const unsigned w = GB[(base + ((k & 127) >> 1)) * 128 + (k & 1) * 64 + (k >> 7)], wm = GB[(base + ((km & 127) >> 1)) * 128 + (km & 1) * 64 + (km >> 7)];
            vr = bf2f(w & 0xffffu); vi = bf2f(w >> 16); mr = bf2f(wm & 0xffffu); mi = bf2f(wm >> 16); }
        else { const float2 w = GC[((size_t)b * 512 + cc) * 256 + k], wm = GC[((size_t)b * 512 + cc) * 256 + km]; vr = w.x; vi = w.y; mr = wm.x; mi = wm.y; }
        float o;
        if (jc == 0) o = 0.5f * (vr + mr); else if (jc == 128) o = 0.5f * (vi + mi); else if (jc < 128) o = mr; else o = vr;
        o *= lat ? 6.9053396600248786e-4f : 3.90625e-3f;
        MX[(size_t)R * 3072 + 2048 + col] = (bf16)f2bf(o);
    }
}

#if !FAST_ATTN
__device__ __forceinline__ void ph_attn_naive(const Frame& F, const Args& A, int l) {
    const bf16 *Kb = WSP(bf16, WS_KB), *Vb = WSP(bf16, WS_VB), *Qb = WSP(bf16, WS_QB); bf16* MX = WSP(bf16, WS_MIXIN);
    const float* lq = A.in[10] + l * 256; float d01 = 0.f, d23 = 0.f;
    for (int i = 0; i < 64; ++i) { d01 += lq[i] * lq[64 + i]; d23 += lq[128 + i] * lq[192 + i]; }
    const float lam_init = 0.8f - 0.6f * expf(-0.3f * (float)l), lam = expf(d01) - expf(d23) + lam_init;
    LAS float* Ks = (LAS float*)F.lds; LAS float* Vs = Ks + 64 * 132; LAS float* Qs = Vs + 64 * 132; LAS float* Ws = Qs + 16 * 128;
    const int r = F.tid >> 5, tl = F.tid & 31;
    for (int u = F.bid; u < 16 * 528; u += F.G) {
        const int bh = u / 528, qb = u % 528, b = bh >> 3, h = bh & 7; const size_t R0 = (size_t)b * TPB + qb * 16; const int nkeys = qb < 16 ? CTX : TPB;
        __syncthreads();
        for (int e = F.tid; e < 2048; e += 512) Qs[e] = bf2f(Qb[(R0 + (e >> 7)) * 1024 + h * 128 + (e & 127)]);
        float m0 = -1e30f, l0 = 0.f, m1 = -1e30f, l1 = 0.f;
        for (int pass = 0; pass < 2; ++pass) {
            float inv0 = 0.f, inv1 = 0.f;
            if (pass == 1) {
#pragma unroll
                for (int o = 1; o < 32; o <<= 1) { float mo = __shfl_xor(m0, o), lo = __shfl_xor(l0, o), mn = fmaxf(m0, mo); l0 = l0 * exp2f(m0 - mn) + lo * exp2f(mo - mn); m0 = mn;
                    mo = __shfl_xor(m1, o); lo = __shfl_xor(l1, o); mn = fmaxf(m1, mo); l1 = l1 * exp2f(m1 - mn) + lo * exp2f(mo - mn); m1 = mn; }
                inv0 = 1.f / l0; inv1 = lam / l1;
            }
            float o4[4] = {0.f, 0.f, 0.f, 0.f};
            for (int kt = 0; kt < nkeys; kt += 64) {
                __syncthreads();
                for (int e = F.tid; e < 1024; e += 512) { const int kk = e >> 4, c8 = (e & 15) * 8; const size_t src = ((size_t)b * TPB + kt + kk) * 1024 + h * 128 + c8;
                    const v4u kv = *(const v4u*)(Kb + src);
                    Ks[kk * 132 + c8 + 0] = bf2f(kv.x & 0xffffu); Ks[kk * 132 + c8 + 1] = bf2f(kv.x >> 16); Ks[kk * 132 + c8 + 2] = bf2f(kv.y & 0xffffu); Ks[kk * 132 + c8 + 3] = bf2f(kv.y >> 16);
                    Ks[kk * 132 + c8 + 4] = bf2f(kv.z & 0xffffu); Ks[kk * 132 + c8 + 5] = bf2f(kv.z >> 16); Ks[kk * 132 + c8 + 6] = bf2f(kv.w & 0xffffu); Ks[kk * 132 + c8 + 7] = bf2f(kv.w >> 16);
                    if (pass == 1) { const v4u vv = *(const v4u*)(Vb + src);
                        Vs[kk * 132 + c8 + 0] = bf2f(vv.x & 0xffffu); Vs[kk * 132 + c8 + 1] = bf2f(vv.x >> 16); Vs[kk * 132 + c8 + 2] = bf2f(vv.y & 0xffffu); Vs[kk * 132 + c8 + 3] = bf2f(vv.y >> 16);
                        Vs[kk * 132 + c8 + 4] = bf2f(vv.z & 0xffffu); Vs[kk * 132 + c8 + 5] = bf2f(vv.z >> 16); Vs[kk * 132 + c8 + 6] = bf2f(vv.w & 0xffffu); Vs[kk * 132 + c8 + 7] = bf2f(vv.w >> 16); } }
                __syncthreads();
#pragma unroll
                for (int kq = 0; kq < 2; ++kq) { const int kk = tl + 32 * kq; float s0 = 0.f, s1 = 0.f;
                    for (int d = 0; d < 64; d += 4) { const f32x4 q0 = *(const LAS f32x4*)(Qs + r * 128 + d), q1 = *(const LAS f32x4*)(Qs + r * 128 + 64 + d), k0 = *(const LAS f32x4*)(Ks + kk * 132 + d), k1 = *(const LAS f32x4*)(Ks + kk * 132 + 64 + d);
                        s0 += q0.x * k0.x + q0.y * k0.y + q0.z * k0.z + q0.w * k0.w; s1 += q1.x * k1.x + q1.y * k1.y + q1.z * k1.z + q1.w * k1.w; }
                    if (pass == 0) { float mn = fmaxf(m0, s0); l0 = l0 * exp2f(m0 - mn) + exp2f(s0 - mn); m0 = mn; mn = fmaxf(m1, s1); l1 = l1 * exp2f(m1 - mn) + exp2f(s1 - mn); m1 = mn; }
                    else Ws[r * 64 + kk] = exp2f(s0 - m0) * inv0 - exp2f(s1 - m1) * inv1; }
                if (pass == 1) { __syncthreads();
                    for (int kk = 0; kk < 64; ++kk) { const float w = Ws[r * 64 + kk];
#pragma unroll
                        for (int i = 0; i < 4; ++i) o4[i] += w * Vs[kk * 132 + tl + 32 * i]; } }
            }
            if (pass == 1) { float ss = o4[0] * o4[0] + o4[1] * o4[1] + o4[2] * o4[2] + o4[3] * o4[3];
#pragma unroll
                for (int o = 1; o < 32; o <<= 1) ss += __shfl_xor(ss, o);
                const float sc = rsqrtf(ss * (1.f / 128.f) + EPS) * (1.f - lam_init);
#pragma unroll
                for (int i = 0; i < 4; ++i) MX[(R0 + r) * 3072 + h * 128 + tl + 32 * i] = (bf16)f2bf(o4[i] * sc * A.in[11][l * 128 + tl + 32 * i]); }
        }
    }
}

#endif
namespace da {
using bf16x8 = __attribute__((ext_vector_type(8))) short;
using s16x4  = __attribute__((ext_vector_type(4))) short;
using f32x16 = __attribute__((ext_vector_type(16))) float;
using u32x4  = __attribute__((ext_vector_type(4))) unsigned;
constexpr int KVBLK = 64, LDK = 1024;
constexpr size_t SHM_V = KVBLK * 128 * 2, SHM_K = KVBLK * 128 * 2;
constexpr float THR = 8.f;
#define DA_KSWZ(row, colB) ((row) * 256 + ((colB) ^ (((row) & 7) << 4)))
#define DA_SBAR() __builtin_amdgcn_sched_barrier(0)
__device__ __forceinline__ int crow(int r, int hi) { return (r & 3) + 8 * (r >> 2) + 4 * hi; }
__device__ __forceinline__ unsigned cvtpk(float lo, float hi) { unsigned r; asm volatile("v_cvt_pk_bf16_f32 %0, %1, %2" : "=v"(r) : "v"(lo), "v"(hi)); return r; }
__device__ __forceinline__ void expSM(f32x16& p0, f32x16& p1, float soff) {
  for (int r = 0; r < 16; ++r) p0[r] = __builtin_amdgcn_exp2f(p0[r] - soff); for (int r = 0; r < 16; ++r) p1[r] = __builtin_amdgcn_exp2f(p1[r] - soff);
}
__device__ __forceinline__ void finishSM(f32x16& p0, f32x16& p1, float& l_reg, bf16x8& pa0, bf16x8& pa1, bf16x8& pa2, bf16x8& pa3) {
  float ps = 0; for (int r = 0; r < 16; ++r) ps += p0[r]; for (int r = 0; r < 16; ++r) ps += p1[r];
  l_reg += ps;
#define DA_PK4(P, BASE, OUT) do { unsigned a0 = cvtpk(P[BASE + 0], P[BASE + 1]), a1 = cvtpk(P[BASE + 2], P[BASE + 3]);   \
    unsigned b0 = cvtpk(P[BASE + 4], P[BASE + 5]), b1 = cvtpk(P[BASE + 6], P[BASE + 7]);                              \
    auto r0 = __builtin_amdgcn_permlane32_swap(a0, b0, false, false); auto r1 = __builtin_amdgcn_permlane32_swap(a1, b1, false, false); \
    u32x4 w = {r0[0], r1[0], r0[1], r1[1]}; OUT = *reinterpret_cast<bf16x8*>(&w); } while (0)
  DA_PK4(p0, 0, pa0); DA_PK4(p0, 8, pa1); DA_PK4(p1, 0, pa2); DA_PK4(p1, 8, pa3);
#undef DA_PK4
}
__device__ __forceinline__ void qkt(f32x16& p0, f32x16& p1, const char* Ks, const bf16x8* qr, int r32, int hi, int cbm) {
  p0 = f32x16{}; p1 = f32x16{};
#pragma unroll
  for (int d0 = 0; d0 < 4; ++d0) { const int cb = cbm + (d0 * 16 + hi * 8) * 2;
    bf16x8 b0 = *reinterpret_cast<const bf16x8*>(Ks + DA_KSWZ(r32, cb));
    bf16x8 b1 = *reinterpret_cast<const bf16x8*>(Ks + DA_KSWZ(32 + r32, cb));
    p0 = __builtin_amdgcn_mfma_f32_32x32x16_bf16(b0, qr[d0], p0, 0, 0, 0);
    p1 = __builtin_amdgcn_mfma_f32_32x32x16_bf16(b1, qr[d0], p1, 0, 0, 0); }
}
__device__ __forceinline__ int v_st(int k, int c) { const int kk = (k & ~0xC) | ((k & 4) << 1) | ((k & 8) >> 1); return ((kk >> 3) * 4 + (c >> 5)) * 512 + ((kk & 7) * 32 + (c & 31)) * 2; }
__device__ __forceinline__ int v_rd_base(int lane) { return ((lane & 3) << 3) | (((lane >> 2) & 3) << 6) | (((lane >> 4) & 1) << 5) | (((lane >> 5) & 1) << 8); }
constexpr int v_rd_off(int d0, int ks, int half) { return d0 * 512 + ks * 4096 + half * 2048; }
template <int OFF> __device__ __forceinline__ s16x4 tr_read(int vb) {
  s16x4 r; asm volatile("ds_read_b64_tr_b16 %0, %1 offset:%2" : "=&v"(r) : "v"(vb), "i"(OFF) : "memory"); return r;
}
template <int D0> __device__ __forceinline__ void pv_one(f32x16& od, int vb, bf16x8 pa0, bf16x8 pa1, bf16x8 pa2, bf16x8 pa3) {
  const s16x4 l0 = tr_read<v_rd_off(D0, 0, 0)>(vb), h0 = tr_read<v_rd_off(D0, 0, 1)>(vb), l1 = tr_read<v_rd_off(D0, 1, 0)>(vb), h1 = tr_read<v_rd_off(D0, 1, 1)>(vb);
  const s16x4 l2 = tr_read<v_rd_off(D0, 2, 0)>(vb), h2 = tr_read<v_rd_off(D0, 2, 1)>(vb), l3 = tr_read<v_rd_off(D0, 3, 0)>(vb), h3 = tr_read<v_rd_off(D0, 3, 1)>(vb);
  asm volatile("s_waitcnt lgkmcnt(0)" ::: "memory"); DA_SBAR();
#define DA_PK(L, H) (bf16x8){L[0], L[1], L[2], L[3], H[0], H[1], H[2], H[3]}
  od = __builtin_amdgcn_mfma_f32_32x32x16_bf16(pa0, DA_PK(l0, h0), od, 0, 0, 0);
  od = __builtin_amdgcn_mfma_f32_32x32x16_bf16(pa1, DA_PK(l1, h1), od, 0, 0, 0);
  od = __builtin_amdgcn_mfma_f32_32x32x16_bf16(pa2, DA_PK(l2, h2), od, 0, 0, 0);
  od = __builtin_amdgcn_mfma_f32_32x32x16_bf16(pa3, DA_PK(l3, h3), od, 0, 0, 0);
#undef DA_PK
}
__device__ __forceinline__ void pv_d0(f32x16* o, int vb, bf16x8 pa0, bf16x8 pa1, bf16x8 pa2, bf16x8 pa3) {
  pv_one<0>(o[0], vb, pa0, pa1, pa2, pa3); pv_one<1>(o[1], vb, pa0, pa1, pa2, pa3); pv_one<2>(o[2], vb, pa0, pa1, pa2, pa3); pv_one<3>(o[3], vb, pa0, pa1, pa2, pa3);
}
__device__ __forceinline__ void unit(const unsigned short* __restrict__ Qb, const unsigned short* __restrict__ Kh, const unsigned short* __restrict__ Vh,
                                     unsigned short* __restrict__ Ob, int ldo, int seq, float lam, float oscale, float soff, const float* __restrict__ subg, char* lds) {
  const int tid = otid(), wid = tid >> 6, lane = tid & 63, r32 = lane & 31, hi = lane >> 5, mp = wid >> 2, wq = wid & 3;
  char* V_lds = lds; char* K_lds = lds + 2 * SHM_V;
  float* ws = (float*)(lds + 2 * SHM_V + 2 * SHM_K) + wid * 64; float* li_l = ws;
  float l_reg = 0; f32x16 o[4] = {}; bf16x8 qr[4];
  const unsigned short* Qw = Qb + (long)(wq * 32 + r32) * 1024 + mp * 64 + hi * 8;
#pragma unroll
  for (int d0 = 0; d0 < 4; ++d0) qr[d0] = *reinterpret_cast<const bf16x8*>(Qw + d0 * 16);
  const int cbm = mp * 128;
  const int sr = tid >> 4, sc = (tid & 15) * 8, vst0 = v_st(sr, sc), vst1 = v_st(32 + sr, sc);
  const int vb0 = (int)(uintptr_t)V_lds + v_rd_base(lane);
  struct { bf16x8 vs0, vs1, ks0, ks1; } sr_[2];
#define DA_SLOAD(i, k0) do { sr_[i].vs0 = *reinterpret_cast<const bf16x8*>(&Vh[(long)((k0) + sr) * LDK + sc]); sr_[i].vs1 = *reinterpret_cast<const bf16x8*>(&Vh[(long)((k0) + 32 + sr) * LDK + sc]); \
    sr_[i].ks0 = *reinterpret_cast<const bf16x8*>(&Kh[(long)((k0) + sr) * LDK + sc]); sr_[i].ks1 = *reinterpret_cast<const bf16x8*>(&Kh[(long)((k0) + 32 + sr) * LDK + sc]); } while (0)
#define DA_SWRITE(b, i) do { *(bf16x8*)(V_lds + (b) * SHM_V + vst0) = sr_[i].vs0;          \
    *(bf16x8*)(V_lds + (b) * SHM_V + vst1) = sr_[i].vs1; int kc = sc * 2;               \
    *(bf16x8*)(K_lds + (b) * SHM_K + DA_KSWZ(sr, kc)) = sr_[i].ks0;                       \
    *(bf16x8*)(K_lds + (b) * SHM_K + DA_KSWZ(32 + sr, kc)) = sr_[i].ks1; } while (0)
#define DA_SWAIT() asm volatile("s_waitcnt vmcnt(4)" ::: "memory")
  f32x16 pA0, pA1, pB0, pB1; bf16x8 pa0, pa1, pa2, pa3; const int NT = seq / KVBLK;
  constexpr int SE = 0, SO = 1;
  DA_SLOAD(SE, 0); asm volatile("s_waitcnt vmcnt(0)" ::: "memory"); DA_SWRITE(0, SE); __syncthreads();
  qkt(pA0, pA1, K_lds, qr, r32, hi, cbm); expSM(pA0, pA1, soff);
  DA_SLOAD(SO, KVBLK); if (2 < NT) DA_SLOAD(SE, 2 * KVBLK);
  DA_SWAIT(); DA_SWRITE(1, SO); __syncthreads();
  for (int j = 1; j + 1 < NT; j += 2) {
    DA_SBAR(); qkt(pB0, pB1, K_lds + SHM_K, qr, r32, hi, cbm);
    finishSM(pA0, pA1, l_reg, pa0, pa1, pa2, pa3); DA_SBAR();
    DA_SLOAD(SO, (j + 2) * KVBLK); DA_SBAR();
    pv_d0(o, vb0, pa0, pa1, pa2, pa3); expSM(pB0, pB1, soff);
    __syncthreads(); DA_SWAIT(); DA_SWRITE(0, SE);
    __syncthreads();
    DA_SBAR(); qkt(pA0, pA1, K_lds, qr, r32, hi, cbm);
    finishSM(pB0, pB1, l_reg, pa0, pa1, pa2, pa3); DA_SBAR();
    if (j + 3 < NT) DA_SLOAD(SE, (j + 3) * KVBLK); DA_SBAR();
    pv_d0(o, vb0 + (int)SHM_V, pa0, pa1, pa2, pa3); expSM(pA0, pA1, soff);
    __syncthreads(); DA_SWAIT(); DA_SWRITE(1, SO);
    __syncthreads();
  }
  DA_SBAR(); qkt(pB0, pB1, K_lds + SHM_K, qr, r32, hi, cbm);
  finishSM(pA0, pA1, l_reg, pa0, pa1, pa2, pa3); DA_SBAR();
  pv_d0(o, vb0, pa0, pa1, pa2, pa3); expSM(pB0, pB1, soff);
  __syncthreads();
  finishSM(pB0, pB1, l_reg, pa0, pa1, pa2, pa3); DA_SBAR();
  pv_d0(o, vb0 + (int)SHM_V, pa0, pa1, pa2, pa3);
  { auto rr = __builtin_amdgcn_permlane32_swap(__float_as_uint(l_reg), __float_as_uint(l_reg), false, false); l_reg = __uint_as_float(rr[0]) + __uint_as_float(rr[1]); }
  if (hi == 0) li_l[r32] = l_reg; asm volatile("s_waitcnt lgkmcnt(0)" ::: "memory");
  const float sgn = mp ? lam : 1.f;
#pragma unroll
  for (int r = 0; r < 16; ++r) { const float rl = sgn * __builtin_amdgcn_rcpf(li_l[crow(r, hi)]);
#pragma unroll
    for (int d0 = 0; d0 < 4; ++d0) o[d0][r] *= rl; }
  __syncthreads();
  int xb = wq * 4096 + lane; asm volatile("" : "+v"(xb));
  float* X = (float*)lds + xb;
  if (mp == 1) {
#pragma unroll
    for (int d0 = 0; d0 < 4; ++d0)
#pragma unroll
      for (int r = 0; r < 16; ++r) X[(d0 * 16 + r) * 64] = o[d0][r];
  }
  __syncthreads();
  if (mp == 0) {
    float gg[4];
#pragma unroll
    for (int d0 = 0; d0 < 4; ++d0) gg[d0] = subg[d0 * 32 + r32] * oscale;
    int ob = (wq * 32 + 4 * hi) * ldo + r32; asm volatile("" : "+v"(ob));
    unsigned short* Ow = Ob + ob;
#pragma unroll
    for (int r = 0; r < 16; ++r) { float a = 0.f; float v[4];
#pragma unroll
      for (int d0 = 0; d0 < 4; ++d0) { v[d0] = o[d0][r] - X[(d0 * 16 + r) * 64]; a += v[d0] * v[d0]; }
      a += sx<1>(a); a += sx<2>(a); a += sx<4>(a); a += sx<8>(a); a += sx<16>(a);
      a = rsqrtf(a * (1.f / 128.f) + EPS);
      const int orow = (r & 3) + 8 * (r >> 2);
#pragma unroll
      for (int d0 = 0; d0 < 4; ++d0) Ow[orow * ldo + d0 * 32] = (unsigned short)f2bf(v[d0] * a * gg[d0]); }
  }
  __syncthreads();
#undef DA_SLOAD
#undef DA_SWRITE
#undef DA_SWAIT
}

template <int D0> __device__ __forceinline__ void v_rd8(s16x4 (&f)[8], int vb) {
  f[0] = tr_read<v_rd_off(D0, 0, 0)>(vb); f[1] = tr_read<v_rd_off(D0, 0, 1)>(vb); f[2] = tr_read<v_rd_off(D0, 1, 0)>(vb); f[3] = tr_read<v_rd_off(D0, 1, 1)>(vb);
  f[4] = tr_read<v_rd_off(D0, 2, 0)>(vb); f[5] = tr_read<v_rd_off(D0, 2, 1)>(vb); f[6] = tr_read<v_rd_off(D0, 3, 0)>(vb); f[7] = tr_read<v_rd_off(D0, 3, 1)>(vb);
}
__device__ __forceinline__ void pv_mm(f32x16& od, const s16x4 (&f)[8], bf16x8 pa0, bf16x8 pa1, bf16x8 pa2, bf16x8 pa3) {
#define DA_PK(L, H) (bf16x8){L[0], L[1], L[2], L[3], H[0], H[1], H[2], H[3]}
  od = __builtin_amdgcn_mfma_f32_32x32x16_bf16(pa0, DA_PK(f[0], f[1]), od, 0, 0, 0);
  od = __builtin_amdgcn_mfma_f32_32x32x16_bf16(pa1, DA_PK(f[2], f[3]), od, 0, 0, 0);
  od = __builtin_amdgcn_mfma_f32_32x32x16_bf16(pa2, DA_PK(f[4], f[5]), od, 0, 0, 0);
  od = __builtin_amdgcn_mfma_f32_32x32x16_bf16(pa3, DA_PK(f[6], f[7]), od, 0, 0, 0);
#undef DA_PK
}
__device__ __forceinline__ void pv_pipe(f32x16* o, int vb, bf16x8 pa0, bf16x8 pa1, bf16x8 pa2, bf16x8 pa3) {
  s16x4 fa[8], fb[8];
  v_rd8<0>(fa, vb); v_rd8<1>(fb, vb);
  asm volatile("s_waitcnt lgkmcnt(8)" ::: "memory"); DA_SBAR(); pv_mm(o[0], fa, pa0, pa1, pa2, pa3); DA_SBAR();
  v_rd8<2>(fa, vb);
  asm volatile("s_waitcnt lgkmcnt(8)" ::: "memory"); DA_SBAR(); pv_mm(o[1], fb, pa0, pa1, pa2, pa3); DA_SBAR();
  v_rd8<3>(fb, vb);
  asm volatile("s_waitcnt lgkmcnt(8)" ::: "memory"); DA_SBAR(); pv_mm(o[2], fa, pa0, pa1, pa2, pa3); DA_SBAR();
  asm volatile("s_waitcnt lgkmcnt(0)" ::: "memory"); DA_SBAR(); pv_mm(o[3], fb, pa0, pa1, pa2, pa3); DA_SBAR();
}
__device__ __forceinline__ void unit8(const unsigned short* __restrict__ Qb, const unsigned short* __restrict__ Kh, const unsigned short* __restrict__ Vh,
                                      unsigned short* __restrict__ Ob, int ldo, int seq, float lam, float oscale, float soff, const float* __restrict__ subg, LAS unsigned char* ldsl) {
  const int tid = otid(), wid = __builtin_amdgcn_readfirstlane(tid >> 6), lane = tid & 63, r32 = lane & 31, hi = lane >> 5, mp = wid >> 2, wq = wid & 3;
  constexpr int SLOT = 16384;
  char* lds = (char*)ldsl; char* K_lds = lds; const int vbase = (int)(uintptr_t)(lds + 3 * SLOT) + v_rd_base(lane);
  float* li_l = (float*)(lds + 6 * SLOT) + wid * 64;
  f32x16 o[4] = {}; bf16x8 qr[4];
  const unsigned short* Qw = Qb + (long)(wq * 32 + r32) * 1024 + mp * 64 + hi * 8;
#pragma unroll
  for (int d0 = 0; d0 < 4; ++d0) qr[d0] = *reinterpret_cast<const bf16x8*>(Qw + d0 * 16);
  asm volatile("s_waitcnt vmcnt(0)" ::: "memory");
  const int cbm = mp * 128;
  const unsigned wl = (unsigned)wid * 1024u;
  unsigned kso[2], vso[2];
#pragma unroll
  for (int i = 0; i < 2; ++i) { const int P = (i * 8 + wid) * 64 + lane;
    { const int row = P >> 4, chunk = (P & 15) ^ (row & 7); kso[i] = (unsigned)(row * LDK + chunk * 8) * 2u; }
    { const int sub = P >> 5, kk = (sub >> 2) * 8 + ((P & 31) >> 2), key = (kk & ~0xC) | ((kk & 4) << 1) | ((kk & 8) >> 1); vso[i] = (unsigned)(key * LDK + (sub & 3) * 32 + (P & 3) * 8) * 2u; } }
#define DA_DMA_K(t, slot) do { const unsigned to_ = (unsigned)(t) * (unsigned)(KVBLK * LDK * 2); _Pragma("unroll") for (int i_ = 0; i_ < 2; ++i_) \
      __builtin_amdgcn_global_load_lds((const unsigned*)((const char*)Kh + (kso[i_] + to_)), (LAS unsigned*)(ldsl + (slot) * SLOT + i_ * 8192 + wl), 16, 0, 0); } while (0)
#define DA_DMA_V(t, slot) do { const unsigned to_ = (unsigned)(t) * (unsigned)(KVBLK * LDK * 2); _Pragma("unroll") for (int i_ = 0; i_ < 2; ++i_) \
      __builtin_amdgcn_global_load_lds((const unsigned*)((const char*)Vh + (vso[i_] + to_)), (LAS unsigned*)(ldsl + (3 + (slot)) * SLOT + i_ * 8192 + wl), 16, 0, 0); } while (0)
#define U8_PK(t, slot, i_) __builtin_amdgcn_global_load_lds((const unsigned*)((const char*)Kh + (kso[i_] + (unsigned)(t) * (unsigned)(KVBLK * LDK * 2))), (LAS unsigned*)(ldsl + (slot) * SLOT + (i_) * 8192 + wl), 16, 0, 0)
#define U8_PV(t, slot, i_) __builtin_amdgcn_global_load_lds((const unsigned*)((const char*)Vh + (vso[i_] + (unsigned)(t) * (unsigned)(KVBLK * LDK * 2))), (LAS unsigned*)(ldsl + (3 + (slot)) * SLOT + (i_) * 8192 + wl), 16, 0, 0)
#define DA_WAITBAR(N) do { asm volatile("s_waitcnt vmcnt(" #N ") lgkmcnt(0)" ::: "memory"); __builtin_amdgcn_s_barrier(); asm volatile("" ::: "memory"); } while (0)
  f32x16 pA0, pA1, pB0, pB1; u32x4 pw0, pw1, pw2, pw3; const int NT = seq / KVBLK;
  bf16x8 kf[8];
  f32x16 negm, ol = {};
#pragma unroll
  for (int r = 0; r < 16; ++r) negm[r] = -soff;
  const bf16x8 ones = {0x3F80, 0x3F80, 0x3F80, 0x3F80, 0x3F80, 0x3F80, 0x3F80, 0x3F80};
  const int pkr = ((r32 & 3) + 4 * (r32 >> 3)), pk = (pkr & 7) + 16 * (pkr >> 3) + 8 * ((r32 >> 2) & 1);
#define U5_KADDR(d0) ((int)(uintptr_t)K_lds + pk * 256 + ((((cbm >> 4) + 2 * (d0) + hi) ^ (pk & 7)) * 16))
#define U5_KLOAD(slot) do { const int so_ = (slot) * SLOT; _Pragma("unroll") for (int d0 = 0; d0 < 4; ++d0) { const int ad_ = U5_KADDR(d0) + so_; \
    asm volatile("ds_read_b128 %0, %2\n\tds_read_b128 %1, %2 offset:8192" : "=&v"(kf[2 * d0]), "=&v"(kf[2 * d0 + 1]) : "v"(ad_) : "memory"); } } while (0)
#define U5_PIN(x) asm volatile("" : "+v"(x))
#define U5_EX(v) __builtin_amdgcn_exp2f(v)
#define U5_VRD(L, H, m) do { asm volatile("ds_read_b64_tr_b16 %0, %1 offset:%2" : "=&v"(L) : "v"(vb_), "i"(v_rd_off((m) >> 2, (m) & 3, 0)) : "memory"); \
    asm volatile("ds_read_b64_tr_b16 %0, %1 offset:%2" : "=&v"(H) : "v"(vb_), "i"(v_rd_off((m) >> 2, (m) & 3, 1)) : "memory"); } while (0)
#define U5_GAPA(MF, X, B4, PW, VR, CV0, CV1) do { MF; VR; CV0; CV1; U5_PIN(PW); DA_SBAR(); } while (0)
#define U5_CVT(P, b) cvtpk(P[b], P[b + 1])
#define U5_PHASE_A(C0, C1, P0, P1, VSLOT, HK0, HK1, HV0, HV1) do { const int vb_ = vbase + (VSLOT) * SLOT; \
    U5_GAPA(C0 = __builtin_amdgcn_mfma_f32_32x32x16_bf16(kf[0], qr[0], negm, 0, 0, 0), P0, 0, pw0, HK0, pw0[0] = U5_CVT(P0, 0), pw0[1] = U5_CVT(P0, 2)); \
    U5_GAPA(C1 = __builtin_amdgcn_mfma_f32_32x32x16_bf16(kf[1], qr[0], negm, 0, 0, 0), P0, 4, pw0, HK1, pw0[2] = U5_CVT(P0, 4), pw0[3] = U5_CVT(P0, 6)); \
    U5_GAPA(C0 = __builtin_amdgcn_mfma_f32_32x32x16_bf16(kf[2], qr[1], C0, 0, 0, 0), P0, 8, pw1, do { HV0; HV1; } while (0), pw1[0] = U5_CVT(P0, 8), pw1[1] = U5_CVT(P0, 10)); \
    U5_GAPA(C1 = __builtin_amdgcn_mfma_f32_32x32x16_bf16(kf[3], qr[1], C1, 0, 0, 0), P0, 12, pw1, U5_VRD(vl0, vh0, 0), pw1[2] = U5_CVT(P0, 12), pw1[3] = U5_CVT(P0, 14)); \
    U5_GAPA(C0 = __builtin_amdgcn_mfma_f32_32x32x16_bf16(kf[4], qr[2], C0, 0, 0, 0), P1, 0, pw2, U5_VRD(vl1, vh1, 1), pw2[0] = U5_CVT(P1, 0), pw2[1] = U5_CVT(P1, 2)); \
    U5_GAPA(C1 = __builtin_amdgcn_mfma_f32_32x32x16_bf16(kf[5], qr[2], C1, 0, 0, 0), P1, 4, pw2, U5_VRD(vl2, vh2, 2), pw2[2] = U5_CVT(P1, 4), pw2[3] = U5_CVT(P1, 6)); \
    U5_GAPA(C0 = __builtin_amdgcn_mfma_f32_32x32x16_bf16(kf[6], qr[3], C0, 0, 0, 0), P1, 8, pw3, U5_VRD(vl3, vh3, 3), pw3[0] = U5_CVT(P1, 8), pw3[1] = U5_CVT(P1, 10)); \
    U5_GAPA(C1 = __builtin_amdgcn_mfma_f32_32x32x16_bf16(kf[7], qr[3], C1, 0, 0, 0), P1, 12, pw3, U5_VRD(vl4, vh4, 4), pw3[2] = U5_CVT(P1, 12), pw3[3] = U5_CVT(P1, 14)); \
    } while (0)
#define U5_PKV(L, H) (bf16x8){L[0], L[1], L[2], L[3], H[0], H[1], H[2], H[3]}
#define U5_PAF(k) __builtin_bit_cast(bf16x8, pw##k)
#define U5_GAPB(WAITN, OD, PK, L, H, X, B2, NEXT) do { asm volatile("s_waitcnt lgkmcnt(" #WAITN ")" ::: "memory"); DA_SBAR(); \
    OD = __builtin_amdgcn_mfma_f32_32x32x16_bf16(PK, U5_PKV(L, H), OD, 0, 0, 0); NEXT; X[B2] = U5_EX(X[B2]); X[B2 + 1] = U5_EX(X[B2 + 1]); U5_PIN(X); DA_SBAR(); } while (0)
#define U5_GAPS(PK, X, B2) do { ol = __builtin_amdgcn_mfma_f32_32x32x16_bf16(PK, ones, ol, 0, 0, 0); X[B2] = U5_EX(X[B2]); X[B2 + 1] = U5_EX(X[B2 + 1]); U5_PIN(X); DA_SBAR(); } while (0)
#define U5_GAPN(WAITN, OD, PK, L, H, NEXT) do { asm volatile("s_waitcnt lgkmcnt(" #WAITN ")" ::: "memory"); DA_SBAR(); \
    OD = __builtin_amdgcn_mfma_f32_32x32x16_bf16(PK, U5_PKV(L, H), OD, 0, 0, 0); NEXT; DA_SBAR(); } while (0)
#define U5_PHASE_B(C0, C1, VSLOT, KSLOT, DOK) do { const int vb_ = vbase + (VSLOT) * SLOT; \
    U5_GAPS(U5_PAF(0), C0, 0); U5_GAPS(U5_PAF(1), C0, 2); U5_GAPS(U5_PAF(2), C0, 4); U5_GAPS(U5_PAF(3), C0, 6); \
    U5_GAPB(8, o[0], U5_PAF(0), vl0, vh0, C0, 8, U5_VRD(vl5, vh5, 5)); \
    U5_GAPB(8, o[0], U5_PAF(1), vl1, vh1, C0, 10, U5_VRD(vl0, vh0, 6)); \
    U5_GAPB(8, o[0], U5_PAF(2), vl2, vh2, C0, 12, U5_VRD(vl1, vh1, 7)); \
    U5_GAPB(8, o[0], U5_PAF(3), vl3, vh3, C0, 14, U5_VRD(vl2, vh2, 8)); \
    U5_GAPB(8, o[1], U5_PAF(0), vl4, vh4, C1, 0, U5_VRD(vl3, vh3, 9)); \
    U5_GAPB(8, o[1], U5_PAF(1), vl5, vh5, C1, 2, U5_VRD(vl4, vh4, 10)); \
    U5_GAPB(8, o[1], U5_PAF(2), vl0, vh0, C1, 4, U5_VRD(vl5, vh5, 11)); \
    U5_GAPB(8, o[1], U5_PAF(3), vl1, vh1, C1, 6, U5_VRD(vl0, vh0, 12)); \
    U5_GAPB(8, o[2], U5_PAF(0), vl2, vh2, C1, 8, U5_VRD(vl1, vh1, 13)); \
    U5_GAPB(8, o[2], U5_PAF(1), vl3, vh3, C1, 10, U5_VRD(vl2, vh2, 14)); \
    U5_GAPB(8, o[2], U5_PAF(2), vl4, vh4, C1, 12, U5_VRD(vl3, vh3, 15)); \
    U5_GAPB(8, o[2], U5_PAF(3), vl5, vh5, C1, 14, (void)0); \
    U5_GAPN(6, o[3], U5_PAF(0), vl0, vh0, (void)0); \
    if (DOK) { U5_GAPN(4, o[3], U5_PAF(1), vl1, vh1, U5_KLOAD(KSLOT)); U5_GAPN(10, o[3], U5_PAF(2), vl2, vh2, (void)0); U5_GAPN(8, o[3], U5_PAF(3), vl3, vh3, (void)0); } \
    else { U5_GAPN(4, o[3], U5_PAF(1), vl1, vh1, (void)0); U5_GAPN(2, o[3], U5_PAF(2), vl2, vh2, (void)0); U5_GAPN(0, o[3], U5_PAF(3), vl3, vh3, (void)0); } } while (0)
#define DA_ROT(x) ((x) == 2 ? 0 : (x) + 1)
#define DA_PRV(x) ((x) == 0 ? 2 : (x) - 1)
  s16x4 vl0, vh0, vl1, vh1, vl2, vh2, vl3, vh3, vl4, vh4, vl5, vh5;
  DA_DMA_K(0, 0); DA_DMA_K(1, 1); DA_DMA_V(0, 0);
  DA_WAITBAR(0);
  U5_KLOAD(0); DA_DMA_K(2, 2); DA_DMA_V(1, 1);
  DA_WAITBAR(4);
  DA_DMA_K(3, 0);
  DA_SBAR();
  pA0 = negm; pA1 = negm;
#pragma unroll
  for (int d0 = 0; d0 < 4; ++d0) { pA0 = __builtin_amdgcn_mfma_f32_32x32x16_bf16(kf[2 * d0], qr[d0], pA0, 0, 0, 0); pA1 = __builtin_amdgcn_mfma_f32_32x32x16_bf16(kf[2 * d0 + 1], qr[d0], pA1, 0, 0, 0); }
  DA_SBAR(); U5_KLOAD(1);
  expSM(pA0, pA1, 0.f);
  DA_WAITBAR(2);
  int c = 1;
  for (int j = 1; j + 1 < NT; j += 2) {
    { const bool mk = j + 3 < NT;
      DA_SBAR(); U5_PHASE_A(pB0, pB1, pA0, pA1, DA_PRV(c), if (mk) U8_PK(j + 3, c, 0), if (mk) U8_PK(j + 3, c, 1), U8_PV(j + 1, DA_ROT(c), 0), U8_PV(j + 1, DA_ROT(c), 1));
      U5_PHASE_B(pB0, pB1, DA_PRV(c), DA_ROT(c), true);
      if (mk) DA_WAITBAR(4); else DA_WAITBAR(2);
      c = DA_ROT(c); }
    { const bool mk = j + 4 < NT;
      DA_SBAR(); U5_PHASE_A(pA0, pA1, pB0, pB1, DA_PRV(c), if (mk) U8_PK(j + 4, c, 0), if (mk) U8_PK(j + 4, c, 1), U8_PV(j + 2, DA_ROT(c), 0), U8_PV(j + 2, DA_ROT(c), 1));
      U5_PHASE_B(pA0, pA1, DA_PRV(c), DA_ROT(c), true);
      if (mk) DA_WAITBAR(4); else DA_WAITBAR(2);
      c = DA_ROT(c); }
  }
  DA_SBAR(); U5_PHASE_A(pB0, pB1, pA0, pA1, DA_PRV(c), (void)0, (void)0, (void)0, (void)0);
  U5_PHASE_B(pB0, pB1, DA_PRV(c), 0, false);
  DA_WAITBAR(0);
  { u32x4 w0 = {cvtpk(pB0[0], pB0[1]), cvtpk(pB0[2], pB0[3]), cvtpk(pB0[4], pB0[5]), cvtpk(pB0[6], pB0[7])}, w1 = {cvtpk(pB0[8], pB0[9]), cvtpk(pB0[10], pB0[11]), cvtpk(pB0[12], pB0[13]), cvtpk(pB0[14], pB0[15])};
    u32x4 w2 = {cvtpk(pB1[0], pB1[1]), cvtpk(pB1[2], pB1[3]), cvtpk(pB1[4], pB1[5]), cvtpk(pB1[6], pB1[7])}, w3 = {cvtpk(pB1[8], pB1[9]), cvtpk(pB1[10], pB1[11]), cvtpk(pB1[12], pB1[13]), cvtpk(pB1[14], pB1[15])};
    const bf16x8 pa0 = __builtin_bit_cast(bf16x8, w0), pa1 = __builtin_bit_cast(bf16x8, w1), pa2 = __builtin_bit_cast(bf16x8, w2), pa3 = __builtin_bit_cast(bf16x8, w3); DA_SBAR();
    ol = __builtin_amdgcn_mfma_f32_32x32x16_bf16(pa0, ones, ol, 0, 0, 0); ol = __builtin_amdgcn_mfma_f32_32x32x16_bf16(pa1, ones, ol, 0, 0, 0);
    ol = __builtin_amdgcn_mfma_f32_32x32x16_bf16(pa2, ones, ol, 0, 0, 0); ol = __builtin_amdgcn_mfma_f32_32x32x16_bf16(pa3, ones, ol, 0, 0, 0);
    pv_d0(o, vbase + c * SLOT, pa0, pa1, pa2, pa3); }
#undef U5_KADDR
#undef U5_KLOAD
#undef U5_PIN
#undef U5_EX
#undef U5_GAPA
#undef U5_CVT
#undef U5_PHASE_A
#undef U5_VRD
#undef U5_PKV
#undef U5_PAF
#undef U5_GAPB
#undef U5_GAPS
#undef U5_GAPN
#undef U5_PHASE_B
  const int tid2 = otid(), wid2 = __builtin_amdgcn_readfirstlane(tid2 >> 6), lane2 = tid2 & 63; { const int r32 = lane2 & 31, hi = lane2 >> 5, mp = wid2 >> 2, wq = wid2 & 3, lane = lane2; float* li_l = (float*)(lds + 6 * SLOT) + wid2 * 64;
  const float sgn = mp ? lam : 1.f;
#pragma unroll
  for (int r = 0; r < 16; ++r) { const float rl = sgn * __builtin_amdgcn_rcpf(ol[r]);
#pragma unroll
    for (int d0 = 0; d0 < 4; ++d0) o[d0][r] *= rl; }
  __syncthreads();
  int xb = wq * 4096 + lane; asm volatile("" : "+v"(xb));
  float* X = (float*)lds + xb;
  if (mp == 1) {
#pragma unroll
    for (int d0 = 0; d0 < 4; ++d0)
#pragma unroll
      for (int r = 0; r < 16; ++r) X[(d0 * 16 + r) * 64] = o[d0][r];
  }
  __syncthreads();
  if (mp == 0) {
    float gg[4];
#pragma unroll
    for (int d0 = 0; d0 < 4; ++d0) gg[d0] = subg[d0 * 32 + r32] * oscale;
    int ob = (wq * 32 + 4 * hi) * ldo + r32; asm volatile("" : "+v"(ob));
    unsigned short* Ow = Ob + ob;
#pragma unroll
    for (int r = 0; r < 16; ++r) { float a = 0.f; float v[4];
#pragma unroll
      for (int d0 = 0; d0 < 4; ++d0) { v[d0] = o[d0][r] - X[(d0 * 16 + r) * 64]; a += v[d0] * v[d0]; }
      a += sx<1>(a); a += sx<2>(a); a += sx<4>(a); a += sx<8>(a); a += sx<16>(a);
      a = rsqrtf(a * (1.f / 128.f) + EPS);
      const int orow = (r & 3) + 8 * (r >> 2);
#pragma unroll
      for (int d0 = 0; d0 < 4; ++d0) Ow[orow * ldo + d0 * 32] = (unsigned short)f2bf(v[d0] * a * gg[d0]); }
  }
  }
  asm volatile("s_waitcnt vmcnt(0)" ::: "memory");
  __syncthreads();
#undef DA_DMA_K
#undef DA_DMA_V
#undef DA_WAITBAR
#undef DA_ROT
#undef DA_PRV
}
}
__device__ __forceinline__ void ph_attn(const Frame& F, const Args& A, int l) {
    const bf16 *Kb = WSP(bf16, WS_KB), *Vb = WSP(bf16, WS_VB), *Qb = WSP(bf16, WS_QB); bf16* MX = WSP(bf16, WS_MIXIN);
    const float* lq = A.in[10] + l * 256; float d01 = 0.f, d23 = 0.f;
    for (int i = 0; i < 64; ++i) { d01 += lq[i] * lq[64 + i]; d23 += lq[128 + i] * lq[192 + i]; }
    const float lam_init = 0.8f - 0.6f * expf(-0.3f * (float)l); float lam = expf(d01) - expf(d23) + lam_init;
    float mq = 0.f, mk = 0.f;
    for (int i = 0; i < 64; ++i) { mq = fmaxf(mq, fabsf(A.in[8][l * 64 + i])); mk = fmaxf(mk, fabsf(A.in[9][l * 64 + i])); }
    const float soff = __uint_as_float(__builtin_amdgcn_readfirstlane(__float_as_uint(64.f * mq * mk * QSCALE)));
    lam = __uint_as_float(__builtin_amdgcn_readfirstlane(__float_as_uint(lam))); const float osc = __uint_as_float(__builtin_amdgcn_readfirstlane(__float_as_uint(1.f - lam_init)));
    const int vcu = (F.G % 8 == 0) ? (F.bid % 8) * (F.G / 8) + F.bid / 8 : F.bid;
    for (int u = vcu; u < (l == DEPTH - 1 ? 1024 : 16 * 66); u += F.G) {
        const int bh = (u % 1024) / 64 , b = bh >> 3, h = bh & 7;
        int qb; int bb = b, hh = h;
        if (u < 1024) qb = 2 + (u & 63); else { const int v = u - 1024; bb = v >> 4; hh = (v >> 1) & 7; qb = v & 1; }
        const size_t R0 = (size_t)bb * TPB + qb * 128; const int seq = qb < 2 ? CTX : TPB;
#if ATTN_V2 == 8
        da::unit8(Qb + R0 * 1024 + hh * 128, Kb + (size_t)bb * TPB * 1024 + hh * 128, Vb + (size_t)bb * TPB * 1024 + hh * 128,
                  MX + R0 * 3072 + hh * 128, 3072, seq, lam, osc, soff, A.in[11] + l * 128, F.lds);
#else
        da::unit(Qb + R0 * 1024 + hh * 128, Kb + (size_t)bb * TPB * 1024 + hh * 128, Vb + (size_t)bb * TPB * 1024 + hh * 128,
                 MX + R0 * 3072 + hh * 128, 3072, seq, lam, osc, soff, A.in[11] + l * 128, (char*)F.lds);
#endif
    }
}

__device__ __forceinline__ void ph_mix(const Frame& F, const Args& A) {
    const float *PA = WSP(float, WS_PA), *PR = WSP(float, WS_PR), *PF = WSP(float, WS_PF); const bf16* GT = WSP(bf16, WS_GATES); bf16* MD = WSP(bf16, WS_MIXED);
    for (long i = F.gtid; i < (long)MROWS * 1024; i += F.NT) { const size_t R = (size_t)(i >> 10); const int c = (int)(i & 1023);
        MD[i] = (bf16)f2bf(bf2f(GT[R * 3072 + c]) * PA[i] + bf2f(GT[R * 3072 + 1024 + c]) * PR[i] + bf2f(GT[R * 3072 + 2048 + c]) * PF[i]); }
}
__device__ __forceinline__ void ph_resid_norm2(const Frame& F, const Args& A, int l) {
    float* X = WSP(float, WS_XALL); const float* Y1 = WSP(float, WS_Y1); bf16* TOK = WSP(bf16, WS_TOK);
    for (int R = F.gw; R < MROWS; R += F.NGW) {
        const int b = R / TPB, p = R % TPB, s = (p < CTX) ? 2 : b; const float* g1 = MODP(l, s, 2);
        f32x4 v[4];
#pragma unroll
        for (int j = 0; j < 4; ++j) { const int c = 4 * F.lane + 256 * j; const f32x4 x = *(const f32x4*)(X + (size_t)R * 1024 + c), y = *(const f32x4*)(Y1 + (size_t)R * 1024 + c), gg = *(const f32x4*)(g1 + c);
            v[j] = x + gg * y; *(f32x4*)(X + (size_t)R * 1024 + c) = v[j]; }
        norm_mod_row(v, A.in[23] + l * 1024, MODP(l, s, 4), MODP(l, s, 3), TOK + (size_t)R * 1024, F.lane);
    }
}
#define G1(T) __attribute__((address_space(1))) T
template <int CTRL, int RM = 0xf> __device__ __forceinline__ float dpp_f(float v) {
    return __uint_as_float(__builtin_amdgcn_update_dpp(__float_as_uint(v), __float_as_uint(v), CTRL, RM, 0xf, false)); }
__device__ __forceinline__ float wave_max63(float v) {
    asm volatile("s_nop 1\n\tv_max_f32_dpp %0, %0, %0 row_ror:1 row_mask:0xf bank_mask:0xf\n\ts_nop 1\n\tv_max_f32_dpp %0, %0, %0 row_ror:2 row_mask:0xf bank_mask:0xf\n\t"
                 "s_nop 1\n\tv_max_f32_dpp %0, %0, %0 row_ror:4 row_mask:0xf bank_mask:0xf\n\ts_nop 1\n\tv_max_f32_dpp %0, %0, %0 row_ror:8 row_mask:0xf bank_mask:0xf\n\t"
                 "s_nop 1\n\tv_max_f32_dpp %0, %0, %0 row_bcast:15 row_mask:0xa bank_mask:0xf\n\ts_nop 1\n\tv_max_f32_dpp %0, %0, %0 row_bcast:31 row_mask:0xc bank_mask:0xf\n\ts_nop 1" : "+v"(v));
    return v; }
template <bool DRY = false> __device__ __forceinline__ void ph_topk(const Frame& F, const Args& A, int l) {
    const float* LG = WSP(float, WS_LOG);
    int* LIST = DRY ? WSP(int, WS_PR) : WSP(int, WS_LIST); float* TOPW = DRY ? WSP(float, WS_PR + 18 * MiB) : WSP(float, WS_TOPW); int* EPO = DRY ? WSP(int, WS_PR + 19 * MiB) : WSP(int, WS_EP);
    int* CNT = (int*)(A.ws + WS_CTL) + CW_CNT + (DRY ? 2 : l) * 256 * CNT_STRIDE;
    const float NEG = -__builtin_inff();
    const bool skipctx = l == DEPTH - 1;
    const f32x4 rb4 = *(const G1(f32x4)*)(A.in[25] + l * 256 + 4 * F.lane);
    constexpr int SLOTS = 9;
    for (int base = F.gw; base < MROWS; base += SLOTS * F.NGW) {
        f32x4 lg[SLOTS]; int es[SLOTS], ps[SLOTS]; float wt[SLOTS];
#pragma unroll
        for (int i = 0; i < SLOTS; ++i) { const int R = base + i * F.NGW; lg[i] = f32x4{0.f, 0.f, 0.f, 0.f}; es[i] = 0; ps[i] = 0; wt[i] = 0.f;
            if (R < MROWS && !(skipctx && (R % TPB) < CTX)) lg[i] = *(const G1(f32x4)*)(LG + (size_t)R * 256 + 4 * F.lane); }
#pragma unroll
        for (int i = 0; i < SLOTS; ++i) { const int R = base + i * F.NGW;
            if (R < MROWS && !(skipctx && (R % TPB) < CTX)) {
                const float sc[4] = {sigmoidf_(lg[i].x), sigmoidf_(lg[i].y), sigmoidf_(lg[i].z), sigmoidf_(lg[i].w)};
                const float bi[4] = {sc[0] + rb4.x, sc[1] + rb4.y, sc[2] + rb4.z, sc[3] + rb4.w};
                float t1 = fmaxf(bi[0], bi[1]), t2 = fminf(bi[0], bi[1]);
                { const float u1 = fmaxf(bi[2], bi[3]), u2 = fminf(bi[2], bi[3]); const float n1 = fmaxf(t1, u1), n2 = fmaxf(fminf(t1, u1), fmaxf(t2, u2)); t1 = n1; t2 = n2; }
#define TK_M2(C) { const float o1 = dpp_f<C>(t1), o2 = dpp_f<C>(t2); const float n1 = fmaxf(t1, o1), n2 = fmaxf(fminf(t1, o1), fmaxf(t2, o2)); t1 = n1; t2 = n2; }
                TK_M2(0xB1) TK_M2(0x4E) TK_M2(0x141)
#undef TK_M2
                const float gs = t1 + t2; const int mygrp = F.lane >> 3; int rank = 0;
#pragma unroll
                for (int j = 0; j < 8; ++j) { const float sj = __uint_as_float(__builtin_amdgcn_readlane(__float_as_uint(gs), j * 8)); rank += (int)(sj > gs) | ((int)(sj == gs) & (int)(j < mygrp)); }
                const bool sel = rank < 4;
                float cand[4];
#pragma unroll
                for (int q = 0; q < 4; ++q) cand[q] = sel ? bi[q] : NEG;
                int my_e = 0; float my_s = 0.f, ssum = 0.f;
#pragma unroll
                for (int k = 0; k < 8; ++k) {
                    float bv = cand[0], bs = sc[0]; int bq = 0;
#pragma unroll
                    for (int q = 1; q < 4; ++q) { const bool g = cand[q] > bv; bv = g ? cand[q] : bv; bs = g ? sc[q] : bs; bq = g ? q : bq; }
                    const float mx = __uint_as_float(__builtin_amdgcn_readlane(__float_as_uint(wave_max63(bv)), 63));
                    const int ol = (int)__builtin_ctzll(__ballot(bv == mx));
                    const int oq = __builtin_amdgcn_readlane(bq, ol); const float sv = __uint_as_float(__builtin_amdgcn_readlane(__float_as_uint(bs), ol));
                    const bool me = F.lane == ol;
#pragma unroll
                    for (int q = 0; q < 4; ++q) cand[q] = (me & (oq == q)) ? NEG : cand[q];
                    ssum += sv;
                    { const int ev = 4 * ol + oq; asm volatile("v_writelane_b32 %0, %1, %2" : "+v"(my_e) : "s"(ev), "n"(k)); asm volatile("v_writelane_b32 %0, %1, %2" : "+v"(my_s) : "s"(sv), "n"(k)); }
                }
                es[i] = my_e; wt[i] = my_s * __builtin_amdgcn_rcpf(ssum) * 2.5f;
            } }
#pragma unroll
        for (int i = 0; i < SLOTS; ++i) { const int R = base + i * F.NGW;
            if (R < MROWS && !(skipctx && (R % TPB) < CTX) && F.lane < 8) ps[i] = __hip_atomic_fetch_add((G1(int)*)(CNT + es[i] * CNT_STRIDE), 1, __ATOMIC_RELAXED, __HIP_MEMORY_SCOPE_AGENT); }
#pragma unroll
        for (int i = 0; i < SLOTS; ++i) { const int R = base + i * F.NGW;
            if (R < MROWS && !(skipctx && (R % TPB) < CTX) && F.lane < 8) {
                *(G1(int)*)(LIST + (size_t)es[i] * LCAP + ps[i]) = R * 8 + F.lane; *(G1(float)*)(TOPW + (size_t)R * 8 + F.lane) = wt[i]; *(G1(int)*)(EPO + (size_t)R * 8 + F.lane) = es[i] * LCAP + ps[i]; } }
    }
}
__device__ __forceinline__ void ph_experts_naive(const Frame& F, const Args& A, int l) {
    const bf16* TOK = WSP(bf16, WS_TOK); const int* LIST = WSP(int, WS_LIST); const float* TOPW = WSP(float, WS_TOPW); float* YB = WSP(float, WS_YB);
    const int* CNT = (const int*)(A.ws + WS_CTL) + CW_CNT + l * 256 * CNT_STRIDE;
    LAS bf16* Xs = (LAS bf16*)F.lds;
    LAS float* Hs = (LAS float*)(F.lds + 65536);
    LAS int* pref = (LAS int*)(F.lds + 98304);
    LAS int* sPair = pref + 320; LAS float* sW = (LAS float*)(sPair + 32);
    __syncthreads();
    if (F.tid == 0) { int s = 0; for (int e = 0; e < 256; ++e) { pref[e] = s; s += (CNT[e] + 31) >> 5; } pref[256] = s; }
    __syncthreads();
    const int total = pref[256];
    for (int id = F.bid; id < total; id += F.G) {
        int lo = 0, hi = 255; while (lo < hi) { const int mid = (lo + hi + 1) >> 1; if (pref[mid] <= id) lo = mid; else hi = mid - 1; }
        const int e = lo, c = id - pref[e], n = min(32, CNT[e] - c * 32);
        __syncthreads();
        if (F.tid < 32) { const int pr = F.tid < n ? LIST[(size_t)e * LCAP + c * 32 + F.tid] : -1; sPair[F.tid] = pr; sW[F.tid] = pr >= 0 ? TOPW[pr] : 0.f; }
        __syncthreads();
        for (int pc = F.tid; pc < 4096; pc += 512) { const int row = pc >> 7, c8 = (pc & 127) * 8, pr = sPair[row];
            v4u v = {0u, 0u, 0u, 0u}; if (pr >= 0) v = *(const v4u*)(TOK + (size_t)(pr >> 3) * 1024 + c8);
            *(LAS v4u*)(Xs + row * 1024 + c8) = v; }
        __syncthreads();
        { const int f = F.tid & 255, gu = F.tid >> 8; const float* W = (gu ? A.in[27] : A.in[26]) + ((size_t)(l * 256 + e) * 1024) * 256 + f;
          float acc[32];
#pragma unroll
          for (int r = 0; r < 32; ++r) acc[r] = 0.f;
          for (int k = 0; k < 1024; ++k) { const float w = W[(size_t)k * 256];
#pragma unroll
              for (int r = 0; r < 32; ++r) acc[r] += bf2f(Xs[r * 1024 + k]) * w; }
          if (gu == 0) {
#pragma unroll
              for (int r = 0; r < 32; ++r) Hs[r * 256 + f] = siluf_(acc[r]); }
          __syncthreads();
          if (gu == 1) {
#pragma unroll
              for (int r = 0; r < 32; ++r) Hs[r * 256 + f] *= acc[r]; }
          __syncthreads(); }
        { const float* Wd = A.in[28] + ((size_t)(l * 256 + e) * 256) * 1024 + F.tid;
          float a0[32], a1[32];
#pragma unroll
          for (int r = 0; r < 32; ++r) { a0[r] = 0.f; a1[r] = 0.f; }
          for (int k = 0; k < 256; ++k) { const float w0 = Wd[(size_t)k * 1024], w1 = Wd[(size_t)k * 1024 + 512];
#pragma unroll
              for (int r = 0; r < 32; ++r) { const float hv = Hs[r * 256 + k]; a0[r] += hv * w0; a1[r] += hv * w1; } }
#pragma unroll
          for (int r = 0; r < 32; ++r) { const int pr = sPair[r]; if (pr >= 0) { const float w = sW[r]; YB[(size_t)pr * 1024 + F.tid] = a0[r] * w; YB[(size_t)pr * 1024 + 512 + F.tid] = a1[r] * w; } } }
    }
}
struct TrItem { const float* W; bf16* WT; int ldw, k0, n0, ldwt, rowbase; };
__device__ __forceinline__ void tr_load(const TrItem& t, f32x4 (&v)[8], int lane) {
    const int rr = lane >> 3, c4 = (lane & 7) * 4;
#pragma unroll
    for (int i = 0; i < 8; ++i) v[i] = __builtin_nontemporal_load((const f32x4*)(t.W + (size_t)(t.k0 + 8 * i + rr) * t.ldw + t.n0 + c4));
}
__device__ __forceinline__ void tr_load_a(const TrItem& t, f32x4 (&v)[8], int lane) {
    const int rr = lane >> 3, c4 = (lane & 7) * 4;
#pragma unroll
    for (int i = 0; i < 8; ++i) { const float* p = t.W + (size_t)(t.k0 + 8 * i + rr) * t.ldw + t.n0 + c4; asm volatile("global_load_dwordx4 %0, %1, off nt" : "=v"(v[i]) : "v"(p) : "memory"); }
}
__device__ __forceinline__ void tr_store(const TrItem& t, const f32x4 (&v)[8], LAS float* scr, int lane) {
    const int rr = lane >> 3, c4 = (lane & 7) * 4;
#pragma unroll
    for (int i = 0; i < 8; ++i) { LAS float* d = scr + (8 * i + rr) * 33 + c4; d[0] = v[i].x; d[1] = v[i].y; d[2] = v[i].z; d[3] = v[i].w; }
    LDS_WAIT(); asm volatile("" ::: "memory");
    const int c = lane & 7;
#pragma unroll
    for (int j = 0; j < 4; ++j) { const int n = (lane >> 3) + 8 * j; const LAS float* sp = scr + (8 * c) * 33 + n;
        v4u o; o.x = pk2(sp[0 * 33], sp[1 * 33]); o.y = pk2(sp[2 * 33], sp[3 * 33]); o.z = pk2(sp[4 * 33], sp[5 * 33]); o.w = pk2(sp[6 * 33], sp[7 * 33]);
        __builtin_nontemporal_store(o, (v4u*)(t.WT + (size_t)(t.rowbase + n) * t.ldwt + t.k0 + 8 * c)); }
    LDS_WAIT(); asm volatile("" ::: "memory");
}
__device__ __forceinline__ TrItem expert_item(const Args& A, int l, int it) {
    const int e = it / 384, r = it % 384; bf16* E1 = (bf16*)(A.ws + EWL(l) + (size_t)e * EW_STRIDE); TrItem t;
    if (r < 256) { const int up = r >> 7, q = r & 127, kb = q >> 3, nb = q & 7, n0 = 32 * nb;
        t.W = (up ? A.in[27] : A.in[26]) + ((size_t)(l * 256 + e) * 1024) * 256; t.ldw = 256; t.k0 = 64 * kb; t.n0 = n0; t.WT = E1; t.ldwt = 1024; t.rowbase = (n0 >> 7) * 256 + up * 128 + (n0 & 127); }
    else { const int q = r - 256, kb = q >> 5, nb = q & 31;
        t.W = A.in[28] + ((size_t)(l * 256 + e) * 256) * 1024; t.ldw = 1024; t.k0 = 64 * kb; t.n0 = 32 * nb; t.WT = E1 + 512 * 1024; t.ldwt = 256; t.rowbase = 32 * nb; }
    return t;
}
__device__ __forceinline__ void ph_expert_w_idx(const Frame& F, const Args& A, int l, int lo, int hi, int ci, int nblk) {
    if (ci < 0 || ci >= nblk) return;
    LAS float* scr = (LAS float*)(F.lds + F.wave * 16384);
    const int stride = nblk * NWAVES; int it = lo + ci * NWAVES + F.wave; if (it >= hi) return;
    f32x4 va[8], vb[8], vc[8]; TrItem ta = expert_item(A, l, it), tb = ta, tc = ta;
    tr_load_a(ta, va, F.lane);
    if (it + stride < hi) { tb = expert_item(A, l, it + stride); tr_load_a(tb, vb, F.lane); }
#define EW_STEP(TP, VP, TS, VS) { if (it + 2 * stride < hi) { TP = expert_item(A, l, it + 2 * stride); tr_load_a(TP, VP, F.lane); asm volatile("s_waitcnt vmcnt(16)" ::: "memory"); } \
        else asm volatile("s_waitcnt vmcnt(0)" ::: "memory"); \
        tr_store(TS, VS, scr, F.lane); it += stride; if (it >= hi) break; }
    for (;;) {
        EW_STEP(tc, vc, ta, va)
        EW_STEP(ta, va, tb, vb)
        EW_STEP(tb, vb, tc, vc)
    }
#undef EW_STEP
}
__device__ __forceinline__ void ph_expert_w(const Frame& F, const Args& A, int l, int lo, int hi, int blk0, int nblk) { ph_expert_w_idx(F, A, l, lo, hi, F.bid - blk0, nblk); }
constexpr int EWI_N = 256 * 384, EWI_A = 9800, EWI_B = 20800, EWI_C = 75000, EWI_D = 90000;
constexpr int KCONV_WIN = 18, KCONV_LRU = 44, KCONV_D = 124;
constexpr int KCONV_RS = 58, Q13 = 12, Q15 = 72, Q16 = 48;
__device__ __forceinline__ int moe_geff(int units, int G) { if (units <= 0) return G; const int rounds = (units + G - 1) / G; return (units + rounds - 1) / rounds; }
constexpr int MOE_MAXU = 11;
struct MoeSched {
    const LAS int* pref; const LAS int* cnt; const int* list; const char* abase; const char* bbase; int npn, G, c, lda2; size_t b_pn_stride; bool gather; LAS int* idx;
    __device__ __forceinline__ bool next(int i, pg8::UnitG& U) const {
        const long id = (long)i * G + c; const int total = pref[256]; if (id >= (long)total * npn) return false;
        const int tau = (int)(id / npn), pn = (int)(id % npn);
        int lo = 0, hi = 255; while (lo < hi) { const int mid = (lo + hi + 1) >> 1; if (pref[mid] <= tau) lo = mid; else hi = mid - 1; }
        const int e = lo, t = tau - pref[e];
        U.e = e; U.pn = pn; U.valid = min(256, cnt[e] - t * 256); U.rows = list + (size_t)e * LCAP + t * 256; U.row0 = tau * 256; U.lrows = idx ? idx + (i % MOE_MAXU) * 256 : nullptr;
        U.a = gather ? abase : abase + (size_t)tau * 256 * lda2; U.b = bbase + (size_t)e * EW_STRIDE + (size_t)pn * b_pn_stride; return true;
    }
};
__device__ __forceinline__ void moe_prefix(const Frame& F, const int* CNT, LAS int* pref) {
    LAS int* tmp = pref + 320;
    __syncthreads();
    if (F.tid < 256) tmp[F.tid] = CNT[F.tid * CNT_STRIDE];
    __syncthreads();
    if (F.tid <= 256) { int sum = 0; for (int e = 0; e < F.tid; ++e) sum += (tmp[e] + 255) >> 8; pref[F.tid] = sum; }
    __syncthreads();
}
struct EpiSwiGLU {
    static constexpr bool PERM = true;
    bf16* HB;
    __device__ __forceinline__ void operator()(const f32x4 (&acc)[2][2][4][2], const pg8::UnitG& u, int wr, int wc, int fr, int fq) const {
#pragma unroll
        for (int ai = 0; ai < 2; ++ai)
#pragma unroll
            for (int m = 0; m < 4; ++m) { const int r = ai * 128 + wr * 64 + m * 16 + fr;
                const f32x4 g0 = acc[ai][0][m][0], g1 = acc[ai][0][m][1], u0 = acc[ai][1][m][0], u1 = acc[ai][1][m][1];
                v4u w; w.x = pk2(siluf_(g0[0]) * u0[0], siluf_(g0[1]) * u0[1]); w.y = pk2(siluf_(g0[2]) * u0[2], siluf_(g0[3]) * u0[3]);
                w.z = pk2(siluf_(g1[0]) * u1[0], siluf_(g1[1]) * u1[1]); w.w = pk2(siluf_(g1[2]) * u1[2], siluf_(g1[3]) * u1[3]);
                *(v4u*)(HB + (size_t)(u.row0 + r) * 256 + u.pn * 128 + wc * 32 + 8 * fq) = w; }
    }
};
struct EpiScatter {
    static constexpr bool PERM = true;
    bf16* Y;
    __device__ __forceinline__ void operator()(const f32x4 (&acc)[2][2][4][2], const pg8::UnitG& u, int wr, int wc, int fr, int fq) const {
#pragma unroll
        for (int ai = 0; ai < 2; ++ai)
#pragma unroll
            for (int m = 0; m < 4; ++m) { const int r = ai * 128 + wr * 64 + m * 16 + fr;
                if (r < u.valid) { bf16* dst = Y + (size_t)(u.row0 + r) * 1024 + u.pn * 256 + wc * 32 + 8 * fq;
#pragma unroll
                    for (int bj = 0; bj < 2; ++bj) { const f32x4 v0 = acc[ai][bj][m][0], v1 = acc[ai][bj][m][1];
                        v4u o; o.x = pk2(v0[0], v0[1]); o.y = pk2(v0[2], v0[3]); o.z = pk2(v1[0], v1[1]); o.w = pk2(v1[2], v1[3]);
                        *(v4u*)(dst + bj * 128) = o; } } }
    }
};
__device__ __forceinline__ int conv_base(const Frame& F, const Args& A, int l) {
    if (l == 0) return 0;
    const int* CNT = (const int*)(A.ws + WS_CTL) + CW_CNT + (l - 1) * 256 * CNT_STRIDE; LAS int* pref = (LAS int*)(F.lds + RING_BYTES + 1024);
    moe_prefix(F, CNT, pref);
    const int tiles = pref[256], k15 = F.G - moe_geff(2 * tiles, F.G), k16 = F.G - moe_geff(4 * tiles, F.G);
    int base = KCONV_RS * NWAVES * Q13 + k15 * NWAVES * Q15 + k16 * NWAVES * Q16;
    __syncthreads();
    return base < EWI_N ? base : EWI_N;
}
__device__ __forceinline__ void ph_experts_up(const Frame& F, const Args& A, int l) {
    const int* CNT = (const int*)(A.ws + WS_CTL) + CW_CNT + l * 256 * CNT_STRIDE; LAS int* pref = (LAS int*)(F.lds + RING_BYTES + 1024);
    moe_prefix(F, CNT, pref);
    const int vcu = (F.G % 8 == 0) ? (F.bid % 8) * (F.G / 8) + F.bid / 8 : F.bid;
    const bool early = l + 1 < DEPTH; const int tiles = pref[256], Ge = early ? moe_geff(2 * tiles, F.G) : F.G;
    if (vcu < Ge) {
        LAS int* idx = (LAS int*)(F.lds + RING_BYTES + 4608);
        MoeSched S{pref, pref + 320, WSP(int, WS_LIST), (const char*)WSP(bf16, WS_TOK), (const char*)(A.ws + EWL(l)), 2, Ge, vcu, 2048, (size_t)256 * 1024 * 2, true, idx};
        { int vals[MOE_MAXU];
#pragma unroll
          for (int i = 0; i < MOE_MAXU; ++i) { pg8::UnitG U; vals[i] = 0; if (S.next(i, U) && F.tid < 256) vals[i] = *(const G1(int)*)(U.rows + min(F.tid, U.valid - 1)); }
#pragma unroll
          for (int i = 0; i < MOE_MAXU; ++i) if (F.tid < 256) idx[i * 256 + F.tid] = vals[i]; }
        __syncthreads();
        EpiSwiGLU E{WSP(bf16, WS_HB)};
        pg8::gemm_phase_g<EpiSwiGLU, MoeSched, true>(F.lds, 1024, 1024, 1024, S, E);
    } else { const int k = F.G - Ge, lo = KCONV_RS * NWAVES * Q13; ph_expert_w_idx(F, A, l + 1, lo, min(EWI_N, lo + k * NWAVES * Q15), vcu - Ge, k); }
    __syncthreads();
}
__device__ __forceinline__ void ph_experts_down(const Frame& F, const Args& A, int l) {
    const int* CNT = (const int*)(A.ws + WS_CTL) + CW_CNT + l * 256 * CNT_STRIDE; LAS int* pref = (LAS int*)(F.lds + RING_BYTES + 1024);
    moe_prefix(F, CNT, pref);
    const int vcu = (F.G % 8 == 0) ? (F.bid % 8) * (F.G / 8) + F.bid / 8 : F.bid;
    const bool early = l + 1 < DEPTH; const int tiles = pref[256], Ge = early ? moe_geff(4 * tiles, F.G) : F.G;
    if (vcu < Ge) {
        MoeSched S{pref, pref + 320, WSP(int, WS_LIST), (const char*)WSP(bf16, WS_HB), (const char*)(A.ws + EWL(l) + 512 * 1024 * 2), 4, Ge, vcu, 512, (size_t)256 * 256 * 2, false, nullptr};
        EpiScatter E{WSP(bf16, WS_Y16)};
        pg8::gemm_phase_g<EpiScatter, MoeSched, false>(F.lds, 256, 256, 256, S, E);
    } else { const int k = F.G - Ge, k15 = F.G - moe_geff(2 * tiles, F.G), lo = KCONV_RS * NWAVES * Q13 + k15 * NWAVES * Q15;
        ph_expert_w_idx(F, A, l + 1, min(EWI_N, lo), min(EWI_N, lo + k * NWAVES * Q16), vcu - Ge, k); }
}
template <bool DRY = false> __device__ __forceinline__ void ph_combine(const Frame& F, const Args& A, int l) {
    const float* X = WSP(float, WS_XALL); float* XO = DRY ? WSP(float, WS_U + 492 * MiB) : WSP(float, WS_XALL); bf16* HO = DRY ? WSP(bf16, WS_U + 558 * MiB) : WSP(bf16, WS_H); const bf16* SD = WSP(bf16, WS_SD); const bf16* YS = WSP(bf16, WS_Y16); const int* EP = WSP(int, WS_EP); const float* TOPW = WSP(float, WS_TOPW);
    const int* CNT = (const int*)(A.ws + WS_CTL) + CW_CNT + l * 256 * CNT_STRIDE; LAS int* pref = (LAS int*)(F.lds + RING_BYTES + 1024);
    moe_prefix(F, CNT, pref);
    for (int R = F.gw; R < MROWS; R += F.NGW) {
        const int b = R / TPB, p = R % TPB, s = (p < CTX) ? 2 : b; const float* g2 = MODP(l, s, 5);
        if (l == DEPTH - 1 && p < CTX) continue;
        size_t so[8]; float wk[8];
#pragma unroll
        for (int k = 0; k < 8; ++k) { const int ep = EP[(size_t)R * 8 + k], e = ep / LCAP, pos = ep - e * LCAP; so[k] = ((size_t)pref[e] * 256 + pos) * 1024; wk[k] = TOPW[(size_t)R * 8 + k]; }
        v4u yv[2][8], sd[2]; f32x4 xin[2][2];
#pragma unroll
        for (int j = 0; j < 2; ++j) { const int c = 8 * F.lane + 512 * j;
#pragma unroll
            for (int k = 0; k < 8; ++k) yv[j][k] = *(const v4u*)(YS + so[k] + c);
            sd[j] = *(const v4u*)(SD + (size_t)R * 1024 + c);
            xin[j][0] = *(const f32x4*)(X + (size_t)R * 1024 + c); xin[j][1] = *(const f32x4*)(X + (size_t)R * 1024 + c + 4); }
        float xo[2][8]; float ss = 0.f;
#pragma unroll
        for (int j = 0; j < 2; ++j) { const int c = 8 * F.lane + 512 * j; float f[8] = {bf2f(sd[j].x & 0xffffu), bf2f(sd[j].x >> 16), bf2f(sd[j].y & 0xffffu), bf2f(sd[j].y >> 16), bf2f(sd[j].z & 0xffffu), bf2f(sd[j].z >> 16), bf2f(sd[j].w & 0xffffu), bf2f(sd[j].w >> 16)};
#pragma unroll
            for (int k = 0; k < 8; ++k) { const unsigned ws[4] = {yv[j][k].x, yv[j][k].y, yv[j][k].z, yv[j][k].w};
#pragma unroll
                for (int q = 0; q < 4; ++q) { f[2 * q] += wk[k] * bf2f(ws[q] & 0xffffu); f[2 * q + 1] += wk[k] * bf2f(ws[q] >> 16); } }
            const f32x4 ga = *(const f32x4*)(g2 + c), gb = *(const f32x4*)(g2 + c + 4);
            const f32x4 xa = xin[j][0] + ga * (f32x4){f[0], f[1], f[2], f[3]}, xb = xin[j][1] + gb * (f32x4){f[4], f[5], f[6], f[7]};
            if (l + 1 < DEPTH || DRY) { *(f32x4*)(XO + (size_t)R * 1024 + c) = xa; *(f32x4*)(XO + (size_t)R * 1024 + c + 4) = xb; }
            if (l == DEPTH - 1 && !DRY) { *(f32x4*)(A.out + ((size_t)b * SEQ + (p - CTX)) * 1024 + c) = xa; *(f32x4*)(A.out + ((size_t)b * SEQ + (p - CTX)) * 1024 + c + 4) = xb; }
            xo[j][0] = xa.x; xo[j][1] = xa.y; xo[j][2] = xa.z; xo[j][3] = xa.w; xo[j][4] = xb.x; xo[j][5] = xb.y; xo[j][6] = xb.z; xo[j][7] = xb.w;
#pragma unroll
            for (int e = 0; e < 8; ++e) ss += xo[j][e] * xo[j][e]; }
        if (l + 1 < DEPTH || DRY) {
            const int ln = DRY ? 0 : l + 1; const float rs = rsqrtf(wave_sum(ss) * (1.f / 1024.f) + EPS);
            const float* gn = A.in[6] + ln * 1024; const float* sc1 = MODP(ln, s, 1); const float* sh1 = MODP(ln, s, 0);
#pragma unroll
            for (int j = 0; j < 2; ++j) { const int c = 8 * F.lane + 512 * j; float y[8];
#pragma unroll
                for (int h = 0; h < 2; ++h) { const f32x4 gg = *(const f32x4*)(gn + c + 4 * h), s1 = *(const f32x4*)(sc1 + c + 4 * h), s0 = *(const f32x4*)(sh1 + c + 4 * h);
                    y[4 * h] = xo[j][4 * h] * rs * gg.x * (1.f + s1.x) + s0.x; y[4 * h + 1] = xo[j][4 * h + 1] * rs * gg.y * (1.f + s1.y) + s0.y;
                    y[4 * h + 2] = xo[j][4 * h + 2] * rs * gg.z * (1.f + s1.z) + s0.z; y[4 * h + 3] = xo[j][4 * h + 3] * rs * gg.w * (1.f + s1.w) + s0.w; }
                v4u o; o.x = pk2(y[0], y[1]); o.y = pk2(y[2], y[3]); o.z = pk2(y[4], y[5]); o.w = pk2(y[6], y[7]);
                *(v4u*)(HO + (size_t)R * 1024 + c) = o; } }
    }
}

struct EpiWin {
    static constexpr bool PERM = true; static constexpr int MIDK = 0;
    bf16 *Kb, *Vb, *Qb, *LXb, *GLG, *ZP, *GT; const float* qg; const float* kg;
    __device__ __forceinline__ void operator()(const f32x4 (&acc)[2][2][4][2], const pg8::Unit& u, int wr, int wc, int fr, int fq) const {
        const int pn = u.pn, sec = pn >> 2;
        if (sec == 0 || sec == 3) {
            const bool isq = sec == 3; const bool lat = (u.pm % 33) != 0;
            bf16* dst = (isq ? Qb : Kb) + (pn & 3) * 256 + wc * 64 + 4 * fq; const float* gn = isq ? qg : kg; const float gs = isq ? QSCALE : 1.f;
            f32x4 g[2][2]; float invf[4];
#pragma unroll
            for (int bj = 0; bj < 2; ++bj)
#pragma unroll
                for (int n = 0; n < 2; ++n) g[bj][n] = *(const f32x4*)(gn + 32 * bj + 16 * n + 4 * fq) * gs;
#pragma unroll
            for (int e = 0; e < 4; ++e) invf[e] = exp2f(-(float)(4 * fq + e) * (13.287712379549449f / 16.f)) * 0.15915494309189535f;
#pragma unroll
            for (int ai = 0; ai < 2; ++ai)
#pragma unroll
                for (int m = 0; m < 4; ++m) { const int R = u.pm * 256 + ai * 128 + wr * 64 + m * 16 + fr, t = (R % TPB) - CTX;
                    float ss = 0.f;
#pragma unroll
                    for (int bj = 0; bj < 2; ++bj)
#pragma unroll
                        for (int n = 0; n < 2; ++n) { const f32x4 v = acc[ai][bj][m][n]; ss += (v[0] * v[0] + v[1] * v[1]) + (v[2] * v[2] + v[3] * v[3]); }
                    ss += sx<16>(ss); ss += sx<32>(ss);
                    const float rs = rsqrtf(ss * (1.f / 64.f) + EPS);
#pragma unroll
                    for (int bj = 0; bj < 2; ++bj) { const float pos = (float)(bj ? (t & 63) : (t >> 6));
                        const f32x4 y1 = acc[ai][bj][m][0] * rs * g[bj][0], y2 = acc[ai][bj][m][1] * rs * g[bj][1]; f32x4 o1 = y1, o2 = y2;
                        if (lat) {
#pragma unroll
                            for (int e = 0; e < 4; ++e) { const float rev = pos * invf[e]; const float cs = __builtin_amdgcn_cosf(rev), sn = __builtin_amdgcn_sinf(rev);
                                o1[e] = y1[e] * cs - y2[e] * sn; o2[e] = y1[e] * sn + y2[e] * cs; } }
                        bf16* p = dst + (size_t)R * 1024 + 32 * bj;
                        *(unsigned long long*)p = (unsigned long long)pk2(o1[0], o1[1]) | ((unsigned long long)pk2(o1[2], o1[3]) << 32);
                        *(unsigned long long*)(p + 16) = (unsigned long long)pk2(o2[0], o2[1]) | ((unsigned long long)pk2(o2[2], o2[3]) << 32); }
                    asm volatile("" ::: "memory"); }
        } else {
            bf16* base; int ld = 1024, act = 0;
            if (sec == 1) base = Vb + (pn & 3) * 256; else if (sec == 2) base = LXb + (pn & 3) * 256; else if (sec == 4) { base = GLG + (pn & 3) * 256; act = 1; }
            else if (sec == 5) base = ZP + (pn & 3) * 256; else { base = GT + (pn - 24) * 256; ld = 3072; act = 2; }
            base += wc * 32 + 8 * fq;
#pragma unroll
            for (int ai = 0; ai < 2; ++ai)
#pragma unroll
                for (int m = 0; m < 4; ++m) { bf16* rowp = base + (size_t)(u.pm * 256 + ai * 128 + wr * 64 + m * 16 + fr) * ld;
#pragma unroll
                    for (int bj = 0; bj < 2; ++bj) { f32x4 v0 = acc[ai][bj][m][0], v1 = acc[ai][bj][m][1];
                        if (act == 1) {
#pragma unroll
                            for (int e = 0; e < 4; ++e) { v0[e] = gelu_tanh(v0[e]); v1[e] = gelu_tanh(v1[e]); } }
                        else if (act == 2) {
#pragma unroll
                            for (int e = 0; e < 4; ++e) { v0[e] = sigmoidf_(v0[e]); v1[e] = sigmoidf_(v1[e]); } }
                        v4u o; o.x = pk2(v0[0], v0[1]); o.y = pk2(v0[2], v0[3]); o.z = pk2(v1[0], v1[1]); o.w = pk2(v1[2], v1[3]);
                        *(v4u*)(rowp + bj * 128) = o; } }
        }
    }
};

struct EpiMix {
    static constexpr bool PERM = true; static constexpr int MIDK = 16;
    const bf16* GT; bf16* MD;
    __device__ __forceinline__ void mid(f32x4 (&acc)[2][2][4][2], const pg8::Unit& u, int wr, int wc, int fr, int fq, int seg) const {
        const bf16* gb = GT + (size_t)(u.pm * 256 + wr * 64 + fr) * 3072 + (seg - 1) * 1024 + u.pn * 256 + wc * 32 + 8 * fq;
#pragma unroll
        for (int ai = 0; ai < 2; ++ai)
#pragma unroll
            for (int m = 0; m < 4; ++m)
#pragma unroll
                for (int bj = 0; bj < 2; ++bj) { const bf16* p = gb + (size_t)(ai * 128 + m * 16) * 3072 + bj * 128;
                    const v4u a = *(const v4u*)p, b = *(const v4u*)(p + 1024);
                    const unsigned aw[4] = {a.x, a.y, a.z, a.w}, bw[4] = {b.x, b.y, b.z, b.w};
#pragma unroll
                    for (int q = 0; q < 4; ++q) { const float r0 = bf2f(aw[q] & 0xffffu) * __builtin_amdgcn_rcpf(fmaxf(bf2f(bw[q] & 0xffffu), 1e-30f)), r1 = bf2f(aw[q] >> 16) * __builtin_amdgcn_rcpf(fmaxf(bf2f(bw[q] >> 16), 1e-30f));
                        acc[ai][bj][m][q >> 1][(q & 1) * 2] *= r0; acc[ai][bj][m][q >> 1][(q & 1) * 2 + 1] *= r1; } }
    }
    __device__ __forceinline__ void operator()(const f32x4 (&acc)[2][2][4][2], const pg8::Unit& u, int wr, int wc, int fr, int fq) const {
        const size_t r0 = (size_t)(u.pm * 256 + wr * 64 + fr); const int c0 = u.pn * 256 + wc * 32 + 8 * fq;
#pragma unroll
        for (int ai = 0; ai < 2; ++ai)
#pragma unroll
            for (int m = 0; m < 4; ++m)
#pragma unroll
                for (int bj = 0; bj < 2; ++bj) { const size_t R = r0 + ai * 128 + m * 16; const v4u gv = *(const v4u*)(GT + R * 3072 + 2048 + c0 + bj * 128);
                    const f32x4 v0 = acc[ai][bj][m][0], v1 = acc[ai][bj][m][1]; v4u o;
                    o.x = pk2(v0[0] * bf2f(gv.x & 0xffffu), v0[1] * bf2f(gv.x >> 16)); o.y = pk2(v0[2] * bf2f(gv.y & 0xffffu), v0[3] * bf2f(gv.y >> 16));
                    o.z = pk2(v1[0] * bf2f(gv.z & 0xffffu), v1[1] * bf2f(gv.z >> 16)); o.w = pk2(v1[2] * bf2f(gv.w & 0xffffu), v1[3] * bf2f(gv.w >> 16));
                    *(v4u*)(MD + R * 1024 + c0 + bj * 128) = o; }
    }
};
struct EpiResid {
    static constexpr bool PERM = false; static constexpr int MIDK = 0;
    float* X; const float* mod;
    const float* Xin; const float* Cin;
    __device__ __forceinline__ void operator()(const f32x4 (&acc)[2][2][4][2], const pg8::Unit& u, int wr, int wc, int fr, int fq) const {
        const int src = (u.pm % 33 == 0) ? 2 : u.pm / 33; const float* g1 = mod + src * 6144 + 2 * 1024;
        const float* sbase = Xin ? ((u.pm % 33 == 0) ? Cin + (size_t)(u.pm / 33) * CTX * 1024 : Xin + ((size_t)(u.pm / 33) * SEQ + (size_t)(u.pm % 33 - 1) * 256) * 1024) : X + (size_t)u.pm * 256 * 1024;
        const int col0 = u.pn * 256 + wc * 32 + 4 * fq;
        f32x4 gv[2][2];
#pragma unroll
        for (int bj = 0; bj < 2; ++bj)
#pragma unroll
            for (int n = 0; n < 2; ++n) gv[bj][n] = *(const f32x4*)(g1 + col0 + bj * 128 + n * 16);
#pragma unroll
        for (int ai = 0; ai < 2; ++ai)
#pragma unroll
            for (int m = 0; m < 4; ++m) { const size_t ro = (size_t)(ai * 128 + wr * 64 + m * 16 + fr) * 1024 + col0; float* rowp = X + (size_t)u.pm * 256 * 1024 + ro; const float* srow = sbase + ro;
#pragma unroll
                for (int bj = 0; bj < 2; ++bj)
#pragma unroll
                    for (int n = 0; n < 2; ++n) { *(f32x4*)(rowp + bj * 128 + n * 16) = *(const f32x4*)(srow + bj * 128 + n * 16) + gv[bj][n] * acc[ai][bj][m][n]; } }
    }
};
struct EpiRS {
    static constexpr bool PERM = true; static constexpr int MIDK = 0;
    float* LG; bf16* SH;
    __device__ __forceinline__ void operator()(const f32x4 (&acc)[2][2][4][2], const pg8::Unit& u, int wr, int wc, int fr, int fq) const {
#pragma unroll
        for (int ai = 0; ai < 2; ++ai)
#pragma unroll
            for (int m = 0; m < 4; ++m) { const size_t R = (size_t)u.pm * 256 + ai * 128 + wr * 64 + m * 16 + fr;
                if (u.pn == 0) {
#pragma unroll
                    for (int bj = 0; bj < 2; ++bj) { float* p = LG + R * 256 + bj * 128 + wc * 32 + 8 * fq; *(f32x4*)p = acc[ai][bj][m][0]; *(f32x4*)(p + 4) = acc[ai][bj][m][1]; } }
                else { const f32x4 g0 = acc[ai][0][m][0], g1 = acc[ai][0][m][1], u0 = acc[ai][1][m][0], u1 = acc[ai][1][m][1];
                    v4u w; w.x = pk2(siluf_(g0[0]) * u0[0], siluf_(g0[1]) * u0[1]); w.y = pk2(siluf_(g0[2]) * u0[2], siluf_(g0[3]) * u0[3]);
                    w.z = pk2(siluf_(g1[0]) * u1[0], siluf_(g1[1]) * u1[1]); w.w = pk2(siluf_(g1[2]) * u1[2], siluf_(g1[3]) * u1[3]);
                    *(v4u*)(SH + R * 256 + (u.pn - 1) * 128 + wc * 32 + 8 * fq) = w; } }
    }
};
__device__ __forceinline__ void ph_norm2(const Frame& F, const Args& A, int l) {
    const float* X = WSP(float, WS_XALL); bf16* TOK = WSP(bf16, WS_TOK);
    for (int R = F.gw; R < MROWS; R += F.NGW) {
        const int b = R / TPB, p = R % TPB, s = (p < CTX) ? 2 : b;
        if (l == DEPTH - 1 && p < CTX) continue;
        f32x4 v[4];
#pragma unroll
        for (int j = 0; j < 4; ++j) v[j] = *(const f32x4*)(X + (size_t)R * 1024 + 4 * F.lane + 256 * j);
        norm_mod_row(v, A.in[23] + l * 1024, MODP(l, s, 4), MODP(l, s, 3), TOK + (size_t)R * 1024, F.lane);
    }
}

constexpr int PH_PER_L = 18, N_PHASES = 1 + DEPTH * PH_PER_L;
template <int P, bool DRY = false> __device__ __forceinline__ void run_phase(const Frame& F, const Args& A, int l) {
    if constexpr (P == -1) ph_prologue(F, A);
    if constexpr (P == 0) ph_norm1(F, A, l);
#if !FAST_WIN
#error oracle w_in path removed
#endif
    if constexpr (P == 1) { const int Ge = F.G - KCONV_WIN; const int cb = conv_base(F, A, l);
        if (F.bid < Ge) { pg8::Gemm g{WSP(bf16, WS_H), WLP(l, WO_WIN), MROWS, INW, 1024, 1024, 1024}; pg8::StaticOrder S; S.init(MROWS, INW, Ge, F.bid);
            EpiWin E{WSP(bf16, WS_KB), WSP(bf16, WS_VB), WSP(bf16, WS_QB), WSP(bf16, WS_LXB), WSP(bf16, WS_GLG), WSP(bf16, WS_ZP), WSP(bf16, WS_GATES), A.in[8] + l * 64, A.in[9] + l * 64};
            pg8::gemm_phase(F.lds, g, S, E); }
        else ph_expert_w(F, A, l, min(EWI_N, cb), min(EWI_N, cb + EWI_A), Ge, KCONV_WIN); }
    if constexpr (P == 3) { ph_conv(F, A, l); ph_fft_t1_fast(F, A);
        { const int cb = conv_base(F, A, l); ph_expert_w(F, A, l, min(EWI_N, cb + (l == 0 ? EWI_D : EWI_B)), EWI_N, 0, F.G); } }
    if constexpr (P == 4) {
        { const int cb = conv_base(F, A, l);
          if (F.bid < F.G - KCONV_LRU) ph_lru_gemm(F, A, l, F.G - KCONV_LRU); else ph_expert_w(F, A, l, min(EWI_N, cb + EWI_A), min(EWI_N, cb + EWI_B), F.G - KCONV_LRU, KCONV_LRU); }
        __syncthreads();
#if FAST_FFT_A
        ph_fft_a_gemm(F, A);
#else
        ph_fft_a(F, A);
#endif
        if (l + 1 < DEPTH || DRY) ph_fft_c(F, A);
    }
    if constexpr (P == 5) {
        ph_scan1(F, A);
#if FAST_FFT_B
        ph_fft_b_gemm(F, A);
#else
        ph_fft_b(F, A);
#endif
    }
    if constexpr (P == 6) { ph_scan2_fast(F, A); ph_fft_t2_fast(F, A, l); }
    if constexpr (P == 7) { ph_scan3(F, A, l);
#if FAST_ATTN
        ph_attn(F, A, l);
#endif
    }
    if constexpr (P == 8) {
#if !FAST_ATTN
        ph_attn_naive(F, A, l);
#endif
        __syncthreads(); }
#if FAST_MIX
    if constexpr (P == 9) { const bool sp = (l == 0) && F.G > 2 * KCONV_D; const int Ge = sp ? F.G - KCONV_D : F.G;
        if (F.bid < Ge) { pg8::Gemm g{WSP(bf16, WS_MIXIN), WLP(l, WO_D1), MROWS, 1024, 3072, 3072, 3072}; pg8::StaticOrder S; S.init(MROWS, 1024, Ge, F.bid, l == DEPTH - 1);
            EpiMix E{WSP(bf16, WS_GATES), WSP(bf16, WS_MIXED)}; pg8::gemm_phase(F.lds, g, S, E); }
        else ph_expert_w(F, A, l, EWI_B, EWI_C, Ge, KCONV_D); }
    if constexpr (P == 11) { const bool sp = (l == 0) && F.G > 2 * KCONV_D; const int Ge = sp ? F.G - KCONV_D : F.G;
        if (F.bid < Ge) { pg8::Gemm g{WSP(bf16, WS_MIXED), WLP(l, WO_OUT), MROWS, 1024, 1024, 1024, 1024}; pg8::StaticOrder S; S.init(MROWS, 1024, Ge, F.bid, l == DEPTH - 1);
            EpiResid E{WSP(float, WS_XALL), (const float*)(A.ws + WS_CTL) + CW_MOD + l * 3 * 6144, l == 0 ? A.in[0] : nullptr, l == 0 ? A.in[2] : nullptr}; pg8::gemm_phase(F.lds, g, S, E); }
        else ph_expert_w(F, A, l, EWI_C, EWI_D, Ge, KCONV_D); }
    if constexpr (P == 12) ph_norm2(F, A, l);
#else
    if constexpr (P == 9) {
        { pg8::Gemm g{WSP(bf16, WS_MIXIN), WLP(l, WO_D1), MROWS, 1024, 1024, 3072, 3072}; pg8::StaticOrder S; S.init(MROWS, 1024, F.G, F.bid); pg8::EpiF32 E{WSP(float, WS_PA), 1024}; pg8::gemm_phase(F.lds, g, S, E); }
        { pg8::Gemm g{WSP(bf16, WS_MIXIN) + 1024, WLP(l, WO_D1) + 1024, MROWS, 1024, 1024, 3072, 3072}; pg8::StaticOrder S; S.init(MROWS, 1024, F.G, F.bid); pg8::EpiF32 E{WSP(float, WS_PR), 1024}; pg8::gemm_phase(F.lds, g, S, E); }
        { pg8::Gemm g{WSP(bf16, WS_MIXIN) + 2048, WLP(l, WO_D1) + 2048, MROWS, 1024, 1024, 3072, 3072}; pg8::StaticOrder S; S.init(MROWS, 1024, F.G, F.bid); pg8::EpiF32 E{WSP(float, WS_PF), 1024}; pg8::gemm_phase(F.lds, g, S, E); } }
    if constexpr (P == 10) ph_mix(F, A);
    if constexpr (P == 11) { pg8::Gemm g{WSP(bf16, WS_MIXED), WLP(l, WO_OUT), MROWS, 1024, 1024, 1024, 1024}; pg8::StaticOrder S; S.init(MROWS, 1024, F.G, F.bid);
        pg8::EpiF32 E{WSP(float, WS_Y1), 1024}; pg8::gemm_phase(F.lds, g, S, E); }
    if constexpr (P == 12) ph_resid_norm2(F, A, l);
#endif
    if constexpr (P == 13) { const bool early = l + 1 < DEPTH; const int Ge = early ? F.G - KCONV_RS : F.G;
        if (F.bid < Ge) { pg8::Gemm g{WSP(bf16, WS_TOK), WLP(l, WO_R), MROWS, 768, 1024, 1024, 1024}; pg8::StaticOrder S; S.init(MROWS, 768, Ge, F.bid, l == DEPTH - 1);
            EpiRS E{WSP(float, WS_LOG), WSP(bf16, WS_SH)}; pg8::gemm_phase(F.lds, g, S, E); }
        else ph_expert_w(F, A, l + 1, 0, KCONV_RS * NWAVES * Q13, Ge, KCONV_RS); }
    if constexpr (P == 14) ph_topk<DRY>(F, A, l);
    if constexpr (P == 15) {
#if FAST_MOE
        ph_experts_up(F, A, l);
#else
        ph_experts_naive(F, A, l); __syncthreads();
#endif

        { pg8::Gemm g{WSP(bf16, WS_SH), WLP(l, WO_SD), MROWS, 1024, 256, 256, 256}; pg8::StaticOrder S; S.init(MROWS, 1024, F.G, F.bid, l == DEPTH - 1); EpiBf16U E{WSP(bf16, WS_SD), 1024}; pg8::gemm_phase(F.lds, g, S, E); } }
    if constexpr (P == 16) {
#if FAST_MOE
        ph_experts_down(F, A, l);
#endif
    }
    if constexpr (P == 17) ph_combine<DRY>(F, A, l);
}
__device__ __forceinline__ Frame make_frame(unsigned char* lds) {
    Frame F; F.lds = (LAS unsigned char*)lds; F.tid = otid(); F.lane = F.tid & 63; F.wave = __builtin_amdgcn_readfirstlane(F.tid >> 6);
    F.bid = obid(); F.G = ogrid(); F.gw = F.bid * NWAVES + F.wave; F.NGW = F.G * NWAVES; F.gtid = (long)F.bid * 512 + F.tid; F.NT = (long)F.G * 512;
    return F;
}
template <int P> __global__ void __launch_bounds__(NWAVES * 64, 2) mk_phase(Args A) {
    extern __shared__ __attribute__((aligned(16))) unsigned char lds[];
    const Frame F = make_frame(lds);
    run_phase<P>(F, A, A.ph_lo);
}
#if N_LAUNCH_MODE == 1
__device__ __forceinline__ const float* lds_ptr(const LAS unsigned long long* tab, int i) {
    const unsigned long long v = tab[i];
    const unsigned lo = __builtin_amdgcn_readfirstlane((unsigned)v), hi = __builtin_amdgcn_readfirstlane((unsigned)(v >> 32));
    return (const float*)(const __attribute__((address_space(1))) float*)(((unsigned long long)hi << 32) | lo);
}
__device__ __forceinline__ void load_args(Args& L, const LAS unsigned long long* tab) {
#pragma unroll
    for (int i = 0; i < 32; ++i) L.in[i] = lds_ptr(tab, i);
    L.out = (float*)lds_ptr(tab, 32); L.ws = (unsigned char*)lds_ptr(tab, 33); L.ph_lo = 0; L.ph_hi = 0;
}
__global__ void __launch_bounds__(NWAVES * 64, 2) mk_fwd(Args A) {
    extern __shared__ __attribute__((aligned(16))) unsigned char lds[];
    LAS unsigned char* L3 = (LAS unsigned char*)lds;
    volatile LAS unsigned* MISC = (volatile LAS unsigned*)(L3 + MISC_OFF);
    for (int u = threadIdx.x; u < (LDS_BYTES - RING_BYTES) / 4; u += NWAVES * 64) ((LAS unsigned*)(L3 + RING_BYTES))[u] = 0u;
    __syncthreads();
    LAS unsigned long long* tab = (LAS unsigned long long*)(L3 + RING_BYTES + 4096);
    if (threadIdx.x == 0) {
#define ST(i) tab[i] = (unsigned long long)A.in[i];
        ST(0) ST(1) ST(2) ST(3) ST(4) ST(5) ST(6) ST(7) ST(8) ST(9) ST(10) ST(11) ST(12) ST(13) ST(14) ST(15) ST(16) ST(17) ST(18) ST(19) ST(20) ST(21) ST(22) ST(23) ST(24) ST(25) ST(26) ST(27) ST(28) ST(29) ST(30) ST(31)
#undef ST
        tab[32] = (unsigned long long)A.out; tab[33] = (unsigned long long)A.ws;
    }
    __syncthreads();
    (void)xcd_barrier_post((unsigned*)(A.ws + WS_CTL) + CW_BAR, MISC + 8);
#define RUN(P) do { asm volatile("; PHASE_MARK " #P); { unsigned tb_ = RING_BYTES + 4096; asm volatile("" : "+v"(tb_)); Args L; load_args(L, (const LAS unsigned long long*)(L3 + tb_)); \
        const Frame F = make_frame(lds); run_phase<P>(F, L, l); \
        if constexpr (P >= 0 && ((REP_MASK >> (P < 0 ? 0 : P)) & 1)) { for (int rp_ = 0; rp_ < REP_N; ++rp_) { asm volatile("s_waitcnt vmcnt(0)" ::: "memory"); __syncthreads(); run_phase<P, true>(F, L, l); } } \
        XcdBarrier bar; bar.bar = (unsigned*)(L.ws + WS_CTL) + CW_BAR; bar.x = xb_xcc_id(); { unsigned mo_ = MISC_OFF + 32; asm volatile("" : "+v"(mo_)); bar.st = (volatile LAS unsigned*)(L3 + mo_); } \
        xcd_barrier(bar); } } while (0)
    { const int l = 0; RUN(-1);
#if REP_PRO
      for (int rp_ = 0; rp_ < 2; ++rp_) { RUN(-1); }
#endif
    }
    for (int l = 0; l < DEPTH; ++l) {
        if (l == 0) RUN(0);
        RUN(1); RUN(3); RUN(4); RUN(5); RUN(6); RUN(7); RUN(9); RUN(11); RUN(12); RUN(13); RUN(14); RUN(15); RUN(16); RUN(17);
    }
#undef RUN
}
#endif

extern "C" void kernel_launch(void* const* d_in, const int* in_sizes, int n_in, void* d_out, int out_size, void* d_ws, size_t ws_size, hipStream_t stream) {
    static int grid = 0;
    if (grid == 0) {
        if (n_in != 32 || out_size != NB * SEQ * DM || ws_size < WS_END) { fprintf(stderr, "kernel_launch: unexpected shapes (n_in %d, out %d, ws %zu < %zu)\n", n_in, out_size, ws_size, (size_t)WS_END); grid = -1; return; }
        int dev = 0, cus = 0;
        if (hipGetDevice(&dev) != hipSuccess || hipDeviceGetAttribute(&cus, hipDeviceAttributeMultiprocessorCount, dev) != hipSuccess) { grid = -1; return; }
#define SETA(K) if (hipFuncSetAttribute((const void*)K, hipFuncAttributeMaxDynamicSharedMemorySize, LDS_BYTES) != hipSuccess) { fprintf(stderr, "kernel_launch: hipFuncSetAttribute failed\n"); grid = -1; return; }
#if N_LAUNCH_MODE == 1
        SETA(mk_fwd)
#else
        SETA(mk_phase<-1>) SETA(mk_phase<0>) SETA(mk_phase<1>) SETA(mk_phase<2>) SETA(mk_phase<3>) SETA(mk_phase<4>) SETA(mk_phase<5>) SETA(mk_phase<6>) SETA(mk_phase<7>) SETA(mk_phase<8>)
        SETA(mk_phase<9>) SETA(mk_phase<10>) SETA(mk_phase<11>) SETA(mk_phase<12>) SETA(mk_phase<13>) SETA(mk_phase<14>) SETA(mk_phase<15>) SETA(mk_phase<16>) SETA(mk_phase<17>)
#endif
#undef SETA
        int per_cu = 0;
        (void)per_cu;
        if (cus * MOE_MAXU < 2 * (NPAIR / 256 + 256)) { fprintf(stderr, "kernel_launch: too few CUs (%d) for the staged MoE row lists\n", cus); grid = -1; return; }
        grid = cus;
    }
    if (grid < 0) return;
    (void)hipMemsetAsync((char*)d_ws + WS_CTL, 0, CTL_ZERO_BYTES, stream);
    Args a{};
    for (int i = 0; i < 32; ++i) a.in[i] = (const float*)d_in[i];
    a.out = (float*)d_out; a.ws = (unsigned char*)d_ws;
#if N_LAUNCH_MODE == 1
    a.ph_lo = 0; a.ph_hi = N_PHASES;
    hipLaunchKernelGGL(mk_fwd, dim3(grid), dim3(NWAVES * 64), LDS_BYTES, stream, a);
#else
#define LAUNCH_P(P) hipLaunchKernelGGL(mk_phase<P>, dim3(grid), dim3(NWAVES * 64), LDS_BYTES, stream, a)
    a.ph_lo = 0; a.ph_hi = 0; LAUNCH_P(-1);
    for (int l = 0; l < DEPTH; ++l) { a.ph_lo = l;
        LAUNCH_P(0); LAUNCH_P(1); LAUNCH_P(2); LAUNCH_P(3); LAUNCH_P(4); LAUNCH_P(5); LAUNCH_P(6); LAUNCH_P(7); LAUNCH_P(8); LAUNCH_P(9); LAUNCH_P(10); LAUNCH_P(11); LAUNCH_P(12); LAUNCH_P(13); LAUNCH_P(14); LAUNCH_P(15); LAUNCH_P(16); LAUNCH_P(17); }
#undef LAUNCH_P
#endif
    const hipError_t le = hipPeekAtLastError();
    if (le != hipSuccess) fprintf(stderr, "kernel_launch: launch failed: %s\n", hipGetErrorName(le));
}
```

```cpp
#include <hip/hip_runtime.h>
#include <cstdio>
#include <cstdint>

#ifndef ATTN_V2
#define ATTN_V2 8
#endif
#ifndef REP_PRO
#define REP_PRO 0
#endif
#ifndef REP_MASK
#define REP_MASK 0
#endif
#ifndef REP_N
#define REP_N 2
#endif
#ifndef FAST_MIX
#define FAST_MIX 1
#endif
#ifndef FAST_WIN
#define FAST_WIN 1
#endif
#ifndef FAST_LRU
#define FAST_LRU 1
#endif
#define FAST_FFT 0
#ifndef FAST_FFT_A
#define FAST_FFT_A 1
#endif
#ifndef FAST_FFT_B
#define FAST_FFT_B 1
#endif
#ifndef FAST_MOE
#define FAST_MOE 1
#endif
#ifndef FAST_ATTN
#define FAST_ATTN 1
#endif
#ifndef N_LAUNCH_MODE
#define N_LAUNCH_MODE 1
#endif

__device__ __forceinline__ int otid() { int t = threadIdx.x; asm volatile("" : "+v"(t)); return t; }
__device__ __forceinline__ int obid() { int b = blockIdx.x; asm volatile("" : "+s"(b)); return b; }
__device__ __forceinline__ int ogrid() { int g = gridDim.x; asm volatile("" : "+s"(g)); return g; }
template <int M> __device__ __forceinline__ float sx(float v) {
    static_assert(M == 1 || M == 2 || M == 4 || M == 8 || M == 16 || M == 32, "xor mask");
    if constexpr (M < 32) return __uint_as_float((unsigned)__builtin_amdgcn_ds_swizzle((int)__float_as_uint(v), (M << 10) | 0x1f));
    else { auto rr = __builtin_amdgcn_permlane32_swap(__float_as_uint(v), __float_as_uint(v), false, false); const unsigned a = rr[0], b = rr[1]; return __uint_as_float(a == __float_as_uint(v) ? b : a); }
}
template <int M> __device__ __forceinline__ int sxi(int v) { return (int)__float_as_uint(sx<M>(__uint_as_float((unsigned)v))); }
namespace pg8 {
#define PG8_LAS __attribute__((address_space(3)))
typedef unsigned short bf16_t;
typedef short bf16x8 __attribute__((ext_vector_type(8)));
typedef float f32x4 __attribute__((ext_vector_type(4)));
typedef unsigned u32x4 __attribute__((ext_vector_type(4)));
constexpr int BM = 256, BK = 64, HALF = 128, HTB = HALF * BK * 2, STAGE_BYTES = 8 * HTB, NXCD = 8, WGM = 8;
__host__ __device__ __forceinline__ int lds_byte(int r, int c) { const int st = (r >> 4) * 2 + (c >> 5), rr = r & 15, cc = c & 31, ob = rr * 64 + cc * 2; return st * 1024 + (ob ^ (((ob >> 9) & 1) << 5)); }
__host__ __device__ __forceinline__ void stage_rc(int b, int& R, int& C) { const int st = b / 1024, sb = b % 1024, swz = sb ^ (((sb >> 9) & 1) << 5); R = (st >> 1) * 16 + swz / 64; C = (st & 1) * 32 + (swz % 64) / 2; }
__host__ __device__ __forceinline__ int perm32(int rho) { const int n = rho >> 4, i = rho & 15; return 8 * (i >> 2) + 4 * n + (i & 3); }
struct Unit { int pm, pn; };
struct Gemm { const bf16_t* A; const bf16_t* Bt; int M, N, K, lda, ldb; };
struct StaticOrder {
    int nM, nN, nwg, G, c; bool skipctx;
    __host__ __device__ void init(int M, int N, int G_, int c_, bool skip = false) { nM = skip ? 64 : M / BM; nN = N / BM; nwg = nM * nN; G = G_; c = c_; skipctx = skip; }
    __host__ __device__ bool next(int i, Unit& u) const {
        const long L = (long)i * G + c; if (L >= nwg) return false;
        int wgid = (int)L; { const int q = nwg / NXCD, r = nwg % NXCD, xcd = wgid % NXCD, off = wgid / NXCD; wgid = (xcd < r ? xcd * (q + 1) : r * (q + 1) + (xcd - r) * q) + off; }
        const int nig = WGM * nN, gid = wgid / nig, fm = gid * WGM, gsz = (nM - fm) < WGM ? (nM - fm) : WGM;
        u.pm = fm + ((wgid % nig) % gsz); u.pn = (wgid % nig) / gsz;
        if (skipctx) u.pm += 1 + (u.pm >= 32 ? 1 : 0);
        return true;
    }
};
__device__ __forceinline__ unsigned cvt_pk_bf16(float lo, float hi) { unsigned r; asm volatile("v_cvt_pk_bf16_f32 %0, %1, %2" : "=v"(r) : "v"(lo), "v"(hi)); return r; }

struct EpiF32 {
    static constexpr bool PERM = false; static constexpr int MIDK = 0;
    float* C; int ldc;
    __device__ __forceinline__ void operator()(const f32x4 (&acc)[2][2][4][2], const Unit& u, int wr, int wc, int fr, int fq) const {
        const int row0 = u.pm * BM + wr * 64 + fr, col0 = u.pn * BM + wc * 32 + 4 * fq;
#pragma unroll
        for (int ai = 0; ai < 2; ++ai)
#pragma unroll
            for (int m = 0; m < 4; ++m) { float* rowp = C + (size_t)(row0 + ai * HALF + m * 16) * ldc + col0;
#pragma unroll
                for (int bj = 0; bj < 2; ++bj)
#pragma unroll
                    for (int n = 0; n < 2; ++n) *(f32x4*)(rowp + bj * HALF + n * 16) = acc[ai][bj][m][n]; }
    }
};

template <class Epi>
__device__ __forceinline__ void gemm_phase(PG8_LAS unsigned char* lds, const Gemm g, const StaticOrder& S, const Epi& E) {
    const int tid = otid(), wid = __builtin_amdgcn_readfirstlane(tid >> 6), lane = tid & 63, wr = wid >> 2, wc = wid & 3, fr = lane & 15, fq = lane >> 4;
    const int K = g.K, nt = K / BK;
    unsigned voffA[2], voffB[2];
#pragma unroll
    for (int i = 0; i < 2; ++i) { int R, C; stage_rc(tid * 16 + i * 8192, R, C); const int Rb = Epi::PERM ? ((R & ~31) + perm32(R & 31)) : R;
        voffA[i] = (unsigned)(R * g.lda + C) * 2u; voffB[i] = (unsigned)(Rb * g.ldb + C) * 2u; }
    const size_t kstep = (size_t)(BK * 2);
    const size_t hA = (size_t)HALF * g.lda * 2, hB = (size_t)HALF * g.ldb * 2;
    const size_t tA = 2 * hA, tB = 2 * hB;
    const unsigned ldsw = (unsigned)wid * 1024u;
    const int aoff = lds_byte(wr * 64 + fr, fq * 8), boff = lds_byte(wc * 32 + fr, fq * 8);
#define PG8_SA(b, h) (((b) * 2 + (h)) * HTB)
#define PG8_SB(b, h) ((4 + (b) * 2 + (h)) * HTB)
#define PG8_STAGE(bufoff, gbase, voff) do { _Pragma("unroll") for (int _i = 0; _i < 2; ++_i) \
        __builtin_amdgcn_global_load_lds((const unsigned*)((const char*)(gbase) + (voff)[_i]), (PG8_LAS unsigned*)(lds + (bufoff) + ldsw + _i * 8192), 16, 0, 0); } while (0)
#define PG8_LDA(dst, b, h) do { _Pragma("unroll") for (int m = 0; m < 4; ++m) _Pragma("unroll") for (int k = 0; k < 2; ++k) dst[m][k] = *(const PG8_LAS bf16x8*)(lds + PG8_SA(b, h) + aoff + m * 2048 + k * 1024); } while (0)
#define PG8_LDB(dst, b, h) do { _Pragma("unroll") for (int n = 0; n < 2; ++n) _Pragma("unroll") for (int k = 0; k < 2; ++k) dst[n][k] = *(const PG8_LAS bf16x8*)(lds + PG8_SB(b, h) + boff + n * 2048 + k * 1024); } while (0)
#define PG8_MMA(ai, bj, At, Bt) do { __builtin_amdgcn_s_setprio(1); _Pragma("unroll") for (int m = 0; m < 4; ++m) _Pragma("unroll") for (int n = 0; n < 2; ++n) _Pragma("unroll") for (int k = 0; k < 2; ++k) \
        acc[ai][bj][m][n] = __builtin_amdgcn_mfma_f32_16x16x32_bf16(Bt[n][k], At[m][k], acc[ai][bj][m][n], 0, 0, 0); __builtin_amdgcn_s_setprio(0); } while (0)
#define PG8_WAIT_V(n) asm volatile("s_waitcnt vmcnt(" #n ")" ::: "memory")
#define PG8_WAIT_L(n) asm volatile("s_waitcnt lgkmcnt(" #n ")" ::: "memory")
#define PG8_BAR __builtin_amdgcn_s_barrier()
#define PG8_SCHED __builtin_amdgcn_sched_barrier(0)
    Unit cur, nxt; int ui = 0;
    if (!S.next(0, cur)) return;
    f32x4 acc[2][2][4][2];
#pragma unroll
    for (int a = 0; a < 2; ++a)
#pragma unroll
        for (int b = 0; b < 2; ++b)
#pragma unroll
            for (int m = 0; m < 4; ++m)
#pragma unroll
                for (int n = 0; n < 2; ++n) acc[a][b][m][n] = (f32x4){0.f, 0.f, 0.f, 0.f};
    bf16x8 At[4][2], B0[2][2], B1[2][2];
    const char* cA = (const char*)g.A + (size_t)cur.pm * tA; const char* cB = (const char*)g.Bt + (size_t)cur.pn * tB;
    PG8_STAGE(PG8_SB(0, 0), cB, voffB); PG8_STAGE(PG8_SB(0, 1), cB + hB, voffB); PG8_STAGE(PG8_SA(0, 0), cA, voffA); PG8_STAGE(PG8_SA(0, 1), cA + hA, voffA);
    if (wr == 1) PG8_BAR;
    PG8_WAIT_V(2); PG8_BAR;
    PG8_STAGE(PG8_SB(1, 0), cB + kstep, voffB); PG8_STAGE(PG8_SA(1, 0), cA + kstep, voffA); PG8_STAGE(PG8_SB(1, 1), cB + hB + kstep, voffB);
    PG8_WAIT_V(6); PG8_BAR;
    for (;;) {
        const bool has_next = S.next(ui + 1, nxt);
        const char* nA = has_next ? (const char*)g.A + (size_t)nxt.pm * tA : cA; const char* nB = has_next ? (const char*)g.Bt + (size_t)nxt.pn * tB : cB;
#pragma unroll 1
        for (int t = 0; t < nt; t += 2) {
            if constexpr (Epi::MIDK > 0) { if (t > 0 && (t % Epi::MIDK) == 0) E.mid(acc, cur, wr, wc, fr, fq, t / Epi::MIDK); }
            const bool last = (t == nt - 2);
            const char* a1 = cA + (size_t)(t + 1) * kstep;
            const char* a2 = last ? nA : cA + (size_t)(t + 2) * kstep; const char* b2 = last ? nB : cB + (size_t)(t + 2) * kstep;
            const char* a3 = a2 + kstep; const char* b3 = b2 + kstep;
            PG8_LDB(B0, 0, 0); PG8_LDB(B1, 0, 1); PG8_SCHED; PG8_LDA(At, 0, 0); PG8_STAGE(PG8_SA(1, 1), a1 + hA, voffA);
            PG8_WAIT_V(8); PG8_WAIT_L(0); PG8_BAR; PG8_MMA(0, 0, At, B0); PG8_MMA(0, 1, At, B1); PG8_BAR; PG8_SCHED;
            PG8_LDA(At, 0, 1); PG8_STAGE(PG8_SB(0, 0), b2, voffB); PG8_STAGE(PG8_SB(0, 1), b2 + hB, voffB); PG8_STAGE(PG8_SA(0, 0), a2, voffA);
            PG8_WAIT_V(8); PG8_WAIT_L(0); PG8_BAR; PG8_MMA(1, 0, At, B0); PG8_MMA(1, 1, At, B1); PG8_BAR; PG8_SCHED;
            PG8_LDB(B0, 1, 0); PG8_LDB(B1, 1, 1); PG8_SCHED; PG8_LDA(At, 1, 0); PG8_STAGE(PG8_SA(0, 1), a2 + hA, voffA);
            PG8_WAIT_V(8); PG8_WAIT_L(0); PG8_BAR; PG8_MMA(0, 0, At, B0); PG8_MMA(0, 1, At, B1); PG8_BAR; PG8_SCHED;
            PG8_LDA(At, 1, 1); PG8_STAGE(PG8_SB(1, 0), b3, voffB); PG8_STAGE(PG8_SB(1, 1), b3 + hB, voffB); PG8_STAGE(PG8_SA(1, 0), a3, voffA);
            PG8_WAIT_V(8); PG8_WAIT_L(0); PG8_BAR; PG8_MMA(1, 0, At, B0); PG8_MMA(1, 1, At, B1); PG8_BAR; PG8_SCHED;
        }
        if (wr == 0) PG8_BAR;
        E(acc, cur, wr, wc, fr, fq);
        if (!has_next) break;
#pragma unroll
        for (int a = 0; a < 2; ++a)
#pragma unroll
            for (int b = 0; b < 2; ++b)
#pragma unroll
                for (int m = 0; m < 4; ++m)
#pragma unroll
                    for (int n = 0; n < 2; ++n) acc[a][b][m][n] = (f32x4){0.f, 0.f, 0.f, 0.f};
        cur = nxt; cA = nA; cB = nB; ++ui;
        if (wr == 1) PG8_BAR;
    }
    PG8_WAIT_V(0);
    PG8_BAR;
#undef PG8_SA
#undef PG8_SB
#undef PG8_STAGE
#undef PG8_LDA
#undef PG8_LDB
#undef PG8_MMA
#undef PG8_WAIT_V
#undef PG8_WAIT_L
#undef PG8_BAR
#undef PG8_SCHED
}

struct UnitG { const char* a; const char* b; int row0, pn, e, valid; const int* rows; const PG8_LAS int* lrows; };
template <class Epi, class Sched, bool GATHER>
__device__ __forceinline__ void gemm_phase_g(PG8_LAS unsigned char* lds, const int K, const int lda, const int ldb, const Sched& S, const Epi& E) {
    const int tid = otid(), wid = __builtin_amdgcn_readfirstlane(tid >> 6), lane = tid & 63, wr = wid >> 2, wc = wid & 3, fr = lane & 15, fq = lane >> 4;
    const int nt = K / BK;
    int RA[2], CA[2]; unsigned voffB[2];
#pragma unroll
    for (int i = 0; i < 2; ++i) { int R, C; stage_rc(tid * 16 + i * 8192, R, C); const int Rb = Epi::PERM ? ((R & ~31) + perm32(R & 31)) : R;
        RA[i] = R; CA[i] = C; voffB[i] = (unsigned)(Rb * ldb + C) * 2u; }
    const size_t kstep = (size_t)(BK * 2);
    const size_t hB = (size_t)HALF * ldb * 2;
    const unsigned ldsw = (unsigned)wid * 1024u;
    const int aoff = lds_byte(wr * 64 + fr, fq * 8), boff = lds_byte(wc * 32 + fr, fq * 8);
#define PG8_SA(b, h) (((b) * 2 + (h)) * HTB)
#define PG8_SB(b, h) ((4 + (b) * 2 + (h)) * HTB)
#define PG8_STAGE(bufoff, gbase, voff) do { _Pragma("unroll") for (int _i = 0; _i < 2; ++_i) \
        __builtin_amdgcn_global_load_lds((const unsigned*)((const char*)(gbase) + (voff)[_i]), (PG8_LAS unsigned*)(lds + (bufoff) + ldsw + _i * 8192), 16, 0, 0); } while (0)
#define PG8_LDA(dst, b, h) do { _Pragma("unroll") for (int m = 0; m < 4; ++m) _Pragma("unroll") for (int k = 0; k < 2; ++k) dst[m][k] = *(const PG8_LAS bf16x8*)(lds + PG8_SA(b, h) + aoff + m * 2048 + k * 1024); } while (0)
#define PG8_LDB(dst, b, h) do { _Pragma("unroll") for (int n = 0; n < 2; ++n) _Pragma("unroll") for (int k = 0; k < 2; ++k) dst[n][k] = *(const PG8_LAS bf16x8*)(lds + PG8_SB(b, h) + boff + n * 2048 + k * 1024); } while (0)
#define PG8_MMA(ai, bj, At, Bt) do { __builtin_amdgcn_s_setprio(1); _Pragma("unroll") for (int m = 0; m < 4; ++m) _Pragma("unroll") for (int n = 0; n < 2; ++n) _Pragma("unroll") for (int k = 0; k < 2; ++k) \
        acc[ai][bj][m][n] = __builtin_amdgcn_mfma_f32_16x16x32_bf16(Bt[n][k], At[m][k], acc[ai][bj][m][n], 0, 0, 0); __builtin_amdgcn_s_setprio(0); } while (0)
#define PG8_WAIT_V(n) asm volatile("s_waitcnt vmcnt(" #n ")" ::: "memory")
#define PG8_WAIT_L(n) asm volatile("s_waitcnt lgkmcnt(" #n ")" ::: "memory")
#define PG8_BAR __builtin_amdgcn_s_barrier()
#define PG8_SCHED __builtin_amdgcn_sched_barrier(0)
#define PG8_MKOFF(u, v) do { _Pragma("unroll") for (int _h = 0; _h < 2; ++_h) _Pragma("unroll") for (int _i = 0; _i < 2; ++_i) { const int _row = _h * HALF + RA[_i]; \
        if (GATHER) { const int _pr = (u).lrows[_row]; v[_h][_i] = (unsigned)(_pr >> 3) * (unsigned)(lda * 2) + (unsigned)(CA[_i] * 2); } \
        else v[_h][_i] = (unsigned)(_row * lda + CA[_i]) * 2u; } } while (0)
    UnitG cur, nxt; int ui = 0;
    if (!S.next(0, cur)) return;
    f32x4 acc[2][2][4][2];
#pragma unroll
    for (int a = 0; a < 2; ++a)
#pragma unroll
        for (int b = 0; b < 2; ++b)
#pragma unroll
            for (int m = 0; m < 4; ++m)
#pragma unroll
                for (int n = 0; n < 2; ++n) acc[a][b][m][n] = (f32x4){0.f, 0.f, 0.f, 0.f};
    bf16x8 At[4][2], B0[2][2], B1[2][2];
    unsigned vA[2][2], vN[2][2];
    PG8_MKOFF(cur, vA);
    const char* cA = cur.a; const char* cB = cur.b;
    PG8_STAGE(PG8_SB(0, 0), cB, voffB); PG8_STAGE(PG8_SB(0, 1), cB + hB, voffB); PG8_STAGE(PG8_SA(0, 0), cA, vA[0]); PG8_STAGE(PG8_SA(0, 1), cA, vA[1]);
    if (wr == 1) PG8_BAR;
    PG8_WAIT_V(2); PG8_BAR;
    PG8_STAGE(PG8_SB(1, 0), cB + kstep, voffB); PG8_STAGE(PG8_SA(1, 0), cA + kstep, vA[0]); PG8_STAGE(PG8_SB(1, 1), cB + hB + kstep, voffB);
    PG8_WAIT_V(6); PG8_BAR;
    for (;;) {
        const bool has_next = S.next(ui + 1, nxt);
        if constexpr (GATHER) { if (has_next) { PG8_MKOFF(nxt, vN); } else { vN[0][0] = vA[0][0]; vN[0][1] = vA[0][1]; vN[1][0] = vA[1][0]; vN[1][1] = vA[1][1]; } }
        const char* nA = has_next ? nxt.a : cA; const char* nB = has_next ? nxt.b : cB;
#pragma unroll 1
        for (int t = 0; t < nt; t += 2) {
            const bool last = (t == nt - 2);
            const char* a1 = cA + (size_t)(t + 1) * kstep;
            const char* a2 = last ? nA : cA + (size_t)(t + 2) * kstep; const char* b2 = last ? nB : cB + (size_t)(t + 2) * kstep;
            const char* a3 = a2 + kstep; const char* b3 = b2 + kstep;
            unsigned s0[2], s1[2];
            if constexpr (GATHER) { s0[0] = last ? vN[0][0] : vA[0][0]; s0[1] = last ? vN[0][1] : vA[0][1]; s1[0] = last ? vN[1][0] : vA[1][0]; s1[1] = last ? vN[1][1] : vA[1][1]; }
            else { s0[0] = vA[0][0]; s0[1] = vA[0][1]; s1[0] = vA[1][0]; s1[1] = vA[1][1]; }
            PG8_LDB(B0, 0, 0); PG8_LDB(B1, 0, 1); PG8_SCHED; PG8_LDA(At, 0, 0); PG8_STAGE(PG8_SA(1, 1), a1, vA[1]);
            PG8_WAIT_V(8); PG8_WAIT_L(0); PG8_BAR; PG8_MMA(0, 0, At, B0); PG8_MMA(0, 1, At, B1); PG8_BAR; PG8_SCHED;
            PG8_LDA(At, 0, 1); PG8_STAGE(PG8_SB(0, 0), b2, voffB); PG8_STAGE(PG8_SB(0, 1), b2 + hB, voffB); PG8_STAGE(PG8_SA(0, 0), a2, s0);
            PG8_WAIT_V(8); PG8_WAIT_L(0); PG8_BAR; PG8_MMA(1, 0, At, B0); PG8_MMA(1, 1, At, B1); PG8_BAR; PG8_SCHED;
            PG8_LDB(B0, 1, 0); PG8_LDB(B1, 1, 1); PG8_SCHED; PG8_LDA(At, 1, 0); PG8_STAGE(PG8_SA(0, 1), a2, s1);
            PG8_WAIT_V(8); PG8_WAIT_L(0); PG8_BAR; PG8_MMA(0, 0, At, B0); PG8_MMA(0, 1, At, B1); PG8_BAR; PG8_SCHED;
            PG8_LDA(At, 1, 1); PG8_STAGE(PG8_SB(1, 0), b3, voffB); PG8_STAGE(PG8_SB(1, 1), b3 + hB, voffB); PG8_STAGE(PG8_SA(1, 0), a3, s0);
            PG8_WAIT_V(8); PG8_WAIT_L(0); PG8_BAR; PG8_MMA(1, 0, At, B0); PG8_MMA(1, 1, At, B1); PG8_BAR; PG8_SCHED;
        }
        if (wr == 0) PG8_BAR;
        E(acc, cur, wr, wc, fr, fq);
        if (!has_next) break;
#pragma unroll
        for (int a = 0; a < 2; ++a)
#pragma unroll
            for (int b = 0; b < 2; ++b)
#pragma unroll
                for (int m = 0; m < 4; ++m)
#pragma unroll
                    for (int n = 0; n < 2; ++n) acc[a][b][m][n] = (f32x4){0.f, 0.f, 0.f, 0.f};
        cur = nxt; cA = nA; cB = nB; ++ui;
        if constexpr (GATHER) { vA[0][0] = vN[0][0]; vA[0][1] = vN[0][1]; vA[1][0] = vN[1][0]; vA[1][1] = vN[1][1]; }
        if (wr == 1) PG8_BAR;
    }
    PG8_WAIT_V(0);
    PG8_BAR;
#undef PG8_SA
#undef PG8_SB
#undef PG8_STAGE
#undef PG8_LDA
#undef PG8_LDB
#undef PG8_MMA
#undef PG8_WAIT_V
#undef PG8_WAIT_L
#undef PG8_BAR
#undef PG8_SCHED
#undef PG8_MKOFF
}
}

constexpr int DM = 1024, NB = 2, SEQ = 8192, CTX = 256, TPB = SEQ + CTX, MROWS = NB * TPB, DEPTH = 2;
constexpr int INW = 9216, COL_K = 0, COL_V = 1024, COL_LX = 2048, COL_Q = 3072, COL_LG = 4096, COL_F = 5120, COL_G = 6144;
constexpr int NE = 256, TOPK = 8, EFF = 256, NPAIR = MROWS * TOPK, LCAP = MROWS;
constexpr float EPS = 1e-6f;
constexpr float QSCALE = 0.125f * 1.4426950408889634f;
constexpr int NCHUNK = TPB / 64;
static_assert(MROWS % 256 == 0, "rows");

constexpr size_t MiB = 1u << 20;
constexpr size_t WS_CTL = 0, CTL_ZERO_BYTES = 1 * MiB;
constexpr size_t WS_W = 1 * MiB, WL_STRIDE = 32 * MiB;
constexpr size_t WO_TAB = 31 * MiB;
constexpr size_t WO_WIN = 0, WO_D1 = 18 * MiB, WO_OUT = 24 * MiB, WO_R = 26 * MiB, WO_SGU = 27 * MiB, WO_SD = 28 * MiB, WO_LRU = 29 * MiB;
constexpr size_t WS_XALL = 65 * MiB;
constexpr size_t WS_H = WS_XALL + 66 * MiB;
constexpr size_t WS_U = WS_H + 33 * MiB;
constexpr size_t WS_KB = WS_U + 594 * MiB, WS_VB = WS_KB + 33 * MiB, WS_QB = WS_VB + 33 * MiB, WS_LXB = WS_QB + 33 * MiB, WS_GLG = WS_LXB + 33 * MiB, WS_ZP = WS_GLG + 33 * MiB;
constexpr size_t WS_GATES = WS_ZP + 33 * MiB;
constexpr size_t WS_MIXIN = WS_GATES + 99 * MiB;
constexpr size_t WS_S = WS_MIXIN + 99 * MiB;
constexpr size_t WS_UC = WS_S, WS_AB = WS_UC + 33 * MiB, WS_SUMM = WS_AB + 132 * MiB, WS_CARRY = WS_SUMM + 5 * MiB, WS_XA = WS_CARRY + 3 * MiB, WS_XB = WS_XA + 32 * MiB, WS_GB = WS_XB + 32 * MiB, WS_GC = WS_GB + 32 * MiB;
constexpr size_t WS_PA = WS_S, WS_PR = WS_PA + 66 * MiB, WS_PF = WS_PR + 66 * MiB, WS_Y1 = WS_PF + 66 * MiB;
static_assert(WS_GC + 3 * MiB <= WS_S + 280 * MiB && WS_Y1 + 66 * MiB <= WS_S + 280 * MiB, "scratch S");
constexpr size_t WS_MIXED = WS_S + 280 * MiB, WS_TOK = WS_MIXED + 33 * MiB;
constexpr size_t WS_LOG = WS_TOK + 33 * MiB, WS_SGU = WS_LOG + 17 * MiB, WS_SH = WS_SGU + 33 * MiB, WS_LIST = WS_SH + 9 * MiB, WS_TOPW = WS_LIST + 17 * MiB, WS_SD = WS_TOPW + 1 * MiB;
constexpr size_t WS_YB = WS_U;
constexpr size_t WS_Y16 = WS_KB, WS_HB = WS_S;
constexpr size_t WS_EP = WS_SUMM;
constexpr size_t WS_Y16_OLD = WS_U;
constexpr size_t WS_EW = WS_SD + 66 * MiB, WS_EW1 = WS_U, EW_STRIDE = 3 * MiB / 2;
#define EWL(l) (((l) & 1) ? WS_EW1 : WS_EW)
static_assert(WS_KB + 396 * MiB == WS_S && 392 * MiB <= 396 * MiB && WS_U + 384 * MiB <= WS_KB, "overlays");
constexpr size_t WS_END = WS_EW + 384 * MiB;
static_assert(WS_END <= 2048 * MiB, "d_ws budget");
constexpr int CW_BAR = 4096;
constexpr int CW_CNT = 16384, CNT_STRIDE = 32;
constexpr int CW_MOD = 65536;
static_assert((CW_MOD + 2 * 3 * 6144) * 4 <= (int)CTL_ZERO_BYTES, "ctl");

constexpr int LDS_BYTES = 147456, RING_BYTES = 131072, MISC_OFF = RING_BYTES + 320;
constexpr int NWAVES = 8;

#define GAS __attribute__((address_space(1)))
#define LAS __attribute__((address_space(3)))
typedef unsigned short bf16;
typedef unsigned v4u __attribute__((ext_vector_type(4)));
typedef float f32x4 __attribute__((ext_vector_type(4)));
typedef GAS unsigned gu32;
#define RLX_AGENT __ATOMIC_RELAXED, __HIP_MEMORY_SCOPE_AGENT
#define LDS_WAIT() asm volatile("s_waitcnt lgkmcnt(0)" ::: "memory")
typedef float f32x2_t __attribute__((ext_vector_type(2))); typedef __bf16 bf16x2_t __attribute__((ext_vector_type(2)));
__device__ __forceinline__ unsigned pk2(float lo, float hi) { const f32x2_t v = {lo, hi}; const bf16x2_t b = __builtin_convertvector(v, bf16x2_t); return __builtin_bit_cast(unsigned, b); }
__device__ __forceinline__ unsigned f2bf(float f) { return pk2(f, f) & 0xffffu; }
__device__ __forceinline__ float bf2f(unsigned h) { return __uint_as_float(h << 16); }
__device__ __forceinline__ float sigmoidf_(float x) { return __builtin_amdgcn_rcpf(1.f + __expf(-x)); }
__device__ __forceinline__ float siluf_(float x) { return x * __builtin_amdgcn_rcpf(1.f + __expf(-x)); }
__device__ __forceinline__ float gelu_tanh(float x) { const float u = 0.7978845608028654f * (x + 0.044715f * x * x * x); return x * __builtin_amdgcn_rcpf(1.f + __expf(-2.f * u)); }

#define XB_TMO      128
#define XB_XCNT(j)  (256  + 64 * (j))
#define XB_XSUB(j)  (1280 + 64 * (j))
#define XB_XGEN(j)  (2304 + 64 * (j))
#define XB_TOP      3328
#define XB_TOPGEN   3392
#define XCD_BAR_WORDS 3456
#define XB_SPIN_CAP (1u << 18)
__device__ __forceinline__ unsigned xb_ld(unsigned* p)              { return __hip_atomic_load(p, __ATOMIC_RELAXED, __HIP_MEMORY_SCOPE_AGENT); }
__device__ __forceinline__ unsigned xb_add(unsigned* p, unsigned v) { return __hip_atomic_fetch_add(p, v, __ATOMIC_RELAXED, __HIP_MEMORY_SCOPE_AGENT); }
__device__ __forceinline__ unsigned xb_xcc_id() { return (unsigned)__builtin_amdgcn_s_getreg((3 << 11) | 20) & 0xFu; }
#define XB_SPIN(cond, bar) do { unsigned _sp = 0; while (cond) { __builtin_amdgcn_s_sleep(1); \
    if ((++_sp & 255u) == 0u) { if (xb_ld(&(bar)[XB_TMO])) break; if (_sp > XB_SPIN_CAP) { atomicAdd(&(bar)[XB_TMO], 1u); break; } } } } while (0)
struct XcdBarrier { unsigned* bar; unsigned x; volatile LAS unsigned* st; };
__device__ __forceinline__ XcdBarrier xcd_barrier_post(unsigned* bar, volatile LAS unsigned* st) {
    XcdBarrier b; b.bar = bar; b.x = xb_xcc_id(); b.st = st;
    if (threadIdx.x == 0) (void)xb_add(&bar[XB_XCNT(b.x)], 1u);
    return b;
}
__device__ __forceinline__ void xcd_barrier_complete(unsigned* bar, unsigned x, unsigned& nloc, unsigned& nx) {
    const unsigned G = gridDim.x * gridDim.y * gridDim.z;
    unsigned sum, cnt, mine, sp = 0u;
    for (;;) {
        sum = 0u; cnt = 0u; mine = 0u;
#pragma unroll
        for (unsigned j = 0; j < 16; ++j) { const unsigned c = xb_ld(&bar[XB_XCNT(j)]); sum += c; cnt += (c > 0u) ? 1u : 0u; mine = (j == x) ? c : mine; }
        if (sum == G) break;
        __builtin_amdgcn_s_sleep(1);
        if ((++sp & 255u) == 0u) { if (xb_ld(&bar[XB_TMO])) break; if (sp > XB_SPIN_CAP) { atomicAdd(&bar[XB_TMO], 1u); break; } }
    }
    nloc = mine > 0u ? mine : 1u; nx = cnt > 0u ? cnt : 1u;
}
__device__ __forceinline__ void xcd_barrier(const XcdBarrier& b) {
    asm volatile("s_waitcnt vmcnt(0)" ::: "memory");
    __syncthreads();
    if (threadIdx.x == 0) {
        unsigned* bar = b.bar; asm volatile("" : "+s"(bar));
        __builtin_amdgcn_s_waitcnt(0);
        unsigned nloc = b.st[0], nx = b.st[1];
        unsigned bx = b.x; asm volatile("" : "+s"(bx));
        if (nloc == 0u) { xcd_barrier_complete(bar, bx, nloc, nx); b.st[0] = nloc; b.st[1] = nx; }
        const unsigned old = xb_add(&bar[XB_XSUB(bx)], 1u);
        const unsigned gen = old / nloc;
        if (old + 1u == (gen + 1u) * nloc) {
            __builtin_amdgcn_fence(__ATOMIC_RELEASE, "agent");
            asm volatile("s_waitcnt vmcnt(0)" ::: "memory");
            const unsigned og = xb_add(&bar[XB_TOP], 1u);
            const unsigned tg = og / nx;
            if (og + 1u == (tg + 1u) * nx) xb_add(&bar[XB_TOPGEN], 1u);
            else XB_SPIN(xb_ld(&bar[XB_TOPGEN]) == tg, bar);
            __builtin_amdgcn_fence(__ATOMIC_ACQUIRE, "agent");
            xb_add(&bar[XB_XGEN(bx)], 1u);
            asm volatile("s_waitcnt vmcnt(0)" ::: "memory");
        } else {
            XB_SPIN(xb_ld(&bar[XB_XGEN(bx)]) == gen, bar);
            __builtin_amdgcn_fence(__ATOMIC_ACQUIRE, "agent");
            asm volatile("s_waitcnt vmcnt(0)" ::: "memory");
        }
    }
    __syncthreads();
}

struct Args { const float* in[32]; float* out; unsigned char* ws; int ph_lo, ph_hi; };
struct Frame { LAS unsigned char* lds; int tid, lane, wave, bid, G, gw, NGW; long gtid, NT; };
#define WSP(T, off) ((T*)(A.ws + (off)))
#define WLP(l, off) ((bf16*)(A.ws + WS_W + (size_t)(l) * WL_STRIDE + (off)))
#define MODP(l, s, j) ((const float*)(A.ws + WS_CTL) + CW_MOD + ((l) * 3 + (s)) * 6144 + (j) * 1024)

__device__ __forceinline__ float wave_sum(float v) {
    v += sx<1>(v); v += sx<2>(v); v += sx<4>(v); v += sx<8>(v); v += sx<16>(v); v += sx<32>(v);
    return v;
}
__device__ __forceinline__ int win_row(int c) {
    const int sec = c >> 10; if (sec != 0 && sec != 3) return c;
    const int L = c & 255, g = L >> 6, a = (L >> 5) & 1, x = (L >> 4) & 1, q = (L >> 2) & 3, e = L & 3;
    return (c & ~255) | (128 * a + 32 * g + 8 * q + 4 * x + e);
}
template <bool WINMAP = false>
__device__ __forceinline__ void p0_transpose_item(const float* W, int K, int N, bf16* WT, int ldwt, int row_off, int col_off, LAS float* scr, int item, int lane) {
    const int nblk = N / 32, kb = item / nblk, nb = item % nblk, k0 = 64 * kb, n0 = 32 * nb;
    { f32x4 v[8]; const int rr = lane >> 3, c4 = (lane & 7) * 4;
#pragma unroll
      for (int i = 0; i < 8; ++i) v[i] = *(const f32x4*)(W + (size_t)(k0 + 8 * i + rr) * N + n0 + c4);
#pragma unroll
      for (int i = 0; i < 8; ++i) { LAS float* d = scr + (8 * i + rr) * 33 + c4; d[0] = v[i].x; d[1] = v[i].y; d[2] = v[i].z; d[3] = v[i].w; } }
    LDS_WAIT(); asm volatile("" ::: "memory");
    const int c = lane & 7;
#pragma unroll
    for (int j = 0; j < 4; ++j) { const int n = (lane >> 3) + 8 * j; const LAS float* s = scr + (8 * c) * 33 + n;
        v4u o; o.x = pk2(s[0 * 33], s[1 * 33]); o.y = pk2(s[2 * 33], s[3 * 33]); o.z = pk2(s[4 * 33], s[5 * 33]); o.w = pk2(s[6 * 33], s[7 * 33]);
        const int rr = WINMAP ? win_row(n0 + n) : n0 + n;
        *(v4u*)(WT + (size_t)(row_off + rr) * ldwt + col_off + k0 + 8 * c) = o; }
    LDS_WAIT(); asm volatile("" ::: "memory");
}

struct PItem { const float* W; bf16* WT; int N, ldwt, k0, n0, rowbase; bool winmap, skip; };
constexpr int PRO_I_WIN = 16 * 288, PRO_I_SQ = 16 * 32, PRO_I_R = 16 * 8, PRO_I_SD = 4 * 32, PRO_PER_L = PRO_I_WIN + 4 * PRO_I_SQ + 3 * PRO_I_R + PRO_I_SD;
__device__ __forceinline__ void pi_set(PItem& t, const float* W, int N, bf16* WT, int ldwt, int row_off, int col_off, int item) {
    const int nblk = N / 32, kb = item / nblk, nb = item % nblk; t.W = W; t.N = N; t.WT = WT + col_off; t.ldwt = ldwt; t.k0 = 64 * kb; t.n0 = 32 * nb; t.rowbase = row_off; }
__device__ __forceinline__ PItem pro_item(const Args& A, int it) {
    const int l = it / PRO_PER_L; int r = it % PRO_PER_L; PItem t; t.winmap = false; t.skip = false;
    if (r < PRO_I_WIN) { const int nb = r % 288; t.skip = nb >= 160 && nb < 192; t.winmap = true;
        pi_set(t, A.in[7] + (size_t)l * 1024 * 9216, 9216, WLP(l, WO_WIN), 1024, 0, 0, r); return t; } r -= PRO_I_WIN;
    if (r < PRO_I_SQ) { pi_set(t, A.in[12] + (size_t)l * 1048576, 1024, WLP(l, WO_D1), 3072, 0, 0, r); return t; } r -= PRO_I_SQ;
    if (r < PRO_I_SQ) { pi_set(t, A.in[20] + (size_t)l * 1048576, 1024, WLP(l, WO_D1), 3072, 0, 1024, r); return t; } r -= PRO_I_SQ;
    if (r < PRO_I_SQ) { pi_set(t, A.in[21] + (size_t)l * 1048576, 1024, WLP(l, WO_D1), 3072, 0, 2048, r); return t; } r -= PRO_I_SQ;
    if (r < PRO_I_SQ) { pi_set(t, A.in[22] + (size_t)l * 1048576, 1024, WLP(l, WO_OUT), 1024, 0, 0, r); return t; } r -= PRO_I_SQ;
    if (r < PRO_I_R) { pi_set(t, A.in[24] + (size_t)l * 262144, 256, WLP(l, WO_R), 1024, 0, 0, r); return t; } r -= PRO_I_R;
    if (r < PRO_I_R) { pi_set(t, A.in[29] + (size_t)l * 262144, 256, WLP(l, WO_R), 1024, 256 + ((r % 8) >> 2) * 128, 0, r); return t; } r -= PRO_I_R;
    if (r < PRO_I_R) { pi_set(t, A.in[30] + (size_t)l * 262144, 256, WLP(l, WO_R), 1024, 384 + ((r % 8) >> 2) * 128, 0, r); return t; } r -= PRO_I_R;
    pi_set(t, A.in[31] + (size_t)l * 262144, 1024, WLP(l, WO_SD), 256, 0, 0, r); return t;
}
__device__ __forceinline__ void pi_load(const PItem& t, f32x4 (&v)[8], int lane) {
    const int rr = lane >> 3, c4 = (lane & 7) * 4;
#pragma unroll
    for (int i = 0; i < 8; ++i) v[i] = *(const f32x4*)(t.W + (size_t)(t.k0 + 8 * i + rr) * t.N + t.n0 + c4);
}
__device__ __forceinline__ void pi_load_a(const PItem& t, f32x4 (&v)[8], int lane) {
    const int rr = lane >> 3, c4 = (lane & 7) * 4;
#pragma unroll
    for (int i = 0; i < 8; ++i) { const float* p = t.W + (size_t)(t.k0 + 8 * i + rr) * t.N + t.n0 + c4; asm volatile("global_load_dwordx4 %0, %1, off" : "=v"(v[i]) : "v"(p) : "memory"); }
}
__device__ __forceinline__ void pi_store(const PItem& t, const f32x4 (&v)[8], LAS float* scr, int lane) {
    const int rr = lane >> 3, c4 = (lane & 7) * 4;
#pragma unroll
    for (int i = 0; i < 8; ++i) { LAS float* d = scr + (8 * i + rr) * 33 + c4; d[0] = v[i].x; d[1] = v[i].y; d[2] = v[i].z; d[3] = v[i].w; }
    LDS_WAIT(); asm volatile("" ::: "memory");
    const int c = lane & 7;
#pragma unroll
    for (int j = 0; j < 4; ++j) { const int n = (lane >> 3) + 8 * j; const LAS float* sp = scr + (8 * c) * 33 + n;
        v4u o; o.x = pk2(sp[0 * 33], sp[1 * 33]); o.y = pk2(sp[2 * 33], sp[3 * 33]); o.z = pk2(sp[4 * 33], sp[5 * 33]); o.w = pk2(sp[6 * 33], sp[7 * 33]);
        const int row = t.winmap ? win_row(t.n0 + n) : t.n0 + n;
        *(v4u*)(t.WT + (size_t)(t.rowbase + row) * t.ldwt + t.k0 + 8 * c) = o; }
    LDS_WAIT(); asm volatile("" ::: "memory");
}

__device__ __forceinline__ void ph_prologue(const Frame& F, const Args& A) {
    LAS float* scr = (LAS float*)(F.lds + F.wave * 16384);
    { const int stride = F.NGW, hi = 2 * PRO_PER_L; int it = F.gw;
      if (it < hi) { f32x4 va[8], vb[8], vc[8]; PItem ta = pro_item(A, it), tb = ta, tc = ta;
        pi_load_a(ta, va, F.lane);
        if (it + stride < hi) { tb = pro_item(A, it + stride); pi_load_a(tb, vb, F.lane); }
#define PRO_STEP(TP, VP, TS, VS) { if (it + 2 * stride < hi) { TP = pro_item(A, it + 2 * stride); pi_load_a(TP, VP, F.lane); asm volatile("s_waitcnt vmcnt(16)" ::: "memory"); } \
            else asm volatile("s_waitcnt vmcnt(0)" ::: "memory"); \
            if (!TS.skip) pi_store(TS, VS, scr, F.lane); it += stride; if (it >= hi) break; }
        for (;;) {
            PRO_STEP(tc, vc, ta, va)
            PRO_STEP(ta, va, tb, vb)
            PRO_STEP(tb, vb, tc, vc)
        }
#undef PRO_STEP
      } }
#if FAST_WIN
    {
        LAS float* sW = (LAS float*)F.lds; LAS float* sT = sW + 32 * 256;
        __syncthreads();
        if (F.tid < 256) sT[F.tid] = cospif((float)F.tid / 128.0f);
        for (int it = F.bid; it < 2 * 4 * 32; it += F.G) {
            const int l = it >> 7, g = (it >> 5) & 3, k0 = (it & 31) * 32;
            __syncthreads();
            for (int e = F.tid; e < 32 * 256; e += 512) sW[e] = A.in[7][((size_t)l * 1024 + k0 + (e >> 8)) * 9216 + COL_F + g * 256 + (e & 255)];
            __syncthreads();
            const int o = F.tid & 255, kh = F.tid >> 8; int j = o >> 1, odd = o & 1; if (o == 1) { j = 128; odd = 0; }
            const int m0 = odd ? 192 : 0; float acc[16];
#pragma unroll
            for (int q = 0; q < 16; ++q) acc[q] = 0.f;
            for (int c = 0; c < 256; c += 4) { const float r0 = sT[(j * c + m0) & 255], r1 = sT[(j * (c + 1) + m0) & 255], r2 = sT[(j * (c + 2) + m0) & 255], r3 = sT[(j * (c + 3) + m0) & 255];
#pragma unroll
                for (int q = 0; q < 16; ++q) { const f32x4 w = *(const LAS f32x4*)(sW + (kh * 16 + q) * 256 + c); acc[q] += w.x * r0; acc[q] += w.y * r1; acc[q] += w.z * r2; acc[q] += w.w * r3; } }
            bf16* dst = WLP(l, WO_WIN) + (size_t)(COL_F + g * 256 + o) * 1024 + k0 + kh * 16;
            v4u w0, w1; w0.x = pk2(acc[0], acc[1]); w0.y = pk2(acc[2], acc[3]); w0.z = pk2(acc[4], acc[5]); w0.w = pk2(acc[6], acc[7]);
            w1.x = pk2(acc[8], acc[9]); w1.y = pk2(acc[10], acc[11]); w1.z = pk2(acc[12], acc[13]); w1.w = pk2(acc[14], acc[15]);
            *(v4u*)dst = w0; *(v4u*)(dst + 8) = w1;
        }
        __syncthreads();
    }
#endif
    float* MOD = (float*)(A.ws + WS_CTL) + CW_MOD;
    LAS float* part = (LAS float*)(F.lds + 8 * 16384 - 8192);
    LAS float* ssil = (LAS float*)(F.lds + 8 * 16384 - 8192 - 12288);
    if (F.bid < 2 * 96) { for (int e = F.tid; e < 3072; e += NWAVES * 64) { const int k = e & 1023; ssil[e] = siluf_(e < 1024 ? A.in[1][k] : e < 2048 ? A.in[1][1024 + k] : A.in[3][k]); } }
    __syncthreads();
    for (int it = F.bid; it < 2 * 96; it += F.G) {
        const int l = it / 96, nb = it % 96, n = nb * 64 + F.lane;
        const float* wm = A.in[4] + (size_t)l * 1024 * 6144 + n;
        float a0 = 0.f, a1 = 0.f, a2 = 0.f;
#pragma unroll 32
        for (int k = F.wave * 128; k < F.wave * 128 + 128; ++k) {
            const float w = wm[(size_t)k * 6144];
            a0 += ssil[k] * w; a1 += ssil[1024 + k] * w; a2 += ssil[2048 + k] * w;
        }
        __syncthreads();
        part[(F.wave * 3 + 0) * 64 + F.lane] = a0; part[(F.wave * 3 + 1) * 64 + F.lane] = a1; part[(F.wave * 3 + 2) * 64 + F.lane] = a2;
        __syncthreads();
        if (F.wave < 3) { float s = A.in[5][l * 6144 + n];
#pragma unroll
            for (int w = 0; w < 8; ++w) s += part[(w * 3 + F.wave) * 64 + F.lane];
            MOD[(l * 3 + F.wave) * 6144 + n] = s; }
    }
    for (long i = F.gtid; i < 2L * 4096 * 256; i += F.NT) {
        const int l = (int)(i >> 20), n = (int)((i >> 8) & 4095), kk = (int)(i & 255), pn = n >> 8, rr = n & 255, gate = rr >> 7, rho = rr & 127, d = pn >> 3, cb = pn & 7;
        const int cho = 128 * cb + rho, blk = cho >> 6, e = cho & 63, chi = 256 * (cb >> 1) + kk; float v = 0.f;
        if ((chi >> 6) == blk) v = (gate ? A.in[17] : A.in[15])[((size_t)(l * 2 + d) * 16 + blk) * 4096 + (chi & 63) * 64 + e];
        WLP(l, WO_LRU)[i & 0xFFFFF] = (bf16)f2bf(v);
    }
    for (long i = F.gtid; i < 2L * 65536; i += F.NT) {
        const int which = (int)(i >> 16), n = (int)((i >> 8) & 255), k = (int)(i & 255); float v;
        if (which == 0) { const int k1 = n >> 1, cp = n & 1, t1 = k >> 1, c = k & 1; const float rev = (float)((k1 * t1) & 127) * (1.f / 128.f);
            const float cs = __builtin_amdgcn_cosf(rev), sn = __builtin_amdgcn_sinf(rev); v = cp == 0 ? (c == 0 ? cs : sn) : (c == 0 ? -sn : cs); }
        else { const int h = n >> 7, k2 = (n >> 1) & 63, cp = n & 1, hp = k >> 7, t2 = (k >> 1) & 63, c = k & 1; const float rev = (float)((k2 * t2) & 63) * (1.f / 64.f);
            const float cs = __builtin_amdgcn_cosf(rev), sn = __builtin_amdgcn_sinf(rev); v = (h != hp) ? 0.f : (cp == 0 ? (c == 0 ? cs : sn) : (c == 0 ? -sn : cs)); }
        WLP(0, WO_TAB)[i] = (bf16)f2bf(v);
    }
    for (long i = F.gtid; i < 4096; i += F.NT) ((float*)(A.ws + WS_W + WO_TAB + 262144))[i] = log1pf(expf(-A.in[19][i]));
}

__device__ __forceinline__ void norm_mod_row(const f32x4 (&v)[4], const float* g, const float* sc, const float* sh, bf16* orow, int lane) {
    float s = 0.f;
#pragma unroll
    for (int j = 0; j < 4; ++j) s += (v[j].x * v[j].x + v[j].y * v[j].y) + (v[j].z * v[j].z + v[j].w * v[j].w);
    const float rs = rsqrtf(wave_sum(s) * (1.f / 1024.f) + EPS);
#pragma unroll
    for (int j = 0; j < 4; ++j) { const int c = 4 * lane + 256 * j;
        const f32x4 gg = *(const f32x4*)(g + c), s1 = *(const f32x4*)(sc + c), s0 = *(const f32x4*)(sh + c);
        const float y0 = v[j].x * rs * gg.x * (1.f + s1.x) + s0.x, y1 = v[j].y * rs * gg.y * (1.f + s1.y) + s0.y, y2 = v[j].z * rs * gg.z * (1.f + s1.z) + s0.z, y3 = v[j].w * rs * gg.w * (1.f + s1.w) + s0.w;
        *(unsigned long long*)(orow + c) = (unsigned long long)pk2(y0, y1) | ((unsigned long long)pk2(y2, y3) << 32); }
}
__device__ __forceinline__ void ph_norm1(const Frame& F, const Args& A, int l) {
    bf16* H = WSP(bf16, WS_H);
    for (int R = F.gw; R < MROWS; R += F.NGW) {
        const int b = R / TPB, p = R % TPB, s = (p < CTX) ? 2 : b;
        const float* X = (p < CTX) ? A.in[2] + ((size_t)b * CTX + p) * 1024 : A.in[0] + ((size_t)b * SEQ + (p - CTX)) * 1024;
        f32x4 v[4];
#pragma unroll
        for (int j = 0; j < 4; ++j) v[j] = *(const f32x4*)(X + 4 * F.lane + 256 * j);
        norm_mod_row(v, A.in[6] + l * 1024, MODP(l, s, 1), MODP(l, s, 0), H + (size_t)R * 1024, F.lane);
    }
}

__device__ __forceinline__ void ph_uelem(const Frame& F, const Args& A, int l) {
    const float* U = WSP(float, WS_U);
    bf16 *Kb = WSP(bf16, WS_KB), *Vb = WSP(bf16, WS_VB), *Qb = WSP(bf16, WS_QB), *LXb = WSP(bf16, WS_LXB), *GLG = WSP(bf16, WS_GLG), *ZP = WSP(bf16, WS_ZP), *GT = WSP(bf16, WS_GATES);
    LAS float* sF = (LAS float*)F.lds; LAS float* sT = sF + 1024;
    if (F.tid < 256) sT[F.tid] = cospif((float)F.tid / 128.0f);
    __syncthreads();
    for (int R = F.bid; R < MROWS; R += F.G) {
        const float* u = U + (size_t)R * INW; const int p = R % TPB; const bool lat = p >= CTX; const int t = p - CTX;
        for (int gi = F.wave; gi < 32; gi += 8) {
            const bool isq = gi >= 16; const int grp = gi & 15;
            const float v = u[(isq ? COL_Q : COL_K) + grp * 64 + F.lane];
            const float ss = wave_sum(v * v);
            float y = v * rsqrtf(ss * (1.f / 64.f) + EPS) * (isq ? A.in[8] : A.in[9])[l * 64 + F.lane];
            const float part = sx<16>(y);
            if (lat) { const int axis = F.lane >> 5, hf = (F.lane >> 4) & 1, f = F.lane & 15;
                const float pos = (float)(axis ? (t & 63) : (t >> 6)); const float inv = exp2f(-(float)f * (13.287712379549449f / 16.f));
                float sn, cs; sincosf(pos * inv, &sn, &cs);
                y = hf ? (part * sn + y * cs) : (y * cs - part * sn); }
            if (isq) y *= QSCALE;
            (isq ? Qb : Kb)[(size_t)R * 1024 + grp * 64 + F.lane] = (bf16)f2bf(y);
        }
        for (int c = F.tid; c < 1024; c += 512) { const size_t o = (size_t)R * 1024 + c;
            Vb[o] = (bf16)f2bf(u[COL_V + c]); LXb[o] = (bf16)f2bf(u[COL_LX + c]); GLG[o] = (bf16)f2bf(gelu_tanh(u[COL_LG + c])); sF[c] = u[COL_F + c]; }
        for (int c = F.tid; c < 3072; c += 512) GT[(size_t)R * 3072 + c] = (bf16)f2bf(sigmoidf_(u[COL_G + c]));
        __syncthreads();
        for (int o = F.tid; o < 1024; o += 512) { const int g = o >> 8, oo = o & 255; int j = oo >> 1, odd = oo & 1; if (oo == 1) { j = 128; odd = 0; }
            const int m0 = odd ? 192 : 0; float acc = 0.f;
            for (int c = 0; c < 256; ++c) acc += sF[g * 256 + c] * sT[(j * c + m0) & 255];
            ZP[(size_t)R * 1024 + o] = (bf16)f2bf(acc); }
        __syncthreads();
    }
}

__device__ __forceinline__ void ph_conv(const Frame& F, const Args& A, int l) {
    const bf16* LXb = WSP(bf16, WS_LXB); bf16* UC = WSP(bf16, WS_UC);
    const int c8 = (int)(F.gtid & 127) * 8, r0 = (int)(F.gtid >> 7), rstep = (int)(F.NT >> 7);
    float w[4][8], bia[8];
#pragma unroll
    for (int j = 0; j < 4; ++j) { const f32x4 a = *(const f32x4*)(A.in[13] + l * 4096 + j * 1024 + c8), b = *(const f32x4*)(A.in[13] + l * 4096 + j * 1024 + c8 + 4);
        w[j][0] = a.x; w[j][1] = a.y; w[j][2] = a.z; w[j][3] = a.w; w[j][4] = b.x; w[j][5] = b.y; w[j][6] = b.z; w[j][7] = b.w; }
    { const f32x4 a = *(const f32x4*)(A.in[14] + l * 1024 + c8), b = *(const f32x4*)(A.in[14] + l * 1024 + c8 + 4);
      bia[0] = a.x; bia[1] = a.y; bia[2] = a.z; bia[3] = a.w; bia[4] = b.x; bia[5] = b.y; bia[6] = b.z; bia[7] = b.w; }
    for (int Rb = r0; Rb < MROWS; Rb += 4 * rstep) {
        v4u x[4][4];
#pragma unroll
        for (int u = 0; u < 4; ++u) { const int R = Rb + u * rstep; if (R < MROWS) { const int p = R % TPB, lo = p < CTX ? 0 : CTX, hi = p < CTX ? CTX : TPB;
#pragma unroll
            for (int j = 0; j < 4; ++j) { const int pp = p + j - 2; x[u][j] = (pp >= lo && pp < hi) ? *(const v4u*)(LXb + (size_t)(R + j - 2) * 1024 + c8) : (v4u){0u, 0u, 0u, 0u}; } } }
#pragma unroll
        for (int u = 0; u < 4; ++u) { const int R = Rb + u * rstep; if (R < MROWS) { float acc[8];
#pragma unroll
            for (int e = 0; e < 8; ++e) acc[e] = bia[e];
#pragma unroll
            for (int j = 0; j < 4; ++j) { const unsigned xs[4] = {x[u][j].x, x[u][j].y, x[u][j].z, x[u][j].w};
#pragma unroll
                for (int q = 0; q < 4; ++q) { acc[2 * q] += w[j][2 * q] * bf2f(xs[q] & 0xffffu); acc[2 * q + 1] += w[j][2 * q + 1] * bf2f(xs[q] >> 16); } }
            v4u o; o.x = pk2(acc[0], acc[1]); o.y = pk2(acc[2], acc[3]); o.z = pk2(acc[4], acc[5]); o.w = pk2(acc[6], acc[7]);
            *(v4u*)(UC + (size_t)R * 1024 + c8) = o; } }
    }
}
#if !FAST_LRU
__device__ __forceinline__ void ph_lrucoef(const Frame& F, const Args& A, int l) {
    const bf16* UC = WSP(bf16, WS_UC); unsigned* AB = WSP(unsigned, WS_AB);
    for (long i = F.gtid; i < 2L * MROWS * 1024; i += F.NT) {
        const int d = (int)(i / ((long)MROWS * 1024)); const long rem = i % ((long)MROWS * 1024); const int R = (int)(rem >> 10), ch = (int)(rem & 1023), blk = ch >> 6, e = ch & 63;
        const float* wa = A.in[15] + ((size_t)(l * 2 + d) * 16 + blk) * 4096 + e; const float* wi = A.in[17] + ((size_t)(l * 2 + d) * 16 + blk) * 4096 + e;
        float r = A.in[16][(l * 2 + d) * 1024 + ch], ig = A.in[18][(l * 2 + d) * 1024 + ch];
        const bf16* ur = UC + (size_t)R * 1024 + blk * 64;
        for (int dd = 0; dd < 64; ++dd) { const float x = bf2f(ur[dd]); r += x * wa[dd * 64]; ig += x * wi[dd * 64]; }
        const float lam = A.in[19][(l * 2 + d) * 1024 + ch]; const float sp = log1pf(expf(-lam));
        const float la = -8.f * sigmoidf_(r) * sp; const float mult = sqrtf(-expm1f(2.f * la));
        const float bc = mult * sigmoidf_(ig) * bf2f(ur[e]);
        AB[i] = pk2(la, bc);
    }
}
#endif
struct LruSched {
    const char* uc; const char* w; int G, c;
    __device__ __forceinline__ bool next(int i, pg8::UnitG& U) const {
        const long id = (long)i * G + c; if (id >= 66 * 16) return false;
        const int pm = (int)(id >> 4), pn = (int)(id & 15);
        U.a = uc + ((size_t)pm * 256 * 1024 + 256 * ((pn & 7) >> 1)) * 2; U.b = w + (size_t)pn * 256 * 256 * 2; U.row0 = pm * 256; U.pn = pn; U.e = 0; U.valid = 256; U.rows = nullptr; return true;
    }
};
struct EpiLru {
    static constexpr bool PERM = false;
    unsigned* AB; const bf16* UC; const float* ba; const float* bi; const float* sp;
    __device__ __forceinline__ void operator()(const f32x4 (&acc)[2][2][4][2], const pg8::UnitG& u, int wr, int wc, int fr, int fq) const {
        const int d = u.pn >> 3, cb = u.pn & 7, ch0 = 128 * cb + wc * 32 + 4 * fq;
        f32x4 vba[2], vbi[2], vsp[2];
#pragma unroll
        for (int n = 0; n < 2; ++n) { vba[n] = *(const f32x4*)(ba + d * 1024 + ch0 + 16 * n) * -1.4426950408889634f; vbi[n] = *(const f32x4*)(bi + d * 1024 + ch0 + 16 * n) * -1.4426950408889634f; vsp[n] = *(const f32x4*)(sp + d * 1024 + ch0 + 16 * n) * -8.f; }
#pragma unroll
        for (int ai = 0; ai < 2; ++ai) { unsigned long long uxs[4][2];
#pragma unroll
            for (int m = 0; m < 4; ++m)
#pragma unroll
                for (int n = 0; n < 2; ++n) uxs[m][n] = *(const unsigned long long*)(UC + ((size_t)u.row0 + ai * 128 + wr * 64 + m * 16 + fr) * 1024 + ch0 + 16 * n);
#pragma unroll
            for (int m = 0; m < 4; ++m) { const size_t R = (size_t)u.row0 + ai * 128 + wr * 64 + m * 16 + fr;
#pragma unroll
                for (int n = 0; n < 2; ++n) { const int ch = ch0 + 16 * n;
                    const unsigned long long ux = uxs[m][n];
                    const float x[4] = {bf2f((unsigned)ux & 0xffffu), bf2f(((unsigned)ux) >> 16), bf2f((unsigned)(ux >> 32) & 0xffffu), bf2f((unsigned)(ux >> 48))};
                    const f32x4 r = acc[ai][0][m][n], g = acc[ai][1][m][n]; v4u o;
#pragma unroll
                    for (int e = 0; e < 4; ++e) {
                        const float la = vsp[n][e] * __builtin_amdgcn_rcpf(1.f + __builtin_amdgcn_exp2f(__builtin_fmaf(r[e], -1.4426950408889634f, vba[n][e])));
                        const float mult = __builtin_amdgcn_sqrtf(1.f - __builtin_amdgcn_exp2f(la * 2.8853900817779268f));
                        o[e] = pk2(la, mult * __builtin_amdgcn_rcpf(1.f + __builtin_amdgcn_exp2f(__builtin_fmaf(g[e], -1.4426950408889634f, vbi[n][e]))) * x[e]); }
                    *(v4u*)(AB + ((size_t)d * MROWS + R) * 1024 + ch) = o; } }
            asm volatile("" ::: "memory"); }
    }
};
__device__ __forceinline__ void ph_lru_gemm(const Frame& F, const Args& A, int l, int Ge) {
    LruSched S{(const char*)WSP(bf16, WS_UC), (const char*)WLP(l, WO_LRU), Ge, F.bid};
    EpiLru E{WSP(unsigned, WS_AB), WSP(bf16, WS_UC), A.in[16] + l * 2048, A.in[18] + l * 2048, (const float*)(A.ws + WS_W + WO_TAB + 262144) + l * 2048};
    pg8::gemm_phase_g<EpiLru, LruSched, false>(F.lds, 256, 1024, 256, S, E);
}
struct FftSched {
    const char* x; const char* w; int nunits, G, c;
    __device__ __forceinline__ bool next(int i, pg8::UnitG& U) const {
        const long id = (long)i * G + c; if (id >= nunits) return false;
        U.a = x + (size_t)id * 256 * 256 * 2; U.b = w; U.row0 = (int)id * 256; U.pn = 0; U.e = 0; U.valid = 256; U.rows = nullptr; return true;
    }
};
struct EpiFftA {
    static constexpr bool PERM = false;
    unsigned* XB;
    __device__ __forceinline__ void operator()(const f32x4 (&acc)[2][2][4][2], const pg8::UnitG& u, int wr, int wc, int fr, int fq) const {
#pragma unroll
        for (int ai = 0; ai < 2; ++ai)
#pragma unroll
            for (int m = 0; m < 4; ++m) { int r0 = u.row0; asm volatile("" : "+s"(r0));
                const int row = r0 + ai * 128 + wr * 64 + m * 16 + fr, t2 = row & 63; const size_t bc = (size_t)(row >> 6);
#pragma unroll
                for (int bj = 0; bj < 2; ++bj)
#pragma unroll
                    for (int n = 0; n < 2; ++n) { const int k1 = 64 * bj + 16 * wc + 8 * n + 2 * fq; const f32x4 v = acc[ai][bj][m][n];
#pragma unroll
                        for (int q = 0; q < 2; ++q) { const int kk = k1 + q; const float rev = (float)(kk * t2) * (1.f / 8192.f);
                            const float cs = __builtin_amdgcn_cosf(rev), sn = __builtin_amdgcn_sinf(rev); const float yr = v[2 * q], yi = v[2 * q + 1];
                            XB[(bc * 64 + (kk >> 1)) * 128 + (kk & 1) * 64 + t2] = pk2(yr * cs + yi * sn, yi * cs - yr * sn); } }
                asm volatile("" ::: "memory"); }
    }
};
struct EpiBf16Plain {
    static constexpr bool PERM = true;
    bf16* C; int ldc;
    __device__ __forceinline__ void operator()(const f32x4 (&acc)[2][2][4][2], const pg8::UnitG& u, int wr, int wc, int fr, int fq) const {
#pragma unroll
        for (int ai = 0; ai < 2; ++ai)
#pragma unroll
            for (int m = 0; m < 4; ++m) { bf16* rowp = C + (size_t)(u.row0 + ai * 128 + wr * 64 + m * 16 + fr) * ldc + u.pn * 256 + wc * 32 + 8 * fq;
#pragma unroll
                for (int bj = 0; bj < 2; ++bj) { const f32x4 v0 = acc[ai][bj][m][0], v1 = acc[ai][bj][m][1];
                    v4u o; o.x = pk2(v0[0], v0[1]); o.y = pk2(v0[2], v0[3]); o.z = pk2(v1[0], v1[1]); o.w = pk2(v1[2], v1[3]);
                    *(v4u*)(rowp + bj * 128) = o; } }
    }
};
struct EpiBf16U {
    static constexpr bool PERM = true; static constexpr int MIDK = 0;
    bf16* C; int ldc;
    __device__ __forceinline__ void operator()(const f32x4 (&acc)[2][2][4][2], const pg8::Unit& u, int wr, int wc, int fr, int fq) const {
#pragma unroll
        for (int ai = 0; ai < 2; ++ai)
#pragma unroll
            for (int m = 0; m < 4; ++m) { bf16* rowp = C + (size_t)(u.pm * 256 + ai * 128 + wr * 64 + m * 16 + fr) * ldc + u.pn * 256 + wc * 32 + 8 * fq;
#pragma unroll
                for (int bj = 0; bj < 2; ++bj) { const f32x4 v0 = acc[ai][bj][m][0], v1 = acc[ai][bj][m][1];
                    v4u o; o.x = pk2(v0[0], v0[1]); o.y = pk2(v0[2], v0[3]); o.z = pk2(v1[0], v1[1]); o.w = pk2(v1[2], v1[3]);
                    *(v4u*)(rowp + bj * 128) = o; } }
    }
};
__device__ __forceinline__ void ph_fft_a_gemm(const Frame& F, const Args& A) {
    FftSched S{(const char*)WSP(bf16, WS_XA), (const char*)WLP(0, WO_TAB), 256, F.G, F.bid};
    EpiFftA E{WSP(unsigned, WS_XB)};
    pg8::gemm_phase_g<EpiFftA, FftSched, false>(F.lds, 256, 256, 256, S, E);
}
__device__ __forceinline__ void ph_fft_b_gemm(const Frame& F, const Args& A) {
    FftSched S{(const char*)WSP(bf16, WS_XB), (const char*)(WLP(0, WO_TAB) + 65536), 256, F.G, F.bid};
    EpiBf16Plain E{WSP(bf16, WS_GB), 256};
    pg8::gemm_phase_g<EpiBf16Plain, FftSched, false>(F.lds, 256, 256, 256, S, E);
}
__device__ __forceinline__ void ph_scan1(const Frame& F, const Args& A) {
    const unsigned* AB = WSP(unsigned, WS_AB); float2* SUMM = WSP(float2, WS_SUMM);
    for (int it = F.gw; it < NB * 2 * NCHUNK * 16; it += F.NGW) {
        const int cg = it & 15, ck = (it >> 4) % NCHUNK, bd = (it >> 4) / NCHUNK, b = bd >> 1, d = bd & 1, ch = cg * 64 + F.lane;
        const unsigned* ab = AB + ((size_t)d * MROWS + (size_t)b * TPB + ck * 64) * 1024 + ch;
        float ac = 1.f, h = 0.f;
#pragma unroll
        for (int q = 0; q < 4; ++q) { unsigned w[16];
#pragma unroll
            for (int k = 0; k < 16; ++k) { const int i = q * 16 + k, ii = d ? 63 - i : i; w[k] = ab[(size_t)ii * 1024]; }
#pragma unroll
            for (int k = 0; k < 16; ++k) { const float a = __expf(bf2f(w[k] & 0xffffu)); h = a * h + bf2f(w[k] >> 16); ac *= a; } }
        SUMM[((size_t)bd * NCHUNK + ck) * 1024 + ch] = make_float2(ac, h);
    }
}
__device__ __forceinline__ void ph_scan2(const Frame& F, const Args& A) {
    const float2* SUMM = WSP(float2, WS_SUMM); float* CARRY = WSP(float, WS_CARRY);
    if (F.gtid < 4096) {
        const int bd = (int)(F.gtid >> 10), ch = (int)(F.gtid & 1023), d = bd & 1; float h = 0.f;
        for (int s = 0; s < NCHUNK; ++s) { const int ck = d ? (s < 4 ? 3 - s : NCHUNK + 3 - s) : s;
            const size_t o = ((size_t)bd * NCHUNK + ck) * 1024 + ch; CARRY[o] = h; const float2 v = SUMM[o]; h = v.x * h + v.y; }
    }
}
__device__ __forceinline__ void ph_scan3(const Frame& F, const Args& A, int l) {
    const unsigned* AB = WSP(unsigned, WS_AB); const float* CARRY = WSP(float, WS_CARRY); const bf16* GLG = WSP(bf16, WS_GLG); bf16* MX = WSP(bf16, WS_MIXIN);
    const int c0 = (l == DEPTH - 1) ? CTX / 64 : 0, nck = NCHUNK - c0;
    for (int it = F.gw; it < NB * nck * 16; it += F.NGW) {
        const int cg = it & 15, ck = c0 + (it >> 4) % nck, b = (it >> 4) / nck, ch = cg * 64 + F.lane; const size_t R0 = (size_t)b * TPB + ck * 64;
        const unsigned* ab0 = AB + R0 * 1024 + ch; const unsigned* ab1 = AB + ((size_t)MROWS + R0) * 1024 + ch;
        float hf[64]; float h = CARRY[((size_t)(b * 2 + 0) * NCHUNK + ck) * 1024 + ch];
#pragma unroll
        for (int q = 0; q < 4; ++q) { unsigned w[16];
#pragma unroll
            for (int k = 0; k < 16; ++k) w[k] = ab0[(size_t)(q * 16 + k) * 1024];
#pragma unroll
            for (int k = 0; k < 16; ++k) { h = __expf(bf2f(w[k] & 0xffffu)) * h + bf2f(w[k] >> 16); hf[q * 16 + k] = h; } }
        h = CARRY[((size_t)(b * 2 + 1) * NCHUNK + ck) * 1024 + ch];
#pragma unroll
        for (int q = 3; q >= 0; --q) { unsigned w[16]; bf16 g[16];
#pragma unroll
            for (int k = 0; k < 16; ++k) { const int i = q * 16 + 15 - k; w[k] = ab1[(size_t)i * 1024]; g[k] = GLG[(R0 + i) * 1024 + ch]; }
#pragma unroll
            for (int k = 0; k < 16; ++k) { const int i = q * 16 + 15 - k; h = __expf(bf2f(w[k] & 0xffffu)) * h + bf2f(w[k] >> 16);
                MX[(R0 + i) * 3072 + 1024 + ch] = (bf16)f2bf((hf[i] + h) * bf2f(g[k])); } }
    }
}

__device__ __forceinline__ void ph_fft_t1_fast(const Frame& F, const Args& A) {
    const unsigned* ZP = WSP(unsigned, WS_ZP); unsigned* XA = WSP(unsigned, WS_XA); LAS unsigned* T = (LAS unsigned*)F.lds;
    for (int item = F.bid; item < 512; item += F.G) {
        const int b = item >> 8, t2 = (item >> 2) & 63, cq = item & 3;
        __syncthreads();
#pragma unroll
        for (int i = 0; i < 8; ++i) { const int p = F.tid + 512 * i, t1 = p >> 5, w4 = (p & 31) * 4;
            const v4u v = *(const v4u*)(ZP + ((size_t)b * TPB + CTX + 64 * t1 + t2) * 512 + cq * 128 + w4);
            T[t1 * 129 + w4] = v.x; T[t1 * 129 + w4 + 1] = v.y; T[t1 * 129 + w4 + 2] = v.z; T[t1 * 129 + w4 + 3] = v.w; }
        __syncthreads();
#pragma unroll
        for (int i = 0; i < 16; ++i) { const int p = F.tid + 512 * i, cc = p >> 6, t1 = (p & 63) * 2;
            const unsigned long long v = (unsigned long long)T[t1 * 129 + cc] | ((unsigned long long)T[(t1 + 1) * 129 + cc] << 32);
            *(unsigned long long*)(XA + (((size_t)b * 512 + cq * 128 + cc) * 64 + t2) * 128 + t1) = v; }
    }
    __syncthreads();
}
__device__ __forceinline__ void ph_fft_t2_fast(const Frame& F, const Args& A, int l) {
    const unsigned* GB = WSP(unsigned, WS_GB); bf16* MX = WSP(bf16, WS_MIXIN); LAS unsigned* T = (LAS unsigned*)F.lds;
    LAS unsigned short* OUTS = (LAS unsigned short*)(F.lds + 2 * 128 * 65 * 4);
    const bool bal = F.G == 256; const int nmine = bal ? (F.bid < 252 ? 2 : 4) : (520 - F.bid + F.G - 1) / F.G;
    for (int ii = 0; ii < nmine; ++ii) {
        int b, kp, g;
        if (bal) { if (F.bid < 252) { const int f = 2 * F.bid + ii; b = f / 252; const int rem = f % 252; kp = 1 + (rem >> 2); g = rem & 3; }
                   else { const int h = 4 * (F.bid - 252) + ii; b = h >> 3; kp = ((h >> 2) & 1) ? 64 : 0; g = h & 3; } }
        else { const int item = F.bid + ii * F.G; b = item / 260; const int rem = item % 260; kp = rem >> 2; g = rem & 3; }
        const int k1a = kp, k1b = (128 - kp) & 127;
        __syncthreads();
#pragma unroll
        for (int i = 0; i < 8; ++i) { const int p = F.tid + 512 * i, blk = p >> 11, cc = (p >> 4) & 127, w4 = (p & 15) * 4, kk = blk ? k1b : k1a;
            const v4u v = *(const v4u*)(GB + (((size_t)b * 512 + g * 128 + cc) * 64 + (kk >> 1)) * 128 + (kk & 1) * 64 + w4);
            LAS unsigned* d = T + blk * (128 * 65) + cc * 65 + w4; d[0] = v.x; d[1] = v.y; d[2] = v.z; d[3] = v.w; }
        __syncthreads();
        const int jc = F.tid & 255, j = (jc == 0 || jc == 128) ? 0 : (jc < 128 ? jc : 256 - jc);
        const int nset = (k1a == k1b) ? 1 : 2;
        for (int set = 0; set < nset; ++set) { const int ka = set ? k1b : k1a;
            for (int k2 = (F.tid >> 8); k2 < 64; k2 += 2) {
                const int mk2 = (ka == 0) ? ((64 - k2) & 63) : 63 - k2;
                const unsigned own = T[set * (128 * 65) + j * 65 + k2], mir = T[(nset == 1 ? 0 : (1 - set)) * (128 * 65) + j * 65 + mk2];
                float o; if (jc == 0) o = 0.5f * (bf2f(own & 0xffffu) + bf2f(mir & 0xffffu)); else if (jc == 128) o = 0.5f * (bf2f(own >> 16) + bf2f(mir >> 16)); else if (jc < 128) o = bf2f(mir & 0xffffu); else o = bf2f(own & 0xffffu);
                OUTS[k2 * 256 + jc] = (unsigned short)f2bf(o * 6.9053396600248786e-4f); }
            __syncthreads();
#pragma unroll
            for (int i = 0; i < 4; ++i) { const int p = F.tid + 512 * i, k2 = p >> 5, c8 = (p & 31) * 8;
                *(v4u*)(MX + ((size_t)b * TPB + CTX + ka + 128 * k2) * 3072 + 2048 + g * 256 + c8) = *(const LAS v4u*)(OUTS + k2 * 256 + c8); }
            __syncthreads(); }
    }
    __syncthreads();
    const float2* GC = WSP(float2, WS_GC);
    if (l + 1 < DEPTH) for (long i = F.gtid; i < (long)NB * CTX * 1024; i += F.NT) {
        const int col = (int)(i & 1023), k = (int)((i >> 10) & 255), b = (int)(i >> 18), g = col >> 8, jc = col & 255, km = (256 - k) & 255;
        const int j = (jc == 0 || jc == 128) ? 0 : (jc < 128 ? jc : 256 - jc); const size_t base = ((size_t)b * 512 + g * 128 + j) * 256;
        const float2 w = GC[base + k], wm = GC[base + km];
        float o; if (jc == 0) o = 0.5f * (w.x + wm.x); else if (jc == 128) o = 0.5f * (w.y + wm.y); else if (jc < 128) o = wm.x; else o = w.x;
        MX[((size_t)b * TPB + k) * 3072 + 2048 + col] = (bf16)f2bf(o * 3.90625e-3f);
    }
}
__device__ __forceinline__ void ph_scan2_fast(const Frame& F, const Args& A) {
    const float2* SUMM = WSP(float2, WS_SUMM); float* CARRY = WSP(float, WS_CARRY);
    for (int it = F.gw; it < 256; it += F.NGW) {
        const int bd = it >> 6, d = bd & 1, ch = (it & 63) * 16 + (F.lane & 15), seg = F.lane >> 4;
        float2 v[33]; float as = 1.f, hs = 0.f;
#pragma unroll
        for (int q = 0; q < 33; ++q) { const int sidx = seg * 33 + q, ck = d ? (sidx < 4 ? 3 - sidx : NCHUNK + 3 - sidx) : sidx; v[q] = SUMM[((size_t)bd * NCHUNK + ck) * 1024 + ch]; }
#pragma unroll
        for (int q = 0; q < 33; ++q) { hs = v[q].x * hs + v[q].y; as *= v[q].x; }
        const float a16 = sx<16>(as), h16 = sx<16>(hs), a32 = sx<32>(as), h32 = sx<32>(hs), a48 = sx<32>(a16), h48 = sx<32>(h16);
        float h = 0.f;
#pragma unroll
        for (int jx = 0; jx < 3; ++jx) { const int x = jx ^ seg;
            const float aj = x == 0 ? as : (x == 1 ? a16 : (x == 2 ? a32 : a48)), hj = x == 0 ? hs : (x == 1 ? h16 : (x == 2 ? h32 : h48));
            if (jx < seg) h = aj * h + hj; }
#pragma unroll
        for (int q = 0; q < 33; ++q) { const int sidx = seg * 33 + q, ck = d ? (sidx < 4 ? 3 - sidx : NCHUNK + 3 - sidx) : sidx; CARRY[((size_t)bd * NCHUNK + ck) * 1024 + ch] = h; h = v[q].x * h + v[q].y; }
    }
}

__device__ __forceinline__ void ph_fft_t1(const Frame& F, const Args& A) {
    const unsigned* ZP = WSP(unsigned, WS_ZP); unsigned* XA = WSP(unsigned, WS_XA);
    for (long i = F.gtid; i < (long)NB * 512 * 8192; i += F.NT) {
        const int t1 = (int)(i & 127), t2 = (int)((i >> 7) & 63), cc = (int)((i >> 13) & 511), b = (int)(i >> 22);
        XA[i] = ZP[((size_t)b * TPB + CTX + 64 * t1 + t2) * 512 + cc];
    }
}
#if !FAST_FFT
__device__ __forceinline__ void ph_fft_a(const Frame& F, const Args& A) {
    const unsigned* XA = WSP(unsigned, WS_XA); unsigned* XB = WSP(unsigned, WS_XB);
    for (long i = F.gtid; i < (long)NB * 512 * 8192; i += F.NT) {
        const int k1 = (int)(i & 127); const long row = i >> 7; const int t2 = (int)(row & 63); const long bc = row >> 6;
        const unsigned* x = XA + row * 128; float yr = 0.f, yi = 0.f;
        for (int t1 = 0; t1 < 128; ++t1) { const unsigned w = x[t1]; const float wr = bf2f(w & 0xffffu), wi = bf2f(w >> 16);
            float sn, cs; sincospif((float)((k1 * t1) & 127) / 64.0f, &sn, &cs);
            yr += wr * cs + wi * sn; yi += wi * cs - wr * sn; }
        float sn, cs; sincospif((float)(k1 * t2) / 4096.0f, &sn, &cs);
        const float zr = yr * cs + yi * sn, zi = yi * cs - yr * sn;
        XB[(bc * 64 + (k1 >> 1)) * 128 + (k1 & 1) * 64 + t2] = pk2(zr, zi);
    }
}
#endif
#if !FAST_FFT
__device__ __forceinline__ void ph_fft_b(const Frame& F, const Args& A) {
    const unsigned* XB = WSP(unsigned, WS_XB); unsigned* GB = WSP(unsigned, WS_GB);
    for (long i = F.gtid; i < (long)NB * 512 * 8192; i += F.NT) {
        const int k2 = (int)(i & 63); const long hrow = i >> 6;
        const unsigned* x = XB + hrow * 64; float yr = 0.f, yi = 0.f;
        for (int t2 = 0; t2 < 64; ++t2) { const unsigned w = x[t2]; const float wr = bf2f(w & 0xffffu), wi = bf2f(w >> 16);
            float sn, cs; sincospif((float)((k2 * t2) & 63) / 32.0f, &sn, &cs);
            yr += wr * cs + wi * sn; yi += wi * cs - wr * sn; }
        GB[hrow * 64 + k2] = pk2(yr, yi);
    }
}
#endif
__device__ __forceinline__ void ph_fft_c(const Frame& F, const Args& A) {
    const unsigned* ZP = WSP(unsigned, WS_ZP); float2* GC = WSP(float2, WS_GC);
    LAS unsigned* Z = (LAS unsigned*)F.lds; LAS float* TWc = (LAS float*)(F.lds + 16384); LAS float* TWs = TWc + 256;
    __syncthreads();
    if (F.tid < 256) { const float rev = (float)F.tid * (1.f / 256.f); TWc[F.tid] = __builtin_amdgcn_cosf(rev); TWs[F.tid] = __builtin_amdgcn_sinf(rev); }
    for (int item = F.bid; item < 256; item += F.G) {
        const int b = item >> 7, c0 = ((item >> 2) & 31) * 16, kq = item & 3;
        __syncthreads();
        for (int e = F.tid; e < 4096; e += 512) Z[e] = ZP[((size_t)b * TPB + (e >> 4)) * 512 + c0 + (e & 15)];
        __syncthreads();
        const int cc = F.tid & 15, kb = kq * 64 + (F.tid >> 4) * 2; float ar[2], ai[2]; int m[2];
#pragma unroll
        for (int q = 0; q < 2; ++q) { ar[q] = 0.f; ai[q] = 0.f; m[q] = 0; }
#pragma unroll 4
        for (int t = 0; t < 256; ++t) { const unsigned w = Z[t * 16 + cc]; const float wr = bf2f(w & 0xffffu), wi = bf2f(w >> 16);
#pragma unroll
            for (int q = 0; q < 2; ++q) { const float tc = TWc[m[q]], ts = TWs[m[q]]; ar[q] += wr * tc + wi * ts; ai[q] += wi * tc - wr * ts; m[q] = (m[q] + kb + q) & 255; } }
#pragma unroll
        for (int q = 0; q < 2; ++q) GC[((size_t)b * 512 + c0 + cc) * 256 + kb + q] = make_float2(ar[q], ai[q]);
    }
    __syncthreads();
}
__device__ __forceinline__ void ph_fft_t2(const Frame& F, const Args& A) {
    const unsigned* GB = WSP(unsigned, WS_GB); const float2* GC = WSP(float2, WS_GC); bf16* MX = WSP(bf16, WS_MIXIN);
    for (long i = F.gtid; i < (long)MROWS * 1024; i += F.NT) {
        const int R = (int)(i >> 10), col = (int)(i & 1023), g = col >> 8, jc = col & 255, b = R / TPB, p = R % TPB;
        const bool lat = p >= CTX; const int T = lat ? SEQ : CTX, k = lat ? p - CTX : p, km = (T - k) & (T - 1);
        const int j = (jc == 0 || jc == 128) ? 0 : (jc < 128 ? jc : 256 - jc); const int cc = g * 128 + j;
        float vr, vi, mr, mi;
        if (lat) { const size_t base = ((size_t)b * 512 + cc) * 64;
            const unsigned w = GB[(base + ((k & 127) >> 1)) * 128 + (k & 1) * 64 + (k >> 7)], wm = GB[(base + ((km & 127) >> 1)) * 128 + (km & 1) * 64 + (km >> 7)];
            vr = bf2f(w & 0xffffu); vi = bf2f(w >> 16); mr = bf2f(wm & 0xffffu); mi = bf2f(wm >> 16); }
        else { const float2 w = GC[((size_t)b * 512 + cc) * 256 + k], wm = GC[((size_t)b * 512 + cc) * 256 + km]; vr = w.x; vi = w.y; mr = wm.x; mi = wm.y; }
        float o;
        if (jc == 0) o = 0.5f * (vr + mr); else if (jc == 128) o = 0.5f * (vi + mi); else if (jc < 128) o = mr; else o = vr;
        o *= lat ? 6.9053396600248786e-4f : 3.90625e-3f;
        MX[(size_t)R * 3072 + 2048 + col] = (bf16)f2bf(o);
    }
}

#if !FAST_ATTN
__device__ __forceinline__ void ph_attn_naive(const Frame& F, const Args& A, int l) {
    const bf16 *Kb = WSP(bf16, WS_KB), *Vb = WSP(bf16, WS_VB), *Qb = WSP(bf16, WS_QB); bf16* MX = WSP(bf16, WS_MIXIN);
    const float* lq = A.in[10] + l * 256; float d01 = 0.f, d23 = 0.f;
    for (int i = 0; i < 64; ++i) { d01 += lq[i] * lq[64 + i]; d23 += lq[128 + i] * lq[192 + i]; }
    const float lam_init = 0.8f - 0.6f * expf(-0.3f * (float)l), lam = expf(d01) - expf(d23) + lam_init;
    LAS float* Ks = (LAS float*)F.lds; LAS float* Vs = Ks + 64 * 132; LAS float* Qs = Vs + 64 * 132; LAS float* Ws = Qs + 16 * 128;
    const int r = F.tid >> 5, tl = F.tid & 31;
    for (int u = F.bid; u < 16 * 528; u += F.G) {
        const int bh = u / 528, qb = u % 528, b = bh >> 3, h = bh & 7; const size_t R0 = (size_t)b * TPB + qb * 16; const int nkeys = qb < 16 ? CTX : TPB;
        __syncthreads();
        for (int e = F.tid; e < 2048; e += 512) Qs[e] = bf2f(Qb[(R0 + (e >> 7)) * 1024 + h * 128 + (e & 127)]);
        float m0 = -1e30f, l0 = 0.f, m1 = -1e30f, l1 = 0.f;
        for (int pass = 0; pass < 2; ++pass) {
            float inv0 = 0.f, inv1 = 0.f;
            if (pass == 1) {
#pragma unroll
                for (int o = 1; o < 32; o <<= 1) { float mo = __shfl_xor(m0, o), lo = __shfl_xor(l0, o), mn = fmaxf(m0, mo); l0 = l0 * exp2f(m0 - mn) + lo * exp2f(mo - mn); m0 = mn;
                    mo = __shfl_xor(m1, o); lo = __shfl_xor(l1, o); mn = fmaxf(m1, mo); l1 = l1 * exp2f(m1 - mn) + lo * exp2f(mo - mn); m1 = mn; }
                inv0 = 1.f / l0; inv1 = lam / l1;
            }
            float o4[4] = {0.f, 0.f, 0.f, 0.f};
            for (int kt = 0; kt < nkeys; kt += 64) {
                __syncthreads();
                for (int e = F.tid; e < 1024; e += 512) { const int kk = e >> 4, c8 = (e & 15) * 8; const size_t src = ((size_t)b * TPB + kt + kk) * 1024 + h * 128 + c8;
                    const v4u kv = *(const v4u*)(Kb + src);
                    Ks[kk * 132 + c8 + 0] = bf2f(kv.x & 0xffffu); Ks[kk * 132 + c8 + 1] = bf2f(kv.x >> 16); Ks[kk * 132 + c8 + 2] = bf2f(kv.y & 0xffffu); Ks[kk * 132 + c8 + 3] = bf2f(kv.y >> 16);
                    Ks[kk * 132 + c8 + 4] = bf2f(kv.z & 0xffffu); Ks[kk * 132 + c8 + 5] = bf2f(kv.z >> 16); Ks[kk * 132 + c8 + 6] = bf2f(kv.w & 0xffffu); Ks[kk * 132 + c8 + 7] = bf2f(kv.w >> 16);
                    if (pass == 1) { const v4u vv = *(const v4u*)(Vb + src);
                        Vs[kk * 132 + c8 + 0] = bf2f(vv.x & 0xffffu); Vs[kk * 132 + c8 + 1] = bf2f(vv.x >> 16); Vs[kk * 132 + c8 + 2] = bf2f(vv.y & 0xffffu); Vs[kk * 132 + c8 + 3] = bf2f(vv.y >> 16);
                        Vs[kk * 132 + c8 + 4] = bf2f(vv.z & 0xffffu); Vs[kk * 132 + c8 + 5] = bf2f(vv.z >> 16); Vs[kk * 132 + c8 + 6] = bf2f(vv.w & 0xffffu); Vs[kk * 132 + c8 + 7] = bf2f(vv.w >> 16); } }
                __syncthreads();
#pragma unroll
                for (int kq = 0; kq < 2; ++kq) { const int kk = tl + 32 * kq; float s0 = 0.f, s1 = 0.f;
                    for (int d = 0; d < 64; d += 4) { const f32x4 q0 = *(const LAS f32x4*)(Qs + r * 128 + d), q1 = *(const LAS f32x4*)(Qs + r * 128 + 64 + d), k0 = *(const LAS f32x4*)(Ks + kk * 132 + d), k1 = *(const LAS f32x4*)(Ks + kk * 132 + 64 + d);
                        s0 += q0.x * k0.x + q0.y * k0.y + q0.z * k0.z + q0.w * k0.w; s1 += q1.x * k1.x + q1.y * k1.y + q1.z * k1.z + q1.w * k1.w; }
                    if (pass == 0) { float mn = fmaxf(m0, s0); l0 = l0 * exp2f(m0 - mn) + exp2f(s0 - mn); m0 = mn; mn = fmaxf(m1, s1); l1 = l1 * exp2f(m1 - mn) + exp2f(s1 - mn); m1 = mn; }
                    else Ws[r * 64 + kk] = exp2f(s0 - m0) * inv0 - exp2f(s1 - m1) * inv1; }
                if (pass == 1) { __syncthreads();
                    for (int kk = 0; kk < 64; ++kk) { const float w = Ws[r * 64 + kk];
#pragma unroll
                        for (int i = 0; i < 4; ++i) o4[i] += w * Vs[kk * 132 + tl + 32 * i]; } }
            }
            if (pass == 1) { float ss = o4[0] * o4[0] + o4[1] * o4[1] + o4[2] * o4[2] + o4[3] * o4[3];
#pragma unroll
                for (int o = 1; o < 32; o <<= 1) ss += __shfl_xor(ss, o);
                const float sc = rsqrtf(ss * (1.f / 128.f) + EPS) * (1.f - lam_init);
#pragma unroll
                for (int i = 0; i < 4; ++i) MX[(R0 + r) * 3072 + h * 128 + tl + 32 * i] = (bf16)f2bf(o4[i] * sc * A.in[11][l * 128 + tl + 32 * i]); }
        }
    }
}

#endif
namespace da {
using bf16x8 = __attribute__((ext_vector_type(8))) short;
using s16x4  = __attribute__((ext_vector_type(4))) short;
using f32x16 = __attribute__((ext_vector_type(16))) float;
using u32x4  = __attribute__((ext_vector_type(4))) unsigned;
constexpr int KVBLK = 64, LDK = 1024;
constexpr size_t SHM_V = KVBLK * 128 * 2, SHM_K = KVBLK * 128 * 2;
constexpr float THR = 8.f;
#define DA_KSWZ(row, colB) ((row) * 256 + ((colB) ^ (((row) & 7) << 4)))
#define DA_SBAR() __builtin_amdgcn_sched_barrier(0)
__device__ __forceinline__ int crow(int r, int hi) { return (r & 3) + 8 * (r >> 2) + 4 * hi; }
__device__ __forceinline__ unsigned cvtpk(float lo, float hi) { unsigned r; asm volatile("v_cvt_pk_bf16_f32 %0, %1, %2" : "=v"(r) : "v"(lo), "v"(hi)); return r; }
__device__ __forceinline__ void expSM(f32x16& p0, f32x16& p1, float soff) {
  for (int r = 0; r < 16; ++r) p0[r] = __builtin_amdgcn_exp2f(p0[r] - soff); for (int r = 0; r < 16; ++r) p1[r] = __builtin_amdgcn_exp2f(p1[r] - soff);
}
__device__ __forceinline__ void finishSM(f32x16& p0, f32x16& p1, float& l_reg, bf16x8& pa0, bf16x8& pa1, bf16x8& pa2, bf16x8& pa3) {
  float ps = 0; for (int r = 0; r < 16; ++r) ps += p0[r]; for (int r = 0; r < 16; ++r) ps += p1[r];
  l_reg += ps;
#define DA_PK4(P, BASE, OUT) do { unsigned a0 = cvtpk(P[BASE + 0], P[BASE + 1]), a1 = cvtpk(P[BASE + 2], P[BASE + 3]);   \
    unsigned b0 = cvtpk(P[BASE + 4], P[BASE + 5]), b1 = cvtpk(P[BASE + 6], P[BASE + 7]);                              \
    auto r0 = __builtin_amdgcn_permlane32_swap(a0, b0, false, false); auto r1 = __builtin_amdgcn_permlane32_swap(a1, b1, false, false); \
    u32x4 w = {r0[0], r1[0], r0[1], r1[1]}; OUT = *reinterpret_cast<bf16x8*>(&w); } while (0)
  DA_PK4(p0, 0, pa0); DA_PK4(p0, 8, pa1); DA_PK4(p1, 0, pa2); DA_PK4(p1, 8, pa3);
#undef DA_PK4
}
__device__ __forceinline__ void qkt(f32x16& p0, f32x16& p1, const char* Ks, const bf16x8* qr, int r32, int hi, int cbm) {
  p0 = f32x16{}; p1 = f32x16{};
#pragma unroll
  for (int d0 = 0; d0 < 4; ++d0) { const int cb = cbm + (d0 * 16 + hi * 8) * 2;
    bf16x8 b0 = *reinterpret_cast<const bf16x8*>(Ks + DA_KSWZ(r32, cb));
    bf16x8 b1 = *reinterpret_cast<const bf16x8*>(Ks + DA_KSWZ(32 + r32, cb));
    p0 = __builtin_amdgcn_mfma_f32_32x32x16_bf16(b0, qr[d0], p0, 0, 0, 0);
    p1 = __builtin_amdgcn_mfma_f32_32x32x16_bf16(b1, qr[d0], p1, 0, 0, 0); }
}
__device__ __forceinline__ int v_st(int k, int c) { const int kk = (k & ~0xC) | ((k & 4) << 1) | ((k & 8) >> 1); return ((kk >> 3) * 4 + (c >> 5)) * 512 + ((kk & 7) * 32 + (c & 31)) * 2; }
__device__ __forceinline__ int v_rd_base(int lane) { return ((lane & 3) << 3) | (((lane >> 2) & 3) << 6) | (((lane >> 4) & 1) << 5) | (((lane >> 5) & 1) << 8); }
constexpr int v_rd_off(int d0, int ks, int half) { return d0 * 512 + ks * 4096 + half * 2048; }
template <int OFF> __device__ __forceinline__ s16x4 tr_read(int vb) {
  s16x4 r; asm volatile("ds_read_b64_tr_b16 %0, %1 offset:%2" : "=&v"(r) : "v"(vb), "i"(OFF) : "memory"); return r;
}
template <int D0> __device__ __forceinline__ void pv_one(f32x16& od, int vb, bf16x8 pa0, bf16x8 pa1, bf16x8 pa2, bf16x8 pa3) {
  const s16x4 l0 = tr_read<v_rd_off(D0, 0, 0)>(vb), h0 = tr_read<v_rd_off(D0, 0, 1)>(vb), l1 = tr_read<v_rd_off(D0, 1, 0)>(vb), h1 = tr_read<v_rd_off(D0, 1, 1)>(vb);
  const s16x4 l2 = tr_read<v_rd_off(D0, 2, 0)>(vb), h2 = tr_read<v_rd_off(D0, 2, 1)>(vb), l3 = tr_read<v_rd_off(D0, 3, 0)>(vb), h3 = tr_read<v_rd_off(D0, 3, 1)>(vb);
  asm volatile("s_waitcnt lgkmcnt(0)" ::: "memory"); DA_SBAR();
#define DA_PK(L, H) (bf16x8){L[0], L[1], L[2], L[3], H[0], H[1], H[2], H[3]}
  od = __builtin_amdgcn_mfma_f32_32x32x16_bf16(pa0, DA_PK(l0, h0), od, 0, 0, 0);
  od = __builtin_amdgcn_mfma_f32_32x32x16_bf16(pa1, DA_PK(l1, h1), od, 0, 0, 0);
  od = __builtin_amdgcn_mfma_f32_32x32x16_bf16(pa2, DA_PK(l2, h2), od, 0, 0, 0);
  od = __builtin_amdgcn_mfma_f32_32x32x16_bf16(pa3, DA_PK(l3, h3), od, 0, 0, 0);
#undef DA_PK
}
__device__ __forceinline__ void pv_d0(f32x16* o, int vb, bf16x8 pa0, bf16x8 pa1, bf16x8 pa2, bf16x8 pa3) {
  pv_one<0>(o[0], vb, pa0, pa1, pa2, pa3); pv_one<1>(o[1], vb, pa0, pa1, pa2, pa3); pv_one<2>(o[2], vb, pa0, pa1, pa2, pa3); pv_one<3>(o[3], vb, pa0, pa1, pa2, pa3);
}
__device__ __forceinline__ void unit(const unsigned short* __restrict__ Qb, const unsigned short* __restrict__ Kh, const unsigned short* __restrict__ Vh,
                                     unsigned short* __restrict__ Ob, int ldo, int seq, float lam, float oscale, float soff, const float* __restrict__ subg, char* lds) {
  const int tid = otid(), wid = tid >> 6, lane = tid & 63, r32 = lane & 31, hi = lane >> 5, mp = wid >> 2, wq = wid & 3;
  char* V_lds = lds; char* K_lds = lds + 2 * SHM_V;
  float* ws = (float*)(lds + 2 * SHM_V + 2 * SHM_K) + wid * 64; float* li_l = ws;
  float l_reg = 0; f32x16 o[4] = {}; bf16x8 qr[4];
  const unsigned short* Qw = Qb + (long)(wq * 32 + r32) * 1024 + mp * 64 + hi * 8;
#pragma unroll
  for (int d0 = 0; d0 < 4; ++d0) qr[d0] = *reinterpret_cast<const bf16x8*>(Qw + d0 * 16);
  const int cbm = mp * 128;
  const int sr = tid >> 4, sc = (tid & 15) * 8, vst0 = v_st(sr, sc), vst1 = v_st(32 + sr, sc);
  const int vb0 = (int)(uintptr_t)V_lds + v_rd_base(lane);
  struct { bf16x8 vs0, vs1, ks0, ks1; } sr_[2];
#define DA_SLOAD(i, k0) do { sr_[i].vs0 = *reinterpret_cast<const bf16x8*>(&Vh[(long)((k0) + sr) * LDK + sc]); sr_[i].vs1 = *reinterpret_cast<const bf16x8*>(&Vh[(long)((k0) + 32 + sr) * LDK + sc]); \
    sr_[i].ks0 = *reinterpret_cast<const bf16x8*>(&Kh[(long)((k0) + sr) * LDK + sc]); sr_[i].ks1 = *reinterpret_cast<const bf16x8*>(&Kh[(long)((k0) + 32 + sr) * LDK + sc]); } while (0)
#define DA_SWRITE(b, i) do { *(bf16x8*)(V_lds + (b) * SHM_V + vst0) = sr_[i].vs0;          \
    *(bf16x8*)(V_lds + (b) * SHM_V + vst1) = sr_[i].vs1; int kc = sc * 2;               \
    *(bf16x8*)(K_lds + (b) * SHM_K + DA_KSWZ(sr, kc)) = sr_[i].ks0;                       \
    *(bf16x8*)(K_lds + (b) * SHM_K + DA_KSWZ(32 + sr, kc)) = sr_[i].ks1; } while (0)
#define DA_SWAIT() asm volatile("s_waitcnt vmcnt(4)" ::: "memory")
  f32x16 pA0, pA1, pB0, pB1; bf16x8 pa0, pa1, pa2, pa3; const int NT = seq / KVBLK;
  constexpr int SE = 0, SO = 1;
  DA_SLOAD(SE, 0); asm volatile("s_waitcnt vmcnt(0)" ::: "memory"); DA_SWRITE(0, SE); __syncthreads();
  qkt(pA0, pA1, K_lds, qr, r32, hi, cbm); expSM(pA0, pA1, soff);
  DA_SLOAD(SO, KVBLK); if (2 < NT) DA_SLOAD(SE, 2 * KVBLK);
  DA_SWAIT(); DA_SWRITE(1, SO); __syncthreads();
  for (int j = 1; j + 1 < NT; j += 2) {
    DA_SBAR(); qkt(pB0, pB1, K_lds + SHM_K, qr, r32, hi, cbm);
    finishSM(pA0, pA1, l_reg, pa0, pa1, pa2, pa3); DA_SBAR();
    DA_SLOAD(SO, (j + 2) * KVBLK); DA_SBAR();
    pv_d0(o, vb0, pa0, pa1, pa2, pa3); expSM(pB0, pB1, soff);
    __syncthreads(); DA_SWAIT(); DA_SWRITE(0, SE);
    __syncthreads();
    DA_SBAR(); qkt(pA0, pA1, K_lds, qr, r32, hi, cbm);
    finishSM(pB0, pB1, l_reg, pa0, pa1, pa2, pa3); DA_SBAR();
    if (j + 3 < NT) DA_SLOAD(SE, (j + 3) * KVBLK); DA_SBAR();
    pv_d0(o, vb0 + (int)SHM_V, pa0, pa1, pa2, pa3); expSM(pA0, pA1, soff);
    __syncthreads(); DA_SWAIT(); DA_SWRITE(1, SO);
    __syncthreads();
  }
  DA_SBAR(); qkt(pB0, pB1, K_lds + SHM_K, qr, r32, hi, cbm);
  finishSM(pA0, pA1, l_reg, pa0, pa1, pa2, pa3); DA_SBAR();
  pv_d0(o, vb0, pa0, pa1, pa2, pa3); expSM(pB0, pB1, soff);
  __syncthreads();
  finishSM(pB0, pB1, l_reg, pa0, pa1, pa2, pa3); DA_SBAR();
  pv_d0(o, vb0 + (int)SHM_V, pa0, pa1, pa2, pa3);
  { auto rr = __builtin_amdgcn_permlane32_swap(__float_as_uint(l_reg), __float_as_uint(l_reg), false, false); l_reg = __uint_as_float(rr[0]) + __uint_as_float(rr[1]); }
  if (hi == 0) li_l[r32] = l_reg; asm volatile("s_waitcnt lgkmcnt(0)" ::: "memory");
  const float sgn = mp ? lam : 1.f;
#pragma unroll
  for (int r = 0; r < 16; ++r) { const float rl = sgn * __builtin_amdgcn_rcpf(li_l[crow(r, hi)]);
#pragma unroll
    for (int d0 = 0; d0 < 4; ++d0) o[d0][r] *= rl; }
  __syncthreads();
  int xb = wq * 4096 + lane; asm volatile("" : "+v"(xb));
  float* X = (float*)lds + xb;
  if (mp == 1) {
#pragma unroll
    for (int d0 = 0; d0 < 4; ++d0)
#pragma unroll
      for (int r = 0; r < 16; ++r) X[(d0 * 16 + r) * 64] = o[d0][r];
  }
  __syncthreads();
  if (mp == 0) {
    float gg[4];
#pragma unroll
    for (int d0 = 0; d0 < 4; ++d0) gg[d0] = subg[d0 * 32 + r32] * oscale;
    int ob = (wq * 32 + 4 * hi) * ldo + r32; asm volatile("" : "+v"(ob));
    unsigned short* Ow = Ob + ob;
#pragma unroll
    for (int r = 0; r < 16; ++r) { float a = 0.f; float v[4];
#pragma unroll
      for (int d0 = 0; d0 < 4; ++d0) { v[d0] = o[d0][r] - X[(d0 * 16 + r) * 64]; a += v[d0] * v[d0]; }
      a += sx<1>(a); a += sx<2>(a); a += sx<4>(a); a += sx<8>(a); a += sx<16>(a);
      a = rsqrtf(a * (1.f / 128.f) + EPS);
      const int orow = (r & 3) + 8 * (r >> 2);
#pragma unroll
      for (int d0 = 0; d0 < 4; ++d0) Ow[orow * ldo + d0 * 32] = (unsigned short)f2bf(v[d0] * a * gg[d0]); }
  }
  __syncthreads();
#undef DA_SLOAD
#undef DA_SWRITE
#undef DA_SWAIT
}

template <int D0> __device__ __forceinline__ void v_rd8(s16x4 (&f)[8], int vb) {
  f[0] = tr_read<v_rd_off(D0, 0, 0)>(vb); f[1] = tr_read<v_rd_off(D0, 0, 1)>(vb); f[2] = tr_read<v_rd_off(D0, 1, 0)>(vb); f[3] = tr_read<v_rd_off(D0, 1, 1)>(vb);
  f[4] = tr_read<v_rd_off(D0, 2, 0)>(vb); f[5] = tr_read<v_rd_off(D0, 2, 1)>(vb); f[6] = tr_read<v_rd_off(D0, 3, 0)>(vb); f[7] = tr_read<v_rd_off(D0, 3, 1)>(vb);
}
__device__ __forceinline__ void pv_mm(f32x16& od, const s16x4 (&f)[8], bf16x8 pa0, bf16x8 pa1, bf16x8 pa2, bf16x8 pa3) {
#define DA_PK(L, H) (bf16x8){L[0], L[1], L[2], L[3], H[0], H[1], H[2], H[3]}
  od = __builtin_amdgcn_mfma_f32_32x32x16_bf16(pa0, DA_PK(f[0], f[1]), od, 0, 0, 0);
  od = __builtin_amdgcn_mfma_f32_32x32x16_bf16(pa1, DA_PK(f[2], f[3]), od, 0, 0, 0);
  od = __builtin_amdgcn_mfma_f32_32x32x16_bf16(pa2, DA_PK(f[4], f[5]), od, 0, 0, 0);
  od = __builtin_amdgcn_mfma_f32_32x32x16_bf16(pa3, DA_PK(f[6], f[7]), od, 0, 0, 0);
#undef DA_PK
}
__device__ __forceinline__ void pv_pipe(f32x16* o, int vb, bf16x8 pa0, bf16x8 pa1, bf16x8 pa2, bf16x8 pa3) {
  s16x4 fa[8], fb[8];
  v_rd8<0>(fa, vb); v_rd8<1>(fb, vb);
  asm volatile("s_waitcnt lgkmcnt(8)" ::: "memory"); DA_SBAR(); pv_mm(o[0], fa, pa0, pa1, pa2, pa3); DA_SBAR();
  v_rd8<2>(fa, vb);
  asm volatile("s_waitcnt lgkmcnt(8)" ::: "memory"); DA_SBAR(); pv_mm(o[1], fb, pa0, pa1, pa2, pa3); DA_SBAR();
  v_rd8<3>(fb, vb);
  asm volatile("s_waitcnt lgkmcnt(8)" ::: "memory"); DA_SBAR(); pv_mm(o[2], fa, pa0, pa1, pa2, pa3); DA_SBAR();
  asm volatile("s_waitcnt lgkmcnt(0)" ::: "memory"); DA_SBAR(); pv_mm(o[3], fb, pa0, pa1, pa2, pa3); DA_SBAR();
}
__device__ __forceinline__ void unit8(const unsigned short* __restrict__ Qb, const unsigned short* __restrict__ Kh, const unsigned short* __restrict__ Vh,
                                      unsigned short* __restrict__ Ob, int ldo, int seq, float lam, float oscale, float soff, const float* __restrict__ subg, LAS unsigned char* ldsl) {
  const int tid = otid(), wid = __builtin_amdgcn_readfirstlane(tid >> 6), lane = tid & 63, r32 = lane & 31, hi = lane >> 5, mp = wid >> 2, wq = wid & 3;
  constexpr int SLOT = 16384;
  char* lds = (char*)ldsl; char* K_lds = lds; const int vbase = (int)(uintptr_t)(lds + 3 * SLOT) + v_rd_base(lane);
  float* li_l = (float*)(lds + 6 * SLOT) + wid * 64;
  f32x16 o[4] = {}; bf16x8 qr[4];
  const unsigned short* Qw = Qb + (long)(wq * 32 + r32) * 1024 + mp * 64 + hi * 8;
#pragma unroll
  for (int d0 = 0; d0 < 4; ++d0) qr[d0] = *reinterpret_cast<const bf16x8*>(Qw + d0 * 16);
  asm volatile("s_waitcnt vmcnt(0)" ::: "memory");
  const int cbm = mp * 128;
  const unsigned wl = (unsigned)wid * 1024u;
  unsigned kso[2], vso[2];
#pragma unroll
  for (int i = 0; i < 2; ++i) { const int P = (i * 8 + wid) * 64 + lane;
    { const int row = P >> 4, chunk = (P & 15) ^ (row & 7); kso[i] = (unsigned)(row * LDK + chunk * 8) * 2u; }
    { const int sub = P >> 5, kk = (sub >> 2) * 8 + ((P & 31) >> 2), key = (kk & ~0xC) | ((kk & 4) << 1) | ((kk & 8) >> 1); vso[i] = (unsigned)(key * LDK + (sub & 3) * 32 + (P & 3) * 8) * 2u; } }
#define DA_DMA_K(t, slot) do { const unsigned to_ = (unsigned)(t) * (unsigned)(KVBLK * LDK * 2); _Pragma("unroll") for (int i_ = 0; i_ < 2; ++i_) \
      __builtin_amdgcn_global_load_lds((const unsigned*)((const char*)Kh + (kso[i_] + to_)), (LAS unsigned*)(ldsl + (slot) * SLOT + i_ * 8192 + wl), 16, 0, 0); } while (0)
#define DA_DMA_V(t, slot) do { const unsigned to_ = (unsigned)(t) * (unsigned)(KVBLK * LDK * 2); _Pragma("unroll") for (int i_ = 0; i_ < 2; ++i_) \
      __builtin_amdgcn_global_load_lds((const unsigned*)((const char*)Vh + (vso[i_] + to_)), (LAS unsigned*)(ldsl + (3 + (slot)) * SLOT + i_ * 8192 + wl), 16, 0, 0); } while (0)
#define U8_PK(t, slot, i_) __builtin_amdgcn_global_load_lds((const unsigned*)((const char*)Kh + (kso[i_] + (unsigned)(t) * (unsigned)(KVBLK * LDK * 2))), (LAS unsigned*)(ldsl + (slot) * SLOT + (i_) * 8192 + wl), 16, 0, 0)
#define U8_PV(t, slot, i_) __builtin_amdgcn_global_load_lds((const unsigned*)((const char*)Vh + (vso[i_] + (unsigned)(t) * (unsigned)(KVBLK * LDK * 2))), (LAS unsigned*)(ldsl + (3 + (slot)) * SLOT + (i_) * 8192 + wl), 16, 0, 0)
#define DA_WAITBAR(N) do { asm volatile("s_waitcnt vmcnt(" #N ") lgkmcnt(0)" ::: "memory"); __builtin_amdgcn_s_barrier(); asm volatile("" ::: "memory"); } while (0)
  f32x16 pA0, pA1, pB0, pB1; u32x4 pw0, pw1, pw2, pw3; const int NT = seq / KVBLK;
  bf16x8 kf[8];
  f32x16 negm, ol = {};
#pragma unroll
  for (int r = 0; r < 16; ++r) negm[r] = -soff;
  const bf16x8 ones = {0x3F80, 0x3F80, 0x3F80, 0x3F80, 0x3F80, 0x3F80, 0x3F80, 0x3F80};
  const int pkr = ((r32 & 3) + 4 * (r32 >> 3)), pk = (pkr & 7) + 16 * (pkr >> 3) + 8 * ((r32 >> 2) & 1);
#define U5_KADDR(d0) ((int)(uintptr_t)K_lds + pk * 256 + ((((cbm >> 4) + 2 * (d0) + hi) ^ (pk & 7)) * 16))
#define U5_KLOAD(slot) do { const int so_ = (slot) * SLOT; _Pragma("unroll") for (int d0 = 0; d0 < 4; ++d0) { const int ad_ = U5_KADDR(d0) + so_; \
    asm volatile("ds_read_b128 %0, %2\n\tds_read_b128 %1, %2 offset:8192" : "=&v"(kf[2 * d0]), "=&v"(kf[2 * d0 + 1]) : "v"(ad_) : "memory"); } } while (0)
#define U5_PIN(x) asm volatile("" : "+v"(x))
#define U5_EX(v) __builtin_amdgcn_exp2f(v)
#define U5_VRD(L, H, m) do { asm volatile("ds_read_b64_tr_b16 %0, %1 offset:%2" : "=&v"(L) : "v"(vb_), "i"(v_rd_off((m) >> 2, (m) & 3, 0)) : "memory"); \
    asm volatile("ds_read_b64_tr_b16 %0, %1 offset:%2" : "=&v"(H) : "v"(vb_), "i"(v_rd_off((m) >> 2, (m) & 3, 1)) : "memory"); } while (0)
#define U5_GAPA(MF, X, B4, PW, VR, CV0, CV1) do { MF; VR; CV0; CV1; U5_PIN(PW); DA_SBAR(); } while (0)
#define U5_CVT(P, b) cvtpk(P[b], P[b + 1])
#define U5_PHASE_A(C0, C1, P0, P1, VSLOT, HK0, HK1, HV0, HV1) do { const int vb_ = vbase + (VSLOT) * SLOT; \
    U5_GAPA(C0 = __builtin_amdgcn_mfma_f32_32x32x16_bf16(kf[0], qr[0], negm, 0, 0, 0), P0, 0, pw0, HK0, pw0[0] = U5_CVT(P0, 0), pw0[1] = U5_CVT(P0, 2)); \
    U5_GAPA(C1 = __builtin_amdgcn_mfma_f32_32x32x16_bf16(kf[1], qr[0], negm, 0, 0, 0), P0, 4, pw0, HK1, pw0[2] = U5_CVT(P0, 4), pw0[3] = U5_CVT(P0, 6)); \
    U5_GAPA(C0 = __builtin_amdgcn_mfma_f32_32x32x16_bf16(kf[2], qr[1], C0, 0, 0, 0), P0, 8, pw1, do { HV0; HV1; } while (0), pw1[0] = U5_CVT(P0, 8), pw1[1] = U5_CVT(P0, 10)); \
    U5_GAPA(C1 = __builtin_amdgcn_mfma_f32_32x32x16_bf16(kf[3], qr[1], C1, 0, 0, 0), P0, 12, pw1, U5_VRD(vl0, vh0, 0), pw1[2] = U5_CVT(P0, 12), pw1[3] = U5_CVT(P0, 14)); \
    U5_GAPA(C0 = __builtin_amdgcn_mfma_f32_32x32x16_bf16(kf[4], qr[2], C0, 0, 0, 0), P1, 0, pw2, U5_VRD(vl1, vh1, 1), pw2[0] = U5_CVT(P1, 0), pw2[1] = U5_CVT(P1, 2)); \
    U5_GAPA(C1 = __builtin_amdgcn_mfma_f32_32x32x16_bf16(kf[5], qr[2], C1, 0, 0, 0), P1, 4, pw2, U5_VRD(vl2, vh2, 2), pw2[2] = U5_CVT(P1, 4), pw2[3] = U5_CVT(P1, 6)); \
    U5_GAPA(C0 = __builtin_amdgcn_mfma_f32_32x32x16_bf16(kf[6], qr[3], C0, 0, 0, 0), P1, 8, pw3, U5_VRD(vl3, vh3, 3), pw3[0] = U5_CVT(P1, 8), pw3[1] = U5_CVT(P1, 10)); \
    U5_GAPA(C1 = __builtin_amdgcn_mfma_f32_32x32x16_bf16(kf[7], qr[3], C1, 0, 0, 0), P1, 12, pw3, U5_VRD(vl4, vh4, 4), pw3[2] = U5_CVT(P1, 12), pw3[3] = U5_CVT(P1, 14)); \
    } while (0)
#define U5_PKV(L, H) (bf16x8){L[0], L[1], L[2], L[3], H[0], H[1], H[2], H[3]}
#define U5_PAF(k) __builtin_bit_cast(bf16x8, pw##k)
#define U5_GAPB(WAITN, OD, PK, L, H, X, B2, NEXT) do { asm volatile("s_waitcnt lgkmcnt(" #WAITN ")" ::: "memory"); DA_SBAR(); \
    OD = __builtin_amdgcn_mfma_f32_32x32x16_bf16(PK, U5_PKV(L, H), OD, 0, 0, 0); NEXT; X[B2] = U5_EX(X[B2]); X[B2 + 1] = U5_EX(X[B2 + 1]); U5_PIN(X); DA_SBAR(); } while (0)
#define U5_GAPS(PK, X, B2) do { ol = __builtin_amdgcn_mfma_f32_32x32x16_bf16(PK, ones, ol, 0, 0, 0); X[B2] = U5_EX(X[B2]); X[B2 + 1] = U5_EX(X[B2 + 1]); U5_PIN(X); DA_SBAR(); } while (0)
#define U5_GAPN(WAITN, OD, PK, L, H, NEXT) do { asm volatile("s_waitcnt lgkmcnt(" #WAITN ")" ::: "memory"); DA_SBAR(); \
    OD = __builtin_amdgcn_mfma_f32_32x32x16_bf16(PK, U5_PKV(L, H), OD, 0, 0, 0); NEXT; DA_SBAR(); } while (0)
#define U5_PHASE_B(C0, C1, VSLOT, KSLOT, DOK) do { const int vb_ = vbase + (VSLOT) * SLOT; \
    U5_GAPS(U5_PAF(0), C0, 0); U5_GAPS(U5_PAF(1), C0, 2); U5_GAPS(U5_PAF(2), C0, 4); U5_GAPS(U5_PAF(3), C0, 6); \
    U5_GAPB(8, o[0], U5_PAF(0), vl0, vh0, C0, 8, U5_VRD(vl5, vh5, 5)); \
    U5_GAPB(8, o[0], U5_PAF(1), vl1, vh1, C0, 10, U5_VRD(vl0, vh0, 6)); \
    U5_GAPB(8, o[0], U5_PAF(2), vl2, vh2, C0, 12, U5_VRD(vl1, vh1, 7)); \
    U5_GAPB(8, o[0], U5_PAF(3), vl3, vh3, C0, 14, U5_VRD(vl2, vh2, 8)); \
    U5_GAPB(8, o[1], U5_PAF(0), vl4, vh4, C1, 0, U5_VRD(vl3, vh3, 9)); \
    U5_GAPB(8, o[1], U5_PAF(1), vl5, vh5, C1, 2, U5_VRD(vl4, vh4, 10)); \
    U5_GAPB(8, o[1], U5_PAF(2), vl0, vh0, C1, 4, U5_VRD(vl5, vh5, 11)); \
    U5_GAPB(8, o[1], U5_PAF(3), vl1, vh1, C1, 6, U5_VRD(vl0, vh0, 12)); \
    U5_GAPB(8, o[2], U5_PAF(0), vl2, vh2, C1, 8, U5_VRD(vl1, vh1, 13)); \
    U5_GAPB(8, o[2], U5_PAF(1), vl3, vh3, C1, 10, U5_VRD(vl2, vh2, 14)); \
    U5_GAPB(8, o[2], U5_PAF(2), vl4, vh4, C1, 12, U5_VRD(vl3, vh3, 15)); \
    U5_GAPB(8, o[2], U5_PAF(3), vl5, vh5, C1, 14, (void)0); \
    U5_GAPN(6, o[3], U5_PAF(0), vl0, vh0, (void)0); \
    if (DOK) { U5_GAPN(4, o[3], U5_PAF(1), vl1, vh1, U5_KLOAD(KSLOT)); U5_GAPN(10, o[3], U5_PAF(2), vl2, vh2, (void)0); U5_GAPN(8, o[3], U5_PAF(3), vl3, vh3, (void)0); } \
    else { U5_GAPN(4, o[3], U5_PAF(1), vl1, vh1, (void)0); U5_GAPN(2, o[3], U5_PAF(2), vl2, vh2, (void)0); U5_GAPN(0, o[3], U5_PAF(3), vl3, vh3, (void)0); } } while (0)
#define DA_ROT(x) ((x) == 2 ? 0 : (x) + 1)
#define DA_PRV(x) ((x) == 0 ? 2 : (x) - 1)
  s16x4 vl0, vh0, vl1, vh1, vl2, vh2, vl3, vh3, vl4, vh4, vl5, vh5;
  DA_DMA_K(0, 0); DA_DMA_K(1, 1); DA_DMA_V(0, 0);
  DA_WAITBAR(0);
  U5_KLOAD(0); DA_DMA_K(2, 2); DA_DMA_V(1, 1);
  DA_WAITBAR(4);
  DA_DMA_K(3, 0);
  DA_SBAR();
  pA0 = negm; pA1 = negm;
#pragma unroll
  for (int d0 = 0; d0 < 4; ++d0) { pA0 = __builtin_amdgcn_mfma_f32_32x32x16_bf16(kf[2 * d0], qr[d0], pA0, 0, 0, 0); pA1 = __builtin_amdgcn_mfma_f32_32x32x16_bf16(kf[2 * d0 + 1], qr[d0], pA1, 0, 0, 0); }
  DA_SBAR(); U5_KLOAD(1);
  expSM(pA0, pA1, 0.f);
  DA_WAITBAR(2);
  int c = 1;
  for (int j = 1; j + 1 < NT; j += 2) {
    { const bool mk = j + 3 < NT;
      DA_SBAR(); U5_PHASE_A(pB0, pB1, pA0, pA1, DA_PRV(c), if (mk) U8_PK(j + 3, c, 0), if (mk) U8_PK(j + 3, c, 1), U8_PV(j + 1, DA_ROT(c), 0), U8_PV(j + 1, DA_ROT(c), 1));
      U5_PHASE_B(pB0, pB1, DA_PRV(c), DA_ROT(c), true);
      if (mk) DA_WAITBAR(4); else DA_WAITBAR(2);
      c = DA_ROT(c); }
    { const bool mk = j + 4 < NT;
      DA_SBAR(); U5_PHASE_A(pA0, pA1, pB0, pB1, DA_PRV(c), if (mk) U8_PK(j + 4, c, 0), if (mk) U8_PK(j + 4, c, 1), U8_PV(j + 2, DA_ROT(c), 0), U8_PV(j + 2, DA_ROT(c), 1));
      U5_PHASE_B(pA0, pA1, DA_PRV(c), DA_ROT(c), true);
      if (mk) DA_WAITBAR(4); else DA_WAITBAR(2);
      c = DA_ROT(c); }
  }
  DA_SBAR(); U5_PHASE_A(pB0, pB1, pA0, pA1, DA_PRV(c), (void)0, (void)0, (void)0, (void)0);
  U5_PHASE_B(pB0, pB1, DA_PRV(c), 0, false);
  DA_WAITBAR(0);
  { u32x4 w0 = {cvtpk(pB0[0], pB0[1]), cvtpk(pB0[2], pB0[3]), cvtpk(pB0[4], pB0[5]), cvtpk(pB0[6], pB0[7])}, w1 = {cvtpk(pB0[8], pB0[9]), cvtpk(pB0[10], pB0[11]), cvtpk(pB0[12], pB0[13]), cvtpk(pB0[14], pB0[15])};
    u32x4 w2 = {cvtpk(pB1[0], pB1[1]), cvtpk(pB1[2], pB1[3]), cvtpk(pB1[4], pB1[5]), cvtpk(pB1[6], pB1[7])}, w3 = {cvtpk(pB1[8], pB1[9]), cvtpk(pB1[10], pB1[11]), cvtpk(pB1[12], pB1[13]), cvtpk(pB1[14], pB1[15])};
    const bf16x8 pa0 = __builtin_bit_cast(bf16x8, w0), pa1 = __builtin_bit_cast(bf16x8, w1), pa2 = __builtin_bit_cast(bf16x8, w2), pa3 = __builtin_bit_cast(bf16x8, w3); DA_SBAR();
    ol = __builtin_amdgcn_mfma_f32_32x32x16_bf16(pa0, ones, ol, 0, 0, 0); ol = __builtin_amdgcn_mfma_f32_32x32x16_bf16(pa1, ones, ol, 0, 0, 0);
    ol = __builtin_amdgcn_mfma_f32_32x32x16_bf16(pa2, ones, ol, 0, 0, 0); ol = __builtin_amdgcn_mfma_f32_32x32x16_bf16(pa3, ones, ol, 0, 0, 0);
    pv_d0(o, vbase + c * SLOT, pa0, pa1, pa2, pa3); }
#undef U5_KADDR
#undef U5_KLOAD
#undef U5_PIN
#undef U5_EX
#undef U5_GAPA
#undef U5_CVT
#undef U5_PHASE_A
#undef U5_VRD
#undef U5_PKV
#undef U5_PAF
#undef U5_GAPB
#undef U5_GAPS
#undef U5_GAPN
#undef U5_PHASE_B
  const int tid2 = otid(), wid2 = __builtin_amdgcn_readfirstlane(tid2 >> 6), lane2 = tid2 & 63; { const int r32 = lane2 & 31, hi = lane2 >> 5, mp = wid2 >> 2, wq = wid2 & 3, lane = lane2; float* li_l = (float*)(lds + 6 * SLOT) + wid2 * 64;
  const float sgn = mp ? lam : 1.f;
#pragma unroll
  for (int r = 0; r < 16; ++r) { const float rl = sgn * __builtin_amdgcn_rcpf(ol[r]);
#pragma unroll
    for (int d0 = 0; d0 < 4; ++d0) o[d0][r] *= rl; }
  __syncthreads();
  int xb = wq * 4096 + lane; asm volatile("" : "+v"(xb));
  float* X = (float*)lds + xb;
  if (mp == 1) {
#pragma unroll
    for (int d0 = 0; d0 < 4; ++d0)
#pragma unroll
      for (int r = 0; r < 16; ++r) X[(d0 * 16 + r) * 64] = o[d0][r];
  }
  __syncthreads();
  if (mp == 0) {
    float gg[4];
#pragma unroll
    for (int d0 = 0; d0 < 4; ++d0) gg[d0] = subg[d0 * 32 + r32] * oscale;
    int ob = (wq * 32 + 4 * hi) * ldo + r32; asm volatile("" : "+v"(ob));
    unsigned short* Ow = Ob + ob;
#pragma unroll
    for (int r = 0; r < 16; ++r) { float a = 0.f; float v[4];
#pragma unroll
      for (int d0 = 0; d0 < 4; ++d0) { v[d0] = o[d0][r] - X[(d0 * 16 + r) * 64]; a += v[d0] * v[d0]; }
      a += sx<1>(a); a += sx<2>(a); a += sx<4>(a); a += sx<8>(a); a += sx<16>(a);
      a = rsqrtf(a * (1.f / 128.f) + EPS);
      const int orow = (r & 3) + 8 * (r >> 2);
#pragma unroll
      for (int d0 = 0; d0 < 4; ++d0) Ow[orow * ldo + d0 * 32] = (unsigned short)f2bf(v[d0] * a * gg[d0]); }
  }
  }
  asm volatile("s_waitcnt vmcnt(0)" ::: "memory");
  __syncthreads();
#undef DA_DMA_K
#undef DA_DMA_V
#undef DA_WAITBAR
#undef DA_ROT
#undef DA_PRV
}
}
__device__ __forceinline__ void ph_attn(const Frame& F, const Args& A, int l) {
    const bf16 *Kb = WSP(bf16, WS_KB), *Vb = WSP(bf16, WS_VB), *Qb = WSP(bf16, WS_QB); bf16* MX = WSP(bf16, WS_MIXIN);
    const float* lq = A.in[10] + l * 256; float d01 = 0.f, d23 = 0.f;
    for (int i = 0; i < 64; ++i) { d01 += lq[i] * lq[64 + i]; d23 += lq[128 + i] * lq[192 + i]; }
    const float lam_init = 0.8f - 0.6f * expf(-0.3f * (float)l); float lam = expf(d01) - expf(d23) + lam_init;
    float mq = 0.f, mk = 0.f;
    for (int i = 0; i < 64; ++i) { mq = fmaxf(mq, fabsf(A.in[8][l * 64 + i])); mk = fmaxf(mk, fabsf(A.in[9][l * 64 + i])); }
    const float soff = __uint_as_float(__builtin_amdgcn_readfirstlane(__float_as_uint(64.f * mq * mk * QSCALE)));
    lam = __uint_as_float(__builtin_amdgcn_readfirstlane(__float_as_uint(lam))); const float osc = __uint_as_float(__builtin_amdgcn_readfirstlane(__float_as_uint(1.f - lam_init)));
    const int vcu = (F.G % 8 == 0) ? (F.bid % 8) * (F.G / 8) + F.bid / 8 : F.bid;
    for (int u = vcu; u < (l == DEPTH - 1 ? 1024 : 16 * 66); u += F.G) {
        const int bh = (u % 1024) / 64 , b = bh >> 3, h = bh & 7;
        int qb; int bb = b, hh = h;
        if (u < 1024) qb = 2 + (u & 63); else { const int v = u - 1024; bb = v >> 4; hh = (v >> 1) & 7; qb = v & 1; }
        const size_t R0 = (size_t)bb * TPB + qb * 128; const int seq = qb < 2 ? CTX : TPB;
#if ATTN_V2 == 8
        da::unit8(Qb + R0 * 1024 + hh * 128, Kb + (size_t)bb * TPB * 1024 + hh * 128, Vb + (size_t)bb * TPB * 1024 + hh * 128,
                  MX + R0 * 3072 + hh * 128, 3072, seq, lam, osc, soff, A.in[11] + l * 128, F.lds);
#else
        da::unit(Qb + R0 * 1024 + hh * 128, Kb + (size_t)bb * TPB * 1024 + hh * 128, Vb + (size_t)bb * TPB * 1024 + hh * 128,
                 MX + R0 * 3072 + hh * 128, 3072, seq, lam, osc, soff, A.in[11] + l * 128, (char*)F.lds);
#endif
    }
}

__device__ __forceinline__ void ph_mix(const Frame& F, const Args& A) {
    const float *PA = WSP(float, WS_PA), *PR = WSP(float, WS_PR), *PF = WSP(float, WS_PF); const bf16* GT = WSP(bf16, WS_GATES); bf16* MD = WSP(bf16, WS_MIXED);
    for (long i = F.gtid; i < (long)MROWS * 1024; i += F.NT) { const size_t R = (size_t)(i >> 10); const int c = (int)(i & 1023);
        MD[i] = (bf16)f2bf(bf2f(GT[R * 3072 + c]) * PA[i] + bf2f(GT[R * 3072 + 1024 + c]) * PR[i] + bf2f(GT[R * 3072 + 2048 + c]) * PF[i]); }
}
__device__ __forceinline__ void ph_resid_norm2(const Frame& F, const Args& A, int l) {
    float* X = WSP(float, WS_XALL); const float* Y1 = WSP(float, WS_Y1); bf16* TOK = WSP(bf16, WS_TOK);
    for (int R = F.gw; R < MROWS; R += F.NGW) {
        const int b = R / TPB, p = R % TPB, s = (p < CTX) ? 2 : b; const float* g1 = MODP(l, s, 2);
        f32x4 v[4];
#pragma unroll
        for (int j = 0; j < 4; ++j) { const int c = 4 * F.lane + 256 * j; const f32x4 x = *(const f32x4*)(X + (size_t)R * 1024 + c), y = *(const f32x4*)(Y1 + (size_t)R * 1024 + c), gg = *(const f32x4*)(g1 + c);
            v[j] = x + gg * y; *(f32x4*)(X + (size_t)R * 1024 + c) = v[j]; }
        norm_mod_row(v, A.in[23] + l * 1024, MODP(l, s, 4), MODP(l, s, 3), TOK + (size_t)R * 1024, F.lane);
    }
}
#define G1(T) __attribute__((address_space(1))) T
template <int CTRL, int RM = 0xf> __device__ __forceinline__ float dpp_f(float v) {
    return __uint_as_float(__builtin_amdgcn_update_dpp(__float_as_uint(v), __float_as_uint(v), CTRL, RM, 0xf, false)); }
__device__ __forceinline__ float wave_max63(float v) {
    asm volatile("s_nop 1\n\tv_max_f32_dpp %0, %0, %0 row_ror:1 row_mask:0xf bank_mask:0xf\n\ts_nop 1\n\tv_max_f32_dpp %0, %0, %0 row_ror:2 row_mask:0xf bank_mask:0xf\n\t"
                 "s_nop 1\n\tv_max_f32_dpp %0, %0, %0 row_ror:4 row_mask:0xf bank_mask:0xf\n\ts_nop 1\n\tv_max_f32_dpp %0, %0, %0 row_ror:8 row_mask:0xf bank_mask:0xf\n\t"
                 "s_nop 1\n\tv_max_f32_dpp %0, %0, %0 row_bcast:15 row_mask:0xa bank_mask:0xf\n\ts_nop 1\n\tv_max_f32_dpp %0, %0, %0 row_bcast:31 row_mask:0xc bank_mask:0xf\n\ts_nop 1" : "+v"(v));
    return v; }
template <bool DRY = false> __device__ __forceinline__ void ph_topk(const Frame& F, const Args& A, int l) {
    const float* LG = WSP(float, WS_LOG);
    int* LIST = DRY ? WSP(int, WS_PR) : WSP(int, WS_LIST); float* TOPW = DRY ? WSP(float, WS_PR + 18 * MiB) : WSP(float, WS_TOPW); int* EPO = DRY ? WSP(int, WS_PR + 19 * MiB) : WSP(int, WS_EP);
    int* CNT = (int*)(A.ws + WS_CTL) + CW_CNT + (DRY ? 2 : l) * 256 * CNT_STRIDE;
    const float NEG = -__builtin_inff();
    const bool skipctx = l == DEPTH - 1;
    const f32x4 rb4 = *(const G1(f32x4)*)(A.in[25] + l * 256 + 4 * F.lane);
    constexpr int SLOTS = 9;
    for (int base = F.gw; base < MROWS; base += SLOTS * F.NGW) {
        f32x4 lg[SLOTS]; int es[SLOTS], ps[SLOTS]; float wt[SLOTS];
#pragma unroll
        for (int i = 0; i < SLOTS; ++i) { const int R = base + i * F.NGW; lg[i] = f32x4{0.f, 0.f, 0.f, 0.f}; es[i] = 0; ps[i] = 0; wt[i] = 0.f;
            if (R < MROWS && !(skipctx && (R % TPB) < CTX)) lg[i] = *(const G1(f32x4)*)(LG + (size_t)R * 256 + 4 * F.lane); }
#pragma unroll
        for (int i = 0; i < SLOTS; ++i) { const int R = base + i * F.NGW;
            if (R < MROWS && !(skipctx && (R % TPB) < CTX)) {
                const float sc[4] = {sigmoidf_(lg[i].x), sigmoidf_(lg[i].y), sigmoidf_(lg[i].z), sigmoidf_(lg[i].w)};
                const float bi[4] = {sc[0] + rb4.x, sc[1] + rb4.y, sc[2] + rb4.z, sc[3] + rb4.w};
                float t1 = fmaxf(bi[0], bi[1]), t2 = fminf(bi[0], bi[1]);
                { const float u1 = fmaxf(bi[2], bi[3]), u2 = fminf(bi[2], bi[3]); const float n1 = fmaxf(t1, u1), n2 = fmaxf(fminf(t1, u1), fmaxf(t2, u2)); t1 = n1; t2 = n2; }
#define TK_M2(C) { const float o1 = dpp_f<C>(t1), o2 = dpp_f<C>(t2); const float n1 = fmaxf(t1, o1), n2 = fmaxf(fminf(t1, o1), fmaxf(t2, o2)); t1 = n1; t2 = n2; }
                TK_M2(0xB1) TK_M2(0x4E) TK_M2(0x141)
#undef TK_M2
                const float gs = t1 + t2; const int mygrp = F.lane >> 3; int rank = 0;
#pragma unroll
                for (int j = 0; j < 8; ++j) { const float sj = __uint_as_float(__builtin_amdgcn_readlane(__float_as_uint(gs), j * 8)); rank += (int)(sj > gs) | ((int)(sj == gs) & (int)(j < mygrp)); }
                const bool sel = rank < 4;
                float cand[4];
#pragma unroll
                for (int q = 0; q < 4; ++q) cand[q] = sel ? bi[q] : NEG;
                int my_e = 0; float my_s = 0.f, ssum = 0.f;
#pragma unroll
                for (int k = 0; k < 8; ++k) {
                    float bv = cand[0], bs = sc[0]; int bq = 0;
#pragma unroll
                    for (int q = 1; q < 4; ++q) { const bool g = cand[q] > bv; bv = g ? cand[q] : bv; bs = g ? sc[q] : bs; bq = g ? q : bq; }
                    const float mx = __uint_as_float(__builtin_amdgcn_readlane(__float_as_uint(wave_max63(bv)), 63));
                    const int ol = (int)__builtin_ctzll(__ballot(bv == mx));
                    const int oq = __builtin_amdgcn_readlane(bq, ol); const float sv = __uint_as_float(__builtin_amdgcn_readlane(__float_as_uint(bs), ol));
                    const bool me = F.lane == ol;
#pragma unroll
                    for (int q = 0; q < 4; ++q) cand[q] = (me & (oq == q)) ? NEG : cand[q];
                    ssum += sv;
                    { const int ev = 4 * ol + oq; asm volatile("v_writelane_b32 %0, %1, %2" : "+v"(my_e) : "s"(ev), "n"(k)); asm volatile("v_writelane_b32 %0, %1, %2" : "+v"(my_s) : "s"(sv), "n"(k)); }
                }
                es[i] = my_e; wt[i] = my_s * __builtin_amdgcn_rcpf(ssum) * 2.5f;
            } }
#pragma unroll
        for (int i = 0; i < SLOTS; ++i) { const int R = base + i * F.NGW;
            if (R < MROWS && !(skipctx && (R % TPB) < CTX) && F.lane < 8) ps[i] = __hip_atomic_fetch_add((G1(int)*)(CNT + es[i] * CNT_STRIDE), 1, __ATOMIC_RELAXED, __HIP_MEMORY_SCOPE_AGENT); }
#pragma unroll
        for (int i = 0; i < SLOTS; ++i) { const int R = base + i * F.NGW;
            if (R < MROWS && !(skipctx && (R % TPB) < CTX) && F.lane < 8) {
                *(G1(int)*)(LIST + (size_t)es[i] * LCAP + ps[i]) = R * 8 + F.lane; *(G1(float)*)(TOPW + (size_t)R * 8 + F.lane) = wt[i]; *(G1(int)*)(EPO + (size_t)R * 8 + F.lane) = es[i] * LCAP + ps[i]; } }
    }
}
__device__ __forceinline__ void ph_experts_naive(const Frame& F, const Args& A, int l) {
    const bf16* TOK = WSP(bf16, WS_TOK); const int* LIST = WSP(int, WS_LIST); const float* TOPW = WSP(float, WS_TOPW); float* YB = WSP(float, WS_YB);
    const int* CNT = (const int*)(A.ws + WS_CTL) + CW_CNT + l * 256 * CNT_STRIDE;
    LAS bf16* Xs = (LAS bf16*)F.lds;
    LAS float* Hs = (LAS float*)(F.lds + 65536);
    LAS int* pref = (LAS int*)(F.lds + 98304);
    LAS int* sPair = pref + 320; LAS float* sW = (LAS float*)(sPair + 32);
    __syncthreads();
    if (F.tid == 0) { int s = 0; for (int e = 0; e < 256; ++e) { pref[e] = s; s += (CNT[e] + 31) >> 5; } pref[256] = s; }
    __syncthreads();
    const int total = pref[256];
    for (int id = F.bid; id < total; id += F.G) {
        int lo = 0, hi = 255; while (lo < hi) { const int mid = (lo + hi + 1) >> 1; if (pref[mid] <= id) lo = mid; else hi = mid - 1; }
        const int e = lo, c = id - pref[e], n = min(32, CNT[e] - c * 32);
        __syncthreads();
        if (F.tid < 32) { const int pr = F.tid < n ? LIST[(size_t)e * LCAP + c * 32 + F.tid] : -1; sPair[F.tid] = pr; sW[F.tid] = pr >= 0 ? TOPW[pr] : 0.f; }
        __syncthreads();
        for (int pc = F.tid; pc < 4096; pc += 512) { const int row = pc >> 7, c8 = (pc & 127) * 8, pr = sPair[row];
            v4u v = {0u, 0u, 0u, 0u}; if (pr >= 0) v = *(const v4u*)(TOK + (size_t)(pr >> 3) * 1024 + c8);
            *(LAS v4u*)(Xs + row * 1024 + c8) = v; }
        __syncthreads();
        { const int f = F.tid & 255, gu = F.tid >> 8; const float* W = (gu ? A.in[27] : A.in[26]) + ((size_t)(l * 256 + e) * 1024) * 256 + f;
          float acc[32];
#pragma unroll
          for (int r = 0; r < 32; ++r) acc[r] = 0.f;
          for (int k = 0; k < 1024; ++k) { const float w = W[(size_t)k * 256];
#pragma unroll
              for (int r = 0; r < 32; ++r) acc[r] += bf2f(Xs[r * 1024 + k]) * w; }
          if (gu == 0) {
#pragma unroll
              for (int r = 0; r < 32; ++r) Hs[r * 256 + f] = siluf_(acc[r]); }
          __syncthreads();
          if (gu == 1) {
#pragma unroll
              for (int r = 0; r < 32; ++r) Hs[r * 256 + f] *= acc[r]; }
          __syncthreads(); }
        { const float* Wd = A.in[28] + ((size_t)(l * 256 + e) * 256) * 1024 + F.tid;
          float a0[32], a1[32];
#pragma unroll
          for (int r = 0; r < 32; ++r) { a0[r] = 0.f; a1[r] = 0.f; }
          for (int k = 0; k < 256; ++k) { const float w0 = Wd[(size_t)k * 1024], w1 = Wd[(size_t)k * 1024 + 512];
#pragma unroll
              for (int r = 0; r < 32; ++r) { const float hv = Hs[r * 256 + k]; a0[r] += hv * w0; a1[r] += hv * w1; } }
#pragma unroll
          for (int r = 0; r < 32; ++r) { const int pr = sPair[r]; if (pr >= 0) { const float w = sW[r]; YB[(size_t)pr * 1024 + F.tid] = a0[r] * w; YB[(size_t)pr * 1024 + 512 + F.tid] = a1[r] * w; } } }
    }
}
struct TrItem { const float* W; bf16* WT; int ldw, k0, n0, ldwt, rowbase; };
__device__ __forceinline__ void tr_load(const TrItem& t, f32x4 (&v)[8], int lane) {
    const int rr = lane >> 3, c4 = (lane & 7) * 4;
#pragma unroll
    for (int i = 0; i < 8; ++i) v[i] = __builtin_nontemporal_load((const f32x4*)(t.W + (size_t)(t.k0 + 8 * i + rr) * t.ldw + t.n0 + c4));
}
__device__ __forceinline__ void tr_load_a(const TrItem& t, f32x4 (&v)[8], int lane) {
    const int rr = lane >> 3, c4 = (lane & 7) * 4;
#pragma unroll
    for (int i = 0; i < 8; ++i) { const float* p = t.W + (size_t)(t.k0 + 8 * i + rr) * t.ldw + t.n0 + c4; asm volatile("global_load_dwordx4 %0, %1, off nt" : "=v"(v[i]) : "v"(p) : "memory"); }
}
__device__ __forceinline__ void tr_store(const TrItem& t, const f32x4 (&v)[8], LAS float* scr, int lane) {
    const int rr = lane >> 3, c4 = (lane & 7) * 4;
#pragma unroll
    for (int i = 0; i < 8; ++i) { LAS float* d = scr + (8 * i + rr) * 33 + c4; d[0] = v[i].x; d[1] = v[i].y; d[2] = v[i].z; d[3] = v[i].w; }
    LDS_WAIT(); asm volatile("" ::: "memory");
    const int c = lane & 7;
#pragma unroll
    for (int j = 0; j < 4; ++j) { const int n = (lane >> 3) + 8 * j; const LAS float* sp = scr + (8 * c) * 33 + n;
        v4u o; o.x = pk2(sp[0 * 33], sp[1 * 33]); o.y = pk2(sp[2 * 33], sp[3 * 33]); o.z = pk2(sp[4 * 33], sp[5 * 33]); o.w = pk2(sp[6 * 33], sp[7 * 33]);
        __builtin_nontemporal_store(o, (v4u*)(t.WT + (size_t)(t.rowbase + n) * t.ldwt + t.k0 + 8 * c)); }
    LDS_WAIT(); asm volatile("" ::: "memory");
}
__device__ __forceinline__ TrItem expert_item(const Args& A, int l, int it) {
    const int e = it / 384, r = it % 384; bf16* E1 = (bf16*)(A.ws + EWL(l) + (size_t)e * EW_STRIDE); TrItem t;
    if (r < 256) { const int up = r >> 7, q = r & 127, kb = q >> 3, nb = q & 7, n0 = 32 * nb;
        t.W = (up ? A.in[27] : A.in[26]) + ((size_t)(l * 256 + e) * 1024) * 256; t.ldw = 256; t.k0 = 64 * kb; t.n0 = n0; t.WT = E1; t.ldwt = 1024; t.rowbase = (n0 >> 7) * 256 + up * 128 + (n0 & 127); }
    else { const int q = r - 256, kb = q >> 5, nb = q & 31;
        t.W = A.in[28] + ((size_t)(l * 256 + e) * 256) * 1024; t.ldw = 1024; t.k0 = 64 * kb; t.n0 = 32 * nb; t.WT = E1 + 512 * 1024; t.ldwt = 256; t.rowbase = 32 * nb; }
    return t;
}
__device__ __forceinline__ void ph_expert_w_idx(const Frame& F, const Args& A, int l, int lo, int hi, int ci, int nblk) {
    if (ci < 0 || ci >= nblk) return;
    LAS float* scr = (LAS float*)(F.lds + F.wave * 16384);
    const int stride = nblk * NWAVES; int it = lo + ci * NWAVES + F.wave; if (it >= hi) return;
    f32x4 va[8], vb[8], vc[8]; TrItem ta = expert_item(A, l, it), tb = ta, tc = ta;
    tr_load_a(ta, va, F.lane);
    if (it + stride < hi) { tb = expert_item(A, l, it + stride); tr_load_a(tb, vb, F.lane); }
#define EW_STEP(TP, VP, TS, VS) { if (it + 2 * stride < hi) { TP = expert_item(A, l, it + 2 * stride); tr_load_a(TP, VP, F.lane); asm volatile("s_waitcnt vmcnt(16)" ::: "memory"); } \
        else asm volatile("s_waitcnt vmcnt(0)" ::: "memory"); \
        tr_store(TS, VS, scr, F.lane); it += stride; if (it >= hi) break; }
    for (;;) {
        EW_STEP(tc, vc, ta, va)
        EW_STEP(ta, va, tb, vb)
        EW_STEP(tb, vb, tc, vc)
    }
#undef EW_STEP
}
__device__ __forceinline__ void ph_expert_w(const Frame& F, const Args& A, int l, int lo, int hi, int blk0, int nblk) { ph_expert_w_idx(F, A, l, lo, hi, F.bid - blk0, nblk); }
constexpr int EWI_N = 256 * 384, EWI_A = 9800, EWI_B = 20800, EWI_C = 75000, EWI_D = 90000;
constexpr int KCONV_WIN = 18, KCONV_LRU = 44, KCONV_D = 124;
constexpr int KCONV_RS = 58, Q13 = 12, Q15 = 72, Q16 = 48;
__device__ __forceinline__ int moe_geff(int units, int G) { if (units <= 0) return G; const int rounds = (units + G - 1) / G; return (units + rounds - 1) / rounds; }
constexpr int MOE_MAXU = 11;
struct MoeSched {
    const LAS int* pref; const LAS int* cnt; const int* list; const char* abase; const char* bbase; int npn, G, c, lda2; size_t b_pn_stride; bool gather; LAS int* idx;
    __device__ __forceinline__ bool next(int i, pg8::UnitG& U) const {
        const long id = (long)i * G + c; const int total = pref[256]; if (id >= (long)total * npn) return false;
        const int tau = (int)(id / npn), pn = (int)(id % npn);
        int lo = 0, hi = 255; while (lo < hi) { const int mid = (lo + hi + 1) >> 1; if (pref[mid] <= tau) lo = mid; else hi = mid - 1; }
        const int e = lo, t = tau - pref[e];
        U.e = e; U.pn = pn; U.valid = min(256, cnt[e] - t * 256); U.rows = list + (size_t)e * LCAP + t * 256; U.row0 = tau * 256; U.lrows = idx ? idx + (i % MOE_MAXU) * 256 : nullptr;
        U.a = gather ? abase : abase + (size_t)tau * 256 * lda2; U.b = bbase + (size_t)e * EW_STRIDE + (size_t)pn * b_pn_stride; return true;
    }
};
__device__ __forceinline__ void moe_prefix(const Frame& F, const int* CNT, LAS int* pref) {
    LAS int* tmp = pref + 320;
    __syncthreads();
    if (F.tid < 256) tmp[F.tid] = CNT[F.tid * CNT_STRIDE];
    __syncthreads();
    if (F.tid <= 256) { int sum = 0; for (int e = 0; e < F.tid; ++e) sum += (tmp[e] + 255) >> 8; pref[F.tid] = sum; }
    __syncthreads();
}
struct EpiSwiGLU {
    static constexpr bool PERM = true;
    bf16* HB;
    __device__ __forceinline__ void operator()(const f32x4 (&acc)[2][2][4][2], const pg8::UnitG& u, int wr, int wc, int fr, int fq) const {
#pragma unroll
        for (int ai = 0; ai < 2; ++ai)
#pragma unroll
            for (int m = 0; m < 4; ++m) { const int r = ai * 128 + wr * 64 + m * 16 + fr;
                const f32x4 g0 = acc[ai][0][m][0], g1 = acc[ai][0][m][1], u0 = acc[ai][1][m][0], u1 = acc[ai][1][m][1];
                v4u w; w.x = pk2(siluf_(g0[0]) * u0[0], siluf_(g0[1]) * u0[1]); w.y = pk2(siluf_(g0[2]) * u0[2], siluf_(g0[3]) * u0[3]);
                w.z = pk2(siluf_(g1[0]) * u1[0], siluf_(g1[1]) * u1[1]); w.w = pk2(siluf_(g1[2]) * u1[2], siluf_(g1[3]) * u1[3]);
                *(v4u*)(HB + (size_t)(u.row0 + r) * 256 + u.pn * 128 + wc * 32 + 8 * fq) = w; }
    }
};
struct EpiScatter {
    static constexpr bool PERM = true;
    bf16* Y;
    __device__ __forceinline__ void operator()(const f32x4 (&acc)[2][2][4][2], const pg8::UnitG& u, int wr, int wc, int fr, int fq) const {
#pragma unroll
        for (int ai = 0; ai < 2; ++ai)
#pragma unroll
            for (int m = 0; m < 4; ++m) { const int r = ai * 128 + wr * 64 + m * 16 + fr;
                if (r < u.valid) { bf16* dst = Y + (size_t)(u.row0 + r) * 1024 + u.pn * 256 + wc * 32 + 8 * fq;
#pragma unroll
                    for (int bj = 0; bj < 2; ++bj) { const f32x4 v0 = acc[ai][bj][m][0], v1 = acc[ai][bj][m][1];
                        v4u o; o.x = pk2(v0[0], v0[1]); o.y = pk2(v0[2], v0[3]); o.z = pk2(v1[0], v1[1]); o.w = pk2(v1[2], v1[3]);
                        *(v4u*)(dst + bj * 128) = o; } } }
    }
};
__device__ __forceinline__ int conv_base(const Frame& F, const Args& A, int l) {
    if (l == 0) return 0;
    const int* CNT = (const int*)(A.ws + WS_CTL) + CW_CNT + (l - 1) * 256 * CNT_STRIDE; LAS int* pref = (LAS int*)(F.lds + RING_BYTES + 1024);
    moe_prefix(F, CNT, pref);
    const int tiles = pref[256], k15 = F.G - moe_geff(2 * tiles, F.G), k16 = F.G - moe_geff(4 * tiles, F.G);
    int base = KCONV_RS * NWAVES * Q13 + k15 * NWAVES * Q15 + k16 * NWAVES * Q16;
    __syncthreads();
    return base < EWI_N ? base : EWI_N;
}
__device__ __forceinline__ void ph_experts_up(const Frame& F, const Args& A, int l) {
    const int* CNT = (const int*)(A.ws + WS_CTL) + CW_CNT + l * 256 * CNT_STRIDE; LAS int* pref = (LAS int*)(F.lds + RING_BYTES + 1024);
    moe_prefix(F, CNT, pref);
    const int vcu = (F.G % 8 == 0) ? (F.bid % 8) * (F.G / 8) + F.bid / 8 : F.bid;
    const bool early = l + 1 < DEPTH; const int tiles = pref[256], Ge = early ? moe_geff(2 * tiles, F.G) : F.G;
    if (vcu < Ge) {
        LAS int* idx = (LAS int*)(F.lds + RING_BYTES + 4608);
        MoeSched S{pref, pref + 320, WSP(int, WS_LIST), (const char*)WSP(bf16, WS_TOK), (const char*)(A.ws + EWL(l)), 2, Ge, vcu, 2048, (size_t)256 * 1024 * 2, true, idx};
        { int vals[MOE_MAXU];
#pragma unroll
          for (int i = 0; i < MOE_MAXU; ++i) { pg8::UnitG U; vals[i] = 0; if (S.next(i, U) && F.tid < 256) vals[i] = *(const G1(int)*)(U.rows + min(F.tid, U.valid - 1)); }
#pragma unroll
          for (int i = 0; i < MOE_MAXU; ++i) if (F.tid < 256) idx[i * 256 + F.tid] = vals[i]; }
        __syncthreads();
        EpiSwiGLU E{WSP(bf16, WS_HB)};
        pg8::gemm_phase_g<EpiSwiGLU, MoeSched, true>(F.lds, 1024, 1024, 1024, S, E);
    } else { const int k = F.G - Ge, lo = KCONV_RS * NWAVES * Q13; ph_expert_w_idx(F, A, l + 1, lo, min(EWI_N, lo + k * NWAVES * Q15), vcu - Ge, k); }
    __syncthreads();
}
__device__ __forceinline__ void ph_experts_down(const Frame& F, const Args& A, int l) {
    const int* CNT = (const int*)(A.ws + WS_CTL) + CW_CNT + l * 256 * CNT_STRIDE; LAS int* pref = (LAS int*)(F.lds + RING_BYTES + 1024);
    moe_prefix(F, CNT, pref);
    const int vcu = (F.G % 8 == 0) ? (F.bid % 8) * (F.G / 8) + F.bid / 8 : F.bid;
    const bool early = l + 1 < DEPTH; const int tiles = pref[256], Ge = early ? moe_geff(4 * tiles, F.G) : F.G;
    if (vcu < Ge) {
        MoeSched S{pref, pref + 320, WSP(int, WS_LIST), (const char*)WSP(bf16, WS_HB), (const char*)(A.ws + EWL(l) + 512 * 1024 * 2), 4, Ge, vcu, 512, (size_t)256 * 256 * 2, false, nullptr};
        EpiScatter E{WSP(bf16, WS_Y16)};
        pg8::gemm_phase_g<EpiScatter, MoeSched, false>(F.lds, 256, 256, 256, S, E);
    } else { const int k = F.G - Ge, k15 = F.G - moe_geff(2 * tiles, F.G), lo = KCONV_RS * NWAVES * Q13 + k15 * NWAVES * Q15;
        ph_expert_w_idx(F, A, l + 1, min(EWI_N, lo), min(EWI_N, lo + k * NWAVES * Q16), vcu - Ge, k); }
}
template <bool DRY = false> __device__ __forceinline__ void ph_combine(const Frame& F, const Args& A, int l) {
    const float* X = WSP(float, WS_XALL); float* XO = DRY ? WSP(float, WS_U + 492 * MiB) : WSP(float, WS_XALL); bf16* HO = DRY ? WSP(bf16, WS_U + 558 * MiB) : WSP(bf16, WS_H); const bf16* SD = WSP(bf16, WS_SD); const bf16* YS = WSP(bf16, WS_Y16); const int* EP = WSP(int, WS_EP); const float* TOPW = WSP(float, WS_TOPW);
    const int* CNT = (const int*)(A.ws + WS_CTL) + CW_CNT + l * 256 * CNT_STRIDE; LAS int* pref = (LAS int*)(F.lds + RING_BYTES + 1024);
    moe_prefix(F, CNT, pref);
    for (int R = F.gw; R < MROWS; R += F.NGW) {
        const int b = R / TPB, p = R % TPB, s = (p < CTX) ? 2 : b; const float* g2 = MODP(l, s, 5);
        if (l == DEPTH - 1 && p < CTX) continue;
        size_t so[8]; float wk[8];
#pragma unroll
        for (int k = 0; k < 8; ++k) { const int ep = EP[(size_t)R * 8 + k], e = ep / LCAP, pos = ep - e * LCAP; so[k] = ((size_t)pref[e] * 256 + pos) * 1024; wk[k] = TOPW[(size_t)R * 8 + k]; }
        v4u yv[2][8], sd[2]; f32x4 xin[2][2];
#pragma unroll
        for (int j = 0; j < 2; ++j) { const int c = 8 * F.lane + 512 * j;
#pragma unroll
            for (int k = 0; k < 8; ++k) yv[j][k] = *(const v4u*)(YS + so[k] + c);
            sd[j] = *(const v4u*)(SD + (size_t)R * 1024 + c);
            xin[j][0] = *(const f32x4*)(X + (size_t)R * 1024 + c); xin[j][1] = *(const f32x4*)(X + (size_t)R * 1024 + c + 4); }
        float xo[2][8]; float ss = 0.f;
#pragma unroll
        for (int j = 0; j < 2; ++j) { const int c = 8 * F.lane + 512 * j; float f[8] = {bf2f(sd[j].x & 0xffffu), bf2f(sd[j].x >> 16), bf2f(sd[j].y & 0xffffu), bf2f(sd[j].y >> 16), bf2f(sd[j].z & 0xffffu), bf2f(sd[j].z >> 16), bf2f(sd[j].w & 0xffffu), bf2f(sd[j].w >> 16)};
#pragma unroll
            for (int k = 0; k < 8; ++k) { const unsigned ws[4] = {yv[j][k].x, yv[j][k].y, yv[j][k].z, yv[j][k].w};
#pragma unroll
                for (int q = 0; q < 4; ++q) { f[2 * q] += wk[k] * bf2f(ws[q] & 0xffffu); f[2 * q + 1] += wk[k] * bf2f(ws[q] >> 16); } }
            const f32x4 ga = *(const f32x4*)(g2 + c), gb = *(const f32x4*)(g2 + c + 4);
            const f32x4 xa = xin[j][0] + ga * (f32x4){f[0], f[1], f[2], f[3]}, xb = xin[j][1] + gb * (f32x4){f[4], f[5], f[6], f[7]};
            if (l + 1 < DEPTH || DRY) { *(f32x4*)(XO + (size_t)R * 1024 + c) = xa; *(f32x4*)(XO + (size_t)R * 1024 + c + 4) = xb; }
            if (l == DEPTH - 1 && !DRY) { *(f32x4*)(A.out + ((size_t)b * SEQ + (p - CTX)) * 1024 + c) = xa; *(f32x4*)(A.out + ((size_t)b * SEQ + (p - CTX)) * 1024 + c + 4) = xb; }
            xo[j][0] = xa.x; xo[j][1] = xa.y; xo[j][2] = xa.z; xo[j][3] = xa.w; xo[j][4] = xb.x; xo[j][5] = xb.y; xo[j][6] = xb.z; xo[j][7] = xb.w;
#pragma unroll
            for (int e = 0; e < 8; ++e) ss += xo[j][e] * xo[j][e]; }
        if (l + 1 < DEPTH || DRY) {
            const int ln = DRY ? 0 : l + 1; const float rs = rsqrtf(wave_sum(ss) * (1.f / 1024.f) + EPS);
            const float* gn = A.in[6] + ln * 1024; const float* sc1 = MODP(ln, s, 1); const float* sh1 = MODP(ln, s, 0);
#pragma unroll
            for (int j = 0; j < 2; ++j) { const int c = 8 * F.lane + 512 * j; float y[8];
#pragma unroll
                for (int h = 0; h < 2; ++h) { const f32x4 gg = *(const f32x4*)(gn + c + 4 * h), s1 = *(const f32x4*)(sc1 + c + 4 * h), s0 = *(const f32x4*)(sh1 + c + 4 * h);
                    y[4 * h] = xo[j][4 * h] * rs * gg.x * (1.f + s1.x) + s0.x; y[4 * h + 1] = xo[j][4 * h + 1] * rs * gg.y * (1.f + s1.y) + s0.y;
                    y[4 * h + 2] = xo[j][4 * h + 2] * rs * gg.z * (1.f + s1.z) + s0.z; y[4 * h + 3] = xo[j][4 * h + 3] * rs * gg.w * (1.f + s1.w) + s0.w; }
                v4u o; o.x = pk2(y[0], y[1]); o.y = pk2(y[2], y[3]); o.z = pk2(y[4], y[5]); o.w = pk2(y[6], y[7]);
                *(v4u*)(HO + (size_t)R * 1024 + c) = o; } }
    }
}

struct EpiWin {
    static constexpr bool PERM = true; static constexpr int MIDK = 0;
    bf16 *Kb, *Vb, *Qb, *LXb, *GLG, *ZP, *GT; const float* qg; const float* kg;
    __device__ __forceinline__ void operator()(const f32x4 (&acc)[2][2][4][2], const pg8::Unit& u, int wr, int wc, int fr, int fq) const {
        const int pn = u.pn, sec = pn >> 2;
        if (sec == 0 || sec == 3) {
            const bool isq = sec == 3; const bool lat = (u.pm % 33) != 0;
            bf16* dst = (isq ? Qb : Kb) + (pn & 3) * 256 + wc * 64 + 8 * fq; const float* gn = isq ? qg : kg; const float gs = isq ? QSCALE : 1.f;
            f32x4 g[2][2]; float invf[4];
#pragma unroll
            for (int bj = 0; bj < 2; ++bj)
#pragma unroll
                for (int n = 0; n < 2; ++n) g[bj][n] = *(const f32x4*)(gn + 32 * bj + 16 * n + 4 * fq) * gs;
#pragma unroll
            for (int e = 0; e < 4; ++e) invf[e] = exp2f(-(float)(4 * fq + e) * (13.287712379549449f / 16.f)) * 0.15915494309189535f;
#pragma unroll
            for (int ai = 0; ai < 2; ++ai)
#pragma unroll
                for (int m = 0; m < 4; ++m) { const int R = u.pm * 256 + ai * 128 + wr * 64 + m * 16 + fr, t = (R % TPB) - CTX;
                    float ss = 0.f;
#pragma unroll
                    for (int bj = 0; bj < 2; ++bj)
#pragma unroll
                        for (int n = 0; n < 2; ++n) { const f32x4 v = acc[ai][bj][m][n]; ss += (v[0] * v[0] + v[1] * v[1]) + (v[2] * v[2] + v[3] * v[3]); }
                    ss += sx<16>(ss); ss += sx<32>(ss);
                    const float rs = rsqrtf(ss * (1.f / 64.f) + EPS);
#pragma unroll
                    for (int bj = 0; bj < 2; ++bj) { const float pos = (float)(bj ? (t & 63) : (t >> 6));
                        const f32x4 y1 = acc[ai][bj][m][0] * rs * g[bj][0], y2 = acc[ai][bj][m][1] * rs * g[bj][1]; f32x4 o1 = y1, o2 = y2;
                        if (lat) {
#pragma unroll
                            for (int e = 0; e < 4; ++e) { const float rev = pos * invf[e]; const float cs = __builtin_amdgcn_cosf(rev), sn = __builtin_amdgcn_sinf(rev);
                                o1[e] = y1[e] * cs - y2[e] * sn; o2[e] = y1[e] * sn + y2[e] * cs; } }
                        bf16* p = dst + (size_t)R * 1024 + 32 * bj;
                        v4u ov; ov.x = pk2(o1[0], o1[1]); ov.y = pk2(o1[2], o1[3]); ov.z = pk2(o2[0], o2[1]); ov.w = pk2(o2[2], o2[3]);
                        *(v4u*)p = ov; }
                    asm volatile("" ::: "memory"); }
        } else {
            bf16* base; int ld = 1024, act = 0;
            if (sec == 1) base = Vb + (pn & 3) * 256; else if (sec == 2) base = LXb + (pn & 3) * 256; else if (sec == 4) { base = GLG + (pn & 3) * 256; act = 1; }
            else if (sec == 5) base = ZP + (pn & 3) * 256; else { base = GT + (pn - 24) * 256; ld = 3072; act = 2; }
            base += wc * 32 + 8 * fq;
#pragma unroll
            for (int ai = 0; ai < 2; ++ai)
#pragma unroll
                for (int m = 0; m < 4; ++m) { bf16* rowp = base + (size_t)(u.pm * 256 + ai * 128 + wr * 64 + m * 16 + fr) * ld;
#pragma unroll
                    for (int bj = 0; bj < 2; ++bj) { f32x4 v0 = acc[ai][bj][m][0], v1 = acc[ai][bj][m][1];
                        if (act == 1) {
#pragma unroll
                            for (int e = 0; e < 4; ++e) { v0[e] = gelu_tanh(v0[e]); v1[e] = gelu_tanh(v1[e]); } }
                        else if (act == 2) {
#pragma unroll
                            for (int e = 0; e < 4; ++e) { v0[e] = sigmoidf_(v0[e]); v1[e] = sigmoidf_(v1[e]); } }
                        v4u o; o.x = pk2(v0[0], v0[1]); o.y = pk2(v0[2], v0[3]); o.z = pk2(v1[0], v1[1]); o.w = pk2(v1[2], v1[3]);
                        *(v4u*)(rowp + bj * 128) = o; } }
        }
    }
};

struct EpiMix {
    static constexpr bool PERM = true; static constexpr int MIDK = 16;
    const bf16* GT; bf16* MD;
    __device__ __forceinline__ void mid(f32x4 (&acc)[2][2][4][2], const pg8::Unit& u, int wr, int wc, int fr, int fq, int seg) const {
        const bf16* gb = GT + (size_t)(u.pm * 256 + wr * 64 + fr) * 3072 + (seg - 1) * 1024 + u.pn * 256 + wc * 32 + 8 * fq;
#pragma unroll
        for (int ai = 0; ai < 2; ++ai)
#pragma unroll
            for (int m = 0; m < 4; ++m)
#pragma unroll
                for (int bj = 0; bj < 2; ++bj) { const bf16* p = gb + (size_t)(ai * 128 + m * 16) * 3072 + bj * 128;
                    const v4u a = *(const v4u*)p, b = *(const v4u*)(p + 1024);
                    const unsigned aw[4] = {a.x, a.y, a.z, a.w}, bw[4] = {b.x, b.y, b.z, b.w};
#pragma unroll
                    for (int q = 0; q < 4; ++q) { const float r0 = bf2f(aw[q] & 0xffffu) * __builtin_amdgcn_rcpf(fmaxf(bf2f(bw[q] & 0xffffu), 1e-30f)), r1 = bf2f(aw[q] >> 16) * __builtin_amdgcn_rcpf(fmaxf(bf2f(bw[q] >> 16), 1e-30f));
                        acc[ai][bj][m][q >> 1][(q & 1) * 2] *= r0; acc[ai][bj][m][q >> 1][(q & 1) * 2 + 1] *= r1; } }
    }
    __device__ __forceinline__ void operator()(const f32x4 (&acc)[2][2][4][2], const pg8::Unit& u, int wr, int wc, int fr, int fq) const {
        const size_t r0 = (size_t)(u.pm * 256 + wr * 64 + fr); const int c0 = u.pn * 256 + wc * 32 + 8 * fq;
#pragma unroll
        for (int ai = 0; ai < 2; ++ai)
#pragma unroll
            for (int m = 0; m < 4; ++m)
#pragma unroll
                for (int bj = 0; bj < 2; ++bj) { const size_t R = r0 + ai * 128 + m * 16; const v4u gv = *(const v4u*)(GT + R * 3072 + 2048 + c0 + bj * 128);
                    const f32x4 v0 = acc[ai][bj][m][0], v1 = acc[ai][bj][m][1]; v4u o;
                    o.x = pk2(v0[0] * bf2f(gv.x & 0xffffu), v0[1] * bf2f(gv.x >> 16)); o.y = pk2(v0[2] * bf2f(gv.y & 0xffffu), v0[3] * bf2f(gv.y >> 16));
                    o.z = pk2(v1[0] * bf2f(gv.z & 0xffffu), v1[1] * bf2f(gv.z >> 16)); o.w = pk2(v1[2] * bf2f(gv.w & 0xffffu), v1[3] * bf2f(gv.w >> 16));
                    *(v4u*)(MD + R * 1024 + c0 + bj * 128) = o; }
    }
};
struct EpiResid {
    static constexpr bool PERM = false; static constexpr int MIDK = 0;
    float* X; const float* mod;
    const float* Xin; const float* Cin;
    __device__ __forceinline__ void operator()(const f32x4 (&acc)[2][2][4][2], const pg8::Unit& u, int wr, int wc, int fr, int fq) const {
        const int src = (u.pm % 33 == 0) ? 2 : u.pm / 33; const float* g1 = mod + src * 6144 + 2 * 1024;
        const float* sbase = Xin ? ((u.pm % 33 == 0) ? Cin + (size_t)(u.pm / 33) * CTX * 1024 : Xin + ((size_t)(u.pm / 33) * SEQ + (size_t)(u.pm % 33 - 1) * 256) * 1024) : X + (size_t)u.pm * 256 * 1024;
        const int col0 = u.pn * 256 + wc * 32 + 4 * fq;
        f32x4 gv[2][2];
#pragma unroll
        for (int bj = 0; bj < 2; ++bj)
#pragma unroll
            for (int n = 0; n < 2; ++n) gv[bj][n] = *(const f32x4*)(g1 + col0 + bj * 128 + n * 16);
#pragma unroll
        for (int ai = 0; ai < 2; ++ai)
#pragma unroll
            for (int m = 0; m < 4; ++m) { const size_t ro = (size_t)(ai * 128 + wr * 64 + m * 16 + fr) * 1024 + col0; float* rowp = X + (size_t)u.pm * 256 * 1024 + ro; const float* srow = sbase + ro;
#pragma unroll
                for (int bj = 0; bj < 2; ++bj)
#pragma unroll
                    for (int n = 0; n < 2; ++n) { *(f32x4*)(rowp + bj * 128 + n * 16) = *(const f32x4*)(srow + bj * 128 + n * 16) + gv[bj][n] * acc[ai][bj][m][n]; } }
    }
};
struct EpiRS {
    static constexpr bool PERM = true; static constexpr int MIDK = 0;
    float* LG; bf16* SH;
    __device__ __forceinline__ void operator()(const f32x4 (&acc)[2][2][4][2], const pg8::Unit& u, int wr, int wc, int fr, int fq) const {
#pragma unroll
        for (int ai = 0; ai < 2; ++ai)
#pragma unroll
            for (int m = 0; m < 4; ++m) { const size_t R = (size_t)u.pm * 256 + ai * 128 + wr * 64 + m * 16 + fr;
                if (u.pn == 0) {
#pragma unroll
                    for (int bj = 0; bj < 2; ++bj) { float* p = LG + R * 256 + bj * 128 + wc * 32 + 8 * fq; *(f32x4*)p = acc[ai][bj][m][0]; *(f32x4*)(p + 4) = acc[ai][bj][m][1]; } }
                else { const f32x4 g0 = acc[ai][0][m][0], g1 = acc[ai][0][m][1], u0 = acc[ai][1][m][0], u1 = acc[ai][1][m][1];
                    v4u w; w.x = pk2(siluf_(g0[0]) * u0[0], siluf_(g0[1]) * u0[1]); w.y = pk2(siluf_(g0[2]) * u0[2], siluf_(g0[3]) * u0[3]);
                    w.z = pk2(siluf_(g1[0]) * u1[0], siluf_(g1[1]) * u1[1]); w.w = pk2(siluf_(g1[2]) * u1[2], siluf_(g1[3]) * u1[3]);
                    *(v4u*)(SH + R * 256 + (u.pn - 1) * 128 + wc * 32 + 8 * fq) = w; } }
    }
};
__device__ __forceinline__ void ph_norm2(const Frame& F, const Args& A, int l) {
    const float* X = WSP(float, WS_XALL); bf16* TOK = WSP(bf16, WS_TOK);
    for (int R = F.gw; R < MROWS; R += F.NGW) {
        const int b = R / TPB, p = R % TPB, s = (p < CTX) ? 2 : b;
        if (l == DEPTH - 1 && p < CTX) continue;
        f32x4 v[4];
#pragma unroll
        for (int j = 0; j < 4; ++j) v[j] = *(const f32x4*)(X + (size_t)R * 1024 + 4 * F.lane + 256 * j);
        norm_mod_row(v, A.in[23] + l * 1024, MODP(l, s, 4), MODP(l, s, 3), TOK + (size_t)R * 1024, F.lane);
    }
}

constexpr int PH_PER_L = 18, N_PHASES = 1 + DEPTH * PH_PER_L;
template <int P, bool DRY = false> __device__ __forceinline__ void run_phase(const Frame& F, const Args& A, int l) {
    if constexpr (P == -1) ph_prologue(F, A);
    if constexpr (P == 0) ph_norm1(F, A, l);
#if !FAST_WIN
#error oracle w_in path removed
#endif
    if constexpr (P == 1) { const int Ge = F.G - KCONV_WIN; const int cb = conv_base(F, A, l);
        if (F.bid < Ge) { pg8::Gemm g{WSP(bf16, WS_H), WLP(l, WO_WIN), MROWS, INW, 1024, 1024, 1024}; pg8::StaticOrder S; S.init(MROWS, INW, Ge, F.bid);
            EpiWin E{WSP(bf16, WS_KB), WSP(bf16, WS_VB), WSP(bf16, WS_QB), WSP(bf16, WS_LXB), WSP(bf16, WS_GLG), WSP(bf16, WS_ZP), WSP(bf16, WS_GATES), A.in[8] + l * 64, A.in[9] + l * 64};
            pg8::gemm_phase(F.lds, g, S, E); }
        else ph_expert_w(F, A, l, min(EWI_N, cb), min(EWI_N, cb + EWI_A), Ge, KCONV_WIN); }
    if constexpr (P == 3) { ph_conv(F, A, l); ph_fft_t1_fast(F, A);
        { const int cb = conv_base(F, A, l); ph_expert_w(F, A, l, min(EWI_N, cb + (l == 0 ? EWI_D : EWI_B)), EWI_N, 0, F.G); } }
    if constexpr (P == 4) {
        { const int cb = conv_base(F, A, l);
          if (F.bid < F.G - KCONV_LRU) ph_lru_gemm(F, A, l, F.G - KCONV_LRU); else ph_expert_w(F, A, l, min(EWI_N, cb + EWI_A), min(EWI_N, cb + EWI_B), F.G - KCONV_LRU, KCONV_LRU); }
        __syncthreads();
#if FAST_FFT_A
        ph_fft_a_gemm(F, A);
#else
        ph_fft_a(F, A);
#endif
        if (l + 1 < DEPTH || DRY) ph_fft_c(F, A);
    }
    if constexpr (P == 5) {
        ph_scan1(F, A);
#if FAST_FFT_B
        ph_fft_b_gemm(F, A);
#else
        ph_fft_b(F, A);
#endif
    }
    if constexpr (P == 6) { ph_scan2_fast(F, A); ph_fft_t2_fast(F, A, l); }
    if constexpr (P == 7) { ph_scan3(F, A, l);
#if FAST_ATTN
        ph_attn(F, A, l);
#endif
    }
    if constexpr (P == 8) {
#if !FAST_ATTN
        ph_attn_naive(F, A, l);
#endif
        __syncthreads(); }
#if FAST_MIX
    if constexpr (P == 9) { const bool sp = (l == 0) && F.G > 2 * KCONV_D; const int Ge = sp ? F.G - KCONV_D : F.G;
        if (F.bid < Ge) { pg8::Gemm g{WSP(bf16, WS_MIXIN), WLP(l, WO_D1), MROWS, 1024, 3072, 3072, 3072}; pg8::StaticOrder S; S.init(MROWS, 1024, Ge, F.bid, l == DEPTH - 1);
            EpiMix E{WSP(bf16, WS_GATES), WSP(bf16, WS_MIXED)}; pg8::gemm_phase(F.lds, g, S, E); }
        else ph_expert_w(F, A, l, EWI_B, EWI_C, Ge, KCONV_D); }
    if constexpr (P == 11) { const bool sp = (l == 0) && F.G > 2 * KCONV_D; const int Ge = sp ? F.G - KCONV_D : F.G;
        if (F.bid < Ge) { pg8::Gemm g{WSP(bf16, WS_MIXED), WLP(l, WO_OUT), MROWS, 1024, 1024, 1024, 1024}; pg8::StaticOrder S; S.init(MROWS, 1024, Ge, F.bid, l == DEPTH - 1);
            EpiResid E{WSP(float, WS_XALL), (const float*)(A.ws + WS_CTL) + CW_MOD + l * 3 * 6144, l == 0 ? A.in[0] : nullptr, l == 0 ? A.in[2] : nullptr}; pg8::gemm_phase(F.lds, g, S, E); }
        else ph_expert_w(F, A, l, EWI_C, EWI_D, Ge, KCONV_D); }
    if constexpr (P == 12) ph_norm2(F, A, l);
#else
    if constexpr (P == 9) {
        { pg8::Gemm g{WSP(bf16, WS_MIXIN), WLP(l, WO_D1), MROWS, 1024, 1024, 3072, 3072}; pg8::StaticOrder S; S.init(MROWS, 1024, F.G, F.bid); pg8::EpiF32 E{WSP(float, WS_PA), 1024}; pg8::gemm_phase(F.lds, g, S, E); }
        { pg8::Gemm g{WSP(bf16, WS_MIXIN) + 1024, WLP(l, WO_D1) + 1024, MROWS, 1024, 1024, 3072, 3072}; pg8::StaticOrder S; S.init(MROWS, 1024, F.G, F.bid); pg8::EpiF32 E{WSP(float, WS_PR), 1024}; pg8::gemm_phase(F.lds, g, S, E); }
        { pg8::Gemm g{WSP(bf16, WS_MIXIN) + 2048, WLP(l, WO_D1) + 2048, MROWS, 1024, 1024, 3072, 3072}; pg8::StaticOrder S; S.init(MROWS, 1024, F.G, F.bid); pg8::EpiF32 E{WSP(float, WS_PF), 1024}; pg8::gemm_phase(F.lds, g, S, E); } }
    if constexpr (P == 10) ph_mix(F, A);
    if constexpr (P == 11) { pg8::Gemm g{WSP(bf16, WS_MIXED), WLP(l, WO_OUT), MROWS, 1024, 1024, 1024, 1024}; pg8::StaticOrder S; S.init(MROWS, 1024, F.G, F.bid);
        pg8::EpiF32 E{WSP(float, WS_Y1), 1024}; pg8::gemm_phase(F.lds, g, S, E); }
    if constexpr (P == 12) ph_resid_norm2(F, A, l);
#endif
    if constexpr (P == 13) { const bool early = l + 1 < DEPTH; const int Ge = early ? F.G - KCONV_RS : F.G;
        if (F.bid < Ge) { pg8::Gemm g{WSP(bf16, WS_TOK), WLP(l, WO_R), MROWS, 768, 1024, 1024, 1024}; pg8::StaticOrder S; S.init(MROWS, 768, Ge, F.bid, l == DEPTH - 1);
            EpiRS E{WSP(float, WS_LOG), WSP(bf16, WS_SH)}; pg8::gemm_phase(F.lds, g, S, E); }
        else ph_expert_w(F, A, l + 1, 0, KCONV_RS * NWAVES * Q13, Ge, KCONV_RS); }
    if constexpr (P == 14) ph_topk<DRY>(F, A, l);
    if constexpr (P == 15) {
#if FAST_MOE
        ph_experts_up(F, A, l);
#else
        ph_experts_naive(F, A, l); __syncthreads();
#endif

        { pg8::Gemm g{WSP(bf16, WS_SH), WLP(l, WO_SD), MROWS, 1024, 256, 256, 256}; pg8::StaticOrder S; S.init(MROWS, 1024, F.G, F.bid, l == DEPTH - 1); EpiBf16U E{WSP(bf16, WS_SD), 1024}; pg8::gemm_phase(F.lds, g, S, E); } }
    if constexpr (P == 16) {
#if FAST_MOE
        ph_experts_down(F, A, l);
#endif
    }
    if constexpr (P == 17) ph_combine<DRY>(F, A, l);
}
__device__ __forceinline__ Frame make_frame(unsigned char* lds) {
    Frame F; F.lds = (LAS unsigned char*)lds; F.tid = otid(); F.lane = F.tid & 63; F.wave = __builtin_amdgcn_readfirstlane(F.tid >> 6);
    F.bid = obid(); F.G = ogrid(); F.gw = F.bid * NWAVES + F.wave; F.NGW = F.G * NWAVES; F.gtid = (long)F.bid * 512 + F.tid; F.NT = (long)F.G * 512;
    return F;
}
template <int P> __global__ void __launch_bounds__(NWAVES * 64, 2) mk_phase(Args A) {
    extern __shared__ __attribute__((aligned(16))) unsigned char lds[];
    const Frame F = make_frame(lds);
    run_phase<P>(F, A, A.ph_lo);
}
#if N_LAUNCH_MODE == 1
__device__ __forceinline__ const float* lds_ptr(const LAS unsigned long long* tab, int i) {
    const unsigned long long v = tab[i];
    const unsigned lo = __builtin_amdgcn_readfirstlane((unsigned)v), hi = __builtin_amdgcn_readfirstlane((unsigned)(v >> 32));
    return (const float*)(const __attribute__((address_space(1))) float*)(((unsigned long long)hi << 32) | lo);
}
__device__ __forceinline__ void load_args(Args& L, const LAS unsigned long long* tab) {
#pragma unroll
    for (int i = 0; i < 32; ++i) L.in[i] = lds_ptr(tab, i);
    L.out = (float*)lds_ptr(tab, 32); L.ws = (unsigned char*)lds_ptr(tab, 33); L.ph_lo = 0; L.ph_hi = 0;
}
__global__ void __launch_bounds__(NWAVES * 64, 2) mk_fwd(Args A) {
    extern __shared__ __attribute__((aligned(16))) unsigned char lds[];
    LAS unsigned char* L3 = (LAS unsigned char*)lds;
    volatile LAS unsigned* MISC = (volatile LAS unsigned*)(L3 + MISC_OFF);
    for (int u = threadIdx.x; u < (LDS_BYTES - RING_BYTES) / 4; u += NWAVES * 64) ((LAS unsigned*)(L3 + RING_BYTES))[u] = 0u;
    __syncthreads();
    LAS unsigned long long* tab = (LAS unsigned long long*)(L3 + RING_BYTES + 4096);
    if (threadIdx.x == 0) {
#define ST(i) tab[i] = (unsigned long long)A.in[i];
        ST(0) ST(1) ST(2) ST(3) ST(4) ST(5) ST(6) ST(7) ST(8) ST(9) ST(10) ST(11) ST(12) ST(13) ST(14) ST(15) ST(16) ST(17) ST(18) ST(19) ST(20) ST(21) ST(22) ST(23) ST(24) ST(25) ST(26) ST(27) ST(28) ST(29) ST(30) ST(31)
#undef ST
        tab[32] = (unsigned long long)A.out; tab[33] = (unsigned long long)A.ws;
    }
    __syncthreads();
    (void)xcd_barrier_post((unsigned*)(A.ws + WS_CTL) + CW_BAR, MISC + 8);
#define RUN(P) do { asm volatile("; PHASE_MARK " #P); { unsigned tb_ = RING_BYTES + 4096; asm volatile("" : "+v"(tb_)); Args L; load_args(L, (const LAS unsigned long long*)(L3 + tb_)); \
        const Frame F = make_frame(lds); run_phase<P>(F, L, l); \
        if constexpr (P >= 0 && ((REP_MASK >> (P < 0 ? 0 : P)) & 1)) { for (int rp_ = 0; rp_ < REP_N; ++rp_) { asm volatile("s_waitcnt vmcnt(0)" ::: "memory"); __syncthreads(); run_phase<P, true>(F, L, l); } } \
        XcdBarrier bar; bar.bar = (unsigned*)(L.ws + WS_CTL) + CW_BAR; bar.x = xb_xcc_id(); { unsigned mo_ = MISC_OFF + 32; asm volatile("" : "+v"(mo_)); bar.st = (volatile LAS unsigned*)(L3 + mo_); } \
        xcd_barrier(bar); } } while (0)
    { const int l = 0; RUN(-1);
#if REP_PRO
      for (int rp_ = 0; rp_ < 2; ++rp_) { RUN(-1); }
#endif
    }
    for (int l = 0; l < DEPTH; ++l) {
        if (l == 0) RUN(0);
        RUN(1); RUN(3); RUN(4); RUN(5); RUN(6); RUN(7); RUN(9); RUN(11); RUN(12); RUN(13); RUN(14); RUN(15); RUN(16); RUN(17);
    }
#undef RUN
}
#endif

extern "C" void kernel_launch(void* const* d_in, const int* in_sizes, int n_in, void* d_out, int out_size, void* d_ws, size_t ws_size, hipStream_t stream) {
    static int grid = 0;
    if (grid == 0) {
        if (n_in != 32 || out_size != NB * SEQ * DM || ws_size < WS_END) { fprintf(stderr, "kernel_launch: unexpected shapes (n_in %d, out %d, ws %zu < %zu)\n", n_in, out_size, ws_size, (size_t)WS_END); grid = -1; return; }
        int dev = 0, cus = 0;
        if (hipGetDevice(&dev) != hipSuccess || hipDeviceGetAttribute(&cus, hipDeviceAttributeMultiprocessorCount, dev) != hipSuccess) { grid = -1; return; }
#define SETA(K) if (hipFuncSetAttribute((const void*)K, hipFuncAttributeMaxDynamicSharedMemorySize, LDS_BYTES) != hipSuccess) { fprintf(stderr, "kernel_launch: hipFuncSetAttribute failed\n"); grid = -1; return; }
#if N_LAUNCH_MODE == 1
        SETA(mk_fwd)
#else
        SETA(mk_phase<-1>) SETA(mk_phase<0>) SETA(mk_phase<1>) SETA(mk_phase<2>) SETA(mk_phase<3>) SETA(mk_phase<4>) SETA(mk_phase<5>) SETA(mk_phase<6>) SETA(mk_phase<7>) SETA(mk_phase<8>)
        SETA(mk_phase<9>) SETA(mk_phase<10>) SETA(mk_phase<11>) SETA(mk_phase<12>) SETA(mk_phase<13>) SETA(mk_phase<14>) SETA(mk_phase<15>) SETA(mk_phase<16>) SETA(mk_phase<17>)
#endif
#undef SETA
        int per_cu = 0;
        (void)per_cu;
        if (cus * MOE_MAXU < 2 * (NPAIR / 256 + 256)) { fprintf(stderr, "kernel_launch: too few CUs (%d) for the staged MoE row lists\n", cus); grid = -1; return; }
        grid = cus;
    }
    if (grid < 0) return;
    (void)hipMemsetAsync((char*)d_ws + WS_CTL, 0, CTL_ZERO_BYTES, stream);
    Args a{};
    for (int i = 0; i < 32; ++i) a.in[i] = (const float*)d_in[i];
    a.out = (float*)d_out; a.ws = (unsigned char*)d_ws;
#if N_LAUNCH_MODE == 1
    a.ph_lo = 0; a.ph_hi = N_PHASES;
    hipLaunchKernelGGL(mk_fwd, dim3(grid), dim3(NWAVES * 64), LDS_BYTES, stream, a);
#else
#define LAUNCH_P(P) hipLaunchKernelGGL(mk_phase<P>, dim3(grid), dim3(NWAVES * 64), LDS_BYTES, stream, a)
    a.ph_lo = 0; a.ph_hi = 0; LAUNCH_P(-1);
    for (int l = 0; l < DEPTH; ++l) { a.ph_lo = l;
        LAUNCH_P(0); LAUNCH_P(1); LAUNCH_P(2); LAUNCH_P(3); LAUNCH_P(4); LAUNCH_P(5); LAUNCH_P(6); LAUNCH_P(7); LAUNCH_P(8); LAUNCH_P(9); LAUNCH_P(10); LAUNCH_P(11); LAUNCH_P(12); LAUNCH_P(13); LAUNCH_P(14); LAUNCH_P(15); LAUNCH_P(16); LAUNCH_P(17); }
#undef LAUNCH_P
#endif
    const hipError_t le = hipPeekAtLastError();
    if (le != hipSuccess) fprintf(stderr, "kernel_launch: launch failed: %s\n", hipGetErrorName(le));
}
```

```cpp
#include <hip/hip_runtime.h>
#include <cstdio>
#include <cstdint>

#ifndef ATTN_V2
#define ATTN_V2 8
#endif
#ifndef REP_PRO
#define REP_PRO 0
#endif
#ifndef REP_MASK
#define REP_MASK 0
#endif
#ifndef REP_N
#define REP_N 2
#endif
#ifndef FAST_MIX
#define FAST_MIX 1
#endif
#ifndef FAST_WIN
#define FAST_WIN 1
#endif
#ifndef FAST_LRU
#define FAST_LRU 1
#endif
#define FAST_FFT 0
#ifndef FAST_FFT_A
#define FAST_FFT_A 1
#endif
#ifndef FAST_FFT_B
#define FAST_FFT_B 1
#endif
#ifndef FAST_MOE
#define FAST_MOE 1
#endif
#ifndef FAST_ATTN
#define FAST_ATTN 1
#endif
#ifndef N_LAUNCH_MODE
#define N_LAUNCH_MODE 1
#endif

__device__ __forceinline__ int otid() { int t = threadIdx.x; asm volatile("" : "+v"(t)); return t; }
__device__ __forceinline__ int obid() { int b = blockIdx.x; asm volatile("" : "+s"(b)); return b; }
__device__ __forceinline__ int ogrid() { int g = gridDim.x; asm volatile("" : "+s"(g)); return g; }
template <int M> __device__ __forceinline__ float sx(float v) {
    static_assert(M == 1 || M == 2 || M == 4 || M == 8 || M == 16 || M == 32, "xor mask");
    if constexpr (M < 32) return __uint_as_float((unsigned)__builtin_amdgcn_ds_swizzle((int)__float_as_uint(v), (M << 10) | 0x1f));
    else { auto rr = __builtin_amdgcn_permlane32_swap(__float_as_uint(v), __float_as_uint(v), false, false); const unsigned a = rr[0], b = rr[1]; return __uint_as_float(a == __float_as_uint(v) ? b : a); }
}
template <int M> __device__ __forceinline__ int sxi(int v) { return (int)__float_as_uint(sx<M>(__uint_as_float((unsigned)v))); }
namespace pg8 {
#define PG8_LAS __attribute__((address_space(3)))
typedef unsigned short bf16_t;
typedef short bf16x8 __attribute__((ext_vector_type(8)));
typedef float f32x4 __attribute__((ext_vector_type(4)));
typedef unsigned u32x4 __attribute__((ext_vector_type(4)));
constexpr int BM = 256, BK = 64, HALF = 128, HTB = HALF * BK * 2, STAGE_BYTES = 8 * HTB, NXCD = 8, WGM = 8;
__host__ __device__ __forceinline__ int lds_byte(int r, int c) { const int st = (r >> 4) * 2 + (c >> 5), rr = r & 15, cc = c & 31, ob = rr * 64 + cc * 2; return st * 1024 + (ob ^ (((ob >> 9) & 1) << 5)); }
__host__ __device__ __forceinline__ void stage_rc(int b, int& R, int& C) { const int st = b / 1024, sb = b % 1024, swz = sb ^ (((sb >> 9) & 1) << 5); R = (st >> 1) * 16 + swz / 64; C = (st & 1) * 32 + (swz % 64) / 2; }
__host__ __device__ __forceinline__ int perm32(int rho) { const int n = rho >> 4, i = rho & 15; return 8 * (i >> 2) + 4 * n + (i & 3); }
struct Unit { int pm, pn; };
struct Gemm { const bf16_t* A; const bf16_t* Bt; int M, N, K, lda, ldb; };
struct StaticOrder {
    int nM, nN, nwg, G, c; bool skipctx;
    __host__ __device__ void init(int M, int N, int G_, int c_, bool skip = false) { nM = skip ? 64 : M / BM; nN = N / BM; nwg = nM * nN; G = G_; c = c_; skipctx = skip; }
    __host__ __device__ bool next(int i, Unit& u) const {
        const long L = (long)i * G + c; if (L >= nwg) return false;
        int wgid = (int)L; { const int q = nwg / NXCD, r = nwg % NXCD, xcd = wgid % NXCD, off = wgid / NXCD; wgid = (xcd < r ? xcd * (q + 1) : r * (q + 1) + (xcd - r) * q) + off; }
        const int nig = WGM * nN, gid = wgid / nig, fm = gid * WGM, gsz = (nM - fm) < WGM ? (nM - fm) : WGM;
        u.pm = fm + ((wgid % nig) % gsz); u.pn = (wgid % nig) / gsz;
        if (skipctx) u.pm += 1 + (u.pm >= 32 ? 1 : 0);
        return true;
    }
};
__device__ __forceinline__ unsigned cvt_pk_bf16(float lo, float hi) { unsigned r; asm volatile("v_cvt_pk_bf16_f32 %0, %1, %2" : "=v"(r) : "v"(lo), "v"(hi)); return r; }

struct EpiF32 {
    static constexpr bool PERM = false; static constexpr int MIDK = 0;
    float* C; int ldc;
    __device__ __forceinline__ void operator()(const f32x4 (&acc)[2][2][4][2], const Unit& u, int wr, int wc, int fr, int fq) const {
        const int row0 = u.pm * BM + wr * 64 + fr, col0 = u.pn * BM + wc * 32 + 4 * fq;
#pragma unroll
        for (int ai = 0; ai < 2; ++ai)
#pragma unroll
            for (int m = 0; m < 4; ++m) { float* rowp = C + (size_t)(row0 + ai * HALF + m * 16) * ldc + col0;
#pragma unroll
                for (int bj = 0; bj < 2; ++bj)
#pragma unroll
                    for (int n = 0; n < 2; ++n) *(f32x4*)(rowp + bj * HALF + n * 16) = acc[ai][bj][m][n]; }
    }
};

template <class Epi>
__device__ __forceinline__ void gemm_phase(PG8_LAS unsigned char* lds, const Gemm g, const StaticOrder& S, const Epi& E) {
    const int tid = otid(), wid = __builtin_amdgcn_readfirstlane(tid >> 6), lane = tid & 63, wr = wid >> 2, wc = wid & 3, fr = lane & 15, fq = lane >> 4;
    const int K = g.K, nt = K / BK;
    unsigned voffA[2], voffB[2];
#pragma unroll
    for (int i = 0; i < 2; ++i) { int R, C; stage_rc(tid * 16 + i * 8192, R, C); const int Rb = Epi::PERM ? ((R & ~31) + perm32(R & 31)) : R;
        voffA[i] = (unsigned)(R * g.lda + C) * 2u; voffB[i] = (unsigned)(Rb * g.ldb + C) * 2u; }
    const size_t kstep = (size_t)(BK * 2);
    const size_t hA = (size_t)HALF * g.lda * 2, hB = (size_t)HALF * g.ldb * 2;
    const size_t tA = 2 * hA, tB = 2 * hB;
    const unsigned ldsw = (unsigned)wid * 1024u;
    const int aoff = lds_byte(wr * 64 + fr, fq * 8), boff = lds_byte(wc * 32 + fr, fq * 8);
#define PG8_SA(b, h) (((b) * 2 + (h)) * HTB)
#define PG8_SB(b, h) ((4 + (b) * 2 + (h)) * HTB)
#define PG8_STAGE(bufoff, gbase, voff) do { _Pragma("unroll") for (int _i = 0; _i < 2; ++_i) \
        __builtin_amdgcn_global_load_lds((const unsigned*)((const char*)(gbase) + (voff)[_i]), (PG8_LAS unsigned*)(lds + (bufoff) + ldsw + _i * 8192), 16, 0, 0); } while (0)
#define PG8_LDA(dst, b, h) do { _Pragma("unroll") for (int m = 0; m < 4; ++m) _Pragma("unroll") for (int k = 0; k < 2; ++k) dst[m][k] = *(const PG8_LAS bf16x8*)(lds + PG8_SA(b, h) + aoff + m * 2048 + k * 1024); } while (0)
#define PG8_LDB(dst, b, h) do { _Pragma("unroll") for (int n = 0; n < 2; ++n) _Pragma("unroll") for (int k = 0; k < 2; ++k) dst[n][k] = *(const PG8_LAS bf16x8*)(lds + PG8_SB(b, h) + boff + n * 2048 + k * 1024); } while (0)
#define PG8_MMA(ai, bj, At, Bt) do { __builtin_amdgcn_s_setprio(1); _Pragma("unroll") for (int m = 0; m < 4; ++m) _Pragma("unroll") for (int n = 0; n < 2; ++n) _Pragma("unroll") for (int k = 0; k < 2; ++k) \
        acc[ai][bj][m][n] = __builtin_amdgcn_mfma_f32_16x16x32_bf16(Bt[n][k], At[m][k], acc[ai][bj][m][n], 0, 0, 0); __builtin_amdgcn_s_setprio(0); } while (0)
#define PG8_WAIT_V(n) asm volatile("s_waitcnt vmcnt(" #n ")" ::: "memory")
#define PG8_WAIT_L(n) asm volatile("s_waitcnt lgkmcnt(" #n ")" ::: "memory")
#define PG8_BAR __builtin_amdgcn_s_barrier()
#define PG8_SCHED __builtin_amdgcn_sched_barrier(0)
    Unit cur, nxt; int ui = 0;
    if (!S.next(0, cur)) return;
    f32x4 acc[2][2][4][2];
#pragma unroll
    for (int a = 0; a < 2; ++a)
#pragma unroll
        for (int b = 0; b < 2; ++b)
#pragma unroll
            for (int m = 0; m < 4; ++m)
#pragma unroll
                for (int n = 0; n < 2; ++n) acc[a][b][m][n] = (f32x4){0.f, 0.f, 0.f, 0.f};
    bf16x8 At[4][2], B0[2][2], B1[2][2];
    const char* cA = (const char*)g.A + (size_t)cur.pm * tA; const char* cB = (const char*)g.Bt + (size_t)cur.pn * tB;
    PG8_STAGE(PG8_SB(0, 0), cB, voffB); PG8_STAGE(PG8_SB(0, 1), cB + hB, voffB); PG8_STAGE(PG8_SA(0, 0), cA, voffA); PG8_STAGE(PG8_SA(0, 1), cA + hA, voffA);
    if (wr == 1) PG8_BAR;
    PG8_WAIT_V(2); PG8_BAR;
    PG8_STAGE(PG8_SB(1, 0), cB + kstep, voffB); PG8_STAGE(PG8_SA(1, 0), cA + kstep, voffA); PG8_STAGE(PG8_SB(1, 1), cB + hB + kstep, voffB);
    PG8_WAIT_V(6); PG8_BAR;
    for (;;) {
        const bool has_next = S.next(ui + 1, nxt);
        const char* nA = has_next ? (const char*)g.A + (size_t)nxt.pm * tA : cA; const char* nB = has_next ? (const char*)g.Bt + (size_t)nxt.pn * tB : cB;
#pragma unroll 1
        for (int t = 0; t < nt; t += 2) {
            if constexpr (Epi::MIDK > 0) { if (t > 0 && (t % Epi::MIDK) == 0) E.mid(acc, cur, wr, wc, fr, fq, t / Epi::MIDK); }
            const bool last = (t == nt - 2);
            const char* a1 = cA + (size_t)(t + 1) * kstep;
            const char* a2 = last ? nA : cA + (size_t)(t + 2) * kstep; const char* b2 = last ? nB : cB + (size_t)(t + 2) * kstep;
            const char* a3 = a2 + kstep; const char* b3 = b2 + kstep;
            PG8_LDB(B0, 0, 0); PG8_LDB(B1, 0, 1); PG8_SCHED; PG8_LDA(At, 0, 0); PG8_STAGE(PG8_SA(1, 1), a1 + hA, voffA);
            PG8_WAIT_V(8); PG8_WAIT_L(0); PG8_BAR; PG8_MMA(0, 0, At, B0); PG8_MMA(0, 1, At, B1); PG8_BAR; PG8_SCHED;
            PG8_LDA(At, 0, 1); PG8_STAGE(PG8_SB(0, 0), b2, voffB); PG8_STAGE(PG8_SB(0, 1), b2 + hB, voffB); PG8_STAGE(PG8_SA(0, 0), a2, voffA);
            PG8_WAIT_V(8); PG8_WAIT_L(0); PG8_BAR; PG8_MMA(1, 0, At, B0); PG8_MMA(1, 1, At, B1); PG8_BAR; PG8_SCHED;
            PG8_LDB(B0, 1, 0); PG8_LDB(B1, 1, 1); PG8_SCHED; PG8_LDA(At, 1, 0); PG8_STAGE(PG8_SA(0, 1), a2 + hA, voffA);
            PG8_WAIT_V(8); PG8_WAIT_L(0); PG8_BAR; PG8_MMA(0, 0, At, B0); PG8_MMA(0, 1, At, B1); PG8_BAR; PG8_SCHED;
            PG8_LDA(At, 1, 1); PG8_STAGE(PG8_SB(1, 0), b3, voffB); PG8_STAGE(PG8_SB(1, 1), b3 + hB, voffB); PG8_STAGE(PG8_SA(1, 0), a3, voffA);
            PG8_WAIT_V(8); PG8_WAIT_L(0); PG8_BAR; PG8_MMA(1, 0, At, B0); PG8_MMA(1, 1, At, B1); PG8_BAR; PG8_SCHED;
        }
        if (wr == 0) PG8_BAR;
        E(acc, cur, wr, wc, fr, fq);
        if (!has_next) break;
#pragma unroll
        for (int a = 0; a < 2; ++a)
#pragma unroll
            for (int b = 0; b < 2; ++b)
#pragma unroll
                for (int m = 0; m < 4; ++m)
#pragma unroll
                    for (int n = 0; n < 2; ++n) acc[a][b][m][n] = (f32x4){0.f, 0.f, 0.f, 0.f};
        cur = nxt; cA = nA; cB = nB; ++ui;
        if (wr == 1) PG8_BAR;
    }
    PG8_WAIT_V(0);
    PG8_BAR;
#undef PG8_SA
#undef PG8_SB
#undef PG8_STAGE
#undef PG8_LDA
#undef PG8_LDB
#undef PG8_MMA
#undef PG8_WAIT_V
#undef PG8_WAIT_L
#undef PG8_BAR
#undef PG8_SCHED
}

struct UnitG { const char* a; const char* b; int row0, pn, e, valid; const int* rows; const PG8_LAS int* lrows; };
template <class Epi, class Sched, bool GATHER>
__device__ __forceinline__ void gemm_phase_g(PG8_LAS unsigned char* lds, const int K, const int lda, const int ldb, const Sched& S, const Epi& E) {
    const int tid = otid(), wid = __builtin_amdgcn_readfirstlane(tid >> 6), lane = tid & 63, wr = wid >> 2, wc = wid & 3, fr = lane & 15, fq = lane >> 4;
    const int nt = K / BK;
    int RA[2], CA[2]; unsigned voffB[2];
#pragma unroll
    for (int i = 0; i < 2; ++i) { int R, C; stage_rc(tid * 16 + i * 8192, R, C); const int Rb = Epi::PERM ? ((R & ~31) + perm32(R & 31)) : R;
        RA[i] = R; CA[i] = C; voffB[i] = (unsigned)(Rb * ldb + C) * 2u; }
    const size_t kstep = (size_t)(BK * 2);
    const size_t hB = (size_t)HALF * ldb * 2;
    const unsigned ldsw = (unsigned)wid * 1024u;
    const int aoff = lds_byte(wr * 64 + fr, fq * 8), boff = lds_byte(wc * 32 + fr, fq * 8);
#define PG8_SA(b, h) (((b) * 2 + (h)) * HTB)
#define PG8_SB(b, h) ((4 + (b) * 2 + (h)) * HTB)
#define PG8_STAGE(bufoff, gbase, voff) do { _Pragma("unroll") for (int _i = 0; _i < 2; ++_i) \
        __builtin_amdgcn_global_load_lds((const unsigned*)((const char*)(gbase) + (voff)[_i]), (PG8_LAS unsigned*)(lds + (bufoff) + ldsw + _i * 8192), 16, 0, 0); } while (0)
#define PG8_LDA(dst, b, h) do { _Pragma("unroll") for (int m = 0; m < 4; ++m) _Pragma("unroll") for (int k = 0; k < 2; ++k) dst[m][k] = *(const PG8_LAS bf16x8*)(lds + PG8_SA(b, h) + aoff + m * 2048 + k * 1024); } while (0)
#define PG8_LDB(dst, b, h) do { _Pragma("unroll") for (int n = 0; n < 2; ++n) _Pragma("unroll") for (int k = 0; k < 2; ++k) dst[n][k] = *(const PG8_LAS bf16x8*)(lds + PG8_SB(b, h) + boff + n * 2048 + k * 1024); } while (0)
#define PG8_MMA(ai, bj, At, Bt) do { __builtin_amdgcn_s_setprio(1); _Pragma("unroll") for (int m = 0; m < 4; ++m) _Pragma("unroll") for (int n = 0; n < 2; ++n) _Pragma("unroll") for (int k = 0; k < 2; ++k) \
        acc[ai][bj][m][n] = __builtin_amdgcn_mfma_f32_16x16x32_bf16(Bt[n][k], At[m][k], acc[ai][bj][m][n], 0, 0, 0); __builtin_amdgcn_s_setprio(0); } while (0)
#define PG8_WAIT_V(n) asm volatile("s_waitcnt vmcnt(" #n ")" ::: "memory")
#define PG8_WAIT_L(n) asm volatile("s_waitcnt lgkmcnt(" #n ")" ::: "memory")
#define PG8_BAR __builtin_amdgcn_s_barrier()
#define PG8_SCHED __builtin_amdgcn_sched_barrier(0)
#define PG8_MKOFF(u, v) do { _Pragma("unroll") for (int _h = 0; _h < 2; ++_h) _Pragma("unroll") for (int _i = 0; _i < 2; ++_i) { const int _row = _h * HALF + RA[_i]; \
        if (GATHER) { const int _pr = (u).lrows[_row]; v[_h][_i] = (unsigned)(_pr >> 3) * (unsigned)(lda * 2) + (unsigned)(CA[_i] * 2); } \
        else v[_h][_i] = (unsigned)(_row * lda + CA[_i]) * 2u; } } while (0)
    UnitG cur, nxt; int ui = 0;
    if (!S.next(0, cur)) return;
    f32x4 acc[2][2][4][2];
#pragma unroll
    for (int a = 0; a < 2; ++a)
#pragma unroll
        for (int b = 0; b < 2; ++b)
#pragma unroll
            for (int m = 0; m < 4; ++m)
#pragma unroll
                for (int n = 0; n < 2; ++n) acc[a][b][m][n] = (f32x4){0.f, 0.f, 0.f, 0.f};
    bf16x8 At[4][2], B0[2][2], B1[2][2];
    unsigned vA[2][2], vN[2][2];
    PG8_MKOFF(cur, vA);
    const char* cA = cur.a; const char* cB = cur.b;
    PG8_STAGE(PG8_SB(0, 0), cB, voffB); PG8_STAGE(PG8_SB(0, 1), cB + hB, voffB); PG8_STAGE(PG8_SA(0, 0), cA, vA[0]); PG8_STAGE(PG8_SA(0, 1), cA, vA[1]);
    if (wr == 1) PG8_BAR;
    PG8_WAIT_V(2); PG8_BAR;
    PG8_STAGE(PG8_SB(1, 0), cB + kstep, voffB); PG8_STAGE(PG8_SA(1, 0), cA + kstep, vA[0]); PG8_STAGE(PG8_SB(1, 1), cB + hB + kstep, voffB);
    PG8_WAIT_V(6); PG8_BAR;
    for (;;) {
        const bool has_next = S.next(ui + 1, nxt);
        if constexpr (GATHER) { if (has_next) { PG8_MKOFF(nxt, vN); } else { vN[0][0] = vA[0][0]; vN[0][1] = vA[0][1]; vN[1][0] = vA[1][0]; vN[1][1] = vA[1][1]; } }
        const char* nA = has_next ? nxt.a : cA; const char* nB = has_next ? nxt.b : cB;
#pragma unroll 1
        for (int t = 0; t < nt; t += 2) {
            const bool last = (t == nt - 2);
            const char* a1 = cA + (size_t)(t + 1) * kstep;
            const char* a2 = last ? nA : cA + (size_t)(t + 2) * kstep; const char* b2 = last ? nB : cB + (size_t)(t + 2) * kstep;
            const char* a3 = a2 + kstep; const char* b3 = b2 + kstep;
            unsigned s0[2], s1[2];
            if constexpr (GATHER) { s0[0] = last ? vN[0][0] : vA[0][0]; s0[1] = last ? vN[0][1] : vA[0][1]; s1[0] = last ? vN[1][0] : vA[1][0]; s1[1] = last ? vN[1][1] : vA[1][1]; }
            else { s0[0] = vA[0][0]; s0[1] = vA[0][1]; s1[0] = vA[1][0]; s1[1] = vA[1][1]; }
            PG8_LDB(B0, 0, 0); PG8_LDB(B1, 0, 1); PG8_SCHED; PG8_LDA(At, 0, 0); PG8_STAGE(PG8_SA(1, 1), a1, vA[1]);
            PG8_WAIT_V(8); PG8_WAIT_L(0); PG8_BAR; PG8_MMA(0, 0, At, B0); PG8_MMA(0, 1, At, B1); PG8_BAR; PG8_SCHED;
            PG8_LDA(At, 0, 1); PG8_STAGE(PG8_SB(0, 0), b2, voffB); PG8_STAGE(PG8_SB(0, 1), b2 + hB, voffB); PG8_STAGE(PG8_SA(0, 0), a2, s0);
            PG8_WAIT_V(8); PG8_WAIT_L(0); PG8_BAR; PG8_MMA(1, 0, At, B0); PG8_MMA(1, 1, At, B1); PG8_BAR; PG8_SCHED;
            PG8_LDB(B0, 1, 0); PG8_LDB(B1, 1, 1); PG8_SCHED; PG8_LDA(At, 1, 0); PG8_STAGE(PG8_SA(0, 1), a2, s1);
            PG8_WAIT_V(8); PG8_WAIT_L(0); PG8_BAR; PG8_MMA(0, 0, At, B0); PG8_MMA(0, 1, At, B1); PG8_BAR; PG8_SCHED;
            PG8_LDA(At, 1, 1); PG8_STAGE(PG8_SB(1, 0), b3, voffB); PG8_STAGE(PG8_SB(1, 1), b3 + hB, voffB); PG8_STAGE(PG8_SA(1, 0), a3, s0);
            PG8_WAIT_V(8); PG8_WAIT_L(0); PG8_BAR; PG8_MMA(1, 0, At, B0); PG8_MMA(1, 1, At, B1); PG8_BAR; PG8_SCHED;
        }
        if (wr == 0) PG8_BAR;
        E(acc, cur, wr, wc, fr, fq);
        if (!has_next) break;
#pragma unroll
        for (int a = 0; a < 2; ++a)
#pragma unroll
            for (int b = 0; b < 2; ++b)
#pragma unroll
                for (int m = 0; m < 4; ++m)
#pragma unroll
                    for (int n = 0; n < 2; ++n) acc[a][b][m][n] = (f32x4){0.f, 0.f, 0.f, 0.f};
        cur = nxt; cA = nA; cB = nB; ++ui;
        if constexpr (GATHER) { vA[0][0] = vN[0][0]; vA[0][1] = vN[0][1]; vA[1][0] = vN[1][0]; vA[1][1] = vN[1][1]; }
        if (wr == 1) PG8_BAR;
    }
    PG8_WAIT_V(0);
    PG8_BAR;
#undef PG8_SA
#undef PG8_SB
#undef PG8_STAGE
#undef PG8_LDA
#undef PG8_LDB
#undef PG8_MMA
#undef PG8_WAIT_V
#undef PG8_WAIT_L
#undef PG8_BAR
#undef PG8_SCHED
#undef PG8_MKOFF
}
}

constexpr int DM = 1024, NB = 2, SEQ = 8192, CTX = 256, TPB = SEQ + CTX, MROWS = NB * TPB, DEPTH = 2;
constexpr int INW = 9216, COL_K = 0, COL_V = 1024, COL_LX = 2048, COL_Q = 3072, COL_LG = 4096, COL_F = 5120, COL_G = 6144;
constexpr int NE = 256, TOPK = 8, EFF = 256, NPAIR = MROWS * TOPK, LCAP = MROWS;
constexpr float EPS = 1e-6f;
constexpr float QSCALE = 0.125f * 1.4426950408889634f;
constexpr int NCHUNK = TPB / 64;
static_assert(MROWS % 256 == 0, "rows");

constexpr size_t MiB = 1u << 20;
constexpr size_t WS_CTL = 0, CTL_ZERO_BYTES = 1 * MiB;
constexpr size_t WS_W = 1 * MiB, WL_STRIDE = 32 * MiB;
constexpr size_t WO_TAB = 31 * MiB;
constexpr size_t WO_WIN = 0, WO_D1 = 18 * MiB, WO_OUT = 24 * MiB, WO_R = 26 * MiB, WO_SGU = 27 * MiB, WO_SD = 28 * MiB, WO_LRU = 29 * MiB;
constexpr size_t WS_XALL = 65 * MiB;
constexpr size_t WS_H = WS_XALL + 66 * MiB;
constexpr size_t WS_U = WS_H + 33 * MiB;
constexpr size_t WS_KB = WS_U + 594 * MiB, WS_VB = WS_KB + 33 * MiB, WS_QB = WS_VB + 33 * MiB, WS_LXB = WS_QB + 33 * MiB, WS_GLG = WS_LXB + 33 * MiB, WS_ZP = WS_GLG + 33 * MiB;
constexpr size_t WS_GATES = WS_ZP + 33 * MiB;
constexpr size_t WS_MIXIN = WS_GATES + 99 * MiB;
constexpr size_t WS_S = WS_MIXIN + 99 * MiB;
constexpr size_t WS_UC = WS_S, WS_AB = WS_UC + 33 * MiB, WS_SUMM = WS_AB + 132 * MiB, WS_CARRY = WS_SUMM + 5 * MiB, WS_XA = WS_CARRY + 3 * MiB, WS_XB = WS_XA + 32 * MiB, WS_GB = WS_XB + 32 * MiB, WS_GC = WS_GB + 32 * MiB;
constexpr size_t WS_PA = WS_S, WS_PR = WS_PA + 66 * MiB, WS_PF = WS_PR + 66 * MiB, WS_Y1 = WS_PF + 66 * MiB;
static_assert(WS_GC + 3 * MiB <= WS_S + 280 * MiB && WS_Y1 + 66 * MiB <= WS_S + 280 * MiB, "scratch S");
constexpr size_t WS_MIXED = WS_S + 280 * MiB, WS_TOK = WS_MIXED + 33 * MiB;
constexpr size_t WS_LOG = WS_TOK + 33 * MiB, WS_SGU = WS_LOG + 17 * MiB, WS_SH = WS_SGU + 33 * MiB, WS_LIST = WS_SH + 9 * MiB, WS_TOPW = WS_LIST + 17 * MiB, WS_SD = WS_TOPW + 1 * MiB;
constexpr size_t WS_YB = WS_U;
constexpr size_t WS_Y16 = WS_KB, WS_HB = WS_S;
constexpr size_t WS_EP = WS_SUMM;
constexpr size_t WS_Y16_OLD = WS_U;
constexpr size_t WS_EW = WS_SD + 66 * MiB, WS_EW1 = WS_U, EW_STRIDE = 3 * MiB / 2;
#define EWL(l) (((l) & 1) ? WS_EW1 : WS_EW)
static_assert(WS_KB + 396 * MiB == WS_S && 392 * MiB <= 396 * MiB && WS_U + 384 * MiB <= WS_KB, "overlays");
constexpr size_t WS_END = WS_EW + 384 * MiB;
static_assert(WS_END <= 2048 * MiB, "d_ws budget");
constexpr int CW_BAR = 4096;
constexpr int CW_CNT = 16384, CNT_STRIDE = 32;
constexpr int CW_MOD = 65536;
static_assert((CW_MOD + 2 * 3 * 6144) * 4 <= (int)CTL_ZERO_BYTES, "ctl");

constexpr int LDS_BYTES = 147456, RING_BYTES = 131072, MISC_OFF = RING_BYTES + 320;
constexpr int NWAVES = 8;

#define GAS __attribute__((address_space(1)))
#define LAS __attribute__((address_space(3)))
typedef unsigned short bf16;
typedef unsigned v4u __attribute__((ext_vector_type(4)));
typedef float f32x4 __attribute__((ext_vector_type(4)));
typedef GAS unsigned gu32;
#define RLX_AGENT __ATOMIC_RELAXED, __HIP_MEMORY_SCOPE_AGENT
#define LDS_WAIT() asm volatile("s_waitcnt lgkmcnt(0)" ::: "memory")
typedef float f32x2_t __attribute__((ext_vector_type(2))); typedef __bf16 bf16x2_t __attribute__((ext_vector_type(2)));
__device__ __forceinline__ unsigned pk2(float lo, float hi) { const f32x2_t v = {lo, hi}; const bf16x2_t b = __builtin_convertvector(v, bf16x2_t); return __builtin_bit_cast(unsigned, b); }
__device__ __forceinline__ unsigned f2bf(float f) { return pk2(f, f) & 0xffffu; }
__device__ __forceinline__ float bf2f(unsigned h) { return __uint_as_float(h << 16); }
__device__ __forceinline__ float sigmoidf_(float x) { return __builtin_amdgcn_rcpf(1.f + __expf(-x)); }
__device__ __forceinline__ float siluf_(float x) { return x * __builtin_amdgcn_rcpf(1.f + __expf(-x)); }
__device__ __forceinline__ float gelu_tanh(float x) { const float u = 0.7978845608028654f * (x + 0.044715f * x * x * x); return x * __builtin_amdgcn_rcpf(1.f + __expf(-2.f * u)); }

#define XB_TMO      128
#define XB_XCNT(j)  (256  + 64 * (j))
#define XB_XSUB(j)  (1280 + 64 * (j))
#define XB_XGEN(j)  (2304 + 64 * (j))
#define XB_TOP      3328
#define XB_TOPGEN   3392
#define XCD_BAR_WORDS 3456
#define XB_SPIN_CAP (1u << 18)
__device__ __forceinline__ unsigned xb_ld(unsigned* p)              { return __hip_atomic_load(p, __ATOMIC_RELAXED, __HIP_MEMORY_SCOPE_AGENT); }
__device__ __forceinline__ unsigned xb_add(unsigned* p, unsigned v) { return __hip_atomic_fetch_add(p, v, __ATOMIC_RELAXED, __HIP_MEMORY_SCOPE_AGENT); }
__device__ __forceinline__ unsigned xb_xcc_id() { return (unsigned)__builtin_amdgcn_s_getreg((3 << 11) | 20) & 0xFu; }
#define XB_SPIN(cond, bar) do { unsigned _sp = 0; while (cond) { __builtin_amdgcn_s_sleep(1); \
    if ((++_sp & 255u) == 0u) { if (xb_ld(&(bar)[XB_TMO])) break; if (_sp > XB_SPIN_CAP) { atomicAdd(&(bar)[XB_TMO], 1u); break; } } } } while (0)
struct XcdBarrier { unsigned* bar; unsigned x; volatile LAS unsigned* st; };
__device__ __forceinline__ XcdBarrier xcd_barrier_post(unsigned* bar, volatile LAS unsigned* st) {
    XcdBarrier b; b.bar = bar; b.x = xb_xcc_id(); b.st = st;
    if (threadIdx.x == 0) (void)xb_add(&bar[XB_XCNT(b.x)], 1u);
    return b;
}
__device__ __forceinline__ void xcd_barrier_complete(unsigned* bar, unsigned x, unsigned& nloc, unsigned& nx) {
    const unsigned G = gridDim.x * gridDim.y * gridDim.z;
    unsigned sum, cnt, mine, sp = 0u;
    for (;;) {
        sum = 0u; cnt = 0u; mine = 0u;
#pragma unroll
        for (unsigned j = 0; j < 16; ++j) { const unsigned c = xb_ld(&bar[XB_XCNT(j)]); sum += c; cnt += (c > 0u) ? 1u : 0u; mine = (j == x) ? c : mine; }
        if (sum == G) break;
        __builtin_amdgcn_s_sleep(1);
        if ((++sp & 255u) == 0u) { if (xb_ld(&bar[XB_TMO])) break; if (sp > XB_SPIN_CAP) { atomicAdd(&bar[XB_TMO], 1u); break; } }
    }
    nloc = mine > 0u ? mine : 1u; nx = cnt > 0u ? cnt : 1u;
}
__device__ __forceinline__ void xcd_barrier(const XcdBarrier& b) {
    asm volatile("s_waitcnt vmcnt(0)" ::: "memory");
    __syncthreads();
    if (threadIdx.x == 0) {
        unsigned* bar = b.bar; asm volatile("" : "+s"(bar));
        __builtin_amdgcn_s_waitcnt(0);
        unsigned nloc = b.st[0], nx = b.st[1];
        unsigned bx = b.x; asm volatile("" : "+s"(bx));
        if (nloc == 0u) { xcd_barrier_complete(bar, bx, nloc, nx); b.st[0] = nloc; b.st[1] = nx; }
        const unsigned old = xb_add(&bar[XB_XSUB(bx)], 1u);
        const unsigned gen = old / nloc;
        if (old + 1u == (gen + 1u) * nloc) {
            __builtin_amdgcn_fence(__ATOMIC_RELEASE, "agent");
            asm volatile("s_waitcnt vmcnt(0)" ::: "memory");
            const unsigned og = xb_add(&bar[XB_TOP], 1u);
            const unsigned tg = og / nx;
            if (og + 1u == (tg + 1u) * nx) xb_add(&bar[XB_TOPGEN], 1u);
            else XB_SPIN(xb_ld(&bar[XB_TOPGEN]) == tg, bar);
            __builtin_amdgcn_fence(__ATOMIC_ACQUIRE, "agent");
            xb_add(&bar[XB_XGEN(bx)], 1u);
            asm volatile("s_waitcnt vmcnt(0)" ::: "memory");
        } else {
            XB_SPIN(xb_ld(&bar[XB_XGEN(bx)]) == gen, bar);
            __builtin_amdgcn_fence(__ATOMIC_ACQUIRE, "agent");
            asm volatile("s_waitcnt vmcnt(0)" ::: "memory");
        }
    }
    __syncthreads();
}

struct Args { const float* in[32]; float* out; unsigned char* ws; int ph_lo, ph_hi; };
struct Frame { LAS unsigned char* lds; int tid, lane, wave, bid, G, gw, NGW; long gtid, NT; };
#define WSP(T, off) ((T*)(A.ws + (off)))
#define WLP(l, off) ((bf16*)(A.ws + WS_W + (size_t)(l) * WL_STRIDE + (off)))
#define MODP(l, s, j) ((const float*)(A.ws + WS_CTL) + CW_MOD + ((l) * 3 + (s)) * 6144 + (j) * 1024)

__device__ __forceinline__ float wave_sum(float v) {
    v += sx<1>(v); v += sx<2>(v); v += sx<4>(v); v += sx<8>(v); v += sx<16>(v); v += sx<32>(v);
    return v;
}
__device__ __forceinline__ int win_row(int c) {
    const int sec = c >> 10; if (sec != 0 && sec != 3) return c;
    const int L = c & 255, g = L >> 6, a = (L >> 5) & 1, x = (L >> 4) & 1, q = (L >> 2) & 3, e = L & 3;
    return (c & ~255) | (128 * a + 32 * g + 8 * q + 4 * x + e);
}
template <bool WINMAP = false>
__device__ __forceinline__ void p0_transpose_item(const float* W, int K, int N, bf16* WT, int ldwt, int row_off, int col_off, LAS float* scr, int item, int lane) {
    const int nblk = N / 32, kb = item / nblk, nb = item % nblk, k0 = 64 * kb, n0 = 32 * nb;
    { f32x4 v[8]; const int rr = lane >> 3, c4 = (lane & 7) * 4;
#pragma unroll
      for (int i = 0; i < 8; ++i) v[i] = *(const f32x4*)(W + (size_t)(k0 + 8 * i + rr) * N + n0 + c4);
#pragma unroll
      for (int i = 0; i < 8; ++i) { LAS float* d = scr + (8 * i + rr) * 33 + c4; d[0] = v[i].x; d[1] = v[i].y; d[2] = v[i].z; d[3] = v[i].w; } }
    LDS_WAIT(); asm volatile("" ::: "memory");
    const int c = lane & 7;
#pragma unroll
    for (int j = 0; j < 4; ++j) { const int n = (lane >> 3) + 8 * j; const LAS float* s = scr + (8 * c) * 33 + n;
        v4u o; o.x = pk2(s[0 * 33], s[1 * 33]); o.y = pk2(s[2 * 33], s[3 * 33]); o.z = pk2(s[4 * 33], s[5 * 33]); o.w = pk2(s[6 * 33], s[7 * 33]);
        const int rr = WINMAP ? win_row(n0 + n) : n0 + n;
        *(v4u*)(WT + (size_t)(row_off + rr) * ldwt + col_off + k0 + 8 * c) = o; }
    LDS_WAIT(); asm volatile("" ::: "memory");
}

struct PItem { const float* W; bf16* WT; int N, ldwt, k0, n0, rowbase; bool winmap, skip; };
constexpr int PRO_I_WIN = 16 * 288, PRO_I_SQ = 16 * 32, PRO_I_R = 16 * 8, PRO_I_SD = 4 * 32, PRO_PER_L = PRO_I_WIN + 4 * PRO_I_SQ + 3 * PRO_I_R + PRO_I_SD;
__device__ __forceinline__ void pi_set(PItem& t, const float* W, int N, bf16* WT, int ldwt, int row_off, int col_off, int item) {
    const int nblk = N / 32, kb = item / nblk, nb = item % nblk; t.W = W; t.N = N; t.WT = WT + col_off; t.ldwt = ldwt; t.k0 = 64 * kb; t.n0 = 32 * nb; t.rowbase = row_off; }
__device__ __forceinline__ PItem pro_item(const Args& A, int it) {
    const int l = it / PRO_PER_L; int r = it % PRO_PER_L; PItem t; t.winmap = false; t.skip = false;
    if (r < PRO_I_WIN) { const int nb = r % 288; t.skip = nb >= 160 && nb < 192; t.winmap = true;
        pi_set(t, A.in[7] + (size_t)l * 1024 * 9216, 9216, WLP(l, WO_WIN), 1024, 0, 0, r); return t; } r -= PRO_I_WIN;
    if (r < PRO_I_SQ) { pi_set(t, A.in[12] + (size_t)l * 1048576, 1024, WLP(l, WO_D1), 3072, 0, 0, r); return t; } r -= PRO_I_SQ;
    if (r < PRO_I_SQ) { pi_set(t, A.in[20] + (size_t)l * 1048576, 1024, WLP(l, WO_D1), 3072, 0, 1024, r); return t; } r -= PRO_I_SQ;
    if (r < PRO_I_SQ) { pi_set(t, A.in[21] + (size_t)l * 1048576, 1024, WLP(l, WO_D1), 3072, 0, 2048, r); return t; } r -= PRO_I_SQ;
    if (r < PRO_I_SQ) { pi_set(t, A.in[22] + (size_t)l * 1048576, 1024, WLP(l, WO_OUT), 1024, 0, 0, r); return t; } r -= PRO_I_SQ;
    if (r < PRO_I_R) { pi_set(t, A.in[24] + (size_t)l * 262144, 256, WLP(l, WO_R), 1024, 0, 0, r); return t; } r -= PRO_I_R;
    if (r < PRO_I_R) { pi_set(t, A.in[29] + (size_t)l * 262144, 256, WLP(l, WO_R), 1024, 256 + ((r % 8) >> 2) * 128, 0, r); return t; } r -= PRO_I_R;
    if (r < PRO_I_R) { pi_set(t, A.in[30] + (size_t)l * 262144, 256, WLP(l, WO_R), 1024, 384 + ((r % 8) >> 2) * 128, 0, r); return t; } r -= PRO_I_R;
    pi_set(t, A.in[31] + (size_t)l * 262144, 1024, WLP(l, WO_SD), 256, 0, 0, r); return t;
}
__device__ __forceinline__ void pi_load(const PItem& t, f32x4 (&v)[8], int lane) {
    const int rr = lane >> 3, c4 = (lane & 7) * 4;
#pragma unroll
    for (int i = 0; i < 8; ++i) v[i] = *(const f32x4*)(t.W + (size_t)(t.k0 + 8 * i + rr) * t.N + t.n0 + c4);
}
__device__ __forceinline__ void pi_load_a(const PItem& t, f32x4 (&v)[8], int lane) {
    const int rr = lane >> 3, c4 = (lane & 7) * 4;
#pragma unroll
    for (int i = 0; i < 8; ++i) { const float* p = t.W + (size_t)(t.k0 + 8 * i + rr) * t.N + t.n0 + c4; asm volatile("global_load_dwordx4 %0, %1, off" : "=v"(v[i]) : "v"(p) : "memory"); }
}
__device__ __forceinline__ void pi_store(const PItem& t, const f32x4 (&v)[8], LAS float* scr, int lane) {
    const int rr = lane >> 3, c4 = (lane & 7) * 4;
#pragma unroll
    for (int i = 0; i < 8; ++i) { LAS float* d = scr + (8 * i + rr) * 33 + c4; d[0] = v[i].x; d[1] = v[i].y; d[2] = v[i].z; d[3] = v[i].w; }
    LDS_WAIT(); asm volatile("" ::: "memory");
    const int c = lane & 7;
#pragma unroll
    for (int j = 0; j < 4; ++j) { const int n = (lane >> 3) + 8 * j; const LAS float* sp = scr + (8 * c) * 33 + n;
        v4u o; o.x = pk2(sp[0 * 33], sp[1 * 33]); o.y = pk2(sp[2 * 33], sp[3 * 33]); o.z = pk2(sp[4 * 33], sp[5 * 33]); o.w = pk2(sp[6 * 33], sp[7 * 33]);
        const int row = t.winmap ? win_row(t.n0 + n) : t.n0 + n;
        *(v4u*)(t.WT + (size_t)(t.rowbase + row) * t.ldwt + t.k0 + 8 * c) = o; }
    LDS_WAIT(); asm volatile("" ::: "memory");
}

__device__ __forceinline__ void ph_prologue(const Frame& F, const Args& A) {
    LAS float* scr = (LAS float*)(F.lds + F.wave * 16384);
    { const int stride = F.NGW, hi = 2 * PRO_PER_L; int it = F.gw;
      if (it < hi) { f32x4 va[8], vb[8], vc[8]; PItem ta = pro_item(A, it), tb = ta, tc = ta;
        pi_load_a(ta, va, F.lane);
        if (it + stride < hi) { tb = pro_item(A, it + stride); pi_load_a(tb, vb, F.lane); }
#define PRO_STEP(TP, VP, TS, VS) { if (it + 2 * stride < hi) { TP = pro_item(A, it + 2 * stride); pi_load_a(TP, VP, F.lane); asm volatile("s_waitcnt vmcnt(16)" ::: "memory"); } \
            else asm volatile("s_waitcnt vmcnt(0)" ::: "memory"); \
            if (!TS.skip) pi_store(TS, VS, scr, F.lane); it += stride; if (it >= hi) break; }
        for (;;) {
            PRO_STEP(tc, vc, ta, va)
            PRO_STEP(ta, va, tb, vb)
            PRO_STEP(tb, vb, tc, vc)
        }
#undef PRO_STEP
      } }
#if FAST_WIN
    {
        LAS float* sW = (LAS float*)F.lds; LAS float* sT = sW + 32 * 256;
        __syncthreads();
        if (F.tid < 256) sT[F.tid] = cospif((float)F.tid / 128.0f);
        for (int it = F.bid; it < 2 * 4 * 32; it += F.G) {
            const int l = it >> 7, g = (it >> 5) & 3, k0 = (it & 31) * 32;
            __syncthreads();
            for (int e = F.tid; e < 32 * 256; e += 512) sW[e] = A.in[7][((size_t)l * 1024 + k0 + (e >> 8)) * 9216 + COL_F + g * 256 + (e & 255)];
            __syncthreads();
            const int o = F.tid & 255, kh = F.tid >> 8; int j = o >> 1, odd = o & 1; if (o == 1) { j = 128; odd = 0; }
            const int m0 = odd ? 192 : 0; float acc[16];
#pragma unroll
            for (int q = 0; q < 16; ++q) acc[q] = 0.f;
            for (int c = 0; c < 256; c += 4) { const float r0 = sT[(j * c + m0) & 255], r1 = sT[(j * (c + 1) + m0) & 255], r2 = sT[(j * (c + 2) + m0) & 255], r3 = sT[(j * (c + 3) + m0) & 255];
#pragma unroll
                for (int q = 0; q < 16; ++q) { const f32x4 w = *(const LAS f32x4*)(sW + (kh * 16 + q) * 256 + c); acc[q] += w.x * r0; acc[q] += w.y * r1; acc[q] += w.z * r2; acc[q] += w.w * r3; } }
            bf16* dst = WLP(l, WO_WIN) + (size_t)(COL_F + g * 256 + o) * 1024 + k0 + kh * 16;
            v4u w0, w1; w0.x = pk2(acc[0], acc[1]); w0.y = pk2(acc[2], acc[3]); w0.z = pk2(acc[4], acc[5]); w0.w = pk2(acc[6], acc[7]);
            w1.x = pk2(acc[8], acc[9]); w1.y = pk2(acc[10], acc[11]); w1.z = pk2(acc[12], acc[13]); w1.w = pk2(acc[14], acc[15]);
            *(v4u*)dst = w0; *(v4u*)(dst + 8) = w1;
        }
        __syncthreads();
    }
#endif
    float* MOD = (float*)(A.ws + WS_CTL) + CW_MOD;
    LAS float* part = (LAS float*)(F.lds + 8 * 16384 - 8192);
    LAS float* ssil = (LAS float*)(F.lds + 8 * 16384 - 8192 - 12288);
    if (F.bid < 2 * 96) { for (int e = F.tid; e < 3072; e += NWAVES * 64) { const int k = e & 1023; ssil[e] = siluf_(e < 1024 ? A.in[1][k] : e < 2048 ? A.in[1][1024 + k] : A.in[3][k]); } }
    __syncthreads();
    for (int it = F.bid; it < 2 * 96; it += F.G) {
        const int l = it / 96, nb = it % 96, n = nb * 64 + F.lane;
        const float* wm = A.in[4] + (size_t)l * 1024 * 6144 + n;
        float a0 = 0.f, a1 = 0.f, a2 = 0.f;
#pragma unroll 32
        for (int k = F.wave * 128; k < F.wave * 128 + 128; ++k) {
            const float w = wm[(size_t)k * 6144];
            a0 += ssil[k] * w; a1 += ssil[1024 + k] * w; a2 += ssil[2048 + k] * w;
        }
        __syncthreads();
        part[(F.wave * 3 + 0) * 64 + F.lane] = a0; part[(F.wave * 3 + 1) * 64 + F.lane] = a1; part[(F.wave * 3 + 2) * 64 + F.lane] = a2;
        __syncthreads();
        if (F.wave < 3) { float s = A.in[5][l * 6144 + n];
#pragma unroll
            for (int w = 0; w < 8; ++w) s += part[(w * 3 + F.wave) * 64 + F.lane];
            MOD[(l * 3 + F.wave) * 6144 + n] = s; }
    }
    for (long i = F.gtid; i < 2L * 4096 * 256; i += F.NT) {
        const int l = (int)(i >> 20), n = (int)((i >> 8) & 4095), kk = (int)(i & 255), pn = n >> 8, rr = n & 255, gate = rr >> 7, rho = rr & 127, d = pn >> 3, cb = pn & 7;
        const int cho = 128 * cb + rho, blk = cho >> 6, e = cho & 63, chi = 256 * (cb >> 1) + kk; float v = 0.f;
        if ((chi >> 6) == blk) v = (gate ? A.in[17] : A.in[15])[((size_t)(l * 2 + d) * 16 + blk) * 4096 + (chi & 63) * 64 + e];
        WLP(l, WO_LRU)[i & 0xFFFFF] = (bf16)f2bf(v);
    }
    for (long i = F.gtid; i < 2L * 65536; i += F.NT) {
        const int which = (int)(i >> 16), n = (int)((i >> 8) & 255), k = (int)(i & 255); float v;
        if (which == 0) { const int k1 = n >> 1, cp = n & 1, t1 = k >> 1, c = k & 1; const float rev = (float)((k1 * t1) & 127) * (1.f / 128.f);
            const float cs = __builtin_amdgcn_cosf(rev), sn = __builtin_amdgcn_sinf(rev); v = cp == 0 ? (c == 0 ? cs : sn) : (c == 0 ? -sn : cs); }
        else { const int h = n >> 7, k2 = (n >> 1) & 63, cp = n & 1, hp = k >> 7, t2 = (k >> 1) & 63, c = k & 1; const float rev = (float)((k2 * t2) & 63) * (1.f / 64.f);
            const float cs = __builtin_amdgcn_cosf(rev), sn = __builtin_amdgcn_sinf(rev); v = (h != hp) ? 0.f : (cp == 0 ? (c == 0 ? cs : sn) : (c == 0 ? -sn : cs)); }
        WLP(0, WO_TAB)[i] = (bf16)f2bf(v);
    }
    for (long i = F.gtid; i < 4096; i += F.NT) ((float*)(A.ws + WS_W + WO_TAB + 262144))[i] = log1pf(expf(-A.in[19][i]));
}

__device__ __forceinline__ void norm_mod_row(const f32x4 (&v)[4], const float* g, const float* sc, const float* sh, bf16* orow, int lane) {
    float s = 0.f;
#pragma unroll
    for (int j = 0; j < 4; ++j) s += (v[j].x * v[j].x + v[j].y * v[j].y) + (v[j].z * v[j].z + v[j].w * v[j].w);
    const float rs = rsqrtf(wave_sum(s) * (1.f / 1024.f) + EPS);
#pragma unroll
    for (int j = 0; j < 2; ++j) { const int c = 8 * lane + 512 * j; unsigned w[4];
#pragma unroll
        for (int h = 0; h < 2; ++h) { const f32x4 x = v[2 * j + h], gg = *(const f32x4*)(g + c + 4 * h), s1 = *(const f32x4*)(sc + c + 4 * h), s0 = *(const f32x4*)(sh + c + 4 * h);
            const float y0 = x.x * rs * gg.x * (1.f + s1.x) + s0.x, y1 = x.y * rs * gg.y * (1.f + s1.y) + s0.y, y2 = x.z * rs * gg.z * (1.f + s1.z) + s0.z, y3 = x.w * rs * gg.w * (1.f + s1.w) + s0.w;
            w[2 * h] = pk2(y0, y1); w[2 * h + 1] = pk2(y2, y3); }
        v4u o; o.x = w[0]; o.y = w[1]; o.z = w[2]; o.w = w[3];
        *(v4u*)(orow + c) = o; }
}
__device__ __forceinline__ void ph_norm1(const Frame& F, const Args& A, int l) {
    bf16* H = WSP(bf16, WS_H);
    for (int R = F.gw; R < MROWS; R += F.NGW) {
        const int b = R / TPB, p = R % TPB, s = (p < CTX) ? 2 : b;
        const float* X = (p < CTX) ? A.in[2] + ((size_t)b * CTX + p) * 1024 : A.in[0] + ((size_t)b * SEQ + (p - CTX)) * 1024;
        f32x4 v[4];
#pragma unroll
        for (int j = 0; j < 4; ++j) v[j] = *(const f32x4*)(X + 8 * F.lane + 512 * (j >> 1) + 4 * (j & 1));
        norm_mod_row(v, A.in[6] + l * 1024, MODP(l, s, 1), MODP(l, s, 0), H + (size_t)R * 1024, F.lane);
    }
}

__device__ __forceinline__ void ph_uelem(const Frame& F, const Args& A, int l) {
    const float* U = WSP(float, WS_U);
    bf16 *Kb = WSP(bf16, WS_KB), *Vb = WSP(bf16, WS_VB), *Qb = WSP(bf16, WS_QB), *LXb = WSP(bf16, WS_LXB), *GLG = WSP(bf16, WS_GLG), *ZP = WSP(bf16, WS_ZP), *GT = WSP(bf16, WS_GATES);
    LAS float* sF = (LAS float*)F.lds; LAS float* sT = sF + 1024;
    if (F.tid < 256) sT[F.tid] = cospif((float)F.tid / 128.0f);
    __syncthreads();
    for (int R = F.bid; R < MROWS; R += F.G) {
        const float* u = U + (size_t)R * INW; const int p = R % TPB; const bool lat = p >= CTX; const int t = p - CTX;
        for (int gi = F.wave; gi < 32; gi += 8) {
            const bool isq = gi >= 16; const int grp = gi & 15;
            const float v = u[(isq ? COL_Q : COL_K) + grp * 64 + F.lane];
            const float ss = wave_sum(v * v);
            float y = v * rsqrtf(ss * (1.f / 64.f) + EPS) * (isq ? A.in[8] : A.in[9])[l * 64 + F.lane];
            const float part = sx<16>(y);
            if (lat) { const int axis = F.lane >> 5, hf = (F.lane >> 4) & 1, f = F.lane & 15;
                const float pos = (float)(axis ? (t & 63) : (t >> 6)); const float inv = exp2f(-(float)f * (13.287712379549449f / 16.f));
                float sn, cs; sincosf(pos * inv, &sn, &cs);
                y = hf ? (part * sn + y * cs) : (y * cs - part * sn); }
            if (isq) y *= QSCALE;
            (isq ? Qb : Kb)[(size_t)R * 1024 + grp * 64 + F.lane] = (bf16)f2bf(y);
        }
        for (int c = F.tid; c < 1024; c += 512) { const size_t o = (size_t)R * 1024 + c;
            Vb[o] = (bf16)f2bf(u[COL_V + c]); LXb[o] = (bf16)f2bf(u[COL_LX + c]); GLG[o] = (bf16)f2bf(gelu_tanh(u[COL_LG + c])); sF[c] = u[COL_F + c]; }
        for (int c = F.tid; c < 3072; c += 512) GT[(size_t)R * 3072 + c] = (bf16)f2bf(sigmoidf_(u[COL_G + c]));
        __syncthreads();
        for (int o = F.tid; o < 1024; o += 512) { const int g = o >> 8, oo = o & 255; int j = oo >> 1, odd = oo & 1; if (oo == 1) { j = 128; odd = 0; }
            const int m0 = odd ? 192 : 0; float acc = 0.f;
            for (int c = 0; c < 256; ++c) acc += sF[g * 256 + c] * sT[(j * c + m0) & 255];
            ZP[(size_t)R * 1024 + o] = (bf16)f2bf(acc); }
        __syncthreads();
    }
}

__device__ __forceinline__ void ph_conv(const Frame& F, const Args& A, int l) {
    const bf16* LXb = WSP(bf16, WS_LXB); bf16* UC = WSP(bf16, WS_UC);
    const int c8 = (int)(F.gtid & 127) * 8, r0 = (int)(F.gtid >> 7), rstep = (int)(F.NT >> 7);
    float w[4][8], bia[8];
#pragma unroll
    for (int j = 0; j < 4; ++j) { const f32x4 a = *(const f32x4*)(A.in[13] + l * 4096 + j * 1024 + c8), b = *(const f32x4*)(A.in[13] + l * 4096 + j * 1024 + c8 + 4);
        w[j][0] = a.x; w[j][1] = a.y; w[j][2] = a.z; w[j][3] = a.w; w[j][4] = b.x; w[j][5] = b.y; w[j][6] = b.z; w[j][7] = b.w; }
    { const f32x4 a = *(const f32x4*)(A.in[14] + l * 1024 + c8), b = *(const f32x4*)(A.in[14] + l * 1024 + c8 + 4);
      bia[0] = a.x; bia[1] = a.y; bia[2] = a.z; bia[3] = a.w; bia[4] = b.x; bia[5] = b.y; bia[6] = b.z; bia[7] = b.w; }
    for (int Rb = r0; Rb < MROWS; Rb += 4 * rstep) {
        v4u x[4][4];
#pragma unroll
        for (int u = 0; u < 4; ++u) { const int R = Rb + u * rstep; if (R < MROWS) { const int p = R % TPB, lo = p < CTX ? 0 : CTX, hi = p < CTX ? CTX : TPB;
#pragma unroll
            for (int j = 0; j < 4; ++j) { const int pp = p + j - 2; x[u][j] = (pp >= lo && pp < hi) ? *(const v4u*)(LXb + (size_t)(R + j - 2) * 1024 + c8) : (v4u){0u, 0u, 0u, 0u}; } } }
#pragma unroll
        for (int u = 0; u < 4; ++u) { const int R = Rb + u * rstep; if (R < MROWS) { float acc[8];
#pragma unroll
            for (int e = 0; e < 8; ++e) acc[e] = bia[e];
#pragma unroll
            for (int j = 0; j < 4; ++j) { const unsigned xs[4] = {x[u][j].x, x[u][j].y, x[u][j].z, x[u][j].w};
#pragma unroll
                for (int q = 0; q < 4; ++q) { acc[2 * q] += w[j][2 * q] * bf2f(xs[q] & 0xffffu); acc[2 * q + 1] += w[j][2 * q + 1] * bf2f(xs[q] >> 16); } }
            v4u o; o.x = pk2(acc[0], acc[1]); o.y = pk2(acc[2], acc[3]); o.z = pk2(acc[4], acc[5]); o.w = pk2(acc[6], acc[7]);
            *(v4u*)(UC + (size_t)R * 1024 + c8) = o; } }
    }
}
#if !FAST_LRU
__device__ __forceinline__ void ph_lrucoef(const Frame& F, const Args& A, int l) {
    const bf16* UC = WSP(bf16, WS_UC); unsigned* AB = WSP(unsigned, WS_AB);
    for (long i = F.gtid; i < 2L * MROWS * 1024; i += F.NT) {
        const int d = (int)(i / ((long)MROWS * 1024)); const long rem = i % ((long)MROWS * 1024); const int R = (int)(rem >> 10), ch = (int)(rem & 1023), blk = ch >> 6, e = ch & 63;
        const float* wa = A.in[15] + ((size_t)(l * 2 + d) * 16 + blk) * 4096 + e; const float* wi = A.in[17] + ((size_t)(l * 2 + d) * 16 + blk) * 4096 + e;
        float r = A.in[16][(l * 2 + d) * 1024 + ch], ig = A.in[18][(l * 2 + d) * 1024 + ch];
        const bf16* ur = UC + (size_t)R * 1024 + blk * 64;
        for (int dd = 0; dd < 64; ++dd) { const float x = bf2f(ur[dd]); r += x * wa[dd * 64]; ig += x * wi[dd * 64]; }
        const float lam = A.in[19][(l * 2 + d) * 1024 + ch]; const float sp = log1pf(expf(-lam));
        const float la = -8.f * sigmoidf_(r) * sp; const float mult = sqrtf(-expm1f(2.f * la));
        const float bc = mult * sigmoidf_(ig) * bf2f(ur[e]);
        AB[i] = pk2(la, bc);
    }
}
#endif
struct LruSched {
    const char* uc; const char* w; int G, c;
    __device__ __forceinline__ bool next(int i, pg8::UnitG& U) const {
        const long id = (long)i * G + c; if (id >= 66 * 16) return false;
        const int pm = (int)(id >> 4), pn = (int)(id & 15);
        U.a = uc + ((size_t)pm * 256 * 1024 + 256 * ((pn & 7) >> 1)) * 2; U.b = w + (size_t)pn * 256 * 256 * 2; U.row0 = pm * 256; U.pn = pn; U.e = 0; U.valid = 256; U.rows = nullptr; return true;
    }
};
struct EpiLru {
    static constexpr bool PERM = false;
    unsigned* AB; const bf16* UC; const float* ba; const float* bi; const float* sp;
    __device__ __forceinline__ void operator()(const f32x4 (&acc)[2][2][4][2], const pg8::UnitG& u, int wr, int wc, int fr, int fq) const {
        const int d = u.pn >> 3, cb = u.pn & 7, ch0 = 128 * cb + wc * 32 + 4 * fq;
        f32x4 vba[2], vbi[2], vsp[2];
#pragma unroll
        for (int n = 0; n < 2; ++n) { vba[n] = *(const f32x4*)(ba + d * 1024 + ch0 + 16 * n) * -1.4426950408889634f; vbi[n] = *(const f32x4*)(bi + d * 1024 + ch0 + 16 * n) * -1.4426950408889634f; vsp[n] = *(const f32x4*)(sp + d * 1024 + ch0 + 16 * n) * -8.f; }
#pragma unroll
        for (int ai = 0; ai < 2; ++ai) { unsigned long long uxs[4][2];
#pragma unroll
            for (int m = 0; m < 4; ++m)
#pragma unroll
                for (int n = 0; n < 2; ++n) uxs[m][n] = *(const unsigned long long*)(UC + ((size_t)u.row0 + ai * 128 + wr * 64 + m * 16 + fr) * 1024 + ch0 + 16 * n);
#pragma unroll
            for (int m = 0; m < 4; ++m) { const size_t R = (size_t)u.row0 + ai * 128 + wr * 64 + m * 16 + fr;
#pragma unroll
                for (int n = 0; n < 2; ++n) { const int ch = ch0 + 16 * n;
                    const unsigned long long ux = uxs[m][n];
                    const float x[4] = {bf2f((unsigned)ux & 0xffffu), bf2f(((unsigned)ux) >> 16), bf2f((unsigned)(ux >> 32) & 0xffffu), bf2f((unsigned)(ux >> 48))};
                    const f32x4 r = acc[ai][0][m][n], g = acc[ai][1][m][n]; v4u o;
#pragma unroll
                    for (int e = 0; e < 4; ++e) {
                        const float la = vsp[n][e] * __builtin_amdgcn_rcpf(1.f + __builtin_amdgcn_exp2f(__builtin_fmaf(r[e], -1.4426950408889634f, vba[n][e])));
                        const float mult = __builtin_amdgcn_sqrtf(1.f - __builtin_amdgcn_exp2f(la * 2.8853900817779268f));
                        o[e] = pk2(la, mult * __builtin_amdgcn_rcpf(1.f + __builtin_amdgcn_exp2f(__builtin_fmaf(g[e], -1.4426950408889634f, vbi[n][e]))) * x[e]); }
                    *(v4u*)(AB + ((size_t)d * MROWS + R) * 1024 + ch) = o; } }
            asm volatile("" ::: "memory"); }
    }
};
__device__ __forceinline__ void ph_lru_gemm(const Frame& F, const Args& A, int l, int Ge) {
    LruSched S{(const char*)WSP(bf16, WS_UC), (const char*)WLP(l, WO_LRU), Ge, F.bid};
    EpiLru E{WSP(unsigned, WS_AB), WSP(bf16, WS_UC), A.in[16] + l * 2048, A.in[18] + l * 2048, (const float*)(A.ws + WS_W + WO_TAB + 262144) + l * 2048};
    pg8::gemm_phase_g<EpiLru, LruSched, false>(F.lds, 256, 1024, 256, S, E);
}
struct FftSched {
    const char* x; const char* w; int nunits, G, c;
    __device__ __forceinline__ bool next(int i, pg8::UnitG& U) const {
        const long id = (long)i * G + c; if (id >= nunits) return false;
        U.a = x + (size_t)id * 256 * 256 * 2; U.b = w; U.row0 = (int)id * 256; U.pn = 0; U.e = 0; U.valid = 256; U.rows = nullptr; return true;
    }
};
struct EpiFftA {
    static constexpr bool PERM = false;
    unsigned* XB;
    __device__ __forceinline__ void operator()(const f32x4 (&acc)[2][2][4][2], const pg8::UnitG& u, int wr, int wc, int fr, int fq) const {
#pragma unroll
        for (int ai = 0; ai < 2; ++ai)
#pragma unroll
            for (int m = 0; m < 4; ++m) { int r0 = u.row0; asm volatile("" : "+s"(r0));
                const int row = r0 + ai * 128 + wr * 64 + m * 16 + fr, t2 = row & 63; const size_t bc = (size_t)(row >> 6);
#pragma unroll
                for (int bj = 0; bj < 2; ++bj)
#pragma unroll
                    for (int n = 0; n < 2; ++n) { const int k1 = 64 * bj + 16 * wc + 8 * n + 2 * fq; const f32x4 v = acc[ai][bj][m][n];
#pragma unroll
                        for (int q = 0; q < 2; ++q) { const int kk = k1 + q; const float rev = (float)(kk * t2) * (1.f / 8192.f);
                            const float cs = __builtin_amdgcn_cosf(rev), sn = __builtin_amdgcn_sinf(rev); const float yr = v[2 * q], yi = v[2 * q + 1];
                            XB[(bc * 64 + (kk >> 1)) * 128 + (kk & 1) * 64 + t2] = pk2(yr * cs + yi * sn, yi * cs - yr * sn); } }
                asm volatile("" ::: "memory"); }
    }
};
struct EpiBf16Plain {
    static constexpr bool PERM = true;
    bf16* C; int ldc;
    __device__ __forceinline__ void operator()(const f32x4 (&acc)[2][2][4][2], const pg8::UnitG& u, int wr, int wc, int fr, int fq) const {
#pragma unroll
        for (int ai = 0; ai < 2; ++ai)
#pragma unroll
            for (int m = 0; m < 4; ++m) { bf16* rowp = C + (size_t)(u.row0 + ai * 128 + wr * 64 + m * 16 + fr) * ldc + u.pn * 256 + wc * 32 + 8 * fq;
#pragma unroll
                for (int bj = 0; bj < 2; ++bj) { const f32x4 v0 = acc[ai][bj][m][0], v1 = acc[ai][bj][m][1];
                    v4u o; o.x = pk2(v0[0], v0[1]); o.y = pk2(v0[2], v0[3]); o.z = pk2(v1[0], v1[1]); o.w = pk2(v1[2], v1[3]);
                    *(v4u*)(rowp + bj * 128) = o; } }
    }
};
struct EpiBf16U {
    static constexpr bool PERM = true; static constexpr int MIDK = 0;
    bf16* C; int ldc;
    __device__ __forceinline__ void operator()(const f32x4 (&acc)[2][2][4][2], const pg8::Unit& u, int wr, int wc, int fr, int fq) const {
#pragma unroll
        for (int ai = 0; ai < 2; ++ai)
#pragma unroll
            for (int m = 0; m < 4; ++m) { bf16* rowp = C + (size_t)(u.pm * 256 + ai * 128 + wr * 64 + m * 16 + fr) * ldc + u.pn * 256 + wc * 32 + 8 * fq;
#pragma unroll
                for (int bj = 0; bj < 2; ++bj) { const f32x4 v0 = acc[ai][bj][m][0], v1 = acc[ai][bj][m][1];
                    v4u o; o.x = pk2(v0[0], v0[1]); o.y = pk2(v0[2], v0[3]); o.z = pk2(v1[0], v1[1]); o.w = pk2(v1[2], v1[3]);
                    *(v4u*)(rowp + bj * 128) = o; } }
    }
};
__device__ __forceinline__ void ph_fft_a_gemm(const Frame& F, const Args& A) {
    FftSched S{(const char*)WSP(bf16, WS_XA), (const char*)WLP(0, WO_TAB), 256, F.G, F.bid};
    EpiFftA E{WSP(unsigned, WS_XB)};
    pg8::gemm_phase_g<EpiFftA, FftSched, false>(F.lds, 256, 256, 256, S, E);
}
__device__ __forceinline__ void ph_fft_b_gemm(const Frame& F, const Args& A) {
    FftSched S{(const char*)WSP(bf16, WS_XB), (const char*)(WLP(0, WO_TAB) + 65536), 256, F.G, F.bid};
    EpiBf16Plain E{WSP(bf16, WS_GB), 256};
    pg8::gemm_phase_g<EpiBf16Plain, FftSched, false>(F.lds, 256, 256, 256, S, E);
}
__device__ __forceinline__ void ph_scan1(const Frame& F, const Args& A) {
    const unsigned* AB = WSP(unsigned, WS_AB); float2* SUMM = WSP(float2, WS_SUMM);
    for (int it = F.gw; it < NB * 2 * NCHUNK * 16; it += F.NGW) {
        const int cg = it & 15, ck = (it >> 4) % NCHUNK, bd = (it >> 4) / NCHUNK, b = bd >> 1, d = bd & 1, ch = cg * 64 + F.lane;
        const unsigned* ab = AB + ((size_t)d * MROWS + (size_t)b * TPB + ck * 64) * 1024 + ch;
        float ac = 1.f, h = 0.f;
#pragma unroll
        for (int q = 0; q < 4; ++q) { unsigned w[16];
#pragma unroll
            for (int k = 0; k < 16; ++k) { const int i = q * 16 + k, ii = d ? 63 - i : i; w[k] = ab[(size_t)ii * 1024]; }
#pragma unroll
            for (int k = 0; k < 16; ++k) { const float a = __expf(bf2f(w[k] & 0xffffu)); h = a * h + bf2f(w[k] >> 16); ac *= a; } }
        SUMM[((size_t)bd * NCHUNK + ck) * 1024 + ch] = make_float2(ac, h);
    }
}
__device__ __forceinline__ void ph_scan2(const Frame& F, const Args& A) {
    const float2* SUMM = WSP(float2, WS_SUMM); float* CARRY = WSP(float, WS_CARRY);
    if (F.gtid < 4096) {
        const int bd = (int)(F.gtid >> 10), ch = (int)(F.gtid & 1023), d = bd & 1; float h = 0.f;
        for (int s = 0; s < NCHUNK; ++s) { const int ck = d ? (s < 4 ? 3 - s : NCHUNK + 3 - s) : s;
            const size_t o = ((size_t)bd * NCHUNK + ck) * 1024 + ch; CARRY[o] = h; const float2 v = SUMM[o]; h = v.x * h + v.y; }
    }
}
__device__ __forceinline__ void ph_scan3(const Frame& F, const Args& A, int l) {
    const unsigned* AB = WSP(unsigned, WS_AB); const float* CARRY = WSP(float, WS_CARRY); const bf16* GLG = WSP(bf16, WS_GLG); bf16* MX = WSP(bf16, WS_MIXIN);
    const int c0 = (l == DEPTH - 1) ? CTX / 64 : 0, nck = NCHUNK - c0;
    for (int it = F.gw; it < NB * nck * 16; it += F.NGW) {
        const int cg = it & 15, ck = c0 + (it >> 4) % nck, b = (it >> 4) / nck, ch = cg * 64 + F.lane; const size_t R0 = (size_t)b * TPB + ck * 64;
        const unsigned* ab0 = AB + R0 * 1024 + ch; const unsigned* ab1 = AB + ((size_t)MROWS + R0) * 1024 + ch;
        float hf[64]; float h = CARRY[((size_t)(b * 2 + 0) * NCHUNK + ck) * 1024 + ch];
#pragma unroll
        for (int q = 0; q < 4; ++q) { unsigned w[16];
#pragma unroll
            for (int k = 0; k < 16; ++k) w[k] = ab0[(size_t)(q * 16 + k) * 1024];
#pragma unroll
            for (int k = 0; k < 16; ++k) { h = __expf(bf2f(w[k] & 0xffffu)) * h + bf2f(w[k] >> 16); hf[q * 16 + k] = h; } }
        h = CARRY[((size_t)(b * 2 + 1) * NCHUNK + ck) * 1024 + ch];
#pragma unroll
        for (int q = 3; q >= 0; --q) { unsigned w[16]; bf16 g[16];
#pragma unroll
            for (int k = 0; k < 16; ++k) { const int i = q * 16 + 15 - k; w[k] = ab1[(size_t)i * 1024]; g[k] = GLG[(R0 + i) * 1024 + ch]; }
#pragma unroll
            for (int k = 0; k < 16; ++k) { const int i = q * 16 + 15 - k; h = __expf(bf2f(w[k] & 0xffffu)) * h + bf2f(w[k] >> 16);
                MX[(R0 + i) * 3072 + 1024 + ch] = (bf16)f2bf((hf[i] + h) * bf2f(g[k])); } }
    }
}

__device__ __forceinline__ void ph_fft_t1_fast(const Frame& F, const Args& A) {
    const unsigned* ZP = WSP(unsigned, WS_ZP); unsigned* XA = WSP(unsigned, WS_XA); LAS unsigned* T = (LAS unsigned*)F.lds;
    for (int item = F.bid; item < 512; item += F.G) {
        const int b = item >> 8, t2 = (item >> 2) & 63, cq = item & 3;
        __syncthreads();
#pragma unroll
        for (int i = 0; i < 8; ++i) { const int p = F.tid + 512 * i, t1 = p >> 5, w4 = (p & 31) * 4;
            const v4u v = *(const v4u*)(ZP + ((size_t)b * TPB + CTX + 64 * t1 + t2) * 512 + cq * 128 + w4);
            T[t1 * 129 + w4] = v.x; T[t1 * 129 + w4 + 1] = v.y; T[t1 * 129 + w4 + 2] = v.z; T[t1 * 129 + w4 + 3] = v.w; }
        __syncthreads();
#pragma unroll
        for (int i = 0; i < 16; ++i) { const int p = F.tid + 512 * i, cc = p >> 6, t1 = (p & 63) * 2;
            const unsigned long long v = (unsigned long long)T[t1 * 129 + cc] | ((unsigned long long)T[(t1 + 1) * 129 + cc] << 32);
            *(unsigned long long*)(XA + (((size_t)b * 512 + cq * 128 + cc) * 64 + t2) * 128 + t1) = v; }
    }
    __syncthreads();
}
__device__ __forceinline__ void ph_fft_t2_fast(const Frame& F, const Args& A, int l) {
    const unsigned* GB = WSP(unsigned, WS_GB); bf16* MX = WSP(bf16, WS_MIXIN); LAS unsigned* T = (LAS unsigned*)F.lds;
    LAS unsigned short* OUTS = (LAS unsigned short*)(F.lds + 2 * 128 * 65 * 4);
    const bool bal = F.G == 256; const int nmine = bal ? (F.bid < 252 ? 2 : 4) : (520 - F.bid + F.G - 1) / F.G;
    for (int ii = 0; ii < nmine; ++ii) {
        int b, kp, g;
        if (bal) { if (F.bid < 252) { const int f = 2 * F.bid + ii; b = f / 252; const int rem = f % 252; kp = 1 + (rem >> 2); g = rem & 3; }
                   else { const int h = 4 * (F.bid - 252) + ii; b = h >> 3; kp = ((h >> 2) & 1) ? 64 : 0; g = h & 3; } }
        else { const int item = F.bid + ii * F.G; b = item / 260; const int rem = item % 260; kp = rem >> 2; g = rem & 3; }
        const int k1a = kp, k1b = (128 - kp) & 127;
        __syncthreads();
#pragma unroll
        for (int i = 0; i < 8; ++i) { const int p = F.tid + 512 * i, blk = p >> 11, cc = (p >> 4) & 127, w4 = (p & 15) * 4, kk = blk ? k1b : k1a;
            const v4u v = *(const v4u*)(GB + (((size_t)b * 512 + g * 128 + cc) * 64 + (kk >> 1)) * 128 + (kk & 1) * 64 + w4);
            LAS unsigned* d = T + blk * (128 * 65) + cc * 65 + w4; d[0] = v.x; d[1] = v.y; d[2] = v.z; d[3] = v.w; }
        __syncthreads();
        const int jc = F.tid & 255, j = (jc == 0 || jc == 128) ? 0 : (jc < 128 ? jc : 256 - jc);
        const int nset = (k1a == k1b) ? 1 : 2;
        for (int set = 0; set < nset; ++set) { const int ka = set ? k1b : k1a;
            for (int k2 = (F.tid >> 8); k2 < 64; k2 += 2) {
                const int mk2 = (ka == 0) ? ((64 - k2) & 63) : 63 - k2;
                const unsigned own = T[set * (128 * 65) + j * 65 + k2], mir = T[(nset == 1 ? 0 : (1 - set)) * (128 * 65) + j * 65 + mk2];
                float o; if (jc == 0) o = 0.5f * (bf2f(own & 0xffffu) + bf2f(mir & 0xffffu)); else if (jc == 128) o = 0.5f * (bf2f(own >> 16) + bf2f(mir >> 16)); else if (jc < 128) o = bf2f(mir & 0xffffu); else o = bf2f(own & 0xffffu);
                OUTS[k2 * 256 + jc] = (unsigned short)f2bf(o * 6.9053396600248786e-4f); }
            __syncthreads();
#pragma unroll
            for (int i = 0; i < 4; ++i) { const int p = F.tid + 512 * i, k2 = p >> 5, c8 = (p & 31) * 8;
                *(v4u*)(MX + ((size_t)b * TPB + CTX + ka + 128 * k2) * 3072 + 2048 + g * 256 + c8) = *(const LAS v4u*)(OUTS + k2 * 256 + c8); }
            __syncthreads(); }
    }
    __syncthreads();
    const float2* GC = WSP(float2, WS_GC);
    if (l + 1 < DEPTH) for (long i = F.gtid; i < (long)NB * CTX * 1024; i += F.NT) {
        const int col = (int)(i & 1023), k = (int)((i >> 10) & 255), b = (int)(i >> 18), g = col >> 8, jc = col & 255, km = (256 - k) & 255;
        const int j = (jc == 0 || jc == 128) ? 0 : (jc < 128 ? jc : 256 - jc); const size_t base = ((size_t)b * 512 + g * 128 + j) * 256;
        const float2 w = GC[base + k], wm = GC[base + km];
        float o; if (jc == 0) o = 0.5f * (w.x + wm.x); else if (jc == 128) o = 0.5f * (w.y + wm.y); else if (jc < 128) o = wm.x; else o = w.x;
        MX[((size_t)b * TPB + k) * 3072 + 2048 + col] = (bf16)f2bf(o * 3.90625e-3f);
    }
}
__device__ __forceinline__ void ph_scan2_fast(const Frame& F, const Args& A) {
    const float2* SUMM = WSP(float2, WS_SUMM); float* CARRY = WSP(float, WS_CARRY);
    for (int it = F.gw; it < 256; it += F.NGW) {
        const int bd = it >> 6, d = bd & 1, ch = (it & 63) * 16 + (F.lane & 15), seg = F.lane >> 4;
        float2 v[33]; float as = 1.f, hs = 0.f;
#pragma unroll
        for (int q = 0; q < 33; ++q) { const int sidx = seg * 33 + q, ck = d ? (sidx < 4 ? 3 - sidx : NCHUNK + 3 - sidx) : sidx; v[q] = SUMM[((size_t)bd * NCHUNK + ck) * 1024 + ch]; }
#pragma unroll
        for (int q = 0; q < 33; ++q) { hs = v[q].x * hs + v[q].y; as *= v[q].x; }
        const float a16 = sx<16>(as), h16 = sx<16>(hs), a32 = sx<32>(as), h32 = sx<32>(hs), a48 = sx<32>(a16), h48 = sx<32>(h16);
        float h = 0.f;
#pragma unroll
        for (int jx = 0; jx < 3; ++jx) { const int x = jx ^ seg;
            const float aj = x == 0 ? as : (x == 1 ? a16 : (x == 2 ? a32 : a48)), hj = x == 0 ? hs : (x == 1 ? h16 : (x == 2 ? h32 : h48));
            if (jx < seg) h = aj * h + hj; }
#pragma unroll
        for (int q = 0; q < 33; ++q) { const int sidx = seg * 33 + q, ck = d ? (sidx < 4 ? 3 - sidx : NCHUNK + 3 - sidx) : sidx; CARRY[((size_t)bd * NCHUNK + ck) * 1024 + ch] = h; h = v[q].x * h + v[q].y; }
    }
}

__device__ __forceinline__ void ph_fft_t1(const Frame& F, const Args& A) {
    const unsigned* ZP = WSP(unsigned, WS_ZP); unsigned* XA = WSP(unsigned, WS_XA);
    for (long i = F.gtid; i < (long)NB * 512 * 8192; i += F.NT) {
        const int t1 = (int)(i & 127), t2 = (int)((i >> 7) & 63), cc = (int)((i >> 13) & 511), b = (int)(i >> 22);
        XA[i] = ZP[((size_t)b * TPB + CTX + 64 * t1 + t2) * 512 + cc];
    }
}
#if !FAST_FFT
__device__ __forceinline__ void ph_fft_a(const Frame& F, const Args& A) {
    const unsigned* XA = WSP(unsigned, WS_XA); unsigned* XB = WSP(unsigned, WS_XB);
    for (long i = F.gtid; i < (long)NB * 512 * 8192; i += F.NT) {
        const int k1 = (int)(i & 127); const long row = i >> 7; const int t2 = (int)(row & 63); const long bc = row >> 6;
        const unsigned* x = XA + row * 128; float yr = 0.f, yi = 0.f;
        for (int t1 = 0; t1 < 128; ++t1) { const unsigned w = x[t1]; const float wr = bf2f(w & 0xffffu), wi = bf2f(w >> 16);
            float sn, cs; sincospif((float)((k1 * t1) & 127) / 64.0f, &sn, &cs);
            yr += wr * cs + wi * sn; yi += wi * cs - wr * sn; }
        float sn, cs; sincospif((float)(k1 * t2) / 4096.0f, &sn, &cs);
        const float zr = yr * cs + yi * sn, zi = yi * cs - yr * sn;
        XB[(bc * 64 + (k1 >> 1)) * 128 + (k1 & 1) * 64 + t2] = pk2(zr, zi);
    }
}
#endif
#if !FAST_FFT
__device__ __forceinline__ void ph_fft_b(const Frame& F, const Args& A) {
    const unsigned* XB = WSP(unsigned, WS_XB); unsigned* GB = WSP(unsigned, WS_GB);
    for (long i = F.gtid; i < (long)NB * 512 * 8192; i += F.NT) {
        const int k2 = (int)(i & 63); const long hrow = i >> 6;
        const unsigned* x = XB + hrow * 64; float yr = 0.f, yi = 0.f;
        for (int t2 = 0; t2 < 64; ++t2) { const unsigned w = x[t2]; const float wr = bf2f(w & 0xffffu), wi = bf2f(w >> 16);
            float sn, cs; sincospif((float)((k2 * t2) & 63) / 32.0f, &sn, &cs);
            yr += wr * cs + wi * sn; yi += wi * cs - wr * sn; }
        GB[hrow * 64 + k2] = pk2(yr, yi);
    }
}
#endif
__device__ __forceinline__ void ph_fft_c(const Frame& F, const Args& A) {
    const unsigned* ZP = WSP(unsigned, WS_ZP); float2* GC = WSP(float2, WS_GC);
    LAS unsigned* Z = (LAS unsigned*)F.lds; LAS float* TWc = (LAS float*)(F.lds + 16384); LAS float* TWs = TWc + 256;
    __syncthreads();
    if (F.tid < 256) { const float rev = (float)F.tid * (1.f / 256.f); TWc[F.tid] = __builtin_amdgcn_cosf(rev); TWs[F.tid] = __builtin_amdgcn_sinf(rev); }
    for (int item = F.bid; item < 256; item += F.G) {
        const int b = item >> 7, c0 = ((item >> 2) & 31) * 16, kq = item & 3;
        __syncthreads();
        for (int e = F.tid; e < 4096; e += 512) Z[e] = ZP[((size_t)b * TPB + (e >> 4)) * 512 + c0 + (e & 15)];
        __syncthreads();
        const int cc = F.tid & 15, kb = kq * 64 + (F.tid >> 4) * 2; float ar[2], ai[2]; int m[2];
#pragma unroll
        for (int q = 0; q < 2; ++q) { ar[q] = 0.f; ai[q] = 0.f; m[q] = 0; }
#pragma unroll 4
        for (int t = 0; t < 256; ++t) { const unsigned w = Z[t * 16 + cc]; const float wr = bf2f(w & 0xffffu), wi = bf2f(w >> 16);
#pragma unroll
            for (int q = 0; q < 2; ++q) { const float tc = TWc[m[q]], ts = TWs[m[q]]; ar[q] += wr * tc + wi * ts; ai[q] += wi * tc - wr * ts; m[q] = (m[q] + kb + q) & 255; } }
#pragma unroll
        for (int q = 0; q < 2; ++q) GC[((size_t)b * 512 + c0 + cc) * 256 + kb + q] = make_float2(ar[q], ai[q]);
    }
    __syncthreads();
}
__device__ __forceinline__ void ph_fft_t2(const Frame& F, const Args& A) {
    const unsigned* GB = WSP(unsigned, WS_GB); const float2* GC = WSP(float2, WS_GC); bf16* MX = WSP(bf16, WS_MIXIN);
    for (long i = F.gtid; i < (long)MROWS * 1024; i += F.NT) {
        const int R = (int)(i >> 10), col = (int)(i & 1023), g = col >> 8, jc = col & 255, b = R / TPB, p = R % TPB;
        const bool lat = p >= CTX; const int T = lat ? SEQ : CTX, k = lat ? p - CTX : p, km = (T - k) & (T - 1);
        const int j = (jc == 0 || jc == 128) ? 0 : (jc < 128 ? jc : 256 - jc); const int cc = g * 128 + j;
        float vr, vi, mr, mi;
        if (lat) { const size_t base = ((size_t)b * 512 + cc) * 64;
            const unsigned w = GB[(base + ((k & 127) >> 1)) * 128 + (k & 1) * 64 + (k >> 7)], wm = GB[(base + ((km & 127) >> 1)) * 128 + (km & 1) * 64 + (km >> 7)];
            vr = bf2f(w & 0xffffu); vi = bf2f(w >> 16); mr = bf2f(wm & 0xffffu); mi = bf2f(wm >> 16); }
        else { const float2 w = GC[((size_t)b * 512 + cc) * 256 + k], wm = GC[((size_t)b * 512 + cc) * 256 + km]; vr = w.x; vi = w.y; mr = wm.x; mi = wm.y; }
        float o;
        if (jc == 0) o = 0.5f * (vr + mr); else if (jc == 128) o = 0.5f * (vi + mi); else if (jc < 128) o = mr; else o = vr;
        o *= lat ? 6.9053396600248786e-4f : 3.90625e-3f;
        MX[(size_t)R * 3072 + 2048 + col] = (bf16)f2bf(o);
    }
}

#if !FAST_ATTN
__device__ __forceinline__ void ph_attn_naive(const Frame& F, const Args& A, int l) {
    const bf16 *Kb = WSP(bf16, WS_KB), *Vb = WSP(bf16, WS_VB), *Qb = WSP(bf16, WS_QB); bf16* MX = WSP(bf16, WS_MIXIN);
    const float* lq = A.in[10] + l * 256; float d01 = 0.f, d23 = 0.f;
    for (int i = 0; i < 64; ++i) { d01 += lq[i] * lq[64 + i]; d23 += lq[128 + i] * lq[192 + i]; }
    const float lam_init = 0.8f - 0.6f * expf(-0.3f * (float)l), lam = expf(d01) - expf(d23) + lam_init;
    LAS float* Ks = (LAS float*)F.lds; LAS float* Vs = Ks + 64 * 132; LAS float* Qs = Vs + 64 * 132; LAS float* Ws = Qs + 16 * 128;
    const int r = F.tid >> 5, tl = F.tid & 31;
    for (int u = F.bid; u < 16 * 528; u += F.G) {
        const int bh = u / 528, qb = u % 528, b = bh >> 3, h = bh & 7; const size_t R0 = (size_t)b * TPB + qb * 16; const int nkeys = qb < 16 ? CTX : TPB;
        __syncthreads();
        for (int e = F.tid; e < 2048; e += 512) Qs[e] = bf2f(Qb[(R0 + (e >> 7)) * 1024 + h * 128 + (e & 127)]);
        float m0 = -1e30f, l0 = 0.f, m1 = -1e30f, l1 = 0.f;
        for (int pass = 0; pass < 2; ++pass) {
            float inv0 = 0.f, inv1 = 0.f;
            if (pass == 1) {
#pragma unroll
                for (int o = 1; o < 32; o <<= 1) { float mo = __shfl_xor(m0, o), lo = __shfl_xor(l0, o), mn = fmaxf(m0, mo); l0 = l0 * exp2f(m0 - mn) + lo * exp2f(mo - mn); m0 = mn;
                    mo = __shfl_xor(m1, o); lo = __shfl_xor(l1, o); mn = fmaxf(m1, mo); l1 = l1 * exp2f(m1 - mn) + lo * exp2f(mo - mn); m1 = mn; }
                inv0 = 1.f / l0; inv1 = lam / l1;
            }
            float o4[4] = {0.f, 0.f, 0.f, 0.f};
            for (int kt = 0; kt < nkeys; kt += 64) {
                __syncthreads();
                for (int e = F.tid; e < 1024; e += 512) { const int kk = e >> 4, c8 = (e & 15) * 8; const size_t src = ((size_t)b * TPB + kt + kk) * 1024 + h * 128 + c8;
                    const v4u kv = *(const v4u*)(Kb + src);
                    Ks[kk * 132 + c8 + 0] = bf2f(kv.x & 0xffffu); Ks[kk * 132 + c8 + 1] = bf2f(kv.x >> 16); Ks[kk * 132 + c8 + 2] = bf2f(kv.y & 0xffffu); Ks[kk * 132 + c8 + 3] = bf2f(kv.y >> 16);
                    Ks[kk * 132 + c8 + 4] = bf2f(kv.z & 0xffffu); Ks[kk * 132 + c8 + 5] = bf2f(kv.z >> 16); Ks[kk * 132 + c8 + 6] = bf2f(kv.w & 0xffffu); Ks[kk * 132 + c8 + 7] = bf2f(kv.w >> 16);
                    if (pass == 1) { const v4u vv = *(const v4u*)(Vb + src);
                        Vs[kk * 132 + c8 + 0] = bf2f(vv.x & 0xffffu); Vs[kk * 132 + c8 + 1] = bf2f(vv.x >> 16); Vs[kk * 132 + c8 + 2] = bf2f(vv.y & 0xffffu); Vs[kk * 132 + c8 + 3] = bf2f(vv.y >> 16);
                        Vs[kk * 132 + c8 + 4] = bf2f(vv.z & 0xffffu); Vs[kk * 132 + c8 + 5] = bf2f(vv.z >> 16); Vs[kk * 132 + c8 + 6] = bf2f(vv.w & 0xffffu); Vs[kk * 132 + c8 + 7] = bf2f(vv.w >> 16); } }
                __syncthreads();
#pragma unroll
                for (int kq = 0; kq < 2; ++kq) { const int kk = tl + 32 * kq; float s0 = 0.f, s1 = 0.f;
                    for (int d = 0; d < 64; d += 4) { const f32x4 q0 = *(const LAS f32x4*)(Qs + r * 128 + d), q1 = *(const LAS f32x4*)(Qs + r * 128 + 64 + d), k0 = *(const LAS f32x4*)(Ks + kk * 132 + d), k1 = *(const LAS f32x4*)(Ks + kk * 132 + 64 + d);
                        s0 += q0.x * k0.x + q0.y * k0.y + q0.z * k0.z + q0.w * k0.w; s1 += q1.x * k1.x + q1.y * k1.y + q1.z * k1.z + q1.w * k1.w; }
                    if (pass == 0) { float mn = fmaxf(m0, s0); l0 = l0 * exp2f(m0 - mn) + exp2f(s0 - mn); m0 = mn; mn = fmaxf(m1, s1); l1 = l1 * exp2f(m1 - mn) + exp2f(s1 - mn); m1 = mn; }
                    else Ws[r * 64 + kk] = exp2f(s0 - m0) * inv0 - exp2f(s1 - m1) * inv1; }
                if (pass == 1) { __syncthreads();
                    for (int kk = 0; kk < 64; ++kk) { const float w = Ws[r * 64 + kk];
#pragma unroll
                        for (int i = 0; i < 4; ++i) o4[i] += w * Vs[kk * 132 + tl + 32 * i]; } }
            }
            if (pass == 1) { float ss = o4[0] * o4[0] + o4[1] * o4[1] + o4[2] * o4[2] + o4[3] * o4[3];
#pragma unroll
                for (int o = 1; o < 32; o <<= 1) ss += __shfl_xor(ss, o);
                const float sc = rsqrtf(ss * (1.f / 128.f) + EPS) * (1.f - lam_init);
#pragma unroll
                for (int i = 0; i < 4; ++i) MX[(R0 + r) * 3072 + h * 128 + tl + 32 * i] = (bf16)f2bf(o4[i] * sc * A.in[11][l * 128 + tl + 32 * i]); }
        }
    }
}

#endif
namespace da {
using bf16x8 = __attribute__((ext_vector_type(8))) short;
using s16x4  = __attribute__((ext_vector_type(4))) short;
using f32x16 = __attribute__((ext_vector_type(16))) float;
using u32x4  = __attribute__((ext_vector_type(4))) unsigned;
constexpr int KVBLK = 64, LDK = 1024;
constexpr size_t SHM_V = KVBLK * 128 * 2, SHM_K = KVBLK * 128 * 2;
constexpr float THR = 8.f;
#define DA_KSWZ(row, colB) ((row) * 256 + ((colB) ^ (((row) & 7) << 4)))
#define DA_SBAR() __builtin_amdgcn_sched_barrier(0)
__device__ __forceinline__ int crow(int r, int hi) { return (r & 3) + 8 * (r >> 2) + 4 * hi; }
__device__ __forceinline__ unsigned cvtpk(float lo, float hi) { unsigned r; asm volatile("v_cvt_pk_bf16_f32 %0, %1, %2" : "=v"(r) : "v"(lo), "v"(hi)); return r; }
__device__ __forceinline__ void expSM(f32x16& p0, f32x16& p1, float soff) {
  for (int r = 0; r < 16; ++r) p0[r] = __builtin_amdgcn_exp2f(p0[r] - soff); for (int r = 0; r < 16; ++r) p1[r] = __builtin_amdgcn_exp2f(p1[r] - soff);
}
__device__ __forceinline__ void finishSM(f32x16& p0, f32x16& p1, float& l_reg, bf16x8& pa0, bf16x8& pa1, bf16x8& pa2, bf16x8& pa3) {
  float ps = 0; for (int r = 0; r < 16; ++r) ps += p0[r]; for (int r = 0; r < 16; ++r) ps += p1[r];
  l_reg += ps;
#define DA_PK4(P, BASE, OUT) do { unsigned a0 = cvtpk(P[BASE + 0], P[BASE + 1]), a1 = cvtpk(P[BASE + 2], P[BASE + 3]);   \
    unsigned b0 = cvtpk(P[BASE + 4], P[BASE + 5]), b1 = cvtpk(P[BASE + 6], P[BASE + 7]);                              \
    auto r0 = __builtin_amdgcn_permlane32_swap(a0, b0, false, false); auto r1 = __builtin_amdgcn_permlane32_swap(a1, b1, false, false); \
    u32x4 w = {r0[0], r1[0], r0[1], r1[1]}; OUT = *reinterpret_cast<bf16x8*>(&w); } while (0)
  DA_PK4(p0, 0, pa0); DA_PK4(p0, 8, pa1); DA_PK4(p1, 0, pa2); DA_PK4(p1, 8, pa3);
#undef DA_PK4
}
__device__ __forceinline__ void qkt(f32x16& p0, f32x16& p1, const char* Ks, const bf16x8* qr, int r32, int hi, int cbm) {
  p0 = f32x16{}; p1 = f32x16{};
#pragma unroll
  for (int d0 = 0; d0 < 4; ++d0) { const int cb = cbm + (d0 * 16 + hi * 8) * 2;
    bf16x8 b0 = *reinterpret_cast<const bf16x8*>(Ks + DA_KSWZ(r32, cb));
    bf16x8 b1 = *reinterpret_cast<const bf16x8*>(Ks + DA_KSWZ(32 + r32, cb));
    p0 = __builtin_amdgcn_mfma_f32_32x32x16_bf16(b0, qr[d0], p0, 0, 0, 0);
    p1 = __builtin_amdgcn_mfma_f32_32x32x16_bf16(b1, qr[d0], p1, 0, 0, 0); }
}
__device__ __forceinline__ int v_st(int k, int c) { const int kk = (k & ~0xC) | ((k & 4) << 1) | ((k & 8) >> 1); return ((kk >> 3) * 4 + (c >> 5)) * 512 + ((kk & 7) * 32 + (c & 31)) * 2; }
__device__ __forceinline__ int v_rd_base(int lane) { return ((lane & 3) << 3) | (((lane >> 2) & 3) << 6) | (((lane >> 4) & 1) << 5) | (((lane >> 5) & 1) << 8); }
constexpr int v_rd_off(int d0, int ks, int half) { return d0 * 512 + ks * 4096 + half * 2048; }
template <int OFF> __device__ __forceinline__ s16x4 tr_read(int vb) {
  s16x4 r; asm volatile("ds_read_b64_tr_b16 %0, %1 offset:%2" : "=&v"(r) : "v"(vb), "i"(OFF) : "memory"); return r;
}
template <int D0> __device__ __forceinline__ void pv_one(f32x16& od, int vb, bf16x8 pa0, bf16x8 pa1, bf16x8 pa2, bf16x8 pa3) {
  const s16x4 l0 = tr_read<v_rd_off(D0, 0, 0)>(vb), h0 = tr_read<v_rd_off(D0, 0, 1)>(vb), l1 = tr_read<v_rd_off(D0, 1, 0)>(vb), h1 = tr_read<v_rd_off(D0, 1, 1)>(vb);
  const s16x4 l2 = tr_read<v_rd_off(D0, 2, 0)>(vb), h2 = tr_read<v_rd_off(D0, 2, 1)>(vb), l3 = tr_read<v_rd_off(D0, 3, 0)>(vb), h3 = tr_read<v_rd_off(D0, 3, 1)>(vb);
  asm volatile("s_waitcnt lgkmcnt(0)" ::: "memory"); DA_SBAR();
#define DA_PK(L, H) (bf16x8){L[0], L[1], L[2], L[3], H[0], H[1], H[2], H[3]}
  od = __builtin_amdgcn_mfma_f32_32x32x16_bf16(pa0, DA_PK(l0, h0), od, 0, 0, 0);
  od = __builtin_amdgcn_mfma_f32_32x32x16_bf16(pa1, DA_PK(l1, h1), od, 0, 0, 0);
  od = __builtin_amdgcn_mfma_f32_32x32x16_bf16(pa2, DA_PK(l2, h2), od, 0, 0, 0);
  od = __builtin_amdgcn_mfma_f32_32x32x16_bf16(pa3, DA_PK(l3, h3), od, 0, 0, 0);
#undef DA_PK
}
__device__ __forceinline__ void pv_d0(f32x16* o, int vb, bf16x8 pa0, bf16x8 pa1, bf16x8 pa2, bf16x8 pa3) {
  pv_one<0>(o[0], vb, pa0, pa1, pa2, pa3); pv_one<1>(o[1], vb, pa0, pa1, pa2, pa3); pv_one<2>(o[2], vb, pa0, pa1, pa2, pa3); pv_one<3>(o[3], vb, pa0, pa1, pa2, pa3);
}
__device__ __forceinline__ void unit(const unsigned short* __restrict__ Qb, const unsigned short* __restrict__ Kh, const unsigned short* __restrict__ Vh,
                                     unsigned short* __restrict__ Ob, int ldo, int seq, float lam, float oscale, float soff, const float* __restrict__ subg, char* lds) {
  const int tid = otid(), wid = tid >> 6, lane = tid & 63, r32 = lane & 31, hi = lane >> 5, mp = wid >> 2, wq = wid & 3;
  char* V_lds = lds; char* K_lds = lds + 2 * SHM_V;
  float* ws = (float*)(lds + 2 * SHM_V + 2 * SHM_K) + wid * 64; float* li_l = ws;
  float l_reg = 0; f32x16 o[4] = {}; bf16x8 qr[4];
  const unsigned short* Qw = Qb + (long)(wq * 32 + r32) * 1024 + mp * 64 + hi * 8;
#pragma unroll
  for (int d0 = 0; d0 < 4; ++d0) qr[d0] = *reinterpret_cast<const bf16x8*>(Qw + d0 * 16);
  const int cbm = mp * 128;
  const int sr = tid >> 4, sc = (tid & 15) * 8, vst0 = v_st(sr, sc), vst1 = v_st(32 + sr, sc);
  const int vb0 = (int)(uintptr_t)V_lds + v_rd_base(lane);
  struct { bf16x8 vs0, vs1, ks0, ks1; } sr_[2];
#define DA_SLOAD(i, k0) do { sr_[i].vs0 = *reinterpret_cast<const bf16x8*>(&Vh[(long)((k0) + sr) * LDK + sc]); sr_[i].vs1 = *reinterpret_cast<const bf16x8*>(&Vh[(long)((k0) + 32 + sr) * LDK + sc]); \
    sr_[i].ks0 = *reinterpret_cast<const bf16x8*>(&Kh[(long)((k0) + sr) * LDK + sc]); sr_[i].ks1 = *reinterpret_cast<const bf16x8*>(&Kh[(long)((k0) + 32 + sr) * LDK + sc]); } while (0)
#define DA_SWRITE(b, i) do { *(bf16x8*)(V_lds + (b) * SHM_V + vst0) = sr_[i].vs0;          \
    *(bf16x8*)(V_lds + (b) * SHM_V + vst1) = sr_[i].vs1; int kc = sc * 2;               \
    *(bf16x8*)(K_lds + (b) * SHM_K + DA_KSWZ(sr, kc)) = sr_[i].ks0;                       \
    *(bf16x8*)(K_lds + (b) * SHM_K + DA_KSWZ(32 + sr, kc)) = sr_[i].ks1; } while (0)
#define DA_SWAIT() asm volatile("s_waitcnt vmcnt(4)" ::: "memory")
  f32x16 pA0, pA1, pB0, pB1; bf16x8 pa0, pa1, pa2, pa3; const int NT = seq / KVBLK;
  constexpr int SE = 0, SO = 1;
  DA_SLOAD(SE, 0); asm volatile("s_waitcnt vmcnt(0)" ::: "memory"); DA_SWRITE(0, SE); __syncthreads();
  qkt(pA0, pA1, K_lds, qr, r32, hi, cbm); expSM(pA0, pA1, soff);
  DA_SLOAD(SO, KVBLK); if (2 < NT) DA_SLOAD(SE, 2 * KVBLK);
  DA_SWAIT(); DA_SWRITE(1, SO); __syncthreads();
  for (int j = 1; j + 1 < NT; j += 2) {
    DA_SBAR(); qkt(pB0, pB1, K_lds + SHM_K, qr, r32, hi, cbm);
    finishSM(pA0, pA1, l_reg, pa0, pa1, pa2, pa3); DA_SBAR();
    DA_SLOAD(SO, (j + 2) * KVBLK); DA_SBAR();
    pv_d0(o, vb0, pa0, pa1, pa2, pa3); expSM(pB0, pB1, soff);
    __syncthreads(); DA_SWAIT(); DA_SWRITE(0, SE);
    __syncthreads();
    DA_SBAR(); qkt(pA0, pA1, K_lds, qr, r32, hi, cbm);
    finishSM(pB0, pB1, l_reg, pa0, pa1, pa2, pa3); DA_SBAR();
    if (j + 3 < NT) DA_SLOAD(SE, (j + 3) * KVBLK); DA_SBAR();
    pv_d0(o, vb0 + (int)SHM_V, pa0, pa1, pa2, pa3); expSM(pA0, pA1, soff);
    __syncthreads(); DA_SWAIT(); DA_SWRITE(1, SO);
    __syncthreads();
  }
  DA_SBAR(); qkt(pB0, pB1, K_lds + SHM_K, qr, r32, hi, cbm);
  finishSM(pA0, pA1, l_reg, pa0, pa1, pa2, pa3); DA_SBAR();
  pv_d0(o, vb0, pa0, pa1, pa2, pa3); expSM(pB0, pB1, soff);
  __syncthreads();
  finishSM(pB0, pB1, l_reg, pa0, pa1, pa2, pa3); DA_SBAR();
  pv_d0(o, vb0 + (int)SHM_V, pa0, pa1, pa2, pa3);
  { auto rr = __builtin_amdgcn_permlane32_swap(__float_as_uint(l_reg), __float_as_uint(l_reg), false, false); l_reg = __uint_as_float(rr[0]) + __uint_as_float(rr[1]); }
  if (hi == 0) li_l[r32] = l_reg; asm volatile("s_waitcnt lgkmcnt(0)" ::: "memory");
  const float sgn = mp ? lam : 1.f;
#pragma unroll
  for (int r = 0; r < 16; ++r) { const float rl = sgn * __builtin_amdgcn_rcpf(li_l[crow(r, hi)]);
#pragma unroll
    for (int d0 = 0; d0 < 4; ++d0) o[d0][r] *= rl; }
  __syncthreads();
  int xb = wq * 4096 + lane; asm volatile("" : "+v"(xb));
  float* X = (float*)lds + xb;
  if (mp == 1) {
#pragma unroll
    for (int d0 = 0; d0 < 4; ++d0)
#pragma unroll
      for (int r = 0; r < 16; ++r) X[(d0 * 16 + r) * 64] = o[d0][r];
  }
  __syncthreads();
  if (mp == 0) {
    float gg[4];
#pragma unroll
    for (int d0 = 0; d0 < 4; ++d0) gg[d0] = subg[d0 * 32 + r32] * oscale;
    int ob = (wq * 32 + 4 * hi) * ldo + r32; asm volatile("" : "+v"(ob));
    unsigned short* Ow = Ob + ob;
#pragma unroll
    for (int r = 0; r < 16; ++r) { float a = 0.f; float v[4];
#pragma unroll
      for (int d0 = 0; d0 < 4; ++d0) { v[d0] = o[d0][r] - X[(d0 * 16 + r) * 64]; a += v[d0] * v[d0]; }
      a += sx<1>(a); a += sx<2>(a); a += sx<4>(a); a += sx<8>(a); a += sx<16>(a);
      a = rsqrtf(a * (1.f / 128.f) + EPS);
      const int orow = (r & 3) + 8 * (r >> 2);
#pragma unroll
      for (int d0 = 0; d0 < 4; ++d0) Ow[orow * ldo + d0 * 32] = (unsigned short)f2bf(v[d0] * a * gg[d0]); }
  }
  __syncthreads();
#undef DA_SLOAD
#undef DA_SWRITE
#undef DA_SWAIT
}

template <int D0> __device__ __forceinline__ void v_rd8(s16x4 (&f)[8], int vb) {
  f[0] = tr_read<v_rd_off(D0, 0, 0)>(vb); f[1] = tr_read<v_rd_off(D0, 0, 1)>(vb); f[2] = tr_read<v_rd_off(D0, 1, 0)>(vb); f[3] = tr_read<v_rd_off(D0, 1, 1)>(vb);
  f[4] = tr_read<v_rd_off(D0, 2, 0)>(vb); f[5] = tr_read<v_rd_off(D0, 2, 1)>(vb); f[6] = tr_read<v_rd_off(D0, 3, 0)>(vb); f[7] = tr_read<v_rd_off(D0, 3, 1)>(vb);
}
__device__ __forceinline__ void pv_mm(f32x16& od, const s16x4 (&f)[8], bf16x8 pa0, bf16x8 pa1, bf16x8 pa2, bf16x8 pa3) {
#define DA_PK(L, H) (bf16x8){L[0], L[1], L[2], L[3], H[0], H[1], H[2], H[3]}
  od = __builtin_amdgcn_mfma_f32_32x32x16_bf16(pa0, DA_PK(f[0], f[1]), od, 0, 0, 0);
  od = __builtin_amdgcn_mfma_f32_32x32x16_bf16(pa1, DA_PK(f[2], f[3]), od, 0, 0, 0);
  od = __builtin_amdgcn_mfma_f32_32x32x16_bf16(pa2, DA_PK(f[4], f[5]), od, 0, 0, 0);
  od = __builtin_amdgcn_mfma_f32_32x32x16_bf16(pa3, DA_PK(f[6], f[7]), od, 0, 0, 0);
#undef DA_PK
}
__device__ __forceinline__ void pv_pipe(f32x16* o, int vb, bf16x8 pa0, bf16x8 pa1, bf16x8 pa2, bf16x8 pa3) {
  s16x4 fa[8], fb[8];
  v_rd8<0>(fa, vb); v_rd8<1>(fb, vb);
  asm volatile("s_waitcnt lgkmcnt(8)" ::: "memory"); DA_SBAR(); pv_mm(o[0], fa, pa0, pa1, pa2, pa3); DA_SBAR();
  v_rd8<2>(fa, vb);
  asm volatile("s_waitcnt lgkmcnt(8)" ::: "memory"); DA_SBAR(); pv_mm(o[1], fb, pa0, pa1, pa2, pa3); DA_SBAR();
  v_rd8<3>(fb, vb);
  asm volatile("s_waitcnt lgkmcnt(8)" ::: "memory"); DA_SBAR(); pv_mm(o[2], fa, pa0, pa1, pa2, pa3); DA_SBAR();
  asm volatile("s_waitcnt lgkmcnt(0)" ::: "memory"); DA_SBAR(); pv_mm(o[3], fb, pa0, pa1, pa2, pa3); DA_SBAR();
}
__device__ __forceinline__ void unit8(const unsigned short* __restrict__ Qb, const unsigned short* __restrict__ Kh, const unsigned short* __restrict__ Vh,
                                      unsigned short* __restrict__ Ob, int ldo, int seq, float lam, float oscale, float soff, const float* __restrict__ subg, LAS unsigned char* ldsl) {
  const int tid = otid(), wid = __builtin_amdgcn_readfirstlane(tid >> 6), lane = tid & 63, r32 = lane & 31, hi = lane >> 5, mp = wid >> 2, wq = wid & 3;
  constexpr int SLOT = 16384;
  char* lds = (char*)ldsl; char* K_lds = lds; const int vbase = (int)(uintptr_t)(lds + 3 * SLOT) + v_rd_base(lane);
  float* li_l = (float*)(lds + 6 * SLOT) + wid * 64;
  f32x16 o[4] = {}; bf16x8 qr[4];
  const unsigned short* Qw = Qb + (long)(wq * 32 + r32) * 1024 + mp * 64 + hi * 8;
#pragma unroll
  for (int d0 = 0; d0 < 4; ++d0) qr[d0] = *reinterpret_cast<const bf16x8*>(Qw + d0 * 16);
  asm volatile("s_waitcnt vmcnt(0)" ::: "memory");
  const int cbm = mp * 128;
  const unsigned wl = (unsigned)wid * 1024u;
  unsigned kso[2], vso[2];
#pragma unroll
  for (int i = 0; i < 2; ++i) { const int P = (i * 8 + wid) * 64 + lane;
    { const int row = P >> 4, chunk = (P & 15) ^ (row & 7); kso[i] = (unsigned)(row * LDK + chunk * 8) * 2u; }
    { const int sub = P >> 5, kk = (sub >> 2) * 8 + ((P & 31) >> 2), key = (kk & ~0xC) | ((kk & 4) << 1) | ((kk & 8) >> 1); vso[i] = (unsigned)(key * LDK + (sub & 3) * 32 + (P & 3) * 8) * 2u; } }
#define DA_DMA_K(t, slot) do { const unsigned to_ = (unsigned)(t) * (unsigned)(KVBLK * LDK * 2); _Pragma("unroll") for (int i_ = 0; i_ < 2; ++i_) \
      __builtin_amdgcn_global_load_lds((const unsigned*)((const char*)Kh + (kso[i_] + to_)), (LAS unsigned*)(ldsl + (slot) * SLOT + i_ * 8192 + wl), 16, 0, 0); } while (0)
#define DA_DMA_V(t, slot) do { const unsigned to_ = (unsigned)(t) * (unsigned)(KVBLK * LDK * 2); _Pragma("unroll") for (int i_ = 0; i_ < 2; ++i_) \
      __builtin_amdgcn_global_load_lds((const unsigned*)((const char*)Vh + (vso[i_] + to_)), (LAS unsigned*)(ldsl + (3 + (slot)) * SLOT + i_ * 8192 + wl), 16, 0, 0); } while (0)
#define U8_PK(t, slot, i_) __builtin_amdgcn_global_load_lds((const unsigned*)((const char*)Kh + (kso[i_] + (unsigned)(t) * (unsigned)(KVBLK * LDK * 2))), (LAS unsigned*)(ldsl + (slot) * SLOT + (i_) * 8192 + wl), 16, 0, 0)
#define U8_PV(t, slot, i_) __builtin_amdgcn_global_load_lds((const unsigned*)((const char*)Vh + (vso[i_] + (unsigned)(t) * (unsigned)(KVBLK * LDK * 2))), (LAS unsigned*)(ldsl + (3 + (slot)) * SLOT + (i_) * 8192 + wl), 16, 0, 0)
#define DA_WAITBAR(N) do { asm volatile("s_waitcnt vmcnt(" #N ") lgkmcnt(0)" ::: "memory"); __builtin_amdgcn_s_barrier(); asm volatile("" ::: "memory"); } while (0)
  f32x16 pA0, pA1, pB0, pB1; u32x4 pw0, pw1, pw2, pw3; const int NT = seq / KVBLK;
  bf16x8 kf[8];
  f32x16 negm, ol = {};
#pragma unroll
  for (int r = 0; r < 16; ++r) negm[r] = -soff;
  const bf16x8 ones = {0x3F80, 0x3F80, 0x3F80, 0x3F80, 0x3F80, 0x3F80, 0x3F80, 0x3F80};
  const int pkr = ((r32 & 3) + 4 * (r32 >> 3)), pk = (pkr & 7) + 16 * (pkr >> 3) + 8 * ((r32 >> 2) & 1);
#define U5_KADDR(d0) ((int)(uintptr_t)K_lds + pk * 256 + ((((cbm >> 4) + 2 * (d0) + hi) ^ (pk & 7)) * 16))
#define U5_KLOAD(slot) do { const int so_ = (slot) * SLOT; _Pragma("unroll") for (int d0 = 0; d0 < 4; ++d0) { const int ad_ = U5_KADDR(d0) + so_; \
    asm volatile("ds_read_b128 %0, %2\n\tds_read_b128 %1, %2 offset:8192" : "=&v"(kf[2 * d0]), "=&v"(kf[2 * d0 + 1]) : "v"(ad_) : "memory"); } } while (0)
#define U5_PIN(x) asm volatile("" : "+v"(x))
#define U5_EX(v) __builtin_amdgcn_exp2f(v)
#define U5_VRD(L, H, m) do { asm volatile("ds_read_b64_tr_b16 %0, %1 offset:%2" : "=&v"(L) : "v"(vb_), "i"(v_rd_off((m) >> 2, (m) & 3, 0)) : "memory"); \
    asm volatile("ds_read_b64_tr_b16 %0, %1 offset:%2" : "=&v"(H) : "v"(vb_), "i"(v_rd_off((m) >> 2, (m) & 3, 1)) : "memory"); } while (0)
#define U5_GAPA(MF, X, B4, PW, VR, CV0, CV1) do { MF; VR; CV0; CV1; U5_PIN(PW); DA_SBAR(); } while (0)
#define U5_CVT(P, b) cvtpk(P[b], P[b + 1])
#define U5_PHASE_A(C0, C1, P0, P1, VSLOT, HK0, HK1, HV0, HV1) do { const int vb_ = vbase + (VSLOT) * SLOT; \
    U5_GAPA(C0 = __builtin_amdgcn_mfma_f32_32x32x16_bf16(kf[0], qr[0], negm, 0, 0, 0), P0, 0, pw0, HK0, pw0[0] = U5_CVT(P0, 0), pw0[1] = U5_CVT(P0, 2)); \
    U5_GAPA(C1 = __builtin_amdgcn_mfma_f32_32x32x16_bf16(kf[1], qr[0], negm, 0, 0, 0), P0, 4, pw0, HK1, pw0[2] = U5_CVT(P0, 4), pw0[3] = U5_CVT(P0, 6)); \
    U5_GAPA(C0 = __builtin_amdgcn_mfma_f32_32x32x16_bf16(kf[2], qr[1], C0, 0, 0, 0), P0, 8, pw1, do { HV0; HV1; } while (0), pw1[0] = U5_CVT(P0, 8), pw1[1] = U5_CVT(P0, 10)); \
    U5_GAPA(C1 = __builtin_amdgcn_mfma_f32_32x32x16_bf16(kf[3], qr[1], C1, 0, 0, 0), P0, 12, pw1, U5_VRD(vl0, vh0, 0), pw1[2] = U5_CVT(P0, 12), pw1[3] = U5_CVT(P0, 14)); \
    U5_GAPA(C0 = __builtin_amdgcn_mfma_f32_32x32x16_bf16(kf[4], qr[2], C0, 0, 0, 0), P1, 0, pw2, U5_VRD(vl1, vh1, 1), pw2[0] = U5_CVT(P1, 0), pw2[1] = U5_CVT(P1, 2)); \
    U5_GAPA(C1 = __builtin_amdgcn_mfma_f32_32x32x16_bf16(kf[5], qr[2], C1, 0, 0, 0), P1, 4, pw2, U5_VRD(vl2, vh2, 2), pw2[2] = U5_CVT(P1, 4), pw2[3] = U5_CVT(P1, 6)); \
    U5_GAPA(C0 = __builtin_amdgcn_mfma_f32_32x32x16_bf16(kf[6], qr[3], C0, 0, 0, 0), P1, 8, pw3, U5_VRD(vl3, vh3, 3), pw3[0] = U5_CVT(P1, 8), pw3[1] = U5_CVT(P1, 10)); \
    U5_GAPA(C1 = __builtin_amdgcn_mfma_f32_32x32x16_bf16(kf[7], qr[3], C1, 0, 0, 0), P1, 12, pw3, U5_VRD(vl4, vh4, 4), pw3[2] = U5_CVT(P1, 12), pw3[3] = U5_CVT(P1, 14)); \
    } while (0)
#define U5_PKV(L, H) (bf16x8){L[0], L[1], L[2], L[3], H[0], H[1], H[2], H[3]}
#define U5_PAF(k) __builtin_bit_cast(bf16x8, pw##k)
#define U5_GAPB(WAITN, OD, PK, L, H, X, B2, NEXT) do { asm volatile("s_waitcnt lgkmcnt(" #WAITN ")" ::: "memory"); DA_SBAR(); \
    OD = __builtin_amdgcn_mfma_f32_32x32x16_bf16(PK, U5_PKV(L, H), OD, 0, 0, 0); NEXT; X[B2] = U5_EX(X[B2]); X[B2 + 1] = U5_EX(X[B2 + 1]); U5_PIN(X); DA_SBAR(); } while (0)
#define U5_GAPS(PK, X, B2) do { ol = __builtin_amdgcn_mfma_f32_32x32x16_bf16(PK, ones, ol, 0, 0, 0); X[B2] = U5_EX(X[B2]); X[B2 + 1] = U5_EX(X[B2 + 1]); U5_PIN(X); DA_SBAR(); } while (0)
#define U5_GAPN(WAITN, OD, PK, L, H, NEXT) do { asm volatile("s_waitcnt lgkmcnt(" #WAITN ")" ::: "memory"); DA_SBAR(); \
    OD = __builtin_amdgcn_mfma_f32_32x32x16_bf16(PK, U5_PKV(L, H), OD, 0, 0, 0); NEXT; DA_SBAR(); } while (0)
#define U5_PHASE_B(C0, C1, VSLOT, KSLOT, DOK) do { const int vb_ = vbase + (VSLOT) * SLOT; \
    U5_GAPS(U5_PAF(0), C0, 0); U5_GAPS(U5_PAF(1), C0, 2); U5_GAPS(U5_PAF(2), C0, 4); U5_GAPS(U5_PAF(3), C0, 6); \
    U5_GAPB(8, o[0], U5_PAF(0), vl0, vh0, C0, 8, U5_VRD(vl5, vh5, 5)); \
    U5_GAPB(8, o[0], U5_PAF(1), vl1, vh1, C0, 10, U5_VRD(vl0, vh0, 6)); \
    U5_GAPB(8, o[0], U5_PAF(2), vl2, vh2, C0, 12, U5_VRD(vl1, vh1, 7)); \
    U5_GAPB(8, o[0], U5_PAF(3), vl3, vh3, C0, 14, U5_VRD(vl2, vh2, 8)); \
    U5_GAPB(8, o[1], U5_PAF(0), vl4, vh4, C1, 0, U5_VRD(vl3, vh3, 9)); \
    U5_GAPB(8, o[1], U5_PAF(1), vl5, vh5, C1, 2, U5_VRD(vl4, vh4, 10)); \
    U5_GAPB(8, o[1], U5_PAF(2), vl0, vh0, C1, 4, U5_VRD(vl5, vh5, 11)); \
    U5_GAPB(8, o[1], U5_PAF(3), vl1, vh1, C1, 6, U5_VRD(vl0, vh0, 12)); \
    U5_GAPB(8, o[2], U5_PAF(0), vl2, vh2, C1, 8, U5_VRD(vl1, vh1, 13)); \
    U5_GAPB(8, o[2], U5_PAF(1), vl3, vh3, C1, 10, U5_VRD(vl2, vh2, 14)); \
    U5_GAPB(8, o[2], U5_PAF(2), vl4, vh4, C1, 12, U5_VRD(vl3, vh3, 15)); \
    U5_GAPB(8, o[2], U5_PAF(3), vl5, vh5, C1, 14, (void)0); \
    U5_GAPN(6, o[3], U5_PAF(0), vl0, vh0, (void)0); \
    if (DOK) { U5_GAPN(4, o[3], U5_PAF(1), vl1, vh1, U5_KLOAD(KSLOT)); U5_GAPN(10, o[3], U5_PAF(2), vl2, vh2, (void)0); U5_GAPN(8, o[3], U5_PAF(3), vl3, vh3, (void)0); } \
    else { U5_GAPN(4, o[3], U5_PAF(1), vl1, vh1, (void)0); U5_GAPN(2, o[3], U5_PAF(2), vl2, vh2, (void)0); U5_GAPN(0, o[3], U5_PAF(3), vl3, vh3, (void)0); } } while (0)
#define DA_ROT(x) ((x) == 2 ? 0 : (x) + 1)
#define DA_PRV(x) ((x) == 0 ? 2 : (x) - 1)
  s16x4 vl0, vh0, vl1, vh1, vl2, vh2, vl3, vh3, vl4, vh4, vl5, vh5;
  DA_DMA_K(0, 0); DA_DMA_K(1, 1); DA_DMA_V(0, 0);
  DA_WAITBAR(0);
  U5_KLOAD(0); DA_DMA_K(2, 2); DA_DMA_V(1, 1);
  DA_WAITBAR(4);
  DA_DMA_K(3, 0);
  DA_SBAR();
  pA0 = negm; pA1 = negm;
#pragma unroll
  for (int d0 = 0; d0 < 4; ++d0) { pA0 = __builtin_amdgcn_mfma_f32_32x32x16_bf16(kf[2 * d0], qr[d0], pA0, 0, 0, 0); pA1 = __builtin_amdgcn_mfma_f32_32x32x16_bf16(kf[2 * d0 + 1], qr[d0], pA1, 0, 0, 0); }
  DA_SBAR(); U5_KLOAD(1);
  expSM(pA0, pA1, 0.f);
  DA_WAITBAR(2);
  int c = 1;
  for (int j = 1; j + 1 < NT; j += 2) {
    { const bool mk = j + 3 < NT;
      DA_SBAR(); U5_PHASE_A(pB0, pB1, pA0, pA1, DA_PRV(c), if (mk) U8_PK(j + 3, c, 0), if (mk) U8_PK(j + 3, c, 1), U8_PV(j + 1, DA_ROT(c), 0), U8_PV(j + 1, DA_ROT(c), 1));
      U5_PHASE_B(pB0, pB1, DA_PRV(c), DA_ROT(c), true);
      if (mk) DA_WAITBAR(4); else DA_WAITBAR(2);
      c = DA_ROT(c); }
    { const bool mk = j + 4 < NT;
      DA_SBAR(); U5_PHASE_A(pA0, pA1, pB0, pB1, DA_PRV(c), if (mk) U8_PK(j + 4, c, 0), if (mk) U8_PK(j + 4, c, 1), U8_PV(j + 2, DA_ROT(c), 0), U8_PV(j + 2, DA_ROT(c), 1));
      U5_PHASE_B(pA0, pA1, DA_PRV(c), DA_ROT(c), true);
      if (mk) DA_WAITBAR(4); else DA_WAITBAR(2);
      c = DA_ROT(c); }
  }
  DA_SBAR(); U5_PHASE_A(pB0, pB1, pA0, pA1, DA_PRV(c), (void)0, (void)0, (void)0, (void)0);
  U5_PHASE_B(pB0, pB1, DA_PRV(c), 0, false);
  DA_WAITBAR(0);
  { u32x4 w0 = {cvtpk(pB0[0], pB0[1]), cvtpk(pB0[2], pB0[3]), cvtpk(pB0[4], pB0[5]), cvtpk(pB0[6], pB0[7])}, w1 = {cvtpk(pB0[8], pB0[9]), cvtpk(pB0[10], pB0[11]), cvtpk(pB0[12], pB0[13]), cvtpk(pB0[14], pB0[15])};
    u32x4 w2 = {cvtpk(pB1[0], pB1[1]), cvtpk(pB1[2], pB1[3]), cvtpk(pB1[4], pB1[5]), cvtpk(pB1[6], pB1[7])}, w3 = {cvtpk(pB1[8], pB1[9]), cvtpk(pB1[10], pB1[11]), cvtpk(pB1[12], pB1[13]), cvtpk(pB1[14], pB1[15])};
    const bf16x8 pa0 = __builtin_bit_cast(bf16x8, w0), pa1 = __builtin_bit_cast(bf16x8, w1), pa2 = __builtin_bit_cast(bf16x8, w2), pa3 = __builtin_bit_cast(bf16x8, w3); DA_SBAR();
    ol = __builtin_amdgcn_mfma_f32_32x32x16_bf16(pa0, ones, ol, 0, 0, 0); ol = __builtin_amdgcn_mfma_f32_32x32x16_bf16(pa1, ones, ol, 0, 0, 0);
    ol = __builtin_amdgcn_mfma_f32_32x32x16_bf16(pa2, ones, ol, 0, 0, 0); ol = __builtin_amdgcn_mfma_f32_32x32x16_bf16(pa3, ones, ol, 0, 0, 0);
    pv_d0(o, vbase + c * SLOT, pa0, pa1, pa2, pa3); }
#undef U5_KADDR
#undef U5_KLOAD
#undef U5_PIN
#undef U5_EX
#undef U5_GAPA
#undef U5_CVT
#undef U5_PHASE_A
#undef U5_VRD
#undef U5_PKV
#undef U5_PAF
#undef U5_GAPB
#undef U5_GAPS
#undef U5_GAPN
#undef U5_PHASE_B
  const int tid2 = otid(), wid2 = __builtin_amdgcn_readfirstlane(tid2 >> 6), lane2 = tid2 & 63; { const int r32 = lane2 & 31, hi = lane2 >> 5, mp = wid2 >> 2, wq = wid2 & 3, lane = lane2; float* li_l = (float*)(lds + 6 * SLOT) + wid2 * 64;
  const float sgn = mp ? lam : 1.f;
#pragma unroll
  for (int r = 0; r < 16; ++r) { const float rl = sgn * __builtin_amdgcn_rcpf(ol[r]);
#pragma unroll
    for (int d0 = 0; d0 < 4; ++d0) o[d0][r] *= rl; }
  __syncthreads();
  int xb = wq * 4096 + lane; asm volatile("" : "+v"(xb));
  float* X = (float*)lds + xb;
  if (mp == 1) {
#pragma unroll
    for (int d0 = 0; d0 < 4; ++d0)
#pragma unroll
      for (int r = 0; r < 16; ++r) X[(d0 * 16 + r) * 64] = o[d0][r];
  }
  __syncthreads();
  if (mp == 0) {
    float gg[4];
#pragma unroll
    for (int d0 = 0; d0 < 4; ++d0) gg[d0] = subg[d0 * 32 + r32] * oscale;
    int ob = (wq * 32 + 4 * hi) * ldo + r32; asm volatile("" : "+v"(ob));
    unsigned short* Ow = Ob + ob;
#pragma unroll
    for (int r = 0; r < 16; ++r) { float a = 0.f; float v[4];
#pragma unroll
      for (int d0 = 0; d0 < 4; ++d0) { v[d0] = o[d0][r] - X[(d0 * 16 + r) * 64]; a += v[d0] * v[d0]; }
      a += sx<1>(a); a += sx<2>(a); a += sx<4>(a); a += sx<8>(a); a += sx<16>(a);
      a = rsqrtf(a * (1.f / 128.f) + EPS);
      const int orow = (r & 3) + 8 * (r >> 2);
#pragma unroll
      for (int d0 = 0; d0 < 4; ++d0) Ow[orow * ldo + d0 * 32] = (unsigned short)f2bf(v[d0] * a * gg[d0]); }
  }
  }
  asm volatile("s_waitcnt vmcnt(0)" ::: "memory");
  __syncthreads();
#undef DA_DMA_K
#undef DA_DMA_V
#undef DA_WAITBAR
#undef DA_ROT
#undef DA_PRV
}
}
__device__ __forceinline__ void ph_attn(const Frame& F, const Args& A, int l) {
    const bf16 *Kb = WSP(bf16, WS_KB), *Vb = WSP(bf16, WS_VB), *Qb = WSP(bf16, WS_QB); bf16* MX = WSP(bf16, WS_MIXIN);
    const float* lq = A.in[10] + l * 256; float d01 = 0.f, d23 = 0.f;
    for (int i = 0; i < 64; ++i) { d01 += lq[i] * lq[64 + i]; d23 += lq[128 + i] * lq[192 + i]; }
    const float lam_init = 0.8f - 0.6f * expf(-0.3f * (float)l); float lam = expf(d01) - expf(d23) + lam_init;
    float mq = 0.f, mk = 0.f;
    for (int i = 0; i < 64; ++i) { mq = fmaxf(mq, fabsf(A.in[8][l * 64 + i])); mk = fmaxf(mk, fabsf(A.in[9][l * 64 + i])); }
    const float soff = __uint_as_float(__builtin_amdgcn_readfirstlane(__float_as_uint(64.f * mq * mk * QSCALE)));
    lam = __uint_as_float(__builtin_amdgcn_readfirstlane(__float_as_uint(lam))); const float osc = __uint_as_float(__builtin_amdgcn_readfirstlane(__float_as_uint(1.f - lam_init)));
    const int vcu = (F.G % 8 == 0) ? (F.bid % 8) * (F.G / 8) + F.bid / 8 : F.bid;
    for (int u = vcu; u < (l == DEPTH - 1 ? 1024 : 16 * 66); u += F.G) {
        const int bh = (u % 1024) / 64 , b = bh >> 3, h = bh & 7;
        int qb; int bb = b, hh = h;
        if (u < 1024) qb = 2 + (u & 63); else { const int v = u - 1024; bb = v >> 4; hh = (v >> 1) & 7; qb = v & 1; }
        const size_t R0 = (size_t)bb * TPB + qb * 128; const int seq = qb < 2 ? CTX : TPB;
#if ATTN_V2 == 8
        da::unit8(Qb + R0 * 1024 + hh * 128, Kb + (size_t)bb * TPB * 1024 + hh * 128, Vb + (size_t)bb * TPB * 1024 + hh * 128,
                  MX + R0 * 3072 + hh * 128, 3072, seq, lam, osc, soff, A.in[11] + l * 128, F.lds);
#else
        da::unit(Qb + R0 * 1024 + hh * 128, Kb + (size_t)bb * TPB * 1024 + hh * 128, Vb + (size_t)bb * TPB * 1024 + hh * 128,
                 MX + R0 * 3072 + hh * 128, 3072, seq, lam, osc, soff, A.in[11] + l * 128, (char*)F.lds);
#endif
    }
}

__device__ __forceinline__ void ph_mix(const Frame& F, const Args& A) {
    const float *PA = WSP(float, WS_PA), *PR = WSP(float, WS_PR), *PF = WSP(float, WS_PF); const bf16* GT = WSP(bf16, WS_GATES); bf16* MD = WSP(bf16, WS_MIXED);
    for (long i = F.gtid; i < (long)MROWS * 1024; i += F.NT) { const size_t R = (size_t)(i >> 10); const int c = (int)(i & 1023);
        MD[i] = (bf16)f2bf(bf2f(GT[R * 3072 + c]) * PA[i] + bf2f(GT[R * 3072 + 1024 + c]) * PR[i] + bf2f(GT[R * 3072 + 2048 + c]) * PF[i]); }
}
__device__ __forceinline__ void ph_resid_norm2(const Frame& F, const Args& A, int l) {
    float* X = WSP(float, WS_XALL); const float* Y1 = WSP(float, WS_Y1); bf16* TOK = WSP(bf16, WS_TOK);
    for (int R = F.gw; R < MROWS; R += F.NGW) {
        const int b = R / TPB, p = R % TPB, s = (p < CTX) ? 2 : b; const float* g1 = MODP(l, s, 2);
        f32x4 v[4];
#pragma unroll
        for (int j = 0; j < 4; ++j) { const int c = 4 * F.lane + 256 * j; const f32x4 x = *(const f32x4*)(X + (size_t)R * 1024 + c), y = *(const f32x4*)(Y1 + (size_t)R * 1024 + c), gg = *(const f32x4*)(g1 + c);
            v[j] = x + gg * y; *(f32x4*)(X + (size_t)R * 1024 + c) = v[j]; }
        norm_mod_row(v, A.in[23] + l * 1024, MODP(l, s, 4), MODP(l, s, 3), TOK + (size_t)R * 1024, F.lane);
    }
}
#define G1(T) __attribute__((address_space(1))) T
template <int CTRL, int RM = 0xf> __device__ __forceinline__ float dpp_f(float v) {
    return __uint_as_float(__builtin_amdgcn_update_dpp(__float_as_uint(v), __float_as_uint(v), CTRL, RM, 0xf, false)); }
__device__ __forceinline__ float wave_max63(float v) {
    asm volatile("s_nop 1\n\tv_max_f32_dpp %0, %0, %0 row_ror:1 row_mask:0xf bank_mask:0xf\n\ts_nop 1\n\tv_max_f32_dpp %0, %0, %0 row_ror:2 row_mask:0xf bank_mask:0xf\n\t"
                 "s_nop 1\n\tv_max_f32_dpp %0, %0, %0 row_ror:4 row_mask:0xf bank_mask:0xf\n\ts_nop 1\n\tv_max_f32_dpp %0, %0, %0 row_ror:8 row_mask:0xf bank_mask:0xf\n\t"
                 "s_nop 1\n\tv_max_f32_dpp %0, %0, %0 row_bcast:15 row_mask:0xa bank_mask:0xf\n\ts_nop 1\n\tv_max_f32_dpp %0, %0, %0 row_bcast:31 row_mask:0xc bank_mask:0xf\n\ts_nop 1" : "+v"(v));
    return v; }
template <bool DRY = false> __device__ __forceinline__ void ph_topk(const Frame& F, const Args& A, int l) {
    const float* LG = WSP(float, WS_LOG);
    int* LIST = DRY ? WSP(int, WS_PR) : WSP(int, WS_LIST); float* TOPW = DRY ? WSP(float, WS_PR + 18 * MiB) : WSP(float, WS_TOPW); int* EPO = DRY ? WSP(int, WS_PR + 19 * MiB) : WSP(int, WS_EP);
    int* CNT = (int*)(A.ws + WS_CTL) + CW_CNT + (DRY ? 2 : l) * 256 * CNT_STRIDE;
    const float NEG = -__builtin_inff();
    const bool skipctx = l == DEPTH - 1;
    const f32x4 rb4 = *(const G1(f32x4)*)(A.in[25] + l * 256 + 4 * F.lane);
    constexpr int SLOTS = 9;
    for (int base = F.gw; base < MROWS; base += SLOTS * F.NGW) {
        f32x4 lg[SLOTS]; int es[SLOTS], ps[SLOTS]; float wt[SLOTS];
#pragma unroll
        for (int i = 0; i < SLOTS; ++i) { const int R = base + i * F.NGW; lg[i] = f32x4{0.f, 0.f, 0.f, 0.f}; es[i] = 0; ps[i] = 0; wt[i] = 0.f;
            if (R < MROWS && !(skipctx && (R % TPB) < CTX)) lg[i] = *(const G1(f32x4)*)(LG + (size_t)R * 256 + 4 * F.lane); }
#pragma unroll
        for (int i = 0; i < SLOTS; ++i) { const int R = base + i * F.NGW;
            if (R < MROWS && !(skipctx && (R % TPB) < CTX)) {
                const float sc[4] = {sigmoidf_(lg[i].x), sigmoidf_(lg[i].y), sigmoidf_(lg[i].z), sigmoidf_(lg[i].w)};
                const float bi[4] = {sc[0] + rb4.x, sc[1] + rb4.y, sc[2] + rb4.z, sc[3] + rb4.w};
                float t1 = fmaxf(bi[0], bi[1]), t2 = fminf(bi[0], bi[1]);
                { const float u1 = fmaxf(bi[2], bi[3]), u2 = fminf(bi[2], bi[3]); const float n1 = fmaxf(t1, u1), n2 = fmaxf(fminf(t1, u1), fmaxf(t2, u2)); t1 = n1; t2 = n2; }
#define TK_M2(C) { const float o1 = dpp_f<C>(t1), o2 = dpp_f<C>(t2); const float n1 = fmaxf(t1, o1), n2 = fmaxf(fminf(t1, o1), fmaxf(t2, o2)); t1 = n1; t2 = n2; }
                TK_M2(0xB1) TK_M2(0x4E) TK_M2(0x141)
#undef TK_M2
                const float gs = t1 + t2; const int mygrp = F.lane >> 3; int rank = 0;
#pragma unroll
                for (int j = 0; j < 8; ++j) { const float sj = __uint_as_float(__builtin_amdgcn_readlane(__float_as_uint(gs), j * 8)); rank += (int)(sj > gs) | ((int)(sj == gs) & (int)(j < mygrp)); }
                const bool sel = rank < 4;
                float cand[4];
#pragma unroll
                for (int q = 0; q < 4; ++q) cand[q] = sel ? bi[q] : NEG;
                int my_e = 0; float my_s = 0.f, ssum = 0.f;
#pragma unroll
                for (int k = 0; k < 8; ++k) {
                    float bv = cand[0], bs = sc[0]; int bq = 0;
#pragma unroll
                    for (int q = 1; q < 4; ++q) { const bool g = cand[q] > bv; bv = g ? cand[q] : bv; bs = g ? sc[q] : bs; bq = g ? q : bq; }
                    const float mx = __uint_as_float(__builtin_amdgcn_readlane(__float_as_uint(wave_max63(bv)), 63));
                    const int ol = (int)__builtin_ctzll(__ballot(bv == mx));
                    const int oq = __builtin_amdgcn_readlane(bq, ol); const float sv = __uint_as_float(__builtin_amdgcn_readlane(__float_as_uint(bs), ol));
                    const bool me = F.lane == ol;
#pragma unroll
                    for (int q = 0; q < 4; ++q) cand[q] = (me & (oq == q)) ? NEG : cand[q];
                    ssum += sv;
                    { const int ev = 4 * ol + oq; asm volatile("v_writelane_b32 %0, %1, %2" : "+v"(my_e) : "s"(ev), "n"(k)); asm volatile("v_writelane_b32 %0, %1, %2" : "+v"(my_s) : "s"(sv), "n"(k)); }
                }
                es[i] = my_e; wt[i] = my_s * __builtin_amdgcn_rcpf(ssum) * 2.5f;
            } }
#pragma unroll
        for (int i = 0; i < SLOTS; ++i) { const int R = base + i * F.NGW;
            if (R < MROWS && !(skipctx && (R % TPB) < CTX) && F.lane < 8) ps[i] = __hip_atomic_fetch_add((G1(int)*)(CNT + es[i] * CNT_STRIDE), 1, __ATOMIC_RELAXED, __HIP_MEMORY_SCOPE_AGENT); }
#pragma unroll
        for (int i = 0; i < SLOTS; ++i) { const int R = base + i * F.NGW;
            if (R < MROWS && !(skipctx && (R % TPB) < CTX) && F.lane < 8) {
                *(G1(int)*)(LIST + (size_t)es[i] * LCAP + ps[i]) = R * 8 + F.lane; *(G1(float)*)(TOPW + (size_t)R * 8 + F.lane) = wt[i]; *(G1(int)*)(EPO + (size_t)R * 8 + F.lane) = es[i] * LCAP + ps[i]; } }
    }
}
__device__ __forceinline__ void ph_experts_naive(const Frame& F, const Args& A, int l) {
    const bf16* TOK = WSP(bf16, WS_TOK); const int* LIST = WSP(int, WS_LIST); const float* TOPW = WSP(float, WS_TOPW); float* YB = WSP(float, WS_YB);
    const int* CNT = (const int*)(A.ws + WS_CTL) + CW_CNT + l * 256 * CNT_STRIDE;
    LAS bf16* Xs = (LAS bf16*)F.lds;
    LAS float* Hs = (LAS float*)(F.lds + 65536);
    LAS int* pref = (LAS int*)(F.lds + 98304);
    LAS int* sPair = pref + 320; LAS float* sW = (LAS float*)(sPair + 32);
    __syncthreads();
    if (F.tid == 0) { int s = 0; for (int e = 0; e < 256; ++e) { pref[e] = s; s += (CNT[e] + 31) >> 5; } pref[256] = s; }
    __syncthreads();
    const int total = pref[256];
    for (int id = F.bid; id < total; id += F.G) {
        int lo = 0, hi = 255; while (lo < hi) { const int mid = (lo + hi + 1) >> 1; if (pref[mid] <= id) lo = mid; else hi = mid - 1; }
        const int e = lo, c = id - pref[e], n = min(32, CNT[e] - c * 32);
        __syncthreads();
        if (F.tid < 32) { const int pr = F.tid < n ? LIST[(size_t)e * LCAP + c * 32 + F.tid] : -1; sPair[F.tid] = pr; sW[F.tid] = pr >= 0 ? TOPW[pr] : 0.f; }
        __syncthreads();
        for (int pc = F.tid; pc < 4096; pc += 512) { const int row = pc >> 7, c8 = (pc & 127) * 8, pr = sPair[row];
            v4u v = {0u, 0u, 0u, 0u}; if (pr >= 0) v = *(const v4u*)(TOK + (size_t)(pr >> 3) * 1024 + c8);
            *(LAS v4u*)(Xs + row * 1024 + c8) = v; }
        __syncthreads();
        { const int f = F.tid & 255, gu = F.tid >> 8; const float* W = (gu ? A.in[27] : A.in[26]) + ((size_t)(l * 256 + e) * 1024) * 256 + f;
          float acc[32];
#pragma unroll
          for (int r = 0; r < 32; ++r) acc[r] = 0.f;
          for (int k = 0; k < 1024; ++k) { const float w = W[(size_t)k * 256];
#pragma unroll
              for (int r = 0; r < 32; ++r) acc[r] += bf2f(Xs[r * 1024 + k]) * w; }
          if (gu == 0) {
#pragma unroll
              for (int r = 0; r < 32; ++r) Hs[r * 256 + f] = siluf_(acc[r]); }
          __syncthreads();
          if (gu == 1) {
#pragma unroll
              for (int r = 0; r < 32; ++r) Hs[r * 256 + f] *= acc[r]; }
          __syncthreads(); }
        { const float* Wd = A.in[28] + ((size_t)(l * 256 + e) * 256) * 1024 + F.tid;
          float a0[32], a1[32];
#pragma unroll
          for (int r = 0; r < 32; ++r) { a0[r] = 0.f; a1[r] = 0.f; }
          for (int k = 0; k < 256; ++k) { const float w0 = Wd[(size_t)k * 1024], w1 = Wd[(size_t)k * 1024 + 512];
#pragma unroll
              for (int r = 0; r < 32; ++r) { const float hv = Hs[r * 256 + k]; a0[r] += hv * w0; a1[r] += hv * w1; } }
#pragma unroll
          for (int r = 0; r < 32; ++r) { const int pr = sPair[r]; if (pr >= 0) { const float w = sW[r]; YB[(size_t)pr * 1024 + F.tid] = a0[r] * w; YB[(size_t)pr * 1024 + 512 + F.tid] = a1[r] * w; } } }
    }
}
struct TrItem { const float* W; bf16* WT; int ldw, k0, n0, ldwt, rowbase; };
__device__ __forceinline__ void tr_load(const TrItem& t, f32x4 (&v)[8], int lane) {
    const int rr = lane >> 3, c4 = (lane & 7) * 4;
#pragma unroll
    for (int i = 0; i < 8; ++i) v[i] = __builtin_nontemporal_load((const f32x4*)(t.W + (size_t)(t.k0 + 8 * i + rr) * t.ldw + t.n0 + c4));
}
__device__ __forceinline__ void tr_load_a(const TrItem& t, f32x4 (&v)[8], int lane) {
    const int rr = lane >> 3, c4 = (lane & 7) * 4;
#pragma unroll
    for (int i = 0; i < 8; ++i) { const float* p = t.W + (size_t)(t.k0 + 8 * i + rr) * t.ldw + t.n0 + c4; asm volatile("global_load_dwordx4 %0, %1, off nt" : "=v"(v[i]) : "v"(p) : "memory"); }
}
__device__ __forceinline__ void tr_store(const TrItem& t, const f32x4 (&v)[8], LAS float* scr, int lane) {
    const int rr = lane >> 3, c4 = (lane & 7) * 4;
#pragma unroll
    for (int i = 0; i < 8; ++i) { LAS float* d = scr + (8 * i + rr) * 33 + c4; d[0] = v[i].x; d[1] = v[i].y; d[2] = v[i].z; d[3] = v[i].w; }
    LDS_WAIT(); asm volatile("" ::: "memory");
    const int c = lane & 7;
#pragma unroll
    for (int j = 0; j < 4; ++j) { const int n = (lane >> 3) + 8 * j; const LAS float* sp = scr + (8 * c) * 33 + n;
        v4u o; o.x = pk2(sp[0 * 33], sp[1 * 33]); o.y = pk2(sp[2 * 33], sp[3 * 33]); o.z = pk2(sp[4 * 33], sp[5 * 33]); o.w = pk2(sp[6 * 33], sp[7 * 33]);
        __builtin_nontemporal_store(o, (v4u*)(t.WT + (size_t)(t.rowbase + n) * t.ldwt + t.k0 + 8 * c)); }
    LDS_WAIT(); asm volatile("" ::: "memory");
}
__device__ __forceinline__ TrItem expert_item(const Args& A, int l, int it) {
    const int e = it / 384, r = it % 384; bf16* E1 = (bf16*)(A.ws + EWL(l) + (size_t)e * EW_STRIDE); TrItem t;
    if (r < 256) { const int up = r >> 7, q = r & 127, kb = q >> 3, nb = q & 7, n0 = 32 * nb;
        t.W = (up ? A.in[27] : A.in[26]) + ((size_t)(l * 256 + e) * 1024) * 256; t.ldw = 256; t.k0 = 64 * kb; t.n0 = n0; t.WT = E1; t.ldwt = 1024; t.rowbase = (n0 >> 7) * 256 + up * 128 + (n0 & 127); }
    else { const int q = r - 256, kb = q >> 5, nb = q & 31;
        t.W = A.in[28] + ((size_t)(l * 256 + e) * 256) * 1024; t.ldw = 1024; t.k0 = 64 * kb; t.n0 = 32 * nb; t.WT = E1 + 512 * 1024; t.ldwt = 256; t.rowbase = 32 * nb; }
    return t;
}
__device__ __forceinline__ void ph_expert_w_idx(const Frame& F, const Args& A, int l, int lo, int hi, int ci, int nblk) {
    if (ci < 0 || ci >= nblk) return;
    LAS float* scr = (LAS float*)(F.lds + F.wave * 16384);
    const int stride = nblk * NWAVES; int it = lo + ci * NWAVES + F.wave; if (it >= hi) return;
    f32x4 va[8], vb[8], vc[8]; TrItem ta = expert_item(A, l, it), tb = ta, tc = ta;
    tr_load_a(ta, va, F.lane);
    if (it + stride < hi) { tb = expert_item(A, l, it + stride); tr_load_a(tb, vb, F.lane); }
#define EW_STEP(TP, VP, TS, VS) { if (it + 2 * stride < hi) { TP = expert_item(A, l, it + 2 * stride); tr_load_a(TP, VP, F.lane); asm volatile("s_waitcnt vmcnt(16)" ::: "memory"); } \
        else asm volatile("s_waitcnt vmcnt(0)" ::: "memory"); \
        tr_store(TS, VS, scr, F.lane); it += stride; if (it >= hi) break; }
    for (;;) {
        EW_STEP(tc, vc, ta, va)
        EW_STEP(ta, va, tb, vb)
        EW_STEP(tb, vb, tc, vc)
    }
#undef EW_STEP
}
__device__ __forceinline__ void ph_expert_w(const Frame& F, const Args& A, int l, int lo, int hi, int blk0, int nblk) { ph_expert_w_idx(F, A, l, lo, hi, F.bid - blk0, nblk); }
constexpr int EWI_N = 256 * 384, EWI_A = 9800, EWI_B = 20800, EWI_C = 75000, EWI_D = 90000;
constexpr int KCONV_WIN = 18, KCONV_LRU = 44, KCONV_D = 124;
constexpr int KCONV_RS = 58, Q13 = 12, Q15 = 72, Q16 = 48;
__device__ __forceinline__ int moe_geff(int units, int G) { if (units <= 0) return G; const int rounds = (units + G - 1) / G; return (units + rounds - 1) / rounds; }
constexpr int MOE_MAXU = 11;
struct MoeSched {
    const LAS int* pref; const LAS int* cnt; const int* list; const char* abase; const char* bbase; int npn, G, c, lda2; size_t b_pn_stride; bool gather; LAS int* idx;
    __device__ __forceinline__ bool next(int i, pg8::UnitG& U) const {
        const long id = (long)i * G + c; const int total = pref[256]; if (id >= (long)total * npn) return false;
        const int tau = (int)(id / npn), pn = (int)(id % npn);
        int lo = 0, hi = 255; while (lo < hi) { const int mid = (lo + hi + 1) >> 1; if (pref[mid] <= tau) lo = mid; else hi = mid - 1; }
        const int e = lo, t = tau - pref[e];
        U.e = e; U.pn = pn; U.valid = min(256, cnt[e] - t * 256); U.rows = list + (size_t)e * LCAP + t * 256; U.row0 = tau * 256; U.lrows = idx ? idx + (i % MOE_MAXU) * 256 : nullptr;
        U.a = gather ? abase : abase + (size_t)tau * 256 * lda2; U.b = bbase + (size_t)e * EW_STRIDE + (size_t)pn * b_pn_stride; return true;
    }
};
__device__ __forceinline__ void moe_prefix(const Frame& F, const int* CNT, LAS int* pref) {
    LAS int* tmp = pref + 320;
    __syncthreads();
    if (F.tid < 256) tmp[F.tid] = CNT[F.tid * CNT_STRIDE];
    __syncthreads();
    if (F.tid <= 256) { int sum = 0; for (int e = 0; e < F.tid; ++e) sum += (tmp[e] + 255) >> 8; pref[F.tid] = sum; }
    __syncthreads();
}
struct EpiSwiGLU {
    static constexpr bool PERM = true;
    bf16* HB;
    __device__ __forceinline__ void operator()(const f32x4 (&acc)[2][2][4][2], const pg8::UnitG& u, int wr, int wc, int fr, int fq) const {
#pragma unroll
        for (int ai = 0; ai < 2; ++ai)
#pragma unroll
            for (int m = 0; m < 4; ++m) { const int r = ai * 128 + wr * 64 + m * 16 + fr;
                const f32x4 g0 = acc[ai][0][m][0], g1 = acc[ai][0][m][1], u0 = acc[ai][1][m][0], u1 = acc[ai][1][m][1];
                v4u w; w.x = pk2(siluf_(g0[0]) * u0[0], siluf_(g0[1]) * u0[1]); w.y = pk2(siluf_(g0[2]) * u0[2], siluf_(g0[3]) * u0[3]);
                w.z = pk2(siluf_(g1[0]) * u1[0], siluf_(g1[1]) * u1[1]); w.w = pk2(siluf_(g1[2]) * u1[2], siluf_(g1[3]) * u1[3]);
                *(v4u*)(HB + (size_t)(u.row0 + r) * 256 + u.pn * 128 + wc * 32 + 8 * fq) = w; }
    }
};
struct EpiScatter {
    static constexpr bool PERM = true;
    bf16* Y;
    __device__ __forceinline__ void operator()(const f32x4 (&acc)[2][2][4][2], const pg8::UnitG& u, int wr, int wc, int fr, int fq) const {
#pragma unroll
        for (int ai = 0; ai < 2; ++ai)
#pragma unroll
            for (int m = 0; m < 4; ++m) { const int r = ai * 128 + wr * 64 + m * 16 + fr;
                if (r < u.valid) { bf16* dst = Y + (size_t)(u.row0 + r) * 1024 + u.pn * 256 + wc * 32 + 8 * fq;
#pragma unroll
                    for (int bj = 0; bj < 2; ++bj) { const f32x4 v0 = acc[ai][bj][m][0], v1 = acc[ai][bj][m][1];
                        v4u o; o.x = pk2(v0[0], v0[1]); o.y = pk2(v0[2], v0[3]); o.z = pk2(v1[0], v1[1]); o.w = pk2(v1[2], v1[3]);
                        *(v4u*)(dst + bj * 128) = o; } } }
    }
};
__device__ __forceinline__ int conv_base(const Frame& F, const Args& A, int l) {
    if (l == 0) return 0;
    const int* CNT = (const int*)(A.ws + WS_CTL) + CW_CNT + (l - 1) * 256 * CNT_STRIDE; LAS int* pref = (LAS int*)(F.lds + RING_BYTES + 1024);
    moe_prefix(F, CNT, pref);
    const int tiles = pref[256], k15 = F.G - moe_geff(2 * tiles, F.G), k16 = F.G - moe_geff(4 * tiles, F.G);
    int base = KCONV_RS * NWAVES * Q13 + k15 * NWAVES * Q15 + k16 * NWAVES * Q16;
    __syncthreads();
    return base < EWI_N ? base : EWI_N;
}
__device__ __forceinline__ void ph_experts_up(const Frame& F, const Args& A, int l) {
    const int* CNT = (const int*)(A.ws + WS_CTL) + CW_CNT + l * 256 * CNT_STRIDE; LAS int* pref = (LAS int*)(F.lds + RING_BYTES + 1024);
    moe_prefix(F, CNT, pref);
    const int vcu = (F.G % 8 == 0) ? (F.bid % 8) * (F.G / 8) + F.bid / 8 : F.bid;
    const bool early = l + 1 < DEPTH; const int tiles = pref[256], Ge = early ? moe_geff(2 * tiles, F.G) : F.G;
    if (vcu < Ge) {
        LAS int* idx = (LAS int*)(F.lds + RING_BYTES + 4608);
        MoeSched S{pref, pref + 320, WSP(int, WS_LIST), (const char*)WSP(bf16, WS_TOK), (const char*)(A.ws + EWL(l)), 2, Ge, vcu, 2048, (size_t)256 * 1024 * 2, true, idx};
        { int vals[MOE_MAXU];
#pragma unroll
          for (int i = 0; i < MOE_MAXU; ++i) { pg8::UnitG U; vals[i] = 0; if (S.next(i, U) && F.tid < 256) vals[i] = *(const G1(int)*)(U.rows + min(F.tid, U.valid - 1)); }
#pragma unroll
          for (int i = 0; i < MOE_MAXU; ++i) if (F.tid < 256) idx[i * 256 + F.tid] = vals[i]; }
        __syncthreads();
        EpiSwiGLU E{WSP(bf16, WS_HB)};
        pg8::gemm_phase_g<EpiSwiGLU, MoeSched, true>(F.lds, 1024, 1024, 1024, S, E);
    } else { const int k = F.G - Ge, lo = KCONV_RS * NWAVES * Q13; ph_expert_w_idx(F, A, l + 1, lo, min(EWI_N, lo + k * NWAVES * Q15), vcu - Ge, k); }
    __syncthreads();
}
__device__ __forceinline__ void ph_experts_down(const Frame& F, const Args& A, int l) {
    const int* CNT = (const int*)(A.ws + WS_CTL) + CW_CNT + l * 256 * CNT_STRIDE; LAS int* pref = (LAS int*)(F.lds + RING_BYTES + 1024);
    moe_prefix(F, CNT, pref);
    const int vcu = (F.G % 8 == 0) ? (F.bid % 8) * (F.G / 8) + F.bid / 8 : F.bid;
    const bool early = l + 1 < DEPTH; const int tiles = pref[256], Ge = early ? moe_geff(4 * tiles, F.G) : F.G;
    if (vcu < Ge) {
        MoeSched S{pref, pref + 320, WSP(int, WS_LIST), (const char*)WSP(bf16, WS_HB), (const char*)(A.ws + EWL(l) + 512 * 1024 * 2), 4, Ge, vcu, 512, (size_t)256 * 256 * 2, false, nullptr};
        EpiScatter E{WSP(bf16, WS_Y16)};
        pg8::gemm_phase_g<EpiScatter, MoeSched, false>(F.lds, 256, 256, 256, S, E);
    } else { const int k = F.G - Ge, k15 = F.G - moe_geff(2 * tiles, F.G), lo = KCONV_RS * NWAVES * Q13 + k15 * NWAVES * Q15;
        ph_expert_w_idx(F, A, l + 1, min(EWI_N, lo), min(EWI_N, lo + k * NWAVES * Q16), vcu - Ge, k); }
}
template <bool DRY = false> __device__ __forceinline__ void ph_combine(const Frame& F, const Args& A, int l) {
    const float* X = WSP(float, WS_XALL); float* XO = DRY ? WSP(float, WS_U + 492 * MiB) : WSP(float, WS_XALL); bf16* HO = DRY ? WSP(bf16, WS_U + 558 * MiB) : WSP(bf16, WS_H); const bf16* SD = WSP(bf16, WS_SD); const bf16* YS = WSP(bf16, WS_Y16); const int* EP = WSP(int, WS_EP); const float* TOPW = WSP(float, WS_TOPW);
    const int* CNT = (const int*)(A.ws + WS_CTL) + CW_CNT + l * 256 * CNT_STRIDE; LAS int* pref = (LAS int*)(F.lds + RING_BYTES + 1024);
    moe_prefix(F, CNT, pref);
    for (int R = F.gw; R < MROWS; R += F.NGW) {
        const int b = R / TPB, p = R % TPB, s = (p < CTX) ? 2 : b; const float* g2 = MODP(l, s, 5);
        if (l == DEPTH - 1 && p < CTX) continue;
        size_t so[8]; float wk[8];
#pragma unroll
        for (int k = 0; k < 8; ++k) { const int ep = EP[(size_t)R * 8 + k], e = ep / LCAP, pos = ep - e * LCAP; so[k] = ((size_t)pref[e] * 256 + pos) * 1024; wk[k] = TOPW[(size_t)R * 8 + k]; }
        v4u yv[2][8], sd[2]; f32x4 xin[2][2];
#pragma unroll
        for (int j = 0; j < 2; ++j) { const int c = 8 * F.lane + 512 * j;
#pragma unroll
            for (int k = 0; k < 8; ++k) yv[j][k] = *(const v4u*)(YS + so[k] + c);
            sd[j] = *(const v4u*)(SD + (size_t)R * 1024 + c);
            xin[j][0] = *(const f32x4*)(X + (size_t)R * 1024 + c); xin[j][1] = *(const f32x4*)(X + (size_t)R * 1024 + c + 4); }
        float xo[2][8]; float ss = 0.f;
#pragma unroll
        for (int j = 0; j < 2; ++j) { const int c = 8 * F.lane + 512 * j; float f[8] = {bf2f(sd[j].x & 0xffffu), bf2f(sd[j].x >> 16), bf2f(sd[j].y & 0xffffu), bf2f(sd[j].y >> 16), bf2f(sd[j].z & 0xffffu), bf2f(sd[j].z >> 16), bf2f(sd[j].w & 0xffffu), bf2f(sd[j].w >> 16)};
#pragma unroll
            for (int k = 0; k < 8; ++k) { const unsigned ws[4] = {yv[j][k].x, yv[j][k].y, yv[j][k].z, yv[j][k].w};
#pragma unroll
                for (int q = 0; q < 4; ++q) { f[2 * q] += wk[k] * bf2f(ws[q] & 0xffffu); f[2 * q + 1] += wk[k] * bf2f(ws[q] >> 16); } }
            const f32x4 ga = *(const f32x4*)(g2 + c), gb = *(const f32x4*)(g2 + c + 4);
            const f32x4 xa = xin[j][0] + ga * (f32x4){f[0], f[1], f[2], f[3]}, xb = xin[j][1] + gb * (f32x4){f[4], f[5], f[6], f[7]};
            if (l + 1 < DEPTH || DRY) { *(f32x4*)(XO + (size_t)R * 1024 + c) = xa; *(f32x4*)(XO + (size_t)R * 1024 + c + 4) = xb; }
            if (l == DEPTH - 1 && !DRY) { *(f32x4*)(A.out + ((size_t)b * SEQ + (p - CTX)) * 1024 + c) = xa; *(f32x4*)(A.out + ((size_t)b * SEQ + (p - CTX)) * 1024 + c + 4) = xb; }
            xo[j][0] = xa.x; xo[j][1] = xa.y; xo[j][2] = xa.z; xo[j][3] = xa.w; xo[j][4] = xb.x; xo[j][5] = xb.y; xo[j][6] = xb.z; xo[j][7] = xb.w;
#pragma unroll
            for (int e = 0; e < 8; ++e) ss += xo[j][e] * xo[j][e]; }
        if (l + 1 < DEPTH || DRY) {
            const int ln = DRY ? 0 : l + 1; const float rs = rsqrtf(wave_sum(ss) * (1.f / 1024.f) + EPS);
            const float* gn = A.in[6] + ln * 1024; const float* sc1 = MODP(ln, s, 1); const float* sh1 = MODP(ln, s, 0);
#pragma unroll
            for (int j = 0; j < 2; ++j) { const int c = 8 * F.lane + 512 * j; float y[8];
#pragma unroll
                for (int h = 0; h < 2; ++h) { const f32x4 gg = *(const f32x4*)(gn + c + 4 * h), s1 = *(const f32x4*)(sc1 + c + 4 * h), s0 = *(const f32x4*)(sh1 + c + 4 * h);
                    y[4 * h] = xo[j][4 * h] * rs * gg.x * (1.f + s1.x) + s0.x; y[4 * h + 1] = xo[j][4 * h + 1] * rs * gg.y * (1.f + s1.y) + s0.y;
                    y[4 * h + 2] = xo[j][4 * h + 2] * rs * gg.z * (1.f + s1.z) + s0.z; y[4 * h + 3] = xo[j][4 * h + 3] * rs * gg.w * (1.f + s1.w) + s0.w; }
                v4u o; o.x = pk2(y[0], y[1]); o.y = pk2(y[2], y[3]); o.z = pk2(y[4], y[5]); o.w = pk2(y[6], y[7]);
                *(v4u*)(HO + (size_t)R * 1024 + c) = o; } }
    }
}

struct EpiWin {
    static constexpr bool PERM = true; static constexpr int MIDK = 0;
    bf16 *Kb, *Vb, *Qb, *LXb, *GLG, *ZP, *GT; const float* qg; const float* kg;
    __device__ __forceinline__ void operator()(const f32x4 (&acc)[2][2][4][2], const pg8::Unit& u, int wr, int wc, int fr, int fq) const {
        const int pn = u.pn, sec = pn >> 2;
        if (sec == 0 || sec == 3) {
            const bool isq = sec == 3; const bool lat = (u.pm % 33) != 0;
            bf16* dst = (isq ? Qb : Kb) + (pn & 3) * 256 + wc * 64 + 8 * fq; const float* gn = isq ? qg : kg; const float gs = isq ? QSCALE : 1.f;
            f32x4 g[2][2]; float invf[4];
#pragma unroll
            for (int bj = 0; bj < 2; ++bj)
#pragma unroll
                for (int n = 0; n < 2; ++n) g[bj][n] = *(const f32x4*)(gn + 32 * bj + 16 * n + 4 * fq) * gs;
#pragma unroll
            for (int e = 0; e < 4; ++e) invf[e] = exp2f(-(float)(4 * fq + e) * (13.287712379549449f / 16.f)) * 0.15915494309189535f;
#pragma unroll
            for (int ai = 0; ai < 2; ++ai)
#pragma unroll
                for (int m = 0; m < 4; ++m) { const int R = u.pm * 256 + ai * 128 + wr * 64 + m * 16 + fr, t = (R % TPB) - CTX;
                    float ss = 0.f;
#pragma unroll
                    for (int bj = 0; bj < 2; ++bj)
#pragma unroll
                        for (int n = 0; n < 2; ++n) { const f32x4 v = acc[ai][bj][m][n]; ss += (v[0] * v[0] + v[1] * v[1]) + (v[2] * v[2] + v[3] * v[3]); }
                    ss += sx<16>(ss); ss += sx<32>(ss);
                    const float rs = rsqrtf(ss * (1.f / 64.f) + EPS);
#pragma unroll
                    for (int bj = 0; bj < 2; ++bj) { const float pos = (float)(bj ? (t & 63) : (t >> 6));
                        const f32x4 y1 = acc[ai][bj][m][0] * rs * g[bj][0], y2 = acc[ai][bj][m][1] * rs * g[bj][1]; f32x4 o1 = y1, o2 = y2;
                        if (lat) {
#pragma unroll
                            for (int e = 0; e < 4; ++e) { const float rev = pos * invf[e]; const float cs = __builtin_amdgcn_cosf(rev), sn = __builtin_amdgcn_sinf(rev);
                                o1[e] = y1[e] * cs - y2[e] * sn; o2[e] = y1[e] * sn + y2[e] * cs; } }
                        bf16* p = dst + (size_t)R * 1024 + 32 * bj;
                        v4u ov; ov.x = pk2(o1[0], o1[1]); ov.y = pk2(o1[2], o1[3]); ov.z = pk2(o2[0], o2[1]); ov.w = pk2(o2[2], o2[3]);
                        *(v4u*)p = ov; }
                    asm volatile("" ::: "memory"); }
        } else {
            bf16* base; int ld = 1024, act = 0;
            if (sec == 1) base = Vb + (pn & 3) * 256; else if (sec == 2) base = LXb + (pn & 3) * 256; else if (sec == 4) { base = GLG + (pn & 3) * 256; act = 1; }
            else if (sec == 5) base = ZP + (pn & 3) * 256; else { base = GT + (pn - 24) * 256; ld = 3072; act = 2; }
            base += wc * 32 + 8 * fq;
#pragma unroll
            for (int ai = 0; ai < 2; ++ai)
#pragma unroll
                for (int m = 0; m < 4; ++m) { bf16* rowp = base + (size_t)(u.pm * 256 + ai * 128 + wr * 64 + m * 16 + fr) * ld;
#pragma unroll
                    for (int bj = 0; bj < 2; ++bj) { f32x4 v0 = acc[ai][bj][m][0], v1 = acc[ai][bj][m][1];
                        if (act == 1) {
#pragma unroll
                            for (int e = 0; e < 4; ++e) { v0[e] = gelu_tanh(v0[e]); v1[e] = gelu_tanh(v1[e]); } }
                        else if (act == 2) {
#pragma unroll
                            for (int e = 0; e < 4; ++e) { v0[e] = sigmoidf_(v0[e]); v1[e] = sigmoidf_(v1[e]); } }
                        v4u o; o.x = pk2(v0[0], v0[1]); o.y = pk2(v0[2], v0[3]); o.z = pk2(v1[0], v1[1]); o.w = pk2(v1[2], v1[3]);
                        *(v4u*)(rowp + bj * 128) = o; } }
        }
    }
};

struct EpiMix {
    static constexpr bool PERM = true; static constexpr int MIDK = 16;
    const bf16* GT; bf16* MD;
    __device__ __forceinline__ void mid(f32x4 (&acc)[2][2][4][2], const pg8::Unit& u, int wr, int wc, int fr, int fq, int seg) const {
        const bf16* gb = GT + (size_t)(u.pm * 256 + wr * 64 + fr) * 3072 + (seg - 1) * 1024 + u.pn * 256 + wc * 32 + 8 * fq;
#pragma unroll
        for (int ai = 0; ai < 2; ++ai)
#pragma unroll
            for (int m = 0; m < 4; ++m)
#pragma unroll
                for (int bj = 0; bj < 2; ++bj) { const bf16* p = gb + (size_t)(ai * 128 + m * 16) * 3072 + bj * 128;
                    const v4u a = *(const v4u*)p, b = *(const v4u*)(p + 1024);
                    const unsigned aw[4] = {a.x, a.y, a.z, a.w}, bw[4] = {b.x, b.y, b.z, b.w};
#pragma unroll
                    for (int q = 0; q < 4; ++q) { const float r0 = bf2f(aw[q] & 0xffffu) * __builtin_amdgcn_rcpf(fmaxf(bf2f(bw[q] & 0xffffu), 1e-30f)), r1 = bf2f(aw[q] >> 16) * __builtin_amdgcn_rcpf(fmaxf(bf2f(bw[q] >> 16), 1e-30f));
                        acc[ai][bj][m][q >> 1][(q & 1) * 2] *= r0; acc[ai][bj][m][q >> 1][(q & 1) * 2 + 1] *= r1; } }
    }
    __device__ __forceinline__ void operator()(const f32x4 (&acc)[2][2][4][2], const pg8::Unit& u, int wr, int wc, int fr, int fq) const {
        const size_t r0 = (size_t)(u.pm * 256 + wr * 64 + fr); const int c0 = u.pn * 256 + wc * 32 + 8 * fq;
#pragma unroll
        for (int ai = 0; ai < 2; ++ai)
#pragma unroll
            for (int m = 0; m < 4; ++m)
#pragma unroll
                for (int bj = 0; bj < 2; ++bj) { const size_t R = r0 + ai * 128 + m * 16; const v4u gv = *(const v4u*)(GT + R * 3072 + 2048 + c0 + bj * 128);
                    const f32x4 v0 = acc[ai][bj][m][0], v1 = acc[ai][bj][m][1]; v4u o;
                    o.x = pk2(v0[0] * bf2f(gv.x & 0xffffu), v0[1] * bf2f(gv.x >> 16)); o.y = pk2(v0[2] * bf2f(gv.y & 0xffffu), v0[3] * bf2f(gv.y >> 16));
                    o.z = pk2(v1[0] * bf2f(gv.z & 0xffffu), v1[1] * bf2f(gv.z >> 16)); o.w = pk2(v1[2] * bf2f(gv.w & 0xffffu), v1[3] * bf2f(gv.w >> 16));
                    *(v4u*)(MD + R * 1024 + c0 + bj * 128) = o; }
    }
};
struct EpiResid {
    static constexpr bool PERM = false; static constexpr int MIDK = 0;
    float* X; const float* mod;
    const float* Xin; const float* Cin;
    __device__ __forceinline__ void operator()(const f32x4 (&acc)[2][2][4][2], const pg8::Unit& u, int wr, int wc, int fr, int fq) const {
        const int src = (u.pm % 33 == 0) ? 2 : u.pm / 33; const float* g1 = mod + src * 6144 + 2 * 1024;
        const float* sbase = Xin ? ((u.pm % 33 == 0) ? Cin + (size_t)(u.pm / 33) * CTX * 1024 : Xin + ((size_t)(u.pm / 33) * SEQ + (size_t)(u.pm % 33 - 1) * 256) * 1024) : X + (size_t)u.pm * 256 * 1024;
        const int col0 = u.pn * 256 + wc * 32 + 4 * fq;
        f32x4 gv[2][2];
#pragma unroll
        for (int bj = 0; bj < 2; ++bj)
#pragma unroll
            for (int n = 0; n < 2; ++n) gv[bj][n] = *(const f32x4*)(g1 + col0 + bj * 128 + n * 16);
#pragma unroll
        for (int ai = 0; ai < 2; ++ai)
#pragma unroll
            for (int m = 0; m < 4; ++m) { const size_t ro = (size_t)(ai * 128 + wr * 64 + m * 16 + fr) * 1024 + col0; float* rowp = X + (size_t)u.pm * 256 * 1024 + ro; const float* srow = sbase + ro;
#pragma unroll
                for (int bj = 0; bj < 2; ++bj)
#pragma unroll
                    for (int n = 0; n < 2; ++n) { *(f32x4*)(rowp + bj * 128 + n * 16) = *(const f32x4*)(srow + bj * 128 + n * 16) + gv[bj][n] * acc[ai][bj][m][n]; } }
    }
};
struct EpiRS {
    static constexpr bool PERM = true; static constexpr int MIDK = 0;
    float* LG; bf16* SH;
    __device__ __forceinline__ void operator()(const f32x4 (&acc)[2][2][4][2], const pg8::Unit& u, int wr, int wc, int fr, int fq) const {
#pragma unroll
        for (int ai = 0; ai < 2; ++ai)
#pragma unroll
            for (int m = 0; m < 4; ++m) { const size_t R = (size_t)u.pm * 256 + ai * 128 + wr * 64 + m * 16 + fr;
                if (u.pn == 0) {
#pragma unroll
                    for (int bj = 0; bj < 2; ++bj) { float* p = LG + R * 256 + bj * 128 + wc * 32 + 8 * fq; *(f32x4*)p = acc[ai][bj][m][0]; *(f32x4*)(p + 4) = acc[ai][bj][m][1]; } }
                else { const f32x4 g0 = acc[ai][0][m][0], g1 = acc[ai][0][m][1], u0 = acc[ai][1][m][0], u1 = acc[ai][1][m][1];
                    v4u w; w.x = pk2(siluf_(g0[0]) * u0[0], siluf_(g0[1]) * u0[1]); w.y = pk2(siluf_(g0[2]) * u0[2], siluf_(g0[3]) * u0[3]);
                    w.z = pk2(siluf_(g1[0]) * u1[0], siluf_(g1[1]) * u1[1]); w.w = pk2(siluf_(g1[2]) * u1[2], siluf_(g1[3]) * u1[3]);
                    *(v4u*)(SH + R * 256 + (u.pn - 1) * 128 + wc * 32 + 8 * fq) = w; } }
    }
};
__device__ __forceinline__ void ph_norm2(const Frame& F, const Args& A, int l) {
    const float* X = WSP(float, WS_XALL); bf16* TOK = WSP(bf16, WS_TOK);
    for (int R = F.gw; R < MROWS; R += F.NGW) {
        const int b = R / TPB, p = R % TPB, s = (p < CTX) ? 2 : b;
        if (l == DEPTH - 1 && p < CTX) continue;
        f32x4 v[4];
#pragma unroll
        for (int j = 0; j < 4; ++j) v[j] = *(const f32x4*)(X + (size_t)R * 1024 + 8 * F.lane + 512 * (j >> 1) + 4 * (j & 1));
        norm_mod_row(v, A.in[23] + l * 1024, MODP(l, s, 4), MODP(l, s, 3), TOK + (size_t)R * 1024, F.lane);
    }
}

constexpr int PH_PER_L = 18, N_PHASES = 1 + DEPTH * PH_PER_L;
template <int P, bool DRY = false> __device__ __forceinline__ void run_phase(const Frame& F, const Args& A, int l) {
    if constexpr (P == -1) ph_prologue(F, A);
    if constexpr (P == 0) ph_norm1(F, A, l);
#if !FAST_WIN
#error oracle w_in path removed
#endif
    if constexpr (P == 1) { const int Ge = F.G - KCONV_WIN; const int cb = conv_base(F, A, l);
        if (F.bid < Ge) { pg8::Gemm g{WSP(bf16, WS_H), WLP(l, WO_WIN), MROWS, INW, 1024, 1024, 1024}; pg8::StaticOrder S; S.init(MROWS, INW, Ge, F.bid);
            EpiWin E{WSP(bf16, WS_KB), WSP(bf16, WS_VB), WSP(bf16, WS_QB), WSP(bf16, WS_LXB), WSP(bf16, WS_GLG), WSP(bf16, WS_ZP), WSP(bf16, WS_GATES), A.in[8] + l * 64, A.in[9] + l * 64};
            pg8::gemm_phase(F.lds, g, S, E); }
        else ph_expert_w(F, A, l, min(EWI_N, cb), min(EWI_N, cb + EWI_A), Ge, KCONV_WIN); }
    if constexpr (P == 3) { ph_conv(F, A, l); ph_fft_t1_fast(F, A);
        { const int cb = conv_base(F, A, l); ph_expert_w(F, A, l, min(EWI_N, cb + (l == 0 ? EWI_D : EWI_B)), EWI_N, 0, F.G); } }
    if constexpr (P == 4) {
        { const int cb = conv_base(F, A, l);
          if (F.bid < F.G - KCONV_LRU) ph_lru_gemm(F, A, l, F.G - KCONV_LRU); else ph_expert_w(F, A, l, min(EWI_N, cb + EWI_A), min(EWI_N, cb + EWI_B), F.G - KCONV_LRU, KCONV_LRU); }
        __syncthreads();
#if FAST_FFT_A
        ph_fft_a_gemm(F, A);
#else
        ph_fft_a(F, A);
#endif
        if (l + 1 < DEPTH || DRY) ph_fft_c(F, A);
    }
    if constexpr (P == 5) {
        ph_scan1(F, A);
#if FAST_FFT_B
        ph_fft_b_gemm(F, A);
#else
        ph_fft_b(F, A);
#endif
    }
    if constexpr (P == 6) { ph_scan2_fast(F, A); ph_fft_t2_fast(F, A, l); }
    if constexpr (P == 7) { ph_scan3(F, A, l);
#if FAST_ATTN
        ph_attn(F, A, l);
#endif
    }
    if constexpr (P == 8) {
#if !FAST_ATTN
        ph_attn_naive(F, A, l);
#endif
        __syncthreads(); }
#if FAST_MIX
    if constexpr (P == 9) { const bool sp = (l == 0) && F.G > 2 * KCONV_D; const int Ge = sp ? F.G - KCONV_D : F.G;
        if (F.bid < Ge) { pg8::Gemm g{WSP(bf16, WS_MIXIN), WLP(l, WO_D1), MROWS, 1024, 3072, 3072, 3072}; pg8::StaticOrder S; S.init(MROWS, 1024, Ge, F.bid, l == DEPTH - 1);
            EpiMix E{WSP(bf16, WS_GATES), WSP(bf16, WS_MIXED)}; pg8::gemm_phase(F.lds, g, S, E); }
        else ph_expert_w(F, A, l, EWI_B, EWI_C, Ge, KCONV_D); }
    if constexpr (P == 11) { const bool sp = (l == 0) && F.G > 2 * KCONV_D; const int Ge = sp ? F.G - KCONV_D : F.G;
        if (F.bid < Ge) { pg8::Gemm g{WSP(bf16, WS_MIXED), WLP(l, WO_OUT), MROWS, 1024, 1024, 1024, 1024}; pg8::StaticOrder S; S.init(MROWS, 1024, Ge, F.bid, l == DEPTH - 1);
            EpiResid E{WSP(float, WS_XALL), (const float*)(A.ws + WS_CTL) + CW_MOD + l * 3 * 6144, l == 0 ? A.in[0] : nullptr, l == 0 ? A.in[2] : nullptr}; pg8::gemm_phase(F.lds, g, S, E); }
        else ph_expert_w(F, A, l, EWI_C, EWI_D, Ge, KCONV_D); }
    if constexpr (P == 12) ph_norm2(F, A, l);
#else
    if constexpr (P == 9) {
        { pg8::Gemm g{WSP(bf16, WS_MIXIN), WLP(l, WO_D1), MROWS, 1024, 1024, 3072, 3072}; pg8::StaticOrder S; S.init(MROWS, 1024, F.G, F.bid); pg8::EpiF32 E{WSP(float, WS_PA), 1024}; pg8::gemm_phase(F.lds, g, S, E); }
        { pg8::Gemm g{WSP(bf16, WS_MIXIN) + 1024, WLP(l, WO_D1) + 1024, MROWS, 1024, 1024, 3072, 3072}; pg8::StaticOrder S; S.init(MROWS, 1024, F.G, F.bid); pg8::EpiF32 E{WSP(float, WS_PR), 1024}; pg8::gemm_phase(F.lds, g, S, E); }
        { pg8::Gemm g{WSP(bf16, WS_MIXIN) + 2048, WLP(l, WO_D1) + 2048, MROWS, 1024, 1024, 3072, 3072}; pg8::StaticOrder S; S.init(MROWS, 1024, F.G, F.bid); pg8::EpiF32 E{WSP(float, WS_PF), 1024}; pg8::gemm_phase(F.lds, g, S, E); } }
    if constexpr (P == 10) ph_mix(F, A);
    if constexpr (P == 11) { pg8::Gemm g{WSP(bf16, WS_MIXED), WLP(l, WO_OUT), MROWS, 1024, 1024, 1024, 1024}; pg8::StaticOrder S; S.init(MROWS, 1024, F.G, F.bid);
        pg8::EpiF32 E{WSP(float, WS_Y1), 1024}; pg8::gemm_phase(F.lds, g, S, E); }
    if constexpr (P == 12) ph_resid_norm2(F, A, l);
#endif
    if constexpr (P == 13) { const bool early = l + 1 < DEPTH; const int Ge = early ? F.G - KCONV_RS : F.G;
        if (F.bid < Ge) { pg8::Gemm g{WSP(bf16, WS_TOK), WLP(l, WO_R), MROWS, 768, 1024, 1024, 1024}; pg8::StaticOrder S; S.init(MROWS, 768, Ge, F.bid, l == DEPTH - 1);
            EpiRS E{WSP(float, WS_LOG), WSP(bf16, WS_SH)}; pg8::gemm_phase(F.lds, g, S, E); }
        else ph_expert_w(F, A, l + 1, 0, KCONV_RS * NWAVES * Q13, Ge, KCONV_RS); }
    if constexpr (P == 14) ph_topk<DRY>(F, A, l);
    if constexpr (P == 15) {
#if FAST_MOE
        ph_experts_up(F, A, l);
#else
        ph_experts_naive(F, A, l); __syncthreads();
#endif

        { pg8::Gemm g{WSP(bf16, WS_SH), WLP(l, WO_SD), MROWS, 1024, 256, 256, 256}; pg8::StaticOrder S; S.init(MROWS, 1024, F.G, F.bid, l == DEPTH - 1); EpiBf16U E{WSP(bf16, WS_SD), 1024}; pg8::gemm_phase(F.lds, g, S, E); } }
    if constexpr (P == 16) {
#if FAST_MOE
        ph_experts_down(F, A, l);
#endif
    }
    if constexpr (P == 17) ph_combine<DRY>(F, A, l);
}
__device__ __forceinline__ Frame make_frame(unsigned char* lds) {
    Frame F; F.lds = (LAS unsigned char*)lds; F.tid = otid(); F.lane = F.tid & 63; F.wave = __builtin_amdgcn_readfirstlane(F.tid >> 6);
    F.bid = obid(); F.G = ogrid(); F.gw = F.bid * NWAVES + F.wave; F.NGW = F.G * NWAVES; F.gtid = (long)F.bid * 512 + F.tid; F.NT = (long)F.G * 512;
    return F;
}
template <int P> __global__ void __launch_bounds__(NWAVES * 64, 2) mk_phase(Args A) {
    extern __shared__ __attribute__((aligned(16))) unsigned char lds[];
    const Frame F = make_frame(lds);
    run_phase<P>(F, A, A.ph_lo);
}
#if N_LAUNCH_MODE == 1
__device__ __forceinline__ const float* lds_ptr(const LAS unsigned long long* tab, int i) {
    const unsigned long long v = tab[i];
    const unsigned lo = __builtin_amdgcn_readfirstlane((unsigned)v), hi = __builtin_amdgcn_readfirstlane((unsigned)(v >> 32));
    return (const float*)(const __attribute__((address_space(1))) float*)(((unsigned long long)hi << 32) | lo);
}
__device__ __forceinline__ void load_args(Args& L, const LAS unsigned long long* tab) {
#pragma unroll
    for (int i = 0; i < 32; ++i) L.in[i] = lds_ptr(tab, i);
    L.out = (float*)lds_ptr(tab, 32); L.ws = (unsigned char*)lds_ptr(tab, 33); L.ph_lo = 0; L.ph_hi = 0;
}
__global__ void __launch_bounds__(NWAVES * 64, 2) mk_fwd(Args A) {
    extern __shared__ __attribute__((aligned(16))) unsigned char lds[];
    LAS unsigned char* L3 = (LAS unsigned char*)lds;
    volatile LAS unsigned* MISC = (volatile LAS unsigned*)(L3 + MISC_OFF);
    for (int u = threadIdx.x; u < (LDS_BYTES - RING_BYTES) / 4; u += NWAVES * 64) ((LAS unsigned*)(L3 + RING_BYTES))[u] = 0u;
    __syncthreads();
    LAS unsigned long long* tab = (LAS unsigned long long*)(L3 + RING_BYTES + 4096);
    if (threadIdx.x == 0) {
#define ST(i) tab[i] = (unsigned long long)A.in[i];
        ST(0) ST(1) ST(2) ST(3) ST(4) ST(5) ST(6) ST(7) ST(8) ST(9) ST(10) ST(11) ST(12) ST(13) ST(14) ST(15) ST(16) ST(17) ST(18) ST(19) ST(20) ST(21) ST(22) ST(23) ST(24) ST(25) ST(26) ST(27) ST(28) ST(29) ST(30) ST(31)
#undef ST
        tab[32] = (unsigned long long)A.out; tab[33] = (unsigned long long)A.ws;
    }
    __syncthreads();
    (void)xcd_barrier_post((unsigned*)(A.ws + WS_CTL) + CW_BAR, MISC + 8);
#define RUN(P) do { asm volatile("; PHASE_MARK " #P); { unsigned tb_ = RING_BYTES + 4096; asm volatile("" : "+v"(tb_)); Args L; load_args(L, (const LAS unsigned long long*)(L3 + tb_)); \
        const Frame F = make_frame(lds); run_phase<P>(F, L, l); \
        if constexpr (P >= 0 && ((REP_MASK >> (P < 0 ? 0 : P)) & 1)) { for (int rp_ = 0; rp_ < REP_N; ++rp_) { asm volatile("s_waitcnt vmcnt(0)" ::: "memory"); __syncthreads(); run_phase<P, true>(F, L, l); } } \
        XcdBarrier bar; bar.bar = (unsigned*)(L.ws + WS_CTL) + CW_BAR; bar.x = xb_xcc_id(); { unsigned mo_ = MISC_OFF + 32; asm volatile("" : "+v"(mo_)); bar.st = (volatile LAS unsigned*)(L3 + mo_); } \
        xcd_barrier(bar); } } while (0)
    { const int l = 0; RUN(-1);
#if REP_PRO
      for (int rp_ = 0; rp_ < 2; ++rp_) { RUN(-1); }
#endif
    }
    for (int l = 0; l < DEPTH; ++l) {
        if (l == 0) RUN(0);
        RUN(1); RUN(3); RUN(4); RUN(5); RUN(6); RUN(7); RUN(9); RUN(11); RUN(12); RUN(13); RUN(14); RUN(15); RUN(16); RUN(17);
    }
#undef RUN
}
#endif

extern "C" void kernel_launch(void* const* d_in, const int* in_sizes, int n_in, void* d_out, int out_size, void* d_ws, size_t ws_size, hipStream_t stream) {
    static int grid = 0;
    if (grid == 0) {
        if (n_in != 32 || out_size != NB * SEQ * DM || ws_size < WS_END) { fprintf(stderr, "kernel_launch: unexpected shapes (n_in %d, out %d, ws %zu < %zu)\n", n_in, out_size, ws_size, (size_t)WS_END); grid = -1; return; }
        int dev = 0, cus = 0;
        if (hipGetDevice(&dev) != hipSuccess || hipDeviceGetAttribute(&cus, hipDeviceAttributeMultiprocessorCount, dev) != hipSuccess) { grid = -1; return; }
#define SETA(K) if (hipFuncSetAttribute((const void*)K, hipFuncAttributeMaxDynamicSharedMemorySize, LDS_BYTES) != hipSuccess) { fprintf(stderr, "kernel_launch: hipFuncSetAttribute failed\n"); grid = -1; return; }
#if N_LAUNCH_MODE == 1
        SETA(mk_fwd)
#else
        SETA(mk_phase<-1>) SETA(mk_phase<0>) SETA(mk_phase<1>) SETA(mk_phase<2>) SETA(mk_phase<3>) SETA(mk_phase<4>) SETA(mk_phase<5>) SETA(mk_phase<6>) SETA(mk_phase<7>) SETA(mk_phase<8>)
        SETA(mk_phase<9>) SETA(mk_phase<10>) SETA(mk_phase<11>) SETA(mk_phase<12>) SETA(mk_phase<13>) SETA(mk_phase<14>) SETA(mk_phase<15>) SETA(mk_phase<16>) SETA(mk_phase<17>)
#endif
#undef SETA
        int per_cu = 0;
        (void)per_cu;
        if (cus * MOE_MAXU < 2 * (NPAIR / 256 + 256)) { fprintf(stderr, "kernel_launch: too few CUs (%d) for the staged MoE row lists\n", cus); grid = -1; return; }
        grid = cus;
    }
    if (grid < 0) return;
    (void)hipMemsetAsync((char*)d_ws + WS_CTL, 0, CTL_ZERO_BYTES, stream);
    Args a{};
    for (int i = 0; i < 32; ++i) a.in[i] = (const float*)d_in[i];
    a.out = (float*)d_out; a.ws = (unsigned char*)d_ws;
#if N_LAUNCH_MODE == 1
    a.ph_lo = 0; a.ph_hi = N_PHASES;
    hipLaunchKernelGGL(mk_fwd, dim3(grid), dim3(NWAVES * 64), LDS_BYTES, stream, a);
#else
#define LAUNCH_P(P) hipLaunchKernelGGL(mk_phase<P>, dim3(grid), dim3(NWAVES * 64), LDS_BYTES, stream, a)
    a.ph_lo = 0; a.ph_hi = 0; LAUNCH_P(-1);
    for (int l = 0; l < DEPTH; ++l) { a.ph_lo = l;
        LAUNCH_P(0); LAUNCH_P(1); LAUNCH_P(2); LAUNCH_P(3); LAUNCH_P(4); LAUNCH_P(5); LAUNCH_P(6); LAUNCH_P(7); LAUNCH_P(8); LAUNCH_P(9); LAUNCH_P(10); LAUNCH_P(11); LAUNCH_P(12); LAUNCH_P(13); LAUNCH_P(14); LAUNCH_P(15); LAUNCH_P(16); LAUNCH_P(17); }
#undef LAUNCH_P
#endif
    const hipError_t le = hipPeekAtLastError();
    if (le != hipSuccess) fprintf(stderr, "kernel_launch: launch failed: %s\n", hipGetErrorName(le));
}
```
